# Optimizing an MI355X kernel written in HIP

```python
import math
import jax
import jax.numpy as jnp
from jax import lax
import numpy as np

D_MODEL = 1024
BATCH = 8
SEQ = 4096
DEPTH = 2

D_SSM = D_MODEL // 2
SSM_GROUP = 16
N_SSM_GROUPS = D_SSM // SSM_GROUP
SSM_STATE = 64
HEAD_DIM = 64
D_ATTN = D_MODEL - D_SSM
N_HEADS = D_ATTN // HEAD_DIM
N_KV_HEADS = 2
GQA = N_HEADS // N_KV_HEADS
D_KV = N_KV_HEADS * HEAD_DIM
D_IN = D_SSM + D_ATTN + 6 * D_KV + 3 * N_HEADS
CMP_BLOCK = 32
CMP_STRIDE = 16
SEL_BLOCK = 64
SEL_TOPK = 16
N_LOCAL_BLOCKS = 2
WINDOW = 512
Q_BLOCK = 128
N_BUCKETS = 32
MAX_DISTANCE = 128
N_GROUPS = 4
EXPERTS_PER_GROUP = 8
TOPK_EXPERT = 2
D_EXPERT = D_MODEL // 4
EPS = 1e-6
NEG = -1e30
BIG = 1e9

kernel_name = 'hymba_s5_nsa_hier_moe_block'


def _rmsnorm(x, g):
    x32 = x.astype(jnp.float32)
    y = x32 * lax.rsqrt(jnp.mean(x32 * x32, axis=-1, keepdims=True) + EPS)
    return (y * g.astype(jnp.float32)).astype(x.dtype)


def _t5_bucket(dist):
    n = jnp.maximum(dist, 0)
    max_exact = N_BUCKETS // 2
    nf = jnp.maximum(n, 1).astype(jnp.float32)
    large = max_exact + (jnp.log(nf / max_exact) / math.log(MAX_DISTANCE / max_exact)
                         * (N_BUCKETS - max_exact)).astype(jnp.int32)
    large = jnp.minimum(large, N_BUCKETS - 1)
    return jnp.where(n < max_exact, n, large)


def _masked_softmax(s, valid):
    p = jax.nn.softmax(jnp.where(valid, s, NEG), axis=-1)
    return jnp.where(valid, p, 0.0)


def _s5_mixer(u, a_re, a_im, b_re, b_im, c_re, c_im, d, log_dt, w_glu):
    bsz, seq, _ = u.shape
    f32 = jnp.float32
    u32 = u.astype(f32).reshape(bsz, seq, N_SSM_GROUPS, SSM_GROUP)
    lam = lax.complex(a_re.astype(f32), a_im.astype(f32))
    dt = jnp.exp(log_dt.astype(f32))[:, None]
    lam_bar = jnp.exp(lam * dt)
    b = lax.complex(b_re.astype(f32), b_im.astype(f32))
    b_bar = ((lam_bar - 1.0) / lam)[..., None] * b
    c = lax.complex(c_re.astype(f32), c_im.astype(f32))
    bu = jnp.einsum('blgh,gph->blgp', u32, b_bar)
    a = jnp.broadcast_to(lam_bar, bu.shape)

    def combine(left, right):
        a1, b1 = left
        a2, b2 = right
        return a1 * a2, a2 * b1 + b2

    _, states = lax.associative_scan(combine, (a, bu), axis=1)
    y = jnp.real(jnp.einsum('blgp,ghp->blgh', states, c)) + d.astype(f32) * u32
    y = jax.nn.gelu(y.reshape(bsz, seq, D_SSM)).astype(u.dtype)
    ya, yb = jnp.split(y @ w_glu, 2, axis=-1)
    return ya * jax.nn.sigmoid(yb)


def _nsa_mixer(q, k_cmp, v_cmp, k_sel, v_sel, k_win, v_win, gates,
               cmp_pos, cmp_w1, cmp_w2, rel_bias):
    f32 = jnp.float32
    bsz, seq = q.shape[:2]
    dtype = q.dtype
    scale = HEAD_DIM ** -0.5
    q = q.reshape(bsz, seq, N_KV_HEADS, GQA, HEAD_DIM)
    kvs = [a.reshape(bsz, seq, N_KV_HEADS, HEAD_DIM) for a in (k_cmp, v_cmp, k_sel, v_sel, k_win, v_win)]
    k_cmp, v_cmp, k_sel, v_sel, k_win, v_win = kvs
    bias_tab = rel_bias.astype(f32).reshape(N_BUCKETS, N_KV_HEADS, GQA)
    t = jnp.arange(seq)

    n_cmp = (seq - CMP_BLOCK) // CMP_STRIDE + 1
    cidx = np.arange(n_cmp)[:, None] * CMP_STRIDE + np.arange(CMP_BLOCK)[None, :]

    def compress(kv, i):
        blocks = kv[:, cidx] + cmp_pos[i][None, None, :, None, :]
        hid = jax.nn.gelu(jnp.einsum('bnlhd,lde->bnhe', blocks, cmp_w1[i]))
        return jnp.einsum('bnhe,ef->bnhf', hid, cmp_w2[i])

    kc = compress(k_cmp, 0)
    vc = compress(v_cmp, 1)
    cmp_end = jnp.asarray(cidx[:, -1])
    dist_c = t[:, None] - cmp_end[None, :]
    valid_c = dist_c >= 0
    bias_c = bias_tab[_t5_bucket(dist_c)].transpose(2, 3, 0, 1)
    s_c = jnp.einsum('bthgd,bnhd->bhgtn', q, kc).astype(f32) * scale + bias_c
    p_c = _masked_softmax(s_c, valid_c)
    o_cmp = jnp.einsum('bhgtn,bnhd->bthgd', p_c.astype(dtype), vc)

    n_sel = seq // SEL_BLOCK
    cs = np.arange(n_cmp)[:, None] * CMP_STRIDE
    ss = np.arange(n_sel)[None, :] * SEL_BLOCK
    overlap = np.clip(np.minimum(cs + CMP_BLOCK, ss + SEL_BLOCK) - np.maximum(cs, ss), 0, None) / CMP_BLOCK
    overlap = jnp.asarray(overlap, dtype=f32)
    imp = jnp.einsum('bhgtn,nj->bhtj', p_c, overlap)
    j = jnp.arange(n_sel)[None, :]
    blk_t = (t // SEL_BLOCK)[:, None]
    forced = (j == 0) | ((j <= blk_t) & (j > blk_t - N_LOCAL_BLOCKS))
    future = j > blk_t
    imp = jnp.where(forced, BIG, jnp.where(future, -BIG, imp))
    n_top = min(SEL_TOPK, n_sel)
    _, sel_idx = lax.top_k(imp, n_top)

    k_blk = k_sel.reshape(bsz, n_sel, SEL_BLOCK, N_KV_HEADS, HEAD_DIM).transpose(0, 3, 1, 2, 4)
    v_blk = v_sel.reshape(bsz, n_sel, SEL_BLOCK, N_KV_HEADS, HEAD_DIM).transpose(0, 3, 1, 2, 4)
    pad = ((0, 0), (WINDOW, 0), (0, 0), (0, 0))
    k_win_p = jnp.pad(k_win, pad)
    v_win_p = jnp.pad(v_win, pad)
    bi = jnp.arange(bsz)[:, None, None, None]
    hi = jnp.arange(N_KV_HEADS)[None, :, None, None]
    inner = jnp.arange(SEL_BLOCK)
    win_off = jnp.arange(Q_BLOCK + WINDOW) - WINDOW
    n_sk = n_top * SEL_BLOCK

    def query_block(c):
        t0 = c * Q_BLOCK
        tq = t0 + jnp.arange(Q_BLOCK)
        qc = lax.dynamic_slice_in_dim(q, t0, Q_BLOCK, axis=1)
        ic = lax.dynamic_slice_in_dim(sel_idx, t0, Q_BLOCK, axis=2)
        ks = k_blk[bi, hi, ic].reshape(bsz, N_KV_HEADS, Q_BLOCK, n_sk, HEAD_DIM)
        vs = v_blk[bi, hi, ic].reshape(bsz, N_KV_HEADS, Q_BLOCK, n_sk, HEAD_DIM)
        pos_s = (ic[..., None] * SEL_BLOCK + inner).reshape(bsz, N_KV_HEADS, Q_BLOCK, n_sk)
        dist_s = tq[None, None, :, None] - pos_s
        bias_s = jnp.moveaxis(bias_tab[_t5_bucket(dist_s), hi], -1, 2)
        s_s = jnp.einsum('bqhgd,bhqsd->bhgqs', qc, ks).astype(f32) * scale + bias_s
        p_s = _masked_softmax(s_s, (dist_s >= 0)[:, :, None])
        o_s = jnp.einsum('bhgqs,bhqsd->bqhgd', p_s.astype(dtype), vs)
        kw = lax.dynamic_slice_in_dim(k_win_p, t0, Q_BLOCK + WINDOW, axis=1)
        vw = lax.dynamic_slice_in_dim(v_win_p, t0, Q_BLOCK + WINDOW, axis=1)
        pos_w = t0 + win_off
        dist_w = tq[:, None] - pos_w[None, :]
        valid_w = (dist_w >= 0) & (dist_w < WINDOW) & (pos_w[None, :] >= 0)
        bias_w = bias_tab[_t5_bucket(dist_w)].transpose(2, 3, 0, 1)
        s_w = jnp.einsum('bqhgd,bkhd->bhgqk', qc, kw).astype(f32) * scale + bias_w
        p_w = _masked_softmax(s_w, valid_w)
        o_w = jnp.einsum('bhgqk,bkhd->bqhgd', p_w.astype(dtype), vw)
        return o_s, o_w

    o_sel, o_win = lax.map(query_block, jnp.arange(seq // Q_BLOCK))

    def unblock(o):
        return jnp.moveaxis(o, 0, 1).reshape(bsz, seq, N_KV_HEADS, GQA, HEAD_DIM)

    g = jax.nn.sigmoid(gates.astype(f32)).reshape(bsz, seq, N_KV_HEADS, GQA, 3).astype(dtype)
    o = g[..., 0:1] * o_cmp + g[..., 1:2] * unblock(o_sel) + g[..., 2:3] * unblock(o_win)
    return o.reshape(bsz, seq, D_ATTN)


def _hier_moe(h, rg_w, rg_b, re_w, re_b, w_gate, w_up, w_down):
    f32 = jnp.float32
    bsz, seq, d = h.shape
    ht = h.reshape(-1, d)
    pg = jax.nn.softmax((ht @ rg_w + rg_b).astype(f32), axis=-1)
    g_val, g_idx = lax.top_k(pg, 1)
    le = (jnp.einsum('td,ode->toe', ht, re_w) + re_b).astype(f32)
    le = jnp.take_along_axis(le, g_idx[:, :, None], axis=1)[:, 0]
    pe = jax.nn.softmax(le, axis=-1)
    e_val, e_idx = lax.top_k(pe, TOPK_EXPERT)
    e_val = e_val / jnp.sum(e_val, axis=-1, keepdims=True)
    w = g_val * e_val
    coef = jnp.sum(jax.nn.one_hot(e_idx, EXPERTS_PER_GROUP, dtype=f32) * w[..., None], axis=1)
    out = jnp.zeros_like(ht)
    for o in range(N_GROUPS):
        c_o = jnp.where(g_idx == o, coef, 0.0).astype(h.dtype)
        hid = jax.nn.silu(jnp.einsum('td,edf->tef', ht, w_gate[o])) * jnp.einsum('td,edf->tef', ht, w_up[o])
        out = out + jnp.einsum('tef,efd->td', hid * c_o[:, :, None], w_down[o])
    return out.reshape(bsz, seq, d)


def setup_inputs(seed: int = 0) -> dict:
    key = jax.random.key(seed)
    ks = jax.random.split(key, 28)

    def nrm(k, shape, scale):
        return scale * jax.random.normal(k, shape, dtype=jnp.float32)

    L = DEPTH
    G, P, H = N_SSM_GROUPS, SSM_STATE, SSM_GROUP
    return {
        'x': nrm(ks[0], (BATCH, SEQ, D_MODEL), 1.0),
        'norm1_g': 1.0 + nrm(ks[1], (L, D_MODEL), 0.02),
        'norm2_g': 1.0 + nrm(ks[2], (L, D_MODEL), 0.02),
        'final_g': 1.0 + nrm(ks[3], (D_MODEL,), 0.02),
        'w_in': nrm(ks[4], (L, D_MODEL, D_IN), D_MODEL ** -0.5),
        'w_out': nrm(ks[5], (L, D_SSM + D_ATTN, D_MODEL), (D_SSM + D_ATTN) ** -0.5),
        'ssm_a_re': -0.5 + nrm(ks[6], (L, G, P), 0.01),
        'ssm_a_im': math.pi * jnp.arange(P, dtype=jnp.float32)[None, None, :] + nrm(ks[7], (L, G, P), 0.01),
        'ssm_b_re': nrm(ks[8], (L, G, P, H), (0.5 / H) ** 0.5),
        'ssm_b_im': nrm(ks[9], (L, G, P, H), (0.5 / H) ** 0.5),
        'ssm_c_re': nrm(ks[10], (L, G, H, P), (0.5 / P) ** 0.5),
        'ssm_c_im': nrm(ks[11], (L, G, H, P), (0.5 / P) ** 0.5),
        'ssm_d': nrm(ks[12], (L, G, H), 1.0),
        'ssm_log_dt': jax.random.uniform(ks[13], (L, G), dtype=jnp.float32,
                                         minval=math.log(1e-3), maxval=math.log(1e-1)),
        'ssm_w_glu': nrm(ks[14], (L, D_SSM, 2 * D_SSM), D_SSM ** -0.5),
        'cmp_pos': nrm(ks[15], (L, 2, CMP_BLOCK, HEAD_DIM), 0.02),
        'cmp_w1': nrm(ks[16], (L, 2, CMP_BLOCK, HEAD_DIM, HEAD_DIM), (CMP_BLOCK * HEAD_DIM) ** -0.5),
        'cmp_w2': nrm(ks[17], (L, 2, HEAD_DIM, HEAD_DIM), HEAD_DIM ** -0.5),
        'rel_bias': nrm(ks[18], (N_BUCKETS, N_HEADS), 0.5),
        'router_g_w': nrm(ks[19], (L, D_MODEL, N_GROUPS), D_MODEL ** -0.5),
        'router_g_b': nrm(ks[20], (L, N_GROUPS), 0.01),
        'router_e_w': nrm(ks[21], (L, N_GROUPS, D_MODEL, EXPERTS_PER_GROUP), D_MODEL ** -0.5),
        'router_e_b': nrm(ks[22], (L, N_GROUPS, EXPERTS_PER_GROUP), 0.01),
        'exp_w_gate': nrm(ks[23], (L, N_GROUPS, EXPERTS_PER_GROUP, D_MODEL, D_EXPERT), D_MODEL ** -0.5),
        'exp_w_up': nrm(ks[24], (L, N_GROUPS, EXPERTS_PER_GROUP, D_MODEL, D_EXPERT), D_MODEL ** -0.5),
        'exp_w_down': nrm(ks[25], (L, N_GROUPS, EXPERTS_PER_GROUP, D_EXPERT, D_MODEL), D_EXPERT ** -0.5),
    }


def reference(x, norm1_g, norm2_g, final_g, w_in, w_out, ssm_a_re, ssm_a_im, ssm_b_re, ssm_b_im,
              ssm_c_re, ssm_c_im, ssm_d, ssm_log_dt, ssm_w_glu, cmp_pos, cmp_w1, cmp_w2, rel_bias,
              router_g_w, router_g_b, router_e_w, router_e_b, exp_w_gate, exp_w_up, exp_w_down):
    o_q = D_SSM
    o_kv = D_SSM + D_ATTN
    o_g = o_kv + 6 * D_KV
    for l in range(DEPTH):
        h = _rmsnorm(x, norm1_g[l])
        z = h @ w_in[l]
        u_ssm = z[..., :o_q]
        q = z[..., o_q:o_kv]
        k_cmp, v_cmp, k_sel, v_sel, k_win, v_win = jnp.split(z[..., o_kv:o_g], 6, axis=-1)
        gates = z[..., o_g:]
        y_ssm = _s5_mixer(u_ssm, ssm_a_re[l], ssm_a_im[l], ssm_b_re[l], ssm_b_im[l],
                          ssm_c_re[l], ssm_c_im[l], ssm_d[l], ssm_log_dt[l], ssm_w_glu[l])
        y_attn = _nsa_mixer(q, k_cmp, v_cmp, k_sel, v_sel, k_win, v_win, gates,
                            cmp_pos[l], cmp_w1[l], cmp_w2[l], rel_bias)
        x = x + jnp.concatenate([y_ssm, y_attn], axis=-1) @ w_out[l]
        h = _rmsnorm(x, norm2_g[l])
        x = x + _hier_moe(h, router_g_w[l], router_g_b[l], router_e_w[l], router_e_b[l],
                          exp_w_gate[l], exp_w_up[l], exp_w_down[l])
    return _rmsnorm(x, final_g)
```

```cpp
#include <hip/hip_runtime.h>
#include <cstdio>
#include <cstdint>

#ifndef N_LAUNCH_MODE
#define N_LAUNCH_MODE 1
#endif

#define GAS __attribute__((address_space(1)))
#define LAS __attribute__((address_space(3)))
typedef unsigned short bf16;
typedef float f32x4 __attribute__((ext_vector_type(4)));
typedef unsigned u32x4 __attribute__((ext_vector_type(4)));
typedef unsigned u32x2 __attribute__((ext_vector_type(2)));

constexpr int BATCH = 8, SEQ = 4096, DM = 1024, T = BATCH * SEQ, DEPTH = 2;
constexpr int D_SSM = 512, NGRP = 32, SGRP = 16, SST = 64;
constexpr int D_IN = 1816, ZP = 2048;
constexpr int ZC_U = 0, ZC_Q = 512, ZC_KV = 1024, ZC_G = 1792;
constexpr int NCMP = 255, NCMPP = 256;
constexpr float EPS = 1e-6f;
constexpr int NWAVES = 8, NTHR = 512;

constexpr size_t MiB = 1u << 20;
constexpr size_t WS_CTL = 0, CTL_ZERO_BYTES = 1 * MiB;
constexpr size_t WS_KC = 1 * MiB, WS_VC = 2 * MiB, WS_ROUTE = 3 * MiB;
constexpr size_t WS_HN = 16 * MiB;
constexpr size_t WS_Z = 80 * MiB;
constexpr size_t WS_YC = 208 * MiB;
constexpr size_t WS_G1 = 272 * MiB;
constexpr size_t WS_END = 304 * MiB;
constexpr int CW_BAR = 4096;

constexpr int LDS_BYTES = 147456;
constexpr int MISC_OFF = 131072 + 320;

__device__ __forceinline__ float bf2f(bf16 v) { return __uint_as_float(((unsigned)v) << 16); }
__device__ __forceinline__ unsigned f2bf(float f) { unsigned u = __float_as_uint(f); return (u + 0x7fffu + ((u >> 16) & 1u)) >> 16; }
__device__ __forceinline__ unsigned pk2(float lo, float hi) { return f2bf(lo) | (f2bf(hi) << 16); }
__device__ __forceinline__ float wave_sum(float v) {
#pragma unroll
    for (int o = 1; o < 64; o <<= 1) v += __shfl_xor(v, o);
    return v;
}
__device__ __forceinline__ float wave_max(float v) {
#pragma unroll
    for (int o = 1; o < 64; o <<= 1) v = fmaxf(v, __shfl_xor(v, o));
    return v;
}
__device__ __forceinline__ float gelu_tanh(float x) {
    const float u = 0.7978845608028654f * (x + 0.044715f * x * x * x);
    return 0.5f * x * (1.0f + tanhf(u));
}
__device__ __forceinline__ float sigmoidf_(float x) { return 1.0f / (1.0f + __expf(-x)); }
__device__ __forceinline__ int t5_bucket(int n) {
    if (n < 16) return n < 0 ? 0 : n;
    int b = 16;
    b += (n >= 19); b += (n >= 21); b += (n >= 24); b += (n >= 27); b += (n >= 31); b += (n >= 35); b += (n >= 40); b += (n >= 46);
    b += (n >= 52); b += (n >= 59); b += (n >= 67); b += (n >= 77); b += (n >= 87); b += (n >= 99); b += (n >= 113);
    return b;
}

#define XB_TMO      128
#define XB_XCNT(j)  (256  + 64 * (j))
#define XB_XSUB(j)  (1280 + 64 * (j))
#define XB_XGEN(j)  (2304 + 64 * (j))
#define XB_TOP      3328
#define XB_TOPGEN   3392
#define XCD_BAR_WORDS 3456
#define XB_SPIN_CAP (1u << 22)

__device__ __forceinline__ unsigned xb_ld(unsigned* p)              { return __hip_atomic_load(p, __ATOMIC_RELAXED, __HIP_MEMORY_SCOPE_AGENT); }
__device__ __forceinline__ unsigned xb_add(unsigned* p, unsigned v) { return __hip_atomic_fetch_add(p, v, __ATOMIC_RELAXED, __HIP_MEMORY_SCOPE_AGENT); }
__device__ __forceinline__ unsigned xb_xcc_id() { return (unsigned)__builtin_amdgcn_s_getreg((3 << 11) | 20) & 0xFu; }
#define XB_SPIN(cond, bar) do { unsigned _sp = 0; while (cond) { __builtin_amdgcn_s_sleep(1); \
    if ((++_sp & 255u) == 0u) { if (xb_ld(&(bar)[XB_TMO])) break; if (_sp > XB_SPIN_CAP) { atomicAdd(&(bar)[XB_TMO], 1u); break; } } } } while (0)

struct XcdBarrier { unsigned* bar; unsigned x; volatile LAS unsigned* st; };

__device__ __forceinline__ XcdBarrier xcd_barrier_post(unsigned* bar, volatile LAS unsigned* st) {
    XcdBarrier b; b.bar = bar; b.x = xb_xcc_id(); b.st = st;
    if (threadIdx.x == 0) (void)xb_add(&bar[XB_XCNT(b.x)], 1u);
    return b;
}
__device__ __forceinline__ void xcd_barrier_complete(unsigned* bar, unsigned x, unsigned& nloc, unsigned& nx) {
    const unsigned G = gridDim.x * gridDim.y * gridDim.z;
    unsigned sum, cnt, mine, sp = 0u;
    for (;;) {
        sum = 0u; cnt = 0u; mine = 0u;
#pragma unroll
        for (unsigned j = 0; j < 16; ++j) { const unsigned c = xb_ld(&bar[XB_XCNT(j)]); sum += c; cnt += (c > 0u) ? 1u : 0u; mine = (j == x) ? c : mine; }
        if (sum == G) break;
        __builtin_amdgcn_s_sleep(1);
        if ((++sp & 255u) == 0u) { if (xb_ld(&bar[XB_TMO])) break; if (sp > XB_SPIN_CAP) { atomicAdd(&bar[XB_TMO], 1u); break; } }
    }
    nloc = mine > 0u ? mine : 1u; nx = cnt > 0u ? cnt : 1u;
}
__device__ __forceinline__ void xcd_barrier(const XcdBarrier& b) {
    asm volatile("s_waitcnt vmcnt(0)" ::: "memory");
    __syncthreads();
    if (threadIdx.x == 0) {
        unsigned* bar = b.bar;
        __builtin_amdgcn_s_waitcnt(0);
        unsigned nloc = b.st[0], nx = b.st[1];
        if (nloc == 0u) { xcd_barrier_complete(bar, b.x, nloc, nx); b.st[0] = nloc; b.st[1] = nx; }
        const unsigned old = xb_add(&bar[XB_XSUB(b.x)], 1u);
        const unsigned gen = old / nloc;
        if (old + 1u == (gen + 1u) * nloc) {
            __builtin_amdgcn_fence(__ATOMIC_RELEASE, "agent");
            asm volatile("s_waitcnt vmcnt(0)" ::: "memory");
            const unsigned og = xb_add(&bar[XB_TOP], 1u);
            const unsigned tg = og / nx;
            if (og + 1u == (tg + 1u) * nx) xb_add(&bar[XB_TOPGEN], 1u);
            else XB_SPIN(xb_ld(&bar[XB_TOPGEN]) == tg, bar);
            __builtin_amdgcn_fence(__ATOMIC_ACQUIRE, "agent");
            xb_add(&bar[XB_XGEN(b.x)], 1u);
            asm volatile("s_waitcnt vmcnt(0)" ::: "memory");
        } else {
            XB_SPIN(xb_ld(&bar[XB_XGEN(b.x)]) == gen, bar);
            __builtin_amdgcn_fence(__ATOMIC_ACQUIRE, "agent");
            asm volatile("s_waitcnt vmcnt(0)" ::: "memory");
        }
    }
    __syncthreads();
}

struct Args { const float* in[26]; float* out; unsigned char* ws; int ph_lo, ph_hi; };

struct Frame {
    LAS unsigned char* lds;
    int tid, lane, wave, blk, G;
};

__device__ __forceinline__ void ph_norm(const Frame& F, const float* xin, const float* g, bf16* hn) {
    const int gw = F.blk * NWAVES + F.wave, NGW = F.G * NWAVES;
    for (int row = gw; row < T; row += NGW) {
        const f32x4* xr = (const f32x4*)(xin + (size_t)row * DM);
        f32x4 v[4]; float s = 0.f;
#pragma unroll
        for (int j = 0; j < 4; ++j) { v[j] = xr[F.lane + 64 * j]; s += v[j].x * v[j].x + v[j].y * v[j].y + v[j].z * v[j].z + v[j].w * v[j].w; }
        s = wave_sum(s);
        const float r = rsqrtf(s * (1.0f / DM) + EPS);
#pragma unroll
        for (int j = 0; j < 4; ++j) {
            const f32x4 gg = ((const f32x4*)g)[F.lane + 64 * j];
            u32x2 o; o.x = pk2(v[j].x * r * gg.x, v[j].y * r * gg.y); o.y = pk2(v[j].z * r * gg.z, v[j].w * r * gg.w);
            *(u32x2*)(hn + (size_t)row * DM + (F.lane + 64 * j) * 4) = o;
        }
    }
}
__device__ __forceinline__ void ph_final_norm(const Frame& F, float* x, const float* g) {
    const int gw = F.blk * NWAVES + F.wave, NGW = F.G * NWAVES;
    for (int row = gw; row < T; row += NGW) {
        f32x4* xr = (f32x4*)(x + (size_t)row * DM);
        f32x4 v[4]; float s = 0.f;
#pragma unroll
        for (int j = 0; j < 4; ++j) { v[j] = xr[F.lane + 64 * j]; s += v[j].x * v[j].x + v[j].y * v[j].y + v[j].z * v[j].z + v[j].w * v[j].w; }
        s = wave_sum(s);
        const float r = rsqrtf(s * (1.0f / DM) + EPS);
#pragma unroll
        for (int j = 0; j < 4; ++j) {
            const f32x4 gg = ((const f32x4*)g)[F.lane + 64 * j];
            f32x4 o; o.x = v[j].x * r * gg.x; o.y = v[j].y * r * gg.y; o.z = v[j].z * r * gg.z; o.w = v[j].w * r * gg.w;
            xr[F.lane + 64 * j] = o;
        }
    }
}

template <bool DUAL, class Epi>
__device__ __forceinline__ void sgemm_naive(const Frame& F, const bf16* A, int lda, const float* B, int ldb, int M, int N, int K, int dualoff, const Epi& epi) {
    LAS float* As = (LAS float*)F.lds;
    LAS float* Bs = As + 16 * 132;
    LAS float* Bs2 = Bs + 16 * 128;
    const int tiles_n = (N + 127) / 128, tiles_m = M / 128;
    const int tx = F.tid & 31, ty = F.tid >> 5;
    for (int tile = F.blk; tile < tiles_m * tiles_n; tile += F.G) {
        const int tm = tile / tiles_n, tn = tile % tiles_n;
        float acc[8][4], acc2[8][4];
#pragma unroll
        for (int i = 0; i < 8; ++i)
#pragma unroll
            for (int j = 0; j < 4; ++j) { acc[i][j] = 0.f; acc2[i][j] = 0.f; }
        const int arow = F.tid >> 2, akq = (F.tid & 3) * 4;
        const int bk = F.tid >> 5, bn = (F.tid & 31) * 4;
        for (int k0 = 0; k0 < K; k0 += 16) {
            {
                const u32x2 av = *(const u32x2*)(A + (size_t)(tm * 128 + arow) * lda + k0 + akq);
                As[(akq + 0) * 132 + arow] = __uint_as_float(av.x << 16);
                As[(akq + 1) * 132 + arow] = __uint_as_float(av.x & 0xffff0000u);
                As[(akq + 2) * 132 + arow] = __uint_as_float(av.y << 16);
                As[(akq + 3) * 132 + arow] = __uint_as_float(av.y & 0xffff0000u);
                const int col = tn * 128 + bn;
                f32x4 bv = (f32x4){0.f, 0.f, 0.f, 0.f};
                const float* bp = B + (size_t)(k0 + bk) * ldb + col;
                if (col + 3 < N) { bv.x = bp[0]; bv.y = bp[1]; bv.z = bp[2]; bv.w = bp[3]; }
                else { if (col < N) bv.x = bp[0]; if (col + 1 < N) bv.y = bp[1]; if (col + 2 < N) bv.z = bp[2]; }
                *(LAS f32x4*)(Bs + bk * 128 + bn) = bv;
                if (DUAL) {
                    const float* bp2 = bp + dualoff;
                    f32x4 bw; bw.x = bp2[0]; bw.y = bp2[1]; bw.z = bp2[2]; bw.w = bp2[3];
                    *(LAS f32x4*)(Bs2 + bk * 128 + bn) = bw;
                }
            }
            __syncthreads();
#pragma unroll 4
            for (int k = 0; k < 16; ++k) {
                float a[8];
                const f32x4 a0 = *(const LAS f32x4*)(As + k * 132 + ty * 8), a1 = *(const LAS f32x4*)(As + k * 132 + ty * 8 + 4);
                a[0] = a0.x; a[1] = a0.y; a[2] = a0.z; a[3] = a0.w; a[4] = a1.x; a[5] = a1.y; a[6] = a1.z; a[7] = a1.w;
                const f32x4 b = *(const LAS f32x4*)(Bs + k * 128 + tx * 4);
#pragma unroll
                for (int i = 0; i < 8; ++i) { acc[i][0] += a[i] * b.x; acc[i][1] += a[i] * b.y; acc[i][2] += a[i] * b.z; acc[i][3] += a[i] * b.w; }
                if (DUAL) {
                    const f32x4 b2 = *(const LAS f32x4*)(Bs2 + k * 128 + tx * 4);
#pragma unroll
                    for (int i = 0; i < 8; ++i) { acc2[i][0] += a[i] * b2.x; acc2[i][1] += a[i] * b2.y; acc2[i][2] += a[i] * b2.z; acc2[i][3] += a[i] * b2.w; }
                }
            }
            __syncthreads();
        }
#pragma unroll
        for (int i = 0; i < 8; ++i)
#pragma unroll
            for (int j = 0; j < 4; ++j) {
                const int row = tm * 128 + ty * 8 + i, col = tn * 128 + tx * 4 + j;
                if (col < N) epi(row, col, acc[i][j], acc2[i][j]);
            }
    }
}
struct EpiStoreBf16 { bf16* O; int ldo; __device__ __forceinline__ void operator()(int r, int c, float a, float) const { O[(size_t)r * ldo + c] = (bf16)f2bf(a); } };
struct EpiGlu { bf16* O; int ldo; __device__ __forceinline__ void operator()(int r, int c, float a, float b) const { O[(size_t)r * ldo + c] = (bf16)f2bf(a * sigmoidf_(b)); } };
struct EpiResid { const float* X; float* O; __device__ __forceinline__ void operator()(int r, int c, float a, float) const { O[(size_t)r * DM + c] = X[(size_t)r * DM + c] + a; } };

__device__ __forceinline__ void ssm_naive_item(int b, int g, const float* a_re, const float* a_im, const float* b_re, const float* b_im, const float* c_re, const float* c_im,
                                               const float* dpar, const float* log_dt, const bf16* Z, bf16* G1, int lane) {
    const int p = lane;
    const float are = a_re[g * 64 + p], aim = a_im[g * 64 + p], dt = expf(log_dt[g]);
    const float er = expf(are * dt), lbr = er * cosf(aim * dt), lbi = er * sinf(aim * dt);
    const float xx = lbr - 1.0f, yy = lbi, den = are * are + aim * aim;
    const float fr = (xx * are + yy * aim) / den, fi = (yy * are - xx * aim) / den;
    float bbr[16], bbi[16], cr[16], ci[16];
#pragma unroll
    for (int h = 0; h < 16; ++h) {
        const float br = b_re[(g * 64 + p) * 16 + h], bi = b_im[(g * 64 + p) * 16 + h];
        bbr[h] = fr * br - fi * bi; bbi[h] = fr * bi + fi * br;
        cr[h] = c_re[(g * 16 + h) * 64 + p]; ci[h] = c_im[(g * 16 + h) * 64 + p];
    }
    const float dd = dpar[g * 16 + (lane & 15)];
    float xr = 0.f, xi = 0.f;
    for (int t = 0; t < SEQ; ++t) {
        const size_t row = (size_t)b * SEQ + t;
        const u32x4 u0 = *(const u32x4*)(Z + row * ZP + ZC_U + g * 16), u1 = *(const u32x4*)(Z + row * ZP + ZC_U + g * 16 + 8);
        float u[16];
        u[0] = __uint_as_float(u0.x << 16); u[1] = __uint_as_float(u0.x & 0xffff0000u); u[2] = __uint_as_float(u0.y << 16); u[3] = __uint_as_float(u0.y & 0xffff0000u);
        u[4] = __uint_as_float(u0.z << 16); u[5] = __uint_as_float(u0.z & 0xffff0000u); u[6] = __uint_as_float(u0.w << 16); u[7] = __uint_as_float(u0.w & 0xffff0000u);
        u[8] = __uint_as_float(u1.x << 16); u[9] = __uint_as_float(u1.x & 0xffff0000u); u[10] = __uint_as_float(u1.y << 16); u[11] = __uint_as_float(u1.y & 0xffff0000u);
        u[12] = __uint_as_float(u1.z << 16); u[13] = __uint_as_float(u1.z & 0xffff0000u); u[14] = __uint_as_float(u1.w << 16); u[15] = __uint_as_float(u1.w & 0xffff0000u);
        float bur = 0.f, bui = 0.f;
#pragma unroll
        for (int h = 0; h < 16; ++h) { bur += bbr[h] * u[h]; bui += bbi[h] * u[h]; }
        const float nxr = lbr * xr - lbi * xi + bur, nxi = lbr * xi + lbi * xr + bui;
        xr = nxr; xi = nxi;
        float y = 0.f;
#pragma unroll
        for (int h = 0; h < 16; ++h) { const float v = wave_sum(cr[h] * xr - ci[h] * xi); if (lane == h) y = v; }
        if (lane < 16) {
            const float ul = bf2f(Z[row * ZP + ZC_U + g * 16 + lane]);
            G1[row * D_SSM + g * 16 + lane] = (bf16)f2bf(gelu_tanh(y + dd * ul));
        }
    }
}
__device__ __forceinline__ void compress_naive_item(int item, const bf16* Z, const float* pos, const float* w1, const float* w2, float* KC, float* VC, int lane) {
    const int i = item & 1, hkv = (item >> 1) & 1, n = (item >> 2) % NCMP, b = (item >> 2) / NCMP;
    const float* posi = pos + i * 32 * 64; const float* w1i = w1 + (size_t)i * 32 * 64 * 64; const float* w2i = w2 + i * 64 * 64;
    float acc = 0.f;
    for (int l = 0; l < 32; ++l) {
        const bf16* zr = Z + ((size_t)b * SEQ + 16 * n + l) * ZP + ZC_KV + i * 128 + hkv * 64;
        for (int d = 0; d < 64; ++d) acc += (bf2f(zr[d]) + posi[l * 64 + d]) * w1i[(l * 64 + d) * 64 + lane];
    }
    const float hid = gelu_tanh(acc);
    float o = 0.f;
    for (int e = 0; e < 64; ++e) o += __shfl(hid, e) * w2i[e * 64 + lane];
    float* dst = i ? VC : KC;
    dst[(((size_t)b * NCMPP + n) * 2 + hkv) * 64 + lane] = o;
}

__device__ __forceinline__ void attn_chunk(LAS float* wl, const bf16* Z, const float* rel_bias, int b, int hkv, int t, int base, int kcol, int vcol, int lane,
                                           float (&m)[4], float (&l)[4], float (&o)[4]) {
    const int pos = base + lane; const bool valid = (pos >= 0) && (pos <= t);
    const int posc = pos < 0 ? 0 : (pos > SEQ - 1 ? SEQ - 1 : pos);
    const bf16* kr = Z + ((size_t)b * SEQ + posc) * ZP + kcol + hkv * 64;
    float s[4] = {0.f, 0.f, 0.f, 0.f};
#pragma unroll 2
    for (int c = 0; c < 8; ++c) {
        const u32x4 kv = *(const u32x4*)(kr + c * 8);
        float k[8];
        k[0] = __uint_as_float(kv.x << 16); k[1] = __uint_as_float(kv.x & 0xffff0000u); k[2] = __uint_as_float(kv.y << 16); k[3] = __uint_as_float(kv.y & 0xffff0000u);
        k[4] = __uint_as_float(kv.z << 16); k[5] = __uint_as_float(kv.z & 0xffff0000u); k[6] = __uint_as_float(kv.w << 16); k[7] = __uint_as_float(kv.w & 0xffff0000u);
#pragma unroll
        for (int g = 0; g < 4; ++g) {
            const f32x4 q0 = *(const LAS f32x4*)(wl + g * 64 + c * 8), q1 = *(const LAS f32x4*)(wl + g * 64 + c * 8 + 4);
            s[g] += q0.x * k[0] + q0.y * k[1] + q0.z * k[2] + q0.w * k[3] + q1.x * k[4] + q1.y * k[5] + q1.z * k[6] + q1.w * k[7];
        }
    }
    const int bk = t5_bucket(t - pos);
#pragma unroll
    for (int g = 0; g < 4; ++g) {
        const float sv = valid ? s[g] + rel_bias[bk * 8 + hkv * 4 + g] : -1e30f;
        const float mn = fmaxf(m[g], wave_max(sv));
        const float alpha = __expf(m[g] - mn);
        const float p = valid ? __expf(sv - mn) : 0.f;
        l[g] = l[g] * alpha + wave_sum(p);
        o[g] *= alpha; m[g] = mn;
        wl[256 + g * 64 + lane] = p;
    }
#pragma unroll 4
    for (int key = 0; key < 64; ++key) {
        int pk = base + key; pk = pk < 0 ? 0 : (pk > SEQ - 1 ? SEQ - 1 : pk);
        const float v = bf2f(Z[((size_t)b * SEQ + pk) * ZP + vcol + hkv * 64 + lane]);
#pragma unroll
        for (int g = 0; g < 4; ++g) o[g] += wl[256 + g * 64 + key] * v;
    }
}
__device__ __forceinline__ void attn_naive_item(LAS float* wl, int b, int hkv, int t, const bf16* Z, const float* KC, const float* VC, const float* rel_bias, bf16* YC, int lane) {
    const size_t row = (size_t)b * SEQ + t;
#pragma unroll
    for (int g = 0; g < 4; ++g) wl[g * 64 + lane] = bf2f(Z[row * ZP + ZC_Q + hkv * 256 + g * 64 + lane]) * 0.125f;
#pragma unroll 1
    for (int c = 0; c < 4; ++c) {
        const int n = c * 64 + lane; const bool valid = (n < NCMP) && (16 * n + 31 <= t);
        const float* kr = KC + (((size_t)b * NCMPP + (n < NCMP ? n : 0)) * 2 + hkv) * 64;
        float s[4] = {0.f, 0.f, 0.f, 0.f};
#pragma unroll 4
        for (int d4 = 0; d4 < 16; ++d4) {
            const f32x4 k = *(const f32x4*)(kr + d4 * 4);
#pragma unroll
            for (int g = 0; g < 4; ++g) { const f32x4 q = *(const LAS f32x4*)(wl + g * 64 + d4 * 4); s[g] += q.x * k.x + q.y * k.y + q.z * k.z + q.w * k.w; }
        }
        const int bk = t5_bucket(t - (16 * n + 31));
#pragma unroll
        for (int g = 0; g < 4; ++g) wl[256 + g * 256 + n] = valid ? s[g] + rel_bias[bk * 8 + hkv * 4 + g] : -1e30f;
    }
#pragma unroll
    for (int g = 0; g < 4; ++g) {
        float sc[4];
#pragma unroll
        for (int c = 0; c < 4; ++c) sc[c] = wl[256 + g * 256 + c * 64 + lane];
        const float mx = wave_max(fmaxf(fmaxf(sc[0], sc[1]), fmaxf(sc[2], sc[3])));
        float e[4], ls = 0.f;
#pragma unroll
        for (int c = 0; c < 4; ++c) { e[c] = sc[c] > -1e29f ? __expf(sc[c] - mx) : 0.f; ls += e[c]; }
        ls = wave_sum(ls);
        const float inv = ls > 0.f ? 1.0f / ls : 0.f;
#pragma unroll
        for (int c = 0; c < 4; ++c) wl[256 + g * 256 + c * 64 + lane] = e[c] * inv;
    }
    float oc[4] = {0.f, 0.f, 0.f, 0.f};
    const int nmax = t >= 31 ? ((t - 31) / 16 + 1 < NCMP ? (t - 31) / 16 + 1 : NCMP) : 0;
#pragma unroll 4
    for (int n = 0; n < nmax; ++n) {
        const float v = VC[(((size_t)b * NCMPP + n) * 2 + hkv) * 64 + lane];
#pragma unroll
        for (int g = 0; g < 4; ++g) oc[g] += wl[256 + g * 256 + n] * v;
    }
    float imp = 0.f;
#pragma unroll
    for (int g = 0; g < 4; ++g) {
        const LAS float* P = wl + 256 + g * 256;
        imp += P[4 * lane] + P[4 * lane + 1] + P[4 * lane + 2] + 0.5f * P[4 * lane + 3] + (lane > 0 ? 0.5f * P[4 * lane - 1] : 0.f);
    }
    const int blk = t >> 6;
    const bool forced = (lane == 0) || (lane <= blk && lane > blk - 2), future = lane > blk;
    const float v = forced ? 1e9f : (future ? -1e9f : imp);
    int rank = 0;
    for (int jj = 0; jj < 64; ++jj) { const float vj = __shfl(v, jj); rank += (vj > v) || (vj == v && jj < lane); }
    unsigned long long mask = __ballot(rank < 16 && !future);
    float m[4], l[4], o[4];
#pragma unroll
    for (int g = 0; g < 4; ++g) { m[g] = -1e30f; l[g] = 0.f; o[g] = 0.f; }
    while (mask) {
        const int j = __builtin_ctzll(mask); mask &= mask - 1;
        attn_chunk(wl, Z, rel_bias, b, hkv, t, 64 * j, ZC_KV + 256, ZC_KV + 384, lane, m, l, o);
    }
    float os[4];
#pragma unroll
    for (int g = 0; g < 4; ++g) { os[g] = l[g] > 0.f ? o[g] / l[g] : 0.f; m[g] = -1e30f; l[g] = 0.f; o[g] = 0.f; }
    for (int c = 0; c < 8; ++c) attn_chunk(wl, Z, rel_bias, b, hkv, t, t - 511 + 64 * c, ZC_KV + 512, ZC_KV + 640, lane, m, l, o);
#pragma unroll
    for (int g = 0; g < 4; ++g) {
        const float ow = l[g] > 0.f ? o[g] / l[g] : 0.f;
        const bf16* gp = Z + row * ZP + ZC_G + hkv * 12 + g * 3;
        const float r = sigmoidf_(bf2f(gp[0])) * oc[g] + sigmoidf_(bf2f(gp[1])) * os[g] + sigmoidf_(bf2f(gp[2])) * ow;
        YC[row * DM + D_SSM + hkv * 256 + g * 64 + lane] = (bf16)f2bf(r);
    }
}

__device__ __forceinline__ void ph_norm_route(const Frame& F, const float* x, const float* g, const float* rgw, const float* rgb, const float* rew, const float* reb, bf16* hn, unsigned* route) {
    const int gw = F.blk * NWAVES + F.wave, NGW = F.G * NWAVES;
    for (int row = gw; row < T; row += NGW) {
        const f32x4* xr = (const f32x4*)(x + (size_t)row * DM);
        f32x4 v[4]; float s = 0.f;
#pragma unroll
        for (int j = 0; j < 4; ++j) { v[j] = xr[F.lane + 64 * j]; s += v[j].x * v[j].x + v[j].y * v[j].y + v[j].z * v[j].z + v[j].w * v[j].w; }
        s = wave_sum(s);
        const float r = rsqrtf(s * (1.0f / DM) + EPS);
        float lg[4] = {0.f, 0.f, 0.f, 0.f};
#pragma unroll
        for (int j = 0; j < 4; ++j) {
            const f32x4 gg = ((const f32x4*)g)[F.lane + 64 * j];
            v[j].x = v[j].x * r * gg.x; v[j].y = v[j].y * r * gg.y; v[j].z = v[j].z * r * gg.z; v[j].w = v[j].w * r * gg.w;
            u32x2 o; o.x = pk2(v[j].x, v[j].y); o.y = pk2(v[j].z, v[j].w);
            *(u32x2*)(hn + (size_t)row * DM + (F.lane + 64 * j) * 4) = o;
            const int c0 = (F.lane + 64 * j) * 4;
            const f32x4 w0 = ((const f32x4*)rgw)[c0], w1 = ((const f32x4*)rgw)[c0 + 1], w2 = ((const f32x4*)rgw)[c0 + 2], w3 = ((const f32x4*)rgw)[c0 + 3];
            lg[0] += v[j].x * w0.x + v[j].y * w1.x + v[j].z * w2.x + v[j].w * w3.x;
            lg[1] += v[j].x * w0.y + v[j].y * w1.y + v[j].z * w2.y + v[j].w * w3.y;
            lg[2] += v[j].x * w0.z + v[j].y * w1.z + v[j].z * w2.z + v[j].w * w3.z;
            lg[3] += v[j].x * w0.w + v[j].y * w1.w + v[j].z * w2.w + v[j].w * w3.w;
        }
#pragma unroll
        for (int o = 0; o < 4; ++o) lg[o] = wave_sum(lg[o]) + rgb[o];
        int gi = 0; float gm = lg[0];
#pragma unroll
        for (int o = 1; o < 4; ++o) if (lg[o] > gm) { gm = lg[o]; gi = o; }
        float gs = 0.f;
#pragma unroll
        for (int o = 0; o < 4; ++o) gs += __expf(lg[o] - gm);
        const float gval = 1.0f / gs;
        const float* we = rew + (size_t)gi * DM * 8;
        float le[8] = {0.f, 0.f, 0.f, 0.f, 0.f, 0.f, 0.f, 0.f};
#pragma unroll
        for (int j = 0; j < 4; ++j) {
            const int c0 = (F.lane + 64 * j) * 4;
            const float hv[4] = {v[j].x, v[j].y, v[j].z, v[j].w};
#pragma unroll
            for (int c = 0; c < 4; ++c) {
                const f32x4 wa = ((const f32x4*)we)[(c0 + c) * 2], wb = ((const f32x4*)we)[(c0 + c) * 2 + 1];
                le[0] += hv[c] * wa.x; le[1] += hv[c] * wa.y; le[2] += hv[c] * wa.z; le[3] += hv[c] * wa.w;
                le[4] += hv[c] * wb.x; le[5] += hv[c] * wb.y; le[6] += hv[c] * wb.z; le[7] += hv[c] * wb.w;
            }
        }
#pragma unroll
        for (int e = 0; e < 8; ++e) le[e] = wave_sum(le[e]) + reb[gi * 8 + e];
        int e1 = 0; float m1 = le[0];
#pragma unroll
        for (int e = 1; e < 8; ++e) if (le[e] > m1) { m1 = le[e]; e1 = e; }
        int e2 = -1; float m2 = -3.0e38f;
#pragma unroll
        for (int e = 0; e < 8; ++e) if (e != e1 && le[e] > m2) { m2 = le[e]; e2 = e; }
        const float p2 = __expf(m2 - m1), inv = 1.0f / (1.0f + p2);
        if (F.lane == 0) {
            u32x4 o; o.x = (unsigned)(gi * 8 + e1); o.y = (unsigned)(gi * 8 + e2); o.z = __float_as_uint(gval * inv); o.w = __float_as_uint(gval * p2 * inv);
            *(u32x4*)(route + (size_t)row * 4) = o;
        }
    }
}
__device__ __forceinline__ void ph_experts_naive(const Frame& F, const bf16* hn, const unsigned* route, const float* wg, const float* wu, const float* wd, float* x) {
    LAS float* hs = (LAS float*)F.lds;
    LAS float* hd = hs + 1024;
    for (int tok = F.blk; tok < T; tok += F.G) {
        { const unsigned pv = *(const unsigned*)(hn + (size_t)tok * DM + F.tid * 2); hs[F.tid * 2] = __uint_as_float(pv << 16); hs[F.tid * 2 + 1] = __uint_as_float(pv & 0xffff0000u); }
        const u32x4 rt = *(const u32x4*)(route + (size_t)tok * 4);
        __syncthreads();
        {
            const int s = F.tid >> 8, f = F.tid & 255;
            const unsigned e = s ? rt.y : rt.x; const float w = __uint_as_float(s ? rt.w : rt.z);
            const float* pg = wg + (size_t)e * DM * 256 + f; const float* pu = wu + (size_t)e * DM * 256 + f;
            float ga = 0.f, ua = 0.f;
            for (int d = 0; d < DM; ++d) { const float hv = hs[d]; ga += hv * pg[(size_t)d * 256]; ua += hv * pu[(size_t)d * 256]; }
            hd[s * 256 + f] = ga * sigmoidf_(ga) * ua * w;
        }
        __syncthreads();
        for (int dd = F.tid; dd < DM; dd += NTHR) {
            float acc = 0.f;
            const float* p0 = wd + (size_t)rt.x * 256 * DM + dd; const float* p1 = wd + (size_t)rt.y * 256 * DM + dd;
            for (int f = 0; f < 256; ++f) acc += hd[f] * p0[(size_t)f * DM];
            for (int f = 0; f < 256; ++f) acc += hd[256 + f] * p1[(size_t)f * DM];
            x[(size_t)tok * DM + dd] += acc;
        }
        __syncthreads();
    }
}

constexpr int PH_PER_LAYER = 7, N_PHASES = DEPTH * PH_PER_LAYER + 1;

__global__ void __launch_bounds__(NTHR, 2) fwd(Args args) {
    extern __shared__ __attribute__((aligned(16))) unsigned char lds_raw[];
    Frame F;
    F.lds = (LAS unsigned char*)lds_raw;
    F.tid = threadIdx.x; F.lane = F.tid & 63; F.wave = __builtin_amdgcn_readfirstlane(F.tid >> 6);
    F.blk = blockIdx.x; F.G = gridDim.x;
    unsigned char* ws = args.ws;
    volatile LAS unsigned* MISC = (volatile LAS unsigned*)(F.lds + MISC_OFF);
    if (F.tid < 32) MISC[F.tid] = 0u;
    __syncthreads();
    XcdBarrier bar; bar.bar = (unsigned*)(ws + WS_CTL) + CW_BAR; bar.x = 0; bar.st = nullptr;
    if (N_LAUNCH_MODE == 1) bar = xcd_barrier_post((unsigned*)(ws + WS_CTL) + CW_BAR, MISC + 8);
    const int lo = args.ph_lo, hi = args.ph_hi;
#define IN(k) (lo <= (k) && (k) < hi)
#define SEAM(k) do { if (IN(k) && IN((k) + 1)) xcd_barrier(bar); } while (0)

    const float* x0 = args.in[0];
    float* XR = args.out;
    bf16* HN = (bf16*)(ws + WS_HN); bf16* Z = (bf16*)(ws + WS_Z); bf16* YC = (bf16*)(ws + WS_YC); bf16* G1 = (bf16*)(ws + WS_G1);
    float* KC = (float*)(ws + WS_KC); float* VC = (float*)(ws + WS_VC); unsigned* ROUTE = (unsigned*)(ws + WS_ROUTE);

    for (int layer = 0; layer < DEPTH; ++layer) {
        const int pb = layer * PH_PER_LAYER;
        const float* xin = layer == 0 ? x0 : XR;
        if (IN(pb + 0)) ph_norm(F, xin, args.in[1] + layer * DM, HN);
        SEAM(pb + 0);
        if (IN(pb + 1)) { EpiStoreBf16 E{Z, ZP}; sgemm_naive<false>(F, HN, DM, args.in[4] + (size_t)layer * DM * D_IN, D_IN, T, D_IN, DM, 0, E); }
        SEAM(pb + 1);
        if (IN(pb + 2)) {
            if (F.wave == 0) {
                for (int it = F.blk; it < BATCH * NGRP; it += F.G)
                    ssm_naive_item(it / NGRP, it % NGRP, args.in[6] + layer * NGRP * SST, args.in[7] + layer * NGRP * SST, args.in[8] + (size_t)layer * NGRP * SST * SGRP, args.in[9] + (size_t)layer * NGRP * SST * SGRP,
                                   args.in[10] + (size_t)layer * NGRP * SGRP * SST, args.in[11] + (size_t)layer * NGRP * SGRP * SST, args.in[12] + layer * NGRP * SGRP, args.in[13] + layer * NGRP, Z, G1, F.lane);
            } else {
                for (int it = F.blk * 7 + (F.wave - 1); it < BATCH * NCMP * 4; it += F.G * 7)
                    compress_naive_item(it, Z, args.in[15] + (size_t)layer * 2 * 32 * 64, args.in[16] + (size_t)layer * 2 * 32 * 64 * 64, args.in[17] + (size_t)layer * 2 * 64 * 64, KC, VC, F.lane);
            }
        }
        SEAM(pb + 2);
        if (IN(pb + 3)) {
            { EpiGlu E{YC, DM}; sgemm_naive<true>(F, G1, D_SSM, args.in[14] + (size_t)layer * D_SSM * 2 * D_SSM, 2 * D_SSM, T, D_SSM, D_SSM, D_SSM, E); }
            __syncthreads();
            LAS float* wl = (LAS float*)F.lds + F.wave * 1280;
            const int gw = F.blk * NWAVES + F.wave, NGW = F.G * NWAVES;
            for (int it = gw; it < T * 2; it += NGW) { const int hkv = it & 1, tt = it >> 1; attn_naive_item(wl, tt / SEQ, hkv, tt % SEQ, Z, KC, VC, args.in[18], YC, F.lane); }
        }
        SEAM(pb + 3);
        if (IN(pb + 4)) { EpiResid E{xin, XR}; sgemm_naive<false>(F, YC, DM, args.in[5] + (size_t)layer * DM * DM, DM, T, DM, DM, 0, E); }
        SEAM(pb + 4);
        if (IN(pb + 5)) ph_norm_route(F, XR, args.in[2] + layer * DM, args.in[19] + (size_t)layer * DM * 4, args.in[20] + layer * 4, args.in[21] + (size_t)layer * 4 * DM * 8, args.in[22] + layer * 32, HN, ROUTE);
        SEAM(pb + 5);
        if (IN(pb + 6)) ph_experts_naive(F, HN, ROUTE, args.in[23] + (size_t)layer * 32 * DM * 256, args.in[24] + (size_t)layer * 32 * DM * 256, args.in[25] + (size_t)layer * 32 * 256 * DM, XR);
        SEAM(pb + 6);
    }
    if (IN(N_PHASES - 1)) ph_final_norm(F, XR, args.in[3]);
#undef IN
#undef SEAM
}

extern "C" void kernel_launch(void* const* d_in, const int* in_sizes, int n_in, void* d_out, int out_size, void* d_ws, size_t ws_size, hipStream_t stream) {
    static int grid = 0;
    if (grid == 0) {
        if (n_in != 26 || out_size != T * DM || ws_size < WS_END) { fprintf(stderr, "kernel_launch: unexpected shapes (n_in %d out %d ws %zu)\n", n_in, out_size, ws_size); grid = -1; return; }
        int dev = 0, cus = 0, per_cu = 0;
        if (hipGetDevice(&dev) != hipSuccess || hipDeviceGetAttribute(&cus, hipDeviceAttributeMultiprocessorCount, dev) != hipSuccess) { grid = -1; return; }
        if (hipFuncSetAttribute((const void*)fwd, hipFuncAttributeMaxDynamicSharedMemorySize, LDS_BYTES) != hipSuccess) { fprintf(stderr, "kernel_launch: hipFuncSetAttribute failed\n"); grid = -1; return; }
        if (hipOccupancyMaxActiveBlocksPerMultiprocessor(&per_cu, (const void*)fwd, NTHR, LDS_BYTES) != hipSuccess || per_cu < 1) fprintf(stderr, "kernel_launch: occupancy query says %d\n", per_cu);
        (void)hipGetLastError();
        grid = cus;
    }
    if (grid < 0) return;
    (void)hipMemsetAsync((char*)d_ws + WS_CTL, 0, CTL_ZERO_BYTES, stream);
    Args a{};
    for (int i = 0; i < 26; ++i) a.in[i] = (const float*)d_in[i];
    a.out = (float*)d_out; a.ws = (unsigned char*)d_ws;
    if (N_LAUNCH_MODE == 1) {
        a.ph_lo = 0; a.ph_hi = N_PHASES;
        hipLaunchKernelGGL(fwd, dim3(grid), dim3(NTHR), LDS_BYTES, stream, a);
    } else {
        for (int p = 0; p < N_PHASES; ++p) { a.ph_lo = p; a.ph_hi = p + 1; hipLaunchKernelGGL(fwd, dim3(grid), dim3(NTHR), LDS_BYTES, stream, a); }
    }
}
```

```cpp
#include <hip/hip_runtime.h>
#include <cstdio>
#include <cstdint>

#ifndef N_LAUNCH_MODE
#define N_LAUNCH_MODE 1
#endif

#define GAS __attribute__((address_space(1)))
#define LAS __attribute__((address_space(3)))
typedef unsigned short bf16;
typedef float f32x4 __attribute__((ext_vector_type(4)));
typedef unsigned u32x4 __attribute__((ext_vector_type(4)));
typedef unsigned u32x2 __attribute__((ext_vector_type(2)));

constexpr int BATCH = 8, SEQ = 4096, DM = 1024, T = BATCH * SEQ, DEPTH = 2;
constexpr int D_SSM = 512, NGRP = 32, SGRP = 16, SST = 64;
constexpr int D_IN = 1816, ZP = 2048;
constexpr int ZC_U = 0, ZC_Q = 512, ZC_KV = 1024, ZC_G = 1792;
constexpr int NCMP = 255, NCMPP = 256;
constexpr float EPS = 1e-6f;
constexpr int NWAVES = 8, NTHR = 512;

constexpr size_t MiB = 1u << 20;
constexpr size_t WS_CTL = 0, CTL_ZERO_BYTES = 1 * MiB;
constexpr size_t WS_KC = 1 * MiB, WS_VC = 2 * MiB, WS_ROUTE = 3 * MiB;
constexpr size_t WS_HN = 16 * MiB;
constexpr size_t WS_Z = 80 * MiB;
constexpr size_t WS_YC = 208 * MiB;
constexpr size_t WS_G1 = 272 * MiB;
constexpr size_t WS_WIN = 304 * MiB;
constexpr size_t WS_WGLU = 312 * MiB;
constexpr size_t WS_WOUT = 314 * MiB;
constexpr size_t WS_WGU = 318 * MiB;
constexpr size_t WS_WDN = 382 * MiB;
constexpr size_t WS_LIST = 414 * MiB;
constexpr size_t WS_LISTW = 418 * MiB;
constexpr size_t WS_HID = 422 * MiB;
constexpr size_t WS_P2 = WS_Z;
constexpr size_t WS_END = 458 * MiB;
constexpr int LCAP = 32768, CW_CNT = 8192;
constexpr int CW_BAR = 4096;

constexpr int LDS_BYTES = 147456;
constexpr int MISC_OFF = 131072 + 320;

__device__ __forceinline__ float bf2f(bf16 v) { return __uint_as_float(((unsigned)v) << 16); }
__device__ __forceinline__ unsigned f2bf(float f) { unsigned u = __float_as_uint(f); return (u + 0x7fffu + ((u >> 16) & 1u)) >> 16; }
__device__ __forceinline__ unsigned pk2(float lo, float hi) { return f2bf(lo) | (f2bf(hi) << 16); }
__device__ __forceinline__ float wave_sum(float v, int lane) {
#pragma unroll
    for (int o = 1; o < 64; o <<= 1) v += __int_as_float(__builtin_amdgcn_ds_bpermute((lane ^ o) << 2, __float_as_int(v)));
    return v;
}
__device__ __forceinline__ float wave_max(float v, int lane) {
#pragma unroll
    for (int o = 1; o < 64; o <<= 1) v = fmaxf(v, __int_as_float(__builtin_amdgcn_ds_bpermute((lane ^ o) << 2, __float_as_int(v))));
    return v;
}
__device__ __forceinline__ float lane_bcast(float v, int src) { return __int_as_float(__builtin_amdgcn_ds_bpermute(src << 2, __float_as_int(v))); }
__device__ __forceinline__ float gelu_tanh(float x) {
    const float u = 0.7978845608028654f * (x + 0.044715f * x * x * x);
    return 0.5f * x * (1.0f + tanhf(u));
}
__device__ __forceinline__ float sigmoidf_(float x) { return 1.0f / (1.0f + __expf(-x)); }
__device__ __forceinline__ int t5_bucket(int n) {
    if (n < 16) return n < 0 ? 0 : n;
    int b = 16;
    b += (n >= 19); b += (n >= 21); b += (n >= 24); b += (n >= 27); b += (n >= 31); b += (n >= 35); b += (n >= 40); b += (n >= 46);
    b += (n >= 52); b += (n >= 59); b += (n >= 67); b += (n >= 77); b += (n >= 87); b += (n >= 99); b += (n >= 113);
    return b;
}

#define XB_TMO      128
#define XB_XCNT(j)  (256  + 64 * (j))
#define XB_XSUB(j)  (1280 + 64 * (j))
#define XB_XGEN(j)  (2304 + 64 * (j))
#define XB_TOP      3328
#define XB_TOPGEN   3392
#define XCD_BAR_WORDS 3456
#define XB_SPIN_CAP (1u << 22)

__device__ __forceinline__ unsigned xb_ld(unsigned* p)              { return __hip_atomic_load(p, __ATOMIC_RELAXED, __HIP_MEMORY_SCOPE_AGENT); }
__device__ __forceinline__ unsigned xb_add(unsigned* p, unsigned v) { return __hip_atomic_fetch_add(p, v, __ATOMIC_RELAXED, __HIP_MEMORY_SCOPE_AGENT); }
__device__ __forceinline__ unsigned xb_xcc_id() { return (unsigned)__builtin_amdgcn_s_getreg((3 << 11) | 20) & 0xFu; }
#define XB_SPIN(cond, bar) do { unsigned _sp = 0; while (cond) { __builtin_amdgcn_s_sleep(1); \
    if ((++_sp & 255u) == 0u) { if (xb_ld(&(bar)[XB_TMO])) break; if (_sp > XB_SPIN_CAP) { atomicAdd(&(bar)[XB_TMO], 1u); break; } } } } while (0)

struct XcdBarrier { unsigned* bar; unsigned x; volatile LAS unsigned* st; };

__device__ __forceinline__ XcdBarrier xcd_barrier_post(unsigned* bar, volatile LAS unsigned* st) {
    XcdBarrier b; b.bar = bar; b.x = xb_xcc_id(); b.st = st;
    if (threadIdx.x == 0) (void)xb_add(&bar[XB_XCNT(b.x)], 1u);
    return b;
}
__device__ __forceinline__ void xcd_barrier_complete(unsigned* bar, unsigned x, unsigned& nloc, unsigned& nx) {
    const unsigned G = gridDim.x * gridDim.y * gridDim.z;
    unsigned sum, cnt, mine, sp = 0u;
    for (;;) {
        sum = 0u; cnt = 0u; mine = 0u;
#pragma unroll
        for (unsigned j = 0; j < 16; ++j) { const unsigned c = xb_ld(&bar[XB_XCNT(j)]); sum += c; cnt += (c > 0u) ? 1u : 0u; mine = (j == x) ? c : mine; }
        if (sum == G) break;
        __builtin_amdgcn_s_sleep(1);
        if ((++sp & 255u) == 0u) { if (xb_ld(&bar[XB_TMO])) break; if (sp > XB_SPIN_CAP) { atomicAdd(&bar[XB_TMO], 1u); break; } }
    }
    nloc = mine > 0u ? mine : 1u; nx = cnt > 0u ? cnt : 1u;
}
__device__ __forceinline__ void xcd_barrier(const XcdBarrier& b, const int tid) {
    asm volatile("s_waitcnt vmcnt(0)" ::: "memory");
    __syncthreads();
    if (tid == 0) {
        unsigned* bar = b.bar;
        __builtin_amdgcn_s_waitcnt(0);
        unsigned nloc = b.st[0], nx = b.st[1];
        if (nloc == 0u) { xcd_barrier_complete(bar, b.x, nloc, nx); b.st[0] = nloc; b.st[1] = nx; }
        const unsigned old = xb_add(&bar[XB_XSUB(b.x)], 1u);
        const unsigned gen = old / nloc;
        if (old + 1u == (gen + 1u) * nloc) {
            __builtin_amdgcn_fence(__ATOMIC_RELEASE, "agent");
            asm volatile("s_waitcnt vmcnt(0)" ::: "memory");
            const unsigned og = xb_add(&bar[XB_TOP], 1u);
            const unsigned tg = og / nx;
            if (og + 1u == (tg + 1u) * nx) xb_add(&bar[XB_TOPGEN], 1u);
            else XB_SPIN(xb_ld(&bar[XB_TOPGEN]) == tg, bar);
            __builtin_amdgcn_fence(__ATOMIC_ACQUIRE, "agent");
            xb_add(&bar[XB_XGEN(b.x)], 1u);
            asm volatile("s_waitcnt vmcnt(0)" ::: "memory");
        } else {
            XB_SPIN(xb_ld(&bar[XB_XGEN(b.x)]) == gen, bar);
            __builtin_amdgcn_fence(__ATOMIC_ACQUIRE, "agent");
            asm volatile("s_waitcnt vmcnt(0)" ::: "memory");
        }
    }
    __syncthreads();
}

namespace pg8 {
#define PG8_LAS __attribute__((address_space(3)))
typedef unsigned short bf16_t;
typedef short bf16x8 __attribute__((ext_vector_type(8)));
typedef float f32x4 __attribute__((ext_vector_type(4)));
typedef unsigned u32x4 __attribute__((ext_vector_type(4)));
constexpr int BM = 256, BK = 64, HALF = 128, HTB = HALF * BK * 2  , STAGE_BYTES = 8 * HTB, NXCD = 8, WGM = 8;

__host__ __device__ __forceinline__ int lds_byte(int r, int c) { const int st = (r >> 4) * 2 + (c >> 5), rr = r & 15, cc = c & 31, ob = rr * 64 + cc * 2; return st * 1024 + (ob ^ (((ob >> 9) & 1) << 5)); }
__host__ __device__ __forceinline__ void stage_rc(int b, int& R, int& C) { const int st = b / 1024, sb = b % 1024, swz = sb ^ (((sb >> 9) & 1) << 5); R = (st >> 1) * 16 + swz / 64; C = (st & 1) * 32 + (swz % 64) / 2; }
__host__ __device__ __forceinline__ int perm32(int rho) { const int n = rho >> 4, i = rho & 15; return 8 * (i >> 2) + 4 * n + (i & 3); }

struct Unit { int pm, pn, eb, p0, cnt; };
struct Gemm { const bf16_t* A; const bf16_t* Bt; int M, N, K; int lda; size_t bstride; const unsigned* list; int cap; };

struct StaticOrder {
    int nM, nN, nwg, G, c;
    __host__ __device__ void init(int M, int N, int G_, int c_) { nM = M / BM; nN = N / BM; nwg = nM * nN; G = G_; c = c_; }
    __host__ __device__ bool next(int i, Unit& u) const {
        const long L = (long)i * G + c; if (L >= nwg) return false;
        int wgid = (int)L; { const int q = nwg / NXCD, r = nwg % NXCD, xcd = wgid % NXCD, off = wgid / NXCD; wgid = (xcd < r ? xcd * (q + 1) : r * (q + 1) + (xcd - r) * q) + off; }
        const int nig = WGM * nN, gid = wgid / nig, fm = gid * WGM, gsz = (nM - fm) < WGM ? (nM - fm) : WGM;
        u.pm = fm + ((wgid % nig) % gsz); u.pn = (wgid % nig) / gsz; u.eb = 0; u.p0 = 0; u.cnt = 0; return true;
    }
    __device__ __forceinline__ void a_ready(const Unit&) const {}
    __device__ __forceinline__ void done(const Unit&) const {}
};

__device__ __forceinline__ unsigned cvt_pk_bf16(float lo, float hi) { unsigned r; asm volatile("v_cvt_pk_bf16_f32 %0, %1, %2" : "=v"(r) : "v"(lo), "v"(hi)); return r; }
typedef float f32x2 __attribute__((ext_vector_type(2)));
__device__ __forceinline__ f32x2 gelu_pk(f32x2 v) {
    const f32x2 av = __builtin_elementwise_abs(v), d = av * 0.2316418882f + 1.0f;
    f32x2 t; t.x = __builtin_amdgcn_rcpf(d.x); t.y = __builtin_amdgcn_rcpf(d.y);
    f32x2 q = t * 0.5307027145f + (-0.7265760135f); q = q * t + 0.7107068705f; q = q * t + (-0.142248368f); q = q * t + 0.127414796f; q = q * t;
    const f32x2 s = (v * v) * (-0.72134752044f);
    f32x2 e; e.x = __builtin_amdgcn_exp2f(s.x); e.y = __builtin_amdgcn_exp2f(s.y);
    const f32x2 m = v * (q * e), r = v - m;
    f32x2 o; o.x = v.x < 0.f ? m.x : r.x; o.y = v.y < 0.f ? m.y : r.y; return o;
}

template <int ACT  > struct EpiBf16 {
    static constexpr bool PERM = true, AFTER_DRAIN = false; static_assert(ACT == 0 || ACT == 1, "EpiBf16: ACT is 0 (none) or 1 (gelu_pk)");
    bf16_t* O; int ldc; const float* bias; int split_cols; size_t split_stride; float scale0;
    __device__ __forceinline__ void operator()(const f32x4 (&acc)[2][2][4][2], const Unit& u, int wr, int wc, int fr, int fq) const {
        const int row0 = u.pm * BM + wr * 64 + fr; int colt = u.pn * BM; bf16_t* base = O;
        float sc = 1.f; if (split_cols) { const int t = colt / split_cols; base += (size_t)t * split_stride; colt -= t * split_cols; if (t == 0) sc = scale0; }
        const int col0 = colt + wc * 32 + 8 * fq, bcol0 = u.pn * BM + wc * 32 + 8 * fq;
        f32x4 bv[2][2];
#pragma unroll
        for (int bj = 0; bj < 2; ++bj)
#pragma unroll
            for (int n = 0; n < 2; ++n) bv[bj][n] = bias ? *(const f32x4*)(bias + bcol0 + bj * HALF + 4 * n) : (f32x4){0.f, 0.f, 0.f, 0.f};
#pragma unroll
        for (int ai = 0; ai < 2; ++ai)
#pragma unroll
            for (int m = 0; m < 4; ++m) { bf16_t* rowp = base + (size_t)(row0 + ai * HALF + m * 16) * ldc + col0;
#pragma unroll
                for (int bj = 0; bj < 2; ++bj) { f32x4 v0 = acc[ai][bj][m][0] + bv[bj][0], v1 = acc[ai][bj][m][1] + bv[bj][1];
                    if (ACT == 1) { f32x2 a = gelu_pk((f32x2){v0[0], v0[1]}), b = gelu_pk((f32x2){v0[2], v0[3]}), c = gelu_pk((f32x2){v1[0], v1[1]}), d = gelu_pk((f32x2){v1[2], v1[3]});
                        v0 = (f32x4){a.x, a.y, b.x, b.y}; v1 = (f32x4){c.x, c.y, d.x, d.y}; }
                    v0 = v0 * sc; v1 = v1 * sc; u32x4 w; w.x = cvt_pk_bf16(v0[0], v0[1]); w.y = cvt_pk_bf16(v0[2], v0[3]); w.z = cvt_pk_bf16(v1[0], v1[1]); w.w = cvt_pk_bf16(v1[2], v1[3]);
                    *(u32x4*)(rowp + bj * HALF) = w; } }
    }
};
template <class Epi, class Sched, bool ALIGN_EPI = false, bool SP2 = false>
__device__ __forceinline__ void gemm_phase(PG8_LAS unsigned char* lds, const Gemm g, const Sched& S, const Epi& E) {
    int tid_ = threadIdx.x; asm volatile("" : "+v"(tid_));
    const int tid = tid_, wid = __builtin_amdgcn_readfirstlane(tid >> 6), lane = tid & 63, wr = wid >> 2, wc = wid & 3, fr = lane & 15, fq = lane >> 4;
    const int K = g.K, nt = K / BK;
    unsigned voffA[2], voffB[2];
#pragma unroll
    for (int i = 0; i < 2; ++i) { int R, C; stage_rc(tid * 16 + i * 8192, R, C); const int Rb = Epi::PERM ? ((R & ~31) + perm32(R & 31)) : R;
        voffA[i] = (unsigned)(R * K + C) * 2u; voffB[i] = (unsigned)(Rb * K + C) * 2u; }
    const size_t kstep = (size_t)(BK * 2);
    const size_t hstep = (size_t)HALF * K * 2;
    const size_t tstep = 2 * hstep;
    const unsigned ldsw = (unsigned)wid * 1024u;
    const int aoff = lds_byte(wr * 64 + fr, fq * 8), boff = lds_byte(wc * 32 + fr, fq * 8);
#define PG8_SA(b, h) (((b) * 2 + (h)) * HTB)
#define PG8_SB(b, h) ((4 + (b) * 2 + (h)) * HTB)
#define PG8_STAGE(bufoff, gbase, voff) do { _Pragma("unroll") for (int _i = 0; _i < 2; ++_i) \
        __builtin_amdgcn_global_load_lds((const unsigned*)((const char*)(gbase) + (voff)[_i]), (PG8_LAS unsigned*)(lds + (bufoff) + ldsw + _i * 8192), 16, 0, 0); } while (0)
#define PG8_LDA(dst, b, h) do { _Pragma("unroll") for (int m = 0; m < 4; ++m) _Pragma("unroll") for (int k = 0; k < 2; ++k) dst[m][k] = *(const PG8_LAS bf16x8*)(lds + PG8_SA(b, h) + aoff + m * 2048 + k * 1024); } while (0)
#define PG8_LDB(dst, b, h) do { _Pragma("unroll") for (int n = 0; n < 2; ++n) _Pragma("unroll") for (int k = 0; k < 2; ++k) dst[n][k] = *(const PG8_LAS bf16x8*)(lds + PG8_SB(b, h) + boff + n * 2048 + k * 1024); } while (0)
#define PG8_MMA(ai, bj, At, Bt) do { __builtin_amdgcn_s_setprio(1); _Pragma("unroll") for (int m = 0; m < 4; ++m) _Pragma("unroll") for (int n = 0; n < 2; ++n) _Pragma("unroll") for (int k = 0; k < 2; ++k) \
        acc[ai][bj][m][n] = __builtin_amdgcn_mfma_f32_16x16x32_bf16(Bt[n][k], At[m][k], acc[ai][bj][m][n], 0, 0, 0); __builtin_amdgcn_s_setprio(0); } while (0)
#define PG8_WAIT_V(n) asm volatile("s_waitcnt vmcnt(" #n ")" ::: "memory")
#define PG8_WAIT_L(n) asm volatile("s_waitcnt lgkmcnt(" #n ")" ::: "memory")
#define PG8_BAR __builtin_amdgcn_s_barrier()
#define PG8_SCHED __builtin_amdgcn_sched_barrier(0)
    Unit cur, nxt; int ui = 0;
    if (!S.next(0, cur)) return;
    f32x4 acc[2][2][4][2];
#pragma unroll
    for (int a = 0; a < 2; ++a)
#pragma unroll
        for (int b = 0; b < 2; ++b)
#pragma unroll
            for (int m = 0; m < 4; ++m)
#pragma unroll
                for (int n = 0; n < 2; ++n) acc[a][b][m][n] = (f32x4){0.f, 0.f, 0.f, 0.f};
    bf16x8 At[4][2], B0[2][2], B1[2][2];
    const char* cA = (const char*)g.A + (size_t)cur.pm * tstep; const char* cB = (const char*)g.Bt + (size_t)cur.pn * tstep;
    S.a_ready(cur);
    if constexpr (SP2) {
        PG8_STAGE(PG8_SB(0, 0), cB, voffB); PG8_STAGE(PG8_SB(0, 1), cB + hstep, voffB); PG8_STAGE(PG8_SA(0, 0), cA, voffA); PG8_STAGE(PG8_SA(0, 1), cA + hstep, voffA);
        if (wr == 1) PG8_BAR;
        PG8_WAIT_V(2); PG8_BAR;
        PG8_STAGE(PG8_SB(1, 0), cB + kstep, voffB); PG8_STAGE(PG8_SA(1, 0), cA + kstep, voffA); PG8_STAGE(PG8_SB(1, 1), cB + hstep + kstep, voffB);
        PG8_WAIT_V(6); PG8_BAR;
    } else {
        PG8_STAGE(PG8_SB(0, 0), cB, voffB); PG8_STAGE(PG8_SA(0, 0), cA, voffA); PG8_STAGE(PG8_SB(0, 1), cB + hstep, voffB); PG8_STAGE(PG8_SA(0, 1), cA + hstep, voffA);
        if (wr == 1) PG8_BAR;
        PG8_WAIT_V(4); PG8_BAR;
        PG8_STAGE(PG8_SB(1, 0), cB + kstep, voffB); PG8_STAGE(PG8_SA(1, 0), cA + kstep, voffA); PG8_STAGE(PG8_SB(1, 1), cB + hstep + kstep, voffB);
        PG8_WAIT_V(6); PG8_BAR;
    }
    for (;;) {
        const bool has_next = S.next(ui + 1, nxt);
        const char* nA = has_next ? (const char*)g.A + (size_t)nxt.pm * tstep : cA; const char* nB = has_next ? (const char*)g.Bt + (size_t)nxt.pn * tstep : cB;
        for (int t = 0; t < nt; t += 2) {
            const bool last = (t == nt - 2);
            const char* a1 = cA + (size_t)(t + 1) * kstep;
            const char* a2 = last ? nA : cA + (size_t)(t + 2) * kstep; const char* b2 = last ? nB : cB + (size_t)(t + 2) * kstep;
            const char* a3 = a2 + kstep; const char* b3 = b2 + kstep;
            if (last && has_next) S.a_ready(nxt);
            if constexpr (SP2) {
            PG8_LDB(B0, 0, 0); PG8_LDB(B1, 0, 1); PG8_SCHED; PG8_LDA(At, 0, 0); PG8_STAGE(PG8_SA(1, 1), a1 + hstep, voffA);
            PG8_WAIT_V(8); PG8_WAIT_L(0); PG8_BAR; PG8_MMA(0, 0, At, B0); PG8_MMA(0, 1, At, B1); PG8_BAR; PG8_SCHED;
            PG8_LDA(At, 0, 1); PG8_STAGE(PG8_SB(0, 0), b2, voffB); PG8_STAGE(PG8_SB(0, 1), b2 + hstep, voffB); PG8_STAGE(PG8_SA(0, 0), a2, voffA);
            PG8_WAIT_V(8); PG8_WAIT_L(0); PG8_BAR; PG8_MMA(1, 0, At, B0); PG8_MMA(1, 1, At, B1); PG8_BAR; PG8_SCHED;
            PG8_LDB(B0, 1, 0); PG8_LDB(B1, 1, 1); PG8_SCHED; PG8_LDA(At, 1, 0); PG8_STAGE(PG8_SA(0, 1), a2 + hstep, voffA);
            PG8_WAIT_V(8); PG8_WAIT_L(0); PG8_BAR; PG8_MMA(0, 0, At, B0); PG8_MMA(0, 1, At, B1); PG8_BAR; PG8_SCHED;
            PG8_LDA(At, 1, 1); PG8_STAGE(PG8_SB(1, 0), b3, voffB); PG8_STAGE(PG8_SB(1, 1), b3 + hstep, voffB); PG8_STAGE(PG8_SA(1, 0), a3, voffA);
            PG8_WAIT_V(8); PG8_WAIT_L(0); PG8_BAR; PG8_MMA(1, 0, At, B0); PG8_MMA(1, 1, At, B1); PG8_BAR; PG8_SCHED;
            } else {
            PG8_LDB(B0, 0, 0); PG8_SCHED; PG8_LDA(At, 0, 0); PG8_STAGE(PG8_SA(1, 1), a1 + hstep, voffA);
            PG8_WAIT_L(8); PG8_BAR; PG8_WAIT_L(0); PG8_MMA(0, 0, At, B0); PG8_BAR; PG8_SCHED;
            PG8_LDB(B1, 0, 1); PG8_STAGE(PG8_SB(0, 0), b2, voffB);
            PG8_BAR; PG8_WAIT_L(0); PG8_MMA(0, 1, At, B1); PG8_BAR;
            PG8_LDA(At, 0, 1); PG8_STAGE(PG8_SA(0, 0), a2, voffA);
            PG8_BAR; PG8_WAIT_L(0); PG8_MMA(1, 0, At, B0); PG8_BAR; PG8_SCHED;
            PG8_STAGE(PG8_SB(0, 1), b2 + hstep, voffB);
            PG8_WAIT_V(6); PG8_BAR; PG8_MMA(1, 1, At, B1); PG8_BAR;
            PG8_LDB(B0, 1, 0); PG8_SCHED; PG8_LDA(At, 1, 0); PG8_STAGE(PG8_SA(0, 1), a2 + hstep, voffA);
            PG8_WAIT_L(8); PG8_BAR; PG8_WAIT_L(0); PG8_MMA(0, 0, At, B0); PG8_BAR; PG8_SCHED;
            PG8_LDB(B1, 1, 1); PG8_STAGE(PG8_SB(1, 0), b3, voffB);
            PG8_BAR; PG8_WAIT_L(0); PG8_MMA(0, 1, At, B1); PG8_BAR;
            PG8_LDA(At, 1, 1); PG8_STAGE(PG8_SA(1, 0), a3, voffA);
            PG8_BAR; PG8_WAIT_L(0); PG8_MMA(1, 0, At, B0); PG8_BAR; PG8_SCHED;
            PG8_STAGE(PG8_SB(1, 1), b3 + hstep, voffB);
            PG8_WAIT_V(6); PG8_BAR; PG8_MMA(1, 1, At, B1); PG8_BAR;
            }
        }
        if constexpr (ALIGN_EPI) { if (wr == 0) PG8_BAR; }
        if constexpr (!Epi::AFTER_DRAIN) { E(acc, cur, wr, wc, fr, fq); S.done(cur); }
        if (!has_next) break;
#pragma unroll
        for (int a = 0; a < 2; ++a)
#pragma unroll
            for (int b = 0; b < 2; ++b)
#pragma unroll
                for (int m = 0; m < 4; ++m)
#pragma unroll
                    for (int n = 0; n < 2; ++n) acc[a][b][m][n] = (f32x4){0.f, 0.f, 0.f, 0.f};
        cur = nxt; cA = nA; cB = nB; ++ui;
        if constexpr (ALIGN_EPI) { if (wr == 1) PG8_BAR; }
    }
    PG8_WAIT_V(0);
    if constexpr (!ALIGN_EPI) { if (wr == 0) PG8_BAR; }
    PG8_BAR;
    if constexpr (Epi::AFTER_DRAIN) { E.fused(acc, cur, wr, wc, fr, fq, lds, wid, lane); S.done(cur); }
#undef PG8_SA
#undef PG8_SB
#undef PG8_STAGE
#undef PG8_LDA
#undef PG8_LDB
#undef PG8_MMA
#undef PG8_WAIT_V
#undef PG8_WAIT_L
#undef PG8_BAR
#undef PG8_SCHED
}

__device__ __forceinline__ float sigm(float x) { return 1.0f / (1.0f + __expf(-x)); }
struct EpiGlu {
    static constexpr bool PERM = true, AFTER_DRAIN = false;
    bf16_t* O; int ldc;
    __device__ __forceinline__ void operator()(const f32x4 (&acc)[2][2][4][2], const Unit& u, int wr, int wc, int fr, int fq) const {
        const int row0 = u.pm * BM + wr * 64 + fr, col0 = u.pn * HALF + wc * 32 + 8 * fq;
#pragma unroll
        for (int ai = 0; ai < 2; ++ai)
#pragma unroll
            for (int m = 0; m < 4; ++m) {
                bf16_t* rowp = O + (size_t)(row0 + ai * HALF + m * 16) * ldc + col0;
                const f32x4 a0 = acc[ai][0][m][0], a1 = acc[ai][0][m][1], b0 = acc[ai][1][m][0], b1 = acc[ai][1][m][1];
                u32x4 w;
                w.x = cvt_pk_bf16(a0[0] * sigm(b0[0]), a0[1] * sigm(b0[1])); w.y = cvt_pk_bf16(a0[2] * sigm(b0[2]), a0[3] * sigm(b0[3]));
                w.z = cvt_pk_bf16(a1[0] * sigm(b1[0]), a1[1] * sigm(b1[1])); w.w = cvt_pk_bf16(a1[2] * sigm(b1[2]), a1[3] * sigm(b1[3]));
                *(u32x4*)rowp = w;
            }
    }
};
struct EpiResid {
    static constexpr bool PERM = false, AFTER_DRAIN = false;
    const float* X; float* O; int ldc;
    __device__ __forceinline__ void operator()(const f32x4 (&acc)[2][2][4][2], const Unit& u, int wr, int wc, int fr, int fq) const {
        const int row0 = u.pm * BM + wr * 64 + fr, col0 = u.pn * BM + wc * 32 + 4 * fq;
#pragma unroll
        for (int ai = 0; ai < 2; ++ai)
#pragma unroll
            for (int m = 0; m < 4; ++m) {
                const size_t off = (size_t)(row0 + ai * HALF + m * 16) * ldc + col0;
#pragma unroll
                for (int bj = 0; bj < 2; ++bj)
#pragma unroll
                    for (int n = 0; n < 2; ++n) *(f32x4*)(O + off + bj * HALF + n * 16) = *(const f32x4*)(X + off + bj * HALF + n * 16) + acc[ai][bj][m][n];
            }
    }
};

template <class Epi, class Sched, bool GATHER>
__device__ __forceinline__ void gemm2(PG8_LAS unsigned char* lds, const Gemm g, const Sched& S, const Epi& E, const int tid) {
    const int wid = __builtin_amdgcn_readfirstlane(tid >> 6), lane = tid & 63, wr = wid >> 2, wc = wid & 3, fr = lane & 15, fq = lane >> 4;
    const int K = g.K, nt = K / BK, lda = g.lda;
    unsigned voffA[2], voffB[2]; int Rst[2], Cst[2];
#pragma unroll
    for (int i = 0; i < 2; ++i) { int R, C; stage_rc(tid * 16 + i * 8192, R, C); const int Rb = Epi::PERM ? ((R & ~31) + perm32(R & 31)) : R;
        voffA[i] = (unsigned)(R * lda + C) * 2u; voffB[i] = (unsigned)(Rb * K + C) * 2u; Rst[i] = R; Cst[i] = C; }
    const size_t kstep = (size_t)(BK * 2);
    const size_t hstepA = (size_t)HALF * lda * 2, tstepA = 2 * hstepA, hstepB = (size_t)HALF * K * 2, tstepB = 2 * hstepB;
    const unsigned ldsw = (unsigned)wid * 1024u;
    const int aoff = lds_byte(wr * 64 + fr, fq * 8), boff = lds_byte(wc * 32 + fr, fq * 8);
#define PG8_SA(b, h) (((b) * 2 + (h)) * HTB)
#define PG8_SB(b, h) ((4 + (b) * 2 + (h)) * HTB)
#define PG8_STAGE(bufoff, gbase, voff) do { _Pragma("unroll") for (int _i = 0; _i < 2; ++_i) \
        __builtin_amdgcn_global_load_lds((const unsigned*)((const char*)(gbase) + (voff)[_i]), (PG8_LAS unsigned*)(lds + (bufoff) + ldsw + _i * 8192), 16, 0, 0); } while (0)
#define PG8_STAGE_A(bufoff, gbase, h) do { if constexpr (GATHER) { PG8_STAGE(bufoff, gbase, vg[h]); } else { PG8_STAGE(bufoff, (gbase) + (h) * hstepA, voffA); } } while (0)
#define PG8_GOFFS(u, dst) do { _Pragma("unroll") for (int _h = 0; _h < 2; ++_h) _Pragma("unroll") for (int _i = 0; _i < 2; ++_i) { const int _pos = (u).p0 + _h * HALF + Rst[_i]; \
        const unsigned _tok = _pos < (u).cnt ? (g.list[(size_t)(u).eb * g.cap + _pos] >> 1) : 0u; dst[_h][_i] = (_tok * (unsigned)lda + (unsigned)Cst[_i]) * 2u; } } while (0)
#define PG8_LDA(dst, b, h) do { _Pragma("unroll") for (int m = 0; m < 4; ++m) _Pragma("unroll") for (int k = 0; k < 2; ++k) dst[m][k] = *(const PG8_LAS bf16x8*)(lds + PG8_SA(b, h) + aoff + m * 2048 + k * 1024); } while (0)
#define PG8_LDB(dst, b, h) do { _Pragma("unroll") for (int n = 0; n < 2; ++n) _Pragma("unroll") for (int k = 0; k < 2; ++k) dst[n][k] = *(const PG8_LAS bf16x8*)(lds + PG8_SB(b, h) + boff + n * 2048 + k * 1024); } while (0)
#define PG8_MMA(ai, bj, At, Bt) do { __builtin_amdgcn_s_setprio(1); _Pragma("unroll") for (int m = 0; m < 4; ++m) _Pragma("unroll") for (int n = 0; n < 2; ++n) _Pragma("unroll") for (int k = 0; k < 2; ++k) \
        acc[ai][bj][m][n] = __builtin_amdgcn_mfma_f32_16x16x32_bf16(Bt[n][k], At[m][k], acc[ai][bj][m][n], 0, 0, 0); __builtin_amdgcn_s_setprio(0); } while (0)
#define PG8_WAIT_V(n) asm volatile("s_waitcnt vmcnt(" #n ")" ::: "memory")
#define PG8_WAIT_L(n) asm volatile("s_waitcnt lgkmcnt(" #n ")" ::: "memory")
#define PG8_BAR __builtin_amdgcn_s_barrier()
#define PG8_SCHED __builtin_amdgcn_sched_barrier(0)
    Unit cur, nxt; int ui = 0;
    if (!S.next(0, cur)) return;
    f32x4 acc[2][2][4][2];
#pragma unroll
    for (int a = 0; a < 2; ++a)
#pragma unroll
        for (int b = 0; b < 2; ++b)
#pragma unroll
            for (int m = 0; m < 4; ++m)
#pragma unroll
                for (int n = 0; n < 2; ++n) acc[a][b][m][n] = (f32x4){0.f, 0.f, 0.f, 0.f};
    bf16x8 At[4][2], B0[2][2], B1[2][2];
    unsigned vg[2][2] = {{0u, 0u}, {0u, 0u}};
    if constexpr (GATHER) PG8_GOFFS(cur, vg);
    const char* cA = (const char*)g.A + (GATHER ? (size_t)0 : (size_t)cur.pm * tstepA);
    const char* cB = (const char*)g.Bt + ((size_t)cur.eb * g.bstride) * 2 + (size_t)cur.pn * tstepB;
    S.a_ready(cur);
    PG8_STAGE(PG8_SB(0, 0), cB, voffB); PG8_STAGE(PG8_SB(0, 1), cB + hstepB, voffB); PG8_STAGE_A(PG8_SA(0, 0), cA, 0); PG8_STAGE_A(PG8_SA(0, 1), cA, 1);
    if (wr == 1) PG8_BAR;
    PG8_WAIT_V(2); PG8_BAR;
    PG8_STAGE(PG8_SB(1, 0), cB + kstep, voffB); PG8_STAGE_A(PG8_SA(1, 0), cA + kstep, 0); PG8_STAGE(PG8_SB(1, 1), cB + hstepB + kstep, voffB);
    PG8_WAIT_V(6); PG8_BAR;
    for (;;) {
        const bool has_next = S.next(ui + 1, nxt);
        const char* nA = has_next ? (const char*)g.A + (GATHER ? (size_t)0 : (size_t)nxt.pm * tstepA) : cA;
        const char* nB = has_next ? (const char*)g.Bt + ((size_t)nxt.eb * g.bstride) * 2 + (size_t)nxt.pn * tstepB : cB;
        for (int t = 0; t < nt; t += 2) {
            const bool last = (t == nt - 2);
            const char* a1 = cA + (size_t)(t + 1) * kstep;
            const char* a2 = last ? nA : cA + (size_t)(t + 2) * kstep; const char* b2 = last ? nB : cB + (size_t)(t + 2) * kstep;
            const char* a3 = a2 + kstep; const char* b3 = b2 + kstep;
            unsigned vn1[2] = {vg[1][0], vg[1][1]};
            if constexpr (GATHER) { if (last && has_next) { unsigned vn[2][2]; PG8_GOFFS(nxt, vn); vg[0][0] = vn[0][0]; vg[0][1] = vn[0][1]; vn1[0] = vn[1][0]; vn1[1] = vn[1][1]; } }
            if (last && has_next) S.a_ready(nxt);
            PG8_LDB(B0, 0, 0); PG8_LDB(B1, 0, 1); PG8_SCHED; PG8_LDA(At, 0, 0); PG8_STAGE_A(PG8_SA(1, 1), a1, 1);
            PG8_WAIT_V(8); PG8_WAIT_L(0); PG8_BAR; PG8_MMA(0, 0, At, B0); PG8_MMA(0, 1, At, B1); PG8_BAR; PG8_SCHED;
            if constexpr (GATHER) { vg[1][0] = vn1[0]; vg[1][1] = vn1[1]; }
            PG8_LDA(At, 0, 1); PG8_STAGE(PG8_SB(0, 0), b2, voffB); PG8_STAGE(PG8_SB(0, 1), b2 + hstepB, voffB); PG8_STAGE_A(PG8_SA(0, 0), a2, 0);
            PG8_WAIT_V(8); PG8_WAIT_L(0); PG8_BAR; PG8_MMA(1, 0, At, B0); PG8_MMA(1, 1, At, B1); PG8_BAR; PG8_SCHED;
            PG8_LDB(B0, 1, 0); PG8_LDB(B1, 1, 1); PG8_SCHED; PG8_LDA(At, 1, 0); PG8_STAGE_A(PG8_SA(0, 1), a2, 1);
            PG8_WAIT_V(8); PG8_WAIT_L(0); PG8_BAR; PG8_MMA(0, 0, At, B0); PG8_MMA(0, 1, At, B1); PG8_BAR; PG8_SCHED;
            PG8_LDA(At, 1, 1); PG8_STAGE(PG8_SB(1, 0), b3, voffB); PG8_STAGE(PG8_SB(1, 1), b3 + hstepB, voffB); PG8_STAGE_A(PG8_SA(1, 0), a3, 0);
            PG8_WAIT_V(8); PG8_WAIT_L(0); PG8_BAR; PG8_MMA(1, 0, At, B0); PG8_MMA(1, 1, At, B1); PG8_BAR; PG8_SCHED;
        }
        if (wr == 0) PG8_BAR;
        E(acc, cur, wr, wc, fr, fq); S.done(cur);
        if (!has_next) break;
#pragma unroll
        for (int a = 0; a < 2; ++a)
#pragma unroll
            for (int b = 0; b < 2; ++b)
#pragma unroll
                for (int m = 0; m < 4; ++m)
#pragma unroll
                    for (int n = 0; n < 2; ++n) acc[a][b][m][n] = (f32x4){0.f, 0.f, 0.f, 0.f};
        cur = nxt; cA = nA; cB = nB; ++ui;
        if (wr == 1) PG8_BAR;
    }
    PG8_WAIT_V(0);
    PG8_BAR;
#undef PG8_SA
#undef PG8_SB
#undef PG8_STAGE
#undef PG8_STAGE_A
#undef PG8_GOFFS
#undef PG8_LDA
#undef PG8_LDB
#undef PG8_MMA
#undef PG8_WAIT_V
#undef PG8_WAIT_L
#undef PG8_BAR
#undef PG8_SCHED
}

struct ExpertOrder {
    const PG8_LAS int* tab; int nN, G, c;
    __device__ __forceinline__ bool next(int i, Unit& u) const {
        const int total = tab[32] * nN; const long L = (long)i * G + c; if (L >= total) return false;
        const int rt = (int)L / nN, pn = (int)L % nN; int e = 0;
#pragma unroll
        for (int k = 1; k < 32; ++k) e += (rt >= tab[k]) ? 1 : 0;
        u.pm = __builtin_amdgcn_readfirstlane(rt); u.pn = __builtin_amdgcn_readfirstlane(pn); u.eb = __builtin_amdgcn_readfirstlane(e);
        u.p0 = __builtin_amdgcn_readfirstlane((rt - tab[e]) * BM); u.cnt = __builtin_amdgcn_readfirstlane(tab[33 + e]); return true;
    }
    __device__ __forceinline__ void a_ready(const Unit&) const {}
    __device__ __forceinline__ void done(const Unit&) const {}
};
struct EpiGateUp {
    static constexpr bool PERM = true, AFTER_DRAIN = false;
    bf16_t* H; const float* listw; int cap;
    __device__ __forceinline__ void operator()(const f32x4 (&acc)[2][2][4][2], const Unit& u, int wr, int wc, int fr, int fq) const {
        const int rl0 = wr * 64 + fr, col0 = u.pn * HALF + wc * 32 + 8 * fq;
#pragma unroll
        for (int ai = 0; ai < 2; ++ai)
#pragma unroll
            for (int m = 0; m < 4; ++m) {
                const int rl = rl0 + ai * HALF + m * 16, pos = u.p0 + rl;
                const float w = pos < u.cnt ? listw[(size_t)u.eb * cap + pos] : 0.f;
                bf16_t* rowp = H + (size_t)(u.pm * BM + rl) * 256 + col0;
                const f32x4 g0 = acc[ai][0][m][0], g1 = acc[ai][0][m][1], u0 = acc[ai][1][m][0], u1 = acc[ai][1][m][1];
                u32x4 o;
                o.x = cvt_pk_bf16(g0[0] * sigm(g0[0]) * u0[0] * w, g0[1] * sigm(g0[1]) * u0[1] * w); o.y = cvt_pk_bf16(g0[2] * sigm(g0[2]) * u0[2] * w, g0[3] * sigm(g0[3]) * u0[3] * w);
                o.z = cvt_pk_bf16(g1[0] * sigm(g1[0]) * u1[0] * w, g1[1] * sigm(g1[1]) * u1[1] * w); o.w = cvt_pk_bf16(g1[2] * sigm(g1[2]) * u1[2] * w, g1[3] * sigm(g1[3]) * u1[3] * w);
                *(u32x4*)rowp = o;
            }
    }
};
struct EpiDown {
    static constexpr bool PERM = false, AFTER_DRAIN = false;
    float* X; float* P2; const unsigned* list; int cap;
    __device__ __forceinline__ void operator()(const f32x4 (&acc)[2][2][4][2], const Unit& u, int wr, int wc, int fr, int fq) const {
        const int rl0 = wr * 64 + fr, col0 = u.pn * BM + wc * 32 + 4 * fq;
#pragma unroll
        for (int ai = 0; ai < 2; ++ai)
#pragma unroll
            for (int m = 0; m < 4; ++m) {
                const int rl = rl0 + ai * HALF + m * 16, pos = u.p0 + rl;
                if (pos < u.cnt) {
                    const unsigned ent = list[(size_t)u.eb * cap + pos];
                    float* dst = ((ent & 1u) ? P2 : X) + (size_t)(ent >> 1) * 1024 + col0;
#pragma unroll
                    for (int bj = 0; bj < 2; ++bj)
#pragma unroll
                        for (int n = 0; n < 2; ++n) { f32x4 v = acc[ai][bj][m][n]; if (!(ent & 1u)) v += *(const f32x4*)(dst + bj * HALF + n * 16); *(f32x4*)(dst + bj * HALF + n * 16) = v; }
                }
                asm volatile("" ::: "memory");
            }
    }
};
}

struct Args { const float* in[26]; float* out; unsigned char* ws; int ph_lo, ph_hi; };

struct Frame {
    LAS unsigned char* lds;
    int tid, lane, wave, blk, G;
};

__device__ __forceinline__ void ph_norm(const Frame& F, const float* xin, const float* add, float* xout, const float* g, bf16* hn) {
    const int gw = F.blk * NWAVES + F.wave, NGW = F.G * NWAVES;
    for (int row = gw; row < T; row += NGW) {
        const f32x4* xr = (const f32x4*)(xin + (size_t)row * DM);
        f32x4 v[4]; float s = 0.f;
#pragma unroll
        for (int j = 0; j < 4; ++j) { v[j] = xr[F.lane + 64 * j];
            if (add) { v[j] += ((const f32x4*)(add + (size_t)row * DM))[F.lane + 64 * j]; ((f32x4*)(xout + (size_t)row * DM))[F.lane + 64 * j] = v[j]; }
            s += v[j].x * v[j].x + v[j].y * v[j].y + v[j].z * v[j].z + v[j].w * v[j].w; }
        s = wave_sum(s, F.lane);
        const float r = rsqrtf(s * (1.0f / DM) + EPS);
#pragma unroll
        for (int j = 0; j < 4; ++j) {
            const f32x4 gg = ((const f32x4*)g)[F.lane + 64 * j];
            u32x2 o; o.x = pk2(v[j].x * r * gg.x, v[j].y * r * gg.y); o.y = pk2(v[j].z * r * gg.z, v[j].w * r * gg.w);
            *(u32x2*)(hn + (size_t)row * DM + (F.lane + 64 * j) * 4) = o;
        }
    }
}
__device__ __forceinline__ void ph_final_norm(const Frame& F, float* x, const float* add, const float* g) {
    const int gw = F.blk * NWAVES + F.wave, NGW = F.G * NWAVES;
    for (int row = gw; row < T; row += NGW) {
        f32x4* xr = (f32x4*)(x + (size_t)row * DM);
        f32x4 v[4]; float s = 0.f;
#pragma unroll
        for (int j = 0; j < 4; ++j) { v[j] = xr[F.lane + 64 * j]; if (add) v[j] += ((const f32x4*)(add + (size_t)row * DM))[F.lane + 64 * j]; s += v[j].x * v[j].x + v[j].y * v[j].y + v[j].z * v[j].z + v[j].w * v[j].w; }
        s = wave_sum(s, F.lane);
        const float r = rsqrtf(s * (1.0f / DM) + EPS);
#pragma unroll
        for (int j = 0; j < 4; ++j) {
            const f32x4 gg = ((const f32x4*)g)[F.lane + 64 * j];
            f32x4 o; o.x = v[j].x * r * gg.x; o.y = v[j].y * r * gg.y; o.z = v[j].z * r * gg.z; o.w = v[j].w * r * gg.w;
            xr[F.lane + 64 * j] = o;
        }
    }
}

template <bool DUAL, class Epi>
__device__ __forceinline__ void sgemm_naive(const Frame& F, const bf16* A, int lda, const float* B, int ldb, int M, int N, int K, int dualoff, const Epi& epi) {
    LAS float* As = (LAS float*)F.lds;
    LAS float* Bs = As + 16 * 132;
    LAS float* Bs2 = Bs + 16 * 128;
    const int tiles_n = (N + 127) / 128, tiles_m = M / 128;
    const int tx = F.tid & 31, ty = F.tid >> 5;
    for (int tile = F.blk; tile < tiles_m * tiles_n; tile += F.G) {
        const int tm = tile / tiles_n, tn = tile % tiles_n;
        float acc[8][4], acc2[8][4];
#pragma unroll
        for (int i = 0; i < 8; ++i)
#pragma unroll
            for (int j = 0; j < 4; ++j) { acc[i][j] = 0.f; acc2[i][j] = 0.f; }
        const int arow = F.tid >> 2, akq = (F.tid & 3) * 4;
        const int bk = F.tid >> 5, bn = (F.tid & 31) * 4;
        for (int k0 = 0; k0 < K; k0 += 16) {
            {
                const u32x2 av = *(const u32x2*)(A + (size_t)(tm * 128 + arow) * lda + k0 + akq);
                As[(akq + 0) * 132 + arow] = __uint_as_float(av.x << 16);
                As[(akq + 1) * 132 + arow] = __uint_as_float(av.x & 0xffff0000u);
                As[(akq + 2) * 132 + arow] = __uint_as_float(av.y << 16);
                As[(akq + 3) * 132 + arow] = __uint_as_float(av.y & 0xffff0000u);
                const int col = tn * 128 + bn;
                f32x4 bv = (f32x4){0.f, 0.f, 0.f, 0.f};
                const float* bp = B + (size_t)(k0 + bk) * ldb + col;
                if (col + 3 < N) { bv.x = bp[0]; bv.y = bp[1]; bv.z = bp[2]; bv.w = bp[3]; }
                else { if (col < N) bv.x = bp[0]; if (col + 1 < N) bv.y = bp[1]; if (col + 2 < N) bv.z = bp[2]; }
                *(LAS f32x4*)(Bs + bk * 128 + bn) = bv;
                if (DUAL) {
                    const float* bp2 = bp + dualoff;
                    f32x4 bw; bw.x = bp2[0]; bw.y = bp2[1]; bw.z = bp2[2]; bw.w = bp2[3];
                    *(LAS f32x4*)(Bs2 + bk * 128 + bn) = bw;
                }
            }
            __syncthreads();
#pragma unroll 4
            for (int k = 0; k < 16; ++k) {
                float a[8];
                const f32x4 a0 = *(const LAS f32x4*)(As + k * 132 + ty * 8), a1 = *(const LAS f32x4*)(As + k * 132 + ty * 8 + 4);
                a[0] = a0.x; a[1] = a0.y; a[2] = a0.z; a[3] = a0.w; a[4] = a1.x; a[5] = a1.y; a[6] = a1.z; a[7] = a1.w;
                const f32x4 b = *(const LAS f32x4*)(Bs + k * 128 + tx * 4);
#pragma unroll
                for (int i = 0; i < 8; ++i) { acc[i][0] += a[i] * b.x; acc[i][1] += a[i] * b.y; acc[i][2] += a[i] * b.z; acc[i][3] += a[i] * b.w; }
                if (DUAL) {
                    const f32x4 b2 = *(const LAS f32x4*)(Bs2 + k * 128 + tx * 4);
#pragma unroll
                    for (int i = 0; i < 8; ++i) { acc2[i][0] += a[i] * b2.x; acc2[i][1] += a[i] * b2.y; acc2[i][2] += a[i] * b2.z; acc2[i][3] += a[i] * b2.w; }
                }
            }
            __syncthreads();
        }
#pragma unroll
        for (int i = 0; i < 8; ++i)
#pragma unroll
            for (int j = 0; j < 4; ++j) {
                const int row = tm * 128 + ty * 8 + i, col = tn * 128 + tx * 4 + j;
                if (col < N) epi(row, col, acc[i][j], acc2[i][j]);
            }
    }
}
struct EpiStoreBf16 { bf16* O; int ldo; __device__ __forceinline__ void operator()(int r, int c, float a, float) const { O[(size_t)r * ldo + c] = (bf16)f2bf(a); } };
struct EpiGlu { bf16* O; int ldo; __device__ __forceinline__ void operator()(int r, int c, float a, float b) const { O[(size_t)r * ldo + c] = (bf16)f2bf(a * sigmoidf_(b)); } };
struct EpiResid { const float* X; float* O; __device__ __forceinline__ void operator()(int r, int c, float a, float) const { O[(size_t)r * DM + c] = X[(size_t)r * DM + c] + a; } };

__device__ __forceinline__ void ssm_naive_item(int b, int g, const float* a_re, const float* a_im, const float* b_re, const float* b_im, const float* c_re, const float* c_im,
                                               const float* dpar, const float* log_dt, const bf16* Z, bf16* G1, int lane) {
    const int p = lane;
    const float are = a_re[g * 64 + p], aim = a_im[g * 64 + p], dt = expf(log_dt[g]);
    const float er = expf(are * dt), lbr = er * cosf(aim * dt), lbi = er * sinf(aim * dt);
    const float xx = lbr - 1.0f, yy = lbi, den = are * are + aim * aim;
    const float fr = (xx * are + yy * aim) / den, fi = (yy * are - xx * aim) / den;
    float bbr[16], bbi[16], cr[16], ci[16];
#pragma unroll
    for (int h = 0; h < 16; ++h) {
        const float br = b_re[(g * 64 + p) * 16 + h], bi = b_im[(g * 64 + p) * 16 + h];
        bbr[h] = fr * br - fi * bi; bbi[h] = fr * bi + fi * br;
        cr[h] = c_re[(g * 16 + h) * 64 + p]; ci[h] = c_im[(g * 16 + h) * 64 + p];
    }
    const float dd = dpar[g * 16 + (lane & 15)];
    float xr = 0.f, xi = 0.f;
    for (int t = 0; t < SEQ; ++t) {
        const size_t row = (size_t)b * SEQ + t;
        const u32x4 u0 = *(const u32x4*)(Z + row * ZP + ZC_U + g * 16), u1 = *(const u32x4*)(Z + row * ZP + ZC_U + g * 16 + 8);
        float u[16];
        u[0] = __uint_as_float(u0.x << 16); u[1] = __uint_as_float(u0.x & 0xffff0000u); u[2] = __uint_as_float(u0.y << 16); u[3] = __uint_as_float(u0.y & 0xffff0000u);
        u[4] = __uint_as_float(u0.z << 16); u[5] = __uint_as_float(u0.z & 0xffff0000u); u[6] = __uint_as_float(u0.w << 16); u[7] = __uint_as_float(u0.w & 0xffff0000u);
        u[8] = __uint_as_float(u1.x << 16); u[9] = __uint_as_float(u1.x & 0xffff0000u); u[10] = __uint_as_float(u1.y << 16); u[11] = __uint_as_float(u1.y & 0xffff0000u);
        u[12] = __uint_as_float(u1.z << 16); u[13] = __uint_as_float(u1.z & 0xffff0000u); u[14] = __uint_as_float(u1.w << 16); u[15] = __uint_as_float(u1.w & 0xffff0000u);
        float bur = 0.f, bui = 0.f;
#pragma unroll
        for (int h = 0; h < 16; ++h) { bur += bbr[h] * u[h]; bui += bbi[h] * u[h]; }
        const float nxr = lbr * xr - lbi * xi + bur, nxi = lbr * xi + lbi * xr + bui;
        xr = nxr; xi = nxi;
        float y = 0.f;
#pragma unroll
        for (int h = 0; h < 16; ++h) { const float v = wave_sum(cr[h] * xr - ci[h] * xi, lane); if (lane == h) y = v; }
        if (lane < 16) {
            const float ul = bf2f(Z[row * ZP + ZC_U + g * 16 + lane]);
            G1[row * D_SSM + g * 16 + lane] = (bf16)f2bf(gelu_tanh(y + dd * ul));
        }
    }
}
__device__ __forceinline__ void compress_naive_item(int item, const bf16* Z, const float* pos, const float* w1, const float* w2, float* KC, float* VC, int lane) {
    const int i = item & 1, hkv = (item >> 1) & 1, n = (item >> 2) % NCMP, b = (item >> 2) / NCMP;
    const float* posi = pos + i * 32 * 64; const float* w1i = w1 + (size_t)i * 32 * 64 * 64; const float* w2i = w2 + i * 64 * 64;
    float acc = 0.f;
    for (int l = 0; l < 32; ++l) {
        const bf16* zr = Z + ((size_t)b * SEQ + 16 * n + l) * ZP + ZC_KV + i * 128 + hkv * 64;
        for (int d = 0; d < 64; ++d) acc += (bf2f(zr[d]) + posi[l * 64 + d]) * w1i[(l * 64 + d) * 64 + lane];
    }
    const float hid = gelu_tanh(acc);
    float o = 0.f;
    for (int e = 0; e < 64; ++e) o += lane_bcast(hid, e) * w2i[e * 64 + lane];
    float* dst = i ? VC : KC;
    dst[(((size_t)b * NCMPP + n) * 2 + hkv) * 64 + lane] = o;
}

__device__ __forceinline__ void attn_chunk(LAS float* wl, const bf16* Z, const float* rel_bias, int b, int hkv, int t, int base, int kcol, int vcol, int lane,
                                           float (&m)[4], float (&l)[4], float (&o)[4]) {
    const int pos = base + lane; const bool valid = (pos >= 0) && (pos <= t);
    const int posc = pos < 0 ? 0 : (pos > SEQ - 1 ? SEQ - 1 : pos);
    const bf16* kr = Z + ((size_t)b * SEQ + posc) * ZP + kcol + hkv * 64;
    float s[4] = {0.f, 0.f, 0.f, 0.f};
#pragma unroll 2
    for (int c = 0; c < 8; ++c) {
        const u32x4 kv = *(const u32x4*)(kr + c * 8);
        float k[8];
        k[0] = __uint_as_float(kv.x << 16); k[1] = __uint_as_float(kv.x & 0xffff0000u); k[2] = __uint_as_float(kv.y << 16); k[3] = __uint_as_float(kv.y & 0xffff0000u);
        k[4] = __uint_as_float(kv.z << 16); k[5] = __uint_as_float(kv.z & 0xffff0000u); k[6] = __uint_as_float(kv.w << 16); k[7] = __uint_as_float(kv.w & 0xffff0000u);
#pragma unroll
        for (int g = 0; g < 4; ++g) {
            const f32x4 q0 = *(const LAS f32x4*)(wl + g * 64 + c * 8), q1 = *(const LAS f32x4*)(wl + g * 64 + c * 8 + 4);
            s[g] += q0.x * k[0] + q0.y * k[1] + q0.z * k[2] + q0.w * k[3] + q1.x * k[4] + q1.y * k[5] + q1.z * k[6] + q1.w * k[7];
        }
    }
    const int bk = t5_bucket(t - pos);
#pragma unroll
    for (int g = 0; g < 4; ++g) {
        const float sv = valid ? s[g] + rel_bias[bk * 8 + hkv * 4 + g] : -1e30f;
        const float mn = fmaxf(m[g], wave_max(sv, lane));
        const float alpha = __expf(m[g] - mn);
        const float p = valid ? __expf(sv - mn) : 0.f;
        l[g] = l[g] * alpha + wave_sum(p, lane);
        o[g] *= alpha; m[g] = mn;
        wl[256 + g * 64 + lane] = p;
    }
#pragma unroll 4
    for (int key = 0; key < 64; ++key) {
        int pk = base + key; pk = pk < 0 ? 0 : (pk > SEQ - 1 ? SEQ - 1 : pk);
        const float v = bf2f(Z[((size_t)b * SEQ + pk) * ZP + vcol + hkv * 64 + lane]);
#pragma unroll
        for (int g = 0; g < 4; ++g) o[g] += wl[256 + g * 64 + key] * v;
    }
}
__device__ __forceinline__ void attn_naive_item(LAS float* wl, int b, int hkv, int t, const bf16* Z, const float* KC, const float* VC, const float* rel_bias, bf16* YC, int lane) {
    const size_t row = (size_t)b * SEQ + t;
#pragma unroll
    for (int g = 0; g < 4; ++g) wl[g * 64 + lane] = bf2f(Z[row * ZP + ZC_Q + hkv * 256 + g * 64 + lane]) * 0.125f;
#pragma unroll 1
    for (int c = 0; c < 4; ++c) {
        const int n = c * 64 + lane; const bool valid = (n < NCMP) && (16 * n + 31 <= t);
        const float* kr = KC + (((size_t)b * NCMPP + (n < NCMP ? n : 0)) * 2 + hkv) * 64;
        float s[4] = {0.f, 0.f, 0.f, 0.f};
#pragma unroll 4
        for (int d4 = 0; d4 < 16; ++d4) {
            const f32x4 k = *(const f32x4*)(kr + d4 * 4);
#pragma unroll
            for (int g = 0; g < 4; ++g) { const f32x4 q = *(const LAS f32x4*)(wl + g * 64 + d4 * 4); s[g] += q.x * k.x + q.y * k.y + q.z * k.z + q.w * k.w; }
        }
        const int bk = t5_bucket(t - (16 * n + 31));
#pragma unroll
        for (int g = 0; g < 4; ++g) wl[256 + g * 256 + n] = valid ? s[g] + rel_bias[bk * 8 + hkv * 4 + g] : -1e30f;
    }
#pragma unroll
    for (int g = 0; g < 4; ++g) {
        float sc[4];
#pragma unroll
        for (int c = 0; c < 4; ++c) sc[c] = wl[256 + g * 256 + c * 64 + lane];
        const float mx = wave_max(fmaxf(fmaxf(sc[0], sc[1]), fmaxf(sc[2], sc[3])), lane);
        float e[4], ls = 0.f;
#pragma unroll
        for (int c = 0; c < 4; ++c) { e[c] = sc[c] > -1e29f ? __expf(sc[c] - mx) : 0.f; ls += e[c]; }
        ls = wave_sum(ls, lane);
        const float inv = ls > 0.f ? 1.0f / ls : 0.f;
#pragma unroll
        for (int c = 0; c < 4; ++c) wl[256 + g * 256 + c * 64 + lane] = e[c] * inv;
    }
    float oc[4] = {0.f, 0.f, 0.f, 0.f};
    const int nmax = t >= 31 ? ((t - 31) / 16 + 1 < NCMP ? (t - 31) / 16 + 1 : NCMP) : 0;
#pragma unroll 4
    for (int n = 0; n < nmax; ++n) {
        const float v = VC[(((size_t)b * NCMPP + n) * 2 + hkv) * 64 + lane];
#pragma unroll
        for (int g = 0; g < 4; ++g) oc[g] += wl[256 + g * 256 + n] * v;
    }
    float imp = 0.f;
#pragma unroll
    for (int g = 0; g < 4; ++g) {
        const LAS float* P = wl + 256 + g * 256;
        imp += P[4 * lane] + P[4 * lane + 1] + P[4 * lane + 2] + 0.5f * P[4 * lane + 3] + (lane > 0 ? 0.5f * P[4 * lane - 1] : 0.f);
    }
    const int blk = t >> 6;
    const bool forced = (lane == 0) || (lane <= blk && lane > blk - 2), future = lane > blk;
    const float v = forced ? 1e9f : (future ? -1e9f : imp);
    int rank = 0;
    for (int jj = 0; jj < 64; ++jj) { const float vj = lane_bcast(v, jj); rank += (vj > v) || (vj == v && jj < lane); }
    unsigned long long mask = __ballot(rank < 16 && !future);
    float m[4], l[4], o[4];
#pragma unroll
    for (int g = 0; g < 4; ++g) { m[g] = -1e30f; l[g] = 0.f; o[g] = 0.f; }
    while (mask) {
        const int j = __builtin_ctzll(mask); mask &= mask - 1;
        attn_chunk(wl, Z, rel_bias, b, hkv, t, 64 * j, ZC_KV + 256, ZC_KV + 384, lane, m, l, o);
    }
    float os[4];
#pragma unroll
    for (int g = 0; g < 4; ++g) { os[g] = l[g] > 0.f ? o[g] / l[g] : 0.f; m[g] = -1e30f; l[g] = 0.f; o[g] = 0.f; }
    for (int c = 0; c < 8; ++c) attn_chunk(wl, Z, rel_bias, b, hkv, t, t - 511 + 64 * c, ZC_KV + 512, ZC_KV + 640, lane, m, l, o);
#pragma unroll
    for (int g = 0; g < 4; ++g) {
        const float ow = l[g] > 0.f ? o[g] / l[g] : 0.f;
        const bf16* gp = Z + row * ZP + ZC_G + hkv * 12 + g * 3;
        const float r = sigmoidf_(bf2f(gp[0])) * oc[g] + sigmoidf_(bf2f(gp[1])) * os[g] + sigmoidf_(bf2f(gp[2])) * ow;
        YC[row * DM + D_SSM + hkv * 256 + g * 64 + lane] = (bf16)f2bf(r);
    }
}

__device__ __forceinline__ void ph_norm_route(const Frame& F, const float* x, const float* g, const float* rgw, const float* rgb, const float* rew, const float* reb, bf16* hn,
                                              unsigned* gcnt, unsigned* list, float* listw) {
    LAS unsigned* cnt_l = (LAS unsigned*)F.lds; LAS unsigned* base_l = cnt_l + 32; LAS unsigned* ent = cnt_l + 64;
    for (int row0 = F.blk * 128; row0 < T; row0 += F.G * 128) {
        if (F.tid < 32) cnt_l[F.tid] = 0u;
        __syncthreads();
        for (int kk = 0; kk < 16; ++kk) {
            const int row = row0 + F.wave * 16 + kk;
            const f32x4* xr = (const f32x4*)(x + (size_t)row * DM);
            f32x4 v[4]; float s = 0.f;
#pragma unroll
            for (int j = 0; j < 4; ++j) { v[j] = xr[F.lane + 64 * j]; s += v[j].x * v[j].x + v[j].y * v[j].y + v[j].z * v[j].z + v[j].w * v[j].w; }
            s = wave_sum(s, F.lane);
            const float r = rsqrtf(s * (1.0f / DM) + EPS);
            float lg[4] = {0.f, 0.f, 0.f, 0.f};
#pragma unroll
            for (int j = 0; j < 4; ++j) {
                const f32x4 gg = ((const f32x4*)g)[F.lane + 64 * j];
                v[j].x = v[j].x * r * gg.x; v[j].y = v[j].y * r * gg.y; v[j].z = v[j].z * r * gg.z; v[j].w = v[j].w * r * gg.w;
                u32x2 o; o.x = pk2(v[j].x, v[j].y); o.y = pk2(v[j].z, v[j].w);
                *(u32x2*)(hn + (size_t)row * DM + (F.lane + 64 * j) * 4) = o;
                const int c0 = (F.lane + 64 * j) * 4;
                const f32x4 w0 = ((const f32x4*)rgw)[c0], w1 = ((const f32x4*)rgw)[c0 + 1], w2 = ((const f32x4*)rgw)[c0 + 2], w3 = ((const f32x4*)rgw)[c0 + 3];
                lg[0] += v[j].x * w0.x + v[j].y * w1.x + v[j].z * w2.x + v[j].w * w3.x;
                lg[1] += v[j].x * w0.y + v[j].y * w1.y + v[j].z * w2.y + v[j].w * w3.y;
                lg[2] += v[j].x * w0.z + v[j].y * w1.z + v[j].z * w2.z + v[j].w * w3.z;
                lg[3] += v[j].x * w0.w + v[j].y * w1.w + v[j].z * w2.w + v[j].w * w3.w;
            }
#pragma unroll
            for (int o = 0; o < 4; ++o) lg[o] = wave_sum(lg[o], F.lane) + rgb[o];
            int gi = 0; float gm = lg[0];
#pragma unroll
            for (int o = 1; o < 4; ++o) if (lg[o] > gm) { gm = lg[o]; gi = o; }
            float gs = 0.f;
#pragma unroll
            for (int o = 0; o < 4; ++o) gs += __expf(lg[o] - gm);
            const float gval = 1.0f / gs;
            const float* we = rew + (size_t)gi * DM * 8;
            float le[8] = {0.f, 0.f, 0.f, 0.f, 0.f, 0.f, 0.f, 0.f};
#pragma unroll
            for (int j = 0; j < 4; ++j) {
                const int c0 = (F.lane + 64 * j) * 4;
                const float hv[4] = {v[j].x, v[j].y, v[j].z, v[j].w};
#pragma unroll
                for (int c = 0; c < 4; ++c) {
                    const f32x4 wa = ((const f32x4*)we)[(c0 + c) * 2], wb = ((const f32x4*)we)[(c0 + c) * 2 + 1];
                    le[0] += hv[c] * wa.x; le[1] += hv[c] * wa.y; le[2] += hv[c] * wa.z; le[3] += hv[c] * wa.w;
                    le[4] += hv[c] * wb.x; le[5] += hv[c] * wb.y; le[6] += hv[c] * wb.z; le[7] += hv[c] * wb.w;
                }
            }
#pragma unroll
            for (int e = 0; e < 8; ++e) le[e] = wave_sum(le[e], F.lane) + reb[gi * 8 + e];
            int e1 = 0; float m1 = le[0];
#pragma unroll
            for (int e = 1; e < 8; ++e) if (le[e] > m1) { m1 = le[e]; e1 = e; }
            int e2 = -1; float m2 = -3.0e38f;
#pragma unroll
            for (int e = 0; e < 8; ++e) if (e != e1 && le[e] > m2) { m2 = le[e]; e2 = e; }
            const float p2 = __expf(m2 - m1), inv = 1.0f / (1.0f + p2);
            if (F.lane == 0) {
                const unsigned ea = (unsigned)(gi * 8 + e1), eb = (unsigned)(gi * 8 + e2);
                const unsigned pa = __hip_atomic_fetch_add(cnt_l + ea, 1u, __ATOMIC_RELAXED, __HIP_MEMORY_SCOPE_WORKGROUP);
                const unsigned pb = __hip_atomic_fetch_add(cnt_l + eb, 1u, __ATOMIC_RELAXED, __HIP_MEMORY_SCOPE_WORKGROUP);
                LAS unsigned* en = ent + (F.wave * 16 + kk) * 6;
                en[0] = ea; en[1] = eb; en[2] = pa; en[3] = pb; en[4] = __float_as_uint(gval * inv); en[5] = __float_as_uint(gval * p2 * inv);
            }
        }
        __syncthreads();
        if (F.tid < 32) base_l[F.tid] = __hip_atomic_fetch_add(gcnt + F.tid * 64, cnt_l[F.tid], __ATOMIC_RELAXED, __HIP_MEMORY_SCOPE_AGENT);
        __syncthreads();
        if (F.tid < 128) {
            const LAS unsigned* en = ent + F.tid * 6; const unsigned tok = (unsigned)(row0 + F.tid);
            const unsigned ia = en[0] * LCAP + base_l[en[0]] + en[2], ib = en[1] * LCAP + base_l[en[1]] + en[3];
            list[ia] = tok * 2u; listw[ia] = __uint_as_float(en[4]);
            list[ib] = tok * 2u + 1u; listw[ib] = __uint_as_float(en[5]);
        }
        __syncthreads();
    }
}
__device__ __forceinline__ void build_expert_tab(const Frame& F, const unsigned* gcnt, LAS int* tab) {
    if (F.tid < 64) {
        const int c = F.lane < 32 ? (int)__hip_atomic_load(gcnt + F.lane * 64, __ATOMIC_RELAXED, __HIP_MEMORY_SCOPE_AGENT) : 0;
        int tiles = (c + 255) >> 8, incl = tiles;
#pragma unroll
        for (int o = 1; o < 32; o <<= 1) { const int t = __builtin_amdgcn_ds_bpermute((F.lane - o) << 2, incl); if (F.lane >= o) incl += t; }
        if (F.lane < 32) { tab[F.lane + 1] = incl; tab[33 + F.lane] = c; }
        if (F.lane == 0) tab[0] = 0;
    }
    __syncthreads();
}
__device__ __forceinline__ void ph_experts_naive(const Frame& F, const bf16* hn, const unsigned* route, const float* wg, const float* wu, const float* wd, float* x) {
    LAS float* hs = (LAS float*)F.lds;
    LAS float* hd = hs + 1024;
    for (int tok = F.blk; tok < T; tok += F.G) {
        { const unsigned pv = *(const unsigned*)(hn + (size_t)tok * DM + F.tid * 2); hs[F.tid * 2] = __uint_as_float(pv << 16); hs[F.tid * 2 + 1] = __uint_as_float(pv & 0xffff0000u); }
        const u32x4 rt = *(const u32x4*)(route + (size_t)tok * 4);
        __syncthreads();
        {
            const int s = F.tid >> 8, f = F.tid & 255;
            const unsigned e = s ? rt.y : rt.x; const float w = __uint_as_float(s ? rt.w : rt.z);
            const float* pg = wg + (size_t)e * DM * 256 + f; const float* pu = wu + (size_t)e * DM * 256 + f;
            float ga = 0.f, ua = 0.f;
            for (int d = 0; d < DM; ++d) { const float hv = hs[d]; ga += hv * pg[(size_t)d * 256]; ua += hv * pu[(size_t)d * 256]; }
            hd[s * 256 + f] = ga * sigmoidf_(ga) * ua * w;
        }
        __syncthreads();
        for (int dd = F.tid; dd < DM; dd += NTHR) {
            float acc = 0.f;
            const float* p0 = wd + (size_t)rt.x * 256 * DM + dd; const float* p1 = wd + (size_t)rt.y * 256 * DM + dd;
            for (int f = 0; f < 256; ++f) acc += hd[f] * p0[(size_t)f * DM];
            for (int f = 0; f < 256; ++f) acc += hd[256 + f] * p1[(size_t)f * DM];
            x[(size_t)tok * DM + dd] += acc;
        }
        __syncthreads();
    }
}


__device__ __forceinline__ void transpose_item(const float* W, int K, int N, bf16* WT, int k0, int n0, int drow0, LAS float* scr, int lane) {
#pragma unroll 8
    for (int i = 0; i < 32; ++i) { const int kk = 2 * i + (lane >> 5); scr[kk * 33 + (lane & 31)] = W[(size_t)(k0 + kk) * N + n0 + (lane & 31)]; }
    asm volatile("s_waitcnt lgkmcnt(0)" ::: "memory");
    const int c = lane & 7;
#pragma unroll
    for (int j = 0; j < 4; ++j) { const int n = (lane >> 3) + 8 * j; const LAS float* sp = scr + (8 * c) * 33 + n;
        u32x4 o; o.x = pk2(sp[0 * 33], sp[1 * 33]); o.y = pk2(sp[2 * 33], sp[3 * 33]); o.z = pk2(sp[4 * 33], sp[5 * 33]); o.w = pk2(sp[6 * 33], sp[7 * 33]);
        *(u32x4*)(WT + (size_t)(drow0 + n) * K + k0 + 8 * c) = o; }
    asm volatile("s_waitcnt lgkmcnt(0)" ::: "memory");
}
__device__ __forceinline__ void ph_convert(const Frame& F, const __attribute__((address_space(4))) Args* args, unsigned char* ws) {
    LAS float* scr = (LAS float*)(F.lds + F.wave * 16384);
    const int gw = F.blk * NWAVES + F.wave, NGW = F.G * NWAVES;
    constexpr int I_IN = (DM / 64) * (1792 / 32), I_GLU = (D_SSM / 64) * (2 * D_SSM / 32), I_OUT = (DM / 64) * (DM / 32);
    constexpr int PER_LAYER = I_IN + I_GLU + I_OUT;
    for (int it = gw; it < DEPTH * 32 * 384; it += NGW) {
        const int le = it / 384, r = it % 384;
        if (r < 256) { const int isup = r >> 7, q = r & 127, nb = q & 7, kb = q >> 3, n0 = 32 * nb;
            transpose_item(args->in[isup ? 24 : 23] + (size_t)le * DM * 256, DM, 256, (bf16*)(ws + WS_WGU) + (size_t)le * 512 * DM, 64 * kb, n0, 256 * (n0 >> 7) + 128 * isup + (n0 & 127), scr, F.lane); }
        else { const int q = r - 256, nb = q & 31, kb = q >> 5;
            transpose_item(args->in[25] + (size_t)le * 256 * DM, 256, DM, (bf16*)(ws + WS_WDN) + (size_t)le * DM * 256, 64 * kb, 32 * nb, 32 * nb, scr, F.lane); }
    }
    for (int it = gw; it < DEPTH * PER_LAYER; it += NGW) {
        const int layer = it / PER_LAYER; int r = it % PER_LAYER;
        if (r < I_IN) { const int nb = r % 56, kb = r / 56;
            transpose_item(args->in[4] + (size_t)layer * DM * D_IN, DM, D_IN, (bf16*)(ws + WS_WIN) + (size_t)layer * ZP * DM, 64 * kb, 32 * nb, 32 * nb, scr, F.lane); continue; }
        r -= I_IN;
        if (r < I_GLU) { const int nb = r % 32, kb = r / 32, n0 = 32 * nb;
            const int half = n0 >> 9, c = n0 & 511, drow = 256 * (c >> 7) + 128 * half + (c & 127);
            transpose_item(args->in[14] + (size_t)layer * D_SSM * 2 * D_SSM, D_SSM, 2 * D_SSM, (bf16*)(ws + WS_WGLU) + (size_t)layer * 2 * D_SSM * D_SSM, 64 * kb, n0, drow, scr, F.lane); continue; }
        r -= I_GLU;
        { const int nb = r % 32, kb = r / 32;
            transpose_item(args->in[5] + (size_t)layer * DM * DM, DM, DM, (bf16*)(ws + WS_WOUT) + (size_t)layer * DM * DM, 64 * kb, 32 * nb, 32 * nb, scr, F.lane); }
    }
    const int gt = F.blk * NTHR + F.tid, NGT = F.G * NTHR;
    for (int idx = gt; idx < DEPTH * 256 * DM; idx += NGT) {
        const int layer = idx / (256 * DM), rem = idx % (256 * DM), n = 1792 + rem / DM, k = rem % DM;
        const float v = n < D_IN ? args->in[4][(size_t)layer * DM * D_IN + (size_t)k * D_IN + n] : 0.f;
        ((bf16*)(ws + WS_WIN))[(size_t)layer * ZP * DM + (size_t)n * DM + k] = (bf16)f2bf(v);
    }
}

constexpr int PH_PER_LAYER = 8, N_PHASES = 1 + DEPTH * PH_PER_LAYER + 1;
#ifndef FAST_GEMM
#define FAST_GEMM 1
#endif

__global__ void __launch_bounds__(NTHR, 2) fwd(Args args) {
    extern __shared__ __attribute__((aligned(16))) unsigned char lds_raw[];
    Frame F;
    F.lds = (LAS unsigned char*)lds_raw;
    F.tid = threadIdx.x; F.lane = F.tid & 63; F.wave = __builtin_amdgcn_readfirstlane(F.tid >> 6);
    F.blk = blockIdx.x; F.G = gridDim.x;
    typedef const __attribute__((address_space(4))) Args* KArgs;
    KArgs kp = (KArgs)__builtin_amdgcn_kernarg_segment_ptr();
    asm volatile("" : "+s"(kp));
    unsigned char* ws = kp->ws;
    volatile LAS unsigned* MISC = (volatile LAS unsigned*)(F.lds + MISC_OFF);
    if (F.tid < 32) MISC[F.tid] = 0u;
    __syncthreads();
    XcdBarrier bar; bar.bar = (unsigned*)(ws + WS_CTL) + CW_BAR; bar.x = 0; bar.st = nullptr;
    if (N_LAUNCH_MODE == 1) bar = xcd_barrier_post((unsigned*)(ws + WS_CTL) + CW_BAR, MISC + 8);
#define IN(k) (kp->ph_lo <= (k) && (k) < kp->ph_hi)
#define FRESH_IDS() do { int l_; asm volatile("v_mbcnt_lo_u32_b32 %0, -1, 0\n\tv_mbcnt_hi_u32_b32 %0, -1, %0" : "=v"(l_)); asm volatile("" : "+s"(F.wave), "+s"(F.blk), "+s"(F.G)); F.lane = l_; F.tid = F.wave * 64 + l_; asm volatile("" : "+s"(kp)); ws = kp->ws; bar.bar = (unsigned*)(ws + WS_CTL) + CW_BAR; } while (0)
#define SEAM(k) do { FRESH_IDS(); if (IN(k) && IN((k) + 1)) xcd_barrier(bar, F.tid); FRESH_IDS(); } while (0)

    const float* x0 = kp->in[0];
    float* XR = kp->out;
#define HN ((bf16*)(ws + WS_HN))
#define Z ((bf16*)(ws + WS_Z))
#define YC ((bf16*)(ws + WS_YC))
#define G1 ((bf16*)(ws + WS_G1))
#define KC ((float*)(ws + WS_KC))
#define VC ((float*)(ws + WS_VC))
#define LIST ((unsigned*)(ws + WS_LIST))
#define LISTW ((float*)(ws + WS_LISTW))
#define HID ((bf16*)(ws + WS_HID))
#define P2 ((float*)(ws + WS_P2))
    LAS int* etab = (LAS int*)(F.lds + 131072);

    if (IN(0)) ph_convert(F, kp, ws);
    SEAM(0);
    for (int layer = 0; layer < DEPTH; ++layer) {
        const int pb = 1 + layer * PH_PER_LAYER;
        const float* xin = layer == 0 ? x0 : XR;
        unsigned* gcnt = (unsigned*)(ws + WS_CTL) + CW_CNT + layer * 32 * 64;
        if (IN(pb + 0)) ph_norm(F, xin, layer == 0 ? nullptr : P2, XR, kp->in[1] + layer * DM, HN);
        SEAM(pb + 0);
        if (IN(pb + 1)) {
            pg8::Gemm g{HN, (const bf16*)(ws + WS_WIN) + (size_t)layer * ZP * DM, T, ZP, DM, DM, 0, nullptr, 0}; pg8::StaticOrder S; S.init(T, ZP, F.G, F.blk);
            pg8::EpiBf16<0> E{Z, ZP, nullptr, 0, 0, 1.f};
            pg8::gemm2<pg8::EpiBf16<0>, pg8::StaticOrder, false>(F.lds, g, S, E, F.tid);
        }
        SEAM(pb + 1);
        if (IN(pb + 2)) {
            if (F.wave == 0) {
                for (int it = F.blk; it < BATCH * NGRP; it += F.G)
                    ssm_naive_item(it / NGRP, it % NGRP, kp->in[6] + layer * NGRP * SST, kp->in[7] + layer * NGRP * SST, kp->in[8] + (size_t)layer * NGRP * SST * SGRP, kp->in[9] + (size_t)layer * NGRP * SST * SGRP,
                                   kp->in[10] + (size_t)layer * NGRP * SGRP * SST, kp->in[11] + (size_t)layer * NGRP * SGRP * SST, kp->in[12] + layer * NGRP * SGRP, kp->in[13] + layer * NGRP, Z, G1, F.lane);
            } else {
                for (int it = F.blk * 7 + (F.wave - 1); it < BATCH * NCMP * 4; it += F.G * 7)
                    compress_naive_item(it, Z, kp->in[15] + (size_t)layer * 2 * 32 * 64, kp->in[16] + (size_t)layer * 2 * 32 * 64 * 64, kp->in[17] + (size_t)layer * 2 * 64 * 64, KC, VC, F.lane);
            }
        }
        SEAM(pb + 2);
        if (IN(pb + 3)) {
            { pg8::Gemm g{G1, (const bf16*)(ws + WS_WGLU) + (size_t)layer * 2 * D_SSM * D_SSM, T, 2 * D_SSM, D_SSM, D_SSM, 0, nullptr, 0}; pg8::StaticOrder S; S.init(T, 2 * D_SSM, F.G, F.blk);
              pg8::EpiGlu E{YC, DM};
              pg8::gemm2<pg8::EpiGlu, pg8::StaticOrder, false>(F.lds, g, S, E, F.tid); }
            __syncthreads();
            LAS float* wl = (LAS float*)F.lds + F.wave * 1280;
            const int gw = F.blk * NWAVES + F.wave, NGW = F.G * NWAVES;
            for (int it = gw; it < T * 2; it += NGW) { const int hkv = it & 1, tt = it >> 1; attn_naive_item(wl, tt / SEQ, hkv, tt % SEQ, Z, KC, VC, kp->in[18], YC, F.lane); }
        }
        SEAM(pb + 3);
        if (IN(pb + 4)) {
            pg8::Gemm g{YC, (const bf16*)(ws + WS_WOUT) + (size_t)layer * DM * DM, T, DM, DM, DM, 0, nullptr, 0}; pg8::StaticOrder S; S.init(T, DM, F.G, F.blk);
            pg8::EpiResid E{xin, XR, DM};
            pg8::gemm2<pg8::EpiResid, pg8::StaticOrder, false>(F.lds, g, S, E, F.tid);
        }
        SEAM(pb + 4);
        if (IN(pb + 5)) ph_norm_route(F, XR, kp->in[2] + layer * DM, kp->in[19] + (size_t)layer * DM * 4, kp->in[20] + layer * 4, kp->in[21] + (size_t)layer * 4 * DM * 8, kp->in[22] + layer * 32, HN, gcnt, LIST, LISTW);
        SEAM(pb + 5);
        if (IN(pb + 6)) {
            build_expert_tab(F, gcnt, etab);
            pg8::Gemm g{HN, (const bf16*)(ws + WS_WGU) + (size_t)layer * 32 * 512 * DM, 0, 512, DM, DM, (size_t)512 * DM, LIST, LCAP};
            pg8::ExpertOrder S{etab, 2, F.G, F.blk};
            pg8::EpiGateUp E{HID, LISTW, LCAP};
            pg8::gemm2<pg8::EpiGateUp, pg8::ExpertOrder, true>(F.lds, g, S, E, F.tid);
        }
        SEAM(pb + 6);
        if (IN(pb + 7)) {
            build_expert_tab(F, gcnt, etab);
            pg8::Gemm g{HID, (const bf16*)(ws + WS_WDN) + (size_t)layer * 32 * DM * 256, 0, DM, 256, 256, (size_t)DM * 256, nullptr, 0};
            pg8::ExpertOrder S{etab, 4, F.G, F.blk};
            pg8::EpiDown E{XR, P2, LIST, LCAP};
            pg8::gemm2<pg8::EpiDown, pg8::ExpertOrder, false>(F.lds, g, S, E, F.tid);
        }
        SEAM(pb + 7);
    }
    if (IN(N_PHASES - 1)) ph_final_norm(F, XR, P2, kp->in[3]);
#undef IN
#undef SEAM
#undef HN
#undef Z
#undef YC
#undef G1
#undef KC
#undef VC
#undef LIST
#undef LISTW
#undef HID
#undef P2
}

extern "C" void kernel_launch(void* const* d_in, const int* in_sizes, int n_in, void* d_out, int out_size, void* d_ws, size_t ws_size, hipStream_t stream) {
    static int grid = 0;
    if (grid == 0) {
        if (n_in != 26 || out_size != T * DM || ws_size < WS_END) { fprintf(stderr, "kernel_launch: unexpected shapes (n_in %d out %d ws %zu)\n", n_in, out_size, ws_size); grid = -1; return; }
        int dev = 0, cus = 0, per_cu = 0;
        if (hipGetDevice(&dev) != hipSuccess || hipDeviceGetAttribute(&cus, hipDeviceAttributeMultiprocessorCount, dev) != hipSuccess) { grid = -1; return; }
        if (hipFuncSetAttribute((const void*)fwd, hipFuncAttributeMaxDynamicSharedMemorySize, LDS_BYTES) != hipSuccess) { fprintf(stderr, "kernel_launch: hipFuncSetAttribute failed\n"); grid = -1; return; }
        if (hipOccupancyMaxActiveBlocksPerMultiprocessor(&per_cu, (const void*)fwd, NTHR, LDS_BYTES) != hipSuccess || per_cu < 1) fprintf(stderr, "kernel_launch: occupancy query says %d\n", per_cu);
        (void)hipGetLastError();
        grid = cus;
    }
    if (grid < 0) return;
    (void)hipMemsetAsync((char*)d_ws + WS_CTL, 0, CTL_ZERO_BYTES, stream);
    Args a{};
    for (int i = 0; i < 26; ++i) a.in[i] = (const float*)d_in[i];
    a.out = (float*)d_out; a.ws = (unsigned char*)d_ws;
    if (N_LAUNCH_MODE == 1) {
        a.ph_lo = 0; a.ph_hi = N_PHASES;
        hipLaunchKernelGGL(fwd, dim3(grid), dim3(NTHR), LDS_BYTES, stream, a);
    } else {
        for (int p = 0; p < N_PHASES; ++p) { a.ph_lo = p; a.ph_hi = p + 1; hipLaunchKernelGGL(fwd, dim3(grid), dim3(NTHR), LDS_BYTES, stream, a); }
    }
}
```

```cpp
#include <hip/hip_runtime.h>
#include <cstdio>
#include <cstdint>

#ifndef N_LAUNCH_MODE
#define N_LAUNCH_MODE 1
#endif

#define GAS __attribute__((address_space(1)))
#define LAS __attribute__((address_space(3)))
typedef unsigned short bf16;
typedef float f32x4 __attribute__((ext_vector_type(4)));
typedef unsigned u32x4 __attribute__((ext_vector_type(4)));
typedef unsigned u32x2 __attribute__((ext_vector_type(2)));

constexpr int BATCH = 8, SEQ = 4096, DM = 1024, T = BATCH * SEQ, DEPTH = 2;
constexpr int D_SSM = 512, NGRP = 32, SGRP = 16, SST = 64;
constexpr int D_IN = 1816, ZP = 2048;
constexpr int ZC_U = 0, ZC_Q = 512, ZC_KV = 1024, ZC_G = 1792;
constexpr int NCMP = 255, NCMPP = 256;
constexpr float EPS = 1e-6f;
constexpr int NWAVES = 8, NTHR = 512;
constexpr float QSCALE = 0.125f * 1.4426950408889634f;

constexpr size_t MiB = 1u << 20;
constexpr size_t WS_CTL = 0, CTL_ZERO_BYTES = 1 * MiB;
constexpr size_t WS_KC = 1 * MiB, WS_VC = 2 * MiB, WS_ROUTE = 3 * MiB;
constexpr size_t WS_HN = 16 * MiB;
constexpr size_t WS_Z = 80 * MiB;
constexpr size_t WS_YC = 208 * MiB;
constexpr size_t WS_G1 = 272 * MiB;
constexpr size_t WS_WIN = 304 * MiB;
constexpr size_t WS_WGLU = 312 * MiB;
constexpr size_t WS_WOUT = 314 * MiB;
constexpr size_t WS_WGU = 318 * MiB;
constexpr size_t WS_WDN = 382 * MiB;
constexpr size_t WS_LIST = 414 * MiB;
constexpr size_t WS_LISTW = 418 * MiB;
constexpr size_t WS_HID = 422 * MiB;
constexpr size_t WS_P2 = WS_Z;
constexpr size_t WS_END = 458 * MiB;
constexpr int LCAP = 32768, CW_CNT = 8192;
constexpr int CW_BAR = 4096;

constexpr int LDS_BYTES = 147456;
constexpr int MISC_OFF = 131072 + 320;

__device__ __forceinline__ float bf2f(bf16 v) { return __uint_as_float(((unsigned)v) << 16); }
__device__ __forceinline__ unsigned f2bf(float f) { unsigned u = __float_as_uint(f); return (u + 0x7fffu + ((u >> 16) & 1u)) >> 16; }
__device__ __forceinline__ unsigned pk2(float lo, float hi) { return f2bf(lo) | (f2bf(hi) << 16); }
__device__ __forceinline__ float wave_sum(float v, int lane) {
#pragma unroll
    for (int o = 1; o < 64; o <<= 1) v += __int_as_float(__builtin_amdgcn_ds_bpermute((lane ^ o) << 2, __float_as_int(v)));
    return v;
}
__device__ __forceinline__ float wave_max(float v, int lane) {
#pragma unroll
    for (int o = 1; o < 64; o <<= 1) v = fmaxf(v, __int_as_float(__builtin_amdgcn_ds_bpermute((lane ^ o) << 2, __float_as_int(v))));
    return v;
}
__device__ __forceinline__ float lane_bcast(float v, int src) { return __int_as_float(__builtin_amdgcn_ds_bpermute(src << 2, __float_as_int(v))); }
__device__ __forceinline__ float gelu_tanh(float x) {
    const float u = 0.7978845608028654f * (x + 0.044715f * x * x * x);
    return 0.5f * x * (1.0f + tanhf(u));
}
__device__ __forceinline__ float sigmoidf_(float x) { return 1.0f / (1.0f + __expf(-x)); }
__device__ __forceinline__ int t5_bucket(int n) {
    if (n < 16) return n < 0 ? 0 : n;
    int b = 16;
    b += (n >= 19); b += (n >= 21); b += (n >= 24); b += (n >= 27); b += (n >= 31); b += (n >= 35); b += (n >= 40); b += (n >= 46);
    b += (n >= 52); b += (n >= 59); b += (n >= 67); b += (n >= 77); b += (n >= 87); b += (n >= 99); b += (n >= 113);
    return b;
}

#define XB_TMO      128
#define XB_XCNT(j)  (256  + 64 * (j))
#define XB_XSUB(j)  (1280 + 64 * (j))
#define XB_XGEN(j)  (2304 + 64 * (j))
#define XB_TOP      3328
#define XB_TOPGEN   3392
#define XCD_BAR_WORDS 3456
#define XB_SPIN_CAP (1u << 22)

__device__ __forceinline__ unsigned xb_ld(unsigned* p)              { return __hip_atomic_load(p, __ATOMIC_RELAXED, __HIP_MEMORY_SCOPE_AGENT); }
__device__ __forceinline__ unsigned xb_add(unsigned* p, unsigned v) { return __hip_atomic_fetch_add(p, v, __ATOMIC_RELAXED, __HIP_MEMORY_SCOPE_AGENT); }
__device__ __forceinline__ unsigned xb_xcc_id() { return (unsigned)__builtin_amdgcn_s_getreg((3 << 11) | 20) & 0xFu; }
#define XB_SPIN(cond, bar) do { unsigned _sp = 0; while (cond) { __builtin_amdgcn_s_sleep(1); \
    if ((++_sp & 255u) == 0u) { if (xb_ld(&(bar)[XB_TMO])) break; if (_sp > XB_SPIN_CAP) { atomicAdd(&(bar)[XB_TMO], 1u); break; } } } } while (0)

struct XcdBarrier { unsigned* bar; unsigned x; volatile LAS unsigned* st; };

__device__ __forceinline__ XcdBarrier xcd_barrier_post(unsigned* bar, volatile LAS unsigned* st) {
    XcdBarrier b; b.bar = bar; b.x = xb_xcc_id(); b.st = st;
    if (threadIdx.x == 0) (void)xb_add(&bar[XB_XCNT(b.x)], 1u);
    return b;
}
__device__ __forceinline__ void xcd_barrier_complete(unsigned* bar, unsigned x, unsigned& nloc, unsigned& nx) {
    const unsigned G = gridDim.x * gridDim.y * gridDim.z;
    unsigned sum, cnt, mine, sp = 0u;
    for (;;) {
        sum = 0u; cnt = 0u; mine = 0u;
#pragma unroll
        for (unsigned j = 0; j < 16; ++j) { const unsigned c = xb_ld(&bar[XB_XCNT(j)]); sum += c; cnt += (c > 0u) ? 1u : 0u; mine = (j == x) ? c : mine; }
        if (sum == G) break;
        __builtin_amdgcn_s_sleep(1);
        if ((++sp & 255u) == 0u) { if (xb_ld(&bar[XB_TMO])) break; if (sp > XB_SPIN_CAP) { atomicAdd(&bar[XB_TMO], 1u); break; } }
    }
    nloc = mine > 0u ? mine : 1u; nx = cnt > 0u ? cnt : 1u;
}
__device__ __forceinline__ void xcd_barrier(const XcdBarrier& b, const int tid) {
    asm volatile("s_waitcnt vmcnt(0)" ::: "memory");
    __syncthreads();
    if (tid == 0) {
        unsigned* bar = b.bar;
        __builtin_amdgcn_s_waitcnt(0);
        unsigned nloc = b.st[0], nx = b.st[1];
        if (nloc == 0u) { xcd_barrier_complete(bar, b.x, nloc, nx); b.st[0] = nloc; b.st[1] = nx; }
        const unsigned old = xb_add(&bar[XB_XSUB(b.x)], 1u);
        const unsigned gen = old / nloc;
        if (old + 1u == (gen + 1u) * nloc) {
            __builtin_amdgcn_fence(__ATOMIC_RELEASE, "agent");
            asm volatile("s_waitcnt vmcnt(0)" ::: "memory");
            const unsigned og = xb_add(&bar[XB_TOP], 1u);
            const unsigned tg = og / nx;
            if (og + 1u == (tg + 1u) * nx) xb_add(&bar[XB_TOPGEN], 1u);
            else XB_SPIN(xb_ld(&bar[XB_TOPGEN]) == tg, bar);
            __builtin_amdgcn_fence(__ATOMIC_ACQUIRE, "agent");
            xb_add(&bar[XB_XGEN(b.x)], 1u);
            asm volatile("s_waitcnt vmcnt(0)" ::: "memory");
        } else {
            XB_SPIN(xb_ld(&bar[XB_XGEN(b.x)]) == gen, bar);
            __builtin_amdgcn_fence(__ATOMIC_ACQUIRE, "agent");
            asm volatile("s_waitcnt vmcnt(0)" ::: "memory");
        }
    }
    __syncthreads();
}

namespace pg8 {
#define PG8_LAS __attribute__((address_space(3)))
typedef unsigned short bf16_t;
typedef short bf16x8 __attribute__((ext_vector_type(8)));
typedef float f32x4 __attribute__((ext_vector_type(4)));
typedef unsigned u32x4 __attribute__((ext_vector_type(4)));
constexpr int BM = 256, BK = 64, HALF = 128, HTB = HALF * BK * 2  , STAGE_BYTES = 8 * HTB, NXCD = 8, WGM = 8;

__host__ __device__ __forceinline__ int lds_byte(int r, int c) { const int st = (r >> 4) * 2 + (c >> 5), rr = r & 15, cc = c & 31, ob = rr * 64 + cc * 2; return st * 1024 + (ob ^ (((ob >> 9) & 1) << 5)); }
__host__ __device__ __forceinline__ void stage_rc(int b, int& R, int& C) { const int st = b / 1024, sb = b % 1024, swz = sb ^ (((sb >> 9) & 1) << 5); R = (st >> 1) * 16 + swz / 64; C = (st & 1) * 32 + (swz % 64) / 2; }
__host__ __device__ __forceinline__ int perm32(int rho) { const int n = rho >> 4, i = rho & 15; return 8 * (i >> 2) + 4 * n + (i & 3); }

struct Unit { int pm, pn, eb, p0, cnt; };
struct Gemm { const bf16_t* A; const bf16_t* Bt; int M, N, K; int lda; size_t bstride; const unsigned* list; int cap; };

struct StaticOrder {
    int nM, nN, nwg, G, c;
    __host__ __device__ void init(int M, int N, int G_, int c_) { nM = M / BM; nN = N / BM; nwg = nM * nN; G = G_; c = c_; }
    __host__ __device__ bool next(int i, Unit& u) const {
        const long L = (long)i * G + c; if (L >= nwg) return false;
        int wgid = (int)L; { const int q = nwg / NXCD, r = nwg % NXCD, xcd = wgid % NXCD, off = wgid / NXCD; wgid = (xcd < r ? xcd * (q + 1) : r * (q + 1) + (xcd - r) * q) + off; }
        const int nig = WGM * nN, gid = wgid / nig, fm = gid * WGM, gsz = (nM - fm) < WGM ? (nM - fm) : WGM;
        u.pm = fm + ((wgid % nig) % gsz); u.pn = (wgid % nig) / gsz; u.eb = 0; u.p0 = 0; u.cnt = 0; return true;
    }
    __device__ __forceinline__ void a_ready(const Unit&) const {}
    __device__ __forceinline__ void done(const Unit&) const {}
};

__device__ __forceinline__ unsigned cvt_pk_bf16(float lo, float hi) { unsigned r; asm volatile("v_cvt_pk_bf16_f32 %0, %1, %2" : "=v"(r) : "v"(lo), "v"(hi)); return r; }
typedef float f32x2 __attribute__((ext_vector_type(2)));
__device__ __forceinline__ f32x2 gelu_pk(f32x2 v) {
    const f32x2 av = __builtin_elementwise_abs(v), d = av * 0.2316418882f + 1.0f;
    f32x2 t; t.x = __builtin_amdgcn_rcpf(d.x); t.y = __builtin_amdgcn_rcpf(d.y);
    f32x2 q = t * 0.5307027145f + (-0.7265760135f); q = q * t + 0.7107068705f; q = q * t + (-0.142248368f); q = q * t + 0.127414796f; q = q * t;
    const f32x2 s = (v * v) * (-0.72134752044f);
    f32x2 e; e.x = __builtin_amdgcn_exp2f(s.x); e.y = __builtin_amdgcn_exp2f(s.y);
    const f32x2 m = v * (q * e), r = v - m;
    f32x2 o; o.x = v.x < 0.f ? m.x : r.x; o.y = v.y < 0.f ? m.y : r.y; return o;
}

template <int ACT  > struct EpiBf16 {
    static constexpr bool PERM = true, AFTER_DRAIN = false; static_assert(ACT == 0 || ACT == 1, "EpiBf16: ACT is 0 (none) or 1 (gelu_pk)");
    bf16_t* O; int ldc; const float* bias; int split_cols; size_t split_stride; float scale0;
    __device__ __forceinline__ void operator()(const f32x4 (&acc)[2][2][4][2], const Unit& u, int wr, int wc, int fr, int fq) const {
        const int row0 = u.pm * BM + wr * 64 + fr; int colt = u.pn * BM; bf16_t* base = O;
        float sc = 1.f; if (split_cols) { const int t = colt / split_cols; base += (size_t)t * split_stride; colt -= t * split_cols; if (t == 0) sc = scale0; }
        const int col0 = colt + wc * 32 + 8 * fq, bcol0 = u.pn * BM + wc * 32 + 8 * fq;
        f32x4 bv[2][2];
#pragma unroll
        for (int bj = 0; bj < 2; ++bj)
#pragma unroll
            for (int n = 0; n < 2; ++n) bv[bj][n] = bias ? *(const f32x4*)(bias + bcol0 + bj * HALF + 4 * n) : (f32x4){0.f, 0.f, 0.f, 0.f};
#pragma unroll
        for (int ai = 0; ai < 2; ++ai)
#pragma unroll
            for (int m = 0; m < 4; ++m) { bf16_t* rowp = base + (size_t)(row0 + ai * HALF + m * 16) * ldc + col0;
#pragma unroll
                for (int bj = 0; bj < 2; ++bj) { f32x4 v0 = acc[ai][bj][m][0] + bv[bj][0], v1 = acc[ai][bj][m][1] + bv[bj][1];
                    if (ACT == 1) { f32x2 a = gelu_pk((f32x2){v0[0], v0[1]}), b = gelu_pk((f32x2){v0[2], v0[3]}), c = gelu_pk((f32x2){v1[0], v1[1]}), d = gelu_pk((f32x2){v1[2], v1[3]});
                        v0 = (f32x4){a.x, a.y, b.x, b.y}; v1 = (f32x4){c.x, c.y, d.x, d.y}; }
                    v0 = v0 * sc; v1 = v1 * sc; u32x4 w; w.x = cvt_pk_bf16(v0[0], v0[1]); w.y = cvt_pk_bf16(v0[2], v0[3]); w.z = cvt_pk_bf16(v1[0], v1[1]); w.w = cvt_pk_bf16(v1[2], v1[3]);
                    *(u32x4*)(rowp + bj * HALF) = w; } }
    }
};
template <class Epi, class Sched, bool ALIGN_EPI = false, bool SP2 = false>
__device__ __forceinline__ void gemm_phase(PG8_LAS unsigned char* lds, const Gemm g, const Sched& S, const Epi& E) {
    int tid_ = threadIdx.x; asm volatile("" : "+v"(tid_));
    const int tid = tid_, wid = __builtin_amdgcn_readfirstlane(tid >> 6), lane = tid & 63, wr = wid >> 2, wc = wid & 3, fr = lane & 15, fq = lane >> 4;
    const int K = g.K, nt = K / BK;
    unsigned voffA[2], voffB[2];
#pragma unroll
    for (int i = 0; i < 2; ++i) { int R, C; stage_rc(tid * 16 + i * 8192, R, C); const int Rb = Epi::PERM ? ((R & ~31) + perm32(R & 31)) : R;
        voffA[i] = (unsigned)(R * K + C) * 2u; voffB[i] = (unsigned)(Rb * K + C) * 2u; }
    const size_t kstep = (size_t)(BK * 2);
    const size_t hstep = (size_t)HALF * K * 2;
    const size_t tstep = 2 * hstep;
    const unsigned ldsw = (unsigned)wid * 1024u;
    const int aoff = lds_byte(wr * 64 + fr, fq * 8), boff = lds_byte(wc * 32 + fr, fq * 8);
#define PG8_SA(b, h) (((b) * 2 + (h)) * HTB)
#define PG8_SB(b, h) ((4 + (b) * 2 + (h)) * HTB)
#define PG8_STAGE(bufoff, gbase, voff) do { _Pragma("unroll") for (int _i = 0; _i < 2; ++_i) \
        __builtin_amdgcn_global_load_lds((const unsigned*)((const char*)(gbase) + (voff)[_i]), (PG8_LAS unsigned*)(lds + (bufoff) + ldsw + _i * 8192), 16, 0, 0); } while (0)
#define PG8_LDA(dst, b, h) do { _Pragma("unroll") for (int m = 0; m < 4; ++m) _Pragma("unroll") for (int k = 0; k < 2; ++k) dst[m][k] = *(const PG8_LAS bf16x8*)(lds + PG8_SA(b, h) + aoff + m * 2048 + k * 1024); } while (0)
#define PG8_LDB(dst, b, h) do { _Pragma("unroll") for (int n = 0; n < 2; ++n) _Pragma("unroll") for (int k = 0; k < 2; ++k) dst[n][k] = *(const PG8_LAS bf16x8*)(lds + PG8_SB(b, h) + boff + n * 2048 + k * 1024); } while (0)
#define PG8_MMA(ai, bj, At, Bt) do { __builtin_amdgcn_s_setprio(1); _Pragma("unroll") for (int m = 0; m < 4; ++m) _Pragma("unroll") for (int n = 0; n < 2; ++n) _Pragma("unroll") for (int k = 0; k < 2; ++k) \
        acc[ai][bj][m][n] = __builtin_amdgcn_mfma_f32_16x16x32_bf16(Bt[n][k], At[m][k], acc[ai][bj][m][n], 0, 0, 0); __builtin_amdgcn_s_setprio(0); } while (0)
#define PG8_WAIT_V(n) asm volatile("s_waitcnt vmcnt(" #n ")" ::: "memory")
#define PG8_WAIT_L(n) asm volatile("s_waitcnt lgkmcnt(" #n ")" ::: "memory")
#define PG8_BAR __builtin_amdgcn_s_barrier()
#define PG8_SCHED __builtin_amdgcn_sched_barrier(0)
    Unit cur, nxt; int ui = 0;
    if (!S.next(0, cur)) return;
    f32x4 acc[2][2][4][2];
#pragma unroll
    for (int a = 0; a < 2; ++a)
#pragma unroll
        for (int b = 0; b < 2; ++b)
#pragma unroll
            for (int m = 0; m < 4; ++m)
#pragma unroll
                for (int n = 0; n < 2; ++n) acc[a][b][m][n] = (f32x4){0.f, 0.f, 0.f, 0.f};
    bf16x8 At[4][2], B0[2][2], B1[2][2];
    const char* cA = (const char*)g.A + (size_t)cur.pm * tstep; const char* cB = (const char*)g.Bt + (size_t)cur.pn * tstep;
    S.a_ready(cur);
    if constexpr (SP2) {
        PG8_STAGE(PG8_SB(0, 0), cB, voffB); PG8_STAGE(PG8_SB(0, 1), cB + hstep, voffB); PG8_STAGE(PG8_SA(0, 0), cA, voffA); PG8_STAGE(PG8_SA(0, 1), cA + hstep, voffA);
        if (wr == 1) PG8_BAR;
        PG8_WAIT_V(2); PG8_BAR;
        PG8_STAGE(PG8_SB(1, 0), cB + kstep, voffB); PG8_STAGE(PG8_SA(1, 0), cA + kstep, voffA); PG8_STAGE(PG8_SB(1, 1), cB + hstep + kstep, voffB);
        PG8_WAIT_V(6); PG8_BAR;
    } else {
        PG8_STAGE(PG8_SB(0, 0), cB, voffB); PG8_STAGE(PG8_SA(0, 0), cA, voffA); PG8_STAGE(PG8_SB(0, 1), cB + hstep, voffB); PG8_STAGE(PG8_SA(0, 1), cA + hstep, voffA);
        if (wr == 1) PG8_BAR;
        PG8_WAIT_V(4); PG8_BAR;
        PG8_STAGE(PG8_SB(1, 0), cB + kstep, voffB); PG8_STAGE(PG8_SA(1, 0), cA + kstep, voffA); PG8_STAGE(PG8_SB(1, 1), cB + hstep + kstep, voffB);
        PG8_WAIT_V(6); PG8_BAR;
    }
    for (;;) {
        const bool has_next = S.next(ui + 1, nxt);
        const char* nA = has_next ? (const char*)g.A + (size_t)nxt.pm * tstep : cA; const char* nB = has_next ? (const char*)g.Bt + (size_t)nxt.pn * tstep : cB;
        for (int t = 0; t < nt; t += 2) {
            const bool last = (t == nt - 2);
            const char* a1 = cA + (size_t)(t + 1) * kstep;
            const char* a2 = last ? nA : cA + (size_t)(t + 2) * kstep; const char* b2 = last ? nB : cB + (size_t)(t + 2) * kstep;
            const char* a3 = a2 + kstep; const char* b3 = b2 + kstep;
            if (last && has_next) S.a_ready(nxt);
            if constexpr (SP2) {
            PG8_LDB(B0, 0, 0); PG8_LDB(B1, 0, 1); PG8_SCHED; PG8_LDA(At, 0, 0); PG8_STAGE(PG8_SA(1, 1), a1 + hstep, voffA);
            PG8_WAIT_V(8); PG8_WAIT_L(0); PG8_BAR; PG8_MMA(0, 0, At, B0); PG8_MMA(0, 1, At, B1); PG8_BAR; PG8_SCHED;
            PG8_LDA(At, 0, 1); PG8_STAGE(PG8_SB(0, 0), b2, voffB); PG8_STAGE(PG8_SB(0, 1), b2 + hstep, voffB); PG8_STAGE(PG8_SA(0, 0), a2, voffA);
            PG8_WAIT_V(8); PG8_WAIT_L(0); PG8_BAR; PG8_MMA(1, 0, At, B0); PG8_MMA(1, 1, At, B1); PG8_BAR; PG8_SCHED;
            PG8_LDB(B0, 1, 0); PG8_LDB(B1, 1, 1); PG8_SCHED; PG8_LDA(At, 1, 0); PG8_STAGE(PG8_SA(0, 1), a2 + hstep, voffA);
            PG8_WAIT_V(8); PG8_WAIT_L(0); PG8_BAR; PG8_MMA(0, 0, At, B0); PG8_MMA(0, 1, At, B1); PG8_BAR; PG8_SCHED;
            PG8_LDA(At, 1, 1); PG8_STAGE(PG8_SB(1, 0), b3, voffB); PG8_STAGE(PG8_SB(1, 1), b3 + hstep, voffB); PG8_STAGE(PG8_SA(1, 0), a3, voffA);
            PG8_WAIT_V(8); PG8_WAIT_L(0); PG8_BAR; PG8_MMA(1, 0, At, B0); PG8_MMA(1, 1, At, B1); PG8_BAR; PG8_SCHED;
            } else {
            PG8_LDB(B0, 0, 0); PG8_SCHED; PG8_LDA(At, 0, 0); PG8_STAGE(PG8_SA(1, 1), a1 + hstep, voffA);
            PG8_WAIT_L(8); PG8_BAR; PG8_WAIT_L(0); PG8_MMA(0, 0, At, B0); PG8_BAR; PG8_SCHED;
            PG8_LDB(B1, 0, 1); PG8_STAGE(PG8_SB(0, 0), b2, voffB);
            PG8_BAR; PG8_WAIT_L(0); PG8_MMA(0, 1, At, B1); PG8_BAR;
            PG8_LDA(At, 0, 1); PG8_STAGE(PG8_SA(0, 0), a2, voffA);
            PG8_BAR; PG8_WAIT_L(0); PG8_MMA(1, 0, At, B0); PG8_BAR; PG8_SCHED;
            PG8_STAGE(PG8_SB(0, 1), b2 + hstep, voffB);
            PG8_WAIT_V(6); PG8_BAR; PG8_MMA(1, 1, At, B1); PG8_BAR;
            PG8_LDB(B0, 1, 0); PG8_SCHED; PG8_LDA(At, 1, 0); PG8_STAGE(PG8_SA(0, 1), a2 + hstep, voffA);
            PG8_WAIT_L(8); PG8_BAR; PG8_WAIT_L(0); PG8_MMA(0, 0, At, B0); PG8_BAR; PG8_SCHED;
            PG8_LDB(B1, 1, 1); PG8_STAGE(PG8_SB(1, 0), b3, voffB);
            PG8_BAR; PG8_WAIT_L(0); PG8_MMA(0, 1, At, B1); PG8_BAR;
            PG8_LDA(At, 1, 1); PG8_STAGE(PG8_SA(1, 0), a3, voffA);
            PG8_BAR; PG8_WAIT_L(0); PG8_MMA(1, 0, At, B0); PG8_BAR; PG8_SCHED;
            PG8_STAGE(PG8_SB(1, 1), b3 + hstep, voffB);
            PG8_WAIT_V(6); PG8_BAR; PG8_MMA(1, 1, At, B1); PG8_BAR;
            }
        }
        if constexpr (ALIGN_EPI) { if (wr == 0) PG8_BAR; }
        if constexpr (!Epi::AFTER_DRAIN) { E(acc, cur, wr, wc, fr, fq); S.done(cur); }
        if (!has_next) break;
#pragma unroll
        for (int a = 0; a < 2; ++a)
#pragma unroll
            for (int b = 0; b < 2; ++b)
#pragma unroll
                for (int m = 0; m < 4; ++m)
#pragma unroll
                    for (int n = 0; n < 2; ++n) acc[a][b][m][n] = (f32x4){0.f, 0.f, 0.f, 0.f};
        cur = nxt; cA = nA; cB = nB; ++ui;
        if constexpr (ALIGN_EPI) { if (wr == 1) PG8_BAR; }
    }
    PG8_WAIT_V(0);
    if constexpr (!ALIGN_EPI) { if (wr == 0) PG8_BAR; }
    PG8_BAR;
    if constexpr (Epi::AFTER_DRAIN) { E.fused(acc, cur, wr, wc, fr, fq, lds, wid, lane); S.done(cur); }
#undef PG8_SA
#undef PG8_SB
#undef PG8_STAGE
#undef PG8_LDA
#undef PG8_LDB
#undef PG8_MMA
#undef PG8_WAIT_V
#undef PG8_WAIT_L
#undef PG8_BAR
#undef PG8_SCHED
}

__device__ __forceinline__ float sigm(float x) { return 1.0f / (1.0f + __expf(-x)); }
struct EpiGlu {
    static constexpr bool PERM = true, AFTER_DRAIN = false;
    bf16_t* O; int ldc;
    __device__ __forceinline__ void operator()(const f32x4 (&acc)[2][2][4][2], const Unit& u, int wr, int wc, int fr, int fq) const {
        const int row0 = u.pm * BM + wr * 64 + fr, col0 = u.pn * HALF + wc * 32 + 8 * fq;
#pragma unroll
        for (int ai = 0; ai < 2; ++ai)
#pragma unroll
            for (int m = 0; m < 4; ++m) {
                bf16_t* rowp = O + (size_t)(row0 + ai * HALF + m * 16) * ldc + col0;
                const f32x4 a0 = acc[ai][0][m][0], a1 = acc[ai][0][m][1], b0 = acc[ai][1][m][0], b1 = acc[ai][1][m][1];
                u32x4 w;
                w.x = cvt_pk_bf16(a0[0] * sigm(b0[0]), a0[1] * sigm(b0[1])); w.y = cvt_pk_bf16(a0[2] * sigm(b0[2]), a0[3] * sigm(b0[3]));
                w.z = cvt_pk_bf16(a1[0] * sigm(b1[0]), a1[1] * sigm(b1[1])); w.w = cvt_pk_bf16(a1[2] * sigm(b1[2]), a1[3] * sigm(b1[3]));
                *(u32x4*)rowp = w;
            }
    }
};
struct EpiResid {
    static constexpr bool PERM = false, AFTER_DRAIN = false;
    const float* X; float* O; int ldc;
    __device__ __forceinline__ void operator()(const f32x4 (&acc)[2][2][4][2], const Unit& u, int wr, int wc, int fr, int fq) const {
        const int row0 = u.pm * BM + wr * 64 + fr, col0 = u.pn * BM + wc * 32 + 4 * fq;
#pragma unroll
        for (int ai = 0; ai < 2; ++ai)
#pragma unroll
            for (int m = 0; m < 4; ++m) {
                const size_t off = (size_t)(row0 + ai * HALF + m * 16) * ldc + col0;
#pragma unroll
                for (int bj = 0; bj < 2; ++bj)
#pragma unroll
                    for (int n = 0; n < 2; ++n) *(f32x4*)(O + off + bj * HALF + n * 16) = *(const f32x4*)(X + off + bj * HALF + n * 16) + acc[ai][bj][m][n];
            }
    }
};

template <class Epi, class Sched, bool GATHER>
__device__ __forceinline__ void gemm2(PG8_LAS unsigned char* lds, const Gemm g, const Sched& S, const Epi& E, const int tid) {
    const int wid = __builtin_amdgcn_readfirstlane(tid >> 6), lane = tid & 63, wr = wid >> 2, wc = wid & 3, fr = lane & 15, fq = lane >> 4;
    const int K = g.K, nt = K / BK, lda = g.lda;
    unsigned voffA[2], voffB[2]; int Rst[2], Cst[2];
#pragma unroll
    for (int i = 0; i < 2; ++i) { int R, C; stage_rc(tid * 16 + i * 8192, R, C); const int Rb = Epi::PERM ? ((R & ~31) + perm32(R & 31)) : R;
        voffA[i] = (unsigned)(R * lda + C) * 2u; voffB[i] = (unsigned)(Rb * K + C) * 2u; Rst[i] = R; Cst[i] = C; }
    const size_t kstep = (size_t)(BK * 2);
    const size_t hstepA = (size_t)HALF * lda * 2, tstepA = 2 * hstepA, hstepB = (size_t)HALF * K * 2, tstepB = 2 * hstepB;
    const unsigned ldsw = (unsigned)wid * 1024u;
    const int aoff = lds_byte(wr * 64 + fr, fq * 8), boff = lds_byte(wc * 32 + fr, fq * 8);
#define PG8_SA(b, h) (((b) * 2 + (h)) * HTB)
#define PG8_SB(b, h) ((4 + (b) * 2 + (h)) * HTB)
#define PG8_STAGE(bufoff, gbase, voff) do { _Pragma("unroll") for (int _i = 0; _i < 2; ++_i) \
        __builtin_amdgcn_global_load_lds((const unsigned*)((const char*)(gbase) + (voff)[_i]), (PG8_LAS unsigned*)(lds + (bufoff) + ldsw + _i * 8192), 16, 0, 0); } while (0)
#define PG8_STAGE_A(bufoff, gbase, h) do { if constexpr (GATHER) { PG8_STAGE(bufoff, gbase, vg[h]); } else { PG8_STAGE(bufoff, (gbase) + (h) * hstepA, voffA); } } while (0)
#define PG8_GOFFS(u, dst) do { _Pragma("unroll") for (int _h = 0; _h < 2; ++_h) _Pragma("unroll") for (int _i = 0; _i < 2; ++_i) { const int _pos = (u).p0 + _h * HALF + Rst[_i]; \
        const unsigned _tok = _pos < (u).cnt ? (g.list[(size_t)(u).eb * g.cap + _pos] >> 1) : 0u; dst[_h][_i] = (_tok * (unsigned)lda + (unsigned)Cst[_i]) * 2u; } } while (0)
#define PG8_LDA(dst, b, h) do { _Pragma("unroll") for (int m = 0; m < 4; ++m) _Pragma("unroll") for (int k = 0; k < 2; ++k) dst[m][k] = *(const PG8_LAS bf16x8*)(lds + PG8_SA(b, h) + aoff + m * 2048 + k * 1024); } while (0)
#define PG8_LDB(dst, b, h) do { _Pragma("unroll") for (int n = 0; n < 2; ++n) _Pragma("unroll") for (int k = 0; k < 2; ++k) dst[n][k] = *(const PG8_LAS bf16x8*)(lds + PG8_SB(b, h) + boff + n * 2048 + k * 1024); } while (0)
#define PG8_MMA(ai, bj, At, Bt) do { __builtin_amdgcn_s_setprio(1); _Pragma("unroll") for (int m = 0; m < 4; ++m) _Pragma("unroll") for (int n = 0; n < 2; ++n) _Pragma("unroll") for (int k = 0; k < 2; ++k) \
        acc[ai][bj][m][n] = __builtin_amdgcn_mfma_f32_16x16x32_bf16(Bt[n][k], At[m][k], acc[ai][bj][m][n], 0, 0, 0); __builtin_amdgcn_s_setprio(0); } while (0)
#define PG8_WAIT_V(n) asm volatile("s_waitcnt vmcnt(" #n ")" ::: "memory")
#define PG8_WAIT_L(n) asm volatile("s_waitcnt lgkmcnt(" #n ")" ::: "memory")
#define PG8_BAR __builtin_amdgcn_s_barrier()
#define PG8_SCHED __builtin_amdgcn_sched_barrier(0)
    Unit cur, nxt; int ui = 0;
    if (!S.next(0, cur)) return;
    f32x4 acc[2][2][4][2];
#pragma unroll
    for (int a = 0; a < 2; ++a)
#pragma unroll
        for (int b = 0; b < 2; ++b)
#pragma unroll
            for (int m = 0; m < 4; ++m)
#pragma unroll
                for (int n = 0; n < 2; ++n) acc[a][b][m][n] = (f32x4){0.f, 0.f, 0.f, 0.f};
    bf16x8 At[4][2], B0[2][2], B1[2][2];
    unsigned vg[2][2] = {{0u, 0u}, {0u, 0u}};
    if constexpr (GATHER) PG8_GOFFS(cur, vg);
    const char* cA = (const char*)g.A + (GATHER ? (size_t)0 : (size_t)cur.pm * tstepA);
    const char* cB = (const char*)g.Bt + ((size_t)cur.eb * g.bstride) * 2 + (size_t)cur.pn * tstepB;
    S.a_ready(cur);
    PG8_STAGE(PG8_SB(0, 0), cB, voffB); PG8_STAGE(PG8_SB(0, 1), cB + hstepB, voffB); PG8_STAGE_A(PG8_SA(0, 0), cA, 0); PG8_STAGE_A(PG8_SA(0, 1), cA, 1);
    if (wr == 1) PG8_BAR;
    PG8_WAIT_V(2); PG8_BAR;
    PG8_STAGE(PG8_SB(1, 0), cB + kstep, voffB); PG8_STAGE_A(PG8_SA(1, 0), cA + kstep, 0); PG8_STAGE(PG8_SB(1, 1), cB + hstepB + kstep, voffB);
    PG8_WAIT_V(6); PG8_BAR;
    for (;;) {
        const bool has_next = S.next(ui + 1, nxt);
        const char* nA = has_next ? (const char*)g.A + (GATHER ? (size_t)0 : (size_t)nxt.pm * tstepA) : cA;
        const char* nB = has_next ? (const char*)g.Bt + ((size_t)nxt.eb * g.bstride) * 2 + (size_t)nxt.pn * tstepB : cB;
        for (int t = 0; t < nt; t += 2) {
            const bool last = (t == nt - 2);
            const char* a1 = cA + (size_t)(t + 1) * kstep;
            const char* a2 = last ? nA : cA + (size_t)(t + 2) * kstep; const char* b2 = last ? nB : cB + (size_t)(t + 2) * kstep;
            const char* a3 = a2 + kstep; const char* b3 = b2 + kstep;
            unsigned vn1[2] = {vg[1][0], vg[1][1]};
            if constexpr (GATHER) { if (last && has_next) { unsigned vn[2][2]; PG8_GOFFS(nxt, vn); vg[0][0] = vn[0][0]; vg[0][1] = vn[0][1]; vn1[0] = vn[1][0]; vn1[1] = vn[1][1]; } }
            if (last && has_next) S.a_ready(nxt);
            PG8_LDB(B0, 0, 0); PG8_LDB(B1, 0, 1); PG8_SCHED; PG8_LDA(At, 0, 0); PG8_STAGE_A(PG8_SA(1, 1), a1, 1);
            PG8_WAIT_V(8); PG8_WAIT_L(0); PG8_BAR; PG8_MMA(0, 0, At, B0); PG8_MMA(0, 1, At, B1); PG8_BAR; PG8_SCHED;
            if constexpr (GATHER) { vg[1][0] = vn1[0]; vg[1][1] = vn1[1]; }
            PG8_LDA(At, 0, 1); PG8_STAGE(PG8_SB(0, 0), b2, voffB); PG8_STAGE(PG8_SB(0, 1), b2 + hstepB, voffB); PG8_STAGE_A(PG8_SA(0, 0), a2, 0);
            PG8_WAIT_V(8); PG8_WAIT_L(0); PG8_BAR; PG8_MMA(1, 0, At, B0); PG8_MMA(1, 1, At, B1); PG8_BAR; PG8_SCHED;
            PG8_LDB(B0, 1, 0); PG8_LDB(B1, 1, 1); PG8_SCHED; PG8_LDA(At, 1, 0); PG8_STAGE_A(PG8_SA(0, 1), a2, 1);
            PG8_WAIT_V(8); PG8_WAIT_L(0); PG8_BAR; PG8_MMA(0, 0, At, B0); PG8_MMA(0, 1, At, B1); PG8_BAR; PG8_SCHED;
            PG8_LDA(At, 1, 1); PG8_STAGE(PG8_SB(1, 0), b3, voffB); PG8_STAGE(PG8_SB(1, 1), b3 + hstepB, voffB); PG8_STAGE_A(PG8_SA(1, 0), a3, 0);
            PG8_WAIT_V(8); PG8_WAIT_L(0); PG8_BAR; PG8_MMA(1, 0, At, B0); PG8_MMA(1, 1, At, B1); PG8_BAR; PG8_SCHED;
        }
        if (wr == 0) PG8_BAR;
        E(acc, cur, wr, wc, fr, fq); S.done(cur);
        if (!has_next) break;
#pragma unroll
        for (int a = 0; a < 2; ++a)
#pragma unroll
            for (int b = 0; b < 2; ++b)
#pragma unroll
                for (int m = 0; m < 4; ++m)
#pragma unroll
                    for (int n = 0; n < 2; ++n) acc[a][b][m][n] = (f32x4){0.f, 0.f, 0.f, 0.f};
        cur = nxt; cA = nA; cB = nB; ++ui;
        if (wr == 1) PG8_BAR;
    }
    PG8_WAIT_V(0);
    PG8_BAR;
#undef PG8_SA
#undef PG8_SB
#undef PG8_STAGE
#undef PG8_STAGE_A
#undef PG8_GOFFS
#undef PG8_LDA
#undef PG8_LDB
#undef PG8_MMA
#undef PG8_WAIT_V
#undef PG8_WAIT_L
#undef PG8_BAR
#undef PG8_SCHED
}

struct ExpertOrder {
    const PG8_LAS int* tab; int nN, G, c;
    __device__ __forceinline__ bool next(int i, Unit& u) const {
        const int total = tab[32] * nN; const long L = (long)i * G + c; if (L >= total) return false;
        const int rt = (int)L / nN, pn = (int)L % nN; int e = 0;
#pragma unroll
        for (int k = 1; k < 32; ++k) e += (rt >= tab[k]) ? 1 : 0;
        u.pm = __builtin_amdgcn_readfirstlane(rt); u.pn = __builtin_amdgcn_readfirstlane(pn); u.eb = __builtin_amdgcn_readfirstlane(e);
        u.p0 = __builtin_amdgcn_readfirstlane((rt - tab[e]) * BM); u.cnt = __builtin_amdgcn_readfirstlane(tab[33 + e]); return true;
    }
    __device__ __forceinline__ void a_ready(const Unit&) const {}
    __device__ __forceinline__ void done(const Unit&) const {}
};
struct EpiGateUp {
    static constexpr bool PERM = true, AFTER_DRAIN = false;
    bf16_t* H; const float* listw; int cap;
    __device__ __forceinline__ void operator()(const f32x4 (&acc)[2][2][4][2], const Unit& u, int wr, int wc, int fr, int fq) const {
        const int rl0 = wr * 64 + fr, col0 = u.pn * HALF + wc * 32 + 8 * fq;
#pragma unroll
        for (int ai = 0; ai < 2; ++ai)
#pragma unroll
            for (int m = 0; m < 4; ++m) {
                const int rl = rl0 + ai * HALF + m * 16, pos = u.p0 + rl;
                const float w = pos < u.cnt ? listw[(size_t)u.eb * cap + pos] : 0.f;
                bf16_t* rowp = H + (size_t)(u.pm * BM + rl) * 256 + col0;
                const f32x4 g0 = acc[ai][0][m][0], g1 = acc[ai][0][m][1], u0 = acc[ai][1][m][0], u1 = acc[ai][1][m][1];
                u32x4 o;
                o.x = cvt_pk_bf16(g0[0] * sigm(g0[0]) * u0[0] * w, g0[1] * sigm(g0[1]) * u0[1] * w); o.y = cvt_pk_bf16(g0[2] * sigm(g0[2]) * u0[2] * w, g0[3] * sigm(g0[3]) * u0[3] * w);
                o.z = cvt_pk_bf16(g1[0] * sigm(g1[0]) * u1[0] * w, g1[1] * sigm(g1[1]) * u1[1] * w); o.w = cvt_pk_bf16(g1[2] * sigm(g1[2]) * u1[2] * w, g1[3] * sigm(g1[3]) * u1[3] * w);
                *(u32x4*)rowp = o;
            }
    }
};
struct EpiDown {
    static constexpr bool PERM = false, AFTER_DRAIN = false;
    float* X; float* P2; const unsigned* list; int cap;
    __device__ __forceinline__ void operator()(const f32x4 (&acc)[2][2][4][2], const Unit& u, int wr, int wc, int fr, int fq) const {
        const int rl0 = wr * 64 + fr, col0 = u.pn * BM + wc * 32 + 4 * fq;
#pragma unroll
        for (int ai = 0; ai < 2; ++ai)
#pragma unroll
            for (int m = 0; m < 4; ++m) {
                const int rl = rl0 + ai * HALF + m * 16, pos = u.p0 + rl;
                if (pos < u.cnt) {
                    const unsigned ent = list[(size_t)u.eb * cap + pos];
                    float* dst = ((ent & 1u) ? P2 : X) + (size_t)(ent >> 1) * 1024 + col0;
#pragma unroll
                    for (int bj = 0; bj < 2; ++bj)
#pragma unroll
                        for (int n = 0; n < 2; ++n) { f32x4 v = acc[ai][bj][m][n]; if (!(ent & 1u)) v += *(const f32x4*)(dst + bj * HALF + n * 16); *(f32x4*)(dst + bj * HALF + n * 16) = v; }
                }
                asm volatile("" ::: "memory");
            }
    }
};
}

struct Args { const float* in[26]; float* out; unsigned char* ws; int ph_lo, ph_hi; };

struct Frame {
    LAS unsigned char* lds;
    int tid, lane, wave, blk, G;
};

__device__ __forceinline__ void ph_norm(const Frame& F, const float* xin, const float* add, float* xout, const float* g, bf16* hn) {
    const int gw = F.blk * NWAVES + F.wave, NGW = F.G * NWAVES;
    for (int row = gw; row < T; row += NGW) {
        const f32x4* xr = (const f32x4*)(xin + (size_t)row * DM);
        f32x4 v[4]; float s = 0.f;
#pragma unroll
        for (int j = 0; j < 4; ++j) { v[j] = xr[F.lane + 64 * j];
            if (add) { v[j] += ((const f32x4*)(add + (size_t)row * DM))[F.lane + 64 * j]; ((f32x4*)(xout + (size_t)row * DM))[F.lane + 64 * j] = v[j]; }
            s += v[j].x * v[j].x + v[j].y * v[j].y + v[j].z * v[j].z + v[j].w * v[j].w; }
        s = wave_sum(s, F.lane);
        const float r = rsqrtf(s * (1.0f / DM) + EPS);
#pragma unroll
        for (int j = 0; j < 4; ++j) {
            const f32x4 gg = ((const f32x4*)g)[F.lane + 64 * j];
            u32x2 o; o.x = pk2(v[j].x * r * gg.x, v[j].y * r * gg.y); o.y = pk2(v[j].z * r * gg.z, v[j].w * r * gg.w);
            *(u32x2*)(hn + (size_t)row * DM + (F.lane + 64 * j) * 4) = o;
        }
    }
}
__device__ __forceinline__ void ph_final_norm(const Frame& F, float* x, const float* add, const float* g) {
    const int gw = F.blk * NWAVES + F.wave, NGW = F.G * NWAVES;
    for (int row = gw; row < T; row += NGW) {
        f32x4* xr = (f32x4*)(x + (size_t)row * DM);
        f32x4 v[4]; float s = 0.f;
#pragma unroll
        for (int j = 0; j < 4; ++j) { v[j] = xr[F.lane + 64 * j]; if (add) v[j] += ((const f32x4*)(add + (size_t)row * DM))[F.lane + 64 * j]; s += v[j].x * v[j].x + v[j].y * v[j].y + v[j].z * v[j].z + v[j].w * v[j].w; }
        s = wave_sum(s, F.lane);
        const float r = rsqrtf(s * (1.0f / DM) + EPS);
#pragma unroll
        for (int j = 0; j < 4; ++j) {
            const f32x4 gg = ((const f32x4*)g)[F.lane + 64 * j];
            f32x4 o; o.x = v[j].x * r * gg.x; o.y = v[j].y * r * gg.y; o.z = v[j].z * r * gg.z; o.w = v[j].w * r * gg.w;
            xr[F.lane + 64 * j] = o;
        }
    }
}

template <bool DUAL, class Epi>
__device__ __forceinline__ void sgemm_naive(const Frame& F, const bf16* A, int lda, const float* B, int ldb, int M, int N, int K, int dualoff, const Epi& epi) {
    LAS float* As = (LAS float*)F.lds;
    LAS float* Bs = As + 16 * 132;
    LAS float* Bs2 = Bs + 16 * 128;
    const int tiles_n = (N + 127) / 128, tiles_m = M / 128;
    const int tx = F.tid & 31, ty = F.tid >> 5;
    for (int tile = F.blk; tile < tiles_m * tiles_n; tile += F.G) {
        const int tm = tile / tiles_n, tn = tile % tiles_n;
        float acc[8][4], acc2[8][4];
#pragma unroll
        for (int i = 0; i < 8; ++i)
#pragma unroll
            for (int j = 0; j < 4; ++j) { acc[i][j] = 0.f; acc2[i][j] = 0.f; }
        const int arow = F.tid >> 2, akq = (F.tid & 3) * 4;
        const int bk = F.tid >> 5, bn = (F.tid & 31) * 4;
        for (int k0 = 0; k0 < K; k0 += 16) {
            {
                const u32x2 av = *(const u32x2*)(A + (size_t)(tm * 128 + arow) * lda + k0 + akq);
                As[(akq + 0) * 132 + arow] = __uint_as_float(av.x << 16);
                As[(akq + 1) * 132 + arow] = __uint_as_float(av.x & 0xffff0000u);
                As[(akq + 2) * 132 + arow] = __uint_as_float(av.y << 16);
                As[(akq + 3) * 132 + arow] = __uint_as_float(av.y & 0xffff0000u);
                const int col = tn * 128 + bn;
                f32x4 bv = (f32x4){0.f, 0.f, 0.f, 0.f};
                const float* bp = B + (size_t)(k0 + bk) * ldb + col;
                if (col + 3 < N) { bv.x = bp[0]; bv.y = bp[1]; bv.z = bp[2]; bv.w = bp[3]; }
                else { if (col < N) bv.x = bp[0]; if (col + 1 < N) bv.y = bp[1]; if (col + 2 < N) bv.z = bp[2]; }
                *(LAS f32x4*)(Bs + bk * 128 + bn) = bv;
                if (DUAL) {
                    const float* bp2 = bp + dualoff;
                    f32x4 bw; bw.x = bp2[0]; bw.y = bp2[1]; bw.z = bp2[2]; bw.w = bp2[3];
                    *(LAS f32x4*)(Bs2 + bk * 128 + bn) = bw;
                }
            }
            __syncthreads();
#pragma unroll 4
            for (int k = 0; k < 16; ++k) {
                float a[8];
                const f32x4 a0 = *(const LAS f32x4*)(As + k * 132 + ty * 8), a1 = *(const LAS f32x4*)(As + k * 132 + ty * 8 + 4);
                a[0] = a0.x; a[1] = a0.y; a[2] = a0.z; a[3] = a0.w; a[4] = a1.x; a[5] = a1.y; a[6] = a1.z; a[7] = a1.w;
                const f32x4 b = *(const LAS f32x4*)(Bs + k * 128 + tx * 4);
#pragma unroll
                for (int i = 0; i < 8; ++i) { acc[i][0] += a[i] * b.x; acc[i][1] += a[i] * b.y; acc[i][2] += a[i] * b.z; acc[i][3] += a[i] * b.w; }
                if (DUAL) {
                    const f32x4 b2 = *(const LAS f32x4*)(Bs2 + k * 128 + tx * 4);
#pragma unroll
                    for (int i = 0; i < 8; ++i) { acc2[i][0] += a[i] * b2.x; acc2[i][1] += a[i] * b2.y; acc2[i][2] += a[i] * b2.z; acc2[i][3] += a[i] * b2.w; }
                }
            }
            __syncthreads();
        }
#pragma unroll
        for (int i = 0; i < 8; ++i)
#pragma unroll
            for (int j = 0; j < 4; ++j) {
                const int row = tm * 128 + ty * 8 + i, col = tn * 128 + tx * 4 + j;
                if (col < N) epi(row, col, acc[i][j], acc2[i][j]);
            }
    }
}
struct EpiStoreBf16 { bf16* O; int ldo; __device__ __forceinline__ void operator()(int r, int c, float a, float) const { O[(size_t)r * ldo + c] = (bf16)f2bf(a); } };
struct EpiGlu { bf16* O; int ldo; __device__ __forceinline__ void operator()(int r, int c, float a, float b) const { O[(size_t)r * ldo + c] = (bf16)f2bf(a * sigmoidf_(b)); } };
struct EpiResid { const float* X; float* O; __device__ __forceinline__ void operator()(int r, int c, float a, float) const { O[(size_t)r * DM + c] = X[(size_t)r * DM + c] + a; } };

__device__ __forceinline__ void ssm_naive_item(int b, int g, const float* a_re, const float* a_im, const float* b_re, const float* b_im, const float* c_re, const float* c_im,
                                               const float* dpar, const float* log_dt, const bf16* Z, bf16* G1, int lane) {
    const int p = lane;
    const float are = a_re[g * 64 + p], aim = a_im[g * 64 + p], dt = expf(log_dt[g]);
    const float er = expf(are * dt), lbr = er * cosf(aim * dt), lbi = er * sinf(aim * dt);
    const float xx = lbr - 1.0f, yy = lbi, den = are * are + aim * aim;
    const float fr = (xx * are + yy * aim) / den, fi = (yy * are - xx * aim) / den;
    float bbr[16], bbi[16], cr[16], ci[16];
#pragma unroll
    for (int h = 0; h < 16; ++h) {
        const float br = b_re[(g * 64 + p) * 16 + h], bi = b_im[(g * 64 + p) * 16 + h];
        bbr[h] = fr * br - fi * bi; bbi[h] = fr * bi + fi * br;
        cr[h] = c_re[(g * 16 + h) * 64 + p]; ci[h] = c_im[(g * 16 + h) * 64 + p];
    }
    const float dd = dpar[g * 16 + (lane & 15)];
    float xr = 0.f, xi = 0.f;
    for (int t = 0; t < SEQ; ++t) {
        const size_t row = (size_t)b * SEQ + t;
        const u32x4 u0 = *(const u32x4*)(Z + row * ZP + ZC_U + g * 16), u1 = *(const u32x4*)(Z + row * ZP + ZC_U + g * 16 + 8);
        float u[16];
        u[0] = __uint_as_float(u0.x << 16); u[1] = __uint_as_float(u0.x & 0xffff0000u); u[2] = __uint_as_float(u0.y << 16); u[3] = __uint_as_float(u0.y & 0xffff0000u);
        u[4] = __uint_as_float(u0.z << 16); u[5] = __uint_as_float(u0.z & 0xffff0000u); u[6] = __uint_as_float(u0.w << 16); u[7] = __uint_as_float(u0.w & 0xffff0000u);
        u[8] = __uint_as_float(u1.x << 16); u[9] = __uint_as_float(u1.x & 0xffff0000u); u[10] = __uint_as_float(u1.y << 16); u[11] = __uint_as_float(u1.y & 0xffff0000u);
        u[12] = __uint_as_float(u1.z << 16); u[13] = __uint_as_float(u1.z & 0xffff0000u); u[14] = __uint_as_float(u1.w << 16); u[15] = __uint_as_float(u1.w & 0xffff0000u);
        float bur = 0.f, bui = 0.f;
#pragma unroll
        for (int h = 0; h < 16; ++h) { bur += bbr[h] * u[h]; bui += bbi[h] * u[h]; }
        const float nxr = lbr * xr - lbi * xi + bur, nxi = lbr * xi + lbi * xr + bui;
        xr = nxr; xi = nxi;
        float y = 0.f;
#pragma unroll
        for (int h = 0; h < 16; ++h) { const float v = wave_sum(cr[h] * xr - ci[h] * xi, lane); if (lane == h) y = v; }
        if (lane < 16) {
            const float ul = bf2f(Z[row * ZP + ZC_U + g * 16 + lane]);
            G1[row * D_SSM + g * 16 + lane] = (bf16)f2bf(gelu_tanh(y + dd * ul));
        }
    }
}
__device__ __forceinline__ void compress_naive_item(int item, const bf16* Z, const float* pos, const float* w1, const float* w2, bf16* KC, bf16* VC, int lane) {
    const int i = item & 1, hkv = (item >> 1) & 1, n = (item >> 2) % NCMPP, b = (item >> 2) / NCMPP;
    bf16* dst = i ? VC : KC;
    if (n == NCMP) { dst[(((size_t)b * NCMPP + n) * 2 + hkv) * 64 + lane] = 0; return; }
    const float* posi = pos + i * 32 * 64; const float* w1i = w1 + (size_t)i * 32 * 64 * 64; const float* w2i = w2 + i * 64 * 64;
    float acc = 0.f;
    for (int l = 0; l < 32; ++l) {
        const bf16* zr = Z + ((size_t)b * SEQ + 16 * n + l) * ZP + ZC_KV + i * 128 + hkv * 64;
        for (int d = 0; d < 64; ++d) acc += (bf2f(zr[d]) + posi[l * 64 + d]) * w1i[(l * 64 + d) * 64 + lane];
    }
    const float hid = gelu_tanh(acc);
    float o = 0.f;
    for (int e = 0; e < 64; ++e) o += lane_bcast(hid, e) * w2i[e * 64 + lane];
    dst[(((size_t)b * NCMPP + n) * 2 + hkv) * 64 + lane] = (bf16)f2bf(o);
}

__device__ __forceinline__ void attn_chunk(LAS float* wl, const bf16* Z, const float* rel_bias, int b, int hkv, int t, int base, int kcol, int vcol, int lane,
                                           float (&m)[4], float (&l)[4], float (&o)[4]) {
    const int pos = base + lane; const bool valid = (pos >= 0) && (pos <= t);
    const int posc = pos < 0 ? 0 : (pos > SEQ - 1 ? SEQ - 1 : pos);
    const bf16* kr = Z + ((size_t)b * SEQ + posc) * ZP + kcol + hkv * 64;
    float s[4] = {0.f, 0.f, 0.f, 0.f};
#pragma unroll 2
    for (int c = 0; c < 8; ++c) {
        const u32x4 kv = *(const u32x4*)(kr + c * 8);
        float k[8];
        k[0] = __uint_as_float(kv.x << 16); k[1] = __uint_as_float(kv.x & 0xffff0000u); k[2] = __uint_as_float(kv.y << 16); k[3] = __uint_as_float(kv.y & 0xffff0000u);
        k[4] = __uint_as_float(kv.z << 16); k[5] = __uint_as_float(kv.z & 0xffff0000u); k[6] = __uint_as_float(kv.w << 16); k[7] = __uint_as_float(kv.w & 0xffff0000u);
#pragma unroll
        for (int g = 0; g < 4; ++g) {
            const f32x4 q0 = *(const LAS f32x4*)(wl + g * 64 + c * 8), q1 = *(const LAS f32x4*)(wl + g * 64 + c * 8 + 4);
            s[g] += q0.x * k[0] + q0.y * k[1] + q0.z * k[2] + q0.w * k[3] + q1.x * k[4] + q1.y * k[5] + q1.z * k[6] + q1.w * k[7];
        }
    }
    const int bk = t5_bucket(t - pos);
#pragma unroll
    for (int g = 0; g < 4; ++g) {
        const float sv = valid ? s[g] + rel_bias[bk * 8 + hkv * 4 + g] : -1e30f;
        const float mn = fmaxf(m[g], wave_max(sv, lane));
        const float alpha = __expf(m[g] - mn);
        const float p = valid ? __expf(sv - mn) : 0.f;
        l[g] = l[g] * alpha + wave_sum(p, lane);
        o[g] *= alpha; m[g] = mn;
        wl[256 + g * 64 + lane] = p;
    }
#pragma unroll 4
    for (int key = 0; key < 64; ++key) {
        int pk = base + key; pk = pk < 0 ? 0 : (pk > SEQ - 1 ? SEQ - 1 : pk);
        const float v = bf2f(Z[((size_t)b * SEQ + pk) * ZP + vcol + hkv * 64 + lane]);
#pragma unroll
        for (int g = 0; g < 4; ++g) o[g] += wl[256 + g * 64 + key] * v;
    }
}
__device__ __forceinline__ void attn_naive_item(LAS float* wl, int b, int hkv, int t, const bf16* Z, const float* KC, const float* VC, const float* rel_bias, bf16* YC, int lane) {
    const size_t row = (size_t)b * SEQ + t;
#pragma unroll
    for (int g = 0; g < 4; ++g) wl[g * 64 + lane] = bf2f(Z[row * ZP + ZC_Q + hkv * 256 + g * 64 + lane]) * 0.125f;
#pragma unroll 1
    for (int c = 0; c < 4; ++c) {
        const int n = c * 64 + lane; const bool valid = (n < NCMP) && (16 * n + 31 <= t);
        const float* kr = KC + (((size_t)b * NCMPP + (n < NCMP ? n : 0)) * 2 + hkv) * 64;
        float s[4] = {0.f, 0.f, 0.f, 0.f};
#pragma unroll 4
        for (int d4 = 0; d4 < 16; ++d4) {
            const f32x4 k = *(const f32x4*)(kr + d4 * 4);
#pragma unroll
            for (int g = 0; g < 4; ++g) { const f32x4 q = *(const LAS f32x4*)(wl + g * 64 + d4 * 4); s[g] += q.x * k.x + q.y * k.y + q.z * k.z + q.w * k.w; }
        }
        const int bk = t5_bucket(t - (16 * n + 31));
#pragma unroll
        for (int g = 0; g < 4; ++g) wl[256 + g * 256 + n] = valid ? s[g] + rel_bias[bk * 8 + hkv * 4 + g] : -1e30f;
    }
#pragma unroll
    for (int g = 0; g < 4; ++g) {
        float sc[4];
#pragma unroll
        for (int c = 0; c < 4; ++c) sc[c] = wl[256 + g * 256 + c * 64 + lane];
        const float mx = wave_max(fmaxf(fmaxf(sc[0], sc[1]), fmaxf(sc[2], sc[3])), lane);
        float e[4], ls = 0.f;
#pragma unroll
        for (int c = 0; c < 4; ++c) { e[c] = sc[c] > -1e29f ? __expf(sc[c] - mx) : 0.f; ls += e[c]; }
        ls = wave_sum(ls, lane);
        const float inv = ls > 0.f ? 1.0f / ls : 0.f;
#pragma unroll
        for (int c = 0; c < 4; ++c) wl[256 + g * 256 + c * 64 + lane] = e[c] * inv;
    }
    float oc[4] = {0.f, 0.f, 0.f, 0.f};
    const int nmax = t >= 31 ? ((t - 31) / 16 + 1 < NCMP ? (t - 31) / 16 + 1 : NCMP) : 0;
#pragma unroll 4
    for (int n = 0; n < nmax; ++n) {
        const float v = VC[(((size_t)b * NCMPP + n) * 2 + hkv) * 64 + lane];
#pragma unroll
        for (int g = 0; g < 4; ++g) oc[g] += wl[256 + g * 256 + n] * v;
    }
    float imp = 0.f;
#pragma unroll
    for (int g = 0; g < 4; ++g) {
        const LAS float* P = wl + 256 + g * 256;
        imp += P[4 * lane] + P[4 * lane + 1] + P[4 * lane + 2] + 0.5f * P[4 * lane + 3] + (lane > 0 ? 0.5f * P[4 * lane - 1] : 0.f);
    }
    const int blk = t >> 6;
    const bool forced = (lane == 0) || (lane <= blk && lane > blk - 2), future = lane > blk;
    const float v = forced ? 1e9f : (future ? -1e9f : imp);
    int rank = 0;
    for (int jj = 0; jj < 64; ++jj) { const float vj = lane_bcast(v, jj); rank += (vj > v) || (vj == v && jj < lane); }
    unsigned long long mask = __ballot(rank < 16 && !future);
    float m[4], l[4], o[4];
#pragma unroll
    for (int g = 0; g < 4; ++g) { m[g] = -1e30f; l[g] = 0.f; o[g] = 0.f; }
    while (mask) {
        const int j = __builtin_ctzll(mask); mask &= mask - 1;
        attn_chunk(wl, Z, rel_bias, b, hkv, t, 64 * j, ZC_KV + 256, ZC_KV + 384, lane, m, l, o);
    }
    float os[4];
#pragma unroll
    for (int g = 0; g < 4; ++g) { os[g] = l[g] > 0.f ? o[g] / l[g] : 0.f; m[g] = -1e30f; l[g] = 0.f; o[g] = 0.f; }
    for (int c = 0; c < 8; ++c) attn_chunk(wl, Z, rel_bias, b, hkv, t, t - 511 + 64 * c, ZC_KV + 512, ZC_KV + 640, lane, m, l, o);
#pragma unroll
    for (int g = 0; g < 4; ++g) {
        const float ow = l[g] > 0.f ? o[g] / l[g] : 0.f;
        const bf16* gp = Z + row * ZP + ZC_G + hkv * 12 + g * 3;
        const float r = sigmoidf_(bf2f(gp[0])) * oc[g] + sigmoidf_(bf2f(gp[1])) * os[g] + sigmoidf_(bf2f(gp[2])) * ow;
        YC[row * DM + D_SSM + hkv * 256 + g * 64 + lane] = (bf16)f2bf(r);
    }
}

__device__ __forceinline__ void ph_norm_route(const Frame& F, const float* x, const float* g, const float* rgw, const float* rgb, const float* rew, const float* reb, bf16* hn,
                                              unsigned* gcnt, unsigned* list, float* listw) {
    LAS unsigned* cnt_l = (LAS unsigned*)F.lds; LAS unsigned* base_l = cnt_l + 32; LAS unsigned* ent = cnt_l + 64;
    for (int row0 = F.blk * 128; row0 < T; row0 += F.G * 128) {
        if (F.tid < 32) cnt_l[F.tid] = 0u;
        __syncthreads();
        for (int kk = 0; kk < 16; ++kk) {
            const int row = row0 + F.wave * 16 + kk;
            const f32x4* xr = (const f32x4*)(x + (size_t)row * DM);
            f32x4 v[4]; float s = 0.f;
#pragma unroll
            for (int j = 0; j < 4; ++j) { v[j] = xr[F.lane + 64 * j]; s += v[j].x * v[j].x + v[j].y * v[j].y + v[j].z * v[j].z + v[j].w * v[j].w; }
            s = wave_sum(s, F.lane);
            const float r = rsqrtf(s * (1.0f / DM) + EPS);
            float lg[4] = {0.f, 0.f, 0.f, 0.f};
#pragma unroll
            for (int j = 0; j < 4; ++j) {
                const f32x4 gg = ((const f32x4*)g)[F.lane + 64 * j];
                v[j].x = v[j].x * r * gg.x; v[j].y = v[j].y * r * gg.y; v[j].z = v[j].z * r * gg.z; v[j].w = v[j].w * r * gg.w;
                u32x2 o; o.x = pk2(v[j].x, v[j].y); o.y = pk2(v[j].z, v[j].w);
                *(u32x2*)(hn + (size_t)row * DM + (F.lane + 64 * j) * 4) = o;
                const int c0 = (F.lane + 64 * j) * 4;
                const f32x4 w0 = ((const f32x4*)rgw)[c0], w1 = ((const f32x4*)rgw)[c0 + 1], w2 = ((const f32x4*)rgw)[c0 + 2], w3 = ((const f32x4*)rgw)[c0 + 3];
                lg[0] += v[j].x * w0.x + v[j].y * w1.x + v[j].z * w2.x + v[j].w * w3.x;
                lg[1] += v[j].x * w0.y + v[j].y * w1.y + v[j].z * w2.y + v[j].w * w3.y;
                lg[2] += v[j].x * w0.z + v[j].y * w1.z + v[j].z * w2.z + v[j].w * w3.z;
                lg[3] += v[j].x * w0.w + v[j].y * w1.w + v[j].z * w2.w + v[j].w * w3.w;
            }
#pragma unroll
            for (int o = 0; o < 4; ++o) lg[o] = wave_sum(lg[o], F.lane) + rgb[o];
            int gi = 0; float gm = lg[0];
#pragma unroll
            for (int o = 1; o < 4; ++o) if (lg[o] > gm) { gm = lg[o]; gi = o; }
            float gs = 0.f;
#pragma unroll
            for (int o = 0; o < 4; ++o) gs += __expf(lg[o] - gm);
            const float gval = 1.0f / gs;
            const float* we = rew + (size_t)gi * DM * 8;
            float le[8] = {0.f, 0.f, 0.f, 0.f, 0.f, 0.f, 0.f, 0.f};
#pragma unroll
            for (int j = 0; j < 4; ++j) {
                const int c0 = (F.lane + 64 * j) * 4;
                const float hv[4] = {v[j].x, v[j].y, v[j].z, v[j].w};
#pragma unroll
                for (int c = 0; c < 4; ++c) {
                    const f32x4 wa = ((const f32x4*)we)[(c0 + c) * 2], wb = ((const f32x4*)we)[(c0 + c) * 2 + 1];
                    le[0] += hv[c] * wa.x; le[1] += hv[c] * wa.y; le[2] += hv[c] * wa.z; le[3] += hv[c] * wa.w;
                    le[4] += hv[c] * wb.x; le[5] += hv[c] * wb.y; le[6] += hv[c] * wb.z; le[7] += hv[c] * wb.w;
                }
            }
#pragma unroll
            for (int e = 0; e < 8; ++e) le[e] = wave_sum(le[e], F.lane) + reb[gi * 8 + e];
            int e1 = 0; float m1 = le[0];
#pragma unroll
            for (int e = 1; e < 8; ++e) if (le[e] > m1) { m1 = le[e]; e1 = e; }
            int e2 = -1; float m2 = -3.0e38f;
#pragma unroll
            for (int e = 0; e < 8; ++e) if (e != e1 && le[e] > m2) { m2 = le[e]; e2 = e; }
            const float p2 = __expf(m2 - m1), inv = 1.0f / (1.0f + p2);
            if (F.lane == 0) {
                const unsigned ea = (unsigned)(gi * 8 + e1), eb = (unsigned)(gi * 8 + e2);
                const unsigned pa = __hip_atomic_fetch_add(cnt_l + ea, 1u, __ATOMIC_RELAXED, __HIP_MEMORY_SCOPE_WORKGROUP);
                const unsigned pb = __hip_atomic_fetch_add(cnt_l + eb, 1u, __ATOMIC_RELAXED, __HIP_MEMORY_SCOPE_WORKGROUP);
                LAS unsigned* en = ent + (F.wave * 16 + kk) * 6;
                en[0] = ea; en[1] = eb; en[2] = pa; en[3] = pb; en[4] = __float_as_uint(gval * inv); en[5] = __float_as_uint(gval * p2 * inv);
            }
        }
        __syncthreads();
        if (F.tid < 32) base_l[F.tid] = __hip_atomic_fetch_add(gcnt + F.tid * 64, cnt_l[F.tid], __ATOMIC_RELAXED, __HIP_MEMORY_SCOPE_AGENT);
        __syncthreads();
        if (F.tid < 128) {
            const LAS unsigned* en = ent + F.tid * 6; const unsigned tok = (unsigned)(row0 + F.tid);
            const unsigned ia = en[0] * LCAP + base_l[en[0]] + en[2], ib = en[1] * LCAP + base_l[en[1]] + en[3];
            list[ia] = tok * 2u; listw[ia] = __uint_as_float(en[4]);
            list[ib] = tok * 2u + 1u; listw[ib] = __uint_as_float(en[5]);
        }
        __syncthreads();
    }
}
__device__ __forceinline__ void build_expert_tab(const Frame& F, const unsigned* gcnt, LAS int* tab) {
    if (F.tid < 64) {
        const int c = F.lane < 32 ? (int)__hip_atomic_load(gcnt + F.lane * 64, __ATOMIC_RELAXED, __HIP_MEMORY_SCOPE_AGENT) : 0;
        int tiles = (c + 255) >> 8, incl = tiles;
#pragma unroll
        for (int o = 1; o < 32; o <<= 1) { const int t = __builtin_amdgcn_ds_bpermute((F.lane - o) << 2, incl); if (F.lane >= o) incl += t; }
        if (F.lane < 32) { tab[F.lane + 1] = incl; tab[33 + F.lane] = c; }
        if (F.lane == 0) tab[0] = 0;
    }
    __syncthreads();
}
__device__ __forceinline__ void ph_experts_naive(const Frame& F, const bf16* hn, const unsigned* route, const float* wg, const float* wu, const float* wd, float* x) {
    LAS float* hs = (LAS float*)F.lds;
    LAS float* hd = hs + 1024;
    for (int tok = F.blk; tok < T; tok += F.G) {
        { const unsigned pv = *(const unsigned*)(hn + (size_t)tok * DM + F.tid * 2); hs[F.tid * 2] = __uint_as_float(pv << 16); hs[F.tid * 2 + 1] = __uint_as_float(pv & 0xffff0000u); }
        const u32x4 rt = *(const u32x4*)(route + (size_t)tok * 4);
        __syncthreads();
        {
            const int s = F.tid >> 8, f = F.tid & 255;
            const unsigned e = s ? rt.y : rt.x; const float w = __uint_as_float(s ? rt.w : rt.z);
            const float* pg = wg + (size_t)e * DM * 256 + f; const float* pu = wu + (size_t)e * DM * 256 + f;
            float ga = 0.f, ua = 0.f;
            for (int d = 0; d < DM; ++d) { const float hv = hs[d]; ga += hv * pg[(size_t)d * 256]; ua += hv * pu[(size_t)d * 256]; }
            hd[s * 256 + f] = ga * sigmoidf_(ga) * ua * w;
        }
        __syncthreads();
        for (int dd = F.tid; dd < DM; dd += NTHR) {
            float acc = 0.f;
            const float* p0 = wd + (size_t)rt.x * 256 * DM + dd; const float* p1 = wd + (size_t)rt.y * 256 * DM + dd;
            for (int f = 0; f < 256; ++f) acc += hd[f] * p0[(size_t)f * DM];
            for (int f = 0; f < 256; ++f) acc += hd[256 + f] * p1[(size_t)f * DM];
            x[(size_t)tok * DM + dd] += acc;
        }
        __syncthreads();
    }
}


namespace nsa {
typedef short bf16x8 __attribute__((ext_vector_type(8)));
typedef short s16x4 __attribute__((ext_vector_type(4)));
typedef float f32x16 __attribute__((ext_vector_type(16)));
typedef float f32x2_t __attribute__((ext_vector_type(2)));
typedef __bf16 bf16x2_t __attribute__((ext_vector_type(2)));
constexpr int SLOTB = 8192;
constexpr int L_K = 0, L_V = 3 * SLOTB, L_IMP = 6 * SLOTB, L_BT = L_IMP + 65536, L_WS = L_BT + 4 * 132 * 4, L_RL = L_WS + 8 * 64 * 4, L_SM = L_RL + 4 * 64 * 4, L_END = L_SM + 64 * 8;
static_assert(L_END <= 131072, "nsa LDS map");
constexpr float LOG2E = 1.4426950408889634f;
constexpr float NEG_INF = -__builtin_inff();
#define NSA_SBAR() __builtin_amdgcn_sched_barrier(0)
__device__ __forceinline__ int crow(int r, int hi) { return (r & 3) + 8 * (r >> 2) + 4 * hi; }
__device__ __forceinline__ void glds16(const void* gsrc, unsigned lds_dst) { unsigned keep;
    asm volatile("s_mov_b32 %0, m0\n\ts_mov_b32 m0, %2\n\ts_nop 0\n\tglobal_load_lds_dwordx4 %1, off\n\ts_mov_b32 m0, %0" : "=&s"(keep) : "v"(gsrc), "s"(lds_dst) : "memory"); }
__device__ __forceinline__ unsigned cvtpk(float lo, float hi) { f32x2_t v = {lo, hi}; bf16x2_t b = __builtin_convertvector(v, bf16x2_t); return __builtin_bit_cast(unsigned, b); }
#define NSA_WAIT_BAR(N) asm volatile("s_waitcnt vmcnt(" #N ") lgkmcnt(0)\n\ts_barrier" ::: "memory")
__device__ __forceinline__ void qkt(f32x16& p0, f32x16& p1, const LAS char* kb, const bf16x8 (&qr)[4], const f32x16& cinit) {
#pragma unroll
    for (int d0 = 0; d0 < 4; ++d0) {
        const bf16x8 b0 = *(const LAS bf16x8*)(kb + d0 * 2048);
        const bf16x8 b1 = *(const LAS bf16x8*)(kb + d0 * 2048 + 512);
        if (d0 == 0) { p0 = __builtin_amdgcn_mfma_f32_32x32x16_bf16(b0, qr[0], cinit, 0, 0, 0); p1 = __builtin_amdgcn_mfma_f32_32x32x16_bf16(b1, qr[0], cinit, 0, 0, 0); }
        else { p0 = __builtin_amdgcn_mfma_f32_32x32x16_bf16(b0, qr[d0], p0, 0, 0, 0); p1 = __builtin_amdgcn_mfma_f32_32x32x16_bf16(b1, qr[d0], p1, 0, 0, 0); }
    }
}
__device__ __forceinline__ void pv(f32x16 (&o)[2], int vb, bf16x8 pa0, bf16x8 pa1, bf16x8 pa2, bf16x8 pa3) {
#pragma unroll
    for (int d0 = 0; d0 < 2; ++d0) { s16x4 lo[4], hi[4];
#pragma unroll
        for (int ks = 0; ks < 4; ++ks) {
            asm volatile("ds_read_b64_tr_b16 %0,%1 offset:%c2" : "=&v"(lo[ks]) : "v"(vb), "i"(d0 * 4096 + ks * 1024) : "memory");
            asm volatile("ds_read_b64_tr_b16 %0,%1 offset:%c2" : "=&v"(hi[ks]) : "v"(vb), "i"(d0 * 4096 + ks * 1024 + 512) : "memory"); }
        asm volatile("s_waitcnt lgkmcnt(0)" ::: "memory"); NSA_SBAR();
#define NSA_PK(k) (bf16x8){lo[k][0], lo[k][1], lo[k][2], lo[k][3], hi[k][0], hi[k][1], hi[k][2], hi[k][3]}
        o[d0] = __builtin_amdgcn_mfma_f32_32x32x16_bf16(pa0, NSA_PK(0), o[d0], 0, 0, 0);
        o[d0] = __builtin_amdgcn_mfma_f32_32x32x16_bf16(pa1, NSA_PK(1), o[d0], 0, 0, 0);
        o[d0] = __builtin_amdgcn_mfma_f32_32x32x16_bf16(pa2, NSA_PK(2), o[d0], 0, 0, 0);
        o[d0] = __builtin_amdgcn_mfma_f32_32x32x16_bf16(pa3, NSA_PK(3), o[d0], 0, 0, 0);
#undef NSA_PK
    }
}
__device__ __forceinline__ float other_half(float v, int hi) { auto rr = __builtin_amdgcn_permlane32_swap(__float_as_uint(v), __float_as_uint(v), false, false); return __uint_as_float(hi ? rr[0] : rr[1]); }
__device__ __forceinline__ float rowmax(const f32x16& p0, const f32x16& p1, int hi) {
    float a = fmaxf(fmaxf(p0[0], p0[1]), p1[0]), b = fmaxf(fmaxf(p0[2], p0[3]), p1[1]); a = fmaxf(fmaxf(a, p1[2]), p1[3]);
#pragma unroll
    for (int r = 4; r < 16; r += 4) { a = fmaxf(fmaxf(a, p0[r]), p0[r + 1]); b = fmaxf(fmaxf(b, p0[r + 2]), p0[r + 3]); a = fmaxf(fmaxf(a, p1[r]), p1[r + 1]); b = fmaxf(fmaxf(b, p1[r + 2]), p1[r + 3]); }
    const float m = fmaxf(a, b);
    return fmaxf(m, other_half(m, hi));
}
__device__ __forceinline__ void pack_p(const f32x16& p0, const f32x16& p1, bf16x8& a0, bf16x8& a1, bf16x8& a2, bf16x8& a3) {
    u32x4 w0, w1, w2, w3;
    w0 = (u32x4){cvtpk(p0[0], p0[1]), cvtpk(p0[2], p0[3]), cvtpk(p0[4], p0[5]), cvtpk(p0[6], p0[7])};
    w1 = (u32x4){cvtpk(p0[8], p0[9]), cvtpk(p0[10], p0[11]), cvtpk(p0[12], p0[13]), cvtpk(p0[14], p0[15])};
    w2 = (u32x4){cvtpk(p1[0], p1[1]), cvtpk(p1[2], p1[3]), cvtpk(p1[4], p1[5]), cvtpk(p1[6], p1[7])};
    w3 = (u32x4){cvtpk(p1[8], p1[9]), cvtpk(p1[10], p1[11]), cvtpk(p1[12], p1[13]), cvtpk(p1[14], p1[15])};
    a0 = __builtin_bit_cast(bf16x8, w0); a1 = __builtin_bit_cast(bf16x8, w1); a2 = __builtin_bit_cast(bf16x8, w2); a3 = __builtin_bit_cast(bf16x8, w3);
}

struct Ctx {
    LAS char* lds; unsigned lds0; int wid, lane, r32, hi, g, th, qloc;
    const LAS float* bt;
    LAS float* wsf;
    const LAS float* wrow;
    int vb0;
    const LAS char* kb0;
};
__device__ __forceinline__ void dma_k(const Ctx& c, const bf16* kbase, int pitch, int slot) { glds16(kbase + (size_t)c.lane * pitch + c.wid * 8, (unsigned)__builtin_amdgcn_readfirstlane(c.lds0 + L_K + slot * SLOTB + c.wid * 1024)); }
__device__ __forceinline__ void dma_v(const Ctx& c, const bf16* vbase, int pitch, int slot) { glds16(vbase + (size_t)(16 * (c.wid & 3) + (c.lane >> 2)) * pitch + (c.wid >> 2) * 32 + (c.lane & 3) * 8, (unsigned)__builtin_amdgcn_readfirstlane(c.lds0 + L_V + slot * SLOTB + c.wid * 1024)); }

__device__ __forceinline__ void cmp_scores(const Ctx& c, int slot, const bf16x8 (&qr)[4], int t0, int kt, f32x16& p0, f32x16& p1) {
    const int dmin = t0 + 32 * c.th - 16 * (64 * kt + 63) - 31;
    const bool special = dmin < 113;
    f32x16 ci; { const float v = special ? 0.f : c.bt[128];
#pragma unroll
        for (int r = 0; r < 16; ++r) ci[r] = v; }
    qkt(p0, p1, c.kb0 + slot * SLOTB, qr, ci);
    if (special) {
        int hi64 = 64 * c.hi; asm volatile("" : "+v"(hi64));
        const int dqh = t0 + c.qloc - 1024 * kt - 31 - hi64;
#pragma unroll
        for (int r = 0; r < 16; ++r) {
            const int d0 = dqh - 16 * ((r & 3) + 8 * (r >> 2)), d1 = d0 - 512;
            const float b0 = c.bt[d0 < 0 ? 0 : (d0 > 128 ? 128 : d0)], b1 = c.bt[d1 < 0 ? 0 : (d1 > 128 ? 128 : d1)];
            p0[r] = d0 < 0 ? NEG_INF : p0[r] + b0; p1[r] = d1 < 0 ? NEG_INF : p1[r] + b1;
        }
    }
}
template <int MODE>
__device__ __forceinline__ void online_tile(const Ctx& c, int slot, const bf16x8 (&qr)[4], int dq, bool near, bool masked_tile, bool lane_off, float& mhat, float& lsum, f32x16 (&o)[2]) {
    f32x16 ci; { const float v = (near ? 0.f : c.bt[128]) - mhat;
#pragma unroll
        for (int r = 0; r < 16; ++r) ci[r] = v; }
    f32x16 p0, p1;
    qkt(p0, p1, c.kb0 + slot * SLOTB, qr, ci);
    if (near || masked_tile) {
        int hi4 = 4 * c.hi; asm volatile("" : "+v"(hi4));
        const int dqh = dq - hi4;
#pragma unroll
        for (int r = 0; r < 16; ++r) {
            const int d0 = dqh - ((r & 3) + 8 * (r >> 2)), d1 = d0 - 32;
            if (near) { p0[r] += c.bt[d0 < 0 ? 0 : (d0 > 128 ? 128 : d0)]; p1[r] += c.bt[d1 < 0 ? 0 : (d1 > 128 ? 128 : d1)]; }
            if (d0 < 0 || (MODE == 1 && d0 >= 512)) p0[r] = NEG_INF;
            if (d1 < 0 || (MODE == 1 && d1 >= 512)) p1[r] = NEG_INF;
        }
    }
    if (MODE == 0) { if (lane_off) {
#pragma unroll
        for (int r = 0; r < 16; ++r) { p0[r] = NEG_INF; p1[r] = NEG_INF; } } }
    const float rm = rowmax(p0, p1, c.hi);
    if (__any(rm > 8.0f)) {
        const float dl = fmaxf(rm, 0.f); mhat += dl;
#pragma unroll
        for (int r = 0; r < 16; ++r) { p0[r] -= dl; p1[r] -= dl; }
        const float f = __builtin_amdgcn_exp2f(-dl); lsum *= f;
        if (c.hi == 0) c.wsf[c.r32] = f;
        asm volatile("s_waitcnt lgkmcnt(0)" ::: "memory");
#pragma unroll
        for (int r = 0; r < 16; ++r) { const float fr = c.wrow[(r & 3) + 8 * (r >> 2)]; o[0][r] *= fr; o[1][r] *= fr; }
    }
    float sacc = 0.f;
#pragma unroll
    for (int r = 0; r < 16; ++r) { p0[r] = __builtin_amdgcn_exp2f(p0[r]); p1[r] = __builtin_amdgcn_exp2f(p1[r]); sacc += p0[r] + p1[r]; }
    lsum += sacc;
    bf16x8 a0, a1, a2, a3; pack_p(p0, p1, a0, a1, a2, a3);
    pv(o, c.vb0 + slot * SLOTB, a0, a1, a2, a3);
}
__device__ __forceinline__ void add_scaled(const Ctx& c, f32x16 (&oacc)[2], const f32x16 (&o)[2], float s) {
    if (c.hi == 0) c.wsf[32 + c.r32] = s;
    asm volatile("s_waitcnt lgkmcnt(0)" ::: "memory");
#pragma unroll
    for (int r = 0; r < 16; ++r) { const float f = c.wrow[32 + (r & 3) + 8 * (r >> 2)]; oacc[0][r] += o[0][r] * f; oacc[1][r] += o[1][r] * f; }
    asm volatile("s_waitcnt lgkmcnt(0)" ::: "memory");
}

__device__ __forceinline__ void unit(LAS char* lds, int tid, int b, int hkv, int jt, const bf16* Z, const bf16* KCm, const bf16* VCm, const float* rel_bias, bf16* YC) {
    Ctx c; c.lds = lds; c.lds0 = (unsigned)(uintptr_t)lds; c.wid = __builtin_amdgcn_readfirstlane(tid >> 6); c.lane = tid & 63; c.r32 = c.lane & 31; c.hi = c.lane >> 5;
    c.g = c.wid & 3; c.th = c.wid >> 2; c.qloc = 32 * c.th + c.r32;
    c.bt = (const LAS float*)(lds + L_BT) + c.g * 132; c.wsf = (LAS float*)(lds + L_WS) + c.wid * 64; c.wrow = c.wsf + 4 * c.hi;
    c.vb0 = (int)(c.lds0 + L_V) + ((c.lane >> 4) & 1) * 32 + (c.lane & 3) * 8 + (4 * c.hi + ((c.lane & 15) >> 2)) * 64;
    c.kb0 = (const LAS char*)(lds + L_K) + c.hi * 1024 + c.r32 * 16;
    const int t0 = 64 * jt;
    const bf16* Zb = Z + (size_t)b * SEQ * ZP;
    const size_t qrow = (size_t)b * SEQ + t0 + c.qloc;
    for (int i = tid; i < 4 * 129; i += NTHR) { const int gg = i / 129, d = i % 129; ((LAS float*)(lds + L_BT))[gg * 132 + d] = rel_bias[t5_bucket(d) * 8 + hkv * 4 + gg] * LOG2E; }
    bf16x8 qr[4];
#pragma unroll
    for (int d0 = 0; d0 < 4; ++d0) qr[d0] = *(const bf16x8*)(Z + qrow * ZP + ZC_Q + hkv * 256 + c.g * 64 + d0 * 16 + c.hi * 8);
    const bf16* gp = Z + qrow * ZP + ZC_G + hkv * 12 + c.g * 3;
    const float gate0 = sigmoidf_(bf2f(gp[0])), gate1 = sigmoidf_(bf2f(gp[1])), gate2 = sigmoidf_(bf2f(gp[2]));
    f32x16 oacc[2];
#pragma unroll
    for (int r = 0; r < 16; ++r) { oacc[0][r] = 0.f; oacc[1][r] = 0.f; }

    const int nct = (4 * jt + 2) / 64 + 1;
    const bf16* kcb = KCm + (size_t)b * NCMPP * 128 + hkv * 64; const bf16* vcb = VCm + (size_t)b * NCMPP * 128 + hkv * 64;
    float mrow = NEG_INF;
    {
        dma_k(c, kcb, 128, 0); if (nct > 1) dma_k(c, kcb + 64 * 128, 128, 1);
        for (int i = 0; i < nct; ++i) {
            if (i + 1 < nct) NSA_WAIT_BAR(1); else NSA_WAIT_BAR(0);
            if (i + 2 < nct) dma_k(c, kcb + (size_t)(i + 2) * 64 * 128, 128, (i + 2) % 3);
            f32x16 p0, p1; cmp_scores(c, i % 3, qr, t0, i, p0, p1);
            mrow = fmaxf(mrow, rowmax(p0, p1, c.hi));
        }
        NSA_WAIT_BAR(0);
    }
    {
        const float muse = mrow == NEG_INF ? 0.f : mrow;
        float lsum = 0.f, carry = 0.f; f32x16 o[2];
#pragma unroll
        for (int r = 0; r < 16; ++r) { o[0][r] = 0.f; o[1][r] = 0.f; }
        LAS float* impw = (LAS float*)(lds + L_IMP) + (c.g * 64 + c.qloc) * 64;
        dma_k(c, kcb, 128, 0); dma_v(c, vcb, 128, 0); if (nct > 1) { dma_k(c, kcb + 64 * 128, 128, 1); dma_v(c, vcb + 64 * 128, 128, 1); }
        for (int i = 0; i < nct; ++i) {
            if (i + 1 < nct) NSA_WAIT_BAR(2); else NSA_WAIT_BAR(0);
            if (i + 2 < nct) { dma_k(c, kcb + (size_t)(i + 2) * 64 * 128, 128, (i + 2) % 3); dma_v(c, vcb + (size_t)(i + 2) * 64 * 128, 128, (i + 2) % 3); }
            f32x16 p0, p1; cmp_scores(c, i % 3, qr, t0, i, p0, p1);
            float sacc = 0.f;
#pragma unroll
            for (int r = 0; r < 16; ++r) { p0[r] = __builtin_amdgcn_exp2f(p0[r] - muse); p1[r] = __builtin_amdgcn_exp2f(p1[r] - muse); sacc += p0[r] + p1[r]; }
            lsum += sacc;
            float o3[8];
#pragma unroll
            for (int k = 0; k < 4; ++k) { o3[k] = other_half(p0[4 * k + 3], c.hi); o3[4 + k] = other_half(p1[4 * k + 3], c.hi); }
#pragma unroll
            for (int idx = 0; idx < 8; ++idx) {
                const int X = idx >> 2, k = idx & 3;
                const f32x16& p = X ? p1 : p0;
                const float cin = c.hi ? o3[idx] : (idx ? o3[idx - 1] : carry);
                impw[16 * i + 8 * X + 2 * k + c.hi] = p[4 * k] + p[4 * k + 1] + p[4 * k + 2] + 0.5f * p[4 * k + 3] + 0.5f * cin;
            }
            carry = o3[7];
            bf16x8 a0, a1, a2, a3; pack_p(p0, p1, a0, a1, a2, a3);
            pv(o, c.vb0 + (i % 3) * SLOTB, a0, a1, a2, a3);
        }
        const float lt = lsum + other_half(lsum, c.hi);
        const float rl = lt > 0.f ? 1.0f / lt : 0.f;
        if (c.hi == 0) ((LAS float*)(lds + L_RL))[c.g * 64 + c.qloc] = rl;
        add_scaled(c, oacc, o, rl * gate0);
        NSA_WAIT_BAR(0);
    }
    for (int k = 0; k < 8; ++k) {
        const int tok = c.wid * 8 + k;
        float v = 0.f;
#pragma unroll
        for (int gg = 0; gg < 4; ++gg) v += ((const LAS float*)(lds + L_IMP))[(gg * 64 + tok) * 64 + c.lane] * ((const LAS float*)(lds + L_RL))[gg * 64 + tok];
        const bool forced = (c.lane == 0) || (c.lane <= jt && c.lane > jt - 2), future = c.lane > jt;
        v = forced ? 1e9f : (future ? -1e9f : v);
        int rank = 0;
        for (int jj = 0; jj < 64; ++jj) { const float vj = lane_bcast(v, jj); rank += ((vj > v) || (vj == v && jj < c.lane)) ? 1 : 0; }
        const unsigned long long msk = __ballot(rank < 16 && !future);
        if (c.lane == 0) ((LAS unsigned long long*)(lds + L_SM))[tok] = msk;
    }
    NSA_WAIT_BAR(0);
    const unsigned long long mymask = ((const LAS unsigned long long*)(lds + L_SM))[c.qloc];
    {
        const bf16* kb = Zb + ZC_KV + 256 + hkv * 64; const bf16* vb = Zb + ZC_KV + 384 + hkv * 64;
        const int nt = jt + 1;
        float mhat = 0.f, lsum = 0.f; f32x16 o[2];
#pragma unroll
        for (int r = 0; r < 16; ++r) { o[0][r] = 0.f; o[1][r] = 0.f; }
        dma_k(c, kb, ZP, 0); dma_v(c, vb, ZP, 0); if (nt > 1) { dma_k(c, kb + (size_t)64 * ZP, ZP, 1); dma_v(c, vb + (size_t)64 * ZP, ZP, 1); }
        for (int i = 0; i < nt; ++i) {
            if (i + 1 < nt) NSA_WAIT_BAR(2); else NSA_WAIT_BAR(0);
            if (i + 2 < nt) { dma_k(c, kb + (size_t)(i + 2) * 64 * ZP, ZP, (i + 2) % 3); dma_v(c, vb + (size_t)(i + 2) * 64 * ZP, ZP, (i + 2) % 3); }
            online_tile<0>(c, i % 3, qr, 64 * (jt - i) + c.qloc, i >= jt - 2, i == jt, !((mymask >> i) & 1ull), mhat, lsum, o);
        }
        const float lt = lsum + other_half(lsum, c.hi);
        add_scaled(c, oacc, o, (lt > 0.f ? 1.0f / lt : 0.f) * gate1);
        NSA_WAIT_BAR(0);
    }
    {
        const int j0 = jt > 8 ? jt - 8 : 0, nt = jt - j0 + 1;
        const bf16* kb = Zb + (size_t)j0 * 64 * ZP + ZC_KV + 512 + hkv * 64; const bf16* vb = Zb + (size_t)j0 * 64 * ZP + ZC_KV + 640 + hkv * 64;
        float mhat = 0.f, lsum = 0.f; f32x16 o[2];
#pragma unroll
        for (int r = 0; r < 16; ++r) { o[0][r] = 0.f; o[1][r] = 0.f; }
        dma_k(c, kb, ZP, 0); dma_v(c, vb, ZP, 0); if (nt > 1) { dma_k(c, kb + (size_t)64 * ZP, ZP, 1); dma_v(c, vb + (size_t)64 * ZP, ZP, 1); }
        for (int i = 0; i < nt; ++i) {
            if (i + 1 < nt) NSA_WAIT_BAR(2); else NSA_WAIT_BAR(0);
            if (i + 2 < nt) { dma_k(c, kb + (size_t)(i + 2) * 64 * ZP, ZP, (i + 2) % 3); dma_v(c, vb + (size_t)(i + 2) * 64 * ZP, ZP, (i + 2) % 3); }
            const int j = j0 + i;
            online_tile<1>(c, i % 3, qr, 64 * (jt - j) + c.qloc, j >= jt - 2, j == jt || j == jt - 8, false, mhat, lsum, o);
        }
        const float lt = lsum + other_half(lsum, c.hi);
        add_scaled(c, oacc, o, (lt > 0.f ? 1.0f / lt : 0.f) * gate2);
    }
    {
        bf16* yb = YC + ((size_t)b * SEQ + t0 + 32 * c.th + 4 * c.hi) * DM + D_SSM + hkv * 256 + c.g * 64 + c.r32;
#pragma unroll
        for (int r = 0; r < 16; ++r) { bf16* yr = yb + (size_t)((r & 3) + 8 * (r >> 2)) * DM; yr[0] = (bf16)f2bf(oacc[0][r]); yr[32] = (bf16)f2bf(oacc[1][r]); }
    }
    asm volatile("s_waitcnt vmcnt(0)" ::: "memory");
    NSA_WAIT_BAR(0);
}
#undef NSA_SBAR
#undef NSA_WAIT_BAR
}

__device__ __forceinline__ void transpose_item(const float* W, int K, int N, bf16* WT, int k0, int n0, int drow0, LAS float* scr, int lane, float scale = 1.0f) {
#pragma unroll 8
    for (int i = 0; i < 32; ++i) { const int kk = 2 * i + (lane >> 5); scr[kk * 33 + (lane & 31)] = W[(size_t)(k0 + kk) * N + n0 + (lane & 31)]; }
    asm volatile("s_waitcnt lgkmcnt(0)" ::: "memory");
    const int c = lane & 7;
#pragma unroll
    for (int j = 0; j < 4; ++j) { const int n = (lane >> 3) + 8 * j; const LAS float* sp = scr + (8 * c) * 33 + n;
        u32x4 o; o.x = pk2(sp[0 * 33] * scale, sp[1 * 33] * scale); o.y = pk2(sp[2 * 33] * scale, sp[3 * 33] * scale); o.z = pk2(sp[4 * 33] * scale, sp[5 * 33] * scale); o.w = pk2(sp[6 * 33] * scale, sp[7 * 33] * scale);
        *(u32x4*)(WT + (size_t)(drow0 + n) * K + k0 + 8 * c) = o; }
    asm volatile("s_waitcnt lgkmcnt(0)" ::: "memory");
}
__device__ __forceinline__ void ph_convert(const Frame& F, const __attribute__((address_space(4))) Args* args, unsigned char* ws) {
    LAS float* scr = (LAS float*)(F.lds + F.wave * 16384);
    const int gw = F.blk * NWAVES + F.wave, NGW = F.G * NWAVES;
    constexpr int I_IN = (DM / 64) * (1792 / 32), I_GLU = (D_SSM / 64) * (2 * D_SSM / 32), I_OUT = (DM / 64) * (DM / 32);
    constexpr int PER_LAYER = I_IN + I_GLU + I_OUT;
    for (int it = gw; it < DEPTH * 32 * 384; it += NGW) {
        const int le = it / 384, r = it % 384;
        if (r < 256) { const int isup = r >> 7, q = r & 127, nb = q & 7, kb = q >> 3, n0 = 32 * nb;
            transpose_item(args->in[isup ? 24 : 23] + (size_t)le * DM * 256, DM, 256, (bf16*)(ws + WS_WGU) + (size_t)le * 512 * DM, 64 * kb, n0, 256 * (n0 >> 7) + 128 * isup + (n0 & 127), scr, F.lane); }
        else { const int q = r - 256, nb = q & 31, kb = q >> 5;
            transpose_item(args->in[25] + (size_t)le * 256 * DM, 256, DM, (bf16*)(ws + WS_WDN) + (size_t)le * DM * 256, 64 * kb, 32 * nb, 32 * nb, scr, F.lane); }
    }
    for (int it = gw; it < DEPTH * PER_LAYER; it += NGW) {
        const int layer = it / PER_LAYER; int r = it % PER_LAYER;
        if (r < I_IN) { const int nb = r % 56, kb = r / 56;
            transpose_item(args->in[4] + (size_t)layer * DM * D_IN, DM, D_IN, (bf16*)(ws + WS_WIN) + (size_t)layer * ZP * DM, 64 * kb, 32 * nb, 32 * nb, scr, F.lane, (nb >= 16 && nb < 32) ? QSCALE : 1.0f); continue; }
        r -= I_IN;
        if (r < I_GLU) { const int nb = r % 32, kb = r / 32, n0 = 32 * nb;
            const int half = n0 >> 9, c = n0 & 511, drow = 256 * (c >> 7) + 128 * half + (c & 127);
            transpose_item(args->in[14] + (size_t)layer * D_SSM * 2 * D_SSM, D_SSM, 2 * D_SSM, (bf16*)(ws + WS_WGLU) + (size_t)layer * 2 * D_SSM * D_SSM, 64 * kb, n0, drow, scr, F.lane); continue; }
        r -= I_GLU;
        { const int nb = r % 32, kb = r / 32;
            transpose_item(args->in[5] + (size_t)layer * DM * DM, DM, DM, (bf16*)(ws + WS_WOUT) + (size_t)layer * DM * DM, 64 * kb, 32 * nb, 32 * nb, scr, F.lane); }
    }
    const int gt = F.blk * NTHR + F.tid, NGT = F.G * NTHR;
    for (int idx = gt; idx < DEPTH * 256 * DM; idx += NGT) {
        const int layer = idx / (256 * DM), rem = idx % (256 * DM), n = 1792 + rem / DM, k = rem % DM;
        const float v = n < D_IN ? args->in[4][(size_t)layer * DM * D_IN + (size_t)k * D_IN + n] : 0.f;
        ((bf16*)(ws + WS_WIN))[(size_t)layer * ZP * DM + (size_t)n * DM + k] = (bf16)f2bf(v);
    }
}

constexpr int PH_PER_LAYER = 8, N_PHASES = 1 + DEPTH * PH_PER_LAYER + 1;
#ifndef FAST_GEMM
#define FAST_GEMM 1
#endif

__global__ void __launch_bounds__(NTHR, 2) fwd(Args args) {
    extern __shared__ __attribute__((aligned(16))) unsigned char lds_raw[];
    Frame F;
    F.lds = (LAS unsigned char*)lds_raw;
    F.tid = threadIdx.x; F.lane = F.tid & 63; F.wave = __builtin_amdgcn_readfirstlane(F.tid >> 6);
    F.blk = blockIdx.x; F.G = gridDim.x;
    typedef const __attribute__((address_space(4))) Args* KArgs;
    KArgs kp = (KArgs)__builtin_amdgcn_kernarg_segment_ptr();
    asm volatile("" : "+s"(kp));
    unsigned char* ws = kp->ws;
    volatile LAS unsigned* MISC = (volatile LAS unsigned*)(F.lds + MISC_OFF);
    if (F.tid < 32) MISC[F.tid] = 0u;
    __syncthreads();
    XcdBarrier bar; bar.bar = (unsigned*)(ws + WS_CTL) + CW_BAR; bar.x = 0; bar.st = nullptr;
    if (N_LAUNCH_MODE == 1) bar = xcd_barrier_post((unsigned*)(ws + WS_CTL) + CW_BAR, MISC + 8);
#define IN(k) (kp->ph_lo <= (k) && (k) < kp->ph_hi)
#define FRESH_IDS() do { int l_; asm volatile("v_mbcnt_lo_u32_b32 %0, -1, 0\n\tv_mbcnt_hi_u32_b32 %0, -1, %0" : "=v"(l_)); asm volatile("" : "+s"(F.wave), "+s"(F.blk), "+s"(F.G)); F.lane = l_; F.tid = F.wave * 64 + l_; asm volatile("" : "+s"(kp)); ws = kp->ws; bar.bar = (unsigned*)(ws + WS_CTL) + CW_BAR; } while (0)
#define SEAM(k) do { FRESH_IDS(); if (IN(k) && IN((k) + 1)) xcd_barrier(bar, F.tid); FRESH_IDS(); } while (0)

    const float* x0 = kp->in[0];
    float* XR = kp->out;
#define HN ((bf16*)(ws + WS_HN))
#define Z ((bf16*)(ws + WS_Z))
#define YC ((bf16*)(ws + WS_YC))
#define G1 ((bf16*)(ws + WS_G1))
#define KC ((bf16*)(ws + WS_KC))
#define VC ((bf16*)(ws + WS_VC))
#define LIST ((unsigned*)(ws + WS_LIST))
#define LISTW ((float*)(ws + WS_LISTW))
#define HID ((bf16*)(ws + WS_HID))
#define P2 ((float*)(ws + WS_P2))
    LAS int* etab = (LAS int*)(F.lds + 131072);

    if (IN(0)) ph_convert(F, kp, ws);
    SEAM(0);
    for (int layer = 0; layer < DEPTH; ++layer) {
        const int pb = 1 + layer * PH_PER_LAYER;
        const float* xin = layer == 0 ? x0 : XR;
        unsigned* gcnt = (unsigned*)(ws + WS_CTL) + CW_CNT + layer * 32 * 64;
        if (IN(pb + 0)) ph_norm(F, xin, layer == 0 ? nullptr : P2, XR, kp->in[1] + layer * DM, HN);
        SEAM(pb + 0);
        if (IN(pb + 1)) {
            pg8::Gemm g{HN, (const bf16*)(ws + WS_WIN) + (size_t)layer * ZP * DM, T, ZP, DM, DM, 0, nullptr, 0}; pg8::StaticOrder S; S.init(T, ZP, F.G, F.blk);
            pg8::EpiBf16<0> E{Z, ZP, nullptr, 0, 0, 1.f};
            pg8::gemm2<pg8::EpiBf16<0>, pg8::StaticOrder, false>(F.lds, g, S, E, F.tid);
        }
        SEAM(pb + 1);
        if (IN(pb + 2)) {
            if (F.wave == 0) {
                for (int it = F.blk; it < BATCH * NGRP; it += F.G)
                    ssm_naive_item(it / NGRP, it % NGRP, kp->in[6] + layer * NGRP * SST, kp->in[7] + layer * NGRP * SST, kp->in[8] + (size_t)layer * NGRP * SST * SGRP, kp->in[9] + (size_t)layer * NGRP * SST * SGRP,
                                   kp->in[10] + (size_t)layer * NGRP * SGRP * SST, kp->in[11] + (size_t)layer * NGRP * SGRP * SST, kp->in[12] + layer * NGRP * SGRP, kp->in[13] + layer * NGRP, Z, G1, F.lane);
            } else {
                for (int it = F.blk * 7 + (F.wave - 1); it < BATCH * NCMPP * 4; it += F.G * 7)
                    compress_naive_item(it, Z, kp->in[15] + (size_t)layer * 2 * 32 * 64, kp->in[16] + (size_t)layer * 2 * 32 * 64 * 64, kp->in[17] + (size_t)layer * 2 * 64 * 64, KC, VC, F.lane);
            }
        }
        SEAM(pb + 2);
        if (IN(pb + 3)) {
            { pg8::Gemm g{G1, (const bf16*)(ws + WS_WGLU) + (size_t)layer * 2 * D_SSM * D_SSM, T, 2 * D_SSM, D_SSM, D_SSM, 0, nullptr, 0}; pg8::StaticOrder S; S.init(T, 2 * D_SSM, F.G, F.blk);
              pg8::EpiGlu E{YC, DM};
              pg8::gemm2<pg8::EpiGlu, pg8::StaticOrder, false>(F.lds, g, S, E, F.tid); }
            __syncthreads();
            for (int slot = F.blk; slot < 256; slot += F.G) {
                const int bh = slot >> 4, sq = slot & 15;
#pragma unroll 1
                for (int uq = 0; uq < 4; ++uq) { const int jt = uq == 0 ? 63 - sq : (uq == 1 ? 32 + sq : (uq == 2 ? 31 - sq : sq));
                    nsa::unit((LAS char*)F.lds, F.tid, bh >> 1, bh & 1, jt, Z, KC, VC, kp->in[18], YC); }
            }
        }
        SEAM(pb + 3);
        if (IN(pb + 4)) {
            pg8::Gemm g{YC, (const bf16*)(ws + WS_WOUT) + (size_t)layer * DM * DM, T, DM, DM, DM, 0, nullptr, 0}; pg8::StaticOrder S; S.init(T, DM, F.G, F.blk);
            pg8::EpiResid E{xin, XR, DM};
            pg8::gemm2<pg8::EpiResid, pg8::StaticOrder, false>(F.lds, g, S, E, F.tid);
        }
        SEAM(pb + 4);
        if (IN(pb + 5)) ph_norm_route(F, XR, kp->in[2] + layer * DM, kp->in[19] + (size_t)layer * DM * 4, kp->in[20] + layer * 4, kp->in[21] + (size_t)layer * 4 * DM * 8, kp->in[22] + layer * 32, HN, gcnt, LIST, LISTW);
        SEAM(pb + 5);
        if (IN(pb + 6)) {
            build_expert_tab(F, gcnt, etab);
            pg8::Gemm g{HN, (const bf16*)(ws + WS_WGU) + (size_t)layer * 32 * 512 * DM, 0, 512, DM, DM, (size_t)512 * DM, LIST, LCAP};
            pg8::ExpertOrder S{etab, 2, F.G, F.blk};
            pg8::EpiGateUp E{HID, LISTW, LCAP};
            pg8::gemm2<pg8::EpiGateUp, pg8::ExpertOrder, true>(F.lds, g, S, E, F.tid);
        }
        SEAM(pb + 6);
        if (IN(pb + 7)) {
            build_expert_tab(F, gcnt, etab);
            pg8::Gemm g{HID, (const bf16*)(ws + WS_WDN) + (size_t)layer * 32 * DM * 256, 0, DM, 256, 256, (size_t)DM * 256, nullptr, 0};
            pg8::ExpertOrder S{etab, 4, F.G, F.blk};
            pg8::EpiDown E{XR, P2, LIST, LCAP};
            pg8::gemm2<pg8::EpiDown, pg8::ExpertOrder, false>(F.lds, g, S, E, F.tid);
        }
        SEAM(pb + 7);
    }
    if (IN(N_PHASES - 1)) ph_final_norm(F, XR, P2, kp->in[3]);
#undef IN
#undef SEAM
#undef HN
#undef Z
#undef YC
#undef G1
#undef KC
#undef VC
#undef LIST
#undef LISTW
#undef HID
#undef P2
}

extern "C" void kernel_launch(void* const* d_in, const int* in_sizes, int n_in, void* d_out, int out_size, void* d_ws, size_t ws_size, hipStream_t stream) {
    static int grid = 0;
    if (grid == 0) {
        if (n_in != 26 || out_size != T * DM || ws_size < WS_END) { fprintf(stderr, "kernel_launch: unexpected shapes (n_in %d out %d ws %zu)\n", n_in, out_size, ws_size); grid = -1; return; }
        int dev = 0, cus = 0, per_cu = 0;
        if (hipGetDevice(&dev) != hipSuccess || hipDeviceGetAttribute(&cus, hipDeviceAttributeMultiprocessorCount, dev) != hipSuccess) { grid = -1; return; }
        if (hipFuncSetAttribute((const void*)fwd, hipFuncAttributeMaxDynamicSharedMemorySize, LDS_BYTES) != hipSuccess) { fprintf(stderr, "kernel_launch: hipFuncSetAttribute failed\n"); grid = -1; return; }
        if (hipOccupancyMaxActiveBlocksPerMultiprocessor(&per_cu, (const void*)fwd, NTHR, LDS_BYTES) != hipSuccess || per_cu < 1) fprintf(stderr, "kernel_launch: occupancy query says %d\n", per_cu);
        (void)hipGetLastError();
        grid = cus;
    }
    if (grid < 0) return;
    (void)hipMemsetAsync((char*)d_ws + WS_CTL, 0, CTL_ZERO_BYTES, stream);
    Args a{};
    for (int i = 0; i < 26; ++i) a.in[i] = (const float*)d_in[i];
    a.out = (float*)d_out; a.ws = (unsigned char*)d_ws;
    if (N_LAUNCH_MODE == 1) {
        a.ph_lo = 0; a.ph_hi = N_PHASES;
        hipLaunchKernelGGL(fwd, dim3(grid), dim3(NTHR), LDS_BYTES, stream, a);
    } else {
        for (int p = 0; p < N_PHASES; ++p) { a.ph_lo = p; a.ph_hi = p + 1; hipLaunchKernelGGL(fwd, dim3(grid), dim3(NTHR), LDS_BYTES, stream, a); }
    }
}
```

```cpp
#include <hip/hip_runtime.h>
#include <cstdio>
#include <cstdint>

#ifndef N_LAUNCH_MODE
#define N_LAUNCH_MODE 1
#endif

#define GAS __attribute__((address_space(1)))
#define LAS __attribute__((address_space(3)))
typedef unsigned short bf16;
typedef float f32x4 __attribute__((ext_vector_type(4)));
typedef unsigned u32x4 __attribute__((ext_vector_type(4)));
typedef unsigned u32x2 __attribute__((ext_vector_type(2)));

constexpr int BATCH = 8, SEQ = 4096, DM = 1024, T = BATCH * SEQ, DEPTH = 2;
constexpr int D_SSM = 512, NGRP = 32, SGRP = 16, SST = 64;
constexpr int D_IN = 1816, ZP = 2048;
constexpr int ZC_U = 0, ZC_Q = 512, ZC_KV = 1024, ZC_G = 1792;
constexpr int NCMP = 255, NCMPP = 256;
constexpr float EPS = 1e-6f;
constexpr int NWAVES = 8, NTHR = 512;
constexpr float QSCALE = 0.125f * 1.4426950408889634f;

constexpr size_t MiB = 1u << 20;
constexpr size_t WS_CTL = 0, CTL_ZERO_BYTES = 1 * MiB;
constexpr size_t WS_KC = 1 * MiB, WS_VC = 2 * MiB, WS_ROUTE = 3 * MiB;
constexpr size_t WS_HN = 16 * MiB;
constexpr size_t WS_Z = 80 * MiB;
constexpr size_t WS_YC = 208 * MiB;
constexpr size_t WS_G1 = 272 * MiB;
constexpr size_t WS_WIN = 304 * MiB;
constexpr size_t WS_WGLU = 312 * MiB;
constexpr size_t WS_WOUT = 314 * MiB;
constexpr size_t WS_WGU = 318 * MiB;
constexpr size_t WS_WDN = 382 * MiB;
constexpr size_t WS_LIST = 414 * MiB;
constexpr size_t WS_LISTW = 418 * MiB;
constexpr size_t WS_HID = 422 * MiB;
constexpr size_t WS_P2 = WS_Z;
constexpr size_t WS_USSM = WS_YC;
constexpr size_t WS_XL = WS_HID;
constexpr size_t WS_BT1 = 458 * MiB;
constexpr size_t WS_BT2 = 466 * MiB;
constexpr size_t WS_END = 478 * MiB;
constexpr int LCAP = 32768, CW_CNT = 8192;
constexpr int CW_BAR = 4096;

constexpr int LDS_BYTES = 147456;
constexpr int MISC_OFF = 131072 + 320;

__device__ __forceinline__ float bf2f(bf16 v) { return __uint_as_float(((unsigned)v) << 16); }
__device__ __forceinline__ unsigned f2bf(float f) { unsigned u = __float_as_uint(f); return (u + 0x7fffu + ((u >> 16) & 1u)) >> 16; }
__device__ __forceinline__ unsigned pk2(float lo, float hi) { return f2bf(lo) | (f2bf(hi) << 16); }
__device__ __forceinline__ float wave_sum(float v, int lane) {
#pragma unroll
    for (int o = 1; o < 64; o <<= 1) v += __int_as_float(__builtin_amdgcn_ds_bpermute((lane ^ o) << 2, __float_as_int(v)));
    return v;
}
__device__ __forceinline__ float wave_max(float v, int lane) {
#pragma unroll
    for (int o = 1; o < 64; o <<= 1) v = fmaxf(v, __int_as_float(__builtin_amdgcn_ds_bpermute((lane ^ o) << 2, __float_as_int(v))));
    return v;
}
__device__ __forceinline__ float lane_bcast(float v, int src) { return __int_as_float(__builtin_amdgcn_ds_bpermute(src << 2, __float_as_int(v))); }
__device__ __forceinline__ float gelu_tanh(float x) {
    const float u = 0.7978845608028654f * (x + 0.044715f * x * x * x);
    return 0.5f * x * (1.0f + tanhf(u));
}
__device__ __forceinline__ float sigmoidf_(float x) { return 1.0f / (1.0f + __expf(-x)); }
__device__ __forceinline__ int t5_bucket(int n) {
    if (n < 16) return n < 0 ? 0 : n;
    int b = 16;
    b += (n >= 19); b += (n >= 21); b += (n >= 24); b += (n >= 27); b += (n >= 31); b += (n >= 35); b += (n >= 40); b += (n >= 46);
    b += (n >= 52); b += (n >= 59); b += (n >= 67); b += (n >= 77); b += (n >= 87); b += (n >= 99); b += (n >= 113);
    return b;
}

#define XB_TMO      128
#define XB_XCNT(j)  (256  + 64 * (j))
#define XB_XSUB(j)  (1280 + 64 * (j))
#define XB_XGEN(j)  (2304 + 64 * (j))
#define XB_TOP      3328
#define XB_TOPGEN   3392
#define XCD_BAR_WORDS 3456
#define XB_SPIN_CAP (1u << 22)

__device__ __forceinline__ unsigned xb_ld(unsigned* p)              { return __hip_atomic_load(p, __ATOMIC_RELAXED, __HIP_MEMORY_SCOPE_AGENT); }
__device__ __forceinline__ unsigned xb_add(unsigned* p, unsigned v) { return __hip_atomic_fetch_add(p, v, __ATOMIC_RELAXED, __HIP_MEMORY_SCOPE_AGENT); }
__device__ __forceinline__ unsigned xb_xcc_id() { return (unsigned)__builtin_amdgcn_s_getreg((3 << 11) | 20) & 0xFu; }
#define XB_SPIN(cond, bar) do { unsigned _sp = 0; while (cond) { __builtin_amdgcn_s_sleep(1); \
    if ((++_sp & 255u) == 0u) { if (xb_ld(&(bar)[XB_TMO])) break; if (_sp > XB_SPIN_CAP) { atomicAdd(&(bar)[XB_TMO], 1u); break; } } } } while (0)

struct XcdBarrier { unsigned* bar; unsigned x; volatile LAS unsigned* st; };

__device__ __forceinline__ XcdBarrier xcd_barrier_post(unsigned* bar, volatile LAS unsigned* st) {
    XcdBarrier b; b.bar = bar; b.x = xb_xcc_id(); b.st = st;
    if (threadIdx.x == 0) (void)xb_add(&bar[XB_XCNT(b.x)], 1u);
    return b;
}
__device__ __forceinline__ void xcd_barrier_complete(unsigned* bar, unsigned x, unsigned& nloc, unsigned& nx) {
    const unsigned G = gridDim.x * gridDim.y * gridDim.z;
    unsigned sum, cnt, mine, sp = 0u;
    for (;;) {
        sum = 0u; cnt = 0u; mine = 0u;
#pragma unroll
        for (unsigned j = 0; j < 16; ++j) { const unsigned c = xb_ld(&bar[XB_XCNT(j)]); sum += c; cnt += (c > 0u) ? 1u : 0u; mine = (j == x) ? c : mine; }
        if (sum == G) break;
        __builtin_amdgcn_s_sleep(1);
        if ((++sp & 255u) == 0u) { if (xb_ld(&bar[XB_TMO])) break; if (sp > XB_SPIN_CAP) { atomicAdd(&bar[XB_TMO], 1u); break; } }
    }
    nloc = mine > 0u ? mine : 1u; nx = cnt > 0u ? cnt : 1u;
}
__device__ __forceinline__ void xcd_barrier(const XcdBarrier& b, const int tid) {
    asm volatile("s_waitcnt vmcnt(0)" ::: "memory");
    __syncthreads();
    if (tid == 0) {
        unsigned* bar = b.bar;
        __builtin_amdgcn_s_waitcnt(0);
        unsigned nloc = b.st[0], nx = b.st[1];
        if (nloc == 0u) { xcd_barrier_complete(bar, b.x, nloc, nx); b.st[0] = nloc; b.st[1] = nx; }
        const unsigned old = xb_add(&bar[XB_XSUB(b.x)], 1u);
        const unsigned gen = old / nloc;
        if (old + 1u == (gen + 1u) * nloc) {
            __builtin_amdgcn_fence(__ATOMIC_RELEASE, "agent");
            asm volatile("s_waitcnt vmcnt(0)" ::: "memory");
            const unsigned og = xb_add(&bar[XB_TOP], 1u);
            const unsigned tg = og / nx;
            if (og + 1u == (tg + 1u) * nx) xb_add(&bar[XB_TOPGEN], 1u);
            else XB_SPIN(xb_ld(&bar[XB_TOPGEN]) == tg, bar);
            __builtin_amdgcn_fence(__ATOMIC_ACQUIRE, "agent");
            xb_add(&bar[XB_XGEN(b.x)], 1u);
            asm volatile("s_waitcnt vmcnt(0)" ::: "memory");
        } else {
            XB_SPIN(xb_ld(&bar[XB_XGEN(b.x)]) == gen, bar);
            __builtin_amdgcn_fence(__ATOMIC_ACQUIRE, "agent");
            asm volatile("s_waitcnt vmcnt(0)" ::: "memory");
        }
    }
    __syncthreads();
}

namespace pg8 {
#define PG8_LAS __attribute__((address_space(3)))
typedef unsigned short bf16_t;
typedef short bf16x8 __attribute__((ext_vector_type(8)));
typedef float f32x4 __attribute__((ext_vector_type(4)));
typedef unsigned u32x4 __attribute__((ext_vector_type(4)));
constexpr int BM = 256, BK = 64, HALF = 128, HTB = HALF * BK * 2  , STAGE_BYTES = 8 * HTB, NXCD = 8, WGM = 8;

__host__ __device__ __forceinline__ int lds_byte(int r, int c) { const int st = (r >> 4) * 2 + (c >> 5), rr = r & 15, cc = c & 31, ob = rr * 64 + cc * 2; return st * 1024 + (ob ^ (((ob >> 9) & 1) << 5)); }
__host__ __device__ __forceinline__ void stage_rc(int b, int& R, int& C) { const int st = b / 1024, sb = b % 1024, swz = sb ^ (((sb >> 9) & 1) << 5); R = (st >> 1) * 16 + swz / 64; C = (st & 1) * 32 + (swz % 64) / 2; }
__host__ __device__ __forceinline__ int perm32(int rho) { const int n = rho >> 4, i = rho & 15; return 8 * (i >> 2) + 4 * n + (i & 3); }

struct Unit { int pm, pn, eb, p0, cnt; };
struct Gemm { const bf16_t* A; const bf16_t* Bt; int M, N, K; int lda; size_t bstride; const unsigned* list; int cap; size_t astride; };

struct StaticOrder {
    int nM, nN, nwg, G, c;
    __host__ __device__ void init(int M, int N, int G_, int c_) { nM = M / BM; nN = N / BM; nwg = nM * nN; G = G_; c = c_; }
    __host__ __device__ bool next(int i, Unit& u) const {
        const long L = (long)i * G + c; if (L >= nwg) return false;
        int wgid = (int)L; { const int q = nwg / NXCD, r = nwg % NXCD, xcd = wgid % NXCD, off = wgid / NXCD; wgid = (xcd < r ? xcd * (q + 1) : r * (q + 1) + (xcd - r) * q) + off; }
        const int nig = WGM * nN, gid = wgid / nig, fm = gid * WGM, gsz = (nM - fm) < WGM ? (nM - fm) : WGM;
        u.pm = fm + ((wgid % nig) % gsz); u.pn = (wgid % nig) / gsz; u.eb = 0; u.p0 = 0; u.cnt = 0; return true;
    }
    __device__ __forceinline__ void a_ready(const Unit&) const {}
    __device__ __forceinline__ void done(const Unit&) const {}
};

__device__ __forceinline__ unsigned cvt_pk_bf16(float lo, float hi) { unsigned r; asm volatile("v_cvt_pk_bf16_f32 %0, %1, %2" : "=v"(r) : "v"(lo), "v"(hi)); return r; }
typedef float f32x2 __attribute__((ext_vector_type(2)));
__device__ __forceinline__ f32x2 gelu_pk(f32x2 v) {
    const f32x2 av = __builtin_elementwise_abs(v), d = av * 0.2316418882f + 1.0f;
    f32x2 t; t.x = __builtin_amdgcn_rcpf(d.x); t.y = __builtin_amdgcn_rcpf(d.y);
    f32x2 q = t * 0.5307027145f + (-0.7265760135f); q = q * t + 0.7107068705f; q = q * t + (-0.142248368f); q = q * t + 0.127414796f; q = q * t;
    const f32x2 s = (v * v) * (-0.72134752044f);
    f32x2 e; e.x = __builtin_amdgcn_exp2f(s.x); e.y = __builtin_amdgcn_exp2f(s.y);
    const f32x2 m = v * (q * e), r = v - m;
    f32x2 o; o.x = v.x < 0.f ? m.x : r.x; o.y = v.y < 0.f ? m.y : r.y; return o;
}

template <int ACT  > struct EpiBf16 {
    static constexpr bool PERM = true, AFTER_DRAIN = false; static_assert(ACT == 0 || ACT == 1, "EpiBf16: ACT is 0 (none) or 1 (gelu_pk)");
    bf16_t* O; int ldc; const float* bias; int split_cols; size_t split_stride; float scale0;
    __device__ __forceinline__ void operator()(const f32x4 (&acc)[2][2][4][2], const Unit& u, int wr, int wc, int fr, int fq) const {
        const int row0 = u.pm * BM + wr * 64 + fr; int colt = u.pn * BM; bf16_t* base = O;
        float sc = 1.f; if (split_cols) { const int t = colt / split_cols; base += (size_t)t * split_stride; colt -= t * split_cols; if (t == 0) sc = scale0; }
        const int col0 = colt + wc * 32 + 8 * fq, bcol0 = u.pn * BM + wc * 32 + 8 * fq;
        f32x4 bv[2][2];
#pragma unroll
        for (int bj = 0; bj < 2; ++bj)
#pragma unroll
            for (int n = 0; n < 2; ++n) bv[bj][n] = bias ? *(const f32x4*)(bias + bcol0 + bj * HALF + 4 * n) : (f32x4){0.f, 0.f, 0.f, 0.f};
#pragma unroll
        for (int ai = 0; ai < 2; ++ai)
#pragma unroll
            for (int m = 0; m < 4; ++m) { bf16_t* rowp = base + (size_t)(row0 + ai * HALF + m * 16) * ldc + col0;
#pragma unroll
                for (int bj = 0; bj < 2; ++bj) { f32x4 v0 = acc[ai][bj][m][0] + bv[bj][0], v1 = acc[ai][bj][m][1] + bv[bj][1];
                    if (ACT == 1) { f32x2 a = gelu_pk((f32x2){v0[0], v0[1]}), b = gelu_pk((f32x2){v0[2], v0[3]}), c = gelu_pk((f32x2){v1[0], v1[1]}), d = gelu_pk((f32x2){v1[2], v1[3]});
                        v0 = (f32x4){a.x, a.y, b.x, b.y}; v1 = (f32x4){c.x, c.y, d.x, d.y}; }
                    v0 = v0 * sc; v1 = v1 * sc; u32x4 w; w.x = cvt_pk_bf16(v0[0], v0[1]); w.y = cvt_pk_bf16(v0[2], v0[3]); w.z = cvt_pk_bf16(v1[0], v1[1]); w.w = cvt_pk_bf16(v1[2], v1[3]);
                    *(u32x4*)(rowp + bj * HALF) = w; } }
    }
};
template <class Epi, class Sched, bool ALIGN_EPI = false, bool SP2 = false>
__device__ __forceinline__ void gemm_phase(PG8_LAS unsigned char* lds, const Gemm g, const Sched& S, const Epi& E) {
    int tid_ = threadIdx.x; asm volatile("" : "+v"(tid_));
    const int tid = tid_, wid = __builtin_amdgcn_readfirstlane(tid >> 6), lane = tid & 63, wr = wid >> 2, wc = wid & 3, fr = lane & 15, fq = lane >> 4;
    const int K = g.K, nt = K / BK;
    unsigned voffA[2], voffB[2];
#pragma unroll
    for (int i = 0; i < 2; ++i) { int R, C; stage_rc(tid * 16 + i * 8192, R, C); const int Rb = Epi::PERM ? ((R & ~31) + perm32(R & 31)) : R;
        voffA[i] = (unsigned)(R * K + C) * 2u; voffB[i] = (unsigned)(Rb * K + C) * 2u; }
    const size_t kstep = (size_t)(BK * 2);
    const size_t hstep = (size_t)HALF * K * 2;
    const size_t tstep = 2 * hstep;
    const unsigned ldsw = (unsigned)wid * 1024u;
    const int aoff = lds_byte(wr * 64 + fr, fq * 8), boff = lds_byte(wc * 32 + fr, fq * 8);
#define PG8_SA(b, h) (((b) * 2 + (h)) * HTB)
#define PG8_SB(b, h) ((4 + (b) * 2 + (h)) * HTB)
#define PG8_STAGE(bufoff, gbase, voff) do { _Pragma("unroll") for (int _i = 0; _i < 2; ++_i) \
        __builtin_amdgcn_global_load_lds((const unsigned*)((const char*)(gbase) + (voff)[_i]), (PG8_LAS unsigned*)(lds + (bufoff) + ldsw + _i * 8192), 16, 0, 0); } while (0)
#define PG8_LDA(dst, b, h) do { _Pragma("unroll") for (int m = 0; m < 4; ++m) _Pragma("unroll") for (int k = 0; k < 2; ++k) dst[m][k] = *(const PG8_LAS bf16x8*)(lds + PG8_SA(b, h) + aoff + m * 2048 + k * 1024); } while (0)
#define PG8_LDB(dst, b, h) do { _Pragma("unroll") for (int n = 0; n < 2; ++n) _Pragma("unroll") for (int k = 0; k < 2; ++k) dst[n][k] = *(const PG8_LAS bf16x8*)(lds + PG8_SB(b, h) + boff + n * 2048 + k * 1024); } while (0)
#define PG8_MMA(ai, bj, At, Bt) do { __builtin_amdgcn_s_setprio(1); _Pragma("unroll") for (int m = 0; m < 4; ++m) _Pragma("unroll") for (int n = 0; n < 2; ++n) _Pragma("unroll") for (int k = 0; k < 2; ++k) \
        acc[ai][bj][m][n] = __builtin_amdgcn_mfma_f32_16x16x32_bf16(Bt[n][k], At[m][k], acc[ai][bj][m][n], 0, 0, 0); __builtin_amdgcn_s_setprio(0); } while (0)
#define PG8_WAIT_V(n) asm volatile("s_waitcnt vmcnt(" #n ")" ::: "memory")
#define PG8_WAIT_L(n) asm volatile("s_waitcnt lgkmcnt(" #n ")" ::: "memory")
#define PG8_BAR __builtin_amdgcn_s_barrier()
#define PG8_SCHED __builtin_amdgcn_sched_barrier(0)
    Unit cur, nxt; int ui = 0;
    if (!S.next(0, cur)) return;
    f32x4 acc[2][2][4][2];
#pragma unroll
    for (int a = 0; a < 2; ++a)
#pragma unroll
        for (int b = 0; b < 2; ++b)
#pragma unroll
            for (int m = 0; m < 4; ++m)
#pragma unroll
                for (int n = 0; n < 2; ++n) acc[a][b][m][n] = (f32x4){0.f, 0.f, 0.f, 0.f};
    bf16x8 At[4][2], B0[2][2], B1[2][2];
    const char* cA = (const char*)g.A + (size_t)cur.pm * tstep; const char* cB = (const char*)g.Bt + (size_t)cur.pn * tstep;
    S.a_ready(cur);
    if constexpr (SP2) {
        PG8_STAGE(PG8_SB(0, 0), cB, voffB); PG8_STAGE(PG8_SB(0, 1), cB + hstep, voffB); PG8_STAGE(PG8_SA(0, 0), cA, voffA); PG8_STAGE(PG8_SA(0, 1), cA + hstep, voffA);
        if (wr == 1) PG8_BAR;
        PG8_WAIT_V(2); PG8_BAR;
        PG8_STAGE(PG8_SB(1, 0), cB + kstep, voffB); PG8_STAGE(PG8_SA(1, 0), cA + kstep, voffA); PG8_STAGE(PG8_SB(1, 1), cB + hstep + kstep, voffB);
        PG8_WAIT_V(6); PG8_BAR;
    } else {
        PG8_STAGE(PG8_SB(0, 0), cB, voffB); PG8_STAGE(PG8_SA(0, 0), cA, voffA); PG8_STAGE(PG8_SB(0, 1), cB + hstep, voffB); PG8_STAGE(PG8_SA(0, 1), cA + hstep, voffA);
        if (wr == 1) PG8_BAR;
        PG8_WAIT_V(4); PG8_BAR;
        PG8_STAGE(PG8_SB(1, 0), cB + kstep, voffB); PG8_STAGE(PG8_SA(1, 0), cA + kstep, voffA); PG8_STAGE(PG8_SB(1, 1), cB + hstep + kstep, voffB);
        PG8_WAIT_V(6); PG8_BAR;
    }
    for (;;) {
        const bool has_next = S.next(ui + 1, nxt);
        const char* nA = has_next ? (const char*)g.A + (size_t)nxt.pm * tstep : cA; const char* nB = has_next ? (const char*)g.Bt + (size_t)nxt.pn * tstep : cB;
        for (int t = 0; t < nt; t += 2) {
            const bool last = (t == nt - 2);
            const char* a1 = cA + (size_t)(t + 1) * kstep;
            const char* a2 = last ? nA : cA + (size_t)(t + 2) * kstep; const char* b2 = last ? nB : cB + (size_t)(t + 2) * kstep;
            const char* a3 = a2 + kstep; const char* b3 = b2 + kstep;
            if (last && has_next) S.a_ready(nxt);
            if constexpr (SP2) {
            PG8_LDB(B0, 0, 0); PG8_LDB(B1, 0, 1); PG8_SCHED; PG8_LDA(At, 0, 0); PG8_STAGE(PG8_SA(1, 1), a1 + hstep, voffA);
            PG8_WAIT_V(8); PG8_WAIT_L(0); PG8_BAR; PG8_MMA(0, 0, At, B0); PG8_MMA(0, 1, At, B1); PG8_BAR; PG8_SCHED;
            PG8_LDA(At, 0, 1); PG8_STAGE(PG8_SB(0, 0), b2, voffB); PG8_STAGE(PG8_SB(0, 1), b2 + hstep, voffB); PG8_STAGE(PG8_SA(0, 0), a2, voffA);
            PG8_WAIT_V(8); PG8_WAIT_L(0); PG8_BAR; PG8_MMA(1, 0, At, B0); PG8_MMA(1, 1, At, B1); PG8_BAR; PG8_SCHED;
            PG8_LDB(B0, 1, 0); PG8_LDB(B1, 1, 1); PG8_SCHED; PG8_LDA(At, 1, 0); PG8_STAGE(PG8_SA(0, 1), a2 + hstep, voffA);
            PG8_WAIT_V(8); PG8_WAIT_L(0); PG8_BAR; PG8_MMA(0, 0, At, B0); PG8_MMA(0, 1, At, B1); PG8_BAR; PG8_SCHED;
            PG8_LDA(At, 1, 1); PG8_STAGE(PG8_SB(1, 0), b3, voffB); PG8_STAGE(PG8_SB(1, 1), b3 + hstep, voffB); PG8_STAGE(PG8_SA(1, 0), a3, voffA);
            PG8_WAIT_V(8); PG8_WAIT_L(0); PG8_BAR; PG8_MMA(1, 0, At, B0); PG8_MMA(1, 1, At, B1); PG8_BAR; PG8_SCHED;
            } else {
            PG8_LDB(B0, 0, 0); PG8_SCHED; PG8_LDA(At, 0, 0); PG8_STAGE(PG8_SA(1, 1), a1 + hstep, voffA);
            PG8_WAIT_L(8); PG8_BAR; PG8_WAIT_L(0); PG8_MMA(0, 0, At, B0); PG8_BAR; PG8_SCHED;
            PG8_LDB(B1, 0, 1); PG8_STAGE(PG8_SB(0, 0), b2, voffB);
            PG8_BAR; PG8_WAIT_L(0); PG8_MMA(0, 1, At, B1); PG8_BAR;
            PG8_LDA(At, 0, 1); PG8_STAGE(PG8_SA(0, 0), a2, voffA);
            PG8_BAR; PG8_WAIT_L(0); PG8_MMA(1, 0, At, B0); PG8_BAR; PG8_SCHED;
            PG8_STAGE(PG8_SB(0, 1), b2 + hstep, voffB);
            PG8_WAIT_V(6); PG8_BAR; PG8_MMA(1, 1, At, B1); PG8_BAR;
            PG8_LDB(B0, 1, 0); PG8_SCHED; PG8_LDA(At, 1, 0); PG8_STAGE(PG8_SA(0, 1), a2 + hstep, voffA);
            PG8_WAIT_L(8); PG8_BAR; PG8_WAIT_L(0); PG8_MMA(0, 0, At, B0); PG8_BAR; PG8_SCHED;
            PG8_LDB(B1, 1, 1); PG8_STAGE(PG8_SB(1, 0), b3, voffB);
            PG8_BAR; PG8_WAIT_L(0); PG8_MMA(0, 1, At, B1); PG8_BAR;
            PG8_LDA(At, 1, 1); PG8_STAGE(PG8_SA(1, 0), a3, voffA);
            PG8_BAR; PG8_WAIT_L(0); PG8_MMA(1, 0, At, B0); PG8_BAR; PG8_SCHED;
            PG8_STAGE(PG8_SB(1, 1), b3 + hstep, voffB);
            PG8_WAIT_V(6); PG8_BAR; PG8_MMA(1, 1, At, B1); PG8_BAR;
            }
        }
        if constexpr (ALIGN_EPI) { if (wr == 0) PG8_BAR; }
        if constexpr (!Epi::AFTER_DRAIN) { E(acc, cur, wr, wc, fr, fq); S.done(cur); }
        if (!has_next) break;
#pragma unroll
        for (int a = 0; a < 2; ++a)
#pragma unroll
            for (int b = 0; b < 2; ++b)
#pragma unroll
                for (int m = 0; m < 4; ++m)
#pragma unroll
                    for (int n = 0; n < 2; ++n) acc[a][b][m][n] = (f32x4){0.f, 0.f, 0.f, 0.f};
        cur = nxt; cA = nA; cB = nB; ++ui;
        if constexpr (ALIGN_EPI) { if (wr == 1) PG8_BAR; }
    }
    PG8_WAIT_V(0);
    if constexpr (!ALIGN_EPI) { if (wr == 0) PG8_BAR; }
    PG8_BAR;
    if constexpr (Epi::AFTER_DRAIN) { E.fused(acc, cur, wr, wc, fr, fq, lds, wid, lane); S.done(cur); }
#undef PG8_SA
#undef PG8_SB
#undef PG8_STAGE
#undef PG8_LDA
#undef PG8_LDB
#undef PG8_MMA
#undef PG8_WAIT_V
#undef PG8_WAIT_L
#undef PG8_BAR
#undef PG8_SCHED
}

__device__ __forceinline__ float sigm(float x) { return 1.0f / (1.0f + __expf(-x)); }
struct EpiGlu {
    static constexpr bool PERM = true, AFTER_DRAIN = false;
    bf16_t* O; int ldc;
    __device__ __forceinline__ void operator()(const f32x4 (&acc)[2][2][4][2], const Unit& u, int wr, int wc, int fr, int fq) const {
        const int row0 = u.pm * BM + wr * 64 + fr, col0 = u.pn * HALF + wc * 32 + 8 * fq;
#pragma unroll
        for (int ai = 0; ai < 2; ++ai)
#pragma unroll
            for (int m = 0; m < 4; ++m) {
                bf16_t* rowp = O + (size_t)(row0 + ai * HALF + m * 16) * ldc + col0;
                const f32x4 a0 = acc[ai][0][m][0], a1 = acc[ai][0][m][1], b0 = acc[ai][1][m][0], b1 = acc[ai][1][m][1];
                u32x4 w;
                w.x = cvt_pk_bf16(a0[0] * sigm(b0[0]), a0[1] * sigm(b0[1])); w.y = cvt_pk_bf16(a0[2] * sigm(b0[2]), a0[3] * sigm(b0[3]));
                w.z = cvt_pk_bf16(a1[0] * sigm(b1[0]), a1[1] * sigm(b1[1])); w.w = cvt_pk_bf16(a1[2] * sigm(b1[2]), a1[3] * sigm(b1[3]));
                *(u32x4*)rowp = w;
            }
    }
};
struct EpiResid {
    static constexpr bool PERM = false, AFTER_DRAIN = false;
    const float* X; float* O; int ldc;
    __device__ __forceinline__ void operator()(const f32x4 (&acc)[2][2][4][2], const Unit& u, int wr, int wc, int fr, int fq) const {
        const int row0 = u.pm * BM + wr * 64 + fr, col0 = u.pn * BM + wc * 32 + 4 * fq;
#pragma unroll
        for (int ai = 0; ai < 2; ++ai)
#pragma unroll
            for (int m = 0; m < 4; ++m) {
                const size_t off = (size_t)(row0 + ai * HALF + m * 16) * ldc + col0;
#pragma unroll
                for (int bj = 0; bj < 2; ++bj)
#pragma unroll
                    for (int n = 0; n < 2; ++n) *(f32x4*)(O + off + bj * HALF + n * 16) = *(const f32x4*)(X + off + bj * HALF + n * 16) + acc[ai][bj][m][n];
            }
    }
};

template <class Epi, class Sched, bool GATHER>
__device__ __forceinline__ void gemm2(PG8_LAS unsigned char* lds, const Gemm g, const Sched& S, const Epi& E, const int tid) {
    int K_ = g.K; asm volatile("" : "+s"(K_));
    const int wid = __builtin_amdgcn_readfirstlane(tid >> 6), lane = tid & 63, wr = wid >> 2, wc = wid & 3, fr = lane & 15, fq = lane >> 4;
    const int K = K_, nt = K / BK, lda = g.lda;
    unsigned voffA[2], voffB[2]; int Rst[2], Cst[2];
#pragma unroll
    for (int i = 0; i < 2; ++i) { int R, C; stage_rc(tid * 16 + i * 8192, R, C); const int Rb = Epi::PERM ? ((R & ~31) + perm32(R & 31)) : R;
        voffA[i] = (unsigned)(R * lda + C) * 2u; voffB[i] = (unsigned)(Rb * K + C) * 2u; Rst[i] = R; Cst[i] = C; }
    const size_t kstep = (size_t)(BK * 2);
    const size_t hstepA = (size_t)HALF * lda * 2, tstepA = 2 * hstepA, hstepB = (size_t)HALF * K * 2, tstepB = 2 * hstepB;
    const unsigned ldsw = (unsigned)wid * 1024u;
    const int aoff = lds_byte(wr * 64 + fr, fq * 8), boff = lds_byte(wc * 32 + fr, fq * 8);
#define PG8_SA(b, h) (((b) * 2 + (h)) * HTB)
#define PG8_SB(b, h) ((4 + (b) * 2 + (h)) * HTB)
#define PG8_STAGE(bufoff, gbase, voff) do { _Pragma("unroll") for (int _i = 0; _i < 2; ++_i) \
        __builtin_amdgcn_global_load_lds((const unsigned*)((const char*)(gbase) + (voff)[_i]), (PG8_LAS unsigned*)(lds + (bufoff) + ldsw + _i * 8192), 16, 0, 0); } while (0)
#define PG8_STAGE_A(bufoff, gbase, h) do { if constexpr (GATHER) { PG8_STAGE(bufoff, gbase, vg[h]); } else { PG8_STAGE(bufoff, (gbase) + (h) * hstepA, voffA); } } while (0)
#define PG8_GOFFS(u, dst) do { _Pragma("unroll") for (int _h = 0; _h < 2; ++_h) _Pragma("unroll") for (int _i = 0; _i < 2; ++_i) { const int _pos = (u).p0 + _h * HALF + Rst[_i]; \
        const unsigned _tok = _pos < (u).cnt ? (g.list[(size_t)(u).eb * g.cap + _pos] >> 1) : 0u; dst[_h][_i] = (_tok * (unsigned)lda + (unsigned)Cst[_i]) * 2u; } } while (0)
#define PG8_LDA(dst, b, h) do { _Pragma("unroll") for (int m = 0; m < 4; ++m) _Pragma("unroll") for (int k = 0; k < 2; ++k) dst[m][k] = *(const PG8_LAS bf16x8*)(lds + PG8_SA(b, h) + aoff + m * 2048 + k * 1024); } while (0)
#define PG8_LDB(dst, b, h) do { _Pragma("unroll") for (int n = 0; n < 2; ++n) _Pragma("unroll") for (int k = 0; k < 2; ++k) dst[n][k] = *(const PG8_LAS bf16x8*)(lds + PG8_SB(b, h) + boff + n * 2048 + k * 1024); } while (0)
#define PG8_MMA(ai, bj, At, Bt) do { __builtin_amdgcn_s_setprio(1); _Pragma("unroll") for (int m = 0; m < 4; ++m) _Pragma("unroll") for (int n = 0; n < 2; ++n) _Pragma("unroll") for (int k = 0; k < 2; ++k) \
        acc[ai][bj][m][n] = __builtin_amdgcn_mfma_f32_16x16x32_bf16(Bt[n][k], At[m][k], acc[ai][bj][m][n], 0, 0, 0); __builtin_amdgcn_s_setprio(0); } while (0)
#define PG8_WAIT_V(n) asm volatile("s_waitcnt vmcnt(" #n ")" ::: "memory")
#define PG8_WAIT_L(n) asm volatile("s_waitcnt lgkmcnt(" #n ")" ::: "memory")
#define PG8_BAR __builtin_amdgcn_s_barrier()
#define PG8_SCHED __builtin_amdgcn_sched_barrier(0)
    Unit cur, nxt; int ui = 0;
    if (!S.next(0, cur)) return;
    f32x4 acc[2][2][4][2];
#pragma unroll
    for (int a = 0; a < 2; ++a)
#pragma unroll
        for (int b = 0; b < 2; ++b)
#pragma unroll
            for (int m = 0; m < 4; ++m)
#pragma unroll
                for (int n = 0; n < 2; ++n) acc[a][b][m][n] = (f32x4){0.f, 0.f, 0.f, 0.f};
    bf16x8 At[4][2], B0[2][2], B1[2][2];
    unsigned vg[2][2] = {{0u, 0u}, {0u, 0u}};
    if constexpr (GATHER) PG8_GOFFS(cur, vg);
    const char* cA = (const char*)g.A + (GATHER ? (size_t)0 : (size_t)cur.pm * tstepA + (size_t)cur.eb * g.astride * 2);
    const char* cB = (const char*)g.Bt + ((size_t)cur.eb * g.bstride) * 2 + (size_t)cur.pn * tstepB;
    S.a_ready(cur);
    PG8_STAGE(PG8_SB(0, 0), cB, voffB); PG8_STAGE(PG8_SB(0, 1), cB + hstepB, voffB); PG8_STAGE_A(PG8_SA(0, 0), cA, 0); PG8_STAGE_A(PG8_SA(0, 1), cA, 1);
    if (wr == 1) PG8_BAR;
    PG8_WAIT_V(2); PG8_BAR;
    PG8_STAGE(PG8_SB(1, 0), cB + kstep, voffB); PG8_STAGE_A(PG8_SA(1, 0), cA + kstep, 0); PG8_STAGE(PG8_SB(1, 1), cB + hstepB + kstep, voffB);
    PG8_WAIT_V(6); PG8_BAR;
    for (;;) {
        const bool has_next = S.next(ui + 1, nxt);
        const char* nA = has_next ? (const char*)g.A + (GATHER ? (size_t)0 : (size_t)nxt.pm * tstepA + (size_t)nxt.eb * g.astride * 2) : cA;
        const char* nB = has_next ? (const char*)g.Bt + ((size_t)nxt.eb * g.bstride) * 2 + (size_t)nxt.pn * tstepB : cB;
        for (int t = 0; t < nt; t += 2) {
            const bool last = (t == nt - 2);
            const char* a1 = cA + (size_t)(t + 1) * kstep;
            const char* a2 = last ? nA : cA + (size_t)(t + 2) * kstep; const char* b2 = last ? nB : cB + (size_t)(t + 2) * kstep;
            const char* a3 = a2 + kstep; const char* b3 = b2 + kstep;
            unsigned vn1[2] = {vg[1][0], vg[1][1]};
            if constexpr (GATHER) { if (last && has_next) { unsigned vn[2][2]; PG8_GOFFS(nxt, vn); vg[0][0] = vn[0][0]; vg[0][1] = vn[0][1]; vn1[0] = vn[1][0]; vn1[1] = vn[1][1]; } }
            if (last && has_next) S.a_ready(nxt);
            PG8_LDB(B0, 0, 0); PG8_LDB(B1, 0, 1); PG8_SCHED; PG8_LDA(At, 0, 0); PG8_STAGE_A(PG8_SA(1, 1), a1, 1);
            PG8_WAIT_V(8); PG8_WAIT_L(0); PG8_BAR; PG8_MMA(0, 0, At, B0); PG8_MMA(0, 1, At, B1); PG8_BAR; PG8_SCHED;
            if constexpr (GATHER) { vg[1][0] = vn1[0]; vg[1][1] = vn1[1]; }
            PG8_LDA(At, 0, 1); PG8_STAGE(PG8_SB(0, 0), b2, voffB); PG8_STAGE(PG8_SB(0, 1), b2 + hstepB, voffB); PG8_STAGE_A(PG8_SA(0, 0), a2, 0);
            PG8_WAIT_V(8); PG8_WAIT_L(0); PG8_BAR; PG8_MMA(1, 0, At, B0); PG8_MMA(1, 1, At, B1); PG8_BAR; PG8_SCHED;
            PG8_LDB(B0, 1, 0); PG8_LDB(B1, 1, 1); PG8_SCHED; PG8_LDA(At, 1, 0); PG8_STAGE_A(PG8_SA(0, 1), a2, 1);
            PG8_WAIT_V(8); PG8_WAIT_L(0); PG8_BAR; PG8_MMA(0, 0, At, B0); PG8_MMA(0, 1, At, B1); PG8_BAR; PG8_SCHED;
            PG8_LDA(At, 1, 1); PG8_STAGE(PG8_SB(1, 0), b3, voffB); PG8_STAGE(PG8_SB(1, 1), b3 + hstepB, voffB); PG8_STAGE_A(PG8_SA(1, 0), a3, 0);
            PG8_WAIT_V(8); PG8_WAIT_L(0); PG8_BAR; PG8_MMA(1, 0, At, B0); PG8_MMA(1, 1, At, B1); PG8_BAR; PG8_SCHED;
        }
        if (wr == 0) PG8_BAR;
        E(acc, cur, wr, wc, fr, fq); S.done(cur);
        if (!has_next) break;
#pragma unroll
        for (int a = 0; a < 2; ++a)
#pragma unroll
            for (int b = 0; b < 2; ++b)
#pragma unroll
                for (int m = 0; m < 4; ++m)
#pragma unroll
                    for (int n = 0; n < 2; ++n) acc[a][b][m][n] = (f32x4){0.f, 0.f, 0.f, 0.f};
        cur = nxt; cA = nA; cB = nB; ++ui;
        if (wr == 1) PG8_BAR;
    }
    PG8_WAIT_V(0);
    PG8_BAR;
#undef PG8_SA
#undef PG8_SB
#undef PG8_STAGE
#undef PG8_STAGE_A
#undef PG8_GOFFS
#undef PG8_LDA
#undef PG8_LDB
#undef PG8_MMA
#undef PG8_WAIT_V
#undef PG8_WAIT_L
#undef PG8_BAR
#undef PG8_SCHED
}

struct ExpertOrder {
    const PG8_LAS int* tab; int nN, G, c;
    __device__ __forceinline__ bool next(int i, Unit& u) const {
        const int total = tab[32] * nN; const long L = (long)i * G + c; if (L >= total) return false;
        const int rt = (int)L / nN, pn = (int)L % nN; int e = 0;
#pragma unroll
        for (int k = 1; k < 32; ++k) e += (rt >= tab[k]) ? 1 : 0;
        u.pm = __builtin_amdgcn_readfirstlane(rt); u.pn = __builtin_amdgcn_readfirstlane(pn); u.eb = __builtin_amdgcn_readfirstlane(e);
        u.p0 = __builtin_amdgcn_readfirstlane((rt - tab[e]) * BM); u.cnt = __builtin_amdgcn_readfirstlane(tab[33 + e]); return true;
    }
    __device__ __forceinline__ void a_ready(const Unit&) const {}
    __device__ __forceinline__ void done(const Unit&) const {}
};
struct EpiGateUp {
    static constexpr bool PERM = true, AFTER_DRAIN = false;
    bf16_t* H; const float* listw; int cap;
    __device__ __forceinline__ void operator()(const f32x4 (&acc)[2][2][4][2], const Unit& u, int wr, int wc, int fr, int fq) const {
        const int rl0 = wr * 64 + fr, col0 = u.pn * HALF + wc * 32 + 8 * fq;
#pragma unroll
        for (int ai = 0; ai < 2; ++ai)
#pragma unroll
            for (int m = 0; m < 4; ++m) {
                const int rl = rl0 + ai * HALF + m * 16, pos = u.p0 + rl;
                const float w = pos < u.cnt ? listw[(size_t)u.eb * cap + pos] : 0.f;
                bf16_t* rowp = H + (size_t)(u.pm * BM + rl) * 256 + col0;
                const f32x4 g0 = acc[ai][0][m][0], g1 = acc[ai][0][m][1], u0 = acc[ai][1][m][0], u1 = acc[ai][1][m][1];
                u32x4 o;
                o.x = cvt_pk_bf16(g0[0] * sigm(g0[0]) * u0[0] * w, g0[1] * sigm(g0[1]) * u0[1] * w); o.y = cvt_pk_bf16(g0[2] * sigm(g0[2]) * u0[2] * w, g0[3] * sigm(g0[3]) * u0[3] * w);
                o.z = cvt_pk_bf16(g1[0] * sigm(g1[0]) * u1[0] * w, g1[1] * sigm(g1[1]) * u1[1] * w); o.w = cvt_pk_bf16(g1[2] * sigm(g1[2]) * u1[2] * w, g1[3] * sigm(g1[3]) * u1[3] * w);
                *(u32x4*)rowp = o;
            }
    }
};
struct EpiDown {
    static constexpr bool PERM = false, AFTER_DRAIN = false;
    float* X; float* P2; const unsigned* list; int cap;
    __device__ __forceinline__ void operator()(const f32x4 (&acc)[2][2][4][2], const Unit& u, int wr, int wc, int fr, int fq) const {
        const int rl0 = wr * 64 + fr, col0 = u.pn * BM + wc * 32 + 4 * fq;
#pragma unroll
        for (int ai = 0; ai < 2; ++ai)
#pragma unroll
            for (int m = 0; m < 4; ++m) {
                const int rl = rl0 + ai * HALF + m * 16, pos = u.p0 + rl;
                if (pos < u.cnt) {
                    const unsigned ent = list[(size_t)u.eb * cap + pos];
                    float* dst = ((ent & 1u) ? P2 : X) + (size_t)(ent >> 1) * 1024 + col0;
#pragma unroll
                    for (int bj = 0; bj < 2; ++bj)
#pragma unroll
                        for (int n = 0; n < 2; ++n) { f32x4 v = acc[ai][bj][m][n]; if (!(ent & 1u)) v += *(const f32x4*)(dst + bj * HALF + n * 16); *(f32x4*)(dst + bj * HALF + n * 16) = v; }
                }
                asm volatile("" ::: "memory");
            }
    }
};

struct BatchOrder {
    int nb, nM, nN, G, c;
    __device__ __forceinline__ bool next(int i, Unit& u) const {
        const long L = (long)i * G + c; if (L >= (long)nb * nM * nN) return false;
        const int per = nM * nN, e = (int)L / per, rem = (int)L % per;
        u.eb = e; u.pm = rem / nN; u.pn = rem % nN; u.p0 = 0; u.cnt = 0; return true;
    }
    __device__ __forceinline__ void a_ready(const Unit&) const {}
    __device__ __forceinline__ void done(const Unit&) const {}
};
struct EpiInProj {
    static constexpr bool PERM = true, AFTER_DRAIN = false;
    bf16_t* Zo; bf16_t* U;
    __device__ __forceinline__ void operator()(const f32x4 (&acc)[2][2][4][2], const Unit& u, int wr, int wc, int fr, int fq) const {
        const int row0 = u.pm * BM + wr * 64 + fr;
#pragma unroll
        for (int ai = 0; ai < 2; ++ai)
#pragma unroll
            for (int m = 0; m < 4; ++m) { const int row = row0 + ai * HALF + m * 16;
#pragma unroll
                for (int bj = 0; bj < 2; ++bj) { const int c0 = u.pn * BM + bj * HALF + wc * 32 + 8 * fq;
                    const f32x4 v0 = acc[ai][bj][m][0], v1 = acc[ai][bj][m][1];
                    u32x4 w; w.x = cvt_pk_bf16(v0[0], v0[1]); w.y = cvt_pk_bf16(v0[2], v0[3]); w.z = cvt_pk_bf16(v1[0], v1[1]); w.w = cvt_pk_bf16(v1[2], v1[3]);
                    bf16_t* dst = u.pn < 2 ? U + ((size_t)((c0 >> 4) * 2048 + (row >> 4)) * 512 + (row & 15) * 16 + (c0 & 15)) : Zo + (size_t)row * 2048 + c0;
                    *(u32x4*)dst = w; } }
    }
};
struct EpiXloc {
    static constexpr bool PERM = false, AFTER_DRAIN = false;
    float* XL;
    __device__ __forceinline__ void operator()(const f32x4 (&acc)[2][2][4][2], const Unit& u, int wr, int wc, int fr, int fq) const {
        const int row0 = u.pm * BM + wr * 64 + fr, col0 = wc * 32 + 4 * fq;
#pragma unroll
        for (int ai = 0; ai < 2; ++ai)
#pragma unroll
            for (int m = 0; m < 4; ++m) { float* rowp = XL + ((size_t)u.eb * 2048 + row0 + ai * HALF + m * 16) * 128 + col0;
#pragma unroll
                for (int n = 0; n < 2; ++n) *(f32x4*)(rowp + n * 16) = acc[ai][0][m][n]; }
    }
};
__device__ __forceinline__ float gelu_t(float x) { const float u2 = -2.302208198f * (x + 0.044715f * x * x * x); return x * __builtin_amdgcn_rcpf(1.0f + __builtin_amdgcn_exp2f(u2)); }
struct EpiSsmOut {
    static constexpr bool PERM = true, AFTER_DRAIN = false;
    bf16_t* G;
    __device__ __forceinline__ void operator()(const f32x4 (&acc)[2][2][4][2], const Unit& u, int wr, int wc, int fr, int fq) const {
        const int row0 = u.pm * BM + wr * 64 + fr;
#pragma unroll
        for (int ai = 0; ai < 2; ++ai)
#pragma unroll
            for (int m = 0; m < 4; ++m) { const int row = row0 + ai * HALF + m * 16;
#pragma unroll
                for (int bj = 0; bj < 2; ++bj) { const int n0 = bj * HALF + wc * 32 + 8 * fq;
                    const f32x4 v0 = acc[ai][bj][m][0], v1 = acc[ai][bj][m][1];
                    u32x4 w; w.x = cvt_pk_bf16(gelu_t(v0[0]), gelu_t(v0[1])); w.y = cvt_pk_bf16(gelu_t(v0[2]), gelu_t(v0[3])); w.z = cvt_pk_bf16(gelu_t(v1[0]), gelu_t(v1[1])); w.w = cvt_pk_bf16(gelu_t(v1[2]), gelu_t(v1[3]));
                    *(u32x4*)(G + ((size_t)row * 16 + (n0 >> 4)) * 512 + u.eb * 16 + (n0 & 15)) = w; } }
    }
};
}

struct Args { const float* in[26]; float* out; unsigned char* ws; int ph_lo, ph_hi; };

struct Frame {
    LAS unsigned char* lds;
    int tid, lane, wave, blk, G;
};

__device__ __forceinline__ void ph_norm(const Frame& F, const float* xin, const float* add, float* xout, const float* g, bf16* hn) {
    const int gw = F.blk * NWAVES + F.wave, NGW = F.G * NWAVES;
    for (int row = gw; row < T; row += NGW) {
        const f32x4* xr = (const f32x4*)(xin + (size_t)row * DM);
        f32x4 v[4]; float s = 0.f;
#pragma unroll
        for (int j = 0; j < 4; ++j) { v[j] = xr[F.lane + 64 * j];
            if (add) { v[j] += ((const f32x4*)(add + (size_t)row * DM))[F.lane + 64 * j]; ((f32x4*)(xout + (size_t)row * DM))[F.lane + 64 * j] = v[j]; }
            s += v[j].x * v[j].x + v[j].y * v[j].y + v[j].z * v[j].z + v[j].w * v[j].w; }
        s = wave_sum(s, F.lane);
        const float r = rsqrtf(s * (1.0f / DM) + EPS);
#pragma unroll
        for (int j = 0; j < 4; ++j) {
            const f32x4 gg = ((const f32x4*)g)[F.lane + 64 * j];
            u32x2 o; o.x = pk2(v[j].x * r * gg.x, v[j].y * r * gg.y); o.y = pk2(v[j].z * r * gg.z, v[j].w * r * gg.w);
            *(u32x2*)(hn + (size_t)row * DM + (F.lane + 64 * j) * 4) = o;
        }
    }
}
__device__ __forceinline__ void ph_final_norm(const Frame& F, float* x, const float* add, const float* g) {
    const int gw = F.blk * NWAVES + F.wave, NGW = F.G * NWAVES;
    for (int row = gw; row < T; row += NGW) {
        f32x4* xr = (f32x4*)(x + (size_t)row * DM);
        f32x4 v[4]; float s = 0.f;
#pragma unroll
        for (int j = 0; j < 4; ++j) { v[j] = xr[F.lane + 64 * j]; if (add) v[j] += ((const f32x4*)(add + (size_t)row * DM))[F.lane + 64 * j]; s += v[j].x * v[j].x + v[j].y * v[j].y + v[j].z * v[j].z + v[j].w * v[j].w; }
        s = wave_sum(s, F.lane);
        const float r = rsqrtf(s * (1.0f / DM) + EPS);
#pragma unroll
        for (int j = 0; j < 4; ++j) {
            const f32x4 gg = ((const f32x4*)g)[F.lane + 64 * j];
            f32x4 o; o.x = v[j].x * r * gg.x; o.y = v[j].y * r * gg.y; o.z = v[j].z * r * gg.z; o.w = v[j].w * r * gg.w;
            xr[F.lane + 64 * j] = o;
        }
    }
}

template <bool DUAL, class Epi>
__device__ __forceinline__ void sgemm_naive(const Frame& F, const bf16* A, int lda, const float* B, int ldb, int M, int N, int K, int dualoff, const Epi& epi) {
    LAS float* As = (LAS float*)F.lds;
    LAS float* Bs = As + 16 * 132;
    LAS float* Bs2 = Bs + 16 * 128;
    const int tiles_n = (N + 127) / 128, tiles_m = M / 128;
    const int tx = F.tid & 31, ty = F.tid >> 5;
    for (int tile = F.blk; tile < tiles_m * tiles_n; tile += F.G) {
        const int tm = tile / tiles_n, tn = tile % tiles_n;
        float acc[8][4], acc2[8][4];
#pragma unroll
        for (int i = 0; i < 8; ++i)
#pragma unroll
            for (int j = 0; j < 4; ++j) { acc[i][j] = 0.f; acc2[i][j] = 0.f; }
        const int arow = F.tid >> 2, akq = (F.tid & 3) * 4;
        const int bk = F.tid >> 5, bn = (F.tid & 31) * 4;
        for (int k0 = 0; k0 < K; k0 += 16) {
            {
                const u32x2 av = *(const u32x2*)(A + (size_t)(tm * 128 + arow) * lda + k0 + akq);
                As[(akq + 0) * 132 + arow] = __uint_as_float(av.x << 16);
                As[(akq + 1) * 132 + arow] = __uint_as_float(av.x & 0xffff0000u);
                As[(akq + 2) * 132 + arow] = __uint_as_float(av.y << 16);
                As[(akq + 3) * 132 + arow] = __uint_as_float(av.y & 0xffff0000u);
                const int col = tn * 128 + bn;
                f32x4 bv = (f32x4){0.f, 0.f, 0.f, 0.f};
                const float* bp = B + (size_t)(k0 + bk) * ldb + col;
                if (col + 3 < N) { bv.x = bp[0]; bv.y = bp[1]; bv.z = bp[2]; bv.w = bp[3]; }
                else { if (col < N) bv.x = bp[0]; if (col + 1 < N) bv.y = bp[1]; if (col + 2 < N) bv.z = bp[2]; }
                *(LAS f32x4*)(Bs + bk * 128 + bn) = bv;
                if (DUAL) {
                    const float* bp2 = bp + dualoff;
                    f32x4 bw; bw.x = bp2[0]; bw.y = bp2[1]; bw.z = bp2[2]; bw.w = bp2[3];
                    *(LAS f32x4*)(Bs2 + bk * 128 + bn) = bw;
                }
            }
            __syncthreads();
#pragma unroll 4
            for (int k = 0; k < 16; ++k) {
                float a[8];
                const f32x4 a0 = *(const LAS f32x4*)(As + k * 132 + ty * 8), a1 = *(const LAS f32x4*)(As + k * 132 + ty * 8 + 4);
                a[0] = a0.x; a[1] = a0.y; a[2] = a0.z; a[3] = a0.w; a[4] = a1.x; a[5] = a1.y; a[6] = a1.z; a[7] = a1.w;
                const f32x4 b = *(const LAS f32x4*)(Bs + k * 128 + tx * 4);
#pragma unroll
                for (int i = 0; i < 8; ++i) { acc[i][0] += a[i] * b.x; acc[i][1] += a[i] * b.y; acc[i][2] += a[i] * b.z; acc[i][3] += a[i] * b.w; }
                if (DUAL) {
                    const f32x4 b2 = *(const LAS f32x4*)(Bs2 + k * 128 + tx * 4);
#pragma unroll
                    for (int i = 0; i < 8; ++i) { acc2[i][0] += a[i] * b2.x; acc2[i][1] += a[i] * b2.y; acc2[i][2] += a[i] * b2.z; acc2[i][3] += a[i] * b2.w; }
                }
            }
            __syncthreads();
        }
#pragma unroll
        for (int i = 0; i < 8; ++i)
#pragma unroll
            for (int j = 0; j < 4; ++j) {
                const int row = tm * 128 + ty * 8 + i, col = tn * 128 + tx * 4 + j;
                if (col < N) epi(row, col, acc[i][j], acc2[i][j]);
            }
    }
}
struct EpiStoreBf16 { bf16* O; int ldo; __device__ __forceinline__ void operator()(int r, int c, float a, float) const { O[(size_t)r * ldo + c] = (bf16)f2bf(a); } };
struct EpiGlu { bf16* O; int ldo; __device__ __forceinline__ void operator()(int r, int c, float a, float b) const { O[(size_t)r * ldo + c] = (bf16)f2bf(a * sigmoidf_(b)); } };
struct EpiResid { const float* X; float* O; __device__ __forceinline__ void operator()(int r, int c, float a, float) const { O[(size_t)r * DM + c] = X[(size_t)r * DM + c] + a; } };

__device__ __forceinline__ void ssm_naive_item(int b, int g, const float* a_re, const float* a_im, const float* b_re, const float* b_im, const float* c_re, const float* c_im,
                                               const float* dpar, const float* log_dt, const bf16* Z, bf16* G1, int lane) {
    const int p = lane;
    const float are = a_re[g * 64 + p], aim = a_im[g * 64 + p], dt = expf(log_dt[g]);
    const float er = expf(are * dt), lbr = er * cosf(aim * dt), lbi = er * sinf(aim * dt);
    const float xx = lbr - 1.0f, yy = lbi, den = are * are + aim * aim;
    const float fr = (xx * are + yy * aim) / den, fi = (yy * are - xx * aim) / den;
    float bbr[16], bbi[16], cr[16], ci[16];
#pragma unroll
    for (int h = 0; h < 16; ++h) {
        const float br = b_re[(g * 64 + p) * 16 + h], bi = b_im[(g * 64 + p) * 16 + h];
        bbr[h] = fr * br - fi * bi; bbi[h] = fr * bi + fi * br;
        cr[h] = c_re[(g * 16 + h) * 64 + p]; ci[h] = c_im[(g * 16 + h) * 64 + p];
    }
    const float dd = dpar[g * 16 + (lane & 15)];
    float xr = 0.f, xi = 0.f;
    for (int t = 0; t < SEQ; ++t) {
        const size_t row = (size_t)b * SEQ + t;
        const u32x4 u0 = *(const u32x4*)(Z + row * ZP + ZC_U + g * 16), u1 = *(const u32x4*)(Z + row * ZP + ZC_U + g * 16 + 8);
        float u[16];
        u[0] = __uint_as_float(u0.x << 16); u[1] = __uint_as_float(u0.x & 0xffff0000u); u[2] = __uint_as_float(u0.y << 16); u[3] = __uint_as_float(u0.y & 0xffff0000u);
        u[4] = __uint_as_float(u0.z << 16); u[5] = __uint_as_float(u0.z & 0xffff0000u); u[6] = __uint_as_float(u0.w << 16); u[7] = __uint_as_float(u0.w & 0xffff0000u);
        u[8] = __uint_as_float(u1.x << 16); u[9] = __uint_as_float(u1.x & 0xffff0000u); u[10] = __uint_as_float(u1.y << 16); u[11] = __uint_as_float(u1.y & 0xffff0000u);
        u[12] = __uint_as_float(u1.z << 16); u[13] = __uint_as_float(u1.z & 0xffff0000u); u[14] = __uint_as_float(u1.w << 16); u[15] = __uint_as_float(u1.w & 0xffff0000u);
        float bur = 0.f, bui = 0.f;
#pragma unroll
        for (int h = 0; h < 16; ++h) { bur += bbr[h] * u[h]; bui += bbi[h] * u[h]; }
        const float nxr = lbr * xr - lbi * xi + bur, nxi = lbr * xi + lbi * xr + bui;
        xr = nxr; xi = nxi;
        float y = 0.f;
#pragma unroll
        for (int h = 0; h < 16; ++h) { const float v = wave_sum(cr[h] * xr - ci[h] * xi, lane); if (lane == h) y = v; }
        if (lane < 16) {
            const float ul = bf2f(Z[row * ZP + ZC_U + g * 16 + lane]);
            G1[row * D_SSM + g * 16 + lane] = (bf16)f2bf(gelu_tanh(y + dd * ul));
        }
    }
}
__device__ __forceinline__ void compress_naive_item(int item, const bf16* Z, const float* pos, const float* w1, const float* w2, bf16* KC, bf16* VC, int lane) {
    const int i = item & 1, hkv = (item >> 1) & 1, n = (item >> 2) % NCMPP, b = (item >> 2) / NCMPP;
    bf16* dst = i ? VC : KC;
    if (n == NCMP) { dst[(((size_t)b * NCMPP + n) * 2 + hkv) * 64 + lane] = 0; return; }
    const float* posi = pos + i * 32 * 64; const float* w1i = w1 + (size_t)i * 32 * 64 * 64; const float* w2i = w2 + i * 64 * 64;
    float acc = 0.f;
    for (int l = 0; l < 32; ++l) {
        const bf16* zr = Z + ((size_t)b * SEQ + 16 * n + l) * ZP + ZC_KV + i * 128 + hkv * 64;
        for (int d = 0; d < 64; ++d) acc += (bf2f(zr[d]) + posi[l * 64 + d]) * w1i[(l * 64 + d) * 64 + lane];
    }
    const float hid = gelu_tanh(acc);
    float o = 0.f;
    for (int e = 0; e < 64; ++e) o += lane_bcast(hid, e) * w2i[e * 64 + lane];
    dst[(((size_t)b * NCMPP + n) * 2 + hkv) * 64 + lane] = (bf16)f2bf(o);
}

__device__ __forceinline__ void attn_chunk(LAS float* wl, const bf16* Z, const float* rel_bias, int b, int hkv, int t, int base, int kcol, int vcol, int lane,
                                           float (&m)[4], float (&l)[4], float (&o)[4]) {
    const int pos = base + lane; const bool valid = (pos >= 0) && (pos <= t);
    const int posc = pos < 0 ? 0 : (pos > SEQ - 1 ? SEQ - 1 : pos);
    const bf16* kr = Z + ((size_t)b * SEQ + posc) * ZP + kcol + hkv * 64;
    float s[4] = {0.f, 0.f, 0.f, 0.f};
#pragma unroll 2
    for (int c = 0; c < 8; ++c) {
        const u32x4 kv = *(const u32x4*)(kr + c * 8);
        float k[8];
        k[0] = __uint_as_float(kv.x << 16); k[1] = __uint_as_float(kv.x & 0xffff0000u); k[2] = __uint_as_float(kv.y << 16); k[3] = __uint_as_float(kv.y & 0xffff0000u);
        k[4] = __uint_as_float(kv.z << 16); k[5] = __uint_as_float(kv.z & 0xffff0000u); k[6] = __uint_as_float(kv.w << 16); k[7] = __uint_as_float(kv.w & 0xffff0000u);
#pragma unroll
        for (int g = 0; g < 4; ++g) {
            const f32x4 q0 = *(const LAS f32x4*)(wl + g * 64 + c * 8), q1 = *(const LAS f32x4*)(wl + g * 64 + c * 8 + 4);
            s[g] += q0.x * k[0] + q0.y * k[1] + q0.z * k[2] + q0.w * k[3] + q1.x * k[4] + q1.y * k[5] + q1.z * k[6] + q1.w * k[7];
        }
    }
    const int bk = t5_bucket(t - pos);
#pragma unroll
    for (int g = 0; g < 4; ++g) {
        const float sv = valid ? s[g] + rel_bias[bk * 8 + hkv * 4 + g] : -1e30f;
        const float mn = fmaxf(m[g], wave_max(sv, lane));
        const float alpha = __expf(m[g] - mn);
        const float p = valid ? __expf(sv - mn) : 0.f;
        l[g] = l[g] * alpha + wave_sum(p, lane);
        o[g] *= alpha; m[g] = mn;
        wl[256 + g * 64 + lane] = p;
    }
#pragma unroll 4
    for (int key = 0; key < 64; ++key) {
        int pk = base + key; pk = pk < 0 ? 0 : (pk > SEQ - 1 ? SEQ - 1 : pk);
        const float v = bf2f(Z[((size_t)b * SEQ + pk) * ZP + vcol + hkv * 64 + lane]);
#pragma unroll
        for (int g = 0; g < 4; ++g) o[g] += wl[256 + g * 64 + key] * v;
    }
}
__device__ __forceinline__ void attn_naive_item(LAS float* wl, int b, int hkv, int t, const bf16* Z, const float* KC, const float* VC, const float* rel_bias, bf16* YC, int lane) {
    const size_t row = (size_t)b * SEQ + t;
#pragma unroll
    for (int g = 0; g < 4; ++g) wl[g * 64 + lane] = bf2f(Z[row * ZP + ZC_Q + hkv * 256 + g * 64 + lane]) * 0.125f;
#pragma unroll 1
    for (int c = 0; c < 4; ++c) {
        const int n = c * 64 + lane; const bool valid = (n < NCMP) && (16 * n + 31 <= t);
        const float* kr = KC + (((size_t)b * NCMPP + (n < NCMP ? n : 0)) * 2 + hkv) * 64;
        float s[4] = {0.f, 0.f, 0.f, 0.f};
#pragma unroll 4
        for (int d4 = 0; d4 < 16; ++d4) {
            const f32x4 k = *(const f32x4*)(kr + d4 * 4);
#pragma unroll
            for (int g = 0; g < 4; ++g) { const f32x4 q = *(const LAS f32x4*)(wl + g * 64 + d4 * 4); s[g] += q.x * k.x + q.y * k.y + q.z * k.z + q.w * k.w; }
        }
        const int bk = t5_bucket(t - (16 * n + 31));
#pragma unroll
        for (int g = 0; g < 4; ++g) wl[256 + g * 256 + n] = valid ? s[g] + rel_bias[bk * 8 + hkv * 4 + g] : -1e30f;
    }
#pragma unroll
    for (int g = 0; g < 4; ++g) {
        float sc[4];
#pragma unroll
        for (int c = 0; c < 4; ++c) sc[c] = wl[256 + g * 256 + c * 64 + lane];
        const float mx = wave_max(fmaxf(fmaxf(sc[0], sc[1]), fmaxf(sc[2], sc[3])), lane);
        float e[4], ls = 0.f;
#pragma unroll
        for (int c = 0; c < 4; ++c) { e[c] = sc[c] > -1e29f ? __expf(sc[c] - mx) : 0.f; ls += e[c]; }
        ls = wave_sum(ls, lane);
        const float inv = ls > 0.f ? 1.0f / ls : 0.f;
#pragma unroll
        for (int c = 0; c < 4; ++c) wl[256 + g * 256 + c * 64 + lane] = e[c] * inv;
    }
    float oc[4] = {0.f, 0.f, 0.f, 0.f};
    const int nmax = t >= 31 ? ((t - 31) / 16 + 1 < NCMP ? (t - 31) / 16 + 1 : NCMP) : 0;
#pragma unroll 4
    for (int n = 0; n < nmax; ++n) {
        const float v = VC[(((size_t)b * NCMPP + n) * 2 + hkv) * 64 + lane];
#pragma unroll
        for (int g = 0; g < 4; ++g) oc[g] += wl[256 + g * 256 + n] * v;
    }
    float imp = 0.f;
#pragma unroll
    for (int g = 0; g < 4; ++g) {
        const LAS float* P = wl + 256 + g * 256;
        imp += P[4 * lane] + P[4 * lane + 1] + P[4 * lane + 2] + 0.5f * P[4 * lane + 3] + (lane > 0 ? 0.5f * P[4 * lane - 1] : 0.f);
    }
    const int blk = t >> 6;
    const bool forced = (lane == 0) || (lane <= blk && lane > blk - 2), future = lane > blk;
    const float v = forced ? 1e9f : (future ? -1e9f : imp);
    int rank = 0;
    for (int jj = 0; jj < 64; ++jj) { const float vj = lane_bcast(v, jj); rank += (vj > v) || (vj == v && jj < lane); }
    unsigned long long mask = __ballot(rank < 16 && !future);
    float m[4], l[4], o[4];
#pragma unroll
    for (int g = 0; g < 4; ++g) { m[g] = -1e30f; l[g] = 0.f; o[g] = 0.f; }
    while (mask) {
        const int j = __builtin_ctzll(mask); mask &= mask - 1;
        attn_chunk(wl, Z, rel_bias, b, hkv, t, 64 * j, ZC_KV + 256, ZC_KV + 384, lane, m, l, o);
    }
    float os[4];
#pragma unroll
    for (int g = 0; g < 4; ++g) { os[g] = l[g] > 0.f ? o[g] / l[g] : 0.f; m[g] = -1e30f; l[g] = 0.f; o[g] = 0.f; }
    for (int c = 0; c < 8; ++c) attn_chunk(wl, Z, rel_bias, b, hkv, t, t - 511 + 64 * c, ZC_KV + 512, ZC_KV + 640, lane, m, l, o);
#pragma unroll
    for (int g = 0; g < 4; ++g) {
        const float ow = l[g] > 0.f ? o[g] / l[g] : 0.f;
        const bf16* gp = Z + row * ZP + ZC_G + hkv * 12 + g * 3;
        const float r = sigmoidf_(bf2f(gp[0])) * oc[g] + sigmoidf_(bf2f(gp[1])) * os[g] + sigmoidf_(bf2f(gp[2])) * ow;
        YC[row * DM + D_SSM + hkv * 256 + g * 64 + lane] = (bf16)f2bf(r);
    }
}

__device__ __forceinline__ void ph_norm_route(const Frame& F, const float* x, const float* g, const float* rgw, const float* rgb, const float* rew, const float* reb, bf16* hn,
                                              unsigned* gcnt, unsigned* list, float* listw) {
    LAS unsigned* cnt_l = (LAS unsigned*)F.lds; LAS unsigned* base_l = cnt_l + 32; LAS unsigned* ent = cnt_l + 64;
    for (int row0 = F.blk * 128; row0 < T; row0 += F.G * 128) {
        if (F.tid < 32) cnt_l[F.tid] = 0u;
        __syncthreads();
        for (int kk = 0; kk < 16; ++kk) {
            const int row = row0 + F.wave * 16 + kk;
            const f32x4* xr = (const f32x4*)(x + (size_t)row * DM);
            f32x4 v[4]; float s = 0.f;
#pragma unroll
            for (int j = 0; j < 4; ++j) { v[j] = xr[F.lane + 64 * j]; s += v[j].x * v[j].x + v[j].y * v[j].y + v[j].z * v[j].z + v[j].w * v[j].w; }
            s = wave_sum(s, F.lane);
            const float r = rsqrtf(s * (1.0f / DM) + EPS);
            float lg[4] = {0.f, 0.f, 0.f, 0.f};
#pragma unroll
            for (int j = 0; j < 4; ++j) {
                const f32x4 gg = ((const f32x4*)g)[F.lane + 64 * j];
                v[j].x = v[j].x * r * gg.x; v[j].y = v[j].y * r * gg.y; v[j].z = v[j].z * r * gg.z; v[j].w = v[j].w * r * gg.w;
                u32x2 o; o.x = pk2(v[j].x, v[j].y); o.y = pk2(v[j].z, v[j].w);
                *(u32x2*)(hn + (size_t)row * DM + (F.lane + 64 * j) * 4) = o;
                const int c0 = (F.lane + 64 * j) * 4;
                const f32x4 w0 = ((const f32x4*)rgw)[c0], w1 = ((const f32x4*)rgw)[c0 + 1], w2 = ((const f32x4*)rgw)[c0 + 2], w3 = ((const f32x4*)rgw)[c0 + 3];
                lg[0] += v[j].x * w0.x + v[j].y * w1.x + v[j].z * w2.x + v[j].w * w3.x;
                lg[1] += v[j].x * w0.y + v[j].y * w1.y + v[j].z * w2.y + v[j].w * w3.y;
                lg[2] += v[j].x * w0.z + v[j].y * w1.z + v[j].z * w2.z + v[j].w * w3.z;
                lg[3] += v[j].x * w0.w + v[j].y * w1.w + v[j].z * w2.w + v[j].w * w3.w;
            }
#pragma unroll
            for (int o = 0; o < 4; ++o) lg[o] = wave_sum(lg[o], F.lane) + rgb[o];
            int gi = 0; float gm = lg[0];
#pragma unroll
            for (int o = 1; o < 4; ++o) if (lg[o] > gm) { gm = lg[o]; gi = o; }
            float gs = 0.f;
#pragma unroll
            for (int o = 0; o < 4; ++o) gs += __expf(lg[o] - gm);
            const float gval = 1.0f / gs;
            const float* we = rew + (size_t)gi * DM * 8;
            float le[8] = {0.f, 0.f, 0.f, 0.f, 0.f, 0.f, 0.f, 0.f};
#pragma unroll
            for (int j = 0; j < 4; ++j) {
                const int c0 = (F.lane + 64 * j) * 4;
                const float hv[4] = {v[j].x, v[j].y, v[j].z, v[j].w};
#pragma unroll
                for (int c = 0; c < 4; ++c) {
                    const f32x4 wa = ((const f32x4*)we)[(c0 + c) * 2], wb = ((const f32x4*)we)[(c0 + c) * 2 + 1];
                    le[0] += hv[c] * wa.x; le[1] += hv[c] * wa.y; le[2] += hv[c] * wa.z; le[3] += hv[c] * wa.w;
                    le[4] += hv[c] * wb.x; le[5] += hv[c] * wb.y; le[6] += hv[c] * wb.z; le[7] += hv[c] * wb.w;
                }
            }
#pragma unroll
            for (int e = 0; e < 8; ++e) le[e] = wave_sum(le[e], F.lane) + reb[gi * 8 + e];
            int e1 = 0; float m1 = le[0];
#pragma unroll
            for (int e = 1; e < 8; ++e) if (le[e] > m1) { m1 = le[e]; e1 = e; }
            int e2 = -1; float m2 = -3.0e38f;
#pragma unroll
            for (int e = 0; e < 8; ++e) if (e != e1 && le[e] > m2) { m2 = le[e]; e2 = e; }
            const float p2 = __expf(m2 - m1), inv = 1.0f / (1.0f + p2);
            if (F.lane == 0) {
                const unsigned ea = (unsigned)(gi * 8 + e1), eb = (unsigned)(gi * 8 + e2);
                const unsigned pa = __hip_atomic_fetch_add(cnt_l + ea, 1u, __ATOMIC_RELAXED, __HIP_MEMORY_SCOPE_WORKGROUP);
                const unsigned pb = __hip_atomic_fetch_add(cnt_l + eb, 1u, __ATOMIC_RELAXED, __HIP_MEMORY_SCOPE_WORKGROUP);
                LAS unsigned* en = ent + (F.wave * 16 + kk) * 6;
                en[0] = ea; en[1] = eb; en[2] = pa; en[3] = pb; en[4] = __float_as_uint(gval * inv); en[5] = __float_as_uint(gval * p2 * inv);
            }
        }
        __syncthreads();
        if (F.tid < 32) base_l[F.tid] = __hip_atomic_fetch_add(gcnt + F.tid * 64, cnt_l[F.tid], __ATOMIC_RELAXED, __HIP_MEMORY_SCOPE_AGENT);
        __syncthreads();
        if (F.tid < 128) {
            const LAS unsigned* en = ent + F.tid * 6; const unsigned tok = (unsigned)(row0 + F.tid);
            const unsigned ia = en[0] * LCAP + base_l[en[0]] + en[2], ib = en[1] * LCAP + base_l[en[1]] + en[3];
            list[ia] = tok * 2u; listw[ia] = __uint_as_float(en[4]);
            list[ib] = tok * 2u + 1u; listw[ib] = __uint_as_float(en[5]);
        }
        __syncthreads();
    }
}
__device__ __forceinline__ void build_expert_tab(const Frame& F, const unsigned* gcnt, LAS int* tab) {
    if (F.tid < 64) {
        const int c = F.lane < 32 ? (int)__hip_atomic_load(gcnt + F.lane * 64, __ATOMIC_RELAXED, __HIP_MEMORY_SCOPE_AGENT) : 0;
        int tiles = (c + 255) >> 8, incl = tiles;
#pragma unroll
        for (int o = 1; o < 32; o <<= 1) { const int t = __builtin_amdgcn_ds_bpermute((F.lane - o) << 2, incl); if (F.lane >= o) incl += t; }
        if (F.lane < 32) { tab[F.lane + 1] = incl; tab[33 + F.lane] = c; }
        if (F.lane == 0) tab[0] = 0;
    }
    __syncthreads();
}
__device__ __forceinline__ void ph_experts_naive(const Frame& F, const bf16* hn, const unsigned* route, const float* wg, const float* wu, const float* wd, float* x) {
    LAS float* hs = (LAS float*)F.lds;
    LAS float* hd = hs + 1024;
    for (int tok = F.blk; tok < T; tok += F.G) {
        { const unsigned pv = *(const unsigned*)(hn + (size_t)tok * DM + F.tid * 2); hs[F.tid * 2] = __uint_as_float(pv << 16); hs[F.tid * 2 + 1] = __uint_as_float(pv & 0xffff0000u); }
        const u32x4 rt = *(const u32x4*)(route + (size_t)tok * 4);
        __syncthreads();
        {
            const int s = F.tid >> 8, f = F.tid & 255;
            const unsigned e = s ? rt.y : rt.x; const float w = __uint_as_float(s ? rt.w : rt.z);
            const float* pg = wg + (size_t)e * DM * 256 + f; const float* pu = wu + (size_t)e * DM * 256 + f;
            float ga = 0.f, ua = 0.f;
            for (int d = 0; d < DM; ++d) { const float hv = hs[d]; ga += hv * pg[(size_t)d * 256]; ua += hv * pu[(size_t)d * 256]; }
            hd[s * 256 + f] = ga * sigmoidf_(ga) * ua * w;
        }
        __syncthreads();
        for (int dd = F.tid; dd < DM; dd += NTHR) {
            float acc = 0.f;
            const float* p0 = wd + (size_t)rt.x * 256 * DM + dd; const float* p1 = wd + (size_t)rt.y * 256 * DM + dd;
            for (int f = 0; f < 256; ++f) acc += hd[f] * p0[(size_t)f * DM];
            for (int f = 0; f < 256; ++f) acc += hd[256 + f] * p1[(size_t)f * DM];
            x[(size_t)tok * DM + dd] += acc;
        }
        __syncthreads();
    }
}


namespace nsa {
typedef short bf16x8 __attribute__((ext_vector_type(8)));
typedef short s16x4 __attribute__((ext_vector_type(4)));
typedef float f32x16 __attribute__((ext_vector_type(16)));
typedef float f32x2_t __attribute__((ext_vector_type(2)));
typedef __bf16 bf16x2_t __attribute__((ext_vector_type(2)));
constexpr int SLOTB = 8192;
constexpr int L_K = 0, L_V = 3 * SLOTB, L_IMP = 6 * SLOTB, L_BT = L_IMP + 65536, L_WS = L_BT + 4 * 132 * 4, L_RL = L_WS + 8 * 64 * 4, L_SM = L_RL + 4 * 64 * 4, L_END = L_SM + 64 * 8;
static_assert(L_END <= 131072, "nsa LDS map");
constexpr float LOG2E = 1.4426950408889634f;
constexpr float NEG_INF = -__builtin_inff();
#define NSA_SBAR() __builtin_amdgcn_sched_barrier(0)
__device__ __forceinline__ int crow(int r, int hi) { return (r & 3) + 8 * (r >> 2) + 4 * hi; }
__device__ __forceinline__ void glds16(const void* gsrc, unsigned lds_dst) { unsigned keep;
    asm volatile("s_mov_b32 %0, m0\n\ts_mov_b32 m0, %2\n\ts_nop 0\n\tglobal_load_lds_dwordx4 %1, off\n\ts_mov_b32 m0, %0" : "=&s"(keep) : "v"(gsrc), "s"(lds_dst) : "memory"); }
__device__ __forceinline__ unsigned cvtpk(float lo, float hi) { f32x2_t v = {lo, hi}; bf16x2_t b = __builtin_convertvector(v, bf16x2_t); return __builtin_bit_cast(unsigned, b); }
#define NSA_WAIT_BAR(N) asm volatile("s_waitcnt vmcnt(" #N ") lgkmcnt(0)\n\ts_barrier" ::: "memory")
__device__ __forceinline__ void qkt(f32x16& p0, f32x16& p1, const LAS char* kb, const bf16x8 (&qr)[4], const f32x16& cinit) {
#pragma unroll
    for (int d0 = 0; d0 < 4; ++d0) {
        const bf16x8 b0 = *(const LAS bf16x8*)(kb + d0 * 2048);
        const bf16x8 b1 = *(const LAS bf16x8*)(kb + d0 * 2048 + 512);
        if (d0 == 0) { p0 = __builtin_amdgcn_mfma_f32_32x32x16_bf16(b0, qr[0], cinit, 0, 0, 0); p1 = __builtin_amdgcn_mfma_f32_32x32x16_bf16(b1, qr[0], cinit, 0, 0, 0); }
        else { p0 = __builtin_amdgcn_mfma_f32_32x32x16_bf16(b0, qr[d0], p0, 0, 0, 0); p1 = __builtin_amdgcn_mfma_f32_32x32x16_bf16(b1, qr[d0], p1, 0, 0, 0); }
    }
}
__device__ __forceinline__ void pv(f32x16 (&o)[2], int vb, bf16x8 pa0, bf16x8 pa1, bf16x8 pa2, bf16x8 pa3) {
#pragma unroll
    for (int d0 = 0; d0 < 2; ++d0) { s16x4 lo[4], hi[4];
#pragma unroll
        for (int ks = 0; ks < 4; ++ks) {
            asm volatile("ds_read_b64_tr_b16 %0,%1 offset:%c2" : "=&v"(lo[ks]) : "v"(vb), "i"(d0 * 4096 + ks * 1024) : "memory");
            asm volatile("ds_read_b64_tr_b16 %0,%1 offset:%c2" : "=&v"(hi[ks]) : "v"(vb), "i"(d0 * 4096 + ks * 1024 + 512) : "memory"); }
        asm volatile("s_waitcnt lgkmcnt(0)" ::: "memory"); NSA_SBAR();
#define NSA_PK(k) (bf16x8){lo[k][0], lo[k][1], lo[k][2], lo[k][3], hi[k][0], hi[k][1], hi[k][2], hi[k][3]}
        o[d0] = __builtin_amdgcn_mfma_f32_32x32x16_bf16(pa0, NSA_PK(0), o[d0], 0, 0, 0);
        o[d0] = __builtin_amdgcn_mfma_f32_32x32x16_bf16(pa1, NSA_PK(1), o[d0], 0, 0, 0);
        o[d0] = __builtin_amdgcn_mfma_f32_32x32x16_bf16(pa2, NSA_PK(2), o[d0], 0, 0, 0);
        o[d0] = __builtin_amdgcn_mfma_f32_32x32x16_bf16(pa3, NSA_PK(3), o[d0], 0, 0, 0);
#undef NSA_PK
    }
}
__device__ __forceinline__ float other_half(float v, int hi) { auto rr = __builtin_amdgcn_permlane32_swap(__float_as_uint(v), __float_as_uint(v), false, false); return __uint_as_float(hi ? rr[0] : rr[1]); }
__device__ __forceinline__ float rowmax(const f32x16& p0, const f32x16& p1, int hi) {
    float a = fmaxf(fmaxf(p0[0], p0[1]), p1[0]), b = fmaxf(fmaxf(p0[2], p0[3]), p1[1]); a = fmaxf(fmaxf(a, p1[2]), p1[3]);
#pragma unroll
    for (int r = 4; r < 16; r += 4) { a = fmaxf(fmaxf(a, p0[r]), p0[r + 1]); b = fmaxf(fmaxf(b, p0[r + 2]), p0[r + 3]); a = fmaxf(fmaxf(a, p1[r]), p1[r + 1]); b = fmaxf(fmaxf(b, p1[r + 2]), p1[r + 3]); }
    const float m = fmaxf(a, b);
    return fmaxf(m, other_half(m, hi));
}
__device__ __forceinline__ void pack_p(const f32x16& p0, const f32x16& p1, bf16x8& a0, bf16x8& a1, bf16x8& a2, bf16x8& a3) {
    u32x4 w0, w1, w2, w3;
    w0 = (u32x4){cvtpk(p0[0], p0[1]), cvtpk(p0[2], p0[3]), cvtpk(p0[4], p0[5]), cvtpk(p0[6], p0[7])};
    w1 = (u32x4){cvtpk(p0[8], p0[9]), cvtpk(p0[10], p0[11]), cvtpk(p0[12], p0[13]), cvtpk(p0[14], p0[15])};
    w2 = (u32x4){cvtpk(p1[0], p1[1]), cvtpk(p1[2], p1[3]), cvtpk(p1[4], p1[5]), cvtpk(p1[6], p1[7])};
    w3 = (u32x4){cvtpk(p1[8], p1[9]), cvtpk(p1[10], p1[11]), cvtpk(p1[12], p1[13]), cvtpk(p1[14], p1[15])};
    a0 = __builtin_bit_cast(bf16x8, w0); a1 = __builtin_bit_cast(bf16x8, w1); a2 = __builtin_bit_cast(bf16x8, w2); a3 = __builtin_bit_cast(bf16x8, w3);
}

struct Ctx {
    LAS char* lds; unsigned lds0; int wid, lane, r32, hi, g, th, qloc;
    const LAS float* bt;
    LAS float* wsf;
    const LAS float* wrow;
    int vb0;
    const LAS char* kb0;
};
__device__ __forceinline__ void dma_k(const Ctx& c, const bf16* kbase, int pitch, int slot) { glds16(kbase + (size_t)c.lane * pitch + c.wid * 8, (unsigned)__builtin_amdgcn_readfirstlane(c.lds0 + L_K + slot * SLOTB + c.wid * 1024)); }
__device__ __forceinline__ void dma_v(const Ctx& c, const bf16* vbase, int pitch, int slot) { glds16(vbase + (size_t)(16 * (c.wid & 3) + (c.lane >> 2)) * pitch + (c.wid >> 2) * 32 + (c.lane & 3) * 8, (unsigned)__builtin_amdgcn_readfirstlane(c.lds0 + L_V + slot * SLOTB + c.wid * 1024)); }

__device__ __forceinline__ void cmp_scores(const Ctx& c, int slot, const bf16x8 (&qr)[4], int t0, int kt, f32x16& p0, f32x16& p1) {
    const int dmin = t0 + 32 * c.th - 16 * (64 * kt + 63) - 31;
    const bool special = dmin < 113;
    f32x16 ci; { const float v = special ? 0.f : c.bt[128];
#pragma unroll
        for (int r = 0; r < 16; ++r) ci[r] = v; }
    qkt(p0, p1, c.kb0 + slot * SLOTB, qr, ci);
    if (special) {
        int hi64 = 64 * c.hi; asm volatile("" : "+v"(hi64));
        const int dqh = t0 + c.qloc - 1024 * kt - 31 - hi64;
#pragma unroll
        for (int r = 0; r < 16; ++r) {
            const int d0 = dqh - 16 * ((r & 3) + 8 * (r >> 2)), d1 = d0 - 512;
            const float b0 = c.bt[d0 < 0 ? 0 : (d0 > 128 ? 128 : d0)], b1 = c.bt[d1 < 0 ? 0 : (d1 > 128 ? 128 : d1)];
            p0[r] = d0 < 0 ? NEG_INF : p0[r] + b0; p1[r] = d1 < 0 ? NEG_INF : p1[r] + b1;
        }
    }
}
template <int MODE>
__device__ __forceinline__ void online_tile(const Ctx& c, int slot, const bf16x8 (&qr)[4], int dq, bool near, bool masked_tile, bool lane_off, float& mhat, float& lsum, f32x16 (&o)[2]) {
    f32x16 ci; { const float v = (near ? 0.f : c.bt[128]) - mhat;
#pragma unroll
        for (int r = 0; r < 16; ++r) ci[r] = v; }
    f32x16 p0, p1;
    qkt(p0, p1, c.kb0 + slot * SLOTB, qr, ci);
    if (near || masked_tile) {
        int hi4 = 4 * c.hi; asm volatile("" : "+v"(hi4));
        const int dqh = dq - hi4;
#pragma unroll
        for (int r = 0; r < 16; ++r) {
            const int d0 = dqh - ((r & 3) + 8 * (r >> 2)), d1 = d0 - 32;
            if (near) { p0[r] += c.bt[d0 < 0 ? 0 : (d0 > 128 ? 128 : d0)]; p1[r] += c.bt[d1 < 0 ? 0 : (d1 > 128 ? 128 : d1)]; }
            if (d0 < 0 || (MODE == 1 && d0 >= 512)) p0[r] = NEG_INF;
            if (d1 < 0 || (MODE == 1 && d1 >= 512)) p1[r] = NEG_INF;
        }
    }
    if (MODE == 0) { if (lane_off) {
#pragma unroll
        for (int r = 0; r < 16; ++r) { p0[r] = NEG_INF; p1[r] = NEG_INF; } } }
    const float rm = rowmax(p0, p1, c.hi);
    if (__any(rm > 8.0f)) {
        const float dl = fmaxf(rm, 0.f); mhat += dl;
#pragma unroll
        for (int r = 0; r < 16; ++r) { p0[r] -= dl; p1[r] -= dl; }
        const float f = __builtin_amdgcn_exp2f(-dl); lsum *= f;
        if (c.hi == 0) c.wsf[c.r32] = f;
        asm volatile("s_waitcnt lgkmcnt(0)" ::: "memory");
#pragma unroll
        for (int r = 0; r < 16; ++r) { const float fr = c.wrow[(r & 3) + 8 * (r >> 2)]; o[0][r] *= fr; o[1][r] *= fr; }
    }
    float sacc = 0.f;
#pragma unroll
    for (int r = 0; r < 16; ++r) { p0[r] = __builtin_amdgcn_exp2f(p0[r]); p1[r] = __builtin_amdgcn_exp2f(p1[r]); sacc += p0[r] + p1[r]; }
    lsum += sacc;
    bf16x8 a0, a1, a2, a3; pack_p(p0, p1, a0, a1, a2, a3);
    pv(o, c.vb0 + slot * SLOTB, a0, a1, a2, a3);
}
__device__ __forceinline__ void add_scaled(const Ctx& c, f32x16 (&oacc)[2], const f32x16 (&o)[2], float s) {
    if (c.hi == 0) c.wsf[32 + c.r32] = s;
    asm volatile("s_waitcnt lgkmcnt(0)" ::: "memory");
#pragma unroll
    for (int r = 0; r < 16; ++r) { const float f = c.wrow[32 + (r & 3) + 8 * (r >> 2)]; oacc[0][r] += o[0][r] * f; oacc[1][r] += o[1][r] * f; }
    asm volatile("s_waitcnt lgkmcnt(0)" ::: "memory");
}

__device__ __forceinline__ void unit(LAS char* lds, int tid, int b, int hkv, int jt, const bf16* Z, const bf16* KCm, const bf16* VCm, const float* rel_bias, bf16* YC) {
    Ctx c; c.lds = lds; c.lds0 = (unsigned)(uintptr_t)lds; c.wid = __builtin_amdgcn_readfirstlane(tid >> 6); c.lane = tid & 63; c.r32 = c.lane & 31; c.hi = c.lane >> 5;
    c.g = c.wid & 3; c.th = c.wid >> 2; c.qloc = 32 * c.th + c.r32;
    c.bt = (const LAS float*)(lds + L_BT) + c.g * 132; c.wsf = (LAS float*)(lds + L_WS) + c.wid * 64; c.wrow = c.wsf + 4 * c.hi;
    c.vb0 = (int)(c.lds0 + L_V) + ((c.lane >> 4) & 1) * 32 + (c.lane & 3) * 8 + (4 * c.hi + ((c.lane & 15) >> 2)) * 64;
    c.kb0 = (const LAS char*)(lds + L_K) + c.hi * 1024 + c.r32 * 16;
    const int t0 = 64 * jt;
    const bf16* Zb = Z + (size_t)b * SEQ * ZP;
    const size_t qrow = (size_t)b * SEQ + t0 + c.qloc;
    for (int i = tid; i < 4 * 129; i += NTHR) { const int gg = i / 129, d = i % 129; ((LAS float*)(lds + L_BT))[gg * 132 + d] = rel_bias[t5_bucket(d) * 8 + hkv * 4 + gg] * LOG2E; }
    bf16x8 qr[4];
#pragma unroll
    for (int d0 = 0; d0 < 4; ++d0) qr[d0] = *(const bf16x8*)(Z + qrow * ZP + ZC_Q + hkv * 256 + c.g * 64 + d0 * 16 + c.hi * 8);
    const bf16* gp = Z + qrow * ZP + ZC_G + hkv * 12 + c.g * 3;
    const float gate0 = sigmoidf_(bf2f(gp[0])), gate1 = sigmoidf_(bf2f(gp[1])), gate2 = sigmoidf_(bf2f(gp[2]));
    f32x16 oacc[2];
#pragma unroll
    for (int r = 0; r < 16; ++r) { oacc[0][r] = 0.f; oacc[1][r] = 0.f; }

    const int nct = (4 * jt + 2) / 64 + 1;
    const bf16* kcb = KCm + (size_t)b * NCMPP * 128 + hkv * 64; const bf16* vcb = VCm + (size_t)b * NCMPP * 128 + hkv * 64;
    float mrow = NEG_INF;
    {
        dma_k(c, kcb, 128, 0); if (nct > 1) dma_k(c, kcb + 64 * 128, 128, 1);
        for (int i = 0; i < nct; ++i) {
            if (i + 1 < nct) NSA_WAIT_BAR(1); else NSA_WAIT_BAR(0);
            if (i + 2 < nct) dma_k(c, kcb + (size_t)(i + 2) * 64 * 128, 128, (i + 2) % 3);
            f32x16 p0, p1; cmp_scores(c, i % 3, qr, t0, i, p0, p1);
            mrow = fmaxf(mrow, rowmax(p0, p1, c.hi));
        }
        NSA_WAIT_BAR(0);
    }
    {
        const float muse = mrow == NEG_INF ? 0.f : mrow;
        float lsum = 0.f, carry = 0.f; f32x16 o[2];
#pragma unroll
        for (int r = 0; r < 16; ++r) { o[0][r] = 0.f; o[1][r] = 0.f; }
        LAS float* impw = (LAS float*)(lds + L_IMP) + (c.g * 64 + c.qloc) * 64;
        dma_k(c, kcb, 128, 0); dma_v(c, vcb, 128, 0); if (nct > 1) { dma_k(c, kcb + 64 * 128, 128, 1); dma_v(c, vcb + 64 * 128, 128, 1); }
        for (int i = 0; i < nct; ++i) {
            if (i + 1 < nct) NSA_WAIT_BAR(2); else NSA_WAIT_BAR(0);
            if (i + 2 < nct) { dma_k(c, kcb + (size_t)(i + 2) * 64 * 128, 128, (i + 2) % 3); dma_v(c, vcb + (size_t)(i + 2) * 64 * 128, 128, (i + 2) % 3); }
            f32x16 p0, p1; cmp_scores(c, i % 3, qr, t0, i, p0, p1);
            float sacc = 0.f;
#pragma unroll
            for (int r = 0; r < 16; ++r) { p0[r] = __builtin_amdgcn_exp2f(p0[r] - muse); p1[r] = __builtin_amdgcn_exp2f(p1[r] - muse); sacc += p0[r] + p1[r]; }
            lsum += sacc;
            float o3[8];
#pragma unroll
            for (int k = 0; k < 4; ++k) { o3[k] = other_half(p0[4 * k + 3], c.hi); o3[4 + k] = other_half(p1[4 * k + 3], c.hi); }
#pragma unroll
            for (int idx = 0; idx < 8; ++idx) {
                const int X = idx >> 2, k = idx & 3;
                const f32x16& p = X ? p1 : p0;
                const float cin = c.hi ? o3[idx] : (idx ? o3[idx - 1] : carry);
                impw[16 * i + 8 * X + 2 * k + c.hi] = p[4 * k] + p[4 * k + 1] + p[4 * k + 2] + 0.5f * p[4 * k + 3] + 0.5f * cin;
            }
            carry = o3[7];
            bf16x8 a0, a1, a2, a3; pack_p(p0, p1, a0, a1, a2, a3);
            pv(o, c.vb0 + (i % 3) * SLOTB, a0, a1, a2, a3);
        }
        const float lt = lsum + other_half(lsum, c.hi);
        const float rl = lt > 0.f ? 1.0f / lt : 0.f;
        if (c.hi == 0) ((LAS float*)(lds + L_RL))[c.g * 64 + c.qloc] = rl;
        add_scaled(c, oacc, o, rl * gate0);
        NSA_WAIT_BAR(0);
    }
    for (int k = 0; k < 8; ++k) {
        const int tok = c.wid * 8 + k;
        float v = 0.f;
#pragma unroll
        for (int gg = 0; gg < 4; ++gg) v += ((const LAS float*)(lds + L_IMP))[(gg * 64 + tok) * 64 + c.lane] * ((const LAS float*)(lds + L_RL))[gg * 64 + tok];
        const bool forced = (c.lane == 0) || (c.lane <= jt && c.lane > jt - 2), future = c.lane > jt;
        v = forced ? 1e9f : (future ? -1e9f : v);
        int rank = 0;
        for (int jj = 0; jj < 64; ++jj) { const float vj = lane_bcast(v, jj); rank += ((vj > v) || (vj == v && jj < c.lane)) ? 1 : 0; }
        const unsigned long long msk = __ballot(rank < 16 && !future);
        if (c.lane == 0) ((LAS unsigned long long*)(lds + L_SM))[tok] = msk;
    }
    NSA_WAIT_BAR(0);
    const unsigned long long mymask = ((const LAS unsigned long long*)(lds + L_SM))[c.qloc];
    {
        const bf16* kb = Zb + ZC_KV + 256 + hkv * 64; const bf16* vb = Zb + ZC_KV + 384 + hkv * 64;
        const int nt = jt + 1;
        float mhat = 0.f, lsum = 0.f; f32x16 o[2];
#pragma unroll
        for (int r = 0; r < 16; ++r) { o[0][r] = 0.f; o[1][r] = 0.f; }
        dma_k(c, kb, ZP, 0); dma_v(c, vb, ZP, 0); if (nt > 1) { dma_k(c, kb + (size_t)64 * ZP, ZP, 1); dma_v(c, vb + (size_t)64 * ZP, ZP, 1); }
        for (int i = 0; i < nt; ++i) {
            if (i + 1 < nt) NSA_WAIT_BAR(2); else NSA_WAIT_BAR(0);
            if (i + 2 < nt) { dma_k(c, kb + (size_t)(i + 2) * 64 * ZP, ZP, (i + 2) % 3); dma_v(c, vb + (size_t)(i + 2) * 64 * ZP, ZP, (i + 2) % 3); }
            online_tile<0>(c, i % 3, qr, 64 * (jt - i) + c.qloc, i >= jt - 2, i == jt, !((mymask >> i) & 1ull), mhat, lsum, o);
        }
        const float lt = lsum + other_half(lsum, c.hi);
        add_scaled(c, oacc, o, (lt > 0.f ? 1.0f / lt : 0.f) * gate1);
        NSA_WAIT_BAR(0);
    }
    {
        const int j0 = jt > 8 ? jt - 8 : 0, nt = jt - j0 + 1;
        const bf16* kb = Zb + (size_t)j0 * 64 * ZP + ZC_KV + 512 + hkv * 64; const bf16* vb = Zb + (size_t)j0 * 64 * ZP + ZC_KV + 640 + hkv * 64;
        float mhat = 0.f, lsum = 0.f; f32x16 o[2];
#pragma unroll
        for (int r = 0; r < 16; ++r) { o[0][r] = 0.f; o[1][r] = 0.f; }
        dma_k(c, kb, ZP, 0); dma_v(c, vb, ZP, 0); if (nt > 1) { dma_k(c, kb + (size_t)64 * ZP, ZP, 1); dma_v(c, vb + (size_t)64 * ZP, ZP, 1); }
        for (int i = 0; i < nt; ++i) {
            if (i + 1 < nt) NSA_WAIT_BAR(2); else NSA_WAIT_BAR(0);
            if (i + 2 < nt) { dma_k(c, kb + (size_t)(i + 2) * 64 * ZP, ZP, (i + 2) % 3); dma_v(c, vb + (size_t)(i + 2) * 64 * ZP, ZP, (i + 2) % 3); }
            const int j = j0 + i;
            online_tile<1>(c, i % 3, qr, 64 * (jt - j) + c.qloc, j >= jt - 2, j == jt || j == jt - 8, false, mhat, lsum, o);
        }
        const float lt = lsum + other_half(lsum, c.hi);
        add_scaled(c, oacc, o, (lt > 0.f ? 1.0f / lt : 0.f) * gate2);
    }
    {
        bf16* yb = YC + ((size_t)b * SEQ + t0 + 32 * c.th + 4 * c.hi) * DM + D_SSM + hkv * 256 + c.g * 64 + c.r32;
#pragma unroll
        for (int r = 0; r < 16; ++r) { bf16* yr = yb + (size_t)((r & 3) + 8 * (r >> 2)) * DM; yr[0] = (bf16)f2bf(oacc[0][r]); yr[32] = (bf16)f2bf(oacc[1][r]); }
    }
    asm volatile("s_waitcnt vmcnt(0)" ::: "memory");
    NSA_WAIT_BAR(0);
}
#undef NSA_SBAR
#undef NSA_WAIT_BAR
}


__device__ __forceinline__ void ssm_precompute(const Frame& F, const __attribute__((address_space(4))) Args* args, unsigned char* ws, int item) {
    const int layer = item >> 5, g = item & 31, lg = layer * 32 + g;
    LAS float* L = (LAS float*)F.lds;
    LAS float* lkr = L; LAS float* lki = L + 17 * 64; LAS float* bbr = L + 2 * 17 * 64; LAS float* bbi = bbr + 1024; LAS float* ccr = bbi + 1024; LAS float* cci = ccr + 1024;
    LAS float* wk = cci + 1024; LAS float* dd = wk + 4096;
    const float* a_re = args->in[6] + lg * 64; const float* a_im = args->in[7] + lg * 64;
    const float dt = expf(args->in[13][lg]);
    for (int i = F.tid; i < 17 * 64; i += NTHR) { const int k = i >> 6, p = i & 63; const float er = expf(a_re[p] * dt * (float)k), ang = a_im[p] * dt * (float)k; lkr[i] = er * cosf(ang); lki[i] = er * sinf(ang); }
    for (int i = F.tid; i < 1024; i += NTHR) {
        { const int p = i >> 4, h = i & 15; const float are = a_re[p], aim = a_im[p];
          const float er = expf(are * dt), lbr = er * cosf(aim * dt), lbi = er * sinf(aim * dt);
          const float xx = lbr - 1.0f, yy = lbi, den = are * are + aim * aim, fr = (xx * are + yy * aim) / den, fi = (yy * are - xx * aim) / den;
          const float br = args->in[8][((size_t)lg * 64 + p) * 16 + h], bi = args->in[9][((size_t)lg * 64 + p) * 16 + h];
          bbr[i] = fr * br - fi * bi; bbi[i] = fr * bi + fi * br; }
        ccr[i] = args->in[10][(size_t)lg * 1024 + i]; cci[i] = args->in[11][(size_t)lg * 1024 + i];
    }
    if (F.tid < 16) dd[F.tid] = args->in[12][lg * 16 + F.tid];
    __syncthreads();
    for (int i = F.tid; i < 4096; i += NTHR) { const int k = i >> 8, ho = (i >> 4) & 15, hi = i & 15; float acc = 0.f;
        for (int p = 0; p < 64; ++p) { const float cr = ccr[ho * 64 + p], ci = cci[ho * 64 + p], lr = lkr[k * 64 + p], li = lki[k * 64 + p];
            const float tr = cr * lr - ci * li, ti = cr * li + ci * lr; acc += tr * bbr[p * 16 + hi] - ti * bbi[p * 16 + hi]; }
        wk[i] = acc + ((k == 0 && ho == hi) ? dd[ho] : 0.f); }
    __syncthreads();
    bf16* B2 = (bf16*)(ws + WS_BT2) + (size_t)lg * 256 * 384;
    for (int i = F.tid; i < 256 * 384; i += NTHR) { const int n = i / 384, kk = i % 384, t = n >> 4, ho = n & 15; float v;
        if (kk < 256) { const int sidx = kk >> 4, hi = kk & 15; v = sidx <= t ? wk[((t - sidx) << 8) + ho * 16 + hi] : 0.f; }
        else { const int j = kk - 256, p = j & 63; const float cr = ccr[ho * 64 + p], ci = cci[ho * 64 + p], lr = lkr[(t + 1) * 64 + p], li = lki[(t + 1) * 64 + p];
            v = j < 64 ? (cr * lr - ci * li) : -(cr * li + ci * lr); }
        B2[i] = (bf16)f2bf(v); }
    bf16* B1 = (bf16*)(ws + WS_BT1) + (size_t)lg * 256 * 256;
    for (int i = F.tid; i < 65536; i += NTHR) { const int j = i >> 8, kk = i & 255, sidx = kk >> 4, hi = kk & 15; float v = 0.f;
        if (j < 128) { const int p = j & 63; const float lr = lkr[(15 - sidx) * 64 + p], li = lki[(15 - sidx) * 64 + p], br = bbr[p * 16 + hi], bi = bbi[p * 16 + hi];
            v = j < 64 ? (lr * br - li * bi) : (lr * bi + li * br); }
        B1[i] = (bf16)f2bf(v); }
    __syncthreads();
}
__device__ __forceinline__ void ssm_carry_item(int b, int g, const float* a_re, const float* a_im, const float* log_dt, const float* XL, bf16* U, int lane) {
    const float dt16 = 16.0f * expf(log_dt[g]);
    const float er = expf(a_re[g * 64 + lane] * dt16), ang = a_im[g * 64 + lane] * dt16, lr = er * cosf(ang), li = er * sinf(ang);
    float xr = 0.f, xi = 0.f;
    const float* xl = XL + ((size_t)g * 2048 + b * 256) * 128 + lane;
    bf16* up = U + ((size_t)g * 2048 + b * 256) * 512 + 256 + lane;
#pragma unroll 8
    for (int c = 0; c < 256; ++c) {
        up[(size_t)c * 512] = (bf16)f2bf(xr); up[(size_t)c * 512 + 64] = (bf16)f2bf(xi);
        const float ar = xl[(size_t)c * 128], ai = xl[(size_t)c * 128 + 64];
        const float nr = lr * xr - li * xi + ar, ni = lr * xi + li * xr + ai;
        xr = nr; xi = ni;
    }
}

__device__ __forceinline__ void transpose_item(const float* W, int K, int N, bf16* WT, int k0, int n0, int drow0, LAS float* scr, int lane, float scale = 1.0f) {
#pragma unroll 8
    for (int i = 0; i < 32; ++i) { const int kk = 2 * i + (lane >> 5); scr[kk * 33 + (lane & 31)] = W[(size_t)(k0 + kk) * N + n0 + (lane & 31)]; }
    asm volatile("s_waitcnt lgkmcnt(0)" ::: "memory");
    const int c = lane & 7;
#pragma unroll
    for (int j = 0; j < 4; ++j) { const int n = (lane >> 3) + 8 * j; const LAS float* sp = scr + (8 * c) * 33 + n;
        u32x4 o; o.x = pk2(sp[0 * 33] * scale, sp[1 * 33] * scale); o.y = pk2(sp[2 * 33] * scale, sp[3 * 33] * scale); o.z = pk2(sp[4 * 33] * scale, sp[5 * 33] * scale); o.w = pk2(sp[6 * 33] * scale, sp[7 * 33] * scale);
        *(u32x4*)(WT + (size_t)(drow0 + n) * K + k0 + 8 * c) = o; }
    asm volatile("s_waitcnt lgkmcnt(0)" ::: "memory");
}
__device__ __forceinline__ void ph_convert(const Frame& F, const __attribute__((address_space(4))) Args* args, unsigned char* ws) {
    for (int it = F.blk; it < DEPTH * NGRP; it += F.G) ssm_precompute(F, args, ws, it);
    LAS float* scr = (LAS float*)(F.lds + F.wave * 16384);
    const int gw = F.blk * NWAVES + F.wave, NGW = F.G * NWAVES;
    constexpr int I_IN = (DM / 64) * (1792 / 32), I_GLU = (D_SSM / 64) * (2 * D_SSM / 32), I_OUT = (DM / 64) * (DM / 32);
    constexpr int PER_LAYER = I_IN + I_GLU + I_OUT;
    for (int it = gw; it < DEPTH * 32 * 384; it += NGW) {
        const int le = it / 384, r = it % 384;
        if (r < 256) { const int isup = r >> 7, q = r & 127, nb = q & 7, kb = q >> 3, n0 = 32 * nb;
            transpose_item(args->in[isup ? 24 : 23] + (size_t)le * DM * 256, DM, 256, (bf16*)(ws + WS_WGU) + (size_t)le * 512 * DM, 64 * kb, n0, 256 * (n0 >> 7) + 128 * isup + (n0 & 127), scr, F.lane); }
        else { const int q = r - 256, nb = q & 31, kb = q >> 5;
            transpose_item(args->in[25] + (size_t)le * 256 * DM, 256, DM, (bf16*)(ws + WS_WDN) + (size_t)le * DM * 256, 64 * kb, 32 * nb, 32 * nb, scr, F.lane); }
    }
    for (int it = gw; it < DEPTH * PER_LAYER; it += NGW) {
        const int layer = it / PER_LAYER; int r = it % PER_LAYER;
        if (r < I_IN) { const int nb = r % 56, kb = r / 56;
            transpose_item(args->in[4] + (size_t)layer * DM * D_IN, DM, D_IN, (bf16*)(ws + WS_WIN) + (size_t)layer * ZP * DM, 64 * kb, 32 * nb, 32 * nb, scr, F.lane, (nb >= 16 && nb < 32) ? QSCALE : 1.0f); continue; }
        r -= I_IN;
        if (r < I_GLU) { const int nb = r % 32, kb = r / 32, n0 = 32 * nb;
            const int half = n0 >> 9, c = n0 & 511, drow = 256 * (c >> 7) + 128 * half + (c & 127);
            transpose_item(args->in[14] + (size_t)layer * D_SSM * 2 * D_SSM, D_SSM, 2 * D_SSM, (bf16*)(ws + WS_WGLU) + (size_t)layer * 2 * D_SSM * D_SSM, 64 * kb, n0, drow, scr, F.lane); continue; }
        r -= I_GLU;
        { const int nb = r % 32, kb = r / 32;
            transpose_item(args->in[5] + (size_t)layer * DM * DM, DM, DM, (bf16*)(ws + WS_WOUT) + (size_t)layer * DM * DM, 64 * kb, 32 * nb, 32 * nb, scr, F.lane); }
    }
    const int gt = F.blk * NTHR + F.tid, NGT = F.G * NTHR;
    for (int idx = gt; idx < DEPTH * 256 * DM; idx += NGT) {
        const int layer = idx / (256 * DM), rem = idx % (256 * DM), n = 1792 + rem / DM, k = rem % DM;
        const float v = n < D_IN ? args->in[4][(size_t)layer * DM * D_IN + (size_t)k * D_IN + n] : 0.f;
        ((bf16*)(ws + WS_WIN))[(size_t)layer * ZP * DM + (size_t)n * DM + k] = (bf16)f2bf(v);
    }
}

constexpr int PH_PER_LAYER = 10, N_PHASES = 1 + DEPTH * PH_PER_LAYER + 1;
#ifndef FAST_GEMM
#define FAST_GEMM 1
#endif

__global__ void __launch_bounds__(NTHR, 2) fwd(Args args) {
    extern __shared__ __attribute__((aligned(16))) unsigned char lds_raw[];
    Frame F;
    F.lds = (LAS unsigned char*)lds_raw;
    F.tid = threadIdx.x; F.lane = F.tid & 63; F.wave = __builtin_amdgcn_readfirstlane(F.tid >> 6);
    F.blk = blockIdx.x; F.G = gridDim.x;
    typedef const __attribute__((address_space(4))) Args* KArgs;
    KArgs kp = (KArgs)__builtin_amdgcn_kernarg_segment_ptr();
    asm volatile("" : "+s"(kp));
    unsigned char* ws = kp->ws;
    volatile LAS unsigned* MISC = (volatile LAS unsigned*)(F.lds + MISC_OFF);
    if (F.tid < 32) MISC[F.tid] = 0u;
    __syncthreads();
    XcdBarrier bar; bar.bar = (unsigned*)(ws + WS_CTL) + CW_BAR; bar.x = 0; bar.st = nullptr;
    if (N_LAUNCH_MODE == 1) bar = xcd_barrier_post((unsigned*)(ws + WS_CTL) + CW_BAR, MISC + 8);
#define IN(k) (kp->ph_lo <= (k) && (k) < kp->ph_hi)
#define FRESH_IDS() do { int l_; asm volatile("v_mbcnt_lo_u32_b32 %0, -1, 0\n\tv_mbcnt_hi_u32_b32 %0, -1, %0" : "=v"(l_)); asm volatile("" : "+s"(F.wave), "+s"(F.blk), "+s"(F.G)); F.lane = l_; F.tid = F.wave * 64 + l_; asm volatile("" : "+s"(kp)); ws = kp->ws; bar.bar = (unsigned*)(ws + WS_CTL) + CW_BAR; } while (0)
#define SEAM(k) do { FRESH_IDS(); if (IN(k) && IN((k) + 1)) xcd_barrier(bar, F.tid); FRESH_IDS(); } while (0)

    const float* x0 = kp->in[0];
    float* XR = kp->out;
#define HN ((bf16*)(ws + WS_HN))
#define Z ((bf16*)(ws + WS_Z))
#define YC ((bf16*)(ws + WS_YC))
#define G1 ((bf16*)(ws + WS_G1))
#define KC ((bf16*)(ws + WS_KC))
#define VC ((bf16*)(ws + WS_VC))
#define LIST ((unsigned*)(ws + WS_LIST))
#define LISTW ((float*)(ws + WS_LISTW))
#define HID ((bf16*)(ws + WS_HID))
#define P2 ((float*)(ws + WS_P2))
#define USSM ((bf16*)(ws + WS_USSM))
#define XL ((float*)(ws + WS_XL))
    LAS int* etab = (LAS int*)(F.lds + 131072);

    if (IN(0)) ph_convert(F, kp, ws);
    SEAM(0);
    for (int layer = 0; layer < DEPTH; ++layer) {
        const int pb = 1 + layer * PH_PER_LAYER;
        const float* xin = layer == 0 ? x0 : XR;
        unsigned* gcnt = (unsigned*)(ws + WS_CTL) + CW_CNT + layer * 32 * 64;
        if (IN(pb + 0)) ph_norm(F, xin, layer == 0 ? nullptr : P2, XR, kp->in[1] + layer * DM, HN);
        SEAM(pb + 0);
        if (IN(pb + 1)) {
            pg8::Gemm g{HN, (const bf16*)(ws + WS_WIN) + (size_t)layer * ZP * DM, T, ZP, DM, DM, 0, nullptr, 0, 0}; pg8::StaticOrder S; S.init(T, ZP, F.G, F.blk);
            pg8::EpiInProj E{Z, USSM};
            pg8::gemm2<pg8::EpiInProj, pg8::StaticOrder, false>(F.lds, g, S, E, F.tid);
        }
        SEAM(pb + 1);
        if (IN(pb + 2)) {
            { pg8::Gemm g{USSM, (const bf16*)(ws + WS_BT1) + (size_t)layer * 32 * 256 * 256, 0, 256, 256, 512, (size_t)256 * 256, nullptr, 0, (size_t)2048 * 512};
              pg8::BatchOrder S{NGRP, 8, 1, F.G, F.blk}; pg8::EpiXloc E{XL};
              pg8::gemm2<pg8::EpiXloc, pg8::BatchOrder, false>(F.lds, g, S, E, F.tid); }
            for (int it = F.blk * NWAVES + F.wave; it < BATCH * NCMPP * 4; it += F.G * NWAVES)
                compress_naive_item(it, Z, kp->in[15] + (size_t)layer * 2 * 32 * 64, kp->in[16] + (size_t)layer * 2 * 32 * 64 * 64, kp->in[17] + (size_t)layer * 2 * 64 * 64, KC, VC, F.lane);
        }
        SEAM(pb + 2);
        if (IN(pb + 3)) {
            if (F.wave == 0) for (int it = F.blk; it < BATCH * NGRP; it += F.G)
                ssm_carry_item(it / NGRP, it % NGRP, kp->in[6] + layer * NGRP * SST, kp->in[7] + layer * NGRP * SST, kp->in[13] + layer * NGRP, XL, USSM, F.lane);
        }
        SEAM(pb + 3);
        if (IN(pb + 4)) {
            pg8::Gemm g{USSM, (const bf16*)(ws + WS_BT2) + (size_t)layer * 32 * 256 * 384, 0, 256, 384, 512, (size_t)256 * 384, nullptr, 0, (size_t)2048 * 512};
            pg8::BatchOrder S{NGRP, 8, 1, F.G, F.blk}; pg8::EpiSsmOut E{G1};
            pg8::gemm2<pg8::EpiSsmOut, pg8::BatchOrder, false>(F.lds, g, S, E, F.tid);
        }
        SEAM(pb + 4);
        if (IN(pb + 5)) {
            { pg8::Gemm g{G1, (const bf16*)(ws + WS_WGLU) + (size_t)layer * 2 * D_SSM * D_SSM, T, 2 * D_SSM, D_SSM, D_SSM, 0, nullptr, 0, 0}; pg8::StaticOrder S; S.init(T, 2 * D_SSM, F.G, F.blk);
              pg8::EpiGlu E{YC, DM};
              pg8::gemm2<pg8::EpiGlu, pg8::StaticOrder, false>(F.lds, g, S, E, F.tid); }
            __syncthreads();
            for (int slot = F.blk; slot < 256; slot += F.G) {
                const int bh = slot >> 4, sq = slot & 15;
#pragma unroll 1
                for (int uq = 0; uq < 4; ++uq) { const int jt = uq == 0 ? 63 - sq : (uq == 1 ? 32 + sq : (uq == 2 ? 31 - sq : sq));
                    nsa::unit((LAS char*)F.lds, F.tid, bh >> 1, bh & 1, jt, Z, KC, VC, kp->in[18], YC); }
            }
        }
        SEAM(pb + 5);
        if (IN(pb + 6)) {
            pg8::Gemm g{YC, (const bf16*)(ws + WS_WOUT) + (size_t)layer * DM * DM, T, DM, DM, DM, 0, nullptr, 0, 0}; pg8::StaticOrder S; S.init(T, DM, F.G, F.blk);
            pg8::EpiResid E{xin, XR, DM};
            pg8::gemm2<pg8::EpiResid, pg8::StaticOrder, false>(F.lds, g, S, E, F.tid);
        }
        SEAM(pb + 6);
        if (IN(pb + 7)) ph_norm_route(F, XR, kp->in[2] + layer * DM, kp->in[19] + (size_t)layer * DM * 4, kp->in[20] + layer * 4, kp->in[21] + (size_t)layer * 4 * DM * 8, kp->in[22] + layer * 32, HN, gcnt, LIST, LISTW);
        SEAM(pb + 7);
        if (IN(pb + 8)) {
            build_expert_tab(F, gcnt, etab);
            pg8::Gemm g{HN, (const bf16*)(ws + WS_WGU) + (size_t)layer * 32 * 512 * DM, 0, 512, DM, DM, (size_t)512 * DM, LIST, LCAP, 0};
            pg8::ExpertOrder S{etab, 2, F.G, F.blk};
            pg8::EpiGateUp E{HID, LISTW, LCAP};
            pg8::gemm2<pg8::EpiGateUp, pg8::ExpertOrder, true>(F.lds, g, S, E, F.tid);
        }
        SEAM(pb + 8);
        if (IN(pb + 9)) {
            build_expert_tab(F, gcnt, etab);
            pg8::Gemm g{HID, (const bf16*)(ws + WS_WDN) + (size_t)layer * 32 * DM * 256, 0, DM, 256, 256, (size_t)DM * 256, nullptr, 0, 0};
            pg8::ExpertOrder S{etab, 4, F.G, F.blk};
            pg8::EpiDown E{XR, P2, LIST, LCAP};
            pg8::gemm2<pg8::EpiDown, pg8::ExpertOrder, false>(F.lds, g, S, E, F.tid);
        }
        SEAM(pb + 9);
    }
    if (IN(N_PHASES - 1)) ph_final_norm(F, XR, P2, kp->in[3]);
#undef IN
#undef SEAM
#undef HN
#undef Z
#undef YC
#undef G1
#undef KC
#undef VC
#undef LIST
#undef LISTW
#undef HID
#undef P2
#undef USSM
#undef XL
}

extern "C" void kernel_launch(void* const* d_in, const int* in_sizes, int n_in, void* d_out, int out_size, void* d_ws, size_t ws_size, hipStream_t stream) {
    static int grid = 0;
    if (grid == 0) {
        if (n_in != 26 || out_size != T * DM || ws_size < WS_END) { fprintf(stderr, "kernel_launch: unexpected shapes (n_in %d out %d ws %zu)\n", n_in, out_size, ws_size); grid = -1; return; }
        int dev = 0, cus = 0, per_cu = 0;
        if (hipGetDevice(&dev) != hipSuccess || hipDeviceGetAttribute(&cus, hipDeviceAttributeMultiprocessorCount, dev) != hipSuccess) { grid = -1; return; }
        if (hipFuncSetAttribute((const void*)fwd, hipFuncAttributeMaxDynamicSharedMemorySize, LDS_BYTES) != hipSuccess) { fprintf(stderr, "kernel_launch: hipFuncSetAttribute failed\n"); grid = -1; return; }
        if (hipOccupancyMaxActiveBlocksPerMultiprocessor(&per_cu, (const void*)fwd, NTHR, LDS_BYTES) != hipSuccess || per_cu < 1) fprintf(stderr, "kernel_launch: occupancy query says %d\n", per_cu);
        (void)hipGetLastError();
        grid = cus;
    }
    if (grid < 0) return;
    (void)hipMemsetAsync((char*)d_ws + WS_CTL, 0, CTL_ZERO_BYTES, stream);
    Args a{};
    for (int i = 0; i < 26; ++i) a.in[i] = (const float*)d_in[i];
    a.out = (float*)d_out; a.ws = (unsigned char*)d_ws;
    if (N_LAUNCH_MODE == 1) {
        a.ph_lo = 0; a.ph_hi = N_PHASES;
        hipLaunchKernelGGL(fwd, dim3(grid), dim3(NTHR), LDS_BYTES, stream, a);
    } else {
        for (int p = 0; p < N_PHASES; ++p) { a.ph_lo = p; a.ph_hi = p + 1; hipLaunchKernelGGL(fwd, dim3(grid), dim3(NTHR), LDS_BYTES, stream, a); }
    }
}
```

```cpp
#include <hip/hip_runtime.h>
#include <cstdio>
#include <cstdint>

#ifndef N_LAUNCH_MODE
#define N_LAUNCH_MODE 1
#endif

#define GAS __attribute__((address_space(1)))
#define LAS __attribute__((address_space(3)))
typedef unsigned short bf16;
typedef float f32x4 __attribute__((ext_vector_type(4)));
typedef unsigned u32x4 __attribute__((ext_vector_type(4)));
typedef unsigned u32x2 __attribute__((ext_vector_type(2)));

constexpr int BATCH = 8, SEQ = 4096, DM = 1024, T = BATCH * SEQ, DEPTH = 2;
constexpr int D_SSM = 512, NGRP = 32, SGRP = 16, SST = 64;
constexpr int D_IN = 1816, ZP = 2048;
constexpr int ZC_U = 0, ZC_Q = 512, ZC_KV = 1024, ZC_G = 1792;
constexpr int NCMP = 255, NCMPP = 256;
constexpr float EPS = 1e-6f;
constexpr int NWAVES = 8, NTHR = 512;
constexpr float QSCALE = 0.125f * 1.4426950408889634f;

constexpr size_t MiB = 1u << 20;
constexpr size_t WS_CTL = 0, CTL_ZERO_BYTES = 1 * MiB;
constexpr size_t WS_KC = 1 * MiB, WS_VC = 2 * MiB, WS_ROUTE = 3 * MiB;
constexpr size_t WS_HN = 16 * MiB;
constexpr size_t WS_Z = 80 * MiB;
constexpr size_t WS_YC = 208 * MiB;
constexpr size_t WS_G1 = 272 * MiB;
constexpr size_t WS_WIN = 304 * MiB;
constexpr size_t WS_WGLU = 312 * MiB;
constexpr size_t WS_WOUT = 314 * MiB;
constexpr size_t WS_WGU = 318 * MiB;
constexpr size_t WS_WDN = 382 * MiB;
constexpr size_t WS_LIST = 414 * MiB;
constexpr size_t WS_LISTW = 418 * MiB;
constexpr size_t WS_HID = 422 * MiB;
constexpr size_t WS_P2 = WS_Z;
constexpr size_t WS_USSM = WS_YC;
constexpr size_t WS_XL = WS_HID;
constexpr size_t WS_BT1 = 458 * MiB;
constexpr size_t WS_BT2 = 466 * MiB;
constexpr size_t WS_W1T = 478 * MiB;
constexpr size_t WS_HIDC = 4 * MiB;
constexpr size_t WS_CBIAS = 5 * MiB;
constexpr size_t WS_END = 482 * MiB;
constexpr int LCAP = 32768, CW_CNT = 8192;
constexpr int CW_BAR = 4096;

constexpr int LDS_BYTES = 147456;
constexpr int MISC_OFF = 131072 + 320;

__device__ __forceinline__ float bf2f(bf16 v) { return __uint_as_float(((unsigned)v) << 16); }
__device__ __forceinline__ unsigned f2bf(float f) { unsigned u = __float_as_uint(f); return (u + 0x7fffu + ((u >> 16) & 1u)) >> 16; }
__device__ __forceinline__ unsigned pk2(float lo, float hi) { return f2bf(lo) | (f2bf(hi) << 16); }
__device__ __forceinline__ float wave_sum(float v, int lane) {
#pragma unroll
    for (int o = 1; o < 64; o <<= 1) v += __int_as_float(__builtin_amdgcn_ds_bpermute((lane ^ o) << 2, __float_as_int(v)));
    return v;
}
__device__ __forceinline__ float wave_max(float v, int lane) {
#pragma unroll
    for (int o = 1; o < 64; o <<= 1) v = fmaxf(v, __int_as_float(__builtin_amdgcn_ds_bpermute((lane ^ o) << 2, __float_as_int(v))));
    return v;
}
__device__ __forceinline__ float lane_bcast(float v, int src) { return __int_as_float(__builtin_amdgcn_ds_bpermute(src << 2, __float_as_int(v))); }
__device__ __forceinline__ float gelu_tanh(float x) {
    const float u = 0.7978845608028654f * (x + 0.044715f * x * x * x);
    return 0.5f * x * (1.0f + tanhf(u));
}
__device__ __forceinline__ float sigmoidf_(float x) { return 1.0f / (1.0f + __expf(-x)); }
__device__ __forceinline__ int t5_bucket(int n) {
    if (n < 16) return n < 0 ? 0 : n;
    int b = 16;
    b += (n >= 19); b += (n >= 21); b += (n >= 24); b += (n >= 27); b += (n >= 31); b += (n >= 35); b += (n >= 40); b += (n >= 46);
    b += (n >= 52); b += (n >= 59); b += (n >= 67); b += (n >= 77); b += (n >= 87); b += (n >= 99); b += (n >= 113);
    return b;
}

#define XB_TMO      128
#define XB_XCNT(j)  (256  + 64 * (j))
#define XB_XSUB(j)  (1280 + 64 * (j))
#define XB_XGEN(j)  (2304 + 64 * (j))
#define XB_TOP      3328
#define XB_TOPGEN   3392
#define XCD_BAR_WORDS 3456
#define XB_SPIN_CAP (1u << 22)

__device__ __forceinline__ unsigned xb_ld(unsigned* p)              { return __hip_atomic_load(p, __ATOMIC_RELAXED, __HIP_MEMORY_SCOPE_AGENT); }
__device__ __forceinline__ unsigned xb_add(unsigned* p, unsigned v) { return __hip_atomic_fetch_add(p, v, __ATOMIC_RELAXED, __HIP_MEMORY_SCOPE_AGENT); }
__device__ __forceinline__ unsigned xb_xcc_id() { return (unsigned)__builtin_amdgcn_s_getreg((3 << 11) | 20) & 0xFu; }
#define XB_SPIN(cond, bar) do { unsigned _sp = 0; while (cond) { __builtin_amdgcn_s_sleep(1); \
    if ((++_sp & 255u) == 0u) { if (xb_ld(&(bar)[XB_TMO])) break; if (_sp > XB_SPIN_CAP) { atomicAdd(&(bar)[XB_TMO], 1u); break; } } } } while (0)

struct XcdBarrier { unsigned* bar; unsigned x; volatile LAS unsigned* st; };

__device__ __forceinline__ XcdBarrier xcd_barrier_post(unsigned* bar, volatile LAS unsigned* st) {
    XcdBarrier b; b.bar = bar; b.x = xb_xcc_id(); b.st = st;
    if (threadIdx.x == 0) (void)xb_add(&bar[XB_XCNT(b.x)], 1u);
    return b;
}
__device__ __forceinline__ void xcd_barrier_complete(unsigned* bar, unsigned x, unsigned& nloc, unsigned& nx) {
    const unsigned G = gridDim.x * gridDim.y * gridDim.z;
    unsigned sum, cnt, mine, sp = 0u;
    for (;;) {
        sum = 0u; cnt = 0u; mine = 0u;
#pragma unroll
        for (unsigned j = 0; j < 16; ++j) { const unsigned c = xb_ld(&bar[XB_XCNT(j)]); sum += c; cnt += (c > 0u) ? 1u : 0u; mine = (j == x) ? c : mine; }
        if (sum == G) break;
        __builtin_amdgcn_s_sleep(1);
        if ((++sp & 255u) == 0u) { if (xb_ld(&bar[XB_TMO])) break; if (sp > XB_SPIN_CAP) { atomicAdd(&bar[XB_TMO], 1u); break; } }
    }
    nloc = mine > 0u ? mine : 1u; nx = cnt > 0u ? cnt : 1u;
}
__device__ __forceinline__ void xcd_barrier(const XcdBarrier& b, const int tid) {
    asm volatile("s_waitcnt vmcnt(0)" ::: "memory");
    __syncthreads();
    if (tid == 0) {
        unsigned* bar = b.bar;
        __builtin_amdgcn_s_waitcnt(0);
        unsigned nloc = b.st[0], nx = b.st[1];
        if (nloc == 0u) { xcd_barrier_complete(bar, b.x, nloc, nx); b.st[0] = nloc; b.st[1] = nx; }
        const unsigned old = xb_add(&bar[XB_XSUB(b.x)], 1u);
        const unsigned gen = old / nloc;
        if (old + 1u == (gen + 1u) * nloc) {
            __builtin_amdgcn_fence(__ATOMIC_RELEASE, "agent");
            asm volatile("s_waitcnt vmcnt(0)" ::: "memory");
            const unsigned og = xb_add(&bar[XB_TOP], 1u);
            const unsigned tg = og / nx;
            if (og + 1u == (tg + 1u) * nx) xb_add(&bar[XB_TOPGEN], 1u);
            else XB_SPIN(xb_ld(&bar[XB_TOPGEN]) == tg, bar);
            __builtin_amdgcn_fence(__ATOMIC_ACQUIRE, "agent");
            xb_add(&bar[XB_XGEN(b.x)], 1u);
            asm volatile("s_waitcnt vmcnt(0)" ::: "memory");
        } else {
            XB_SPIN(xb_ld(&bar[XB_XGEN(b.x)]) == gen, bar);
            __builtin_amdgcn_fence(__ATOMIC_ACQUIRE, "agent");
            asm volatile("s_waitcnt vmcnt(0)" ::: "memory");
        }
    }
    __syncthreads();
}

namespace pg8 {
#define PG8_LAS __attribute__((address_space(3)))
typedef unsigned short bf16_t;
typedef short bf16x8 __attribute__((ext_vector_type(8)));
typedef float f32x4 __attribute__((ext_vector_type(4)));
typedef unsigned u32x4 __attribute__((ext_vector_type(4)));
constexpr int BM = 256, BK = 64, HALF = 128, HTB = HALF * BK * 2  , STAGE_BYTES = 8 * HTB, NXCD = 8, WGM = 8;

__host__ __device__ __forceinline__ int lds_byte(int r, int c) { const int st = (r >> 4) * 2 + (c >> 5), rr = r & 15, cc = c & 31, ob = rr * 64 + cc * 2; return st * 1024 + (ob ^ (((ob >> 9) & 1) << 5)); }
__host__ __device__ __forceinline__ void stage_rc(int b, int& R, int& C) { const int st = b / 1024, sb = b % 1024, swz = sb ^ (((sb >> 9) & 1) << 5); R = (st >> 1) * 16 + swz / 64; C = (st & 1) * 32 + (swz % 64) / 2; }
__host__ __device__ __forceinline__ int perm32(int rho) { const int n = rho >> 4, i = rho & 15; return 8 * (i >> 2) + 4 * n + (i & 3); }

struct Unit { int pm, pn, eb, p0, cnt; };
struct Gemm { const bf16_t* A; const bf16_t* Bt; int M, N, K; int lda; size_t bstride; const unsigned* list; int cap; size_t astride; int kstepA; };

struct StaticOrder {
    int nM, nN, nwg, G, c;
    __host__ __device__ void init(int M, int N, int G_, int c_) { nM = M / BM; nN = N / BM; nwg = nM * nN; G = G_; c = c_; }
    __host__ __device__ bool next(int i, Unit& u) const {
        const long L = (long)i * G + c; if (L >= nwg) return false;
        int wgid = (int)L; { const int q = nwg / NXCD, r = nwg % NXCD, xcd = wgid % NXCD, off = wgid / NXCD; wgid = (xcd < r ? xcd * (q + 1) : r * (q + 1) + (xcd - r) * q) + off; }
        const int nig = WGM * nN, gid = wgid / nig, fm = gid * WGM, gsz = (nM - fm) < WGM ? (nM - fm) : WGM;
        u.pm = fm + ((wgid % nig) % gsz); u.pn = (wgid % nig) / gsz; u.eb = 0; u.p0 = 0; u.cnt = 0; return true;
    }
    __device__ __forceinline__ void a_ready(const Unit&) const {}
    __device__ __forceinline__ void done(const Unit&) const {}
};

__device__ __forceinline__ unsigned cvt_pk_bf16(float lo, float hi) { unsigned r; asm volatile("v_cvt_pk_bf16_f32 %0, %1, %2" : "=v"(r) : "v"(lo), "v"(hi)); return r; }
typedef float f32x2 __attribute__((ext_vector_type(2)));
__device__ __forceinline__ f32x2 gelu_pk(f32x2 v) {
    const f32x2 av = __builtin_elementwise_abs(v), d = av * 0.2316418882f + 1.0f;
    f32x2 t; t.x = __builtin_amdgcn_rcpf(d.x); t.y = __builtin_amdgcn_rcpf(d.y);
    f32x2 q = t * 0.5307027145f + (-0.7265760135f); q = q * t + 0.7107068705f; q = q * t + (-0.142248368f); q = q * t + 0.127414796f; q = q * t;
    const f32x2 s = (v * v) * (-0.72134752044f);
    f32x2 e; e.x = __builtin_amdgcn_exp2f(s.x); e.y = __builtin_amdgcn_exp2f(s.y);
    const f32x2 m = v * (q * e), r = v - m;
    f32x2 o; o.x = v.x < 0.f ? m.x : r.x; o.y = v.y < 0.f ? m.y : r.y; return o;
}

template <int ACT  > struct EpiBf16 {
    static constexpr bool PERM = true, AFTER_DRAIN = false; static_assert(ACT == 0 || ACT == 1, "EpiBf16: ACT is 0 (none) or 1 (gelu_pk)");
    bf16_t* O; int ldc; const float* bias; int split_cols; size_t split_stride; float scale0;
    __device__ __forceinline__ void operator()(const f32x4 (&acc)[2][2][4][2], const Unit& u, int wr, int wc, int fr, int fq) const {
        const int row0 = u.pm * BM + wr * 64 + fr; int colt = u.pn * BM; bf16_t* base = O;
        float sc = 1.f; if (split_cols) { const int t = colt / split_cols; base += (size_t)t * split_stride; colt -= t * split_cols; if (t == 0) sc = scale0; }
        const int col0 = colt + wc * 32 + 8 * fq, bcol0 = u.pn * BM + wc * 32 + 8 * fq;
        f32x4 bv[2][2];
#pragma unroll
        for (int bj = 0; bj < 2; ++bj)
#pragma unroll
            for (int n = 0; n < 2; ++n) bv[bj][n] = bias ? *(const f32x4*)(bias + bcol0 + bj * HALF + 4 * n) : (f32x4){0.f, 0.f, 0.f, 0.f};
#pragma unroll
        for (int ai = 0; ai < 2; ++ai)
#pragma unroll
            for (int m = 0; m < 4; ++m) { bf16_t* rowp = base + (size_t)(row0 + ai * HALF + m * 16) * ldc + col0;
#pragma unroll
                for (int bj = 0; bj < 2; ++bj) { f32x4 v0 = acc[ai][bj][m][0] + bv[bj][0], v1 = acc[ai][bj][m][1] + bv[bj][1];
                    if (ACT == 1) { f32x2 a = gelu_pk((f32x2){v0[0], v0[1]}), b = gelu_pk((f32x2){v0[2], v0[3]}), c = gelu_pk((f32x2){v1[0], v1[1]}), d = gelu_pk((f32x2){v1[2], v1[3]});
                        v0 = (f32x4){a.x, a.y, b.x, b.y}; v1 = (f32x4){c.x, c.y, d.x, d.y}; }
                    v0 = v0 * sc; v1 = v1 * sc; u32x4 w; w.x = cvt_pk_bf16(v0[0], v0[1]); w.y = cvt_pk_bf16(v0[2], v0[3]); w.z = cvt_pk_bf16(v1[0], v1[1]); w.w = cvt_pk_bf16(v1[2], v1[3]);
                    *(u32x4*)(rowp + bj * HALF) = w; } }
    }
};
template <class Epi, class Sched, bool ALIGN_EPI = false, bool SP2 = false>
__device__ __forceinline__ void gemm_phase(PG8_LAS unsigned char* lds, const Gemm g, const Sched& S, const Epi& E) {
    int tid_ = threadIdx.x; asm volatile("" : "+v"(tid_));
    const int tid = tid_, wid = __builtin_amdgcn_readfirstlane(tid >> 6), lane = tid & 63, wr = wid >> 2, wc = wid & 3, fr = lane & 15, fq = lane >> 4;
    const int K = g.K, nt = K / BK;
    unsigned voffA[2], voffB[2];
#pragma unroll
    for (int i = 0; i < 2; ++i) { int R, C; stage_rc(tid * 16 + i * 8192, R, C); const int Rb = Epi::PERM ? ((R & ~31) + perm32(R & 31)) : R;
        voffA[i] = (unsigned)(R * K + C) * 2u; voffB[i] = (unsigned)(Rb * K + C) * 2u; }
    const size_t kstep = (size_t)(BK * 2);
    const size_t hstep = (size_t)HALF * K * 2;
    const size_t tstep = 2 * hstep;
    const unsigned ldsw = (unsigned)wid * 1024u;
    const int aoff = lds_byte(wr * 64 + fr, fq * 8), boff = lds_byte(wc * 32 + fr, fq * 8);
#define PG8_SA(b, h) (((b) * 2 + (h)) * HTB)
#define PG8_SB(b, h) ((4 + (b) * 2 + (h)) * HTB)
#define PG8_STAGE(bufoff, gbase, voff) do { _Pragma("unroll") for (int _i = 0; _i < 2; ++_i) \
        __builtin_amdgcn_global_load_lds((const unsigned*)((const char*)(gbase) + (voff)[_i]), (PG8_LAS unsigned*)(lds + (bufoff) + ldsw + _i * 8192), 16, 0, 0); } while (0)
#define PG8_LDA(dst, b, h) do { _Pragma("unroll") for (int m = 0; m < 4; ++m) _Pragma("unroll") for (int k = 0; k < 2; ++k) dst[m][k] = *(const PG8_LAS bf16x8*)(lds + PG8_SA(b, h) + aoff + m * 2048 + k * 1024); } while (0)
#define PG8_LDB(dst, b, h) do { _Pragma("unroll") for (int n = 0; n < 2; ++n) _Pragma("unroll") for (int k = 0; k < 2; ++k) dst[n][k] = *(const PG8_LAS bf16x8*)(lds + PG8_SB(b, h) + boff + n * 2048 + k * 1024); } while (0)
#define PG8_MMA(ai, bj, At, Bt) do { __builtin_amdgcn_s_setprio(1); _Pragma("unroll") for (int m = 0; m < 4; ++m) _Pragma("unroll") for (int n = 0; n < 2; ++n) _Pragma("unroll") for (int k = 0; k < 2; ++k) \
        acc[ai][bj][m][n] = __builtin_amdgcn_mfma_f32_16x16x32_bf16(Bt[n][k], At[m][k], acc[ai][bj][m][n], 0, 0, 0); __builtin_amdgcn_s_setprio(0); } while (0)
#define PG8_WAIT_V(n) asm volatile("s_waitcnt vmcnt(" #n ")" ::: "memory")
#define PG8_WAIT_L(n) asm volatile("s_waitcnt lgkmcnt(" #n ")" ::: "memory")
#define PG8_BAR __builtin_amdgcn_s_barrier()
#define PG8_SCHED __builtin_amdgcn_sched_barrier(0)
    Unit cur, nxt; int ui = 0;
    if (!S.next(0, cur)) return;
    f32x4 acc[2][2][4][2];
#pragma unroll
    for (int a = 0; a < 2; ++a)
#pragma unroll
        for (int b = 0; b < 2; ++b)
#pragma unroll
            for (int m = 0; m < 4; ++m)
#pragma unroll
                for (int n = 0; n < 2; ++n) acc[a][b][m][n] = (f32x4){0.f, 0.f, 0.f, 0.f};
    bf16x8 At[4][2], B0[2][2], B1[2][2];
    const char* cA = (const char*)g.A + (size_t)cur.pm * tstep; const char* cB = (const char*)g.Bt + (size_t)cur.pn * tstep;
    S.a_ready(cur);
    if constexpr (SP2) {
        PG8_STAGE(PG8_SB(0, 0), cB, voffB); PG8_STAGE(PG8_SB(0, 1), cB + hstep, voffB); PG8_STAGE(PG8_SA(0, 0), cA, voffA); PG8_STAGE(PG8_SA(0, 1), cA + hstep, voffA);
        if (wr == 1) PG8_BAR;
        PG8_WAIT_V(2); PG8_BAR;
        PG8_STAGE(PG8_SB(1, 0), cB + kstep, voffB); PG8_STAGE(PG8_SA(1, 0), cA + kstep, voffA); PG8_STAGE(PG8_SB(1, 1), cB + hstep + kstep, voffB);
        PG8_WAIT_V(6); PG8_BAR;
    } else {
        PG8_STAGE(PG8_SB(0, 0), cB, voffB); PG8_STAGE(PG8_SA(0, 0), cA, voffA); PG8_STAGE(PG8_SB(0, 1), cB + hstep, voffB); PG8_STAGE(PG8_SA(0, 1), cA + hstep, voffA);
        if (wr == 1) PG8_BAR;
        PG8_WAIT_V(4); PG8_BAR;
        PG8_STAGE(PG8_SB(1, 0), cB + kstep, voffB); PG8_STAGE(PG8_SA(1, 0), cA + kstep, voffA); PG8_STAGE(PG8_SB(1, 1), cB + hstep + kstep, voffB);
        PG8_WAIT_V(6); PG8_BAR;
    }
    for (;;) {
        const bool has_next = S.next(ui + 1, nxt);
        const char* nA = has_next ? (const char*)g.A + (size_t)nxt.pm * tstep : cA; const char* nB = has_next ? (const char*)g.Bt + (size_t)nxt.pn * tstep : cB;
        for (int t = 0; t < nt; t += 2) {
            const bool last = (t == nt - 2);
            const char* a1 = cA + (size_t)(t + 1) * kstep;
            const char* a2 = last ? nA : cA + (size_t)(t + 2) * kstep; const char* b2 = last ? nB : cB + (size_t)(t + 2) * kstep;
            const char* a3 = a2 + kstep; const char* b3 = b2 + kstep;
            if (last && has_next) S.a_ready(nxt);
            if constexpr (SP2) {
            PG8_LDB(B0, 0, 0); PG8_LDB(B1, 0, 1); PG8_SCHED; PG8_LDA(At, 0, 0); PG8_STAGE(PG8_SA(1, 1), a1 + hstep, voffA);
            PG8_WAIT_V(8); PG8_WAIT_L(0); PG8_BAR; PG8_MMA(0, 0, At, B0); PG8_MMA(0, 1, At, B1); PG8_BAR; PG8_SCHED;
            PG8_LDA(At, 0, 1); PG8_STAGE(PG8_SB(0, 0), b2, voffB); PG8_STAGE(PG8_SB(0, 1), b2 + hstep, voffB); PG8_STAGE(PG8_SA(0, 0), a2, voffA);
            PG8_WAIT_V(8); PG8_WAIT_L(0); PG8_BAR; PG8_MMA(1, 0, At, B0); PG8_MMA(1, 1, At, B1); PG8_BAR; PG8_SCHED;
            PG8_LDB(B0, 1, 0); PG8_LDB(B1, 1, 1); PG8_SCHED; PG8_LDA(At, 1, 0); PG8_STAGE(PG8_SA(0, 1), a2 + hstep, voffA);
            PG8_WAIT_V(8); PG8_WAIT_L(0); PG8_BAR; PG8_MMA(0, 0, At, B0); PG8_MMA(0, 1, At, B1); PG8_BAR; PG8_SCHED;
            PG8_LDA(At, 1, 1); PG8_STAGE(PG8_SB(1, 0), b3, voffB); PG8_STAGE(PG8_SB(1, 1), b3 + hstep, voffB); PG8_STAGE(PG8_SA(1, 0), a3, voffA);
            PG8_WAIT_V(8); PG8_WAIT_L(0); PG8_BAR; PG8_MMA(1, 0, At, B0); PG8_MMA(1, 1, At, B1); PG8_BAR; PG8_SCHED;
            } else {
            PG8_LDB(B0, 0, 0); PG8_SCHED; PG8_LDA(At, 0, 0); PG8_STAGE(PG8_SA(1, 1), a1 + hstep, voffA);
            PG8_WAIT_L(8); PG8_BAR; PG8_WAIT_L(0); PG8_MMA(0, 0, At, B0); PG8_BAR; PG8_SCHED;
            PG8_LDB(B1, 0, 1); PG8_STAGE(PG8_SB(0, 0), b2, voffB);
            PG8_BAR; PG8_WAIT_L(0); PG8_MMA(0, 1, At, B1); PG8_BAR;
            PG8_LDA(At, 0, 1); PG8_STAGE(PG8_SA(0, 0), a2, voffA);
            PG8_BAR; PG8_WAIT_L(0); PG8_MMA(1, 0, At, B0); PG8_BAR; PG8_SCHED;
            PG8_STAGE(PG8_SB(0, 1), b2 + hstep, voffB);
            PG8_WAIT_V(6); PG8_BAR; PG8_MMA(1, 1, At, B1); PG8_BAR;
            PG8_LDB(B0, 1, 0); PG8_SCHED; PG8_LDA(At, 1, 0); PG8_STAGE(PG8_SA(0, 1), a2 + hstep, voffA);
            PG8_WAIT_L(8); PG8_BAR; PG8_WAIT_L(0); PG8_MMA(0, 0, At, B0); PG8_BAR; PG8_SCHED;
            PG8_LDB(B1, 1, 1); PG8_STAGE(PG8_SB(1, 0), b3, voffB);
            PG8_BAR; PG8_WAIT_L(0); PG8_MMA(0, 1, At, B1); PG8_BAR;
            PG8_LDA(At, 1, 1); PG8_STAGE(PG8_SA(1, 0), a3, voffA);
            PG8_BAR; PG8_WAIT_L(0); PG8_MMA(1, 0, At, B0); PG8_BAR; PG8_SCHED;
            PG8_STAGE(PG8_SB(1, 1), b3 + hstep, voffB);
            PG8_WAIT_V(6); PG8_BAR; PG8_MMA(1, 1, At, B1); PG8_BAR;
            }
        }
        if constexpr (ALIGN_EPI) { if (wr == 0) PG8_BAR; }
        if constexpr (!Epi::AFTER_DRAIN) { E(acc, cur, wr, wc, fr, fq); S.done(cur); }
        if (!has_next) break;
#pragma unroll
        for (int a = 0; a < 2; ++a)
#pragma unroll
            for (int b = 0; b < 2; ++b)
#pragma unroll
                for (int m = 0; m < 4; ++m)
#pragma unroll
                    for (int n = 0; n < 2; ++n) acc[a][b][m][n] = (f32x4){0.f, 0.f, 0.f, 0.f};
        cur = nxt; cA = nA; cB = nB; ++ui;
        if constexpr (ALIGN_EPI) { if (wr == 1) PG8_BAR; }
    }
    PG8_WAIT_V(0);
    if constexpr (!ALIGN_EPI) { if (wr == 0) PG8_BAR; }
    PG8_BAR;
    if constexpr (Epi::AFTER_DRAIN) { E.fused(acc, cur, wr, wc, fr, fq, lds, wid, lane); S.done(cur); }
#undef PG8_SA
#undef PG8_SB
#undef PG8_STAGE
#undef PG8_LDA
#undef PG8_LDB
#undef PG8_MMA
#undef PG8_WAIT_V
#undef PG8_WAIT_L
#undef PG8_BAR
#undef PG8_SCHED
}

__device__ __forceinline__ float sigm(float x) { return 1.0f / (1.0f + __expf(-x)); }
struct EpiGlu {
    static constexpr bool PERM = true, AFTER_DRAIN = false;
    bf16_t* O; int ldc;
    __device__ __forceinline__ void operator()(const f32x4 (&acc)[2][2][4][2], const Unit& u, int wr, int wc, int fr, int fq) const {
        const int row0 = u.pm * BM + wr * 64 + fr, col0 = u.pn * HALF + wc * 32 + 8 * fq;
#pragma unroll
        for (int ai = 0; ai < 2; ++ai)
#pragma unroll
            for (int m = 0; m < 4; ++m) {
                bf16_t* rowp = O + (size_t)(row0 + ai * HALF + m * 16) * ldc + col0;
                const f32x4 a0 = acc[ai][0][m][0], a1 = acc[ai][0][m][1], b0 = acc[ai][1][m][0], b1 = acc[ai][1][m][1];
                u32x4 w;
                w.x = cvt_pk_bf16(a0[0] * sigm(b0[0]), a0[1] * sigm(b0[1])); w.y = cvt_pk_bf16(a0[2] * sigm(b0[2]), a0[3] * sigm(b0[3]));
                w.z = cvt_pk_bf16(a1[0] * sigm(b1[0]), a1[1] * sigm(b1[1])); w.w = cvt_pk_bf16(a1[2] * sigm(b1[2]), a1[3] * sigm(b1[3]));
                *(u32x4*)rowp = w;
            }
    }
};
struct EpiResid {
    static constexpr bool PERM = false, AFTER_DRAIN = false;
    const float* X; float* O; int ldc;
    __device__ __forceinline__ void operator()(const f32x4 (&acc)[2][2][4][2], const Unit& u, int wr, int wc, int fr, int fq) const {
        const int row0 = u.pm * BM + wr * 64 + fr, col0 = u.pn * BM + wc * 32 + 4 * fq;
#pragma unroll
        for (int ai = 0; ai < 2; ++ai)
#pragma unroll
            for (int m = 0; m < 4; ++m) {
                const size_t off = (size_t)(row0 + ai * HALF + m * 16) * ldc + col0;
#pragma unroll
                for (int bj = 0; bj < 2; ++bj)
#pragma unroll
                    for (int n = 0; n < 2; ++n) *(f32x4*)(O + off + bj * HALF + n * 16) = *(const f32x4*)(X + off + bj * HALF + n * 16) + acc[ai][bj][m][n];
            }
    }
};

struct ADense { static constexpr bool GATHER = false; __device__ __forceinline__ static unsigned rowoff(const Gemm&, const Unit&, int) { return 0u; } };
struct AList { static constexpr bool GATHER = true;
    __device__ __forceinline__ static unsigned rowoff(const Gemm& g, const Unit& u, int r) { const int pos = u.p0 + r; const unsigned tok = pos < u.cnt ? (g.list[(size_t)u.eb * g.cap + pos] >> 1) : 0u; return tok * (unsigned)g.lda * 2u; } };
struct ACompress { static constexpr bool GATHER = true;
    __device__ __forceinline__ static unsigned rowoff(const Gemm&, const Unit& u, int r) { const unsigned rg = (unsigned)(u.pm * BM + r), b = rg >> 9, n = (rg >> 1) & 255u, hkv = rg & 1u;
        return (((b * 4096u + 16u * n) * 2048u) + 1024u + (unsigned)u.eb * 128u + hkv * 64u) * 2u; } };
template <class Epi, class Sched, class AMap>
__device__ __forceinline__ void gemm2(PG8_LAS unsigned char* lds, const Gemm g, const Sched& S, const Epi& E, const int tid) {
    constexpr bool GATHER = AMap::GATHER;
    int K_ = g.K; asm volatile("" : "+s"(K_));
    const int wid = __builtin_amdgcn_readfirstlane(tid >> 6), lane = tid & 63, wr = wid >> 2, wc = wid & 3, fr = lane & 15, fq = lane >> 4;
    const int K = K_, nt = K / BK, lda = g.lda;
    unsigned voffA[2], voffB[2]; int Rst[2], Cst[2];
#pragma unroll
    for (int i = 0; i < 2; ++i) { int R, C; stage_rc(tid * 16 + i * 8192, R, C); const int Rb = Epi::PERM ? ((R & ~31) + perm32(R & 31)) : R;
        voffA[i] = (unsigned)(R * lda + C) * 2u; voffB[i] = (unsigned)(Rb * K + C) * 2u; Rst[i] = R; Cst[i] = C; }
    const size_t kstep = (size_t)(BK * 2), kstepA = (size_t)g.kstepA;
    const size_t hstepA = (size_t)HALF * lda * 2, tstepA = 2 * hstepA, hstepB = (size_t)HALF * K * 2, tstepB = 2 * hstepB;
    const unsigned ldsw = (unsigned)wid * 1024u;
    const int aoff = lds_byte(wr * 64 + fr, fq * 8), boff = lds_byte(wc * 32 + fr, fq * 8);
#define PG8_SA(b, h) (((b) * 2 + (h)) * HTB)
#define PG8_SB(b, h) ((4 + (b) * 2 + (h)) * HTB)
#define PG8_STAGE(bufoff, gbase, voff) do { _Pragma("unroll") for (int _i = 0; _i < 2; ++_i) \
        __builtin_amdgcn_global_load_lds((const unsigned*)((const char*)(gbase) + (voff)[_i]), (PG8_LAS unsigned*)(lds + (bufoff) + ldsw + _i * 8192), 16, 0, 0); } while (0)
#define PG8_STAGE_A(bufoff, gbase, h) do { if constexpr (GATHER) { PG8_STAGE(bufoff, gbase, vg[h]); } else { PG8_STAGE(bufoff, (gbase) + (h) * hstepA, voffA); } } while (0)
#define PG8_GOFFS(u, dst) do { _Pragma("unroll") for (int _h = 0; _h < 2; ++_h) _Pragma("unroll") for (int _i = 0; _i < 2; ++_i) dst[_h][_i] = AMap::rowoff(g, (u), _h * HALF + Rst[_i]) + (unsigned)Cst[_i] * 2u; } while (0)
#define PG8_LDA(dst, b, h) do { _Pragma("unroll") for (int m = 0; m < 4; ++m) _Pragma("unroll") for (int k = 0; k < 2; ++k) dst[m][k] = *(const PG8_LAS bf16x8*)(lds + PG8_SA(b, h) + aoff + m * 2048 + k * 1024); } while (0)
#define PG8_LDB(dst, b, h) do { _Pragma("unroll") for (int n = 0; n < 2; ++n) _Pragma("unroll") for (int k = 0; k < 2; ++k) dst[n][k] = *(const PG8_LAS bf16x8*)(lds + PG8_SB(b, h) + boff + n * 2048 + k * 1024); } while (0)
#define PG8_MMA(ai, bj, At, Bt) do { __builtin_amdgcn_s_setprio(1); _Pragma("unroll") for (int m = 0; m < 4; ++m) _Pragma("unroll") for (int n = 0; n < 2; ++n) _Pragma("unroll") for (int k = 0; k < 2; ++k) \
        acc[ai][bj][m][n] = __builtin_amdgcn_mfma_f32_16x16x32_bf16(Bt[n][k], At[m][k], acc[ai][bj][m][n], 0, 0, 0); __builtin_amdgcn_s_setprio(0); } while (0)
#define PG8_WAIT_V(n) asm volatile("s_waitcnt vmcnt(" #n ")" ::: "memory")
#define PG8_WAIT_L(n) asm volatile("s_waitcnt lgkmcnt(" #n ")" ::: "memory")
#define PG8_BAR __builtin_amdgcn_s_barrier()
#define PG8_SCHED __builtin_amdgcn_sched_barrier(0)
    Unit cur, nxt; int ui = 0;
    if (!S.next(0, cur)) return;
    f32x4 acc[2][2][4][2];
#pragma unroll
    for (int a = 0; a < 2; ++a)
#pragma unroll
        for (int b = 0; b < 2; ++b)
#pragma unroll
            for (int m = 0; m < 4; ++m)
#pragma unroll
                for (int n = 0; n < 2; ++n) acc[a][b][m][n] = (f32x4){0.f, 0.f, 0.f, 0.f};
    bf16x8 At[4][2], B0[2][2], B1[2][2];
    unsigned vg[2][2] = {{0u, 0u}, {0u, 0u}};
    if constexpr (GATHER) PG8_GOFFS(cur, vg);
    const char* cA = (const char*)g.A + (GATHER ? (size_t)0 : (size_t)cur.pm * tstepA + (size_t)cur.eb * g.astride * 2);
    const char* cB = (const char*)g.Bt + ((size_t)cur.eb * g.bstride) * 2 + (size_t)cur.pn * tstepB;
    S.a_ready(cur);
    PG8_STAGE(PG8_SB(0, 0), cB, voffB); PG8_STAGE(PG8_SB(0, 1), cB + hstepB, voffB); PG8_STAGE_A(PG8_SA(0, 0), cA, 0); PG8_STAGE_A(PG8_SA(0, 1), cA, 1);
    if (wr == 1) PG8_BAR;
    PG8_WAIT_V(2); PG8_BAR;
    PG8_STAGE(PG8_SB(1, 0), cB + kstep, voffB); PG8_STAGE_A(PG8_SA(1, 0), cA + kstepA, 0); PG8_STAGE(PG8_SB(1, 1), cB + hstepB + kstep, voffB);
    PG8_WAIT_V(6); PG8_BAR;
    for (;;) {
        const bool has_next = S.next(ui + 1, nxt);
        const char* nA = has_next ? (const char*)g.A + (GATHER ? (size_t)0 : (size_t)nxt.pm * tstepA + (size_t)nxt.eb * g.astride * 2) : cA;
        const char* nB = has_next ? (const char*)g.Bt + ((size_t)nxt.eb * g.bstride) * 2 + (size_t)nxt.pn * tstepB : cB;
        for (int t = 0; t < nt; t += 2) {
            const bool last = (t == nt - 2);
            const char* a1 = cA + (size_t)(t + 1) * kstepA;
            const char* a2 = last ? nA : cA + (size_t)(t + 2) * kstepA; const char* b2 = last ? nB : cB + (size_t)(t + 2) * kstep;
            const char* a3 = a2 + kstepA; const char* b3 = b2 + kstep;
            unsigned vn1[2] = {vg[1][0], vg[1][1]};
            if constexpr (GATHER) { if (last && has_next) { unsigned vn[2][2]; PG8_GOFFS(nxt, vn); vg[0][0] = vn[0][0]; vg[0][1] = vn[0][1]; vn1[0] = vn[1][0]; vn1[1] = vn[1][1]; } }
            if (last && has_next) S.a_ready(nxt);
            PG8_LDB(B0, 0, 0); PG8_LDB(B1, 0, 1); PG8_SCHED; PG8_LDA(At, 0, 0); PG8_STAGE_A(PG8_SA(1, 1), a1, 1);
            PG8_WAIT_V(8); PG8_WAIT_L(0); PG8_BAR; PG8_MMA(0, 0, At, B0); PG8_MMA(0, 1, At, B1); PG8_BAR; PG8_SCHED;
            if constexpr (GATHER) { vg[1][0] = vn1[0]; vg[1][1] = vn1[1]; }
            PG8_LDA(At, 0, 1); PG8_STAGE(PG8_SB(0, 0), b2, voffB); PG8_STAGE(PG8_SB(0, 1), b2 + hstepB, voffB); PG8_STAGE_A(PG8_SA(0, 0), a2, 0);
            PG8_WAIT_V(8); PG8_WAIT_L(0); PG8_BAR; PG8_MMA(1, 0, At, B0); PG8_MMA(1, 1, At, B1); PG8_BAR; PG8_SCHED;
            PG8_LDB(B0, 1, 0); PG8_LDB(B1, 1, 1); PG8_SCHED; PG8_LDA(At, 1, 0); PG8_STAGE_A(PG8_SA(0, 1), a2, 1);
            PG8_WAIT_V(8); PG8_WAIT_L(0); PG8_BAR; PG8_MMA(0, 0, At, B0); PG8_MMA(0, 1, At, B1); PG8_BAR; PG8_SCHED;
            PG8_LDA(At, 1, 1); PG8_STAGE(PG8_SB(1, 0), b3, voffB); PG8_STAGE(PG8_SB(1, 1), b3 + hstepB, voffB); PG8_STAGE_A(PG8_SA(1, 0), a3, 0);
            PG8_WAIT_V(8); PG8_WAIT_L(0); PG8_BAR; PG8_MMA(1, 0, At, B0); PG8_MMA(1, 1, At, B1); PG8_BAR; PG8_SCHED;
        }
        if (wr == 0) PG8_BAR;
        E(acc, cur, wr, wc, fr, fq); S.done(cur);
        if (!has_next) break;
#pragma unroll
        for (int a = 0; a < 2; ++a)
#pragma unroll
            for (int b = 0; b < 2; ++b)
#pragma unroll
                for (int m = 0; m < 4; ++m)
#pragma unroll
                    for (int n = 0; n < 2; ++n) acc[a][b][m][n] = (f32x4){0.f, 0.f, 0.f, 0.f};
        cur = nxt; cA = nA; cB = nB; ++ui;
        if (wr == 1) PG8_BAR;
    }
    PG8_WAIT_V(0);
    PG8_BAR;
#undef PG8_SA
#undef PG8_SB
#undef PG8_STAGE
#undef PG8_STAGE_A
#undef PG8_GOFFS
#undef PG8_LDA
#undef PG8_LDB
#undef PG8_MMA
#undef PG8_WAIT_V
#undef PG8_WAIT_L
#undef PG8_BAR
#undef PG8_SCHED
}

struct ExpertOrder {
    const PG8_LAS int* tab; int nN, G, c;
    __device__ __forceinline__ bool next(int i, Unit& u) const {
        const int total = tab[32] * nN; const long L = (long)i * G + c; if (L >= total) return false;
        const int rt = (int)L / nN, pn = (int)L % nN; int e = 0;
#pragma unroll
        for (int k = 1; k < 32; ++k) e += (rt >= tab[k]) ? 1 : 0;
        u.pm = __builtin_amdgcn_readfirstlane(rt); u.pn = __builtin_amdgcn_readfirstlane(pn); u.eb = __builtin_amdgcn_readfirstlane(e);
        u.p0 = __builtin_amdgcn_readfirstlane((rt - tab[e]) * BM); u.cnt = __builtin_amdgcn_readfirstlane(tab[33 + e]); return true;
    }
    __device__ __forceinline__ void a_ready(const Unit&) const {}
    __device__ __forceinline__ void done(const Unit&) const {}
};
struct EpiGateUp {
    static constexpr bool PERM = true, AFTER_DRAIN = false;
    bf16_t* H; const float* listw; int cap;
    __device__ __forceinline__ void operator()(const f32x4 (&acc)[2][2][4][2], const Unit& u, int wr, int wc, int fr, int fq) const {
        const int rl0 = wr * 64 + fr, col0 = u.pn * HALF + wc * 32 + 8 * fq;
#pragma unroll
        for (int ai = 0; ai < 2; ++ai)
#pragma unroll
            for (int m = 0; m < 4; ++m) {
                const int rl = rl0 + ai * HALF + m * 16, pos = u.p0 + rl;
                const float w = pos < u.cnt ? listw[(size_t)u.eb * cap + pos] : 0.f;
                bf16_t* rowp = H + (size_t)(u.pm * BM + rl) * 256 + col0;
                const f32x4 g0 = acc[ai][0][m][0], g1 = acc[ai][0][m][1], u0 = acc[ai][1][m][0], u1 = acc[ai][1][m][1];
                u32x4 o;
                o.x = cvt_pk_bf16(g0[0] * sigm(g0[0]) * u0[0] * w, g0[1] * sigm(g0[1]) * u0[1] * w); o.y = cvt_pk_bf16(g0[2] * sigm(g0[2]) * u0[2] * w, g0[3] * sigm(g0[3]) * u0[3] * w);
                o.z = cvt_pk_bf16(g1[0] * sigm(g1[0]) * u1[0] * w, g1[1] * sigm(g1[1]) * u1[1] * w); o.w = cvt_pk_bf16(g1[2] * sigm(g1[2]) * u1[2] * w, g1[3] * sigm(g1[3]) * u1[3] * w);
                *(u32x4*)rowp = o;
            }
    }
};
struct EpiDown {
    static constexpr bool PERM = false, AFTER_DRAIN = false;
    float* X; float* P2; const unsigned* list; int cap;
    __device__ __forceinline__ void operator()(const f32x4 (&acc)[2][2][4][2], const Unit& u, int wr, int wc, int fr, int fq) const {
        const int rl0 = wr * 64 + fr, col0 = u.pn * BM + wc * 32 + 4 * fq;
#pragma unroll
        for (int ai = 0; ai < 2; ++ai)
#pragma unroll
            for (int m = 0; m < 4; ++m) {
                const int rl = rl0 + ai * HALF + m * 16, pos = u.p0 + rl;
                if (pos < u.cnt) {
                    const unsigned ent = list[(size_t)u.eb * cap + pos];
                    float* dst = ((ent & 1u) ? P2 : X) + (size_t)(ent >> 1) * 1024 + col0;
#pragma unroll
                    for (int bj = 0; bj < 2; ++bj)
#pragma unroll
                        for (int n = 0; n < 2; ++n) { f32x4 v = acc[ai][bj][m][n]; if (!(ent & 1u)) v += *(const f32x4*)(dst + bj * HALF + n * 16); *(f32x4*)(dst + bj * HALF + n * 16) = v; }
                }
                asm volatile("" ::: "memory");
            }
    }
};

struct BatchOrder {
    int nb, nM, nN, G, c;
    __device__ __forceinline__ bool next(int i, Unit& u) const {
        const long L = (long)i * G + c; if (L >= (long)nb * nM * nN) return false;
        const int per = nM * nN, e = (int)L / per, rem = (int)L % per;
        u.eb = e; u.pm = rem / nN; u.pn = rem % nN; u.p0 = 0; u.cnt = 0; return true;
    }
    __device__ __forceinline__ void a_ready(const Unit&) const {}
    __device__ __forceinline__ void done(const Unit&) const {}
};
struct EpiInProj {
    static constexpr bool PERM = true, AFTER_DRAIN = false;
    bf16_t* Zo; bf16_t* U;
    __device__ __forceinline__ void operator()(const f32x4 (&acc)[2][2][4][2], const Unit& u, int wr, int wc, int fr, int fq) const {
        const int row0 = u.pm * BM + wr * 64 + fr;
#pragma unroll
        for (int ai = 0; ai < 2; ++ai)
#pragma unroll
            for (int m = 0; m < 4; ++m) { const int row = row0 + ai * HALF + m * 16;
#pragma unroll
                for (int bj = 0; bj < 2; ++bj) { const int c0 = u.pn * BM + bj * HALF + wc * 32 + 8 * fq;
                    const f32x4 v0 = acc[ai][bj][m][0], v1 = acc[ai][bj][m][1];
                    u32x4 w; w.x = cvt_pk_bf16(v0[0], v0[1]); w.y = cvt_pk_bf16(v0[2], v0[3]); w.z = cvt_pk_bf16(v1[0], v1[1]); w.w = cvt_pk_bf16(v1[2], v1[3]);
                    bf16_t* dst = u.pn < 2 ? U + ((size_t)((c0 >> 4) * 2048 + (row >> 4)) * 512 + (row & 15) * 16 + (c0 & 15)) : Zo + (size_t)row * 2048 + c0;
                    *(u32x4*)dst = w; } }
    }
};
struct EpiXloc {
    static constexpr bool PERM = false, AFTER_DRAIN = false;
    float* XL;
    __device__ __forceinline__ void operator()(const f32x4 (&acc)[2][2][4][2], const Unit& u, int wr, int wc, int fr, int fq) const {
        const int row0 = u.pm * BM + wr * 64 + fr, col0 = wc * 32 + 4 * fq;
#pragma unroll
        for (int ai = 0; ai < 2; ++ai)
#pragma unroll
            for (int m = 0; m < 4; ++m) { float* rowp = XL + ((size_t)u.eb * 2048 + row0 + ai * HALF + m * 16) * 128 + col0;
#pragma unroll
                for (int n = 0; n < 2; ++n) *(f32x4*)(rowp + n * 16) = acc[ai][0][m][n]; }
    }
};
__device__ __forceinline__ float gelu_t(float x) { const float u2 = -2.302208198f * (x + 0.044715f * x * x * x); return x * __builtin_amdgcn_rcpf(1.0f + __builtin_amdgcn_exp2f(u2)); }
struct EpiSsmOut {
    static constexpr bool PERM = true, AFTER_DRAIN = false;
    bf16_t* G;
    __device__ __forceinline__ void operator()(const f32x4 (&acc)[2][2][4][2], const Unit& u, int wr, int wc, int fr, int fq) const {
        const int row0 = u.pm * BM + wr * 64 + fr;
#pragma unroll
        for (int ai = 0; ai < 2; ++ai)
#pragma unroll
            for (int m = 0; m < 4; ++m) { const int row = row0 + ai * HALF + m * 16;
#pragma unroll
                for (int bj = 0; bj < 2; ++bj) { const int n0 = bj * HALF + wc * 32 + 8 * fq;
                    const f32x4 v0 = acc[ai][bj][m][0], v1 = acc[ai][bj][m][1];
                    u32x4 w; w.x = cvt_pk_bf16(gelu_t(v0[0]), gelu_t(v0[1])); w.y = cvt_pk_bf16(gelu_t(v0[2]), gelu_t(v0[3])); w.z = cvt_pk_bf16(gelu_t(v1[0]), gelu_t(v1[1])); w.w = cvt_pk_bf16(gelu_t(v1[2]), gelu_t(v1[3]));
                    *(u32x4*)(G + ((size_t)row * 16 + (n0 >> 4)) * 512 + u.eb * 16 + (n0 & 15)) = w; } }
    }
};

struct CmpOrder {
    int G, c;
    __device__ __forceinline__ bool next(int i, Unit& u) const { const int L = i * G + c; if (L >= 32) return false; u.eb = L >> 4; u.pm = L & 15; u.pn = 0; u.p0 = 0; u.cnt = 0; return true; }
    __device__ __forceinline__ void a_ready(const Unit&) const {}
    __device__ __forceinline__ void done(const Unit&) const {}
};
struct EpiCmpHid {
    static constexpr bool PERM = false, AFTER_DRAIN = false;
    bf16_t* HC; const float* bias;
    __device__ __forceinline__ void operator()(const f32x4 (&acc)[2][2][4][2], const Unit& u, int wr, int wc, int fr, int fq) const {
        if (wc < 2) {
            const int row0 = u.pm * BM + wr * 64 + fr, col0 = wc * 32 + 4 * fq;
#pragma unroll
            for (int n = 0; n < 2; ++n) { const f32x4 bv = *(const f32x4*)(bias + u.eb * 64 + col0 + n * 16);
#pragma unroll
                for (int ai = 0; ai < 2; ++ai)
#pragma unroll
                    for (int m = 0; m < 4; ++m) { const f32x4 v = acc[ai][0][m][n] + bv;
                        typedef unsigned u32x2_ __attribute__((ext_vector_type(2)));
                        u32x2_ w; w.x = cvt_pk_bf16(gelu_t(v[0]), gelu_t(v[1])); w.y = cvt_pk_bf16(gelu_t(v[2]), gelu_t(v[3]));
                        *(u32x2_*)(HC + ((size_t)u.eb * 4096 + row0 + ai * HALF + m * 16) * 64 + col0 + n * 16) = w; } }
        }
    }
};
}

struct Args { const float* in[26]; float* out; unsigned char* ws; int ph_lo, ph_hi; };

struct Frame {
    LAS unsigned char* lds;
    int tid, lane, wave, blk, G;
};

__device__ __forceinline__ void ph_norm(const Frame& F, const float* xin, const float* add, float* xout, const float* g, bf16* hn) {
    const int gw = F.blk * NWAVES + F.wave, NGW = F.G * NWAVES;
    for (int row = gw; row < T; row += NGW) {
        const f32x4* xr = (const f32x4*)(xin + (size_t)row * DM);
        f32x4 v[4]; float s = 0.f;
#pragma unroll
        for (int j = 0; j < 4; ++j) { v[j] = xr[F.lane + 64 * j];
            if (add) { v[j] += ((const f32x4*)(add + (size_t)row * DM))[F.lane + 64 * j]; ((f32x4*)(xout + (size_t)row * DM))[F.lane + 64 * j] = v[j]; }
            s += v[j].x * v[j].x + v[j].y * v[j].y + v[j].z * v[j].z + v[j].w * v[j].w; }
        s = wave_sum(s, F.lane);
        const float r = rsqrtf(s * (1.0f / DM) + EPS);
#pragma unroll
        for (int j = 0; j < 4; ++j) {
            const f32x4 gg = ((const f32x4*)g)[F.lane + 64 * j];
            u32x2 o; o.x = pk2(v[j].x * r * gg.x, v[j].y * r * gg.y); o.y = pk2(v[j].z * r * gg.z, v[j].w * r * gg.w);
            *(u32x2*)(hn + (size_t)row * DM + (F.lane + 64 * j) * 4) = o;
        }
    }
}
__device__ __forceinline__ void ph_final_norm(const Frame& F, float* x, const float* add, const float* g) {
    const int gw = F.blk * NWAVES + F.wave, NGW = F.G * NWAVES;
    for (int row = gw; row < T; row += NGW) {
        f32x4* xr = (f32x4*)(x + (size_t)row * DM);
        f32x4 v[4]; float s = 0.f;
#pragma unroll
        for (int j = 0; j < 4; ++j) { v[j] = xr[F.lane + 64 * j]; if (add) v[j] += ((const f32x4*)(add + (size_t)row * DM))[F.lane + 64 * j]; s += v[j].x * v[j].x + v[j].y * v[j].y + v[j].z * v[j].z + v[j].w * v[j].w; }
        s = wave_sum(s, F.lane);
        const float r = rsqrtf(s * (1.0f / DM) + EPS);
#pragma unroll
        for (int j = 0; j < 4; ++j) {
            const f32x4 gg = ((const f32x4*)g)[F.lane + 64 * j];
            f32x4 o; o.x = v[j].x * r * gg.x; o.y = v[j].y * r * gg.y; o.z = v[j].z * r * gg.z; o.w = v[j].w * r * gg.w;
            xr[F.lane + 64 * j] = o;
        }
    }
}

template <bool DUAL, class Epi>
__device__ __forceinline__ void sgemm_naive(const Frame& F, const bf16* A, int lda, const float* B, int ldb, int M, int N, int K, int dualoff, const Epi& epi) {
    LAS float* As = (LAS float*)F.lds;
    LAS float* Bs = As + 16 * 132;
    LAS float* Bs2 = Bs + 16 * 128;
    const int tiles_n = (N + 127) / 128, tiles_m = M / 128;
    const int tx = F.tid & 31, ty = F.tid >> 5;
    for (int tile = F.blk; tile < tiles_m * tiles_n; tile += F.G) {
        const int tm = tile / tiles_n, tn = tile % tiles_n;
        float acc[8][4], acc2[8][4];
#pragma unroll
        for (int i = 0; i < 8; ++i)
#pragma unroll
            for (int j = 0; j < 4; ++j) { acc[i][j] = 0.f; acc2[i][j] = 0.f; }
        const int arow = F.tid >> 2, akq = (F.tid & 3) * 4;
        const int bk = F.tid >> 5, bn = (F.tid & 31) * 4;
        for (int k0 = 0; k0 < K; k0 += 16) {
            {
                const u32x2 av = *(const u32x2*)(A + (size_t)(tm * 128 + arow) * lda + k0 + akq);
                As[(akq + 0) * 132 + arow] = __uint_as_float(av.x << 16);
                As[(akq + 1) * 132 + arow] = __uint_as_float(av.x & 0xffff0000u);
                As[(akq + 2) * 132 + arow] = __uint_as_float(av.y << 16);
                As[(akq + 3) * 132 + arow] = __uint_as_float(av.y & 0xffff0000u);
                const int col = tn * 128 + bn;
                f32x4 bv = (f32x4){0.f, 0.f, 0.f, 0.f};
                const float* bp = B + (size_t)(k0 + bk) * ldb + col;
                if (col + 3 < N) { bv.x = bp[0]; bv.y = bp[1]; bv.z = bp[2]; bv.w = bp[3]; }
                else { if (col < N) bv.x = bp[0]; if (col + 1 < N) bv.y = bp[1]; if (col + 2 < N) bv.z = bp[2]; }
                *(LAS f32x4*)(Bs + bk * 128 + bn) = bv;
                if (DUAL) {
                    const float* bp2 = bp + dualoff;
                    f32x4 bw; bw.x = bp2[0]; bw.y = bp2[1]; bw.z = bp2[2]; bw.w = bp2[3];
                    *(LAS f32x4*)(Bs2 + bk * 128 + bn) = bw;
                }
            }
            __syncthreads();
#pragma unroll 4
            for (int k = 0; k < 16; ++k) {
                float a[8];
                const f32x4 a0 = *(const LAS f32x4*)(As + k * 132 + ty * 8), a1 = *(const LAS f32x4*)(As + k * 132 + ty * 8 + 4);
                a[0] = a0.x; a[1] = a0.y; a[2] = a0.z; a[3] = a0.w; a[4] = a1.x; a[5] = a1.y; a[6] = a1.z; a[7] = a1.w;
                const f32x4 b = *(const LAS f32x4*)(Bs + k * 128 + tx * 4);
#pragma unroll
                for (int i = 0; i < 8; ++i) { acc[i][0] += a[i] * b.x; acc[i][1] += a[i] * b.y; acc[i][2] += a[i] * b.z; acc[i][3] += a[i] * b.w; }
                if (DUAL) {
                    const f32x4 b2 = *(const LAS f32x4*)(Bs2 + k * 128 + tx * 4);
#pragma unroll
                    for (int i = 0; i < 8; ++i) { acc2[i][0] += a[i] * b2.x; acc2[i][1] += a[i] * b2.y; acc2[i][2] += a[i] * b2.z; acc2[i][3] += a[i] * b2.w; }
                }
            }
            __syncthreads();
        }
#pragma unroll
        for (int i = 0; i < 8; ++i)
#pragma unroll
            for (int j = 0; j < 4; ++j) {
                const int row = tm * 128 + ty * 8 + i, col = tn * 128 + tx * 4 + j;
                if (col < N) epi(row, col, acc[i][j], acc2[i][j]);
            }
    }
}
struct EpiStoreBf16 { bf16* O; int ldo; __device__ __forceinline__ void operator()(int r, int c, float a, float) const { O[(size_t)r * ldo + c] = (bf16)f2bf(a); } };
struct EpiGlu { bf16* O; int ldo; __device__ __forceinline__ void operator()(int r, int c, float a, float b) const { O[(size_t)r * ldo + c] = (bf16)f2bf(a * sigmoidf_(b)); } };
struct EpiResid { const float* X; float* O; __device__ __forceinline__ void operator()(int r, int c, float a, float) const { O[(size_t)r * DM + c] = X[(size_t)r * DM + c] + a; } };

__device__ __forceinline__ void ssm_naive_item(int b, int g, const float* a_re, const float* a_im, const float* b_re, const float* b_im, const float* c_re, const float* c_im,
                                               const float* dpar, const float* log_dt, const bf16* Z, bf16* G1, int lane) {
    const int p = lane;
    const float are = a_re[g * 64 + p], aim = a_im[g * 64 + p], dt = expf(log_dt[g]);
    const float er = expf(are * dt), lbr = er * cosf(aim * dt), lbi = er * sinf(aim * dt);
    const float xx = lbr - 1.0f, yy = lbi, den = are * are + aim * aim;
    const float fr = (xx * are + yy * aim) / den, fi = (yy * are - xx * aim) / den;
    float bbr[16], bbi[16], cr[16], ci[16];
#pragma unroll
    for (int h = 0; h < 16; ++h) {
        const float br = b_re[(g * 64 + p) * 16 + h], bi = b_im[(g * 64 + p) * 16 + h];
        bbr[h] = fr * br - fi * bi; bbi[h] = fr * bi + fi * br;
        cr[h] = c_re[(g * 16 + h) * 64 + p]; ci[h] = c_im[(g * 16 + h) * 64 + p];
    }
    const float dd = dpar[g * 16 + (lane & 15)];
    float xr = 0.f, xi = 0.f;
    for (int t = 0; t < SEQ; ++t) {
        const size_t row = (size_t)b * SEQ + t;
        const u32x4 u0 = *(const u32x4*)(Z + row * ZP + ZC_U + g * 16), u1 = *(const u32x4*)(Z + row * ZP + ZC_U + g * 16 + 8);
        float u[16];
        u[0] = __uint_as_float(u0.x << 16); u[1] = __uint_as_float(u0.x & 0xffff0000u); u[2] = __uint_as_float(u0.y << 16); u[3] = __uint_as_float(u0.y & 0xffff0000u);
        u[4] = __uint_as_float(u0.z << 16); u[5] = __uint_as_float(u0.z & 0xffff0000u); u[6] = __uint_as_float(u0.w << 16); u[7] = __uint_as_float(u0.w & 0xffff0000u);
        u[8] = __uint_as_float(u1.x << 16); u[9] = __uint_as_float(u1.x & 0xffff0000u); u[10] = __uint_as_float(u1.y << 16); u[11] = __uint_as_float(u1.y & 0xffff0000u);
        u[12] = __uint_as_float(u1.z << 16); u[13] = __uint_as_float(u1.z & 0xffff0000u); u[14] = __uint_as_float(u1.w << 16); u[15] = __uint_as_float(u1.w & 0xffff0000u);
        float bur = 0.f, bui = 0.f;
#pragma unroll
        for (int h = 0; h < 16; ++h) { bur += bbr[h] * u[h]; bui += bbi[h] * u[h]; }
        const float nxr = lbr * xr - lbi * xi + bur, nxi = lbr * xi + lbi * xr + bui;
        xr = nxr; xi = nxi;
        float y = 0.f;
#pragma unroll
        for (int h = 0; h < 16; ++h) { const float v = wave_sum(cr[h] * xr - ci[h] * xi, lane); if (lane == h) y = v; }
        if (lane < 16) {
            const float ul = bf2f(Z[row * ZP + ZC_U + g * 16 + lane]);
            G1[row * D_SSM + g * 16 + lane] = (bf16)f2bf(gelu_tanh(y + dd * ul));
        }
    }
}
__device__ __forceinline__ void compress_naive_item(int item, const bf16* Z, const float* pos, const float* w1, const float* w2, bf16* KC, bf16* VC, int lane) {
    const int i = item & 1, hkv = (item >> 1) & 1, n = (item >> 2) % NCMPP, b = (item >> 2) / NCMPP;
    bf16* dst = i ? VC : KC;
    if (n == NCMP) { dst[(((size_t)b * NCMPP + n) * 2 + hkv) * 64 + lane] = 0; return; }
    const float* posi = pos + i * 32 * 64; const float* w1i = w1 + (size_t)i * 32 * 64 * 64; const float* w2i = w2 + i * 64 * 64;
    float acc = 0.f;
    for (int l = 0; l < 32; ++l) {
        const bf16* zr = Z + ((size_t)b * SEQ + 16 * n + l) * ZP + ZC_KV + i * 128 + hkv * 64;
        for (int d = 0; d < 64; ++d) acc += (bf2f(zr[d]) + posi[l * 64 + d]) * w1i[(l * 64 + d) * 64 + lane];
    }
    const float hid = gelu_tanh(acc);
    float o = 0.f;
    for (int e = 0; e < 64; ++e) o += lane_bcast(hid, e) * w2i[e * 64 + lane];
    dst[(((size_t)b * NCMPP + n) * 2 + hkv) * 64 + lane] = (bf16)f2bf(o);
}

__device__ __forceinline__ void attn_chunk(LAS float* wl, const bf16* Z, const float* rel_bias, int b, int hkv, int t, int base, int kcol, int vcol, int lane,
                                           float (&m)[4], float (&l)[4], float (&o)[4]) {
    const int pos = base + lane; const bool valid = (pos >= 0) && (pos <= t);
    const int posc = pos < 0 ? 0 : (pos > SEQ - 1 ? SEQ - 1 : pos);
    const bf16* kr = Z + ((size_t)b * SEQ + posc) * ZP + kcol + hkv * 64;
    float s[4] = {0.f, 0.f, 0.f, 0.f};
#pragma unroll 2
    for (int c = 0; c < 8; ++c) {
        const u32x4 kv = *(const u32x4*)(kr + c * 8);
        float k[8];
        k[0] = __uint_as_float(kv.x << 16); k[1] = __uint_as_float(kv.x & 0xffff0000u); k[2] = __uint_as_float(kv.y << 16); k[3] = __uint_as_float(kv.y & 0xffff0000u);
        k[4] = __uint_as_float(kv.z << 16); k[5] = __uint_as_float(kv.z & 0xffff0000u); k[6] = __uint_as_float(kv.w << 16); k[7] = __uint_as_float(kv.w & 0xffff0000u);
#pragma unroll
        for (int g = 0; g < 4; ++g) {
            const f32x4 q0 = *(const LAS f32x4*)(wl + g * 64 + c * 8), q1 = *(const LAS f32x4*)(wl + g * 64 + c * 8 + 4);
            s[g] += q0.x * k[0] + q0.y * k[1] + q0.z * k[2] + q0.w * k[3] + q1.x * k[4] + q1.y * k[5] + q1.z * k[6] + q1.w * k[7];
        }
    }
    const int bk = t5_bucket(t - pos);
#pragma unroll
    for (int g = 0; g < 4; ++g) {
        const float sv = valid ? s[g] + rel_bias[bk * 8 + hkv * 4 + g] : -1e30f;
        const float mn = fmaxf(m[g], wave_max(sv, lane));
        const float alpha = __expf(m[g] - mn);
        const float p = valid ? __expf(sv - mn) : 0.f;
        l[g] = l[g] * alpha + wave_sum(p, lane);
        o[g] *= alpha; m[g] = mn;
        wl[256 + g * 64 + lane] = p;
    }
#pragma unroll 4
    for (int key = 0; key < 64; ++key) {
        int pk = base + key; pk = pk < 0 ? 0 : (pk > SEQ - 1 ? SEQ - 1 : pk);
        const float v = bf2f(Z[((size_t)b * SEQ + pk) * ZP + vcol + hkv * 64 + lane]);
#pragma unroll
        for (int g = 0; g < 4; ++g) o[g] += wl[256 + g * 64 + key] * v;
    }
}
__device__ __forceinline__ void attn_naive_item(LAS float* wl, int b, int hkv, int t, const bf16* Z, const float* KC, const float* VC, const float* rel_bias, bf16* YC, int lane) {
    const size_t row = (size_t)b * SEQ + t;
#pragma unroll
    for (int g = 0; g < 4; ++g) wl[g * 64 + lane] = bf2f(Z[row * ZP + ZC_Q + hkv * 256 + g * 64 + lane]) * 0.125f;
#pragma unroll 1
    for (int c = 0; c < 4; ++c) {
        const int n = c * 64 + lane; const bool valid = (n < NCMP) && (16 * n + 31 <= t);
        const float* kr = KC + (((size_t)b * NCMPP + (n < NCMP ? n : 0)) * 2 + hkv) * 64;
        float s[4] = {0.f, 0.f, 0.f, 0.f};
#pragma unroll 4
        for (int d4 = 0; d4 < 16; ++d4) {
            const f32x4 k = *(const f32x4*)(kr + d4 * 4);
#pragma unroll
            for (int g = 0; g < 4; ++g) { const f32x4 q = *(const LAS f32x4*)(wl + g * 64 + d4 * 4); s[g] += q.x * k.x + q.y * k.y + q.z * k.z + q.w * k.w; }
        }
        const int bk = t5_bucket(t - (16 * n + 31));
#pragma unroll
        for (int g = 0; g < 4; ++g) wl[256 + g * 256 + n] = valid ? s[g] + rel_bias[bk * 8 + hkv * 4 + g] : -1e30f;
    }
#pragma unroll
    for (int g = 0; g < 4; ++g) {
        float sc[4];
#pragma unroll
        for (int c = 0; c < 4; ++c) sc[c] = wl[256 + g * 256 + c * 64 + lane];
        const float mx = wave_max(fmaxf(fmaxf(sc[0], sc[1]), fmaxf(sc[2], sc[3])), lane);
        float e[4], ls = 0.f;
#pragma unroll
        for (int c = 0; c < 4; ++c) { e[c] = sc[c] > -1e29f ? __expf(sc[c] - mx) : 0.f; ls += e[c]; }
        ls = wave_sum(ls, lane);
        const float inv = ls > 0.f ? 1.0f / ls : 0.f;
#pragma unroll
        for (int c = 0; c < 4; ++c) wl[256 + g * 256 + c * 64 + lane] = e[c] * inv;
    }
    float oc[4] = {0.f, 0.f, 0.f, 0.f};
    const int nmax = t >= 31 ? ((t - 31) / 16 + 1 < NCMP ? (t - 31) / 16 + 1 : NCMP) : 0;
#pragma unroll 4
    for (int n = 0; n < nmax; ++n) {
        const float v = VC[(((size_t)b * NCMPP + n) * 2 + hkv) * 64 + lane];
#pragma unroll
        for (int g = 0; g < 4; ++g) oc[g] += wl[256 + g * 256 + n] * v;
    }
    float imp = 0.f;
#pragma unroll
    for (int g = 0; g < 4; ++g) {
        const LAS float* P = wl + 256 + g * 256;
        imp += P[4 * lane] + P[4 * lane + 1] + P[4 * lane + 2] + 0.5f * P[4 * lane + 3] + (lane > 0 ? 0.5f * P[4 * lane - 1] : 0.f);
    }
    const int blk = t >> 6;
    const bool forced = (lane == 0) || (lane <= blk && lane > blk - 2), future = lane > blk;
    const float v = forced ? 1e9f : (future ? -1e9f : imp);
    int rank = 0;
    for (int jj = 0; jj < 64; ++jj) { const float vj = lane_bcast(v, jj); rank += (vj > v) || (vj == v && jj < lane); }
    unsigned long long mask = __ballot(rank < 16 && !future);
    float m[4], l[4], o[4];
#pragma unroll
    for (int g = 0; g < 4; ++g) { m[g] = -1e30f; l[g] = 0.f; o[g] = 0.f; }
    while (mask) {
        const int j = __builtin_ctzll(mask); mask &= mask - 1;
        attn_chunk(wl, Z, rel_bias, b, hkv, t, 64 * j, ZC_KV + 256, ZC_KV + 384, lane, m, l, o);
    }
    float os[4];
#pragma unroll
    for (int g = 0; g < 4; ++g) { os[g] = l[g] > 0.f ? o[g] / l[g] : 0.f; m[g] = -1e30f; l[g] = 0.f; o[g] = 0.f; }
    for (int c = 0; c < 8; ++c) attn_chunk(wl, Z, rel_bias, b, hkv, t, t - 511 + 64 * c, ZC_KV + 512, ZC_KV + 640, lane, m, l, o);
#pragma unroll
    for (int g = 0; g < 4; ++g) {
        const float ow = l[g] > 0.f ? o[g] / l[g] : 0.f;
        const bf16* gp = Z + row * ZP + ZC_G + hkv * 12 + g * 3;
        const float r = sigmoidf_(bf2f(gp[0])) * oc[g] + sigmoidf_(bf2f(gp[1])) * os[g] + sigmoidf_(bf2f(gp[2])) * ow;
        YC[row * DM + D_SSM + hkv * 256 + g * 64 + lane] = (bf16)f2bf(r);
    }
}

__device__ __forceinline__ void ph_norm_route(const Frame& F, const float* x, const float* g, const float* rgw, const float* rgb, const float* rew, const float* reb, bf16* hn,
                                              unsigned* gcnt, unsigned* list, float* listw) {
    LAS unsigned* cnt_l = (LAS unsigned*)F.lds; LAS unsigned* base_l = cnt_l + 32; LAS unsigned* ent = cnt_l + 64;
    for (int row0 = F.blk * 128; row0 < T; row0 += F.G * 128) {
        if (F.tid < 32) cnt_l[F.tid] = 0u;
        __syncthreads();
        for (int kk = 0; kk < 16; ++kk) {
            const int row = row0 + F.wave * 16 + kk;
            const f32x4* xr = (const f32x4*)(x + (size_t)row * DM);
            f32x4 v[4]; float s = 0.f;
#pragma unroll
            for (int j = 0; j < 4; ++j) { v[j] = xr[F.lane + 64 * j]; s += v[j].x * v[j].x + v[j].y * v[j].y + v[j].z * v[j].z + v[j].w * v[j].w; }
            s = wave_sum(s, F.lane);
            const float r = rsqrtf(s * (1.0f / DM) + EPS);
            float lg[4] = {0.f, 0.f, 0.f, 0.f};
#pragma unroll
            for (int j = 0; j < 4; ++j) {
                const f32x4 gg = ((const f32x4*)g)[F.lane + 64 * j];
                v[j].x = v[j].x * r * gg.x; v[j].y = v[j].y * r * gg.y; v[j].z = v[j].z * r * gg.z; v[j].w = v[j].w * r * gg.w;
                u32x2 o; o.x = pk2(v[j].x, v[j].y); o.y = pk2(v[j].z, v[j].w);
                *(u32x2*)(hn + (size_t)row * DM + (F.lane + 64 * j) * 4) = o;
                const int c0 = (F.lane + 64 * j) * 4;
                const f32x4 w0 = ((const f32x4*)rgw)[c0], w1 = ((const f32x4*)rgw)[c0 + 1], w2 = ((const f32x4*)rgw)[c0 + 2], w3 = ((const f32x4*)rgw)[c0 + 3];
                lg[0] += v[j].x * w0.x + v[j].y * w1.x + v[j].z * w2.x + v[j].w * w3.x;
                lg[1] += v[j].x * w0.y + v[j].y * w1.y + v[j].z * w2.y + v[j].w * w3.y;
                lg[2] += v[j].x * w0.z + v[j].y * w1.z + v[j].z * w2.z + v[j].w * w3.z;
                lg[3] += v[j].x * w0.w + v[j].y * w1.w + v[j].z * w2.w + v[j].w * w3.w;
            }
#pragma unroll
            for (int o = 0; o < 4; ++o) lg[o] = wave_sum(lg[o], F.lane) + rgb[o];
            int gi = 0; float gm = lg[0];
#pragma unroll
            for (int o = 1; o < 4; ++o) if (lg[o] > gm) { gm = lg[o]; gi = o; }
            float gs = 0.f;
#pragma unroll
            for (int o = 0; o < 4; ++o) gs += __expf(lg[o] - gm);
            const float gval = 1.0f / gs;
            const float* we = rew + (size_t)gi * DM * 8;
            float le[8] = {0.f, 0.f, 0.f, 0.f, 0.f, 0.f, 0.f, 0.f};
#pragma unroll
            for (int j = 0; j < 4; ++j) {
                const int c0 = (F.lane + 64 * j) * 4;
                const float hv[4] = {v[j].x, v[j].y, v[j].z, v[j].w};
#pragma unroll
                for (int c = 0; c < 4; ++c) {
                    const f32x4 wa = ((const f32x4*)we)[(c0 + c) * 2], wb = ((const f32x4*)we)[(c0 + c) * 2 + 1];
                    le[0] += hv[c] * wa.x; le[1] += hv[c] * wa.y; le[2] += hv[c] * wa.z; le[3] += hv[c] * wa.w;
                    le[4] += hv[c] * wb.x; le[5] += hv[c] * wb.y; le[6] += hv[c] * wb.z; le[7] += hv[c] * wb.w;
                }
            }
#pragma unroll
            for (int e = 0; e < 8; ++e) le[e] = wave_sum(le[e], F.lane) + reb[gi * 8 + e];
            int e1 = 0; float m1 = le[0];
#pragma unroll
            for (int e = 1; e < 8; ++e) if (le[e] > m1) { m1 = le[e]; e1 = e; }
            int e2 = -1; float m2 = -3.0e38f;
#pragma unroll
            for (int e = 0; e < 8; ++e) if (e != e1 && le[e] > m2) { m2 = le[e]; e2 = e; }
            const float p2 = __expf(m2 - m1), inv = 1.0f / (1.0f + p2);
            if (F.lane == 0) {
                const unsigned ea = (unsigned)(gi * 8 + e1), eb = (unsigned)(gi * 8 + e2);
                const unsigned pa = __hip_atomic_fetch_add(cnt_l + ea, 1u, __ATOMIC_RELAXED, __HIP_MEMORY_SCOPE_WORKGROUP);
                const unsigned pb = __hip_atomic_fetch_add(cnt_l + eb, 1u, __ATOMIC_RELAXED, __HIP_MEMORY_SCOPE_WORKGROUP);
                LAS unsigned* en = ent + (F.wave * 16 + kk) * 6;
                en[0] = ea; en[1] = eb; en[2] = pa; en[3] = pb; en[4] = __float_as_uint(gval * inv); en[5] = __float_as_uint(gval * p2 * inv);
            }
        }
        __syncthreads();
        if (F.tid < 32) base_l[F.tid] = __hip_atomic_fetch_add(gcnt + F.tid * 64, cnt_l[F.tid], __ATOMIC_RELAXED, __HIP_MEMORY_SCOPE_AGENT);
        __syncthreads();
        if (F.tid < 128) {
            const LAS unsigned* en = ent + F.tid * 6; const unsigned tok = (unsigned)(row0 + F.tid);
            const unsigned ia = en[0] * LCAP + base_l[en[0]] + en[2], ib = en[1] * LCAP + base_l[en[1]] + en[3];
            list[ia] = tok * 2u; listw[ia] = __uint_as_float(en[4]);
            list[ib] = tok * 2u + 1u; listw[ib] = __uint_as_float(en[5]);
        }
        __syncthreads();
    }
}
__device__ __forceinline__ void build_expert_tab(const Frame& F, const unsigned* gcnt, LAS int* tab) {
    if (F.tid < 64) {
        const int c = F.lane < 32 ? (int)__hip_atomic_load(gcnt + F.lane * 64, __ATOMIC_RELAXED, __HIP_MEMORY_SCOPE_AGENT) : 0;
        int tiles = (c + 255) >> 8, incl = tiles;
#pragma unroll
        for (int o = 1; o < 32; o <<= 1) { const int t = __builtin_amdgcn_ds_bpermute((F.lane - o) << 2, incl); if (F.lane >= o) incl += t; }
        if (F.lane < 32) { tab[F.lane + 1] = incl; tab[33 + F.lane] = c; }
        if (F.lane == 0) tab[0] = 0;
    }
    __syncthreads();
}
__device__ __forceinline__ void ph_experts_naive(const Frame& F, const bf16* hn, const unsigned* route, const float* wg, const float* wu, const float* wd, float* x) {
    LAS float* hs = (LAS float*)F.lds;
    LAS float* hd = hs + 1024;
    for (int tok = F.blk; tok < T; tok += F.G) {
        { const unsigned pv = *(const unsigned*)(hn + (size_t)tok * DM + F.tid * 2); hs[F.tid * 2] = __uint_as_float(pv << 16); hs[F.tid * 2 + 1] = __uint_as_float(pv & 0xffff0000u); }
        const u32x4 rt = *(const u32x4*)(route + (size_t)tok * 4);
        __syncthreads();
        {
            const int s = F.tid >> 8, f = F.tid & 255;
            const unsigned e = s ? rt.y : rt.x; const float w = __uint_as_float(s ? rt.w : rt.z);
            const float* pg = wg + (size_t)e * DM * 256 + f; const float* pu = wu + (size_t)e * DM * 256 + f;
            float ga = 0.f, ua = 0.f;
            for (int d = 0; d < DM; ++d) { const float hv = hs[d]; ga += hv * pg[(size_t)d * 256]; ua += hv * pu[(size_t)d * 256]; }
            hd[s * 256 + f] = ga * sigmoidf_(ga) * ua * w;
        }
        __syncthreads();
        for (int dd = F.tid; dd < DM; dd += NTHR) {
            float acc = 0.f;
            const float* p0 = wd + (size_t)rt.x * 256 * DM + dd; const float* p1 = wd + (size_t)rt.y * 256 * DM + dd;
            for (int f = 0; f < 256; ++f) acc += hd[f] * p0[(size_t)f * DM];
            for (int f = 0; f < 256; ++f) acc += hd[256 + f] * p1[(size_t)f * DM];
            x[(size_t)tok * DM + dd] += acc;
        }
        __syncthreads();
    }
}


namespace nsa {
typedef short bf16x8 __attribute__((ext_vector_type(8)));
typedef short s16x4 __attribute__((ext_vector_type(4)));
typedef float f32x16 __attribute__((ext_vector_type(16)));
typedef float f32x2_t __attribute__((ext_vector_type(2)));
typedef __bf16 bf16x2_t __attribute__((ext_vector_type(2)));
constexpr int SLOTB = 8192;
constexpr int L_K = 0, L_V = 3 * SLOTB, L_IMP = 6 * SLOTB, L_BT = L_IMP + 65536, L_WS = L_BT + 4 * 132 * 4, L_RL = L_WS + 8 * 64 * 4, L_SM = L_RL + 4 * 64 * 4, L_END = L_SM + 64 * 8;
static_assert(L_END <= 131072, "nsa LDS map");
constexpr float LOG2E = 1.4426950408889634f;
constexpr float NEG_INF = -__builtin_inff();
#define NSA_SBAR() __builtin_amdgcn_sched_barrier(0)
__device__ __forceinline__ int crow(int r, int hi) { return (r & 3) + 8 * (r >> 2) + 4 * hi; }
__device__ __forceinline__ void glds16(const void* gsrc, unsigned lds_dst) { unsigned keep;
    asm volatile("s_mov_b32 %0, m0\n\ts_mov_b32 m0, %2\n\ts_nop 0\n\tglobal_load_lds_dwordx4 %1, off\n\ts_mov_b32 m0, %0" : "=&s"(keep) : "v"(gsrc), "s"(lds_dst) : "memory"); }
__device__ __forceinline__ unsigned cvtpk(float lo, float hi) { f32x2_t v = {lo, hi}; bf16x2_t b = __builtin_convertvector(v, bf16x2_t); return __builtin_bit_cast(unsigned, b); }
#define NSA_WAIT_BAR(N) asm volatile("s_waitcnt vmcnt(" #N ") lgkmcnt(0)\n\ts_barrier" ::: "memory")
__device__ __forceinline__ void qkt(f32x16& p0, f32x16& p1, const LAS char* kb, const bf16x8 (&qr)[4], const f32x16& cinit) {
#pragma unroll
    for (int d0 = 0; d0 < 4; ++d0) {
        const bf16x8 b0 = *(const LAS bf16x8*)(kb + d0 * 2048);
        const bf16x8 b1 = *(const LAS bf16x8*)(kb + d0 * 2048 + 512);
        if (d0 == 0) { p0 = __builtin_amdgcn_mfma_f32_32x32x16_bf16(b0, qr[0], cinit, 0, 0, 0); p1 = __builtin_amdgcn_mfma_f32_32x32x16_bf16(b1, qr[0], cinit, 0, 0, 0); }
        else { p0 = __builtin_amdgcn_mfma_f32_32x32x16_bf16(b0, qr[d0], p0, 0, 0, 0); p1 = __builtin_amdgcn_mfma_f32_32x32x16_bf16(b1, qr[d0], p1, 0, 0, 0); }
    }
}
__device__ __forceinline__ void pv(f32x16 (&o)[2], int vb, bf16x8 pa0, bf16x8 pa1, bf16x8 pa2, bf16x8 pa3) {
#pragma unroll
    for (int d0 = 0; d0 < 2; ++d0) { s16x4 lo[4], hi[4];
#pragma unroll
        for (int ks = 0; ks < 4; ++ks) {
            asm volatile("ds_read_b64_tr_b16 %0,%1 offset:%c2" : "=&v"(lo[ks]) : "v"(vb), "i"(d0 * 4096 + ks * 1024) : "memory");
            asm volatile("ds_read_b64_tr_b16 %0,%1 offset:%c2" : "=&v"(hi[ks]) : "v"(vb), "i"(d0 * 4096 + ks * 1024 + 512) : "memory"); }
        asm volatile("s_waitcnt lgkmcnt(0)" ::: "memory"); NSA_SBAR();
#define NSA_PK(k) (bf16x8){lo[k][0], lo[k][1], lo[k][2], lo[k][3], hi[k][0], hi[k][1], hi[k][2], hi[k][3]}
        o[d0] = __builtin_amdgcn_mfma_f32_32x32x16_bf16(pa0, NSA_PK(0), o[d0], 0, 0, 0);
        o[d0] = __builtin_amdgcn_mfma_f32_32x32x16_bf16(pa1, NSA_PK(1), o[d0], 0, 0, 0);
        o[d0] = __builtin_amdgcn_mfma_f32_32x32x16_bf16(pa2, NSA_PK(2), o[d0], 0, 0, 0);
        o[d0] = __builtin_amdgcn_mfma_f32_32x32x16_bf16(pa3, NSA_PK(3), o[d0], 0, 0, 0);
#undef NSA_PK
    }
}
__device__ __forceinline__ float other_half(float v, int hi) { auto rr = __builtin_amdgcn_permlane32_swap(__float_as_uint(v), __float_as_uint(v), false, false); return __uint_as_float(hi ? rr[0] : rr[1]); }
__device__ __forceinline__ float rowmax(const f32x16& p0, const f32x16& p1, int hi) {
    float a = fmaxf(fmaxf(p0[0], p0[1]), p1[0]), b = fmaxf(fmaxf(p0[2], p0[3]), p1[1]); a = fmaxf(fmaxf(a, p1[2]), p1[3]);
#pragma unroll
    for (int r = 4; r < 16; r += 4) { a = fmaxf(fmaxf(a, p0[r]), p0[r + 1]); b = fmaxf(fmaxf(b, p0[r + 2]), p0[r + 3]); a = fmaxf(fmaxf(a, p1[r]), p1[r + 1]); b = fmaxf(fmaxf(b, p1[r + 2]), p1[r + 3]); }
    const float m = fmaxf(a, b);
    return fmaxf(m, other_half(m, hi));
}
__device__ __forceinline__ void pack_p(const f32x16& p0, const f32x16& p1, bf16x8& a0, bf16x8& a1, bf16x8& a2, bf16x8& a3) {
    u32x4 w0, w1, w2, w3;
    w0 = (u32x4){cvtpk(p0[0], p0[1]), cvtpk(p0[2], p0[3]), cvtpk(p0[4], p0[5]), cvtpk(p0[6], p0[7])};
    w1 = (u32x4){cvtpk(p0[8], p0[9]), cvtpk(p0[10], p0[11]), cvtpk(p0[12], p0[13]), cvtpk(p0[14], p0[15])};
    w2 = (u32x4){cvtpk(p1[0], p1[1]), cvtpk(p1[2], p1[3]), cvtpk(p1[4], p1[5]), cvtpk(p1[6], p1[7])};
    w3 = (u32x4){cvtpk(p1[8], p1[9]), cvtpk(p1[10], p1[11]), cvtpk(p1[12], p1[13]), cvtpk(p1[14], p1[15])};
    a0 = __builtin_bit_cast(bf16x8, w0); a1 = __builtin_bit_cast(bf16x8, w1); a2 = __builtin_bit_cast(bf16x8, w2); a3 = __builtin_bit_cast(bf16x8, w3);
}

struct Ctx {
    LAS char* lds; unsigned lds0; int wid, lane, r32, hi, g, th, qloc;
    const LAS float* bt;
    LAS float* wsf;
    const LAS float* wrow;
    int vb0;
    const LAS char* kb0;
};
__device__ __forceinline__ void dma_k(const Ctx& c, const bf16* kbase, int pitch, int slot) { glds16(kbase + (size_t)c.lane * pitch + c.wid * 8, (unsigned)__builtin_amdgcn_readfirstlane(c.lds0 + L_K + slot * SLOTB + c.wid * 1024)); }
__device__ __forceinline__ void dma_v(const Ctx& c, const bf16* vbase, int pitch, int slot) { glds16(vbase + (size_t)(16 * (c.wid & 3) + (c.lane >> 2)) * pitch + (c.wid >> 2) * 32 + (c.lane & 3) * 8, (unsigned)__builtin_amdgcn_readfirstlane(c.lds0 + L_V + slot * SLOTB + c.wid * 1024)); }

__device__ __forceinline__ void cmp_scores(const Ctx& c, int slot, const bf16x8 (&qr)[4], int t0, int kt, f32x16& p0, f32x16& p1) {
    const int dmin = t0 + 32 * c.th - 16 * (64 * kt + 63) - 31;
    const bool special = dmin < 113;
    f32x16 ci; { const float v = special ? 0.f : c.bt[128];
#pragma unroll
        for (int r = 0; r < 16; ++r) ci[r] = v; }
    qkt(p0, p1, c.kb0 + slot * SLOTB, qr, ci);
    if (special) {
        int hi64 = 64 * c.hi; asm volatile("" : "+v"(hi64));
        const int dqh = t0 + c.qloc - 1024 * kt - 31 - hi64;
#pragma unroll
        for (int r = 0; r < 16; ++r) {
            const int d0 = dqh - 16 * ((r & 3) + 8 * (r >> 2)), d1 = d0 - 512;
            const float b0 = c.bt[d0 < 0 ? 0 : (d0 > 128 ? 128 : d0)], b1 = c.bt[d1 < 0 ? 0 : (d1 > 128 ? 128 : d1)];
            p0[r] = d0 < 0 ? NEG_INF : p0[r] + b0; p1[r] = d1 < 0 ? NEG_INF : p1[r] + b1;
        }
    }
}
template <int MODE>
__device__ __forceinline__ void online_tile(const Ctx& c, int slot, const bf16x8 (&qr)[4], int dq, bool near, bool masked_tile, bool lane_off, float& mhat, float& lsum, f32x16 (&o)[2]) {
    f32x16 ci; { const float v = (near ? 0.f : c.bt[128]) - mhat;
#pragma unroll
        for (int r = 0; r < 16; ++r) ci[r] = v; }
    f32x16 p0, p1;
    qkt(p0, p1, c.kb0 + slot * SLOTB, qr, ci);
    if (near || masked_tile) {
        int hi4 = 4 * c.hi; asm volatile("" : "+v"(hi4));
        const int dqh = dq - hi4;
#pragma unroll
        for (int r = 0; r < 16; ++r) {
            const int d0 = dqh - ((r & 3) + 8 * (r >> 2)), d1 = d0 - 32;
            if (near) { p0[r] += c.bt[d0 < 0 ? 0 : (d0 > 128 ? 128 : d0)]; p1[r] += c.bt[d1 < 0 ? 0 : (d1 > 128 ? 128 : d1)]; }
            if (d0 < 0 || (MODE == 1 && d0 >= 512)) p0[r] = NEG_INF;
            if (d1 < 0 || (MODE == 1 && d1 >= 512)) p1[r] = NEG_INF;
        }
    }
    if (MODE == 0) { if (lane_off) {
#pragma unroll
        for (int r = 0; r < 16; ++r) { p0[r] = NEG_INF; p1[r] = NEG_INF; } } }
    const float rm = rowmax(p0, p1, c.hi);
    if (__any(rm > 8.0f)) {
        const float dl = fmaxf(rm, 0.f); mhat += dl;
#pragma unroll
        for (int r = 0; r < 16; ++r) { p0[r] -= dl; p1[r] -= dl; }
        const float f = __builtin_amdgcn_exp2f(-dl); lsum *= f;
        if (c.hi == 0) c.wsf[c.r32] = f;
        asm volatile("s_waitcnt lgkmcnt(0)" ::: "memory");
#pragma unroll
        for (int r = 0; r < 16; ++r) { const float fr = c.wrow[(r & 3) + 8 * (r >> 2)]; o[0][r] *= fr; o[1][r] *= fr; }
    }
    float sacc = 0.f;
#pragma unroll
    for (int r = 0; r < 16; ++r) { p0[r] = __builtin_amdgcn_exp2f(p0[r]); p1[r] = __builtin_amdgcn_exp2f(p1[r]); sacc += p0[r] + p1[r]; }
    lsum += sacc;
    bf16x8 a0, a1, a2, a3; pack_p(p0, p1, a0, a1, a2, a3);
    pv(o, c.vb0 + slot * SLOTB, a0, a1, a2, a3);
}
__device__ __forceinline__ void add_scaled(const Ctx& c, f32x16 (&oacc)[2], const f32x16 (&o)[2], float s) {
    if (c.hi == 0) c.wsf[32 + c.r32] = s;
    asm volatile("s_waitcnt lgkmcnt(0)" ::: "memory");
#pragma unroll
    for (int r = 0; r < 16; ++r) { const float f = c.wrow[32 + (r & 3) + 8 * (r >> 2)]; oacc[0][r] += o[0][r] * f; oacc[1][r] += o[1][r] * f; }
    asm volatile("s_waitcnt lgkmcnt(0)" ::: "memory");
}

__device__ __forceinline__ void unit(LAS char* lds, int tid, int b, int hkv, int jt, const bf16* Z, const bf16* KCm, const bf16* VCm, const float* rel_bias, bf16* YC) {
    Ctx c; c.lds = lds; c.lds0 = (unsigned)(uintptr_t)lds; c.wid = __builtin_amdgcn_readfirstlane(tid >> 6); c.lane = tid & 63; c.r32 = c.lane & 31; c.hi = c.lane >> 5;
    c.g = c.wid & 3; c.th = c.wid >> 2; c.qloc = 32 * c.th + c.r32;
    c.bt = (const LAS float*)(lds + L_BT) + c.g * 132; c.wsf = (LAS float*)(lds + L_WS) + c.wid * 64; c.wrow = c.wsf + 4 * c.hi;
    c.vb0 = (int)(c.lds0 + L_V) + ((c.lane >> 4) & 1) * 32 + (c.lane & 3) * 8 + (4 * c.hi + ((c.lane & 15) >> 2)) * 64;
    c.kb0 = (const LAS char*)(lds + L_K) + c.hi * 1024 + c.r32 * 16;
    const int t0 = 64 * jt;
    const bf16* Zb = Z + (size_t)b * SEQ * ZP;
    const size_t qrow = (size_t)b * SEQ + t0 + c.qloc;
    for (int i = tid; i < 4 * 129; i += NTHR) { const int gg = i / 129, d = i % 129; ((LAS float*)(lds + L_BT))[gg * 132 + d] = rel_bias[t5_bucket(d) * 8 + hkv * 4 + gg] * LOG2E; }
    bf16x8 qr[4];
#pragma unroll
    for (int d0 = 0; d0 < 4; ++d0) qr[d0] = *(const bf16x8*)(Z + qrow * ZP + ZC_Q + hkv * 256 + c.g * 64 + d0 * 16 + c.hi * 8);
    const bf16* gp = Z + qrow * ZP + ZC_G + hkv * 12 + c.g * 3;
    const float gate0 = sigmoidf_(bf2f(gp[0])), gate1 = sigmoidf_(bf2f(gp[1])), gate2 = sigmoidf_(bf2f(gp[2]));
    f32x16 oacc[2];
#pragma unroll
    for (int r = 0; r < 16; ++r) { oacc[0][r] = 0.f; oacc[1][r] = 0.f; }

    const int nct = (4 * jt + 2) / 64 + 1;
    const bf16* kcb = KCm + (size_t)b * NCMPP * 128 + hkv * 64; const bf16* vcb = VCm + (size_t)b * NCMPP * 128 + hkv * 64;
    float mrow = NEG_INF;
    {
        dma_k(c, kcb, 128, 0); if (nct > 1) dma_k(c, kcb + 64 * 128, 128, 1);
        for (int i = 0; i < nct; ++i) {
            if (i + 1 < nct) NSA_WAIT_BAR(1); else NSA_WAIT_BAR(0);
            if (i + 2 < nct) dma_k(c, kcb + (size_t)(i + 2) * 64 * 128, 128, (i + 2) % 3);
            f32x16 p0, p1; cmp_scores(c, i % 3, qr, t0, i, p0, p1);
            mrow = fmaxf(mrow, rowmax(p0, p1, c.hi));
        }
        NSA_WAIT_BAR(0);
    }
    {
        const float muse = mrow == NEG_INF ? 0.f : mrow;
        float lsum = 0.f, carry = 0.f; f32x16 o[2];
#pragma unroll
        for (int r = 0; r < 16; ++r) { o[0][r] = 0.f; o[1][r] = 0.f; }
        LAS float* impw = (LAS float*)(lds + L_IMP) + (c.g * 64 + c.qloc) * 64;
        dma_k(c, kcb, 128, 0); dma_v(c, vcb, 128, 0); if (nct > 1) { dma_k(c, kcb + 64 * 128, 128, 1); dma_v(c, vcb + 64 * 128, 128, 1); }
        for (int i = 0; i < nct; ++i) {
            if (i + 1 < nct) NSA_WAIT_BAR(2); else NSA_WAIT_BAR(0);
            if (i + 2 < nct) { dma_k(c, kcb + (size_t)(i + 2) * 64 * 128, 128, (i + 2) % 3); dma_v(c, vcb + (size_t)(i + 2) * 64 * 128, 128, (i + 2) % 3); }
            f32x16 p0, p1; cmp_scores(c, i % 3, qr, t0, i, p0, p1);
            float sacc = 0.f;
#pragma unroll
            for (int r = 0; r < 16; ++r) { p0[r] = __builtin_amdgcn_exp2f(p0[r] - muse); p1[r] = __builtin_amdgcn_exp2f(p1[r] - muse); sacc += p0[r] + p1[r]; }
            lsum += sacc;
            float o3[8];
#pragma unroll
            for (int k = 0; k < 4; ++k) { o3[k] = other_half(p0[4 * k + 3], c.hi); o3[4 + k] = other_half(p1[4 * k + 3], c.hi); }
#pragma unroll
            for (int idx = 0; idx < 8; ++idx) {
                const int X = idx >> 2, k = idx & 3;
                const f32x16& p = X ? p1 : p0;
                const float cin = c.hi ? o3[idx] : (idx ? o3[idx - 1] : carry);
                impw[16 * i + 8 * X + 2 * k + c.hi] = p[4 * k] + p[4 * k + 1] + p[4 * k + 2] + 0.5f * p[4 * k + 3] + 0.5f * cin;
            }
            carry = o3[7];
            bf16x8 a0, a1, a2, a3; pack_p(p0, p1, a0, a1, a2, a3);
            pv(o, c.vb0 + (i % 3) * SLOTB, a0, a1, a2, a3);
        }
        const float lt = lsum + other_half(lsum, c.hi);
        const float rl = lt > 0.f ? 1.0f / lt : 0.f;
        if (c.hi == 0) ((LAS float*)(lds + L_RL))[c.g * 64 + c.qloc] = rl;
        add_scaled(c, oacc, o, rl * gate0);
        NSA_WAIT_BAR(0);
    }
    for (int k = 0; k < 8; ++k) {
        const int tok = c.wid * 8 + k;
        float v = 0.f;
#pragma unroll
        for (int gg = 0; gg < 4; ++gg) v += ((const LAS float*)(lds + L_IMP))[(gg * 64 + tok) * 64 + c.lane] * ((const LAS float*)(lds + L_RL))[gg * 64 + tok];
        const bool forced = (c.lane == 0) || (c.lane <= jt && c.lane > jt - 2), future = c.lane > jt;
        v = forced ? 1e9f : (future ? -1e9f : v);
        int rank = 0;
        for (int jj = 0; jj < 64; ++jj) { const float vj = lane_bcast(v, jj); rank += ((vj > v) || (vj == v && jj < c.lane)) ? 1 : 0; }
        const unsigned long long msk = __ballot(rank < 16 && !future);
        if (c.lane == 0) ((LAS unsigned long long*)(lds + L_SM))[tok] = msk;
    }
    NSA_WAIT_BAR(0);
    const unsigned long long mymask = ((const LAS unsigned long long*)(lds + L_SM))[c.qloc];
    {
        const bf16* kb = Zb + ZC_KV + 256 + hkv * 64; const bf16* vb = Zb + ZC_KV + 384 + hkv * 64;
        const int nt = jt + 1;
        float mhat = 0.f, lsum = 0.f; f32x16 o[2];
#pragma unroll
        for (int r = 0; r < 16; ++r) { o[0][r] = 0.f; o[1][r] = 0.f; }
        dma_k(c, kb, ZP, 0); dma_v(c, vb, ZP, 0); if (nt > 1) { dma_k(c, kb + (size_t)64 * ZP, ZP, 1); dma_v(c, vb + (size_t)64 * ZP, ZP, 1); }
        for (int i = 0; i < nt; ++i) {
            if (i + 1 < nt) NSA_WAIT_BAR(2); else NSA_WAIT_BAR(0);
            if (i + 2 < nt) { dma_k(c, kb + (size_t)(i + 2) * 64 * ZP, ZP, (i + 2) % 3); dma_v(c, vb + (size_t)(i + 2) * 64 * ZP, ZP, (i + 2) % 3); }
            online_tile<0>(c, i % 3, qr, 64 * (jt - i) + c.qloc, i >= jt - 2, i == jt, !((mymask >> i) & 1ull), mhat, lsum, o);
        }
        const float lt = lsum + other_half(lsum, c.hi);
        add_scaled(c, oacc, o, (lt > 0.f ? 1.0f / lt : 0.f) * gate1);
        NSA_WAIT_BAR(0);
    }
    {
        const int j0 = jt > 8 ? jt - 8 : 0, nt = jt - j0 + 1;
        const bf16* kb = Zb + (size_t)j0 * 64 * ZP + ZC_KV + 512 + hkv * 64; const bf16* vb = Zb + (size_t)j0 * 64 * ZP + ZC_KV + 640 + hkv * 64;
        float mhat = 0.f, lsum = 0.f; f32x16 o[2];
#pragma unroll
        for (int r = 0; r < 16; ++r) { o[0][r] = 0.f; o[1][r] = 0.f; }
        dma_k(c, kb, ZP, 0); dma_v(c, vb, ZP, 0); if (nt > 1) { dma_k(c, kb + (size_t)64 * ZP, ZP, 1); dma_v(c, vb + (size_t)64 * ZP, ZP, 1); }
        for (int i = 0; i < nt; ++i) {
            if (i + 1 < nt) NSA_WAIT_BAR(2); else NSA_WAIT_BAR(0);
            if (i + 2 < nt) { dma_k(c, kb + (size_t)(i + 2) * 64 * ZP, ZP, (i + 2) % 3); dma_v(c, vb + (size_t)(i + 2) * 64 * ZP, ZP, (i + 2) % 3); }
            const int j = j0 + i;
            online_tile<1>(c, i % 3, qr, 64 * (jt - j) + c.qloc, j >= jt - 2, j == jt || j == jt - 8, false, mhat, lsum, o);
        }
        const float lt = lsum + other_half(lsum, c.hi);
        add_scaled(c, oacc, o, (lt > 0.f ? 1.0f / lt : 0.f) * gate2);
    }
    {
        bf16* yb = YC + ((size_t)b * SEQ + t0 + 32 * c.th + 4 * c.hi) * DM + D_SSM + hkv * 256 + c.g * 64 + c.r32;
#pragma unroll
        for (int r = 0; r < 16; ++r) { bf16* yr = yb + (size_t)((r & 3) + 8 * (r >> 2)) * DM; yr[0] = (bf16)f2bf(oacc[0][r]); yr[32] = (bf16)f2bf(oacc[1][r]); }
    }
    asm volatile("s_waitcnt vmcnt(0)" ::: "memory");
    NSA_WAIT_BAR(0);
}
#undef NSA_SBAR
#undef NSA_WAIT_BAR
}


__device__ __forceinline__ void ssm_precompute(const Frame& F, const __attribute__((address_space(4))) Args* args, unsigned char* ws, int item) {
    const int layer = item >> 5, g = item & 31, lg = layer * 32 + g;
    LAS float* L = (LAS float*)F.lds;
    LAS float* lkr = L; LAS float* lki = L + 17 * 64; LAS float* bbr = L + 2 * 17 * 64; LAS float* bbi = bbr + 1024; LAS float* ccr = bbi + 1024; LAS float* cci = ccr + 1024;
    LAS float* wk = cci + 1024; LAS float* dd = wk + 4096;
    const float* a_re = args->in[6] + lg * 64; const float* a_im = args->in[7] + lg * 64;
    const float dt = expf(args->in[13][lg]);
    for (int i = F.tid; i < 17 * 64; i += NTHR) { const int k = i >> 6, p = i & 63; const float er = expf(a_re[p] * dt * (float)k), ang = a_im[p] * dt * (float)k; lkr[i] = er * cosf(ang); lki[i] = er * sinf(ang); }
    for (int i = F.tid; i < 1024; i += NTHR) {
        { const int p = i >> 4, h = i & 15; const float are = a_re[p], aim = a_im[p];
          const float er = expf(are * dt), lbr = er * cosf(aim * dt), lbi = er * sinf(aim * dt);
          const float xx = lbr - 1.0f, yy = lbi, den = are * are + aim * aim, fr = (xx * are + yy * aim) / den, fi = (yy * are - xx * aim) / den;
          const float br = args->in[8][((size_t)lg * 64 + p) * 16 + h], bi = args->in[9][((size_t)lg * 64 + p) * 16 + h];
          bbr[i] = fr * br - fi * bi; bbi[i] = fr * bi + fi * br; }
        ccr[i] = args->in[10][(size_t)lg * 1024 + i]; cci[i] = args->in[11][(size_t)lg * 1024 + i];
    }
    if (F.tid < 16) dd[F.tid] = args->in[12][lg * 16 + F.tid];
    __syncthreads();
    for (int i = F.tid; i < 4096; i += NTHR) { const int k = i >> 8, ho = (i >> 4) & 15, hi = i & 15; float acc = 0.f;
        for (int p = 0; p < 64; ++p) { const float cr = ccr[ho * 64 + p], ci = cci[ho * 64 + p], lr = lkr[k * 64 + p], li = lki[k * 64 + p];
            const float tr = cr * lr - ci * li, ti = cr * li + ci * lr; acc += tr * bbr[p * 16 + hi] - ti * bbi[p * 16 + hi]; }
        wk[i] = acc + ((k == 0 && ho == hi) ? dd[ho] : 0.f); }
    __syncthreads();
    bf16* B2 = (bf16*)(ws + WS_BT2) + (size_t)lg * 256 * 384;
    for (int i = F.tid; i < 256 * 384; i += NTHR) { const int n = i / 384, kk = i % 384, t = n >> 4, ho = n & 15; float v;
        if (kk < 256) { const int sidx = kk >> 4, hi = kk & 15; v = sidx <= t ? wk[((t - sidx) << 8) + ho * 16 + hi] : 0.f; }
        else { const int j = kk - 256, p = j & 63; const float cr = ccr[ho * 64 + p], ci = cci[ho * 64 + p], lr = lkr[(t + 1) * 64 + p], li = lki[(t + 1) * 64 + p];
            v = j < 64 ? (cr * lr - ci * li) : -(cr * li + ci * lr); }
        B2[i] = (bf16)f2bf(v); }
    bf16* B1 = (bf16*)(ws + WS_BT1) + (size_t)lg * 256 * 256;
    for (int i = F.tid; i < 65536; i += NTHR) { const int j = i >> 8, kk = i & 255, sidx = kk >> 4, hi = kk & 15; float v = 0.f;
        if (j < 128) { const int p = j & 63; const float lr = lkr[(15 - sidx) * 64 + p], li = lki[(15 - sidx) * 64 + p], br = bbr[p * 16 + hi], bi = bbi[p * 16 + hi];
            v = j < 64 ? (lr * br - li * bi) : (lr * bi + li * br); }
        B1[i] = (bf16)f2bf(v); }
    __syncthreads();
}
__device__ __forceinline__ void ssm_carry_item(int b, int g, const float* a_re, const float* a_im, const float* log_dt, const float* XL, bf16* U, int lane) {
    const float dt16 = 16.0f * expf(log_dt[g]);
    const float er = expf(a_re[g * 64 + lane] * dt16), ang = a_im[g * 64 + lane] * dt16, lr = er * cosf(ang), li = er * sinf(ang);
    float xr = 0.f, xi = 0.f;
    const float* __restrict__ xl = XL + ((size_t)g * 2048 + b * 256) * 128 + lane;
    bf16* __restrict__ up = U + ((size_t)g * 2048 + b * 256) * 512 + 256 + lane;
    float ar[16], ai[16], nr_[16], ni_[16];
#pragma unroll
    for (int k = 0; k < 16; ++k) { ar[k] = xl[(size_t)k * 128]; ai[k] = xl[(size_t)k * 128 + 64]; }
    for (int cb = 0; cb < 16; ++cb) {
        const int cn = cb < 15 ? (cb + 1) * 16 : cb * 16;
#pragma unroll
        for (int k = 0; k < 16; ++k) { nr_[k] = xl[(size_t)(cn + k) * 128]; ni_[k] = xl[(size_t)(cn + k) * 128 + 64]; }
#pragma unroll
        for (int k = 0; k < 16; ++k) {
            const int c = cb * 16 + k;
            up[(size_t)c * 512] = (bf16)f2bf(xr); up[(size_t)c * 512 + 64] = (bf16)f2bf(xi);
            const float nr = lr * xr - li * xi + ar[k], ni = lr * xi + li * xr + ai[k];
            xr = nr; xi = ni;
        }
#pragma unroll
        for (int k = 0; k < 16; ++k) { ar[k] = nr_[k]; ai[k] = ni_[k]; }
    }
}


__device__ __forceinline__ void compress_stage2(const Frame& F, int eb, int pm, const bf16* HC, const float* w2, bf16* KCo, bf16* VCo) {
    const int r = F.tid >> 1, f0 = (F.tid & 1) * 32, rg = pm * 256 + r;
    const bf16* hr = HC + ((size_t)eb * 4096 + rg) * 64; const float* w = w2 + eb * 64 * 64 + f0;
    float acc[32];
#pragma unroll
    for (int f = 0; f < 32; ++f) acc[f] = 0.f;
#pragma unroll 2
    for (int e = 0; e < 64; ++e) { const float h = bf2f(hr[e]);
#pragma unroll
        for (int f4 = 0; f4 < 8; ++f4) { const f32x4 wv = *(const f32x4*)(w + e * 64 + f4 * 4); acc[f4 * 4] += h * wv.x; acc[f4 * 4 + 1] += h * wv.y; acc[f4 * 4 + 2] += h * wv.z; acc[f4 * 4 + 3] += h * wv.w; } }
    const bool pad = ((rg >> 1) & 255) == NCMP;
    bf16* dst = (eb ? VCo : KCo) + (size_t)rg * 64 + f0;
#pragma unroll
    for (int f8 = 0; f8 < 4; ++f8) { u32x4 o; o.x = pad ? 0u : pk2(acc[f8 * 8], acc[f8 * 8 + 1]); o.y = pad ? 0u : pk2(acc[f8 * 8 + 2], acc[f8 * 8 + 3]); o.z = pad ? 0u : pk2(acc[f8 * 8 + 4], acc[f8 * 8 + 5]); o.w = pad ? 0u : pk2(acc[f8 * 8 + 6], acc[f8 * 8 + 7]);
        *(u32x4*)(dst + f8 * 8) = o; }
}

__device__ __forceinline__ void transpose_item(const float* W, int K, int N, bf16* WT, int k0, int n0, int drow0, LAS float* scr, int lane, float scale = 1.0f) {
#pragma unroll 8
    for (int i = 0; i < 32; ++i) { const int kk = 2 * i + (lane >> 5); scr[kk * 33 + (lane & 31)] = W[(size_t)(k0 + kk) * N + n0 + (lane & 31)]; }
    asm volatile("s_waitcnt lgkmcnt(0)" ::: "memory");
    const int c = lane & 7;
#pragma unroll
    for (int j = 0; j < 4; ++j) { const int n = (lane >> 3) + 8 * j; const LAS float* sp = scr + (8 * c) * 33 + n;
        u32x4 o; o.x = pk2(sp[0 * 33] * scale, sp[1 * 33] * scale); o.y = pk2(sp[2 * 33] * scale, sp[3 * 33] * scale); o.z = pk2(sp[4 * 33] * scale, sp[5 * 33] * scale); o.w = pk2(sp[6 * 33] * scale, sp[7 * 33] * scale);
        *(u32x4*)(WT + (size_t)(drow0 + n) * K + k0 + 8 * c) = o; }
    asm volatile("s_waitcnt lgkmcnt(0)" ::: "memory");
}
__device__ __forceinline__ void ph_convert(const Frame& F, const __attribute__((address_space(4))) Args* args, unsigned char* ws) {
    for (int it = F.blk; it < DEPTH * NGRP; it += F.G) ssm_precompute(F, args, ws, it);
    LAS float* scr = (LAS float*)(F.lds + F.wave * 16384);
    const int gw = F.blk * NWAVES + F.wave, NGW = F.G * NWAVES;
    constexpr int I_IN = (DM / 64) * (1792 / 32), I_GLU = (D_SSM / 64) * (2 * D_SSM / 32), I_OUT = (DM / 64) * (DM / 32);
    constexpr int PER_LAYER = I_IN + I_GLU + I_OUT;
    for (int it = gw; it < DEPTH * 32 * 384; it += NGW) {
        const int le = it / 384, r = it % 384;
        if (r < 256) { const int isup = r >> 7, q = r & 127, nb = q & 7, kb = q >> 3, n0 = 32 * nb;
            transpose_item(args->in[isup ? 24 : 23] + (size_t)le * DM * 256, DM, 256, (bf16*)(ws + WS_WGU) + (size_t)le * 512 * DM, 64 * kb, n0, 256 * (n0 >> 7) + 128 * isup + (n0 & 127), scr, F.lane); }
        else { const int q = r - 256, nb = q & 31, kb = q >> 5;
            transpose_item(args->in[25] + (size_t)le * 256 * DM, 256, DM, (bf16*)(ws + WS_WDN) + (size_t)le * DM * 256, 64 * kb, 32 * nb, 32 * nb, scr, F.lane); }
    }
    for (int it = gw; it < DEPTH * 2 * 64; it += NGW) { const int li = it >> 6, q = it & 63, nb = q & 1, kb = q >> 1;
        transpose_item(args->in[16] + (size_t)li * 2048 * 64, 2048, 64, (bf16*)(ws + WS_W1T) + (size_t)li * 256 * 2048, 64 * kb, 32 * nb, 32 * nb, scr, F.lane); }
    { const int gt = F.blk * NTHR + F.tid, NGT = F.G * NTHR;
      for (int idx = gt; idx < DEPTH * 2 * 192 * 2048 / 8; idx += NGT) { const int li = idx / (192 * 256), rem = idx % (192 * 256);
          *(u32x4*)((bf16*)(ws + WS_W1T) + (size_t)li * 256 * 2048 + (size_t)64 * 2048 + (size_t)rem * 8) = (u32x4){0u, 0u, 0u, 0u}; }
      for (int idx = gt; idx < DEPTH * 2 * 64; idx += NGT) { const int li = idx >> 6, e = idx & 63; const float* pp = args->in[15] + (size_t)li * 2048; const float* ww = args->in[16] + (size_t)li * 2048 * 64 + e;
          float a = 0.f; for (int k = 0; k < 2048; ++k) a += pp[k] * ww[(size_t)k * 64];
          ((float*)(ws + WS_CBIAS))[idx] = a; } }
    for (int it = gw; it < DEPTH * PER_LAYER; it += NGW) {
        const int layer = it / PER_LAYER; int r = it % PER_LAYER;
        if (r < I_IN) { const int nb = r % 56, kb = r / 56;
            transpose_item(args->in[4] + (size_t)layer * DM * D_IN, DM, D_IN, (bf16*)(ws + WS_WIN) + (size_t)layer * ZP * DM, 64 * kb, 32 * nb, 32 * nb, scr, F.lane, (nb >= 16 && nb < 32) ? QSCALE : 1.0f); continue; }
        r -= I_IN;
        if (r < I_GLU) { const int nb = r % 32, kb = r / 32, n0 = 32 * nb;
            const int half = n0 >> 9, c = n0 & 511, drow = 256 * (c >> 7) + 128 * half + (c & 127);
            transpose_item(args->in[14] + (size_t)layer * D_SSM * 2 * D_SSM, D_SSM, 2 * D_SSM, (bf16*)(ws + WS_WGLU) + (size_t)layer * 2 * D_SSM * D_SSM, 64 * kb, n0, drow, scr, F.lane); continue; }
        r -= I_GLU;
        { const int nb = r % 32, kb = r / 32;
            transpose_item(args->in[5] + (size_t)layer * DM * DM, DM, DM, (bf16*)(ws + WS_WOUT) + (size_t)layer * DM * DM, 64 * kb, 32 * nb, 32 * nb, scr, F.lane); }
    }
    const int gt = F.blk * NTHR + F.tid, NGT = F.G * NTHR;
    for (int idx = gt; idx < DEPTH * 256 * DM; idx += NGT) {
        const int layer = idx / (256 * DM), rem = idx % (256 * DM), n = 1792 + rem / DM, k = rem % DM;
        const float v = n < D_IN ? args->in[4][(size_t)layer * DM * D_IN + (size_t)k * D_IN + n] : 0.f;
        ((bf16*)(ws + WS_WIN))[(size_t)layer * ZP * DM + (size_t)n * DM + k] = (bf16)f2bf(v);
    }
}

constexpr int PH_PER_LAYER = 10, N_PHASES = 1 + DEPTH * PH_PER_LAYER + 1;
#ifndef FAST_GEMM
#define FAST_GEMM 1
#endif
#ifndef REP_ATTN
#define REP_ATTN 1
#endif
#ifndef REP_CMP
#define REP_CMP 1
#endif
#ifndef REP_CARRY
#define REP_CARRY 1
#endif
#ifndef REP_CONV
#define REP_CONV 1
#endif

__global__ void __launch_bounds__(NTHR, 2) fwd(Args args) {
    extern __shared__ __attribute__((aligned(16))) unsigned char lds_raw[];
    Frame F;
    F.lds = (LAS unsigned char*)lds_raw;
    F.tid = threadIdx.x; F.lane = F.tid & 63; F.wave = __builtin_amdgcn_readfirstlane(F.tid >> 6);
    F.blk = blockIdx.x; F.G = gridDim.x;
    typedef const __attribute__((address_space(4))) Args* KArgs;
    KArgs kp = (KArgs)__builtin_amdgcn_kernarg_segment_ptr();
    asm volatile("" : "+s"(kp));
    unsigned char* ws = kp->ws;
    volatile LAS unsigned* MISC = (volatile LAS unsigned*)(F.lds + MISC_OFF);
    if (F.tid < 32) MISC[F.tid] = 0u;
    __syncthreads();
    XcdBarrier bar; bar.bar = (unsigned*)(ws + WS_CTL) + CW_BAR; bar.x = 0; bar.st = nullptr;
    if (N_LAUNCH_MODE == 1) bar = xcd_barrier_post((unsigned*)(ws + WS_CTL) + CW_BAR, MISC + 8);
#define IN(k) (kp->ph_lo <= (k) && (k) < kp->ph_hi)
#define FRESH_IDS() do { int l_; asm volatile("v_mbcnt_lo_u32_b32 %0, -1, 0\n\tv_mbcnt_hi_u32_b32 %0, -1, %0" : "=v"(l_)); asm volatile("" : "+s"(F.wave), "+s"(F.blk), "+s"(F.G)); F.lane = l_; F.tid = F.wave * 64 + l_; asm volatile("" : "+s"(kp)); ws = kp->ws; bar.bar = (unsigned*)(ws + WS_CTL) + CW_BAR; } while (0)
#define SEAM(k) do { FRESH_IDS(); if (IN(k) && IN((k) + 1)) xcd_barrier(bar, F.tid); FRESH_IDS(); } while (0)

    const float* x0 = kp->in[0];
    float* XR = kp->out;
#define HN ((bf16*)(ws + WS_HN))
#define Z ((bf16*)(ws + WS_Z))
#define YC ((bf16*)(ws + WS_YC))
#define G1 ((bf16*)(ws + WS_G1))
#define KC ((bf16*)(ws + WS_KC))
#define VC ((bf16*)(ws + WS_VC))
#define LIST ((unsigned*)(ws + WS_LIST))
#define LISTW ((float*)(ws + WS_LISTW))
#define HID ((bf16*)(ws + WS_HID))
#define P2 ((float*)(ws + WS_P2))
#define USSM ((bf16*)(ws + WS_USSM))
#define XL ((float*)(ws + WS_XL))
    LAS int* etab = (LAS int*)(F.lds + 131072);

    if (IN(0)) for (int rep_ = 0; rep_ < REP_CONV; ++rep_) ph_convert(F, kp, ws);
    SEAM(0);
    for (int layer = 0; layer < DEPTH; ++layer) {
        const int pb = 1 + layer * PH_PER_LAYER;
        const float* xin = layer == 0 ? x0 : XR;
        unsigned* gcnt = (unsigned*)(ws + WS_CTL) + CW_CNT + layer * 32 * 64;
        if (IN(pb + 0)) ph_norm(F, xin, layer == 0 ? nullptr : P2, XR, kp->in[1] + layer * DM, HN);
        SEAM(pb + 0);
        if (IN(pb + 1)) {
            pg8::Gemm g{HN, (const bf16*)(ws + WS_WIN) + (size_t)layer * ZP * DM, T, ZP, DM, DM, 0, nullptr, 0, 0, 128}; pg8::StaticOrder S; S.init(T, ZP, F.G, F.blk);
            pg8::EpiInProj E{Z, USSM};
            pg8::gemm2<pg8::EpiInProj, pg8::StaticOrder, pg8::ADense>(F.lds, g, S, E, F.tid);
        }
        SEAM(pb + 1);
        if (IN(pb + 2)) {
            { pg8::Gemm g{USSM, (const bf16*)(ws + WS_BT1) + (size_t)layer * 32 * 256 * 256, 0, 256, 256, 512, (size_t)256 * 256, nullptr, 0, (size_t)2048 * 512, 128};
              pg8::BatchOrder S{NGRP, 8, 1, F.G, F.blk}; pg8::EpiXloc E{XL};
              pg8::gemm2<pg8::EpiXloc, pg8::BatchOrder, pg8::ADense>(F.lds, g, S, E, F.tid); }
            for (int rep_ = 0; rep_ < REP_CMP; ++rep_) {
                { pg8::Gemm g{Z, (const bf16*)(ws + WS_W1T) + (size_t)layer * 2 * 256 * 2048, 0, 256, 2048, ZP, (size_t)256 * 2048, nullptr, 0, 0, ZP * 2};
                  pg8::CmpOrder S{F.G, F.blk}; pg8::EpiCmpHid E{(bf16*)(ws + WS_HIDC), (const float*)(ws + WS_CBIAS) + layer * 128};
                  pg8::gemm2<pg8::EpiCmpHid, pg8::CmpOrder, pg8::ACompress>(F.lds, g, S, E, F.tid); }
                asm volatile("s_waitcnt vmcnt(0)" ::: "memory"); __syncthreads();
                for (int L = F.blk; L < 32; L += F.G) compress_stage2(F, L >> 4, L & 15, (const bf16*)(ws + WS_HIDC), kp->in[17] + (size_t)layer * 2 * 64 * 64, KC, VC);
            }
        }
        SEAM(pb + 2);
        if (IN(pb + 3)) {
            for (int rep_ = 0; rep_ < REP_CARRY; ++rep_)
            if (F.wave == 0) for (int it = F.blk; it < BATCH * NGRP; it += F.G)
                ssm_carry_item(it / NGRP, it % NGRP, kp->in[6] + layer * NGRP * SST, kp->in[7] + layer * NGRP * SST, kp->in[13] + layer * NGRP, XL, USSM, F.lane);
        }
        SEAM(pb + 3);
        if (IN(pb + 4)) {
            pg8::Gemm g{USSM, (const bf16*)(ws + WS_BT2) + (size_t)layer * 32 * 256 * 384, 0, 256, 384, 512, (size_t)256 * 384, nullptr, 0, (size_t)2048 * 512, 128};
            pg8::BatchOrder S{NGRP, 8, 1, F.G, F.blk}; pg8::EpiSsmOut E{G1};
            pg8::gemm2<pg8::EpiSsmOut, pg8::BatchOrder, pg8::ADense>(F.lds, g, S, E, F.tid);
        }
        SEAM(pb + 4);
        if (IN(pb + 5)) {
            { pg8::Gemm g{G1, (const bf16*)(ws + WS_WGLU) + (size_t)layer * 2 * D_SSM * D_SSM, T, 2 * D_SSM, D_SSM, D_SSM, 0, nullptr, 0, 0, 128}; pg8::StaticOrder S; S.init(T, 2 * D_SSM, F.G, F.blk);
              pg8::EpiGlu E{YC, DM};
              pg8::gemm2<pg8::EpiGlu, pg8::StaticOrder, pg8::ADense>(F.lds, g, S, E, F.tid); }
            __syncthreads();
            for (int rep_ = 0; rep_ < REP_ATTN; ++rep_)
            for (int slot = F.blk; slot < 256; slot += F.G) {
                const int bh = slot >> 4, sq = slot & 15;
#pragma unroll 1
                for (int uq = 0; uq < 4; ++uq) { const int jt = uq == 0 ? 63 - sq : (uq == 1 ? 32 + sq : (uq == 2 ? 31 - sq : sq));
                    nsa::unit((LAS char*)F.lds, F.tid, bh >> 1, bh & 1, jt, Z, KC, VC, kp->in[18], YC); }
            }
        }
        SEAM(pb + 5);
        if (IN(pb + 6)) {
            pg8::Gemm g{YC, (const bf16*)(ws + WS_WOUT) + (size_t)layer * DM * DM, T, DM, DM, DM, 0, nullptr, 0, 0, 128}; pg8::StaticOrder S; S.init(T, DM, F.G, F.blk);
            pg8::EpiResid E{xin, XR, DM};
            pg8::gemm2<pg8::EpiResid, pg8::StaticOrder, pg8::ADense>(F.lds, g, S, E, F.tid);
        }
        SEAM(pb + 6);
        if (IN(pb + 7)) ph_norm_route(F, XR, kp->in[2] + layer * DM, kp->in[19] + (size_t)layer * DM * 4, kp->in[20] + layer * 4, kp->in[21] + (size_t)layer * 4 * DM * 8, kp->in[22] + layer * 32, HN, gcnt, LIST, LISTW);
        SEAM(pb + 7);
        if (IN(pb + 8)) {
            build_expert_tab(F, gcnt, etab);
            pg8::Gemm g{HN, (const bf16*)(ws + WS_WGU) + (size_t)layer * 32 * 512 * DM, 0, 512, DM, DM, (size_t)512 * DM, LIST, LCAP, 0, 128};
            pg8::ExpertOrder S{etab, 2, F.G, F.blk};
            pg8::EpiGateUp E{HID, LISTW, LCAP};
            pg8::gemm2<pg8::EpiGateUp, pg8::ExpertOrder, pg8::AList>(F.lds, g, S, E, F.tid);
        }
        SEAM(pb + 8);
        if (IN(pb + 9)) {
            build_expert_tab(F, gcnt, etab);
            pg8::Gemm g{HID, (const bf16*)(ws + WS_WDN) + (size_t)layer * 32 * DM * 256, 0, DM, 256, 256, (size_t)DM * 256, nullptr, 0, 0, 128};
            pg8::ExpertOrder S{etab, 4, F.G, F.blk};
            pg8::EpiDown E{XR, P2, LIST, LCAP};
            pg8::gemm2<pg8::EpiDown, pg8::ExpertOrder, pg8::ADense>(F.lds, g, S, E, F.tid);
        }
        SEAM(pb + 9);
    }
    if (IN(N_PHASES - 1)) ph_final_norm(F, XR, P2, kp->in[3]);
#undef IN
#undef SEAM
#undef HN
#undef Z
#undef YC
#undef G1
#undef KC
#undef VC
#undef LIST
#undef LISTW
#undef HID
#undef P2
#undef USSM
#undef XL
}

extern "C" void kernel_launch(void* const* d_in, const int* in_sizes, int n_in, void* d_out, int out_size, void* d_ws, size_t ws_size, hipStream_t stream) {
    static int grid = 0;
    if (grid == 0) {
        if (n_in != 26 || out_size != T * DM || ws_size < WS_END) { fprintf(stderr, "kernel_launch: unexpected shapes (n_in %d out %d ws %zu)\n", n_in, out_size, ws_size); grid = -1; return; }
        int dev = 0, cus = 0, per_cu = 0;
        if (hipGetDevice(&dev) != hipSuccess || hipDeviceGetAttribute(&cus, hipDeviceAttributeMultiprocessorCount, dev) != hipSuccess) { grid = -1; return; }
        if (hipFuncSetAttribute((const void*)fwd, hipFuncAttributeMaxDynamicSharedMemorySize, LDS_BYTES) != hipSuccess) { fprintf(stderr, "kernel_launch: hipFuncSetAttribute failed\n"); grid = -1; return; }
        if (hipOccupancyMaxActiveBlocksPerMultiprocessor(&per_cu, (const void*)fwd, NTHR, LDS_BYTES) != hipSuccess || per_cu < 1) fprintf(stderr, "kernel_launch: occupancy query says %d\n", per_cu);
        (void)hipGetLastError();
        grid = cus;
    }
    if (grid < 0) return;
    (void)hipMemsetAsync((char*)d_ws + WS_CTL, 0, CTL_ZERO_BYTES, stream);
    Args a{};
    for (int i = 0; i < 26; ++i) a.in[i] = (const float*)d_in[i];
    a.out = (float*)d_out; a.ws = (unsigned char*)d_ws;
    if (N_LAUNCH_MODE == 1) {
        a.ph_lo = 0; a.ph_hi = N_PHASES;
        hipLaunchKernelGGL(fwd, dim3(grid), dim3(NTHR), LDS_BYTES, stream, a);
    } else {
        for (int p = 0; p < N_PHASES; ++p) { a.ph_lo = p; a.ph_hi = p + 1; hipLaunchKernelGGL(fwd, dim3(grid), dim3(NTHR), LDS_BYTES, stream, a); }
    }
}
```

```cpp
#include <hip/hip_runtime.h>
#include <cstdio>
#include <cstdint>

#ifndef N_LAUNCH_MODE
#define N_LAUNCH_MODE 1
#endif

#define GAS __attribute__((address_space(1)))
#define LAS __attribute__((address_space(3)))
typedef unsigned short bf16;
typedef float f32x4 __attribute__((ext_vector_type(4)));
typedef unsigned u32x4 __attribute__((ext_vector_type(4)));
typedef unsigned u32x2 __attribute__((ext_vector_type(2)));

constexpr int BATCH = 8, SEQ = 4096, DM = 1024, T = BATCH * SEQ, DEPTH = 2;
constexpr int D_SSM = 512, NGRP = 32, SGRP = 16, SST = 64;
constexpr int D_IN = 1816, ZP = 2048;
constexpr int ZC_U = 0, ZC_Q = 512, ZC_KV = 1024, ZC_G = 1792;
constexpr int NCMP = 255, NCMPP = 256;
constexpr float EPS = 1e-6f;
constexpr int NWAVES = 8, NTHR = 512;
constexpr float QSCALE = 0.125f * 1.4426950408889634f;

constexpr size_t MiB = 1u << 20;
constexpr size_t WS_CTL = 0, CTL_ZERO_BYTES = 1 * MiB;
constexpr size_t WS_KC = 1 * MiB, WS_VC = 2 * MiB, WS_ROUTE = 3 * MiB;
constexpr size_t WS_HN = 16 * MiB;
constexpr size_t WS_Z = 80 * MiB;
constexpr size_t WS_YC = 208 * MiB;
constexpr size_t WS_G1 = 272 * MiB;
constexpr size_t WS_WIN = 304 * MiB;
constexpr size_t WS_WGLU = 312 * MiB;
constexpr size_t WS_WOUT = 314 * MiB;
constexpr size_t WS_WGU = 318 * MiB;
constexpr size_t WS_WDN = 382 * MiB;
constexpr size_t WS_LIST = 414 * MiB;
constexpr size_t WS_LISTW = 418 * MiB;
constexpr size_t WS_HID = 422 * MiB;
constexpr size_t WS_P2 = WS_Z;
constexpr size_t WS_USSM = WS_YC;
constexpr size_t WS_XL = WS_HID;
constexpr size_t WS_BT1 = 458 * MiB;
constexpr size_t WS_BT2 = 466 * MiB;
constexpr size_t WS_W1T = 478 * MiB;
constexpr size_t WS_HIDC = 4 * MiB;
constexpr size_t WS_CBIAS = 5 * MiB;
constexpr size_t WS_END = 482 * MiB;
constexpr int LCAP = 32768, CW_CNT = 8192;
constexpr int CW_BAR = 4096;

constexpr int LDS_BYTES = 163840;
constexpr int ETAB_OFF = LDS_BYTES - 1024, MISC_OFF = LDS_BYTES - 512;

__device__ __forceinline__ float bf2f(bf16 v) { return __uint_as_float(((unsigned)v) << 16); }
__device__ __forceinline__ unsigned f2bf(float f) { unsigned u = __float_as_uint(f); return (u + 0x7fffu + ((u >> 16) & 1u)) >> 16; }
__device__ __forceinline__ unsigned pk2(float lo, float hi) { return f2bf(lo) | (f2bf(hi) << 16); }
__device__ __forceinline__ float wave_sum(float v, int lane) {
#pragma unroll
    for (int o = 1; o < 64; o <<= 1) v += __int_as_float(__builtin_amdgcn_ds_bpermute((lane ^ o) << 2, __float_as_int(v)));
    return v;
}
__device__ __forceinline__ float wave_max(float v, int lane) {
#pragma unroll
    for (int o = 1; o < 64; o <<= 1) v = fmaxf(v, __int_as_float(__builtin_amdgcn_ds_bpermute((lane ^ o) << 2, __float_as_int(v))));
    return v;
}
__device__ __forceinline__ float lane_bcast(float v, int src) { return __int_as_float(__builtin_amdgcn_ds_bpermute(src << 2, __float_as_int(v))); }
__device__ __forceinline__ float gelu_tanh(float x) {
    const float u = 0.7978845608028654f * (x + 0.044715f * x * x * x);
    return 0.5f * x * (1.0f + tanhf(u));
}
__device__ __forceinline__ float sigmoidf_(float x) { return 1.0f / (1.0f + __expf(-x)); }
__device__ __forceinline__ int t5_bucket(int n) {
    if (n < 16) return n < 0 ? 0 : n;
    int b = 16;
    b += (n >= 19); b += (n >= 21); b += (n >= 24); b += (n >= 27); b += (n >= 31); b += (n >= 35); b += (n >= 40); b += (n >= 46);
    b += (n >= 52); b += (n >= 59); b += (n >= 67); b += (n >= 77); b += (n >= 87); b += (n >= 99); b += (n >= 113);
    return b;
}

#define XB_TMO      128
#define XB_XCNT(j)  (256  + 64 * (j))
#define XB_XSUB(j)  (1280 + 64 * (j))
#define XB_XGEN(j)  (2304 + 64 * (j))
#define XB_TOP      3328
#define XB_TOPGEN   3392
#define XCD_BAR_WORDS 3456
#define XB_SPIN_CAP (1u << 22)

__device__ __forceinline__ unsigned xb_ld(unsigned* p)              { return __hip_atomic_load(p, __ATOMIC_RELAXED, __HIP_MEMORY_SCOPE_AGENT); }
__device__ __forceinline__ unsigned xb_add(unsigned* p, unsigned v) { return __hip_atomic_fetch_add(p, v, __ATOMIC_RELAXED, __HIP_MEMORY_SCOPE_AGENT); }
__device__ __forceinline__ unsigned xb_xcc_id() { return (unsigned)__builtin_amdgcn_s_getreg((3 << 11) | 20) & 0xFu; }
#define XB_SPIN(cond, bar) do { unsigned _sp = 0; while (cond) { __builtin_amdgcn_s_sleep(1); \
    if ((++_sp & 255u) == 0u) { if (xb_ld(&(bar)[XB_TMO])) break; if (_sp > XB_SPIN_CAP) { atomicAdd(&(bar)[XB_TMO], 1u); break; } } } } while (0)

struct XcdBarrier { unsigned* bar; unsigned x; volatile LAS unsigned* st; };

__device__ __forceinline__ XcdBarrier xcd_barrier_post(unsigned* bar, volatile LAS unsigned* st) {
    XcdBarrier b; b.bar = bar; b.x = xb_xcc_id(); b.st = st;
    if (threadIdx.x == 0) (void)xb_add(&bar[XB_XCNT(b.x)], 1u);
    return b;
}
__device__ __forceinline__ void xcd_barrier_complete(unsigned* bar, unsigned x, unsigned& nloc, unsigned& nx) {
    const unsigned G = gridDim.x * gridDim.y * gridDim.z;
    unsigned sum, cnt, mine, sp = 0u;
    for (;;) {
        sum = 0u; cnt = 0u; mine = 0u;
#pragma unroll
        for (unsigned j = 0; j < 16; ++j) { const unsigned c = xb_ld(&bar[XB_XCNT(j)]); sum += c; cnt += (c > 0u) ? 1u : 0u; mine = (j == x) ? c : mine; }
        if (sum == G) break;
        __builtin_amdgcn_s_sleep(1);
        if ((++sp & 255u) == 0u) { if (xb_ld(&bar[XB_TMO])) break; if (sp > XB_SPIN_CAP) { atomicAdd(&bar[XB_TMO], 1u); break; } }
    }
    nloc = mine > 0u ? mine : 1u; nx = cnt > 0u ? cnt : 1u;
}
__device__ __forceinline__ void xcd_barrier(const XcdBarrier& b, const int tid) {
    asm volatile("s_waitcnt vmcnt(0)" ::: "memory");
    __syncthreads();
    if (tid == 0) {
        unsigned* bar = b.bar;
        __builtin_amdgcn_s_waitcnt(0);
        unsigned nloc = b.st[0], nx = b.st[1];
        if (nloc == 0u) { xcd_barrier_complete(bar, b.x, nloc, nx); b.st[0] = nloc; b.st[1] = nx; }
        const unsigned old = xb_add(&bar[XB_XSUB(b.x)], 1u);
        const unsigned gen = old / nloc;
        if (old + 1u == (gen + 1u) * nloc) {
            __builtin_amdgcn_fence(__ATOMIC_RELEASE, "agent");
            asm volatile("s_waitcnt vmcnt(0)" ::: "memory");
            const unsigned og = xb_add(&bar[XB_TOP], 1u);
            const unsigned tg = og / nx;
            if (og + 1u == (tg + 1u) * nx) xb_add(&bar[XB_TOPGEN], 1u);
            else XB_SPIN(xb_ld(&bar[XB_TOPGEN]) == tg, bar);
            __builtin_amdgcn_fence(__ATOMIC_ACQUIRE, "agent");
            xb_add(&bar[XB_XGEN(b.x)], 1u);
            asm volatile("s_waitcnt vmcnt(0)" ::: "memory");
        } else {
            XB_SPIN(xb_ld(&bar[XB_XGEN(b.x)]) == gen, bar);
            __builtin_amdgcn_fence(__ATOMIC_ACQUIRE, "agent");
            asm volatile("s_waitcnt vmcnt(0)" ::: "memory");
        }
    }
    __syncthreads();
}

namespace pg8 {
#define PG8_LAS __attribute__((address_space(3)))
typedef unsigned short bf16_t;
typedef short bf16x8 __attribute__((ext_vector_type(8)));
typedef float f32x4 __attribute__((ext_vector_type(4)));
typedef unsigned u32x4 __attribute__((ext_vector_type(4)));
constexpr int BM = 256, BK = 64, HALF = 128, HTB = HALF * BK * 2  , STAGE_BYTES = 8 * HTB, NXCD = 8, WGM = 8;

__host__ __device__ __forceinline__ int lds_byte(int r, int c) { const int st = (r >> 4) * 2 + (c >> 5), rr = r & 15, cc = c & 31, ob = rr * 64 + cc * 2; return st * 1024 + (ob ^ (((ob >> 9) & 1) << 5)); }
__host__ __device__ __forceinline__ void stage_rc(int b, int& R, int& C) { const int st = b / 1024, sb = b % 1024, swz = sb ^ (((sb >> 9) & 1) << 5); R = (st >> 1) * 16 + swz / 64; C = (st & 1) * 32 + (swz % 64) / 2; }
__host__ __device__ __forceinline__ int perm32(int rho) { const int n = rho >> 4, i = rho & 15; return 8 * (i >> 2) + 4 * n + (i & 3); }

struct Unit { int pm, pn, eb, p0, cnt; };
struct Gemm { const bf16_t* A; const bf16_t* Bt; int M, N, K; int lda; size_t bstride; const unsigned* list; int cap; size_t astride; int kstepA; };

struct StaticOrder {
    int nM, nN, nwg, G, c;
    __host__ __device__ void init(int M, int N, int G_, int c_) { nM = M / BM; nN = N / BM; nwg = nM * nN; G = G_; c = c_; }
    __host__ __device__ bool next(int i, Unit& u) const {
        const long L = (long)i * G + c; if (L >= nwg) return false;
        int wgid = (int)L; { const int q = nwg / NXCD, r = nwg % NXCD, xcd = wgid % NXCD, off = wgid / NXCD; wgid = (xcd < r ? xcd * (q + 1) : r * (q + 1) + (xcd - r) * q) + off; }
        const int nig = WGM * nN, gid = wgid / nig, fm = gid * WGM, gsz = (nM - fm) < WGM ? (nM - fm) : WGM;
        u.pm = fm + ((wgid % nig) % gsz); u.pn = (wgid % nig) / gsz; u.eb = 0; u.p0 = 0; u.cnt = 0; return true;
    }
    __device__ __forceinline__ void a_ready(const Unit&) const {}
    __device__ __forceinline__ void done(const Unit&) const {}
};

__device__ __forceinline__ unsigned cvt_pk_bf16(float lo, float hi) { unsigned r; asm volatile("v_cvt_pk_bf16_f32 %0, %1, %2" : "=v"(r) : "v"(lo), "v"(hi)); return r; }
typedef float f32x2 __attribute__((ext_vector_type(2)));
__device__ __forceinline__ f32x2 gelu_pk(f32x2 v) {
    const f32x2 av = __builtin_elementwise_abs(v), d = av * 0.2316418882f + 1.0f;
    f32x2 t; t.x = __builtin_amdgcn_rcpf(d.x); t.y = __builtin_amdgcn_rcpf(d.y);
    f32x2 q = t * 0.5307027145f + (-0.7265760135f); q = q * t + 0.7107068705f; q = q * t + (-0.142248368f); q = q * t + 0.127414796f; q = q * t;
    const f32x2 s = (v * v) * (-0.72134752044f);
    f32x2 e; e.x = __builtin_amdgcn_exp2f(s.x); e.y = __builtin_amdgcn_exp2f(s.y);
    const f32x2 m = v * (q * e), r = v - m;
    f32x2 o; o.x = v.x < 0.f ? m.x : r.x; o.y = v.y < 0.f ? m.y : r.y; return o;
}

template <int ACT  > struct EpiBf16 {
    static constexpr bool PERM = true, AFTER_DRAIN = false; static_assert(ACT == 0 || ACT == 1, "EpiBf16: ACT is 0 (none) or 1 (gelu_pk)");
    bf16_t* O; int ldc; const float* bias; int split_cols; size_t split_stride; float scale0;
    __device__ __forceinline__ void operator()(const f32x4 (&acc)[2][2][4][2], const Unit& u, int wr, int wc, int fr, int fq) const {
        const int row0 = u.pm * BM + wr * 64 + fr; int colt = u.pn * BM; bf16_t* base = O;
        float sc = 1.f; if (split_cols) { const int t = colt / split_cols; base += (size_t)t * split_stride; colt -= t * split_cols; if (t == 0) sc = scale0; }
        const int col0 = colt + wc * 32 + 8 * fq, bcol0 = u.pn * BM + wc * 32 + 8 * fq;
        f32x4 bv[2][2];
#pragma unroll
        for (int bj = 0; bj < 2; ++bj)
#pragma unroll
            for (int n = 0; n < 2; ++n) bv[bj][n] = bias ? *(const f32x4*)(bias + bcol0 + bj * HALF + 4 * n) : (f32x4){0.f, 0.f, 0.f, 0.f};
#pragma unroll
        for (int ai = 0; ai < 2; ++ai)
#pragma unroll
            for (int m = 0; m < 4; ++m) { bf16_t* rowp = base + (size_t)(row0 + ai * HALF + m * 16) * ldc + col0;
#pragma unroll
                for (int bj = 0; bj < 2; ++bj) { f32x4 v0 = acc[ai][bj][m][0] + bv[bj][0], v1 = acc[ai][bj][m][1] + bv[bj][1];
                    if (ACT == 1) { f32x2 a = gelu_pk((f32x2){v0[0], v0[1]}), b = gelu_pk((f32x2){v0[2], v0[3]}), c = gelu_pk((f32x2){v1[0], v1[1]}), d = gelu_pk((f32x2){v1[2], v1[3]});
                        v0 = (f32x4){a.x, a.y, b.x, b.y}; v1 = (f32x4){c.x, c.y, d.x, d.y}; }
                    v0 = v0 * sc; v1 = v1 * sc; u32x4 w; w.x = cvt_pk_bf16(v0[0], v0[1]); w.y = cvt_pk_bf16(v0[2], v0[3]); w.z = cvt_pk_bf16(v1[0], v1[1]); w.w = cvt_pk_bf16(v1[2], v1[3]);
                    *(u32x4*)(rowp + bj * HALF) = w; } }
    }
};
template <class Epi, class Sched, bool ALIGN_EPI = false, bool SP2 = false>
__device__ __forceinline__ void gemm_phase(PG8_LAS unsigned char* lds, const Gemm g, const Sched& S, const Epi& E) {
    int tid_ = threadIdx.x; asm volatile("" : "+v"(tid_));
    const int tid = tid_, wid = __builtin_amdgcn_readfirstlane(tid >> 6), lane = tid & 63, wr = wid >> 2, wc = wid & 3, fr = lane & 15, fq = lane >> 4;
    const int K = g.K, nt = K / BK;
    unsigned voffA[2], voffB[2];
#pragma unroll
    for (int i = 0; i < 2; ++i) { int R, C; stage_rc(tid * 16 + i * 8192, R, C); const int Rb = Epi::PERM ? ((R & ~31) + perm32(R & 31)) : R;
        voffA[i] = (unsigned)(R * K + C) * 2u; voffB[i] = (unsigned)(Rb * K + C) * 2u; }
    const size_t kstep = (size_t)(BK * 2);
    const size_t hstep = (size_t)HALF * K * 2;
    const size_t tstep = 2 * hstep;
    const unsigned ldsw = (unsigned)wid * 1024u;
    const int aoff = lds_byte(wr * 64 + fr, fq * 8), boff = lds_byte(wc * 32 + fr, fq * 8);
#define PG8_SA(b, h) (((b) * 2 + (h)) * HTB)
#define PG8_SB(b, h) ((4 + (b) * 2 + (h)) * HTB)
#define PG8_STAGE(bufoff, gbase, voff) do { _Pragma("unroll") for (int _i = 0; _i < 2; ++_i) \
        __builtin_amdgcn_global_load_lds((const unsigned*)((const char*)(gbase) + (voff)[_i]), (PG8_LAS unsigned*)(lds + (bufoff) + ldsw + _i * 8192), 16, 0, 0); } while (0)
#define PG8_LDA(dst, b, h) do { _Pragma("unroll") for (int m = 0; m < 4; ++m) _Pragma("unroll") for (int k = 0; k < 2; ++k) dst[m][k] = *(const PG8_LAS bf16x8*)(lds + PG8_SA(b, h) + aoff + m * 2048 + k * 1024); } while (0)
#define PG8_LDB(dst, b, h) do { _Pragma("unroll") for (int n = 0; n < 2; ++n) _Pragma("unroll") for (int k = 0; k < 2; ++k) dst[n][k] = *(const PG8_LAS bf16x8*)(lds + PG8_SB(b, h) + boff + n * 2048 + k * 1024); } while (0)
#define PG8_MMA(ai, bj, At, Bt) do { __builtin_amdgcn_s_setprio(1); _Pragma("unroll") for (int m = 0; m < 4; ++m) _Pragma("unroll") for (int n = 0; n < 2; ++n) _Pragma("unroll") for (int k = 0; k < 2; ++k) \
        acc[ai][bj][m][n] = __builtin_amdgcn_mfma_f32_16x16x32_bf16(Bt[n][k], At[m][k], acc[ai][bj][m][n], 0, 0, 0); __builtin_amdgcn_s_setprio(0); } while (0)
#define PG8_WAIT_V(n) asm volatile("s_waitcnt vmcnt(" #n ")" ::: "memory")
#define PG8_WAIT_L(n) asm volatile("s_waitcnt lgkmcnt(" #n ")" ::: "memory")
#define PG8_BAR __builtin_amdgcn_s_barrier()
#define PG8_SCHED __builtin_amdgcn_sched_barrier(0)
    Unit cur, nxt; int ui = 0;
    if (!S.next(0, cur)) return;
    f32x4 acc[2][2][4][2];
#pragma unroll
    for (int a = 0; a < 2; ++a)
#pragma unroll
        for (int b = 0; b < 2; ++b)
#pragma unroll
            for (int m = 0; m < 4; ++m)
#pragma unroll
                for (int n = 0; n < 2; ++n) acc[a][b][m][n] = (f32x4){0.f, 0.f, 0.f, 0.f};
    bf16x8 At[4][2], B0[2][2], B1[2][2];
    const char* cA = (const char*)g.A + (size_t)cur.pm * tstep; const char* cB = (const char*)g.Bt + (size_t)cur.pn * tstep;
    S.a_ready(cur);
    if constexpr (SP2) {
        PG8_STAGE(PG8_SB(0, 0), cB, voffB); PG8_STAGE(PG8_SB(0, 1), cB + hstep, voffB); PG8_STAGE(PG8_SA(0, 0), cA, voffA); PG8_STAGE(PG8_SA(0, 1), cA + hstep, voffA);
        if (wr == 1) PG8_BAR;
        PG8_WAIT_V(2); PG8_BAR;
        PG8_STAGE(PG8_SB(1, 0), cB + kstep, voffB); PG8_STAGE(PG8_SA(1, 0), cA + kstep, voffA); PG8_STAGE(PG8_SB(1, 1), cB + hstep + kstep, voffB);
        PG8_WAIT_V(6); PG8_BAR;
    } else {
        PG8_STAGE(PG8_SB(0, 0), cB, voffB); PG8_STAGE(PG8_SA(0, 0), cA, voffA); PG8_STAGE(PG8_SB(0, 1), cB + hstep, voffB); PG8_STAGE(PG8_SA(0, 1), cA + hstep, voffA);
        if (wr == 1) PG8_BAR;
        PG8_WAIT_V(4); PG8_BAR;
        PG8_STAGE(PG8_SB(1, 0), cB + kstep, voffB); PG8_STAGE(PG8_SA(1, 0), cA + kstep, voffA); PG8_STAGE(PG8_SB(1, 1), cB + hstep + kstep, voffB);
        PG8_WAIT_V(6); PG8_BAR;
    }
    for (;;) {
        const bool has_next = S.next(ui + 1, nxt);
        const char* nA = has_next ? (const char*)g.A + (size_t)nxt.pm * tstep : cA; const char* nB = has_next ? (const char*)g.Bt + (size_t)nxt.pn * tstep : cB;
        for (int t = 0; t < nt; t += 2) {
            const bool last = (t == nt - 2);
            const char* a1 = cA + (size_t)(t + 1) * kstep;
            const char* a2 = last ? nA : cA + (size_t)(t + 2) * kstep; const char* b2 = last ? nB : cB + (size_t)(t + 2) * kstep;
            const char* a3 = a2 + kstep; const char* b3 = b2 + kstep;
            if (last && has_next) S.a_ready(nxt);
            if constexpr (SP2) {
            PG8_LDB(B0, 0, 0); PG8_LDB(B1, 0, 1); PG8_SCHED; PG8_LDA(At, 0, 0); PG8_STAGE(PG8_SA(1, 1), a1 + hstep, voffA);
            PG8_WAIT_V(8); PG8_WAIT_L(0); PG8_BAR; PG8_MMA(0, 0, At, B0); PG8_MMA(0, 1, At, B1); PG8_BAR; PG8_SCHED;
            PG8_LDA(At, 0, 1); PG8_STAGE(PG8_SB(0, 0), b2, voffB); PG8_STAGE(PG8_SB(0, 1), b2 + hstep, voffB); PG8_STAGE(PG8_SA(0, 0), a2, voffA);
            PG8_WAIT_V(8); PG8_WAIT_L(0); PG8_BAR; PG8_MMA(1, 0, At, B0); PG8_MMA(1, 1, At, B1); PG8_BAR; PG8_SCHED;
            PG8_LDB(B0, 1, 0); PG8_LDB(B1, 1, 1); PG8_SCHED; PG8_LDA(At, 1, 0); PG8_STAGE(PG8_SA(0, 1), a2 + hstep, voffA);
            PG8_WAIT_V(8); PG8_WAIT_L(0); PG8_BAR; PG8_MMA(0, 0, At, B0); PG8_MMA(0, 1, At, B1); PG8_BAR; PG8_SCHED;
            PG8_LDA(At, 1, 1); PG8_STAGE(PG8_SB(1, 0), b3, voffB); PG8_STAGE(PG8_SB(1, 1), b3 + hstep, voffB); PG8_STAGE(PG8_SA(1, 0), a3, voffA);
            PG8_WAIT_V(8); PG8_WAIT_L(0); PG8_BAR; PG8_MMA(1, 0, At, B0); PG8_MMA(1, 1, At, B1); PG8_BAR; PG8_SCHED;
            } else {
            PG8_LDB(B0, 0, 0); PG8_SCHED; PG8_LDA(At, 0, 0); PG8_STAGE(PG8_SA(1, 1), a1 + hstep, voffA);
            PG8_WAIT_L(8); PG8_BAR; PG8_WAIT_L(0); PG8_MMA(0, 0, At, B0); PG8_BAR; PG8_SCHED;
            PG8_LDB(B1, 0, 1); PG8_STAGE(PG8_SB(0, 0), b2, voffB);
            PG8_BAR; PG8_WAIT_L(0); PG8_MMA(0, 1, At, B1); PG8_BAR;
            PG8_LDA(At, 0, 1); PG8_STAGE(PG8_SA(0, 0), a2, voffA);
            PG8_BAR; PG8_WAIT_L(0); PG8_MMA(1, 0, At, B0); PG8_BAR; PG8_SCHED;
            PG8_STAGE(PG8_SB(0, 1), b2 + hstep, voffB);
            PG8_WAIT_V(6); PG8_BAR; PG8_MMA(1, 1, At, B1); PG8_BAR;
            PG8_LDB(B0, 1, 0); PG8_SCHED; PG8_LDA(At, 1, 0); PG8_STAGE(PG8_SA(0, 1), a2 + hstep, voffA);
            PG8_WAIT_L(8); PG8_BAR; PG8_WAIT_L(0); PG8_MMA(0, 0, At, B0); PG8_BAR; PG8_SCHED;
            PG8_LDB(B1, 1, 1); PG8_STAGE(PG8_SB(1, 0), b3, voffB);
            PG8_BAR; PG8_WAIT_L(0); PG8_MMA(0, 1, At, B1); PG8_BAR;
            PG8_LDA(At, 1, 1); PG8_STAGE(PG8_SA(1, 0), a3, voffA);
            PG8_BAR; PG8_WAIT_L(0); PG8_MMA(1, 0, At, B0); PG8_BAR; PG8_SCHED;
            PG8_STAGE(PG8_SB(1, 1), b3 + hstep, voffB);
            PG8_WAIT_V(6); PG8_BAR; PG8_MMA(1, 1, At, B1); PG8_BAR;
            }
        }
        if constexpr (ALIGN_EPI) { if (wr == 0) PG8_BAR; }
        if constexpr (!Epi::AFTER_DRAIN) { E(acc, cur, wr, wc, fr, fq); S.done(cur); }
        if (!has_next) break;
#pragma unroll
        for (int a = 0; a < 2; ++a)
#pragma unroll
            for (int b = 0; b < 2; ++b)
#pragma unroll
                for (int m = 0; m < 4; ++m)
#pragma unroll
                    for (int n = 0; n < 2; ++n) acc[a][b][m][n] = (f32x4){0.f, 0.f, 0.f, 0.f};
        cur = nxt; cA = nA; cB = nB; ++ui;
        if constexpr (ALIGN_EPI) { if (wr == 1) PG8_BAR; }
    }
    PG8_WAIT_V(0);
    if constexpr (!ALIGN_EPI) { if (wr == 0) PG8_BAR; }
    PG8_BAR;
    if constexpr (Epi::AFTER_DRAIN) { E.fused(acc, cur, wr, wc, fr, fq, lds, wid, lane); S.done(cur); }
#undef PG8_SA
#undef PG8_SB
#undef PG8_STAGE
#undef PG8_LDA
#undef PG8_LDB
#undef PG8_MMA
#undef PG8_WAIT_V
#undef PG8_WAIT_L
#undef PG8_BAR
#undef PG8_SCHED
}

__device__ __forceinline__ float sigm(float x) { return 1.0f / (1.0f + __expf(-x)); }
struct EpiGlu {
    static constexpr bool PERM = true, AFTER_DRAIN = false;
    bf16_t* O; int ldc;
    __device__ __forceinline__ void operator()(const f32x4 (&acc)[2][2][4][2], const Unit& u, int wr, int wc, int fr, int fq) const {
        const int row0 = u.pm * BM + wr * 64 + fr, col0 = u.pn * HALF + wc * 32 + 8 * fq;
#pragma unroll
        for (int ai = 0; ai < 2; ++ai)
#pragma unroll
            for (int m = 0; m < 4; ++m) {
                bf16_t* rowp = O + (size_t)(row0 + ai * HALF + m * 16) * ldc + col0;
                const f32x4 a0 = acc[ai][0][m][0], a1 = acc[ai][0][m][1], b0 = acc[ai][1][m][0], b1 = acc[ai][1][m][1];
                u32x4 w;
                w.x = cvt_pk_bf16(a0[0] * sigm(b0[0]), a0[1] * sigm(b0[1])); w.y = cvt_pk_bf16(a0[2] * sigm(b0[2]), a0[3] * sigm(b0[3]));
                w.z = cvt_pk_bf16(a1[0] * sigm(b1[0]), a1[1] * sigm(b1[1])); w.w = cvt_pk_bf16(a1[2] * sigm(b1[2]), a1[3] * sigm(b1[3]));
                *(u32x4*)rowp = w;
            }
    }
};
struct EpiResid {
    static constexpr bool PERM = false, AFTER_DRAIN = false;
    const float* X; float* O; int ldc;
    __device__ __forceinline__ void operator()(const f32x4 (&acc)[2][2][4][2], const Unit& u, int wr, int wc, int fr, int fq) const {
        const int row0 = u.pm * BM + wr * 64 + fr, col0 = u.pn * BM + wc * 32 + 4 * fq;
#pragma unroll
        for (int ai = 0; ai < 2; ++ai)
#pragma unroll
            for (int m = 0; m < 4; ++m) {
                const size_t off = (size_t)(row0 + ai * HALF + m * 16) * ldc + col0;
#pragma unroll
                for (int bj = 0; bj < 2; ++bj)
#pragma unroll
                    for (int n = 0; n < 2; ++n) *(f32x4*)(O + off + bj * HALF + n * 16) = *(const f32x4*)(X + off + bj * HALF + n * 16) + acc[ai][bj][m][n];
            }
    }
};

struct ADense { static constexpr bool GATHER = false; __device__ __forceinline__ static unsigned rowoff(const Gemm&, const Unit&, int) { return 0u; } };
struct AList { static constexpr bool GATHER = true;
    __device__ __forceinline__ static unsigned rowoff(const Gemm& g, const Unit& u, int r) { const int pos = u.p0 + r; const unsigned tok = pos < u.cnt ? (g.list[(size_t)u.eb * g.cap + pos] >> 1) : 0u; return tok * (unsigned)g.lda * 2u; } };
struct ACompress { static constexpr bool GATHER = true;
    __device__ __forceinline__ static unsigned rowoff(const Gemm&, const Unit& u, int r) { const unsigned rg = (unsigned)(u.pm * BM + r), b = rg >> 9, n = (rg >> 1) & 255u, hkv = rg & 1u;
        return (((b * 4096u + 16u * n) * 2048u) + 1024u + (unsigned)u.eb * 128u + hkv * 64u) * 2u; } };
template <class Epi, class Sched, class AMap>
__device__ __forceinline__ void gemm2(PG8_LAS unsigned char* lds, const Gemm g, const Sched& S, const Epi& E, const int tid) {
    constexpr bool GATHER = AMap::GATHER;
    int K_ = g.K; asm volatile("" : "+s"(K_));
    const int wid = __builtin_amdgcn_readfirstlane(tid >> 6), lane = tid & 63, wr = wid >> 2, wc = wid & 3, fr = lane & 15, fq = lane >> 4;
    const int K = K_, nt = K / BK, lda = g.lda;
    unsigned voffA[2], voffB[2]; int Rst[2], Cst[2];
#pragma unroll
    for (int i = 0; i < 2; ++i) { int R, C; stage_rc(tid * 16 + i * 8192, R, C); const int Rb = Epi::PERM ? ((R & ~31) + perm32(R & 31)) : R;
        voffA[i] = (unsigned)(R * lda + C) * 2u; voffB[i] = (unsigned)(Rb * K + C) * 2u; Rst[i] = R; Cst[i] = C; }
    const size_t kstep = (size_t)(BK * 2), kstepA = (size_t)g.kstepA;
    const size_t hstepA = (size_t)HALF * lda * 2, tstepA = 2 * hstepA, hstepB = (size_t)HALF * K * 2, tstepB = 2 * hstepB;
    const unsigned ldsw = (unsigned)wid * 1024u;
    const int aoff = lds_byte(wr * 64 + fr, fq * 8), boff = lds_byte(wc * 32 + fr, fq * 8);
#define PG8_SA(b, h) (((b) * 2 + (h)) * HTB)
#define PG8_SB(b, h) ((4 + (b) * 2 + (h)) * HTB)
#define PG8_STAGE(bufoff, gbase, voff) do { _Pragma("unroll") for (int _i = 0; _i < 2; ++_i) \
        __builtin_amdgcn_global_load_lds((const unsigned*)((const char*)(gbase) + (voff)[_i]), (PG8_LAS unsigned*)(lds + (bufoff) + ldsw + _i * 8192), 16, 0, 0); } while (0)
#define PG8_STAGE_A(bufoff, gbase, h) do { if constexpr (GATHER) { PG8_STAGE(bufoff, gbase, vg[h]); } else { PG8_STAGE(bufoff, (gbase) + (h) * hstepA, voffA); } } while (0)
#define PG8_GOFFS(u, dst) do { _Pragma("unroll") for (int _h = 0; _h < 2; ++_h) _Pragma("unroll") for (int _i = 0; _i < 2; ++_i) dst[_h][_i] = AMap::rowoff(g, (u), _h * HALF + Rst[_i]) + (unsigned)Cst[_i] * 2u; } while (0)
#define PG8_LDA(dst, b, h) do { _Pragma("unroll") for (int m = 0; m < 4; ++m) _Pragma("unroll") for (int k = 0; k < 2; ++k) dst[m][k] = *(const PG8_LAS bf16x8*)(lds + PG8_SA(b, h) + aoff + m * 2048 + k * 1024); } while (0)
#define PG8_LDB(dst, b, h) do { _Pragma("unroll") for (int n = 0; n < 2; ++n) _Pragma("unroll") for (int k = 0; k < 2; ++k) dst[n][k] = *(const PG8_LAS bf16x8*)(lds + PG8_SB(b, h) + boff + n * 2048 + k * 1024); } while (0)
#define PG8_MMA(ai, bj, At, Bt) do { __builtin_amdgcn_s_setprio(1); _Pragma("unroll") for (int m = 0; m < 4; ++m) _Pragma("unroll") for (int n = 0; n < 2; ++n) _Pragma("unroll") for (int k = 0; k < 2; ++k) \
        acc[ai][bj][m][n] = __builtin_amdgcn_mfma_f32_16x16x32_bf16(Bt[n][k], At[m][k], acc[ai][bj][m][n], 0, 0, 0); __builtin_amdgcn_s_setprio(0); } while (0)
#define PG8_WAIT_V(n) asm volatile("s_waitcnt vmcnt(" #n ")" ::: "memory")
#define PG8_WAIT_L(n) asm volatile("s_waitcnt lgkmcnt(" #n ")" ::: "memory")
#define PG8_BAR __builtin_amdgcn_s_barrier()
#define PG8_SCHED __builtin_amdgcn_sched_barrier(0)
    Unit cur, nxt; int ui = 0;
    if (!S.next(0, cur)) return;
    f32x4 acc[2][2][4][2];
#pragma unroll
    for (int a = 0; a < 2; ++a)
#pragma unroll
        for (int b = 0; b < 2; ++b)
#pragma unroll
            for (int m = 0; m < 4; ++m)
#pragma unroll
                for (int n = 0; n < 2; ++n) acc[a][b][m][n] = (f32x4){0.f, 0.f, 0.f, 0.f};
    bf16x8 At[4][2], B0[2][2], B1[2][2];
    unsigned vg[2][2] = {{0u, 0u}, {0u, 0u}};
    if constexpr (GATHER) PG8_GOFFS(cur, vg);
    const char* cA = (const char*)g.A + (GATHER ? (size_t)0 : (size_t)cur.pm * tstepA + (size_t)cur.eb * g.astride * 2);
    const char* cB = (const char*)g.Bt + ((size_t)cur.eb * g.bstride) * 2 + (size_t)cur.pn * tstepB;
    S.a_ready(cur);
    PG8_STAGE(PG8_SB(0, 0), cB, voffB); PG8_STAGE(PG8_SB(0, 1), cB + hstepB, voffB); PG8_STAGE_A(PG8_SA(0, 0), cA, 0); PG8_STAGE_A(PG8_SA(0, 1), cA, 1);
    if (wr == 1) PG8_BAR;
    PG8_WAIT_V(2); PG8_BAR;
    PG8_STAGE(PG8_SB(1, 0), cB + kstep, voffB); PG8_STAGE_A(PG8_SA(1, 0), cA + kstepA, 0); PG8_STAGE(PG8_SB(1, 1), cB + hstepB + kstep, voffB);
    PG8_WAIT_V(6); PG8_BAR;
    for (;;) {
        const bool has_next = S.next(ui + 1, nxt);
        const char* nA = has_next ? (const char*)g.A + (GATHER ? (size_t)0 : (size_t)nxt.pm * tstepA + (size_t)nxt.eb * g.astride * 2) : cA;
        const char* nB = has_next ? (const char*)g.Bt + ((size_t)nxt.eb * g.bstride) * 2 + (size_t)nxt.pn * tstepB : cB;
        for (int t = 0; t < nt; t += 2) {
            const bool last = (t == nt - 2);
            const char* a1 = cA + (size_t)(t + 1) * kstepA;
            const char* a2 = last ? nA : cA + (size_t)(t + 2) * kstepA; const char* b2 = last ? nB : cB + (size_t)(t + 2) * kstep;
            const char* a3 = a2 + kstepA; const char* b3 = b2 + kstep;
            unsigned vn1[2] = {vg[1][0], vg[1][1]};
            if constexpr (GATHER) { if (last && has_next) { unsigned vn[2][2]; PG8_GOFFS(nxt, vn); vg[0][0] = vn[0][0]; vg[0][1] = vn[0][1]; vn1[0] = vn[1][0]; vn1[1] = vn[1][1]; } }
            if (last && has_next) S.a_ready(nxt);
            PG8_LDB(B0, 0, 0); PG8_LDB(B1, 0, 1); PG8_SCHED; PG8_LDA(At, 0, 0); PG8_STAGE_A(PG8_SA(1, 1), a1, 1);
            PG8_WAIT_V(8); PG8_WAIT_L(0); PG8_BAR; PG8_MMA(0, 0, At, B0); PG8_MMA(0, 1, At, B1); PG8_BAR; PG8_SCHED;
            if constexpr (GATHER) { vg[1][0] = vn1[0]; vg[1][1] = vn1[1]; }
            PG8_LDA(At, 0, 1); PG8_STAGE(PG8_SB(0, 0), b2, voffB); PG8_STAGE(PG8_SB(0, 1), b2 + hstepB, voffB); PG8_STAGE_A(PG8_SA(0, 0), a2, 0);
            PG8_WAIT_V(8); PG8_WAIT_L(0); PG8_BAR; PG8_MMA(1, 0, At, B0); PG8_MMA(1, 1, At, B1); PG8_BAR; PG8_SCHED;
            PG8_LDB(B0, 1, 0); PG8_LDB(B1, 1, 1); PG8_SCHED; PG8_LDA(At, 1, 0); PG8_STAGE_A(PG8_SA(0, 1), a2, 1);
            PG8_WAIT_V(8); PG8_WAIT_L(0); PG8_BAR; PG8_MMA(0, 0, At, B0); PG8_MMA(0, 1, At, B1); PG8_BAR; PG8_SCHED;
            PG8_LDA(At, 1, 1); PG8_STAGE(PG8_SB(1, 0), b3, voffB); PG8_STAGE(PG8_SB(1, 1), b3 + hstepB, voffB); PG8_STAGE_A(PG8_SA(1, 0), a3, 0);
            PG8_WAIT_V(8); PG8_WAIT_L(0); PG8_BAR; PG8_MMA(1, 0, At, B0); PG8_MMA(1, 1, At, B1); PG8_BAR; PG8_SCHED;
        }
        if (wr == 0) PG8_BAR;
        E(acc, cur, wr, wc, fr, fq); S.done(cur);
        if (!has_next) break;
#pragma unroll
        for (int a = 0; a < 2; ++a)
#pragma unroll
            for (int b = 0; b < 2; ++b)
#pragma unroll
                for (int m = 0; m < 4; ++m)
#pragma unroll
                    for (int n = 0; n < 2; ++n) acc[a][b][m][n] = (f32x4){0.f, 0.f, 0.f, 0.f};
        cur = nxt; cA = nA; cB = nB; ++ui;
        if (wr == 1) PG8_BAR;
    }
    PG8_WAIT_V(0);
    PG8_BAR;
#undef PG8_SA
#undef PG8_SB
#undef PG8_STAGE
#undef PG8_STAGE_A
#undef PG8_GOFFS
#undef PG8_LDA
#undef PG8_LDB
#undef PG8_MMA
#undef PG8_WAIT_V
#undef PG8_WAIT_L
#undef PG8_BAR
#undef PG8_SCHED
}

struct ExpertOrder {
    const PG8_LAS int* tab; int nN, G, c;
    __device__ __forceinline__ bool next(int i, Unit& u) const {
        const int total = tab[32] * nN; const long L = (long)i * G + c; if (L >= total) return false;
        const int rt = (int)L / nN, pn = (int)L % nN; int e = 0;
#pragma unroll
        for (int k = 1; k < 32; ++k) e += (rt >= tab[k]) ? 1 : 0;
        u.pm = __builtin_amdgcn_readfirstlane(rt); u.pn = __builtin_amdgcn_readfirstlane(pn); u.eb = __builtin_amdgcn_readfirstlane(e);
        u.p0 = __builtin_amdgcn_readfirstlane((rt - tab[e]) * BM); u.cnt = __builtin_amdgcn_readfirstlane(tab[33 + e]); return true;
    }
    __device__ __forceinline__ void a_ready(const Unit&) const {}
    __device__ __forceinline__ void done(const Unit&) const {}
};
struct EpiGateUp {
    static constexpr bool PERM = true, AFTER_DRAIN = false;
    bf16_t* H; const float* listw; int cap;
    __device__ __forceinline__ void operator()(const f32x4 (&acc)[2][2][4][2], const Unit& u, int wr, int wc, int fr, int fq) const {
        const int rl0 = wr * 64 + fr, col0 = u.pn * HALF + wc * 32 + 8 * fq;
#pragma unroll
        for (int ai = 0; ai < 2; ++ai)
#pragma unroll
            for (int m = 0; m < 4; ++m) {
                const int rl = rl0 + ai * HALF + m * 16, pos = u.p0 + rl;
                const float w = pos < u.cnt ? listw[(size_t)u.eb * cap + pos] : 0.f;
                bf16_t* rowp = H + (size_t)(u.pm * BM + rl) * 256 + col0;
                const f32x4 g0 = acc[ai][0][m][0], g1 = acc[ai][0][m][1], u0 = acc[ai][1][m][0], u1 = acc[ai][1][m][1];
                u32x4 o;
                o.x = cvt_pk_bf16(g0[0] * sigm(g0[0]) * u0[0] * w, g0[1] * sigm(g0[1]) * u0[1] * w); o.y = cvt_pk_bf16(g0[2] * sigm(g0[2]) * u0[2] * w, g0[3] * sigm(g0[3]) * u0[3] * w);
                o.z = cvt_pk_bf16(g1[0] * sigm(g1[0]) * u1[0] * w, g1[1] * sigm(g1[1]) * u1[1] * w); o.w = cvt_pk_bf16(g1[2] * sigm(g1[2]) * u1[2] * w, g1[3] * sigm(g1[3]) * u1[3] * w);
                *(u32x4*)rowp = o;
            }
    }
};
struct EpiDown {
    static constexpr bool PERM = false, AFTER_DRAIN = false;
    float* X; float* P2; const unsigned* list; int cap;
    __device__ __forceinline__ void operator()(const f32x4 (&acc)[2][2][4][2], const Unit& u, int wr, int wc, int fr, int fq) const {
        const int rl0 = wr * 64 + fr, col0 = u.pn * BM + wc * 32 + 4 * fq;
#pragma unroll
        for (int ai = 0; ai < 2; ++ai)
#pragma unroll
            for (int m = 0; m < 4; ++m) {
                const int rl = rl0 + ai * HALF + m * 16, pos = u.p0 + rl;
                if (pos < u.cnt) {
                    const unsigned ent = list[(size_t)u.eb * cap + pos];
                    float* dst = ((ent & 1u) ? P2 : X) + (size_t)(ent >> 1) * 1024 + col0;
#pragma unroll
                    for (int bj = 0; bj < 2; ++bj)
#pragma unroll
                        for (int n = 0; n < 2; ++n) { f32x4 v = acc[ai][bj][m][n]; if (!(ent & 1u)) v += *(const f32x4*)(dst + bj * HALF + n * 16); *(f32x4*)(dst + bj * HALF + n * 16) = v; }
                }
                asm volatile("" ::: "memory");
            }
    }
};

struct BatchOrder {
    int nb, nM, nN, G, c;
    __device__ __forceinline__ bool next(int i, Unit& u) const {
        const long L = (long)i * G + c; if (L >= (long)nb * nM * nN) return false;
        const int per = nM * nN, e = (int)L / per, rem = (int)L % per;
        u.eb = e; u.pm = rem / nN; u.pn = rem % nN; u.p0 = 0; u.cnt = 0; return true;
    }
    __device__ __forceinline__ void a_ready(const Unit&) const {}
    __device__ __forceinline__ void done(const Unit&) const {}
};
struct EpiInProj {
    static constexpr bool PERM = true, AFTER_DRAIN = false;
    bf16_t* Zo; bf16_t* U;
    __device__ __forceinline__ void operator()(const f32x4 (&acc)[2][2][4][2], const Unit& u, int wr, int wc, int fr, int fq) const {
        const int row0 = u.pm * BM + wr * 64 + fr;
#pragma unroll
        for (int ai = 0; ai < 2; ++ai)
#pragma unroll
            for (int m = 0; m < 4; ++m) { const int row = row0 + ai * HALF + m * 16;
#pragma unroll
                for (int bj = 0; bj < 2; ++bj) { const int c0 = u.pn * BM + bj * HALF + wc * 32 + 8 * fq;
                    const f32x4 v0 = acc[ai][bj][m][0], v1 = acc[ai][bj][m][1];
                    u32x4 w; w.x = cvt_pk_bf16(v0[0], v0[1]); w.y = cvt_pk_bf16(v0[2], v0[3]); w.z = cvt_pk_bf16(v1[0], v1[1]); w.w = cvt_pk_bf16(v1[2], v1[3]);
                    bf16_t* dst = u.pn < 2 ? U + ((size_t)((c0 >> 4) * 2048 + (row >> 4)) * 512 + (row & 15) * 16 + (c0 & 15)) : Zo + (size_t)row * 2048 + c0;
                    *(u32x4*)dst = w; } }
    }
};
struct EpiXloc {
    static constexpr bool PERM = false, AFTER_DRAIN = false;
    float* XL;
    __device__ __forceinline__ void operator()(const f32x4 (&acc)[2][2][4][2], const Unit& u, int wr, int wc, int fr, int fq) const {
        const int row0 = u.pm * BM + wr * 64 + fr, col0 = wc * 32 + 4 * fq;
#pragma unroll
        for (int ai = 0; ai < 2; ++ai)
#pragma unroll
            for (int m = 0; m < 4; ++m) { float* rowp = XL + ((size_t)u.eb * 2048 + row0 + ai * HALF + m * 16) * 128 + col0;
#pragma unroll
                for (int n = 0; n < 2; ++n) *(f32x4*)(rowp + n * 16) = acc[ai][0][m][n]; }
    }
};
__device__ __forceinline__ float gelu_t(float x) { const float u2 = -2.302208198f * (x + 0.044715f * x * x * x); return x * __builtin_amdgcn_rcpf(1.0f + __builtin_amdgcn_exp2f(u2)); }
struct EpiSsmOut {
    static constexpr bool PERM = true, AFTER_DRAIN = false;
    bf16_t* G;
    __device__ __forceinline__ void operator()(const f32x4 (&acc)[2][2][4][2], const Unit& u, int wr, int wc, int fr, int fq) const {
        const int row0 = u.pm * BM + wr * 64 + fr;
#pragma unroll
        for (int ai = 0; ai < 2; ++ai)
#pragma unroll
            for (int m = 0; m < 4; ++m) { const int row = row0 + ai * HALF + m * 16;
#pragma unroll
                for (int bj = 0; bj < 2; ++bj) { const int n0 = bj * HALF + wc * 32 + 8 * fq;
                    const f32x4 v0 = acc[ai][bj][m][0], v1 = acc[ai][bj][m][1];
                    u32x4 w; w.x = cvt_pk_bf16(gelu_t(v0[0]), gelu_t(v0[1])); w.y = cvt_pk_bf16(gelu_t(v0[2]), gelu_t(v0[3])); w.z = cvt_pk_bf16(gelu_t(v1[0]), gelu_t(v1[1])); w.w = cvt_pk_bf16(gelu_t(v1[2]), gelu_t(v1[3]));
                    *(u32x4*)(G + ((size_t)row * 16 + (n0 >> 4)) * 512 + u.eb * 16 + (n0 & 15)) = w; } }
    }
};

struct CmpOrder {
    int G, c;
    __device__ __forceinline__ bool next(int i, Unit& u) const { const int L = i * G + c; if (L >= 32) return false; u.eb = L >> 4; u.pm = L & 15; u.pn = 0; u.p0 = 0; u.cnt = 0; return true; }
    __device__ __forceinline__ void a_ready(const Unit&) const {}
    __device__ __forceinline__ void done(const Unit&) const {}
};
struct EpiCmpHid {
    static constexpr bool PERM = false, AFTER_DRAIN = false;
    bf16_t* HC; const float* bias;
    __device__ __forceinline__ void operator()(const f32x4 (&acc)[2][2][4][2], const Unit& u, int wr, int wc, int fr, int fq) const {
        if (wc < 2) {
            const int row0 = u.pm * BM + wr * 64 + fr, col0 = wc * 32 + 4 * fq;
#pragma unroll
            for (int n = 0; n < 2; ++n) { const f32x4 bv = *(const f32x4*)(bias + u.eb * 64 + col0 + n * 16);
#pragma unroll
                for (int ai = 0; ai < 2; ++ai)
#pragma unroll
                    for (int m = 0; m < 4; ++m) { const f32x4 v = acc[ai][0][m][n] + bv;
                        typedef unsigned u32x2_ __attribute__((ext_vector_type(2)));
                        u32x2_ w; w.x = cvt_pk_bf16(gelu_t(v[0]), gelu_t(v[1])); w.y = cvt_pk_bf16(gelu_t(v[2]), gelu_t(v[3]));
                        *(u32x2_*)(HC + ((size_t)u.eb * 4096 + row0 + ai * HALF + m * 16) * 64 + col0 + n * 16) = w; } }
        }
    }
};

struct SingleUnit {
    int eb, pm;
    __device__ __forceinline__ bool next(int i, Unit& u) const { if (i > 0) return false; u.eb = eb; u.pm = pm; u.pn = 0; u.p0 = 0; u.cnt = 0; return true; }
    __device__ __forceinline__ void a_ready(const Unit&) const {}
    __device__ __forceinline__ void done(const Unit&) const {}
};
}

struct Args { const float* in[26]; float* out; unsigned char* ws; int ph_lo, ph_hi; };

struct Frame {
    LAS unsigned char* lds;
    int tid, lane, wave, blk, G;
};

__device__ __forceinline__ void ph_norm(const Frame& F, const float* xin, const float* add, float* xout, const float* g, bf16* hn) {
    const int gw = F.blk * NWAVES + F.wave, NGW = F.G * NWAVES;
    for (int row = gw; row < T; row += NGW) {
        const f32x4* xr = (const f32x4*)(xin + (size_t)row * DM);
        f32x4 v[4]; float s = 0.f;
#pragma unroll
        for (int j = 0; j < 4; ++j) { v[j] = xr[F.lane + 64 * j];
            if (add) { v[j] += ((const f32x4*)(add + (size_t)row * DM))[F.lane + 64 * j]; ((f32x4*)(xout + (size_t)row * DM))[F.lane + 64 * j] = v[j]; }
            s += v[j].x * v[j].x + v[j].y * v[j].y + v[j].z * v[j].z + v[j].w * v[j].w; }
        s = wave_sum(s, F.lane);
        const float r = rsqrtf(s * (1.0f / DM) + EPS);
#pragma unroll
        for (int j = 0; j < 4; ++j) {
            const f32x4 gg = ((const f32x4*)g)[F.lane + 64 * j];
            u32x2 o; o.x = pk2(v[j].x * r * gg.x, v[j].y * r * gg.y); o.y = pk2(v[j].z * r * gg.z, v[j].w * r * gg.w);
            *(u32x2*)(hn + (size_t)row * DM + (F.lane + 64 * j) * 4) = o;
        }
    }
}
__device__ __forceinline__ void ph_final_norm(const Frame& F, float* x, const float* add, const float* g) {
    const int gw = F.blk * NWAVES + F.wave, NGW = F.G * NWAVES;
    for (int row = gw; row < T; row += NGW) {
        f32x4* xr = (f32x4*)(x + (size_t)row * DM);
        f32x4 v[4]; float s = 0.f;
#pragma unroll
        for (int j = 0; j < 4; ++j) { v[j] = xr[F.lane + 64 * j]; if (add) v[j] += ((const f32x4*)(add + (size_t)row * DM))[F.lane + 64 * j]; s += v[j].x * v[j].x + v[j].y * v[j].y + v[j].z * v[j].z + v[j].w * v[j].w; }
        s = wave_sum(s, F.lane);
        const float r = rsqrtf(s * (1.0f / DM) + EPS);
#pragma unroll
        for (int j = 0; j < 4; ++j) {
            const f32x4 gg = ((const f32x4*)g)[F.lane + 64 * j];
            f32x4 o; o.x = v[j].x * r * gg.x; o.y = v[j].y * r * gg.y; o.z = v[j].z * r * gg.z; o.w = v[j].w * r * gg.w;
            xr[F.lane + 64 * j] = o;
        }
    }
}

template <bool DUAL, class Epi>
__device__ __forceinline__ void sgemm_naive(const Frame& F, const bf16* A, int lda, const float* B, int ldb, int M, int N, int K, int dualoff, const Epi& epi) {
    LAS float* As = (LAS float*)F.lds;
    LAS float* Bs = As + 16 * 132;
    LAS float* Bs2 = Bs + 16 * 128;
    const int tiles_n = (N + 127) / 128, tiles_m = M / 128;
    const int tx = F.tid & 31, ty = F.tid >> 5;
    for (int tile = F.blk; tile < tiles_m * tiles_n; tile += F.G) {
        const int tm = tile / tiles_n, tn = tile % tiles_n;
        float acc[8][4], acc2[8][4];
#pragma unroll
        for (int i = 0; i < 8; ++i)
#pragma unroll
            for (int j = 0; j < 4; ++j) { acc[i][j] = 0.f; acc2[i][j] = 0.f; }
        const int arow = F.tid >> 2, akq = (F.tid & 3) * 4;
        const int bk = F.tid >> 5, bn = (F.tid & 31) * 4;
        for (int k0 = 0; k0 < K; k0 += 16) {
            {
                const u32x2 av = *(const u32x2*)(A + (size_t)(tm * 128 + arow) * lda + k0 + akq);
                As[(akq + 0) * 132 + arow] = __uint_as_float(av.x << 16);
                As[(akq + 1) * 132 + arow] = __uint_as_float(av.x & 0xffff0000u);
                As[(akq + 2) * 132 + arow] = __uint_as_float(av.y << 16);
                As[(akq + 3) * 132 + arow] = __uint_as_float(av.y & 0xffff0000u);
                const int col = tn * 128 + bn;
                f32x4 bv = (f32x4){0.f, 0.f, 0.f, 0.f};
                const float* bp = B + (size_t)(k0 + bk) * ldb + col;
                if (col + 3 < N) { bv.x = bp[0]; bv.y = bp[1]; bv.z = bp[2]; bv.w = bp[3]; }
                else { if (col < N) bv.x = bp[0]; if (col + 1 < N) bv.y = bp[1]; if (col + 2 < N) bv.z = bp[2]; }
                *(LAS f32x4*)(Bs + bk * 128 + bn) = bv;
                if (DUAL) {
                    const float* bp2 = bp + dualoff;
                    f32x4 bw; bw.x = bp2[0]; bw.y = bp2[1]; bw.z = bp2[2]; bw.w = bp2[3];
                    *(LAS f32x4*)(Bs2 + bk * 128 + bn) = bw;
                }
            }
            __syncthreads();
#pragma unroll 4
            for (int k = 0; k < 16; ++k) {
                float a[8];
                const f32x4 a0 = *(const LAS f32x4*)(As + k * 132 + ty * 8), a1 = *(const LAS f32x4*)(As + k * 132 + ty * 8 + 4);
                a[0] = a0.x; a[1] = a0.y; a[2] = a0.z; a[3] = a0.w; a[4] = a1.x; a[5] = a1.y; a[6] = a1.z; a[7] = a1.w;
                const f32x4 b = *(const LAS f32x4*)(Bs + k * 128 + tx * 4);
#pragma unroll
                for (int i = 0; i < 8; ++i) { acc[i][0] += a[i] * b.x; acc[i][1] += a[i] * b.y; acc[i][2] += a[i] * b.z; acc[i][3] += a[i] * b.w; }
                if (DUAL) {
                    const f32x4 b2 = *(const LAS f32x4*)(Bs2 + k * 128 + tx * 4);
#pragma unroll
                    for (int i = 0; i < 8; ++i) { acc2[i][0] += a[i] * b2.x; acc2[i][1] += a[i] * b2.y; acc2[i][2] += a[i] * b2.z; acc2[i][3] += a[i] * b2.w; }
                }
            }
            __syncthreads();
        }
#pragma unroll
        for (int i = 0; i < 8; ++i)
#pragma unroll
            for (int j = 0; j < 4; ++j) {
                const int row = tm * 128 + ty * 8 + i, col = tn * 128 + tx * 4 + j;
                if (col < N) epi(row, col, acc[i][j], acc2[i][j]);
            }
    }
}
struct EpiStoreBf16 { bf16* O; int ldo; __device__ __forceinline__ void operator()(int r, int c, float a, float) const { O[(size_t)r * ldo + c] = (bf16)f2bf(a); } };
struct EpiGlu { bf16* O; int ldo; __device__ __forceinline__ void operator()(int r, int c, float a, float b) const { O[(size_t)r * ldo + c] = (bf16)f2bf(a * sigmoidf_(b)); } };
struct EpiResid { const float* X; float* O; __device__ __forceinline__ void operator()(int r, int c, float a, float) const { O[(size_t)r * DM + c] = X[(size_t)r * DM + c] + a; } };

__device__ __forceinline__ void ssm_naive_item(int b, int g, const float* a_re, const float* a_im, const float* b_re, const float* b_im, const float* c_re, const float* c_im,
                                               const float* dpar, const float* log_dt, const bf16* Z, bf16* G1, int lane) {
    const int p = lane;
    const float are = a_re[g * 64 + p], aim = a_im[g * 64 + p], dt = expf(log_dt[g]);
    const float er = expf(are * dt), lbr = er * cosf(aim * dt), lbi = er * sinf(aim * dt);
    const float xx = lbr - 1.0f, yy = lbi, den = are * are + aim * aim;
    const float fr = (xx * are + yy * aim) / den, fi = (yy * are - xx * aim) / den;
    float bbr[16], bbi[16], cr[16], ci[16];
#pragma unroll
    for (int h = 0; h < 16; ++h) {
        const float br = b_re[(g * 64 + p) * 16 + h], bi = b_im[(g * 64 + p) * 16 + h];
        bbr[h] = fr * br - fi * bi; bbi[h] = fr * bi + fi * br;
        cr[h] = c_re[(g * 16 + h) * 64 + p]; ci[h] = c_im[(g * 16 + h) * 64 + p];
    }
    const float dd = dpar[g * 16 + (lane & 15)];
    float xr = 0.f, xi = 0.f;
    for (int t = 0; t < SEQ; ++t) {
        const size_t row = (size_t)b * SEQ + t;
        const u32x4 u0 = *(const u32x4*)(Z + row * ZP + ZC_U + g * 16), u1 = *(const u32x4*)(Z + row * ZP + ZC_U + g * 16 + 8);
        float u[16];
        u[0] = __uint_as_float(u0.x << 16); u[1] = __uint_as_float(u0.x & 0xffff0000u); u[2] = __uint_as_float(u0.y << 16); u[3] = __uint_as_float(u0.y & 0xffff0000u);
        u[4] = __uint_as_float(u0.z << 16); u[5] = __uint_as_float(u0.z & 0xffff0000u); u[6] = __uint_as_float(u0.w << 16); u[7] = __uint_as_float(u0.w & 0xffff0000u);
        u[8] = __uint_as_float(u1.x << 16); u[9] = __uint_as_float(u1.x & 0xffff0000u); u[10] = __uint_as_float(u1.y << 16); u[11] = __uint_as_float(u1.y & 0xffff0000u);
        u[12] = __uint_as_float(u1.z << 16); u[13] = __uint_as_float(u1.z & 0xffff0000u); u[14] = __uint_as_float(u1.w << 16); u[15] = __uint_as_float(u1.w & 0xffff0000u);
        float bur = 0.f, bui = 0.f;
#pragma unroll
        for (int h = 0; h < 16; ++h) { bur += bbr[h] * u[h]; bui += bbi[h] * u[h]; }
        const float nxr = lbr * xr - lbi * xi + bur, nxi = lbr * xi + lbi * xr + bui;
        xr = nxr; xi = nxi;
        float y = 0.f;
#pragma unroll
        for (int h = 0; h < 16; ++h) { const float v = wave_sum(cr[h] * xr - ci[h] * xi, lane); if (lane == h) y = v; }
        if (lane < 16) {
            const float ul = bf2f(Z[row * ZP + ZC_U + g * 16 + lane]);
            G1[row * D_SSM + g * 16 + lane] = (bf16)f2bf(gelu_tanh(y + dd * ul));
        }
    }
}
__device__ __forceinline__ void compress_naive_item(int item, const bf16* Z, const float* pos, const float* w1, const float* w2, bf16* KC, bf16* VC, int lane) {
    const int i = item & 1, hkv = (item >> 1) & 1, n = (item >> 2) % NCMPP, b = (item >> 2) / NCMPP;
    bf16* dst = i ? VC : KC;
    if (n == NCMP) { dst[(((size_t)b * NCMPP + n) * 2 + hkv) * 64 + lane] = 0; return; }
    const float* posi = pos + i * 32 * 64; const float* w1i = w1 + (size_t)i * 32 * 64 * 64; const float* w2i = w2 + i * 64 * 64;
    float acc = 0.f;
    for (int l = 0; l < 32; ++l) {
        const bf16* zr = Z + ((size_t)b * SEQ + 16 * n + l) * ZP + ZC_KV + i * 128 + hkv * 64;
        for (int d = 0; d < 64; ++d) acc += (bf2f(zr[d]) + posi[l * 64 + d]) * w1i[(l * 64 + d) * 64 + lane];
    }
    const float hid = gelu_tanh(acc);
    float o = 0.f;
    for (int e = 0; e < 64; ++e) o += lane_bcast(hid, e) * w2i[e * 64 + lane];
    dst[(((size_t)b * NCMPP + n) * 2 + hkv) * 64 + lane] = (bf16)f2bf(o);
}

__device__ __forceinline__ void attn_chunk(LAS float* wl, const bf16* Z, const float* rel_bias, int b, int hkv, int t, int base, int kcol, int vcol, int lane,
                                           float (&m)[4], float (&l)[4], float (&o)[4]) {
    const int pos = base + lane; const bool valid = (pos >= 0) && (pos <= t);
    const int posc = pos < 0 ? 0 : (pos > SEQ - 1 ? SEQ - 1 : pos);
    const bf16* kr = Z + ((size_t)b * SEQ + posc) * ZP + kcol + hkv * 64;
    float s[4] = {0.f, 0.f, 0.f, 0.f};
#pragma unroll 2
    for (int c = 0; c < 8; ++c) {
        const u32x4 kv = *(const u32x4*)(kr + c * 8);
        float k[8];
        k[0] = __uint_as_float(kv.x << 16); k[1] = __uint_as_float(kv.x & 0xffff0000u); k[2] = __uint_as_float(kv.y << 16); k[3] = __uint_as_float(kv.y & 0xffff0000u);
        k[4] = __uint_as_float(kv.z << 16); k[5] = __uint_as_float(kv.z & 0xffff0000u); k[6] = __uint_as_float(kv.w << 16); k[7] = __uint_as_float(kv.w & 0xffff0000u);
#pragma unroll
        for (int g = 0; g < 4; ++g) {
            const f32x4 q0 = *(const LAS f32x4*)(wl + g * 64 + c * 8), q1 = *(const LAS f32x4*)(wl + g * 64 + c * 8 + 4);
            s[g] += q0.x * k[0] + q0.y * k[1] + q0.z * k[2] + q0.w * k[3] + q1.x * k[4] + q1.y * k[5] + q1.z * k[6] + q1.w * k[7];
        }
    }
    const int bk = t5_bucket(t - pos);
#pragma unroll
    for (int g = 0; g < 4; ++g) {
        const float sv = valid ? s[g] + rel_bias[bk * 8 + hkv * 4 + g] : -1e30f;
        const float mn = fmaxf(m[g], wave_max(sv, lane));
        const float alpha = __expf(m[g] - mn);
        const float p = valid ? __expf(sv - mn) : 0.f;
        l[g] = l[g] * alpha + wave_sum(p, lane);
        o[g] *= alpha; m[g] = mn;
        wl[256 + g * 64 + lane] = p;
    }
#pragma unroll 4
    for (int key = 0; key < 64; ++key) {
        int pk = base + key; pk = pk < 0 ? 0 : (pk > SEQ - 1 ? SEQ - 1 : pk);
        const float v = bf2f(Z[((size_t)b * SEQ + pk) * ZP + vcol + hkv * 64 + lane]);
#pragma unroll
        for (int g = 0; g < 4; ++g) o[g] += wl[256 + g * 64 + key] * v;
    }
}
__device__ __forceinline__ void attn_naive_item(LAS float* wl, int b, int hkv, int t, const bf16* Z, const float* KC, const float* VC, const float* rel_bias, bf16* YC, int lane) {
    const size_t row = (size_t)b * SEQ + t;
#pragma unroll
    for (int g = 0; g < 4; ++g) wl[g * 64 + lane] = bf2f(Z[row * ZP + ZC_Q + hkv * 256 + g * 64 + lane]) * 0.125f;
#pragma unroll 1
    for (int c = 0; c < 4; ++c) {
        const int n = c * 64 + lane; const bool valid = (n < NCMP) && (16 * n + 31 <= t);
        const float* kr = KC + (((size_t)b * NCMPP + (n < NCMP ? n : 0)) * 2 + hkv) * 64;
        float s[4] = {0.f, 0.f, 0.f, 0.f};
#pragma unroll 4
        for (int d4 = 0; d4 < 16; ++d4) {
            const f32x4 k = *(const f32x4*)(kr + d4 * 4);
#pragma unroll
            for (int g = 0; g < 4; ++g) { const f32x4 q = *(const LAS f32x4*)(wl + g * 64 + d4 * 4); s[g] += q.x * k.x + q.y * k.y + q.z * k.z + q.w * k.w; }
        }
        const int bk = t5_bucket(t - (16 * n + 31));
#pragma unroll
        for (int g = 0; g < 4; ++g) wl[256 + g * 256 + n] = valid ? s[g] + rel_bias[bk * 8 + hkv * 4 + g] : -1e30f;
    }
#pragma unroll
    for (int g = 0; g < 4; ++g) {
        float sc[4];
#pragma unroll
        for (int c = 0; c < 4; ++c) sc[c] = wl[256 + g * 256 + c * 64 + lane];
        const float mx = wave_max(fmaxf(fmaxf(sc[0], sc[1]), fmaxf(sc[2], sc[3])), lane);
        float e[4], ls = 0.f;
#pragma unroll
        for (int c = 0; c < 4; ++c) { e[c] = sc[c] > -1e29f ? __expf(sc[c] - mx) : 0.f; ls += e[c]; }
        ls = wave_sum(ls, lane);
        const float inv = ls > 0.f ? 1.0f / ls : 0.f;
#pragma unroll
        for (int c = 0; c < 4; ++c) wl[256 + g * 256 + c * 64 + lane] = e[c] * inv;
    }
    float oc[4] = {0.f, 0.f, 0.f, 0.f};
    const int nmax = t >= 31 ? ((t - 31) / 16 + 1 < NCMP ? (t - 31) / 16 + 1 : NCMP) : 0;
#pragma unroll 4
    for (int n = 0; n < nmax; ++n) {
        const float v = VC[(((size_t)b * NCMPP + n) * 2 + hkv) * 64 + lane];
#pragma unroll
        for (int g = 0; g < 4; ++g) oc[g] += wl[256 + g * 256 + n] * v;
    }
    float imp = 0.f;
#pragma unroll
    for (int g = 0; g < 4; ++g) {
        const LAS float* P = wl + 256 + g * 256;
        imp += P[4 * lane] + P[4 * lane + 1] + P[4 * lane + 2] + 0.5f * P[4 * lane + 3] + (lane > 0 ? 0.5f * P[4 * lane - 1] : 0.f);
    }
    const int blk = t >> 6;
    const bool forced = (lane == 0) || (lane <= blk && lane > blk - 2), future = lane > blk;
    const float v = forced ? 1e9f : (future ? -1e9f : imp);
    int rank = 0;
    for (int jj = 0; jj < 64; ++jj) { const float vj = lane_bcast(v, jj); rank += (vj > v) || (vj == v && jj < lane); }
    unsigned long long mask = __ballot(rank < 16 && !future);
    float m[4], l[4], o[4];
#pragma unroll
    for (int g = 0; g < 4; ++g) { m[g] = -1e30f; l[g] = 0.f; o[g] = 0.f; }
    while (mask) {
        const int j = __builtin_ctzll(mask); mask &= mask - 1;
        attn_chunk(wl, Z, rel_bias, b, hkv, t, 64 * j, ZC_KV + 256, ZC_KV + 384, lane, m, l, o);
    }
    float os[4];
#pragma unroll
    for (int g = 0; g < 4; ++g) { os[g] = l[g] > 0.f ? o[g] / l[g] : 0.f; m[g] = -1e30f; l[g] = 0.f; o[g] = 0.f; }
    for (int c = 0; c < 8; ++c) attn_chunk(wl, Z, rel_bias, b, hkv, t, t - 511 + 64 * c, ZC_KV + 512, ZC_KV + 640, lane, m, l, o);
#pragma unroll
    for (int g = 0; g < 4; ++g) {
        const float ow = l[g] > 0.f ? o[g] / l[g] : 0.f;
        const bf16* gp = Z + row * ZP + ZC_G + hkv * 12 + g * 3;
        const float r = sigmoidf_(bf2f(gp[0])) * oc[g] + sigmoidf_(bf2f(gp[1])) * os[g] + sigmoidf_(bf2f(gp[2])) * ow;
        YC[row * DM + D_SSM + hkv * 256 + g * 64 + lane] = (bf16)f2bf(r);
    }
}

__device__ __forceinline__ void ph_norm_route(const Frame& F, const float* x, const float* g, const float* rgw, const float* rgb, const float* rew, const float* reb, bf16* hn,
                                              unsigned* gcnt, unsigned* list, float* listw) {
    LAS f32x4* RG = (LAS f32x4*)F.lds; LAS f32x4* RE = RG + 1024;
    LAS unsigned* cnt_l = (LAS unsigned*)(F.lds + 147456); LAS unsigned* base_l = cnt_l + 32; LAS unsigned* ent = cnt_l + 64;
    for (int d = F.tid; d < 1024; d += NTHR) { const int ln = d & 63, jc = d >> 6, row = (ln + 64 * (jc >> 2)) * 4 + (jc & 3); RG[d] = ((const f32x4*)rgw)[row]; }
    for (int d = F.tid; d < 8192; d += NTHR) { const int ln = d & 63, q = d >> 6, half = q & 1, c = (q >> 1) & 3, j = (q >> 3) & 3, gi = q >> 5, row = (ln + 64 * j) * 4 + c;
        RE[d] = ((const f32x4*)rew)[((size_t)gi * DM + row) * 2 + half]; }
    __syncthreads();
    for (int row0 = F.blk * 128; row0 < T; row0 += F.G * 128) {
        if (F.tid < 32) cnt_l[F.tid] = 0u;
        __syncthreads();
        for (int kk = 0; kk < 16; ++kk) {
            const int row = row0 + F.wave * 16 + kk;
            const f32x4* xr = (const f32x4*)(x + (size_t)row * DM);
            f32x4 v[4]; float s = 0.f;
#pragma unroll
            for (int j = 0; j < 4; ++j) { v[j] = xr[F.lane + 64 * j]; s += v[j].x * v[j].x + v[j].y * v[j].y + v[j].z * v[j].z + v[j].w * v[j].w; }
            s = wave_sum(s, F.lane);
            const float r = rsqrtf(s * (1.0f / DM) + EPS);
            float lg[4] = {0.f, 0.f, 0.f, 0.f};
#pragma unroll
            for (int j = 0; j < 4; ++j) {
                const f32x4 gg = ((const f32x4*)g)[F.lane + 64 * j];
                v[j].x = v[j].x * r * gg.x; v[j].y = v[j].y * r * gg.y; v[j].z = v[j].z * r * gg.z; v[j].w = v[j].w * r * gg.w;
                u32x2 o; o.x = pk2(v[j].x, v[j].y); o.y = pk2(v[j].z, v[j].w);
                *(u32x2*)(hn + (size_t)row * DM + (F.lane + 64 * j) * 4) = o;
                const f32x4 w0 = RG[(j * 4 + 0) * 64 + F.lane], w1 = RG[(j * 4 + 1) * 64 + F.lane], w2 = RG[(j * 4 + 2) * 64 + F.lane], w3 = RG[(j * 4 + 3) * 64 + F.lane];
                lg[0] += v[j].x * w0.x + v[j].y * w1.x + v[j].z * w2.x + v[j].w * w3.x;
                lg[1] += v[j].x * w0.y + v[j].y * w1.y + v[j].z * w2.y + v[j].w * w3.y;
                lg[2] += v[j].x * w0.z + v[j].y * w1.z + v[j].z * w2.z + v[j].w * w3.z;
                lg[3] += v[j].x * w0.w + v[j].y * w1.w + v[j].z * w2.w + v[j].w * w3.w;
            }
#pragma unroll
            for (int o = 0; o < 4; ++o) lg[o] = wave_sum(lg[o], F.lane) + rgb[o];
            int gi = 0; float gm = lg[0];
#pragma unroll
            for (int o = 1; o < 4; ++o) if (lg[o] > gm) { gm = lg[o]; gi = o; }
            float gs = 0.f;
#pragma unroll
            for (int o = 0; o < 4; ++o) gs += __expf(lg[o] - gm);
            const float gval = 1.0f / gs;
            const LAS f32x4* we = RE + gi * 2048;
            float le[8] = {0.f, 0.f, 0.f, 0.f, 0.f, 0.f, 0.f, 0.f};
#pragma unroll
            for (int j = 0; j < 4; ++j) {
                const float hv[4] = {v[j].x, v[j].y, v[j].z, v[j].w};
#pragma unroll
                for (int c = 0; c < 4; ++c) {
                    const f32x4 wa = we[((j * 4 + c) * 2 + 0) * 64 + F.lane], wb = we[((j * 4 + c) * 2 + 1) * 64 + F.lane];
                    le[0] += hv[c] * wa.x; le[1] += hv[c] * wa.y; le[2] += hv[c] * wa.z; le[3] += hv[c] * wa.w;
                    le[4] += hv[c] * wb.x; le[5] += hv[c] * wb.y; le[6] += hv[c] * wb.z; le[7] += hv[c] * wb.w;
                }
            }
#pragma unroll
            for (int e = 0; e < 8; ++e) le[e] = wave_sum(le[e], F.lane) + reb[gi * 8 + e];
            int e1 = 0; float m1 = le[0];
#pragma unroll
            for (int e = 1; e < 8; ++e) if (le[e] > m1) { m1 = le[e]; e1 = e; }
            int e2 = -1; float m2 = -3.0e38f;
#pragma unroll
            for (int e = 0; e < 8; ++e) if (e != e1 && le[e] > m2) { m2 = le[e]; e2 = e; }
            const float p2 = __expf(m2 - m1), inv = 1.0f / (1.0f + p2);
            if (F.lane == 0) {
                const unsigned ea = (unsigned)(gi * 8 + e1), eb = (unsigned)(gi * 8 + e2);
                const unsigned pa = __hip_atomic_fetch_add(cnt_l + ea, 1u, __ATOMIC_RELAXED, __HIP_MEMORY_SCOPE_WORKGROUP);
                const unsigned pb = __hip_atomic_fetch_add(cnt_l + eb, 1u, __ATOMIC_RELAXED, __HIP_MEMORY_SCOPE_WORKGROUP);
                LAS unsigned* en = ent + (F.wave * 16 + kk) * 6;
                en[0] = ea; en[1] = eb; en[2] = pa; en[3] = pb; en[4] = __float_as_uint(gval * inv); en[5] = __float_as_uint(gval * p2 * inv);
            }
        }
        __syncthreads();
        if (F.tid < 32) base_l[F.tid] = __hip_atomic_fetch_add(gcnt + F.tid * 64, cnt_l[F.tid], __ATOMIC_RELAXED, __HIP_MEMORY_SCOPE_AGENT);
        __syncthreads();
        if (F.tid < 128) {
            const LAS unsigned* en = ent + F.tid * 6; const unsigned tok = (unsigned)(row0 + F.tid);
            const unsigned ia = en[0] * LCAP + base_l[en[0]] + en[2], ib = en[1] * LCAP + base_l[en[1]] + en[3];
            list[ia] = tok * 2u; listw[ia] = __uint_as_float(en[4]);
            list[ib] = tok * 2u + 1u; listw[ib] = __uint_as_float(en[5]);
        }
        __syncthreads();
    }
}
__device__ __forceinline__ void build_expert_tab(const Frame& F, const unsigned* gcnt, LAS int* tab) {
    if (F.tid < 64) {
        const int c = F.lane < 32 ? (int)__hip_atomic_load(gcnt + F.lane * 64, __ATOMIC_RELAXED, __HIP_MEMORY_SCOPE_AGENT) : 0;
        int tiles = (c + 255) >> 8, incl = tiles;
#pragma unroll
        for (int o = 1; o < 32; o <<= 1) { const int t = __builtin_amdgcn_ds_bpermute((F.lane - o) << 2, incl); if (F.lane >= o) incl += t; }
        if (F.lane < 32) { tab[F.lane + 1] = incl; tab[33 + F.lane] = c; }
        if (F.lane == 0) tab[0] = 0;
    }
    __syncthreads();
}
__device__ __forceinline__ void ph_experts_naive(const Frame& F, const bf16* hn, const unsigned* route, const float* wg, const float* wu, const float* wd, float* x) {
    LAS float* hs = (LAS float*)F.lds;
    LAS float* hd = hs + 1024;
    for (int tok = F.blk; tok < T; tok += F.G) {
        { const unsigned pv = *(const unsigned*)(hn + (size_t)tok * DM + F.tid * 2); hs[F.tid * 2] = __uint_as_float(pv << 16); hs[F.tid * 2 + 1] = __uint_as_float(pv & 0xffff0000u); }
        const u32x4 rt = *(const u32x4*)(route + (size_t)tok * 4);
        __syncthreads();
        {
            const int s = F.tid >> 8, f = F.tid & 255;
            const unsigned e = s ? rt.y : rt.x; const float w = __uint_as_float(s ? rt.w : rt.z);
            const float* pg = wg + (size_t)e * DM * 256 + f; const float* pu = wu + (size_t)e * DM * 256 + f;
            float ga = 0.f, ua = 0.f;
            for (int d = 0; d < DM; ++d) { const float hv = hs[d]; ga += hv * pg[(size_t)d * 256]; ua += hv * pu[(size_t)d * 256]; }
            hd[s * 256 + f] = ga * sigmoidf_(ga) * ua * w;
        }
        __syncthreads();
        for (int dd = F.tid; dd < DM; dd += NTHR) {
            float acc = 0.f;
            const float* p0 = wd + (size_t)rt.x * 256 * DM + dd; const float* p1 = wd + (size_t)rt.y * 256 * DM + dd;
            for (int f = 0; f < 256; ++f) acc += hd[f] * p0[(size_t)f * DM];
            for (int f = 0; f < 256; ++f) acc += hd[256 + f] * p1[(size_t)f * DM];
            x[(size_t)tok * DM + dd] += acc;
        }
        __syncthreads();
    }
}


namespace nsa {
typedef short bf16x8 __attribute__((ext_vector_type(8)));
typedef short s16x4 __attribute__((ext_vector_type(4)));
typedef float f32x16 __attribute__((ext_vector_type(16)));
typedef float f32x2_t __attribute__((ext_vector_type(2)));
typedef __bf16 bf16x2_t __attribute__((ext_vector_type(2)));
constexpr int SLOTB = 8192;
constexpr int L_K = 0, L_V = 3 * SLOTB, L_IMP = 6 * SLOTB, L_BT = L_IMP + 65536, L_WS = L_BT + 4 * 132 * 4, L_RL = L_WS + 8 * 64 * 4, L_SM = L_RL + 4 * 64 * 4, L_END = L_SM + 64 * 8;
static_assert(L_END <= 131072, "nsa LDS map");
constexpr float LOG2E = 1.4426950408889634f;
constexpr float NEG_INF = -__builtin_inff();
#define NSA_SBAR() __builtin_amdgcn_sched_barrier(0)
__device__ __forceinline__ int crow(int r, int hi) { return (r & 3) + 8 * (r >> 2) + 4 * hi; }
__device__ __forceinline__ void glds16(const void* gsrc, unsigned lds_dst) { unsigned keep;
    asm volatile("s_mov_b32 %0, m0\n\ts_mov_b32 m0, %2\n\ts_nop 0\n\tglobal_load_lds_dwordx4 %1, off\n\ts_mov_b32 m0, %0" : "=&s"(keep) : "v"(gsrc), "s"(lds_dst) : "memory"); }
__device__ __forceinline__ unsigned cvtpk(float lo, float hi) { f32x2_t v = {lo, hi}; bf16x2_t b = __builtin_convertvector(v, bf16x2_t); return __builtin_bit_cast(unsigned, b); }
#define NSA_WAIT_BAR(N) asm volatile("s_waitcnt vmcnt(" #N ") lgkmcnt(0)\n\ts_barrier" ::: "memory")
__device__ __forceinline__ void qkt(f32x16& p0, f32x16& p1, const LAS char* kb, const bf16x8 (&qr)[4], const f32x16& cinit) {
#pragma unroll
    for (int d0 = 0; d0 < 4; ++d0) {
        const bf16x8 b0 = *(const LAS bf16x8*)(kb + d0 * 2048);
        const bf16x8 b1 = *(const LAS bf16x8*)(kb + d0 * 2048 + 512);
        if (d0 == 0) { p0 = __builtin_amdgcn_mfma_f32_32x32x16_bf16(b0, qr[0], cinit, 0, 0, 0); p1 = __builtin_amdgcn_mfma_f32_32x32x16_bf16(b1, qr[0], cinit, 0, 0, 0); }
        else { p0 = __builtin_amdgcn_mfma_f32_32x32x16_bf16(b0, qr[d0], p0, 0, 0, 0); p1 = __builtin_amdgcn_mfma_f32_32x32x16_bf16(b1, qr[d0], p1, 0, 0, 0); }
    }
}
__device__ __forceinline__ void pv(f32x16 (&o)[2], int vb, bf16x8 pa0, bf16x8 pa1, bf16x8 pa2, bf16x8 pa3) {
#pragma unroll
    for (int d0 = 0; d0 < 2; ++d0) { s16x4 lo[4], hi[4];
#pragma unroll
        for (int ks = 0; ks < 4; ++ks) {
            asm volatile("ds_read_b64_tr_b16 %0,%1 offset:%c2" : "=&v"(lo[ks]) : "v"(vb), "i"(d0 * 4096 + ks * 1024) : "memory");
            asm volatile("ds_read_b64_tr_b16 %0,%1 offset:%c2" : "=&v"(hi[ks]) : "v"(vb), "i"(d0 * 4096 + ks * 1024 + 512) : "memory"); }
        asm volatile("s_waitcnt lgkmcnt(0)" ::: "memory"); NSA_SBAR();
#define NSA_PK(k) (bf16x8){lo[k][0], lo[k][1], lo[k][2], lo[k][3], hi[k][0], hi[k][1], hi[k][2], hi[k][3]}
        o[d0] = __builtin_amdgcn_mfma_f32_32x32x16_bf16(pa0, NSA_PK(0), o[d0], 0, 0, 0);
        o[d0] = __builtin_amdgcn_mfma_f32_32x32x16_bf16(pa1, NSA_PK(1), o[d0], 0, 0, 0);
        o[d0] = __builtin_amdgcn_mfma_f32_32x32x16_bf16(pa2, NSA_PK(2), o[d0], 0, 0, 0);
        o[d0] = __builtin_amdgcn_mfma_f32_32x32x16_bf16(pa3, NSA_PK(3), o[d0], 0, 0, 0);
#undef NSA_PK
    }
}
__device__ __forceinline__ float other_half(float v, int hi) { auto rr = __builtin_amdgcn_permlane32_swap(__float_as_uint(v), __float_as_uint(v), false, false); return __uint_as_float(hi ? rr[0] : rr[1]); }
__device__ __forceinline__ float rowmax(const f32x16& p0, const f32x16& p1, int hi) {
    float a = fmaxf(fmaxf(p0[0], p0[1]), p1[0]), b = fmaxf(fmaxf(p0[2], p0[3]), p1[1]); a = fmaxf(fmaxf(a, p1[2]), p1[3]);
#pragma unroll
    for (int r = 4; r < 16; r += 4) { a = fmaxf(fmaxf(a, p0[r]), p0[r + 1]); b = fmaxf(fmaxf(b, p0[r + 2]), p0[r + 3]); a = fmaxf(fmaxf(a, p1[r]), p1[r + 1]); b = fmaxf(fmaxf(b, p1[r + 2]), p1[r + 3]); }
    const float m = fmaxf(a, b);
    return fmaxf(m, other_half(m, hi));
}
__device__ __forceinline__ void pack_p(const f32x16& p0, const f32x16& p1, bf16x8& a0, bf16x8& a1, bf16x8& a2, bf16x8& a3) {
    u32x4 w0, w1, w2, w3;
    w0 = (u32x4){cvtpk(p0[0], p0[1]), cvtpk(p0[2], p0[3]), cvtpk(p0[4], p0[5]), cvtpk(p0[6], p0[7])};
    w1 = (u32x4){cvtpk(p0[8], p0[9]), cvtpk(p0[10], p0[11]), cvtpk(p0[12], p0[13]), cvtpk(p0[14], p0[15])};
    w2 = (u32x4){cvtpk(p1[0], p1[1]), cvtpk(p1[2], p1[3]), cvtpk(p1[4], p1[5]), cvtpk(p1[6], p1[7])};
    w3 = (u32x4){cvtpk(p1[8], p1[9]), cvtpk(p1[10], p1[11]), cvtpk(p1[12], p1[13]), cvtpk(p1[14], p1[15])};
    a0 = __builtin_bit_cast(bf16x8, w0); a1 = __builtin_bit_cast(bf16x8, w1); a2 = __builtin_bit_cast(bf16x8, w2); a3 = __builtin_bit_cast(bf16x8, w3);
}

struct Ctx {
    LAS char* lds; unsigned lds0; int wid, lane, r32, hi, g, th, qloc;
    const LAS float* bt;
    LAS float* wsf;
    const LAS float* wrow;
    int vb0;
    const LAS char* kb0;
};
__device__ __forceinline__ void dma_k(const Ctx& c, const bf16* kbase, int pitch, int slot) { glds16(kbase + (size_t)c.lane * pitch + c.wid * 8, (unsigned)__builtin_amdgcn_readfirstlane(c.lds0 + L_K + slot * SLOTB + c.wid * 1024)); }
__device__ __forceinline__ void dma_v(const Ctx& c, const bf16* vbase, int pitch, int slot) { glds16(vbase + (size_t)(16 * (c.wid & 3) + (c.lane >> 2)) * pitch + (c.wid >> 2) * 32 + (c.lane & 3) * 8, (unsigned)__builtin_amdgcn_readfirstlane(c.lds0 + L_V + slot * SLOTB + c.wid * 1024)); }

__device__ __forceinline__ void cmp_scores(const Ctx& c, int slot, const bf16x8 (&qr)[4], int t0, int kt, f32x16& p0, f32x16& p1) {
    const int dmin = t0 + 32 * c.th - 16 * (64 * kt + 63) - 31;
    const bool special = dmin < 113;
    f32x16 ci; { const float v = special ? 0.f : c.bt[128];
#pragma unroll
        for (int r = 0; r < 16; ++r) ci[r] = v; }
    qkt(p0, p1, c.kb0 + slot * SLOTB, qr, ci);
    if (special) {
        int hi64 = 64 * c.hi; asm volatile("" : "+v"(hi64));
        const int dqh = t0 + c.qloc - 1024 * kt - 31 - hi64;
#pragma unroll
        for (int r = 0; r < 16; ++r) {
            const int d0 = dqh - 16 * ((r & 3) + 8 * (r >> 2)), d1 = d0 - 512;
            const float b0 = c.bt[d0 < 0 ? 0 : (d0 > 128 ? 128 : d0)], b1 = c.bt[d1 < 0 ? 0 : (d1 > 128 ? 128 : d1)];
            p0[r] = d0 < 0 ? NEG_INF : p0[r] + b0; p1[r] = d1 < 0 ? NEG_INF : p1[r] + b1;
        }
    }
}
template <int MODE>
__device__ __forceinline__ void online_tile(const Ctx& c, int slot, const bf16x8 (&qr)[4], int dq, bool near, bool masked_tile, bool lane_off, float& mhat, float& lsum, f32x16 (&o)[2]) {
    f32x16 ci; { const float v = (near ? 0.f : c.bt[128]) - mhat;
#pragma unroll
        for (int r = 0; r < 16; ++r) ci[r] = v; }
    f32x16 p0, p1;
    qkt(p0, p1, c.kb0 + slot * SLOTB, qr, ci);
    if (near || masked_tile) {
        int hi4 = 4 * c.hi; asm volatile("" : "+v"(hi4));
        const int dqh = dq - hi4;
#pragma unroll
        for (int r = 0; r < 16; ++r) {
            const int d0 = dqh - ((r & 3) + 8 * (r >> 2)), d1 = d0 - 32;
            if (near) { p0[r] += c.bt[d0 < 0 ? 0 : (d0 > 128 ? 128 : d0)]; p1[r] += c.bt[d1 < 0 ? 0 : (d1 > 128 ? 128 : d1)]; }
            if (d0 < 0 || (MODE == 1 && d0 >= 512)) p0[r] = NEG_INF;
            if (d1 < 0 || (MODE == 1 && d1 >= 512)) p1[r] = NEG_INF;
        }
    }
    if (MODE == 0) { if (lane_off) {
#pragma unroll
        for (int r = 0; r < 16; ++r) { p0[r] = NEG_INF; p1[r] = NEG_INF; } } }
    const float rm = rowmax(p0, p1, c.hi);
    if (__any(rm > 8.0f)) {
        const float dl = fmaxf(rm, 0.f); mhat += dl;
#pragma unroll
        for (int r = 0; r < 16; ++r) { p0[r] -= dl; p1[r] -= dl; }
        const float f = __builtin_amdgcn_exp2f(-dl); lsum *= f;
        if (c.hi == 0) c.wsf[c.r32] = f;
        asm volatile("s_waitcnt lgkmcnt(0)" ::: "memory");
#pragma unroll
        for (int r = 0; r < 16; ++r) { const float fr = c.wrow[(r & 3) + 8 * (r >> 2)]; o[0][r] *= fr; o[1][r] *= fr; }
    }
    float sacc = 0.f;
#pragma unroll
    for (int r = 0; r < 16; ++r) { p0[r] = __builtin_amdgcn_exp2f(p0[r]); p1[r] = __builtin_amdgcn_exp2f(p1[r]); sacc += p0[r] + p1[r]; }
    lsum += sacc;
    bf16x8 a0, a1, a2, a3; pack_p(p0, p1, a0, a1, a2, a3);
    pv(o, c.vb0 + slot * SLOTB, a0, a1, a2, a3);
}
__device__ __forceinline__ void add_scaled(const Ctx& c, f32x16 (&oacc)[2], const f32x16 (&o)[2], float s) {
    if (c.hi == 0) c.wsf[32 + c.r32] = s;
    asm volatile("s_waitcnt lgkmcnt(0)" ::: "memory");
#pragma unroll
    for (int r = 0; r < 16; ++r) { const float f = c.wrow[32 + (r & 3) + 8 * (r >> 2)]; oacc[0][r] += o[0][r] * f; oacc[1][r] += o[1][r] * f; }
    asm volatile("s_waitcnt lgkmcnt(0)" ::: "memory");
}

__device__ __forceinline__ void unit(LAS char* lds, int tid, int b, int hkv, int jt, const bf16* Z, const bf16* KCm, const bf16* VCm, const float* rel_bias, bf16* YC) {
    Ctx c; c.lds = lds; c.lds0 = (unsigned)(uintptr_t)lds; c.wid = __builtin_amdgcn_readfirstlane(tid >> 6); c.lane = tid & 63; c.r32 = c.lane & 31; c.hi = c.lane >> 5;
    c.g = c.wid & 3; c.th = c.wid >> 2; c.qloc = 32 * c.th + c.r32;
    c.bt = (const LAS float*)(lds + L_BT) + c.g * 132; c.wsf = (LAS float*)(lds + L_WS) + c.wid * 64; c.wrow = c.wsf + 4 * c.hi;
    c.vb0 = (int)(c.lds0 + L_V) + ((c.lane >> 4) & 1) * 32 + (c.lane & 3) * 8 + (4 * c.hi + ((c.lane & 15) >> 2)) * 64;
    c.kb0 = (const LAS char*)(lds + L_K) + c.hi * 1024 + c.r32 * 16;
    const int t0 = 64 * jt;
    const bf16* Zb = Z + (size_t)b * SEQ * ZP;
    const size_t qrow = (size_t)b * SEQ + t0 + c.qloc;
    for (int i = tid; i < 4 * 129; i += NTHR) { const int gg = i / 129, d = i % 129; ((LAS float*)(lds + L_BT))[gg * 132 + d] = rel_bias[t5_bucket(d) * 8 + hkv * 4 + gg] * LOG2E; }
    bf16x8 qr[4];
#pragma unroll
    for (int d0 = 0; d0 < 4; ++d0) qr[d0] = *(const bf16x8*)(Z + qrow * ZP + ZC_Q + hkv * 256 + c.g * 64 + d0 * 16 + c.hi * 8);
    const bf16* gp = Z + qrow * ZP + ZC_G + hkv * 12 + c.g * 3;
    const float gate0 = sigmoidf_(bf2f(gp[0])), gate1 = sigmoidf_(bf2f(gp[1])), gate2 = sigmoidf_(bf2f(gp[2]));
    f32x16 oacc[2];
#pragma unroll
    for (int r = 0; r < 16; ++r) { oacc[0][r] = 0.f; oacc[1][r] = 0.f; }

    const int nct = (4 * jt + 2) / 64 + 1;
    const bf16* kcb = KCm + (size_t)b * NCMPP * 128 + hkv * 64; const bf16* vcb = VCm + (size_t)b * NCMPP * 128 + hkv * 64;
    float mrow = NEG_INF;
    {
        dma_k(c, kcb, 128, 0); if (nct > 1) dma_k(c, kcb + 64 * 128, 128, 1);
        for (int i = 0; i < nct; ++i) {
            if (i + 1 < nct) NSA_WAIT_BAR(1); else NSA_WAIT_BAR(0);
            if (i + 2 < nct) dma_k(c, kcb + (size_t)(i + 2) * 64 * 128, 128, (i + 2) % 3);
            f32x16 p0, p1; cmp_scores(c, i % 3, qr, t0, i, p0, p1);
            mrow = fmaxf(mrow, rowmax(p0, p1, c.hi));
        }
        NSA_WAIT_BAR(0);
    }
    {
        const float muse = mrow == NEG_INF ? 0.f : mrow;
        float lsum = 0.f, carry = 0.f; f32x16 o[2];
#pragma unroll
        for (int r = 0; r < 16; ++r) { o[0][r] = 0.f; o[1][r] = 0.f; }
        LAS float* impw = (LAS float*)(lds + L_IMP) + (c.g * 64 + c.qloc) * 64;
        dma_k(c, kcb, 128, 0); dma_v(c, vcb, 128, 0); if (nct > 1) { dma_k(c, kcb + 64 * 128, 128, 1); dma_v(c, vcb + 64 * 128, 128, 1); }
        for (int i = 0; i < nct; ++i) {
            if (i + 1 < nct) NSA_WAIT_BAR(2); else NSA_WAIT_BAR(0);
            if (i + 2 < nct) { dma_k(c, kcb + (size_t)(i + 2) * 64 * 128, 128, (i + 2) % 3); dma_v(c, vcb + (size_t)(i + 2) * 64 * 128, 128, (i + 2) % 3); }
            f32x16 p0, p1; cmp_scores(c, i % 3, qr, t0, i, p0, p1);
            float sacc = 0.f;
#pragma unroll
            for (int r = 0; r < 16; ++r) { p0[r] = __builtin_amdgcn_exp2f(p0[r] - muse); p1[r] = __builtin_amdgcn_exp2f(p1[r] - muse); sacc += p0[r] + p1[r]; }
            lsum += sacc;
            float o3[8];
#pragma unroll
            for (int k = 0; k < 4; ++k) { o3[k] = other_half(p0[4 * k + 3], c.hi); o3[4 + k] = other_half(p1[4 * k + 3], c.hi); }
#pragma unroll
            for (int idx = 0; idx < 8; ++idx) {
                const int X = idx >> 2, k = idx & 3;
                const f32x16& p = X ? p1 : p0;
                const float cin = c.hi ? o3[idx] : (idx ? o3[idx - 1] : carry);
                impw[16 * i + 8 * X + 2 * k + c.hi] = p[4 * k] + p[4 * k + 1] + p[4 * k + 2] + 0.5f * p[4 * k + 3] + 0.5f * cin;
            }
            carry = o3[7];
            bf16x8 a0, a1, a2, a3; pack_p(p0, p1, a0, a1, a2, a3);
            pv(o, c.vb0 + (i % 3) * SLOTB, a0, a1, a2, a3);
        }
        const float lt = lsum + other_half(lsum, c.hi);
        const float rl = lt > 0.f ? 1.0f / lt : 0.f;
        if (c.hi == 0) ((LAS float*)(lds + L_RL))[c.g * 64 + c.qloc] = rl;
        add_scaled(c, oacc, o, rl * gate0);
        NSA_WAIT_BAR(0);
    }
    for (int k = 0; k < 8; ++k) {
        const int tok = c.wid * 8 + k;
        float v = 0.f;
#pragma unroll
        for (int gg = 0; gg < 4; ++gg) v += ((const LAS float*)(lds + L_IMP))[(gg * 64 + tok) * 64 + c.lane] * ((const LAS float*)(lds + L_RL))[gg * 64 + tok];
        const bool forced = (c.lane == 0) || (c.lane <= jt && c.lane > jt - 2), future = c.lane > jt;
        v = forced ? 1e9f : (future ? -1e9f : v);
        int rank = 0;
        for (int jj = 0; jj < 64; ++jj) { const float vj = lane_bcast(v, jj); rank += ((vj > v) || (vj == v && jj < c.lane)) ? 1 : 0; }
        const unsigned long long msk = __ballot(rank < 16 && !future);
        if (c.lane == 0) ((LAS unsigned long long*)(lds + L_SM))[tok] = msk;
    }
    NSA_WAIT_BAR(0);
    const unsigned long long mymask = ((const LAS unsigned long long*)(lds + L_SM))[c.qloc];
    {
        const bf16* kb = Zb + ZC_KV + 256 + hkv * 64; const bf16* vb = Zb + ZC_KV + 384 + hkv * 64;
        const int nt = jt + 1;
        float mhat = 0.f, lsum = 0.f; f32x16 o[2];
#pragma unroll
        for (int r = 0; r < 16; ++r) { o[0][r] = 0.f; o[1][r] = 0.f; }
        dma_k(c, kb, ZP, 0); dma_v(c, vb, ZP, 0); if (nt > 1) { dma_k(c, kb + (size_t)64 * ZP, ZP, 1); dma_v(c, vb + (size_t)64 * ZP, ZP, 1); }
        for (int i = 0; i < nt; ++i) {
            if (i + 1 < nt) NSA_WAIT_BAR(2); else NSA_WAIT_BAR(0);
            if (i + 2 < nt) { dma_k(c, kb + (size_t)(i + 2) * 64 * ZP, ZP, (i + 2) % 3); dma_v(c, vb + (size_t)(i + 2) * 64 * ZP, ZP, (i + 2) % 3); }
            online_tile<0>(c, i % 3, qr, 64 * (jt - i) + c.qloc, i >= jt - 2, i == jt, !((mymask >> i) & 1ull), mhat, lsum, o);
        }
        const float lt = lsum + other_half(lsum, c.hi);
        add_scaled(c, oacc, o, (lt > 0.f ? 1.0f / lt : 0.f) * gate1);
        NSA_WAIT_BAR(0);
    }
    {
        const int j0 = jt > 8 ? jt - 8 : 0, nt = jt - j0 + 1;
        const bf16* kb = Zb + (size_t)j0 * 64 * ZP + ZC_KV + 512 + hkv * 64; const bf16* vb = Zb + (size_t)j0 * 64 * ZP + ZC_KV + 640 + hkv * 64;
        float mhat = 0.f, lsum = 0.f; f32x16 o[2];
#pragma unroll
        for (int r = 0; r < 16; ++r) { o[0][r] = 0.f; o[1][r] = 0.f; }
        dma_k(c, kb, ZP, 0); dma_v(c, vb, ZP, 0); if (nt > 1) { dma_k(c, kb + (size_t)64 * ZP, ZP, 1); dma_v(c, vb + (size_t)64 * ZP, ZP, 1); }
        for (int i = 0; i < nt; ++i) {
            if (i + 1 < nt) NSA_WAIT_BAR(2); else NSA_WAIT_BAR(0);
            if (i + 2 < nt) { dma_k(c, kb + (size_t)(i + 2) * 64 * ZP, ZP, (i + 2) % 3); dma_v(c, vb + (size_t)(i + 2) * 64 * ZP, ZP, (i + 2) % 3); }
            const int j = j0 + i;
            online_tile<1>(c, i % 3, qr, 64 * (jt - j) + c.qloc, j >= jt - 2, j == jt || j == jt - 8, false, mhat, lsum, o);
        }
        const float lt = lsum + other_half(lsum, c.hi);
        add_scaled(c, oacc, o, (lt > 0.f ? 1.0f / lt : 0.f) * gate2);
    }
    {
        bf16* yb = YC + ((size_t)b * SEQ + t0 + 32 * c.th + 4 * c.hi) * DM + D_SSM + hkv * 256 + c.g * 64 + c.r32;
#pragma unroll
        for (int r = 0; r < 16; ++r) { bf16* yr = yb + (size_t)((r & 3) + 8 * (r >> 2)) * DM; yr[0] = (bf16)f2bf(oacc[0][r]); yr[32] = (bf16)f2bf(oacc[1][r]); }
    }
    asm volatile("s_waitcnt vmcnt(0)" ::: "memory");
    NSA_WAIT_BAR(0);
}
#undef NSA_SBAR
#undef NSA_WAIT_BAR
}


__device__ __forceinline__ void ssm_precompute(const Frame& F, const __attribute__((address_space(4))) Args* args, unsigned char* ws, int item) {
    const int layer = item >> 5, g = item & 31, lg = layer * 32 + g;
    LAS float* L = (LAS float*)F.lds;
    LAS float* lkr = L; LAS float* lki = L + 17 * 64; LAS float* bbr = L + 2 * 17 * 64; LAS float* bbi = bbr + 1024; LAS float* ccr = bbi + 1024; LAS float* cci = ccr + 1024;
    LAS float* wk = cci + 1024; LAS float* dd = wk + 4096;
    const float* a_re = args->in[6] + lg * 64; const float* a_im = args->in[7] + lg * 64;
    const float dt = expf(args->in[13][lg]);
    for (int i = F.tid; i < 17 * 64; i += NTHR) { const int k = i >> 6, p = i & 63; const float er = expf(a_re[p] * dt * (float)k), ang = a_im[p] * dt * (float)k; lkr[i] = er * cosf(ang); lki[i] = er * sinf(ang); }
    for (int i = F.tid; i < 1024; i += NTHR) {
        { const int p = i >> 4, h = i & 15; const float are = a_re[p], aim = a_im[p];
          const float er = expf(are * dt), lbr = er * cosf(aim * dt), lbi = er * sinf(aim * dt);
          const float xx = lbr - 1.0f, yy = lbi, den = are * are + aim * aim, fr = (xx * are + yy * aim) / den, fi = (yy * are - xx * aim) / den;
          const float br = args->in[8][((size_t)lg * 64 + p) * 16 + h], bi = args->in[9][((size_t)lg * 64 + p) * 16 + h];
          bbr[i] = fr * br - fi * bi; bbi[i] = fr * bi + fi * br; }
        ccr[i] = args->in[10][(size_t)lg * 1024 + i]; cci[i] = args->in[11][(size_t)lg * 1024 + i];
    }
    if (F.tid < 16) dd[F.tid] = args->in[12][lg * 16 + F.tid];
    __syncthreads();
    for (int i = F.tid; i < 4096; i += NTHR) { const int k = i >> 8, ho = (i >> 4) & 15, hi = i & 15; float acc = 0.f;
        for (int p = 0; p < 64; ++p) { const float cr = ccr[ho * 64 + p], ci = cci[ho * 64 + p], lr = lkr[k * 64 + p], li = lki[k * 64 + p];
            const float tr = cr * lr - ci * li, ti = cr * li + ci * lr; acc += tr * bbr[p * 16 + hi] - ti * bbi[p * 16 + hi]; }
        wk[i] = acc + ((k == 0 && ho == hi) ? dd[ho] : 0.f); }
    __syncthreads();
    bf16* B2 = (bf16*)(ws + WS_BT2) + (size_t)lg * 256 * 384;
    for (int i = F.tid; i < 256 * 384; i += NTHR) { const int n = i / 384, kk = i % 384, t = n >> 4, ho = n & 15; float v;
        if (kk < 256) { const int sidx = kk >> 4, hi = kk & 15; v = sidx <= t ? wk[((t - sidx) << 8) + ho * 16 + hi] : 0.f; }
        else { const int j = kk - 256, p = j & 63; const float cr = ccr[ho * 64 + p], ci = cci[ho * 64 + p], lr = lkr[(t + 1) * 64 + p], li = lki[(t + 1) * 64 + p];
            v = j < 64 ? (cr * lr - ci * li) : -(cr * li + ci * lr); }
        B2[i] = (bf16)f2bf(v); }
    bf16* B1 = (bf16*)(ws + WS_BT1) + (size_t)lg * 256 * 256;
    for (int i = F.tid; i < 65536; i += NTHR) { const int j = i >> 8, kk = i & 255, sidx = kk >> 4, hi = kk & 15; float v = 0.f;
        if (j < 128) { const int p = j & 63; const float lr = lkr[(15 - sidx) * 64 + p], li = lki[(15 - sidx) * 64 + p], br = bbr[p * 16 + hi], bi = bbi[p * 16 + hi];
            v = j < 64 ? (lr * br - li * bi) : (lr * bi + li * br); }
        B1[i] = (bf16)f2bf(v); }
    __syncthreads();
}
__device__ __forceinline__ void ssm_carry_item(int b, int g, const float* a_re, const float* a_im, const float* log_dt, const float* XL, bf16* U, int lane) {
    const float dt16 = 16.0f * expf(log_dt[g]);
    const float er = expf(a_re[g * 64 + lane] * dt16), ang = a_im[g * 64 + lane] * dt16, lr = er * cosf(ang), li = er * sinf(ang);
    float xr = 0.f, xi = 0.f;
    const float* __restrict__ xl = XL + ((size_t)g * 2048 + b * 256) * 128 + lane;
    bf16* __restrict__ up = U + ((size_t)g * 2048 + b * 256) * 512 + 256 + lane;
    float ar[16], ai[16], nr_[16], ni_[16];
#pragma unroll
    for (int k = 0; k < 16; ++k) { ar[k] = xl[(size_t)k * 128]; ai[k] = xl[(size_t)k * 128 + 64]; }
    for (int cb = 0; cb < 16; ++cb) {
        const int cn = cb < 15 ? (cb + 1) * 16 : cb * 16;
#pragma unroll
        for (int k = 0; k < 16; ++k) { nr_[k] = xl[(size_t)(cn + k) * 128]; ni_[k] = xl[(size_t)(cn + k) * 128 + 64]; }
#pragma unroll
        for (int k = 0; k < 16; ++k) {
            const int c = cb * 16 + k;
            up[(size_t)c * 512] = (bf16)f2bf(xr); up[(size_t)c * 512 + 64] = (bf16)f2bf(xi);
            const float nr = lr * xr - li * xi + ar[k], ni = lr * xi + li * xr + ai[k];
            xr = nr; xi = ni;
        }
#pragma unroll
        for (int k = 0; k < 16; ++k) { ar[k] = nr_[k]; ai[k] = ni_[k]; }
    }
}


__device__ __forceinline__ void compress_stage2(const Frame& F, int eb, int pm, const bf16* HC, const float* w2, bf16* KCo, bf16* VCo) {
    const int r = F.tid >> 1, f0 = (F.tid & 1) * 32, rg = pm * 256 + r;
    const bf16* hr = HC + ((size_t)eb * 4096 + rg) * 64; const float* w = w2 + eb * 64 * 64 + f0;
    float acc[32];
#pragma unroll
    for (int f = 0; f < 32; ++f) acc[f] = 0.f;
#pragma unroll 2
    for (int e = 0; e < 64; ++e) { const float h = bf2f(hr[e]);
#pragma unroll
        for (int f4 = 0; f4 < 8; ++f4) { const f32x4 wv = *(const f32x4*)(w + e * 64 + f4 * 4); acc[f4 * 4] += h * wv.x; acc[f4 * 4 + 1] += h * wv.y; acc[f4 * 4 + 2] += h * wv.z; acc[f4 * 4 + 3] += h * wv.w; } }
    const bool pad = ((rg >> 1) & 255) == NCMP;
    bf16* dst = (eb ? VCo : KCo) + (size_t)rg * 64 + f0;
#pragma unroll
    for (int f8 = 0; f8 < 4; ++f8) { u32x4 o; o.x = pad ? 0u : pk2(acc[f8 * 8], acc[f8 * 8 + 1]); o.y = pad ? 0u : pk2(acc[f8 * 8 + 2], acc[f8 * 8 + 3]); o.z = pad ? 0u : pk2(acc[f8 * 8 + 4], acc[f8 * 8 + 5]); o.w = pad ? 0u : pk2(acc[f8 * 8 + 6], acc[f8 * 8 + 7]);
        *(u32x4*)(dst + f8 * 8) = o; }
}

__device__ __forceinline__ void transpose_item(const float* W, int K, int N, bf16* WT, int k0, int n0, int drow0, LAS float* scr, int lane, float scale = 1.0f) {
#pragma unroll 8
    for (int i = 0; i < 32; ++i) { const int kk = 2 * i + (lane >> 5); scr[kk * 33 + (lane & 31)] = W[(size_t)(k0 + kk) * N + n0 + (lane & 31)]; }
    asm volatile("s_waitcnt lgkmcnt(0)" ::: "memory");
    const int c = lane & 7;
#pragma unroll
    for (int j = 0; j < 4; ++j) { const int n = (lane >> 3) + 8 * j; const LAS float* sp = scr + (8 * c) * 33 + n;
        u32x4 o; o.x = pk2(sp[0 * 33] * scale, sp[1 * 33] * scale); o.y = pk2(sp[2 * 33] * scale, sp[3 * 33] * scale); o.z = pk2(sp[4 * 33] * scale, sp[5 * 33] * scale); o.w = pk2(sp[6 * 33] * scale, sp[7 * 33] * scale);
        *(u32x4*)(WT + (size_t)(drow0 + n) * K + k0 + 8 * c) = o; }
    asm volatile("s_waitcnt lgkmcnt(0)" ::: "memory");
}
__device__ __forceinline__ void ph_convert(const Frame& F, const __attribute__((address_space(4))) Args* args, unsigned char* ws) {
    for (int it = F.blk; it < DEPTH * NGRP; it += F.G) ssm_precompute(F, args, ws, it);
    LAS float* scr = (LAS float*)(F.lds + F.wave * 16384);
    const int gw = F.blk * NWAVES + F.wave, NGW = F.G * NWAVES;
    constexpr int I_IN = (DM / 64) * (1792 / 32), I_GLU = (D_SSM / 64) * (2 * D_SSM / 32), I_OUT = (DM / 64) * (DM / 32);
    constexpr int PER_LAYER = I_IN + I_GLU + I_OUT;
    for (int it = gw; it < DEPTH * 32 * 384; it += NGW) {
        const int le = it / 384, r = it % 384;
        if (r < 256) { const int isup = r >> 7, q = r & 127, nb = q & 7, kb = q >> 3, n0 = 32 * nb;
            transpose_item(args->in[isup ? 24 : 23] + (size_t)le * DM * 256, DM, 256, (bf16*)(ws + WS_WGU) + (size_t)le * 512 * DM, 64 * kb, n0, 256 * (n0 >> 7) + 128 * isup + (n0 & 127), scr, F.lane); }
        else { const int q = r - 256, nb = q & 31, kb = q >> 5;
            transpose_item(args->in[25] + (size_t)le * 256 * DM, 256, DM, (bf16*)(ws + WS_WDN) + (size_t)le * DM * 256, 64 * kb, 32 * nb, 32 * nb, scr, F.lane); }
    }
    for (int it = gw; it < DEPTH * 2 * 64; it += NGW) { const int li = it >> 6, q = it & 63, nb = q & 1, kb = q >> 1;
        transpose_item(args->in[16] + (size_t)li * 2048 * 64, 2048, 64, (bf16*)(ws + WS_W1T) + (size_t)li * 256 * 2048, 64 * kb, 32 * nb, 32 * nb, scr, F.lane); }
    { const int gt = F.blk * NTHR + F.tid, NGT = F.G * NTHR;
      for (int idx = gt; idx < DEPTH * 2 * 192 * 2048 / 8; idx += NGT) { const int li = idx / (192 * 256), rem = idx % (192 * 256);
          *(u32x4*)((bf16*)(ws + WS_W1T) + (size_t)li * 256 * 2048 + (size_t)64 * 2048 + (size_t)rem * 8) = (u32x4){0u, 0u, 0u, 0u}; }
      for (int idx = gt; idx < DEPTH * 2 * 64; idx += NGT) { const int li = idx >> 6, e = idx & 63; const float* pp = args->in[15] + (size_t)li * 2048; const float* ww = args->in[16] + (size_t)li * 2048 * 64 + e;
          float a = 0.f; for (int k = 0; k < 2048; ++k) a += pp[k] * ww[(size_t)k * 64];
          ((float*)(ws + WS_CBIAS))[idx] = a; } }
    for (int it = gw; it < DEPTH * PER_LAYER; it += NGW) {
        const int layer = it / PER_LAYER; int r = it % PER_LAYER;
        if (r < I_IN) { const int nb = r % 56, kb = r / 56;
            transpose_item(args->in[4] + (size_t)layer * DM * D_IN, DM, D_IN, (bf16*)(ws + WS_WIN) + (size_t)layer * ZP * DM, 64 * kb, 32 * nb, 32 * nb, scr, F.lane, (nb >= 16 && nb < 32) ? QSCALE : 1.0f); continue; }
        r -= I_IN;
        if (r < I_GLU) { const int nb = r % 32, kb = r / 32, n0 = 32 * nb;
            const int half = n0 >> 9, c = n0 & 511, drow = 256 * (c >> 7) + 128 * half + (c & 127);
            transpose_item(args->in[14] + (size_t)layer * D_SSM * 2 * D_SSM, D_SSM, 2 * D_SSM, (bf16*)(ws + WS_WGLU) + (size_t)layer * 2 * D_SSM * D_SSM, 64 * kb, n0, drow, scr, F.lane); continue; }
        r -= I_GLU;
        { const int nb = r % 32, kb = r / 32;
            transpose_item(args->in[5] + (size_t)layer * DM * DM, DM, DM, (bf16*)(ws + WS_WOUT) + (size_t)layer * DM * DM, 64 * kb, 32 * nb, 32 * nb, scr, F.lane); }
    }
    const int gt = F.blk * NTHR + F.tid, NGT = F.G * NTHR;
    for (int idx = gt; idx < DEPTH * 256 * DM; idx += NGT) {
        const int layer = idx / (256 * DM), rem = idx % (256 * DM), n = 1792 + rem / DM, k = rem % DM;
        const float v = n < D_IN ? args->in[4][(size_t)layer * DM * D_IN + (size_t)k * D_IN + n] : 0.f;
        ((bf16*)(ws + WS_WIN))[(size_t)layer * ZP * DM + (size_t)n * DM + k] = (bf16)f2bf(v);
    }
}

constexpr int PH_PER_LAYER = 8, N_PHASES = 1 + DEPTH * PH_PER_LAYER + 1;
#ifndef FAST_GEMM
#define FAST_GEMM 1
#endif
#ifndef REP_ATTN
#define REP_ATTN 1
#endif
#ifndef REP_CMP
#define REP_CMP 1
#endif
#ifndef REP_CARRY
#define REP_CARRY 1
#endif
#ifndef REP_CONV
#define REP_CONV 1
#endif
#ifndef REP_INPROJ
#define REP_INPROJ 1
#endif
#ifndef REP_G1
#define REP_G1 1
#endif
#ifndef REP_G2
#define REP_G2 1
#endif
#ifndef REP_GLU
#define REP_GLU 1
#endif
#ifndef REP_OUT
#define REP_OUT 1
#endif
#ifndef REP_NORM
#define REP_NORM 1
#endif
#ifndef REP_ROUTE
#define REP_ROUTE 1
#endif
#ifndef REP_GU
#define REP_GU 1
#endif
#ifndef REP_DN
#define REP_DN 1
#endif

__global__ void __launch_bounds__(NTHR, 2) fwd(Args args) {
    extern __shared__ __attribute__((aligned(16))) unsigned char lds_raw[];
    Frame F;
    F.lds = (LAS unsigned char*)lds_raw;
    F.tid = threadIdx.x; F.lane = F.tid & 63; F.wave = __builtin_amdgcn_readfirstlane(F.tid >> 6);
    F.blk = blockIdx.x; F.G = gridDim.x;
    typedef const __attribute__((address_space(4))) Args* KArgs;
    KArgs kp = (KArgs)__builtin_amdgcn_kernarg_segment_ptr();
    asm volatile("" : "+s"(kp));
    unsigned char* ws = kp->ws;
    volatile LAS unsigned* MISC = (volatile LAS unsigned*)(F.lds + MISC_OFF);
    if (F.tid < 32) MISC[F.tid] = 0u;
    __syncthreads();
    XcdBarrier bar; bar.bar = (unsigned*)(ws + WS_CTL) + CW_BAR; bar.x = 0; bar.st = nullptr;
    if (N_LAUNCH_MODE == 1) bar = xcd_barrier_post((unsigned*)(ws + WS_CTL) + CW_BAR, MISC + 8);
#define IN(k) (kp->ph_lo <= (k) && (k) < kp->ph_hi)
#define FRESH_IDS() do { int l_; asm volatile("v_mbcnt_lo_u32_b32 %0, -1, 0\n\tv_mbcnt_hi_u32_b32 %0, -1, %0" : "=v"(l_)); asm volatile("" : "+s"(F.wave), "+s"(F.blk), "+s"(F.G)); F.lane = l_; F.tid = F.wave * 64 + l_; asm volatile("" : "+s"(kp)); ws = kp->ws; bar.bar = (unsigned*)(ws + WS_CTL) + CW_BAR; } while (0)
#define SEAM(k) do { FRESH_IDS(); if (IN(k) && IN((k) + 1)) xcd_barrier(bar, F.tid); FRESH_IDS(); } while (0)

    const float* x0 = kp->in[0];
    float* XR = kp->out;
#define HN ((bf16*)(ws + WS_HN))
#define Z ((bf16*)(ws + WS_Z))
#define YC ((bf16*)(ws + WS_YC))
#define G1 ((bf16*)(ws + WS_G1))
#define KC ((bf16*)(ws + WS_KC))
#define VC ((bf16*)(ws + WS_VC))
#define LIST ((unsigned*)(ws + WS_LIST))
#define LISTW ((float*)(ws + WS_LISTW))
#define HID ((bf16*)(ws + WS_HID))
#define P2 ((float*)(ws + WS_P2))
#define USSM ((bf16*)(ws + WS_USSM))
#define XL ((float*)(ws + WS_XL))
    LAS int* etab = (LAS int*)(F.lds + ETAB_OFF);

    if (IN(0)) for (int rep_ = 0; rep_ < REP_CONV; ++rep_) ph_convert(F, kp, ws);
    SEAM(0);
    for (int layer = 0; layer < DEPTH; ++layer) {
        const int pb = 1 + layer * PH_PER_LAYER;
        const float* xin = layer == 0 ? x0 : XR;
        unsigned* gcnt = (unsigned*)(ws + WS_CTL) + CW_CNT + layer * 32 * 64;
        if (IN(pb + 0)) { ph_norm(F, xin, layer == 0 ? nullptr : P2, XR, kp->in[1] + layer * DM, HN); for (int rep_ = 1; rep_ < REP_NORM; ++rep_) ph_norm(F, xin, nullptr, XR, kp->in[1] + layer * DM, HN); }
        SEAM(pb + 0);
        if (IN(pb + 1)) {
            pg8::Gemm g{HN, (const bf16*)(ws + WS_WIN) + (size_t)layer * ZP * DM, T, ZP, DM, DM, 0, nullptr, 0, 0, 128}; pg8::StaticOrder S; S.init(T, ZP, F.G, F.blk);
            pg8::EpiInProj E{Z, USSM};
            for (int rep_ = 0; rep_ < REP_INPROJ; ++rep_) pg8::gemm2<pg8::EpiInProj, pg8::StaticOrder, pg8::ADense>(F.lds, g, S, E, F.tid);
        }
        SEAM(pb + 1);
        if (IN(pb + 2)) {
            for (int rep_ = 0; rep_ < REP_CMP; ++rep_) {
                { pg8::Gemm g{Z, (const bf16*)(ws + WS_W1T) + (size_t)layer * 2 * 256 * 2048, 0, 256, 2048, ZP, (size_t)256 * 2048, nullptr, 0, 0, ZP * 2};
                  pg8::CmpOrder S{F.G, F.blk}; pg8::EpiCmpHid E{(bf16*)(ws + WS_HIDC), (const float*)(ws + WS_CBIAS) + layer * 128};
                  pg8::gemm2<pg8::EpiCmpHid, pg8::CmpOrder, pg8::ACompress>(F.lds, g, S, E, F.tid); }
                asm volatile("s_waitcnt vmcnt(0)" ::: "memory"); __syncthreads();
                for (int L = F.blk; L < 32; L += F.G) compress_stage2(F, L >> 4, L & 15, (const bf16*)(ws + WS_HIDC), kp->in[17] + (size_t)layer * 2 * 64 * 64, KC, VC);
            }
#pragma unroll 1
            for (int L = F.blk; L < NGRP * BATCH; L += F.G) {
                const int sg = L >> 3, sb = L & 7;
                FRESH_IDS();
                { pg8::Gemm g{USSM, (const bf16*)(ws + WS_BT1) + (size_t)layer * 32 * 256 * 256, 0, 256, 256, 512, (size_t)256 * 256, nullptr, 0, (size_t)2048 * 512, 128};
                  pg8::SingleUnit S{sg, sb}; pg8::EpiXloc E{XL};
                  pg8::gemm2<pg8::EpiXloc, pg8::SingleUnit, pg8::ADense>(F.lds, g, S, E, F.tid); }
                asm volatile("s_waitcnt vmcnt(0)" ::: "memory"); __syncthreads();
                for (int rep_ = 0; rep_ < REP_CARRY; ++rep_)
                if (F.wave == 0) ssm_carry_item(sb, sg, kp->in[6] + layer * NGRP * SST, kp->in[7] + layer * NGRP * SST, kp->in[13] + layer * NGRP, XL, USSM, F.lane);
                asm volatile("s_waitcnt vmcnt(0)" ::: "memory"); __syncthreads();
                FRESH_IDS();
                { pg8::Gemm g{USSM, (const bf16*)(ws + WS_BT2) + (size_t)layer * 32 * 256 * 384, 0, 256, 384, 512, (size_t)256 * 384, nullptr, 0, (size_t)2048 * 512, 128};
                  pg8::SingleUnit S{sg, sb}; pg8::EpiSsmOut E{G1};
                  pg8::gemm2<pg8::EpiSsmOut, pg8::SingleUnit, pg8::ADense>(F.lds, g, S, E, F.tid); }
            }
        }
        SEAM(pb + 2);
        if (IN(pb + 3)) {
            { pg8::Gemm g{G1, (const bf16*)(ws + WS_WGLU) + (size_t)layer * 2 * D_SSM * D_SSM, T, 2 * D_SSM, D_SSM, D_SSM, 0, nullptr, 0, 0, 128}; pg8::StaticOrder S; S.init(T, 2 * D_SSM, F.G, F.blk);
              pg8::EpiGlu E{YC, DM};
              for (int rep_ = 0; rep_ < REP_GLU; ++rep_) pg8::gemm2<pg8::EpiGlu, pg8::StaticOrder, pg8::ADense>(F.lds, g, S, E, F.tid); }
            __syncthreads();
            for (int rep_ = 0; rep_ < REP_ATTN; ++rep_)
            for (int slot = F.blk; slot < 256; slot += F.G) {
                const int bh = slot >> 4, sq = slot & 15;
#pragma unroll 1
                for (int uq = 0; uq < 4; ++uq) { const int jt = uq == 0 ? 63 - sq : (uq == 1 ? 32 + sq : (uq == 2 ? 31 - sq : sq));
                    nsa::unit((LAS char*)F.lds, F.tid, bh >> 1, bh & 1, jt, Z, KC, VC, kp->in[18], YC); }
            }
        }
        SEAM(pb + 3);
        if (IN(pb + 4)) {
            pg8::Gemm g{YC, (const bf16*)(ws + WS_WOUT) + (size_t)layer * DM * DM, T, DM, DM, DM, 0, nullptr, 0, 0, 128}; pg8::StaticOrder S; S.init(T, DM, F.G, F.blk);
            for (int rep_ = 1; rep_ < REP_OUT; ++rep_) { pg8::EpiResid Ed{xin, (float*)(ws + WS_Z), DM}; pg8::gemm2<pg8::EpiResid, pg8::StaticOrder, pg8::ADense>(F.lds, g, S, Ed, F.tid); }
            pg8::EpiResid E{xin, XR, DM};
            pg8::gemm2<pg8::EpiResid, pg8::StaticOrder, pg8::ADense>(F.lds, g, S, E, F.tid);
        }
        SEAM(pb + 4);
        if (IN(pb + 5)) ph_norm_route(F, XR, kp->in[2] + layer * DM, kp->in[19] + (size_t)layer * DM * 4, kp->in[20] + layer * 4, kp->in[21] + (size_t)layer * 4 * DM * 8, kp->in[22] + layer * 32, HN, gcnt, LIST, LISTW);
        if (IN(pb + 5)) for (int rep_ = 1; rep_ < REP_ROUTE; ++rep_) ph_norm_route(F, XR, kp->in[2] + layer * DM, kp->in[19] + (size_t)layer * DM * 4, kp->in[20] + layer * 4, kp->in[21] + (size_t)layer * 4 * DM * 8, kp->in[22] + layer * 32, HN, gcnt + (2 + rep_) * 32 * 64, (unsigned*)(ws + 484 * MiB), (float*)(ws + 488 * MiB));
        SEAM(pb + 5);
        if (IN(pb + 6)) {
            build_expert_tab(F, gcnt, etab);
            pg8::Gemm g{HN, (const bf16*)(ws + WS_WGU) + (size_t)layer * 32 * 512 * DM, 0, 512, DM, DM, (size_t)512 * DM, LIST, LCAP, 0, 128};
            pg8::ExpertOrder S{etab, 2, F.G, F.blk};
            pg8::EpiGateUp E{HID, LISTW, LCAP};
            for (int rep_ = 0; rep_ < REP_GU; ++rep_) pg8::gemm2<pg8::EpiGateUp, pg8::ExpertOrder, pg8::AList>(F.lds, g, S, E, F.tid);
        }
        SEAM(pb + 6);
        if (IN(pb + 7)) {
            build_expert_tab(F, gcnt, etab);
            pg8::Gemm g{HID, (const bf16*)(ws + WS_WDN) + (size_t)layer * 32 * DM * 256, 0, DM, 256, 256, (size_t)DM * 256, nullptr, 0, 0, 128};
            pg8::ExpertOrder S{etab, 4, F.G, F.blk};
            for (int rep_ = 1; rep_ < REP_DN; ++rep_) { pg8::EpiDown Ed{P2, P2, LIST, LCAP}; pg8::gemm2<pg8::EpiDown, pg8::ExpertOrder, pg8::ADense>(F.lds, g, S, Ed, F.tid); }
            pg8::EpiDown E{XR, P2, LIST, LCAP};
            pg8::gemm2<pg8::EpiDown, pg8::ExpertOrder, pg8::ADense>(F.lds, g, S, E, F.tid);
        }
        SEAM(pb + 7);
    }
    if (IN(N_PHASES - 1)) ph_final_norm(F, XR, P2, kp->in[3]);
#undef IN
#undef SEAM
#undef HN
#undef Z
#undef YC
#undef G1
#undef KC
#undef VC
#undef LIST
#undef LISTW
#undef HID
#undef P2
#undef USSM
#undef XL
}

extern "C" void kernel_launch(void* const* d_in, const int* in_sizes, int n_in, void* d_out, int out_size, void* d_ws, size_t ws_size, hipStream_t stream) {
    static int grid = 0;
    if (grid == 0) {
        if (n_in != 26 || out_size != T * DM || ws_size < WS_END) { fprintf(stderr, "kernel_launch: unexpected shapes (n_in %d out %d ws %zu)\n", n_in, out_size, ws_size); grid = -1; return; }
        int dev = 0, cus = 0, per_cu = 0;
        if (hipGetDevice(&dev) != hipSuccess || hipDeviceGetAttribute(&cus, hipDeviceAttributeMultiprocessorCount, dev) != hipSuccess) { grid = -1; return; }
        if (hipFuncSetAttribute((const void*)fwd, hipFuncAttributeMaxDynamicSharedMemorySize, LDS_BYTES) != hipSuccess) { fprintf(stderr, "kernel_launch: hipFuncSetAttribute failed\n"); grid = -1; return; }
        if (hipOccupancyMaxActiveBlocksPerMultiprocessor(&per_cu, (const void*)fwd, NTHR, LDS_BYTES) != hipSuccess || per_cu < 1) fprintf(stderr, "kernel_launch: occupancy query says %d\n", per_cu);
        (void)hipGetLastError();
        grid = cus;
    }
    if (grid < 0) return;
    (void)hipMemsetAsync((char*)d_ws + WS_CTL, 0, CTL_ZERO_BYTES, stream);
    Args a{};
    for (int i = 0; i < 26; ++i) a.in[i] = (const float*)d_in[i];
    a.out = (float*)d_out; a.ws = (unsigned char*)d_ws;
    if (N_LAUNCH_MODE == 1) {
        a.ph_lo = 0; a.ph_hi = N_PHASES;
        hipLaunchKernelGGL(fwd, dim3(grid), dim3(NTHR), LDS_BYTES, stream, a);
    } else {
        for (int p = 0; p < N_PHASES; ++p) { a.ph_lo = p; a.ph_hi = p + 1; hipLaunchKernelGGL(fwd, dim3(grid), dim3(NTHR), LDS_BYTES, stream, a); }
    }
}
```

```cpp
#include <hip/hip_runtime.h>
#include <cstdio>
#include <cstdint>

#ifndef N_LAUNCH_MODE
#define N_LAUNCH_MODE 1
#endif

#define GAS __attribute__((address_space(1)))
#define LAS __attribute__((address_space(3)))
typedef unsigned short bf16;
typedef float f32x4 __attribute__((ext_vector_type(4)));
typedef unsigned u32x4 __attribute__((ext_vector_type(4)));
typedef unsigned u32x2 __attribute__((ext_vector_type(2)));

constexpr int BATCH = 8, SEQ = 4096, DM = 1024, T = BATCH * SEQ, DEPTH = 2;
constexpr int D_SSM = 512, NGRP = 32, SGRP = 16, SST = 64;
constexpr int D_IN = 1816, ZP = 2048;
constexpr int ZC_U = 0, ZC_Q = 512, ZC_KV = 1024, ZC_G = 1792;
constexpr int NCMP = 255, NCMPP = 256;
constexpr float EPS = 1e-6f;
constexpr int NWAVES = 8, NTHR = 512;
constexpr float QSCALE = 0.125f * 1.4426950408889634f;

constexpr size_t MiB = 1u << 20;
constexpr size_t WS_CTL = 0, CTL_ZERO_BYTES = 1 * MiB;
constexpr size_t WS_KC = 1 * MiB, WS_VC = 2 * MiB, WS_ROUTE = 3 * MiB;
constexpr size_t WS_HN = 16 * MiB;
constexpr size_t WS_Z = 80 * MiB;
constexpr size_t WS_YC = 208 * MiB;
constexpr size_t WS_G1 = 272 * MiB;
constexpr size_t WS_WIN = 304 * MiB;
constexpr size_t WS_WGLU = 312 * MiB;
constexpr size_t WS_WOUT = 314 * MiB;
constexpr size_t WS_WGU = 318 * MiB;
constexpr size_t WS_WDN = 382 * MiB;
constexpr size_t WS_LIST = 414 * MiB;
constexpr size_t WS_LISTW = 418 * MiB;
constexpr size_t WS_HID = 422 * MiB;
constexpr size_t WS_P2 = WS_Z;
constexpr size_t WS_USSM = WS_YC;
constexpr size_t WS_XL = WS_HID;
constexpr size_t WS_BT1 = 458 * MiB;
constexpr size_t WS_BT2 = 466 * MiB;
constexpr size_t WS_W1T = 478 * MiB;
constexpr size_t WS_HIDC = 4 * MiB;
constexpr size_t WS_CBIAS = 5 * MiB;
constexpr size_t WS_END = 482 * MiB;
constexpr int LCAP = 32768, CW_CNT = 8192;
constexpr int CW_BAR = 4096;

constexpr int LDS_BYTES = 163840;
constexpr int ETAB_OFF = LDS_BYTES - 1024, MISC_OFF = LDS_BYTES - 512;

__device__ __forceinline__ float bf2f(bf16 v) { return __uint_as_float(((unsigned)v) << 16); }
__device__ __forceinline__ unsigned f2bf(float f) { unsigned u = __float_as_uint(f); return (u + 0x7fffu + ((u >> 16) & 1u)) >> 16; }
__device__ __forceinline__ unsigned pk2(float lo, float hi) { return f2bf(lo) | (f2bf(hi) << 16); }
__device__ __forceinline__ float wave_sum(float v, int lane) {
#pragma unroll
    for (int o = 1; o < 64; o <<= 1) v += __int_as_float(__builtin_amdgcn_ds_bpermute((lane ^ o) << 2, __float_as_int(v)));
    return v;
}
__device__ __forceinline__ float wave_max(float v, int lane) {
#pragma unroll
    for (int o = 1; o < 64; o <<= 1) v = fmaxf(v, __int_as_float(__builtin_amdgcn_ds_bpermute((lane ^ o) << 2, __float_as_int(v))));
    return v;
}
__device__ __forceinline__ float lane_bcast(float v, int src) { return __int_as_float(__builtin_amdgcn_ds_bpermute(src << 2, __float_as_int(v))); }
__device__ __forceinline__ float gelu_tanh(float x) {
    const float u = 0.7978845608028654f * (x + 0.044715f * x * x * x);
    return 0.5f * x * (1.0f + tanhf(u));
}
__device__ __forceinline__ float sigmoidf_(float x) { return 1.0f / (1.0f + __expf(-x)); }
__device__ __forceinline__ int t5_bucket(int n) {
    if (n < 16) return n < 0 ? 0 : n;
    int b = 16;
    b += (n >= 19); b += (n >= 21); b += (n >= 24); b += (n >= 27); b += (n >= 31); b += (n >= 35); b += (n >= 40); b += (n >= 46);
    b += (n >= 52); b += (n >= 59); b += (n >= 67); b += (n >= 77); b += (n >= 87); b += (n >= 99); b += (n >= 113);
    return b;
}

#define XB_TMO      128
#define XB_XCNT(j)  (256  + 64 * (j))
#define XB_XSUB(j)  (1280 + 64 * (j))
#define XB_XGEN(j)  (2304 + 64 * (j))
#define XB_TOP      3328
#define XB_TOPGEN   3392
#define XCD_BAR_WORDS 3456
#define XB_SPIN_CAP (1u << 22)

__device__ __forceinline__ unsigned xb_ld(unsigned* p)              { return __hip_atomic_load(p, __ATOMIC_RELAXED, __HIP_MEMORY_SCOPE_AGENT); }
__device__ __forceinline__ unsigned xb_add(unsigned* p, unsigned v) { return __hip_atomic_fetch_add(p, v, __ATOMIC_RELAXED, __HIP_MEMORY_SCOPE_AGENT); }
__device__ __forceinline__ unsigned xb_xcc_id() { return (unsigned)__builtin_amdgcn_s_getreg((3 << 11) | 20) & 0xFu; }
#define XB_SPIN(cond, bar) do { unsigned _sp = 0; while (cond) { __builtin_amdgcn_s_sleep(1); \
    if ((++_sp & 255u) == 0u) { if (xb_ld(&(bar)[XB_TMO])) break; if (_sp > XB_SPIN_CAP) { atomicAdd(&(bar)[XB_TMO], 1u); break; } } } } while (0)

struct XcdBarrier { unsigned* bar; unsigned x; volatile LAS unsigned* st; };

__device__ __forceinline__ XcdBarrier xcd_barrier_post(unsigned* bar, volatile LAS unsigned* st) {
    XcdBarrier b; b.bar = bar; b.x = xb_xcc_id(); b.st = st;
    if (threadIdx.x == 0) (void)xb_add(&bar[XB_XCNT(b.x)], 1u);
    return b;
}
__device__ __forceinline__ void xcd_barrier_complete(unsigned* bar, unsigned x, unsigned& nloc, unsigned& nx) {
    const unsigned G = gridDim.x * gridDim.y * gridDim.z;
    unsigned sum, cnt, mine, sp = 0u;
    for (;;) {
        sum = 0u; cnt = 0u; mine = 0u;
#pragma unroll
        for (unsigned j = 0; j < 16; ++j) { const unsigned c = xb_ld(&bar[XB_XCNT(j)]); sum += c; cnt += (c > 0u) ? 1u : 0u; mine = (j == x) ? c : mine; }
        if (sum == G) break;
        __builtin_amdgcn_s_sleep(1);
        if ((++sp & 255u) == 0u) { if (xb_ld(&bar[XB_TMO])) break; if (sp > XB_SPIN_CAP) { atomicAdd(&bar[XB_TMO], 1u); break; } }
    }
    nloc = mine > 0u ? mine : 1u; nx = cnt > 0u ? cnt : 1u;
}
__device__ __forceinline__ void xcd_barrier(const XcdBarrier& b, const int tid) {
    asm volatile("s_waitcnt vmcnt(0)" ::: "memory");
    __syncthreads();
    if (tid == 0) {
        unsigned* bar = b.bar;
        __builtin_amdgcn_s_waitcnt(0);
        unsigned nloc = b.st[0], nx = b.st[1];
        if (nloc == 0u) { xcd_barrier_complete(bar, b.x, nloc, nx); b.st[0] = nloc; b.st[1] = nx; }
        const unsigned old = xb_add(&bar[XB_XSUB(b.x)], 1u);
        const unsigned gen = old / nloc;
        if (old + 1u == (gen + 1u) * nloc) {
            __builtin_amdgcn_fence(__ATOMIC_RELEASE, "agent");
            asm volatile("s_waitcnt vmcnt(0)" ::: "memory");
            const unsigned og = xb_add(&bar[XB_TOP], 1u);
            const unsigned tg = og / nx;
            if (og + 1u == (tg + 1u) * nx) xb_add(&bar[XB_TOPGEN], 1u);
            else XB_SPIN(xb_ld(&bar[XB_TOPGEN]) == tg, bar);
            __builtin_amdgcn_fence(__ATOMIC_ACQUIRE, "agent");
            xb_add(&bar[XB_XGEN(b.x)], 1u);
            asm volatile("s_waitcnt vmcnt(0)" ::: "memory");
        } else {
            XB_SPIN(xb_ld(&bar[XB_XGEN(b.x)]) == gen, bar);
            __builtin_amdgcn_fence(__ATOMIC_ACQUIRE, "agent");
            asm volatile("s_waitcnt vmcnt(0)" ::: "memory");
        }
    }
    __syncthreads();
}

namespace pg8 {
#define PG8_LAS __attribute__((address_space(3)))
typedef unsigned short bf16_t;
typedef short bf16x8 __attribute__((ext_vector_type(8)));
typedef float f32x4 __attribute__((ext_vector_type(4)));
typedef unsigned u32x4 __attribute__((ext_vector_type(4)));
constexpr int BM = 256, BK = 64, HALF = 128, HTB = HALF * BK * 2  , STAGE_BYTES = 8 * HTB, NXCD = 8, WGM = 8;

__host__ __device__ __forceinline__ int lds_byte(int r, int c) { const int st = (r >> 4) * 2 + (c >> 5), rr = r & 15, cc = c & 31, ob = rr * 64 + cc * 2; return st * 1024 + (ob ^ (((ob >> 9) & 1) << 5)); }
__host__ __device__ __forceinline__ void stage_rc(int b, int& R, int& C) { const int st = b / 1024, sb = b % 1024, swz = sb ^ (((sb >> 9) & 1) << 5); R = (st >> 1) * 16 + swz / 64; C = (st & 1) * 32 + (swz % 64) / 2; }
__host__ __device__ __forceinline__ int perm32(int rho) { const int n = rho >> 4, i = rho & 15; return 8 * (i >> 2) + 4 * n + (i & 3); }

struct Unit { int pm, pn, eb, p0, cnt; };
struct Gemm { const bf16_t* A; const bf16_t* Bt; int M, N, K; int lda; size_t bstride; const unsigned* list; int cap; size_t astride; int kstepA; };

struct StaticOrder {
    int nM, nN, nwg, G, c;
    __host__ __device__ void init(int M, int N, int G_, int c_) { nM = M / BM; nN = N / BM; nwg = nM * nN; G = G_; c = c_; }
    __host__ __device__ bool next(int i, Unit& u) const {
        const long L = (long)i * G + c; if (L >= nwg) return false;
        int wgid = (int)L; { const int q = nwg / NXCD, r = nwg % NXCD, xcd = wgid % NXCD, off = wgid / NXCD; wgid = (xcd < r ? xcd * (q + 1) : r * (q + 1) + (xcd - r) * q) + off; }
        const int nig = WGM * nN, gid = wgid / nig, fm = gid * WGM, gsz = (nM - fm) < WGM ? (nM - fm) : WGM;
        u.pm = fm + ((wgid % nig) % gsz); u.pn = (wgid % nig) / gsz; u.eb = 0; u.p0 = 0; u.cnt = 0; return true;
    }
    __device__ __forceinline__ void a_ready(const Unit&) const {}
    __device__ __forceinline__ void done(const Unit&) const {}
};

__device__ __forceinline__ unsigned cvt_pk_bf16(float lo, float hi) { unsigned r; asm volatile("v_cvt_pk_bf16_f32 %0, %1, %2" : "=v"(r) : "v"(lo), "v"(hi)); return r; }
typedef float f32x2 __attribute__((ext_vector_type(2)));
__device__ __forceinline__ f32x2 gelu_pk(f32x2 v) {
    const f32x2 av = __builtin_elementwise_abs(v), d = av * 0.2316418882f + 1.0f;
    f32x2 t; t.x = __builtin_amdgcn_rcpf(d.x); t.y = __builtin_amdgcn_rcpf(d.y);
    f32x2 q = t * 0.5307027145f + (-0.7265760135f); q = q * t + 0.7107068705f; q = q * t + (-0.142248368f); q = q * t + 0.127414796f; q = q * t;
    const f32x2 s = (v * v) * (-0.72134752044f);
    f32x2 e; e.x = __builtin_amdgcn_exp2f(s.x); e.y = __builtin_amdgcn_exp2f(s.y);
    const f32x2 m = v * (q * e), r = v - m;
    f32x2 o; o.x = v.x < 0.f ? m.x : r.x; o.y = v.y < 0.f ? m.y : r.y; return o;
}

template <int ACT  > struct EpiBf16 {
    static constexpr bool PERM = true, AFTER_DRAIN = false; static_assert(ACT == 0 || ACT == 1, "EpiBf16: ACT is 0 (none) or 1 (gelu_pk)");
    bf16_t* O; int ldc; const float* bias; int split_cols; size_t split_stride; float scale0;
    __device__ __forceinline__ void operator()(const f32x4 (&acc)[2][2][4][2], const Unit& u, int wr, int wc, int fr, int fq) const {
        const int row0 = u.pm * BM + wr * 64 + fr; int colt = u.pn * BM; bf16_t* base = O;
        float sc = 1.f; if (split_cols) { const int t = colt / split_cols; base += (size_t)t * split_stride; colt -= t * split_cols; if (t == 0) sc = scale0; }
        const int col0 = colt + wc * 32 + 8 * fq, bcol0 = u.pn * BM + wc * 32 + 8 * fq;
        f32x4 bv[2][2];
#pragma unroll
        for (int bj = 0; bj < 2; ++bj)
#pragma unroll
            for (int n = 0; n < 2; ++n) bv[bj][n] = bias ? *(const f32x4*)(bias + bcol0 + bj * HALF + 4 * n) : (f32x4){0.f, 0.f, 0.f, 0.f};
#pragma unroll
        for (int ai = 0; ai < 2; ++ai)
#pragma unroll
            for (int m = 0; m < 4; ++m) { bf16_t* rowp = base + (size_t)(row0 + ai * HALF + m * 16) * ldc + col0;
#pragma unroll
                for (int bj = 0; bj < 2; ++bj) { f32x4 v0 = acc[ai][bj][m][0] + bv[bj][0], v1 = acc[ai][bj][m][1] + bv[bj][1];
                    if (ACT == 1) { f32x2 a = gelu_pk((f32x2){v0[0], v0[1]}), b = gelu_pk((f32x2){v0[2], v0[3]}), c = gelu_pk((f32x2){v1[0], v1[1]}), d = gelu_pk((f32x2){v1[2], v1[3]});
                        v0 = (f32x4){a.x, a.y, b.x, b.y}; v1 = (f32x4){c.x, c.y, d.x, d.y}; }
                    v0 = v0 * sc; v1 = v1 * sc; u32x4 w; w.x = cvt_pk_bf16(v0[0], v0[1]); w.y = cvt_pk_bf16(v0[2], v0[3]); w.z = cvt_pk_bf16(v1[0], v1[1]); w.w = cvt_pk_bf16(v1[2], v1[3]);
                    *(u32x4*)(rowp + bj * HALF) = w; } }
    }
};
template <class Epi, class Sched, bool ALIGN_EPI = false, bool SP2 = false>
__device__ __forceinline__ void gemm_phase(PG8_LAS unsigned char* lds, const Gemm g, const Sched& S, const Epi& E) {
    int tid_ = threadIdx.x; asm volatile("" : "+v"(tid_));
    const int tid = tid_, wid = __builtin_amdgcn_readfirstlane(tid >> 6), lane = tid & 63, wr = wid >> 2, wc = wid & 3, fr = lane & 15, fq = lane >> 4;
    const int K = g.K, nt = K / BK;
    unsigned voffA[2], voffB[2];
#pragma unroll
    for (int i = 0; i < 2; ++i) { int R, C; stage_rc(tid * 16 + i * 8192, R, C); const int Rb = Epi::PERM ? ((R & ~31) + perm32(R & 31)) : R;
        voffA[i] = (unsigned)(R * K + C) * 2u; voffB[i] = (unsigned)(Rb * K + C) * 2u; }
    const size_t kstep = (size_t)(BK * 2);
    const size_t hstep = (size_t)HALF * K * 2;
    const size_t tstep = 2 * hstep;
    const unsigned ldsw = (unsigned)wid * 1024u;
    const int aoff = lds_byte(wr * 64 + fr, fq * 8), boff = lds_byte(wc * 32 + fr, fq * 8);
#define PG8_SA(b, h) (((b) * 2 + (h)) * HTB)
#define PG8_SB(b, h) ((4 + (b) * 2 + (h)) * HTB)
#define PG8_STAGE(bufoff, gbase, voff) do { _Pragma("unroll") for (int _i = 0; _i < 2; ++_i) \
        __builtin_amdgcn_global_load_lds((const unsigned*)((const char*)(gbase) + (voff)[_i]), (PG8_LAS unsigned*)(lds + (bufoff) + ldsw + _i * 8192), 16, 0, 0); } while (0)
#define PG8_LDA(dst, b, h) do { _Pragma("unroll") for (int m = 0; m < 4; ++m) _Pragma("unroll") for (int k = 0; k < 2; ++k) dst[m][k] = *(const PG8_LAS bf16x8*)(lds + PG8_SA(b, h) + aoff + m * 2048 + k * 1024); } while (0)
#define PG8_LDB(dst, b, h) do { _Pragma("unroll") for (int n = 0; n < 2; ++n) _Pragma("unroll") for (int k = 0; k < 2; ++k) dst[n][k] = *(const PG8_LAS bf16x8*)(lds + PG8_SB(b, h) + boff + n * 2048 + k * 1024); } while (0)
#define PG8_MMA(ai, bj, At, Bt) do { __builtin_amdgcn_s_setprio(1); _Pragma("unroll") for (int m = 0; m < 4; ++m) _Pragma("unroll") for (int n = 0; n < 2; ++n) _Pragma("unroll") for (int k = 0; k < 2; ++k) \
        acc[ai][bj][m][n] = __builtin_amdgcn_mfma_f32_16x16x32_bf16(Bt[n][k], At[m][k], acc[ai][bj][m][n], 0, 0, 0); __builtin_amdgcn_s_setprio(0); } while (0)
#define PG8_WAIT_V(n) asm volatile("s_waitcnt vmcnt(" #n ")" ::: "memory")
#define PG8_WAIT_L(n) asm volatile("s_waitcnt lgkmcnt(" #n ")" ::: "memory")
#define PG8_BAR __builtin_amdgcn_s_barrier()
#define PG8_SCHED __builtin_amdgcn_sched_barrier(0)
    Unit cur, nxt; int ui = 0;
    if (!S.next(0, cur)) return;
    f32x4 acc[2][2][4][2];
#pragma unroll
    for (int a = 0; a < 2; ++a)
#pragma unroll
        for (int b = 0; b < 2; ++b)
#pragma unroll
            for (int m = 0; m < 4; ++m)
#pragma unroll
                for (int n = 0; n < 2; ++n) acc[a][b][m][n] = (f32x4){0.f, 0.f, 0.f, 0.f};
    bf16x8 At[4][2], B0[2][2], B1[2][2];
    const char* cA = (const char*)g.A + (size_t)cur.pm * tstep; const char* cB = (const char*)g.Bt + (size_t)cur.pn * tstep;
    S.a_ready(cur);
    if constexpr (SP2) {
        PG8_STAGE(PG8_SB(0, 0), cB, voffB); PG8_STAGE(PG8_SB(0, 1), cB + hstep, voffB); PG8_STAGE(PG8_SA(0, 0), cA, voffA); PG8_STAGE(PG8_SA(0, 1), cA + hstep, voffA);
        if (wr == 1) PG8_BAR;
        PG8_WAIT_V(2); PG8_BAR;
        PG8_STAGE(PG8_SB(1, 0), cB + kstep, voffB); PG8_STAGE(PG8_SA(1, 0), cA + kstep, voffA); PG8_STAGE(PG8_SB(1, 1), cB + hstep + kstep, voffB);
        PG8_WAIT_V(6); PG8_BAR;
    } else {
        PG8_STAGE(PG8_SB(0, 0), cB, voffB); PG8_STAGE(PG8_SA(0, 0), cA, voffA); PG8_STAGE(PG8_SB(0, 1), cB + hstep, voffB); PG8_STAGE(PG8_SA(0, 1), cA + hstep, voffA);
        if (wr == 1) PG8_BAR;
        PG8_WAIT_V(4); PG8_BAR;
        PG8_STAGE(PG8_SB(1, 0), cB + kstep, voffB); PG8_STAGE(PG8_SA(1, 0), cA + kstep, voffA); PG8_STAGE(PG8_SB(1, 1), cB + hstep + kstep, voffB);
        PG8_WAIT_V(6); PG8_BAR;
    }
    for (;;) {
        const bool has_next = S.next(ui + 1, nxt);
        const char* nA = has_next ? (const char*)g.A + (size_t)nxt.pm * tstep : cA; const char* nB = has_next ? (const char*)g.Bt + (size_t)nxt.pn * tstep : cB;
        for (int t = 0; t < nt; t += 2) {
            const bool last = (t == nt - 2);
            const char* a1 = cA + (size_t)(t + 1) * kstep;
            const char* a2 = last ? nA : cA + (size_t)(t + 2) * kstep; const char* b2 = last ? nB : cB + (size_t)(t + 2) * kstep;
            const char* a3 = a2 + kstep; const char* b3 = b2 + kstep;
            if (last && has_next) S.a_ready(nxt);
            if constexpr (SP2) {
            PG8_LDB(B0, 0, 0); PG8_LDB(B1, 0, 1); PG8_SCHED; PG8_LDA(At, 0, 0); PG8_STAGE(PG8_SA(1, 1), a1 + hstep, voffA);
            PG8_WAIT_V(8); PG8_WAIT_L(0); PG8_BAR; PG8_MMA(0, 0, At, B0); PG8_MMA(0, 1, At, B1); PG8_BAR; PG8_SCHED;
            PG8_LDA(At, 0, 1); PG8_STAGE(PG8_SB(0, 0), b2, voffB); PG8_STAGE(PG8_SB(0, 1), b2 + hstep, voffB); PG8_STAGE(PG8_SA(0, 0), a2, voffA);
            PG8_WAIT_V(8); PG8_WAIT_L(0); PG8_BAR; PG8_MMA(1, 0, At, B0); PG8_MMA(1, 1, At, B1); PG8_BAR; PG8_SCHED;
            PG8_LDB(B0, 1, 0); PG8_LDB(B1, 1, 1); PG8_SCHED; PG8_LDA(At, 1, 0); PG8_STAGE(PG8_SA(0, 1), a2 + hstep, voffA);
            PG8_WAIT_V(8); PG8_WAIT_L(0); PG8_BAR; PG8_MMA(0, 0, At, B0); PG8_MMA(0, 1, At, B1); PG8_BAR; PG8_SCHED;
            PG8_LDA(At, 1, 1); PG8_STAGE(PG8_SB(1, 0), b3, voffB); PG8_STAGE(PG8_SB(1, 1), b3 + hstep, voffB); PG8_STAGE(PG8_SA(1, 0), a3, voffA);
            PG8_WAIT_V(8); PG8_WAIT_L(0); PG8_BAR; PG8_MMA(1, 0, At, B0); PG8_MMA(1, 1, At, B1); PG8_BAR; PG8_SCHED;
            } else {
            PG8_LDB(B0, 0, 0); PG8_SCHED; PG8_LDA(At, 0, 0); PG8_STAGE(PG8_SA(1, 1), a1 + hstep, voffA);
            PG8_WAIT_L(8); PG8_BAR; PG8_WAIT_L(0); PG8_MMA(0, 0, At, B0); PG8_BAR; PG8_SCHED;
            PG8_LDB(B1, 0, 1); PG8_STAGE(PG8_SB(0, 0), b2, voffB);
            PG8_BAR; PG8_WAIT_L(0); PG8_MMA(0, 1, At, B1); PG8_BAR;
            PG8_LDA(At, 0, 1); PG8_STAGE(PG8_SA(0, 0), a2, voffA);
            PG8_BAR; PG8_WAIT_L(0); PG8_MMA(1, 0, At, B0); PG8_BAR; PG8_SCHED;
            PG8_STAGE(PG8_SB(0, 1), b2 + hstep, voffB);
            PG8_WAIT_V(6); PG8_BAR; PG8_MMA(1, 1, At, B1); PG8_BAR;
            PG8_LDB(B0, 1, 0); PG8_SCHED; PG8_LDA(At, 1, 0); PG8_STAGE(PG8_SA(0, 1), a2 + hstep, voffA);
            PG8_WAIT_L(8); PG8_BAR; PG8_WAIT_L(0); PG8_MMA(0, 0, At, B0); PG8_BAR; PG8_SCHED;
            PG8_LDB(B1, 1, 1); PG8_STAGE(PG8_SB(1, 0), b3, voffB);
            PG8_BAR; PG8_WAIT_L(0); PG8_MMA(0, 1, At, B1); PG8_BAR;
            PG8_LDA(At, 1, 1); PG8_STAGE(PG8_SA(1, 0), a3, voffA);
            PG8_BAR; PG8_WAIT_L(0); PG8_MMA(1, 0, At, B0); PG8_BAR; PG8_SCHED;
            PG8_STAGE(PG8_SB(1, 1), b3 + hstep, voffB);
            PG8_WAIT_V(6); PG8_BAR; PG8_MMA(1, 1, At, B1); PG8_BAR;
            }
        }
        if constexpr (ALIGN_EPI) { if (wr == 0) PG8_BAR; }
        if constexpr (!Epi::AFTER_DRAIN) { E(acc, cur, wr, wc, fr, fq); S.done(cur); }
        if (!has_next) break;
#pragma unroll
        for (int a = 0; a < 2; ++a)
#pragma unroll
            for (int b = 0; b < 2; ++b)
#pragma unroll
                for (int m = 0; m < 4; ++m)
#pragma unroll
                    for (int n = 0; n < 2; ++n) acc[a][b][m][n] = (f32x4){0.f, 0.f, 0.f, 0.f};
        cur = nxt; cA = nA; cB = nB; ++ui;
        if constexpr (ALIGN_EPI) { if (wr == 1) PG8_BAR; }
    }
    PG8_WAIT_V(0);
    if constexpr (!ALIGN_EPI) { if (wr == 0) PG8_BAR; }
    PG8_BAR;
    if constexpr (Epi::AFTER_DRAIN) { E.fused(acc, cur, wr, wc, fr, fq, lds, wid, lane); S.done(cur); }
#undef PG8_SA
#undef PG8_SB
#undef PG8_STAGE
#undef PG8_LDA
#undef PG8_LDB
#undef PG8_MMA
#undef PG8_WAIT_V
#undef PG8_WAIT_L
#undef PG8_BAR
#undef PG8_SCHED
}

__device__ __forceinline__ float sigm(float x) { return 1.0f / (1.0f + __expf(-x)); }
struct EpiGlu {
    static constexpr bool PERM = true, AFTER_DRAIN = false;
    bf16_t* O; int ldc;
    __device__ __forceinline__ void operator()(const f32x4 (&acc)[2][2][4][2], const Unit& u, int wr, int wc, int fr, int fq) const {
        const int row0 = u.pm * BM + wr * 64 + fr, col0 = u.pn * HALF + wc * 32 + 8 * fq;
#pragma unroll
        for (int ai = 0; ai < 2; ++ai)
#pragma unroll
            for (int m = 0; m < 4; ++m) {
                bf16_t* rowp = O + (size_t)(row0 + ai * HALF + m * 16) * ldc + col0;
                const f32x4 a0 = acc[ai][0][m][0], a1 = acc[ai][0][m][1], b0 = acc[ai][1][m][0], b1 = acc[ai][1][m][1];
                u32x4 w;
                w.x = cvt_pk_bf16(a0[0] * sigm(b0[0]), a0[1] * sigm(b0[1])); w.y = cvt_pk_bf16(a0[2] * sigm(b0[2]), a0[3] * sigm(b0[3]));
                w.z = cvt_pk_bf16(a1[0] * sigm(b1[0]), a1[1] * sigm(b1[1])); w.w = cvt_pk_bf16(a1[2] * sigm(b1[2]), a1[3] * sigm(b1[3]));
                *(u32x4*)rowp = w;
            }
    }
};
struct EpiResid {
    static constexpr bool PERM = false, AFTER_DRAIN = false;
    const float* X; float* O; int ldc;
    __device__ __forceinline__ void operator()(const f32x4 (&acc)[2][2][4][2], const Unit& u, int wr, int wc, int fr, int fq) const {
        const int row0 = u.pm * BM + wr * 64 + fr, col0 = u.pn * BM + wc * 32 + 4 * fq;
#pragma unroll
        for (int ai = 0; ai < 2; ++ai)
#pragma unroll
            for (int m = 0; m < 4; ++m) {
                const size_t off = (size_t)(row0 + ai * HALF + m * 16) * ldc + col0;
#pragma unroll
                for (int bj = 0; bj < 2; ++bj)
#pragma unroll
                    for (int n = 0; n < 2; ++n) *(f32x4*)(O + off + bj * HALF + n * 16) = *(const f32x4*)(X + off + bj * HALF + n * 16) + acc[ai][bj][m][n];
            }
    }
};

struct ADense { static constexpr bool GATHER = false; __device__ __forceinline__ static unsigned rowoff(const Gemm&, const Unit&, int) { return 0u; } };
struct AList { static constexpr bool GATHER = true;
    __device__ __forceinline__ static unsigned rowoff(const Gemm& g, const Unit& u, int r) { const int pos = u.p0 + r; const unsigned tok = pos < u.cnt ? (g.list[(size_t)u.eb * g.cap + pos] >> 1) : 0u; return tok * (unsigned)g.lda * 2u; } };
struct ACompress { static constexpr bool GATHER = true;
    __device__ __forceinline__ static unsigned rowoff(const Gemm&, const Unit& u, int r) { const unsigned rg = (unsigned)(u.pm * BM + r), b = rg >> 9, n = (rg >> 1) & 255u, hkv = rg & 1u;
        return (((b * 4096u + 16u * n) * 2048u) + 1024u + (unsigned)u.eb * 128u + hkv * 64u) * 2u; } };
template <class Epi, class Sched, class AMap>
__device__ __forceinline__ void gemm2(PG8_LAS unsigned char* lds, const Gemm g, const Sched& S, const Epi& E, const int tid) {
    constexpr bool GATHER = AMap::GATHER;
    int K_ = g.K; asm volatile("" : "+s"(K_));
    const int wid = __builtin_amdgcn_readfirstlane(tid >> 6), lane = tid & 63, wr = wid >> 2, wc = wid & 3, fr = lane & 15, fq = lane >> 4;
    const int K = K_, nt = K / BK, lda = g.lda;
    unsigned voffA[2], voffB[2]; int Rst[2], Cst[2];
#pragma unroll
    for (int i = 0; i < 2; ++i) { int R, C; stage_rc(tid * 16 + i * 8192, R, C); const int Rb = Epi::PERM ? ((R & ~31) + perm32(R & 31)) : R;
        voffA[i] = (unsigned)(R * lda + C) * 2u; voffB[i] = (unsigned)(Rb * K + C) * 2u; Rst[i] = R; Cst[i] = C; }
    const size_t kstep = (size_t)(BK * 2), kstepA = (size_t)g.kstepA;
    const size_t hstepA = (size_t)HALF * lda * 2, tstepA = 2 * hstepA, hstepB = (size_t)HALF * K * 2, tstepB = 2 * hstepB;
    const unsigned ldsw = (unsigned)wid * 1024u;
    const int aoff = lds_byte(wr * 64 + fr, fq * 8), boff = lds_byte(wc * 32 + fr, fq * 8);
#define PG8_SA(b, h) (((b) * 2 + (h)) * HTB)
#define PG8_SB(b, h) ((4 + (b) * 2 + (h)) * HTB)
#define PG8_STAGE(bufoff, gbase, voff) do { _Pragma("unroll") for (int _i = 0; _i < 2; ++_i) \
        __builtin_amdgcn_global_load_lds((const unsigned*)((const char*)(gbase) + (voff)[_i]), (PG8_LAS unsigned*)(lds + (bufoff) + ldsw + _i * 8192), 16, 0, 0); } while (0)
#define PG8_STAGE_A(bufoff, gbase, h) do { if constexpr (GATHER) { PG8_STAGE(bufoff, gbase, vg[h]); } else { PG8_STAGE(bufoff, (gbase) + (h) * hstepA, voffA); } } while (0)
#define PG8_GOFFS(u, dst) do { _Pragma("unroll") for (int _h = 0; _h < 2; ++_h) _Pragma("unroll") for (int _i = 0; _i < 2; ++_i) dst[_h][_i] = AMap::rowoff(g, (u), _h * HALF + Rst[_i]) + (unsigned)Cst[_i] * 2u; } while (0)
#define PG8_LDA(dst, b, h) do { _Pragma("unroll") for (int m = 0; m < 4; ++m) _Pragma("unroll") for (int k = 0; k < 2; ++k) dst[m][k] = *(const PG8_LAS bf16x8*)(lds + PG8_SA(b, h) + aoff + m * 2048 + k * 1024); } while (0)
#define PG8_LDB(dst, b, h) do { _Pragma("unroll") for (int n = 0; n < 2; ++n) _Pragma("unroll") for (int k = 0; k < 2; ++k) dst[n][k] = *(const PG8_LAS bf16x8*)(lds + PG8_SB(b, h) + boff + n * 2048 + k * 1024); } while (0)
#define PG8_MMA(ai, bj, At, Bt) do { __builtin_amdgcn_s_setprio(1); _Pragma("unroll") for (int m = 0; m < 4; ++m) _Pragma("unroll") for (int n = 0; n < 2; ++n) _Pragma("unroll") for (int k = 0; k < 2; ++k) \
        acc[ai][bj][m][n] = __builtin_amdgcn_mfma_f32_16x16x32_bf16(Bt[n][k], At[m][k], acc[ai][bj][m][n], 0, 0, 0); __builtin_amdgcn_s_setprio(0); } while (0)
#define PG8_WAIT_V(n) asm volatile("s_waitcnt vmcnt(" #n ")" ::: "memory")
#define PG8_WAIT_L(n) asm volatile("s_waitcnt lgkmcnt(" #n ")" ::: "memory")
#define PG8_BAR __builtin_amdgcn_s_barrier()
#define PG8_SCHED __builtin_amdgcn_sched_barrier(0)
    Unit cur, nxt; int ui = 0;
    if (!S.next(0, cur)) return;
    f32x4 acc[2][2][4][2];
#pragma unroll
    for (int a = 0; a < 2; ++a)
#pragma unroll
        for (int b = 0; b < 2; ++b)
#pragma unroll
            for (int m = 0; m < 4; ++m)
#pragma unroll
                for (int n = 0; n < 2; ++n) acc[a][b][m][n] = (f32x4){0.f, 0.f, 0.f, 0.f};
    bf16x8 At[4][2], B0[2][2], B1[2][2];
    unsigned vg[2][2] = {{0u, 0u}, {0u, 0u}};
    if constexpr (GATHER) PG8_GOFFS(cur, vg);
    const char* cA = (const char*)g.A + (GATHER ? (size_t)0 : (size_t)cur.pm * tstepA + (size_t)cur.eb * g.astride * 2);
    const char* cB = (const char*)g.Bt + ((size_t)cur.eb * g.bstride) * 2 + (size_t)cur.pn * tstepB;
    S.a_ready(cur);
    PG8_STAGE(PG8_SB(0, 0), cB, voffB); PG8_STAGE(PG8_SB(0, 1), cB + hstepB, voffB); PG8_STAGE_A(PG8_SA(0, 0), cA, 0); PG8_STAGE_A(PG8_SA(0, 1), cA, 1);
    if (wr == 1) PG8_BAR;
    PG8_WAIT_V(2); PG8_BAR;
    PG8_STAGE(PG8_SB(1, 0), cB + kstep, voffB); PG8_STAGE_A(PG8_SA(1, 0), cA + kstepA, 0); PG8_STAGE(PG8_SB(1, 1), cB + hstepB + kstep, voffB);
    PG8_WAIT_V(6); PG8_BAR;
    for (;;) {
        const bool has_next = S.next(ui + 1, nxt);
        const char* nA = has_next ? (const char*)g.A + (GATHER ? (size_t)0 : (size_t)nxt.pm * tstepA + (size_t)nxt.eb * g.astride * 2) : cA;
        const char* nB = has_next ? (const char*)g.Bt + ((size_t)nxt.eb * g.bstride) * 2 + (size_t)nxt.pn * tstepB : cB;
        for (int t = 0; t < nt; t += 2) {
            const bool last = (t == nt - 2);
            const char* a1 = cA + (size_t)(t + 1) * kstepA;
            const char* a2 = last ? nA : cA + (size_t)(t + 2) * kstepA; const char* b2 = last ? nB : cB + (size_t)(t + 2) * kstep;
            const char* a3 = a2 + kstepA; const char* b3 = b2 + kstep;
            unsigned vn1[2] = {vg[1][0], vg[1][1]};
            if constexpr (GATHER) { if (last && has_next) { unsigned vn[2][2]; PG8_GOFFS(nxt, vn); vg[0][0] = vn[0][0]; vg[0][1] = vn[0][1]; vn1[0] = vn[1][0]; vn1[1] = vn[1][1]; } }
            if (last && has_next) S.a_ready(nxt);
            PG8_LDB(B0, 0, 0); PG8_LDB(B1, 0, 1); PG8_SCHED; PG8_LDA(At, 0, 0); PG8_STAGE_A(PG8_SA(1, 1), a1, 1);
            PG8_WAIT_V(8); PG8_WAIT_L(0); PG8_BAR; PG8_MMA(0, 0, At, B0); PG8_MMA(0, 1, At, B1); PG8_BAR; PG8_SCHED;
            if constexpr (GATHER) { vg[1][0] = vn1[0]; vg[1][1] = vn1[1]; }
            PG8_LDA(At, 0, 1); PG8_STAGE(PG8_SB(0, 0), b2, voffB); PG8_STAGE(PG8_SB(0, 1), b2 + hstepB, voffB); PG8_STAGE_A(PG8_SA(0, 0), a2, 0);
            PG8_WAIT_V(8); PG8_WAIT_L(0); PG8_BAR; PG8_MMA(1, 0, At, B0); PG8_MMA(1, 1, At, B1); PG8_BAR; PG8_SCHED;
            PG8_LDB(B0, 1, 0); PG8_LDB(B1, 1, 1); PG8_SCHED; PG8_LDA(At, 1, 0); PG8_STAGE_A(PG8_SA(0, 1), a2, 1);
            PG8_WAIT_V(8); PG8_WAIT_L(0); PG8_BAR; PG8_MMA(0, 0, At, B0); PG8_MMA(0, 1, At, B1); PG8_BAR; PG8_SCHED;
            PG8_LDA(At, 1, 1); PG8_STAGE(PG8_SB(1, 0), b3, voffB); PG8_STAGE(PG8_SB(1, 1), b3 + hstepB, voffB); PG8_STAGE_A(PG8_SA(1, 0), a3, 0);
            PG8_WAIT_V(8); PG8_WAIT_L(0); PG8_BAR; PG8_MMA(1, 0, At, B0); PG8_MMA(1, 1, At, B1); PG8_BAR; PG8_SCHED;
        }
        if (wr == 0) PG8_BAR;
        E(acc, cur, wr, wc, fr, fq); S.done(cur);
        if (!has_next) break;
#pragma unroll
        for (int a = 0; a < 2; ++a)
#pragma unroll
            for (int b = 0; b < 2; ++b)
#pragma unroll
                for (int m = 0; m < 4; ++m)
#pragma unroll
                    for (int n = 0; n < 2; ++n) acc[a][b][m][n] = (f32x4){0.f, 0.f, 0.f, 0.f};
        cur = nxt; cA = nA; cB = nB; ++ui;
        if (wr == 1) PG8_BAR;
    }
    PG8_WAIT_V(0);
    PG8_BAR;
#undef PG8_SA
#undef PG8_SB
#undef PG8_STAGE
#undef PG8_STAGE_A
#undef PG8_GOFFS
#undef PG8_LDA
#undef PG8_LDB
#undef PG8_MMA
#undef PG8_WAIT_V
#undef PG8_WAIT_L
#undef PG8_BAR
#undef PG8_SCHED
}

struct ExpertOrder {
    const PG8_LAS int* tab; int nN, G, c;
    __device__ __forceinline__ bool next(int i, Unit& u) const {
        const int total = tab[32] * nN; const long L = (long)i * G + c; if (L >= total) return false;
        const int rt = (int)L / nN, pn = (int)L % nN; int e = 0;
#pragma unroll
        for (int k = 1; k < 32; ++k) e += (rt >= tab[k]) ? 1 : 0;
        u.pm = __builtin_amdgcn_readfirstlane(rt); u.pn = __builtin_amdgcn_readfirstlane(pn); u.eb = __builtin_amdgcn_readfirstlane(e);
        u.p0 = __builtin_amdgcn_readfirstlane((rt - tab[e]) * BM); u.cnt = __builtin_amdgcn_readfirstlane(tab[33 + e]); return true;
    }
    __device__ __forceinline__ void a_ready(const Unit&) const {}
    __device__ __forceinline__ void done(const Unit&) const {}
};
struct EpiGateUp {
    static constexpr bool PERM = true, AFTER_DRAIN = false;
    bf16_t* H; const float* listw; int cap;
    __device__ __forceinline__ void operator()(const f32x4 (&acc)[2][2][4][2], const Unit& u, int wr, int wc, int fr, int fq) const {
        const int rl0 = wr * 64 + fr, col0 = u.pn * HALF + wc * 32 + 8 * fq;
#pragma unroll
        for (int ai = 0; ai < 2; ++ai)
#pragma unroll
            for (int m = 0; m < 4; ++m) {
                const int rl = rl0 + ai * HALF + m * 16, pos = u.p0 + rl;
                const float w = pos < u.cnt ? listw[(size_t)u.eb * cap + pos] : 0.f;
                bf16_t* rowp = H + (size_t)(u.pm * BM + rl) * 256 + col0;
                const f32x4 g0 = acc[ai][0][m][0], g1 = acc[ai][0][m][1], u0 = acc[ai][1][m][0], u1 = acc[ai][1][m][1];
                u32x4 o;
                o.x = cvt_pk_bf16(g0[0] * sigm(g0[0]) * u0[0] * w, g0[1] * sigm(g0[1]) * u0[1] * w); o.y = cvt_pk_bf16(g0[2] * sigm(g0[2]) * u0[2] * w, g0[3] * sigm(g0[3]) * u0[3] * w);
                o.z = cvt_pk_bf16(g1[0] * sigm(g1[0]) * u1[0] * w, g1[1] * sigm(g1[1]) * u1[1] * w); o.w = cvt_pk_bf16(g1[2] * sigm(g1[2]) * u1[2] * w, g1[3] * sigm(g1[3]) * u1[3] * w);
                *(u32x4*)rowp = o;
            }
    }
};
struct EpiDown {
    static constexpr bool PERM = true, AFTER_DRAIN = false;
    bf16_t* P1; long d12; const unsigned* list; int cap;
    __device__ __forceinline__ void operator()(const f32x4 (&acc)[2][2][4][2], const Unit& u, int wr, int wc, int fr, int fq) const {
        const int rl0 = wr * 64 + fr, col0 = u.pn * BM + wc * 32 + 8 * fq;
#pragma unroll
        for (int ai = 0; ai < 2; ++ai) {
            unsigned ent[4];
#pragma unroll
            for (int m = 0; m < 4; ++m) { const int pos = u.p0 + rl0 + ai * HALF + m * 16; ent[m] = pos < u.cnt ? list[(size_t)u.eb * cap + pos] : 0xffffffffu; }
#pragma unroll
            for (int m = 0; m < 4; ++m) {
                if (ent[m] != 0xffffffffu) {
                    bf16_t* dst = P1 + (long)(ent[m] & 1u) * d12 + (size_t)(ent[m] >> 1) * 1024 + col0;
#pragma unroll
                    for (int bj = 0; bj < 2; ++bj) { const f32x4 v0 = acc[ai][bj][m][0], v1 = acc[ai][bj][m][1];
                        u32x4 w; w.x = cvt_pk_bf16(v0[0], v0[1]); w.y = cvt_pk_bf16(v0[2], v0[3]); w.z = cvt_pk_bf16(v1[0], v1[1]); w.w = cvt_pk_bf16(v1[2], v1[3]);
                        *(u32x4*)(dst + bj * HALF) = w; }
                }
            }
            asm volatile("" ::: "memory");
        }
    }
};

struct BatchOrder {
    int nb, nM, nN, G, c;
    __device__ __forceinline__ bool next(int i, Unit& u) const {
        const long L = (long)i * G + c; if (L >= (long)nb * nM * nN) return false;
        const int per = nM * nN, e = (int)L / per, rem = (int)L % per;
        u.eb = e; u.pm = rem / nN; u.pn = rem % nN; u.p0 = 0; u.cnt = 0; return true;
    }
    __device__ __forceinline__ void a_ready(const Unit&) const {}
    __device__ __forceinline__ void done(const Unit&) const {}
};
struct EpiInProj {
    static constexpr bool PERM = true, AFTER_DRAIN = false;
    bf16_t* Zo; bf16_t* U;
    __device__ __forceinline__ void operator()(const f32x4 (&acc)[2][2][4][2], const Unit& u, int wr, int wc, int fr, int fq) const {
        const int row0 = u.pm * BM + wr * 64 + fr;
#pragma unroll
        for (int ai = 0; ai < 2; ++ai)
#pragma unroll
            for (int m = 0; m < 4; ++m) { const int row = row0 + ai * HALF + m * 16;
#pragma unroll
                for (int bj = 0; bj < 2; ++bj) { const int c0 = u.pn * BM + bj * HALF + wc * 32 + 8 * fq;
                    const f32x4 v0 = acc[ai][bj][m][0], v1 = acc[ai][bj][m][1];
                    u32x4 w; w.x = cvt_pk_bf16(v0[0], v0[1]); w.y = cvt_pk_bf16(v0[2], v0[3]); w.z = cvt_pk_bf16(v1[0], v1[1]); w.w = cvt_pk_bf16(v1[2], v1[3]);
                    bf16_t* dst = u.pn < 2 ? U + ((size_t)((c0 >> 4) * 2048 + (row >> 4)) * 512 + (row & 15) * 16 + (c0 & 15)) : Zo + (size_t)row * 2048 + c0;
                    *(u32x4*)dst = w; } }
    }
};
struct EpiXloc {
    static constexpr bool PERM = false, AFTER_DRAIN = false;
    float* XL;
    __device__ __forceinline__ void operator()(const f32x4 (&acc)[2][2][4][2], const Unit& u, int wr, int wc, int fr, int fq) const {
        const int row0 = u.pm * BM + wr * 64 + fr, col0 = wc * 32 + 4 * fq;
#pragma unroll
        for (int ai = 0; ai < 2; ++ai)
#pragma unroll
            for (int m = 0; m < 4; ++m) { float* rowp = XL + ((size_t)u.eb * 2048 + row0 + ai * HALF + m * 16) * 128 + col0;
#pragma unroll
                for (int n = 0; n < 2; ++n) *(f32x4*)(rowp + n * 16) = acc[ai][0][m][n]; }
    }
};
__device__ __forceinline__ float gelu_t(float x) { const float u2 = -2.302208198f * (x + 0.044715f * x * x * x); return x * __builtin_amdgcn_rcpf(1.0f + __builtin_amdgcn_exp2f(u2)); }
struct EpiSsmOut {
    static constexpr bool PERM = true, AFTER_DRAIN = false;
    bf16_t* G;
    __device__ __forceinline__ void operator()(const f32x4 (&acc)[2][2][4][2], const Unit& u, int wr, int wc, int fr, int fq) const {
        const int row0 = u.pm * BM + wr * 64 + fr;
#pragma unroll
        for (int ai = 0; ai < 2; ++ai)
#pragma unroll
            for (int m = 0; m < 4; ++m) { const int row = row0 + ai * HALF + m * 16;
#pragma unroll
                for (int bj = 0; bj < 2; ++bj) { const int n0 = bj * HALF + wc * 32 + 8 * fq;
                    const f32x4 v0 = acc[ai][bj][m][0], v1 = acc[ai][bj][m][1];
                    u32x4 w; w.x = cvt_pk_bf16(gelu_t(v0[0]), gelu_t(v0[1])); w.y = cvt_pk_bf16(gelu_t(v0[2]), gelu_t(v0[3])); w.z = cvt_pk_bf16(gelu_t(v1[0]), gelu_t(v1[1])); w.w = cvt_pk_bf16(gelu_t(v1[2]), gelu_t(v1[3]));
                    *(u32x4*)(G + ((size_t)row * 16 + (n0 >> 4)) * 512 + u.eb * 16 + (n0 & 15)) = w; } }
    }
};

struct CmpOrder {
    int G, c;
    __device__ __forceinline__ bool next(int i, Unit& u) const { const int L = i * G + c; if (L >= 32) return false; u.eb = L >> 4; u.pm = L & 15; u.pn = 0; u.p0 = 0; u.cnt = 0; return true; }
    __device__ __forceinline__ void a_ready(const Unit&) const {}
    __device__ __forceinline__ void done(const Unit&) const {}
};
struct EpiCmpHid {
    static constexpr bool PERM = false, AFTER_DRAIN = false;
    bf16_t* HC; const float* bias;
    __device__ __forceinline__ void operator()(const f32x4 (&acc)[2][2][4][2], const Unit& u, int wr, int wc, int fr, int fq) const {
        if (wc < 2) {
            const int row0 = u.pm * BM + wr * 64 + fr, col0 = wc * 32 + 4 * fq;
#pragma unroll
            for (int n = 0; n < 2; ++n) { const f32x4 bv = *(const f32x4*)(bias + u.eb * 64 + col0 + n * 16);
#pragma unroll
                for (int ai = 0; ai < 2; ++ai)
#pragma unroll
                    for (int m = 0; m < 4; ++m) { const f32x4 v = acc[ai][0][m][n] + bv;
                        typedef unsigned u32x2_ __attribute__((ext_vector_type(2)));
                        u32x2_ w; w.x = cvt_pk_bf16(gelu_t(v[0]), gelu_t(v[1])); w.y = cvt_pk_bf16(gelu_t(v[2]), gelu_t(v[3]));
                        *(u32x2_*)(HC + ((size_t)u.eb * 4096 + row0 + ai * HALF + m * 16) * 64 + col0 + n * 16) = w; } }
        }
    }
};

struct SingleUnit {
    int eb, pm;
    __device__ __forceinline__ bool next(int i, Unit& u) const { if (i > 0) return false; u.eb = eb; u.pm = pm; u.pn = 0; u.p0 = 0; u.cnt = 0; return true; }
    __device__ __forceinline__ void a_ready(const Unit&) const {}
    __device__ __forceinline__ void done(const Unit&) const {}
};
}

struct Args { const float* in[26]; float* out; unsigned char* ws; int ph_lo, ph_hi; };

struct Frame {
    LAS unsigned char* lds;
    int tid, lane, wave, blk, G;
};

__device__ __forceinline__ f32x4 bf4(u32x2 p) { f32x4 r; r.x = __uint_as_float(p.x << 16); r.y = __uint_as_float(p.x & 0xffff0000u); r.z = __uint_as_float(p.y << 16); r.w = __uint_as_float(p.y & 0xffff0000u); return r; }
__device__ __forceinline__ void ph_norm(const Frame& F, const float* xin, const bf16* add, const bf16* add2, float* xout, const float* g, bf16* hn) {
    const int gw = F.blk * NWAVES + F.wave, NGW = F.G * NWAVES;
    for (int row = gw; row < T; row += NGW) {
        const f32x4* xr = (const f32x4*)(xin + (size_t)row * DM);
        f32x4 v[4]; float s = 0.f;
#pragma unroll
        for (int j = 0; j < 4; ++j) { v[j] = xr[F.lane + 64 * j];
            if (add) { v[j] += bf4(((const u32x2*)(add + (size_t)row * DM))[F.lane + 64 * j]) + bf4(((const u32x2*)(add2 + (size_t)row * DM))[F.lane + 64 * j]); ((f32x4*)(xout + (size_t)row * DM))[F.lane + 64 * j] = v[j]; }
            s += v[j].x * v[j].x + v[j].y * v[j].y + v[j].z * v[j].z + v[j].w * v[j].w; }
        s = wave_sum(s, F.lane);
        const float r = rsqrtf(s * (1.0f / DM) + EPS);
#pragma unroll
        for (int j = 0; j < 4; ++j) {
            const f32x4 gg = ((const f32x4*)g)[F.lane + 64 * j];
            u32x2 o; o.x = pk2(v[j].x * r * gg.x, v[j].y * r * gg.y); o.y = pk2(v[j].z * r * gg.z, v[j].w * r * gg.w);
            *(u32x2*)(hn + (size_t)row * DM + (F.lane + 64 * j) * 4) = o;
        }
    }
}
__device__ __forceinline__ void ph_final_norm(const Frame& F, float* x, const bf16* add, const bf16* add2, const float* g) {
    const int gw = F.blk * NWAVES + F.wave, NGW = F.G * NWAVES;
    for (int row = gw; row < T; row += NGW) {
        f32x4* xr = (f32x4*)(x + (size_t)row * DM);
        f32x4 v[4]; float s = 0.f;
#pragma unroll
        for (int j = 0; j < 4; ++j) { v[j] = xr[F.lane + 64 * j]; if (add) v[j] += bf4(((const u32x2*)(add + (size_t)row * DM))[F.lane + 64 * j]) + bf4(((const u32x2*)(add2 + (size_t)row * DM))[F.lane + 64 * j]); s += v[j].x * v[j].x + v[j].y * v[j].y + v[j].z * v[j].z + v[j].w * v[j].w; }
        s = wave_sum(s, F.lane);
        const float r = rsqrtf(s * (1.0f / DM) + EPS);
#pragma unroll
        for (int j = 0; j < 4; ++j) {
            const f32x4 gg = ((const f32x4*)g)[F.lane + 64 * j];
            f32x4 o; o.x = v[j].x * r * gg.x; o.y = v[j].y * r * gg.y; o.z = v[j].z * r * gg.z; o.w = v[j].w * r * gg.w;
            xr[F.lane + 64 * j] = o;
        }
    }
}

template <bool DUAL, class Epi>
__device__ __forceinline__ void sgemm_naive(const Frame& F, const bf16* A, int lda, const float* B, int ldb, int M, int N, int K, int dualoff, const Epi& epi) {
    LAS float* As = (LAS float*)F.lds;
    LAS float* Bs = As + 16 * 132;
    LAS float* Bs2 = Bs + 16 * 128;
    const int tiles_n = (N + 127) / 128, tiles_m = M / 128;
    const int tx = F.tid & 31, ty = F.tid >> 5;
    for (int tile = F.blk; tile < tiles_m * tiles_n; tile += F.G) {
        const int tm = tile / tiles_n, tn = tile % tiles_n;
        float acc[8][4], acc2[8][4];
#pragma unroll
        for (int i = 0; i < 8; ++i)
#pragma unroll
            for (int j = 0; j < 4; ++j) { acc[i][j] = 0.f; acc2[i][j] = 0.f; }
        const int arow = F.tid >> 2, akq = (F.tid & 3) * 4;
        const int bk = F.tid >> 5, bn = (F.tid & 31) * 4;
        for (int k0 = 0; k0 < K; k0 += 16) {
            {
                const u32x2 av = *(const u32x2*)(A + (size_t)(tm * 128 + arow) * lda + k0 + akq);
                As[(akq + 0) * 132 + arow] = __uint_as_float(av.x << 16);
                As[(akq + 1) * 132 + arow] = __uint_as_float(av.x & 0xffff0000u);
                As[(akq + 2) * 132 + arow] = __uint_as_float(av.y << 16);
                As[(akq + 3) * 132 + arow] = __uint_as_float(av.y & 0xffff0000u);
                const int col = tn * 128 + bn;
                f32x4 bv = (f32x4){0.f, 0.f, 0.f, 0.f};
                const float* bp = B + (size_t)(k0 + bk) * ldb + col;
                if (col + 3 < N) { bv.x = bp[0]; bv.y = bp[1]; bv.z = bp[2]; bv.w = bp[3]; }
                else { if (col < N) bv.x = bp[0]; if (col + 1 < N) bv.y = bp[1]; if (col + 2 < N) bv.z = bp[2]; }
                *(LAS f32x4*)(Bs + bk * 128 + bn) = bv;
                if (DUAL) {
                    const float* bp2 = bp + dualoff;
                    f32x4 bw; bw.x = bp2[0]; bw.y = bp2[1]; bw.z = bp2[2]; bw.w = bp2[3];
                    *(LAS f32x4*)(Bs2 + bk * 128 + bn) = bw;
                }
            }
            __syncthreads();
#pragma unroll 4
            for (int k = 0; k < 16; ++k) {
                float a[8];
                const f32x4 a0 = *(const LAS f32x4*)(As + k * 132 + ty * 8), a1 = *(const LAS f32x4*)(As + k * 132 + ty * 8 + 4);
                a[0] = a0.x; a[1] = a0.y; a[2] = a0.z; a[3] = a0.w; a[4] = a1.x; a[5] = a1.y; a[6] = a1.z; a[7] = a1.w;
                const f32x4 b = *(const LAS f32x4*)(Bs + k * 128 + tx * 4);
#pragma unroll
                for (int i = 0; i < 8; ++i) { acc[i][0] += a[i] * b.x; acc[i][1] += a[i] * b.y; acc[i][2] += a[i] * b.z; acc[i][3] += a[i] * b.w; }
                if (DUAL) {
                    const f32x4 b2 = *(const LAS f32x4*)(Bs2 + k * 128 + tx * 4);
#pragma unroll
                    for (int i = 0; i < 8; ++i) { acc2[i][0] += a[i] * b2.x; acc2[i][1] += a[i] * b2.y; acc2[i][2] += a[i] * b2.z; acc2[i][3] += a[i] * b2.w; }
                }
            }
            __syncthreads();
        }
#pragma unroll
        for (int i = 0; i < 8; ++i)
#pragma unroll
            for (int j = 0; j < 4; ++j) {
                const int row = tm * 128 + ty * 8 + i, col = tn * 128 + tx * 4 + j;
                if (col < N) epi(row, col, acc[i][j], acc2[i][j]);
            }
    }
}
struct EpiStoreBf16 { bf16* O; int ldo; __device__ __forceinline__ void operator()(int r, int c, float a, float) const { O[(size_t)r * ldo + c] = (bf16)f2bf(a); } };
struct EpiGlu { bf16* O; int ldo; __device__ __forceinline__ void operator()(int r, int c, float a, float b) const { O[(size_t)r * ldo + c] = (bf16)f2bf(a * sigmoidf_(b)); } };
struct EpiResid { const float* X; float* O; __device__ __forceinline__ void operator()(int r, int c, float a, float) const { O[(size_t)r * DM + c] = X[(size_t)r * DM + c] + a; } };

__device__ __forceinline__ void ssm_naive_item(int b, int g, const float* a_re, const float* a_im, const float* b_re, const float* b_im, const float* c_re, const float* c_im,
                                               const float* dpar, const float* log_dt, const bf16* Z, bf16* G1, int lane) {
    const int p = lane;
    const float are = a_re[g * 64 + p], aim = a_im[g * 64 + p], dt = expf(log_dt[g]);
    const float er = expf(are * dt), lbr = er * cosf(aim * dt), lbi = er * sinf(aim * dt);
    const float xx = lbr - 1.0f, yy = lbi, den = are * are + aim * aim;
    const float fr = (xx * are + yy * aim) / den, fi = (yy * are - xx * aim) / den;
    float bbr[16], bbi[16], cr[16], ci[16];
#pragma unroll
    for (int h = 0; h < 16; ++h) {
        const float br = b_re[(g * 64 + p) * 16 + h], bi = b_im[(g * 64 + p) * 16 + h];
        bbr[h] = fr * br - fi * bi; bbi[h] = fr * bi + fi * br;
        cr[h] = c_re[(g * 16 + h) * 64 + p]; ci[h] = c_im[(g * 16 + h) * 64 + p];
    }
    const float dd = dpar[g * 16 + (lane & 15)];
    float xr = 0.f, xi = 0.f;
    for (int t = 0; t < SEQ; ++t) {
        const size_t row = (size_t)b * SEQ + t;
        const u32x4 u0 = *(const u32x4*)(Z + row * ZP + ZC_U + g * 16), u1 = *(const u32x4*)(Z + row * ZP + ZC_U + g * 16 + 8);
        float u[16];
        u[0] = __uint_as_float(u0.x << 16); u[1] = __uint_as_float(u0.x & 0xffff0000u); u[2] = __uint_as_float(u0.y << 16); u[3] = __uint_as_float(u0.y & 0xffff0000u);
        u[4] = __uint_as_float(u0.z << 16); u[5] = __uint_as_float(u0.z & 0xffff0000u); u[6] = __uint_as_float(u0.w << 16); u[7] = __uint_as_float(u0.w & 0xffff0000u);
        u[8] = __uint_as_float(u1.x << 16); u[9] = __uint_as_float(u1.x & 0xffff0000u); u[10] = __uint_as_float(u1.y << 16); u[11] = __uint_as_float(u1.y & 0xffff0000u);
        u[12] = __uint_as_float(u1.z << 16); u[13] = __uint_as_float(u1.z & 0xffff0000u); u[14] = __uint_as_float(u1.w << 16); u[15] = __uint_as_float(u1.w & 0xffff0000u);
        float bur = 0.f, bui = 0.f;
#pragma unroll
        for (int h = 0; h < 16; ++h) { bur += bbr[h] * u[h]; bui += bbi[h] * u[h]; }
        const float nxr = lbr * xr - lbi * xi + bur, nxi = lbr * xi + lbi * xr + bui;
        xr = nxr; xi = nxi;
        float y = 0.f;
#pragma unroll
        for (int h = 0; h < 16; ++h) { const float v = wave_sum(cr[h] * xr - ci[h] * xi, lane); if (lane == h) y = v; }
        if (lane < 16) {
            const float ul = bf2f(Z[row * ZP + ZC_U + g * 16 + lane]);
            G1[row * D_SSM + g * 16 + lane] = (bf16)f2bf(gelu_tanh(y + dd * ul));
        }
    }
}
__device__ __forceinline__ void compress_naive_item(int item, const bf16* Z, const float* pos, const float* w1, const float* w2, bf16* KC, bf16* VC, int lane) {
    const int i = item & 1, hkv = (item >> 1) & 1, n = (item >> 2) % NCMPP, b = (item >> 2) / NCMPP;
    bf16* dst = i ? VC : KC;
    if (n == NCMP) { dst[(((size_t)b * NCMPP + n) * 2 + hkv) * 64 + lane] = 0; return; }
    const float* posi = pos + i * 32 * 64; const float* w1i = w1 + (size_t)i * 32 * 64 * 64; const float* w2i = w2 + i * 64 * 64;
    float acc = 0.f;
    for (int l = 0; l < 32; ++l) {
        const bf16* zr = Z + ((size_t)b * SEQ + 16 * n + l) * ZP + ZC_KV + i * 128 + hkv * 64;
        for (int d = 0; d < 64; ++d) acc += (bf2f(zr[d]) + posi[l * 64 + d]) * w1i[(l * 64 + d) * 64 + lane];
    }
    const float hid = gelu_tanh(acc);
    float o = 0.f;
    for (int e = 0; e < 64; ++e) o += lane_bcast(hid, e) * w2i[e * 64 + lane];
    dst[(((size_t)b * NCMPP + n) * 2 + hkv) * 64 + lane] = (bf16)f2bf(o);
}

__device__ __forceinline__ void attn_chunk(LAS float* wl, const bf16* Z, const float* rel_bias, int b, int hkv, int t, int base, int kcol, int vcol, int lane,
                                           float (&m)[4], float (&l)[4], float (&o)[4]) {
    const int pos = base + lane; const bool valid = (pos >= 0) && (pos <= t);
    const int posc = pos < 0 ? 0 : (pos > SEQ - 1 ? SEQ - 1 : pos);
    const bf16* kr = Z + ((size_t)b * SEQ + posc) * ZP + kcol + hkv * 64;
    float s[4] = {0.f, 0.f, 0.f, 0.f};
#pragma unroll 2
    for (int c = 0; c < 8; ++c) {
        const u32x4 kv = *(const u32x4*)(kr + c * 8);
        float k[8];
        k[0] = __uint_as_float(kv.x << 16); k[1] = __uint_as_float(kv.x & 0xffff0000u); k[2] = __uint_as_float(kv.y << 16); k[3] = __uint_as_float(kv.y & 0xffff0000u);
        k[4] = __uint_as_float(kv.z << 16); k[5] = __uint_as_float(kv.z & 0xffff0000u); k[6] = __uint_as_float(kv.w << 16); k[7] = __uint_as_float(kv.w & 0xffff0000u);
#pragma unroll
        for (int g = 0; g < 4; ++g) {
            const f32x4 q0 = *(const LAS f32x4*)(wl + g * 64 + c * 8), q1 = *(const LAS f32x4*)(wl + g * 64 + c * 8 + 4);
            s[g] += q0.x * k[0] + q0.y * k[1] + q0.z * k[2] + q0.w * k[3] + q1.x * k[4] + q1.y * k[5] + q1.z * k[6] + q1.w * k[7];
        }
    }
    const int bk = t5_bucket(t - pos);
#pragma unroll
    for (int g = 0; g < 4; ++g) {
        const float sv = valid ? s[g] + rel_bias[bk * 8 + hkv * 4 + g] : -1e30f;
        const float mn = fmaxf(m[g], wave_max(sv, lane));
        const float alpha = __expf(m[g] - mn);
        const float p = valid ? __expf(sv - mn) : 0.f;
        l[g] = l[g] * alpha + wave_sum(p, lane);
        o[g] *= alpha; m[g] = mn;
        wl[256 + g * 64 + lane] = p;
    }
#pragma unroll 4
    for (int key = 0; key < 64; ++key) {
        int pk = base + key; pk = pk < 0 ? 0 : (pk > SEQ - 1 ? SEQ - 1 : pk);
        const float v = bf2f(Z[((size_t)b * SEQ + pk) * ZP + vcol + hkv * 64 + lane]);
#pragma unroll
        for (int g = 0; g < 4; ++g) o[g] += wl[256 + g * 64 + key] * v;
    }
}
__device__ __forceinline__ void attn_naive_item(LAS float* wl, int b, int hkv, int t, const bf16* Z, const float* KC, const float* VC, const float* rel_bias, bf16* YC, int lane) {
    const size_t row = (size_t)b * SEQ + t;
#pragma unroll
    for (int g = 0; g < 4; ++g) wl[g * 64 + lane] = bf2f(Z[row * ZP + ZC_Q + hkv * 256 + g * 64 + lane]) * 0.125f;
#pragma unroll 1
    for (int c = 0; c < 4; ++c) {
        const int n = c * 64 + lane; const bool valid = (n < NCMP) && (16 * n + 31 <= t);
        const float* kr = KC + (((size_t)b * NCMPP + (n < NCMP ? n : 0)) * 2 + hkv) * 64;
        float s[4] = {0.f, 0.f, 0.f, 0.f};
#pragma unroll 4
        for (int d4 = 0; d4 < 16; ++d4) {
            const f32x4 k = *(const f32x4*)(kr + d4 * 4);
#pragma unroll
            for (int g = 0; g < 4; ++g) { const f32x4 q = *(const LAS f32x4*)(wl + g * 64 + d4 * 4); s[g] += q.x * k.x + q.y * k.y + q.z * k.z + q.w * k.w; }
        }
        const int bk = t5_bucket(t - (16 * n + 31));
#pragma unroll
        for (int g = 0; g < 4; ++g) wl[256 + g * 256 + n] = valid ? s[g] + rel_bias[bk * 8 + hkv * 4 + g] : -1e30f;
    }
#pragma unroll
    for (int g = 0; g < 4; ++g) {
        float sc[4];
#pragma unroll
        for (int c = 0; c < 4; ++c) sc[c] = wl[256 + g * 256 + c * 64 + lane];
        const float mx = wave_max(fmaxf(fmaxf(sc[0], sc[1]), fmaxf(sc[2], sc[3])), lane);
        float e[4], ls = 0.f;
#pragma unroll
        for (int c = 0; c < 4; ++c) { e[c] = sc[c] > -1e29f ? __expf(sc[c] - mx) : 0.f; ls += e[c]; }
        ls = wave_sum(ls, lane);
        const float inv = ls > 0.f ? 1.0f / ls : 0.f;
#pragma unroll
        for (int c = 0; c < 4; ++c) wl[256 + g * 256 + c * 64 + lane] = e[c] * inv;
    }
    float oc[4] = {0.f, 0.f, 0.f, 0.f};
    const int nmax = t >= 31 ? ((t - 31) / 16 + 1 < NCMP ? (t - 31) / 16 + 1 : NCMP) : 0;
#pragma unroll 4
    for (int n = 0; n < nmax; ++n) {
        const float v = VC[(((size_t)b * NCMPP + n) * 2 + hkv) * 64 + lane];
#pragma unroll
        for (int g = 0; g < 4; ++g) oc[g] += wl[256 + g * 256 + n] * v;
    }
    float imp = 0.f;
#pragma unroll
    for (int g = 0; g < 4; ++g) {
        const LAS float* P = wl + 256 + g * 256;
        imp += P[4 * lane] + P[4 * lane + 1] + P[4 * lane + 2] + 0.5f * P[4 * lane + 3] + (lane > 0 ? 0.5f * P[4 * lane - 1] : 0.f);
    }
    const int blk = t >> 6;
    const bool forced = (lane == 0) || (lane <= blk && lane > blk - 2), future = lane > blk;
    const float v = forced ? 1e9f : (future ? -1e9f : imp);
    int rank = 0;
    for (int jj = 0; jj < 64; ++jj) { const float vj = lane_bcast(v, jj); rank += (vj > v) || (vj == v && jj < lane); }
    unsigned long long mask = __ballot(rank < 16 && !future);
    float m[4], l[4], o[4];
#pragma unroll
    for (int g = 0; g < 4; ++g) { m[g] = -1e30f; l[g] = 0.f; o[g] = 0.f; }
    while (mask) {
        const int j = __builtin_ctzll(mask); mask &= mask - 1;
        attn_chunk(wl, Z, rel_bias, b, hkv, t, 64 * j, ZC_KV + 256, ZC_KV + 384, lane, m, l, o);
    }
    float os[4];
#pragma unroll
    for (int g = 0; g < 4; ++g) { os[g] = l[g] > 0.f ? o[g] / l[g] : 0.f; m[g] = -1e30f; l[g] = 0.f; o[g] = 0.f; }
    for (int c = 0; c < 8; ++c) attn_chunk(wl, Z, rel_bias, b, hkv, t, t - 511 + 64 * c, ZC_KV + 512, ZC_KV + 640, lane, m, l, o);
#pragma unroll
    for (int g = 0; g < 4; ++g) {
        const float ow = l[g] > 0.f ? o[g] / l[g] : 0.f;
        const bf16* gp = Z + row * ZP + ZC_G + hkv * 12 + g * 3;
        const float r = sigmoidf_(bf2f(gp[0])) * oc[g] + sigmoidf_(bf2f(gp[1])) * os[g] + sigmoidf_(bf2f(gp[2])) * ow;
        YC[row * DM + D_SSM + hkv * 256 + g * 64 + lane] = (bf16)f2bf(r);
    }
}

__device__ __forceinline__ void ph_norm_route(const Frame& F, const float* x, const float* g, const float* rgw, const float* rgb, const float* rew, const float* reb, bf16* hn,
                                              unsigned* gcnt, unsigned* list, float* listw) {
    LAS f32x4* RG = (LAS f32x4*)F.lds; LAS f32x4* RE = RG + 1024;
    LAS unsigned* cnt_l = (LAS unsigned*)(F.lds + 147456); LAS unsigned* base_l = cnt_l + 32; LAS unsigned* ent = cnt_l + 64;
    for (int d = F.tid; d < 1024; d += NTHR) { const int ln = d & 63, jc = d >> 6, row = (ln + 64 * (jc >> 2)) * 4 + (jc & 3); RG[d] = ((const f32x4*)rgw)[row]; }
    for (int d = F.tid; d < 8192; d += NTHR) { const int ln = d & 63, q = d >> 6, half = q & 1, c = (q >> 1) & 3, j = (q >> 3) & 3, gi = q >> 5, row = (ln + 64 * j) * 4 + c;
        RE[d] = ((const f32x4*)rew)[((size_t)gi * DM + row) * 2 + half]; }
    __syncthreads();
    for (int row0 = F.blk * 128; row0 < T; row0 += F.G * 128) {
        if (F.tid < 32) cnt_l[F.tid] = 0u;
        __syncthreads();
        for (int kk = 0; kk < 16; ++kk) {
            const int row = row0 + F.wave * 16 + kk;
            const f32x4* xr = (const f32x4*)(x + (size_t)row * DM);
            f32x4 v[4]; float s = 0.f;
#pragma unroll
            for (int j = 0; j < 4; ++j) { v[j] = xr[F.lane + 64 * j]; s += v[j].x * v[j].x + v[j].y * v[j].y + v[j].z * v[j].z + v[j].w * v[j].w; }
            s = wave_sum(s, F.lane);
            const float r = rsqrtf(s * (1.0f / DM) + EPS);
            float lg[4] = {0.f, 0.f, 0.f, 0.f};
#pragma unroll
            for (int j = 0; j < 4; ++j) {
                const f32x4 gg = ((const f32x4*)g)[F.lane + 64 * j];
                v[j].x = v[j].x * r * gg.x; v[j].y = v[j].y * r * gg.y; v[j].z = v[j].z * r * gg.z; v[j].w = v[j].w * r * gg.w;
                u32x2 o; o.x = pk2(v[j].x, v[j].y); o.y = pk2(v[j].z, v[j].w);
                *(u32x2*)(hn + (size_t)row * DM + (F.lane + 64 * j) * 4) = o;
                const f32x4 w0 = RG[(j * 4 + 0) * 64 + F.lane], w1 = RG[(j * 4 + 1) * 64 + F.lane], w2 = RG[(j * 4 + 2) * 64 + F.lane], w3 = RG[(j * 4 + 3) * 64 + F.lane];
                lg[0] += v[j].x * w0.x + v[j].y * w1.x + v[j].z * w2.x + v[j].w * w3.x;
                lg[1] += v[j].x * w0.y + v[j].y * w1.y + v[j].z * w2.y + v[j].w * w3.y;
                lg[2] += v[j].x * w0.z + v[j].y * w1.z + v[j].z * w2.z + v[j].w * w3.z;
                lg[3] += v[j].x * w0.w + v[j].y * w1.w + v[j].z * w2.w + v[j].w * w3.w;
            }
#pragma unroll
            for (int o = 0; o < 4; ++o) lg[o] = wave_sum(lg[o], F.lane) + rgb[o];
            int gi = 0; float gm = lg[0];
#pragma unroll
            for (int o = 1; o < 4; ++o) if (lg[o] > gm) { gm = lg[o]; gi = o; }
            float gs = 0.f;
#pragma unroll
            for (int o = 0; o < 4; ++o) gs += __expf(lg[o] - gm);
            const float gval = 1.0f / gs;
            const LAS f32x4* we = RE + gi * 2048;
            float le[8] = {0.f, 0.f, 0.f, 0.f, 0.f, 0.f, 0.f, 0.f};
#pragma unroll
            for (int j = 0; j < 4; ++j) {
                const float hv[4] = {v[j].x, v[j].y, v[j].z, v[j].w};
#pragma unroll
                for (int c = 0; c < 4; ++c) {
                    const f32x4 wa = we[((j * 4 + c) * 2 + 0) * 64 + F.lane], wb = we[((j * 4 + c) * 2 + 1) * 64 + F.lane];
                    le[0] += hv[c] * wa.x; le[1] += hv[c] * wa.y; le[2] += hv[c] * wa.z; le[3] += hv[c] * wa.w;
                    le[4] += hv[c] * wb.x; le[5] += hv[c] * wb.y; le[6] += hv[c] * wb.z; le[7] += hv[c] * wb.w;
                }
            }
#pragma unroll
            for (int e = 0; e < 8; ++e) le[e] = wave_sum(le[e], F.lane) + reb[gi * 8 + e];
            int e1 = 0; float m1 = le[0];
#pragma unroll
            for (int e = 1; e < 8; ++e) if (le[e] > m1) { m1 = le[e]; e1 = e; }
            int e2 = -1; float m2 = -3.0e38f;
#pragma unroll
            for (int e = 0; e < 8; ++e) if (e != e1 && le[e] > m2) { m2 = le[e]; e2 = e; }
            const float p2 = __expf(m2 - m1), inv = 1.0f / (1.0f + p2);
            if (F.lane == 0) {
                const unsigned ea = (unsigned)(gi * 8 + e1), eb = (unsigned)(gi * 8 + e2);
                const unsigned pa = __hip_atomic_fetch_add(cnt_l + ea, 1u, __ATOMIC_RELAXED, __HIP_MEMORY_SCOPE_WORKGROUP);
                const unsigned pb = __hip_atomic_fetch_add(cnt_l + eb, 1u, __ATOMIC_RELAXED, __HIP_MEMORY_SCOPE_WORKGROUP);
                LAS unsigned* en = ent + (F.wave * 16 + kk) * 6;
                en[0] = ea; en[1] = eb; en[2] = pa; en[3] = pb; en[4] = __float_as_uint(gval * inv); en[5] = __float_as_uint(gval * p2 * inv);
            }
        }
        __syncthreads();
        if (F.tid < 32) base_l[F.tid] = __hip_atomic_fetch_add(gcnt + F.tid * 64, cnt_l[F.tid], __ATOMIC_RELAXED, __HIP_MEMORY_SCOPE_AGENT);
        __syncthreads();
        if (F.tid < 128) {
            const LAS unsigned* en = ent + F.tid * 6; const unsigned tok = (unsigned)(row0 + F.tid);
            const unsigned ia = en[0] * LCAP + base_l[en[0]] + en[2], ib = en[1] * LCAP + base_l[en[1]] + en[3];
            list[ia] = tok * 2u; listw[ia] = __uint_as_float(en[4]);
            list[ib] = tok * 2u + 1u; listw[ib] = __uint_as_float(en[5]);
        }
        __syncthreads();
    }
}
__device__ __forceinline__ void build_expert_tab(const Frame& F, const unsigned* gcnt, LAS int* tab) {
    if (F.tid < 64) {
        const int c = F.lane < 32 ? (int)__hip_atomic_load(gcnt + F.lane * 64, __ATOMIC_RELAXED, __HIP_MEMORY_SCOPE_AGENT) : 0;
        int tiles = (c + 255) >> 8, incl = tiles;
#pragma unroll
        for (int o = 1; o < 32; o <<= 1) { const int t = __builtin_amdgcn_ds_bpermute((F.lane - o) << 2, incl); if (F.lane >= o) incl += t; }
        if (F.lane < 32) { tab[F.lane + 1] = incl; tab[33 + F.lane] = c; }
        if (F.lane == 0) tab[0] = 0;
    }
    __syncthreads();
}
__device__ __forceinline__ void ph_experts_naive(const Frame& F, const bf16* hn, const unsigned* route, const float* wg, const float* wu, const float* wd, float* x) {
    LAS float* hs = (LAS float*)F.lds;
    LAS float* hd = hs + 1024;
    for (int tok = F.blk; tok < T; tok += F.G) {
        { const unsigned pv = *(const unsigned*)(hn + (size_t)tok * DM + F.tid * 2); hs[F.tid * 2] = __uint_as_float(pv << 16); hs[F.tid * 2 + 1] = __uint_as_float(pv & 0xffff0000u); }
        const u32x4 rt = *(const u32x4*)(route + (size_t)tok * 4);
        __syncthreads();
        {
            const int s = F.tid >> 8, f = F.tid & 255;
            const unsigned e = s ? rt.y : rt.x; const float w = __uint_as_float(s ? rt.w : rt.z);
            const float* pg = wg + (size_t)e * DM * 256 + f; const float* pu = wu + (size_t)e * DM * 256 + f;
            float ga = 0.f, ua = 0.f;
            for (int d = 0; d < DM; ++d) { const float hv = hs[d]; ga += hv * pg[(size_t)d * 256]; ua += hv * pu[(size_t)d * 256]; }
            hd[s * 256 + f] = ga * sigmoidf_(ga) * ua * w;
        }
        __syncthreads();
        for (int dd = F.tid; dd < DM; dd += NTHR) {
            float acc = 0.f;
            const float* p0 = wd + (size_t)rt.x * 256 * DM + dd; const float* p1 = wd + (size_t)rt.y * 256 * DM + dd;
            for (int f = 0; f < 256; ++f) acc += hd[f] * p0[(size_t)f * DM];
            for (int f = 0; f < 256; ++f) acc += hd[256 + f] * p1[(size_t)f * DM];
            x[(size_t)tok * DM + dd] += acc;
        }
        __syncthreads();
    }
}


namespace nsa {
typedef short bf16x8 __attribute__((ext_vector_type(8)));
typedef short s16x4 __attribute__((ext_vector_type(4)));
typedef float f32x16 __attribute__((ext_vector_type(16)));
typedef float f32x2_t __attribute__((ext_vector_type(2)));
typedef __bf16 bf16x2_t __attribute__((ext_vector_type(2)));
constexpr int SLOTB = 8192;
constexpr int L_K = 0, L_V = 3 * SLOTB, L_IMP = 6 * SLOTB, L_BT = L_IMP + 65536, L_WS = L_BT + 4 * 132 * 4, L_RL = L_WS + 8 * 64 * 4, L_SM = L_RL + 4 * 64 * 4, L_END = L_SM + 64 * 8;
static_assert(L_END <= 131072, "nsa LDS map");
constexpr float LOG2E = 1.4426950408889634f;
constexpr float NEG_INF = -__builtin_inff();
#define NSA_SBAR() __builtin_amdgcn_sched_barrier(0)
__device__ __forceinline__ int crow(int r, int hi) { return (r & 3) + 8 * (r >> 2) + 4 * hi; }
__device__ __forceinline__ void glds16(const void* gsrc, unsigned lds_dst) { unsigned keep;
    asm volatile("s_mov_b32 %0, m0\n\ts_mov_b32 m0, %2\n\ts_nop 0\n\tglobal_load_lds_dwordx4 %1, off\n\ts_mov_b32 m0, %0" : "=&s"(keep) : "v"(gsrc), "s"(lds_dst) : "memory"); }
__device__ __forceinline__ unsigned cvtpk(float lo, float hi) { f32x2_t v = {lo, hi}; bf16x2_t b = __builtin_convertvector(v, bf16x2_t); return __builtin_bit_cast(unsigned, b); }
#define NSA_WAIT_BAR(N) asm volatile("s_waitcnt vmcnt(" #N ") lgkmcnt(0)\n\ts_barrier" ::: "memory")
__device__ __forceinline__ void qkt(f32x16& p0, f32x16& p1, const LAS char* kb, const bf16x8 (&qr)[4], const f32x16& cinit) {
#pragma unroll
    for (int d0 = 0; d0 < 4; ++d0) {
        const bf16x8 b0 = *(const LAS bf16x8*)(kb + d0 * 2048);
        const bf16x8 b1 = *(const LAS bf16x8*)(kb + d0 * 2048 + 512);
        if (d0 == 0) { p0 = __builtin_amdgcn_mfma_f32_32x32x16_bf16(b0, qr[0], cinit, 0, 0, 0); p1 = __builtin_amdgcn_mfma_f32_32x32x16_bf16(b1, qr[0], cinit, 0, 0, 0); }
        else { p0 = __builtin_amdgcn_mfma_f32_32x32x16_bf16(b0, qr[d0], p0, 0, 0, 0); p1 = __builtin_amdgcn_mfma_f32_32x32x16_bf16(b1, qr[d0], p1, 0, 0, 0); }
    }
}
__device__ __forceinline__ void pv(f32x16 (&o)[2], int vb, bf16x8 pa0, bf16x8 pa1, bf16x8 pa2, bf16x8 pa3) {
#pragma unroll
    for (int d0 = 0; d0 < 2; ++d0) { s16x4 lo[4], hi[4];
#pragma unroll
        for (int ks = 0; ks < 4; ++ks) {
            asm volatile("ds_read_b64_tr_b16 %0,%1 offset:%c2" : "=&v"(lo[ks]) : "v"(vb), "i"(d0 * 4096 + ks * 1024) : "memory");
            asm volatile("ds_read_b64_tr_b16 %0,%1 offset:%c2" : "=&v"(hi[ks]) : "v"(vb), "i"(d0 * 4096 + ks * 1024 + 512) : "memory"); }
        asm volatile("s_waitcnt lgkmcnt(0)" ::: "memory"); NSA_SBAR();
#define NSA_PK(k) (bf16x8){lo[k][0], lo[k][1], lo[k][2], lo[k][3], hi[k][0], hi[k][1], hi[k][2], hi[k][3]}
        o[d0] = __builtin_amdgcn_mfma_f32_32x32x16_bf16(pa0, NSA_PK(0), o[d0], 0, 0, 0);
        o[d0] = __builtin_amdgcn_mfma_f32_32x32x16_bf16(pa1, NSA_PK(1), o[d0], 0, 0, 0);
        o[d0] = __builtin_amdgcn_mfma_f32_32x32x16_bf16(pa2, NSA_PK(2), o[d0], 0, 0, 0);
        o[d0] = __builtin_amdgcn_mfma_f32_32x32x16_bf16(pa3, NSA_PK(3), o[d0], 0, 0, 0);
#undef NSA_PK
    }
}
typedef short v4i16_t __attribute__((ext_vector_type(4)));
__device__ __forceinline__ s16x4 vtr(const LAS char* p) { return __builtin_bit_cast(s16x4, __builtin_amdgcn_ds_read_tr16_b64_v4i16((LAS v4i16_t*)p)); }
__device__ __forceinline__ void pv2(f32x16 (&o)[2], const LAS char* vp, bf16x8 pa0, bf16x8 pa1, bf16x8 pa2, bf16x8 pa3) {
#pragma unroll
    for (int d0 = 0; d0 < 2; ++d0) {
        s16x4 lo[4], hi[4];
#pragma unroll
        for (int ks = 0; ks < 4; ++ks) { lo[ks] = vtr(vp + d0 * 4096 + ks * 1024); hi[ks] = vtr(vp + d0 * 4096 + ks * 1024 + 512); }
#define NSA_PK(k) (bf16x8){lo[k][0], lo[k][1], lo[k][2], lo[k][3], hi[k][0], hi[k][1], hi[k][2], hi[k][3]}
        o[d0] = __builtin_amdgcn_mfma_f32_32x32x16_bf16(pa0, NSA_PK(0), o[d0], 0, 0, 0);
        o[d0] = __builtin_amdgcn_mfma_f32_32x32x16_bf16(pa1, NSA_PK(1), o[d0], 0, 0, 0);
        o[d0] = __builtin_amdgcn_mfma_f32_32x32x16_bf16(pa2, NSA_PK(2), o[d0], 0, 0, 0);
        o[d0] = __builtin_amdgcn_mfma_f32_32x32x16_bf16(pa3, NSA_PK(3), o[d0], 0, 0, 0);
#undef NSA_PK
    }
}
__device__ __forceinline__ float other_half(float v, int hi) { auto rr = __builtin_amdgcn_permlane32_swap(__float_as_uint(v), __float_as_uint(v), false, false); return __uint_as_float(hi ? rr[0] : rr[1]); }
__device__ __forceinline__ float rowmax(const f32x16& p0, const f32x16& p1, int hi) {
    float a = fmaxf(fmaxf(p0[0], p0[1]), p1[0]), b = fmaxf(fmaxf(p0[2], p0[3]), p1[1]); a = fmaxf(fmaxf(a, p1[2]), p1[3]);
#pragma unroll
    for (int r = 4; r < 16; r += 4) { a = fmaxf(fmaxf(a, p0[r]), p0[r + 1]); b = fmaxf(fmaxf(b, p0[r + 2]), p0[r + 3]); a = fmaxf(fmaxf(a, p1[r]), p1[r + 1]); b = fmaxf(fmaxf(b, p1[r + 2]), p1[r + 3]); }
    const float m = fmaxf(a, b);
    return fmaxf(m, other_half(m, hi));
}
__device__ __forceinline__ void pack_p(const f32x16& p0, const f32x16& p1, bf16x8& a0, bf16x8& a1, bf16x8& a2, bf16x8& a3) {
    u32x4 w0, w1, w2, w3;
    w0 = (u32x4){cvtpk(p0[0], p0[1]), cvtpk(p0[2], p0[3]), cvtpk(p0[4], p0[5]), cvtpk(p0[6], p0[7])};
    w1 = (u32x4){cvtpk(p0[8], p0[9]), cvtpk(p0[10], p0[11]), cvtpk(p0[12], p0[13]), cvtpk(p0[14], p0[15])};
    w2 = (u32x4){cvtpk(p1[0], p1[1]), cvtpk(p1[2], p1[3]), cvtpk(p1[4], p1[5]), cvtpk(p1[6], p1[7])};
    w3 = (u32x4){cvtpk(p1[8], p1[9]), cvtpk(p1[10], p1[11]), cvtpk(p1[12], p1[13]), cvtpk(p1[14], p1[15])};
    a0 = __builtin_bit_cast(bf16x8, w0); a1 = __builtin_bit_cast(bf16x8, w1); a2 = __builtin_bit_cast(bf16x8, w2); a3 = __builtin_bit_cast(bf16x8, w3);
}

struct Ctx {
    LAS char* lds; unsigned lds0; int wid, lane, r32, hi, g, th, qloc;
    const LAS float* bt;
    LAS float* wsf;
    const LAS float* wrow;
    int vb0;
    const LAS char* vp0;
    const LAS char* kb0;
};
__device__ __forceinline__ void dma_k(const Ctx& c, const bf16* kbase, int pitch, int slot) { glds16(kbase + (size_t)c.lane * pitch + c.wid * 8, (unsigned)__builtin_amdgcn_readfirstlane(c.lds0 + L_K + slot * SLOTB + c.wid * 1024)); }
__device__ __forceinline__ void dma_v(const Ctx& c, const bf16* vbase, int pitch, int slot) { glds16(vbase + (size_t)(16 * (c.wid & 3) + (c.lane >> 2)) * pitch + (c.wid >> 2) * 32 + (c.lane & 3) * 8, (unsigned)__builtin_amdgcn_readfirstlane(c.lds0 + L_V + slot * SLOTB + c.wid * 1024)); }

__device__ __forceinline__ void cmp_scores(const Ctx& c, int slot, const bf16x8 (&qr)[4], int t0, int kt, f32x16& p0, f32x16& p1) {
    const int dmin = t0 + 32 * c.th - 16 * (64 * kt + 63) - 31;
    const bool special = dmin < 113;
    f32x16 ci; { const float v = special ? 0.f : c.bt[128];
#pragma unroll
        for (int r = 0; r < 16; ++r) ci[r] = v; }
    qkt(p0, p1, c.kb0 + slot * SLOTB, qr, ci);
    if (special) {
        int hi64 = 64 * c.hi; asm volatile("" : "+v"(hi64));
        const int dqh = t0 + c.qloc - 1024 * kt - 31 - hi64;
#pragma unroll
        for (int r = 0; r < 16; ++r) {
            const int d0 = dqh - 16 * ((r & 3) + 8 * (r >> 2)), d1 = d0 - 512;
            const float b0 = c.bt[d0 < 0 ? 0 : (d0 > 128 ? 128 : d0)], b1 = c.bt[d1 < 0 ? 0 : (d1 > 128 ? 128 : d1)];
            p0[r] = d0 < 0 ? NEG_INF : p0[r] + b0; p1[r] = d1 < 0 ? NEG_INF : p1[r] + b1;
        }
    }
}
template <int MODE>
__device__ __forceinline__ void online_tile(const Ctx& c, int slot, const bf16x8 (&qr)[4], int dq, bool near, bool masked_tile, bool lane_off, float& mhat, float& lsum, f32x16 (&o)[2]) {
    f32x16 ci; { const float v = (near ? 0.f : c.bt[128]) - mhat;
#pragma unroll
        for (int r = 0; r < 16; ++r) ci[r] = v; }
    f32x16 p0, p1;
    qkt(p0, p1, c.kb0 + slot * SLOTB, qr, ci);
    if (near || masked_tile) {
        int hi4 = 4 * c.hi; asm volatile("" : "+v"(hi4));
        const int dqh = dq - hi4;
#pragma unroll
        for (int r = 0; r < 16; ++r) {
            const int d0 = dqh - ((r & 3) + 8 * (r >> 2)), d1 = d0 - 32;
            if (near) { p0[r] += c.bt[d0 < 0 ? 0 : (d0 > 128 ? 128 : d0)]; p1[r] += c.bt[d1 < 0 ? 0 : (d1 > 128 ? 128 : d1)]; }
            if (d0 < 0 || (MODE == 1 && d0 >= 512)) p0[r] = NEG_INF;
            if (d1 < 0 || (MODE == 1 && d1 >= 512)) p1[r] = NEG_INF;
        }
    }
    if (MODE == 0) { if (lane_off) {
#pragma unroll
        for (int r = 0; r < 16; ++r) { p0[r] = NEG_INF; p1[r] = NEG_INF; } } }
    const float rm = rowmax(p0, p1, c.hi);
    if (__any(rm > 8.0f)) {
        const float dl = fmaxf(rm, 0.f); mhat += dl;
#pragma unroll
        for (int r = 0; r < 16; ++r) { p0[r] -= dl; p1[r] -= dl; }
        const float f = __builtin_amdgcn_exp2f(-dl); lsum *= f;
        if (c.hi == 0) c.wsf[c.r32] = f;
        asm volatile("s_waitcnt lgkmcnt(0)" ::: "memory");
#pragma unroll
        for (int r = 0; r < 16; ++r) { const float fr = c.wrow[(r & 3) + 8 * (r >> 2)]; o[0][r] *= fr; o[1][r] *= fr; }
    }
    float sacc = 0.f;
#pragma unroll
    for (int r = 0; r < 16; ++r) { p0[r] = __builtin_amdgcn_exp2f(p0[r]); p1[r] = __builtin_amdgcn_exp2f(p1[r]); sacc += p0[r] + p1[r]; }
    lsum += sacc;
    bf16x8 a0, a1, a2, a3; pack_p(p0, p1, a0, a1, a2, a3);
    pv(o, c.vb0 + slot * SLOTB, a0, a1, a2, a3);
}
struct Pipe { bf16x8 a0, a1, a2, a3; bool have, resc; };
template <int MODE, bool SPECIAL, bool HAVE>
__device__ __forceinline__ void online_step(const Ctx& c, int kslot, int vslot_prev, const bf16x8 (&qr)[4], int dq, bool near, bool lane_off, float& mhat, float& lsum, f32x16 (&o)[2], Pipe& pp) {
    if (pp.resc) {
#pragma unroll
        for (int r = 0; r < 16; ++r) { const float fr = c.wrow[(r & 3) + 8 * (r >> 2)]; o[0][r] *= fr; o[1][r] *= fr; }
    }
    f32x16 ci; { const float v = ((SPECIAL && near) ? 0.f : c.bt[128]) - mhat;
#pragma unroll
        for (int r = 0; r < 16; ++r) ci[r] = v; }
    f32x16 p0, p1;
    qkt(p0, p1, c.kb0 + kslot * SLOTB, qr, ci);
    if (HAVE) pv2(o, c.vp0 + vslot_prev * SLOTB, pp.a0, pp.a1, pp.a2, pp.a3);
    if (SPECIAL) {
        int hi4 = 4 * c.hi; asm volatile("" : "+v"(hi4));
        const int dqh = dq - hi4;
#pragma unroll
        for (int r = 0; r < 16; ++r) {
            const int d0 = dqh - ((r & 3) + 8 * (r >> 2)), d1 = d0 - 32;
            if (near) { p0[r] += c.bt[d0 < 0 ? 0 : (d0 > 128 ? 128 : d0)]; p1[r] += c.bt[d1 < 0 ? 0 : (d1 > 128 ? 128 : d1)]; }
            if (d0 < 0 || (MODE == 1 && d0 >= 512)) p0[r] = NEG_INF;
            if (d1 < 0 || (MODE == 1 && d1 >= 512)) p1[r] = NEG_INF;
        }
    }
    if (MODE == 0) {
#pragma unroll
        for (int r = 0; r < 16; ++r) { p0[r] = lane_off ? NEG_INF : p0[r]; p1[r] = lane_off ? NEG_INF : p1[r]; } }
    const float rm = rowmax(p0, p1, c.hi);
    const bool mv = __any(rm > 8.0f);
    const float dl = mv ? fmaxf(rm, 0.f) : 0.f;
    mhat += dl;
    const float f = __builtin_amdgcn_exp2f(-dl); lsum *= f;
    c.wsf[c.r32] = f;
    pp.resc = mv;
    float sacc = 0.f;
#pragma unroll
    for (int r = 0; r < 16; ++r) { p0[r] = __builtin_amdgcn_exp2f(p0[r] - dl); p1[r] = __builtin_amdgcn_exp2f(p1[r] - dl); sacc += p0[r] + p1[r]; }
    lsum += sacc;
    pack_p(p0, p1, pp.a0, pp.a1, pp.a2, pp.a3); pp.have = true;
}
__device__ __forceinline__ void online_drain(const Ctx& c, int vslot_prev, f32x16 (&o)[2], Pipe& pp) {
    if (pp.resc) {
#pragma unroll
        for (int r = 0; r < 16; ++r) { const float fr = c.wrow[(r & 3) + 8 * (r >> 2)]; o[0][r] *= fr; o[1][r] *= fr; }
    }
    if (pp.have) pv2(o, c.vp0 + vslot_prev * SLOTB, pp.a0, pp.a1, pp.a2, pp.a3);
}
__device__ __forceinline__ void add_scaled(const Ctx& c, f32x16 (&oacc)[2], const f32x16 (&o)[2], float s) {
    if (c.hi == 0) c.wsf[32 + c.r32] = s;
    asm volatile("s_waitcnt lgkmcnt(0)" ::: "memory");
#pragma unroll
    for (int r = 0; r < 16; ++r) { const float f = c.wrow[32 + (r & 3) + 8 * (r >> 2)]; oacc[0][r] += o[0][r] * f; oacc[1][r] += o[1][r] * f; }
    asm volatile("s_waitcnt lgkmcnt(0)" ::: "memory");
}

__device__ __forceinline__ void add_scaled_park(const Ctx& c, LAS float* park, const f32x16 (&o)[2], float s) {
    if (c.hi == 0) c.wsf[32 + c.r32] = s;
    asm volatile("s_waitcnt lgkmcnt(0)" ::: "memory");
#pragma unroll
    for (int r = 0; r < 16; ++r) { const float f = c.wrow[32 + (r & 3) + 8 * (r >> 2)]; park[r * 64] += o[0][r] * f; park[(16 + r) * 64] += o[1][r] * f; }
    asm volatile("s_waitcnt lgkmcnt(0)" ::: "memory");
}
__device__ __forceinline__ void unit(LAS char* lds, int tid, int b, int hkv, int jt, const bf16* Z, const bf16* KCm, const bf16* VCm, const float* rel_bias, bf16* YC) {
    Ctx c; c.lds = lds; c.lds0 = (unsigned)(uintptr_t)lds; c.wid = __builtin_amdgcn_readfirstlane(tid >> 6); c.lane = tid & 63; c.r32 = c.lane & 31; c.hi = c.lane >> 5;
    c.g = c.wid & 3; c.th = c.wid >> 2; c.qloc = 32 * c.th + c.r32;
    c.bt = (const LAS float*)(lds + L_BT) + c.g * 132; c.wsf = (LAS float*)(lds + L_WS) + c.wid * 64; c.wrow = c.wsf + 4 * c.hi;
    c.vb0 = (int)(c.lds0 + L_V) + ((c.lane >> 4) & 1) * 32 + (c.lane & 3) * 8 + (4 * c.hi + ((c.lane & 15) >> 2)) * 64;
    c.kb0 = (const LAS char*)(lds + L_K) + c.hi * 1024 + c.r32 * 16;
    c.vp0 = (const LAS char*)(lds + L_V) + ((c.lane >> 4) & 1) * 32 + (c.lane & 3) * 8 + (4 * c.hi + ((c.lane & 15) >> 2)) * 64;
    const int t0 = 64 * jt;
    const bf16* Zb = Z + (size_t)b * SEQ * ZP;
    const size_t qrow = (size_t)b * SEQ + t0 + c.qloc;
    for (int i = tid; i < 4 * 129; i += NTHR) { const int gg = i / 129, d = i % 129; ((LAS float*)(lds + L_BT))[gg * 132 + d] = rel_bias[t5_bucket(d) * 8 + hkv * 4 + gg] * LOG2E; }
    bf16x8 qr[4];
#pragma unroll
    for (int d0 = 0; d0 < 4; ++d0) qr[d0] = *(const bf16x8*)(Z + qrow * ZP + ZC_Q + hkv * 256 + c.g * 64 + d0 * 16 + c.hi * 8);
    const bf16* gp = Z + qrow * ZP + ZC_G + hkv * 12 + c.g * 3;
    const float gate0 = sigmoidf_(bf2f(gp[0])), gate1 = sigmoidf_(bf2f(gp[1])), gate2 = sigmoidf_(bf2f(gp[2]));
    f32x16 oacc[2];
#pragma unroll
    for (int r = 0; r < 16; ++r) { oacc[0][r] = 0.f; oacc[1][r] = 0.f; }

    const int nct = (4 * jt + 2) / 64 + 1;
    const bf16* kcb = KCm + (size_t)b * NCMPP * 128 + hkv * 64; const bf16* vcb = VCm + (size_t)b * NCMPP * 128 + hkv * 64;
    float mrow = NEG_INF;
    {
        dma_k(c, kcb, 128, 0); if (nct > 1) dma_k(c, kcb + 64 * 128, 128, 1);
        for (int i = 0; i < nct; ++i) {
            if (i + 1 < nct) NSA_WAIT_BAR(1); else NSA_WAIT_BAR(0);
            if (i + 2 < nct) dma_k(c, kcb + (size_t)(i + 2) * 64 * 128, 128, (i + 2) % 3);
            f32x16 p0, p1; cmp_scores(c, i % 3, qr, t0, i, p0, p1);
            mrow = fmaxf(mrow, rowmax(p0, p1, c.hi));
        }
        NSA_WAIT_BAR(0);
    }
    {
        const float muse = mrow == NEG_INF ? 0.f : mrow;
        float lsum = 0.f, carry = 0.f; f32x16 o[2];
#pragma unroll
        for (int r = 0; r < 16; ++r) { o[0][r] = 0.f; o[1][r] = 0.f; }
        LAS float* impw = (LAS float*)(lds + L_IMP) + (c.g * 64 + c.qloc) * 64;
        dma_k(c, kcb, 128, 0); dma_v(c, vcb, 128, 0); if (nct > 1) { dma_k(c, kcb + 64 * 128, 128, 1); dma_v(c, vcb + 64 * 128, 128, 1); }
        for (int i = 0; i < nct; ++i) {
            if (i + 1 < nct) NSA_WAIT_BAR(2); else NSA_WAIT_BAR(0);
            if (i + 2 < nct) { dma_k(c, kcb + (size_t)(i + 2) * 64 * 128, 128, (i + 2) % 3); dma_v(c, vcb + (size_t)(i + 2) * 64 * 128, 128, (i + 2) % 3); }
            f32x16 p0, p1; cmp_scores(c, i % 3, qr, t0, i, p0, p1);
            float sacc = 0.f;
#pragma unroll
            for (int r = 0; r < 16; ++r) { p0[r] = __builtin_amdgcn_exp2f(p0[r] - muse); p1[r] = __builtin_amdgcn_exp2f(p1[r] - muse); sacc += p0[r] + p1[r]; }
            lsum += sacc;
            float o3[8];
#pragma unroll
            for (int k = 0; k < 4; ++k) { o3[k] = other_half(p0[4 * k + 3], c.hi); o3[4 + k] = other_half(p1[4 * k + 3], c.hi); }
#pragma unroll
            for (int idx = 0; idx < 8; ++idx) {
                const int X = idx >> 2, k = idx & 3;
                const f32x16& p = X ? p1 : p0;
                const float cin = c.hi ? o3[idx] : (idx ? o3[idx - 1] : carry);
                impw[16 * i + 8 * X + 2 * k + c.hi] = p[4 * k] + p[4 * k + 1] + p[4 * k + 2] + 0.5f * p[4 * k + 3] + 0.5f * cin;
            }
            carry = o3[7];
            bf16x8 a0, a1, a2, a3; pack_p(p0, p1, a0, a1, a2, a3);
            pv(o, c.vb0 + (i % 3) * SLOTB, a0, a1, a2, a3);
        }
        const float lt = lsum + other_half(lsum, c.hi);
        const float rl = lt > 0.f ? 1.0f / lt : 0.f;
        if (c.hi == 0) ((LAS float*)(lds + L_RL))[c.g * 64 + c.qloc] = rl;
        add_scaled(c, oacc, o, rl * gate0);
        NSA_WAIT_BAR(0);
    }
    for (int k = 0; k < 8; ++k) {
        const int tok = c.wid * 8 + k;
        float v = 0.f;
#pragma unroll
        for (int gg = 0; gg < 4; ++gg) v += ((const LAS float*)(lds + L_IMP))[(gg * 64 + tok) * 64 + c.lane] * ((const LAS float*)(lds + L_RL))[gg * 64 + tok];
        const bool forced = (c.lane == 0) || (c.lane <= jt && c.lane > jt - 2), future = c.lane > jt;
        v = forced ? 1e9f : (future ? -1e9f : v);
        int rank = 0;
        for (int jj = 0; jj < 64; ++jj) { const float vj = lane_bcast(v, jj); rank += ((vj > v) || (vj == v && jj < c.lane)) ? 1 : 0; }
        const unsigned long long msk = __ballot(rank < 16 && !future);
        if (c.lane == 0) ((LAS unsigned long long*)(lds + L_SM))[tok] = msk;
    }
    NSA_WAIT_BAR(0);
    const unsigned long long mymask = ((const LAS unsigned long long*)(lds + L_SM))[c.qloc];
    LAS float* park = (LAS float*)(lds + L_IMP) + c.wid * 2048 + c.lane;
#pragma unroll
    for (int r = 0; r < 16; ++r) { park[r * 64] = oacc[0][r]; park[(16 + r) * 64] = oacc[1][r]; }
    {
        const bf16* kb = Zb + ZC_KV + 256 + hkv * 64; const bf16* vb = Zb + ZC_KV + 384 + hkv * 64;
        const int nt = jt + 1;
        float mhat = 0.f, lsum = 0.f; f32x16 o[2]; Pipe pp; pp.have = false; pp.resc = false;
#pragma unroll
        for (int r = 0; r < 16; ++r) { o[0][r] = 0.f; o[1][r] = 0.f; }
        dma_k(c, kb, ZP, 0); if (nt > 1) dma_k(c, kb + (size_t)64 * ZP, ZP, 1); dma_v(c, vb, ZP, 0);
#define NSA_ITER_HEAD(i) do { if ((i) + 1 < nt) NSA_WAIT_BAR(2); else NSA_WAIT_BAR(1); \
            if ((i) + 2 < nt) dma_k(c, kb + (size_t)((i) + 2) * 64 * ZP, ZP, ((i) + 2) % 3); \
            if ((i) + 1 < nt) dma_v(c, vb + (size_t)((i) + 1) * 64 * ZP, ZP, ((i) + 1) % 3); } while (0)
        {
            NSA_ITER_HEAD(0);
            online_step<0, true, false>(c, 0, 2, qr, 64 * jt + c.qloc, 0 >= jt - 2, !(mymask & 1ull), mhat, lsum, o, pp); }
        const int nfar = jt - 2;
        int i = 1;
        for (; i < nfar; ++i) { NSA_ITER_HEAD(i);
            online_step<0, false, true>(c, i % 3, (i + 2) % 3, qr, 0, false, !((mymask >> i) & 1ull), mhat, lsum, o, pp); }
        for (; i < nt; ++i) { NSA_ITER_HEAD(i);
            online_step<0, true, true>(c, i % 3, (i + 2) % 3, qr, 64 * (jt - i) + c.qloc, i >= jt - 2, !((mymask >> i) & 1ull), mhat, lsum, o, pp); }
        NSA_WAIT_BAR(0);
        online_drain(c, (nt - 1) % 3, o, pp);
        const float lt = lsum + other_half(lsum, c.hi);
        add_scaled_park(c, park, o, (lt > 0.f ? 1.0f / lt : 0.f) * gate1);
        NSA_WAIT_BAR(0);
    }
    {
        const int j0 = jt > 8 ? jt - 8 : 0, nt = jt - j0 + 1;
        const bf16* kb = Zb + (size_t)j0 * 64 * ZP + ZC_KV + 512 + hkv * 64; const bf16* vb = Zb + (size_t)j0 * 64 * ZP + ZC_KV + 640 + hkv * 64;
        float mhat = 0.f, lsum = 0.f; f32x16 o[2]; Pipe pp; pp.have = false; pp.resc = false;
#pragma unroll
        for (int r = 0; r < 16; ++r) { o[0][r] = 0.f; o[1][r] = 0.f; }
        dma_k(c, kb, ZP, 0); if (nt > 1) dma_k(c, kb + (size_t)64 * ZP, ZP, 1); dma_v(c, vb, ZP, 0);
        {
            NSA_ITER_HEAD(0);
            online_step<1, true, false>(c, 0, 2, qr, 64 * (jt - j0) + c.qloc, j0 >= jt - 2, false, mhat, lsum, o, pp); }
        int i = 1;
        for (; j0 + i < jt - 2; ++i) { NSA_ITER_HEAD(i);
            online_step<1, false, true>(c, i % 3, (i + 2) % 3, qr, 0, false, false, mhat, lsum, o, pp); }
        for (; i < nt; ++i) { NSA_ITER_HEAD(i); const int j = j0 + i;
            online_step<1, true, true>(c, i % 3, (i + 2) % 3, qr, 64 * (jt - j) + c.qloc, j >= jt - 2, false, mhat, lsum, o, pp); }
#undef NSA_ITER_HEAD
        NSA_WAIT_BAR(0);
        online_drain(c, (nt - 1) % 3, o, pp);
        const float lt = lsum + other_half(lsum, c.hi);
        add_scaled_park(c, park, o, (lt > 0.f ? 1.0f / lt : 0.f) * gate2);
    }
    {
        bf16* yb = YC + ((size_t)b * SEQ + t0 + 32 * c.th + 4 * c.hi) * DM + D_SSM + hkv * 256 + c.g * 64 + c.r32;
#pragma unroll
        for (int r = 0; r < 16; ++r) { bf16* yr = yb + (size_t)((r & 3) + 8 * (r >> 2)) * DM; yr[0] = (bf16)f2bf(park[r * 64]); yr[32] = (bf16)f2bf(park[(16 + r) * 64]); }
    }
    asm volatile("s_waitcnt vmcnt(0)" ::: "memory");
    NSA_WAIT_BAR(0);
}
#undef NSA_SBAR
#undef NSA_WAIT_BAR
}


__device__ __forceinline__ void ssm_precompute(const Frame& F, const __attribute__((address_space(4))) Args* args, unsigned char* ws, int item) {
    const int layer = item >> 5, g = item & 31, lg = layer * 32 + g;
    LAS float* L = (LAS float*)F.lds;
    LAS float* lkr = L; LAS float* lki = L + 17 * 64; LAS float* bbr = L + 2 * 17 * 64; LAS float* bbi = bbr + 1024; LAS float* ccr = bbi + 1024; LAS float* cci = ccr + 1024;
    LAS float* wk = cci + 1024; LAS float* dd = wk + 4096;
    const float* a_re = args->in[6] + lg * 64; const float* a_im = args->in[7] + lg * 64;
    const float dt = expf(args->in[13][lg]);
    for (int i = F.tid; i < 17 * 64; i += NTHR) { const int k = i >> 6, p = i & 63; const float er = expf(a_re[p] * dt * (float)k), ang = a_im[p] * dt * (float)k; lkr[i] = er * cosf(ang); lki[i] = er * sinf(ang); }
    for (int i = F.tid; i < 1024; i += NTHR) {
        { const int p = i >> 4, h = i & 15; const float are = a_re[p], aim = a_im[p];
          const float er = expf(are * dt), lbr = er * cosf(aim * dt), lbi = er * sinf(aim * dt);
          const float xx = lbr - 1.0f, yy = lbi, den = are * are + aim * aim, fr = (xx * are + yy * aim) / den, fi = (yy * are - xx * aim) / den;
          const float br = args->in[8][((size_t)lg * 64 + p) * 16 + h], bi = args->in[9][((size_t)lg * 64 + p) * 16 + h];
          bbr[i] = fr * br - fi * bi; bbi[i] = fr * bi + fi * br; }
        ccr[i] = args->in[10][(size_t)lg * 1024 + i]; cci[i] = args->in[11][(size_t)lg * 1024 + i];
    }
    if (F.tid < 16) dd[F.tid] = args->in[12][lg * 16 + F.tid];
    __syncthreads();
    for (int i = F.tid; i < 4096; i += NTHR) { const int k = i >> 8, ho = (i >> 4) & 15, hi = i & 15; float acc = 0.f;
        for (int p = 0; p < 64; ++p) { const float cr = ccr[ho * 64 + p], ci = cci[ho * 64 + p], lr = lkr[k * 64 + p], li = lki[k * 64 + p];
            const float tr = cr * lr - ci * li, ti = cr * li + ci * lr; acc += tr * bbr[p * 16 + hi] - ti * bbi[p * 16 + hi]; }
        wk[i] = acc + ((k == 0 && ho == hi) ? dd[ho] : 0.f); }
    __syncthreads();
    bf16* B2 = (bf16*)(ws + WS_BT2) + (size_t)lg * 256 * 384;
    for (int i = F.tid; i < 256 * 384; i += NTHR) { const int n = i / 384, kk = i % 384, t = n >> 4, ho = n & 15; float v;
        if (kk < 256) { const int sidx = kk >> 4, hi = kk & 15; v = sidx <= t ? wk[((t - sidx) << 8) + ho * 16 + hi] : 0.f; }
        else { const int j = kk - 256, p = j & 63; const float cr = ccr[ho * 64 + p], ci = cci[ho * 64 + p], lr = lkr[(t + 1) * 64 + p], li = lki[(t + 1) * 64 + p];
            v = j < 64 ? (cr * lr - ci * li) : -(cr * li + ci * lr); }
        B2[i] = (bf16)f2bf(v); }
    bf16* B1 = (bf16*)(ws + WS_BT1) + (size_t)lg * 256 * 256;
    for (int i = F.tid; i < 65536; i += NTHR) { const int j = i >> 8, kk = i & 255, sidx = kk >> 4, hi = kk & 15; float v = 0.f;
        if (j < 128) { const int p = j & 63; const float lr = lkr[(15 - sidx) * 64 + p], li = lki[(15 - sidx) * 64 + p], br = bbr[p * 16 + hi], bi = bbi[p * 16 + hi];
            v = j < 64 ? (lr * br - li * bi) : (lr * bi + li * br); }
        B1[i] = (bf16)f2bf(v); }
    __syncthreads();
}
__device__ __forceinline__ void ssm_carry_item(int b, int g, const float* a_re, const float* a_im, const float* log_dt, const float* XL, bf16* U, int lane) {
    const float dt16 = 16.0f * expf(log_dt[g]);
    const float er = expf(a_re[g * 64 + lane] * dt16), ang = a_im[g * 64 + lane] * dt16, lr = er * cosf(ang), li = er * sinf(ang);
    float xr = 0.f, xi = 0.f;
    const float* __restrict__ xl = XL + ((size_t)g * 2048 + b * 256) * 128 + lane;
    bf16* __restrict__ up = U + ((size_t)g * 2048 + b * 256) * 512 + 256 + lane;
    float ar[16], ai[16], nr_[16], ni_[16];
#pragma unroll
    for (int k = 0; k < 16; ++k) { ar[k] = xl[(size_t)k * 128]; ai[k] = xl[(size_t)k * 128 + 64]; }
    for (int cb = 0; cb < 16; ++cb) {
        const int cn = cb < 15 ? (cb + 1) * 16 : cb * 16;
#pragma unroll
        for (int k = 0; k < 16; ++k) { nr_[k] = xl[(size_t)(cn + k) * 128]; ni_[k] = xl[(size_t)(cn + k) * 128 + 64]; }
#pragma unroll
        for (int k = 0; k < 16; ++k) {
            const int c = cb * 16 + k;
            up[(size_t)c * 512] = (bf16)f2bf(xr); up[(size_t)c * 512 + 64] = (bf16)f2bf(xi);
            const float nr = lr * xr - li * xi + ar[k], ni = lr * xi + li * xr + ai[k];
            xr = nr; xi = ni;
        }
#pragma unroll
        for (int k = 0; k < 16; ++k) { ar[k] = nr_[k]; ai[k] = ni_[k]; }
    }
}


__device__ __forceinline__ void compress_stage2(const Frame& F, int eb, int pm, const bf16* HC, const float* w2, bf16* KCo, bf16* VCo) {
    const int r = F.tid >> 1, f0 = (F.tid & 1) * 32, rg = pm * 256 + r;
    const bf16* hr = HC + ((size_t)eb * 4096 + rg) * 64; const float* w = w2 + eb * 64 * 64 + f0;
    float acc[32];
#pragma unroll
    for (int f = 0; f < 32; ++f) acc[f] = 0.f;
#pragma unroll 2
    for (int e = 0; e < 64; ++e) { const float h = bf2f(hr[e]);
#pragma unroll
        for (int f4 = 0; f4 < 8; ++f4) { const f32x4 wv = *(const f32x4*)(w + e * 64 + f4 * 4); acc[f4 * 4] += h * wv.x; acc[f4 * 4 + 1] += h * wv.y; acc[f4 * 4 + 2] += h * wv.z; acc[f4 * 4 + 3] += h * wv.w; } }
    const bool pad = ((rg >> 1) & 255) == NCMP;
    bf16* dst = (eb ? VCo : KCo) + (size_t)rg * 64 + f0;
#pragma unroll
    for (int f8 = 0; f8 < 4; ++f8) { u32x4 o; o.x = pad ? 0u : pk2(acc[f8 * 8], acc[f8 * 8 + 1]); o.y = pad ? 0u : pk2(acc[f8 * 8 + 2], acc[f8 * 8 + 3]); o.z = pad ? 0u : pk2(acc[f8 * 8 + 4], acc[f8 * 8 + 5]); o.w = pad ? 0u : pk2(acc[f8 * 8 + 6], acc[f8 * 8 + 7]);
        *(u32x4*)(dst + f8 * 8) = o; }
}

__device__ __forceinline__ void transpose_item(const float* W, int K, int N, bf16* WT, int k0, int n0, int drow0, LAS float* scr, int lane, float scale = 1.0f) {
#pragma unroll 8
    for (int i = 0; i < 32; ++i) { const int kk = 2 * i + (lane >> 5); scr[kk * 33 + (lane & 31)] = W[(size_t)(k0 + kk) * N + n0 + (lane & 31)]; }
    asm volatile("s_waitcnt lgkmcnt(0)" ::: "memory");
    const int c = lane & 7;
#pragma unroll
    for (int j = 0; j < 4; ++j) { const int n = (lane >> 3) + 8 * j; const LAS float* sp = scr + (8 * c) * 33 + n;
        u32x4 o; o.x = pk2(sp[0 * 33] * scale, sp[1 * 33] * scale); o.y = pk2(sp[2 * 33] * scale, sp[3 * 33] * scale); o.z = pk2(sp[4 * 33] * scale, sp[5 * 33] * scale); o.w = pk2(sp[6 * 33] * scale, sp[7 * 33] * scale);
        *(u32x4*)(WT + (size_t)(drow0 + n) * K + k0 + 8 * c) = o; }
    asm volatile("s_waitcnt lgkmcnt(0)" ::: "memory");
}
__device__ __forceinline__ void ph_convert(const Frame& F, const __attribute__((address_space(4))) Args* args, unsigned char* ws) {
    for (int it = F.blk; it < DEPTH * NGRP; it += F.G) ssm_precompute(F, args, ws, it);
    LAS float* scr = (LAS float*)(F.lds + F.wave * 16384);
    const int gw = F.blk * NWAVES + F.wave, NGW = F.G * NWAVES;
    constexpr int I_IN = (DM / 64) * (1792 / 32), I_GLU = (D_SSM / 64) * (2 * D_SSM / 32), I_OUT = (DM / 64) * (DM / 32);
    constexpr int PER_LAYER = I_IN + I_GLU + I_OUT;
    for (int it = gw; it < DEPTH * 32 * 384; it += NGW) {
        const int le = it / 384, r = it % 384;
        if (r < 256) { const int isup = r >> 7, q = r & 127, nb = q & 7, kb = q >> 3, n0 = 32 * nb;
            transpose_item(args->in[isup ? 24 : 23] + (size_t)le * DM * 256, DM, 256, (bf16*)(ws + WS_WGU) + (size_t)le * 512 * DM, 64 * kb, n0, 256 * (n0 >> 7) + 128 * isup + (n0 & 127), scr, F.lane); }
        else { const int q = r - 256, nb = q & 31, kb = q >> 5;
            transpose_item(args->in[25] + (size_t)le * 256 * DM, 256, DM, (bf16*)(ws + WS_WDN) + (size_t)le * DM * 256, 64 * kb, 32 * nb, 32 * nb, scr, F.lane); }
    }
    for (int it = gw; it < DEPTH * 2 * 64; it += NGW) { const int li = it >> 6, q = it & 63, nb = q & 1, kb = q >> 1;
        transpose_item(args->in[16] + (size_t)li * 2048 * 64, 2048, 64, (bf16*)(ws + WS_W1T) + (size_t)li * 256 * 2048, 64 * kb, 32 * nb, 32 * nb, scr, F.lane); }
    { const int gt = F.blk * NTHR + F.tid, NGT = F.G * NTHR;
      for (int idx = gt; idx < DEPTH * 2 * 192 * 2048 / 8; idx += NGT) { const int li = idx / (192 * 256), rem = idx % (192 * 256);
          *(u32x4*)((bf16*)(ws + WS_W1T) + (size_t)li * 256 * 2048 + (size_t)64 * 2048 + (size_t)rem * 8) = (u32x4){0u, 0u, 0u, 0u}; }
      for (int idx = gt; idx < DEPTH * 2 * 64; idx += NGT) { const int li = idx >> 6, e = idx & 63; const float* pp = args->in[15] + (size_t)li * 2048; const float* ww = args->in[16] + (size_t)li * 2048 * 64 + e;
          float a = 0.f; for (int k = 0; k < 2048; ++k) a += pp[k] * ww[(size_t)k * 64];
          ((float*)(ws + WS_CBIAS))[idx] = a; } }
    for (int it = gw; it < DEPTH * PER_LAYER; it += NGW) {
        const int layer = it / PER_LAYER; int r = it % PER_LAYER;
        if (r < I_IN) { const int nb = r % 56, kb = r / 56;
            transpose_item(args->in[4] + (size_t)layer * DM * D_IN, DM, D_IN, (bf16*)(ws + WS_WIN) + (size_t)layer * ZP * DM, 64 * kb, 32 * nb, 32 * nb, scr, F.lane, (nb >= 16 && nb < 32) ? QSCALE : 1.0f); continue; }
        r -= I_IN;
        if (r < I_GLU) { const int nb = r % 32, kb = r / 32, n0 = 32 * nb;
            const int half = n0 >> 9, c = n0 & 511, drow = 256 * (c >> 7) + 128 * half + (c & 127);
            transpose_item(args->in[14] + (size_t)layer * D_SSM * 2 * D_SSM, D_SSM, 2 * D_SSM, (bf16*)(ws + WS_WGLU) + (size_t)layer * 2 * D_SSM * D_SSM, 64 * kb, n0, drow, scr, F.lane); continue; }
        r -= I_GLU;
        { const int nb = r % 32, kb = r / 32;
            transpose_item(args->in[5] + (size_t)layer * DM * DM, DM, DM, (bf16*)(ws + WS_WOUT) + (size_t)layer * DM * DM, 64 * kb, 32 * nb, 32 * nb, scr, F.lane); }
    }
    const int gt = F.blk * NTHR + F.tid, NGT = F.G * NTHR;
    for (int idx = gt; idx < DEPTH * 256 * DM; idx += NGT) {
        const int layer = idx / (256 * DM), rem = idx % (256 * DM), n = 1792 + rem / DM, k = rem % DM;
        const float v = n < D_IN ? args->in[4][(size_t)layer * DM * D_IN + (size_t)k * D_IN + n] : 0.f;
        ((bf16*)(ws + WS_WIN))[(size_t)layer * ZP * DM + (size_t)n * DM + k] = (bf16)f2bf(v);
    }
}

constexpr int PH_PER_LAYER = 8, N_PHASES = 1 + DEPTH * PH_PER_LAYER + 1;
#ifndef FAST_GEMM
#define FAST_GEMM 1
#endif
#ifndef REP_ATTN
#define REP_ATTN 1
#endif
#ifndef REP_CMP
#define REP_CMP 1
#endif
#ifndef REP_CARRY
#define REP_CARRY 1
#endif
#ifndef REP_CONV
#define REP_CONV 1
#endif
#ifndef REP_INPROJ
#define REP_INPROJ 1
#endif
#ifndef REP_G1
#define REP_G1 1
#endif
#ifndef REP_G2
#define REP_G2 1
#endif
#ifndef REP_GLU
#define REP_GLU 1
#endif
#ifndef REP_OUT
#define REP_OUT 1
#endif
#ifndef REP_NORM
#define REP_NORM 1
#endif
#ifndef REP_ROUTE
#define REP_ROUTE 1
#endif
#ifndef REP_GU
#define REP_GU 1
#endif
#ifndef REP_DN
#define REP_DN 1
#endif

__global__ void __launch_bounds__(NTHR, 2) fwd(Args args) {
    extern __shared__ __attribute__((aligned(16))) unsigned char lds_raw[];
    Frame F;
    F.lds = (LAS unsigned char*)lds_raw;
    F.tid = threadIdx.x; F.lane = F.tid & 63; F.wave = __builtin_amdgcn_readfirstlane(F.tid >> 6);
    F.blk = blockIdx.x; F.G = gridDim.x;
    typedef const __attribute__((address_space(4))) Args* KArgs;
    KArgs kp = (KArgs)__builtin_amdgcn_kernarg_segment_ptr();
    asm volatile("" : "+s"(kp));
    unsigned char* ws = kp->ws;
    volatile LAS unsigned* MISC = (volatile LAS unsigned*)(F.lds + MISC_OFF);
    if (F.tid < 32) MISC[F.tid] = 0u;
    __syncthreads();
    XcdBarrier bar; bar.bar = (unsigned*)(ws + WS_CTL) + CW_BAR; bar.x = 0; bar.st = nullptr;
    if (N_LAUNCH_MODE == 1) bar = xcd_barrier_post((unsigned*)(ws + WS_CTL) + CW_BAR, MISC + 8);
#define IN(k) (kp->ph_lo <= (k) && (k) < kp->ph_hi)
#define FRESH_IDS() do { int l_; asm volatile("v_mbcnt_lo_u32_b32 %0, -1, 0\n\tv_mbcnt_hi_u32_b32 %0, -1, %0" : "=v"(l_)); asm volatile("" : "+s"(F.wave), "+s"(F.blk), "+s"(F.G)); F.lane = l_; F.tid = F.wave * 64 + l_; asm volatile("" : "+s"(kp)); ws = kp->ws; bar.bar = (unsigned*)(ws + WS_CTL) + CW_BAR; } while (0)
#define SEAM(k) do { FRESH_IDS(); if (IN(k) && IN((k) + 1)) xcd_barrier(bar, F.tid); FRESH_IDS(); } while (0)

    const float* x0 = kp->in[0];
    float* XR = kp->out;
#define HN ((bf16*)(ws + WS_HN))
#define Z ((bf16*)(ws + WS_Z))
#define YC ((bf16*)(ws + WS_YC))
#define G1 ((bf16*)(ws + WS_G1))
#define KC ((bf16*)(ws + WS_KC))
#define VC ((bf16*)(ws + WS_VC))
#define LIST ((unsigned*)(ws + WS_LIST))
#define LISTW ((float*)(ws + WS_LISTW))
#define HID ((bf16*)(ws + WS_HID))
#define P2 ((bf16*)(ws + WS_P2))
#define P1B ((bf16*)(ws + WS_YC))
#define USSM ((bf16*)(ws + WS_USSM))
#define XL ((float*)(ws + WS_XL))
    LAS int* etab = (LAS int*)(F.lds + ETAB_OFF);

    if (IN(0)) for (int rep_ = 0; rep_ < REP_CONV; ++rep_) ph_convert(F, kp, ws);
    SEAM(0);
    for (int layer = 0; layer < DEPTH; ++layer) {
        const int pb = 1 + layer * PH_PER_LAYER;
        const float* xin = layer == 0 ? x0 : XR;
        unsigned* gcnt = (unsigned*)(ws + WS_CTL) + CW_CNT + layer * 32 * 64;
        if (IN(pb + 0)) { ph_norm(F, xin, layer == 0 ? nullptr : P1B, P2, XR, kp->in[1] + layer * DM, HN); for (int rep_ = 1; rep_ < REP_NORM; ++rep_) ph_norm(F, xin, nullptr, nullptr, XR, kp->in[1] + layer * DM, HN); }
        SEAM(pb + 0);
        if (IN(pb + 1)) {
            pg8::Gemm g{HN, (const bf16*)(ws + WS_WIN) + (size_t)layer * ZP * DM, T, ZP, DM, DM, 0, nullptr, 0, 0, 128}; pg8::StaticOrder S; S.init(T, ZP, F.G, F.blk);
            pg8::EpiInProj E{Z, USSM};
            for (int rep_ = 0; rep_ < REP_INPROJ; ++rep_) pg8::gemm2<pg8::EpiInProj, pg8::StaticOrder, pg8::ADense>(F.lds, g, S, E, F.tid);
        }
        SEAM(pb + 1);
        if (IN(pb + 2)) {
            for (int rep_ = 0; rep_ < REP_CMP; ++rep_) {
                { pg8::Gemm g{Z, (const bf16*)(ws + WS_W1T) + (size_t)layer * 2 * 256 * 2048, 0, 256, 2048, ZP, (size_t)256 * 2048, nullptr, 0, 0, ZP * 2};
                  pg8::CmpOrder S{F.G, F.blk}; pg8::EpiCmpHid E{(bf16*)(ws + WS_HIDC), (const float*)(ws + WS_CBIAS) + layer * 128};
                  pg8::gemm2<pg8::EpiCmpHid, pg8::CmpOrder, pg8::ACompress>(F.lds, g, S, E, F.tid); }
                asm volatile("s_waitcnt vmcnt(0)" ::: "memory"); __syncthreads();
                for (int L = F.blk; L < 32; L += F.G) compress_stage2(F, L >> 4, L & 15, (const bf16*)(ws + WS_HIDC), kp->in[17] + (size_t)layer * 2 * 64 * 64, KC, VC);
            }
#pragma unroll 1
            for (int L = F.blk; L < NGRP * BATCH; L += F.G) {
                const int sg = L >> 3, sb = L & 7;
                FRESH_IDS();
                { pg8::Gemm g{USSM, (const bf16*)(ws + WS_BT1) + (size_t)layer * 32 * 256 * 256, 0, 256, 256, 512, (size_t)256 * 256, nullptr, 0, (size_t)2048 * 512, 128};
                  pg8::SingleUnit S{sg, sb}; pg8::EpiXloc E{XL};
                  pg8::gemm2<pg8::EpiXloc, pg8::SingleUnit, pg8::ADense>(F.lds, g, S, E, F.tid); }
                asm volatile("s_waitcnt vmcnt(0)" ::: "memory"); __syncthreads();
                for (int rep_ = 0; rep_ < REP_CARRY; ++rep_)
                if (F.wave == 0) ssm_carry_item(sb, sg, kp->in[6] + layer * NGRP * SST, kp->in[7] + layer * NGRP * SST, kp->in[13] + layer * NGRP, XL, USSM, F.lane);
                asm volatile("s_waitcnt vmcnt(0)" ::: "memory"); __syncthreads();
                FRESH_IDS();
                { pg8::Gemm g{USSM, (const bf16*)(ws + WS_BT2) + (size_t)layer * 32 * 256 * 384, 0, 256, 384, 512, (size_t)256 * 384, nullptr, 0, (size_t)2048 * 512, 128};
                  pg8::SingleUnit S{sg, sb}; pg8::EpiSsmOut E{G1};
                  pg8::gemm2<pg8::EpiSsmOut, pg8::SingleUnit, pg8::ADense>(F.lds, g, S, E, F.tid); }
            }
        }
        SEAM(pb + 2);
        if (IN(pb + 3)) {
            { pg8::Gemm g{G1, (const bf16*)(ws + WS_WGLU) + (size_t)layer * 2 * D_SSM * D_SSM, T, 2 * D_SSM, D_SSM, D_SSM, 0, nullptr, 0, 0, 128}; pg8::StaticOrder S; S.init(T, 2 * D_SSM, F.G, F.blk);
              pg8::EpiGlu E{YC, DM};
              for (int rep_ = 0; rep_ < REP_GLU; ++rep_) pg8::gemm2<pg8::EpiGlu, pg8::StaticOrder, pg8::ADense>(F.lds, g, S, E, F.tid); }
            __syncthreads();
            for (int rep_ = 0; rep_ < REP_ATTN; ++rep_)
            for (int slot = F.blk; slot < 256; slot += F.G) {
                const int bh = slot >> 4, sq = slot & 15;
#pragma unroll 1
                for (int uq = 0; uq < 4; ++uq) { const int jt = uq == 0 ? 63 - sq : (uq == 1 ? 32 + sq : (uq == 2 ? 31 - sq : sq));
                    nsa::unit((LAS char*)F.lds, F.tid, bh >> 1, bh & 1, jt, Z, KC, VC, kp->in[18], YC); }
            }
        }
        SEAM(pb + 3);
        if (IN(pb + 4)) {
            pg8::Gemm g{YC, (const bf16*)(ws + WS_WOUT) + (size_t)layer * DM * DM, T, DM, DM, DM, 0, nullptr, 0, 0, 128}; pg8::StaticOrder S; S.init(T, DM, F.G, F.blk);
            for (int rep_ = 1; rep_ < REP_OUT; ++rep_) { pg8::EpiResid Ed{xin, (float*)(ws + WS_Z), DM}; pg8::gemm2<pg8::EpiResid, pg8::StaticOrder, pg8::ADense>(F.lds, g, S, Ed, F.tid); }
            pg8::EpiResid E{xin, XR, DM};
            pg8::gemm2<pg8::EpiResid, pg8::StaticOrder, pg8::ADense>(F.lds, g, S, E, F.tid);
        }
        SEAM(pb + 4);
        if (IN(pb + 5)) ph_norm_route(F, XR, kp->in[2] + layer * DM, kp->in[19] + (size_t)layer * DM * 4, kp->in[20] + layer * 4, kp->in[21] + (size_t)layer * 4 * DM * 8, kp->in[22] + layer * 32, HN, gcnt, LIST, LISTW);
        if (IN(pb + 5)) for (int rep_ = 1; rep_ < REP_ROUTE; ++rep_) ph_norm_route(F, XR, kp->in[2] + layer * DM, kp->in[19] + (size_t)layer * DM * 4, kp->in[20] + layer * 4, kp->in[21] + (size_t)layer * 4 * DM * 8, kp->in[22] + layer * 32, HN, gcnt + (2 + rep_) * 32 * 64, (unsigned*)(ws + 484 * MiB), (float*)(ws + 488 * MiB));
        SEAM(pb + 5);
        if (IN(pb + 6)) {
            build_expert_tab(F, gcnt, etab);
            pg8::Gemm g{HN, (const bf16*)(ws + WS_WGU) + (size_t)layer * 32 * 512 * DM, 0, 512, DM, DM, (size_t)512 * DM, LIST, LCAP, 0, 128};
            pg8::ExpertOrder S{etab, 2, F.G, F.blk};
            pg8::EpiGateUp E{HID, LISTW, LCAP};
            for (int rep_ = 0; rep_ < REP_GU; ++rep_) pg8::gemm2<pg8::EpiGateUp, pg8::ExpertOrder, pg8::AList>(F.lds, g, S, E, F.tid);
        }
        SEAM(pb + 6);
        if (IN(pb + 7)) {
            build_expert_tab(F, gcnt, etab);
            pg8::Gemm g{HID, (const bf16*)(ws + WS_WDN) + (size_t)layer * 32 * DM * 256, 0, DM, 256, 256, (size_t)DM * 256, nullptr, 0, 0, 128};
            pg8::ExpertOrder S{etab, 4, F.G, F.blk};
            for (int rep_ = 1; rep_ < REP_DN; ++rep_) { pg8::EpiDown Ed{P1B, (long)(P2 - P1B), LIST, LCAP}; pg8::gemm2<pg8::EpiDown, pg8::ExpertOrder, pg8::ADense>(F.lds, g, S, Ed, F.tid); }
            pg8::EpiDown E{P1B, (long)(P2 - P1B), LIST, LCAP};
            pg8::gemm2<pg8::EpiDown, pg8::ExpertOrder, pg8::ADense>(F.lds, g, S, E, F.tid);
        }
        SEAM(pb + 7);
    }
    if (IN(N_PHASES - 1)) ph_final_norm(F, XR, P1B, P2, kp->in[3]);
#undef IN
#undef SEAM
#undef HN
#undef Z
#undef YC
#undef G1
#undef KC
#undef VC
#undef LIST
#undef LISTW
#undef HID
#undef P2
#undef P1B
#undef USSM
#undef XL
}

extern "C" void kernel_launch(void* const* d_in, const int* in_sizes, int n_in, void* d_out, int out_size, void* d_ws, size_t ws_size, hipStream_t stream) {
    static int grid = 0;
    if (grid == 0) {
        if (n_in != 26 || out_size != T * DM || ws_size < WS_END) { fprintf(stderr, "kernel_launch: unexpected shapes (n_in %d out %d ws %zu)\n", n_in, out_size, ws_size); grid = -1; return; }
        int dev = 0, cus = 0, per_cu = 0;
        if (hipGetDevice(&dev) != hipSuccess || hipDeviceGetAttribute(&cus, hipDeviceAttributeMultiprocessorCount, dev) != hipSuccess) { grid = -1; return; }
        if (hipFuncSetAttribute((const void*)fwd, hipFuncAttributeMaxDynamicSharedMemorySize, LDS_BYTES) != hipSuccess) { fprintf(stderr, "kernel_launch: hipFuncSetAttribute failed\n"); grid = -1; return; }
        if (hipOccupancyMaxActiveBlocksPerMultiprocessor(&per_cu, (const void*)fwd, NTHR, LDS_BYTES) != hipSuccess || per_cu < 1) fprintf(stderr, "kernel_launch: occupancy query says %d\n", per_cu);
        (void)hipGetLastError();
        grid = cus;
    }
    if (grid < 0) return;
    (void)hipMemsetAsync((char*)d_ws + WS_CTL, 0, CTL_ZERO_BYTES, stream);
    Args a{};
    for (int i = 0; i < 26; ++i) a.in[i] = (const float*)d_in[i];
    a.out = (float*)d_out; a.ws = (unsigned char*)d_ws;
    if (N_LAUNCH_MODE == 1) {
        a.ph_lo = 0; a.ph_hi = N_PHASES;
        hipLaunchKernelGGL(fwd, dim3(grid), dim3(NTHR), LDS_BYTES, stream, a);
    } else {
        for (int p = 0; p < N_PHASES; ++p) { a.ph_lo = p; a.ph_hi = p + 1; hipLaunchKernelGGL(fwd, dim3(grid), dim3(NTHR), LDS_BYTES, stream, a); }
    }
}
```

```cpp
#include <hip/hip_runtime.h>
#include <cstdio>
#include <cstdint>

#ifndef N_LAUNCH_MODE
#define N_LAUNCH_MODE 1
#endif

#define GAS __attribute__((address_space(1)))
#define LAS __attribute__((address_space(3)))
typedef unsigned short bf16;
typedef float f32x4 __attribute__((ext_vector_type(4)));
typedef unsigned u32x4 __attribute__((ext_vector_type(4)));
typedef unsigned u32x2 __attribute__((ext_vector_type(2)));

constexpr int BATCH = 8, SEQ = 4096, DM = 1024, T = BATCH * SEQ, DEPTH = 2;
constexpr int D_SSM = 512, NGRP = 32, SGRP = 16, SST = 64;
constexpr int D_IN = 1816, ZP = 2048;
constexpr int ZC_U = 0, ZC_Q = 512, ZC_KV = 1024, ZC_G = 1792;
constexpr int NCMP = 255, NCMPP = 256;
constexpr float EPS = 1e-6f;
constexpr int NWAVES = 8, NTHR = 512;
constexpr float QSCALE = 0.125f * 1.4426950408889634f;

constexpr size_t MiB = 1u << 20;
constexpr size_t WS_CTL = 0, CTL_ZERO_BYTES = 1 * MiB;
constexpr size_t WS_KC = 1 * MiB, WS_VC = 2 * MiB, WS_ROUTE = 3 * MiB;
constexpr size_t WS_HN = 16 * MiB;
constexpr size_t WS_Z = 80 * MiB;
constexpr size_t WS_YC = 208 * MiB;
constexpr size_t WS_G1 = 272 * MiB;
constexpr size_t WS_WIN = 304 * MiB;
constexpr size_t WS_WGLU = 312 * MiB;
constexpr size_t WS_WOUT = 314 * MiB;
constexpr size_t WS_WGU = 318 * MiB;
constexpr size_t WS_WDN = 382 * MiB;
constexpr size_t WS_LIST = 414 * MiB;
constexpr size_t WS_LISTW = 418 * MiB;
constexpr size_t WS_HID = 422 * MiB;
constexpr size_t WS_P2 = WS_Z;
constexpr size_t WS_USSM = WS_YC;
constexpr size_t WS_XL = WS_HID;
constexpr size_t WS_BT1 = 458 * MiB;
constexpr size_t WS_BT2 = 466 * MiB;
constexpr size_t WS_W1T = 478 * MiB;
constexpr size_t WS_HIDC = 4 * MiB;
constexpr size_t WS_CBIAS = 5 * MiB;
constexpr size_t WS_END = 482 * MiB;
constexpr int LCAP = 32768, CW_CNT = 8192;
constexpr int CW_BAR = 4096;

constexpr int LDS_BYTES = 163840;
constexpr int ETAB_OFF = LDS_BYTES - 1024, MISC_OFF = LDS_BYTES - 512;

__device__ __forceinline__ float bf2f(bf16 v) { return __uint_as_float(((unsigned)v) << 16); }
__device__ __forceinline__ unsigned f2bf(float f) { unsigned u = __float_as_uint(f); return (u + 0x7fffu + ((u >> 16) & 1u)) >> 16; }
__device__ __forceinline__ unsigned pk2(float lo, float hi) { return f2bf(lo) | (f2bf(hi) << 16); }
__device__ __forceinline__ float wave_sum(float v, int) {
    v += __builtin_bit_cast(float, __builtin_amdgcn_update_dpp(0, __builtin_bit_cast(int, v), 0xB1, 0xF, 0xF, true));
    v += __builtin_bit_cast(float, __builtin_amdgcn_update_dpp(0, __builtin_bit_cast(int, v), 0x4E, 0xF, 0xF, true));
    v += __builtin_bit_cast(float, __builtin_amdgcn_update_dpp(0, __builtin_bit_cast(int, v), 0x141, 0xF, 0xF, true));
    v += __builtin_bit_cast(float, __builtin_amdgcn_update_dpp(0, __builtin_bit_cast(int, v), 0x140, 0xF, 0xF, true));
    const int iv = __builtin_bit_cast(int, v);
    const float s0 = __builtin_bit_cast(float, __builtin_amdgcn_readlane(iv, 0)), s1 = __builtin_bit_cast(float, __builtin_amdgcn_readlane(iv, 16));
    const float s2 = __builtin_bit_cast(float, __builtin_amdgcn_readlane(iv, 32)), s3 = __builtin_bit_cast(float, __builtin_amdgcn_readlane(iv, 48));
    return (s0 + s1) + (s2 + s3);
}
__device__ __forceinline__ float wave_max(float v, int lane) {
#pragma unroll
    for (int o = 1; o < 64; o <<= 1) v = fmaxf(v, __int_as_float(__builtin_amdgcn_ds_bpermute((lane ^ o) << 2, __float_as_int(v))));
    return v;
}
__device__ __forceinline__ float lane_bcast(float v, int src) { return __int_as_float(__builtin_amdgcn_ds_bpermute(src << 2, __float_as_int(v))); }
__device__ __forceinline__ float gelu_tanh(float x) {
    const float u = 0.7978845608028654f * (x + 0.044715f * x * x * x);
    return 0.5f * x * (1.0f + tanhf(u));
}
__device__ __forceinline__ float sigmoidf_(float x) { return 1.0f / (1.0f + __expf(-x)); }
__device__ __forceinline__ int t5_bucket(int n) {
    if (n < 16) return n < 0 ? 0 : n;
    int b = 16;
    b += (n >= 19); b += (n >= 21); b += (n >= 24); b += (n >= 27); b += (n >= 31); b += (n >= 35); b += (n >= 40); b += (n >= 46);
    b += (n >= 52); b += (n >= 59); b += (n >= 67); b += (n >= 77); b += (n >= 87); b += (n >= 99); b += (n >= 113);
    return b;
}

#define XB_TMO      128
#define XB_XCNT(j)  (256  + 64 * (j))
#define XB_XSUB(j)  (1280 + 64 * (j))
#define XB_XGEN(j)  (2304 + 64 * (j))
#define XB_TOP      3328
#define XB_TOPGEN   3392
#define XCD_BAR_WORDS 3456
#define XB_SPIN_CAP (1u << 22)

__device__ __forceinline__ unsigned xb_ld(unsigned* p)              { return __hip_atomic_load(p, __ATOMIC_RELAXED, __HIP_MEMORY_SCOPE_AGENT); }
__device__ __forceinline__ unsigned xb_add(unsigned* p, unsigned v) { return __hip_atomic_fetch_add(p, v, __ATOMIC_RELAXED, __HIP_MEMORY_SCOPE_AGENT); }
__device__ __forceinline__ unsigned xb_xcc_id() { return (unsigned)__builtin_amdgcn_s_getreg((3 << 11) | 20) & 0xFu; }
#define XB_SPIN(cond, bar) do { unsigned _sp = 0; while (cond) { __builtin_amdgcn_s_sleep(1); \
    if ((++_sp & 255u) == 0u) { if (xb_ld(&(bar)[XB_TMO])) break; if (_sp > XB_SPIN_CAP) { atomicAdd(&(bar)[XB_TMO], 1u); break; } } } } while (0)

struct XcdBarrier { unsigned* bar; unsigned x; volatile LAS unsigned* st; };

__device__ __forceinline__ XcdBarrier xcd_barrier_post(unsigned* bar, volatile LAS unsigned* st) {
    XcdBarrier b; b.bar = bar; b.x = xb_xcc_id(); b.st = st;
    if (threadIdx.x == 0) (void)xb_add(&bar[XB_XCNT(b.x)], 1u);
    return b;
}
__device__ __forceinline__ void xcd_barrier_complete(unsigned* bar, unsigned x, unsigned& nloc, unsigned& nx) {
    const unsigned G = gridDim.x * gridDim.y * gridDim.z;
    unsigned sum, cnt, mine, sp = 0u;
    for (;;) {
        sum = 0u; cnt = 0u; mine = 0u;
#pragma unroll
        for (unsigned j = 0; j < 16; ++j) { const unsigned c = xb_ld(&bar[XB_XCNT(j)]); sum += c; cnt += (c > 0u) ? 1u : 0u; mine = (j == x) ? c : mine; }
        if (sum == G) break;
        __builtin_amdgcn_s_sleep(1);
        if ((++sp & 255u) == 0u) { if (xb_ld(&bar[XB_TMO])) break; if (sp > XB_SPIN_CAP) { atomicAdd(&bar[XB_TMO], 1u); break; } }
    }
    nloc = mine > 0u ? mine : 1u; nx = cnt > 0u ? cnt : 1u;
}
__device__ __forceinline__ void xcd_barrier(const XcdBarrier& b, const int tid) {
    asm volatile("s_waitcnt vmcnt(0)" ::: "memory");
    __syncthreads();
    if (tid == 0) {
        unsigned* bar = b.bar;
        __builtin_amdgcn_s_waitcnt(0);
        unsigned nloc = b.st[0], nx = b.st[1];
        if (nloc == 0u) { xcd_barrier_complete(bar, b.x, nloc, nx); b.st[0] = nloc; b.st[1] = nx; }
        const unsigned old = xb_add(&bar[XB_XSUB(b.x)], 1u);
        const unsigned gen = old / nloc;
        if (old + 1u == (gen + 1u) * nloc) {
            __builtin_amdgcn_fence(__ATOMIC_RELEASE, "agent");
            asm volatile("s_waitcnt vmcnt(0)" ::: "memory");
            const unsigned og = xb_add(&bar[XB_TOP], 1u);
            const unsigned tg = og / nx;
            if (og + 1u == (tg + 1u) * nx) xb_add(&bar[XB_TOPGEN], 1u);
            else XB_SPIN(xb_ld(&bar[XB_TOPGEN]) == tg, bar);
            __builtin_amdgcn_fence(__ATOMIC_ACQUIRE, "agent");
            xb_add(&bar[XB_XGEN(b.x)], 1u);
            asm volatile("s_waitcnt vmcnt(0)" ::: "memory");
        } else {
            XB_SPIN(xb_ld(&bar[XB_XGEN(b.x)]) == gen, bar);
            __builtin_amdgcn_fence(__ATOMIC_ACQUIRE, "agent");
            asm volatile("s_waitcnt vmcnt(0)" ::: "memory");
        }
    }
    __syncthreads();
}

namespace pg8 {
#define PG8_LAS __attribute__((address_space(3)))
typedef unsigned short bf16_t;
typedef short bf16x8 __attribute__((ext_vector_type(8)));
typedef float f32x4 __attribute__((ext_vector_type(4)));
typedef unsigned u32x4 __attribute__((ext_vector_type(4)));
constexpr int BM = 256, BK = 64, HALF = 128, HTB = HALF * BK * 2  , STAGE_BYTES = 8 * HTB, NXCD = 8, WGM = 8;

__host__ __device__ __forceinline__ int lds_byte(int r, int c) { const int st = (r >> 4) * 2 + (c >> 5), rr = r & 15, cc = c & 31, ob = rr * 64 + cc * 2; return st * 1024 + (ob ^ (((ob >> 9) & 1) << 5)); }
__host__ __device__ __forceinline__ void stage_rc(int b, int& R, int& C) { const int st = b / 1024, sb = b % 1024, swz = sb ^ (((sb >> 9) & 1) << 5); R = (st >> 1) * 16 + swz / 64; C = (st & 1) * 32 + (swz % 64) / 2; }
__host__ __device__ __forceinline__ int perm32(int rho) { const int n = rho >> 4, i = rho & 15; return 8 * (i >> 2) + 4 * n + (i & 3); }

struct Unit { int pm, pn, eb, p0, cnt; };
struct Gemm { const bf16_t* A; const bf16_t* Bt; int M, N, K; int lda; size_t bstride; const unsigned* list; int cap; size_t astride; int kstepA; };

struct StaticOrder {
    int nM, nN, nwg, G, c;
    __host__ __device__ void init(int M, int N, int G_, int c_) { nM = M / BM; nN = N / BM; nwg = nM * nN; G = G_; c = c_; }
    __host__ __device__ bool next(int i, Unit& u) const {
        const long L = (long)i * G + c; if (L >= nwg) return false;
        int wgid = (int)L; { const int q = nwg / NXCD, r = nwg % NXCD, xcd = wgid % NXCD, off = wgid / NXCD; wgid = (xcd < r ? xcd * (q + 1) : r * (q + 1) + (xcd - r) * q) + off; }
        const int nig = WGM * nN, gid = wgid / nig, fm = gid * WGM, gsz = (nM - fm) < WGM ? (nM - fm) : WGM;
        u.pm = fm + ((wgid % nig) % gsz); u.pn = (wgid % nig) / gsz; u.eb = 0; u.p0 = 0; u.cnt = 0; return true;
    }
    __device__ __forceinline__ void a_ready(const Unit&) const {}
    __device__ __forceinline__ void done(const Unit&) const {}
};

__device__ __forceinline__ unsigned cvt_pk_bf16(float lo, float hi) { unsigned r; asm volatile("v_cvt_pk_bf16_f32 %0, %1, %2" : "=v"(r) : "v"(lo), "v"(hi)); return r; }
typedef float f32x2 __attribute__((ext_vector_type(2)));
__device__ __forceinline__ f32x2 gelu_pk(f32x2 v) {
    const f32x2 av = __builtin_elementwise_abs(v), d = av * 0.2316418882f + 1.0f;
    f32x2 t; t.x = __builtin_amdgcn_rcpf(d.x); t.y = __builtin_amdgcn_rcpf(d.y);
    f32x2 q = t * 0.5307027145f + (-0.7265760135f); q = q * t + 0.7107068705f; q = q * t + (-0.142248368f); q = q * t + 0.127414796f; q = q * t;
    const f32x2 s = (v * v) * (-0.72134752044f);
    f32x2 e; e.x = __builtin_amdgcn_exp2f(s.x); e.y = __builtin_amdgcn_exp2f(s.y);
    const f32x2 m = v * (q * e), r = v - m;
    f32x2 o; o.x = v.x < 0.f ? m.x : r.x; o.y = v.y < 0.f ? m.y : r.y; return o;
}

template <int ACT  > struct EpiBf16 {
    static constexpr bool PERM = true, AFTER_DRAIN = false; static_assert(ACT == 0 || ACT == 1, "EpiBf16: ACT is 0 (none) or 1 (gelu_pk)");
    bf16_t* O; int ldc; const float* bias; int split_cols; size_t split_stride; float scale0;
    __device__ __forceinline__ void operator()(const f32x4 (&acc)[2][2][4][2], const Unit& u, int wr, int wc, int fr, int fq) const {
        const int row0 = u.pm * BM + wr * 64 + fr; int colt = u.pn * BM; bf16_t* base = O;
        float sc = 1.f; if (split_cols) { const int t = colt / split_cols; base += (size_t)t * split_stride; colt -= t * split_cols; if (t == 0) sc = scale0; }
        const int col0 = colt + wc * 32 + 8 * fq, bcol0 = u.pn * BM + wc * 32 + 8 * fq;
        f32x4 bv[2][2];
#pragma unroll
        for (int bj = 0; bj < 2; ++bj)
#pragma unroll
            for (int n = 0; n < 2; ++n) bv[bj][n] = bias ? *(const f32x4*)(bias + bcol0 + bj * HALF + 4 * n) : (f32x4){0.f, 0.f, 0.f, 0.f};
#pragma unroll
        for (int ai = 0; ai < 2; ++ai)
#pragma unroll
            for (int m = 0; m < 4; ++m) { bf16_t* rowp = base + (size_t)(row0 + ai * HALF + m * 16) * ldc + col0;
#pragma unroll
                for (int bj = 0; bj < 2; ++bj) { f32x4 v0 = acc[ai][bj][m][0] + bv[bj][0], v1 = acc[ai][bj][m][1] + bv[bj][1];
                    if (ACT == 1) { f32x2 a = gelu_pk((f32x2){v0[0], v0[1]}), b = gelu_pk((f32x2){v0[2], v0[3]}), c = gelu_pk((f32x2){v1[0], v1[1]}), d = gelu_pk((f32x2){v1[2], v1[3]});
                        v0 = (f32x4){a.x, a.y, b.x, b.y}; v1 = (f32x4){c.x, c.y, d.x, d.y}; }
                    v0 = v0 * sc; v1 = v1 * sc; u32x4 w; w.x = cvt_pk_bf16(v0[0], v0[1]); w.y = cvt_pk_bf16(v0[2], v0[3]); w.z = cvt_pk_bf16(v1[0], v1[1]); w.w = cvt_pk_bf16(v1[2], v1[3]);
                    *(u32x4*)(rowp + bj * HALF) = w; } }
    }
};
template <class Epi, class Sched, bool ALIGN_EPI = false, bool SP2 = false>
__device__ __forceinline__ void gemm_phase(PG8_LAS unsigned char* lds, const Gemm g, const Sched& S, const Epi& E) {
    int tid_ = threadIdx.x; asm volatile("" : "+v"(tid_));
    const int tid = tid_, wid = __builtin_amdgcn_readfirstlane(tid >> 6), lane = tid & 63, wr = wid >> 2, wc = wid & 3, fr = lane & 15, fq = lane >> 4;
    const int K = g.K, nt = K / BK;
    unsigned voffA[2], voffB[2];
#pragma unroll
    for (int i = 0; i < 2; ++i) { int R, C; stage_rc(tid * 16 + i * 8192, R, C); const int Rb = Epi::PERM ? ((R & ~31) + perm32(R & 31)) : R;
        voffA[i] = (unsigned)(R * K + C) * 2u; voffB[i] = (unsigned)(Rb * K + C) * 2u; }
    const size_t kstep = (size_t)(BK * 2);
    const size_t hstep = (size_t)HALF * K * 2;
    const size_t tstep = 2 * hstep;
    const unsigned ldsw = (unsigned)wid * 1024u;
    const int aoff = lds_byte(wr * 64 + fr, fq * 8), boff = lds_byte(wc * 32 + fr, fq * 8);
#define PG8_SA(b, h) (((b) * 2 + (h)) * HTB)
#define PG8_SB(b, h) ((4 + (b) * 2 + (h)) * HTB)
#define PG8_STAGE(bufoff, gbase, voff) do { _Pragma("unroll") for (int _i = 0; _i < 2; ++_i) \
        __builtin_amdgcn_global_load_lds((const unsigned*)((const char*)(gbase) + (voff)[_i]), (PG8_LAS unsigned*)(lds + (bufoff) + ldsw + _i * 8192), 16, 0, 0); } while (0)
#define PG8_LDA(dst, b, h) do { _Pragma("unroll") for (int m = 0; m < 4; ++m) _Pragma("unroll") for (int k = 0; k < 2; ++k) dst[m][k] = *(const PG8_LAS bf16x8*)(lds + PG8_SA(b, h) + aoff + m * 2048 + k * 1024); } while (0)
#define PG8_LDB(dst, b, h) do { _Pragma("unroll") for (int n = 0; n < 2; ++n) _Pragma("unroll") for (int k = 0; k < 2; ++k) dst[n][k] = *(const PG8_LAS bf16x8*)(lds + PG8_SB(b, h) + boff + n * 2048 + k * 1024); } while (0)
#define PG8_MMA(ai, bj, At, Bt) do { __builtin_amdgcn_s_setprio(1); _Pragma("unroll") for (int m = 0; m < 4; ++m) _Pragma("unroll") for (int n = 0; n < 2; ++n) _Pragma("unroll") for (int k = 0; k < 2; ++k) \
        acc[ai][bj][m][n] = __builtin_amdgcn_mfma_f32_16x16x32_bf16(Bt[n][k], At[m][k], acc[ai][bj][m][n], 0, 0, 0); __builtin_amdgcn_s_setprio(0); } while (0)
#define PG8_WAIT_V(n) asm volatile("s_waitcnt vmcnt(" #n ")" ::: "memory")
#define PG8_WAIT_L(n) asm volatile("s_waitcnt lgkmcnt(" #n ")" ::: "memory")
#define PG8_BAR __builtin_amdgcn_s_barrier()
#define PG8_SCHED __builtin_amdgcn_sched_barrier(0)
    Unit cur, nxt; int ui = 0;
    if (!S.next(0, cur)) return;
    f32x4 acc[2][2][4][2];
#pragma unroll
    for (int a = 0; a < 2; ++a)
#pragma unroll
        for (int b = 0; b < 2; ++b)
#pragma unroll
            for (int m = 0; m < 4; ++m)
#pragma unroll
                for (int n = 0; n < 2; ++n) acc[a][b][m][n] = (f32x4){0.f, 0.f, 0.f, 0.f};
    bf16x8 At[4][2], B0[2][2], B1[2][2];
    const char* cA = (const char*)g.A + (size_t)cur.pm * tstep; const char* cB = (const char*)g.Bt + (size_t)cur.pn * tstep;
    S.a_ready(cur);
    if constexpr (SP2) {
        PG8_STAGE(PG8_SB(0, 0), cB, voffB); PG8_STAGE(PG8_SB(0, 1), cB + hstep, voffB); PG8_STAGE(PG8_SA(0, 0), cA, voffA); PG8_STAGE(PG8_SA(0, 1), cA + hstep, voffA);
        if (wr == 1) PG8_BAR;
        PG8_WAIT_V(2); PG8_BAR;
        PG8_STAGE(PG8_SB(1, 0), cB + kstep, voffB); PG8_STAGE(PG8_SA(1, 0), cA + kstep, voffA); PG8_STAGE(PG8_SB(1, 1), cB + hstep + kstep, voffB);
        PG8_WAIT_V(6); PG8_BAR;
    } else {
        PG8_STAGE(PG8_SB(0, 0), cB, voffB); PG8_STAGE(PG8_SA(0, 0), cA, voffA); PG8_STAGE(PG8_SB(0, 1), cB + hstep, voffB); PG8_STAGE(PG8_SA(0, 1), cA + hstep, voffA);
        if (wr == 1) PG8_BAR;
        PG8_WAIT_V(4); PG8_BAR;
        PG8_STAGE(PG8_SB(1, 0), cB + kstep, voffB); PG8_STAGE(PG8_SA(1, 0), cA + kstep, voffA); PG8_STAGE(PG8_SB(1, 1), cB + hstep + kstep, voffB);
        PG8_WAIT_V(6); PG8_BAR;
    }
    for (;;) {
        const bool has_next = S.next(ui + 1, nxt);
        const char* nA = has_next ? (const char*)g.A + (size_t)nxt.pm * tstep : cA; const char* nB = has_next ? (const char*)g.Bt + (size_t)nxt.pn * tstep : cB;
        for (int t = 0; t < nt; t += 2) {
            const bool last = (t == nt - 2);
            const char* a1 = cA + (size_t)(t + 1) * kstep;
            const char* a2 = last ? nA : cA + (size_t)(t + 2) * kstep; const char* b2 = last ? nB : cB + (size_t)(t + 2) * kstep;
            const char* a3 = a2 + kstep; const char* b3 = b2 + kstep;
            if (last && has_next) S.a_ready(nxt);
            if constexpr (SP2) {
            PG8_LDB(B0, 0, 0); PG8_LDB(B1, 0, 1); PG8_SCHED; PG8_LDA(At, 0, 0); PG8_STAGE(PG8_SA(1, 1), a1 + hstep, voffA);
            PG8_WAIT_V(8); PG8_WAIT_L(0); PG8_BAR; PG8_MMA(0, 0, At, B0); PG8_MMA(0, 1, At, B1); PG8_BAR; PG8_SCHED;
            PG8_LDA(At, 0, 1); PG8_STAGE(PG8_SB(0, 0), b2, voffB); PG8_STAGE(PG8_SB(0, 1), b2 + hstep, voffB); PG8_STAGE(PG8_SA(0, 0), a2, voffA);
            PG8_WAIT_V(8); PG8_WAIT_L(0); PG8_BAR; PG8_MMA(1, 0, At, B0); PG8_MMA(1, 1, At, B1); PG8_BAR; PG8_SCHED;
            PG8_LDB(B0, 1, 0); PG8_LDB(B1, 1, 1); PG8_SCHED; PG8_LDA(At, 1, 0); PG8_STAGE(PG8_SA(0, 1), a2 + hstep, voffA);
            PG8_WAIT_V(8); PG8_WAIT_L(0); PG8_BAR; PG8_MMA(0, 0, At, B0); PG8_MMA(0, 1, At, B1); PG8_BAR; PG8_SCHED;
            PG8_LDA(At, 1, 1); PG8_STAGE(PG8_SB(1, 0), b3, voffB); PG8_STAGE(PG8_SB(1, 1), b3 + hstep, voffB); PG8_STAGE(PG8_SA(1, 0), a3, voffA);
            PG8_WAIT_V(8); PG8_WAIT_L(0); PG8_BAR; PG8_MMA(1, 0, At, B0); PG8_MMA(1, 1, At, B1); PG8_BAR; PG8_SCHED;
            } else {
            PG8_LDB(B0, 0, 0); PG8_SCHED; PG8_LDA(At, 0, 0); PG8_STAGE(PG8_SA(1, 1), a1 + hstep, voffA);
            PG8_WAIT_L(8); PG8_BAR; PG8_WAIT_L(0); PG8_MMA(0, 0, At, B0); PG8_BAR; PG8_SCHED;
            PG8_LDB(B1, 0, 1); PG8_STAGE(PG8_SB(0, 0), b2, voffB);
            PG8_BAR; PG8_WAIT_L(0); PG8_MMA(0, 1, At, B1); PG8_BAR;
            PG8_LDA(At, 0, 1); PG8_STAGE(PG8_SA(0, 0), a2, voffA);
            PG8_BAR; PG8_WAIT_L(0); PG8_MMA(1, 0, At, B0); PG8_BAR; PG8_SCHED;
            PG8_STAGE(PG8_SB(0, 1), b2 + hstep, voffB);
            PG8_WAIT_V(6); PG8_BAR; PG8_MMA(1, 1, At, B1); PG8_BAR;
            PG8_LDB(B0, 1, 0); PG8_SCHED; PG8_LDA(At, 1, 0); PG8_STAGE(PG8_SA(0, 1), a2 + hstep, voffA);
            PG8_WAIT_L(8); PG8_BAR; PG8_WAIT_L(0); PG8_MMA(0, 0, At, B0); PG8_BAR; PG8_SCHED;
            PG8_LDB(B1, 1, 1); PG8_STAGE(PG8_SB(1, 0), b3, voffB);
            PG8_BAR; PG8_WAIT_L(0); PG8_MMA(0, 1, At, B1); PG8_BAR;
            PG8_LDA(At, 1, 1); PG8_STAGE(PG8_SA(1, 0), a3, voffA);
            PG8_BAR; PG8_WAIT_L(0); PG8_MMA(1, 0, At, B0); PG8_BAR; PG8_SCHED;
            PG8_STAGE(PG8_SB(1, 1), b3 + hstep, voffB);
            PG8_WAIT_V(6); PG8_BAR; PG8_MMA(1, 1, At, B1); PG8_BAR;
            }
        }
        if constexpr (ALIGN_EPI) { if (wr == 0) PG8_BAR; }
        if constexpr (!Epi::AFTER_DRAIN) { E(acc, cur, wr, wc, fr, fq); S.done(cur); }
        if (!has_next) break;
#pragma unroll
        for (int a = 0; a < 2; ++a)
#pragma unroll
            for (int b = 0; b < 2; ++b)
#pragma unroll
                for (int m = 0; m < 4; ++m)
#pragma unroll
                    for (int n = 0; n < 2; ++n) acc[a][b][m][n] = (f32x4){0.f, 0.f, 0.f, 0.f};
        cur = nxt; cA = nA; cB = nB; ++ui;
        if constexpr (ALIGN_EPI) { if (wr == 1) PG8_BAR; }
    }
    PG8_WAIT_V(0);
    if constexpr (!ALIGN_EPI) { if (wr == 0) PG8_BAR; }
    PG8_BAR;
    if constexpr (Epi::AFTER_DRAIN) { E.fused(acc, cur, wr, wc, fr, fq, lds, wid, lane); S.done(cur); }
#undef PG8_SA
#undef PG8_SB
#undef PG8_STAGE
#undef PG8_LDA
#undef PG8_LDB
#undef PG8_MMA
#undef PG8_WAIT_V
#undef PG8_WAIT_L
#undef PG8_BAR
#undef PG8_SCHED
}

__device__ __forceinline__ float sigm(float x) { return 1.0f / (1.0f + __expf(-x)); }
struct EpiGlu {
    static constexpr bool PERM = true, AFTER_DRAIN = false;
    bf16_t* O; int ldc;
    __device__ __forceinline__ void operator()(const f32x4 (&acc)[2][2][4][2], const Unit& u, int wr, int wc, int fr, int fq) const {
        const int row0 = u.pm * BM + wr * 64 + fr, col0 = u.pn * HALF + wc * 32 + 8 * fq;
#pragma unroll
        for (int ai = 0; ai < 2; ++ai)
#pragma unroll
            for (int m = 0; m < 4; ++m) {
                bf16_t* rowp = O + (size_t)(row0 + ai * HALF + m * 16) * ldc + col0;
                const f32x4 a0 = acc[ai][0][m][0], a1 = acc[ai][0][m][1], b0 = acc[ai][1][m][0], b1 = acc[ai][1][m][1];
                u32x4 w;
                w.x = cvt_pk_bf16(a0[0] * sigm(b0[0]), a0[1] * sigm(b0[1])); w.y = cvt_pk_bf16(a0[2] * sigm(b0[2]), a0[3] * sigm(b0[3]));
                w.z = cvt_pk_bf16(a1[0] * sigm(b1[0]), a1[1] * sigm(b1[1])); w.w = cvt_pk_bf16(a1[2] * sigm(b1[2]), a1[3] * sigm(b1[3]));
                *(u32x4*)rowp = w;
            }
    }
};
struct EpiResid {
    static constexpr bool PERM = false, AFTER_DRAIN = false;
    const float* X; float* O; int ldc;
    __device__ __forceinline__ void operator()(const f32x4 (&acc)[2][2][4][2], const Unit& u, int wr, int wc, int fr, int fq) const {
        const int row0 = u.pm * BM + wr * 64 + fr, col0 = u.pn * BM + wc * 32 + 4 * fq;
#pragma unroll
        for (int ai = 0; ai < 2; ++ai)
#pragma unroll
            for (int m = 0; m < 4; ++m) {
                const size_t off = (size_t)(row0 + ai * HALF + m * 16) * ldc + col0;
#pragma unroll
                for (int bj = 0; bj < 2; ++bj)
#pragma unroll
                    for (int n = 0; n < 2; ++n) *(f32x4*)(O + off + bj * HALF + n * 16) = *(const f32x4*)(X + off + bj * HALF + n * 16) + acc[ai][bj][m][n];
            }
    }
};

struct ADense { static constexpr bool GATHER = false; __device__ __forceinline__ static unsigned rowoff(const Gemm&, const Unit&, int) { return 0u; } };
struct AList { static constexpr bool GATHER = true;
    __device__ __forceinline__ static unsigned rowoff(const Gemm& g, const Unit& u, int r) { const int pos = u.p0 + r; const unsigned tok = pos < u.cnt ? (g.list[(size_t)u.eb * g.cap + pos] >> 1) : 0u; return tok * (unsigned)g.lda * 2u; } };
struct ACompress { static constexpr bool GATHER = true;
    __device__ __forceinline__ static unsigned rowoff(const Gemm&, const Unit& u, int r) { const unsigned rg = (unsigned)(u.pm * BM + r), b = rg >> 9, n = (rg >> 1) & 255u, hkv = rg & 1u;
        return (((b * 4096u + 16u * n) * 2048u) + 1024u + (unsigned)u.eb * 128u + hkv * 64u) * 2u; } };
template <class Epi, class Sched, class AMap>
__device__ __forceinline__ void gemm2(PG8_LAS unsigned char* lds, const Gemm g, const Sched& S, const Epi& E, const int tid) {
    constexpr bool GATHER = AMap::GATHER;
    int K_ = g.K; asm volatile("" : "+s"(K_));
    const int wid = __builtin_amdgcn_readfirstlane(tid >> 6), lane = tid & 63, wr = wid >> 2, wc = wid & 3, fr = lane & 15, fq = lane >> 4;
    const int K = K_, nt = K / BK, lda = g.lda;
    unsigned voffA[2], voffB[2]; int Rst[2], Cst[2];
#pragma unroll
    for (int i = 0; i < 2; ++i) { int R, C; stage_rc(tid * 16 + i * 8192, R, C); const int Rb = Epi::PERM ? ((R & ~31) + perm32(R & 31)) : R;
        voffA[i] = (unsigned)(R * lda + C) * 2u; voffB[i] = (unsigned)(Rb * K + C) * 2u; Rst[i] = R; Cst[i] = C; }
    const size_t kstep = (size_t)(BK * 2), kstepA = (size_t)g.kstepA;
    const size_t hstepA = (size_t)HALF * lda * 2, tstepA = 2 * hstepA, hstepB = (size_t)HALF * K * 2, tstepB = 2 * hstepB;
    const unsigned ldsw = (unsigned)wid * 1024u;
    const int aoff = lds_byte(wr * 64 + fr, fq * 8), boff = lds_byte(wc * 32 + fr, fq * 8);
#define PG8_SA(b, h) (((b) * 2 + (h)) * HTB)
#define PG8_SB(b, h) ((4 + (b) * 2 + (h)) * HTB)
#define PG8_STAGE(bufoff, gbase, voff) do { _Pragma("unroll") for (int _i = 0; _i < 2; ++_i) \
        __builtin_amdgcn_global_load_lds((const unsigned*)((const char*)(gbase) + (voff)[_i]), (PG8_LAS unsigned*)(lds + (bufoff) + ldsw + _i * 8192), 16, 0, 0); } while (0)
#define PG8_STAGE_A(bufoff, gbase, h) do { if constexpr (GATHER) { PG8_STAGE(bufoff, gbase, vg[h]); } else { PG8_STAGE(bufoff, (gbase) + (h) * hstepA, voffA); } } while (0)
#define PG8_GOFFS(u, dst) do { _Pragma("unroll") for (int _h = 0; _h < 2; ++_h) _Pragma("unroll") for (int _i = 0; _i < 2; ++_i) dst[_h][_i] = AMap::rowoff(g, (u), _h * HALF + Rst[_i]) + (unsigned)Cst[_i] * 2u; } while (0)
#define PG8_LDA(dst, b, h) do { _Pragma("unroll") for (int m = 0; m < 4; ++m) _Pragma("unroll") for (int k = 0; k < 2; ++k) dst[m][k] = *(const PG8_LAS bf16x8*)(lds + PG8_SA(b, h) + aoff + m * 2048 + k * 1024); } while (0)
#define PG8_LDB(dst, b, h) do { _Pragma("unroll") for (int n = 0; n < 2; ++n) _Pragma("unroll") for (int k = 0; k < 2; ++k) dst[n][k] = *(const PG8_LAS bf16x8*)(lds + PG8_SB(b, h) + boff + n * 2048 + k * 1024); } while (0)
#define PG8_MMA(ai, bj, At, Bt) do { __builtin_amdgcn_s_setprio(1); _Pragma("unroll") for (int m = 0; m < 4; ++m) _Pragma("unroll") for (int n = 0; n < 2; ++n) _Pragma("unroll") for (int k = 0; k < 2; ++k) \
        acc[ai][bj][m][n] = __builtin_amdgcn_mfma_f32_16x16x32_bf16(Bt[n][k], At[m][k], acc[ai][bj][m][n], 0, 0, 0); __builtin_amdgcn_s_setprio(0); } while (0)
#define PG8_WAIT_V(n) asm volatile("s_waitcnt vmcnt(" #n ")" ::: "memory")
#define PG8_WAIT_L(n) asm volatile("s_waitcnt lgkmcnt(" #n ")" ::: "memory")
#define PG8_BAR __builtin_amdgcn_s_barrier()
#define PG8_SCHED __builtin_amdgcn_sched_barrier(0)
    Unit cur, nxt; int ui = 0;
    if (!S.next(0, cur)) return;
    f32x4 acc[2][2][4][2];
#pragma unroll
    for (int a = 0; a < 2; ++a)
#pragma unroll
        for (int b = 0; b < 2; ++b)
#pragma unroll
            for (int m = 0; m < 4; ++m)
#pragma unroll
                for (int n = 0; n < 2; ++n) acc[a][b][m][n] = (f32x4){0.f, 0.f, 0.f, 0.f};
    bf16x8 At[4][2], B0[2][2], B1[2][2];
    unsigned vg[2][2] = {{0u, 0u}, {0u, 0u}};
    if constexpr (GATHER) PG8_GOFFS(cur, vg);
    const char* cA = (const char*)g.A + (GATHER ? (size_t)0 : (size_t)cur.pm * tstepA + (size_t)cur.eb * g.astride * 2);
    const char* cB = (const char*)g.Bt + ((size_t)cur.eb * g.bstride) * 2 + (size_t)cur.pn * tstepB;
    S.a_ready(cur);
    PG8_STAGE(PG8_SB(0, 0), cB, voffB); PG8_STAGE(PG8_SB(0, 1), cB + hstepB, voffB); PG8_STAGE_A(PG8_SA(0, 0), cA, 0); PG8_STAGE_A(PG8_SA(0, 1), cA, 1);
    if (wr == 1) PG8_BAR;
    PG8_WAIT_V(2); PG8_BAR;
    PG8_STAGE(PG8_SB(1, 0), cB + kstep, voffB); PG8_STAGE_A(PG8_SA(1, 0), cA + kstepA, 0); PG8_STAGE(PG8_SB(1, 1), cB + hstepB + kstep, voffB);
    PG8_WAIT_V(6); PG8_BAR;
    for (;;) {
        const bool has_next = S.next(ui + 1, nxt);
        const char* nA = has_next ? (const char*)g.A + (GATHER ? (size_t)0 : (size_t)nxt.pm * tstepA + (size_t)nxt.eb * g.astride * 2) : cA;
        const char* nB = has_next ? (const char*)g.Bt + ((size_t)nxt.eb * g.bstride) * 2 + (size_t)nxt.pn * tstepB : cB;
        for (int t = 0; t < nt; t += 2) {
            const bool last = (t == nt - 2);
            const char* a1 = cA + (size_t)(t + 1) * kstepA;
            const char* a2 = last ? nA : cA + (size_t)(t + 2) * kstepA; const char* b2 = last ? nB : cB + (size_t)(t + 2) * kstep;
            const char* a3 = a2 + kstepA; const char* b3 = b2 + kstep;
            unsigned vn1[2] = {vg[1][0], vg[1][1]};
            if constexpr (GATHER) { if (last && has_next) { unsigned vn[2][2]; PG8_GOFFS(nxt, vn); vg[0][0] = vn[0][0]; vg[0][1] = vn[0][1]; vn1[0] = vn[1][0]; vn1[1] = vn[1][1]; } }
            if (last && has_next) S.a_ready(nxt);
            PG8_LDB(B0, 0, 0); PG8_LDB(B1, 0, 1); PG8_SCHED; PG8_LDA(At, 0, 0); PG8_STAGE_A(PG8_SA(1, 1), a1, 1);
            PG8_WAIT_V(8); PG8_WAIT_L(0); PG8_BAR; PG8_MMA(0, 0, At, B0); PG8_MMA(0, 1, At, B1); PG8_BAR; PG8_SCHED;
            if constexpr (GATHER) { vg[1][0] = vn1[0]; vg[1][1] = vn1[1]; }
            PG8_LDA(At, 0, 1); PG8_STAGE(PG8_SB(0, 0), b2, voffB); PG8_STAGE(PG8_SB(0, 1), b2 + hstepB, voffB); PG8_STAGE_A(PG8_SA(0, 0), a2, 0);
            PG8_WAIT_V(8); PG8_WAIT_L(0); PG8_BAR; PG8_MMA(1, 0, At, B0); PG8_MMA(1, 1, At, B1); PG8_BAR; PG8_SCHED;
            PG8_LDB(B0, 1, 0); PG8_LDB(B1, 1, 1); PG8_SCHED; PG8_LDA(At, 1, 0); PG8_STAGE_A(PG8_SA(0, 1), a2, 1);
            PG8_WAIT_V(8); PG8_WAIT_L(0); PG8_BAR; PG8_MMA(0, 0, At, B0); PG8_MMA(0, 1, At, B1); PG8_BAR; PG8_SCHED;
            PG8_LDA(At, 1, 1); PG8_STAGE(PG8_SB(1, 0), b3, voffB); PG8_STAGE(PG8_SB(1, 1), b3 + hstepB, voffB); PG8_STAGE_A(PG8_SA(1, 0), a3, 0);
            PG8_WAIT_V(8); PG8_WAIT_L(0); PG8_BAR; PG8_MMA(1, 0, At, B0); PG8_MMA(1, 1, At, B1); PG8_BAR; PG8_SCHED;
        }
        if (wr == 0) PG8_BAR;
        E(acc, cur, wr, wc, fr, fq); S.done(cur);
        if (!has_next) break;
#pragma unroll
        for (int a = 0; a < 2; ++a)
#pragma unroll
            for (int b = 0; b < 2; ++b)
#pragma unroll
                for (int m = 0; m < 4; ++m)
#pragma unroll
                    for (int n = 0; n < 2; ++n) acc[a][b][m][n] = (f32x4){0.f, 0.f, 0.f, 0.f};
        cur = nxt; cA = nA; cB = nB; ++ui;
        if (wr == 1) PG8_BAR;
    }
    PG8_WAIT_V(0);
    PG8_BAR;
#undef PG8_SA
#undef PG8_SB
#undef PG8_STAGE
#undef PG8_STAGE_A
#undef PG8_GOFFS
#undef PG8_LDA
#undef PG8_LDB
#undef PG8_MMA
#undef PG8_WAIT_V
#undef PG8_WAIT_L
#undef PG8_BAR
#undef PG8_SCHED
}

struct ExpertOrder {
    const PG8_LAS int* tab; int nN, G, c;
    __device__ __forceinline__ bool next(int i, Unit& u) const {
        const int total = tab[32] * nN; const long L = (long)i * G + c; if (L >= total) return false;
        const int rt = (int)L / nN, pn = (int)L % nN; int e = 0;
#pragma unroll
        for (int k = 1; k < 32; ++k) e += (rt >= tab[k]) ? 1 : 0;
        u.pm = __builtin_amdgcn_readfirstlane(rt); u.pn = __builtin_amdgcn_readfirstlane(pn); u.eb = __builtin_amdgcn_readfirstlane(e);
        u.p0 = __builtin_amdgcn_readfirstlane((rt - tab[e]) * BM); u.cnt = __builtin_amdgcn_readfirstlane(tab[33 + e]); return true;
    }
    __device__ __forceinline__ void a_ready(const Unit&) const {}
    __device__ __forceinline__ void done(const Unit&) const {}
};
struct EpiGateUp {
    static constexpr bool PERM = true, AFTER_DRAIN = false;
    bf16_t* H; const float* listw; int cap;
    __device__ __forceinline__ void operator()(const f32x4 (&acc)[2][2][4][2], const Unit& u, int wr, int wc, int fr, int fq) const {
        const int rl0 = wr * 64 + fr, col0 = u.pn * HALF + wc * 32 + 8 * fq;
#pragma unroll
        for (int ai = 0; ai < 2; ++ai)
#pragma unroll
            for (int m = 0; m < 4; ++m) {
                const int rl = rl0 + ai * HALF + m * 16, pos = u.p0 + rl;
                const float w = pos < u.cnt ? listw[(size_t)u.eb * cap + pos] : 0.f;
                bf16_t* rowp = H + (size_t)(u.pm * BM + rl) * 256 + col0;
                const f32x4 g0 = acc[ai][0][m][0], g1 = acc[ai][0][m][1], u0 = acc[ai][1][m][0], u1 = acc[ai][1][m][1];
                u32x4 o;
                o.x = cvt_pk_bf16(g0[0] * sigm(g0[0]) * u0[0] * w, g0[1] * sigm(g0[1]) * u0[1] * w); o.y = cvt_pk_bf16(g0[2] * sigm(g0[2]) * u0[2] * w, g0[3] * sigm(g0[3]) * u0[3] * w);
                o.z = cvt_pk_bf16(g1[0] * sigm(g1[0]) * u1[0] * w, g1[1] * sigm(g1[1]) * u1[1] * w); o.w = cvt_pk_bf16(g1[2] * sigm(g1[2]) * u1[2] * w, g1[3] * sigm(g1[3]) * u1[3] * w);
                *(u32x4*)rowp = o;
            }
    }
};
struct EpiDown {
    static constexpr bool PERM = true, AFTER_DRAIN = false;
    bf16_t* P1; long d12; const unsigned* list; int cap;
    __device__ __forceinline__ void operator()(const f32x4 (&acc)[2][2][4][2], const Unit& u, int wr, int wc, int fr, int fq) const {
        const int rl0 = wr * 64 + fr, col0 = u.pn * BM + wc * 32 + 8 * fq;
#pragma unroll
        for (int ai = 0; ai < 2; ++ai) {
            unsigned ent[4];
#pragma unroll
            for (int m = 0; m < 4; ++m) { const int pos = u.p0 + rl0 + ai * HALF + m * 16; ent[m] = pos < u.cnt ? list[(size_t)u.eb * cap + pos] : 0xffffffffu; }
#pragma unroll
            for (int m = 0; m < 4; ++m) {
                if (ent[m] != 0xffffffffu) {
                    bf16_t* dst = P1 + (long)(ent[m] & 1u) * d12 + (size_t)(ent[m] >> 1) * 1024 + col0;
#pragma unroll
                    for (int bj = 0; bj < 2; ++bj) { const f32x4 v0 = acc[ai][bj][m][0], v1 = acc[ai][bj][m][1];
                        u32x4 w; w.x = cvt_pk_bf16(v0[0], v0[1]); w.y = cvt_pk_bf16(v0[2], v0[3]); w.z = cvt_pk_bf16(v1[0], v1[1]); w.w = cvt_pk_bf16(v1[2], v1[3]);
                        *(u32x4*)(dst + bj * HALF) = w; }
                }
            }
            asm volatile("" ::: "memory");
        }
    }
};

struct BatchOrder {
    int nb, nM, nN, G, c;
    __device__ __forceinline__ bool next(int i, Unit& u) const {
        const long L = (long)i * G + c; if (L >= (long)nb * nM * nN) return false;
        const int per = nM * nN, e = (int)L / per, rem = (int)L % per;
        u.eb = e; u.pm = rem / nN; u.pn = rem % nN; u.p0 = 0; u.cnt = 0; return true;
    }
    __device__ __forceinline__ void a_ready(const Unit&) const {}
    __device__ __forceinline__ void done(const Unit&) const {}
};
struct EpiInProj {
    static constexpr bool PERM = true, AFTER_DRAIN = false;
    bf16_t* Zo; bf16_t* U;
    __device__ __forceinline__ void operator()(const f32x4 (&acc)[2][2][4][2], const Unit& u, int wr, int wc, int fr, int fq) const {
        const int row0 = u.pm * BM + wr * 64 + fr;
#pragma unroll
        for (int ai = 0; ai < 2; ++ai)
#pragma unroll
            for (int m = 0; m < 4; ++m) { const int row = row0 + ai * HALF + m * 16;
#pragma unroll
                for (int bj = 0; bj < 2; ++bj) { const int c0 = u.pn * BM + bj * HALF + wc * 32 + 8 * fq;
                    const f32x4 v0 = acc[ai][bj][m][0], v1 = acc[ai][bj][m][1];
                    u32x4 w; w.x = cvt_pk_bf16(v0[0], v0[1]); w.y = cvt_pk_bf16(v0[2], v0[3]); w.z = cvt_pk_bf16(v1[0], v1[1]); w.w = cvt_pk_bf16(v1[2], v1[3]);
                    bf16_t* dst = u.pn < 2 ? U + ((size_t)((c0 >> 4) * 2048 + (row >> 4)) * 512 + (row & 15) * 16 + (c0 & 15)) : Zo + (size_t)row * 2048 + c0;
                    *(u32x4*)dst = w; } }
    }
};
struct EpiXloc {
    static constexpr bool PERM = false, AFTER_DRAIN = false;
    float* XL;
    __device__ __forceinline__ void operator()(const f32x4 (&acc)[2][2][4][2], const Unit& u, int wr, int wc, int fr, int fq) const {
        const int row0 = u.pm * BM + wr * 64 + fr, col0 = wc * 32 + 4 * fq;
#pragma unroll
        for (int ai = 0; ai < 2; ++ai)
#pragma unroll
            for (int m = 0; m < 4; ++m) { float* rowp = XL + ((size_t)u.eb * 2048 + row0 + ai * HALF + m * 16) * 128 + col0;
#pragma unroll
                for (int n = 0; n < 2; ++n) *(f32x4*)(rowp + n * 16) = acc[ai][0][m][n]; }
    }
};
__device__ __forceinline__ float gelu_t(float x) { const float u2 = -2.302208198f * (x + 0.044715f * x * x * x); return x * __builtin_amdgcn_rcpf(1.0f + __builtin_amdgcn_exp2f(u2)); }
struct EpiSsmOut {
    static constexpr bool PERM = true, AFTER_DRAIN = false;
    bf16_t* G;
    __device__ __forceinline__ void operator()(const f32x4 (&acc)[2][2][4][2], const Unit& u, int wr, int wc, int fr, int fq) const {
        const int row0 = u.pm * BM + wr * 64 + fr;
#pragma unroll
        for (int ai = 0; ai < 2; ++ai)
#pragma unroll
            for (int m = 0; m < 4; ++m) { const int row = row0 + ai * HALF + m * 16;
#pragma unroll
                for (int bj = 0; bj < 2; ++bj) { const int n0 = bj * HALF + wc * 32 + 8 * fq;
                    const f32x4 v0 = acc[ai][bj][m][0], v1 = acc[ai][bj][m][1];
                    u32x4 w; w.x = cvt_pk_bf16(gelu_t(v0[0]), gelu_t(v0[1])); w.y = cvt_pk_bf16(gelu_t(v0[2]), gelu_t(v0[3])); w.z = cvt_pk_bf16(gelu_t(v1[0]), gelu_t(v1[1])); w.w = cvt_pk_bf16(gelu_t(v1[2]), gelu_t(v1[3]));
                    *(u32x4*)(G + ((size_t)row * 16 + (n0 >> 4)) * 512 + u.eb * 16 + (n0 & 15)) = w; } }
    }
};

struct CmpOrder {
    int G, c;
    __device__ __forceinline__ bool next(int i, Unit& u) const { const int L = i * G + c; if (L >= 32) return false; u.eb = L >> 4; u.pm = L & 15; u.pn = 0; u.p0 = 0; u.cnt = 0; return true; }
    __device__ __forceinline__ void a_ready(const Unit&) const {}
    __device__ __forceinline__ void done(const Unit&) const {}
};
struct EpiCmpHid {
    static constexpr bool PERM = false, AFTER_DRAIN = false;
    bf16_t* HC; const float* bias;
    __device__ __forceinline__ void operator()(const f32x4 (&acc)[2][2][4][2], const Unit& u, int wr, int wc, int fr, int fq) const {
        if (wc < 2) {
            const int row0 = u.pm * BM + wr * 64 + fr, col0 = wc * 32 + 4 * fq;
#pragma unroll
            for (int n = 0; n < 2; ++n) { const f32x4 bv = *(const f32x4*)(bias + u.eb * 64 + col0 + n * 16);
#pragma unroll
                for (int ai = 0; ai < 2; ++ai)
#pragma unroll
                    for (int m = 0; m < 4; ++m) { const f32x4 v = acc[ai][0][m][n] + bv;
                        typedef unsigned u32x2_ __attribute__((ext_vector_type(2)));
                        u32x2_ w; w.x = cvt_pk_bf16(gelu_t(v[0]), gelu_t(v[1])); w.y = cvt_pk_bf16(gelu_t(v[2]), gelu_t(v[3]));
                        *(u32x2_*)(HC + ((size_t)u.eb * 4096 + row0 + ai * HALF + m * 16) * 64 + col0 + n * 16) = w; } }
        }
    }
};

struct SingleUnit {
    int eb, pm;
    __device__ __forceinline__ bool next(int i, Unit& u) const { if (i > 0) return false; u.eb = eb; u.pm = pm; u.pn = 0; u.p0 = 0; u.cnt = 0; return true; }
    __device__ __forceinline__ void a_ready(const Unit&) const {}
    __device__ __forceinline__ void done(const Unit&) const {}
};
}

struct Args { const float* in[26]; float* out; unsigned char* ws; int ph_lo, ph_hi; };

struct Frame {
    LAS unsigned char* lds;
    int tid, lane, wave, blk, G;
};

__device__ __forceinline__ f32x4 bf4(u32x2 p) { f32x4 r; r.x = __uint_as_float(p.x << 16); r.y = __uint_as_float(p.x & 0xffff0000u); r.z = __uint_as_float(p.y << 16); r.w = __uint_as_float(p.y & 0xffff0000u); return r; }
__device__ __forceinline__ void ph_norm(const Frame& F, const float* xin, const bf16* add, const bf16* add2, float* xout, const float* g, bf16* hn) {
    const int gw = F.blk * NWAVES + F.wave, NGW = F.G * NWAVES;
    f32x4 gg[4];
#pragma unroll
    for (int j = 0; j < 4; ++j) gg[j] = ((const f32x4*)g)[F.lane + 64 * j];
    f32x4 nv[4]; u32x2 na[4], nb[4];
    if (gw < T) {
#pragma unroll
        for (int j = 0; j < 4; ++j) { nv[j] = ((const f32x4*)(xin + (size_t)gw * DM))[F.lane + 64 * j];
            if (add) { na[j] = ((const u32x2*)(add + (size_t)gw * DM))[F.lane + 64 * j]; nb[j] = ((const u32x2*)(add2 + (size_t)gw * DM))[F.lane + 64 * j]; } }
    }
    for (int row = gw; row < T; row += NGW) {
        f32x4 v[4]; float s = 0.f;
#pragma unroll
        for (int j = 0; j < 4; ++j) { v[j] = nv[j]; if (add) v[j] += bf4(na[j]) + bf4(nb[j]); }
        const int nrow = row + NGW;
        if (nrow < T) {
#pragma unroll
            for (int j = 0; j < 4; ++j) { nv[j] = ((const f32x4*)(xin + (size_t)nrow * DM))[F.lane + 64 * j];
                if (add) { na[j] = ((const u32x2*)(add + (size_t)nrow * DM))[F.lane + 64 * j]; nb[j] = ((const u32x2*)(add2 + (size_t)nrow * DM))[F.lane + 64 * j]; } }
        }
#pragma unroll
        for (int j = 0; j < 4; ++j) { if (add) ((f32x4*)(xout + (size_t)row * DM))[F.lane + 64 * j] = v[j];
            s += v[j].x * v[j].x + v[j].y * v[j].y + v[j].z * v[j].z + v[j].w * v[j].w; }
        s = wave_sum(s, F.lane);
        const float r = rsqrtf(s * (1.0f / DM) + EPS);
#pragma unroll
        for (int j = 0; j < 4; ++j) {
            u32x2 o; o.x = pk2(v[j].x * r * gg[j].x, v[j].y * r * gg[j].y); o.y = pk2(v[j].z * r * gg[j].z, v[j].w * r * gg[j].w);
            *(u32x2*)(hn + (size_t)row * DM + (F.lane + 64 * j) * 4) = o;
        }
    }
}
__device__ __forceinline__ void ph_final_norm(const Frame& F, float* x, const bf16* add, const bf16* add2, const float* g) {
    const int gw = F.blk * NWAVES + F.wave, NGW = F.G * NWAVES;
    f32x4 gg[4];
#pragma unroll
    for (int j = 0; j < 4; ++j) gg[j] = ((const f32x4*)g)[F.lane + 64 * j];
    f32x4 nv[4]; u32x2 na[4], nb[4];
    if (gw < T) {
#pragma unroll
        for (int j = 0; j < 4; ++j) { nv[j] = ((const f32x4*)(x + (size_t)gw * DM))[F.lane + 64 * j]; na[j] = ((const u32x2*)(add + (size_t)gw * DM))[F.lane + 64 * j]; nb[j] = ((const u32x2*)(add2 + (size_t)gw * DM))[F.lane + 64 * j]; }
    }
    for (int row = gw; row < T; row += NGW) {
        f32x4 v[4]; float s = 0.f;
#pragma unroll
        for (int j = 0; j < 4; ++j) { v[j] = nv[j] + bf4(na[j]) + bf4(nb[j]); s += v[j].x * v[j].x + v[j].y * v[j].y + v[j].z * v[j].z + v[j].w * v[j].w; }
        const int nrow = row + NGW;
        if (nrow < T) {
#pragma unroll
            for (int j = 0; j < 4; ++j) { nv[j] = ((const f32x4*)(x + (size_t)nrow * DM))[F.lane + 64 * j]; na[j] = ((const u32x2*)(add + (size_t)nrow * DM))[F.lane + 64 * j]; nb[j] = ((const u32x2*)(add2 + (size_t)nrow * DM))[F.lane + 64 * j]; }
        }
        s = wave_sum(s, F.lane);
        const float r = rsqrtf(s * (1.0f / DM) + EPS);
#pragma unroll
        for (int j = 0; j < 4; ++j) {
            f32x4 o; o.x = v[j].x * r * gg[j].x; o.y = v[j].y * r * gg[j].y; o.z = v[j].z * r * gg[j].z; o.w = v[j].w * r * gg[j].w;
            ((f32x4*)(x + (size_t)row * DM))[F.lane + 64 * j] = o;
        }
    }
}

template <bool DUAL, class Epi>
__device__ __forceinline__ void sgemm_naive(const Frame& F, const bf16* A, int lda, const float* B, int ldb, int M, int N, int K, int dualoff, const Epi& epi) {
    LAS float* As = (LAS float*)F.lds;
    LAS float* Bs = As + 16 * 132;
    LAS float* Bs2 = Bs + 16 * 128;
    const int tiles_n = (N + 127) / 128, tiles_m = M / 128;
    const int tx = F.tid & 31, ty = F.tid >> 5;
    for (int tile = F.blk; tile < tiles_m * tiles_n; tile += F.G) {
        const int tm = tile / tiles_n, tn = tile % tiles_n;
        float acc[8][4], acc2[8][4];
#pragma unroll
        for (int i = 0; i < 8; ++i)
#pragma unroll
            for (int j = 0; j < 4; ++j) { acc[i][j] = 0.f; acc2[i][j] = 0.f; }
        const int arow = F.tid >> 2, akq = (F.tid & 3) * 4;
        const int bk = F.tid >> 5, bn = (F.tid & 31) * 4;
        for (int k0 = 0; k0 < K; k0 += 16) {
            {
                const u32x2 av = *(const u32x2*)(A + (size_t)(tm * 128 + arow) * lda + k0 + akq);
                As[(akq + 0) * 132 + arow] = __uint_as_float(av.x << 16);
                As[(akq + 1) * 132 + arow] = __uint_as_float(av.x & 0xffff0000u);
                As[(akq + 2) * 132 + arow] = __uint_as_float(av.y << 16);
                As[(akq + 3) * 132 + arow] = __uint_as_float(av.y & 0xffff0000u);
                const int col = tn * 128 + bn;
                f32x4 bv = (f32x4){0.f, 0.f, 0.f, 0.f};
                const float* bp = B + (size_t)(k0 + bk) * ldb + col;
                if (col + 3 < N) { bv.x = bp[0]; bv.y = bp[1]; bv.z = bp[2]; bv.w = bp[3]; }
                else { if (col < N) bv.x = bp[0]; if (col + 1 < N) bv.y = bp[1]; if (col + 2 < N) bv.z = bp[2]; }
                *(LAS f32x4*)(Bs + bk * 128 + bn) = bv;
                if (DUAL) {
                    const float* bp2 = bp + dualoff;
                    f32x4 bw; bw.x = bp2[0]; bw.y = bp2[1]; bw.z = bp2[2]; bw.w = bp2[3];
                    *(LAS f32x4*)(Bs2 + bk * 128 + bn) = bw;
                }
            }
            __syncthreads();
#pragma unroll 4
            for (int k = 0; k < 16; ++k) {
                float a[8];
                const f32x4 a0 = *(const LAS f32x4*)(As + k * 132 + ty * 8), a1 = *(const LAS f32x4*)(As + k * 132 + ty * 8 + 4);
                a[0] = a0.x; a[1] = a0.y; a[2] = a0.z; a[3] = a0.w; a[4] = a1.x; a[5] = a1.y; a[6] = a1.z; a[7] = a1.w;
                const f32x4 b = *(const LAS f32x4*)(Bs + k * 128 + tx * 4);
#pragma unroll
                for (int i = 0; i < 8; ++i) { acc[i][0] += a[i] * b.x; acc[i][1] += a[i] * b.y; acc[i][2] += a[i] * b.z; acc[i][3] += a[i] * b.w; }
                if (DUAL) {
                    const f32x4 b2 = *(const LAS f32x4*)(Bs2 + k * 128 + tx * 4);
#pragma unroll
                    for (int i = 0; i < 8; ++i) { acc2[i][0] += a[i] * b2.x; acc2[i][1] += a[i] * b2.y; acc2[i][2] += a[i] * b2.z; acc2[i][3] += a[i] * b2.w; }
                }
            }
            __syncthreads();
        }
#pragma unroll
        for (int i = 0; i < 8; ++i)
#pragma unroll
            for (int j = 0; j < 4; ++j) {
                const int row = tm * 128 + ty * 8 + i, col = tn * 128 + tx * 4 + j;
                if (col < N) epi(row, col, acc[i][j], acc2[i][j]);
            }
    }
}
struct EpiStoreBf16 { bf16* O; int ldo; __device__ __forceinline__ void operator()(int r, int c, float a, float) const { O[(size_t)r * ldo + c] = (bf16)f2bf(a); } };
struct EpiGlu { bf16* O; int ldo; __device__ __forceinline__ void operator()(int r, int c, float a, float b) const { O[(size_t)r * ldo + c] = (bf16)f2bf(a * sigmoidf_(b)); } };
struct EpiResid { const float* X; float* O; __device__ __forceinline__ void operator()(int r, int c, float a, float) const { O[(size_t)r * DM + c] = X[(size_t)r * DM + c] + a; } };

__device__ __forceinline__ void ssm_naive_item(int b, int g, const float* a_re, const float* a_im, const float* b_re, const float* b_im, const float* c_re, const float* c_im,
                                               const float* dpar, const float* log_dt, const bf16* Z, bf16* G1, int lane) {
    const int p = lane;
    const float are = a_re[g * 64 + p], aim = a_im[g * 64 + p], dt = expf(log_dt[g]);
    const float er = expf(are * dt), lbr = er * cosf(aim * dt), lbi = er * sinf(aim * dt);
    const float xx = lbr - 1.0f, yy = lbi, den = are * are + aim * aim;
    const float fr = (xx * are + yy * aim) / den, fi = (yy * are - xx * aim) / den;
    float bbr[16], bbi[16], cr[16], ci[16];
#pragma unroll
    for (int h = 0; h < 16; ++h) {
        const float br = b_re[(g * 64 + p) * 16 + h], bi = b_im[(g * 64 + p) * 16 + h];
        bbr[h] = fr * br - fi * bi; bbi[h] = fr * bi + fi * br;
        cr[h] = c_re[(g * 16 + h) * 64 + p]; ci[h] = c_im[(g * 16 + h) * 64 + p];
    }
    const float dd = dpar[g * 16 + (lane & 15)];
    float xr = 0.f, xi = 0.f;
    for (int t = 0; t < SEQ; ++t) {
        const size_t row = (size_t)b * SEQ + t;
        const u32x4 u0 = *(const u32x4*)(Z + row * ZP + ZC_U + g * 16), u1 = *(const u32x4*)(Z + row * ZP + ZC_U + g * 16 + 8);
        float u[16];
        u[0] = __uint_as_float(u0.x << 16); u[1] = __uint_as_float(u0.x & 0xffff0000u); u[2] = __uint_as_float(u0.y << 16); u[3] = __uint_as_float(u0.y & 0xffff0000u);
        u[4] = __uint_as_float(u0.z << 16); u[5] = __uint_as_float(u0.z & 0xffff0000u); u[6] = __uint_as_float(u0.w << 16); u[7] = __uint_as_float(u0.w & 0xffff0000u);
        u[8] = __uint_as_float(u1.x << 16); u[9] = __uint_as_float(u1.x & 0xffff0000u); u[10] = __uint_as_float(u1.y << 16); u[11] = __uint_as_float(u1.y & 0xffff0000u);
        u[12] = __uint_as_float(u1.z << 16); u[13] = __uint_as_float(u1.z & 0xffff0000u); u[14] = __uint_as_float(u1.w << 16); u[15] = __uint_as_float(u1.w & 0xffff0000u);
        float bur = 0.f, bui = 0.f;
#pragma unroll
        for (int h = 0; h < 16; ++h) { bur += bbr[h] * u[h]; bui += bbi[h] * u[h]; }
        const float nxr = lbr * xr - lbi * xi + bur, nxi = lbr * xi + lbi * xr + bui;
        xr = nxr; xi = nxi;
        float y = 0.f;
#pragma unroll
        for (int h = 0; h < 16; ++h) { const float v = wave_sum(cr[h] * xr - ci[h] * xi, lane); if (lane == h) y = v; }
        if (lane < 16) {
            const float ul = bf2f(Z[row * ZP + ZC_U + g * 16 + lane]);
            G1[row * D_SSM + g * 16 + lane] = (bf16)f2bf(gelu_tanh(y + dd * ul));
        }
    }
}
__device__ __forceinline__ void compress_naive_item(int item, const bf16* Z, const float* pos, const float* w1, const float* w2, bf16* KC, bf16* VC, int lane) {
    const int i = item & 1, hkv = (item >> 1) & 1, n = (item >> 2) % NCMPP, b = (item >> 2) / NCMPP;
    bf16* dst = i ? VC : KC;
    if (n == NCMP) { dst[(((size_t)b * NCMPP + n) * 2 + hkv) * 64 + lane] = 0; return; }
    const float* posi = pos + i * 32 * 64; const float* w1i = w1 + (size_t)i * 32 * 64 * 64; const float* w2i = w2 + i * 64 * 64;
    float acc = 0.f;
    for (int l = 0; l < 32; ++l) {
        const bf16* zr = Z + ((size_t)b * SEQ + 16 * n + l) * ZP + ZC_KV + i * 128 + hkv * 64;
        for (int d = 0; d < 64; ++d) acc += (bf2f(zr[d]) + posi[l * 64 + d]) * w1i[(l * 64 + d) * 64 + lane];
    }
    const float hid = gelu_tanh(acc);
    float o = 0.f;
    for (int e = 0; e < 64; ++e) o += lane_bcast(hid, e) * w2i[e * 64 + lane];
    dst[(((size_t)b * NCMPP + n) * 2 + hkv) * 64 + lane] = (bf16)f2bf(o);
}

__device__ __forceinline__ void attn_chunk(LAS float* wl, const bf16* Z, const float* rel_bias, int b, int hkv, int t, int base, int kcol, int vcol, int lane,
                                           float (&m)[4], float (&l)[4], float (&o)[4]) {
    const int pos = base + lane; const bool valid = (pos >= 0) && (pos <= t);
    const int posc = pos < 0 ? 0 : (pos > SEQ - 1 ? SEQ - 1 : pos);
    const bf16* kr = Z + ((size_t)b * SEQ + posc) * ZP + kcol + hkv * 64;
    float s[4] = {0.f, 0.f, 0.f, 0.f};
#pragma unroll 2
    for (int c = 0; c < 8; ++c) {
        const u32x4 kv = *(const u32x4*)(kr + c * 8);
        float k[8];
        k[0] = __uint_as_float(kv.x << 16); k[1] = __uint_as_float(kv.x & 0xffff0000u); k[2] = __uint_as_float(kv.y << 16); k[3] = __uint_as_float(kv.y & 0xffff0000u);
        k[4] = __uint_as_float(kv.z << 16); k[5] = __uint_as_float(kv.z & 0xffff0000u); k[6] = __uint_as_float(kv.w << 16); k[7] = __uint_as_float(kv.w & 0xffff0000u);
#pragma unroll
        for (int g = 0; g < 4; ++g) {
            const f32x4 q0 = *(const LAS f32x4*)(wl + g * 64 + c * 8), q1 = *(const LAS f32x4*)(wl + g * 64 + c * 8 + 4);
            s[g] += q0.x * k[0] + q0.y * k[1] + q0.z * k[2] + q0.w * k[3] + q1.x * k[4] + q1.y * k[5] + q1.z * k[6] + q1.w * k[7];
        }
    }
    const int bk = t5_bucket(t - pos);
#pragma unroll
    for (int g = 0; g < 4; ++g) {
        const float sv = valid ? s[g] + rel_bias[bk * 8 + hkv * 4 + g] : -1e30f;
        const float mn = fmaxf(m[g], wave_max(sv, lane));
        const float alpha = __expf(m[g] - mn);
        const float p = valid ? __expf(sv - mn) : 0.f;
        l[g] = l[g] * alpha + wave_sum(p, lane);
        o[g] *= alpha; m[g] = mn;
        wl[256 + g * 64 + lane] = p;
    }
#pragma unroll 4
    for (int key = 0; key < 64; ++key) {
        int pk = base + key; pk = pk < 0 ? 0 : (pk > SEQ - 1 ? SEQ - 1 : pk);
        const float v = bf2f(Z[((size_t)b * SEQ + pk) * ZP + vcol + hkv * 64 + lane]);
#pragma unroll
        for (int g = 0; g < 4; ++g) o[g] += wl[256 + g * 64 + key] * v;
    }
}
__device__ __forceinline__ void attn_naive_item(LAS float* wl, int b, int hkv, int t, const bf16* Z, const float* KC, const float* VC, const float* rel_bias, bf16* YC, int lane) {
    const size_t row = (size_t)b * SEQ + t;
#pragma unroll
    for (int g = 0; g < 4; ++g) wl[g * 64 + lane] = bf2f(Z[row * ZP + ZC_Q + hkv * 256 + g * 64 + lane]) * 0.125f;
#pragma unroll 1
    for (int c = 0; c < 4; ++c) {
        const int n = c * 64 + lane; const bool valid = (n < NCMP) && (16 * n + 31 <= t);
        const float* kr = KC + (((size_t)b * NCMPP + (n < NCMP ? n : 0)) * 2 + hkv) * 64;
        float s[4] = {0.f, 0.f, 0.f, 0.f};
#pragma unroll 4
        for (int d4 = 0; d4 < 16; ++d4) {
            const f32x4 k = *(const f32x4*)(kr + d4 * 4);
#pragma unroll
            for (int g = 0; g < 4; ++g) { const f32x4 q = *(const LAS f32x4*)(wl + g * 64 + d4 * 4); s[g] += q.x * k.x + q.y * k.y + q.z * k.z + q.w * k.w; }
        }
        const int bk = t5_bucket(t - (16 * n + 31));
#pragma unroll
        for (int g = 0; g < 4; ++g) wl[256 + g * 256 + n] = valid ? s[g] + rel_bias[bk * 8 + hkv * 4 + g] : -1e30f;
    }
#pragma unroll
    for (int g = 0; g < 4; ++g) {
        float sc[4];
#pragma unroll
        for (int c = 0; c < 4; ++c) sc[c] = wl[256 + g * 256 + c * 64 + lane];
        const float mx = wave_max(fmaxf(fmaxf(sc[0], sc[1]), fmaxf(sc[2], sc[3])), lane);
        float e[4], ls = 0.f;
#pragma unroll
        for (int c = 0; c < 4; ++c) { e[c] = sc[c] > -1e29f ? __expf(sc[c] - mx) : 0.f; ls += e[c]; }
        ls = wave_sum(ls, lane);
        const float inv = ls > 0.f ? 1.0f / ls : 0.f;
#pragma unroll
        for (int c = 0; c < 4; ++c) wl[256 + g * 256 + c * 64 + lane] = e[c] * inv;
    }
    float oc[4] = {0.f, 0.f, 0.f, 0.f};
    const int nmax = t >= 31 ? ((t - 31) / 16 + 1 < NCMP ? (t - 31) / 16 + 1 : NCMP) : 0;
#pragma unroll 4
    for (int n = 0; n < nmax; ++n) {
        const float v = VC[(((size_t)b * NCMPP + n) * 2 + hkv) * 64 + lane];
#pragma unroll
        for (int g = 0; g < 4; ++g) oc[g] += wl[256 + g * 256 + n] * v;
    }
    float imp = 0.f;
#pragma unroll
    for (int g = 0; g < 4; ++g) {
        const LAS float* P = wl + 256 + g * 256;
        imp += P[4 * lane] + P[4 * lane + 1] + P[4 * lane + 2] + 0.5f * P[4 * lane + 3] + (lane > 0 ? 0.5f * P[4 * lane - 1] : 0.f);
    }
    const int blk = t >> 6;
    const bool forced = (lane == 0) || (lane <= blk && lane > blk - 2), future = lane > blk;
    const float v = forced ? 1e9f : (future ? -1e9f : imp);
    int rank = 0;
    for (int jj = 0; jj < 64; ++jj) { const float vj = lane_bcast(v, jj); rank += (vj > v) || (vj == v && jj < lane); }
    unsigned long long mask = __ballot(rank < 16 && !future);
    float m[4], l[4], o[4];
#pragma unroll
    for (int g = 0; g < 4; ++g) { m[g] = -1e30f; l[g] = 0.f; o[g] = 0.f; }
    while (mask) {
        const int j = __builtin_ctzll(mask); mask &= mask - 1;
        attn_chunk(wl, Z, rel_bias, b, hkv, t, 64 * j, ZC_KV + 256, ZC_KV + 384, lane, m, l, o);
    }
    float os[4];
#pragma unroll
    for (int g = 0; g < 4; ++g) { os[g] = l[g] > 0.f ? o[g] / l[g] : 0.f; m[g] = -1e30f; l[g] = 0.f; o[g] = 0.f; }
    for (int c = 0; c < 8; ++c) attn_chunk(wl, Z, rel_bias, b, hkv, t, t - 511 + 64 * c, ZC_KV + 512, ZC_KV + 640, lane, m, l, o);
#pragma unroll
    for (int g = 0; g < 4; ++g) {
        const float ow = l[g] > 0.f ? o[g] / l[g] : 0.f;
        const bf16* gp = Z + row * ZP + ZC_G + hkv * 12 + g * 3;
        const float r = sigmoidf_(bf2f(gp[0])) * oc[g] + sigmoidf_(bf2f(gp[1])) * os[g] + sigmoidf_(bf2f(gp[2])) * ow;
        YC[row * DM + D_SSM + hkv * 256 + g * 64 + lane] = (bf16)f2bf(r);
    }
}

__device__ __forceinline__ void ph_norm_route(const Frame& F, const float* x, const float* g, const float* rgw, const float* rgb, const float* rew, const float* reb, bf16* hn,
                                              unsigned* gcnt, unsigned* list, float* listw) {
    LAS f32x4* RG = (LAS f32x4*)F.lds; LAS f32x4* RE = RG + 1024;
    LAS unsigned* cnt_l = (LAS unsigned*)(F.lds + 147456); LAS unsigned* base_l = cnt_l + 32; LAS unsigned* ent = cnt_l + 64;
    for (int d = F.tid; d < 1024; d += NTHR) { const int ln = d & 63, jc = d >> 6, row = (ln + 64 * (jc >> 2)) * 4 + (jc & 3); RG[d] = ((const f32x4*)rgw)[row]; }
    { f32x4 t[16];
#pragma unroll
      for (int k = 0; k < 16; ++k) { const int d = F.tid + k * NTHR, ln = d & 63, q = d >> 6, half = q & 1, c = (q >> 1) & 3, j = (q >> 3) & 3, gi = q >> 5, row = (ln + 64 * j) * 4 + c;
          t[k] = ((const f32x4*)rew)[((size_t)gi * DM + row) * 2 + half]; }
#pragma unroll
      for (int k = 0; k < 16; ++k) RE[F.tid + k * NTHR] = t[k]; }
    __syncthreads();
    for (int row0 = F.blk * 128; row0 < T; row0 += F.G * 128) {
        if (F.tid < 32) cnt_l[F.tid] = 0u;
        __syncthreads();
        f32x4 nv[4];
#pragma unroll
        for (int j = 0; j < 4; ++j) nv[j] = ((const f32x4*)(x + (size_t)(row0 + F.wave * 16) * DM))[F.lane + 64 * j];
        for (int kk = 0; kk < 16; ++kk) {
            const int row = row0 + F.wave * 16 + kk;
            f32x4 v[4]; float s = 0.f;
#pragma unroll
            for (int j = 0; j < 4; ++j) { v[j] = nv[j]; s += v[j].x * v[j].x + v[j].y * v[j].y + v[j].z * v[j].z + v[j].w * v[j].w; }
            if (kk < 15) {
#pragma unroll
                for (int j = 0; j < 4; ++j) nv[j] = ((const f32x4*)(x + (size_t)(row + 1) * DM))[F.lane + 64 * j]; }
            s = wave_sum(s, F.lane);
            const float r = rsqrtf(s * (1.0f / DM) + EPS);
            float lg[4] = {0.f, 0.f, 0.f, 0.f};
#pragma unroll
            for (int j = 0; j < 4; ++j) {
                const f32x4 gg = ((const f32x4*)g)[F.lane + 64 * j];
                v[j].x = v[j].x * r * gg.x; v[j].y = v[j].y * r * gg.y; v[j].z = v[j].z * r * gg.z; v[j].w = v[j].w * r * gg.w;
                u32x2 o; o.x = pk2(v[j].x, v[j].y); o.y = pk2(v[j].z, v[j].w);
                *(u32x2*)(hn + (size_t)row * DM + (F.lane + 64 * j) * 4) = o;
                const f32x4 w0 = RG[(j * 4 + 0) * 64 + F.lane], w1 = RG[(j * 4 + 1) * 64 + F.lane], w2 = RG[(j * 4 + 2) * 64 + F.lane], w3 = RG[(j * 4 + 3) * 64 + F.lane];
                lg[0] += v[j].x * w0.x + v[j].y * w1.x + v[j].z * w2.x + v[j].w * w3.x;
                lg[1] += v[j].x * w0.y + v[j].y * w1.y + v[j].z * w2.y + v[j].w * w3.y;
                lg[2] += v[j].x * w0.z + v[j].y * w1.z + v[j].z * w2.z + v[j].w * w3.z;
                lg[3] += v[j].x * w0.w + v[j].y * w1.w + v[j].z * w2.w + v[j].w * w3.w;
            }
#pragma unroll
            for (int o = 0; o < 4; ++o) lg[o] = wave_sum(lg[o], F.lane) + rgb[o];
            int gi = 0; float gm = lg[0];
#pragma unroll
            for (int o = 1; o < 4; ++o) if (lg[o] > gm) { gm = lg[o]; gi = o; }
            float gs = 0.f;
#pragma unroll
            for (int o = 0; o < 4; ++o) gs += __expf(lg[o] - gm);
            const float gval = 1.0f / gs;
            const LAS f32x4* we = RE + gi * 2048;
            float le[8] = {0.f, 0.f, 0.f, 0.f, 0.f, 0.f, 0.f, 0.f};
#pragma unroll
            for (int j = 0; j < 4; ++j) {
                const float hv[4] = {v[j].x, v[j].y, v[j].z, v[j].w};
#pragma unroll
                for (int c = 0; c < 4; ++c) {
                    const f32x4 wa = we[((j * 4 + c) * 2 + 0) * 64 + F.lane], wb = we[((j * 4 + c) * 2 + 1) * 64 + F.lane];
                    le[0] += hv[c] * wa.x; le[1] += hv[c] * wa.y; le[2] += hv[c] * wa.z; le[3] += hv[c] * wa.w;
                    le[4] += hv[c] * wb.x; le[5] += hv[c] * wb.y; le[6] += hv[c] * wb.z; le[7] += hv[c] * wb.w;
                }
            }
#pragma unroll
            for (int e = 0; e < 8; ++e) le[e] = wave_sum(le[e], F.lane) + reb[gi * 8 + e];
            int e1 = 0; float m1 = le[0];
#pragma unroll
            for (int e = 1; e < 8; ++e) if (le[e] > m1) { m1 = le[e]; e1 = e; }
            int e2 = -1; float m2 = -3.0e38f;
#pragma unroll
            for (int e = 0; e < 8; ++e) if (e != e1 && le[e] > m2) { m2 = le[e]; e2 = e; }
            const float p2 = __expf(m2 - m1), inv = 1.0f / (1.0f + p2);
            if (F.lane == 0) {
                const unsigned ea = (unsigned)(gi * 8 + e1), eb = (unsigned)(gi * 8 + e2);
                const unsigned pa = __hip_atomic_fetch_add(cnt_l + ea, 1u, __ATOMIC_RELAXED, __HIP_MEMORY_SCOPE_WORKGROUP);
                const unsigned pb = __hip_atomic_fetch_add(cnt_l + eb, 1u, __ATOMIC_RELAXED, __HIP_MEMORY_SCOPE_WORKGROUP);
                LAS unsigned* en = ent + (F.wave * 16 + kk) * 6;
                en[0] = ea; en[1] = eb; en[2] = pa; en[3] = pb; en[4] = __float_as_uint(gval * inv); en[5] = __float_as_uint(gval * p2 * inv);
            }
        }
        __syncthreads();
        if (F.tid < 32) base_l[F.tid] = __hip_atomic_fetch_add(gcnt + F.tid * 64, cnt_l[F.tid], __ATOMIC_RELAXED, __HIP_MEMORY_SCOPE_AGENT);
        __syncthreads();
        if (F.tid < 128) {
            const LAS unsigned* en = ent + F.tid * 6; const unsigned tok = (unsigned)(row0 + F.tid);
            const unsigned ia = en[0] * LCAP + base_l[en[0]] + en[2], ib = en[1] * LCAP + base_l[en[1]] + en[3];
            list[ia] = tok * 2u; listw[ia] = __uint_as_float(en[4]);
            list[ib] = tok * 2u + 1u; listw[ib] = __uint_as_float(en[5]);
        }
        __syncthreads();
    }
}
__device__ __forceinline__ void build_expert_tab(const Frame& F, const unsigned* gcnt, LAS int* tab) {
    if (F.tid < 64) {
        const int c = F.lane < 32 ? (int)__hip_atomic_load(gcnt + F.lane * 64, __ATOMIC_RELAXED, __HIP_MEMORY_SCOPE_AGENT) : 0;
        int tiles = (c + 255) >> 8, incl = tiles;
#pragma unroll
        for (int o = 1; o < 32; o <<= 1) { const int t = __builtin_amdgcn_ds_bpermute((F.lane - o) << 2, incl); if (F.lane >= o) incl += t; }
        if (F.lane < 32) { tab[F.lane + 1] = incl; tab[33 + F.lane] = c; }
        if (F.lane == 0) tab[0] = 0;
    }
    __syncthreads();
}
__device__ __forceinline__ void ph_experts_naive(const Frame& F, const bf16* hn, const unsigned* route, const float* wg, const float* wu, const float* wd, float* x) {
    LAS float* hs = (LAS float*)F.lds;
    LAS float* hd = hs + 1024;
    for (int tok = F.blk; tok < T; tok += F.G) {
        { const unsigned pv = *(const unsigned*)(hn + (size_t)tok * DM + F.tid * 2); hs[F.tid * 2] = __uint_as_float(pv << 16); hs[F.tid * 2 + 1] = __uint_as_float(pv & 0xffff0000u); }
        const u32x4 rt = *(const u32x4*)(route + (size_t)tok * 4);
        __syncthreads();
        {
            const int s = F.tid >> 8, f = F.tid & 255;
            const unsigned e = s ? rt.y : rt.x; const float w = __uint_as_float(s ? rt.w : rt.z);
            const float* pg = wg + (size_t)e * DM * 256 + f; const float* pu = wu + (size_t)e * DM * 256 + f;
            float ga = 0.f, ua = 0.f;
            for (int d = 0; d < DM; ++d) { const float hv = hs[d]; ga += hv * pg[(size_t)d * 256]; ua += hv * pu[(size_t)d * 256]; }
            hd[s * 256 + f] = ga * sigmoidf_(ga) * ua * w;
        }
        __syncthreads();
        for (int dd = F.tid; dd < DM; dd += NTHR) {
            float acc = 0.f;
            const float* p0 = wd + (size_t)rt.x * 256 * DM + dd; const float* p1 = wd + (size_t)rt.y * 256 * DM + dd;
            for (int f = 0; f < 256; ++f) acc += hd[f] * p0[(size_t)f * DM];
            for (int f = 0; f < 256; ++f) acc += hd[256 + f] * p1[(size_t)f * DM];
            x[(size_t)tok * DM + dd] += acc;
        }
        __syncthreads();
    }
}


namespace nsa {
typedef short bf16x8 __attribute__((ext_vector_type(8)));
typedef short s16x4 __attribute__((ext_vector_type(4)));
typedef float f32x16 __attribute__((ext_vector_type(16)));
typedef float f32x2_t __attribute__((ext_vector_type(2)));
typedef __bf16 bf16x2_t __attribute__((ext_vector_type(2)));
constexpr int SLOTB = 8192;
constexpr int L_K = 0, L_V = 3 * SLOTB, L_IMP = 6 * SLOTB, L_BT = L_IMP + 65536, L_WS = L_BT + 4 * 132 * 4, L_RL = L_WS + 8 * 64 * 4, L_SM = L_RL + 4 * 64 * 4, L_END = L_SM + 64 * 8;
static_assert(L_END <= 131072, "nsa LDS map");
constexpr float LOG2E = 1.4426950408889634f;
constexpr float NEG_INF = -__builtin_inff();
#define NSA_SBAR() __builtin_amdgcn_sched_barrier(0)
__device__ __forceinline__ int crow(int r, int hi) { return (r & 3) + 8 * (r >> 2) + 4 * hi; }
__device__ __forceinline__ void glds16(const void* gsrc, unsigned lds_dst) { unsigned keep;
    asm volatile("s_mov_b32 %0, m0\n\ts_mov_b32 m0, %2\n\ts_nop 0\n\tglobal_load_lds_dwordx4 %1, off\n\ts_mov_b32 m0, %0" : "=&s"(keep) : "v"(gsrc), "s"(lds_dst) : "memory"); }
__device__ __forceinline__ unsigned cvtpk(float lo, float hi) { f32x2_t v = {lo, hi}; bf16x2_t b = __builtin_convertvector(v, bf16x2_t); return __builtin_bit_cast(unsigned, b); }
#define NSA_WAIT_BAR(N) asm volatile("s_waitcnt vmcnt(" #N ") lgkmcnt(0)\n\ts_barrier" ::: "memory")
__device__ __forceinline__ void qkt(f32x16& p0, f32x16& p1, const LAS char* kb, const bf16x8 (&qr)[4], const f32x16& cinit) {
#pragma unroll
    for (int d0 = 0; d0 < 4; ++d0) {
        const bf16x8 b0 = *(const LAS bf16x8*)(kb + d0 * 2048);
        const bf16x8 b1 = *(const LAS bf16x8*)(kb + d0 * 2048 + 512);
        if (d0 == 0) { p0 = __builtin_amdgcn_mfma_f32_32x32x16_bf16(b0, qr[0], cinit, 0, 0, 0); p1 = __builtin_amdgcn_mfma_f32_32x32x16_bf16(b1, qr[0], cinit, 0, 0, 0); }
        else { p0 = __builtin_amdgcn_mfma_f32_32x32x16_bf16(b0, qr[d0], p0, 0, 0, 0); p1 = __builtin_amdgcn_mfma_f32_32x32x16_bf16(b1, qr[d0], p1, 0, 0, 0); }
    }
}
__device__ __forceinline__ void pv(f32x16 (&o)[2], int vb, bf16x8 pa0, bf16x8 pa1, bf16x8 pa2, bf16x8 pa3) {
#pragma unroll
    for (int d0 = 0; d0 < 2; ++d0) { s16x4 lo[4], hi[4];
#pragma unroll
        for (int ks = 0; ks < 4; ++ks) {
            asm volatile("ds_read_b64_tr_b16 %0,%1 offset:%c2" : "=&v"(lo[ks]) : "v"(vb), "i"(d0 * 4096 + ks * 1024) : "memory");
            asm volatile("ds_read_b64_tr_b16 %0,%1 offset:%c2" : "=&v"(hi[ks]) : "v"(vb), "i"(d0 * 4096 + ks * 1024 + 512) : "memory"); }
        asm volatile("s_waitcnt lgkmcnt(0)" ::: "memory"); NSA_SBAR();
#define NSA_PK(k) (bf16x8){lo[k][0], lo[k][1], lo[k][2], lo[k][3], hi[k][0], hi[k][1], hi[k][2], hi[k][3]}
        o[d0] = __builtin_amdgcn_mfma_f32_32x32x16_bf16(pa0, NSA_PK(0), o[d0], 0, 0, 0);
        o[d0] = __builtin_amdgcn_mfma_f32_32x32x16_bf16(pa1, NSA_PK(1), o[d0], 0, 0, 0);
        o[d0] = __builtin_amdgcn_mfma_f32_32x32x16_bf16(pa2, NSA_PK(2), o[d0], 0, 0, 0);
        o[d0] = __builtin_amdgcn_mfma_f32_32x32x16_bf16(pa3, NSA_PK(3), o[d0], 0, 0, 0);
#undef NSA_PK
    }
}
typedef short v4i16_t __attribute__((ext_vector_type(4)));
__device__ __forceinline__ s16x4 vtr(const LAS char* p) { return __builtin_bit_cast(s16x4, __builtin_amdgcn_ds_read_tr16_b64_v4i16((LAS v4i16_t*)p)); }
__device__ __forceinline__ void pv2(f32x16 (&o)[2], const LAS char* vp, bf16x8 pa0, bf16x8 pa1, bf16x8 pa2, bf16x8 pa3) {
#pragma unroll
    for (int d0 = 0; d0 < 2; ++d0) {
        s16x4 lo[4], hi[4];
#pragma unroll
        for (int ks = 0; ks < 4; ++ks) { lo[ks] = vtr(vp + d0 * 4096 + ks * 1024); hi[ks] = vtr(vp + d0 * 4096 + ks * 1024 + 512); }
#define NSA_PK(k) (bf16x8){lo[k][0], lo[k][1], lo[k][2], lo[k][3], hi[k][0], hi[k][1], hi[k][2], hi[k][3]}
        o[d0] = __builtin_amdgcn_mfma_f32_32x32x16_bf16(pa0, NSA_PK(0), o[d0], 0, 0, 0);
        o[d0] = __builtin_amdgcn_mfma_f32_32x32x16_bf16(pa1, NSA_PK(1), o[d0], 0, 0, 0);
        o[d0] = __builtin_amdgcn_mfma_f32_32x32x16_bf16(pa2, NSA_PK(2), o[d0], 0, 0, 0);
        o[d0] = __builtin_amdgcn_mfma_f32_32x32x16_bf16(pa3, NSA_PK(3), o[d0], 0, 0, 0);
#undef NSA_PK
    }
}
__device__ __forceinline__ float other_half(float v, int hi) { auto rr = __builtin_amdgcn_permlane32_swap(__float_as_uint(v), __float_as_uint(v), false, false); return __uint_as_float(hi ? rr[0] : rr[1]); }
__device__ __forceinline__ float rowmax(const f32x16& p0, const f32x16& p1, int hi) {
    float a = fmaxf(fmaxf(p0[0], p0[1]), p1[0]), b = fmaxf(fmaxf(p0[2], p0[3]), p1[1]); a = fmaxf(fmaxf(a, p1[2]), p1[3]);
#pragma unroll
    for (int r = 4; r < 16; r += 4) { a = fmaxf(fmaxf(a, p0[r]), p0[r + 1]); b = fmaxf(fmaxf(b, p0[r + 2]), p0[r + 3]); a = fmaxf(fmaxf(a, p1[r]), p1[r + 1]); b = fmaxf(fmaxf(b, p1[r + 2]), p1[r + 3]); }
    const float m = fmaxf(a, b);
    return fmaxf(m, other_half(m, hi));
}
__device__ __forceinline__ void pack_p(const f32x16& p0, const f32x16& p1, bf16x8& a0, bf16x8& a1, bf16x8& a2, bf16x8& a3) {
    u32x4 w0, w1, w2, w3;
    w0 = (u32x4){cvtpk(p0[0], p0[1]), cvtpk(p0[2], p0[3]), cvtpk(p0[4], p0[5]), cvtpk(p0[6], p0[7])};
    w1 = (u32x4){cvtpk(p0[8], p0[9]), cvtpk(p0[10], p0[11]), cvtpk(p0[12], p0[13]), cvtpk(p0[14], p0[15])};
    w2 = (u32x4){cvtpk(p1[0], p1[1]), cvtpk(p1[2], p1[3]), cvtpk(p1[4], p1[5]), cvtpk(p1[6], p1[7])};
    w3 = (u32x4){cvtpk(p1[8], p1[9]), cvtpk(p1[10], p1[11]), cvtpk(p1[12], p1[13]), cvtpk(p1[14], p1[15])};
    a0 = __builtin_bit_cast(bf16x8, w0); a1 = __builtin_bit_cast(bf16x8, w1); a2 = __builtin_bit_cast(bf16x8, w2); a3 = __builtin_bit_cast(bf16x8, w3);
}

struct Ctx {
    LAS char* lds; unsigned lds0; int wid, lane, r32, hi, g, th, qloc;
    const LAS float* bt;
    LAS float* wsf;
    const LAS float* wrow;
    int vb0;
    const LAS char* vp0;
    const LAS char* kb0;
};
__device__ __forceinline__ void dma_k(const Ctx& c, const bf16* kbase, int pitch, int slot) { glds16(kbase + (size_t)c.lane * pitch + c.wid * 8, (unsigned)__builtin_amdgcn_readfirstlane(c.lds0 + L_K + slot * SLOTB + c.wid * 1024)); }
__device__ __forceinline__ void dma_v(const Ctx& c, const bf16* vbase, int pitch, int slot) { glds16(vbase + (size_t)(16 * (c.wid & 3) + (c.lane >> 2)) * pitch + (c.wid >> 2) * 32 + (c.lane & 3) * 8, (unsigned)__builtin_amdgcn_readfirstlane(c.lds0 + L_V + slot * SLOTB + c.wid * 1024)); }

__device__ __forceinline__ void cmp_scores(const Ctx& c, int slot, const bf16x8 (&qr)[4], int t0, int kt, f32x16& p0, f32x16& p1) {
    const int dmin = t0 + 32 * c.th - 16 * (64 * kt + 63) - 31;
    const bool special = dmin < 113;
    f32x16 ci; { const float v = special ? 0.f : c.bt[128];
#pragma unroll
        for (int r = 0; r < 16; ++r) ci[r] = v; }
    qkt(p0, p1, c.kb0 + slot * SLOTB, qr, ci);
    if (special) {
        int hi64 = 64 * c.hi; asm volatile("" : "+v"(hi64));
        const int dqh = t0 + c.qloc - 1024 * kt - 31 - hi64;
#pragma unroll
        for (int r = 0; r < 16; ++r) {
            const int d0 = dqh - 16 * ((r & 3) + 8 * (r >> 2)), d1 = d0 - 512;
            const float b0 = c.bt[d0 < 0 ? 0 : (d0 > 128 ? 128 : d0)], b1 = c.bt[d1 < 0 ? 0 : (d1 > 128 ? 128 : d1)];
            p0[r] = d0 < 0 ? NEG_INF : p0[r] + b0; p1[r] = d1 < 0 ? NEG_INF : p1[r] + b1;
        }
    }
}
template <int MODE>
__device__ __forceinline__ void online_tile(const Ctx& c, int slot, const bf16x8 (&qr)[4], int dq, bool near, bool masked_tile, bool lane_off, float& mhat, float& lsum, f32x16 (&o)[2]) {
    f32x16 ci; { const float v = (near ? 0.f : c.bt[128]) - mhat;
#pragma unroll
        for (int r = 0; r < 16; ++r) ci[r] = v; }
    f32x16 p0, p1;
    qkt(p0, p1, c.kb0 + slot * SLOTB, qr, ci);
    if (near || masked_tile) {
        int hi4 = 4 * c.hi; asm volatile("" : "+v"(hi4));
        const int dqh = dq - hi4;
#pragma unroll
        for (int r = 0; r < 16; ++r) {
            const int d0 = dqh - ((r & 3) + 8 * (r >> 2)), d1 = d0 - 32;
            if (near) { p0[r] += c.bt[d0 < 0 ? 0 : (d0 > 128 ? 128 : d0)]; p1[r] += c.bt[d1 < 0 ? 0 : (d1 > 128 ? 128 : d1)]; }
            if (d0 < 0 || (MODE == 1 && d0 >= 512)) p0[r] = NEG_INF;
            if (d1 < 0 || (MODE == 1 && d1 >= 512)) p1[r] = NEG_INF;
        }
    }
    if (MODE == 0) { if (lane_off) {
#pragma unroll
        for (int r = 0; r < 16; ++r) { p0[r] = NEG_INF; p1[r] = NEG_INF; } } }
    const float rm = rowmax(p0, p1, c.hi);
    if (__any(rm > 8.0f)) {
        const float dl = fmaxf(rm, 0.f); mhat += dl;
#pragma unroll
        for (int r = 0; r < 16; ++r) { p0[r] -= dl; p1[r] -= dl; }
        const float f = __builtin_amdgcn_exp2f(-dl); lsum *= f;
        if (c.hi == 0) c.wsf[c.r32] = f;
        asm volatile("s_waitcnt lgkmcnt(0)" ::: "memory");
#pragma unroll
        for (int r = 0; r < 16; ++r) { const float fr = c.wrow[(r & 3) + 8 * (r >> 2)]; o[0][r] *= fr; o[1][r] *= fr; }
    }
    float sacc = 0.f;
#pragma unroll
    for (int r = 0; r < 16; ++r) { p0[r] = __builtin_amdgcn_exp2f(p0[r]); p1[r] = __builtin_amdgcn_exp2f(p1[r]); sacc += p0[r] + p1[r]; }
    lsum += sacc;
    bf16x8 a0, a1, a2, a3; pack_p(p0, p1, a0, a1, a2, a3);
    pv(o, c.vb0 + slot * SLOTB, a0, a1, a2, a3);
}
struct Pipe { bf16x8 a0, a1, a2, a3; bool have, resc; };
template <int MODE, bool SPECIAL, bool HAVE>
__device__ __forceinline__ void online_step(const Ctx& c, int kslot, int vslot_prev, const bf16x8 (&qr)[4], int dq, bool near, bool lane_off, float& mhat, float& lsum, f32x16 (&o)[2], Pipe& pp) {
    if (pp.resc) {
#pragma unroll
        for (int r = 0; r < 16; ++r) { const float fr = c.wrow[(r & 3) + 8 * (r >> 2)]; o[0][r] *= fr; o[1][r] *= fr; }
    }
    f32x16 ci; { const float v = (MODE == 0 && lane_off) ? NEG_INF : (((SPECIAL && near) ? 0.f : c.bt[128]) - mhat);
#pragma unroll
        for (int r = 0; r < 16; ++r) ci[r] = v; }
    f32x16 p0, p1;
    qkt(p0, p1, c.kb0 + kslot * SLOTB, qr, ci);
    if (HAVE) pv2(o, c.vp0 + vslot_prev * SLOTB, pp.a0, pp.a1, pp.a2, pp.a3);
    if (SPECIAL) {
        int hi4 = 4 * c.hi; asm volatile("" : "+v"(hi4));
        const int dqh = dq - hi4;
#pragma unroll
        for (int r = 0; r < 16; ++r) {
            const int d0 = dqh - ((r & 3) + 8 * (r >> 2)), d1 = d0 - 32;
            if (near) { p0[r] += c.bt[d0 < 0 ? 0 : (d0 > 128 ? 128 : d0)]; p1[r] += c.bt[d1 < 0 ? 0 : (d1 > 128 ? 128 : d1)]; }
            if (d0 < 0 || (MODE == 1 && d0 >= 512)) p0[r] = NEG_INF;
            if (d1 < 0 || (MODE == 1 && d1 >= 512)) p1[r] = NEG_INF;
        }
    }
    const float rm = rowmax(p0, p1, c.hi);
    const bool mv = __any(rm > 8.0f);
    if (mv) {
        const float dl = fmaxf(rm, 0.f); mhat += dl;
#pragma unroll
        for (int r = 0; r < 16; ++r) { p0[r] -= dl; p1[r] -= dl; }
        const float f = __builtin_amdgcn_exp2f(-dl); lsum *= f;
        c.wsf[c.r32] = f;
    }
    pp.resc = mv;
    float sacc = 0.f;
#pragma unroll
    for (int r = 0; r < 16; ++r) { p0[r] = __builtin_amdgcn_exp2f(p0[r]); p1[r] = __builtin_amdgcn_exp2f(p1[r]); sacc += p0[r] + p1[r]; }
    lsum += sacc;
    pack_p(p0, p1, pp.a0, pp.a1, pp.a2, pp.a3); pp.have = true;
}
__device__ __forceinline__ void online_drain(const Ctx& c, int vslot_prev, f32x16 (&o)[2], Pipe& pp) {
    if (pp.resc) {
#pragma unroll
        for (int r = 0; r < 16; ++r) { const float fr = c.wrow[(r & 3) + 8 * (r >> 2)]; o[0][r] *= fr; o[1][r] *= fr; }
    }
    if (pp.have) pv2(o, c.vp0 + vslot_prev * SLOTB, pp.a0, pp.a1, pp.a2, pp.a3);
}
__device__ __forceinline__ void add_scaled(const Ctx& c, f32x16 (&oacc)[2], const f32x16 (&o)[2], float s) {
    if (c.hi == 0) c.wsf[32 + c.r32] = s;
    asm volatile("s_waitcnt lgkmcnt(0)" ::: "memory");
#pragma unroll
    for (int r = 0; r < 16; ++r) { const float f = c.wrow[32 + (r & 3) + 8 * (r >> 2)]; oacc[0][r] += o[0][r] * f; oacc[1][r] += o[1][r] * f; }
    asm volatile("s_waitcnt lgkmcnt(0)" ::: "memory");
}

__device__ __forceinline__ void add_scaled_park(const Ctx& c, LAS float* park, const f32x16 (&o)[2], float s) {
    if (c.hi == 0) c.wsf[32 + c.r32] = s;
    asm volatile("s_waitcnt lgkmcnt(0)" ::: "memory");
#pragma unroll
    for (int r = 0; r < 16; ++r) { const float f = c.wrow[32 + (r & 3) + 8 * (r >> 2)]; park[r * 64] += o[0][r] * f; park[(16 + r) * 64] += o[1][r] * f; }
    asm volatile("s_waitcnt lgkmcnt(0)" ::: "memory");
}
__device__ __forceinline__ void unit(LAS char* lds, int tid, int b, int hkv, int jt, const bf16* Z, const bf16* KCm, const bf16* VCm, const float* rel_bias, bf16* YC, bool fill_table) {
    Ctx c; c.lds = lds; c.lds0 = (unsigned)(uintptr_t)lds; c.wid = __builtin_amdgcn_readfirstlane(tid >> 6); c.lane = tid & 63; c.r32 = c.lane & 31; c.hi = c.lane >> 5;
    c.g = c.wid & 3; c.th = c.wid >> 2; c.qloc = 32 * c.th + c.r32;
    c.bt = (const LAS float*)(lds + L_BT) + c.g * 132; c.wsf = (LAS float*)(lds + L_WS) + c.wid * 64; c.wrow = c.wsf + 4 * c.hi;
    c.vb0 = (int)(c.lds0 + L_V) + ((c.lane >> 4) & 1) * 32 + (c.lane & 3) * 8 + (4 * c.hi + ((c.lane & 15) >> 2)) * 64;
    c.kb0 = (const LAS char*)(lds + L_K) + c.hi * 1024 + c.r32 * 16;
    c.vp0 = (const LAS char*)(lds + L_V) + ((c.lane >> 4) & 1) * 32 + (c.lane & 3) * 8 + (4 * c.hi + ((c.lane & 15) >> 2)) * 64;
    const int t0 = 64 * jt;
    const bf16* Zb = Z + (size_t)b * SEQ * ZP;
    const size_t qrow = (size_t)b * SEQ + t0 + c.qloc;
    if (fill_table) for (int i = tid; i < 4 * 129; i += NTHR) { const int gg = i / 129, d = i % 129; ((LAS float*)(lds + L_BT))[gg * 132 + d] = rel_bias[t5_bucket(d) * 8 + hkv * 4 + gg] * LOG2E; }
    bf16x8 qr[4];
#pragma unroll
    for (int d0 = 0; d0 < 4; ++d0) qr[d0] = *(const bf16x8*)(Z + qrow * ZP + ZC_Q + hkv * 256 + c.g * 64 + d0 * 16 + c.hi * 8);
    const bf16* gp = Z + qrow * ZP + ZC_G + hkv * 12 + c.g * 3;
    const float gate0 = sigmoidf_(bf2f(gp[0])), gate1 = sigmoidf_(bf2f(gp[1])), gate2 = sigmoidf_(bf2f(gp[2]));
    f32x16 oacc[2];
#pragma unroll
    for (int r = 0; r < 16; ++r) { oacc[0][r] = 0.f; oacc[1][r] = 0.f; }

    const int nct = (4 * jt + 2) / 64 + 1;
    const bf16* kcb = KCm + (size_t)b * NCMPP * 128 + hkv * 64; const bf16* vcb = VCm + (size_t)b * NCMPP * 128 + hkv * 64;
    const bf16* skb = Zb + ZC_KV + 256 + hkv * 64; const bf16* svb = Zb + ZC_KV + 384 + hkv * 64;
    {
        float mhat = 0.f, lsum = 0.f, carry = 0.f; f32x16 o[2];
#pragma unroll
        for (int r = 0; r < 16; ++r) { o[0][r] = 0.f; o[1][r] = 0.f; }
        LAS float* impw = (LAS float*)(lds + L_IMP) + (c.g * 64 + c.qloc) * 64;
        dma_k(c, kcb, 128, 0); dma_v(c, vcb, 128, 0); if (nct > 1) { dma_k(c, kcb + 64 * 128, 128, 1); dma_v(c, vcb + 64 * 128, 128, 1); }
        for (int i = 0; i < nct; ++i) {
            if (i + 1 < nct) NSA_WAIT_BAR(2); else NSA_WAIT_BAR(0);
            if (i + 2 < nct) { dma_k(c, kcb + (size_t)(i + 2) * 64 * 128, 128, (i + 2) % 3); dma_v(c, vcb + (size_t)(i + 2) * 64 * 128, 128, (i + 2) % 3); }
            f32x16 p0, p1; cmp_scores(c, i % 3, qr, t0, i, p0, p1);
            const float rm = rowmax(p0, p1, c.hi) - mhat;
            if (__any(rm > 8.0f)) {
                const float dl = fmaxf(rm, 0.f); mhat += dl;
                const float f = __builtin_amdgcn_exp2f(-dl); lsum *= f; carry *= f;
                c.wsf[c.r32] = f;
                asm volatile("s_waitcnt lgkmcnt(0)" ::: "memory");
#pragma unroll
                for (int r = 0; r < 16; ++r) { const float fr = c.wrow[(r & 3) + 8 * (r >> 2)]; o[0][r] *= fr; o[1][r] *= fr; }
                for (int e = c.hi; e < 16 * i; e += 2) impw[e] *= f;
            }
            float sacc = 0.f;
#pragma unroll
            for (int r = 0; r < 16; ++r) { p0[r] = __builtin_amdgcn_exp2f(p0[r] - mhat); p1[r] = __builtin_amdgcn_exp2f(p1[r] - mhat); sacc += p0[r] + p1[r]; }
            lsum += sacc;
            float o3[8];
#pragma unroll
            for (int k = 0; k < 4; ++k) { o3[k] = other_half(p0[4 * k + 3], c.hi); o3[4 + k] = other_half(p1[4 * k + 3], c.hi); }
#pragma unroll
            for (int idx = 0; idx < 8; ++idx) {
                const int X = idx >> 2, k = idx & 3;
                const f32x16& p = X ? p1 : p0;
                const float cin = c.hi ? o3[idx] : (idx ? o3[idx - 1] : carry);
                impw[16 * i + 8 * X + 2 * k + c.hi] = p[4 * k] + p[4 * k + 1] + p[4 * k + 2] + 0.5f * p[4 * k + 3] + 0.5f * cin;
            }
            carry = o3[7];
            bf16x8 a0, a1, a2, a3; pack_p(p0, p1, a0, a1, a2, a3);
            pv(o, c.vb0 + (i % 3) * SLOTB, a0, a1, a2, a3);
        }
        const float lt = lsum + other_half(lsum, c.hi);
        const float rl = lt > 0.f ? 1.0f / lt : 0.f;
        if (c.hi == 0) ((LAS float*)(lds + L_RL))[c.g * 64 + c.qloc] = rl;
        add_scaled(c, oacc, o, rl * gate0);
        NSA_WAIT_BAR(0);
    }
    { const int nt = jt + 1; dma_k(c, skb, ZP, 0); if (nt > 1) dma_k(c, skb + (size_t)64 * ZP, ZP, 1); dma_v(c, svb, ZP, 0); }
    for (int k = 0; k < 8; ++k) {
        const int tok = c.wid * 8 + k;
        float v = 0.f;
#pragma unroll
        for (int gg = 0; gg < 4; ++gg) v += ((const LAS float*)(lds + L_IMP))[(gg * 64 + tok) * 64 + c.lane] * ((const LAS float*)(lds + L_RL))[gg * 64 + tok];
        const bool forced = (c.lane == 0) || (c.lane <= jt && c.lane > jt - 2), future = c.lane > jt;
        v = forced ? 1e9f : (future ? -1e9f : v);
        int rank = 0;
#pragma unroll
        for (int jj = 0; jj < 64; ++jj) { const float vj = __builtin_bit_cast(float, __builtin_amdgcn_readlane(__builtin_bit_cast(int, v), jj)); rank += ((vj > v) || (vj == v && jj < c.lane)) ? 1 : 0; }
        const unsigned long long msk = __ballot(rank < 16 && !future);
        if (c.lane == 0) ((LAS unsigned long long*)(lds + L_SM))[tok] = msk;
    }
    asm volatile("s_waitcnt lgkmcnt(0)\n\ts_barrier" ::: "memory");
    const unsigned long long mymask = ((const LAS unsigned long long*)(lds + L_SM))[c.qloc];
    LAS float* park = (LAS float*)(lds + L_IMP) + c.wid * 2048 + c.lane;
#pragma unroll
    for (int r = 0; r < 16; ++r) { park[r * 64] = oacc[0][r]; park[(16 + r) * 64] = oacc[1][r]; }
    {
        const bf16* kb = skb; const bf16* vb = svb;
        const int nt = jt + 1;
        float mhat = 0.f, lsum = 0.f; f32x16 o[2]; Pipe pp; pp.have = false; pp.resc = false;
#pragma unroll
        for (int r = 0; r < 16; ++r) { o[0][r] = 0.f; o[1][r] = 0.f; }
#define NSA_ITER_HEAD(i) do { if ((i) + 1 < nt) NSA_WAIT_BAR(2); else NSA_WAIT_BAR(1); \
            if ((i) + 2 < nt) dma_k(c, kb + (size_t)((i) + 2) * 64 * ZP, ZP, ((i) + 2) % 3); \
            if ((i) + 1 < nt) dma_v(c, vb + (size_t)((i) + 1) * 64 * ZP, ZP, ((i) + 1) % 3); } while (0)
        {
            NSA_ITER_HEAD(0);
            online_step<0, true, false>(c, 0, 2, qr, 64 * jt + c.qloc, 0 >= jt - 2, !(mymask & 1ull), mhat, lsum, o, pp); }
        const int nfar = jt - 2;
        int i = 1;
        for (; i < nfar; ++i) { NSA_ITER_HEAD(i);
            online_step<0, false, true>(c, i % 3, (i + 2) % 3, qr, 0, false, !((mymask >> i) & 1ull), mhat, lsum, o, pp); }
        for (; i < nt; ++i) { NSA_ITER_HEAD(i);
            online_step<0, true, true>(c, i % 3, (i + 2) % 3, qr, 64 * (jt - i) + c.qloc, i >= jt - 2, !((mymask >> i) & 1ull), mhat, lsum, o, pp); }
        NSA_WAIT_BAR(0);
        online_drain(c, (nt - 1) % 3, o, pp);
        const float lt = lsum + other_half(lsum, c.hi);
        add_scaled_park(c, park, o, (lt > 0.f ? 1.0f / lt : 0.f) * gate1);
        NSA_WAIT_BAR(0);
    }
    {
        const int j0 = jt > 8 ? jt - 8 : 0, nt = jt - j0 + 1;
        const bf16* kb = Zb + (size_t)j0 * 64 * ZP + ZC_KV + 512 + hkv * 64; const bf16* vb = Zb + (size_t)j0 * 64 * ZP + ZC_KV + 640 + hkv * 64;
        float mhat = 0.f, lsum = 0.f; f32x16 o[2]; Pipe pp; pp.have = false; pp.resc = false;
#pragma unroll
        for (int r = 0; r < 16; ++r) { o[0][r] = 0.f; o[1][r] = 0.f; }
        dma_k(c, kb, ZP, 0); if (nt > 1) dma_k(c, kb + (size_t)64 * ZP, ZP, 1); dma_v(c, vb, ZP, 0);
        {
            NSA_ITER_HEAD(0);
            online_step<1, true, false>(c, 0, 2, qr, 64 * (jt - j0) + c.qloc, j0 >= jt - 2, false, mhat, lsum, o, pp); }
        int i = 1;
        for (; j0 + i < jt - 2; ++i) { NSA_ITER_HEAD(i);
            online_step<1, false, true>(c, i % 3, (i + 2) % 3, qr, 0, false, false, mhat, lsum, o, pp); }
        for (; i < nt; ++i) { NSA_ITER_HEAD(i); const int j = j0 + i;
            online_step<1, true, true>(c, i % 3, (i + 2) % 3, qr, 64 * (jt - j) + c.qloc, j >= jt - 2, false, mhat, lsum, o, pp); }
#undef NSA_ITER_HEAD
        NSA_WAIT_BAR(0);
        online_drain(c, (nt - 1) % 3, o, pp);
        const float lt = lsum + other_half(lsum, c.hi);
        add_scaled_park(c, park, o, (lt > 0.f ? 1.0f / lt : 0.f) * gate2);
    }
    {
        bf16* yb = YC + ((size_t)b * SEQ + t0 + 32 * c.th + 4 * c.hi) * DM + D_SSM + hkv * 256 + c.g * 64 + c.r32;
#pragma unroll
        for (int r = 0; r < 16; ++r) { bf16* yr = yb + (size_t)((r & 3) + 8 * (r >> 2)) * DM; yr[0] = (bf16)f2bf(park[r * 64]); yr[32] = (bf16)f2bf(park[(16 + r) * 64]); }
    }
    asm volatile("s_waitcnt vmcnt(0)" ::: "memory");
    NSA_WAIT_BAR(0);
}
#undef NSA_SBAR
#undef NSA_WAIT_BAR
}


__device__ __forceinline__ void ssm_precompute(const Frame& F, const __attribute__((address_space(4))) Args* args, unsigned char* ws, int item) {
    const int layer = item >> 5, g = item & 31, lg = layer * 32 + g;
    LAS float* L = (LAS float*)F.lds;
    LAS float* lkr = L; LAS float* lki = L + 17 * 64; LAS float* bbr = L + 2 * 17 * 64; LAS float* bbi = bbr + 1024; LAS float* ccr = bbi + 1024; LAS float* cci = ccr + 1024;
    LAS float* wk = cci + 1024; LAS float* dd = wk + 4096;
    const float* a_re = args->in[6] + lg * 64; const float* a_im = args->in[7] + lg * 64;
    const float dt = expf(args->in[13][lg]);
    for (int i = F.tid; i < 17 * 64; i += NTHR) { const int k = i >> 6, p = i & 63; const float er = expf(a_re[p] * dt * (float)k), ang = a_im[p] * dt * (float)k; lkr[i] = er * cosf(ang); lki[i] = er * sinf(ang); }
    for (int i = F.tid; i < 1024; i += NTHR) {
        { const int p = i >> 4, h = i & 15; const float are = a_re[p], aim = a_im[p];
          const float er = expf(are * dt), lbr = er * cosf(aim * dt), lbi = er * sinf(aim * dt);
          const float xx = lbr - 1.0f, yy = lbi, den = are * are + aim * aim, fr = (xx * are + yy * aim) / den, fi = (yy * are - xx * aim) / den;
          const float br = args->in[8][((size_t)lg * 64 + p) * 16 + h], bi = args->in[9][((size_t)lg * 64 + p) * 16 + h];
          bbr[i] = fr * br - fi * bi; bbi[i] = fr * bi + fi * br; }
        ccr[i] = args->in[10][(size_t)lg * 1024 + i]; cci[i] = args->in[11][(size_t)lg * 1024 + i];
    }
    if (F.tid < 16) dd[F.tid] = args->in[12][lg * 16 + F.tid];
    __syncthreads();
    for (int i = F.tid; i < 4096; i += NTHR) { const int k = i >> 8, ho = (i >> 4) & 15, hi = i & 15; float acc = 0.f;
        for (int p = 0; p < 64; ++p) { const float cr = ccr[ho * 64 + p], ci = cci[ho * 64 + p], lr = lkr[k * 64 + p], li = lki[k * 64 + p];
            const float tr = cr * lr - ci * li, ti = cr * li + ci * lr; acc += tr * bbr[p * 16 + hi] - ti * bbi[p * 16 + hi]; }
        wk[i] = acc + ((k == 0 && ho == hi) ? dd[ho] : 0.f); }
    __syncthreads();
    bf16* B2 = (bf16*)(ws + WS_BT2) + (size_t)lg * 256 * 384;
    for (int i = F.tid; i < 256 * 384; i += NTHR) { const int n = i / 384, kk = i % 384, t = n >> 4, ho = n & 15; float v;
        if (kk < 256) { const int sidx = kk >> 4, hi = kk & 15; v = sidx <= t ? wk[((t - sidx) << 8) + ho * 16 + hi] : 0.f; }
        else { const int j = kk - 256, p = j & 63; const float cr = ccr[ho * 64 + p], ci = cci[ho * 64 + p], lr = lkr[(t + 1) * 64 + p], li = lki[(t + 1) * 64 + p];
            v = j < 64 ? (cr * lr - ci * li) : -(cr * li + ci * lr); }
        B2[i] = (bf16)f2bf(v); }
    bf16* B1 = (bf16*)(ws + WS_BT1) + (size_t)lg * 256 * 256;
    for (int i = F.tid; i < 65536; i += NTHR) { const int j = i >> 8, kk = i & 255, sidx = kk >> 4, hi = kk & 15; float v = 0.f;
        if (j < 128) { const int p = j & 63; const float lr = lkr[(15 - sidx) * 64 + p], li = lki[(15 - sidx) * 64 + p], br = bbr[p * 16 + hi], bi = bbi[p * 16 + hi];
            v = j < 64 ? (lr * br - li * bi) : (lr * bi + li * br); }
        B1[i] = (bf16)f2bf(v); }
    __syncthreads();
}
__device__ __forceinline__ void ssm_carry_item(int b, int g, const float* a_re, const float* a_im, const float* log_dt, const float* XL, bf16* U, int lane) {
    const float dt16 = 16.0f * expf(log_dt[g]);
    const float er = expf(a_re[g * 64 + lane] * dt16), ang = a_im[g * 64 + lane] * dt16, lr = er * cosf(ang), li = er * sinf(ang);
    float xr = 0.f, xi = 0.f;
    const float* __restrict__ xl = XL + ((size_t)g * 2048 + b * 256) * 128 + lane;
    bf16* __restrict__ up = U + ((size_t)g * 2048 + b * 256) * 512 + 256 + lane;
    float ar[16], ai[16], nr_[16], ni_[16];
#pragma unroll
    for (int k = 0; k < 16; ++k) { ar[k] = xl[(size_t)k * 128]; ai[k] = xl[(size_t)k * 128 + 64]; }
    for (int cb = 0; cb < 16; ++cb) {
        const int cn = cb < 15 ? (cb + 1) * 16 : cb * 16;
#pragma unroll
        for (int k = 0; k < 16; ++k) { nr_[k] = xl[(size_t)(cn + k) * 128]; ni_[k] = xl[(size_t)(cn + k) * 128 + 64]; }
#pragma unroll
        for (int k = 0; k < 16; ++k) {
            const int c = cb * 16 + k;
            up[(size_t)c * 512] = (bf16)f2bf(xr); up[(size_t)c * 512 + 64] = (bf16)f2bf(xi);
            const float nr = lr * xr - li * xi + ar[k], ni = lr * xi + li * xr + ai[k];
            xr = nr; xi = ni;
        }
#pragma unroll
        for (int k = 0; k < 16; ++k) { ar[k] = nr_[k]; ai[k] = ni_[k]; }
    }
}


__device__ __forceinline__ void compress_stage2(const Frame& F, int eb, int pm, const bf16* HC, const float* w2, bf16* KCo, bf16* VCo) {
    const int r = F.tid >> 1, f0 = (F.tid & 1) * 32, rg = pm * 256 + r;
    const bf16* hr = HC + ((size_t)eb * 4096 + rg) * 64; const float* w = w2 + eb * 64 * 64 + f0;
    float acc[32];
#pragma unroll
    for (int f = 0; f < 32; ++f) acc[f] = 0.f;
#pragma unroll 2
    for (int e = 0; e < 64; ++e) { const float h = bf2f(hr[e]);
#pragma unroll
        for (int f4 = 0; f4 < 8; ++f4) { const f32x4 wv = *(const f32x4*)(w + e * 64 + f4 * 4); acc[f4 * 4] += h * wv.x; acc[f4 * 4 + 1] += h * wv.y; acc[f4 * 4 + 2] += h * wv.z; acc[f4 * 4 + 3] += h * wv.w; } }
    const bool pad = ((rg >> 1) & 255) == NCMP;
    bf16* dst = (eb ? VCo : KCo) + (size_t)rg * 64 + f0;
#pragma unroll
    for (int f8 = 0; f8 < 4; ++f8) { u32x4 o; o.x = pad ? 0u : pk2(acc[f8 * 8], acc[f8 * 8 + 1]); o.y = pad ? 0u : pk2(acc[f8 * 8 + 2], acc[f8 * 8 + 3]); o.z = pad ? 0u : pk2(acc[f8 * 8 + 4], acc[f8 * 8 + 5]); o.w = pad ? 0u : pk2(acc[f8 * 8 + 6], acc[f8 * 8 + 7]);
        *(u32x4*)(dst + f8 * 8) = o; }
}

__device__ __forceinline__ void transpose_item(const float* W, int K, int N, bf16* WT, int k0, int n0, int drow0, LAS float* scr, int lane, float scale = 1.0f) {
#pragma unroll 8
    for (int i = 0; i < 32; ++i) { const int kk = 2 * i + (lane >> 5); scr[kk * 33 + (lane & 31)] = W[(size_t)(k0 + kk) * N + n0 + (lane & 31)]; }
    asm volatile("s_waitcnt lgkmcnt(0)" ::: "memory");
    const int c = lane & 7;
#pragma unroll
    for (int j = 0; j < 4; ++j) { const int n = (lane >> 3) + 8 * j; const LAS float* sp = scr + (8 * c) * 33 + n;
        u32x4 o; o.x = pk2(sp[0 * 33] * scale, sp[1 * 33] * scale); o.y = pk2(sp[2 * 33] * scale, sp[3 * 33] * scale); o.z = pk2(sp[4 * 33] * scale, sp[5 * 33] * scale); o.w = pk2(sp[6 * 33] * scale, sp[7 * 33] * scale);
        *(u32x4*)(WT + (size_t)(drow0 + n) * K + k0 + 8 * c) = o; }
    asm volatile("s_waitcnt lgkmcnt(0)" ::: "memory");
}
__device__ __forceinline__ void ph_convert(const Frame& F, const __attribute__((address_space(4))) Args* args, unsigned char* ws) {
    for (int it = F.blk; it < DEPTH * NGRP; it += F.G) ssm_precompute(F, args, ws, it);
    LAS float* scr = (LAS float*)(F.lds + F.wave * 16384);
    const int gw = F.blk * NWAVES + F.wave, NGW = F.G * NWAVES;
    constexpr int I_IN = (DM / 64) * (1792 / 32), I_GLU = (D_SSM / 64) * (2 * D_SSM / 32), I_OUT = (DM / 64) * (DM / 32);
    constexpr int PER_LAYER = I_IN + I_GLU + I_OUT;
    for (int it = gw; it < DEPTH * 32 * 384; it += NGW) {
        const int le = it / 384, r = it % 384;
        if (r < 256) { const int isup = r >> 7, q = r & 127, nb = q & 7, kb = q >> 3, n0 = 32 * nb;
            transpose_item(args->in[isup ? 24 : 23] + (size_t)le * DM * 256, DM, 256, (bf16*)(ws + WS_WGU) + (size_t)le * 512 * DM, 64 * kb, n0, 256 * (n0 >> 7) + 128 * isup + (n0 & 127), scr, F.lane); }
        else { const int q = r - 256, nb = q & 31, kb = q >> 5;
            transpose_item(args->in[25] + (size_t)le * 256 * DM, 256, DM, (bf16*)(ws + WS_WDN) + (size_t)le * DM * 256, 64 * kb, 32 * nb, 32 * nb, scr, F.lane); }
    }
    for (int it = gw; it < DEPTH * 2 * 64; it += NGW) { const int li = it >> 6, q = it & 63, nb = q & 1, kb = q >> 1;
        transpose_item(args->in[16] + (size_t)li * 2048 * 64, 2048, 64, (bf16*)(ws + WS_W1T) + (size_t)li * 256 * 2048, 64 * kb, 32 * nb, 32 * nb, scr, F.lane); }
    { const int gt = F.blk * NTHR + F.tid, NGT = F.G * NTHR;
      for (int idx = gt; idx < DEPTH * 2 * 192 * 2048 / 8; idx += NGT) { const int li = idx / (192 * 256), rem = idx % (192 * 256);
          *(u32x4*)((bf16*)(ws + WS_W1T) + (size_t)li * 256 * 2048 + (size_t)64 * 2048 + (size_t)rem * 8) = (u32x4){0u, 0u, 0u, 0u}; }
      for (int idx = gt; idx < DEPTH * 2 * 64; idx += NGT) { const int li = idx >> 6, e = idx & 63; const float* pp = args->in[15] + (size_t)li * 2048; const float* ww = args->in[16] + (size_t)li * 2048 * 64 + e;
          float a = 0.f; for (int k = 0; k < 2048; ++k) a += pp[k] * ww[(size_t)k * 64];
          ((float*)(ws + WS_CBIAS))[idx] = a; } }
    for (int it = gw; it < DEPTH * PER_LAYER; it += NGW) {
        const int layer = it / PER_LAYER; int r = it % PER_LAYER;
        if (r < I_IN) { const int nb = r % 56, kb = r / 56;
            transpose_item(args->in[4] + (size_t)layer * DM * D_IN, DM, D_IN, (bf16*)(ws + WS_WIN) + (size_t)layer * ZP * DM, 64 * kb, 32 * nb, 32 * nb, scr, F.lane, (nb >= 16 && nb < 32) ? QSCALE : 1.0f); continue; }
        r -= I_IN;
        if (r < I_GLU) { const int nb = r % 32, kb = r / 32, n0 = 32 * nb;
            const int half = n0 >> 9, c = n0 & 511, drow = 256 * (c >> 7) + 128 * half + (c & 127);
            transpose_item(args->in[14] + (size_t)layer * D_SSM * 2 * D_SSM, D_SSM, 2 * D_SSM, (bf16*)(ws + WS_WGLU) + (size_t)layer * 2 * D_SSM * D_SSM, 64 * kb, n0, drow, scr, F.lane); continue; }
        r -= I_GLU;
        { const int nb = r % 32, kb = r / 32;
            transpose_item(args->in[5] + (size_t)layer * DM * DM, DM, DM, (bf16*)(ws + WS_WOUT) + (size_t)layer * DM * DM, 64 * kb, 32 * nb, 32 * nb, scr, F.lane); }
    }
    const int gt = F.blk * NTHR + F.tid, NGT = F.G * NTHR;
    for (int idx = gt; idx < DEPTH * 256 * DM; idx += NGT) {
        const int layer = idx / (256 * DM), rem = idx % (256 * DM), n = 1792 + rem / DM, k = rem % DM;
        const float v = n < D_IN ? args->in[4][(size_t)layer * DM * D_IN + (size_t)k * D_IN + n] : 0.f;
        ((bf16*)(ws + WS_WIN))[(size_t)layer * ZP * DM + (size_t)n * DM + k] = (bf16)f2bf(v);
    }
}

constexpr int PH_PER_LAYER = 8, N_PHASES = 1 + DEPTH * PH_PER_LAYER + 1;
#ifndef FAST_GEMM
#define FAST_GEMM 1
#endif
#ifndef REP_ATTN
#define REP_ATTN 1
#endif
#ifndef REP_CMP
#define REP_CMP 1
#endif
#ifndef REP_CARRY
#define REP_CARRY 1
#endif
#ifndef REP_CONV
#define REP_CONV 1
#endif
#ifndef REP_INPROJ
#define REP_INPROJ 1
#endif
#ifndef REP_G1
#define REP_G1 1
#endif
#ifndef REP_G2
#define REP_G2 1
#endif
#ifndef REP_GLU
#define REP_GLU 1
#endif
#ifndef REP_OUT
#define REP_OUT 1
#endif
#ifndef REP_NORM
#define REP_NORM 1
#endif
#ifndef REP_ROUTE
#define REP_ROUTE 1
#endif
#ifndef REP_GU
#define REP_GU 1
#endif
#ifndef REP_DN
#define REP_DN 1
#endif

__global__ void __launch_bounds__(NTHR, 2) fwd(Args args) {
    extern __shared__ __attribute__((aligned(16))) unsigned char lds_raw[];
    Frame F;
    F.lds = (LAS unsigned char*)lds_raw;
    F.tid = threadIdx.x; F.lane = F.tid & 63; F.wave = __builtin_amdgcn_readfirstlane(F.tid >> 6);
    F.blk = blockIdx.x; F.G = gridDim.x;
    typedef const __attribute__((address_space(4))) Args* KArgs;
    KArgs kp = (KArgs)__builtin_amdgcn_kernarg_segment_ptr();
    asm volatile("" : "+s"(kp));
    unsigned char* ws = kp->ws;
    volatile LAS unsigned* MISC = (volatile LAS unsigned*)(F.lds + MISC_OFF);
    if (F.tid < 32) MISC[F.tid] = 0u;
    __syncthreads();
    XcdBarrier bar; bar.bar = (unsigned*)(ws + WS_CTL) + CW_BAR; bar.x = 0; bar.st = nullptr;
    if (N_LAUNCH_MODE == 1) bar = xcd_barrier_post((unsigned*)(ws + WS_CTL) + CW_BAR, MISC + 8);
#define IN(k) (kp->ph_lo <= (k) && (k) < kp->ph_hi)
#define FRESH_IDS() do { int l_; asm volatile("v_mbcnt_lo_u32_b32 %0, -1, 0\n\tv_mbcnt_hi_u32_b32 %0, -1, %0" : "=v"(l_)); asm volatile("" : "+s"(F.wave), "+s"(F.blk), "+s"(F.G)); F.lane = l_; F.tid = F.wave * 64 + l_; asm volatile("" : "+s"(kp)); ws = kp->ws; bar.bar = (unsigned*)(ws + WS_CTL) + CW_BAR; } while (0)
#define SEAM(k) do { FRESH_IDS(); if (IN(k) && IN((k) + 1)) xcd_barrier(bar, F.tid); FRESH_IDS(); } while (0)

    const float* x0 = kp->in[0];
    float* XR = kp->out;
#define HN ((bf16*)(ws + WS_HN))
#define Z ((bf16*)(ws + WS_Z))
#define YC ((bf16*)(ws + WS_YC))
#define G1 ((bf16*)(ws + WS_G1))
#define KC ((bf16*)(ws + WS_KC))
#define VC ((bf16*)(ws + WS_VC))
#define LIST ((unsigned*)(ws + WS_LIST))
#define LISTW ((float*)(ws + WS_LISTW))
#define HID ((bf16*)(ws + WS_HID))
#define P2 ((bf16*)(ws + WS_P2))
#define P1B ((bf16*)(ws + WS_YC))
#define USSM ((bf16*)(ws + WS_USSM))
#define XL ((float*)(ws + WS_XL))
    LAS int* etab = (LAS int*)(F.lds + ETAB_OFF);

    if (IN(0)) for (int rep_ = 0; rep_ < REP_CONV; ++rep_) ph_convert(F, kp, ws);
    SEAM(0);
    for (int layer = 0; layer < DEPTH; ++layer) {
        const int pb = 1 + layer * PH_PER_LAYER;
        const float* xin = layer == 0 ? x0 : XR;
        unsigned* gcnt = (unsigned*)(ws + WS_CTL) + CW_CNT + layer * 32 * 64;
        if (IN(pb + 0)) { ph_norm(F, xin, layer == 0 ? nullptr : P1B, P2, XR, kp->in[1] + layer * DM, HN); for (int rep_ = 1; rep_ < REP_NORM; ++rep_) ph_norm(F, xin, nullptr, nullptr, XR, kp->in[1] + layer * DM, HN); }
        SEAM(pb + 0);
        if (IN(pb + 1)) {
            pg8::Gemm g{HN, (const bf16*)(ws + WS_WIN) + (size_t)layer * ZP * DM, T, ZP, DM, DM, 0, nullptr, 0, 0, 128}; pg8::StaticOrder S; S.init(T, ZP, F.G, F.blk);
            pg8::EpiInProj E{Z, USSM};
            for (int rep_ = 0; rep_ < REP_INPROJ; ++rep_) pg8::gemm2<pg8::EpiInProj, pg8::StaticOrder, pg8::ADense>(F.lds, g, S, E, F.tid);
        }
        SEAM(pb + 1);
        if (IN(pb + 2)) {
            for (int rep_ = 0; rep_ < REP_CMP; ++rep_) {
                { pg8::Gemm g{Z, (const bf16*)(ws + WS_W1T) + (size_t)layer * 2 * 256 * 2048, 0, 256, 2048, ZP, (size_t)256 * 2048, nullptr, 0, 0, ZP * 2};
                  pg8::CmpOrder S{F.G, F.blk}; pg8::EpiCmpHid E{(bf16*)(ws + WS_HIDC), (const float*)(ws + WS_CBIAS) + layer * 128};
                  pg8::gemm2<pg8::EpiCmpHid, pg8::CmpOrder, pg8::ACompress>(F.lds, g, S, E, F.tid); }
                asm volatile("s_waitcnt vmcnt(0)" ::: "memory"); __syncthreads();
                for (int L = F.blk; L < 32; L += F.G) compress_stage2(F, L >> 4, L & 15, (const bf16*)(ws + WS_HIDC), kp->in[17] + (size_t)layer * 2 * 64 * 64, KC, VC);
            }
#pragma unroll 1
            for (int L = F.blk; L < NGRP * BATCH; L += F.G) {
                const int sg = L >> 3, sb = L & 7;
                FRESH_IDS();
                { pg8::Gemm g{USSM, (const bf16*)(ws + WS_BT1) + (size_t)layer * 32 * 256 * 256, 0, 256, 256, 512, (size_t)256 * 256, nullptr, 0, (size_t)2048 * 512, 128};
                  pg8::SingleUnit S{sg, sb}; pg8::EpiXloc E{XL};
                  pg8::gemm2<pg8::EpiXloc, pg8::SingleUnit, pg8::ADense>(F.lds, g, S, E, F.tid); }
                asm volatile("s_waitcnt vmcnt(0)" ::: "memory"); __syncthreads();
                for (int rep_ = 0; rep_ < REP_CARRY; ++rep_)
                if (F.wave == 0) ssm_carry_item(sb, sg, kp->in[6] + layer * NGRP * SST, kp->in[7] + layer * NGRP * SST, kp->in[13] + layer * NGRP, XL, USSM, F.lane);
                asm volatile("s_waitcnt vmcnt(0)" ::: "memory"); __syncthreads();
                FRESH_IDS();
                { pg8::Gemm g{USSM, (const bf16*)(ws + WS_BT2) + (size_t)layer * 32 * 256 * 384, 0, 256, 384, 512, (size_t)256 * 384, nullptr, 0, (size_t)2048 * 512, 128};
                  pg8::SingleUnit S{sg, sb}; pg8::EpiSsmOut E{G1};
                  pg8::gemm2<pg8::EpiSsmOut, pg8::SingleUnit, pg8::ADense>(F.lds, g, S, E, F.tid); }
            }
        }
        SEAM(pb + 2);
        if (IN(pb + 3)) {
            { pg8::Gemm g{G1, (const bf16*)(ws + WS_WGLU) + (size_t)layer * 2 * D_SSM * D_SSM, T, 2 * D_SSM, D_SSM, D_SSM, 0, nullptr, 0, 0, 128}; pg8::StaticOrder S; S.init(T, 2 * D_SSM, F.G, F.blk);
              pg8::EpiGlu E{YC, DM};
              for (int rep_ = 0; rep_ < REP_GLU; ++rep_) pg8::gemm2<pg8::EpiGlu, pg8::StaticOrder, pg8::ADense>(F.lds, g, S, E, F.tid); }
            __syncthreads();
            int last_hkv = -1;
            for (int rep_ = 0; rep_ < REP_ATTN; ++rep_)
            for (int slot = F.blk; slot < 256; slot += F.G) {
                const int bh = slot >> 4, sq = slot & 15;
#pragma unroll 1
                for (int uq = 0; uq < 4; ++uq) { const int jt = uq == 0 ? 63 - sq : (uq == 1 ? 32 + sq : (uq == 2 ? 31 - sq : sq));
                    nsa::unit((LAS char*)F.lds, F.tid, bh >> 1, bh & 1, jt, Z, KC, VC, kp->in[18], YC, (bh & 1) != last_hkv); last_hkv = bh & 1; }
            }
        }
        SEAM(pb + 3);
        if (IN(pb + 4)) {
            pg8::Gemm g{YC, (const bf16*)(ws + WS_WOUT) + (size_t)layer * DM * DM, T, DM, DM, DM, 0, nullptr, 0, 0, 128}; pg8::StaticOrder S; S.init(T, DM, F.G, F.blk);
            for (int rep_ = 1; rep_ < REP_OUT; ++rep_) { pg8::EpiResid Ed{xin, (float*)(ws + WS_Z), DM}; pg8::gemm2<pg8::EpiResid, pg8::StaticOrder, pg8::ADense>(F.lds, g, S, Ed, F.tid); }
            pg8::EpiResid E{xin, XR, DM};
            pg8::gemm2<pg8::EpiResid, pg8::StaticOrder, pg8::ADense>(F.lds, g, S, E, F.tid);
        }
        SEAM(pb + 4);
        if (IN(pb + 5)) ph_norm_route(F, XR, kp->in[2] + layer * DM, kp->in[19] + (size_t)layer * DM * 4, kp->in[20] + layer * 4, kp->in[21] + (size_t)layer * 4 * DM * 8, kp->in[22] + layer * 32, HN, gcnt, LIST, LISTW);
        if (IN(pb + 5)) for (int rep_ = 1; rep_ < REP_ROUTE; ++rep_) ph_norm_route(F, XR, kp->in[2] + layer * DM, kp->in[19] + (size_t)layer * DM * 4, kp->in[20] + layer * 4, kp->in[21] + (size_t)layer * 4 * DM * 8, kp->in[22] + layer * 32, HN, gcnt + (2 + rep_) * 32 * 64, (unsigned*)(ws + 484 * MiB), (float*)(ws + 488 * MiB));
        SEAM(pb + 5);
        if (IN(pb + 6)) {
            build_expert_tab(F, gcnt, etab);
            pg8::Gemm g{HN, (const bf16*)(ws + WS_WGU) + (size_t)layer * 32 * 512 * DM, 0, 512, DM, DM, (size_t)512 * DM, LIST, LCAP, 0, 128};
            pg8::ExpertOrder S{etab, 2, F.G, F.blk};
            pg8::EpiGateUp E{HID, LISTW, LCAP};
            for (int rep_ = 0; rep_ < REP_GU; ++rep_) pg8::gemm2<pg8::EpiGateUp, pg8::ExpertOrder, pg8::AList>(F.lds, g, S, E, F.tid);
        }
        SEAM(pb + 6);
        if (IN(pb + 7)) {
            build_expert_tab(F, gcnt, etab);
            pg8::Gemm g{HID, (const bf16*)(ws + WS_WDN) + (size_t)layer * 32 * DM * 256, 0, DM, 256, 256, (size_t)DM * 256, nullptr, 0, 0, 128};
            pg8::ExpertOrder S{etab, 4, F.G, F.blk};
            for (int rep_ = 1; rep_ < REP_DN; ++rep_) { pg8::EpiDown Ed{P1B, (long)(P2 - P1B), LIST, LCAP}; pg8::gemm2<pg8::EpiDown, pg8::ExpertOrder, pg8::ADense>(F.lds, g, S, Ed, F.tid); }
            pg8::EpiDown E{P1B, (long)(P2 - P1B), LIST, LCAP};
            pg8::gemm2<pg8::EpiDown, pg8::ExpertOrder, pg8::ADense>(F.lds, g, S, E, F.tid);
        }
        SEAM(pb + 7);
    }
    if (IN(N_PHASES - 1)) ph_final_norm(F, XR, P1B, P2, kp->in[3]);
#undef IN
#undef SEAM
#undef HN
#undef Z
#undef YC
#undef G1
#undef KC
#undef VC
#undef LIST
#undef LISTW
#undef HID
#undef P2
#undef P1B
#undef USSM
#undef XL
}

extern "C" void kernel_launch(void* const* d_in, const int* in_sizes, int n_in, void* d_out, int out_size, void* d_ws, size_t ws_size, hipStream_t stream) {
    static int grid = 0;
    if (grid == 0) {
        if (n_in != 26 || out_size != T * DM || ws_size < WS_END) { fprintf(stderr, "kernel_launch: unexpected shapes (n_in %d out %d ws %zu)\n", n_in, out_size, ws_size); grid = -1; return; }
        int dev = 0, cus = 0, per_cu = 0;
        if (hipGetDevice(&dev) != hipSuccess || hipDeviceGetAttribute(&cus, hipDeviceAttributeMultiprocessorCount, dev) != hipSuccess) { grid = -1; return; }
        if (hipFuncSetAttribute((const void*)fwd, hipFuncAttributeMaxDynamicSharedMemorySize, LDS_BYTES) != hipSuccess) { fprintf(stderr, "kernel_launch: hipFuncSetAttribute failed\n"); grid = -1; return; }
        if (hipOccupancyMaxActiveBlocksPerMultiprocessor(&per_cu, (const void*)fwd, NTHR, LDS_BYTES) != hipSuccess || per_cu < 1) fprintf(stderr, "kernel_launch: occupancy query says %d\n", per_cu);
        (void)hipGetLastError();
        grid = cus;
    }
    if (grid < 0) return;
    (void)hipMemsetAsync((char*)d_ws + WS_CTL, 0, CTL_ZERO_BYTES, stream);
    Args a{};
    for (int i = 0; i < 26; ++i) a.in[i] = (const float*)d_in[i];
    a.out = (float*)d_out; a.ws = (unsigned char*)d_ws;
    if (N_LAUNCH_MODE == 1) {
        a.ph_lo = 0; a.ph_hi = N_PHASES;
        hipLaunchKernelGGL(fwd, dim3(grid), dim3(NTHR), LDS_BYTES, stream, a);
    } else {
        for (int p = 0; p < N_PHASES; ++p) { a.ph_lo = p; a.ph_hi = p + 1; hipLaunchKernelGGL(fwd, dim3(grid), dim3(NTHR), LDS_BYTES, stream, a); }
    }
}
```

```cpp
#include <hip/hip_runtime.h>
#include <cstdio>
#include <cstdint>

#ifndef N_LAUNCH_MODE
#define N_LAUNCH_MODE 1
#endif

#define GAS __attribute__((address_space(1)))
#define LAS __attribute__((address_space(3)))
typedef unsigned short bf16;
typedef float f32x4 __attribute__((ext_vector_type(4)));
typedef unsigned u32x4 __attribute__((ext_vector_type(4)));
typedef unsigned u32x2 __attribute__((ext_vector_type(2)));

constexpr int BATCH = 8, SEQ = 4096, DM = 1024, T = BATCH * SEQ, DEPTH = 2;
constexpr int D_SSM = 512, NGRP = 32, SGRP = 16, SST = 64;
constexpr int D_IN = 1816, ZP = 2048;
constexpr int ZC_U = 0, ZC_Q = 512, ZC_KV = 1024, ZC_G = 1792;
constexpr int NCMP = 255, NCMPP = 256;
constexpr float EPS = 1e-6f;
constexpr int NWAVES = 8, NTHR = 512;
constexpr float QSCALE = 0.125f * 1.4426950408889634f;

constexpr size_t MiB = 1u << 20;
constexpr size_t WS_CTL = 0, CTL_ZERO_BYTES = 1 * MiB;
constexpr size_t WS_KC = 1 * MiB, WS_VC = 2 * MiB, WS_ROUTE = 3 * MiB;
constexpr size_t WS_HN = 16 * MiB;
constexpr size_t WS_Z = 80 * MiB;
constexpr size_t WS_YC = 208 * MiB;
constexpr size_t WS_G1 = 272 * MiB;
constexpr size_t WS_WIN = 304 * MiB;
constexpr size_t WS_WGLU = 312 * MiB;
constexpr size_t WS_WOUT = 314 * MiB;
constexpr size_t WS_WGU = 318 * MiB;
constexpr size_t WS_WDN = 382 * MiB;
constexpr size_t WS_LIST = 414 * MiB;
constexpr size_t WS_LISTW = 418 * MiB;
constexpr size_t WS_HID = 422 * MiB;
constexpr size_t WS_P2 = WS_Z;
constexpr size_t WS_USSM = WS_YC;
constexpr size_t WS_XL = WS_HID;
constexpr size_t WS_BT1 = 458 * MiB;
constexpr size_t WS_BT2 = 466 * MiB;
constexpr size_t WS_W1T = 478 * MiB;
constexpr size_t WS_HIDC = 4 * MiB;
constexpr size_t WS_CBIAS = 5 * MiB;
constexpr size_t WS_W2T = 6 * MiB;
constexpr size_t WS_END = 482 * MiB;
constexpr int LCAP = 32768, CW_CNT = 8192;
constexpr int CW_BAR = 4096;

constexpr int LDS_BYTES = 163840;
constexpr int ETAB_OFF = LDS_BYTES - 1024, MISC_OFF = LDS_BYTES - 512;

__device__ __forceinline__ float bf2f(bf16 v) { return __uint_as_float(((unsigned)v) << 16); }
__device__ __forceinline__ unsigned f2bf(float f) { unsigned u = __float_as_uint(f); return (u + 0x7fffu + ((u >> 16) & 1u)) >> 16; }
__device__ __forceinline__ unsigned pk2(float lo, float hi) { return f2bf(lo) | (f2bf(hi) << 16); }
__device__ __forceinline__ float wave_sum(float v, int) {
    v += __builtin_bit_cast(float, __builtin_amdgcn_update_dpp(0, __builtin_bit_cast(int, v), 0xB1, 0xF, 0xF, true));
    v += __builtin_bit_cast(float, __builtin_amdgcn_update_dpp(0, __builtin_bit_cast(int, v), 0x4E, 0xF, 0xF, true));
    v += __builtin_bit_cast(float, __builtin_amdgcn_update_dpp(0, __builtin_bit_cast(int, v), 0x141, 0xF, 0xF, true));
    v += __builtin_bit_cast(float, __builtin_amdgcn_update_dpp(0, __builtin_bit_cast(int, v), 0x140, 0xF, 0xF, true));
    const int iv = __builtin_bit_cast(int, v);
    const float s0 = __builtin_bit_cast(float, __builtin_amdgcn_readlane(iv, 0)), s1 = __builtin_bit_cast(float, __builtin_amdgcn_readlane(iv, 16));
    const float s2 = __builtin_bit_cast(float, __builtin_amdgcn_readlane(iv, 32)), s3 = __builtin_bit_cast(float, __builtin_amdgcn_readlane(iv, 48));
    return (s0 + s1) + (s2 + s3);
}
__device__ __forceinline__ float wave_max(float v, int lane) {
#pragma unroll
    for (int o = 1; o < 64; o <<= 1) v = fmaxf(v, __int_as_float(__builtin_amdgcn_ds_bpermute((lane ^ o) << 2, __float_as_int(v))));
    return v;
}
__device__ __forceinline__ float lane_bcast(float v, int src) { return __int_as_float(__builtin_amdgcn_ds_bpermute(src << 2, __float_as_int(v))); }
__device__ __forceinline__ float gelu_tanh(float x) {
    const float u = 0.7978845608028654f * (x + 0.044715f * x * x * x);
    return 0.5f * x * (1.0f + tanhf(u));
}
__device__ __forceinline__ float sigmoidf_(float x) { return 1.0f / (1.0f + __expf(-x)); }
__device__ __forceinline__ int t5_bucket(int n) {
    if (n < 16) return n < 0 ? 0 : n;
    int b = 16;
    b += (n >= 19); b += (n >= 21); b += (n >= 24); b += (n >= 27); b += (n >= 31); b += (n >= 35); b += (n >= 40); b += (n >= 46);
    b += (n >= 52); b += (n >= 59); b += (n >= 67); b += (n >= 77); b += (n >= 87); b += (n >= 99); b += (n >= 113);
    return b;
}

#define XB_TMO      128
#define XB_XCNT(j)  (256  + 64 * (j))
#define XB_XSUB(j)  (1280 + 64 * (j))
#define XB_XGEN(j)  (2304 + 64 * (j))
#define XB_TOP      3328
#define XB_TOPGEN   3392
#define XCD_BAR_WORDS 3456
#define XB_SPIN_CAP (1u << 22)

__device__ __forceinline__ unsigned xb_ld(unsigned* p)              { return __hip_atomic_load(p, __ATOMIC_RELAXED, __HIP_MEMORY_SCOPE_AGENT); }
__device__ __forceinline__ unsigned xb_add(unsigned* p, unsigned v) { return __hip_atomic_fetch_add(p, v, __ATOMIC_RELAXED, __HIP_MEMORY_SCOPE_AGENT); }
__device__ __forceinline__ unsigned xb_xcc_id() { return (unsigned)__builtin_amdgcn_s_getreg((3 << 11) | 20) & 0xFu; }
#define XB_SPIN(cond, bar) do { unsigned _sp = 0; while (cond) { __builtin_amdgcn_s_sleep(1); \
    if ((++_sp & 255u) == 0u) { if (xb_ld(&(bar)[XB_TMO])) break; if (_sp > XB_SPIN_CAP) { atomicAdd(&(bar)[XB_TMO], 1u); break; } } } } while (0)

struct XcdBarrier { unsigned* bar; unsigned x; volatile LAS unsigned* st; };

__device__ __forceinline__ XcdBarrier xcd_barrier_post(unsigned* bar, volatile LAS unsigned* st) {
    XcdBarrier b; b.bar = bar; b.x = xb_xcc_id(); b.st = st;
    if (threadIdx.x == 0) (void)xb_add(&bar[XB_XCNT(b.x)], 1u);
    return b;
}
__device__ __forceinline__ void xcd_barrier_complete(unsigned* bar, unsigned x, unsigned& nloc, unsigned& nx) {
    const unsigned G = gridDim.x * gridDim.y * gridDim.z;
    unsigned sum, cnt, mine, sp = 0u;
    for (;;) {
        sum = 0u; cnt = 0u; mine = 0u;
#pragma unroll
        for (unsigned j = 0; j < 16; ++j) { const unsigned c = xb_ld(&bar[XB_XCNT(j)]); sum += c; cnt += (c > 0u) ? 1u : 0u; mine = (j == x) ? c : mine; }
        if (sum == G) break;
        __builtin_amdgcn_s_sleep(1);
        if ((++sp & 255u) == 0u) { if (xb_ld(&bar[XB_TMO])) break; if (sp > XB_SPIN_CAP) { atomicAdd(&bar[XB_TMO], 1u); break; } }
    }
    nloc = mine > 0u ? mine : 1u; nx = cnt > 0u ? cnt : 1u;
}
__device__ __forceinline__ void xcd_barrier(const XcdBarrier& b, const int tid) {
    asm volatile("s_waitcnt vmcnt(0)" ::: "memory");
    __syncthreads();
    if (tid == 0) {
        unsigned* bar = b.bar;
        __builtin_amdgcn_s_waitcnt(0);
        unsigned nloc = b.st[0], nx = b.st[1];
        if (nloc == 0u) { xcd_barrier_complete(bar, b.x, nloc, nx); b.st[0] = nloc; b.st[1] = nx; }
        const unsigned old = xb_add(&bar[XB_XSUB(b.x)], 1u);
        const unsigned gen = old / nloc;
        if (old + 1u == (gen + 1u) * nloc) {
            __builtin_amdgcn_fence(__ATOMIC_RELEASE, "agent");
            asm volatile("s_waitcnt vmcnt(0)" ::: "memory");
            const unsigned og = xb_add(&bar[XB_TOP], 1u);
            const unsigned tg = og / nx;
            if (og + 1u == (tg + 1u) * nx) xb_add(&bar[XB_TOPGEN], 1u);
            else XB_SPIN(xb_ld(&bar[XB_TOPGEN]) == tg, bar);
            __builtin_amdgcn_fence(__ATOMIC_ACQUIRE, "agent");
            xb_add(&bar[XB_XGEN(b.x)], 1u);
            asm volatile("s_waitcnt vmcnt(0)" ::: "memory");
        } else {
            XB_SPIN(xb_ld(&bar[XB_XGEN(b.x)]) == gen, bar);
            __builtin_amdgcn_fence(__ATOMIC_ACQUIRE, "agent");
            asm volatile("s_waitcnt vmcnt(0)" ::: "memory");
        }
    }
    __syncthreads();
}

namespace pg8 {
#define PG8_LAS __attribute__((address_space(3)))
typedef unsigned short bf16_t;
typedef short bf16x8 __attribute__((ext_vector_type(8)));
typedef float f32x4 __attribute__((ext_vector_type(4)));
typedef unsigned u32x4 __attribute__((ext_vector_type(4)));
constexpr int BM = 256, BK = 64, HALF = 128, HTB = HALF * BK * 2  , STAGE_BYTES = 8 * HTB, NXCD = 8, WGM = 8;

__host__ __device__ __forceinline__ int lds_byte(int r, int c) { const int st = (r >> 4) * 2 + (c >> 5), rr = r & 15, cc = c & 31, ob = rr * 64 + cc * 2; return st * 1024 + (ob ^ (((ob >> 9) & 1) << 5)); }
__host__ __device__ __forceinline__ void stage_rc(int b, int& R, int& C) { const int st = b / 1024, sb = b % 1024, swz = sb ^ (((sb >> 9) & 1) << 5); R = (st >> 1) * 16 + swz / 64; C = (st & 1) * 32 + (swz % 64) / 2; }
__host__ __device__ __forceinline__ int perm32(int rho) { const int n = rho >> 4, i = rho & 15; return 8 * (i >> 2) + 4 * n + (i & 3); }

struct Unit { int pm, pn, eb, p0, cnt; };
struct Gemm { const bf16_t* A; const bf16_t* Bt; int M, N, K; int lda; size_t bstride; const unsigned* list; int cap; size_t astride; int kstepA; };

struct StaticOrder {
    int nM, nN, nwg, G, c;
    __host__ __device__ void init(int M, int N, int G_, int c_) { nM = M / BM; nN = N / BM; nwg = nM * nN; G = G_; c = c_; }
    __host__ __device__ bool next(int i, Unit& u) const {
        const long L = (long)i * G + c; if (L >= nwg) return false;
        int wgid = (int)L; { const int q = nwg / NXCD, r = nwg % NXCD, xcd = wgid % NXCD, off = wgid / NXCD; wgid = (xcd < r ? xcd * (q + 1) : r * (q + 1) + (xcd - r) * q) + off; }
        const int nig = WGM * nN, gid = wgid / nig, fm = gid * WGM, gsz = (nM - fm) < WGM ? (nM - fm) : WGM;
        u.pm = fm + ((wgid % nig) % gsz); u.pn = (wgid % nig) / gsz; u.eb = 0; u.p0 = 0; u.cnt = 0; return true;
    }
    __device__ __forceinline__ void a_ready(const Unit&) const {}
    __device__ __forceinline__ void done(const Unit&) const {}
};

__device__ __forceinline__ unsigned cvt_pk_bf16(float lo, float hi) { unsigned r; asm volatile("v_cvt_pk_bf16_f32 %0, %1, %2" : "=v"(r) : "v"(lo), "v"(hi)); return r; }
typedef float f32x2 __attribute__((ext_vector_type(2)));
__device__ __forceinline__ f32x2 gelu_pk(f32x2 v) {
    const f32x2 av = __builtin_elementwise_abs(v), d = av * 0.2316418882f + 1.0f;
    f32x2 t; t.x = __builtin_amdgcn_rcpf(d.x); t.y = __builtin_amdgcn_rcpf(d.y);
    f32x2 q = t * 0.5307027145f + (-0.7265760135f); q = q * t + 0.7107068705f; q = q * t + (-0.142248368f); q = q * t + 0.127414796f; q = q * t;
    const f32x2 s = (v * v) * (-0.72134752044f);
    f32x2 e; e.x = __builtin_amdgcn_exp2f(s.x); e.y = __builtin_amdgcn_exp2f(s.y);
    const f32x2 m = v * (q * e), r = v - m;
    f32x2 o; o.x = v.x < 0.f ? m.x : r.x; o.y = v.y < 0.f ? m.y : r.y; return o;
}

template <int ACT  > struct EpiBf16 {
    static constexpr bool PERM = true, AFTER_DRAIN = false; static_assert(ACT == 0 || ACT == 1, "EpiBf16: ACT is 0 (none) or 1 (gelu_pk)");
    bf16_t* O; int ldc; const float* bias; int split_cols; size_t split_stride; float scale0;
    __device__ __forceinline__ void operator()(const f32x4 (&acc)[2][2][4][2], const Unit& u, int wr, int wc, int fr, int fq) const {
        const int row0 = u.pm * BM + wr * 64 + fr; int colt = u.pn * BM; bf16_t* base = O;
        float sc = 1.f; if (split_cols) { const int t = colt / split_cols; base += (size_t)t * split_stride; colt -= t * split_cols; if (t == 0) sc = scale0; }
        const int col0 = colt + wc * 32 + 8 * fq, bcol0 = u.pn * BM + wc * 32 + 8 * fq;
        f32x4 bv[2][2];
#pragma unroll
        for (int bj = 0; bj < 2; ++bj)
#pragma unroll
            for (int n = 0; n < 2; ++n) bv[bj][n] = bias ? *(const f32x4*)(bias + bcol0 + bj * HALF + 4 * n) : (f32x4){0.f, 0.f, 0.f, 0.f};
#pragma unroll
        for (int ai = 0; ai < 2; ++ai)
#pragma unroll
            for (int m = 0; m < 4; ++m) { bf16_t* rowp = base + (size_t)(row0 + ai * HALF + m * 16) * ldc + col0;
#pragma unroll
                for (int bj = 0; bj < 2; ++bj) { f32x4 v0 = acc[ai][bj][m][0] + bv[bj][0], v1 = acc[ai][bj][m][1] + bv[bj][1];
                    if (ACT == 1) { f32x2 a = gelu_pk((f32x2){v0[0], v0[1]}), b = gelu_pk((f32x2){v0[2], v0[3]}), c = gelu_pk((f32x2){v1[0], v1[1]}), d = gelu_pk((f32x2){v1[2], v1[3]});
                        v0 = (f32x4){a.x, a.y, b.x, b.y}; v1 = (f32x4){c.x, c.y, d.x, d.y}; }
                    v0 = v0 * sc; v1 = v1 * sc; u32x4 w; w.x = cvt_pk_bf16(v0[0], v0[1]); w.y = cvt_pk_bf16(v0[2], v0[3]); w.z = cvt_pk_bf16(v1[0], v1[1]); w.w = cvt_pk_bf16(v1[2], v1[3]);
                    *(u32x4*)(rowp + bj * HALF) = w; } }
    }
};
template <class Epi, class Sched, bool ALIGN_EPI = false, bool SP2 = false>
__device__ __forceinline__ void gemm_phase(PG8_LAS unsigned char* lds, const Gemm g, const Sched& S, const Epi& E) {
    int tid_ = threadIdx.x; asm volatile("" : "+v"(tid_));
    const int tid = tid_, wid = __builtin_amdgcn_readfirstlane(tid >> 6), lane = tid & 63, wr = wid >> 2, wc = wid & 3, fr = lane & 15, fq = lane >> 4;
    const int K = g.K, nt = K / BK;
    unsigned voffA[2], voffB[2];
#pragma unroll
    for (int i = 0; i < 2; ++i) { int R, C; stage_rc(tid * 16 + i * 8192, R, C); const int Rb = Epi::PERM ? ((R & ~31) + perm32(R & 31)) : R;
        voffA[i] = (unsigned)(R * K + C) * 2u; voffB[i] = (unsigned)(Rb * K + C) * 2u; }
    const size_t kstep = (size_t)(BK * 2);
    const size_t hstep = (size_t)HALF * K * 2;
    const size_t tstep = 2 * hstep;
    const unsigned ldsw = (unsigned)wid * 1024u;
    const int aoff = lds_byte(wr * 64 + fr, fq * 8), boff = lds_byte(wc * 32 + fr, fq * 8);
#define PG8_SA(b, h) (((b) * 2 + (h)) * HTB)
#define PG8_SB(b, h) ((4 + (b) * 2 + (h)) * HTB)
#define PG8_STAGE(bufoff, gbase, voff) do { _Pragma("unroll") for (int _i = 0; _i < 2; ++_i) \
        __builtin_amdgcn_global_load_lds((const unsigned*)((const char*)(gbase) + (voff)[_i]), (PG8_LAS unsigned*)(lds + (bufoff) + ldsw + _i * 8192), 16, 0, 0); } while (0)
#define PG8_LDA(dst, b, h) do { _Pragma("unroll") for (int m = 0; m < 4; ++m) _Pragma("unroll") for (int k = 0; k < 2; ++k) dst[m][k] = *(const PG8_LAS bf16x8*)(lds + PG8_SA(b, h) + aoff + m * 2048 + k * 1024); } while (0)
#define PG8_LDB(dst, b, h) do { _Pragma("unroll") for (int n = 0; n < 2; ++n) _Pragma("unroll") for (int k = 0; k < 2; ++k) dst[n][k] = *(const PG8_LAS bf16x8*)(lds + PG8_SB(b, h) + boff + n * 2048 + k * 1024); } while (0)
#define PG8_MMA(ai, bj, At, Bt) do { __builtin_amdgcn_s_setprio(1); _Pragma("unroll") for (int m = 0; m < 4; ++m) _Pragma("unroll") for (int n = 0; n < 2; ++n) _Pragma("unroll") for (int k = 0; k < 2; ++k) \
        acc[ai][bj][m][n] = __builtin_amdgcn_mfma_f32_16x16x32_bf16(Bt[n][k], At[m][k], acc[ai][bj][m][n], 0, 0, 0); __builtin_amdgcn_s_setprio(0); } while (0)
#define PG8_WAIT_V(n) asm volatile("s_waitcnt vmcnt(" #n ")" ::: "memory")
#define PG8_WAIT_L(n) asm volatile("s_waitcnt lgkmcnt(" #n ")" ::: "memory")
#define PG8_BAR __builtin_amdgcn_s_barrier()
#define PG8_SCHED __builtin_amdgcn_sched_barrier(0)
    Unit cur, nxt; int ui = 0;
    if (!S.next(0, cur)) return;
    f32x4 acc[2][2][4][2];
#pragma unroll
    for (int a = 0; a < 2; ++a)
#pragma unroll
        for (int b = 0; b < 2; ++b)
#pragma unroll
            for (int m = 0; m < 4; ++m)
#pragma unroll
                for (int n = 0; n < 2; ++n) acc[a][b][m][n] = (f32x4){0.f, 0.f, 0.f, 0.f};
    bf16x8 At[4][2], B0[2][2], B1[2][2];
    const char* cA = (const char*)g.A + (size_t)cur.pm * tstep; const char* cB = (const char*)g.Bt + (size_t)cur.pn * tstep;
    S.a_ready(cur);
    if constexpr (SP2) {
        PG8_STAGE(PG8_SB(0, 0), cB, voffB); PG8_STAGE(PG8_SB(0, 1), cB + hstep, voffB); PG8_STAGE(PG8_SA(0, 0), cA, voffA); PG8_STAGE(PG8_SA(0, 1), cA + hstep, voffA);
        if (wr == 1) PG8_BAR;
        PG8_WAIT_V(2); PG8_BAR;
        PG8_STAGE(PG8_SB(1, 0), cB + kstep, voffB); PG8_STAGE(PG8_SA(1, 0), cA + kstep, voffA); PG8_STAGE(PG8_SB(1, 1), cB + hstep + kstep, voffB);
        PG8_WAIT_V(6); PG8_BAR;
    } else {
        PG8_STAGE(PG8_SB(0, 0), cB, voffB); PG8_STAGE(PG8_SA(0, 0), cA, voffA); PG8_STAGE(PG8_SB(0, 1), cB + hstep, voffB); PG8_STAGE(PG8_SA(0, 1), cA + hstep, voffA);
        if (wr == 1) PG8_BAR;
        PG8_WAIT_V(4); PG8_BAR;
        PG8_STAGE(PG8_SB(1, 0), cB + kstep, voffB); PG8_STAGE(PG8_SA(1, 0), cA + kstep, voffA); PG8_STAGE(PG8_SB(1, 1), cB + hstep + kstep, voffB);
        PG8_WAIT_V(6); PG8_BAR;
    }
    for (;;) {
        const bool has_next = S.next(ui + 1, nxt);
        const char* nA = has_next ? (const char*)g.A + (size_t)nxt.pm * tstep : cA; const char* nB = has_next ? (const char*)g.Bt + (size_t)nxt.pn * tstep : cB;
        for (int t = 0; t < nt; t += 2) {
            const bool last = (t == nt - 2);
            const char* a1 = cA + (size_t)(t + 1) * kstep;
            const char* a2 = last ? nA : cA + (size_t)(t + 2) * kstep; const char* b2 = last ? nB : cB + (size_t)(t + 2) * kstep;
            const char* a3 = a2 + kstep; const char* b3 = b2 + kstep;
            if (last && has_next) S.a_ready(nxt);
            if constexpr (SP2) {
            PG8_LDB(B0, 0, 0); PG8_LDB(B1, 0, 1); PG8_SCHED; PG8_LDA(At, 0, 0); PG8_STAGE(PG8_SA(1, 1), a1 + hstep, voffA);
            PG8_WAIT_V(8); PG8_WAIT_L(0); PG8_BAR; PG8_MMA(0, 0, At, B0); PG8_MMA(0, 1, At, B1); PG8_BAR; PG8_SCHED;
            PG8_LDA(At, 0, 1); PG8_STAGE(PG8_SB(0, 0), b2, voffB); PG8_STAGE(PG8_SB(0, 1), b2 + hstep, voffB); PG8_STAGE(PG8_SA(0, 0), a2, voffA);
            PG8_WAIT_V(8); PG8_WAIT_L(0); PG8_BAR; PG8_MMA(1, 0, At, B0); PG8_MMA(1, 1, At, B1); PG8_BAR; PG8_SCHED;
            PG8_LDB(B0, 1, 0); PG8_LDB(B1, 1, 1); PG8_SCHED; PG8_LDA(At, 1, 0); PG8_STAGE(PG8_SA(0, 1), a2 + hstep, voffA);
            PG8_WAIT_V(8); PG8_WAIT_L(0); PG8_BAR; PG8_MMA(0, 0, At, B0); PG8_MMA(0, 1, At, B1); PG8_BAR; PG8_SCHED;
            PG8_LDA(At, 1, 1); PG8_STAGE(PG8_SB(1, 0), b3, voffB); PG8_STAGE(PG8_SB(1, 1), b3 + hstep, voffB); PG8_STAGE(PG8_SA(1, 0), a3, voffA);
            PG8_WAIT_V(8); PG8_WAIT_L(0); PG8_BAR; PG8_MMA(1, 0, At, B0); PG8_MMA(1, 1, At, B1); PG8_BAR; PG8_SCHED;
            } else {
            PG8_LDB(B0, 0, 0); PG8_SCHED; PG8_LDA(At, 0, 0); PG8_STAGE(PG8_SA(1, 1), a1 + hstep, voffA);
            PG8_WAIT_L(8); PG8_BAR; PG8_WAIT_L(0); PG8_MMA(0, 0, At, B0); PG8_BAR; PG8_SCHED;
            PG8_LDB(B1, 0, 1); PG8_STAGE(PG8_SB(0, 0), b2, voffB);
            PG8_BAR; PG8_WAIT_L(0); PG8_MMA(0, 1, At, B1); PG8_BAR;
            PG8_LDA(At, 0, 1); PG8_STAGE(PG8_SA(0, 0), a2, voffA);
            PG8_BAR; PG8_WAIT_L(0); PG8_MMA(1, 0, At, B0); PG8_BAR; PG8_SCHED;
            PG8_STAGE(PG8_SB(0, 1), b2 + hstep, voffB);
            PG8_WAIT_V(6); PG8_BAR; PG8_MMA(1, 1, At, B1); PG8_BAR;
            PG8_LDB(B0, 1, 0); PG8_SCHED; PG8_LDA(At, 1, 0); PG8_STAGE(PG8_SA(0, 1), a2 + hstep, voffA);
            PG8_WAIT_L(8); PG8_BAR; PG8_WAIT_L(0); PG8_MMA(0, 0, At, B0); PG8_BAR; PG8_SCHED;
            PG8_LDB(B1, 1, 1); PG8_STAGE(PG8_SB(1, 0), b3, voffB);
            PG8_BAR; PG8_WAIT_L(0); PG8_MMA(0, 1, At, B1); PG8_BAR;
            PG8_LDA(At, 1, 1); PG8_STAGE(PG8_SA(1, 0), a3, voffA);
            PG8_BAR; PG8_WAIT_L(0); PG8_MMA(1, 0, At, B0); PG8_BAR; PG8_SCHED;
            PG8_STAGE(PG8_SB(1, 1), b3 + hstep, voffB);
            PG8_WAIT_V(6); PG8_BAR; PG8_MMA(1, 1, At, B1); PG8_BAR;
            }
        }
        if constexpr (ALIGN_EPI) { if (wr == 0) PG8_BAR; }
        if constexpr (!Epi::AFTER_DRAIN) { E(acc, cur, wr, wc, fr, fq); S.done(cur); }
        if (!has_next) break;
#pragma unroll
        for (int a = 0; a < 2; ++a)
#pragma unroll
            for (int b = 0; b < 2; ++b)
#pragma unroll
                for (int m = 0; m < 4; ++m)
#pragma unroll
                    for (int n = 0; n < 2; ++n) acc[a][b][m][n] = (f32x4){0.f, 0.f, 0.f, 0.f};
        cur = nxt; cA = nA; cB = nB; ++ui;
        if constexpr (ALIGN_EPI) { if (wr == 1) PG8_BAR; }
    }
    PG8_WAIT_V(0);
    if constexpr (!ALIGN_EPI) { if (wr == 0) PG8_BAR; }
    PG8_BAR;
    if constexpr (Epi::AFTER_DRAIN) { E.fused(acc, cur, wr, wc, fr, fq, lds, wid, lane); S.done(cur); }
#undef PG8_SA
#undef PG8_SB
#undef PG8_STAGE
#undef PG8_LDA
#undef PG8_LDB
#undef PG8_MMA
#undef PG8_WAIT_V
#undef PG8_WAIT_L
#undef PG8_BAR
#undef PG8_SCHED
}

__device__ __forceinline__ float sigm(float x) { return 1.0f / (1.0f + __expf(-x)); }
struct EpiGlu {
    static constexpr bool PERM = true, AFTER_DRAIN = false;
    bf16_t* O; int ldc;
    __device__ __forceinline__ void operator()(const f32x4 (&acc)[2][2][4][2], const Unit& u, int wr, int wc, int fr, int fq) const {
        const int row0 = u.pm * BM + wr * 64 + fr, col0 = u.pn * HALF + wc * 32 + 8 * fq;
#pragma unroll
        for (int ai = 0; ai < 2; ++ai)
#pragma unroll
            for (int m = 0; m < 4; ++m) {
                bf16_t* rowp = O + (size_t)(row0 + ai * HALF + m * 16) * ldc + col0;
                const f32x4 a0 = acc[ai][0][m][0], a1 = acc[ai][0][m][1], b0 = acc[ai][1][m][0], b1 = acc[ai][1][m][1];
                u32x4 w;
                w.x = cvt_pk_bf16(a0[0] * sigm(b0[0]), a0[1] * sigm(b0[1])); w.y = cvt_pk_bf16(a0[2] * sigm(b0[2]), a0[3] * sigm(b0[3]));
                w.z = cvt_pk_bf16(a1[0] * sigm(b1[0]), a1[1] * sigm(b1[1])); w.w = cvt_pk_bf16(a1[2] * sigm(b1[2]), a1[3] * sigm(b1[3]));
                *(u32x4*)rowp = w;
            }
    }
};
struct EpiResid {
    static constexpr bool PERM = false, AFTER_DRAIN = false;
    const float* X; float* O; int ldc;
    __device__ __forceinline__ void operator()(const f32x4 (&acc)[2][2][4][2], const Unit& u, int wr, int wc, int fr, int fq) const {
        const int row0 = u.pm * BM + wr * 64 + fr, col0 = u.pn * BM + wc * 32 + 4 * fq;
#pragma unroll
        for (int ai = 0; ai < 2; ++ai)
#pragma unroll
            for (int m = 0; m < 4; ++m) {
                const size_t off = (size_t)(row0 + ai * HALF + m * 16) * ldc + col0;
#pragma unroll
                for (int bj = 0; bj < 2; ++bj)
#pragma unroll
                    for (int n = 0; n < 2; ++n) *(f32x4*)(O + off + bj * HALF + n * 16) = *(const f32x4*)(X + off + bj * HALF + n * 16) + acc[ai][bj][m][n];
            }
    }
};

struct ADense { static constexpr bool GATHER = false; __device__ __forceinline__ static unsigned rowoff(const Gemm&, const Unit&, int) { return 0u; } };
struct AList { static constexpr bool GATHER = true;
    __device__ __forceinline__ static unsigned rowoff(const Gemm& g, const Unit& u, int r) { const int pos = u.p0 + r; const unsigned tok = pos < u.cnt ? (g.list[(size_t)u.eb * g.cap + pos] >> 1) : 0u; return tok * (unsigned)g.lda * 2u; } };
struct ACompress { static constexpr bool GATHER = true;
    __device__ __forceinline__ static unsigned rowoff(const Gemm&, const Unit& u, int r) { const unsigned rg = (unsigned)(u.pm * BM + r), b = rg >> 9, n = (rg >> 1) & 255u, hkv = rg & 1u;
        return (((b * 4096u + 16u * n) * 2048u) + 1024u + (unsigned)u.eb * 128u + hkv * 64u) * 2u; } };
template <class Epi, class Sched, class AMap>
__device__ __forceinline__ void gemm2(PG8_LAS unsigned char* lds, const Gemm g, const Sched& S, const Epi& E, const int tid) {
    constexpr bool GATHER = AMap::GATHER;
    int K_ = g.K; asm volatile("" : "+s"(K_));
    const int wid = __builtin_amdgcn_readfirstlane(tid >> 6), lane = tid & 63, wr = wid >> 2, wc = wid & 3, fr = lane & 15, fq = lane >> 4;
    const int K = K_, nt = K / BK, lda = g.lda;
    unsigned voffA[2], voffB[2]; int Rst[2], Cst[2];
#pragma unroll
    for (int i = 0; i < 2; ++i) { int R, C; stage_rc(tid * 16 + i * 8192, R, C); const int Rb = Epi::PERM ? ((R & ~31) + perm32(R & 31)) : R;
        voffA[i] = (unsigned)(R * lda + C) * 2u; voffB[i] = (unsigned)(Rb * K + C) * 2u; Rst[i] = R; Cst[i] = C; }
    const size_t kstep = (size_t)(BK * 2), kstepA = (size_t)g.kstepA;
    const size_t hstepA = (size_t)HALF * lda * 2, tstepA = 2 * hstepA, hstepB = (size_t)HALF * K * 2, tstepB = 2 * hstepB;
    const unsigned ldsw = (unsigned)wid * 1024u;
    const int aoff = lds_byte(wr * 64 + fr, fq * 8), boff = lds_byte(wc * 32 + fr, fq * 8);
#define PG8_SA(b, h) (((b) * 2 + (h)) * HTB)
#define PG8_SB(b, h) ((4 + (b) * 2 + (h)) * HTB)
#define PG8_STAGE(bufoff, gbase, voff) do { _Pragma("unroll") for (int _i = 0; _i < 2; ++_i) \
        __builtin_amdgcn_global_load_lds((const unsigned*)((const char*)(gbase) + (voff)[_i]), (PG8_LAS unsigned*)(lds + (bufoff) + ldsw + _i * 8192), 16, 0, 0); } while (0)
#define PG8_STAGE_A(bufoff, gbase, h) do { if constexpr (GATHER) { PG8_STAGE(bufoff, gbase, vg[h]); } else { PG8_STAGE(bufoff, (gbase) + (h) * hstepA, voffA); } } while (0)
#define PG8_GOFFS(u, dst) do { _Pragma("unroll") for (int _h = 0; _h < 2; ++_h) _Pragma("unroll") for (int _i = 0; _i < 2; ++_i) dst[_h][_i] = AMap::rowoff(g, (u), _h * HALF + Rst[_i]) + (unsigned)Cst[_i] * 2u; } while (0)
#define PG8_LDA(dst, b, h) do { _Pragma("unroll") for (int m = 0; m < 4; ++m) _Pragma("unroll") for (int k = 0; k < 2; ++k) dst[m][k] = *(const PG8_LAS bf16x8*)(lds + PG8_SA(b, h) + aoff + m * 2048 + k * 1024); } while (0)
#define PG8_LDB(dst, b, h) do { _Pragma("unroll") for (int n = 0; n < 2; ++n) _Pragma("unroll") for (int k = 0; k < 2; ++k) dst[n][k] = *(const PG8_LAS bf16x8*)(lds + PG8_SB(b, h) + boff + n * 2048 + k * 1024); } while (0)
#define PG8_MMA(ai, bj, At, Bt) do { __builtin_amdgcn_s_setprio(1); _Pragma("unroll") for (int m = 0; m < 4; ++m) _Pragma("unroll") for (int n = 0; n < 2; ++n) _Pragma("unroll") for (int k = 0; k < 2; ++k) \
        acc[ai][bj][m][n] = __builtin_amdgcn_mfma_f32_16x16x32_bf16(Bt[n][k], At[m][k], acc[ai][bj][m][n], 0, 0, 0); __builtin_amdgcn_s_setprio(0); } while (0)
#define PG8_WAIT_V(n) asm volatile("s_waitcnt vmcnt(" #n ")" ::: "memory")
#define PG8_WAIT_L(n) asm volatile("s_waitcnt lgkmcnt(" #n ")" ::: "memory")
#define PG8_BAR __builtin_amdgcn_s_barrier()
#define PG8_SCHED __builtin_amdgcn_sched_barrier(0)
    Unit cur, nxt; int ui = 0;
    if (!S.next(0, cur)) return;
    f32x4 acc[2][2][4][2];
#pragma unroll
    for (int a = 0; a < 2; ++a)
#pragma unroll
        for (int b = 0; b < 2; ++b)
#pragma unroll
            for (int m = 0; m < 4; ++m)
#pragma unroll
                for (int n = 0; n < 2; ++n) acc[a][b][m][n] = (f32x4){0.f, 0.f, 0.f, 0.f};
    bf16x8 At[4][2], B0[2][2], B1[2][2];
    unsigned vg[2][2] = {{0u, 0u}, {0u, 0u}};
    if constexpr (GATHER) PG8_GOFFS(cur, vg);
    const char* cA = (const char*)g.A + (GATHER ? (size_t)0 : (size_t)cur.pm * tstepA + (size_t)cur.eb * g.astride * 2);
    const char* cB = (const char*)g.Bt + ((size_t)cur.eb * g.bstride) * 2 + (size_t)cur.pn * tstepB;
    S.a_ready(cur);
    PG8_STAGE(PG8_SB(0, 0), cB, voffB); PG8_STAGE(PG8_SB(0, 1), cB + hstepB, voffB); PG8_STAGE_A(PG8_SA(0, 0), cA, 0); PG8_STAGE_A(PG8_SA(0, 1), cA, 1);
    if (wr == 1) PG8_BAR;
    PG8_WAIT_V(2); PG8_BAR;
    PG8_STAGE(PG8_SB(1, 0), cB + kstep, voffB); PG8_STAGE_A(PG8_SA(1, 0), cA + kstepA, 0); PG8_STAGE(PG8_SB(1, 1), cB + hstepB + kstep, voffB);
    PG8_WAIT_V(6); PG8_BAR;
    for (;;) {
        const bool has_next = S.next(ui + 1, nxt);
        const char* nA = has_next ? (const char*)g.A + (GATHER ? (size_t)0 : (size_t)nxt.pm * tstepA + (size_t)nxt.eb * g.astride * 2) : cA;
        const char* nB = has_next ? (const char*)g.Bt + ((size_t)nxt.eb * g.bstride) * 2 + (size_t)nxt.pn * tstepB : cB;
        for (int t = 0; t < nt; t += 2) {
            const bool last = (t == nt - 2);
            const char* a1 = cA + (size_t)(t + 1) * kstepA;
            const char* a2 = last ? nA : cA + (size_t)(t + 2) * kstepA; const char* b2 = last ? nB : cB + (size_t)(t + 2) * kstep;
            const char* a3 = a2 + kstepA; const char* b3 = b2 + kstep;
            unsigned vn1[2] = {vg[1][0], vg[1][1]};
            if constexpr (GATHER) { if (last && has_next) { unsigned vn[2][2]; PG8_GOFFS(nxt, vn); vg[0][0] = vn[0][0]; vg[0][1] = vn[0][1]; vn1[0] = vn[1][0]; vn1[1] = vn[1][1]; } }
            if (last && has_next) S.a_ready(nxt);
            PG8_LDB(B0, 0, 0); PG8_LDB(B1, 0, 1); PG8_SCHED; PG8_LDA(At, 0, 0); PG8_STAGE_A(PG8_SA(1, 1), a1, 1);
            PG8_WAIT_V(8); PG8_WAIT_L(0); PG8_BAR; PG8_MMA(0, 0, At, B0); PG8_MMA(0, 1, At, B1); PG8_BAR; PG8_SCHED;
            if constexpr (GATHER) { vg[1][0] = vn1[0]; vg[1][1] = vn1[1]; }
            PG8_LDA(At, 0, 1); PG8_STAGE(PG8_SB(0, 0), b2, voffB); PG8_STAGE(PG8_SB(0, 1), b2 + hstepB, voffB); PG8_STAGE_A(PG8_SA(0, 0), a2, 0);
            PG8_WAIT_V(8); PG8_WAIT_L(0); PG8_BAR; PG8_MMA(1, 0, At, B0); PG8_MMA(1, 1, At, B1); PG8_BAR; PG8_SCHED;
            PG8_LDB(B0, 1, 0); PG8_LDB(B1, 1, 1); PG8_SCHED; PG8_LDA(At, 1, 0); PG8_STAGE_A(PG8_SA(0, 1), a2, 1);
            PG8_WAIT_V(8); PG8_WAIT_L(0); PG8_BAR; PG8_MMA(0, 0, At, B0); PG8_MMA(0, 1, At, B1); PG8_BAR; PG8_SCHED;
            PG8_LDA(At, 1, 1); PG8_STAGE(PG8_SB(1, 0), b3, voffB); PG8_STAGE(PG8_SB(1, 1), b3 + hstepB, voffB); PG8_STAGE_A(PG8_SA(1, 0), a3, 0);
            PG8_WAIT_V(8); PG8_WAIT_L(0); PG8_BAR; PG8_MMA(1, 0, At, B0); PG8_MMA(1, 1, At, B1); PG8_BAR; PG8_SCHED;
        }
        if (wr == 0) PG8_BAR;
        E(acc, cur, wr, wc, fr, fq); S.done(cur);
        if (!has_next) break;
#pragma unroll
        for (int a = 0; a < 2; ++a)
#pragma unroll
            for (int b = 0; b < 2; ++b)
#pragma unroll
                for (int m = 0; m < 4; ++m)
#pragma unroll
                    for (int n = 0; n < 2; ++n) acc[a][b][m][n] = (f32x4){0.f, 0.f, 0.f, 0.f};
        cur = nxt; cA = nA; cB = nB; ++ui;
        if (wr == 1) PG8_BAR;
    }
    PG8_WAIT_V(0);
    PG8_BAR;
#undef PG8_SA
#undef PG8_SB
#undef PG8_STAGE
#undef PG8_STAGE_A
#undef PG8_GOFFS
#undef PG8_LDA
#undef PG8_LDB
#undef PG8_MMA
#undef PG8_WAIT_V
#undef PG8_WAIT_L
#undef PG8_BAR
#undef PG8_SCHED
}

struct ExpertOrder {
    const PG8_LAS int* tab; int nN, G, c;
    __device__ __forceinline__ bool next(int i, Unit& u) const {
        const int total = tab[32] * nN; const long L = (long)i * G + c; if (L >= total) return false;
        const int rt = (int)L / nN, pn = (int)L % nN; int e = 0;
#pragma unroll
        for (int k = 1; k < 32; ++k) e += (rt >= tab[k]) ? 1 : 0;
        u.pm = __builtin_amdgcn_readfirstlane(rt); u.pn = __builtin_amdgcn_readfirstlane(pn); u.eb = __builtin_amdgcn_readfirstlane(e);
        u.p0 = __builtin_amdgcn_readfirstlane((rt - tab[e]) * BM); u.cnt = __builtin_amdgcn_readfirstlane(tab[33 + e]); return true;
    }
    __device__ __forceinline__ void a_ready(const Unit&) const {}
    __device__ __forceinline__ void done(const Unit&) const {}
};
struct EpiGateUp {
    static constexpr bool PERM = true, AFTER_DRAIN = false;
    bf16_t* H; const float* listw; int cap;
    __device__ __forceinline__ void operator()(const f32x4 (&acc)[2][2][4][2], const Unit& u, int wr, int wc, int fr, int fq) const {
        const int rl0 = wr * 64 + fr, col0 = u.pn * HALF + wc * 32 + 8 * fq;
#pragma unroll
        for (int ai = 0; ai < 2; ++ai)
#pragma unroll
            for (int m = 0; m < 4; ++m) {
                const int rl = rl0 + ai * HALF + m * 16, pos = u.p0 + rl;
                const float w = pos < u.cnt ? listw[(size_t)u.eb * cap + pos] : 0.f;
                bf16_t* rowp = H + (size_t)(u.pm * BM + rl) * 256 + col0;
                const f32x4 g0 = acc[ai][0][m][0], g1 = acc[ai][0][m][1], u0 = acc[ai][1][m][0], u1 = acc[ai][1][m][1];
                u32x4 o;
                o.x = cvt_pk_bf16(g0[0] * sigm(g0[0]) * u0[0] * w, g0[1] * sigm(g0[1]) * u0[1] * w); o.y = cvt_pk_bf16(g0[2] * sigm(g0[2]) * u0[2] * w, g0[3] * sigm(g0[3]) * u0[3] * w);
                o.z = cvt_pk_bf16(g1[0] * sigm(g1[0]) * u1[0] * w, g1[1] * sigm(g1[1]) * u1[1] * w); o.w = cvt_pk_bf16(g1[2] * sigm(g1[2]) * u1[2] * w, g1[3] * sigm(g1[3]) * u1[3] * w);
                *(u32x4*)rowp = o;
            }
    }
};
struct EpiDown {
    static constexpr bool PERM = true, AFTER_DRAIN = false;
    bf16_t* P1; long d12; const unsigned* list; int cap;
    __device__ __forceinline__ void operator()(const f32x4 (&acc)[2][2][4][2], const Unit& u, int wr, int wc, int fr, int fq) const {
        const int rl0 = wr * 64 + fr, col0 = u.pn * BM + wc * 32 + 8 * fq;
#pragma unroll
        for (int ai = 0; ai < 2; ++ai) {
            unsigned ent[4];
#pragma unroll
            for (int m = 0; m < 4; ++m) { const int pos = u.p0 + rl0 + ai * HALF + m * 16; ent[m] = pos < u.cnt ? list[(size_t)u.eb * cap + pos] : 0xffffffffu; }
#pragma unroll
            for (int m = 0; m < 4; ++m) {
                if (ent[m] != 0xffffffffu) {
                    bf16_t* dst = P1 + (long)(ent[m] & 1u) * d12 + (size_t)(ent[m] >> 1) * 1024 + col0;
#pragma unroll
                    for (int bj = 0; bj < 2; ++bj) { const f32x4 v0 = acc[ai][bj][m][0], v1 = acc[ai][bj][m][1];
                        u32x4 w; w.x = cvt_pk_bf16(v0[0], v0[1]); w.y = cvt_pk_bf16(v0[2], v0[3]); w.z = cvt_pk_bf16(v1[0], v1[1]); w.w = cvt_pk_bf16(v1[2], v1[3]);
                        *(u32x4*)(dst + bj * HALF) = w; }
                }
            }
            asm volatile("" ::: "memory");
        }
    }
};

struct BatchOrder {
    int nb, nM, nN, G, c;
    __device__ __forceinline__ bool next(int i, Unit& u) const {
        const long L = (long)i * G + c; if (L >= (long)nb * nM * nN) return false;
        const int per = nM * nN, e = (int)L / per, rem = (int)L % per;
        u.eb = e; u.pm = rem / nN; u.pn = rem % nN; u.p0 = 0; u.cnt = 0; return true;
    }
    __device__ __forceinline__ void a_ready(const Unit&) const {}
    __device__ __forceinline__ void done(const Unit&) const {}
};
struct EpiInProj {
    static constexpr bool PERM = true, AFTER_DRAIN = false;
    bf16_t* Zo; bf16_t* U;
    __device__ __forceinline__ void operator()(const f32x4 (&acc)[2][2][4][2], const Unit& u, int wr, int wc, int fr, int fq) const {
        const int row0 = u.pm * BM + wr * 64 + fr;
#pragma unroll
        for (int ai = 0; ai < 2; ++ai)
#pragma unroll
            for (int m = 0; m < 4; ++m) { const int row = row0 + ai * HALF + m * 16;
#pragma unroll
                for (int bj = 0; bj < 2; ++bj) { const int c0 = u.pn * BM + bj * HALF + wc * 32 + 8 * fq;
                    const f32x4 v0 = acc[ai][bj][m][0], v1 = acc[ai][bj][m][1];
                    u32x4 w; w.x = cvt_pk_bf16(v0[0], v0[1]); w.y = cvt_pk_bf16(v0[2], v0[3]); w.z = cvt_pk_bf16(v1[0], v1[1]); w.w = cvt_pk_bf16(v1[2], v1[3]);
                    bf16_t* dst = u.pn < 2 ? U + ((size_t)((c0 >> 4) * 2048 + (row >> 4)) * 512 + (row & 15) * 16 + (c0 & 15)) : Zo + (size_t)row * 2048 + c0;
                    *(u32x4*)dst = w; } }
    }
};
struct EpiXloc {
    static constexpr bool PERM = false, AFTER_DRAIN = false;
    float* XL;
    __device__ __forceinline__ void operator()(const f32x4 (&acc)[2][2][4][2], const Unit& u, int wr, int wc, int fr, int fq) const {
        const int row0 = u.pm * BM + wr * 64 + fr, col0 = wc * 32 + 4 * fq;
#pragma unroll
        for (int ai = 0; ai < 2; ++ai)
#pragma unroll
            for (int m = 0; m < 4; ++m) { float* rowp = XL + ((size_t)u.eb * 2048 + row0 + ai * HALF + m * 16) * 128 + col0;
#pragma unroll
                for (int n = 0; n < 2; ++n) *(f32x4*)(rowp + n * 16) = acc[ai][0][m][n]; }
    }
};
__device__ __forceinline__ float gelu_t(float x) { const float u2 = -2.302208198f * (x + 0.044715f * x * x * x); return x * __builtin_amdgcn_rcpf(1.0f + __builtin_amdgcn_exp2f(u2)); }
struct EpiSsmOut {
    static constexpr bool PERM = true, AFTER_DRAIN = false;
    bf16_t* G;
    __device__ __forceinline__ void operator()(const f32x4 (&acc)[2][2][4][2], const Unit& u, int wr, int wc, int fr, int fq) const {
        const int row0 = u.pm * BM + wr * 64 + fr;
#pragma unroll
        for (int ai = 0; ai < 2; ++ai)
#pragma unroll
            for (int m = 0; m < 4; ++m) { const int row = row0 + ai * HALF + m * 16;
#pragma unroll
                for (int bj = 0; bj < 2; ++bj) { const int n0 = bj * HALF + wc * 32 + 8 * fq;
                    const f32x4 v0 = acc[ai][bj][m][0], v1 = acc[ai][bj][m][1];
                    u32x4 w; w.x = cvt_pk_bf16(gelu_t(v0[0]), gelu_t(v0[1])); w.y = cvt_pk_bf16(gelu_t(v0[2]), gelu_t(v0[3])); w.z = cvt_pk_bf16(gelu_t(v1[0]), gelu_t(v1[1])); w.w = cvt_pk_bf16(gelu_t(v1[2]), gelu_t(v1[3]));
                    *(u32x4*)(G + ((size_t)row * 16 + (n0 >> 4)) * 512 + u.eb * 16 + (n0 & 15)) = w; } }
    }
};

struct CmpOrder {
    int G, c;
    __device__ __forceinline__ bool next(int i, Unit& u) const { const int L = i * G + c; if (L >= 32) return false; u.eb = L >> 4; u.pm = L & 15; u.pn = 0; u.p0 = 0; u.cnt = 0; return true; }
    __device__ __forceinline__ void a_ready(const Unit&) const {}
    __device__ __forceinline__ void done(const Unit&) const {}
};
struct EpiCmpHid {
    static constexpr bool PERM = false, AFTER_DRAIN = false;
    bf16_t* HC; const float* bias;
    __device__ __forceinline__ void operator()(const f32x4 (&acc)[2][2][4][2], const Unit& u, int wr, int wc, int fr, int fq) const {
        if (wc < 2) {
            const int row0 = u.pm * BM + wr * 64 + fr, col0 = wc * 32 + 4 * fq;
#pragma unroll
            for (int n = 0; n < 2; ++n) { const f32x4 bv = *(const f32x4*)(bias + u.eb * 64 + col0 + n * 16);
#pragma unroll
                for (int ai = 0; ai < 2; ++ai)
#pragma unroll
                    for (int m = 0; m < 4; ++m) { const f32x4 v = acc[ai][0][m][n] + bv;
                        typedef unsigned u32x2_ __attribute__((ext_vector_type(2)));
                        u32x2_ w; w.x = cvt_pk_bf16(gelu_t(v[0]), gelu_t(v[1])); w.y = cvt_pk_bf16(gelu_t(v[2]), gelu_t(v[3]));
                        *(u32x2_*)(HC + ((size_t)u.eb * 4096 + row0 + ai * HALF + m * 16) * 64 + col0 + n * 16) = w; } }
        }
    }
};

struct SingleUnit {
    int eb, pm;
    __device__ __forceinline__ bool next(int i, Unit& u) const { if (i > 0) return false; u.eb = eb; u.pm = pm; u.pn = 0; u.p0 = 0; u.cnt = 0; return true; }
    __device__ __forceinline__ void a_ready(const Unit&) const {}
    __device__ __forceinline__ void done(const Unit&) const {}
};
}

struct Args { const float* in[26]; float* out; unsigned char* ws; int ph_lo, ph_hi; };

struct Frame {
    LAS unsigned char* lds;
    int tid, lane, wave, blk, G;
};

__device__ __forceinline__ f32x4 bf4(u32x2 p) { f32x4 r; r.x = __uint_as_float(p.x << 16); r.y = __uint_as_float(p.x & 0xffff0000u); r.z = __uint_as_float(p.y << 16); r.w = __uint_as_float(p.y & 0xffff0000u); return r; }
__device__ __forceinline__ void ph_norm(const Frame& F, const float* xin, const bf16* add, const bf16* add2, float* xout, const float* g, bf16* hn) {
    const int gw = F.blk * NWAVES + F.wave, NGW = F.G * NWAVES;
    f32x4 gg[4];
#pragma unroll
    for (int j = 0; j < 4; ++j) gg[j] = ((const f32x4*)g)[F.lane + 64 * j];
    f32x4 nv[4]; u32x2 na[4], nb[4];
    if (gw < T) {
#pragma unroll
        for (int j = 0; j < 4; ++j) { nv[j] = ((const f32x4*)(xin + (size_t)gw * DM))[F.lane + 64 * j];
            if (add) { na[j] = ((const u32x2*)(add + (size_t)gw * DM))[F.lane + 64 * j]; nb[j] = ((const u32x2*)(add2 + (size_t)gw * DM))[F.lane + 64 * j]; } }
    }
    for (int row = gw; row < T; row += NGW) {
        f32x4 v[4]; float s = 0.f;
#pragma unroll
        for (int j = 0; j < 4; ++j) { v[j] = nv[j]; if (add) v[j] += bf4(na[j]) + bf4(nb[j]); }
        const int nrow = row + NGW;
        if (nrow < T) {
#pragma unroll
            for (int j = 0; j < 4; ++j) { nv[j] = ((const f32x4*)(xin + (size_t)nrow * DM))[F.lane + 64 * j];
                if (add) { na[j] = ((const u32x2*)(add + (size_t)nrow * DM))[F.lane + 64 * j]; nb[j] = ((const u32x2*)(add2 + (size_t)nrow * DM))[F.lane + 64 * j]; } }
        }
#pragma unroll
        for (int j = 0; j < 4; ++j) { if (add) ((f32x4*)(xout + (size_t)row * DM))[F.lane + 64 * j] = v[j];
            s += v[j].x * v[j].x + v[j].y * v[j].y + v[j].z * v[j].z + v[j].w * v[j].w; }
        s = wave_sum(s, F.lane);
        const float r = rsqrtf(s * (1.0f / DM) + EPS);
#pragma unroll
        for (int j = 0; j < 4; ++j) {
            u32x2 o; o.x = pk2(v[j].x * r * gg[j].x, v[j].y * r * gg[j].y); o.y = pk2(v[j].z * r * gg[j].z, v[j].w * r * gg[j].w);
            *(u32x2*)(hn + (size_t)row * DM + (F.lane + 64 * j) * 4) = o;
        }
    }
}
__device__ __forceinline__ void ph_final_norm(const Frame& F, float* x, const bf16* add, const bf16* add2, const float* g) {
    const int gw = F.blk * NWAVES + F.wave, NGW = F.G * NWAVES;
    f32x4 gg[4];
#pragma unroll
    for (int j = 0; j < 4; ++j) gg[j] = ((const f32x4*)g)[F.lane + 64 * j];
    f32x4 nv[4]; u32x2 na[4], nb[4];
    if (gw < T) {
#pragma unroll
        for (int j = 0; j < 4; ++j) { nv[j] = ((const f32x4*)(x + (size_t)gw * DM))[F.lane + 64 * j]; na[j] = ((const u32x2*)(add + (size_t)gw * DM))[F.lane + 64 * j]; nb[j] = ((const u32x2*)(add2 + (size_t)gw * DM))[F.lane + 64 * j]; }
    }
    for (int row = gw; row < T; row += NGW) {
        f32x4 v[4]; float s = 0.f;
#pragma unroll
        for (int j = 0; j < 4; ++j) { v[j] = nv[j] + bf4(na[j]) + bf4(nb[j]); s += v[j].x * v[j].x + v[j].y * v[j].y + v[j].z * v[j].z + v[j].w * v[j].w; }
        const int nrow = row + NGW;
        if (nrow < T) {
#pragma unroll
            for (int j = 0; j < 4; ++j) { nv[j] = ((const f32x4*)(x + (size_t)nrow * DM))[F.lane + 64 * j]; na[j] = ((const u32x2*)(add + (size_t)nrow * DM))[F.lane + 64 * j]; nb[j] = ((const u32x2*)(add2 + (size_t)nrow * DM))[F.lane + 64 * j]; }
        }
        s = wave_sum(s, F.lane);
        const float r = rsqrtf(s * (1.0f / DM) + EPS);
#pragma unroll
        for (int j = 0; j < 4; ++j) {
            f32x4 o; o.x = v[j].x * r * gg[j].x; o.y = v[j].y * r * gg[j].y; o.z = v[j].z * r * gg[j].z; o.w = v[j].w * r * gg[j].w;
            ((f32x4*)(x + (size_t)row * DM))[F.lane + 64 * j] = o;
        }
    }
}

template <bool DUAL, class Epi>
__device__ __forceinline__ void sgemm_naive(const Frame& F, const bf16* A, int lda, const float* B, int ldb, int M, int N, int K, int dualoff, const Epi& epi) {
    LAS float* As = (LAS float*)F.lds;
    LAS float* Bs = As + 16 * 132;
    LAS float* Bs2 = Bs + 16 * 128;
    const int tiles_n = (N + 127) / 128, tiles_m = M / 128;
    const int tx = F.tid & 31, ty = F.tid >> 5;
    for (int tile = F.blk; tile < tiles_m * tiles_n; tile += F.G) {
        const int tm = tile / tiles_n, tn = tile % tiles_n;
        float acc[8][4], acc2[8][4];
#pragma unroll
        for (int i = 0; i < 8; ++i)
#pragma unroll
            for (int j = 0; j < 4; ++j) { acc[i][j] = 0.f; acc2[i][j] = 0.f; }
        const int arow = F.tid >> 2, akq = (F.tid & 3) * 4;
        const int bk = F.tid >> 5, bn = (F.tid & 31) * 4;
        for (int k0 = 0; k0 < K; k0 += 16) {
            {
                const u32x2 av = *(const u32x2*)(A + (size_t)(tm * 128 + arow) * lda + k0 + akq);
                As[(akq + 0) * 132 + arow] = __uint_as_float(av.x << 16);
                As[(akq + 1) * 132 + arow] = __uint_as_float(av.x & 0xffff0000u);
                As[(akq + 2) * 132 + arow] = __uint_as_float(av.y << 16);
                As[(akq + 3) * 132 + arow] = __uint_as_float(av.y & 0xffff0000u);
                const int col = tn * 128 + bn;
                f32x4 bv = (f32x4){0.f, 0.f, 0.f, 0.f};
                const float* bp = B + (size_t)(k0 + bk) * ldb + col;
                if (col + 3 < N) { bv.x = bp[0]; bv.y = bp[1]; bv.z = bp[2]; bv.w = bp[3]; }
                else { if (col < N) bv.x = bp[0]; if (col + 1 < N) bv.y = bp[1]; if (col + 2 < N) bv.z = bp[2]; }
                *(LAS f32x4*)(Bs + bk * 128 + bn) = bv;
                if (DUAL) {
                    const float* bp2 = bp + dualoff;
                    f32x4 bw; bw.x = bp2[0]; bw.y = bp2[1]; bw.z = bp2[2]; bw.w = bp2[3];
                    *(LAS f32x4*)(Bs2 + bk * 128 + bn) = bw;
                }
            }
            __syncthreads();
#pragma unroll 4
            for (int k = 0; k < 16; ++k) {
                float a[8];
                const f32x4 a0 = *(const LAS f32x4*)(As + k * 132 + ty * 8), a1 = *(const LAS f32x4*)(As + k * 132 + ty * 8 + 4);
                a[0] = a0.x; a[1] = a0.y; a[2] = a0.z; a[3] = a0.w; a[4] = a1.x; a[5] = a1.y; a[6] = a1.z; a[7] = a1.w;
                const f32x4 b = *(const LAS f32x4*)(Bs + k * 128 + tx * 4);
#pragma unroll
                for (int i = 0; i < 8; ++i) { acc[i][0] += a[i] * b.x; acc[i][1] += a[i] * b.y; acc[i][2] += a[i] * b.z; acc[i][3] += a[i] * b.w; }
                if (DUAL) {
                    const f32x4 b2 = *(const LAS f32x4*)(Bs2 + k * 128 + tx * 4);
#pragma unroll
                    for (int i = 0; i < 8; ++i) { acc2[i][0] += a[i] * b2.x; acc2[i][1] += a[i] * b2.y; acc2[i][2] += a[i] * b2.z; acc2[i][3] += a[i] * b2.w; }
                }
            }
            __syncthreads();
        }
#pragma unroll
        for (int i = 0; i < 8; ++i)
#pragma unroll
            for (int j = 0; j < 4; ++j) {
                const int row = tm * 128 + ty * 8 + i, col = tn * 128 + tx * 4 + j;
                if (col < N) epi(row, col, acc[i][j], acc2[i][j]);
            }
    }
}
struct EpiStoreBf16 { bf16* O; int ldo; __device__ __forceinline__ void operator()(int r, int c, float a, float) const { O[(size_t)r * ldo + c] = (bf16)f2bf(a); } };
struct EpiGlu { bf16* O; int ldo; __device__ __forceinline__ void operator()(int r, int c, float a, float b) const { O[(size_t)r * ldo + c] = (bf16)f2bf(a * sigmoidf_(b)); } };
struct EpiResid { const float* X; float* O; __device__ __forceinline__ void operator()(int r, int c, float a, float) const { O[(size_t)r * DM + c] = X[(size_t)r * DM + c] + a; } };

__device__ __forceinline__ void ssm_naive_item(int b, int g, const float* a_re, const float* a_im, const float* b_re, const float* b_im, const float* c_re, const float* c_im,
                                               const float* dpar, const float* log_dt, const bf16* Z, bf16* G1, int lane) {
    const int p = lane;
    const float are = a_re[g * 64 + p], aim = a_im[g * 64 + p], dt = expf(log_dt[g]);
    const float er = expf(are * dt), lbr = er * cosf(aim * dt), lbi = er * sinf(aim * dt);
    const float xx = lbr - 1.0f, yy = lbi, den = are * are + aim * aim;
    const float fr = (xx * are + yy * aim) / den, fi = (yy * are - xx * aim) / den;
    float bbr[16], bbi[16], cr[16], ci[16];
#pragma unroll
    for (int h = 0; h < 16; ++h) {
        const float br = b_re[(g * 64 + p) * 16 + h], bi = b_im[(g * 64 + p) * 16 + h];
        bbr[h] = fr * br - fi * bi; bbi[h] = fr * bi + fi * br;
        cr[h] = c_re[(g * 16 + h) * 64 + p]; ci[h] = c_im[(g * 16 + h) * 64 + p];
    }
    const float dd = dpar[g * 16 + (lane & 15)];
    float xr = 0.f, xi = 0.f;
    for (int t = 0; t < SEQ; ++t) {
        const size_t row = (size_t)b * SEQ + t;
        const u32x4 u0 = *(const u32x4*)(Z + row * ZP + ZC_U + g * 16), u1 = *(const u32x4*)(Z + row * ZP + ZC_U + g * 16 + 8);
        float u[16];
        u[0] = __uint_as_float(u0.x << 16); u[1] = __uint_as_float(u0.x & 0xffff0000u); u[2] = __uint_as_float(u0.y << 16); u[3] = __uint_as_float(u0.y & 0xffff0000u);
        u[4] = __uint_as_float(u0.z << 16); u[5] = __uint_as_float(u0.z & 0xffff0000u); u[6] = __uint_as_float(u0.w << 16); u[7] = __uint_as_float(u0.w & 0xffff0000u);
        u[8] = __uint_as_float(u1.x << 16); u[9] = __uint_as_float(u1.x & 0xffff0000u); u[10] = __uint_as_float(u1.y << 16); u[11] = __uint_as_float(u1.y & 0xffff0000u);
        u[12] = __uint_as_float(u1.z << 16); u[13] = __uint_as_float(u1.z & 0xffff0000u); u[14] = __uint_as_float(u1.w << 16); u[15] = __uint_as_float(u1.w & 0xffff0000u);
        float bur = 0.f, bui = 0.f;
#pragma unroll
        for (int h = 0; h < 16; ++h) { bur += bbr[h] * u[h]; bui += bbi[h] * u[h]; }
        const float nxr = lbr * xr - lbi * xi + bur, nxi = lbr * xi + lbi * xr + bui;
        xr = nxr; xi = nxi;
        float y = 0.f;
#pragma unroll
        for (int h = 0; h < 16; ++h) { const float v = wave_sum(cr[h] * xr - ci[h] * xi, lane); if (lane == h) y = v; }
        if (lane < 16) {
            const float ul = bf2f(Z[row * ZP + ZC_U + g * 16 + lane]);
            G1[row * D_SSM + g * 16 + lane] = (bf16)f2bf(gelu_tanh(y + dd * ul));
        }
    }
}
__device__ __forceinline__ void compress_naive_item(int item, const bf16* Z, const float* pos, const float* w1, const float* w2, bf16* KC, bf16* VC, int lane) {
    const int i = item & 1, hkv = (item >> 1) & 1, n = (item >> 2) % NCMPP, b = (item >> 2) / NCMPP;
    bf16* dst = i ? VC : KC;
    if (n == NCMP) { dst[(((size_t)b * NCMPP + n) * 2 + hkv) * 64 + lane] = 0; return; }
    const float* posi = pos + i * 32 * 64; const float* w1i = w1 + (size_t)i * 32 * 64 * 64; const float* w2i = w2 + i * 64 * 64;
    float acc = 0.f;
    for (int l = 0; l < 32; ++l) {
        const bf16* zr = Z + ((size_t)b * SEQ + 16 * n + l) * ZP + ZC_KV + i * 128 + hkv * 64;
        for (int d = 0; d < 64; ++d) acc += (bf2f(zr[d]) + posi[l * 64 + d]) * w1i[(l * 64 + d) * 64 + lane];
    }
    const float hid = gelu_tanh(acc);
    float o = 0.f;
    for (int e = 0; e < 64; ++e) o += lane_bcast(hid, e) * w2i[e * 64 + lane];
    dst[(((size_t)b * NCMPP + n) * 2 + hkv) * 64 + lane] = (bf16)f2bf(o);
}

__device__ __forceinline__ void attn_chunk(LAS float* wl, const bf16* Z, const float* rel_bias, int b, int hkv, int t, int base, int kcol, int vcol, int lane,
                                           float (&m)[4], float (&l)[4], float (&o)[4]) {
    const int pos = base + lane; const bool valid = (pos >= 0) && (pos <= t);
    const int posc = pos < 0 ? 0 : (pos > SEQ - 1 ? SEQ - 1 : pos);
    const bf16* kr = Z + ((size_t)b * SEQ + posc) * ZP + kcol + hkv * 64;
    float s[4] = {0.f, 0.f, 0.f, 0.f};
#pragma unroll 2
    for (int c = 0; c < 8; ++c) {
        const u32x4 kv = *(const u32x4*)(kr + c * 8);
        float k[8];
        k[0] = __uint_as_float(kv.x << 16); k[1] = __uint_as_float(kv.x & 0xffff0000u); k[2] = __uint_as_float(kv.y << 16); k[3] = __uint_as_float(kv.y & 0xffff0000u);
        k[4] = __uint_as_float(kv.z << 16); k[5] = __uint_as_float(kv.z & 0xffff0000u); k[6] = __uint_as_float(kv.w << 16); k[7] = __uint_as_float(kv.w & 0xffff0000u);
#pragma unroll
        for (int g = 0; g < 4; ++g) {
            const f32x4 q0 = *(const LAS f32x4*)(wl + g * 64 + c * 8), q1 = *(const LAS f32x4*)(wl + g * 64 + c * 8 + 4);
            s[g] += q0.x * k[0] + q0.y * k[1] + q0.z * k[2] + q0.w * k[3] + q1.x * k[4] + q1.y * k[5] + q1.z * k[6] + q1.w * k[7];
        }
    }
    const int bk = t5_bucket(t - pos);
#pragma unroll
    for (int g = 0; g < 4; ++g) {
        const float sv = valid ? s[g] + rel_bias[bk * 8 + hkv * 4 + g] : -1e30f;
        const float mn = fmaxf(m[g], wave_max(sv, lane));
        const float alpha = __expf(m[g] - mn);
        const float p = valid ? __expf(sv - mn) : 0.f;
        l[g] = l[g] * alpha + wave_sum(p, lane);
        o[g] *= alpha; m[g] = mn;
        wl[256 + g * 64 + lane] = p;
    }
#pragma unroll 4
    for (int key = 0; key < 64; ++key) {
        int pk = base + key; pk = pk < 0 ? 0 : (pk > SEQ - 1 ? SEQ - 1 : pk);
        const float v = bf2f(Z[((size_t)b * SEQ + pk) * ZP + vcol + hkv * 64 + lane]);
#pragma unroll
        for (int g = 0; g < 4; ++g) o[g] += wl[256 + g * 64 + key] * v;
    }
}
__device__ __forceinline__ void attn_naive_item(LAS float* wl, int b, int hkv, int t, const bf16* Z, const float* KC, const float* VC, const float* rel_bias, bf16* YC, int lane) {
    const size_t row = (size_t)b * SEQ + t;
#pragma unroll
    for (int g = 0; g < 4; ++g) wl[g * 64 + lane] = bf2f(Z[row * ZP + ZC_Q + hkv * 256 + g * 64 + lane]) * 0.125f;
#pragma unroll 1
    for (int c = 0; c < 4; ++c) {
        const int n = c * 64 + lane; const bool valid = (n < NCMP) && (16 * n + 31 <= t);
        const float* kr = KC + (((size_t)b * NCMPP + (n < NCMP ? n : 0)) * 2 + hkv) * 64;
        float s[4] = {0.f, 0.f, 0.f, 0.f};
#pragma unroll 4
        for (int d4 = 0; d4 < 16; ++d4) {
            const f32x4 k = *(const f32x4*)(kr + d4 * 4);
#pragma unroll
            for (int g = 0; g < 4; ++g) { const f32x4 q = *(const LAS f32x4*)(wl + g * 64 + d4 * 4); s[g] += q.x * k.x + q.y * k.y + q.z * k.z + q.w * k.w; }
        }
        const int bk = t5_bucket(t - (16 * n + 31));
#pragma unroll
        for (int g = 0; g < 4; ++g) wl[256 + g * 256 + n] = valid ? s[g] + rel_bias[bk * 8 + hkv * 4 + g] : -1e30f;
    }
#pragma unroll
    for (int g = 0; g < 4; ++g) {
        float sc[4];
#pragma unroll
        for (int c = 0; c < 4; ++c) sc[c] = wl[256 + g * 256 + c * 64 + lane];
        const float mx = wave_max(fmaxf(fmaxf(sc[0], sc[1]), fmaxf(sc[2], sc[3])), lane);
        float e[4], ls = 0.f;
#pragma unroll
        for (int c = 0; c < 4; ++c) { e[c] = sc[c] > -1e29f ? __expf(sc[c] - mx) : 0.f; ls += e[c]; }
        ls = wave_sum(ls, lane);
        const float inv = ls > 0.f ? 1.0f / ls : 0.f;
#pragma unroll
        for (int c = 0; c < 4; ++c) wl[256 + g * 256 + c * 64 + lane] = e[c] * inv;
    }
    float oc[4] = {0.f, 0.f, 0.f, 0.f};
    const int nmax = t >= 31 ? ((t - 31) / 16 + 1 < NCMP ? (t - 31) / 16 + 1 : NCMP) : 0;
#pragma unroll 4
    for (int n = 0; n < nmax; ++n) {
        const float v = VC[(((size_t)b * NCMPP + n) * 2 + hkv) * 64 + lane];
#pragma unroll
        for (int g = 0; g < 4; ++g) oc[g] += wl[256 + g * 256 + n] * v;
    }
    float imp = 0.f;
#pragma unroll
    for (int g = 0; g < 4; ++g) {
        const LAS float* P = wl + 256 + g * 256;
        imp += P[4 * lane] + P[4 * lane + 1] + P[4 * lane + 2] + 0.5f * P[4 * lane + 3] + (lane > 0 ? 0.5f * P[4 * lane - 1] : 0.f);
    }
    const int blk = t >> 6;
    const bool forced = (lane == 0) || (lane <= blk && lane > blk - 2), future = lane > blk;
    const float v = forced ? 1e9f : (future ? -1e9f : imp);
    int rank = 0;
    for (int jj = 0; jj < 64; ++jj) { const float vj = lane_bcast(v, jj); rank += (vj > v) || (vj == v && jj < lane); }
    unsigned long long mask = __ballot(rank < 16 && !future);
    float m[4], l[4], o[4];
#pragma unroll
    for (int g = 0; g < 4; ++g) { m[g] = -1e30f; l[g] = 0.f; o[g] = 0.f; }
    while (mask) {
        const int j = __builtin_ctzll(mask); mask &= mask - 1;
        attn_chunk(wl, Z, rel_bias, b, hkv, t, 64 * j, ZC_KV + 256, ZC_KV + 384, lane, m, l, o);
    }
    float os[4];
#pragma unroll
    for (int g = 0; g < 4; ++g) { os[g] = l[g] > 0.f ? o[g] / l[g] : 0.f; m[g] = -1e30f; l[g] = 0.f; o[g] = 0.f; }
    for (int c = 0; c < 8; ++c) attn_chunk(wl, Z, rel_bias, b, hkv, t, t - 511 + 64 * c, ZC_KV + 512, ZC_KV + 640, lane, m, l, o);
#pragma unroll
    for (int g = 0; g < 4; ++g) {
        const float ow = l[g] > 0.f ? o[g] / l[g] : 0.f;
        const bf16* gp = Z + row * ZP + ZC_G + hkv * 12 + g * 3;
        const float r = sigmoidf_(bf2f(gp[0])) * oc[g] + sigmoidf_(bf2f(gp[1])) * os[g] + sigmoidf_(bf2f(gp[2])) * ow;
        YC[row * DM + D_SSM + hkv * 256 + g * 64 + lane] = (bf16)f2bf(r);
    }
}

__device__ __forceinline__ void ph_norm_route(const Frame& F, const float* x, const float* g, const float* rgw, const float* rgb, const float* rew, const float* reb, bf16* hn,
                                              unsigned* gcnt, unsigned* list, float* listw) {
    LAS f32x4* RG = (LAS f32x4*)F.lds; LAS f32x4* RE = RG + 1024;
    LAS unsigned* cnt_l = (LAS unsigned*)(F.lds + 147456); LAS unsigned* base_l = cnt_l + 32; LAS unsigned* ent = cnt_l + 64;
    for (int d = F.tid; d < 1024; d += NTHR) { const int ln = d & 63, jc = d >> 6, row = (ln + 64 * (jc >> 2)) * 4 + (jc & 3); RG[d] = ((const f32x4*)rgw)[row]; }
    { f32x4 t[16];
#pragma unroll
      for (int k = 0; k < 16; ++k) { const int d = F.tid + k * NTHR, ln = d & 63, q = d >> 6, half = q & 1, c = (q >> 1) & 3, j = (q >> 3) & 3, gi = q >> 5, row = (ln + 64 * j) * 4 + c;
          t[k] = ((const f32x4*)rew)[((size_t)gi * DM + row) * 2 + half]; }
#pragma unroll
      for (int k = 0; k < 16; ++k) RE[F.tid + k * NTHR] = t[k]; }
    __syncthreads();
    for (int row0 = F.blk * 128; row0 < T; row0 += F.G * 128) {
        if (F.tid < 32) cnt_l[F.tid] = 0u;
        __syncthreads();
        f32x4 nv[4];
#pragma unroll
        for (int j = 0; j < 4; ++j) nv[j] = ((const f32x4*)(x + (size_t)(row0 + F.wave * 16) * DM))[F.lane + 64 * j];
        for (int kk = 0; kk < 16; ++kk) {
            const int row = row0 + F.wave * 16 + kk;
            f32x4 v[4]; float s = 0.f;
#pragma unroll
            for (int j = 0; j < 4; ++j) { v[j] = nv[j]; s += v[j].x * v[j].x + v[j].y * v[j].y + v[j].z * v[j].z + v[j].w * v[j].w; }
            if (kk < 15) {
#pragma unroll
                for (int j = 0; j < 4; ++j) nv[j] = ((const f32x4*)(x + (size_t)(row + 1) * DM))[F.lane + 64 * j]; }
            s = wave_sum(s, F.lane);
            const float r = rsqrtf(s * (1.0f / DM) + EPS);
            float lg[4] = {0.f, 0.f, 0.f, 0.f};
#pragma unroll
            for (int j = 0; j < 4; ++j) {
                const f32x4 gg = ((const f32x4*)g)[F.lane + 64 * j];
                v[j].x = v[j].x * r * gg.x; v[j].y = v[j].y * r * gg.y; v[j].z = v[j].z * r * gg.z; v[j].w = v[j].w * r * gg.w;
                u32x2 o; o.x = pk2(v[j].x, v[j].y); o.y = pk2(v[j].z, v[j].w);
                *(u32x2*)(hn + (size_t)row * DM + (F.lane + 64 * j) * 4) = o;
                const f32x4 w0 = RG[(j * 4 + 0) * 64 + F.lane], w1 = RG[(j * 4 + 1) * 64 + F.lane], w2 = RG[(j * 4 + 2) * 64 + F.lane], w3 = RG[(j * 4 + 3) * 64 + F.lane];
                lg[0] += v[j].x * w0.x + v[j].y * w1.x + v[j].z * w2.x + v[j].w * w3.x;
                lg[1] += v[j].x * w0.y + v[j].y * w1.y + v[j].z * w2.y + v[j].w * w3.y;
                lg[2] += v[j].x * w0.z + v[j].y * w1.z + v[j].z * w2.z + v[j].w * w3.z;
                lg[3] += v[j].x * w0.w + v[j].y * w1.w + v[j].z * w2.w + v[j].w * w3.w;
            }
#pragma unroll
            for (int o = 0; o < 4; ++o) lg[o] = wave_sum(lg[o], F.lane) + rgb[o];
            int gi = 0; float gm = lg[0];
#pragma unroll
            for (int o = 1; o < 4; ++o) if (lg[o] > gm) { gm = lg[o]; gi = o; }
            float gs = 0.f;
#pragma unroll
            for (int o = 0; o < 4; ++o) gs += __expf(lg[o] - gm);
            const float gval = 1.0f / gs;
            const LAS f32x4* we = RE + gi * 2048;
            float le[8] = {0.f, 0.f, 0.f, 0.f, 0.f, 0.f, 0.f, 0.f};
#pragma unroll
            for (int j = 0; j < 4; ++j) {
                const float hv[4] = {v[j].x, v[j].y, v[j].z, v[j].w};
#pragma unroll
                for (int c = 0; c < 4; ++c) {
                    const f32x4 wa = we[((j * 4 + c) * 2 + 0) * 64 + F.lane], wb = we[((j * 4 + c) * 2 + 1) * 64 + F.lane];
                    le[0] += hv[c] * wa.x; le[1] += hv[c] * wa.y; le[2] += hv[c] * wa.z; le[3] += hv[c] * wa.w;
                    le[4] += hv[c] * wb.x; le[5] += hv[c] * wb.y; le[6] += hv[c] * wb.z; le[7] += hv[c] * wb.w;
                }
            }
#pragma unroll
            for (int e = 0; e < 8; ++e) le[e] = wave_sum(le[e], F.lane) + reb[gi * 8 + e];
            int e1 = 0; float m1 = le[0];
#pragma unroll
            for (int e = 1; e < 8; ++e) if (le[e] > m1) { m1 = le[e]; e1 = e; }
            int e2 = -1; float m2 = -3.0e38f;
#pragma unroll
            for (int e = 0; e < 8; ++e) if (e != e1 && le[e] > m2) { m2 = le[e]; e2 = e; }
            const float p2 = __expf(m2 - m1), inv = 1.0f / (1.0f + p2);
            if (F.lane == 0) {
                const unsigned ea = (unsigned)(gi * 8 + e1), eb = (unsigned)(gi * 8 + e2);
                const unsigned pa = __hip_atomic_fetch_add(cnt_l + ea, 1u, __ATOMIC_RELAXED, __HIP_MEMORY_SCOPE_WORKGROUP);
                const unsigned pb = __hip_atomic_fetch_add(cnt_l + eb, 1u, __ATOMIC_RELAXED, __HIP_MEMORY_SCOPE_WORKGROUP);
                LAS unsigned* en = ent + (F.wave * 16 + kk) * 6;
                en[0] = ea; en[1] = eb; en[2] = pa; en[3] = pb; en[4] = __float_as_uint(gval * inv); en[5] = __float_as_uint(gval * p2 * inv);
            }
        }
        __syncthreads();
        if (F.tid < 32) base_l[F.tid] = __hip_atomic_fetch_add(gcnt + F.tid * 64, cnt_l[F.tid], __ATOMIC_RELAXED, __HIP_MEMORY_SCOPE_AGENT);
        __syncthreads();
        if (F.tid < 128) {
            const LAS unsigned* en = ent + F.tid * 6; const unsigned tok = (unsigned)(row0 + F.tid);
            const unsigned ia = en[0] * LCAP + base_l[en[0]] + en[2], ib = en[1] * LCAP + base_l[en[1]] + en[3];
            list[ia] = tok * 2u; listw[ia] = __uint_as_float(en[4]);
            list[ib] = tok * 2u + 1u; listw[ib] = __uint_as_float(en[5]);
        }
        __syncthreads();
    }
}
__device__ __forceinline__ void build_expert_tab(const Frame& F, const unsigned* gcnt, LAS int* tab) {
    if (F.tid < 64) {
        const int c = F.lane < 32 ? (int)__hip_atomic_load(gcnt + F.lane * 64, __ATOMIC_RELAXED, __HIP_MEMORY_SCOPE_AGENT) : 0;
        int tiles = (c + 255) >> 8, incl = tiles;
#pragma unroll
        for (int o = 1; o < 32; o <<= 1) { const int t = __builtin_amdgcn_ds_bpermute((F.lane - o) << 2, incl); if (F.lane >= o) incl += t; }
        if (F.lane < 32) { tab[F.lane + 1] = incl; tab[33 + F.lane] = c; }
        if (F.lane == 0) tab[0] = 0;
    }
    __syncthreads();
}
__device__ __forceinline__ void ph_experts_naive(const Frame& F, const bf16* hn, const unsigned* route, const float* wg, const float* wu, const float* wd, float* x) {
    LAS float* hs = (LAS float*)F.lds;
    LAS float* hd = hs + 1024;
    for (int tok = F.blk; tok < T; tok += F.G) {
        { const unsigned pv = *(const unsigned*)(hn + (size_t)tok * DM + F.tid * 2); hs[F.tid * 2] = __uint_as_float(pv << 16); hs[F.tid * 2 + 1] = __uint_as_float(pv & 0xffff0000u); }
        const u32x4 rt = *(const u32x4*)(route + (size_t)tok * 4);
        __syncthreads();
        {
            const int s = F.tid >> 8, f = F.tid & 255;
            const unsigned e = s ? rt.y : rt.x; const float w = __uint_as_float(s ? rt.w : rt.z);
            const float* pg = wg + (size_t)e * DM * 256 + f; const float* pu = wu + (size_t)e * DM * 256 + f;
            float ga = 0.f, ua = 0.f;
            for (int d = 0; d < DM; ++d) { const float hv = hs[d]; ga += hv * pg[(size_t)d * 256]; ua += hv * pu[(size_t)d * 256]; }
            hd[s * 256 + f] = ga * sigmoidf_(ga) * ua * w;
        }
        __syncthreads();
        for (int dd = F.tid; dd < DM; dd += NTHR) {
            float acc = 0.f;
            const float* p0 = wd + (size_t)rt.x * 256 * DM + dd; const float* p1 = wd + (size_t)rt.y * 256 * DM + dd;
            for (int f = 0; f < 256; ++f) acc += hd[f] * p0[(size_t)f * DM];
            for (int f = 0; f < 256; ++f) acc += hd[256 + f] * p1[(size_t)f * DM];
            x[(size_t)tok * DM + dd] += acc;
        }
        __syncthreads();
    }
}


namespace nsa {
typedef short bf16x8 __attribute__((ext_vector_type(8)));
typedef short s16x4 __attribute__((ext_vector_type(4)));
typedef float f32x16 __attribute__((ext_vector_type(16)));
typedef float f32x2_t __attribute__((ext_vector_type(2)));
typedef __bf16 bf16x2_t __attribute__((ext_vector_type(2)));
constexpr int SLOTB = 8192;
constexpr int L_K = 0, L_V = 3 * SLOTB, L_IMP = 6 * SLOTB, L_BT = L_IMP + 65536, L_WS = L_BT + 4 * 132 * 4, L_RL = L_WS + 8 * 64 * 4, L_SM = L_RL + 4 * 64 * 4, L_END = L_SM + 64 * 8;
static_assert(L_END <= 131072, "nsa LDS map");
constexpr float LOG2E = 1.4426950408889634f;
constexpr float NEG_INF = -__builtin_inff();
#define NSA_SBAR() __builtin_amdgcn_sched_barrier(0)
__device__ __forceinline__ int crow(int r, int hi) { return (r & 3) + 8 * (r >> 2) + 4 * hi; }
__device__ __forceinline__ void glds16(const void* gsrc, unsigned lds_dst) { unsigned keep;
    asm volatile("s_mov_b32 %0, m0\n\ts_mov_b32 m0, %2\n\ts_nop 0\n\tglobal_load_lds_dwordx4 %1, off\n\ts_mov_b32 m0, %0" : "=&s"(keep) : "v"(gsrc), "s"(lds_dst) : "memory"); }
__device__ __forceinline__ unsigned cvtpk(float lo, float hi) { f32x2_t v = {lo, hi}; bf16x2_t b = __builtin_convertvector(v, bf16x2_t); return __builtin_bit_cast(unsigned, b); }
#define NSA_WAIT_BAR(N) asm volatile("s_waitcnt vmcnt(" #N ") lgkmcnt(0)\n\ts_barrier" ::: "memory")
__device__ __forceinline__ void qkt(f32x16& p0, f32x16& p1, const LAS char* kb, const bf16x8 (&qr)[4], const f32x16& cinit) {
#pragma unroll
    for (int d0 = 0; d0 < 4; ++d0) {
        const bf16x8 b0 = *(const LAS bf16x8*)(kb + d0 * 2048);
        const bf16x8 b1 = *(const LAS bf16x8*)(kb + d0 * 2048 + 512);
        if (d0 == 0) { p0 = __builtin_amdgcn_mfma_f32_32x32x16_bf16(b0, qr[0], cinit, 0, 0, 0); p1 = __builtin_amdgcn_mfma_f32_32x32x16_bf16(b1, qr[0], cinit, 0, 0, 0); }
        else { p0 = __builtin_amdgcn_mfma_f32_32x32x16_bf16(b0, qr[d0], p0, 0, 0, 0); p1 = __builtin_amdgcn_mfma_f32_32x32x16_bf16(b1, qr[d0], p1, 0, 0, 0); }
    }
}
__device__ __forceinline__ void pv(f32x16 (&o)[2], int vb, bf16x8 pa0, bf16x8 pa1, bf16x8 pa2, bf16x8 pa3) {
#pragma unroll
    for (int d0 = 0; d0 < 2; ++d0) { s16x4 lo[4], hi[4];
#pragma unroll
        for (int ks = 0; ks < 4; ++ks) {
            asm volatile("ds_read_b64_tr_b16 %0,%1 offset:%c2" : "=&v"(lo[ks]) : "v"(vb), "i"(d0 * 4096 + ks * 1024) : "memory");
            asm volatile("ds_read_b64_tr_b16 %0,%1 offset:%c2" : "=&v"(hi[ks]) : "v"(vb), "i"(d0 * 4096 + ks * 1024 + 512) : "memory"); }
        asm volatile("s_waitcnt lgkmcnt(0)" ::: "memory"); NSA_SBAR();
#define NSA_PK(k) (bf16x8){lo[k][0], lo[k][1], lo[k][2], lo[k][3], hi[k][0], hi[k][1], hi[k][2], hi[k][3]}
        o[d0] = __builtin_amdgcn_mfma_f32_32x32x16_bf16(pa0, NSA_PK(0), o[d0], 0, 0, 0);
        o[d0] = __builtin_amdgcn_mfma_f32_32x32x16_bf16(pa1, NSA_PK(1), o[d0], 0, 0, 0);
        o[d0] = __builtin_amdgcn_mfma_f32_32x32x16_bf16(pa2, NSA_PK(2), o[d0], 0, 0, 0);
        o[d0] = __builtin_amdgcn_mfma_f32_32x32x16_bf16(pa3, NSA_PK(3), o[d0], 0, 0, 0);
#undef NSA_PK
    }
}
typedef short v4i16_t __attribute__((ext_vector_type(4)));
__device__ __forceinline__ s16x4 vtr(const LAS char* p) { return __builtin_bit_cast(s16x4, __builtin_amdgcn_ds_read_tr16_b64_v4i16((LAS v4i16_t*)p)); }
__device__ __forceinline__ void pv2(f32x16 (&o)[2], const LAS char* vp, bf16x8 pa0, bf16x8 pa1, bf16x8 pa2, bf16x8 pa3) {
#pragma unroll
    for (int d0 = 0; d0 < 2; ++d0) {
        s16x4 lo[4], hi[4];
#pragma unroll
        for (int ks = 0; ks < 4; ++ks) { lo[ks] = vtr(vp + d0 * 4096 + ks * 1024); hi[ks] = vtr(vp + d0 * 4096 + ks * 1024 + 512); }
#define NSA_PK(k) (bf16x8){lo[k][0], lo[k][1], lo[k][2], lo[k][3], hi[k][0], hi[k][1], hi[k][2], hi[k][3]}
        o[d0] = __builtin_amdgcn_mfma_f32_32x32x16_bf16(pa0, NSA_PK(0), o[d0], 0, 0, 0);
        o[d0] = __builtin_amdgcn_mfma_f32_32x32x16_bf16(pa1, NSA_PK(1), o[d0], 0, 0, 0);
        o[d0] = __builtin_amdgcn_mfma_f32_32x32x16_bf16(pa2, NSA_PK(2), o[d0], 0, 0, 0);
        o[d0] = __builtin_amdgcn_mfma_f32_32x32x16_bf16(pa3, NSA_PK(3), o[d0], 0, 0, 0);
#undef NSA_PK
    }
}
__device__ __forceinline__ float other_half(float v, int hi) { auto rr = __builtin_amdgcn_permlane32_swap(__float_as_uint(v), __float_as_uint(v), false, false); return __uint_as_float(hi ? rr[0] : rr[1]); }
__device__ __forceinline__ float rowmax(const f32x16& p0, const f32x16& p1, int hi) {
    float a = fmaxf(fmaxf(p0[0], p0[1]), p1[0]), b = fmaxf(fmaxf(p0[2], p0[3]), p1[1]); a = fmaxf(fmaxf(a, p1[2]), p1[3]);
#pragma unroll
    for (int r = 4; r < 16; r += 4) { a = fmaxf(fmaxf(a, p0[r]), p0[r + 1]); b = fmaxf(fmaxf(b, p0[r + 2]), p0[r + 3]); a = fmaxf(fmaxf(a, p1[r]), p1[r + 1]); b = fmaxf(fmaxf(b, p1[r + 2]), p1[r + 3]); }
    const float m = fmaxf(a, b);
    return fmaxf(m, other_half(m, hi));
}
__device__ __forceinline__ void pack_p(const f32x16& p0, const f32x16& p1, bf16x8& a0, bf16x8& a1, bf16x8& a2, bf16x8& a3) {
    u32x4 w0, w1, w2, w3;
    w0 = (u32x4){cvtpk(p0[0], p0[1]), cvtpk(p0[2], p0[3]), cvtpk(p0[4], p0[5]), cvtpk(p0[6], p0[7])};
    w1 = (u32x4){cvtpk(p0[8], p0[9]), cvtpk(p0[10], p0[11]), cvtpk(p0[12], p0[13]), cvtpk(p0[14], p0[15])};
    w2 = (u32x4){cvtpk(p1[0], p1[1]), cvtpk(p1[2], p1[3]), cvtpk(p1[4], p1[5]), cvtpk(p1[6], p1[7])};
    w3 = (u32x4){cvtpk(p1[8], p1[9]), cvtpk(p1[10], p1[11]), cvtpk(p1[12], p1[13]), cvtpk(p1[14], p1[15])};
    a0 = __builtin_bit_cast(bf16x8, w0); a1 = __builtin_bit_cast(bf16x8, w1); a2 = __builtin_bit_cast(bf16x8, w2); a3 = __builtin_bit_cast(bf16x8, w3);
}

struct Ctx {
    LAS char* lds; unsigned lds0; int wid, lane, r32, hi, g, th, qloc;
    const LAS float* bt;
    LAS float* wsf;
    const LAS float* wrow;
    int vb0;
    const LAS char* vp0;
    const LAS char* kb0;
};
__device__ __forceinline__ void dma_k(const Ctx& c, const bf16* kbase, int pitch, int slot) { glds16(kbase + (size_t)c.lane * pitch + c.wid * 8, (unsigned)__builtin_amdgcn_readfirstlane(c.lds0 + L_K + slot * SLOTB + c.wid * 1024)); }
__device__ __forceinline__ void dma_v(const Ctx& c, const bf16* vbase, int pitch, int slot) { glds16(vbase + (size_t)(16 * (c.wid & 3) + (c.lane >> 2)) * pitch + (c.wid >> 2) * 32 + (c.lane & 3) * 8, (unsigned)__builtin_amdgcn_readfirstlane(c.lds0 + L_V + slot * SLOTB + c.wid * 1024)); }

__device__ __forceinline__ void cmp_scores(const Ctx& c, int slot, const bf16x8 (&qr)[4], int t0, int kt, f32x16& p0, f32x16& p1) {
    const int dmin = t0 + 32 * c.th - 16 * (64 * kt + 63) - 31;
    const bool special = dmin < 113;
    f32x16 ci; { const float v = special ? 0.f : c.bt[128];
#pragma unroll
        for (int r = 0; r < 16; ++r) ci[r] = v; }
    qkt(p0, p1, c.kb0 + slot * SLOTB, qr, ci);
    if (special) {
        int hi64 = 64 * c.hi; asm volatile("" : "+v"(hi64));
        const int dqh = t0 + c.qloc - 1024 * kt - 31 - hi64;
#pragma unroll
        for (int r = 0; r < 16; ++r) {
            const int d0 = dqh - 16 * ((r & 3) + 8 * (r >> 2)), d1 = d0 - 512;
            const float b0 = c.bt[d0 < 0 ? 0 : (d0 > 128 ? 128 : d0)], b1 = c.bt[d1 < 0 ? 0 : (d1 > 128 ? 128 : d1)];
            p0[r] = d0 < 0 ? NEG_INF : p0[r] + b0; p1[r] = d1 < 0 ? NEG_INF : p1[r] + b1;
        }
    }
}
template <int MODE>
__device__ __forceinline__ void online_tile(const Ctx& c, int slot, const bf16x8 (&qr)[4], int dq, bool near, bool masked_tile, bool lane_off, float& mhat, float& lsum, f32x16 (&o)[2]) {
    f32x16 ci; { const float v = (near ? 0.f : c.bt[128]) - mhat;
#pragma unroll
        for (int r = 0; r < 16; ++r) ci[r] = v; }
    f32x16 p0, p1;
    qkt(p0, p1, c.kb0 + slot * SLOTB, qr, ci);
    if (near || masked_tile) {
        int hi4 = 4 * c.hi; asm volatile("" : "+v"(hi4));
        const int dqh = dq - hi4;
#pragma unroll
        for (int r = 0; r < 16; ++r) {
            const int d0 = dqh - ((r & 3) + 8 * (r >> 2)), d1 = d0 - 32;
            if (near) { p0[r] += c.bt[d0 < 0 ? 0 : (d0 > 128 ? 128 : d0)]; p1[r] += c.bt[d1 < 0 ? 0 : (d1 > 128 ? 128 : d1)]; }
            if (d0 < 0 || (MODE == 1 && d0 >= 512)) p0[r] = NEG_INF;
            if (d1 < 0 || (MODE == 1 && d1 >= 512)) p1[r] = NEG_INF;
        }
    }
    if (MODE == 0) { if (lane_off) {
#pragma unroll
        for (int r = 0; r < 16; ++r) { p0[r] = NEG_INF; p1[r] = NEG_INF; } } }
    const float rm = rowmax(p0, p1, c.hi);
    if (__any(rm > 8.0f)) {
        const float dl = fmaxf(rm, 0.f); mhat += dl;
#pragma unroll
        for (int r = 0; r < 16; ++r) { p0[r] -= dl; p1[r] -= dl; }
        const float f = __builtin_amdgcn_exp2f(-dl); lsum *= f;
        if (c.hi == 0) c.wsf[c.r32] = f;
        asm volatile("s_waitcnt lgkmcnt(0)" ::: "memory");
#pragma unroll
        for (int r = 0; r < 16; ++r) { const float fr = c.wrow[(r & 3) + 8 * (r >> 2)]; o[0][r] *= fr; o[1][r] *= fr; }
    }
    float sacc = 0.f;
#pragma unroll
    for (int r = 0; r < 16; ++r) { p0[r] = __builtin_amdgcn_exp2f(p0[r]); p1[r] = __builtin_amdgcn_exp2f(p1[r]); sacc += p0[r] + p1[r]; }
    lsum += sacc;
    bf16x8 a0, a1, a2, a3; pack_p(p0, p1, a0, a1, a2, a3);
    pv(o, c.vb0 + slot * SLOTB, a0, a1, a2, a3);
}
struct Pipe { bf16x8 a0, a1, a2, a3; bool have, resc; };
template <int MODE, bool SPECIAL, bool HAVE>
__device__ __forceinline__ void online_step(const Ctx& c, int kslot, int vslot_prev, const bf16x8 (&qr)[4], int dq, bool near, bool lane_off, float& mhat, float& lsum, f32x16 (&o)[2], Pipe& pp) {
    if (pp.resc) {
#pragma unroll
        for (int r = 0; r < 16; ++r) { const float fr = c.wrow[(r & 3) + 8 * (r >> 2)]; o[0][r] *= fr; o[1][r] *= fr; }
    }
    f32x16 ci; { const float v = (MODE == 0 && lane_off) ? NEG_INF : (((SPECIAL && near) ? 0.f : c.bt[128]) - mhat);
#pragma unroll
        for (int r = 0; r < 16; ++r) ci[r] = v; }
    f32x16 p0, p1;
    qkt(p0, p1, c.kb0 + kslot * SLOTB, qr, ci);
    if (HAVE) pv2(o, c.vp0 + vslot_prev * SLOTB, pp.a0, pp.a1, pp.a2, pp.a3);
    if (SPECIAL) {
        int hi4 = 4 * c.hi; asm volatile("" : "+v"(hi4));
        const int dqh = dq - hi4;
#pragma unroll
        for (int r = 0; r < 16; ++r) {
            const int d0 = dqh - ((r & 3) + 8 * (r >> 2)), d1 = d0 - 32;
            if (near) { p0[r] += c.bt[d0 < 0 ? 0 : (d0 > 128 ? 128 : d0)]; p1[r] += c.bt[d1 < 0 ? 0 : (d1 > 128 ? 128 : d1)]; }
            if (d0 < 0 || (MODE == 1 && d0 >= 512)) p0[r] = NEG_INF;
            if (d1 < 0 || (MODE == 1 && d1 >= 512)) p1[r] = NEG_INF;
        }
    }
    const float rm = rowmax(p0, p1, c.hi);
    const bool mv = __any(rm > 8.0f);
    if (mv) {
        const float dl = fmaxf(rm, 0.f); mhat += dl;
#pragma unroll
        for (int r = 0; r < 16; ++r) { p0[r] -= dl; p1[r] -= dl; }
        const float f = __builtin_amdgcn_exp2f(-dl); lsum *= f;
        c.wsf[c.r32] = f;
    }
    pp.resc = mv;
    float sacc = 0.f;
#pragma unroll
    for (int r = 0; r < 16; ++r) { p0[r] = __builtin_amdgcn_exp2f(p0[r]); p1[r] = __builtin_amdgcn_exp2f(p1[r]); sacc += p0[r] + p1[r]; }
    lsum += sacc;
    pack_p(p0, p1, pp.a0, pp.a1, pp.a2, pp.a3); pp.have = true;
}
__device__ __forceinline__ void online_drain(const Ctx& c, int vslot_prev, f32x16 (&o)[2], Pipe& pp) {
    if (pp.resc) {
#pragma unroll
        for (int r = 0; r < 16; ++r) { const float fr = c.wrow[(r & 3) + 8 * (r >> 2)]; o[0][r] *= fr; o[1][r] *= fr; }
    }
    if (pp.have) pv2(o, c.vp0 + vslot_prev * SLOTB, pp.a0, pp.a1, pp.a2, pp.a3);
}
__device__ __forceinline__ void add_scaled(const Ctx& c, f32x16 (&oacc)[2], const f32x16 (&o)[2], float s) {
    if (c.hi == 0) c.wsf[32 + c.r32] = s;
    asm volatile("s_waitcnt lgkmcnt(0)" ::: "memory");
#pragma unroll
    for (int r = 0; r < 16; ++r) { const float f = c.wrow[32 + (r & 3) + 8 * (r >> 2)]; oacc[0][r] += o[0][r] * f; oacc[1][r] += o[1][r] * f; }
    asm volatile("s_waitcnt lgkmcnt(0)" ::: "memory");
}

__device__ __forceinline__ void add_scaled_park(const Ctx& c, LAS float* park, const f32x16 (&o)[2], float s) {
    if (c.hi == 0) c.wsf[32 + c.r32] = s;
    asm volatile("s_waitcnt lgkmcnt(0)" ::: "memory");
#pragma unroll
    for (int r = 0; r < 16; ++r) { const float f = c.wrow[32 + (r & 3) + 8 * (r >> 2)]; park[r * 64] += o[0][r] * f; park[(16 + r) * 64] += o[1][r] * f; }
    asm volatile("s_waitcnt lgkmcnt(0)" ::: "memory");
}
__device__ __forceinline__ void unit(LAS char* lds, int tid, int b, int hkv, int jt, const bf16* Z, const bf16* KCm, const bf16* VCm, const float* rel_bias, bf16* YC, bool fill_table) {
    Ctx c; c.lds = lds; c.lds0 = (unsigned)(uintptr_t)lds; c.wid = __builtin_amdgcn_readfirstlane(tid >> 6); c.lane = tid & 63; c.r32 = c.lane & 31; c.hi = c.lane >> 5;
    c.g = c.wid & 3; c.th = c.wid >> 2; c.qloc = 32 * c.th + c.r32;
    c.bt = (const LAS float*)(lds + L_BT) + c.g * 132; c.wsf = (LAS float*)(lds + L_WS) + c.wid * 64; c.wrow = c.wsf + 4 * c.hi;
    c.vb0 = (int)(c.lds0 + L_V) + ((c.lane >> 4) & 1) * 32 + (c.lane & 3) * 8 + (4 * c.hi + ((c.lane & 15) >> 2)) * 64;
    c.kb0 = (const LAS char*)(lds + L_K) + c.hi * 1024 + c.r32 * 16;
    c.vp0 = (const LAS char*)(lds + L_V) + ((c.lane >> 4) & 1) * 32 + (c.lane & 3) * 8 + (4 * c.hi + ((c.lane & 15) >> 2)) * 64;
    const int t0 = 64 * jt;
    const bf16* Zb = Z + (size_t)b * SEQ * ZP;
    const size_t qrow = (size_t)b * SEQ + t0 + c.qloc;
    if (fill_table) for (int i = tid; i < 4 * 129; i += NTHR) { const int gg = i / 129, d = i % 129; ((LAS float*)(lds + L_BT))[gg * 132 + d] = rel_bias[t5_bucket(d) * 8 + hkv * 4 + gg] * LOG2E; }
    bf16x8 qr[4];
#pragma unroll
    for (int d0 = 0; d0 < 4; ++d0) qr[d0] = *(const bf16x8*)(Z + qrow * ZP + ZC_Q + hkv * 256 + c.g * 64 + d0 * 16 + c.hi * 8);
    const bf16* gp = Z + qrow * ZP + ZC_G + hkv * 12 + c.g * 3;
    const float gate0 = sigmoidf_(bf2f(gp[0])), gate1 = sigmoidf_(bf2f(gp[1])), gate2 = sigmoidf_(bf2f(gp[2]));
    f32x16 oacc[2];
#pragma unroll
    for (int r = 0; r < 16; ++r) { oacc[0][r] = 0.f; oacc[1][r] = 0.f; }

    const int nct = (4 * jt + 2) / 64 + 1;
    const bf16* kcb = KCm + (size_t)b * NCMPP * 128 + hkv * 64; const bf16* vcb = VCm + (size_t)b * NCMPP * 128 + hkv * 64;
    const bf16* skb = Zb + ZC_KV + 256 + hkv * 64; const bf16* svb = Zb + ZC_KV + 384 + hkv * 64;
    {
        float mhat = 0.f, lsum = 0.f, carry = 0.f; f32x16 o[2];
#pragma unroll
        for (int r = 0; r < 16; ++r) { o[0][r] = 0.f; o[1][r] = 0.f; }
        LAS float* impw = (LAS float*)(lds + L_IMP) + (c.g * 64 + c.qloc) * 64;
        dma_k(c, kcb, 128, 0); dma_v(c, vcb, 128, 0); if (nct > 1) { dma_k(c, kcb + 64 * 128, 128, 1); dma_v(c, vcb + 64 * 128, 128, 1); }
        for (int i = 0; i < nct; ++i) {
            if (i + 1 < nct) NSA_WAIT_BAR(2); else NSA_WAIT_BAR(0);
            if (i + 2 < nct) { dma_k(c, kcb + (size_t)(i + 2) * 64 * 128, 128, (i + 2) % 3); dma_v(c, vcb + (size_t)(i + 2) * 64 * 128, 128, (i + 2) % 3); }
            f32x16 p0, p1; cmp_scores(c, i % 3, qr, t0, i, p0, p1);
            const float rm = rowmax(p0, p1, c.hi) - mhat;
            if (__any(rm > 8.0f)) {
                const float dl = fmaxf(rm, 0.f); mhat += dl;
                const float f = __builtin_amdgcn_exp2f(-dl); lsum *= f; carry *= f;
                c.wsf[c.r32] = f;
                asm volatile("s_waitcnt lgkmcnt(0)" ::: "memory");
#pragma unroll
                for (int r = 0; r < 16; ++r) { const float fr = c.wrow[(r & 3) + 8 * (r >> 2)]; o[0][r] *= fr; o[1][r] *= fr; }
                for (int e = c.hi; e < 16 * i; e += 2) impw[e] *= f;
            }
            float sacc = 0.f;
#pragma unroll
            for (int r = 0; r < 16; ++r) { p0[r] = __builtin_amdgcn_exp2f(p0[r] - mhat); p1[r] = __builtin_amdgcn_exp2f(p1[r] - mhat); sacc += p0[r] + p1[r]; }
            lsum += sacc;
            float o3[8];
#pragma unroll
            for (int k = 0; k < 4; ++k) { o3[k] = other_half(p0[4 * k + 3], c.hi); o3[4 + k] = other_half(p1[4 * k + 3], c.hi); }
#pragma unroll
            for (int idx = 0; idx < 8; ++idx) {
                const int X = idx >> 2, k = idx & 3;
                const f32x16& p = X ? p1 : p0;
                const float cin = c.hi ? o3[idx] : (idx ? o3[idx - 1] : carry);
                impw[16 * i + 8 * X + 2 * k + c.hi] = p[4 * k] + p[4 * k + 1] + p[4 * k + 2] + 0.5f * p[4 * k + 3] + 0.5f * cin;
            }
            carry = o3[7];
            bf16x8 a0, a1, a2, a3; pack_p(p0, p1, a0, a1, a2, a3);
            pv(o, c.vb0 + (i % 3) * SLOTB, a0, a1, a2, a3);
        }
        const float lt = lsum + other_half(lsum, c.hi);
        const float rl = lt > 0.f ? 1.0f / lt : 0.f;
        if (c.hi == 0) ((LAS float*)(lds + L_RL))[c.g * 64 + c.qloc] = rl;
        add_scaled(c, oacc, o, rl * gate0);
        NSA_WAIT_BAR(0);
    }
    { const int nt = jt + 1; dma_k(c, skb, ZP, 0); if (nt > 1) dma_k(c, skb + (size_t)64 * ZP, ZP, 1); dma_v(c, svb, ZP, 0); }
    for (int k = 0; k < 8; ++k) {
        const int tok = c.wid * 8 + k;
        float v = 0.f;
#pragma unroll
        for (int gg = 0; gg < 4; ++gg) v += ((const LAS float*)(lds + L_IMP))[(gg * 64 + tok) * 64 + c.lane] * ((const LAS float*)(lds + L_RL))[gg * 64 + tok];
        const bool forced = (c.lane == 0) || (c.lane <= jt && c.lane > jt - 2), future = c.lane > jt;
        v = forced ? 1e9f : (future ? -1e9f : v);
        int rank = 0;
#pragma unroll
        for (int jj = 0; jj < 64; ++jj) { const float vj = __builtin_bit_cast(float, __builtin_amdgcn_readlane(__builtin_bit_cast(int, v), jj)); rank += ((vj > v) || (vj == v && jj < c.lane)) ? 1 : 0; }
        const unsigned long long msk = __ballot(rank < 16 && !future);
        if (c.lane == 0) ((LAS unsigned long long*)(lds + L_SM))[tok] = msk;
    }
    asm volatile("s_waitcnt lgkmcnt(0)\n\ts_barrier" ::: "memory");
    const unsigned long long mymask = ((const LAS unsigned long long*)(lds + L_SM))[c.qloc];
    LAS float* park = (LAS float*)(lds + L_IMP) + c.wid * 2048 + c.lane;
#pragma unroll
    for (int r = 0; r < 16; ++r) { park[r * 64] = oacc[0][r]; park[(16 + r) * 64] = oacc[1][r]; }
    {
        const bf16* kb = skb; const bf16* vb = svb;
        const int nt = jt + 1;
        float mhat = 0.f, lsum = 0.f; f32x16 o[2]; Pipe pp; pp.have = false; pp.resc = false;
#pragma unroll
        for (int r = 0; r < 16; ++r) { o[0][r] = 0.f; o[1][r] = 0.f; }
#define NSA_ITER_HEAD(i) do { if ((i) + 1 < nt) NSA_WAIT_BAR(2); else NSA_WAIT_BAR(1); \
            if ((i) + 2 < nt) dma_k(c, kb + (size_t)((i) + 2) * 64 * ZP, ZP, ((i) + 2) % 3); \
            if ((i) + 1 < nt) dma_v(c, vb + (size_t)((i) + 1) * 64 * ZP, ZP, ((i) + 1) % 3); } while (0)
        {
            NSA_ITER_HEAD(0);
            online_step<0, true, false>(c, 0, 2, qr, 64 * jt + c.qloc, 0 >= jt - 2, !(mymask & 1ull), mhat, lsum, o, pp); }
        const int nfar = jt - 2;
        int i = 1;
        for (; i < nfar; ++i) { NSA_ITER_HEAD(i);
            online_step<0, false, true>(c, i % 3, (i + 2) % 3, qr, 0, false, !((mymask >> i) & 1ull), mhat, lsum, o, pp); }
        for (; i < nt; ++i) { NSA_ITER_HEAD(i);
            online_step<0, true, true>(c, i % 3, (i + 2) % 3, qr, 64 * (jt - i) + c.qloc, i >= jt - 2, !((mymask >> i) & 1ull), mhat, lsum, o, pp); }
        NSA_WAIT_BAR(0);
        online_drain(c, (nt - 1) % 3, o, pp);
        const float lt = lsum + other_half(lsum, c.hi);
        add_scaled_park(c, park, o, (lt > 0.f ? 1.0f / lt : 0.f) * gate1);
        NSA_WAIT_BAR(0);
    }
    {
        const int j0 = jt > 8 ? jt - 8 : 0, nt = jt - j0 + 1;
        const bf16* kb = Zb + (size_t)j0 * 64 * ZP + ZC_KV + 512 + hkv * 64; const bf16* vb = Zb + (size_t)j0 * 64 * ZP + ZC_KV + 640 + hkv * 64;
        float mhat = 0.f, lsum = 0.f; f32x16 o[2]; Pipe pp; pp.have = false; pp.resc = false;
#pragma unroll
        for (int r = 0; r < 16; ++r) { o[0][r] = 0.f; o[1][r] = 0.f; }
        dma_k(c, kb, ZP, 0); if (nt > 1) dma_k(c, kb + (size_t)64 * ZP, ZP, 1); dma_v(c, vb, ZP, 0);
        {
            NSA_ITER_HEAD(0);
            online_step<1, true, false>(c, 0, 2, qr, 64 * (jt - j0) + c.qloc, j0 >= jt - 2, false, mhat, lsum, o, pp); }
        int i = 1;
        for (; j0 + i < jt - 2; ++i) { NSA_ITER_HEAD(i);
            online_step<1, false, true>(c, i % 3, (i + 2) % 3, qr, 0, false, false, mhat, lsum, o, pp); }
        for (; i < nt; ++i) { NSA_ITER_HEAD(i); const int j = j0 + i;
            online_step<1, true, true>(c, i % 3, (i + 2) % 3, qr, 64 * (jt - j) + c.qloc, j >= jt - 2, false, mhat, lsum, o, pp); }
#undef NSA_ITER_HEAD
        NSA_WAIT_BAR(0);
        online_drain(c, (nt - 1) % 3, o, pp);
        const float lt = lsum + other_half(lsum, c.hi);
        add_scaled_park(c, park, o, (lt > 0.f ? 1.0f / lt : 0.f) * gate2);
    }
    {
        bf16* yb = YC + ((size_t)b * SEQ + t0 + 32 * c.th + 4 * c.hi) * DM + D_SSM + hkv * 256 + c.g * 64 + c.r32;
#pragma unroll
        for (int r = 0; r < 16; ++r) { bf16* yr = yb + (size_t)((r & 3) + 8 * (r >> 2)) * DM; yr[0] = (bf16)f2bf(park[r * 64]); yr[32] = (bf16)f2bf(park[(16 + r) * 64]); }
    }
    asm volatile("s_waitcnt vmcnt(0)" ::: "memory");
    NSA_WAIT_BAR(0);
}
#undef NSA_SBAR
#undef NSA_WAIT_BAR
}


__device__ __forceinline__ void ssm_precompute(const Frame& F, const __attribute__((address_space(4))) Args* args, unsigned char* ws, int item) {
    const int layer = item >> 5, g = item & 31, lg = layer * 32 + g;
    LAS float* L = (LAS float*)F.lds;
    LAS float* lkr = L; LAS float* lki = L + 17 * 64; LAS float* bbr = L + 2 * 17 * 64; LAS float* bbi = bbr + 1024; LAS float* ccr = bbi + 1024; LAS float* cci = ccr + 1024;
    LAS float* wk = cci + 1024; LAS float* dd = wk + 4096;
    const float* a_re = args->in[6] + lg * 64; const float* a_im = args->in[7] + lg * 64;
    const float dt = expf(args->in[13][lg]);
    for (int i = F.tid; i < 17 * 64; i += NTHR) { const int k = i >> 6, p = i & 63; const float er = expf(a_re[p] * dt * (float)k), ang = a_im[p] * dt * (float)k; lkr[i] = er * cosf(ang); lki[i] = er * sinf(ang); }
    for (int i = F.tid; i < 1024; i += NTHR) {
        { const int p = i >> 4, h = i & 15; const float are = a_re[p], aim = a_im[p];
          const float er = expf(are * dt), lbr = er * cosf(aim * dt), lbi = er * sinf(aim * dt);
          const float xx = lbr - 1.0f, yy = lbi, den = are * are + aim * aim, fr = (xx * are + yy * aim) / den, fi = (yy * are - xx * aim) / den;
          const float br = args->in[8][((size_t)lg * 64 + p) * 16 + h], bi = args->in[9][((size_t)lg * 64 + p) * 16 + h];
          bbr[i] = fr * br - fi * bi; bbi[i] = fr * bi + fi * br; }
        ccr[i] = args->in[10][(size_t)lg * 1024 + i]; cci[i] = args->in[11][(size_t)lg * 1024 + i];
    }
    if (F.tid < 16) dd[F.tid] = args->in[12][lg * 16 + F.tid];
    __syncthreads();
    for (int i = F.tid; i < 4096; i += NTHR) { const int k = i >> 8, ho = (i >> 4) & 15, hi = i & 15; float acc = 0.f;
        for (int p = 0; p < 64; ++p) { const float cr = ccr[ho * 64 + p], ci = cci[ho * 64 + p], lr = lkr[k * 64 + p], li = lki[k * 64 + p];
            const float tr = cr * lr - ci * li, ti = cr * li + ci * lr; acc += tr * bbr[p * 16 + hi] - ti * bbi[p * 16 + hi]; }
        wk[i] = acc + ((k == 0 && ho == hi) ? dd[ho] : 0.f); }
    __syncthreads();
    bf16* B2 = (bf16*)(ws + WS_BT2) + (size_t)lg * 256 * 384;
    for (int i = F.tid; i < 256 * 384; i += NTHR) { const int n = i / 384, kk = i % 384, t = n >> 4, ho = n & 15; float v;
        if (kk < 256) { const int sidx = kk >> 4, hi = kk & 15; v = sidx <= t ? wk[((t - sidx) << 8) + ho * 16 + hi] : 0.f; }
        else { const int j = kk - 256, p = j & 63; const float cr = ccr[ho * 64 + p], ci = cci[ho * 64 + p], lr = lkr[(t + 1) * 64 + p], li = lki[(t + 1) * 64 + p];
            v = j < 64 ? (cr * lr - ci * li) : -(cr * li + ci * lr); }
        B2[i] = (bf16)f2bf(v); }
    bf16* B1 = (bf16*)(ws + WS_BT1) + (size_t)lg * 256 * 256;
    for (int i = F.tid; i < 65536; i += NTHR) { const int j = i >> 8, kk = i & 255, sidx = kk >> 4, hi = kk & 15; float v = 0.f;
        if (j < 128) { const int p = j & 63; const float lr = lkr[(15 - sidx) * 64 + p], li = lki[(15 - sidx) * 64 + p], br = bbr[p * 16 + hi], bi = bbi[p * 16 + hi];
            v = j < 64 ? (lr * br - li * bi) : (lr * bi + li * br); }
        B1[i] = (bf16)f2bf(v); }
    __syncthreads();
}
__device__ __forceinline__ void ssm_carry_item(int b, int g, const float* a_re, const float* a_im, const float* log_dt, const float* XL, bf16* U, int lane) {
    const float dt16 = 16.0f * expf(log_dt[g]);
    const float er = expf(a_re[g * 64 + lane] * dt16), ang = a_im[g * 64 + lane] * dt16, lr = er * cosf(ang), li = er * sinf(ang);
    float xr = 0.f, xi = 0.f;
    const float* __restrict__ xl = XL + ((size_t)g * 2048 + b * 256) * 128 + lane;
    bf16* __restrict__ up = U + ((size_t)g * 2048 + b * 256) * 512 + 256 + lane;
    float ar[16], ai[16], nr_[16], ni_[16];
#pragma unroll
    for (int k = 0; k < 16; ++k) { ar[k] = xl[(size_t)k * 128]; ai[k] = xl[(size_t)k * 128 + 64]; }
    for (int cb = 0; cb < 16; ++cb) {
        const int cn = cb < 15 ? (cb + 1) * 16 : cb * 16;
#pragma unroll
        for (int k = 0; k < 16; ++k) { nr_[k] = xl[(size_t)(cn + k) * 128]; ni_[k] = xl[(size_t)(cn + k) * 128 + 64]; }
#pragma unroll
        for (int k = 0; k < 16; ++k) {
            const int c = cb * 16 + k;
            up[(size_t)c * 512] = (bf16)f2bf(xr); up[(size_t)c * 512 + 64] = (bf16)f2bf(xi);
            const float nr = lr * xr - li * xi + ar[k], ni = lr * xi + li * xr + ai[k];
            xr = nr; xi = ni;
        }
#pragma unroll
        for (int k = 0; k < 16; ++k) { ar[k] = nr_[k]; ai[k] = ni_[k]; }
    }
}


__device__ __forceinline__ void compress_stage2(const Frame& F, int eb, int pm, const bf16* HC, const bf16* W2T, bf16* KCo, bf16* VCo) {
    typedef short bf16x8_ __attribute__((ext_vector_type(8))); typedef float f32x16_ __attribute__((ext_vector_type(16)));
    const int r32 = F.lane & 31, hi = F.lane >> 5, rg0 = pm * 256 + F.wave * 32;
    const bf16* ar = HC + ((size_t)eb * 4096 + rg0 + r32) * 64 + 8 * hi; const bf16* br = W2T + (size_t)eb * 4096 + (size_t)r32 * 64 + 8 * hi;
    bf16x8_ a[4], b0[4], b1[4];
#pragma unroll
    for (int ks = 0; ks < 4; ++ks) { a[ks] = *(const bf16x8_*)(ar + ks * 16); b0[ks] = *(const bf16x8_*)(br + ks * 16); b1[ks] = *(const bf16x8_*)(br + 32 * 64 + ks * 16); }
    f32x16_ d0, d1;
#pragma unroll
    for (int r = 0; r < 16; ++r) { d0[r] = 0.f; d1[r] = 0.f; }
#pragma unroll
    for (int ks = 0; ks < 4; ++ks) { d0 = __builtin_amdgcn_mfma_f32_32x32x16_bf16(a[ks], b0[ks], d0, 0, 0, 0); d1 = __builtin_amdgcn_mfma_f32_32x32x16_bf16(a[ks], b1[ks], d1, 0, 0, 0); }
    bf16* dstb = (eb ? VCo : KCo) + (size_t)(rg0 + 4 * hi) * 64 + r32;
#pragma unroll
    for (int r = 0; r < 16; ++r) { const int ro = (r & 3) + 8 * (r >> 2); const bool pad = (((rg0 + 4 * hi + ro) >> 1) & 255) == NCMP;
        dstb[(size_t)ro * 64] = pad ? (bf16)0 : (bf16)f2bf(d0[r]); dstb[(size_t)ro * 64 + 32] = pad ? (bf16)0 : (bf16)f2bf(d1[r]); }
}

__device__ __forceinline__ void transpose_item(const float* W, int K, int N, bf16* WT, int k0, int n0, int drow0, LAS float* scr, int lane, float scale = 1.0f) {
    { float t[32];
#pragma unroll
      for (int i = 0; i < 32; ++i) t[i] = W[(size_t)(k0 + 2 * i + (lane >> 5)) * N + n0 + (lane & 31)];
#pragma unroll
      for (int i = 0; i < 32; ++i) scr[(2 * i + (lane >> 5)) * 33 + (lane & 31)] = t[i]; }
    asm volatile("s_waitcnt lgkmcnt(0)" ::: "memory");
    const int c = lane & 7;
#pragma unroll
    for (int j = 0; j < 4; ++j) { const int n = (lane >> 3) + 8 * j; const LAS float* sp = scr + (8 * c) * 33 + n;
        u32x4 o; o.x = pk2(sp[0 * 33] * scale, sp[1 * 33] * scale); o.y = pk2(sp[2 * 33] * scale, sp[3 * 33] * scale); o.z = pk2(sp[4 * 33] * scale, sp[5 * 33] * scale); o.w = pk2(sp[6 * 33] * scale, sp[7 * 33] * scale);
        *(u32x4*)(WT + (size_t)(drow0 + n) * K + k0 + 8 * c) = o; }
    asm volatile("s_waitcnt lgkmcnt(0)" ::: "memory");
}
__device__ __forceinline__ void ph_convert(const Frame& F, const __attribute__((address_space(4))) Args* args, unsigned char* ws) {
    for (int it = F.blk; it < DEPTH * NGRP; it += F.G) ssm_precompute(F, args, ws, it);
    LAS float* scr = (LAS float*)(F.lds + F.wave * 16384);
    const int gw = F.blk * NWAVES + F.wave, NGW = F.G * NWAVES;
    constexpr int I_IN = (DM / 64) * (1792 / 32), I_GLU = (D_SSM / 64) * (2 * D_SSM / 32), I_OUT = (DM / 64) * (DM / 32);
    constexpr int PER_LAYER = I_IN + I_GLU + I_OUT;
    for (int it = gw; it < DEPTH * 32 * 384; it += NGW) {
        const int le = it / 384, r = it % 384;
        if (r < 256) { const int isup = r >> 7, q = r & 127, nb = q & 7, kb = q >> 3, n0 = 32 * nb;
            transpose_item(args->in[isup ? 24 : 23] + (size_t)le * DM * 256, DM, 256, (bf16*)(ws + WS_WGU) + (size_t)le * 512 * DM, 64 * kb, n0, 256 * (n0 >> 7) + 128 * isup + (n0 & 127), scr, F.lane); }
        else { const int q = r - 256, nb = q & 31, kb = q >> 5;
            transpose_item(args->in[25] + (size_t)le * 256 * DM, 256, DM, (bf16*)(ws + WS_WDN) + (size_t)le * DM * 256, 64 * kb, 32 * nb, 32 * nb, scr, F.lane); }
    }
    for (int it = gw; it < DEPTH * 2 * 64; it += NGW) { const int li = it >> 6, q = it & 63, nb = q & 1, kb = q >> 1;
        transpose_item(args->in[16] + (size_t)li * 2048 * 64, 2048, 64, (bf16*)(ws + WS_W1T) + (size_t)li * 256 * 2048, 64 * kb, 32 * nb, 32 * nb, scr, F.lane); }
    { const int gt = F.blk * NTHR + F.tid, NGT = F.G * NTHR;
      for (int idx = gt; idx < DEPTH * 2 * 192 * 2048 / 8; idx += NGT) { const int li = idx / (192 * 256), rem = idx % (192 * 256);
          *(u32x4*)((bf16*)(ws + WS_W1T) + (size_t)li * 256 * 2048 + (size_t)64 * 2048 + (size_t)rem * 8) = (u32x4){0u, 0u, 0u, 0u}; }
      for (int idx = gt; idx < DEPTH * 2 * 4096; idx += NGT) { const int li = idx >> 12, f = (idx >> 6) & 63, e = idx & 63; ((bf16*)(ws + WS_W2T))[idx] = (bf16)f2bf(args->in[17][(size_t)li * 4096 + e * 64 + f]); }
    }
    for (int idx = gw; idx < DEPTH * 2 * 64; idx += NGW) { const int li = idx >> 6, e = idx & 63; const float* pp = args->in[15] + (size_t)li * 2048; const float* ww = args->in[16] + (size_t)li * 2048 * 64 + e;
        float a = 0.f;
#pragma unroll 8
        for (int k = F.lane; k < 2048; k += 64) a += pp[k] * ww[(size_t)k * 64];
        a = wave_sum(a, F.lane);
        if (F.lane == 0) ((float*)(ws + WS_CBIAS))[idx] = a; }
    for (int it = gw; it < DEPTH * PER_LAYER; it += NGW) {
        const int layer = it / PER_LAYER; int r = it % PER_LAYER;
        if (r < I_IN) { const int nb = r % 56, kb = r / 56;
            transpose_item(args->in[4] + (size_t)layer * DM * D_IN, DM, D_IN, (bf16*)(ws + WS_WIN) + (size_t)layer * ZP * DM, 64 * kb, 32 * nb, 32 * nb, scr, F.lane, (nb >= 16 && nb < 32) ? QSCALE : 1.0f); continue; }
        r -= I_IN;
        if (r < I_GLU) { const int nb = r % 32, kb = r / 32, n0 = 32 * nb;
            const int half = n0 >> 9, c = n0 & 511, drow = 256 * (c >> 7) + 128 * half + (c & 127);
            transpose_item(args->in[14] + (size_t)layer * D_SSM * 2 * D_SSM, D_SSM, 2 * D_SSM, (bf16*)(ws + WS_WGLU) + (size_t)layer * 2 * D_SSM * D_SSM, 64 * kb, n0, drow, scr, F.lane); continue; }
        r -= I_GLU;
        { const int nb = r % 32, kb = r / 32;
            transpose_item(args->in[5] + (size_t)layer * DM * DM, DM, DM, (bf16*)(ws + WS_WOUT) + (size_t)layer * DM * DM, 64 * kb, 32 * nb, 32 * nb, scr, F.lane); }
    }
    const int gt = F.blk * NTHR + F.tid, NGT = F.G * NTHR;
    for (int idx = gt; idx < DEPTH * 256 * DM; idx += NGT) {
        const int layer = idx / (256 * DM), rem = idx % (256 * DM), n = 1792 + rem / DM, k = rem % DM;
        const float v = n < D_IN ? args->in[4][(size_t)layer * DM * D_IN + (size_t)k * D_IN + n] : 0.f;
        ((bf16*)(ws + WS_WIN))[(size_t)layer * ZP * DM + (size_t)n * DM + k] = (bf16)f2bf(v);
    }
}

constexpr int PH_PER_LAYER = 8, N_PHASES = 1 + DEPTH * PH_PER_LAYER + 1;
#ifndef FAST_GEMM
#define FAST_GEMM 1
#endif
#ifndef REP_ATTN
#define REP_ATTN 1
#endif
#ifndef REP_CMP
#define REP_CMP 1
#endif
#ifndef REP_CARRY
#define REP_CARRY 1
#endif
#ifndef REP_CONV
#define REP_CONV 1
#endif
#ifndef REP_INPROJ
#define REP_INPROJ 1
#endif
#ifndef REP_G1
#define REP_G1 1
#endif
#ifndef REP_G2
#define REP_G2 1
#endif
#ifndef REP_GLU
#define REP_GLU 1
#endif
#ifndef REP_OUT
#define REP_OUT 1
#endif
#ifndef REP_NORM
#define REP_NORM 1
#endif
#ifndef REP_ROUTE
#define REP_ROUTE 1
#endif
#ifndef REP_GU
#define REP_GU 1
#endif
#ifndef REP_DN
#define REP_DN 1
#endif

__global__ void __launch_bounds__(NTHR, 2) fwd(Args args) {
    extern __shared__ __attribute__((aligned(16))) unsigned char lds_raw[];
    Frame F;
    F.lds = (LAS unsigned char*)lds_raw;
    F.tid = threadIdx.x; F.lane = F.tid & 63; F.wave = __builtin_amdgcn_readfirstlane(F.tid >> 6);
    F.blk = blockIdx.x; F.G = gridDim.x;
    typedef const __attribute__((address_space(4))) Args* KArgs;
    KArgs kp = (KArgs)__builtin_amdgcn_kernarg_segment_ptr();
    asm volatile("" : "+s"(kp));
    unsigned char* ws = kp->ws;
    volatile LAS unsigned* MISC = (volatile LAS unsigned*)(F.lds + MISC_OFF);
    if (F.tid < 32) MISC[F.tid] = 0u;
    __syncthreads();
    XcdBarrier bar; bar.bar = (unsigned*)(ws + WS_CTL) + CW_BAR; bar.x = 0; bar.st = nullptr;
    if (N_LAUNCH_MODE == 1) bar = xcd_barrier_post((unsigned*)(ws + WS_CTL) + CW_BAR, MISC + 8);
#define IN(k) (kp->ph_lo <= (k) && (k) < kp->ph_hi)
#define FRESH_IDS() do { int l_; asm volatile("v_mbcnt_lo_u32_b32 %0, -1, 0\n\tv_mbcnt_hi_u32_b32 %0, -1, %0" : "=v"(l_)); asm volatile("" : "+s"(F.wave), "+s"(F.blk), "+s"(F.G)); F.lane = l_; F.tid = F.wave * 64 + l_; asm volatile("" : "+s"(kp)); ws = kp->ws; bar.bar = (unsigned*)(ws + WS_CTL) + CW_BAR; } while (0)
#define SEAM(k) do { FRESH_IDS(); if (IN(k) && IN((k) + 1)) xcd_barrier(bar, F.tid); FRESH_IDS(); } while (0)

    const float* x0 = kp->in[0];
    float* XR = kp->out;
#define HN ((bf16*)(ws + WS_HN))
#define Z ((bf16*)(ws + WS_Z))
#define YC ((bf16*)(ws + WS_YC))
#define G1 ((bf16*)(ws + WS_G1))
#define KC ((bf16*)(ws + WS_KC))
#define VC ((bf16*)(ws + WS_VC))
#define LIST ((unsigned*)(ws + WS_LIST))
#define LISTW ((float*)(ws + WS_LISTW))
#define HID ((bf16*)(ws + WS_HID))
#define P2 ((bf16*)(ws + WS_P2))
#define P1B ((bf16*)(ws + WS_YC))
#define USSM ((bf16*)(ws + WS_USSM))
#define XL ((float*)(ws + WS_XL))
    LAS int* etab = (LAS int*)(F.lds + ETAB_OFF);

    if (IN(0)) for (int rep_ = 0; rep_ < REP_CONV; ++rep_) ph_convert(F, kp, ws);
    SEAM(0);
    for (int layer = 0; layer < DEPTH; ++layer) {
        const int pb = 1 + layer * PH_PER_LAYER;
        const float* xin = layer == 0 ? x0 : XR;
        unsigned* gcnt = (unsigned*)(ws + WS_CTL) + CW_CNT + layer * 32 * 64;
        if (IN(pb + 0)) { ph_norm(F, xin, layer == 0 ? nullptr : P1B, P2, XR, kp->in[1] + layer * DM, HN); for (int rep_ = 1; rep_ < REP_NORM; ++rep_) ph_norm(F, xin, nullptr, nullptr, XR, kp->in[1] + layer * DM, HN); }
        SEAM(pb + 0);
        if (IN(pb + 1)) {
            pg8::Gemm g{HN, (const bf16*)(ws + WS_WIN) + (size_t)layer * ZP * DM, T, ZP, DM, DM, 0, nullptr, 0, 0, 128}; pg8::StaticOrder S; S.init(T, ZP, F.G, F.blk);
            pg8::EpiInProj E{Z, USSM};
            for (int rep_ = 0; rep_ < REP_INPROJ; ++rep_) pg8::gemm2<pg8::EpiInProj, pg8::StaticOrder, pg8::ADense>(F.lds, g, S, E, F.tid);
        }
        SEAM(pb + 1);
        if (IN(pb + 2)) {
            for (int rep_ = 0; rep_ < REP_CMP; ++rep_) {
                { pg8::Gemm g{Z, (const bf16*)(ws + WS_W1T) + (size_t)layer * 2 * 256 * 2048, 0, 256, 2048, ZP, (size_t)256 * 2048, nullptr, 0, 0, ZP * 2};
                  pg8::CmpOrder S{F.G, F.blk}; pg8::EpiCmpHid E{(bf16*)(ws + WS_HIDC), (const float*)(ws + WS_CBIAS) + layer * 128};
                  pg8::gemm2<pg8::EpiCmpHid, pg8::CmpOrder, pg8::ACompress>(F.lds, g, S, E, F.tid); }
                asm volatile("s_waitcnt vmcnt(0)" ::: "memory"); __syncthreads();
                for (int L = F.blk; L < 32; L += F.G) compress_stage2(F, L >> 4, L & 15, (const bf16*)(ws + WS_HIDC), (const bf16*)(ws + WS_W2T) + (size_t)layer * 2 * 4096, KC, VC);
            }
#pragma unroll 1
            for (int L = F.blk; L < NGRP * BATCH; L += F.G) {
                const int sg = L >> 3, sb = L & 7;
                FRESH_IDS();
                { pg8::Gemm g{USSM, (const bf16*)(ws + WS_BT1) + (size_t)layer * 32 * 256 * 256, 0, 256, 256, 512, (size_t)256 * 256, nullptr, 0, (size_t)2048 * 512, 128};
                  pg8::SingleUnit S{sg, sb}; pg8::EpiXloc E{XL};
                  pg8::gemm2<pg8::EpiXloc, pg8::SingleUnit, pg8::ADense>(F.lds, g, S, E, F.tid); }
                asm volatile("s_waitcnt vmcnt(0)" ::: "memory"); __syncthreads();
                for (int rep_ = 0; rep_ < REP_CARRY; ++rep_)
                if (F.wave == 0) ssm_carry_item(sb, sg, kp->in[6] + layer * NGRP * SST, kp->in[7] + layer * NGRP * SST, kp->in[13] + layer * NGRP, XL, USSM, F.lane);
                asm volatile("s_waitcnt vmcnt(0)" ::: "memory"); __syncthreads();
                FRESH_IDS();
                { pg8::Gemm g{USSM, (const bf16*)(ws + WS_BT2) + (size_t)layer * 32 * 256 * 384, 0, 256, 384, 512, (size_t)256 * 384, nullptr, 0, (size_t)2048 * 512, 128};
                  pg8::SingleUnit S{sg, sb}; pg8::EpiSsmOut E{G1};
                  pg8::gemm2<pg8::EpiSsmOut, pg8::SingleUnit, pg8::ADense>(F.lds, g, S, E, F.tid); }
            }
        }
        SEAM(pb + 2);
        if (IN(pb + 3)) {
            { pg8::Gemm g{G1, (const bf16*)(ws + WS_WGLU) + (size_t)layer * 2 * D_SSM * D_SSM, T, 2 * D_SSM, D_SSM, D_SSM, 0, nullptr, 0, 0, 128}; pg8::StaticOrder S; S.init(T, 2 * D_SSM, F.G, F.blk);
              pg8::EpiGlu E{YC, DM};
              for (int rep_ = 0; rep_ < REP_GLU; ++rep_) pg8::gemm2<pg8::EpiGlu, pg8::StaticOrder, pg8::ADense>(F.lds, g, S, E, F.tid); }
            __syncthreads();
            int last_hkv = -1;
            for (int rep_ = 0; rep_ < REP_ATTN; ++rep_)
            for (int slot = F.blk; slot < 256; slot += F.G) {
                const int bh = slot >> 4, sq = slot & 15;
#pragma unroll 1
                for (int uq = 0; uq < 4; ++uq) { const int jt = uq == 0 ? 63 - sq : (uq == 1 ? 32 + sq : (uq == 2 ? 31 - sq : sq));
                    nsa::unit((LAS char*)F.lds, F.tid, bh >> 1, bh & 1, jt, Z, KC, VC, kp->in[18], YC, (bh & 1) != last_hkv); last_hkv = bh & 1; }
            }
        }
        SEAM(pb + 3);
        if (IN(pb + 4)) {
            pg8::Gemm g{YC, (const bf16*)(ws + WS_WOUT) + (size_t)layer * DM * DM, T, DM, DM, DM, 0, nullptr, 0, 0, 128}; pg8::StaticOrder S; S.init(T, DM, F.G, F.blk);
            for (int rep_ = 1; rep_ < REP_OUT; ++rep_) { pg8::EpiResid Ed{xin, (float*)(ws + WS_Z), DM}; pg8::gemm2<pg8::EpiResid, pg8::StaticOrder, pg8::ADense>(F.lds, g, S, Ed, F.tid); }
            pg8::EpiResid E{xin, XR, DM};
            pg8::gemm2<pg8::EpiResid, pg8::StaticOrder, pg8::ADense>(F.lds, g, S, E, F.tid);
        }
        SEAM(pb + 4);
        if (IN(pb + 5)) ph_norm_route(F, XR, kp->in[2] + layer * DM, kp->in[19] + (size_t)layer * DM * 4, kp->in[20] + layer * 4, kp->in[21] + (size_t)layer * 4 * DM * 8, kp->in[22] + layer * 32, HN, gcnt, LIST, LISTW);
        if (IN(pb + 5)) for (int rep_ = 1; rep_ < REP_ROUTE; ++rep_) ph_norm_route(F, XR, kp->in[2] + layer * DM, kp->in[19] + (size_t)layer * DM * 4, kp->in[20] + layer * 4, kp->in[21] + (size_t)layer * 4 * DM * 8, kp->in[22] + layer * 32, HN, gcnt + (2 + rep_) * 32 * 64, (unsigned*)(ws + 484 * MiB), (float*)(ws + 488 * MiB));
        SEAM(pb + 5);
        if (IN(pb + 6)) {
            build_expert_tab(F, gcnt, etab);
            pg8::Gemm g{HN, (const bf16*)(ws + WS_WGU) + (size_t)layer * 32 * 512 * DM, 0, 512, DM, DM, (size_t)512 * DM, LIST, LCAP, 0, 128};
            pg8::ExpertOrder S{etab, 2, F.G, F.blk};
            pg8::EpiGateUp E{HID, LISTW, LCAP};
            for (int rep_ = 0; rep_ < REP_GU; ++rep_) pg8::gemm2<pg8::EpiGateUp, pg8::ExpertOrder, pg8::AList>(F.lds, g, S, E, F.tid);
        }
        SEAM(pb + 6);
        if (IN(pb + 7)) {
            build_expert_tab(F, gcnt, etab);
            pg8::Gemm g{HID, (const bf16*)(ws + WS_WDN) + (size_t)layer * 32 * DM * 256, 0, DM, 256, 256, (size_t)DM * 256, nullptr, 0, 0, 128};
            pg8::ExpertOrder S{etab, 4, F.G, F.blk};
            for (int rep_ = 1; rep_ < REP_DN; ++rep_) { pg8::EpiDown Ed{P1B, (long)(P2 - P1B), LIST, LCAP}; pg8::gemm2<pg8::EpiDown, pg8::ExpertOrder, pg8::ADense>(F.lds, g, S, Ed, F.tid); }
            pg8::EpiDown E{P1B, (long)(P2 - P1B), LIST, LCAP};
            pg8::gemm2<pg8::EpiDown, pg8::ExpertOrder, pg8::ADense>(F.lds, g, S, E, F.tid);
        }
        SEAM(pb + 7);
    }
    if (IN(N_PHASES - 1)) ph_final_norm(F, XR, P1B, P2, kp->in[3]);
#undef IN
#undef SEAM
#undef HN
#undef Z
#undef YC
#undef G1
#undef KC
#undef VC
#undef LIST
#undef LISTW
#undef HID
#undef P2
#undef P1B
#undef USSM
#undef XL
}

extern "C" void kernel_launch(void* const* d_in, const int* in_sizes, int n_in, void* d_out, int out_size, void* d_ws, size_t ws_size, hipStream_t stream) {
    static int grid = 0;
    if (grid == 0) {
        if (n_in != 26 || out_size != T * DM || ws_size < WS_END) { fprintf(stderr, "kernel_launch: unexpected shapes (n_in %d out %d ws %zu)\n", n_in, out_size, ws_size); grid = -1; return; }
        int dev = 0, cus = 0, per_cu = 0;
        if (hipGetDevice(&dev) != hipSuccess || hipDeviceGetAttribute(&cus, hipDeviceAttributeMultiprocessorCount, dev) != hipSuccess) { grid = -1; return; }
        if (hipFuncSetAttribute((const void*)fwd, hipFuncAttributeMaxDynamicSharedMemorySize, LDS_BYTES) != hipSuccess) { fprintf(stderr, "kernel_launch: hipFuncSetAttribute failed\n"); grid = -1; return; }
        if (hipOccupancyMaxActiveBlocksPerMultiprocessor(&per_cu, (const void*)fwd, NTHR, LDS_BYTES) != hipSuccess || per_cu < 1) fprintf(stderr, "kernel_launch: occupancy query says %d\n", per_cu);
        (void)hipGetLastError();
        grid = cus;
    }
    if (grid < 0) return;
    (void)hipMemsetAsync((char*)d_ws + WS_CTL, 0, CTL_ZERO_BYTES, stream);
    Args a{};
    for (int i = 0; i < 26; ++i) a.in[i] = (const float*)d_in[i];
    a.out = (float*)d_out; a.ws = (unsigned char*)d_ws;
    if (N_LAUNCH_MODE == 1) {
        a.ph_lo = 0; a.ph_hi = N_PHASES;
        hipLaunchKernelGGL(fwd, dim3(grid), dim3(NTHR), LDS_BYTES, stream, a);
    } else {
        for (int p = 0; p < N_PHASES; ++p) { a.ph_lo = p; a.ph_hi = p + 1; hipLaunchKernelGGL(fwd, dim3(grid), dim3(NTHR), LDS_BYTES, stream, a); }
    }
}
```

```cpp
#include <hip/hip_runtime.h>
#include <cstdio>
#include <cstdint>

#ifndef N_LAUNCH_MODE
#define N_LAUNCH_MODE 1
#endif

#define GAS __attribute__((address_space(1)))
#define LAS __attribute__((address_space(3)))
typedef unsigned short bf16;
typedef float f32x4 __attribute__((ext_vector_type(4)));
typedef unsigned u32x4 __attribute__((ext_vector_type(4)));
typedef unsigned u32x2 __attribute__((ext_vector_type(2)));

constexpr int BATCH = 8, SEQ = 4096, DM = 1024, T = BATCH * SEQ, DEPTH = 2;
constexpr int D_SSM = 512, NGRP = 32, SGRP = 16, SST = 64;
constexpr int D_IN = 1816, ZP = 2048;
constexpr int ZC_U = 0, ZC_Q = 512, ZC_KV = 1024, ZC_G = 1792;
constexpr int NCMP = 255, NCMPP = 256;
constexpr float EPS = 1e-6f;
constexpr int NWAVES = 8, NTHR = 512;
constexpr float QSCALE = 0.125f * 1.4426950408889634f;

constexpr size_t MiB = 1u << 20;
constexpr size_t WS_CTL = 0, CTL_ZERO_BYTES = 1 * MiB;
constexpr size_t WS_KC = 1 * MiB, WS_VC = 2 * MiB, WS_ROUTE = 3 * MiB;
constexpr size_t WS_HN = 16 * MiB;
constexpr size_t WS_Z = 80 * MiB;
constexpr size_t WS_YC = 208 * MiB;
constexpr size_t WS_G1 = 272 * MiB;
constexpr size_t WS_WIN = 304 * MiB;
constexpr size_t WS_WGLU = 312 * MiB;
constexpr size_t WS_WOUT = 314 * MiB;
constexpr size_t WS_WGU = 318 * MiB;
constexpr size_t WS_WDN = 382 * MiB;
constexpr size_t WS_LIST = 414 * MiB;
constexpr size_t WS_LISTW = 418 * MiB;
constexpr size_t WS_HID = 422 * MiB;
constexpr size_t WS_P2 = WS_Z;
constexpr size_t WS_USSM = WS_YC;
constexpr size_t WS_XL = WS_HID;
constexpr size_t WS_BT1 = 458 * MiB;
constexpr size_t WS_BT2 = 466 * MiB;
constexpr size_t WS_W1T = 478 * MiB;
constexpr size_t WS_HIDC = 4 * MiB;
constexpr size_t WS_CBIAS = 5 * MiB;
constexpr size_t WS_W2T = 6 * MiB;
constexpr size_t WS_END = 482 * MiB;
constexpr int LCAP = 32768, CW_CNT = 8192;
constexpr int CW_BAR = 4096;

constexpr int LDS_BYTES = 163840;
constexpr int ETAB_OFF = LDS_BYTES - 1024, MISC_OFF = LDS_BYTES - 512;

__device__ __forceinline__ float bf2f(bf16 v) { return __uint_as_float(((unsigned)v) << 16); }
__device__ __forceinline__ unsigned f2bf(float f) { unsigned u = __float_as_uint(f); return (u + 0x7fffu + ((u >> 16) & 1u)) >> 16; }
__device__ __forceinline__ unsigned pk2(float lo, float hi) { return f2bf(lo) | (f2bf(hi) << 16); }
__device__ __forceinline__ float wave_sum(float v, int) {
    v += __builtin_bit_cast(float, __builtin_amdgcn_update_dpp(0, __builtin_bit_cast(int, v), 0xB1, 0xF, 0xF, true));
    v += __builtin_bit_cast(float, __builtin_amdgcn_update_dpp(0, __builtin_bit_cast(int, v), 0x4E, 0xF, 0xF, true));
    v += __builtin_bit_cast(float, __builtin_amdgcn_update_dpp(0, __builtin_bit_cast(int, v), 0x141, 0xF, 0xF, true));
    v += __builtin_bit_cast(float, __builtin_amdgcn_update_dpp(0, __builtin_bit_cast(int, v), 0x140, 0xF, 0xF, true));
    const int iv = __builtin_bit_cast(int, v);
    const float s0 = __builtin_bit_cast(float, __builtin_amdgcn_readlane(iv, 0)), s1 = __builtin_bit_cast(float, __builtin_amdgcn_readlane(iv, 16));
    const float s2 = __builtin_bit_cast(float, __builtin_amdgcn_readlane(iv, 32)), s3 = __builtin_bit_cast(float, __builtin_amdgcn_readlane(iv, 48));
    return (s0 + s1) + (s2 + s3);
}
__device__ __forceinline__ float wave_max(float v, int lane) {
#pragma unroll
    for (int o = 1; o < 64; o <<= 1) v = fmaxf(v, __int_as_float(__builtin_amdgcn_ds_bpermute((lane ^ o) << 2, __float_as_int(v))));
    return v;
}
__device__ __forceinline__ float lane_bcast(float v, int src) { return __int_as_float(__builtin_amdgcn_ds_bpermute(src << 2, __float_as_int(v))); }
__device__ __forceinline__ float gelu_tanh(float x) {
    const float u = 0.7978845608028654f * (x + 0.044715f * x * x * x);
    return 0.5f * x * (1.0f + tanhf(u));
}
__device__ __forceinline__ float sigmoidf_(float x) { return 1.0f / (1.0f + __expf(-x)); }
__device__ __forceinline__ int t5_bucket(int n) {
    if (n < 16) return n < 0 ? 0 : n;
    int b = 16;
    b += (n >= 19); b += (n >= 21); b += (n >= 24); b += (n >= 27); b += (n >= 31); b += (n >= 35); b += (n >= 40); b += (n >= 46);
    b += (n >= 52); b += (n >= 59); b += (n >= 67); b += (n >= 77); b += (n >= 87); b += (n >= 99); b += (n >= 113);
    return b;
}

#define XB_TMO      128
#define XB_XCNT(j)  (256  + 64 * (j))
#define XB_XSUB(j)  (1280 + 64 * (j))
#define XB_XGEN(j)  (2304 + 64 * (j))
#define XB_TOP      3328
#define XB_TOPGEN   3392
#define XCD_BAR_WORDS 3456
#define XB_SPIN_CAP (1u << 22)

__device__ __forceinline__ unsigned xb_ld(unsigned* p)              { return __hip_atomic_load(p, __ATOMIC_RELAXED, __HIP_MEMORY_SCOPE_AGENT); }
__device__ __forceinline__ unsigned xb_add(unsigned* p, unsigned v) { return __hip_atomic_fetch_add(p, v, __ATOMIC_RELAXED, __HIP_MEMORY_SCOPE_AGENT); }
__device__ __forceinline__ unsigned xb_xcc_id() { return (unsigned)__builtin_amdgcn_s_getreg((3 << 11) | 20) & 0xFu; }
#define XB_SPIN(cond, bar) do { unsigned _sp = 0; while (cond) { __builtin_amdgcn_s_sleep(1); \
    if ((++_sp & 255u) == 0u) { if (xb_ld(&(bar)[XB_TMO])) break; if (_sp > XB_SPIN_CAP) { atomicAdd(&(bar)[XB_TMO], 1u); break; } } } } while (0)

struct XcdBarrier { unsigned* bar; unsigned x; volatile LAS unsigned* st; };

__device__ __forceinline__ XcdBarrier xcd_barrier_post(unsigned* bar, volatile LAS unsigned* st) {
    XcdBarrier b; b.bar = bar; b.x = xb_xcc_id(); b.st = st;
    if (threadIdx.x == 0) (void)xb_add(&bar[XB_XCNT(b.x)], 1u);
    return b;
}
__device__ __forceinline__ void xcd_barrier_complete(unsigned* bar, unsigned x, unsigned& nloc, unsigned& nx) {
    const unsigned G = gridDim.x * gridDim.y * gridDim.z;
    unsigned sum, cnt, mine, sp = 0u;
    for (;;) {
        sum = 0u; cnt = 0u; mine = 0u;
#pragma unroll
        for (unsigned j = 0; j < 16; ++j) { const unsigned c = xb_ld(&bar[XB_XCNT(j)]); sum += c; cnt += (c > 0u) ? 1u : 0u; mine = (j == x) ? c : mine; }
        if (sum == G) break;
        __builtin_amdgcn_s_sleep(1);
        if ((++sp & 255u) == 0u) { if (xb_ld(&bar[XB_TMO])) break; if (sp > XB_SPIN_CAP) { atomicAdd(&bar[XB_TMO], 1u); break; } }
    }
    nloc = mine > 0u ? mine : 1u; nx = cnt > 0u ? cnt : 1u;
}
__device__ __forceinline__ void xcd_barrier(const XcdBarrier& b, const int tid) {
    asm volatile("s_waitcnt vmcnt(0)" ::: "memory");
    __syncthreads();
    if (tid == 0) {
        unsigned* bar = b.bar;
        __builtin_amdgcn_s_waitcnt(0);
        unsigned nloc = b.st[0], nx = b.st[1];
        if (nloc == 0u) { xcd_barrier_complete(bar, b.x, nloc, nx); b.st[0] = nloc; b.st[1] = nx; }
        const unsigned old = xb_add(&bar[XB_XSUB(b.x)], 1u);
        const unsigned gen = old / nloc;
        if (old + 1u == (gen + 1u) * nloc) {
            __builtin_amdgcn_fence(__ATOMIC_RELEASE, "agent");
            asm volatile("s_waitcnt vmcnt(0)" ::: "memory");
            const unsigned og = xb_add(&bar[XB_TOP], 1u);
            const unsigned tg = og / nx;
            if (og + 1u == (tg + 1u) * nx) xb_add(&bar[XB_TOPGEN], 1u);
            else XB_SPIN(xb_ld(&bar[XB_TOPGEN]) == tg, bar);
            __builtin_amdgcn_fence(__ATOMIC_ACQUIRE, "agent");
            xb_add(&bar[XB_XGEN(b.x)], 1u);
            asm volatile("s_waitcnt vmcnt(0)" ::: "memory");
        } else {
            XB_SPIN(xb_ld(&bar[XB_XGEN(b.x)]) == gen, bar);
            __builtin_amdgcn_fence(__ATOMIC_ACQUIRE, "agent");
            asm volatile("s_waitcnt vmcnt(0)" ::: "memory");
        }
    }
    __syncthreads();
}

namespace pg8 {
#define PG8_LAS __attribute__((address_space(3)))
typedef unsigned short bf16_t;
typedef short bf16x8 __attribute__((ext_vector_type(8)));
typedef float f32x4 __attribute__((ext_vector_type(4)));
typedef unsigned u32x4 __attribute__((ext_vector_type(4)));
constexpr int BM = 256, BK = 64, HALF = 128, HTB = HALF * BK * 2  , STAGE_BYTES = 8 * HTB, NXCD = 8, WGM = 8;

__host__ __device__ __forceinline__ int lds_byte(int r, int c) { const int st = (r >> 4) * 2 + (c >> 5), rr = r & 15, cc = c & 31, ob = rr * 64 + cc * 2; return st * 1024 + (ob ^ (((ob >> 9) & 1) << 5)); }
__host__ __device__ __forceinline__ void stage_rc(int b, int& R, int& C) { const int st = b / 1024, sb = b % 1024, swz = sb ^ (((sb >> 9) & 1) << 5); R = (st >> 1) * 16 + swz / 64; C = (st & 1) * 32 + (swz % 64) / 2; }
__host__ __device__ __forceinline__ int perm32(int rho) { const int n = rho >> 4, i = rho & 15; return 8 * (i >> 2) + 4 * n + (i & 3); }

struct Unit { int pm, pn, eb, p0, cnt; };
struct Gemm { const bf16_t* A; const bf16_t* Bt; int M, N, K; int lda; size_t bstride; const unsigned* list; int cap; size_t astride; int kstepA; };

struct StaticOrder {
    int nM, nN, nwg, G, c;
    __host__ __device__ void init(int M, int N, int G_, int c_) { nM = M / BM; nN = N / BM; nwg = nM * nN; G = G_; c = c_; }
    __host__ __device__ bool next(int i, Unit& u) const {
        const long L = (long)i * G + c; if (L >= nwg) return false;
        int wgid = (int)L; { const int q = nwg / NXCD, r = nwg % NXCD, xcd = wgid % NXCD, off = wgid / NXCD; wgid = (xcd < r ? xcd * (q + 1) : r * (q + 1) + (xcd - r) * q) + off; }
        const int nig = WGM * nN, gid = wgid / nig, fm = gid * WGM, gsz = (nM - fm) < WGM ? (nM - fm) : WGM;
        u.pm = fm + ((wgid % nig) % gsz); u.pn = (wgid % nig) / gsz; u.eb = 0; u.p0 = 0; u.cnt = 0; return true;
    }
    __device__ __forceinline__ void a_ready(const Unit&) const {}
    __device__ __forceinline__ void done(const Unit&) const {}
};

__device__ __forceinline__ unsigned cvt_pk_bf16(float lo, float hi) { unsigned r; asm volatile("v_cvt_pk_bf16_f32 %0, %1, %2" : "=v"(r) : "v"(lo), "v"(hi)); return r; }
typedef float f32x2 __attribute__((ext_vector_type(2)));
__device__ __forceinline__ f32x2 gelu_pk(f32x2 v) {
    const f32x2 av = __builtin_elementwise_abs(v), d = av * 0.2316418882f + 1.0f;
    f32x2 t; t.x = __builtin_amdgcn_rcpf(d.x); t.y = __builtin_amdgcn_rcpf(d.y);
    f32x2 q = t * 0.5307027145f + (-0.7265760135f); q = q * t + 0.7107068705f; q = q * t + (-0.142248368f); q = q * t + 0.127414796f; q = q * t;
    const f32x2 s = (v * v) * (-0.72134752044f);
    f32x2 e; e.x = __builtin_amdgcn_exp2f(s.x); e.y = __builtin_amdgcn_exp2f(s.y);
    const f32x2 m = v * (q * e), r = v - m;
    f32x2 o; o.x = v.x < 0.f ? m.x : r.x; o.y = v.y < 0.f ? m.y : r.y; return o;
}

template <int ACT  > struct EpiBf16 {
    static constexpr bool PERM = true, AFTER_DRAIN = false; static_assert(ACT == 0 || ACT == 1, "EpiBf16: ACT is 0 (none) or 1 (gelu_pk)");
    bf16_t* O; int ldc; const float* bias; int split_cols; size_t split_stride; float scale0;
    __device__ __forceinline__ void operator()(const f32x4 (&acc)[2][2][4][2], const Unit& u, int wr, int wc, int fr, int fq) const {
        const int row0 = u.pm * BM + wr * 64 + fr; int colt = u.pn * BM; bf16_t* base = O;
        float sc = 1.f; if (split_cols) { const int t = colt / split_cols; base += (size_t)t * split_stride; colt -= t * split_cols; if (t == 0) sc = scale0; }
        const int col0 = colt + wc * 32 + 8 * fq, bcol0 = u.pn * BM + wc * 32 + 8 * fq;
        f32x4 bv[2][2];
#pragma unroll
        for (int bj = 0; bj < 2; ++bj)
#pragma unroll
            for (int n = 0; n < 2; ++n) bv[bj][n] = bias ? *(const f32x4*)(bias + bcol0 + bj * HALF + 4 * n) : (f32x4){0.f, 0.f, 0.f, 0.f};
#pragma unroll
        for (int ai = 0; ai < 2; ++ai)
#pragma unroll
            for (int m = 0; m < 4; ++m) { bf16_t* rowp = base + (size_t)(row0 + ai * HALF + m * 16) * ldc + col0;
#pragma unroll
                for (int bj = 0; bj < 2; ++bj) { f32x4 v0 = acc[ai][bj][m][0] + bv[bj][0], v1 = acc[ai][bj][m][1] + bv[bj][1];
                    if (ACT == 1) { f32x2 a = gelu_pk((f32x2){v0[0], v0[1]}), b = gelu_pk((f32x2){v0[2], v0[3]}), c = gelu_pk((f32x2){v1[0], v1[1]}), d = gelu_pk((f32x2){v1[2], v1[3]});
                        v0 = (f32x4){a.x, a.y, b.x, b.y}; v1 = (f32x4){c.x, c.y, d.x, d.y}; }
                    v0 = v0 * sc; v1 = v1 * sc; u32x4 w; w.x = cvt_pk_bf16(v0[0], v0[1]); w.y = cvt_pk_bf16(v0[2], v0[3]); w.z = cvt_pk_bf16(v1[0], v1[1]); w.w = cvt_pk_bf16(v1[2], v1[3]);
                    *(u32x4*)(rowp + bj * HALF) = w; } }
    }
};
template <class Epi, class Sched, bool ALIGN_EPI = false, bool SP2 = false>
__device__ __forceinline__ void gemm_phase(PG8_LAS unsigned char* lds, const Gemm g, const Sched& S, const Epi& E) {
    int tid_ = threadIdx.x; asm volatile("" : "+v"(tid_));
    const int tid = tid_, wid = __builtin_amdgcn_readfirstlane(tid >> 6), lane = tid & 63, wr = wid >> 2, wc = wid & 3, fr = lane & 15, fq = lane >> 4;
    const int K = g.K, nt = K / BK;
    unsigned voffA[2], voffB[2];
#pragma unroll
    for (int i = 0; i < 2; ++i) { int R, C; stage_rc(tid * 16 + i * 8192, R, C); const int Rb = Epi::PERM ? ((R & ~31) + perm32(R & 31)) : R;
        voffA[i] = (unsigned)(R * K + C) * 2u; voffB[i] = (unsigned)(Rb * K + C) * 2u; }
    const size_t kstep = (size_t)(BK * 2);
    const size_t hstep = (size_t)HALF * K * 2;
    const size_t tstep = 2 * hstep;
    const unsigned ldsw = (unsigned)wid * 1024u;
    const int aoff = lds_byte(wr * 64 + fr, fq * 8), boff = lds_byte(wc * 32 + fr, fq * 8);
#define PG8_SA(b, h) (((b) * 2 + (h)) * HTB)
#define PG8_SB(b, h) ((4 + (b) * 2 + (h)) * HTB)
#define PG8_STAGE(bufoff, gbase, voff) do { _Pragma("unroll") for (int _i = 0; _i < 2; ++_i) \
        __builtin_amdgcn_global_load_lds((const unsigned*)((const char*)(gbase) + (voff)[_i]), (PG8_LAS unsigned*)(lds + (bufoff) + ldsw + _i * 8192), 16, 0, 0); } while (0)
#define PG8_LDA(dst, b, h) do { _Pragma("unroll") for (int m = 0; m < 4; ++m) _Pragma("unroll") for (int k = 0; k < 2; ++k) dst[m][k] = *(const PG8_LAS bf16x8*)(lds + PG8_SA(b, h) + aoff + m * 2048 + k * 1024); } while (0)
#define PG8_LDB(dst, b, h) do { _Pragma("unroll") for (int n = 0; n < 2; ++n) _Pragma("unroll") for (int k = 0; k < 2; ++k) dst[n][k] = *(const PG8_LAS bf16x8*)(lds + PG8_SB(b, h) + boff + n * 2048 + k * 1024); } while (0)
#define PG8_MMA(ai, bj, At, Bt) do { __builtin_amdgcn_s_setprio(1); _Pragma("unroll") for (int m = 0; m < 4; ++m) _Pragma("unroll") for (int n = 0; n < 2; ++n) _Pragma("unroll") for (int k = 0; k < 2; ++k) \
        acc[ai][bj][m][n] = __builtin_amdgcn_mfma_f32_16x16x32_bf16(Bt[n][k], At[m][k], acc[ai][bj][m][n], 0, 0, 0); __builtin_amdgcn_s_setprio(0); } while (0)
#define PG8_WAIT_V(n) asm volatile("s_waitcnt vmcnt(" #n ")" ::: "memory")
#define PG8_WAIT_L(n) asm volatile("s_waitcnt lgkmcnt(" #n ")" ::: "memory")
#define PG8_BAR __builtin_amdgcn_s_barrier()
#define PG8_SCHED __builtin_amdgcn_sched_barrier(0)
    Unit cur, nxt; int ui = 0;
    if (!S.next(0, cur)) return;
    f32x4 acc[2][2][4][2];
#pragma unroll
    for (int a = 0; a < 2; ++a)
#pragma unroll
        for (int b = 0; b < 2; ++b)
#pragma unroll
            for (int m = 0; m < 4; ++m)
#pragma unroll
                for (int n = 0; n < 2; ++n) acc[a][b][m][n] = (f32x4){0.f, 0.f, 0.f, 0.f};
    bf16x8 At[4][2], B0[2][2], B1[2][2];
    const char* cA = (const char*)g.A + (size_t)cur.pm * tstep; const char* cB = (const char*)g.Bt + (size_t)cur.pn * tstep;
    S.a_ready(cur);
    if constexpr (SP2) {
        PG8_STAGE(PG8_SB(0, 0), cB, voffB); PG8_STAGE(PG8_SB(0, 1), cB + hstep, voffB); PG8_STAGE(PG8_SA(0, 0), cA, voffA); PG8_STAGE(PG8_SA(0, 1), cA + hstep, voffA);
        if (wr == 1) PG8_BAR;
        PG8_WAIT_V(2); PG8_BAR;
        PG8_STAGE(PG8_SB(1, 0), cB + kstep, voffB); PG8_STAGE(PG8_SA(1, 0), cA + kstep, voffA); PG8_STAGE(PG8_SB(1, 1), cB + hstep + kstep, voffB);
        PG8_WAIT_V(6); PG8_BAR;
    } else {
        PG8_STAGE(PG8_SB(0, 0), cB, voffB); PG8_STAGE(PG8_SA(0, 0), cA, voffA); PG8_STAGE(PG8_SB(0, 1), cB + hstep, voffB); PG8_STAGE(PG8_SA(0, 1), cA + hstep, voffA);
        if (wr == 1) PG8_BAR;
        PG8_WAIT_V(4); PG8_BAR;
        PG8_STAGE(PG8_SB(1, 0), cB + kstep, voffB); PG8_STAGE(PG8_SA(1, 0), cA + kstep, voffA); PG8_STAGE(PG8_SB(1, 1), cB + hstep + kstep, voffB);
        PG8_WAIT_V(6); PG8_BAR;
    }
    for (;;) {
        const bool has_next = S.next(ui + 1, nxt);
        const char* nA = has_next ? (const char*)g.A + (size_t)nxt.pm * tstep : cA; const char* nB = has_next ? (const char*)g.Bt + (size_t)nxt.pn * tstep : cB;
        for (int t = 0; t < nt; t += 2) {
            const bool last = (t == nt - 2);
            const char* a1 = cA + (size_t)(t + 1) * kstep;
            const char* a2 = last ? nA : cA + (size_t)(t + 2) * kstep; const char* b2 = last ? nB : cB + (size_t)(t + 2) * kstep;
            const char* a3 = a2 + kstep; const char* b3 = b2 + kstep;
            if (last && has_next) S.a_ready(nxt);
            if constexpr (SP2) {
            PG8_LDB(B0, 0, 0); PG8_LDB(B1, 0, 1); PG8_SCHED; PG8_LDA(At, 0, 0); PG8_STAGE(PG8_SA(1, 1), a1 + hstep, voffA);
            PG8_WAIT_V(8); PG8_WAIT_L(0); PG8_BAR; PG8_MMA(0, 0, At, B0); PG8_MMA(0, 1, At, B1); PG8_BAR; PG8_SCHED;
            PG8_LDA(At, 0, 1); PG8_STAGE(PG8_SB(0, 0), b2, voffB); PG8_STAGE(PG8_SB(0, 1), b2 + hstep, voffB); PG8_STAGE(PG8_SA(0, 0), a2, voffA);
            PG8_WAIT_V(8); PG8_WAIT_L(0); PG8_BAR; PG8_MMA(1, 0, At, B0); PG8_MMA(1, 1, At, B1); PG8_BAR; PG8_SCHED;
            PG8_LDB(B0, 1, 0); PG8_LDB(B1, 1, 1); PG8_SCHED; PG8_LDA(At, 1, 0); PG8_STAGE(PG8_SA(0, 1), a2 + hstep, voffA);
            PG8_WAIT_V(8); PG8_WAIT_L(0); PG8_BAR; PG8_MMA(0, 0, At, B0); PG8_MMA(0, 1, At, B1); PG8_BAR; PG8_SCHED;
            PG8_LDA(At, 1, 1); PG8_STAGE(PG8_SB(1, 0), b3, voffB); PG8_STAGE(PG8_SB(1, 1), b3 + hstep, voffB); PG8_STAGE(PG8_SA(1, 0), a3, voffA);
            PG8_WAIT_V(8); PG8_WAIT_L(0); PG8_BAR; PG8_MMA(1, 0, At, B0); PG8_MMA(1, 1, At, B1); PG8_BAR; PG8_SCHED;
            } else {
            PG8_LDB(B0, 0, 0); PG8_SCHED; PG8_LDA(At, 0, 0); PG8_STAGE(PG8_SA(1, 1), a1 + hstep, voffA);
            PG8_WAIT_L(8); PG8_BAR; PG8_WAIT_L(0); PG8_MMA(0, 0, At, B0); PG8_BAR; PG8_SCHED;
            PG8_LDB(B1, 0, 1); PG8_STAGE(PG8_SB(0, 0), b2, voffB);
            PG8_BAR; PG8_WAIT_L(0); PG8_MMA(0, 1, At, B1); PG8_BAR;
            PG8_LDA(At, 0, 1); PG8_STAGE(PG8_SA(0, 0), a2, voffA);
            PG8_BAR; PG8_WAIT_L(0); PG8_MMA(1, 0, At, B0); PG8_BAR; PG8_SCHED;
            PG8_STAGE(PG8_SB(0, 1), b2 + hstep, voffB);
            PG8_WAIT_V(6); PG8_BAR; PG8_MMA(1, 1, At, B1); PG8_BAR;
            PG8_LDB(B0, 1, 0); PG8_SCHED; PG8_LDA(At, 1, 0); PG8_STAGE(PG8_SA(0, 1), a2 + hstep, voffA);
            PG8_WAIT_L(8); PG8_BAR; PG8_WAIT_L(0); PG8_MMA(0, 0, At, B0); PG8_BAR; PG8_SCHED;
            PG8_LDB(B1, 1, 1); PG8_STAGE(PG8_SB(1, 0), b3, voffB);
            PG8_BAR; PG8_WAIT_L(0); PG8_MMA(0, 1, At, B1); PG8_BAR;
            PG8_LDA(At, 1, 1); PG8_STAGE(PG8_SA(1, 0), a3, voffA);
            PG8_BAR; PG8_WAIT_L(0); PG8_MMA(1, 0, At, B0); PG8_BAR; PG8_SCHED;
            PG8_STAGE(PG8_SB(1, 1), b3 + hstep, voffB);
            PG8_WAIT_V(6); PG8_BAR; PG8_MMA(1, 1, At, B1); PG8_BAR;
            }
        }
        if constexpr (ALIGN_EPI) { if (wr == 0) PG8_BAR; }
        if constexpr (!Epi::AFTER_DRAIN) { E(acc, cur, wr, wc, fr, fq); S.done(cur); }
        if (!has_next) break;
#pragma unroll
        for (int a = 0; a < 2; ++a)
#pragma unroll
            for (int b = 0; b < 2; ++b)
#pragma unroll
                for (int m = 0; m < 4; ++m)
#pragma unroll
                    for (int n = 0; n < 2; ++n) acc[a][b][m][n] = (f32x4){0.f, 0.f, 0.f, 0.f};
        cur = nxt; cA = nA; cB = nB; ++ui;
        if constexpr (ALIGN_EPI) { if (wr == 1) PG8_BAR; }
    }
    PG8_WAIT_V(0);
    if constexpr (!ALIGN_EPI) { if (wr == 0) PG8_BAR; }
    PG8_BAR;
    if constexpr (Epi::AFTER_DRAIN) { E.fused(acc, cur, wr, wc, fr, fq, lds, wid, lane); S.done(cur); }
#undef PG8_SA
#undef PG8_SB
#undef PG8_STAGE
#undef PG8_LDA
#undef PG8_LDB
#undef PG8_MMA
#undef PG8_WAIT_V
#undef PG8_WAIT_L
#undef PG8_BAR
#undef PG8_SCHED
}

__device__ __forceinline__ float sigm(float x) { return 1.0f / (1.0f + __expf(-x)); }
struct EpiGlu {
    static constexpr bool PERM = true, AFTER_DRAIN = false;
    bf16_t* O; int ldc;
    __device__ __forceinline__ void operator()(const f32x4 (&acc)[2][2][4][2], const Unit& u, int wr, int wc, int fr, int fq) const {
        const int row0 = u.pm * BM + wr * 64 + fr, col0 = u.pn * HALF + wc * 32 + 8 * fq;
#pragma unroll
        for (int ai = 0; ai < 2; ++ai)
#pragma unroll
            for (int m = 0; m < 4; ++m) {
                bf16_t* rowp = O + (size_t)(row0 + ai * HALF + m * 16) * ldc + col0;
                const f32x4 a0 = acc[ai][0][m][0], a1 = acc[ai][0][m][1], b0 = acc[ai][1][m][0], b1 = acc[ai][1][m][1];
                u32x4 w;
                w.x = cvt_pk_bf16(a0[0] * sigm(b0[0]), a0[1] * sigm(b0[1])); w.y = cvt_pk_bf16(a0[2] * sigm(b0[2]), a0[3] * sigm(b0[3]));
                w.z = cvt_pk_bf16(a1[0] * sigm(b1[0]), a1[1] * sigm(b1[1])); w.w = cvt_pk_bf16(a1[2] * sigm(b1[2]), a1[3] * sigm(b1[3]));
                *(u32x4*)rowp = w;
            }
    }
};
struct EpiResid {
    static constexpr bool PERM = false, AFTER_DRAIN = false;
    const float* X; float* O; int ldc;
    __device__ __forceinline__ void operator()(const f32x4 (&acc)[2][2][4][2], const Unit& u, int wr, int wc, int fr, int fq) const {
        const int row0 = u.pm * BM + wr * 64 + fr, col0 = u.pn * BM + wc * 32 + 4 * fq;
#pragma unroll
        for (int ai = 0; ai < 2; ++ai)
#pragma unroll
            for (int m = 0; m < 4; ++m) {
                const size_t off = (size_t)(row0 + ai * HALF + m * 16) * ldc + col0;
#pragma unroll
                for (int bj = 0; bj < 2; ++bj)
#pragma unroll
                    for (int n = 0; n < 2; ++n) *(f32x4*)(O + off + bj * HALF + n * 16) = *(const f32x4*)(X + off + bj * HALF + n * 16) + acc[ai][bj][m][n];
            }
    }
};

struct ADense { static constexpr bool GATHER = false; __device__ __forceinline__ static unsigned rowoff(const Gemm&, const Unit&, int) { return 0u; } };
struct AList { static constexpr bool GATHER = true;
    __device__ __forceinline__ static unsigned rowoff(const Gemm& g, const Unit& u, int r) { const int pos = u.p0 + r; const unsigned tok = pos < u.cnt ? (g.list[(size_t)u.eb * g.cap + pos] >> 1) : 0u; return tok * (unsigned)g.lda * 2u; } };
struct ACompress { static constexpr bool GATHER = true;
    __device__ __forceinline__ static unsigned rowoff(const Gemm&, const Unit& u, int r) { const unsigned rg = (unsigned)(u.pm * BM + r), b = rg >> 9, n = (rg >> 1) & 255u, hkv = rg & 1u;
        return (((b * 4096u + 16u * n) * 2048u) + 1024u + (unsigned)u.eb * 128u + hkv * 64u) * 2u; } };
template <class Epi, class Sched, class AMap>
__device__ __forceinline__ void gemm2(PG8_LAS unsigned char* lds, const Gemm g, const Sched& S, const Epi& E, const int tid) {
    constexpr bool GATHER = AMap::GATHER;
    int K_ = g.K; asm volatile("" : "+s"(K_));
    const int wid = __builtin_amdgcn_readfirstlane(tid >> 6), lane = tid & 63, wr = wid >> 2, wc = wid & 3, fr = lane & 15, fq = lane >> 4;
    const int K = K_, nt = K / BK, lda = g.lda;
    unsigned voffA[2], voffB[2]; int Rst[2], Cst[2];
#pragma unroll
    for (int i = 0; i < 2; ++i) { int R, C; stage_rc(tid * 16 + i * 8192, R, C); const int Rb = Epi::PERM ? ((R & ~31) + perm32(R & 31)) : R;
        voffA[i] = (unsigned)(R * lda + C) * 2u; voffB[i] = (unsigned)(Rb * K + C) * 2u; Rst[i] = R; Cst[i] = C; }
    const size_t kstep = (size_t)(BK * 2), kstepA = (size_t)g.kstepA;
    const size_t hstepA = (size_t)HALF * lda * 2, tstepA = 2 * hstepA, hstepB = (size_t)HALF * K * 2, tstepB = 2 * hstepB;
    const unsigned ldsw = (unsigned)wid * 1024u;
    const int aoff = lds_byte(wr * 64 + fr, fq * 8), boff = lds_byte(wc * 32 + fr, fq * 8);
#define PG8_SA(b, h) (((b) * 2 + (h)) * HTB)
#define PG8_SB(b, h) ((4 + (b) * 2 + (h)) * HTB)
#define PG8_STAGE(bufoff, gbase, voff) do { _Pragma("unroll") for (int _i = 0; _i < 2; ++_i) \
        __builtin_amdgcn_global_load_lds((const unsigned*)((const char*)(gbase) + (voff)[_i]), (PG8_LAS unsigned*)(lds + (bufoff) + ldsw + _i * 8192), 16, 0, 0); } while (0)
#define PG8_STAGE_A(bufoff, gbase, h) do { if constexpr (GATHER) { PG8_STAGE(bufoff, gbase, vg[h]); } else { PG8_STAGE(bufoff, (gbase) + (h) * hstepA, voffA); } } while (0)
#define PG8_GOFFS(u, dst) do { _Pragma("unroll") for (int _h = 0; _h < 2; ++_h) _Pragma("unroll") for (int _i = 0; _i < 2; ++_i) dst[_h][_i] = AMap::rowoff(g, (u), _h * HALF + Rst[_i]) + (unsigned)Cst[_i] * 2u; } while (0)
#define PG8_LDA(dst, b, h) do { _Pragma("unroll") for (int m = 0; m < 4; ++m) _Pragma("unroll") for (int k = 0; k < 2; ++k) dst[m][k] = *(const PG8_LAS bf16x8*)(lds + PG8_SA(b, h) + aoff + m * 2048 + k * 1024); } while (0)
#define PG8_LDB(dst, b, h) do { _Pragma("unroll") for (int n = 0; n < 2; ++n) _Pragma("unroll") for (int k = 0; k < 2; ++k) dst[n][k] = *(const PG8_LAS bf16x8*)(lds + PG8_SB(b, h) + boff + n * 2048 + k * 1024); } while (0)
#define PG8_MMA(ai, bj, At, Bt) do { __builtin_amdgcn_s_setprio(1); _Pragma("unroll") for (int m = 0; m < 4; ++m) _Pragma("unroll") for (int n = 0; n < 2; ++n) _Pragma("unroll") for (int k = 0; k < 2; ++k) \
        acc[ai][bj][m][n] = __builtin_amdgcn_mfma_f32_16x16x32_bf16(Bt[n][k], At[m][k], acc[ai][bj][m][n], 0, 0, 0); __builtin_amdgcn_s_setprio(0); } while (0)
#define PG8_WAIT_V(n) asm volatile("s_waitcnt vmcnt(" #n ")" ::: "memory")
#define PG8_WAIT_L(n) asm volatile("s_waitcnt lgkmcnt(" #n ")" ::: "memory")
#define PG8_BAR __builtin_amdgcn_s_barrier()
#define PG8_SCHED __builtin_amdgcn_sched_barrier(0)
    Unit cur, nxt; int ui = 0;
    if (!S.next(0, cur)) return;
    f32x4 acc[2][2][4][2];
#pragma unroll
    for (int a = 0; a < 2; ++a)
#pragma unroll
        for (int b = 0; b < 2; ++b)
#pragma unroll
            for (int m = 0; m < 4; ++m)
#pragma unroll
                for (int n = 0; n < 2; ++n) acc[a][b][m][n] = (f32x4){0.f, 0.f, 0.f, 0.f};
    bf16x8 At[4][2], B0[2][2], B1[2][2];
    unsigned vg[2][2] = {{0u, 0u}, {0u, 0u}};
    if constexpr (GATHER) PG8_GOFFS(cur, vg);
    const char* cA = (const char*)g.A + (GATHER ? (size_t)0 : (size_t)cur.pm * tstepA + (size_t)cur.eb * g.astride * 2);
    const char* cB = (const char*)g.Bt + ((size_t)cur.eb * g.bstride) * 2 + (size_t)cur.pn * tstepB;
    S.a_ready(cur);
    PG8_STAGE(PG8_SB(0, 0), cB, voffB); PG8_STAGE(PG8_SB(0, 1), cB + hstepB, voffB); PG8_STAGE_A(PG8_SA(0, 0), cA, 0); PG8_STAGE_A(PG8_SA(0, 1), cA, 1);
    if (wr == 1) PG8_BAR;
    PG8_WAIT_V(2); PG8_BAR;
    PG8_STAGE(PG8_SB(1, 0), cB + kstep, voffB); PG8_STAGE_A(PG8_SA(1, 0), cA + kstepA, 0); PG8_STAGE(PG8_SB(1, 1), cB + hstepB + kstep, voffB);
    PG8_WAIT_V(6); PG8_BAR;
    for (;;) {
        const bool has_next = S.next(ui + 1, nxt);
        const char* nA = has_next ? (const char*)g.A + (GATHER ? (size_t)0 : (size_t)nxt.pm * tstepA + (size_t)nxt.eb * g.astride * 2) : cA;
        const char* nB = has_next ? (const char*)g.Bt + ((size_t)nxt.eb * g.bstride) * 2 + (size_t)nxt.pn * tstepB : cB;
        for (int t = 0; t < nt; t += 2) {
            const bool last = (t == nt - 2);
            const char* a1 = cA + (size_t)(t + 1) * kstepA;
            const char* a2 = last ? nA : cA + (size_t)(t + 2) * kstepA; const char* b2 = last ? nB : cB + (size_t)(t + 2) * kstep;
            const char* a3 = a2 + kstepA; const char* b3 = b2 + kstep;
            unsigned vn1[2] = {vg[1][0], vg[1][1]};
            if constexpr (GATHER) { if (last && has_next) { unsigned vn[2][2]; PG8_GOFFS(nxt, vn); vg[0][0] = vn[0][0]; vg[0][1] = vn[0][1]; vn1[0] = vn[1][0]; vn1[1] = vn[1][1]; } }
            if (last && has_next) S.a_ready(nxt);
            PG8_LDB(B0, 0, 0); PG8_LDB(B1, 0, 1); PG8_SCHED; PG8_LDA(At, 0, 0); PG8_STAGE_A(PG8_SA(1, 1), a1, 1);
            PG8_WAIT_V(8); PG8_WAIT_L(0); PG8_BAR; PG8_MMA(0, 0, At, B0); PG8_MMA(0, 1, At, B1); PG8_BAR; PG8_SCHED;
            if constexpr (GATHER) { vg[1][0] = vn1[0]; vg[1][1] = vn1[1]; }
            PG8_LDA(At, 0, 1); PG8_STAGE(PG8_SB(0, 0), b2, voffB); PG8_STAGE(PG8_SB(0, 1), b2 + hstepB, voffB); PG8_STAGE_A(PG8_SA(0, 0), a2, 0);
            PG8_WAIT_V(8); PG8_WAIT_L(0); PG8_BAR; PG8_MMA(1, 0, At, B0); PG8_MMA(1, 1, At, B1); PG8_BAR; PG8_SCHED;
            PG8_LDB(B0, 1, 0); PG8_LDB(B1, 1, 1); PG8_SCHED; PG8_LDA(At, 1, 0); PG8_STAGE_A(PG8_SA(0, 1), a2, 1);
            PG8_WAIT_V(8); PG8_WAIT_L(0); PG8_BAR; PG8_MMA(0, 0, At, B0); PG8_MMA(0, 1, At, B1); PG8_BAR; PG8_SCHED;
            PG8_LDA(At, 1, 1); PG8_STAGE(PG8_SB(1, 0), b3, voffB); PG8_STAGE(PG8_SB(1, 1), b3 + hstepB, voffB); PG8_STAGE_A(PG8_SA(1, 0), a3, 0);
            PG8_WAIT_V(8); PG8_WAIT_L(0); PG8_BAR; PG8_MMA(1, 0, At, B0); PG8_MMA(1, 1, At, B1); PG8_BAR; PG8_SCHED;
        }
        if (wr == 0) PG8_BAR;
        E(acc, cur, wr, wc, fr, fq); S.done(cur);
        if (!has_next) break;
#pragma unroll
        for (int a = 0; a < 2; ++a)
#pragma unroll
            for (int b = 0; b < 2; ++b)
#pragma unroll
                for (int m = 0; m < 4; ++m)
#pragma unroll
                    for (int n = 0; n < 2; ++n) acc[a][b][m][n] = (f32x4){0.f, 0.f, 0.f, 0.f};
        cur = nxt; cA = nA; cB = nB; ++ui;
        if (wr == 1) PG8_BAR;
    }
    PG8_WAIT_V(0);
    PG8_BAR;
#undef PG8_SA
#undef PG8_SB
#undef PG8_STAGE
#undef PG8_STAGE_A
#undef PG8_GOFFS
#undef PG8_LDA
#undef PG8_LDB
#undef PG8_MMA
#undef PG8_WAIT_V
#undef PG8_WAIT_L
#undef PG8_BAR
#undef PG8_SCHED
}

struct ExpertOrder {
    const PG8_LAS int* tab; int nN, G, c;
    __device__ __forceinline__ bool next(int i, Unit& u) const {
        const int total = tab[32] * nN; const long L = (long)i * G + c; if (L >= total) return false;
        const int rt = (int)L / nN, pn = (int)L % nN; int e = 0;
#pragma unroll
        for (int k = 1; k < 32; ++k) e += (rt >= tab[k]) ? 1 : 0;
        u.pm = __builtin_amdgcn_readfirstlane(rt); u.pn = __builtin_amdgcn_readfirstlane(pn); u.eb = __builtin_amdgcn_readfirstlane(e);
        u.p0 = __builtin_amdgcn_readfirstlane((rt - tab[e]) * BM); u.cnt = __builtin_amdgcn_readfirstlane(tab[33 + e]); return true;
    }
    __device__ __forceinline__ void a_ready(const Unit&) const {}
    __device__ __forceinline__ void done(const Unit&) const {}
};
struct EpiGateUp {
    static constexpr bool PERM = true, AFTER_DRAIN = false;
    bf16_t* H; const float* listw; int cap;
    __device__ __forceinline__ void operator()(const f32x4 (&acc)[2][2][4][2], const Unit& u, int wr, int wc, int fr, int fq) const {
        const int rl0 = wr * 64 + fr, col0 = u.pn * HALF + wc * 32 + 8 * fq;
#pragma unroll
        for (int ai = 0; ai < 2; ++ai)
#pragma unroll
            for (int m = 0; m < 4; ++m) {
                const int rl = rl0 + ai * HALF + m * 16, pos = u.p0 + rl;
                const float w = pos < u.cnt ? listw[(size_t)u.eb * cap + pos] : 0.f;
                bf16_t* rowp = H + (size_t)(u.pm * BM + rl) * 256 + col0;
                const f32x4 g0 = acc[ai][0][m][0], g1 = acc[ai][0][m][1], u0 = acc[ai][1][m][0], u1 = acc[ai][1][m][1];
                u32x4 o;
                o.x = cvt_pk_bf16(g0[0] * sigm(g0[0]) * u0[0] * w, g0[1] * sigm(g0[1]) * u0[1] * w); o.y = cvt_pk_bf16(g0[2] * sigm(g0[2]) * u0[2] * w, g0[3] * sigm(g0[3]) * u0[3] * w);
                o.z = cvt_pk_bf16(g1[0] * sigm(g1[0]) * u1[0] * w, g1[1] * sigm(g1[1]) * u1[1] * w); o.w = cvt_pk_bf16(g1[2] * sigm(g1[2]) * u1[2] * w, g1[3] * sigm(g1[3]) * u1[3] * w);
                *(u32x4*)rowp = o;
            }
    }
};
struct EpiDown {
    static constexpr bool PERM = true, AFTER_DRAIN = false;
    bf16_t* P1; long d12; const unsigned* list; int cap;
    __device__ __forceinline__ void operator()(const f32x4 (&acc)[2][2][4][2], const Unit& u, int wr, int wc, int fr, int fq) const {
        const int rl0 = wr * 64 + fr, col0 = u.pn * BM + wc * 32 + 8 * fq;
#pragma unroll
        for (int ai = 0; ai < 2; ++ai) {
            unsigned ent[4];
#pragma unroll
            for (int m = 0; m < 4; ++m) { const int pos = u.p0 + rl0 + ai * HALF + m * 16; ent[m] = pos < u.cnt ? list[(size_t)u.eb * cap + pos] : 0xffffffffu; }
#pragma unroll
            for (int m = 0; m < 4; ++m) {
                if (ent[m] != 0xffffffffu) {
                    bf16_t* dst = P1 + (long)(ent[m] & 1u) * d12 + (size_t)(ent[m] >> 1) * 1024 + col0;
#pragma unroll
                    for (int bj = 0; bj < 2; ++bj) { const f32x4 v0 = acc[ai][bj][m][0], v1 = acc[ai][bj][m][1];
                        u32x4 w; w.x = cvt_pk_bf16(v0[0], v0[1]); w.y = cvt_pk_bf16(v0[2], v0[3]); w.z = cvt_pk_bf16(v1[0], v1[1]); w.w = cvt_pk_bf16(v1[2], v1[3]);
                        *(u32x4*)(dst + bj * HALF) = w; }
                }
            }
            asm volatile("" ::: "memory");
        }
    }
};

struct BatchOrder {
    int nb, nM, nN, G, c;
    __device__ __forceinline__ bool next(int i, Unit& u) const {
        const long L = (long)i * G + c; if (L >= (long)nb * nM * nN) return false;
        const int per = nM * nN, e = (int)L / per, rem = (int)L % per;
        u.eb = e; u.pm = rem / nN; u.pn = rem % nN; u.p0 = 0; u.cnt = 0; return true;
    }
    __device__ __forceinline__ void a_ready(const Unit&) const {}
    __device__ __forceinline__ void done(const Unit&) const {}
};
struct EpiInProj {
    static constexpr bool PERM = true, AFTER_DRAIN = false;
    bf16_t* Zo; bf16_t* U;
    __device__ __forceinline__ void operator()(const f32x4 (&acc)[2][2][4][2], const Unit& u, int wr, int wc, int fr, int fq) const {
        const int row0 = u.pm * BM + wr * 64 + fr;
#pragma unroll
        for (int ai = 0; ai < 2; ++ai)
#pragma unroll
            for (int m = 0; m < 4; ++m) { const int row = row0 + ai * HALF + m * 16;
#pragma unroll
                for (int bj = 0; bj < 2; ++bj) { const int c0 = u.pn * BM + bj * HALF + wc * 32 + 8 * fq;
                    const f32x4 v0 = acc[ai][bj][m][0], v1 = acc[ai][bj][m][1];
                    u32x4 w; w.x = cvt_pk_bf16(v0[0], v0[1]); w.y = cvt_pk_bf16(v0[2], v0[3]); w.z = cvt_pk_bf16(v1[0], v1[1]); w.w = cvt_pk_bf16(v1[2], v1[3]);
                    bf16_t* dst = u.pn < 2 ? U + ((size_t)((c0 >> 4) * 2048 + (row >> 4)) * 512 + (row & 15) * 16 + (c0 & 15)) : Zo + (size_t)row * 2048 + c0;
                    *(u32x4*)dst = w; } }
    }
};
struct EpiXloc {
    static constexpr bool PERM = false, AFTER_DRAIN = false;
    float* XL;
    __device__ __forceinline__ void operator()(const f32x4 (&acc)[2][2][4][2], const Unit& u, int wr, int wc, int fr, int fq) const {
        const int row0 = u.pm * BM + wr * 64 + fr, col0 = wc * 32 + 4 * fq;
#pragma unroll
        for (int ai = 0; ai < 2; ++ai)
#pragma unroll
            for (int m = 0; m < 4; ++m) { float* rowp = XL + ((size_t)u.eb * 2048 + row0 + ai * HALF + m * 16) * 128 + col0;
#pragma unroll
                for (int n = 0; n < 2; ++n) *(f32x4*)(rowp + n * 16) = acc[ai][0][m][n]; }
    }
};
__device__ __forceinline__ float gelu_t(float x) { const float u2 = -2.302208198f * (x + 0.044715f * x * x * x); return x * __builtin_amdgcn_rcpf(1.0f + __builtin_amdgcn_exp2f(u2)); }
struct EpiSsmOut {
    static constexpr bool PERM = true, AFTER_DRAIN = false;
    bf16_t* G;
    __device__ __forceinline__ void operator()(const f32x4 (&acc)[2][2][4][2], const Unit& u, int wr, int wc, int fr, int fq) const {
        const int row0 = u.pm * BM + wr * 64 + fr;
#pragma unroll
        for (int ai = 0; ai < 2; ++ai)
#pragma unroll
            for (int m = 0; m < 4; ++m) { const int row = row0 + ai * HALF + m * 16;
#pragma unroll
                for (int bj = 0; bj < 2; ++bj) { const int n0 = bj * HALF + wc * 32 + 8 * fq;
                    const f32x4 v0 = acc[ai][bj][m][0], v1 = acc[ai][bj][m][1];
                    u32x4 w; w.x = cvt_pk_bf16(gelu_t(v0[0]), gelu_t(v0[1])); w.y = cvt_pk_bf16(gelu_t(v0[2]), gelu_t(v0[3])); w.z = cvt_pk_bf16(gelu_t(v1[0]), gelu_t(v1[1])); w.w = cvt_pk_bf16(gelu_t(v1[2]), gelu_t(v1[3]));
                    *(u32x4*)(G + ((size_t)row * 16 + (n0 >> 4)) * 512 + u.eb * 16 + (n0 & 15)) = w; } }
    }
};

struct CmpOrder {
    int G, c;
    __device__ __forceinline__ bool next(int i, Unit& u) const { const int L = i * G + c; if (L >= 32) return false; u.eb = L >> 4; u.pm = L & 15; u.pn = 0; u.p0 = 0; u.cnt = 0; return true; }
    __device__ __forceinline__ void a_ready(const Unit&) const {}
    __device__ __forceinline__ void done(const Unit&) const {}
};
struct EpiCmpHid {
    static constexpr bool PERM = false, AFTER_DRAIN = false;
    bf16_t* HC; const float* bias;
    __device__ __forceinline__ void operator()(const f32x4 (&acc)[2][2][4][2], const Unit& u, int wr, int wc, int fr, int fq) const {
        if (wc < 2) {
            const int row0 = u.pm * BM + wr * 64 + fr, col0 = wc * 32 + 4 * fq;
#pragma unroll
            for (int n = 0; n < 2; ++n) { const f32x4 bv = *(const f32x4*)(bias + u.eb * 64 + col0 + n * 16);
#pragma unroll
                for (int ai = 0; ai < 2; ++ai)
#pragma unroll
                    for (int m = 0; m < 4; ++m) { const f32x4 v = acc[ai][0][m][n] + bv;
                        typedef unsigned u32x2_ __attribute__((ext_vector_type(2)));
                        u32x2_ w; w.x = cvt_pk_bf16(gelu_t(v[0]), gelu_t(v[1])); w.y = cvt_pk_bf16(gelu_t(v[2]), gelu_t(v[3]));
                        *(u32x2_*)(HC + ((size_t)u.eb * 4096 + row0 + ai * HALF + m * 16) * 64 + col0 + n * 16) = w; } }
        }
    }
};

struct SingleUnit {
    int eb, pm;
    __device__ __forceinline__ bool next(int i, Unit& u) const { if (i > 0) return false; u.eb = eb; u.pm = pm; u.pn = 0; u.p0 = 0; u.cnt = 0; return true; }
    __device__ __forceinline__ void a_ready(const Unit&) const {}
    __device__ __forceinline__ void done(const Unit&) const {}
};
}

struct Args { const float* in[26]; float* out; unsigned char* ws; int ph_lo, ph_hi; };

struct Frame {
    LAS unsigned char* lds;
    int tid, lane, wave, blk, G;
};

__device__ __forceinline__ f32x4 bf4(u32x2 p) { f32x4 r; r.x = __uint_as_float(p.x << 16); r.y = __uint_as_float(p.x & 0xffff0000u); r.z = __uint_as_float(p.y << 16); r.w = __uint_as_float(p.y & 0xffff0000u); return r; }
__device__ __forceinline__ void ph_norm(const Frame& F, const float* xin, const bf16* add, const bf16* add2, float* xout, const float* g, bf16* hn) {
    const int gw = F.blk * NWAVES + F.wave, NGW = F.G * NWAVES;
    f32x4 gg[4];
#pragma unroll
    for (int j = 0; j < 4; ++j) gg[j] = ((const f32x4*)g)[F.lane + 64 * j];
    f32x4 nv[4]; u32x2 na[4], nb[4];
    if (gw < T) {
#pragma unroll
        for (int j = 0; j < 4; ++j) { nv[j] = ((const f32x4*)(xin + (size_t)gw * DM))[F.lane + 64 * j];
            if (add) { na[j] = ((const u32x2*)(add + (size_t)gw * DM))[F.lane + 64 * j]; nb[j] = ((const u32x2*)(add2 + (size_t)gw * DM))[F.lane + 64 * j]; } }
    }
    for (int row = gw; row < T; row += NGW) {
        f32x4 v[4]; float s = 0.f;
#pragma unroll
        for (int j = 0; j < 4; ++j) { v[j] = nv[j]; if (add) v[j] += bf4(na[j]) + bf4(nb[j]); }
        const int nrow = row + NGW;
        if (nrow < T) {
#pragma unroll
            for (int j = 0; j < 4; ++j) { nv[j] = ((const f32x4*)(xin + (size_t)nrow * DM))[F.lane + 64 * j];
                if (add) { na[j] = ((const u32x2*)(add + (size_t)nrow * DM))[F.lane + 64 * j]; nb[j] = ((const u32x2*)(add2 + (size_t)nrow * DM))[F.lane + 64 * j]; } }
        }
#pragma unroll
        for (int j = 0; j < 4; ++j) { if (add) ((f32x4*)(xout + (size_t)row * DM))[F.lane + 64 * j] = v[j];
            s += v[j].x * v[j].x + v[j].y * v[j].y + v[j].z * v[j].z + v[j].w * v[j].w; }
        s = wave_sum(s, F.lane);
        const float r = rsqrtf(s * (1.0f / DM) + EPS);
#pragma unroll
        for (int j = 0; j < 4; ++j) {
            u32x2 o; o.x = pk2(v[j].x * r * gg[j].x, v[j].y * r * gg[j].y); o.y = pk2(v[j].z * r * gg[j].z, v[j].w * r * gg[j].w);
            *(u32x2*)(hn + (size_t)row * DM + (F.lane + 64 * j) * 4) = o;
        }
    }
}
__device__ __forceinline__ void ph_final_norm(const Frame& F, float* x, const bf16* add, const bf16* add2, const float* g) {
    const int gw = F.blk * NWAVES + F.wave, NGW = F.G * NWAVES;
    f32x4 gg[4];
#pragma unroll
    for (int j = 0; j < 4; ++j) gg[j] = ((const f32x4*)g)[F.lane + 64 * j];
    f32x4 nv[4]; u32x2 na[4], nb[4];
    if (gw < T) {
#pragma unroll
        for (int j = 0; j < 4; ++j) { nv[j] = ((const f32x4*)(x + (size_t)gw * DM))[F.lane + 64 * j]; na[j] = ((const u32x2*)(add + (size_t)gw * DM))[F.lane + 64 * j]; nb[j] = ((const u32x2*)(add2 + (size_t)gw * DM))[F.lane + 64 * j]; }
    }
    for (int row = gw; row < T; row += NGW) {
        f32x4 v[4]; float s = 0.f;
#pragma unroll
        for (int j = 0; j < 4; ++j) { v[j] = nv[j] + bf4(na[j]) + bf4(nb[j]); s += v[j].x * v[j].x + v[j].y * v[j].y + v[j].z * v[j].z + v[j].w * v[j].w; }
        const int nrow = row + NGW;
        if (nrow < T) {
#pragma unroll
            for (int j = 0; j < 4; ++j) { nv[j] = ((const f32x4*)(x + (size_t)nrow * DM))[F.lane + 64 * j]; na[j] = ((const u32x2*)(add + (size_t)nrow * DM))[F.lane + 64 * j]; nb[j] = ((const u32x2*)(add2 + (size_t)nrow * DM))[F.lane + 64 * j]; }
        }
        s = wave_sum(s, F.lane);
        const float r = rsqrtf(s * (1.0f / DM) + EPS);
#pragma unroll
        for (int j = 0; j < 4; ++j) {
            f32x4 o; o.x = v[j].x * r * gg[j].x; o.y = v[j].y * r * gg[j].y; o.z = v[j].z * r * gg[j].z; o.w = v[j].w * r * gg[j].w;
            ((f32x4*)(x + (size_t)row * DM))[F.lane + 64 * j] = o;
        }
    }
}

template <bool DUAL, class Epi>
__device__ __forceinline__ void sgemm_naive(const Frame& F, const bf16* A, int lda, const float* B, int ldb, int M, int N, int K, int dualoff, const Epi& epi) {
    LAS float* As = (LAS float*)F.lds;
    LAS float* Bs = As + 16 * 132;
    LAS float* Bs2 = Bs + 16 * 128;
    const int tiles_n = (N + 127) / 128, tiles_m = M / 128;
    const int tx = F.tid & 31, ty = F.tid >> 5;
    for (int tile = F.blk; tile < tiles_m * tiles_n; tile += F.G) {
        const int tm = tile / tiles_n, tn = tile % tiles_n;
        float acc[8][4], acc2[8][4];
#pragma unroll
        for (int i = 0; i < 8; ++i)
#pragma unroll
            for (int j = 0; j < 4; ++j) { acc[i][j] = 0.f; acc2[i][j] = 0.f; }
        const int arow = F.tid >> 2, akq = (F.tid & 3) * 4;
        const int bk = F.tid >> 5, bn = (F.tid & 31) * 4;
        for (int k0 = 0; k0 < K; k0 += 16) {
            {
                const u32x2 av = *(const u32x2*)(A + (size_t)(tm * 128 + arow) * lda + k0 + akq);
                As[(akq + 0) * 132 + arow] = __uint_as_float(av.x << 16);
                As[(akq + 1) * 132 + arow] = __uint_as_float(av.x & 0xffff0000u);
                As[(akq + 2) * 132 + arow] = __uint_as_float(av.y << 16);
                As[(akq + 3) * 132 + arow] = __uint_as_float(av.y & 0xffff0000u);
                const int col = tn * 128 + bn;
                f32x4 bv = (f32x4){0.f, 0.f, 0.f, 0.f};
                const float* bp = B + (size_t)(k0 + bk) * ldb + col;
                if (col + 3 < N) { bv.x = bp[0]; bv.y = bp[1]; bv.z = bp[2]; bv.w = bp[3]; }
                else { if (col < N) bv.x = bp[0]; if (col + 1 < N) bv.y = bp[1]; if (col + 2 < N) bv.z = bp[2]; }
                *(LAS f32x4*)(Bs + bk * 128 + bn) = bv;
                if (DUAL) {
                    const float* bp2 = bp + dualoff;
                    f32x4 bw; bw.x = bp2[0]; bw.y = bp2[1]; bw.z = bp2[2]; bw.w = bp2[3];
                    *(LAS f32x4*)(Bs2 + bk * 128 + bn) = bw;
                }
            }
            __syncthreads();
#pragma unroll 4
            for (int k = 0; k < 16; ++k) {
                float a[8];
                const f32x4 a0 = *(const LAS f32x4*)(As + k * 132 + ty * 8), a1 = *(const LAS f32x4*)(As + k * 132 + ty * 8 + 4);
                a[0] = a0.x; a[1] = a0.y; a[2] = a0.z; a[3] = a0.w; a[4] = a1.x; a[5] = a1.y; a[6] = a1.z; a[7] = a1.w;
                const f32x4 b = *(const LAS f32x4*)(Bs + k * 128 + tx * 4);
#pragma unroll
                for (int i = 0; i < 8; ++i) { acc[i][0] += a[i] * b.x; acc[i][1] += a[i] * b.y; acc[i][2] += a[i] * b.z; acc[i][3] += a[i] * b.w; }
                if (DUAL) {
                    const f32x4 b2 = *(const LAS f32x4*)(Bs2 + k * 128 + tx * 4);
#pragma unroll
                    for (int i = 0; i < 8; ++i) { acc2[i][0] += a[i] * b2.x; acc2[i][1] += a[i] * b2.y; acc2[i][2] += a[i] * b2.z; acc2[i][3] += a[i] * b2.w; }
                }
            }
            __syncthreads();
        }
#pragma unroll
        for (int i = 0; i < 8; ++i)
#pragma unroll
            for (int j = 0; j < 4; ++j) {
                const int row = tm * 128 + ty * 8 + i, col = tn * 128 + tx * 4 + j;
                if (col < N) epi(row, col, acc[i][j], acc2[i][j]);
            }
    }
}
struct EpiStoreBf16 { bf16* O; int ldo; __device__ __forceinline__ void operator()(int r, int c, float a, float) const { O[(size_t)r * ldo + c] = (bf16)f2bf(a); } };
struct EpiGlu { bf16* O; int ldo; __device__ __forceinline__ void operator()(int r, int c, float a, float b) const { O[(size_t)r * ldo + c] = (bf16)f2bf(a * sigmoidf_(b)); } };
struct EpiResid { const float* X; float* O; __device__ __forceinline__ void operator()(int r, int c, float a, float) const { O[(size_t)r * DM + c] = X[(size_t)r * DM + c] + a; } };

__device__ __forceinline__ void ssm_naive_item(int b, int g, const float* a_re, const float* a_im, const float* b_re, const float* b_im, const float* c_re, const float* c_im,
                                               const float* dpar, const float* log_dt, const bf16* Z, bf16* G1, int lane) {
    const int p = lane;
    const float are = a_re[g * 64 + p], aim = a_im[g * 64 + p], dt = expf(log_dt[g]);
    const float er = expf(are * dt), lbr = er * cosf(aim * dt), lbi = er * sinf(aim * dt);
    const float xx = lbr - 1.0f, yy = lbi, den = are * are + aim * aim;
    const float fr = (xx * are + yy * aim) / den, fi = (yy * are - xx * aim) / den;
    float bbr[16], bbi[16], cr[16], ci[16];
#pragma unroll
    for (int h = 0; h < 16; ++h) {
        const float br = b_re[(g * 64 + p) * 16 + h], bi = b_im[(g * 64 + p) * 16 + h];
        bbr[h] = fr * br - fi * bi; bbi[h] = fr * bi + fi * br;
        cr[h] = c_re[(g * 16 + h) * 64 + p]; ci[h] = c_im[(g * 16 + h) * 64 + p];
    }
    const float dd = dpar[g * 16 + (lane & 15)];
    float xr = 0.f, xi = 0.f;
    for (int t = 0; t < SEQ; ++t) {
        const size_t row = (size_t)b * SEQ + t;
        const u32x4 u0 = *(const u32x4*)(Z + row * ZP + ZC_U + g * 16), u1 = *(const u32x4*)(Z + row * ZP + ZC_U + g * 16 + 8);
        float u[16];
        u[0] = __uint_as_float(u0.x << 16); u[1] = __uint_as_float(u0.x & 0xffff0000u); u[2] = __uint_as_float(u0.y << 16); u[3] = __uint_as_float(u0.y & 0xffff0000u);
        u[4] = __uint_as_float(u0.z << 16); u[5] = __uint_as_float(u0.z & 0xffff0000u); u[6] = __uint_as_float(u0.w << 16); u[7] = __uint_as_float(u0.w & 0xffff0000u);
        u[8] = __uint_as_float(u1.x << 16); u[9] = __uint_as_float(u1.x & 0xffff0000u); u[10] = __uint_as_float(u1.y << 16); u[11] = __uint_as_float(u1.y & 0xffff0000u);
        u[12] = __uint_as_float(u1.z << 16); u[13] = __uint_as_float(u1.z & 0xffff0000u); u[14] = __uint_as_float(u1.w << 16); u[15] = __uint_as_float(u1.w & 0xffff0000u);
        float bur = 0.f, bui = 0.f;
#pragma unroll
        for (int h = 0; h < 16; ++h) { bur += bbr[h] * u[h]; bui += bbi[h] * u[h]; }
        const float nxr = lbr * xr - lbi * xi + bur, nxi = lbr * xi + lbi * xr + bui;
        xr = nxr; xi = nxi;
        float y = 0.f;
#pragma unroll
        for (int h = 0; h < 16; ++h) { const float v = wave_sum(cr[h] * xr - ci[h] * xi, lane); if (lane == h) y = v; }
        if (lane < 16) {
            const float ul = bf2f(Z[row * ZP + ZC_U + g * 16 + lane]);
            G1[row * D_SSM + g * 16 + lane] = (bf16)f2bf(gelu_tanh(y + dd * ul));
        }
    }
}
__device__ __forceinline__ void compress_naive_item(int item, const bf16* Z, const float* pos, const float* w1, const float* w2, bf16* KC, bf16* VC, int lane) {
    const int i = item & 1, hkv = (item >> 1) & 1, n = (item >> 2) % NCMPP, b = (item >> 2) / NCMPP;
    bf16* dst = i ? VC : KC;
    if (n == NCMP) { dst[(((size_t)b * NCMPP + n) * 2 + hkv) * 64 + lane] = 0; return; }
    const float* posi = pos + i * 32 * 64; const float* w1i = w1 + (size_t)i * 32 * 64 * 64; const float* w2i = w2 + i * 64 * 64;
    float acc = 0.f;
    for (int l = 0; l < 32; ++l) {
        const bf16* zr = Z + ((size_t)b * SEQ + 16 * n + l) * ZP + ZC_KV + i * 128 + hkv * 64;
        for (int d = 0; d < 64; ++d) acc += (bf2f(zr[d]) + posi[l * 64 + d]) * w1i[(l * 64 + d) * 64 + lane];
    }
    const float hid = gelu_tanh(acc);
    float o = 0.f;
    for (int e = 0; e < 64; ++e) o += lane_bcast(hid, e) * w2i[e * 64 + lane];
    dst[(((size_t)b * NCMPP + n) * 2 + hkv) * 64 + lane] = (bf16)f2bf(o);
}

__device__ __forceinline__ void attn_chunk(LAS float* wl, const bf16* Z, const float* rel_bias, int b, int hkv, int t, int base, int kcol, int vcol, int lane,
                                           float (&m)[4], float (&l)[4], float (&o)[4]) {
    const int pos = base + lane; const bool valid = (pos >= 0) && (pos <= t);
    const int posc = pos < 0 ? 0 : (pos > SEQ - 1 ? SEQ - 1 : pos);
    const bf16* kr = Z + ((size_t)b * SEQ + posc) * ZP + kcol + hkv * 64;
    float s[4] = {0.f, 0.f, 0.f, 0.f};
#pragma unroll 2
    for (int c = 0; c < 8; ++c) {
        const u32x4 kv = *(const u32x4*)(kr + c * 8);
        float k[8];
        k[0] = __uint_as_float(kv.x << 16); k[1] = __uint_as_float(kv.x & 0xffff0000u); k[2] = __uint_as_float(kv.y << 16); k[3] = __uint_as_float(kv.y & 0xffff0000u);
        k[4] = __uint_as_float(kv.z << 16); k[5] = __uint_as_float(kv.z & 0xffff0000u); k[6] = __uint_as_float(kv.w << 16); k[7] = __uint_as_float(kv.w & 0xffff0000u);
#pragma unroll
        for (int g = 0; g < 4; ++g) {
            const f32x4 q0 = *(const LAS f32x4*)(wl + g * 64 + c * 8), q1 = *(const LAS f32x4*)(wl + g * 64 + c * 8 + 4);
            s[g] += q0.x * k[0] + q0.y * k[1] + q0.z * k[2] + q0.w * k[3] + q1.x * k[4] + q1.y * k[5] + q1.z * k[6] + q1.w * k[7];
        }
    }
    const int bk = t5_bucket(t - pos);
#pragma unroll
    for (int g = 0; g < 4; ++g) {
        const float sv = valid ? s[g] + rel_bias[bk * 8 + hkv * 4 + g] : -1e30f;
        const float mn = fmaxf(m[g], wave_max(sv, lane));
        const float alpha = __expf(m[g] - mn);
        const float p = valid ? __expf(sv - mn) : 0.f;
        l[g] = l[g] * alpha + wave_sum(p, lane);
        o[g] *= alpha; m[g] = mn;
        wl[256 + g * 64 + lane] = p;
    }
#pragma unroll 4
    for (int key = 0; key < 64; ++key) {
        int pk = base + key; pk = pk < 0 ? 0 : (pk > SEQ - 1 ? SEQ - 1 : pk);
        const float v = bf2f(Z[((size_t)b * SEQ + pk) * ZP + vcol + hkv * 64 + lane]);
#pragma unroll
        for (int g = 0; g < 4; ++g) o[g] += wl[256 + g * 64 + key] * v;
    }
}
__device__ __forceinline__ void attn_naive_item(LAS float* wl, int b, int hkv, int t, const bf16* Z, const float* KC, const float* VC, const float* rel_bias, bf16* YC, int lane) {
    const size_t row = (size_t)b * SEQ + t;
#pragma unroll
    for (int g = 0; g < 4; ++g) wl[g * 64 + lane] = bf2f(Z[row * ZP + ZC_Q + hkv * 256 + g * 64 + lane]) * 0.125f;
#pragma unroll 1
    for (int c = 0; c < 4; ++c) {
        const int n = c * 64 + lane; const bool valid = (n < NCMP) && (16 * n + 31 <= t);
        const float* kr = KC + (((size_t)b * NCMPP + (n < NCMP ? n : 0)) * 2 + hkv) * 64;
        float s[4] = {0.f, 0.f, 0.f, 0.f};
#pragma unroll 4
        for (int d4 = 0; d4 < 16; ++d4) {
            const f32x4 k = *(const f32x4*)(kr + d4 * 4);
#pragma unroll
            for (int g = 0; g < 4; ++g) { const f32x4 q = *(const LAS f32x4*)(wl + g * 64 + d4 * 4); s[g] += q.x * k.x + q.y * k.y + q.z * k.z + q.w * k.w; }
        }
        const int bk = t5_bucket(t - (16 * n + 31));
#pragma unroll
        for (int g = 0; g < 4; ++g) wl[256 + g * 256 + n] = valid ? s[g] + rel_bias[bk * 8 + hkv * 4 + g] : -1e30f;
    }
#pragma unroll
    for (int g = 0; g < 4; ++g) {
        float sc[4];
#pragma unroll
        for (int c = 0; c < 4; ++c) sc[c] = wl[256 + g * 256 + c * 64 + lane];
        const float mx = wave_max(fmaxf(fmaxf(sc[0], sc[1]), fmaxf(sc[2], sc[3])), lane);
        float e[4], ls = 0.f;
#pragma unroll
        for (int c = 0; c < 4; ++c) { e[c] = sc[c] > -1e29f ? __expf(sc[c] - mx) : 0.f; ls += e[c]; }
        ls = wave_sum(ls, lane);
        const float inv = ls > 0.f ? 1.0f / ls : 0.f;
#pragma unroll
        for (int c = 0; c < 4; ++c) wl[256 + g * 256 + c * 64 + lane] = e[c] * inv;
    }
    float oc[4] = {0.f, 0.f, 0.f, 0.f};
    const int nmax = t >= 31 ? ((t - 31) / 16 + 1 < NCMP ? (t - 31) / 16 + 1 : NCMP) : 0;
#pragma unroll 4
    for (int n = 0; n < nmax; ++n) {
        const float v = VC[(((size_t)b * NCMPP + n) * 2 + hkv) * 64 + lane];
#pragma unroll
        for (int g = 0; g < 4; ++g) oc[g] += wl[256 + g * 256 + n] * v;
    }
    float imp = 0.f;
#pragma unroll
    for (int g = 0; g < 4; ++g) {
        const LAS float* P = wl + 256 + g * 256;
        imp += P[4 * lane] + P[4 * lane + 1] + P[4 * lane + 2] + 0.5f * P[4 * lane + 3] + (lane > 0 ? 0.5f * P[4 * lane - 1] : 0.f);
    }
    const int blk = t >> 6;
    const bool forced = (lane == 0) || (lane <= blk && lane > blk - 2), future = lane > blk;
    const float v = forced ? 1e9f : (future ? -1e9f : imp);
    int rank = 0;
    for (int jj = 0; jj < 64; ++jj) { const float vj = lane_bcast(v, jj); rank += (vj > v) || (vj == v && jj < lane); }
    unsigned long long mask = __ballot(rank < 16 && !future);
    float m[4], l[4], o[4];
#pragma unroll
    for (int g = 0; g < 4; ++g) { m[g] = -1e30f; l[g] = 0.f; o[g] = 0.f; }
    while (mask) {
        const int j = __builtin_ctzll(mask); mask &= mask - 1;
        attn_chunk(wl, Z, rel_bias, b, hkv, t, 64 * j, ZC_KV + 256, ZC_KV + 384, lane, m, l, o);
    }
    float os[4];
#pragma unroll
    for (int g = 0; g < 4; ++g) { os[g] = l[g] > 0.f ? o[g] / l[g] : 0.f; m[g] = -1e30f; l[g] = 0.f; o[g] = 0.f; }
    for (int c = 0; c < 8; ++c) attn_chunk(wl, Z, rel_bias, b, hkv, t, t - 511 + 64 * c, ZC_KV + 512, ZC_KV + 640, lane, m, l, o);
#pragma unroll
    for (int g = 0; g < 4; ++g) {
        const float ow = l[g] > 0.f ? o[g] / l[g] : 0.f;
        const bf16* gp = Z + row * ZP + ZC_G + hkv * 12 + g * 3;
        const float r = sigmoidf_(bf2f(gp[0])) * oc[g] + sigmoidf_(bf2f(gp[1])) * os[g] + sigmoidf_(bf2f(gp[2])) * ow;
        YC[row * DM + D_SSM + hkv * 256 + g * 64 + lane] = (bf16)f2bf(r);
    }
}

__device__ __forceinline__ void ph_norm_route(const Frame& F, const float* x, const float* g, const float* rgw, const float* rgb, const float* rew, const float* reb, bf16* hn,
                                              unsigned* gcnt, unsigned* list, float* listw) {
    LAS f32x4* RG = (LAS f32x4*)F.lds; LAS f32x4* RE = RG + 1024;
    LAS unsigned* cnt_l = (LAS unsigned*)(F.lds + 147456); LAS unsigned* base_l = cnt_l + 32; LAS unsigned* ent = cnt_l + 64;
    for (int d = F.tid; d < 1024; d += NTHR) { const int ln = d & 63, jc = d >> 6, row = (ln + 64 * (jc >> 2)) * 4 + (jc & 3); RG[d] = ((const f32x4*)rgw)[row]; }
    { f32x4 t[16];
#pragma unroll
      for (int k = 0; k < 16; ++k) { const int d = F.tid + k * NTHR, ln = d & 63, q = d >> 6, half = q & 1, c = (q >> 1) & 3, j = (q >> 3) & 3, gi = q >> 5, row = (ln + 64 * j) * 4 + c;
          t[k] = ((const f32x4*)rew)[((size_t)gi * DM + row) * 2 + half]; }
#pragma unroll
      for (int k = 0; k < 16; ++k) RE[F.tid + k * NTHR] = t[k]; }
    __syncthreads();
    for (int row0 = F.blk * 128; row0 < T; row0 += F.G * 128) {
        if (F.tid < 32) cnt_l[F.tid] = 0u;
        __syncthreads();
        f32x4 nv[4];
#pragma unroll
        for (int j = 0; j < 4; ++j) nv[j] = ((const f32x4*)(x + (size_t)(row0 + F.wave * 16) * DM))[F.lane + 64 * j];
        for (int kk = 0; kk < 16; ++kk) {
            const int row = row0 + F.wave * 16 + kk;
            f32x4 v[4]; float s = 0.f;
#pragma unroll
            for (int j = 0; j < 4; ++j) { v[j] = nv[j]; s += v[j].x * v[j].x + v[j].y * v[j].y + v[j].z * v[j].z + v[j].w * v[j].w; }
            if (kk < 15) {
#pragma unroll
                for (int j = 0; j < 4; ++j) nv[j] = ((const f32x4*)(x + (size_t)(row + 1) * DM))[F.lane + 64 * j]; }
            s = wave_sum(s, F.lane);
            const float r = rsqrtf(s * (1.0f / DM) + EPS);
            float lg[4] = {0.f, 0.f, 0.f, 0.f};
#pragma unroll
            for (int j = 0; j < 4; ++j) {
                const f32x4 gg = ((const f32x4*)g)[F.lane + 64 * j];
                v[j].x = v[j].x * r * gg.x; v[j].y = v[j].y * r * gg.y; v[j].z = v[j].z * r * gg.z; v[j].w = v[j].w * r * gg.w;
                u32x2 o; o.x = pk2(v[j].x, v[j].y); o.y = pk2(v[j].z, v[j].w);
                *(u32x2*)(hn + (size_t)row * DM + (F.lane + 64 * j) * 4) = o;
                const f32x4 w0 = RG[(j * 4 + 0) * 64 + F.lane], w1 = RG[(j * 4 + 1) * 64 + F.lane], w2 = RG[(j * 4 + 2) * 64 + F.lane], w3 = RG[(j * 4 + 3) * 64 + F.lane];
                lg[0] += v[j].x * w0.x + v[j].y * w1.x + v[j].z * w2.x + v[j].w * w3.x;
                lg[1] += v[j].x * w0.y + v[j].y * w1.y + v[j].z * w2.y + v[j].w * w3.y;
                lg[2] += v[j].x * w0.z + v[j].y * w1.z + v[j].z * w2.z + v[j].w * w3.z;
                lg[3] += v[j].x * w0.w + v[j].y * w1.w + v[j].z * w2.w + v[j].w * w3.w;
            }
#pragma unroll
            for (int o = 0; o < 4; ++o) lg[o] = wave_sum(lg[o], F.lane) + rgb[o];
            int gi = 0; float gm = lg[0];
#pragma unroll
            for (int o = 1; o < 4; ++o) if (lg[o] > gm) { gm = lg[o]; gi = o; }
            float gs = 0.f;
#pragma unroll
            for (int o = 0; o < 4; ++o) gs += __expf(lg[o] - gm);
            const float gval = 1.0f / gs;
            const LAS f32x4* we = RE + gi * 2048;
            float le[8] = {0.f, 0.f, 0.f, 0.f, 0.f, 0.f, 0.f, 0.f};
#pragma unroll
            for (int j = 0; j < 4; ++j) {
                const float hv[4] = {v[j].x, v[j].y, v[j].z, v[j].w};
#pragma unroll
                for (int c = 0; c < 4; ++c) {
                    const f32x4 wa = we[((j * 4 + c) * 2 + 0) * 64 + F.lane], wb = we[((j * 4 + c) * 2 + 1) * 64 + F.lane];
                    le[0] += hv[c] * wa.x; le[1] += hv[c] * wa.y; le[2] += hv[c] * wa.z; le[3] += hv[c] * wa.w;
                    le[4] += hv[c] * wb.x; le[5] += hv[c] * wb.y; le[6] += hv[c] * wb.z; le[7] += hv[c] * wb.w;
                }
            }
#pragma unroll
            for (int e = 0; e < 8; ++e) le[e] = wave_sum(le[e], F.lane) + reb[gi * 8 + e];
            int e1 = 0; float m1 = le[0];
#pragma unroll
            for (int e = 1; e < 8; ++e) if (le[e] > m1) { m1 = le[e]; e1 = e; }
            int e2 = -1; float m2 = -3.0e38f;
#pragma unroll
            for (int e = 0; e < 8; ++e) if (e != e1 && le[e] > m2) { m2 = le[e]; e2 = e; }
            const float p2 = __expf(m2 - m1), inv = 1.0f / (1.0f + p2);
            if (F.lane == 0) {
                const unsigned ea = (unsigned)(gi * 8 + e1), eb = (unsigned)(gi * 8 + e2);
                const unsigned pa = __hip_atomic_fetch_add(cnt_l + ea, 1u, __ATOMIC_RELAXED, __HIP_MEMORY_SCOPE_WORKGROUP);
                const unsigned pb = __hip_atomic_fetch_add(cnt_l + eb, 1u, __ATOMIC_RELAXED, __HIP_MEMORY_SCOPE_WORKGROUP);
                LAS unsigned* en = ent + (F.wave * 16 + kk) * 6;
                en[0] = ea; en[1] = eb; en[2] = pa; en[3] = pb; en[4] = __float_as_uint(gval * inv); en[5] = __float_as_uint(gval * p2 * inv);
            }
        }
        __syncthreads();
        if (F.tid < 32) base_l[F.tid] = __hip_atomic_fetch_add(gcnt + F.tid * 64, cnt_l[F.tid], __ATOMIC_RELAXED, __HIP_MEMORY_SCOPE_AGENT);
        __syncthreads();
        if (F.tid < 128) {
            const LAS unsigned* en = ent + F.tid * 6; const unsigned tok = (unsigned)(row0 + F.tid);
            const unsigned ia = en[0] * LCAP + base_l[en[0]] + en[2], ib = en[1] * LCAP + base_l[en[1]] + en[3];
            list[ia] = tok * 2u; listw[ia] = __uint_as_float(en[4]);
            list[ib] = tok * 2u + 1u; listw[ib] = __uint_as_float(en[5]);
        }
        __syncthreads();
    }
}
__device__ __forceinline__ void build_expert_tab(const Frame& F, const unsigned* gcnt, LAS int* tab) {
    if (F.tid < 64) {
        const int c = F.lane < 32 ? (int)__hip_atomic_load(gcnt + F.lane * 64, __ATOMIC_RELAXED, __HIP_MEMORY_SCOPE_AGENT) : 0;
        int tiles = (c + 255) >> 8, incl = tiles;
#pragma unroll
        for (int o = 1; o < 32; o <<= 1) { const int t = __builtin_amdgcn_ds_bpermute((F.lane - o) << 2, incl); if (F.lane >= o) incl += t; }
        if (F.lane < 32) { tab[F.lane + 1] = incl; tab[33 + F.lane] = c; }
        if (F.lane == 0) tab[0] = 0;
    }
    __syncthreads();
}
__device__ __forceinline__ void ph_experts_naive(const Frame& F, const bf16* hn, const unsigned* route, const float* wg, const float* wu, const float* wd, float* x) {
    LAS float* hs = (LAS float*)F.lds;
    LAS float* hd = hs + 1024;
    for (int tok = F.blk; tok < T; tok += F.G) {
        { const unsigned pv = *(const unsigned*)(hn + (size_t)tok * DM + F.tid * 2); hs[F.tid * 2] = __uint_as_float(pv << 16); hs[F.tid * 2 + 1] = __uint_as_float(pv & 0xffff0000u); }
        const u32x4 rt = *(const u32x4*)(route + (size_t)tok * 4);
        __syncthreads();
        {
            const int s = F.tid >> 8, f = F.tid & 255;
            const unsigned e = s ? rt.y : rt.x; const float w = __uint_as_float(s ? rt.w : rt.z);
            const float* pg = wg + (size_t)e * DM * 256 + f; const float* pu = wu + (size_t)e * DM * 256 + f;
            float ga = 0.f, ua = 0.f;
            for (int d = 0; d < DM; ++d) { const float hv = hs[d]; ga += hv * pg[(size_t)d * 256]; ua += hv * pu[(size_t)d * 256]; }
            hd[s * 256 + f] = ga * sigmoidf_(ga) * ua * w;
        }
        __syncthreads();
        for (int dd = F.tid; dd < DM; dd += NTHR) {
            float acc = 0.f;
            const float* p0 = wd + (size_t)rt.x * 256 * DM + dd; const float* p1 = wd + (size_t)rt.y * 256 * DM + dd;
            for (int f = 0; f < 256; ++f) acc += hd[f] * p0[(size_t)f * DM];
            for (int f = 0; f < 256; ++f) acc += hd[256 + f] * p1[(size_t)f * DM];
            x[(size_t)tok * DM + dd] += acc;
        }
        __syncthreads();
    }
}


namespace nsa {
typedef short bf16x8 __attribute__((ext_vector_type(8)));
typedef short s16x4 __attribute__((ext_vector_type(4)));
typedef float f32x16 __attribute__((ext_vector_type(16)));
typedef float f32x2_t __attribute__((ext_vector_type(2)));
typedef __bf16 bf16x2_t __attribute__((ext_vector_type(2)));
constexpr int SLOTB = 8192;
constexpr int L_K = 0, L_V = 3 * SLOTB, L_IMP = 6 * SLOTB, L_BT = L_IMP + 65536, L_WS = L_BT + 4 * 132 * 4, L_RL = L_WS + 8 * 64 * 4, L_SM = L_RL + 4 * 64 * 4, L_END = L_SM + 64 * 8;
static_assert(L_END <= 131072, "nsa LDS map");
constexpr float LOG2E = 1.4426950408889634f;
constexpr float NEG_INF = -__builtin_inff();
#define NSA_SBAR() __builtin_amdgcn_sched_barrier(0)
__device__ __forceinline__ int crow(int r, int hi) { return (r & 3) + 8 * (r >> 2) + 4 * hi; }
__device__ __forceinline__ void glds16(const void* gsrc, unsigned lds_dst) { unsigned keep;
    asm volatile("s_mov_b32 %0, m0\n\ts_mov_b32 m0, %2\n\ts_nop 0\n\tglobal_load_lds_dwordx4 %1, off\n\ts_mov_b32 m0, %0" : "=&s"(keep) : "v"(gsrc), "s"(lds_dst) : "memory"); }
__device__ __forceinline__ unsigned cvtpk(float lo, float hi) { f32x2_t v = {lo, hi}; bf16x2_t b = __builtin_convertvector(v, bf16x2_t); return __builtin_bit_cast(unsigned, b); }
#define NSA_WAIT_BAR(N) asm volatile("s_waitcnt vmcnt(" #N ") lgkmcnt(0)\n\ts_barrier" ::: "memory")
__device__ __forceinline__ void qkt(f32x16& p0, f32x16& p1, const LAS char* kb, const bf16x8 (&qr)[4], const f32x16& cinit) {
#pragma unroll
    for (int d0 = 0; d0 < 4; ++d0) {
        const bf16x8 b0 = *(const LAS bf16x8*)(kb + d0 * 2048);
        const bf16x8 b1 = *(const LAS bf16x8*)(kb + d0 * 2048 + 512);
        if (d0 == 0) { p0 = __builtin_amdgcn_mfma_f32_32x32x16_bf16(b0, qr[0], cinit, 0, 0, 0); p1 = __builtin_amdgcn_mfma_f32_32x32x16_bf16(b1, qr[0], cinit, 0, 0, 0); }
        else { p0 = __builtin_amdgcn_mfma_f32_32x32x16_bf16(b0, qr[d0], p0, 0, 0, 0); p1 = __builtin_amdgcn_mfma_f32_32x32x16_bf16(b1, qr[d0], p1, 0, 0, 0); }
    }
}
__device__ __forceinline__ void pv(f32x16 (&o)[2], int vb, bf16x8 pa0, bf16x8 pa1, bf16x8 pa2, bf16x8 pa3) {
#pragma unroll
    for (int d0 = 0; d0 < 2; ++d0) { s16x4 lo[4], hi[4];
#pragma unroll
        for (int ks = 0; ks < 4; ++ks) {
            asm volatile("ds_read_b64_tr_b16 %0,%1 offset:%c2" : "=&v"(lo[ks]) : "v"(vb), "i"(d0 * 4096 + ks * 1024) : "memory");
            asm volatile("ds_read_b64_tr_b16 %0,%1 offset:%c2" : "=&v"(hi[ks]) : "v"(vb), "i"(d0 * 4096 + ks * 1024 + 512) : "memory"); }
        asm volatile("s_waitcnt lgkmcnt(0)" ::: "memory"); NSA_SBAR();
#define NSA_PK(k) (bf16x8){lo[k][0], lo[k][1], lo[k][2], lo[k][3], hi[k][0], hi[k][1], hi[k][2], hi[k][3]}
        o[d0] = __builtin_amdgcn_mfma_f32_32x32x16_bf16(pa0, NSA_PK(0), o[d0], 0, 0, 0);
        o[d0] = __builtin_amdgcn_mfma_f32_32x32x16_bf16(pa1, NSA_PK(1), o[d0], 0, 0, 0);
        o[d0] = __builtin_amdgcn_mfma_f32_32x32x16_bf16(pa2, NSA_PK(2), o[d0], 0, 0, 0);
        o[d0] = __builtin_amdgcn_mfma_f32_32x32x16_bf16(pa3, NSA_PK(3), o[d0], 0, 0, 0);
#undef NSA_PK
    }
}
typedef short v4i16_t __attribute__((ext_vector_type(4)));
__device__ __forceinline__ s16x4 vtr(const LAS char* p) { return __builtin_bit_cast(s16x4, __builtin_amdgcn_ds_read_tr16_b64_v4i16((LAS v4i16_t*)p)); }
__device__ __forceinline__ void pv2(f32x16 (&o)[2], const LAS char* vp, bf16x8 pa0, bf16x8 pa1, bf16x8 pa2, bf16x8 pa3) {
#pragma unroll
    for (int d0 = 0; d0 < 2; ++d0) {
        s16x4 lo[4], hi[4];
#pragma unroll
        for (int ks = 0; ks < 4; ++ks) { lo[ks] = vtr(vp + d0 * 4096 + ks * 1024); hi[ks] = vtr(vp + d0 * 4096 + ks * 1024 + 512); }
#define NSA_PK(k) (bf16x8){lo[k][0], lo[k][1], lo[k][2], lo[k][3], hi[k][0], hi[k][1], hi[k][2], hi[k][3]}
        o[d0] = __builtin_amdgcn_mfma_f32_32x32x16_bf16(pa0, NSA_PK(0), o[d0], 0, 0, 0);
        o[d0] = __builtin_amdgcn_mfma_f32_32x32x16_bf16(pa1, NSA_PK(1), o[d0], 0, 0, 0);
        o[d0] = __builtin_amdgcn_mfma_f32_32x32x16_bf16(pa2, NSA_PK(2), o[d0], 0, 0, 0);
        o[d0] = __builtin_amdgcn_mfma_f32_32x32x16_bf16(pa3, NSA_PK(3), o[d0], 0, 0, 0);
#undef NSA_PK
    }
}
__device__ __forceinline__ float other_half(float v, int hi) { auto rr = __builtin_amdgcn_permlane32_swap(__float_as_uint(v), __float_as_uint(v), false, false); return __uint_as_float(hi ? rr[0] : rr[1]); }
__device__ __forceinline__ float rowmax(const f32x16& p0, const f32x16& p1, int hi) {
    float a = fmaxf(fmaxf(p0[0], p0[1]), p1[0]), b = fmaxf(fmaxf(p0[2], p0[3]), p1[1]); a = fmaxf(fmaxf(a, p1[2]), p1[3]);
#pragma unroll
    for (int r = 4; r < 16; r += 4) { a = fmaxf(fmaxf(a, p0[r]), p0[r + 1]); b = fmaxf(fmaxf(b, p0[r + 2]), p0[r + 3]); a = fmaxf(fmaxf(a, p1[r]), p1[r + 1]); b = fmaxf(fmaxf(b, p1[r + 2]), p1[r + 3]); }
    const float m = fmaxf(a, b);
    return fmaxf(m, other_half(m, hi));
}
__device__ __forceinline__ void pack_p(const f32x16& p0, const f32x16& p1, bf16x8& a0, bf16x8& a1, bf16x8& a2, bf16x8& a3) {
    u32x4 w0, w1, w2, w3;
    w0 = (u32x4){cvtpk(p0[0], p0[1]), cvtpk(p0[2], p0[3]), cvtpk(p0[4], p0[5]), cvtpk(p0[6], p0[7])};
    w1 = (u32x4){cvtpk(p0[8], p0[9]), cvtpk(p0[10], p0[11]), cvtpk(p0[12], p0[13]), cvtpk(p0[14], p0[15])};
    w2 = (u32x4){cvtpk(p1[0], p1[1]), cvtpk(p1[2], p1[3]), cvtpk(p1[4], p1[5]), cvtpk(p1[6], p1[7])};
    w3 = (u32x4){cvtpk(p1[8], p1[9]), cvtpk(p1[10], p1[11]), cvtpk(p1[12], p1[13]), cvtpk(p1[14], p1[15])};
    a0 = __builtin_bit_cast(bf16x8, w0); a1 = __builtin_bit_cast(bf16x8, w1); a2 = __builtin_bit_cast(bf16x8, w2); a3 = __builtin_bit_cast(bf16x8, w3);
}

struct Ctx {
    LAS char* lds; unsigned lds0; int wid, lane, r32, hi, g, th, qloc;
    const LAS float* bt;
    LAS float* wsf;
    const LAS float* wrow;
    int vb0;
    const LAS char* vp0;
    const LAS char* kb0;
};
__device__ __forceinline__ void dma_k(const Ctx& c, const bf16* kbase, int pitch, int slot) { glds16(kbase + (size_t)c.lane * pitch + c.wid * 8, (unsigned)__builtin_amdgcn_readfirstlane(c.lds0 + L_K + slot * SLOTB + c.wid * 1024)); }
__device__ __forceinline__ void dma_v(const Ctx& c, const bf16* vbase, int pitch, int slot) { glds16(vbase + (size_t)(16 * (c.wid & 3) + (c.lane >> 2)) * pitch + (c.wid >> 2) * 32 + (c.lane & 3) * 8, (unsigned)__builtin_amdgcn_readfirstlane(c.lds0 + L_V + slot * SLOTB + c.wid * 1024)); }

__device__ __forceinline__ void cmp_scores(const Ctx& c, int slot, const bf16x8 (&qr)[4], int t0, int kt, f32x16& p0, f32x16& p1) {
    const int dmin = t0 + 32 * c.th - 16 * (64 * kt + 63) - 31;
    const bool special = dmin < 113;
    f32x16 ci; { const float v = special ? 0.f : c.bt[128];
#pragma unroll
        for (int r = 0; r < 16; ++r) ci[r] = v; }
    qkt(p0, p1, c.kb0 + slot * SLOTB, qr, ci);
    if (special) {
        int hi64 = 64 * c.hi; asm volatile("" : "+v"(hi64));
        const int dqh = t0 + c.qloc - 1024 * kt - 31 - hi64;
#pragma unroll
        for (int r = 0; r < 16; ++r) {
            const int d0 = dqh - 16 * ((r & 3) + 8 * (r >> 2)), d1 = d0 - 512;
            const float b0 = c.bt[d0 < 0 ? 0 : (d0 > 128 ? 128 : d0)], b1 = c.bt[d1 < 0 ? 0 : (d1 > 128 ? 128 : d1)];
            p0[r] = d0 < 0 ? NEG_INF : p0[r] + b0; p1[r] = d1 < 0 ? NEG_INF : p1[r] + b1;
        }
    }
}
template <int MODE>
__device__ __forceinline__ void online_tile(const Ctx& c, int slot, const bf16x8 (&qr)[4], int dq, bool near, bool masked_tile, bool lane_off, float& mhat, float& lsum, f32x16 (&o)[2]) {
    f32x16 ci; { const float v = (near ? 0.f : c.bt[128]) - mhat;
#pragma unroll
        for (int r = 0; r < 16; ++r) ci[r] = v; }
    f32x16 p0, p1;
    qkt(p0, p1, c.kb0 + slot * SLOTB, qr, ci);
    if (near || masked_tile) {
        int hi4 = 4 * c.hi; asm volatile("" : "+v"(hi4));
        const int dqh = dq - hi4;
#pragma unroll
        for (int r = 0; r < 16; ++r) {
            const int d0 = dqh - ((r & 3) + 8 * (r >> 2)), d1 = d0 - 32;
            if (near) { p0[r] += c.bt[d0 < 0 ? 0 : (d0 > 128 ? 128 : d0)]; p1[r] += c.bt[d1 < 0 ? 0 : (d1 > 128 ? 128 : d1)]; }
            if (d0 < 0 || (MODE == 1 && d0 >= 512)) p0[r] = NEG_INF;
            if (d1 < 0 || (MODE == 1 && d1 >= 512)) p1[r] = NEG_INF;
        }
    }
    if (MODE == 0) { if (lane_off) {
#pragma unroll
        for (int r = 0; r < 16; ++r) { p0[r] = NEG_INF; p1[r] = NEG_INF; } } }
    const float rm = rowmax(p0, p1, c.hi);
    if (__any(rm > 8.0f)) {
        const float dl = fmaxf(rm, 0.f); mhat += dl;
#pragma unroll
        for (int r = 0; r < 16; ++r) { p0[r] -= dl; p1[r] -= dl; }
        const float f = __builtin_amdgcn_exp2f(-dl); lsum *= f;
        if (c.hi == 0) c.wsf[c.r32] = f;
        asm volatile("s_waitcnt lgkmcnt(0)" ::: "memory");
#pragma unroll
        for (int r = 0; r < 16; ++r) { const float fr = c.wrow[(r & 3) + 8 * (r >> 2)]; o[0][r] *= fr; o[1][r] *= fr; }
    }
    float sacc = 0.f;
#pragma unroll
    for (int r = 0; r < 16; ++r) { p0[r] = __builtin_amdgcn_exp2f(p0[r]); p1[r] = __builtin_amdgcn_exp2f(p1[r]); sacc += p0[r] + p1[r]; }
    lsum += sacc;
    bf16x8 a0, a1, a2, a3; pack_p(p0, p1, a0, a1, a2, a3);
    pv(o, c.vb0 + slot * SLOTB, a0, a1, a2, a3);
}
struct Pipe { bf16x8 a0, a1, a2, a3; bool have, resc; };
template <int MODE, bool SPECIAL, bool HAVE>
__device__ __forceinline__ void online_step(const Ctx& c, int kslot, int vslot_prev, const bf16x8 (&qr)[4], int dq, bool near, bool lane_off, float& mhat, float& lsum, f32x16 (&o)[2], Pipe& pp) {
    if (pp.resc) {
#pragma unroll
        for (int r = 0; r < 16; ++r) { const float fr = c.wrow[(r & 3) + 8 * (r >> 2)]; o[0][r] *= fr; o[1][r] *= fr; }
    }
    f32x16 ci; { const float v = (MODE == 0 && lane_off) ? NEG_INF : (((SPECIAL && near) ? 0.f : c.bt[128]) - mhat);
#pragma unroll
        for (int r = 0; r < 16; ++r) ci[r] = v; }
    f32x16 p0, p1;
    qkt(p0, p1, c.kb0 + kslot * SLOTB, qr, ci);
    if (HAVE) pv2(o, c.vp0 + vslot_prev * SLOTB, pp.a0, pp.a1, pp.a2, pp.a3);
    if (SPECIAL) {
        int hi4 = 4 * c.hi; asm volatile("" : "+v"(hi4));
        const int dqh = dq - hi4;
#pragma unroll
        for (int r = 0; r < 16; ++r) {
            const int d0 = dqh - ((r & 3) + 8 * (r >> 2)), d1 = d0 - 32;
            if (near) { p0[r] += c.bt[d0 < 0 ? 0 : (d0 > 128 ? 128 : d0)]; p1[r] += c.bt[d1 < 0 ? 0 : (d1 > 128 ? 128 : d1)]; }
            if (d0 < 0 || (MODE == 1 && d0 >= 512)) p0[r] = NEG_INF;
            if (d1 < 0 || (MODE == 1 && d1 >= 512)) p1[r] = NEG_INF;
        }
    }
    const float rm = rowmax(p0, p1, c.hi);
    const bool mv = __any(rm > 8.0f);
    if (mv) {
        const float dl = fmaxf(rm, 0.f); mhat += dl;
#pragma unroll
        for (int r = 0; r < 16; ++r) { p0[r] -= dl; p1[r] -= dl; }
        const float f = __builtin_amdgcn_exp2f(-dl); lsum *= f;
        c.wsf[c.r32] = f;
    }
    pp.resc = mv;
    float sacc = 0.f;
#pragma unroll
    for (int r = 0; r < 16; ++r) { p0[r] = __builtin_amdgcn_exp2f(p0[r]); p1[r] = __builtin_amdgcn_exp2f(p1[r]); sacc += p0[r] + p1[r]; }
    lsum += sacc;
    pack_p(p0, p1, pp.a0, pp.a1, pp.a2, pp.a3); pp.have = true;
}
__device__ __forceinline__ void online_drain(const Ctx& c, int vslot_prev, f32x16 (&o)[2], Pipe& pp) {
    if (pp.resc) {
#pragma unroll
        for (int r = 0; r < 16; ++r) { const float fr = c.wrow[(r & 3) + 8 * (r >> 2)]; o[0][r] *= fr; o[1][r] *= fr; }
    }
    if (pp.have) pv2(o, c.vp0 + vslot_prev * SLOTB, pp.a0, pp.a1, pp.a2, pp.a3);
}
__device__ __forceinline__ void add_scaled(const Ctx& c, f32x16 (&oacc)[2], const f32x16 (&o)[2], float s) {
    if (c.hi == 0) c.wsf[32 + c.r32] = s;
    asm volatile("s_waitcnt lgkmcnt(0)" ::: "memory");
#pragma unroll
    for (int r = 0; r < 16; ++r) { const float f = c.wrow[32 + (r & 3) + 8 * (r >> 2)]; oacc[0][r] += o[0][r] * f; oacc[1][r] += o[1][r] * f; }
    asm volatile("s_waitcnt lgkmcnt(0)" ::: "memory");
}

__device__ __forceinline__ void add_scaled_park(const Ctx& c, LAS float* park, const f32x16 (&o)[2], float s) {
    if (c.hi == 0) c.wsf[32 + c.r32] = s;
    asm volatile("s_waitcnt lgkmcnt(0)" ::: "memory");
#pragma unroll
    for (int r = 0; r < 16; ++r) { const float f = c.wrow[32 + (r & 3) + 8 * (r >> 2)]; park[r * 64] += o[0][r] * f; park[(16 + r) * 64] += o[1][r] * f; }
    asm volatile("s_waitcnt lgkmcnt(0)" ::: "memory");
}
__device__ __forceinline__ void unit(LAS char* lds, int tid, int b, int hkv, int jt, const bf16* Z, const bf16* KCm, const bf16* VCm, const float* rel_bias, bf16* YC, bool fill_table) {
    Ctx c; c.lds = lds; c.lds0 = (unsigned)(uintptr_t)lds; c.wid = __builtin_amdgcn_readfirstlane(tid >> 6); c.lane = tid & 63; c.r32 = c.lane & 31; c.hi = c.lane >> 5;
    c.g = c.wid & 3; c.th = c.wid >> 2; c.qloc = 32 * c.th + c.r32;
    c.bt = (const LAS float*)(lds + L_BT) + c.g * 132; c.wsf = (LAS float*)(lds + L_WS) + c.wid * 64; c.wrow = c.wsf + 4 * c.hi;
    c.vb0 = (int)(c.lds0 + L_V) + ((c.lane >> 4) & 1) * 32 + (c.lane & 3) * 8 + (4 * c.hi + ((c.lane & 15) >> 2)) * 64;
    c.kb0 = (const LAS char*)(lds + L_K) + c.hi * 1024 + c.r32 * 16;
    c.vp0 = (const LAS char*)(lds + L_V) + ((c.lane >> 4) & 1) * 32 + (c.lane & 3) * 8 + (4 * c.hi + ((c.lane & 15) >> 2)) * 64;
    const int t0 = 64 * jt;
    const bf16* Zb = Z + (size_t)b * SEQ * ZP;
    const size_t qrow = (size_t)b * SEQ + t0 + c.qloc;
    if (fill_table) for (int i = tid; i < 4 * 129; i += NTHR) { const int gg = i / 129, d = i % 129; ((LAS float*)(lds + L_BT))[gg * 132 + d] = rel_bias[t5_bucket(d) * 8 + hkv * 4 + gg] * LOG2E; }
    bf16x8 qr[4];
#pragma unroll
    for (int d0 = 0; d0 < 4; ++d0) qr[d0] = *(const bf16x8*)(Z + qrow * ZP + ZC_Q + hkv * 256 + c.g * 64 + d0 * 16 + c.hi * 8);
    const bf16* gp = Z + qrow * ZP + ZC_G + hkv * 12 + c.g * 3;
    const float gate0 = sigmoidf_(bf2f(gp[0])), gate1 = sigmoidf_(bf2f(gp[1])), gate2 = sigmoidf_(bf2f(gp[2]));
    f32x16 oacc[2];
#pragma unroll
    for (int r = 0; r < 16; ++r) { oacc[0][r] = 0.f; oacc[1][r] = 0.f; }

    const int nct = (4 * jt + 2) / 64 + 1;
    const bf16* kcb = KCm + (size_t)b * NCMPP * 128 + hkv * 64; const bf16* vcb = VCm + (size_t)b * NCMPP * 128 + hkv * 64;
    const bf16* skb = Zb + ZC_KV + 256 + hkv * 64; const bf16* svb = Zb + ZC_KV + 384 + hkv * 64;
    {
        float mhat = 0.f, lsum = 0.f, carry = 0.f; f32x16 o[2];
#pragma unroll
        for (int r = 0; r < 16; ++r) { o[0][r] = 0.f; o[1][r] = 0.f; }
        LAS float* impw = (LAS float*)(lds + L_IMP) + (c.g * 64 + c.qloc) * 64;
        dma_k(c, kcb, 128, 0); dma_v(c, vcb, 128, 0); if (nct > 1) { dma_k(c, kcb + 64 * 128, 128, 1); dma_v(c, vcb + 64 * 128, 128, 1); }
        for (int i = 0; i < nct; ++i) {
            if (i + 1 < nct) NSA_WAIT_BAR(2); else NSA_WAIT_BAR(0);
            if (i + 2 < nct) { dma_k(c, kcb + (size_t)(i + 2) * 64 * 128, 128, (i + 2) % 3); dma_v(c, vcb + (size_t)(i + 2) * 64 * 128, 128, (i + 2) % 3); }
            f32x16 p0, p1; cmp_scores(c, i % 3, qr, t0, i, p0, p1);
            const float rm = rowmax(p0, p1, c.hi) - mhat;
            if (__any(rm > 8.0f)) {
                const float dl = fmaxf(rm, 0.f); mhat += dl;
                const float f = __builtin_amdgcn_exp2f(-dl); lsum *= f; carry *= f;
                c.wsf[c.r32] = f;
                asm volatile("s_waitcnt lgkmcnt(0)" ::: "memory");
#pragma unroll
                for (int r = 0; r < 16; ++r) { const float fr = c.wrow[(r & 3) + 8 * (r >> 2)]; o[0][r] *= fr; o[1][r] *= fr; }
                for (int e = c.hi; e < 16 * i; e += 2) impw[e] *= f;
            }
            float sacc = 0.f;
#pragma unroll
            for (int r = 0; r < 16; ++r) { p0[r] = __builtin_amdgcn_exp2f(p0[r] - mhat); p1[r] = __builtin_amdgcn_exp2f(p1[r] - mhat); sacc += p0[r] + p1[r]; }
            lsum += sacc;
            float o3[8];
#pragma unroll
            for (int k = 0; k < 4; ++k) { o3[k] = other_half(p0[4 * k + 3], c.hi); o3[4 + k] = other_half(p1[4 * k + 3], c.hi); }
#pragma unroll
            for (int idx = 0; idx < 8; ++idx) {
                const int X = idx >> 2, k = idx & 3;
                const f32x16& p = X ? p1 : p0;
                const float cin = c.hi ? o3[idx] : (idx ? o3[idx - 1] : carry);
                impw[16 * i + 8 * X + 2 * k + c.hi] = p[4 * k] + p[4 * k + 1] + p[4 * k + 2] + 0.5f * p[4 * k + 3] + 0.5f * cin;
            }
            carry = o3[7];
            bf16x8 a0, a1, a2, a3; pack_p(p0, p1, a0, a1, a2, a3);
            pv(o, c.vb0 + (i % 3) * SLOTB, a0, a1, a2, a3);
        }
        const float lt = lsum + other_half(lsum, c.hi);
        const float rl = lt > 0.f ? 1.0f / lt : 0.f;
        if (c.hi == 0) ((LAS float*)(lds + L_RL))[c.g * 64 + c.qloc] = rl;
        add_scaled(c, oacc, o, rl * gate0);
        NSA_WAIT_BAR(0);
    }
    { const int nt = jt + 1; dma_k(c, skb, ZP, 0); if (nt > 1) dma_k(c, skb + (size_t)64 * ZP, ZP, 1); dma_v(c, svb, ZP, 0); }
    for (int k = 0; k < 8; ++k) {
        const int tok = c.wid * 8 + k;
        float v = 0.f;
#pragma unroll
        for (int gg = 0; gg < 4; ++gg) v += ((const LAS float*)(lds + L_IMP))[(gg * 64 + tok) * 64 + c.lane] * ((const LAS float*)(lds + L_RL))[gg * 64 + tok];
        const bool forced = (c.lane == 0) || (c.lane <= jt && c.lane > jt - 2), future = c.lane > jt;
        v = forced ? 1e9f : (future ? -1e9f : v);
        int rank = 0;
#pragma unroll
        for (int jj = 0; jj < 64; ++jj) { const float vj = __builtin_bit_cast(float, __builtin_amdgcn_readlane(__builtin_bit_cast(int, v), jj)); rank += ((vj > v) || (vj == v && jj < c.lane)) ? 1 : 0; }
        const unsigned long long msk = __ballot(rank < 16 && !future);
        if (c.lane == 0) ((LAS unsigned long long*)(lds + L_SM))[tok] = msk;
    }
    asm volatile("s_waitcnt lgkmcnt(0)\n\ts_barrier" ::: "memory");
    const unsigned long long mymask = ((const LAS unsigned long long*)(lds + L_SM))[c.qloc];
    LAS float* park = (LAS float*)(lds + L_IMP) + c.wid * 2048 + c.lane;
#pragma unroll
    for (int r = 0; r < 16; ++r) { park[r * 64] = oacc[0][r]; park[(16 + r) * 64] = oacc[1][r]; }
    {
        const bf16* kb = skb; const bf16* vb = svb;
        const int nt = jt + 1;
        float mhat = 0.f, lsum = 0.f; f32x16 o[2]; Pipe pp; pp.have = false; pp.resc = false;
#pragma unroll
        for (int r = 0; r < 16; ++r) { o[0][r] = 0.f; o[1][r] = 0.f; }
#define NSA_ITER_HEAD(i) do { if ((i) + 1 < nt) NSA_WAIT_BAR(2); else NSA_WAIT_BAR(1); \
            if ((i) + 2 < nt) dma_k(c, kb + (size_t)((i) + 2) * 64 * ZP, ZP, ((i) + 2) % 3); \
            if ((i) + 1 < nt) dma_v(c, vb + (size_t)((i) + 1) * 64 * ZP, ZP, ((i) + 1) % 3); } while (0)
        {
            NSA_ITER_HEAD(0);
            online_step<0, true, false>(c, 0, 2, qr, 64 * jt + c.qloc, 0 >= jt - 2, !(mymask & 1ull), mhat, lsum, o, pp); }
        const int nfar = jt - 2;
        int i = 1;
        for (; i < nfar; ++i) { NSA_ITER_HEAD(i);
            online_step<0, false, true>(c, i % 3, (i + 2) % 3, qr, 0, false, !((mymask >> i) & 1ull), mhat, lsum, o, pp); }
        for (; i < nt; ++i) { NSA_ITER_HEAD(i);
            online_step<0, true, true>(c, i % 3, (i + 2) % 3, qr, 64 * (jt - i) + c.qloc, i >= jt - 2, !((mymask >> i) & 1ull), mhat, lsum, o, pp); }
        NSA_WAIT_BAR(0);
        online_drain(c, (nt - 1) % 3, o, pp);
        const float lt = lsum + other_half(lsum, c.hi);
        add_scaled_park(c, park, o, (lt > 0.f ? 1.0f / lt : 0.f) * gate1);
        NSA_WAIT_BAR(0);
    }
    {
        const int j0 = jt > 8 ? jt - 8 : 0, nt = jt - j0 + 1;
        const bf16* kb = Zb + (size_t)j0 * 64 * ZP + ZC_KV + 512 + hkv * 64; const bf16* vb = Zb + (size_t)j0 * 64 * ZP + ZC_KV + 640 + hkv * 64;
        float mhat = 0.f, lsum = 0.f; f32x16 o[2]; Pipe pp; pp.have = false; pp.resc = false;
#pragma unroll
        for (int r = 0; r < 16; ++r) { o[0][r] = 0.f; o[1][r] = 0.f; }
        dma_k(c, kb, ZP, 0); if (nt > 1) dma_k(c, kb + (size_t)64 * ZP, ZP, 1); dma_v(c, vb, ZP, 0);
        {
            NSA_ITER_HEAD(0);
            online_step<1, true, false>(c, 0, 2, qr, 64 * (jt - j0) + c.qloc, j0 >= jt - 2, false, mhat, lsum, o, pp); }
        int i = 1;
        for (; j0 + i < jt - 2; ++i) { NSA_ITER_HEAD(i);
            online_step<1, false, true>(c, i % 3, (i + 2) % 3, qr, 0, false, false, mhat, lsum, o, pp); }
        for (; i < nt; ++i) { NSA_ITER_HEAD(i); const int j = j0 + i;
            online_step<1, true, true>(c, i % 3, (i + 2) % 3, qr, 64 * (jt - j) + c.qloc, j >= jt - 2, false, mhat, lsum, o, pp); }
#undef NSA_ITER_HEAD
        NSA_WAIT_BAR(0);
        online_drain(c, (nt - 1) % 3, o, pp);
        const float lt = lsum + other_half(lsum, c.hi);
        add_scaled_park(c, park, o, (lt > 0.f ? 1.0f / lt : 0.f) * gate2);
    }
    {
        bf16* yb = YC + ((size_t)b * SEQ + t0 + 32 * c.th + 4 * c.hi) * DM + D_SSM + hkv * 256 + c.g * 64 + c.r32;
#pragma unroll
        for (int r = 0; r < 16; ++r) { bf16* yr = yb + (size_t)((r & 3) + 8 * (r >> 2)) * DM; yr[0] = (bf16)f2bf(park[r * 64]); yr[32] = (bf16)f2bf(park[(16 + r) * 64]); }
    }
    asm volatile("s_waitcnt vmcnt(0)" ::: "memory");
    NSA_WAIT_BAR(0);
}
#undef NSA_SBAR
#undef NSA_WAIT_BAR
}


__device__ __forceinline__ void ssm_precompute(const Frame& F, const __attribute__((address_space(4))) Args* args, unsigned char* ws, int item) {
    const int layer = item >> 5, g = item & 31, lg = layer * 32 + g;
    LAS float* L = (LAS float*)F.lds;
    LAS float* lkr = L; LAS float* lki = L + 17 * 64; LAS float* bbr = L + 2 * 17 * 64; LAS float* bbi = bbr + 1024; LAS float* ccr = bbi + 1024; LAS float* cci = ccr + 1024;
    LAS float* wk = cci + 1024; LAS float* dd = wk + 4096;
    const float* a_re = args->in[6] + lg * 64; const float* a_im = args->in[7] + lg * 64;
    const float dt = expf(args->in[13][lg]);
    for (int i = F.tid; i < 17 * 64; i += NTHR) { const int k = i >> 6, p = i & 63; const float er = expf(a_re[p] * dt * (float)k), ang = a_im[p] * dt * (float)k; lkr[i] = er * cosf(ang); lki[i] = er * sinf(ang); }
    for (int i = F.tid; i < 1024; i += NTHR) {
        { const int p = i >> 4, h = i & 15; const float are = a_re[p], aim = a_im[p];
          const float er = expf(are * dt), lbr = er * cosf(aim * dt), lbi = er * sinf(aim * dt);
          const float xx = lbr - 1.0f, yy = lbi, den = are * are + aim * aim, fr = (xx * are + yy * aim) / den, fi = (yy * are - xx * aim) / den;
          const float br = args->in[8][((size_t)lg * 64 + p) * 16 + h], bi = args->in[9][((size_t)lg * 64 + p) * 16 + h];
          bbr[i] = fr * br - fi * bi; bbi[i] = fr * bi + fi * br; }
        ccr[i] = args->in[10][(size_t)lg * 1024 + i]; cci[i] = args->in[11][(size_t)lg * 1024 + i];
    }
    if (F.tid < 16) dd[F.tid] = args->in[12][lg * 16 + F.tid];
    __syncthreads();
    for (int i = F.tid; i < 4096; i += NTHR) { const int k = i >> 8, ho = (i >> 4) & 15, hi = i & 15; float acc = 0.f;
        for (int p = 0; p < 64; ++p) { const float cr = ccr[ho * 64 + p], ci = cci[ho * 64 + p], lr = lkr[k * 64 + p], li = lki[k * 64 + p];
            const float tr = cr * lr - ci * li, ti = cr * li + ci * lr; acc += tr * bbr[p * 16 + hi] - ti * bbi[p * 16 + hi]; }
        wk[i] = acc + ((k == 0 && ho == hi) ? dd[ho] : 0.f); }
    __syncthreads();
    bf16* B2 = (bf16*)(ws + WS_BT2) + (size_t)lg * 256 * 384;
    for (int i = F.tid; i < 256 * 384; i += NTHR) { const int n = i / 384, kk = i % 384, t = n >> 4, ho = n & 15; float v;
        if (kk < 256) { const int sidx = kk >> 4, hi = kk & 15; v = sidx <= t ? wk[((t - sidx) << 8) + ho * 16 + hi] : 0.f; }
        else { const int j = kk - 256, p = j & 63; const float cr = ccr[ho * 64 + p], ci = cci[ho * 64 + p], lr = lkr[(t + 1) * 64 + p], li = lki[(t + 1) * 64 + p];
            v = j < 64 ? (cr * lr - ci * li) : -(cr * li + ci * lr); }
        B2[i] = (bf16)f2bf(v); }
    bf16* B1 = (bf16*)(ws + WS_BT1) + (size_t)lg * 256 * 256;
    for (int i = F.tid; i < 65536; i += NTHR) { const int j = i >> 8, kk = i & 255, sidx = kk >> 4, hi = kk & 15; float v = 0.f;
        if (j < 128) { const int p = j & 63; const float lr = lkr[(15 - sidx) * 64 + p], li = lki[(15 - sidx) * 64 + p], br = bbr[p * 16 + hi], bi = bbi[p * 16 + hi];
            v = j < 64 ? (lr * br - li * bi) : (lr * bi + li * br); }
        B1[i] = (bf16)f2bf(v); }
    __syncthreads();
}
__device__ __forceinline__ void ssm_carry_item(int b, int g, const float* a_re, const float* a_im, const float* log_dt, const float* XL, bf16* U, int lane) {
    const float dt16 = 16.0f * expf(log_dt[g]);
    const float er = expf(a_re[g * 64 + lane] * dt16), ang = a_im[g * 64 + lane] * dt16, lr = er * cosf(ang), li = er * sinf(ang);
    float xr = 0.f, xi = 0.f;
    const float* __restrict__ xl = XL + ((size_t)g * 2048 + b * 256) * 128 + lane;
    bf16* __restrict__ up = U + ((size_t)g * 2048 + b * 256) * 512 + 256 + lane;
    float ar[16], ai[16], nr_[16], ni_[16];
#pragma unroll
    for (int k = 0; k < 16; ++k) { ar[k] = xl[(size_t)k * 128]; ai[k] = xl[(size_t)k * 128 + 64]; }
    for (int cb = 0; cb < 16; ++cb) {
        const int cn = cb < 15 ? (cb + 1) * 16 : cb * 16;
#pragma unroll
        for (int k = 0; k < 16; ++k) { nr_[k] = xl[(size_t)(cn + k) * 128]; ni_[k] = xl[(size_t)(cn + k) * 128 + 64]; }
#pragma unroll
        for (int k = 0; k < 16; ++k) {
            const int c = cb * 16 + k;
            up[(size_t)c * 512] = (bf16)f2bf(xr); up[(size_t)c * 512 + 64] = (bf16)f2bf(xi);
            const float nr = lr * xr - li * xi + ar[k], ni = lr * xi + li * xr + ai[k];
            xr = nr; xi = ni;
        }
#pragma unroll
        for (int k = 0; k < 16; ++k) { ar[k] = nr_[k]; ai[k] = ni_[k]; }
    }
}


__device__ __forceinline__ void compress_stage2(const Frame& F, int eb, int pm, const bf16* HC, const bf16* W2T, bf16* KCo, bf16* VCo) {
    typedef short bf16x8_ __attribute__((ext_vector_type(8))); typedef float f32x16_ __attribute__((ext_vector_type(16)));
    const int r32 = F.lane & 31, hi = F.lane >> 5, rg0 = pm * 256 + F.wave * 32;
    const bf16* ar = HC + ((size_t)eb * 4096 + rg0 + r32) * 64 + 8 * hi; const bf16* br = W2T + (size_t)eb * 4096 + (size_t)r32 * 64 + 8 * hi;
    bf16x8_ a[4], b0[4], b1[4];
#pragma unroll
    for (int ks = 0; ks < 4; ++ks) { a[ks] = *(const bf16x8_*)(ar + ks * 16); b0[ks] = *(const bf16x8_*)(br + ks * 16); b1[ks] = *(const bf16x8_*)(br + 32 * 64 + ks * 16); }
    f32x16_ d0, d1;
#pragma unroll
    for (int r = 0; r < 16; ++r) { d0[r] = 0.f; d1[r] = 0.f; }
#pragma unroll
    for (int ks = 0; ks < 4; ++ks) { d0 = __builtin_amdgcn_mfma_f32_32x32x16_bf16(a[ks], b0[ks], d0, 0, 0, 0); d1 = __builtin_amdgcn_mfma_f32_32x32x16_bf16(a[ks], b1[ks], d1, 0, 0, 0); }
    bf16* dstb = (eb ? VCo : KCo) + (size_t)(rg0 + 4 * hi) * 64 + r32;
#pragma unroll
    for (int r = 0; r < 16; ++r) { const int ro = (r & 3) + 8 * (r >> 2); const bool pad = (((rg0 + 4 * hi + ro) >> 1) & 255) == NCMP;
        dstb[(size_t)ro * 64] = pad ? (bf16)0 : (bf16)f2bf(d0[r]); dstb[(size_t)ro * 64 + 32] = pad ? (bf16)0 : (bf16)f2bf(d1[r]); }
}

__device__ __forceinline__ void titem_load(const float* W, int N, int k0, int n0, int lane, float (&t)[32]) {
#pragma unroll
    for (int i = 0; i < 32; ++i) t[i] = W[(size_t)(k0 + 2 * i + (lane >> 5)) * N + n0 + (lane & 31)];
}
__device__ __forceinline__ void titem_finish(const float (&t)[32], int K, bf16* WT, int k0, int drow0, LAS float* scr, int lane, float scale) {
#pragma unroll
    for (int i = 0; i < 32; ++i) scr[(2 * i + (lane >> 5)) * 33 + (lane & 31)] = t[i];
    asm volatile("s_waitcnt lgkmcnt(0)" ::: "memory");
    const int c = lane & 7;
#pragma unroll
    for (int j = 0; j < 4; ++j) { const int n = (lane >> 3) + 8 * j; const LAS float* sp = scr + (8 * c) * 33 + n;
        u32x4 o; o.x = pk2(sp[0 * 33] * scale, sp[1 * 33] * scale); o.y = pk2(sp[2 * 33] * scale, sp[3 * 33] * scale); o.z = pk2(sp[4 * 33] * scale, sp[5 * 33] * scale); o.w = pk2(sp[6 * 33] * scale, sp[7 * 33] * scale);
        *(u32x4*)(WT + (size_t)(drow0 + n) * K + k0 + 8 * c) = o; }
    asm volatile("s_waitcnt lgkmcnt(0)" ::: "memory");
}
__device__ __forceinline__ void transpose_item(const float* W, int K, int N, bf16* WT, int k0, int n0, int drow0, LAS float* scr, int lane, float scale = 1.0f) {
    float t[32]; titem_load(W, N, k0, n0, lane, t); titem_finish(t, K, WT, k0, drow0, scr, lane, scale);
}
struct XItem { const float* W; bf16* WT; int K, N, k0, n0, drow0; };
__device__ __forceinline__ XItem xitem(const __attribute__((address_space(4))) Args* args, unsigned char* ws, int it) {
    XItem x; const int le = it / 384, r = it % 384;
    if (r < 256) { const int isup = r >> 7, q = r & 127, nb = q & 7, kb = q >> 3, n0 = 32 * nb;
        x.W = args->in[isup ? 24 : 23] + (size_t)le * DM * 256; x.K = DM; x.N = 256; x.WT = (bf16*)(ws + WS_WGU) + (size_t)le * 512 * DM; x.k0 = 64 * kb; x.n0 = n0; x.drow0 = 256 * (n0 >> 7) + 128 * isup + (n0 & 127); }
    else { const int q = r - 256, nb = q & 31, kb = q >> 5;
        x.W = args->in[25] + (size_t)le * 256 * DM; x.K = 256; x.N = DM; x.WT = (bf16*)(ws + WS_WDN) + (size_t)le * DM * 256; x.k0 = 64 * kb; x.n0 = 32 * nb; x.drow0 = 32 * nb; }
    return x;
}
__device__ __forceinline__ void convert_experts(const Frame& F, const __attribute__((address_space(4))) Args* args, unsigned char* ws, int layer, int vw, int nvw) {
    LAS float* scr = (LAS float*)(F.lds + F.wave * 16384);
    const int lo_ = layer * 32 * 384, hi_ = (layer + 1) * 32 * 384;
    float ta[32], tb[32]; XItem xa, xb;
    int it = lo_ + vw;
    if (it < hi_) { xa = xitem(args, ws, it); titem_load(xa.W, xa.N, xa.k0, xa.n0, F.lane, ta); }
    for (; it < hi_; it += nvw) {
        const bool hn = it + nvw < hi_;
        if (hn) { xb = xitem(args, ws, it + nvw); titem_load(xb.W, xb.N, xb.k0, xb.n0, F.lane, tb); }
        titem_finish(ta, xa.K, xa.WT, xa.k0, xa.drow0, scr, F.lane, 1.0f);
        if (hn) { xa = xb;
#pragma unroll
            for (int i = 0; i < 32; ++i) ta[i] = tb[i]; }
    }
}
__device__ __forceinline__ void ph_convert(const Frame& F, const __attribute__((address_space(4))) Args* args, unsigned char* ws) {
    for (int it = F.blk; it < DEPTH * NGRP; it += F.G) ssm_precompute(F, args, ws, it);
    LAS float* scr = (LAS float*)(F.lds + F.wave * 16384);
    const int gw = F.blk * NWAVES + F.wave, NGW = F.G * NWAVES;
    constexpr int I_IN = (DM / 64) * (1792 / 32), I_GLU = (D_SSM / 64) * (2 * D_SSM / 32), I_OUT = (DM / 64) * (DM / 32);
    constexpr int PER_LAYER = I_IN + I_GLU + I_OUT;
    for (int it = gw; it < DEPTH * 2 * 64; it += NGW) { const int li = it >> 6, q = it & 63, nb = q & 1, kb = q >> 1;
        transpose_item(args->in[16] + (size_t)li * 2048 * 64, 2048, 64, (bf16*)(ws + WS_W1T) + (size_t)li * 256 * 2048, 64 * kb, 32 * nb, 32 * nb, scr, F.lane); }
    { const int gt = F.blk * NTHR + F.tid, NGT = F.G * NTHR;
      for (int idx = gt; idx < DEPTH * 2 * 192 * 2048 / 8; idx += NGT) { const int li = idx / (192 * 256), rem = idx % (192 * 256);
          *(u32x4*)((bf16*)(ws + WS_W1T) + (size_t)li * 256 * 2048 + (size_t)64 * 2048 + (size_t)rem * 8) = (u32x4){0u, 0u, 0u, 0u}; }
      for (int idx = gt; idx < DEPTH * 2 * 4096; idx += NGT) { const int li = idx >> 12, f = (idx >> 6) & 63, e = idx & 63; ((bf16*)(ws + WS_W2T))[idx] = (bf16)f2bf(args->in[17][(size_t)li * 4096 + e * 64 + f]); }
    }
    for (int idx = gw; idx < DEPTH * 2 * 64; idx += NGW) { const int li = idx >> 6, e = idx & 63; const float* pp = args->in[15] + (size_t)li * 2048; const float* ww = args->in[16] + (size_t)li * 2048 * 64 + e;
        float a = 0.f;
#pragma unroll 8
        for (int k = F.lane; k < 2048; k += 64) a += pp[k] * ww[(size_t)k * 64];
        a = wave_sum(a, F.lane);
        if (F.lane == 0) ((float*)(ws + WS_CBIAS))[idx] = a; }
    for (int it = gw; it < DEPTH * PER_LAYER; it += NGW) {
        const int layer = it / PER_LAYER; int r = it % PER_LAYER;
        if (r < I_IN) { const int nb = r % 56, kb = r / 56;
            transpose_item(args->in[4] + (size_t)layer * DM * D_IN, DM, D_IN, (bf16*)(ws + WS_WIN) + (size_t)layer * ZP * DM, 64 * kb, 32 * nb, 32 * nb, scr, F.lane, (nb >= 16 && nb < 32) ? QSCALE : 1.0f); continue; }
        r -= I_IN;
        if (r < I_GLU) { const int nb = r % 32, kb = r / 32, n0 = 32 * nb;
            const int half = n0 >> 9, c = n0 & 511, drow = 256 * (c >> 7) + 128 * half + (c & 127);
            transpose_item(args->in[14] + (size_t)layer * D_SSM * 2 * D_SSM, D_SSM, 2 * D_SSM, (bf16*)(ws + WS_WGLU) + (size_t)layer * 2 * D_SSM * D_SSM, 64 * kb, n0, drow, scr, F.lane); continue; }
        r -= I_GLU;
        { const int nb = r % 32, kb = r / 32;
            transpose_item(args->in[5] + (size_t)layer * DM * DM, DM, DM, (bf16*)(ws + WS_WOUT) + (size_t)layer * DM * DM, 64 * kb, 32 * nb, 32 * nb, scr, F.lane); }
    }
    const int gt = F.blk * NTHR + F.tid, NGT = F.G * NTHR;
    for (int idx = gt; idx < DEPTH * 256 * DM; idx += NGT) {
        const int layer = idx / (256 * DM), rem = idx % (256 * DM), n = 1792 + rem / DM, k = rem % DM;
        const float v = n < D_IN ? args->in[4][(size_t)layer * DM * D_IN + (size_t)k * D_IN + n] : 0.f;
        ((bf16*)(ws + WS_WIN))[(size_t)layer * ZP * DM + (size_t)n * DM + k] = (bf16)f2bf(v);
    }
}

constexpr int PH_PER_LAYER = 8, N_PHASES = 1 + DEPTH * PH_PER_LAYER + 1;
#ifndef FAST_GEMM
#define FAST_GEMM 1
#endif
#ifndef REP_ATTN
#define REP_ATTN 1
#endif
#ifndef REP_CMP
#define REP_CMP 1
#endif
#ifndef REP_CARRY
#define REP_CARRY 1
#endif
#ifndef REP_CONV
#define REP_CONV 1
#endif
#ifndef REP_INPROJ
#define REP_INPROJ 1
#endif
#ifndef REP_G1
#define REP_G1 1
#endif
#ifndef REP_G2
#define REP_G2 1
#endif
#ifndef REP_GLU
#define REP_GLU 1
#endif
#ifndef REP_OUT
#define REP_OUT 1
#endif
#ifndef REP_NORM
#define REP_NORM 1
#endif
#ifndef REP_ROUTE
#define REP_ROUTE 1
#endif
#ifndef REP_GU
#define REP_GU 1
#endif
#ifndef REP_DN
#define REP_DN 1
#endif

__global__ void __launch_bounds__(NTHR, 2) fwd(Args args) {
    extern __shared__ __attribute__((aligned(16))) unsigned char lds_raw[];
    Frame F;
    F.lds = (LAS unsigned char*)lds_raw;
    F.tid = threadIdx.x; F.lane = F.tid & 63; F.wave = __builtin_amdgcn_readfirstlane(F.tid >> 6);
    F.blk = blockIdx.x; F.G = gridDim.x;
    typedef const __attribute__((address_space(4))) Args* KArgs;
    KArgs kp = (KArgs)__builtin_amdgcn_kernarg_segment_ptr();
    asm volatile("" : "+s"(kp));
    unsigned char* ws = kp->ws;
    volatile LAS unsigned* MISC = (volatile LAS unsigned*)(F.lds + MISC_OFF);
    if (F.tid < 32) MISC[F.tid] = 0u;
    __syncthreads();
    XcdBarrier bar; bar.bar = (unsigned*)(ws + WS_CTL) + CW_BAR; bar.x = 0; bar.st = nullptr;
    if (N_LAUNCH_MODE == 1) bar = xcd_barrier_post((unsigned*)(ws + WS_CTL) + CW_BAR, MISC + 8);
#define IN(k) (kp->ph_lo <= (k) && (k) < kp->ph_hi)
#define FRESH_IDS() do { int l_; asm volatile("v_mbcnt_lo_u32_b32 %0, -1, 0\n\tv_mbcnt_hi_u32_b32 %0, -1, %0" : "=v"(l_)); asm volatile("" : "+s"(F.wave), "+s"(F.blk), "+s"(F.G)); F.lane = l_; F.tid = F.wave * 64 + l_; asm volatile("" : "+s"(kp)); ws = kp->ws; bar.bar = (unsigned*)(ws + WS_CTL) + CW_BAR; } while (0)
#define SEAM(k) do { FRESH_IDS(); if (IN(k) && IN((k) + 1)) xcd_barrier(bar, F.tid); FRESH_IDS(); } while (0)

    const float* x0 = kp->in[0];
    float* XR = kp->out;
#define HN ((bf16*)(ws + WS_HN))
#define Z ((bf16*)(ws + WS_Z))
#define YC ((bf16*)(ws + WS_YC))
#define G1 ((bf16*)(ws + WS_G1))
#define KC ((bf16*)(ws + WS_KC))
#define VC ((bf16*)(ws + WS_VC))
#define LIST ((unsigned*)(ws + WS_LIST))
#define LISTW ((float*)(ws + WS_LISTW))
#define HID ((bf16*)(ws + WS_HID))
#define P2 ((bf16*)(ws + WS_P2))
#define P1B ((bf16*)(ws + WS_YC))
#define USSM ((bf16*)(ws + WS_USSM))
#define XL ((float*)(ws + WS_XL))
    LAS int* etab = (LAS int*)(F.lds + ETAB_OFF);

    if (IN(0)) { for (int rep_ = 0; rep_ < REP_CONV; ++rep_) ph_convert(F, kp, ws);
                 ph_norm(F, kp->in[0], nullptr, nullptr, kp->out, kp->in[1], HN); }
    SEAM(0);
    for (int layer = 0; layer < DEPTH; ++layer) {
        const int pb = 1 + layer * PH_PER_LAYER;
        const float* xin = layer == 0 ? x0 : XR;
        unsigned* gcnt = (unsigned*)(ws + WS_CTL) + CW_CNT + layer * 32 * 64;
        if (IN(pb + 0) && layer > 0) { ph_norm(F, xin, P1B, P2, XR, kp->in[1] + layer * DM, HN); for (int rep_ = 1; rep_ < REP_NORM; ++rep_) ph_norm(F, xin, nullptr, nullptr, XR, kp->in[1] + layer * DM, HN); }
        if (layer > 0) SEAM(pb + 0);
        if (IN(pb + 1)) {
            pg8::Gemm g{HN, (const bf16*)(ws + WS_WIN) + (size_t)layer * ZP * DM, T, ZP, DM, DM, 0, nullptr, 0, 0, 128}; pg8::StaticOrder S; S.init(T, ZP, F.G, F.blk);
            pg8::EpiInProj E{Z, USSM};
            for (int rep_ = 0; rep_ < REP_INPROJ; ++rep_) pg8::gemm2<pg8::EpiInProj, pg8::StaticOrder, pg8::ADense>(F.lds, g, S, E, F.tid);
        }
        SEAM(pb + 1);
        if (IN(pb + 2)) {
            for (int rep_ = 0; rep_ < REP_CMP; ++rep_) {
                { pg8::Gemm g{Z, (const bf16*)(ws + WS_W1T) + (size_t)layer * 2 * 256 * 2048, 0, 256, 2048, ZP, (size_t)256 * 2048, nullptr, 0, 0, ZP * 2};
                  pg8::CmpOrder S{F.G, F.blk}; pg8::EpiCmpHid E{(bf16*)(ws + WS_HIDC), (const float*)(ws + WS_CBIAS) + layer * 128};
                  pg8::gemm2<pg8::EpiCmpHid, pg8::CmpOrder, pg8::ACompress>(F.lds, g, S, E, F.tid); }
                asm volatile("s_waitcnt vmcnt(0)" ::: "memory"); __syncthreads();
                for (int L = F.blk; L < 32; L += F.G) compress_stage2(F, L >> 4, L & 15, (const bf16*)(ws + WS_HIDC), (const bf16*)(ws + WS_W2T) + (size_t)layer * 2 * 4096, KC, VC);
            }
#pragma unroll 1
            for (int L = F.blk; L < NGRP * BATCH; L += F.G) {
                const int sg = L >> 3, sb = L & 7;
                FRESH_IDS();
                { pg8::Gemm g{USSM, (const bf16*)(ws + WS_BT1) + (size_t)layer * 32 * 256 * 256, 0, 256, 256, 512, (size_t)256 * 256, nullptr, 0, (size_t)2048 * 512, 128};
                  pg8::SingleUnit S{sg, sb}; pg8::EpiXloc E{XL};
                  pg8::gemm2<pg8::EpiXloc, pg8::SingleUnit, pg8::ADense>(F.lds, g, S, E, F.tid); }
                asm volatile("s_waitcnt vmcnt(0)" ::: "memory"); __syncthreads();
                for (int rep_ = 0; rep_ < REP_CARRY; ++rep_)
                if (F.wave == 0) ssm_carry_item(sb, sg, kp->in[6] + layer * NGRP * SST, kp->in[7] + layer * NGRP * SST, kp->in[13] + layer * NGRP, XL, USSM, F.lane);
                asm volatile("s_waitcnt vmcnt(0)" ::: "memory"); __syncthreads();
                FRESH_IDS();
                { pg8::Gemm g{USSM, (const bf16*)(ws + WS_BT2) + (size_t)layer * 32 * 256 * 384, 0, 256, 384, 512, (size_t)256 * 384, nullptr, 0, (size_t)2048 * 512, 128};
                  pg8::SingleUnit S{sg, sb}; pg8::EpiSsmOut E{G1};
                  pg8::gemm2<pg8::EpiSsmOut, pg8::SingleUnit, pg8::ADense>(F.lds, g, S, E, F.tid); }
            }
            if (F.G > 64) { if (F.blk >= 32) convert_experts(F, kp, ws, layer, (F.blk - 32) * NWAVES + F.wave, (F.G - 32) * NWAVES); }
            else convert_experts(F, kp, ws, layer, F.blk * NWAVES + F.wave, F.G * NWAVES);
        }
        SEAM(pb + 2);
        if (IN(pb + 3)) {
            { pg8::Gemm g{G1, (const bf16*)(ws + WS_WGLU) + (size_t)layer * 2 * D_SSM * D_SSM, T, 2 * D_SSM, D_SSM, D_SSM, 0, nullptr, 0, 0, 128}; pg8::StaticOrder S; S.init(T, 2 * D_SSM, F.G, F.blk);
              pg8::EpiGlu E{YC, DM};
              for (int rep_ = 0; rep_ < REP_GLU; ++rep_) pg8::gemm2<pg8::EpiGlu, pg8::StaticOrder, pg8::ADense>(F.lds, g, S, E, F.tid); }
            __syncthreads();
            int last_hkv = -1;
            for (int rep_ = 0; rep_ < REP_ATTN; ++rep_)
            for (int slot = F.blk; slot < 256; slot += F.G) {
                const int bh = slot >> 4, sq = slot & 15;
#pragma unroll 1
                for (int uq = 0; uq < 4; ++uq) { const int jt = uq == 0 ? 63 - sq : (uq == 1 ? 32 + sq : (uq == 2 ? 31 - sq : sq));
                    nsa::unit((LAS char*)F.lds, F.tid, bh >> 1, bh & 1, jt, Z, KC, VC, kp->in[18], YC, (bh & 1) != last_hkv); last_hkv = bh & 1; }
            }
        }
        SEAM(pb + 3);
        if (IN(pb + 4)) {
            pg8::Gemm g{YC, (const bf16*)(ws + WS_WOUT) + (size_t)layer * DM * DM, T, DM, DM, DM, 0, nullptr, 0, 0, 128}; pg8::StaticOrder S; S.init(T, DM, F.G, F.blk);
            for (int rep_ = 1; rep_ < REP_OUT; ++rep_) { pg8::EpiResid Ed{xin, (float*)(ws + WS_Z), DM}; pg8::gemm2<pg8::EpiResid, pg8::StaticOrder, pg8::ADense>(F.lds, g, S, Ed, F.tid); }
            pg8::EpiResid E{xin, XR, DM};
            pg8::gemm2<pg8::EpiResid, pg8::StaticOrder, pg8::ADense>(F.lds, g, S, E, F.tid);
        }
        SEAM(pb + 4);
        if (IN(pb + 5)) ph_norm_route(F, XR, kp->in[2] + layer * DM, kp->in[19] + (size_t)layer * DM * 4, kp->in[20] + layer * 4, kp->in[21] + (size_t)layer * 4 * DM * 8, kp->in[22] + layer * 32, HN, gcnt, LIST, LISTW);
        if (IN(pb + 5)) for (int rep_ = 1; rep_ < REP_ROUTE; ++rep_) ph_norm_route(F, XR, kp->in[2] + layer * DM, kp->in[19] + (size_t)layer * DM * 4, kp->in[20] + layer * 4, kp->in[21] + (size_t)layer * 4 * DM * 8, kp->in[22] + layer * 32, HN, gcnt + (2 + rep_) * 32 * 64, (unsigned*)(ws + 484 * MiB), (float*)(ws + 488 * MiB));
        SEAM(pb + 5);
        if (IN(pb + 6)) {
            build_expert_tab(F, gcnt, etab);
            pg8::Gemm g{HN, (const bf16*)(ws + WS_WGU) + (size_t)layer * 32 * 512 * DM, 0, 512, DM, DM, (size_t)512 * DM, LIST, LCAP, 0, 128};
            pg8::ExpertOrder S{etab, 2, F.G, F.blk};
            pg8::EpiGateUp E{HID, LISTW, LCAP};
            for (int rep_ = 0; rep_ < REP_GU; ++rep_) pg8::gemm2<pg8::EpiGateUp, pg8::ExpertOrder, pg8::AList>(F.lds, g, S, E, F.tid);
        }
        SEAM(pb + 6);
        if (IN(pb + 7)) {
            build_expert_tab(F, gcnt, etab);
            pg8::Gemm g{HID, (const bf16*)(ws + WS_WDN) + (size_t)layer * 32 * DM * 256, 0, DM, 256, 256, (size_t)DM * 256, nullptr, 0, 0, 128};
            pg8::ExpertOrder S{etab, 4, F.G, F.blk};
            for (int rep_ = 1; rep_ < REP_DN; ++rep_) { pg8::EpiDown Ed{P1B, (long)(P2 - P1B), LIST, LCAP}; pg8::gemm2<pg8::EpiDown, pg8::ExpertOrder, pg8::ADense>(F.lds, g, S, Ed, F.tid); }
            pg8::EpiDown E{P1B, (long)(P2 - P1B), LIST, LCAP};
            pg8::gemm2<pg8::EpiDown, pg8::ExpertOrder, pg8::ADense>(F.lds, g, S, E, F.tid);
        }
        SEAM(pb + 7);
    }
    if (IN(N_PHASES - 1)) ph_final_norm(F, XR, P1B, P2, kp->in[3]);
#undef IN
#undef SEAM
#undef HN
#undef Z
#undef YC
#undef G1
#undef KC
#undef VC
#undef LIST
#undef LISTW
#undef HID
#undef P2
#undef P1B
#undef USSM
#undef XL
}

extern "C" void kernel_launch(void* const* d_in, const int* in_sizes, int n_in, void* d_out, int out_size, void* d_ws, size_t ws_size, hipStream_t stream) {
    static int grid = 0;
    if (grid == 0) {
        if (n_in != 26 || out_size != T * DM || ws_size < WS_END) { fprintf(stderr, "kernel_launch: unexpected shapes (n_in %d out %d ws %zu)\n", n_in, out_size, ws_size); grid = -1; return; }
        int dev = 0, cus = 0, per_cu = 0;
        if (hipGetDevice(&dev) != hipSuccess || hipDeviceGetAttribute(&cus, hipDeviceAttributeMultiprocessorCount, dev) != hipSuccess) { grid = -1; return; }
        if (hipFuncSetAttribute((const void*)fwd, hipFuncAttributeMaxDynamicSharedMemorySize, LDS_BYTES) != hipSuccess) { fprintf(stderr, "kernel_launch: hipFuncSetAttribute failed\n"); grid = -1; return; }
        if (hipOccupancyMaxActiveBlocksPerMultiprocessor(&per_cu, (const void*)fwd, NTHR, LDS_BYTES) != hipSuccess || per_cu < 1) fprintf(stderr, "kernel_launch: occupancy query says %d\n", per_cu);
        (void)hipGetLastError();
        grid = cus;
    }
    if (grid < 0) return;
    (void)hipMemsetAsync((char*)d_ws + WS_CTL, 0, CTL_ZERO_BYTES, stream);
    Args a{};
    for (int i = 0; i < 26; ++i) a.in[i] = (const float*)d_in[i];
    a.out = (float*)d_out; a.ws = (unsigned char*)d_ws;
    if (N_LAUNCH_MODE == 1) {
        a.ph_lo = 0; a.ph_hi = N_PHASES;
        hipLaunchKernelGGL(fwd, dim3(grid), dim3(NTHR), LDS_BYTES, stream, a);
    } else {
        for (int p = 0; p < N_PHASES; ++p) { a.ph_lo = p; a.ph_hi = p + 1; hipLaunchKernelGGL(fwd, dim3(grid), dim3(NTHR), LDS_BYTES, stream, a); }
    }
}
```

```cpp
#include <hip/hip_runtime.h>
#include <cstdio>
#include <cstdint>

#ifndef N_LAUNCH_MODE
#define N_LAUNCH_MODE 1
#endif

#define GAS __attribute__((address_space(1)))
#define LAS __attribute__((address_space(3)))
typedef unsigned short bf16;
typedef float f32x4 __attribute__((ext_vector_type(4)));
typedef unsigned u32x4 __attribute__((ext_vector_type(4)));
typedef unsigned u32x2 __attribute__((ext_vector_type(2)));

constexpr int BATCH = 8, SEQ = 4096, DM = 1024, T = BATCH * SEQ, DEPTH = 2;
constexpr int D_SSM = 512, NGRP = 32, SGRP = 16, SST = 64;
constexpr int D_IN = 1816, ZP = 2048;
constexpr int ZC_U = 0, ZC_Q = 512, ZC_KV = 1024, ZC_G = 1792;
constexpr int NCMP = 255, NCMPP = 256;
constexpr float EPS = 1e-6f;
constexpr int NWAVES = 8, NTHR = 512;
constexpr float QSCALE = 0.125f * 1.4426950408889634f;

constexpr size_t MiB = 1u << 20;
constexpr size_t WS_CTL = 0, CTL_ZERO_BYTES = 1 * MiB;
constexpr size_t WS_KC = 1 * MiB, WS_VC = 2 * MiB, WS_ROUTE = 3 * MiB;
constexpr size_t WS_HN = 16 * MiB;
constexpr size_t WS_Z = 80 * MiB;
constexpr size_t WS_YC = 208 * MiB;
constexpr size_t WS_G1 = 272 * MiB;
constexpr size_t WS_WIN = 304 * MiB;
constexpr size_t WS_WGLU = 312 * MiB;
constexpr size_t WS_WOUT = 314 * MiB;
constexpr size_t WS_WGU = 318 * MiB;
constexpr size_t WS_WDN = 382 * MiB;
constexpr size_t WS_LIST = 414 * MiB;
constexpr size_t WS_LISTW = 418 * MiB;
constexpr size_t WS_HID = 422 * MiB;
constexpr size_t WS_P2 = WS_Z;
constexpr size_t WS_USSM = WS_YC;
constexpr size_t WS_XL = WS_HID;
constexpr size_t WS_BT1 = 458 * MiB;
constexpr size_t WS_BT2 = 466 * MiB;
constexpr size_t WS_W1T = 478 * MiB;
constexpr size_t WS_HIDC = 4 * MiB;
constexpr size_t WS_CBIAS = 5 * MiB;
constexpr size_t WS_W2T = 6 * MiB;
constexpr size_t WS_END = 482 * MiB;
constexpr int LCAP = 32768, CW_CNT = 8192;
constexpr int CW_BAR = 4096;

constexpr int LDS_BYTES = 163840;
constexpr int ETAB_OFF = LDS_BYTES - 1024, MISC_OFF = LDS_BYTES - 512;

__device__ __forceinline__ float bf2f(bf16 v) { return __uint_as_float(((unsigned)v) << 16); }
__device__ __forceinline__ unsigned f2bf(float f) { unsigned u = __float_as_uint(f); return (u + 0x7fffu + ((u >> 16) & 1u)) >> 16; }
__device__ __forceinline__ unsigned pk2(float lo, float hi) { return f2bf(lo) | (f2bf(hi) << 16); }
__device__ __forceinline__ float wave_sum(float v, int) {
    v += __builtin_bit_cast(float, __builtin_amdgcn_update_dpp(0, __builtin_bit_cast(int, v), 0xB1, 0xF, 0xF, true));
    v += __builtin_bit_cast(float, __builtin_amdgcn_update_dpp(0, __builtin_bit_cast(int, v), 0x4E, 0xF, 0xF, true));
    v += __builtin_bit_cast(float, __builtin_amdgcn_update_dpp(0, __builtin_bit_cast(int, v), 0x141, 0xF, 0xF, true));
    v += __builtin_bit_cast(float, __builtin_amdgcn_update_dpp(0, __builtin_bit_cast(int, v), 0x140, 0xF, 0xF, true));
    const int iv = __builtin_bit_cast(int, v);
    const float s0 = __builtin_bit_cast(float, __builtin_amdgcn_readlane(iv, 0)), s1 = __builtin_bit_cast(float, __builtin_amdgcn_readlane(iv, 16));
    const float s2 = __builtin_bit_cast(float, __builtin_amdgcn_readlane(iv, 32)), s3 = __builtin_bit_cast(float, __builtin_amdgcn_readlane(iv, 48));
    return (s0 + s1) + (s2 + s3);
}
__device__ __forceinline__ float wave_max(float v, int lane) {
#pragma unroll
    for (int o = 1; o < 64; o <<= 1) v = fmaxf(v, __int_as_float(__builtin_amdgcn_ds_bpermute((lane ^ o) << 2, __float_as_int(v))));
    return v;
}
__device__ __forceinline__ float lane_bcast(float v, int src) { return __int_as_float(__builtin_amdgcn_ds_bpermute(src << 2, __float_as_int(v))); }
__device__ __forceinline__ float gelu_tanh(float x) {
    const float u = 0.7978845608028654f * (x + 0.044715f * x * x * x);
    return 0.5f * x * (1.0f + tanhf(u));
}
__device__ __forceinline__ float sigmoidf_(float x) { return 1.0f / (1.0f + __expf(-x)); }
__device__ __forceinline__ int t5_bucket(int n) {
    if (n < 16) return n < 0 ? 0 : n;
    int b = 16;
    b += (n >= 19); b += (n >= 21); b += (n >= 24); b += (n >= 27); b += (n >= 31); b += (n >= 35); b += (n >= 40); b += (n >= 46);
    b += (n >= 52); b += (n >= 59); b += (n >= 67); b += (n >= 77); b += (n >= 87); b += (n >= 99); b += (n >= 113);
    return b;
}

#define XB_TMO      128
#define XB_XCNT(j)  (256  + 64 * (j))
#define XB_XSUB(j)  (1280 + 64 * (j))
#define XB_XGEN(j)  (2304 + 64 * (j))
#define XB_TOP      3328
#define XB_TOPGEN   3392
#define XCD_BAR_WORDS 3456
#define XB_SPIN_CAP (1u << 22)

__device__ __forceinline__ unsigned xb_ld(unsigned* p)              { return __hip_atomic_load(p, __ATOMIC_RELAXED, __HIP_MEMORY_SCOPE_AGENT); }
__device__ __forceinline__ unsigned xb_add(unsigned* p, unsigned v) { return __hip_atomic_fetch_add(p, v, __ATOMIC_RELAXED, __HIP_MEMORY_SCOPE_AGENT); }
__device__ __forceinline__ unsigned xb_xcc_id() { return (unsigned)__builtin_amdgcn_s_getreg((3 << 11) | 20) & 0xFu; }
#define XB_SPIN(cond, bar) do { unsigned _sp = 0; while (cond) { __builtin_amdgcn_s_sleep(1); \
    if ((++_sp & 255u) == 0u) { if (xb_ld(&(bar)[XB_TMO])) break; if (_sp > XB_SPIN_CAP) { atomicAdd(&(bar)[XB_TMO], 1u); break; } } } } while (0)

struct XcdBarrier { unsigned* bar; unsigned x; volatile LAS unsigned* st; };

__device__ __forceinline__ XcdBarrier xcd_barrier_post(unsigned* bar, volatile LAS unsigned* st) {
    XcdBarrier b; b.bar = bar; b.x = xb_xcc_id(); b.st = st;
    if (threadIdx.x == 0) (void)xb_add(&bar[XB_XCNT(b.x)], 1u);
    return b;
}
__device__ __forceinline__ void xcd_barrier_complete(unsigned* bar, unsigned x, unsigned& nloc, unsigned& nx) {
    const unsigned G = gridDim.x * gridDim.y * gridDim.z;
    unsigned sum, cnt, mine, sp = 0u;
    for (;;) {
        sum = 0u; cnt = 0u; mine = 0u;
#pragma unroll
        for (unsigned j = 0; j < 16; ++j) { const unsigned c = xb_ld(&bar[XB_XCNT(j)]); sum += c; cnt += (c > 0u) ? 1u : 0u; mine = (j == x) ? c : mine; }
        if (sum == G) break;
        __builtin_amdgcn_s_sleep(1);
        if ((++sp & 255u) == 0u) { if (xb_ld(&bar[XB_TMO])) break; if (sp > XB_SPIN_CAP) { atomicAdd(&bar[XB_TMO], 1u); break; } }
    }
    nloc = mine > 0u ? mine : 1u; nx = cnt > 0u ? cnt : 1u;
}
__device__ __forceinline__ void xcd_barrier(const XcdBarrier& b, const int tid) {
    asm volatile("s_waitcnt vmcnt(0)" ::: "memory");
    __syncthreads();
    if (tid == 0) {
        unsigned* bar = b.bar;
        __builtin_amdgcn_s_waitcnt(0);
        unsigned nloc = b.st[0], nx = b.st[1];
        if (nloc == 0u) { xcd_barrier_complete(bar, b.x, nloc, nx); b.st[0] = nloc; b.st[1] = nx; }
        const unsigned old = xb_add(&bar[XB_XSUB(b.x)], 1u);
        const unsigned gen = old / nloc;
        if (old + 1u == (gen + 1u) * nloc) {
            __builtin_amdgcn_fence(__ATOMIC_RELEASE, "agent");
            asm volatile("s_waitcnt vmcnt(0)" ::: "memory");
            const unsigned og = xb_add(&bar[XB_TOP], 1u);
            const unsigned tg = og / nx;
            if (og + 1u == (tg + 1u) * nx) xb_add(&bar[XB_TOPGEN], 1u);
            else XB_SPIN(xb_ld(&bar[XB_TOPGEN]) == tg, bar);
            __builtin_amdgcn_fence(__ATOMIC_ACQUIRE, "agent");
            xb_add(&bar[XB_XGEN(b.x)], 1u);
            asm volatile("s_waitcnt vmcnt(0)" ::: "memory");
        } else {
            XB_SPIN(xb_ld(&bar[XB_XGEN(b.x)]) == gen, bar);
            __builtin_amdgcn_fence(__ATOMIC_ACQUIRE, "agent");
            asm volatile("s_waitcnt vmcnt(0)" ::: "memory");
        }
    }
    __syncthreads();
}

namespace pg8 {
#define PG8_LAS __attribute__((address_space(3)))
typedef unsigned short bf16_t;
typedef short bf16x8 __attribute__((ext_vector_type(8)));
typedef float f32x4 __attribute__((ext_vector_type(4)));
typedef unsigned u32x4 __attribute__((ext_vector_type(4)));
constexpr int BM = 256, BK = 64, HALF = 128, HTB = HALF * BK * 2  , STAGE_BYTES = 8 * HTB, NXCD = 8, WGM = 8;

__host__ __device__ __forceinline__ int lds_byte(int r, int c) { const int st = (r >> 4) * 2 + (c >> 5), rr = r & 15, cc = c & 31, ob = rr * 64 + cc * 2; return st * 1024 + (ob ^ (((ob >> 9) & 1) << 5)); }
__host__ __device__ __forceinline__ void stage_rc(int b, int& R, int& C) { const int st = b / 1024, sb = b % 1024, swz = sb ^ (((sb >> 9) & 1) << 5); R = (st >> 1) * 16 + swz / 64; C = (st & 1) * 32 + (swz % 64) / 2; }
__host__ __device__ __forceinline__ int perm32(int rho) { const int n = rho >> 4, i = rho & 15; return 8 * (i >> 2) + 4 * n + (i & 3); }

struct Unit { int pm, pn, eb, p0, cnt; };
struct Gemm { const bf16_t* A; const bf16_t* Bt; int M, N, K; int lda; size_t bstride; const unsigned* list; int cap; size_t astride; int kstepA; };

struct StaticOrder {
    int nM, nN, nwg, G, c;
    __host__ __device__ void init(int M, int N, int G_, int c_) { nM = M / BM; nN = N / BM; nwg = nM * nN; G = G_; c = c_; }
    __host__ __device__ bool next(int i, Unit& u) const {
        const long L = (long)i * G + c; if (L >= nwg) return false;
        int wgid = (int)L; { const int q = nwg / NXCD, r = nwg % NXCD, xcd = wgid % NXCD, off = wgid / NXCD; wgid = (xcd < r ? xcd * (q + 1) : r * (q + 1) + (xcd - r) * q) + off; }
        const int nig = WGM * nN, gid = wgid / nig, fm = gid * WGM, gsz = (nM - fm) < WGM ? (nM - fm) : WGM;
        u.pm = fm + ((wgid % nig) % gsz); u.pn = (wgid % nig) / gsz; u.eb = 0; u.p0 = 0; u.cnt = 0; return true;
    }
    __device__ __forceinline__ void a_ready(const Unit&) const {}
    __device__ __forceinline__ void done(const Unit&) const {}
};

__device__ __forceinline__ unsigned cvt_pk_bf16(float lo, float hi) { unsigned r; asm volatile("v_cvt_pk_bf16_f32 %0, %1, %2" : "=v"(r) : "v"(lo), "v"(hi)); return r; }
typedef float f32x2 __attribute__((ext_vector_type(2)));
__device__ __forceinline__ f32x2 gelu_pk(f32x2 v) {
    const f32x2 av = __builtin_elementwise_abs(v), d = av * 0.2316418882f + 1.0f;
    f32x2 t; t.x = __builtin_amdgcn_rcpf(d.x); t.y = __builtin_amdgcn_rcpf(d.y);
    f32x2 q = t * 0.5307027145f + (-0.7265760135f); q = q * t + 0.7107068705f; q = q * t + (-0.142248368f); q = q * t + 0.127414796f; q = q * t;
    const f32x2 s = (v * v) * (-0.72134752044f);
    f32x2 e; e.x = __builtin_amdgcn_exp2f(s.x); e.y = __builtin_amdgcn_exp2f(s.y);
    const f32x2 m = v * (q * e), r = v - m;
    f32x2 o; o.x = v.x < 0.f ? m.x : r.x; o.y = v.y < 0.f ? m.y : r.y; return o;
}

template <int ACT  > struct EpiBf16 {
    static constexpr bool PERM = true, AFTER_DRAIN = false; static_assert(ACT == 0 || ACT == 1, "EpiBf16: ACT is 0 (none) or 1 (gelu_pk)");
    bf16_t* O; int ldc; const float* bias; int split_cols; size_t split_stride; float scale0;
    __device__ __forceinline__ void operator()(const f32x4 (&acc)[2][2][4][2], const Unit& u, int wr, int wc, int fr, int fq) const {
        const int row0 = u.pm * BM + wr * 64 + fr; int colt = u.pn * BM; bf16_t* base = O;
        float sc = 1.f; if (split_cols) { const int t = colt / split_cols; base += (size_t)t * split_stride; colt -= t * split_cols; if (t == 0) sc = scale0; }
        const int col0 = colt + wc * 32 + 8 * fq, bcol0 = u.pn * BM + wc * 32 + 8 * fq;
        f32x4 bv[2][2];
#pragma unroll
        for (int bj = 0; bj < 2; ++bj)
#pragma unroll
            for (int n = 0; n < 2; ++n) bv[bj][n] = bias ? *(const f32x4*)(bias + bcol0 + bj * HALF + 4 * n) : (f32x4){0.f, 0.f, 0.f, 0.f};
#pragma unroll
        for (int ai = 0; ai < 2; ++ai)
#pragma unroll
            for (int m = 0; m < 4; ++m) { bf16_t* rowp = base + (size_t)(row0 + ai * HALF + m * 16) * ldc + col0;
#pragma unroll
                for (int bj = 0; bj < 2; ++bj) { f32x4 v0 = acc[ai][bj][m][0] + bv[bj][0], v1 = acc[ai][bj][m][1] + bv[bj][1];
                    if (ACT == 1) { f32x2 a = gelu_pk((f32x2){v0[0], v0[1]}), b = gelu_pk((f32x2){v0[2], v0[3]}), c = gelu_pk((f32x2){v1[0], v1[1]}), d = gelu_pk((f32x2){v1[2], v1[3]});
                        v0 = (f32x4){a.x, a.y, b.x, b.y}; v1 = (f32x4){c.x, c.y, d.x, d.y}; }
                    v0 = v0 * sc; v1 = v1 * sc; u32x4 w; w.x = cvt_pk_bf16(v0[0], v0[1]); w.y = cvt_pk_bf16(v0[2], v0[3]); w.z = cvt_pk_bf16(v1[0], v1[1]); w.w = cvt_pk_bf16(v1[2], v1[3]);
                    *(u32x4*)(rowp + bj * HALF) = w; } }
    }
};
template <class Epi, class Sched, bool ALIGN_EPI = false, bool SP2 = false>
__device__ __forceinline__ void gemm_phase(PG8_LAS unsigned char* lds, const Gemm g, const Sched& S, const Epi& E) {
    int tid_ = threadIdx.x; asm volatile("" : "+v"(tid_));
    const int tid = tid_, wid = __builtin_amdgcn_readfirstlane(tid >> 6), lane = tid & 63, wr = wid >> 2, wc = wid & 3, fr = lane & 15, fq = lane >> 4;
    const int K = g.K, nt = K / BK;
    unsigned voffA[2], voffB[2];
#pragma unroll
    for (int i = 0; i < 2; ++i) { int R, C; stage_rc(tid * 16 + i * 8192, R, C); const int Rb = Epi::PERM ? ((R & ~31) + perm32(R & 31)) : R;
        voffA[i] = (unsigned)(R * K + C) * 2u; voffB[i] = (unsigned)(Rb * K + C) * 2u; }
    const size_t kstep = (size_t)(BK * 2);
    const size_t hstep = (size_t)HALF * K * 2;
    const size_t tstep = 2 * hstep;
    const unsigned ldsw = (unsigned)wid * 1024u;
    const int aoff = lds_byte(wr * 64 + fr, fq * 8), boff = lds_byte(wc * 32 + fr, fq * 8);
#define PG8_SA(b, h) (((b) * 2 + (h)) * HTB)
#define PG8_SB(b, h) ((4 + (b) * 2 + (h)) * HTB)
#define PG8_STAGE(bufoff, gbase, voff) do { _Pragma("unroll") for (int _i = 0; _i < 2; ++_i) \
        __builtin_amdgcn_global_load_lds((const unsigned*)((const char*)(gbase) + (voff)[_i]), (PG8_LAS unsigned*)(lds + (bufoff) + ldsw + _i * 8192), 16, 0, 0); } while (0)
#define PG8_LDA(dst, b, h) do { _Pragma("unroll") for (int m = 0; m < 4; ++m) _Pragma("unroll") for (int k = 0; k < 2; ++k) dst[m][k] = *(const PG8_LAS bf16x8*)(lds + PG8_SA(b, h) + aoff + m * 2048 + k * 1024); } while (0)
#define PG8_LDB(dst, b, h) do { _Pragma("unroll") for (int n = 0; n < 2; ++n) _Pragma("unroll") for (int k = 0; k < 2; ++k) dst[n][k] = *(const PG8_LAS bf16x8*)(lds + PG8_SB(b, h) + boff + n * 2048 + k * 1024); } while (0)
#define PG8_MMA(ai, bj, At, Bt) do { __builtin_amdgcn_s_setprio(1); _Pragma("unroll") for (int m = 0; m < 4; ++m) _Pragma("unroll") for (int n = 0; n < 2; ++n) _Pragma("unroll") for (int k = 0; k < 2; ++k) \
        acc[ai][bj][m][n] = __builtin_amdgcn_mfma_f32_16x16x32_bf16(Bt[n][k], At[m][k], acc[ai][bj][m][n], 0, 0, 0); __builtin_amdgcn_s_setprio(0); } while (0)
#define PG8_WAIT_V(n) asm volatile("s_waitcnt vmcnt(" #n ")" ::: "memory")
#define PG8_WAIT_L(n) asm volatile("s_waitcnt lgkmcnt(" #n ")" ::: "memory")
#define PG8_BAR __builtin_amdgcn_s_barrier()
#define PG8_SCHED __builtin_amdgcn_sched_barrier(0)
    Unit cur, nxt; int ui = 0;
    if (!S.next(0, cur)) return;
    f32x4 acc[2][2][4][2];
#pragma unroll
    for (int a = 0; a < 2; ++a)
#pragma unroll
        for (int b = 0; b < 2; ++b)
#pragma unroll
            for (int m = 0; m < 4; ++m)
#pragma unroll
                for (int n = 0; n < 2; ++n) acc[a][b][m][n] = (f32x4){0.f, 0.f, 0.f, 0.f};
    bf16x8 At[4][2], B0[2][2], B1[2][2];
    const char* cA = (const char*)g.A + (size_t)cur.pm * tstep; const char* cB = (const char*)g.Bt + (size_t)cur.pn * tstep;
    S.a_ready(cur);
    if constexpr (SP2) {
        PG8_STAGE(PG8_SB(0, 0), cB, voffB); PG8_STAGE(PG8_SB(0, 1), cB + hstep, voffB); PG8_STAGE(PG8_SA(0, 0), cA, voffA); PG8_STAGE(PG8_SA(0, 1), cA + hstep, voffA);
        if (wr == 1) PG8_BAR;
        PG8_WAIT_V(2); PG8_BAR;
        PG8_STAGE(PG8_SB(1, 0), cB + kstep, voffB); PG8_STAGE(PG8_SA(1, 0), cA + kstep, voffA); PG8_STAGE(PG8_SB(1, 1), cB + hstep + kstep, voffB);
        PG8_WAIT_V(6); PG8_BAR;
    } else {
        PG8_STAGE(PG8_SB(0, 0), cB, voffB); PG8_STAGE(PG8_SA(0, 0), cA, voffA); PG8_STAGE(PG8_SB(0, 1), cB + hstep, voffB); PG8_STAGE(PG8_SA(0, 1), cA + hstep, voffA);
        if (wr == 1) PG8_BAR;
        PG8_WAIT_V(4); PG8_BAR;
        PG8_STAGE(PG8_SB(1, 0), cB + kstep, voffB); PG8_STAGE(PG8_SA(1, 0), cA + kstep, voffA); PG8_STAGE(PG8_SB(1, 1), cB + hstep + kstep, voffB);
        PG8_WAIT_V(6); PG8_BAR;
    }
    for (;;) {
        const bool has_next = S.next(ui + 1, nxt);
        const char* nA = has_next ? (const char*)g.A + (size_t)nxt.pm * tstep : cA; const char* nB = has_next ? (const char*)g.Bt + (size_t)nxt.pn * tstep : cB;
        for (int t = 0; t < nt; t += 2) {
            const bool last = (t == nt - 2);
            const char* a1 = cA + (size_t)(t + 1) * kstep;
            const char* a2 = last ? nA : cA + (size_t)(t + 2) * kstep; const char* b2 = last ? nB : cB + (size_t)(t + 2) * kstep;
            const char* a3 = a2 + kstep; const char* b3 = b2 + kstep;
            if (last && has_next) S.a_ready(nxt);
            if constexpr (SP2) {
            PG8_LDB(B0, 0, 0); PG8_LDB(B1, 0, 1); PG8_SCHED; PG8_LDA(At, 0, 0); PG8_STAGE(PG8_SA(1, 1), a1 + hstep, voffA);
            PG8_WAIT_V(8); PG8_WAIT_L(0); PG8_BAR; PG8_MMA(0, 0, At, B0); PG8_MMA(0, 1, At, B1); PG8_BAR; PG8_SCHED;
            PG8_LDA(At, 0, 1); PG8_STAGE(PG8_SB(0, 0), b2, voffB); PG8_STAGE(PG8_SB(0, 1), b2 + hstep, voffB); PG8_STAGE(PG8_SA(0, 0), a2, voffA);
            PG8_WAIT_V(8); PG8_WAIT_L(0); PG8_BAR; PG8_MMA(1, 0, At, B0); PG8_MMA(1, 1, At, B1); PG8_BAR; PG8_SCHED;
            PG8_LDB(B0, 1, 0); PG8_LDB(B1, 1, 1); PG8_SCHED; PG8_LDA(At, 1, 0); PG8_STAGE(PG8_SA(0, 1), a2 + hstep, voffA);
            PG8_WAIT_V(8); PG8_WAIT_L(0); PG8_BAR; PG8_MMA(0, 0, At, B0); PG8_MMA(0, 1, At, B1); PG8_BAR; PG8_SCHED;
            PG8_LDA(At, 1, 1); PG8_STAGE(PG8_SB(1, 0), b3, voffB); PG8_STAGE(PG8_SB(1, 1), b3 + hstep, voffB); PG8_STAGE(PG8_SA(1, 0), a3, voffA);
            PG8_WAIT_V(8); PG8_WAIT_L(0); PG8_BAR; PG8_MMA(1, 0, At, B0); PG8_MMA(1, 1, At, B1); PG8_BAR; PG8_SCHED;
            } else {
            PG8_LDB(B0, 0, 0); PG8_SCHED; PG8_LDA(At, 0, 0); PG8_STAGE(PG8_SA(1, 1), a1 + hstep, voffA);
            PG8_WAIT_L(8); PG8_BAR; PG8_WAIT_L(0); PG8_MMA(0, 0, At, B0); PG8_BAR; PG8_SCHED;
            PG8_LDB(B1, 0, 1); PG8_STAGE(PG8_SB(0, 0), b2, voffB);
            PG8_BAR; PG8_WAIT_L(0); PG8_MMA(0, 1, At, B1); PG8_BAR;
            PG8_LDA(At, 0, 1); PG8_STAGE(PG8_SA(0, 0), a2, voffA);
            PG8_BAR; PG8_WAIT_L(0); PG8_MMA(1, 0, At, B0); PG8_BAR; PG8_SCHED;
            PG8_STAGE(PG8_SB(0, 1), b2 + hstep, voffB);
            PG8_WAIT_V(6); PG8_BAR; PG8_MMA(1, 1, At, B1); PG8_BAR;
            PG8_LDB(B0, 1, 0); PG8_SCHED; PG8_LDA(At, 1, 0); PG8_STAGE(PG8_SA(0, 1), a2 + hstep, voffA);
            PG8_WAIT_L(8); PG8_BAR; PG8_WAIT_L(0); PG8_MMA(0, 0, At, B0); PG8_BAR; PG8_SCHED;
            PG8_LDB(B1, 1, 1); PG8_STAGE(PG8_SB(1, 0), b3, voffB);
            PG8_BAR; PG8_WAIT_L(0); PG8_MMA(0, 1, At, B1); PG8_BAR;
            PG8_LDA(At, 1, 1); PG8_STAGE(PG8_SA(1, 0), a3, voffA);
            PG8_BAR; PG8_WAIT_L(0); PG8_MMA(1, 0, At, B0); PG8_BAR; PG8_SCHED;
            PG8_STAGE(PG8_SB(1, 1), b3 + hstep, voffB);
            PG8_WAIT_V(6); PG8_BAR; PG8_MMA(1, 1, At, B1); PG8_BAR;
            }
        }
        if constexpr (ALIGN_EPI) { if (wr == 0) PG8_BAR; }
        if constexpr (!Epi::AFTER_DRAIN) { E(acc, cur, wr, wc, fr, fq); S.done(cur); }
        if (!has_next) break;
#pragma unroll
        for (int a = 0; a < 2; ++a)
#pragma unroll
            for (int b = 0; b < 2; ++b)
#pragma unroll
                for (int m = 0; m < 4; ++m)
#pragma unroll
                    for (int n = 0; n < 2; ++n) acc[a][b][m][n] = (f32x4){0.f, 0.f, 0.f, 0.f};
        cur = nxt; cA = nA; cB = nB; ++ui;
        if constexpr (ALIGN_EPI) { if (wr == 1) PG8_BAR; }
    }
    PG8_WAIT_V(0);
    if constexpr (!ALIGN_EPI) { if (wr == 0) PG8_BAR; }
    PG8_BAR;
    if constexpr (Epi::AFTER_DRAIN) { E.fused(acc, cur, wr, wc, fr, fq, lds, wid, lane); S.done(cur); }
#undef PG8_SA
#undef PG8_SB
#undef PG8_STAGE
#undef PG8_LDA
#undef PG8_LDB
#undef PG8_MMA
#undef PG8_WAIT_V
#undef PG8_WAIT_L
#undef PG8_BAR
#undef PG8_SCHED
}

__device__ __forceinline__ float sigm(float x) { return 1.0f / (1.0f + __expf(-x)); }
struct EpiGlu {
    static constexpr bool PERM = true, AFTER_DRAIN = false;
    bf16_t* O; int ldc;
    __device__ __forceinline__ void operator()(const f32x4 (&acc)[2][2][4][2], const Unit& u, int wr, int wc, int fr, int fq) const {
        const int row0 = u.pm * BM + wr * 64 + fr, col0 = u.pn * HALF + wc * 32 + 8 * fq;
#pragma unroll
        for (int ai = 0; ai < 2; ++ai)
#pragma unroll
            for (int m = 0; m < 4; ++m) {
                bf16_t* rowp = O + (size_t)(row0 + ai * HALF + m * 16) * ldc + col0;
                const f32x4 a0 = acc[ai][0][m][0], a1 = acc[ai][0][m][1], b0 = acc[ai][1][m][0], b1 = acc[ai][1][m][1];
                u32x4 w;
                w.x = cvt_pk_bf16(a0[0] * sigm(b0[0]), a0[1] * sigm(b0[1])); w.y = cvt_pk_bf16(a0[2] * sigm(b0[2]), a0[3] * sigm(b0[3]));
                w.z = cvt_pk_bf16(a1[0] * sigm(b1[0]), a1[1] * sigm(b1[1])); w.w = cvt_pk_bf16(a1[2] * sigm(b1[2]), a1[3] * sigm(b1[3]));
                *(u32x4*)rowp = w;
            }
    }
};
struct EpiResid {
    static constexpr bool PERM = false, AFTER_DRAIN = false;
    const float* X; float* O; int ldc;
    __device__ __forceinline__ void operator()(const f32x4 (&acc)[2][2][4][2], const Unit& u, int wr, int wc, int fr, int fq) const {
        const int row0 = u.pm * BM + wr * 64 + fr, col0 = u.pn * BM + wc * 32 + 4 * fq;
#pragma unroll
        for (int ai = 0; ai < 2; ++ai)
#pragma unroll
            for (int m = 0; m < 4; ++m) {
                const size_t off = (size_t)(row0 + ai * HALF + m * 16) * ldc + col0;
#pragma unroll
                for (int bj = 0; bj < 2; ++bj)
#pragma unroll
                    for (int n = 0; n < 2; ++n) *(f32x4*)(O + off + bj * HALF + n * 16) = *(const f32x4*)(X + off + bj * HALF + n * 16) + acc[ai][bj][m][n];
            }
    }
};

struct ADense { static constexpr bool GATHER = false; __device__ __forceinline__ static unsigned rowoff(const Gemm&, const Unit&, int) { return 0u; } };
struct AList { static constexpr bool GATHER = true;
    __device__ __forceinline__ static unsigned rowoff(const Gemm& g, const Unit& u, int r) { const int pos = u.p0 + r; const unsigned tok = pos < u.cnt ? (g.list[(size_t)u.eb * g.cap + pos] >> 1) : 0u; return tok * (unsigned)g.lda * 2u; } };
struct ACompress { static constexpr bool GATHER = true;
    __device__ __forceinline__ static unsigned rowoff(const Gemm&, const Unit& u, int r) { const unsigned rg = (unsigned)(u.pm * BM + r), b = rg >> 9, n = (rg >> 1) & 255u, hkv = rg & 1u;
        return (((b * 4096u + 16u * n) * 2048u) + 1024u + (unsigned)u.eb * 128u + hkv * 64u) * 2u; } };
template <class Epi, class Sched, class AMap>
__device__ __forceinline__ void gemm2(PG8_LAS unsigned char* lds, const Gemm g, const Sched& S, const Epi& E, const int tid) {
    constexpr bool GATHER = AMap::GATHER;
    int K_ = g.K; asm volatile("" : "+s"(K_));
    const int wid = __builtin_amdgcn_readfirstlane(tid >> 6), lane = tid & 63, wr = wid >> 2, wc = wid & 3, fr = lane & 15, fq = lane >> 4;
    const int K = K_, nt = K / BK, lda = g.lda;
    unsigned voffA[2], voffB[2]; int Rst[2], Cst[2];
#pragma unroll
    for (int i = 0; i < 2; ++i) { int R, C; stage_rc(tid * 16 + i * 8192, R, C); const int Rb = Epi::PERM ? ((R & ~31) + perm32(R & 31)) : R;
        voffA[i] = (unsigned)(R * lda + C) * 2u; voffB[i] = (unsigned)(Rb * K + C) * 2u; Rst[i] = R; Cst[i] = C; }
    const size_t kstep = (size_t)(BK * 2), kstepA = (size_t)g.kstepA;
    const size_t hstepA = (size_t)HALF * lda * 2, tstepA = 2 * hstepA, hstepB = (size_t)HALF * K * 2, tstepB = 2 * hstepB;
    const unsigned ldsw = (unsigned)wid * 1024u;
    const int aoff = lds_byte(wr * 64 + fr, fq * 8), boff = lds_byte(wc * 32 + fr, fq * 8);
#define PG8_SA(b, h) (((b) * 2 + (h)) * HTB)
#define PG8_SB(b, h) ((4 + (b) * 2 + (h)) * HTB)
#define PG8_STAGE(bufoff, gbase, voff) do { _Pragma("unroll") for (int _i = 0; _i < 2; ++_i) \
        __builtin_amdgcn_global_load_lds((const unsigned*)((const char*)(gbase) + (voff)[_i]), (PG8_LAS unsigned*)(lds + (bufoff) + ldsw + _i * 8192), 16, 0, 0); } while (0)
#define PG8_STAGE_A(bufoff, gbase, h) do { if constexpr (GATHER) { PG8_STAGE(bufoff, gbase, vg[h]); } else { PG8_STAGE(bufoff, (gbase) + (h) * hstepA, voffA); } } while (0)
#define PG8_GOFFS(u, dst) do { _Pragma("unroll") for (int _h = 0; _h < 2; ++_h) _Pragma("unroll") for (int _i = 0; _i < 2; ++_i) dst[_h][_i] = AMap::rowoff(g, (u), _h * HALF + Rst[_i]) + (unsigned)Cst[_i] * 2u; } while (0)
#define PG8_LDA(dst, b, h) do { _Pragma("unroll") for (int m = 0; m < 4; ++m) _Pragma("unroll") for (int k = 0; k < 2; ++k) dst[m][k] = *(const PG8_LAS bf16x8*)(lds + PG8_SA(b, h) + aoff + m * 2048 + k * 1024); } while (0)
#define PG8_LDB(dst, b, h) do { _Pragma("unroll") for (int n = 0; n < 2; ++n) _Pragma("unroll") for (int k = 0; k < 2; ++k) dst[n][k] = *(const PG8_LAS bf16x8*)(lds + PG8_SB(b, h) + boff + n * 2048 + k * 1024); } while (0)
#define PG8_MMA(ai, bj, At, Bt) do { __builtin_amdgcn_s_setprio(1); _Pragma("unroll") for (int m = 0; m < 4; ++m) _Pragma("unroll") for (int n = 0; n < 2; ++n) _Pragma("unroll") for (int k = 0; k < 2; ++k) \
        acc[ai][bj][m][n] = __builtin_amdgcn_mfma_f32_16x16x32_bf16(Bt[n][k], At[m][k], acc[ai][bj][m][n], 0, 0, 0); __builtin_amdgcn_s_setprio(0); } while (0)
#define PG8_WAIT_V(n) asm volatile("s_waitcnt vmcnt(" #n ")" ::: "memory")
#define PG8_WAIT_L(n) asm volatile("s_waitcnt lgkmcnt(" #n ")" ::: "memory")
#define PG8_BAR __builtin_amdgcn_s_barrier()
#define PG8_SCHED __builtin_amdgcn_sched_barrier(0)
    Unit cur, nxt; int ui = 0;
    if (!S.next(0, cur)) return;
    f32x4 acc[2][2][4][2];
#pragma unroll
    for (int a = 0; a < 2; ++a)
#pragma unroll
        for (int b = 0; b < 2; ++b)
#pragma unroll
            for (int m = 0; m < 4; ++m)
#pragma unroll
                for (int n = 0; n < 2; ++n) acc[a][b][m][n] = (f32x4){0.f, 0.f, 0.f, 0.f};
    bf16x8 At[4][2], B0[2][2], B1[2][2];
    unsigned vg[2][2] = {{0u, 0u}, {0u, 0u}};
    if constexpr (GATHER) PG8_GOFFS(cur, vg);
    const char* cA = (const char*)g.A + (GATHER ? (size_t)0 : (size_t)cur.pm * tstepA + (size_t)cur.eb * g.astride * 2);
    const char* cB = (const char*)g.Bt + ((size_t)cur.eb * g.bstride) * 2 + (size_t)cur.pn * tstepB;
    S.a_ready(cur);
    PG8_STAGE(PG8_SB(0, 0), cB, voffB); PG8_STAGE(PG8_SB(0, 1), cB + hstepB, voffB); PG8_STAGE_A(PG8_SA(0, 0), cA, 0); PG8_STAGE_A(PG8_SA(0, 1), cA, 1);
    if (wr == 1) PG8_BAR;
    PG8_WAIT_V(2); PG8_BAR;
    PG8_STAGE(PG8_SB(1, 0), cB + kstep, voffB); PG8_STAGE_A(PG8_SA(1, 0), cA + kstepA, 0); PG8_STAGE(PG8_SB(1, 1), cB + hstepB + kstep, voffB);
    PG8_WAIT_V(6); PG8_BAR;
    for (;;) {
        const bool has_next = S.next(ui + 1, nxt);
        const char* nA = has_next ? (const char*)g.A + (GATHER ? (size_t)0 : (size_t)nxt.pm * tstepA + (size_t)nxt.eb * g.astride * 2) : cA;
        const char* nB = has_next ? (const char*)g.Bt + ((size_t)nxt.eb * g.bstride) * 2 + (size_t)nxt.pn * tstepB : cB;
        for (int t = 0; t < nt; t += 2) {
            const bool last = (t == nt - 2);
            const char* a1 = cA + (size_t)(t + 1) * kstepA;
            const char* a2 = last ? nA : cA + (size_t)(t + 2) * kstepA; const char* b2 = last ? nB : cB + (size_t)(t + 2) * kstep;
            const char* a3 = a2 + kstepA; const char* b3 = b2 + kstep;
            unsigned vn1[2] = {vg[1][0], vg[1][1]};
            if constexpr (GATHER) { if (last && has_next) { unsigned vn[2][2]; PG8_GOFFS(nxt, vn); vg[0][0] = vn[0][0]; vg[0][1] = vn[0][1]; vn1[0] = vn[1][0]; vn1[1] = vn[1][1]; } }
            if (last && has_next) S.a_ready(nxt);
            PG8_LDB(B0, 0, 0); PG8_LDB(B1, 0, 1); PG8_SCHED; PG8_LDA(At, 0, 0); PG8_STAGE_A(PG8_SA(1, 1), a1, 1);
            PG8_WAIT_V(8); PG8_WAIT_L(0); PG8_BAR; PG8_MMA(0, 0, At, B0); PG8_MMA(0, 1, At, B1); PG8_BAR; PG8_SCHED;
            if constexpr (GATHER) { vg[1][0] = vn1[0]; vg[1][1] = vn1[1]; }
            PG8_LDA(At, 0, 1); PG8_STAGE(PG8_SB(0, 0), b2, voffB); PG8_STAGE(PG8_SB(0, 1), b2 + hstepB, voffB); PG8_STAGE_A(PG8_SA(0, 0), a2, 0);
            PG8_WAIT_V(8); PG8_WAIT_L(0); PG8_BAR; PG8_MMA(1, 0, At, B0); PG8_MMA(1, 1, At, B1); PG8_BAR; PG8_SCHED;
            PG8_LDB(B0, 1, 0); PG8_LDB(B1, 1, 1); PG8_SCHED; PG8_LDA(At, 1, 0); PG8_STAGE_A(PG8_SA(0, 1), a2, 1);
            PG8_WAIT_V(8); PG8_WAIT_L(0); PG8_BAR; PG8_MMA(0, 0, At, B0); PG8_MMA(0, 1, At, B1); PG8_BAR; PG8_SCHED;
            PG8_LDA(At, 1, 1); PG8_STAGE(PG8_SB(1, 0), b3, voffB); PG8_STAGE(PG8_SB(1, 1), b3 + hstepB, voffB); PG8_STAGE_A(PG8_SA(1, 0), a3, 0);
            PG8_WAIT_V(8); PG8_WAIT_L(0); PG8_BAR; PG8_MMA(1, 0, At, B0); PG8_MMA(1, 1, At, B1); PG8_BAR; PG8_SCHED;
        }
        if (wr == 0) PG8_BAR;
        E(acc, cur, wr, wc, fr, fq); S.done(cur);
        if (!has_next) break;
#pragma unroll
        for (int a = 0; a < 2; ++a)
#pragma unroll
            for (int b = 0; b < 2; ++b)
#pragma unroll
                for (int m = 0; m < 4; ++m)
#pragma unroll
                    for (int n = 0; n < 2; ++n) acc[a][b][m][n] = (f32x4){0.f, 0.f, 0.f, 0.f};
        cur = nxt; cA = nA; cB = nB; ++ui;
        if (wr == 1) PG8_BAR;
    }
    PG8_WAIT_V(0);
    PG8_BAR;
#undef PG8_SA
#undef PG8_SB
#undef PG8_STAGE
#undef PG8_STAGE_A
#undef PG8_GOFFS
#undef PG8_LDA
#undef PG8_LDB
#undef PG8_MMA
#undef PG8_WAIT_V
#undef PG8_WAIT_L
#undef PG8_BAR
#undef PG8_SCHED
}

struct ExpertOrder {
    const PG8_LAS int* tab; int nN, G, c;
    __device__ __forceinline__ bool next(int i, Unit& u) const {
        int rt, pn, e;
        if ((G & 7) == 0) {
            const int x = c & 7, R = G >> 3, Lx = i * R + (c >> 3);
            const int n0 = (tab[x + 1] - tab[x]) * nN, n1 = (tab[x + 9] - tab[x + 8]) * nN, n2 = (tab[x + 17] - tab[x + 16]) * nN, n3 = (tab[x + 25] - tab[x + 24]) * nN;
            const int c1 = n0, c2 = n0 + n1, c3 = c2 + n2, c4 = c3 + n3;
            if (Lx >= c4) return false;
            const int k = (Lx >= c1 ? 1 : 0) + (Lx >= c2 ? 1 : 0) + (Lx >= c3 ? 1 : 0), ul = Lx - (k == 0 ? 0 : (k == 1 ? c1 : (k == 2 ? c2 : c3)));
            e = x + 8 * k; rt = tab[e] + ul / nN; pn = ul % nN;
        } else {
            const int total = tab[32] * nN; const long L = (long)i * G + c; if (L >= total) return false;
            rt = (int)L / nN; pn = (int)L % nN; e = 0;
#pragma unroll
            for (int k = 1; k < 32; ++k) e += (rt >= tab[k]) ? 1 : 0;
        }
        u.pm = __builtin_amdgcn_readfirstlane(rt); u.pn = __builtin_amdgcn_readfirstlane(pn); u.eb = __builtin_amdgcn_readfirstlane(e);
        u.p0 = __builtin_amdgcn_readfirstlane((rt - tab[e]) * BM); u.cnt = __builtin_amdgcn_readfirstlane(tab[33 + e]); return true;
    }
    __device__ __forceinline__ void a_ready(const Unit&) const {}
    __device__ __forceinline__ void done(const Unit&) const {}
};
struct EpiGateUp {
    static constexpr bool PERM = true, AFTER_DRAIN = false;
    bf16_t* H; const float* listw; int cap;
    __device__ __forceinline__ void operator()(const f32x4 (&acc)[2][2][4][2], const Unit& u, int wr, int wc, int fr, int fq) const {
        const int rl0 = wr * 64 + fr, col0 = u.pn * HALF + wc * 32 + 8 * fq;
#pragma unroll
        for (int ai = 0; ai < 2; ++ai)
#pragma unroll
            for (int m = 0; m < 4; ++m) {
                const int rl = rl0 + ai * HALF + m * 16, pos = u.p0 + rl;
                const float w = pos < u.cnt ? listw[(size_t)u.eb * cap + pos] : 0.f;
                bf16_t* rowp = H + (size_t)(u.pm * BM + rl) * 256 + col0;
                const f32x4 g0 = acc[ai][0][m][0], g1 = acc[ai][0][m][1], u0 = acc[ai][1][m][0], u1 = acc[ai][1][m][1];
                u32x4 o;
                o.x = cvt_pk_bf16(g0[0] * sigm(g0[0]) * u0[0] * w, g0[1] * sigm(g0[1]) * u0[1] * w); o.y = cvt_pk_bf16(g0[2] * sigm(g0[2]) * u0[2] * w, g0[3] * sigm(g0[3]) * u0[3] * w);
                o.z = cvt_pk_bf16(g1[0] * sigm(g1[0]) * u1[0] * w, g1[1] * sigm(g1[1]) * u1[1] * w); o.w = cvt_pk_bf16(g1[2] * sigm(g1[2]) * u1[2] * w, g1[3] * sigm(g1[3]) * u1[3] * w);
                *(u32x4*)rowp = o;
            }
    }
};
struct EpiDown {
    static constexpr bool PERM = true, AFTER_DRAIN = false;
    bf16_t* P1; long d12; const unsigned* list; int cap;
    __device__ __forceinline__ void operator()(const f32x4 (&acc)[2][2][4][2], const Unit& u, int wr, int wc, int fr, int fq) const {
        const int rl0 = wr * 64 + fr, col0 = u.pn * BM + wc * 32 + 8 * fq;
#pragma unroll
        for (int ai = 0; ai < 2; ++ai) {
            unsigned ent[4];
#pragma unroll
            for (int m = 0; m < 4; ++m) { const int pos = u.p0 + rl0 + ai * HALF + m * 16; ent[m] = pos < u.cnt ? list[(size_t)u.eb * cap + pos] : 0xffffffffu; }
#pragma unroll
            for (int m = 0; m < 4; ++m) {
                if (ent[m] != 0xffffffffu) {
                    bf16_t* dst = P1 + (long)(ent[m] & 1u) * d12 + (size_t)(ent[m] >> 1) * 1024 + col0;
#pragma unroll
                    for (int bj = 0; bj < 2; ++bj) { const f32x4 v0 = acc[ai][bj][m][0], v1 = acc[ai][bj][m][1];
                        u32x4 w; w.x = cvt_pk_bf16(v0[0], v0[1]); w.y = cvt_pk_bf16(v0[2], v0[3]); w.z = cvt_pk_bf16(v1[0], v1[1]); w.w = cvt_pk_bf16(v1[2], v1[3]);
                        *(u32x4*)(dst + bj * HALF) = w; }
                }
            }
            asm volatile("" ::: "memory");
        }
    }
};

struct BatchOrder {
    int nb, nM, nN, G, c;
    __device__ __forceinline__ bool next(int i, Unit& u) const {
        const long L = (long)i * G + c; if (L >= (long)nb * nM * nN) return false;
        const int per = nM * nN, e = (int)L / per, rem = (int)L % per;
        u.eb = e; u.pm = rem / nN; u.pn = rem % nN; u.p0 = 0; u.cnt = 0; return true;
    }
    __device__ __forceinline__ void a_ready(const Unit&) const {}
    __device__ __forceinline__ void done(const Unit&) const {}
};
struct EpiInProj {
    static constexpr bool PERM = true, AFTER_DRAIN = false;
    bf16_t* Zo; bf16_t* U;
    __device__ __forceinline__ void operator()(const f32x4 (&acc)[2][2][4][2], const Unit& u, int wr, int wc, int fr, int fq) const {
        const int row0 = u.pm * BM + wr * 64 + fr;
#pragma unroll
        for (int ai = 0; ai < 2; ++ai)
#pragma unroll
            for (int m = 0; m < 4; ++m) { const int row = row0 + ai * HALF + m * 16;
#pragma unroll
                for (int bj = 0; bj < 2; ++bj) { const int c0 = u.pn * BM + bj * HALF + wc * 32 + 8 * fq;
                    const f32x4 v0 = acc[ai][bj][m][0], v1 = acc[ai][bj][m][1];
                    u32x4 w; w.x = cvt_pk_bf16(v0[0], v0[1]); w.y = cvt_pk_bf16(v0[2], v0[3]); w.z = cvt_pk_bf16(v1[0], v1[1]); w.w = cvt_pk_bf16(v1[2], v1[3]);
                    bf16_t* dst = u.pn < 2 ? U + ((size_t)((c0 >> 4) * 2048 + (row >> 4)) * 512 + (row & 15) * 16 + (c0 & 15)) : Zo + (size_t)row * 2048 + c0;
                    *(u32x4*)dst = w; } }
    }
};
struct EpiXloc {
    static constexpr bool PERM = false, AFTER_DRAIN = false;
    float* XL;
    __device__ __forceinline__ void operator()(const f32x4 (&acc)[2][2][4][2], const Unit& u, int wr, int wc, int fr, int fq) const {
        const int row0 = u.pm * BM + wr * 64 + fr, col0 = wc * 32 + 4 * fq;
#pragma unroll
        for (int ai = 0; ai < 2; ++ai)
#pragma unroll
            for (int m = 0; m < 4; ++m) { float* rowp = XL + ((size_t)u.eb * 2048 + row0 + ai * HALF + m * 16) * 128 + col0;
#pragma unroll
                for (int n = 0; n < 2; ++n) *(f32x4*)(rowp + n * 16) = acc[ai][0][m][n]; }
    }
};
__device__ __forceinline__ float gelu_t(float x) { const float u2 = -2.302208198f * (x + 0.044715f * x * x * x); return x * __builtin_amdgcn_rcpf(1.0f + __builtin_amdgcn_exp2f(u2)); }
struct EpiSsmOut {
    static constexpr bool PERM = true, AFTER_DRAIN = false;
    bf16_t* G;
    __device__ __forceinline__ void operator()(const f32x4 (&acc)[2][2][4][2], const Unit& u, int wr, int wc, int fr, int fq) const {
        const int row0 = u.pm * BM + wr * 64 + fr;
#pragma unroll
        for (int ai = 0; ai < 2; ++ai)
#pragma unroll
            for (int m = 0; m < 4; ++m) { const int row = row0 + ai * HALF + m * 16;
#pragma unroll
                for (int bj = 0; bj < 2; ++bj) { const int n0 = bj * HALF + wc * 32 + 8 * fq;
                    const f32x4 v0 = acc[ai][bj][m][0], v1 = acc[ai][bj][m][1];
                    u32x4 w; w.x = cvt_pk_bf16(gelu_t(v0[0]), gelu_t(v0[1])); w.y = cvt_pk_bf16(gelu_t(v0[2]), gelu_t(v0[3])); w.z = cvt_pk_bf16(gelu_t(v1[0]), gelu_t(v1[1])); w.w = cvt_pk_bf16(gelu_t(v1[2]), gelu_t(v1[3]));
                    *(u32x4*)(G + ((size_t)row * 16 + (n0 >> 4)) * 512 + u.eb * 16 + (n0 & 15)) = w; } }
    }
};

struct CmpOrder {
    int G, c;
    __device__ __forceinline__ bool next(int i, Unit& u) const { const int L = i * G + c; if (L >= 32) return false; u.eb = L >> 4; u.pm = L & 15; u.pn = 0; u.p0 = 0; u.cnt = 0; return true; }
    __device__ __forceinline__ void a_ready(const Unit&) const {}
    __device__ __forceinline__ void done(const Unit&) const {}
};
struct EpiCmpHid {
    static constexpr bool PERM = false, AFTER_DRAIN = false;
    bf16_t* HC; const float* bias;
    __device__ __forceinline__ void operator()(const f32x4 (&acc)[2][2][4][2], const Unit& u, int wr, int wc, int fr, int fq) const {
        if (wc < 2) {
            const int row0 = u.pm * BM + wr * 64 + fr, col0 = wc * 32 + 4 * fq;
#pragma unroll
            for (int n = 0; n < 2; ++n) { const f32x4 bv = *(const f32x4*)(bias + u.eb * 64 + col0 + n * 16);
#pragma unroll
                for (int ai = 0; ai < 2; ++ai)
#pragma unroll
                    for (int m = 0; m < 4; ++m) { const f32x4 v = acc[ai][0][m][n] + bv;
                        typedef unsigned u32x2_ __attribute__((ext_vector_type(2)));
                        u32x2_ w; w.x = cvt_pk_bf16(gelu_t(v[0]), gelu_t(v[1])); w.y = cvt_pk_bf16(gelu_t(v[2]), gelu_t(v[3]));
                        *(u32x2_*)(HC + ((size_t)u.eb * 4096 + row0 + ai * HALF + m * 16) * 64 + col0 + n * 16) = w; } }
        }
    }
};

struct SingleUnit {
    int eb, pm;
    __device__ __forceinline__ bool next(int i, Unit& u) const { if (i > 0) return false; u.eb = eb; u.pm = pm; u.pn = 0; u.p0 = 0; u.cnt = 0; return true; }
    __device__ __forceinline__ void a_ready(const Unit&) const {}
    __device__ __forceinline__ void done(const Unit&) const {}
};
}

struct Args { const float* in[26]; float* out; unsigned char* ws; int ph_lo, ph_hi; };

struct Frame {
    LAS unsigned char* lds;
    int tid, lane, wave, blk, G;
};

__device__ __forceinline__ f32x4 bf4(u32x2 p) { f32x4 r; r.x = __uint_as_float(p.x << 16); r.y = __uint_as_float(p.x & 0xffff0000u); r.z = __uint_as_float(p.y << 16); r.w = __uint_as_float(p.y & 0xffff0000u); return r; }
__device__ __forceinline__ void ph_norm(const Frame& F, const float* xin, const bf16* add, const bf16* add2, float* xout, const float* g, bf16* hn) {
    const int gw = F.blk * NWAVES + F.wave, NGW = F.G * NWAVES;
    f32x4 gg[4];
#pragma unroll
    for (int j = 0; j < 4; ++j) gg[j] = ((const f32x4*)g)[F.lane + 64 * j];
    f32x4 nv[4]; u32x2 na[4], nb[4];
    if (gw < T) {
#pragma unroll
        for (int j = 0; j < 4; ++j) { nv[j] = ((const f32x4*)(xin + (size_t)gw * DM))[F.lane + 64 * j];
            if (add) { na[j] = ((const u32x2*)(add + (size_t)gw * DM))[F.lane + 64 * j]; nb[j] = ((const u32x2*)(add2 + (size_t)gw * DM))[F.lane + 64 * j]; } }
    }
    for (int row = gw; row < T; row += NGW) {
        f32x4 v[4]; float s = 0.f;
#pragma unroll
        for (int j = 0; j < 4; ++j) { v[j] = nv[j]; if (add) v[j] += bf4(na[j]) + bf4(nb[j]); }
        const int nrow = row + NGW;
        if (nrow < T) {
#pragma unroll
            for (int j = 0; j < 4; ++j) { nv[j] = ((const f32x4*)(xin + (size_t)nrow * DM))[F.lane + 64 * j];
                if (add) { na[j] = ((const u32x2*)(add + (size_t)nrow * DM))[F.lane + 64 * j]; nb[j] = ((const u32x2*)(add2 + (size_t)nrow * DM))[F.lane + 64 * j]; } }
        }
#pragma unroll
        for (int j = 0; j < 4; ++j) { if (add) ((f32x4*)(xout + (size_t)row * DM))[F.lane + 64 * j] = v[j];
            s += v[j].x * v[j].x + v[j].y * v[j].y + v[j].z * v[j].z + v[j].w * v[j].w; }
        s = wave_sum(s, F.lane);
        const float r = rsqrtf(s * (1.0f / DM) + EPS);
#pragma unroll
        for (int j = 0; j < 4; ++j) {
            u32x2 o; o.x = pk2(v[j].x * r * gg[j].x, v[j].y * r * gg[j].y); o.y = pk2(v[j].z * r * gg[j].z, v[j].w * r * gg[j].w);
            *(u32x2*)(hn + (size_t)row * DM + (F.lane + 64 * j) * 4) = o;
        }
    }
}
__device__ __forceinline__ void ph_final_norm(const Frame& F, float* x, const bf16* add, const bf16* add2, const float* g) {
    const int gw = F.blk * NWAVES + F.wave, NGW = F.G * NWAVES;
    f32x4 gg[4];
#pragma unroll
    for (int j = 0; j < 4; ++j) gg[j] = ((const f32x4*)g)[F.lane + 64 * j];
    f32x4 nv[4]; u32x2 na[4], nb[4];
    if (gw < T) {
#pragma unroll
        for (int j = 0; j < 4; ++j) { nv[j] = ((const f32x4*)(x + (size_t)gw * DM))[F.lane + 64 * j]; na[j] = ((const u32x2*)(add + (size_t)gw * DM))[F.lane + 64 * j]; nb[j] = ((const u32x2*)(add2 + (size_t)gw * DM))[F.lane + 64 * j]; }
    }
    for (int row = gw; row < T; row += NGW) {
        f32x4 v[4]; float s = 0.f;
#pragma unroll
        for (int j = 0; j < 4; ++j) { v[j] = nv[j] + bf4(na[j]) + bf4(nb[j]); s += v[j].x * v[j].x + v[j].y * v[j].y + v[j].z * v[j].z + v[j].w * v[j].w; }
        const int nrow = row + NGW;
        if (nrow < T) {
#pragma unroll
            for (int j = 0; j < 4; ++j) { nv[j] = ((const f32x4*)(x + (size_t)nrow * DM))[F.lane + 64 * j]; na[j] = ((const u32x2*)(add + (size_t)nrow * DM))[F.lane + 64 * j]; nb[j] = ((const u32x2*)(add2 + (size_t)nrow * DM))[F.lane + 64 * j]; }
        }
        s = wave_sum(s, F.lane);
        const float r = rsqrtf(s * (1.0f / DM) + EPS);
#pragma unroll
        for (int j = 0; j < 4; ++j) {
            f32x4 o; o.x = v[j].x * r * gg[j].x; o.y = v[j].y * r * gg[j].y; o.z = v[j].z * r * gg[j].z; o.w = v[j].w * r * gg[j].w;
            ((f32x4*)(x + (size_t)row * DM))[F.lane + 64 * j] = o;
        }
    }
}

template <bool DUAL, class Epi>
__device__ __forceinline__ void sgemm_naive(const Frame& F, const bf16* A, int lda, const float* B, int ldb, int M, int N, int K, int dualoff, const Epi& epi) {
    LAS float* As = (LAS float*)F.lds;
    LAS float* Bs = As + 16 * 132;
    LAS float* Bs2 = Bs + 16 * 128;
    const int tiles_n = (N + 127) / 128, tiles_m = M / 128;
    const int tx = F.tid & 31, ty = F.tid >> 5;
    for (int tile = F.blk; tile < tiles_m * tiles_n; tile += F.G) {
        const int tm = tile / tiles_n, tn = tile % tiles_n;
        float acc[8][4], acc2[8][4];
#pragma unroll
        for (int i = 0; i < 8; ++i)
#pragma unroll
            for (int j = 0; j < 4; ++j) { acc[i][j] = 0.f; acc2[i][j] = 0.f; }
        const int arow = F.tid >> 2, akq = (F.tid & 3) * 4;
        const int bk = F.tid >> 5, bn = (F.tid & 31) * 4;
        for (int k0 = 0; k0 < K; k0 += 16) {
            {
                const u32x2 av = *(const u32x2*)(A + (size_t)(tm * 128 + arow) * lda + k0 + akq);
                As[(akq + 0) * 132 + arow] = __uint_as_float(av.x << 16);
                As[(akq + 1) * 132 + arow] = __uint_as_float(av.x & 0xffff0000u);
                As[(akq + 2) * 132 + arow] = __uint_as_float(av.y << 16);
                As[(akq + 3) * 132 + arow] = __uint_as_float(av.y & 0xffff0000u);
                const int col = tn * 128 + bn;
                f32x4 bv = (f32x4){0.f, 0.f, 0.f, 0.f};
                const float* bp = B + (size_t)(k0 + bk) * ldb + col;
                if (col + 3 < N) { bv.x = bp[0]; bv.y = bp[1]; bv.z = bp[2]; bv.w = bp[3]; }
                else { if (col < N) bv.x = bp[0]; if (col + 1 < N) bv.y = bp[1]; if (col + 2 < N) bv.z = bp[2]; }
                *(LAS f32x4*)(Bs + bk * 128 + bn) = bv;
                if (DUAL) {
                    const float* bp2 = bp + dualoff;
                    f32x4 bw; bw.x = bp2[0]; bw.y = bp2[1]; bw.z = bp2[2]; bw.w = bp2[3];
                    *(LAS f32x4*)(Bs2 + bk * 128 + bn) = bw;
                }
            }
            __syncthreads();
#pragma unroll 4
            for (int k = 0; k < 16; ++k) {
                float a[8];
                const f32x4 a0 = *(const LAS f32x4*)(As + k * 132 + ty * 8), a1 = *(const LAS f32x4*)(As + k * 132 + ty * 8 + 4);
                a[0] = a0.x; a[1] = a0.y; a[2] = a0.z; a[3] = a0.w; a[4] = a1.x; a[5] = a1.y; a[6] = a1.z; a[7] = a1.w;
                const f32x4 b = *(const LAS f32x4*)(Bs + k * 128 + tx * 4);
#pragma unroll
                for (int i = 0; i < 8; ++i) { acc[i][0] += a[i] * b.x; acc[i][1] += a[i] * b.y; acc[i][2] += a[i] * b.z; acc[i][3] += a[i] * b.w; }
                if (DUAL) {
                    const f32x4 b2 = *(const LAS f32x4*)(Bs2 + k * 128 + tx * 4);
#pragma unroll
                    for (int i = 0; i < 8; ++i) { acc2[i][0] += a[i] * b2.x; acc2[i][1] += a[i] * b2.y; acc2[i][2] += a[i] * b2.z; acc2[i][3] += a[i] * b2.w; }
                }
            }
            __syncthreads();
        }
#pragma unroll
        for (int i = 0; i < 8; ++i)
#pragma unroll
            for (int j = 0; j < 4; ++j) {
                const int row = tm * 128 + ty * 8 + i, col = tn * 128 + tx * 4 + j;
                if (col < N) epi(row, col, acc[i][j], acc2[i][j]);
            }
    }
}
struct EpiStoreBf16 { bf16* O; int ldo; __device__ __forceinline__ void operator()(int r, int c, float a, float) const { O[(size_t)r * ldo + c] = (bf16)f2bf(a); } };
struct EpiGlu { bf16* O; int ldo; __device__ __forceinline__ void operator()(int r, int c, float a, float b) const { O[(size_t)r * ldo + c] = (bf16)f2bf(a * sigmoidf_(b)); } };
struct EpiResid { const float* X; float* O; __device__ __forceinline__ void operator()(int r, int c, float a, float) const { O[(size_t)r * DM + c] = X[(size_t)r * DM + c] + a; } };

__device__ __forceinline__ void ssm_naive_item(int b, int g, const float* a_re, const float* a_im, const float* b_re, const float* b_im, const float* c_re, const float* c_im,
                                               const float* dpar, const float* log_dt, const bf16* Z, bf16* G1, int lane) {
    const int p = lane;
    const float are = a_re[g * 64 + p], aim = a_im[g * 64 + p], dt = expf(log_dt[g]);
    const float er = expf(are * dt), lbr = er * cosf(aim * dt), lbi = er * sinf(aim * dt);
    const float xx = lbr - 1.0f, yy = lbi, den = are * are + aim * aim;
    const float fr = (xx * are + yy * aim) / den, fi = (yy * are - xx * aim) / den;
    float bbr[16], bbi[16], cr[16], ci[16];
#pragma unroll
    for (int h = 0; h < 16; ++h) {
        const float br = b_re[(g * 64 + p) * 16 + h], bi = b_im[(g * 64 + p) * 16 + h];
        bbr[h] = fr * br - fi * bi; bbi[h] = fr * bi + fi * br;
        cr[h] = c_re[(g * 16 + h) * 64 + p]; ci[h] = c_im[(g * 16 + h) * 64 + p];
    }
    const float dd = dpar[g * 16 + (lane & 15)];
    float xr = 0.f, xi = 0.f;
    for (int t = 0; t < SEQ; ++t) {
        const size_t row = (size_t)b * SEQ + t;
        const u32x4 u0 = *(const u32x4*)(Z + row * ZP + ZC_U + g * 16), u1 = *(const u32x4*)(Z + row * ZP + ZC_U + g * 16 + 8);
        float u[16];
        u[0] = __uint_as_float(u0.x << 16); u[1] = __uint_as_float(u0.x & 0xffff0000u); u[2] = __uint_as_float(u0.y << 16); u[3] = __uint_as_float(u0.y & 0xffff0000u);
        u[4] = __uint_as_float(u0.z << 16); u[5] = __uint_as_float(u0.z & 0xffff0000u); u[6] = __uint_as_float(u0.w << 16); u[7] = __uint_as_float(u0.w & 0xffff0000u);
        u[8] = __uint_as_float(u1.x << 16); u[9] = __uint_as_float(u1.x & 0xffff0000u); u[10] = __uint_as_float(u1.y << 16); u[11] = __uint_as_float(u1.y & 0xffff0000u);
        u[12] = __uint_as_float(u1.z << 16); u[13] = __uint_as_float(u1.z & 0xffff0000u); u[14] = __uint_as_float(u1.w << 16); u[15] = __uint_as_float(u1.w & 0xffff0000u);
        float bur = 0.f, bui = 0.f;
#pragma unroll
        for (int h = 0; h < 16; ++h) { bur += bbr[h] * u[h]; bui += bbi[h] * u[h]; }
        const float nxr = lbr * xr - lbi * xi + bur, nxi = lbr * xi + lbi * xr + bui;
        xr = nxr; xi = nxi;
        float y = 0.f;
#pragma unroll
        for (int h = 0; h < 16; ++h) { const float v = wave_sum(cr[h] * xr - ci[h] * xi, lane); if (lane == h) y = v; }
        if (lane < 16) {
            const float ul = bf2f(Z[row * ZP + ZC_U + g * 16 + lane]);
            G1[row * D_SSM + g * 16 + lane] = (bf16)f2bf(gelu_tanh(y + dd * ul));
        }
    }
}
__device__ __forceinline__ void compress_naive_item(int item, const bf16* Z, const float* pos, const float* w1, const float* w2, bf16* KC, bf16* VC, int lane) {
    const int i = item & 1, hkv = (item >> 1) & 1, n = (item >> 2) % NCMPP, b = (item >> 2) / NCMPP;
    bf16* dst = i ? VC : KC;
    if (n == NCMP) { dst[(((size_t)b * NCMPP + n) * 2 + hkv) * 64 + lane] = 0; return; }
    const float* posi = pos + i * 32 * 64; const float* w1i = w1 + (size_t)i * 32 * 64 * 64; const float* w2i = w2 + i * 64 * 64;
    float acc = 0.f;
    for (int l = 0; l < 32; ++l) {
        const bf16* zr = Z + ((size_t)b * SEQ + 16 * n + l) * ZP + ZC_KV + i * 128 + hkv * 64;
        for (int d = 0; d < 64; ++d) acc += (bf2f(zr[d]) + posi[l * 64 + d]) * w1i[(l * 64 + d) * 64 + lane];
    }
    const float hid = gelu_tanh(acc);
    float o = 0.f;
    for (int e = 0; e < 64; ++e) o += lane_bcast(hid, e) * w2i[e * 64 + lane];
    dst[(((size_t)b * NCMPP + n) * 2 + hkv) * 64 + lane] = (bf16)f2bf(o);
}

__device__ __forceinline__ void attn_chunk(LAS float* wl, const bf16* Z, const float* rel_bias, int b, int hkv, int t, int base, int kcol, int vcol, int lane,
                                           float (&m)[4], float (&l)[4], float (&o)[4]) {
    const int pos = base + lane; const bool valid = (pos >= 0) && (pos <= t);
    const int posc = pos < 0 ? 0 : (pos > SEQ - 1 ? SEQ - 1 : pos);
    const bf16* kr = Z + ((size_t)b * SEQ + posc) * ZP + kcol + hkv * 64;
    float s[4] = {0.f, 0.f, 0.f, 0.f};
#pragma unroll 2
    for (int c = 0; c < 8; ++c) {
        const u32x4 kv = *(const u32x4*)(kr + c * 8);
        float k[8];
        k[0] = __uint_as_float(kv.x << 16); k[1] = __uint_as_float(kv.x & 0xffff0000u); k[2] = __uint_as_float(kv.y << 16); k[3] = __uint_as_float(kv.y & 0xffff0000u);
        k[4] = __uint_as_float(kv.z << 16); k[5] = __uint_as_float(kv.z & 0xffff0000u); k[6] = __uint_as_float(kv.w << 16); k[7] = __uint_as_float(kv.w & 0xffff0000u);
#pragma unroll
        for (int g = 0; g < 4; ++g) {
            const f32x4 q0 = *(const LAS f32x4*)(wl + g * 64 + c * 8), q1 = *(const LAS f32x4*)(wl + g * 64 + c * 8 + 4);
            s[g] += q0.x * k[0] + q0.y * k[1] + q0.z * k[2] + q0.w * k[3] + q1.x * k[4] + q1.y * k[5] + q1.z * k[6] + q1.w * k[7];
        }
    }
    const int bk = t5_bucket(t - pos);
#pragma unroll
    for (int g = 0; g < 4; ++g) {
        const float sv = valid ? s[g] + rel_bias[bk * 8 + hkv * 4 + g] : -1e30f;
        const float mn = fmaxf(m[g], wave_max(sv, lane));
        const float alpha = __expf(m[g] - mn);
        const float p = valid ? __expf(sv - mn) : 0.f;
        l[g] = l[g] * alpha + wave_sum(p, lane);
        o[g] *= alpha; m[g] = mn;
        wl[256 + g * 64 + lane] = p;
    }
#pragma unroll 4
    for (int key = 0; key < 64; ++key) {
        int pk = base + key; pk = pk < 0 ? 0 : (pk > SEQ - 1 ? SEQ - 1 : pk);
        const float v = bf2f(Z[((size_t)b * SEQ + pk) * ZP + vcol + hkv * 64 + lane]);
#pragma unroll
        for (int g = 0; g < 4; ++g) o[g] += wl[256 + g * 64 + key] * v;
    }
}
__device__ __forceinline__ void attn_naive_item(LAS float* wl, int b, int hkv, int t, const bf16* Z, const float* KC, const float* VC, const float* rel_bias, bf16* YC, int lane) {
    const size_t row = (size_t)b * SEQ + t;
#pragma unroll
    for (int g = 0; g < 4; ++g) wl[g * 64 + lane] = bf2f(Z[row * ZP + ZC_Q + hkv * 256 + g * 64 + lane]) * 0.125f;
#pragma unroll 1
    for (int c = 0; c < 4; ++c) {
        const int n = c * 64 + lane; const bool valid = (n < NCMP) && (16 * n + 31 <= t);
        const float* kr = KC + (((size_t)b * NCMPP + (n < NCMP ? n : 0)) * 2 + hkv) * 64;
        float s[4] = {0.f, 0.f, 0.f, 0.f};
#pragma unroll 4
        for (int d4 = 0; d4 < 16; ++d4) {
            const f32x4 k = *(const f32x4*)(kr + d4 * 4);
#pragma unroll
            for (int g = 0; g < 4; ++g) { const f32x4 q = *(const LAS f32x4*)(wl + g * 64 + d4 * 4); s[g] += q.x * k.x + q.y * k.y + q.z * k.z + q.w * k.w; }
        }
        const int bk = t5_bucket(t - (16 * n + 31));
#pragma unroll
        for (int g = 0; g < 4; ++g) wl[256 + g * 256 + n] = valid ? s[g] + rel_bias[bk * 8 + hkv * 4 + g] : -1e30f;
    }
#pragma unroll
    for (int g = 0; g < 4; ++g) {
        float sc[4];
#pragma unroll
        for (int c = 0; c < 4; ++c) sc[c] = wl[256 + g * 256 + c * 64 + lane];
        const float mx = wave_max(fmaxf(fmaxf(sc[0], sc[1]), fmaxf(sc[2], sc[3])), lane);
        float e[4], ls = 0.f;
#pragma unroll
        for (int c = 0; c < 4; ++c) { e[c] = sc[c] > -1e29f ? __expf(sc[c] - mx) : 0.f; ls += e[c]; }
        ls = wave_sum(ls, lane);
        const float inv = ls > 0.f ? 1.0f / ls : 0.f;
#pragma unroll
        for (int c = 0; c < 4; ++c) wl[256 + g * 256 + c * 64 + lane] = e[c] * inv;
    }
    float oc[4] = {0.f, 0.f, 0.f, 0.f};
    const int nmax = t >= 31 ? ((t - 31) / 16 + 1 < NCMP ? (t - 31) / 16 + 1 : NCMP) : 0;
#pragma unroll 4
    for (int n = 0; n < nmax; ++n) {
        const float v = VC[(((size_t)b * NCMPP + n) * 2 + hkv) * 64 + lane];
#pragma unroll
        for (int g = 0; g < 4; ++g) oc[g] += wl[256 + g * 256 + n] * v;
    }
    float imp = 0.f;
#pragma unroll
    for (int g = 0; g < 4; ++g) {
        const LAS float* P = wl + 256 + g * 256;
        imp += P[4 * lane] + P[4 * lane + 1] + P[4 * lane + 2] + 0.5f * P[4 * lane + 3] + (lane > 0 ? 0.5f * P[4 * lane - 1] : 0.f);
    }
    const int blk = t >> 6;
    const bool forced = (lane == 0) || (lane <= blk && lane > blk - 2), future = lane > blk;
    const float v = forced ? 1e9f : (future ? -1e9f : imp);
    int rank = 0;
    for (int jj = 0; jj < 64; ++jj) { const float vj = lane_bcast(v, jj); rank += (vj > v) || (vj == v && jj < lane); }
    unsigned long long mask = __ballot(rank < 16 && !future);
    float m[4], l[4], o[4];
#pragma unroll
    for (int g = 0; g < 4; ++g) { m[g] = -1e30f; l[g] = 0.f; o[g] = 0.f; }
    while (mask) {
        const int j = __builtin_ctzll(mask); mask &= mask - 1;
        attn_chunk(wl, Z, rel_bias, b, hkv, t, 64 * j, ZC_KV + 256, ZC_KV + 384, lane, m, l, o);
    }
    float os[4];
#pragma unroll
    for (int g = 0; g < 4; ++g) { os[g] = l[g] > 0.f ? o[g] / l[g] : 0.f; m[g] = -1e30f; l[g] = 0.f; o[g] = 0.f; }
    for (int c = 0; c < 8; ++c) attn_chunk(wl, Z, rel_bias, b, hkv, t, t - 511 + 64 * c, ZC_KV + 512, ZC_KV + 640, lane, m, l, o);
#pragma unroll
    for (int g = 0; g < 4; ++g) {
        const float ow = l[g] > 0.f ? o[g] / l[g] : 0.f;
        const bf16* gp = Z + row * ZP + ZC_G + hkv * 12 + g * 3;
        const float r = sigmoidf_(bf2f(gp[0])) * oc[g] + sigmoidf_(bf2f(gp[1])) * os[g] + sigmoidf_(bf2f(gp[2])) * ow;
        YC[row * DM + D_SSM + hkv * 256 + g * 64 + lane] = (bf16)f2bf(r);
    }
}

__device__ __forceinline__ void ph_norm_route(const Frame& F, const float* x, const float* g, const float* rgw, const float* rgb, const float* rew, const float* reb, bf16* hn,
                                              unsigned* gcnt, unsigned* list, float* listw) {
    LAS f32x4* RG = (LAS f32x4*)F.lds; LAS f32x4* RE = RG + 1024;
    LAS unsigned* cnt_l = (LAS unsigned*)(F.lds + 147456); LAS unsigned* base_l = cnt_l + 32; LAS unsigned* ent = cnt_l + 64;
    for (int d = F.tid; d < 1024; d += NTHR) { const int ln = d & 63, jc = d >> 6, row = (ln + 64 * (jc >> 2)) * 4 + (jc & 3); RG[d] = ((const f32x4*)rgw)[row]; }
    { f32x4 t[16];
#pragma unroll
      for (int k = 0; k < 16; ++k) { const int d = F.tid + k * NTHR, ln = d & 63, q = d >> 6, half = q & 1, c = (q >> 1) & 3, j = (q >> 3) & 3, gi = q >> 5, row = (ln + 64 * j) * 4 + c;
          t[k] = ((const f32x4*)rew)[((size_t)gi * DM + row) * 2 + half]; }
#pragma unroll
      for (int k = 0; k < 16; ++k) RE[F.tid + k * NTHR] = t[k]; }
    __syncthreads();
    for (int row0 = F.blk * 128; row0 < T; row0 += F.G * 128) {
        if (F.tid < 32) cnt_l[F.tid] = 0u;
        __syncthreads();
        f32x4 nv[4];
#pragma unroll
        for (int j = 0; j < 4; ++j) nv[j] = ((const f32x4*)(x + (size_t)(row0 + F.wave * 16) * DM))[F.lane + 64 * j];
        for (int kk = 0; kk < 16; ++kk) {
            const int row = row0 + F.wave * 16 + kk;
            f32x4 v[4]; float s = 0.f;
#pragma unroll
            for (int j = 0; j < 4; ++j) { v[j] = nv[j]; s += v[j].x * v[j].x + v[j].y * v[j].y + v[j].z * v[j].z + v[j].w * v[j].w; }
            if (kk < 15) {
#pragma unroll
                for (int j = 0; j < 4; ++j) nv[j] = ((const f32x4*)(x + (size_t)(row + 1) * DM))[F.lane + 64 * j]; }
            s = wave_sum(s, F.lane);
            const float r = rsqrtf(s * (1.0f / DM) + EPS);
            float lg[4] = {0.f, 0.f, 0.f, 0.f};
#pragma unroll
            for (int j = 0; j < 4; ++j) {
                const f32x4 gg = ((const f32x4*)g)[F.lane + 64 * j];
                v[j].x = v[j].x * r * gg.x; v[j].y = v[j].y * r * gg.y; v[j].z = v[j].z * r * gg.z; v[j].w = v[j].w * r * gg.w;
                u32x2 o; o.x = pk2(v[j].x, v[j].y); o.y = pk2(v[j].z, v[j].w);
                *(u32x2*)(hn + (size_t)row * DM + (F.lane + 64 * j) * 4) = o;
                const f32x4 w0 = RG[(j * 4 + 0) * 64 + F.lane], w1 = RG[(j * 4 + 1) * 64 + F.lane], w2 = RG[(j * 4 + 2) * 64 + F.lane], w3 = RG[(j * 4 + 3) * 64 + F.lane];
                lg[0] += v[j].x * w0.x + v[j].y * w1.x + v[j].z * w2.x + v[j].w * w3.x;
                lg[1] += v[j].x * w0.y + v[j].y * w1.y + v[j].z * w2.y + v[j].w * w3.y;
                lg[2] += v[j].x * w0.z + v[j].y * w1.z + v[j].z * w2.z + v[j].w * w3.z;
                lg[3] += v[j].x * w0.w + v[j].y * w1.w + v[j].z * w2.w + v[j].w * w3.w;
            }
#pragma unroll
            for (int o = 0; o < 4; ++o) lg[o] = wave_sum(lg[o], F.lane) + rgb[o];
            int gi = 0; float gm = lg[0];
#pragma unroll
            for (int o = 1; o < 4; ++o) if (lg[o] > gm) { gm = lg[o]; gi = o; }
            float gs = 0.f;
#pragma unroll
            for (int o = 0; o < 4; ++o) gs += __expf(lg[o] - gm);
            const float gval = 1.0f / gs;
            const LAS f32x4* we = RE + gi * 2048;
            float le[8] = {0.f, 0.f, 0.f, 0.f, 0.f, 0.f, 0.f, 0.f};
#pragma unroll
            for (int j = 0; j < 4; ++j) {
                const float hv[4] = {v[j].x, v[j].y, v[j].z, v[j].w};
#pragma unroll
                for (int c = 0; c < 4; ++c) {
                    const f32x4 wa = we[((j * 4 + c) * 2 + 0) * 64 + F.lane], wb = we[((j * 4 + c) * 2 + 1) * 64 + F.lane];
                    le[0] += hv[c] * wa.x; le[1] += hv[c] * wa.y; le[2] += hv[c] * wa.z; le[3] += hv[c] * wa.w;
                    le[4] += hv[c] * wb.x; le[5] += hv[c] * wb.y; le[6] += hv[c] * wb.z; le[7] += hv[c] * wb.w;
                }
            }
#pragma unroll
            for (int e = 0; e < 8; ++e) le[e] = wave_sum(le[e], F.lane) + reb[gi * 8 + e];
            int e1 = 0; float m1 = le[0];
#pragma unroll
            for (int e = 1; e < 8; ++e) if (le[e] > m1) { m1 = le[e]; e1 = e; }
            int e2 = -1; float m2 = -3.0e38f;
#pragma unroll
            for (int e = 0; e < 8; ++e) if (e != e1 && le[e] > m2) { m2 = le[e]; e2 = e; }
            const float p2 = __expf(m2 - m1), inv = 1.0f / (1.0f + p2);
            if (F.lane == 0) {
                const unsigned ea = (unsigned)(gi * 8 + e1), eb = (unsigned)(gi * 8 + e2);
                const unsigned pa = __hip_atomic_fetch_add(cnt_l + ea, 1u, __ATOMIC_RELAXED, __HIP_MEMORY_SCOPE_WORKGROUP);
                const unsigned pb = __hip_atomic_fetch_add(cnt_l + eb, 1u, __ATOMIC_RELAXED, __HIP_MEMORY_SCOPE_WORKGROUP);
                LAS unsigned* en = ent + (F.wave * 16 + kk) * 6;
                en[0] = ea; en[1] = eb; en[2] = pa; en[3] = pb; en[4] = __float_as_uint(gval * inv); en[5] = __float_as_uint(gval * p2 * inv);
            }
        }
        __syncthreads();
        if (F.tid < 32) base_l[F.tid] = __hip_atomic_fetch_add(gcnt + F.tid * 64, cnt_l[F.tid], __ATOMIC_RELAXED, __HIP_MEMORY_SCOPE_AGENT);
        __syncthreads();
        if (F.tid < 128) {
            const LAS unsigned* en = ent + F.tid * 6; const unsigned tok = (unsigned)(row0 + F.tid);
            const unsigned ia = en[0] * LCAP + base_l[en[0]] + en[2], ib = en[1] * LCAP + base_l[en[1]] + en[3];
            list[ia] = tok * 2u; listw[ia] = __uint_as_float(en[4]);
            list[ib] = tok * 2u + 1u; listw[ib] = __uint_as_float(en[5]);
        }
        __syncthreads();
    }
}
__device__ __forceinline__ void build_expert_tab(const Frame& F, const unsigned* gcnt, LAS int* tab) {
    if (F.tid < 64) {
        const int c = F.lane < 32 ? (int)__hip_atomic_load(gcnt + F.lane * 64, __ATOMIC_RELAXED, __HIP_MEMORY_SCOPE_AGENT) : 0;
        int tiles = (c + 255) >> 8, incl = tiles;
#pragma unroll
        for (int o = 1; o < 32; o <<= 1) { const int t = __builtin_amdgcn_ds_bpermute((F.lane - o) << 2, incl); if (F.lane >= o) incl += t; }
        if (F.lane < 32) { tab[F.lane + 1] = incl; tab[33 + F.lane] = c; }
        if (F.lane == 0) tab[0] = 0;
    }
    __syncthreads();
}
__device__ __forceinline__ void ph_experts_naive(const Frame& F, const bf16* hn, const unsigned* route, const float* wg, const float* wu, const float* wd, float* x) {
    LAS float* hs = (LAS float*)F.lds;
    LAS float* hd = hs + 1024;
    for (int tok = F.blk; tok < T; tok += F.G) {
        { const unsigned pv = *(const unsigned*)(hn + (size_t)tok * DM + F.tid * 2); hs[F.tid * 2] = __uint_as_float(pv << 16); hs[F.tid * 2 + 1] = __uint_as_float(pv & 0xffff0000u); }
        const u32x4 rt = *(const u32x4*)(route + (size_t)tok * 4);
        __syncthreads();
        {
            const int s = F.tid >> 8, f = F.tid & 255;
            const unsigned e = s ? rt.y : rt.x; const float w = __uint_as_float(s ? rt.w : rt.z);
            const float* pg = wg + (size_t)e * DM * 256 + f; const float* pu = wu + (size_t)e * DM * 256 + f;
            float ga = 0.f, ua = 0.f;
            for (int d = 0; d < DM; ++d) { const float hv = hs[d]; ga += hv * pg[(size_t)d * 256]; ua += hv * pu[(size_t)d * 256]; }
            hd[s * 256 + f] = ga * sigmoidf_(ga) * ua * w;
        }
        __syncthreads();
        for (int dd = F.tid; dd < DM; dd += NTHR) {
            float acc = 0.f;
            const float* p0 = wd + (size_t)rt.x * 256 * DM + dd; const float* p1 = wd + (size_t)rt.y * 256 * DM + dd;
            for (int f = 0; f < 256; ++f) acc += hd[f] * p0[(size_t)f * DM];
            for (int f = 0; f < 256; ++f) acc += hd[256 + f] * p1[(size_t)f * DM];
            x[(size_t)tok * DM + dd] += acc;
        }
        __syncthreads();
    }
}


namespace nsa {
typedef short bf16x8 __attribute__((ext_vector_type(8)));
typedef short s16x4 __attribute__((ext_vector_type(4)));
typedef float f32x16 __attribute__((ext_vector_type(16)));
typedef float f32x2_t __attribute__((ext_vector_type(2)));
typedef __bf16 bf16x2_t __attribute__((ext_vector_type(2)));
constexpr int SLOTB = 8192;
constexpr int L_K = 0, L_V = 3 * SLOTB, L_IMP = 6 * SLOTB, L_BT = L_IMP + 65536, L_WS = L_BT + 4 * 132 * 4, L_RL = L_WS + 8 * 64 * 4, L_SM = L_RL + 4 * 64 * 4, L_END = L_SM + 64 * 8;
static_assert(L_END <= 131072, "nsa LDS map");
constexpr float LOG2E = 1.4426950408889634f;
constexpr float NEG_INF = -__builtin_inff();
#define NSA_SBAR() __builtin_amdgcn_sched_barrier(0)
__device__ __forceinline__ int crow(int r, int hi) { return (r & 3) + 8 * (r >> 2) + 4 * hi; }
__device__ __forceinline__ void glds16(const void* gsrc, unsigned lds_dst) { unsigned keep;
    asm volatile("s_mov_b32 %0, m0\n\ts_mov_b32 m0, %2\n\ts_nop 0\n\tglobal_load_lds_dwordx4 %1, off\n\ts_mov_b32 m0, %0" : "=&s"(keep) : "v"(gsrc), "s"(lds_dst) : "memory"); }
__device__ __forceinline__ unsigned cvtpk(float lo, float hi) { f32x2_t v = {lo, hi}; bf16x2_t b = __builtin_convertvector(v, bf16x2_t); return __builtin_bit_cast(unsigned, b); }
#define NSA_WAIT_BAR(N) asm volatile("s_waitcnt vmcnt(" #N ") lgkmcnt(0)\n\ts_barrier" ::: "memory")
__device__ __forceinline__ void qkt(f32x16& p0, f32x16& p1, const LAS char* kb, const bf16x8 (&qr)[4], const f32x16& cinit) {
#pragma unroll
    for (int d0 = 0; d0 < 4; ++d0) {
        const bf16x8 b0 = *(const LAS bf16x8*)(kb + d0 * 2048);
        const bf16x8 b1 = *(const LAS bf16x8*)(kb + d0 * 2048 + 512);
        if (d0 == 0) { p0 = __builtin_amdgcn_mfma_f32_32x32x16_bf16(b0, qr[0], cinit, 0, 0, 0); p1 = __builtin_amdgcn_mfma_f32_32x32x16_bf16(b1, qr[0], cinit, 0, 0, 0); }
        else { p0 = __builtin_amdgcn_mfma_f32_32x32x16_bf16(b0, qr[d0], p0, 0, 0, 0); p1 = __builtin_amdgcn_mfma_f32_32x32x16_bf16(b1, qr[d0], p1, 0, 0, 0); }
    }
}
__device__ __forceinline__ void pv(f32x16 (&o)[2], int vb, bf16x8 pa0, bf16x8 pa1, bf16x8 pa2, bf16x8 pa3) {
#pragma unroll
    for (int d0 = 0; d0 < 2; ++d0) { s16x4 lo[4], hi[4];
#pragma unroll
        for (int ks = 0; ks < 4; ++ks) {
            asm volatile("ds_read_b64_tr_b16 %0,%1 offset:%c2" : "=&v"(lo[ks]) : "v"(vb), "i"(d0 * 4096 + ks * 1024) : "memory");
            asm volatile("ds_read_b64_tr_b16 %0,%1 offset:%c2" : "=&v"(hi[ks]) : "v"(vb), "i"(d0 * 4096 + ks * 1024 + 512) : "memory"); }
        asm volatile("s_waitcnt lgkmcnt(0)" ::: "memory"); NSA_SBAR();
#define NSA_PK(k) (bf16x8){lo[k][0], lo[k][1], lo[k][2], lo[k][3], hi[k][0], hi[k][1], hi[k][2], hi[k][3]}
        o[d0] = __builtin_amdgcn_mfma_f32_32x32x16_bf16(pa0, NSA_PK(0), o[d0], 0, 0, 0);
        o[d0] = __builtin_amdgcn_mfma_f32_32x32x16_bf16(pa1, NSA_PK(1), o[d0], 0, 0, 0);
        o[d0] = __builtin_amdgcn_mfma_f32_32x32x16_bf16(pa2, NSA_PK(2), o[d0], 0, 0, 0);
        o[d0] = __builtin_amdgcn_mfma_f32_32x32x16_bf16(pa3, NSA_PK(3), o[d0], 0, 0, 0);
#undef NSA_PK
    }
}
typedef short v4i16_t __attribute__((ext_vector_type(4)));
__device__ __forceinline__ s16x4 vtr(const LAS char* p) { return __builtin_bit_cast(s16x4, __builtin_amdgcn_ds_read_tr16_b64_v4i16((LAS v4i16_t*)p)); }
__device__ __forceinline__ void pv2(f32x16 (&o)[2], const LAS char* vp, bf16x8 pa0, bf16x8 pa1, bf16x8 pa2, bf16x8 pa3) {
#pragma unroll
    for (int d0 = 0; d0 < 2; ++d0) {
        s16x4 lo[4], hi[4];
#pragma unroll
        for (int ks = 0; ks < 4; ++ks) { lo[ks] = vtr(vp + d0 * 4096 + ks * 1024); hi[ks] = vtr(vp + d0 * 4096 + ks * 1024 + 512); }
#define NSA_PK(k) (bf16x8){lo[k][0], lo[k][1], lo[k][2], lo[k][3], hi[k][0], hi[k][1], hi[k][2], hi[k][3]}
        o[d0] = __builtin_amdgcn_mfma_f32_32x32x16_bf16(pa0, NSA_PK(0), o[d0], 0, 0, 0);
        o[d0] = __builtin_amdgcn_mfma_f32_32x32x16_bf16(pa1, NSA_PK(1), o[d0], 0, 0, 0);
        o[d0] = __builtin_amdgcn_mfma_f32_32x32x16_bf16(pa2, NSA_PK(2), o[d0], 0, 0, 0);
        o[d0] = __builtin_amdgcn_mfma_f32_32x32x16_bf16(pa3, NSA_PK(3), o[d0], 0, 0, 0);
#undef NSA_PK
    }
}
__device__ __forceinline__ float other_half(float v, int hi) { auto rr = __builtin_amdgcn_permlane32_swap(__float_as_uint(v), __float_as_uint(v), false, false); return __uint_as_float(hi ? rr[0] : rr[1]); }
__device__ __forceinline__ float rowmax(const f32x16& p0, const f32x16& p1, int hi) {
    float a = fmaxf(fmaxf(p0[0], p0[1]), p1[0]), b = fmaxf(fmaxf(p0[2], p0[3]), p1[1]); a = fmaxf(fmaxf(a, p1[2]), p1[3]);
#pragma unroll
    for (int r = 4; r < 16; r += 4) { a = fmaxf(fmaxf(a, p0[r]), p0[r + 1]); b = fmaxf(fmaxf(b, p0[r + 2]), p0[r + 3]); a = fmaxf(fmaxf(a, p1[r]), p1[r + 1]); b = fmaxf(fmaxf(b, p1[r + 2]), p1[r + 3]); }
    const float m = fmaxf(a, b);
    return fmaxf(m, other_half(m, hi));
}
__device__ __forceinline__ void pack_p(const f32x16& p0, const f32x16& p1, bf16x8& a0, bf16x8& a1, bf16x8& a2, bf16x8& a3) {
    u32x4 w0, w1, w2, w3;
    w0 = (u32x4){cvtpk(p0[0], p0[1]), cvtpk(p0[2], p0[3]), cvtpk(p0[4], p0[5]), cvtpk(p0[6], p0[7])};
    w1 = (u32x4){cvtpk(p0[8], p0[9]), cvtpk(p0[10], p0[11]), cvtpk(p0[12], p0[13]), cvtpk(p0[14], p0[15])};
    w2 = (u32x4){cvtpk(p1[0], p1[1]), cvtpk(p1[2], p1[3]), cvtpk(p1[4], p1[5]), cvtpk(p1[6], p1[7])};
    w3 = (u32x4){cvtpk(p1[8], p1[9]), cvtpk(p1[10], p1[11]), cvtpk(p1[12], p1[13]), cvtpk(p1[14], p1[15])};
    a0 = __builtin_bit_cast(bf16x8, w0); a1 = __builtin_bit_cast(bf16x8, w1); a2 = __builtin_bit_cast(bf16x8, w2); a3 = __builtin_bit_cast(bf16x8, w3);
}

struct Ctx {
    LAS char* lds; unsigned lds0; int wid, lane, r32, hi, g, th, qloc;
    const LAS float* bt;
    LAS float* wsf;
    const LAS float* wrow;
    int vb0;
    const LAS char* vp0;
    const LAS char* kb0;
};
__device__ __forceinline__ void dma_k(const Ctx& c, const bf16* kbase, int pitch, int slot) { glds16(kbase + (size_t)c.lane * pitch + c.wid * 8, (unsigned)__builtin_amdgcn_readfirstlane(c.lds0 + L_K + slot * SLOTB + c.wid * 1024)); }
__device__ __forceinline__ void dma_v(const Ctx& c, const bf16* vbase, int pitch, int slot) { glds16(vbase + (size_t)(16 * (c.wid & 3) + (c.lane >> 2)) * pitch + (c.wid >> 2) * 32 + (c.lane & 3) * 8, (unsigned)__builtin_amdgcn_readfirstlane(c.lds0 + L_V + slot * SLOTB + c.wid * 1024)); }

__device__ __forceinline__ void cmp_scores(const Ctx& c, int slot, const bf16x8 (&qr)[4], int t0, int kt, f32x16& p0, f32x16& p1) {
    const int dmin = t0 + 32 * c.th - 16 * (64 * kt + 63) - 31;
    const bool special = dmin < 113;
    f32x16 ci; { const float v = special ? 0.f : c.bt[128];
#pragma unroll
        for (int r = 0; r < 16; ++r) ci[r] = v; }
    qkt(p0, p1, c.kb0 + slot * SLOTB, qr, ci);
    if (special) {
        int hi64 = 64 * c.hi; asm volatile("" : "+v"(hi64));
        const int dqh = t0 + c.qloc - 1024 * kt - 31 - hi64;
        float b0[16], b1[16];
#pragma unroll
        for (int r = 0; r < 16; ++r) { const int d0 = dqh - 16 * ((r & 3) + 8 * (r >> 2)), d1 = d0 - 512; b0[r] = c.bt[d0 < 0 ? 0 : (d0 > 128 ? 128 : d0)]; b1[r] = c.bt[d1 < 0 ? 0 : (d1 > 128 ? 128 : d1)]; }
#pragma unroll
        for (int r = 0; r < 16; ++r) {
            const int d0 = dqh - 16 * ((r & 3) + 8 * (r >> 2)), d1 = d0 - 512;
            p0[r] = d0 < 0 ? NEG_INF : p0[r] + b0[r]; p1[r] = d1 < 0 ? NEG_INF : p1[r] + b1[r];
        }
    }
}
template <int MODE>
__device__ __forceinline__ void online_tile(const Ctx& c, int slot, const bf16x8 (&qr)[4], int dq, bool near, bool masked_tile, bool lane_off, float& mhat, float& lsum, f32x16 (&o)[2]) {
    f32x16 ci; { const float v = (near ? 0.f : c.bt[128]) - mhat;
#pragma unroll
        for (int r = 0; r < 16; ++r) ci[r] = v; }
    f32x16 p0, p1;
    qkt(p0, p1, c.kb0 + slot * SLOTB, qr, ci);
    if (near || masked_tile) {
        int hi4 = 4 * c.hi; asm volatile("" : "+v"(hi4));
        const int dqh = dq - hi4;
#pragma unroll
        for (int r = 0; r < 16; ++r) {
            const int d0 = dqh - ((r & 3) + 8 * (r >> 2)), d1 = d0 - 32;
            if (near) { p0[r] += c.bt[d0 < 0 ? 0 : (d0 > 128 ? 128 : d0)]; p1[r] += c.bt[d1 < 0 ? 0 : (d1 > 128 ? 128 : d1)]; }
            if (d0 < 0 || (MODE == 1 && d0 >= 512)) p0[r] = NEG_INF;
            if (d1 < 0 || (MODE == 1 && d1 >= 512)) p1[r] = NEG_INF;
        }
    }
    if (MODE == 0) { if (lane_off) {
#pragma unroll
        for (int r = 0; r < 16; ++r) { p0[r] = NEG_INF; p1[r] = NEG_INF; } } }
    const float rm = rowmax(p0, p1, c.hi);
    if (__any(rm > 8.0f)) {
        const float dl = fmaxf(rm, 0.f); mhat += dl;
#pragma unroll
        for (int r = 0; r < 16; ++r) { p0[r] -= dl; p1[r] -= dl; }
        const float f = __builtin_amdgcn_exp2f(-dl); lsum *= f;
        if (c.hi == 0) c.wsf[c.r32] = f;
        asm volatile("s_waitcnt lgkmcnt(0)" ::: "memory");
#pragma unroll
        for (int r = 0; r < 16; ++r) { const float fr = c.wrow[(r & 3) + 8 * (r >> 2)]; o[0][r] *= fr; o[1][r] *= fr; }
    }
    float sacc = 0.f;
#pragma unroll
    for (int r = 0; r < 16; ++r) { p0[r] = __builtin_amdgcn_exp2f(p0[r]); p1[r] = __builtin_amdgcn_exp2f(p1[r]); sacc += p0[r] + p1[r]; }
    lsum += sacc;
    bf16x8 a0, a1, a2, a3; pack_p(p0, p1, a0, a1, a2, a3);
    pv(o, c.vb0 + slot * SLOTB, a0, a1, a2, a3);
}
struct Pipe { bf16x8 a0, a1, a2, a3; bool have, resc; };
template <int MODE, bool SPECIAL, bool HAVE>
__device__ __forceinline__ void online_step(const Ctx& c, int kslot, int vslot_prev, const bf16x8 (&qr)[4], int dq, bool near, bool lane_off, float& mhat, float& lsum, f32x16 (&o)[2], Pipe& pp) {
    if (pp.resc) {
#pragma unroll
        for (int r = 0; r < 16; ++r) { const float fr = c.wrow[(r & 3) + 8 * (r >> 2)]; o[0][r] *= fr; o[1][r] *= fr; }
    }
    f32x16 ci; { const float v = (MODE == 0 && lane_off) ? NEG_INF : (((SPECIAL && near) ? 0.f : c.bt[128]) - mhat);
#pragma unroll
        for (int r = 0; r < 16; ++r) ci[r] = v; }
    f32x16 p0, p1;
    qkt(p0, p1, c.kb0 + kslot * SLOTB, qr, ci);
    if (HAVE) pv2(o, c.vp0 + vslot_prev * SLOTB, pp.a0, pp.a1, pp.a2, pp.a3);
    if (SPECIAL) {
        int hi4 = 4 * c.hi; asm volatile("" : "+v"(hi4));
        const int dqh = dq - hi4;
        if (near) {
            float b0[16], b1[16];
#pragma unroll
            for (int r = 0; r < 16; ++r) { const int d0 = dqh - ((r & 3) + 8 * (r >> 2)), d1 = d0 - 32; b0[r] = c.bt[d0 < 0 ? 0 : (d0 > 128 ? 128 : d0)]; b1[r] = c.bt[d1 < 0 ? 0 : (d1 > 128 ? 128 : d1)]; }
#pragma unroll
            for (int r = 0; r < 16; ++r) { p0[r] += b0[r]; p1[r] += b1[r]; }
        }
#pragma unroll
        for (int r = 0; r < 16; ++r) {
            const int d0 = dqh - ((r & 3) + 8 * (r >> 2)), d1 = d0 - 32;
            if (d0 < 0 || (MODE == 1 && d0 >= 512)) p0[r] = NEG_INF;
            if (d1 < 0 || (MODE == 1 && d1 >= 512)) p1[r] = NEG_INF;
        }
    }
    const float rm = rowmax(p0, p1, c.hi);
    const bool mv = __any(rm > 8.0f);
    if (mv) {
        const float dl = fmaxf(rm, 0.f); mhat += dl;
#pragma unroll
        for (int r = 0; r < 16; ++r) { p0[r] -= dl; p1[r] -= dl; }
        const float f = __builtin_amdgcn_exp2f(-dl); lsum *= f;
        c.wsf[c.r32] = f;
    }
    pp.resc = mv;
    float sacc = 0.f;
#pragma unroll
    for (int r = 0; r < 16; ++r) { p0[r] = __builtin_amdgcn_exp2f(p0[r]); p1[r] = __builtin_amdgcn_exp2f(p1[r]); sacc += p0[r] + p1[r]; }
    lsum += sacc;
    pack_p(p0, p1, pp.a0, pp.a1, pp.a2, pp.a3); pp.have = true;
}
__device__ __forceinline__ void online_drain(const Ctx& c, int vslot_prev, f32x16 (&o)[2], Pipe& pp) {
    if (pp.resc) {
#pragma unroll
        for (int r = 0; r < 16; ++r) { const float fr = c.wrow[(r & 3) + 8 * (r >> 2)]; o[0][r] *= fr; o[1][r] *= fr; }
    }
    if (pp.have) pv2(o, c.vp0 + vslot_prev * SLOTB, pp.a0, pp.a1, pp.a2, pp.a3);
}
__device__ __forceinline__ void add_scaled(const Ctx& c, f32x16 (&oacc)[2], const f32x16 (&o)[2], float s) {
    if (c.hi == 0) c.wsf[32 + c.r32] = s;
    asm volatile("s_waitcnt lgkmcnt(0)" ::: "memory");
#pragma unroll
    for (int r = 0; r < 16; ++r) { const float f = c.wrow[32 + (r & 3) + 8 * (r >> 2)]; oacc[0][r] += o[0][r] * f; oacc[1][r] += o[1][r] * f; }
    asm volatile("s_waitcnt lgkmcnt(0)" ::: "memory");
}

__device__ __forceinline__ void add_scaled_park(const Ctx& c, LAS float* park, const f32x16 (&o)[2], float s) {
    if (c.hi == 0) c.wsf[32 + c.r32] = s;
    asm volatile("s_waitcnt lgkmcnt(0)" ::: "memory");
#pragma unroll
    for (int r = 0; r < 16; ++r) { const float f = c.wrow[32 + (r & 3) + 8 * (r >> 2)]; park[r * 64] += o[0][r] * f; park[(16 + r) * 64] += o[1][r] * f; }
    asm volatile("s_waitcnt lgkmcnt(0)" ::: "memory");
}
__device__ __forceinline__ void unit(LAS char* lds, int tid, int b, int hkv, int jt, const bf16* Z, const bf16* KCm, const bf16* VCm, const float* rel_bias, bf16* YC, bool fill_table) {
    Ctx c; c.lds = lds; c.lds0 = (unsigned)(uintptr_t)lds; c.wid = __builtin_amdgcn_readfirstlane(tid >> 6); c.lane = tid & 63; c.r32 = c.lane & 31; c.hi = c.lane >> 5;
    c.g = c.wid & 3; c.th = c.wid >> 2; c.qloc = 32 * c.th + c.r32;
    c.bt = (const LAS float*)(lds + L_BT) + c.g * 132; c.wsf = (LAS float*)(lds + L_WS) + c.wid * 64; c.wrow = c.wsf + 4 * c.hi;
    c.vb0 = (int)(c.lds0 + L_V) + ((c.lane >> 4) & 1) * 32 + (c.lane & 3) * 8 + (4 * c.hi + ((c.lane & 15) >> 2)) * 64;
    c.kb0 = (const LAS char*)(lds + L_K) + c.hi * 1024 + c.r32 * 16;
    c.vp0 = (const LAS char*)(lds + L_V) + ((c.lane >> 4) & 1) * 32 + (c.lane & 3) * 8 + (4 * c.hi + ((c.lane & 15) >> 2)) * 64;
    const int t0 = 64 * jt;
    const bf16* Zb = Z + (size_t)b * SEQ * ZP;
    const size_t qrow = (size_t)b * SEQ + t0 + c.qloc;
    if (fill_table) for (int i = tid; i < 4 * 129; i += NTHR) { const int gg = i / 129, d = i % 129; ((LAS float*)(lds + L_BT))[gg * 132 + d] = rel_bias[t5_bucket(d) * 8 + hkv * 4 + gg] * LOG2E; }
    bf16x8 qr[4];
#pragma unroll
    for (int d0 = 0; d0 < 4; ++d0) qr[d0] = *(const bf16x8*)(Z + qrow * ZP + ZC_Q + hkv * 256 + c.g * 64 + d0 * 16 + c.hi * 8);
    const bf16* gp = Z + qrow * ZP + ZC_G + hkv * 12 + c.g * 3;
    const float gate0 = sigmoidf_(bf2f(gp[0])), gate1 = sigmoidf_(bf2f(gp[1])), gate2 = sigmoidf_(bf2f(gp[2]));
    f32x16 oacc[2];
#pragma unroll
    for (int r = 0; r < 16; ++r) { oacc[0][r] = 0.f; oacc[1][r] = 0.f; }

    const int nct = (4 * jt + 2) / 64 + 1;
    const bf16* kcb = KCm + (size_t)b * NCMPP * 128 + hkv * 64; const bf16* vcb = VCm + (size_t)b * NCMPP * 128 + hkv * 64;
    const bf16* skb = Zb + ZC_KV + 256 + hkv * 64; const bf16* svb = Zb + ZC_KV + 384 + hkv * 64;
    {
        float mhat = 0.f, lsum = 0.f, carry = 0.f; f32x16 o[2];
#pragma unroll
        for (int r = 0; r < 16; ++r) { o[0][r] = 0.f; o[1][r] = 0.f; }
        LAS float* impw = (LAS float*)(lds + L_IMP) + (c.g * 64 + c.qloc) * 64;
        dma_k(c, kcb, 128, 0); dma_v(c, vcb, 128, 0); if (nct > 1) { dma_k(c, kcb + 64 * 128, 128, 1); dma_v(c, vcb + 64 * 128, 128, 1); }
        for (int i = 0; i < nct; ++i) {
            if (i + 1 < nct) NSA_WAIT_BAR(2); else NSA_WAIT_BAR(0);
            if (i + 2 < nct) { dma_k(c, kcb + (size_t)(i + 2) * 64 * 128, 128, (i + 2) % 3); dma_v(c, vcb + (size_t)(i + 2) * 64 * 128, 128, (i + 2) % 3); }
            f32x16 p0, p1; cmp_scores(c, i % 3, qr, t0, i, p0, p1);
            const float rm = rowmax(p0, p1, c.hi) - mhat;
            if (__any(rm > 8.0f)) {
                const float dl = fmaxf(rm, 0.f); mhat += dl;
                const float f = __builtin_amdgcn_exp2f(-dl); lsum *= f; carry *= f;
                c.wsf[c.r32] = f;
                asm volatile("s_waitcnt lgkmcnt(0)" ::: "memory");
#pragma unroll
                for (int r = 0; r < 16; ++r) { const float fr = c.wrow[(r & 3) + 8 * (r >> 2)]; o[0][r] *= fr; o[1][r] *= fr; }
                for (int e = c.hi; e < 16 * i; e += 2) impw[e] *= f;
            }
            float sacc = 0.f;
#pragma unroll
            for (int r = 0; r < 16; ++r) { p0[r] = __builtin_amdgcn_exp2f(p0[r] - mhat); p1[r] = __builtin_amdgcn_exp2f(p1[r] - mhat); sacc += p0[r] + p1[r]; }
            lsum += sacc;
            float o3[8];
#pragma unroll
            for (int k = 0; k < 4; ++k) { o3[k] = other_half(p0[4 * k + 3], c.hi); o3[4 + k] = other_half(p1[4 * k + 3], c.hi); }
#pragma unroll
            for (int idx = 0; idx < 8; ++idx) {
                const int X = idx >> 2, k = idx & 3;
                const f32x16& p = X ? p1 : p0;
                const float cin = c.hi ? o3[idx] : (idx ? o3[idx - 1] : carry);
                impw[16 * i + 8 * X + 2 * k + c.hi] = p[4 * k] + p[4 * k + 1] + p[4 * k + 2] + 0.5f * p[4 * k + 3] + 0.5f * cin;
            }
            carry = o3[7];
            bf16x8 a0, a1, a2, a3; pack_p(p0, p1, a0, a1, a2, a3);
            pv(o, c.vb0 + (i % 3) * SLOTB, a0, a1, a2, a3);
        }
        const float lt = lsum + other_half(lsum, c.hi);
        const float rl = lt > 0.f ? 1.0f / lt : 0.f;
        if (c.hi == 0) ((LAS float*)(lds + L_RL))[c.g * 64 + c.qloc] = rl;
        add_scaled(c, oacc, o, rl * gate0);
        NSA_WAIT_BAR(0);
    }
    { const int nt = jt + 1; dma_k(c, skb, ZP, 0); if (nt > 1) dma_k(c, skb + (size_t)64 * ZP, ZP, 1); dma_v(c, svb, ZP, 0); }
    for (int k = 0; k < 8; ++k) {
        const int tok = c.wid * 8 + k;
        float v = 0.f;
#pragma unroll
        for (int gg = 0; gg < 4; ++gg) v += ((const LAS float*)(lds + L_IMP))[(gg * 64 + tok) * 64 + c.lane] * ((const LAS float*)(lds + L_RL))[gg * 64 + tok];
        const bool forced = (c.lane == 0) || (c.lane <= jt && c.lane > jt - 2), future = c.lane > jt;
        v = forced ? 1e9f : (future ? -1e9f : v);
        int rank = 0;
#pragma unroll
        for (int jj = 0; jj < 64; ++jj) { const float vj = __builtin_bit_cast(float, __builtin_amdgcn_readlane(__builtin_bit_cast(int, v), jj)); rank += ((vj > v) || (vj == v && jj < c.lane)) ? 1 : 0; }
        const unsigned long long msk = __ballot(rank < 16 && !future);
        if (c.lane == 0) ((LAS unsigned long long*)(lds + L_SM))[tok] = msk;
    }
    asm volatile("s_waitcnt lgkmcnt(0)\n\ts_barrier" ::: "memory");
    const unsigned long long mymask = ((const LAS unsigned long long*)(lds + L_SM))[c.qloc];
    LAS float* park = (LAS float*)(lds + L_IMP) + c.wid * 2048 + c.lane;
#pragma unroll
    for (int r = 0; r < 16; ++r) { park[r * 64] = oacc[0][r]; park[(16 + r) * 64] = oacc[1][r]; }
    {
        const bf16* kb = skb; const bf16* vb = svb;
        const int nt = jt + 1;
        float mhat = 0.f, lsum = 0.f; f32x16 o[2]; Pipe pp; pp.have = false; pp.resc = false;
#pragma unroll
        for (int r = 0; r < 16; ++r) { o[0][r] = 0.f; o[1][r] = 0.f; }
#define NSA_ITER_HEAD(i) do { if ((i) + 1 < nt) NSA_WAIT_BAR(2); else NSA_WAIT_BAR(1); \
            if ((i) + 2 < nt) dma_k(c, kb + (size_t)((i) + 2) * 64 * ZP, ZP, ((i) + 2) % 3); \
            if ((i) + 1 < nt) dma_v(c, vb + (size_t)((i) + 1) * 64 * ZP, ZP, ((i) + 1) % 3); } while (0)
        {
            NSA_ITER_HEAD(0);
            online_step<0, true, false>(c, 0, 2, qr, 64 * jt + c.qloc, 0 >= jt - 2, !(mymask & 1ull), mhat, lsum, o, pp); }
        const int nfar = jt - 2;
        int i = 1;
        for (; i < nfar; ++i) { NSA_ITER_HEAD(i);
            online_step<0, false, true>(c, i % 3, (i + 2) % 3, qr, 0, false, !((mymask >> i) & 1ull), mhat, lsum, o, pp); }
        for (; i < nt; ++i) { NSA_ITER_HEAD(i);
            online_step<0, true, true>(c, i % 3, (i + 2) % 3, qr, 64 * (jt - i) + c.qloc, i >= jt - 2, !((mymask >> i) & 1ull), mhat, lsum, o, pp); }
        NSA_WAIT_BAR(0);
        online_drain(c, (nt - 1) % 3, o, pp);
        const float lt = lsum + other_half(lsum, c.hi);
        add_scaled_park(c, park, o, (lt > 0.f ? 1.0f / lt : 0.f) * gate1);
        NSA_WAIT_BAR(0);
    }
    {
        const int j0 = jt > 8 ? jt - 8 : 0, nt = jt - j0 + 1;
        const bf16* kb = Zb + (size_t)j0 * 64 * ZP + ZC_KV + 512 + hkv * 64; const bf16* vb = Zb + (size_t)j0 * 64 * ZP + ZC_KV + 640 + hkv * 64;
        float mhat = 0.f, lsum = 0.f; f32x16 o[2]; Pipe pp; pp.have = false; pp.resc = false;
#pragma unroll
        for (int r = 0; r < 16; ++r) { o[0][r] = 0.f; o[1][r] = 0.f; }
        dma_k(c, kb, ZP, 0); if (nt > 1) dma_k(c, kb + (size_t)64 * ZP, ZP, 1); dma_v(c, vb, ZP, 0);
        {
            NSA_ITER_HEAD(0);
            online_step<1, true, false>(c, 0, 2, qr, 64 * (jt - j0) + c.qloc, j0 >= jt - 2, false, mhat, lsum, o, pp); }
        int i = 1;
        for (; j0 + i < jt - 2; ++i) { NSA_ITER_HEAD(i);
            online_step<1, false, true>(c, i % 3, (i + 2) % 3, qr, 0, false, false, mhat, lsum, o, pp); }
        for (; i < nt; ++i) { NSA_ITER_HEAD(i); const int j = j0 + i;
            online_step<1, true, true>(c, i % 3, (i + 2) % 3, qr, 64 * (jt - j) + c.qloc, j >= jt - 2, false, mhat, lsum, o, pp); }
#undef NSA_ITER_HEAD
        NSA_WAIT_BAR(0);
        online_drain(c, (nt - 1) % 3, o, pp);
        const float lt = lsum + other_half(lsum, c.hi);
        add_scaled_park(c, park, o, (lt > 0.f ? 1.0f / lt : 0.f) * gate2);
    }
    {
        bf16* yb = YC + ((size_t)b * SEQ + t0 + 32 * c.th + 4 * c.hi) * DM + D_SSM + hkv * 256 + c.g * 64 + c.r32;
#pragma unroll
        for (int r = 0; r < 16; ++r) { bf16* yr = yb + (size_t)((r & 3) + 8 * (r >> 2)) * DM; yr[0] = (bf16)f2bf(park[r * 64]); yr[32] = (bf16)f2bf(park[(16 + r) * 64]); }
    }
    asm volatile("s_waitcnt vmcnt(0)" ::: "memory");
    NSA_WAIT_BAR(0);
}
#undef NSA_SBAR
#undef NSA_WAIT_BAR
}


__device__ __forceinline__ void ssm_precompute(const Frame& F, const __attribute__((address_space(4))) Args* args, unsigned char* ws, int item) {
    const int layer = item >> 5, g = item & 31, lg = layer * 32 + g;
    LAS float* L = (LAS float*)F.lds;
    LAS float* lkr = L; LAS float* lki = L + 17 * 64; LAS float* bbr = L + 2 * 17 * 64; LAS float* bbi = bbr + 1024; LAS float* ccr = bbi + 1024; LAS float* cci = ccr + 1024;
    LAS float* wk = cci + 1024; LAS float* dd = wk + 4096;
    const float* a_re = args->in[6] + lg * 64; const float* a_im = args->in[7] + lg * 64;
    const float dt = expf(args->in[13][lg]);
    for (int i = F.tid; i < 17 * 64; i += NTHR) { const int k = i >> 6, p = i & 63; const float er = expf(a_re[p] * dt * (float)k), ang = a_im[p] * dt * (float)k; lkr[i] = er * cosf(ang); lki[i] = er * sinf(ang); }
    for (int i = F.tid; i < 1024; i += NTHR) {
        { const int p = i >> 4, h = i & 15; const float are = a_re[p], aim = a_im[p];
          const float er = expf(are * dt), lbr = er * cosf(aim * dt), lbi = er * sinf(aim * dt);
          const float xx = lbr - 1.0f, yy = lbi, den = are * are + aim * aim, fr = (xx * are + yy * aim) / den, fi = (yy * are - xx * aim) / den;
          const float br = args->in[8][((size_t)lg * 64 + p) * 16 + h], bi = args->in[9][((size_t)lg * 64 + p) * 16 + h];
          bbr[i] = fr * br - fi * bi; bbi[i] = fr * bi + fi * br; }
        ccr[i] = args->in[10][(size_t)lg * 1024 + i]; cci[i] = args->in[11][(size_t)lg * 1024 + i];
    }
    if (F.tid < 16) dd[F.tid] = args->in[12][lg * 16 + F.tid];
    __syncthreads();
    for (int i = F.tid; i < 4096; i += NTHR) { const int k = i >> 8, ho = (i >> 4) & 15, hi = i & 15; float acc = 0.f;
        for (int p = 0; p < 64; ++p) { const float cr = ccr[ho * 64 + p], ci = cci[ho * 64 + p], lr = lkr[k * 64 + p], li = lki[k * 64 + p];
            const float tr = cr * lr - ci * li, ti = cr * li + ci * lr; acc += tr * bbr[p * 16 + hi] - ti * bbi[p * 16 + hi]; }
        wk[i] = acc + ((k == 0 && ho == hi) ? dd[ho] : 0.f); }
    __syncthreads();
    bf16* B2 = (bf16*)(ws + WS_BT2) + (size_t)lg * 256 * 384;
    for (int i = F.tid; i < 256 * 384; i += NTHR) { const int n = i / 384, kk = i % 384, t = n >> 4, ho = n & 15; float v;
        if (kk < 256) { const int sidx = kk >> 4, hi = kk & 15; v = sidx <= t ? wk[((t - sidx) << 8) + ho * 16 + hi] : 0.f; }
        else { const int j = kk - 256, p = j & 63; const float cr = ccr[ho * 64 + p], ci = cci[ho * 64 + p], lr = lkr[(t + 1) * 64 + p], li = lki[(t + 1) * 64 + p];
            v = j < 64 ? (cr * lr - ci * li) : -(cr * li + ci * lr); }
        B2[i] = (bf16)f2bf(v); }
    bf16* B1 = (bf16*)(ws + WS_BT1) + (size_t)lg * 256 * 256;
    for (int i = F.tid; i < 65536; i += NTHR) { const int j = i >> 8, kk = i & 255, sidx = kk >> 4, hi = kk & 15; float v = 0.f;
        if (j < 128) { const int p = j & 63; const float lr = lkr[(15 - sidx) * 64 + p], li = lki[(15 - sidx) * 64 + p], br = bbr[p * 16 + hi], bi = bbi[p * 16 + hi];
            v = j < 64 ? (lr * br - li * bi) : (lr * bi + li * br); }
        B1[i] = (bf16)f2bf(v); }
    __syncthreads();
}
__device__ __forceinline__ void ssm_carry_item(int b, int g, const float* a_re, const float* a_im, const float* log_dt, const float* XL, bf16* U, int lane) {
    const float dt16 = 16.0f * expf(log_dt[g]);
    const float er = expf(a_re[g * 64 + lane] * dt16), ang = a_im[g * 64 + lane] * dt16, lr = er * cosf(ang), li = er * sinf(ang);
    float xr = 0.f, xi = 0.f;
    const float* __restrict__ xl = XL + ((size_t)g * 2048 + b * 256) * 128 + lane;
    bf16* __restrict__ up = U + ((size_t)g * 2048 + b * 256) * 512 + 256 + lane;
    float ar[16], ai[16], nr_[16], ni_[16];
#pragma unroll
    for (int k = 0; k < 16; ++k) { ar[k] = xl[(size_t)k * 128]; ai[k] = xl[(size_t)k * 128 + 64]; }
    for (int cb = 0; cb < 16; ++cb) {
        const int cn = cb < 15 ? (cb + 1) * 16 : cb * 16;
#pragma unroll
        for (int k = 0; k < 16; ++k) { nr_[k] = xl[(size_t)(cn + k) * 128]; ni_[k] = xl[(size_t)(cn + k) * 128 + 64]; }
#pragma unroll
        for (int k = 0; k < 16; ++k) {
            const int c = cb * 16 + k;
            up[(size_t)c * 512] = (bf16)f2bf(xr); up[(size_t)c * 512 + 64] = (bf16)f2bf(xi);
            const float nr = lr * xr - li * xi + ar[k], ni = lr * xi + li * xr + ai[k];
            xr = nr; xi = ni;
        }
#pragma unroll
        for (int k = 0; k < 16; ++k) { ar[k] = nr_[k]; ai[k] = ni_[k]; }
    }
}


__device__ __forceinline__ void compress_stage2(const Frame& F, int eb, int pm, const bf16* HC, const bf16* W2T, bf16* KCo, bf16* VCo) {
    typedef short bf16x8_ __attribute__((ext_vector_type(8))); typedef float f32x16_ __attribute__((ext_vector_type(16)));
    const int r32 = F.lane & 31, hi = F.lane >> 5, rg0 = pm * 256 + F.wave * 32;
    const bf16* ar = HC + ((size_t)eb * 4096 + rg0 + r32) * 64 + 8 * hi; const bf16* br = W2T + (size_t)eb * 4096 + (size_t)r32 * 64 + 8 * hi;
    bf16x8_ a[4], b0[4], b1[4];
#pragma unroll
    for (int ks = 0; ks < 4; ++ks) { a[ks] = *(const bf16x8_*)(ar + ks * 16); b0[ks] = *(const bf16x8_*)(br + ks * 16); b1[ks] = *(const bf16x8_*)(br + 32 * 64 + ks * 16); }
    f32x16_ d0, d1;
#pragma unroll
    for (int r = 0; r < 16; ++r) { d0[r] = 0.f; d1[r] = 0.f; }
#pragma unroll
    for (int ks = 0; ks < 4; ++ks) { d0 = __builtin_amdgcn_mfma_f32_32x32x16_bf16(a[ks], b0[ks], d0, 0, 0, 0); d1 = __builtin_amdgcn_mfma_f32_32x32x16_bf16(a[ks], b1[ks], d1, 0, 0, 0); }
    bf16* dstb = (eb ? VCo : KCo) + (size_t)(rg0 + 4 * hi) * 64 + r32;
#pragma unroll
    for (int r = 0; r < 16; ++r) { const int ro = (r & 3) + 8 * (r >> 2); const bool pad = (((rg0 + 4 * hi + ro) >> 1) & 255) == NCMP;
        dstb[(size_t)ro * 64] = pad ? (bf16)0 : (bf16)f2bf(d0[r]); dstb[(size_t)ro * 64 + 32] = pad ? (bf16)0 : (bf16)f2bf(d1[r]); }
}

__device__ __forceinline__ void titem_load(const float* W, int N, int k0, int n0, int lane, float (&t)[32]) {
#pragma unroll
    for (int i = 0; i < 32; ++i) t[i] = W[(size_t)(k0 + 2 * i + (lane >> 5)) * N + n0 + (lane & 31)];
}
__device__ __forceinline__ void titem_finish(const float (&t)[32], int K, bf16* WT, int k0, int drow0, LAS float* scr, int lane, float scale) {
#pragma unroll
    for (int i = 0; i < 32; ++i) scr[(2 * i + (lane >> 5)) * 33 + (lane & 31)] = t[i];
    asm volatile("s_waitcnt lgkmcnt(0)" ::: "memory");
    const int c = lane & 7;
#pragma unroll
    for (int j = 0; j < 4; ++j) { const int n = (lane >> 3) + 8 * j; const LAS float* sp = scr + (8 * c) * 33 + n;
        u32x4 o; o.x = pk2(sp[0 * 33] * scale, sp[1 * 33] * scale); o.y = pk2(sp[2 * 33] * scale, sp[3 * 33] * scale); o.z = pk2(sp[4 * 33] * scale, sp[5 * 33] * scale); o.w = pk2(sp[6 * 33] * scale, sp[7 * 33] * scale);
        *(u32x4*)(WT + (size_t)(drow0 + n) * K + k0 + 8 * c) = o; }
    asm volatile("s_waitcnt lgkmcnt(0)" ::: "memory");
}
__device__ __forceinline__ void transpose_item(const float* W, int K, int N, bf16* WT, int k0, int n0, int drow0, LAS float* scr, int lane, float scale = 1.0f) {
    float t[32]; titem_load(W, N, k0, n0, lane, t); titem_finish(t, K, WT, k0, drow0, scr, lane, scale);
}
struct XItem { const float* W; bf16* WT; int K, N, k0, n0, drow0; };
__device__ __forceinline__ XItem xitem(const __attribute__((address_space(4))) Args* args, unsigned char* ws, int it) {
    XItem x; const int le = it / 384, r = it % 384;
    if (r < 256) { const int isup = r >> 7, q = r & 127, nb = q & 7, kb = q >> 3, n0 = 32 * nb;
        x.W = args->in[isup ? 24 : 23] + (size_t)le * DM * 256; x.K = DM; x.N = 256; x.WT = (bf16*)(ws + WS_WGU) + (size_t)le * 512 * DM; x.k0 = 64 * kb; x.n0 = n0; x.drow0 = 256 * (n0 >> 7) + 128 * isup + (n0 & 127); }
    else { const int q = r - 256, nb = q & 31, kb = q >> 5;
        x.W = args->in[25] + (size_t)le * 256 * DM; x.K = 256; x.N = DM; x.WT = (bf16*)(ws + WS_WDN) + (size_t)le * DM * 256; x.k0 = 64 * kb; x.n0 = 32 * nb; x.drow0 = 32 * nb; }
    return x;
}
__device__ __forceinline__ void convert_experts(const Frame& F, const __attribute__((address_space(4))) Args* args, unsigned char* ws, int layer, int vw, int nvw) {
    LAS float* scr = (LAS float*)(F.lds + F.wave * 16384);
    const int lo_ = layer * 32 * 384, hi_ = (layer + 1) * 32 * 384;
    float ta[32], tb[32]; XItem xa, xb;
    int it = lo_ + vw;
    if (it < hi_) { xa = xitem(args, ws, it); titem_load(xa.W, xa.N, xa.k0, xa.n0, F.lane, ta); }
    for (; it < hi_; it += nvw) {
        const bool hn = it + nvw < hi_;
        if (hn) { xb = xitem(args, ws, it + nvw); titem_load(xb.W, xb.N, xb.k0, xb.n0, F.lane, tb); }
        titem_finish(ta, xa.K, xa.WT, xa.k0, xa.drow0, scr, F.lane, 1.0f);
        if (hn) { xa = xb;
#pragma unroll
            for (int i = 0; i < 32; ++i) ta[i] = tb[i]; }
    }
}
__device__ __forceinline__ void ph_convert(const Frame& F, const __attribute__((address_space(4))) Args* args, unsigned char* ws) {
    for (int it = F.blk; it < DEPTH * NGRP; it += F.G) ssm_precompute(F, args, ws, it);
    LAS float* scr = (LAS float*)(F.lds + F.wave * 16384);
    const int gw = F.blk * NWAVES + F.wave, NGW = F.G * NWAVES;
    constexpr int I_IN = (DM / 64) * (1792 / 32), I_GLU = (D_SSM / 64) * (2 * D_SSM / 32), I_OUT = (DM / 64) * (DM / 32);
    constexpr int PER_LAYER = I_IN + I_GLU + I_OUT;
    for (int it = gw; it < DEPTH * 2 * 64; it += NGW) { const int li = it >> 6, q = it & 63, nb = q & 1, kb = q >> 1;
        transpose_item(args->in[16] + (size_t)li * 2048 * 64, 2048, 64, (bf16*)(ws + WS_W1T) + (size_t)li * 256 * 2048, 64 * kb, 32 * nb, 32 * nb, scr, F.lane); }
    { const int gt = F.blk * NTHR + F.tid, NGT = F.G * NTHR;
      for (int idx = gt; idx < DEPTH * 2 * 192 * 2048 / 8; idx += NGT) { const int li = idx / (192 * 256), rem = idx % (192 * 256);
          *(u32x4*)((bf16*)(ws + WS_W1T) + (size_t)li * 256 * 2048 + (size_t)64 * 2048 + (size_t)rem * 8) = (u32x4){0u, 0u, 0u, 0u}; }
      for (int idx = gt; idx < DEPTH * 2 * 4096; idx += NGT) { const int li = idx >> 12, f = (idx >> 6) & 63, e = idx & 63; ((bf16*)(ws + WS_W2T))[idx] = (bf16)f2bf(args->in[17][(size_t)li * 4096 + e * 64 + f]); }
    }
    for (int idx = gw; idx < DEPTH * 2 * 64; idx += NGW) { const int li = idx >> 6, e = idx & 63; const float* pp = args->in[15] + (size_t)li * 2048; const float* ww = args->in[16] + (size_t)li * 2048 * 64 + e;
        float a = 0.f;
#pragma unroll 8
        for (int k = F.lane; k < 2048; k += 64) a += pp[k] * ww[(size_t)k * 64];
        a = wave_sum(a, F.lane);
        if (F.lane == 0) ((float*)(ws + WS_CBIAS))[idx] = a; }
    for (int it = gw; it < DEPTH * PER_LAYER; it += NGW) {
        const int layer = it / PER_LAYER; int r = it % PER_LAYER;
        if (r < I_IN) { const int nb = r % 56, kb = r / 56;
            transpose_item(args->in[4] + (size_t)layer * DM * D_IN, DM, D_IN, (bf16*)(ws + WS_WIN) + (size_t)layer * ZP * DM, 64 * kb, 32 * nb, 32 * nb, scr, F.lane, (nb >= 16 && nb < 32) ? QSCALE : 1.0f); continue; }
        r -= I_IN;
        if (r < I_GLU) { const int nb = r % 32, kb = r / 32, n0 = 32 * nb;
            const int half = n0 >> 9, c = n0 & 511, drow = 256 * (c >> 7) + 128 * half + (c & 127);
            transpose_item(args->in[14] + (size_t)layer * D_SSM * 2 * D_SSM, D_SSM, 2 * D_SSM, (bf16*)(ws + WS_WGLU) + (size_t)layer * 2 * D_SSM * D_SSM, 64 * kb, n0, drow, scr, F.lane); continue; }
        r -= I_GLU;
        { const int nb = r % 32, kb = r / 32;
            transpose_item(args->in[5] + (size_t)layer * DM * DM, DM, DM, (bf16*)(ws + WS_WOUT) + (size_t)layer * DM * DM, 64 * kb, 32 * nb, 32 * nb, scr, F.lane); }
    }
    const int gt = F.blk * NTHR + F.tid, NGT = F.G * NTHR;
    for (int idx = gt; idx < DEPTH * 256 * DM; idx += NGT) {
        const int layer = idx / (256 * DM), rem = idx % (256 * DM), n = 1792 + rem / DM, k = rem % DM;
        const float v = n < D_IN ? args->in[4][(size_t)layer * DM * D_IN + (size_t)k * D_IN + n] : 0.f;
        ((bf16*)(ws + WS_WIN))[(size_t)layer * ZP * DM + (size_t)n * DM + k] = (bf16)f2bf(v);
    }
}

constexpr int PH_PER_LAYER = 8, N_PHASES = 1 + DEPTH * PH_PER_LAYER + 1;
#ifndef FAST_GEMM
#define FAST_GEMM 1
#endif
#ifndef REP_ATTN
#define REP_ATTN 1
#endif
#ifndef REP_CMP
#define REP_CMP 1
#endif
#ifndef REP_CARRY
#define REP_CARRY 1
#endif
#ifndef REP_CONV
#define REP_CONV 1
#endif
#ifndef REP_INPROJ
#define REP_INPROJ 1
#endif
#ifndef REP_G1
#define REP_G1 1
#endif
#ifndef REP_G2
#define REP_G2 1
#endif
#ifndef REP_GLU
#define REP_GLU 1
#endif
#ifndef REP_OUT
#define REP_OUT 1
#endif
#ifndef REP_NORM
#define REP_NORM 1
#endif
#ifndef REP_ROUTE
#define REP_ROUTE 1
#endif
#ifndef REP_GU
#define REP_GU 1
#endif
#ifndef REP_DN
#define REP_DN 1
#endif

__global__ void __launch_bounds__(NTHR, 2) fwd(Args args) {
    extern __shared__ __attribute__((aligned(16))) unsigned char lds_raw[];
    Frame F;
    F.lds = (LAS unsigned char*)lds_raw;
    F.tid = threadIdx.x; F.lane = F.tid & 63; F.wave = __builtin_amdgcn_readfirstlane(F.tid >> 6);
    F.blk = blockIdx.x; F.G = gridDim.x;
    typedef const __attribute__((address_space(4))) Args* KArgs;
    KArgs kp = (KArgs)__builtin_amdgcn_kernarg_segment_ptr();
    asm volatile("" : "+s"(kp));
    unsigned char* ws = kp->ws;
    volatile LAS unsigned* MISC = (volatile LAS unsigned*)(F.lds + MISC_OFF);
    if (F.tid < 32) MISC[F.tid] = 0u;
    __syncthreads();
    XcdBarrier bar; bar.bar = (unsigned*)(ws + WS_CTL) + CW_BAR; bar.x = 0; bar.st = nullptr;
    if (N_LAUNCH_MODE == 1) bar = xcd_barrier_post((unsigned*)(ws + WS_CTL) + CW_BAR, MISC + 8);
#define IN(k) (kp->ph_lo <= (k) && (k) < kp->ph_hi)
#define FRESH_IDS() do { int l_; asm volatile("v_mbcnt_lo_u32_b32 %0, -1, 0\n\tv_mbcnt_hi_u32_b32 %0, -1, %0" : "=v"(l_)); asm volatile("" : "+s"(F.wave), "+s"(F.blk), "+s"(F.G)); F.lane = l_; F.tid = F.wave * 64 + l_; asm volatile("" : "+s"(kp)); ws = kp->ws; bar.bar = (unsigned*)(ws + WS_CTL) + CW_BAR; } while (0)
#define SEAM(k) do { FRESH_IDS(); if (IN(k) && IN((k) + 1)) xcd_barrier(bar, F.tid); FRESH_IDS(); } while (0)

    const float* x0 = kp->in[0];
    float* XR = kp->out;
#define HN ((bf16*)(ws + WS_HN))
#define Z ((bf16*)(ws + WS_Z))
#define YC ((bf16*)(ws + WS_YC))
#define G1 ((bf16*)(ws + WS_G1))
#define KC ((bf16*)(ws + WS_KC))
#define VC ((bf16*)(ws + WS_VC))
#define LIST ((unsigned*)(ws + WS_LIST))
#define LISTW ((float*)(ws + WS_LISTW))
#define HID ((bf16*)(ws + WS_HID))
#define P2 ((bf16*)(ws + WS_P2))
#define P1B ((bf16*)(ws + WS_YC))
#define USSM ((bf16*)(ws + WS_USSM))
#define XL ((float*)(ws + WS_XL))
    LAS int* etab = (LAS int*)(F.lds + ETAB_OFF);

    if (IN(0)) { for (int rep_ = 0; rep_ < REP_CONV; ++rep_) ph_convert(F, kp, ws);
                 ph_norm(F, kp->in[0], nullptr, nullptr, kp->out, kp->in[1], HN); }
    SEAM(0);
    for (int layer = 0; layer < DEPTH; ++layer) {
        const int pb = 1 + layer * PH_PER_LAYER;
        const float* xin = layer == 0 ? x0 : XR;
        unsigned* gcnt = (unsigned*)(ws + WS_CTL) + CW_CNT + layer * 32 * 64;
        if (IN(pb + 0) && layer > 0) { ph_norm(F, xin, P1B, P2, XR, kp->in[1] + layer * DM, HN); for (int rep_ = 1; rep_ < REP_NORM; ++rep_) ph_norm(F, xin, nullptr, nullptr, XR, kp->in[1] + layer * DM, HN); }
        if (layer > 0) SEAM(pb + 0);
        if (IN(pb + 1)) {
            pg8::Gemm g{HN, (const bf16*)(ws + WS_WIN) + (size_t)layer * ZP * DM, T, ZP, DM, DM, 0, nullptr, 0, 0, 128}; pg8::StaticOrder S; S.init(T, ZP, F.G, F.blk);
            pg8::EpiInProj E{Z, USSM};
            for (int rep_ = 0; rep_ < REP_INPROJ; ++rep_) pg8::gemm2<pg8::EpiInProj, pg8::StaticOrder, pg8::ADense>(F.lds, g, S, E, F.tid);
        }
        SEAM(pb + 1);
        if (IN(pb + 2)) {
            for (int rep_ = 0; rep_ < REP_CMP; ++rep_) {
                { pg8::Gemm g{Z, (const bf16*)(ws + WS_W1T) + (size_t)layer * 2 * 256 * 2048, 0, 256, 2048, ZP, (size_t)256 * 2048, nullptr, 0, 0, ZP * 2};
                  pg8::CmpOrder S{F.G, F.blk}; pg8::EpiCmpHid E{(bf16*)(ws + WS_HIDC), (const float*)(ws + WS_CBIAS) + layer * 128};
                  pg8::gemm2<pg8::EpiCmpHid, pg8::CmpOrder, pg8::ACompress>(F.lds, g, S, E, F.tid); }
                asm volatile("s_waitcnt vmcnt(0)" ::: "memory"); __syncthreads();
                for (int L = F.blk; L < 32; L += F.G) compress_stage2(F, L >> 4, L & 15, (const bf16*)(ws + WS_HIDC), (const bf16*)(ws + WS_W2T) + (size_t)layer * 2 * 4096, KC, VC);
            }
#pragma unroll 1
            for (int L = F.blk; L < NGRP * BATCH; L += F.G) {
                const int sg = L >> 3, sb = L & 7;
                FRESH_IDS();
                { pg8::Gemm g{USSM, (const bf16*)(ws + WS_BT1) + (size_t)layer * 32 * 256 * 256, 0, 256, 256, 512, (size_t)256 * 256, nullptr, 0, (size_t)2048 * 512, 128};
                  pg8::SingleUnit S{sg, sb}; pg8::EpiXloc E{XL};
                  pg8::gemm2<pg8::EpiXloc, pg8::SingleUnit, pg8::ADense>(F.lds, g, S, E, F.tid); }
                asm volatile("s_waitcnt vmcnt(0)" ::: "memory"); __syncthreads();
                for (int rep_ = 0; rep_ < REP_CARRY; ++rep_)
                if (F.wave == 0) ssm_carry_item(sb, sg, kp->in[6] + layer * NGRP * SST, kp->in[7] + layer * NGRP * SST, kp->in[13] + layer * NGRP, XL, USSM, F.lane);
                asm volatile("s_waitcnt vmcnt(0)" ::: "memory"); __syncthreads();
                FRESH_IDS();
                { pg8::Gemm g{USSM, (const bf16*)(ws + WS_BT2) + (size_t)layer * 32 * 256 * 384, 0, 256, 384, 512, (size_t)256 * 384, nullptr, 0, (size_t)2048 * 512, 128};
                  pg8::SingleUnit S{sg, sb}; pg8::EpiSsmOut E{G1};
                  pg8::gemm2<pg8::EpiSsmOut, pg8::SingleUnit, pg8::ADense>(F.lds, g, S, E, F.tid); }
            }
            if (F.G > 64) { if (F.blk >= 32) convert_experts(F, kp, ws, layer, (F.blk - 32) * NWAVES + F.wave, (F.G - 32) * NWAVES); }
            else convert_experts(F, kp, ws, layer, F.blk * NWAVES + F.wave, F.G * NWAVES);
        }
        SEAM(pb + 2);
        if (IN(pb + 3)) {
            { pg8::Gemm g{G1, (const bf16*)(ws + WS_WGLU) + (size_t)layer * 2 * D_SSM * D_SSM, T, 2 * D_SSM, D_SSM, D_SSM, 0, nullptr, 0, 0, 128}; pg8::StaticOrder S; S.init(T, 2 * D_SSM, F.G, F.blk);
              pg8::EpiGlu E{YC, DM};
              for (int rep_ = 0; rep_ < REP_GLU; ++rep_) pg8::gemm2<pg8::EpiGlu, pg8::StaticOrder, pg8::ADense>(F.lds, g, S, E, F.tid); }
            __syncthreads();
            int last_hkv = -1;
            for (int rep_ = 0; rep_ < REP_ATTN; ++rep_)
            for (int slot = F.blk; slot < 256; slot += F.G) {
                const int bh = slot >> 4, sq = slot & 15;
#pragma unroll 1
                for (int uq = 0; uq < 4; ++uq) { const int jt = uq == 0 ? 63 - sq : (uq == 1 ? 32 + sq : (uq == 2 ? 31 - sq : sq));
                    nsa::unit((LAS char*)F.lds, F.tid, bh >> 1, bh & 1, jt, Z, KC, VC, kp->in[18], YC, (bh & 1) != last_hkv); last_hkv = bh & 1; }
            }
        }
        SEAM(pb + 3);
        if (IN(pb + 4)) {
            pg8::Gemm g{YC, (const bf16*)(ws + WS_WOUT) + (size_t)layer * DM * DM, T, DM, DM, DM, 0, nullptr, 0, 0, 128}; pg8::StaticOrder S; S.init(T, DM, F.G, F.blk);
            for (int rep_ = 1; rep_ < REP_OUT; ++rep_) { pg8::EpiResid Ed{xin, (float*)(ws + WS_Z), DM}; pg8::gemm2<pg8::EpiResid, pg8::StaticOrder, pg8::ADense>(F.lds, g, S, Ed, F.tid); }
            pg8::EpiResid E{xin, XR, DM};
            pg8::gemm2<pg8::EpiResid, pg8::StaticOrder, pg8::ADense>(F.lds, g, S, E, F.tid);
        }
        SEAM(pb + 4);
        if (IN(pb + 5)) ph_norm_route(F, XR, kp->in[2] + layer * DM, kp->in[19] + (size_t)layer * DM * 4, kp->in[20] + layer * 4, kp->in[21] + (size_t)layer * 4 * DM * 8, kp->in[22] + layer * 32, HN, gcnt, LIST, LISTW);
        if (IN(pb + 5)) for (int rep_ = 1; rep_ < REP_ROUTE; ++rep_) ph_norm_route(F, XR, kp->in[2] + layer * DM, kp->in[19] + (size_t)layer * DM * 4, kp->in[20] + layer * 4, kp->in[21] + (size_t)layer * 4 * DM * 8, kp->in[22] + layer * 32, HN, gcnt + (2 + rep_) * 32 * 64, (unsigned*)(ws + 484 * MiB), (float*)(ws + 488 * MiB));
        SEAM(pb + 5);
        if (IN(pb + 6)) {
            build_expert_tab(F, gcnt, etab);
            pg8::Gemm g{HN, (const bf16*)(ws + WS_WGU) + (size_t)layer * 32 * 512 * DM, 0, 512, DM, DM, (size_t)512 * DM, LIST, LCAP, 0, 128};
            pg8::ExpertOrder S{etab, 2, F.G, F.blk};
            pg8::EpiGateUp E{HID, LISTW, LCAP};
            for (int rep_ = 0; rep_ < REP_GU; ++rep_) pg8::gemm2<pg8::EpiGateUp, pg8::ExpertOrder, pg8::AList>(F.lds, g, S, E, F.tid);
        }
        SEAM(pb + 6);
        if (IN(pb + 7)) {
            build_expert_tab(F, gcnt, etab);
            pg8::Gemm g{HID, (const bf16*)(ws + WS_WDN) + (size_t)layer * 32 * DM * 256, 0, DM, 256, 256, (size_t)DM * 256, nullptr, 0, 0, 128};
            pg8::ExpertOrder S{etab, 4, F.G, F.blk};
            for (int rep_ = 1; rep_ < REP_DN; ++rep_) { pg8::EpiDown Ed{P1B, (long)(P2 - P1B), LIST, LCAP}; pg8::gemm2<pg8::EpiDown, pg8::ExpertOrder, pg8::ADense>(F.lds, g, S, Ed, F.tid); }
            pg8::EpiDown E{P1B, (long)(P2 - P1B), LIST, LCAP};
            pg8::gemm2<pg8::EpiDown, pg8::ExpertOrder, pg8::ADense>(F.lds, g, S, E, F.tid);
        }
        SEAM(pb + 7);
    }
    if (IN(N_PHASES - 1)) ph_final_norm(F, XR, P1B, P2, kp->in[3]);
#undef IN
#undef SEAM
#undef HN
#undef Z
#undef YC
#undef G1
#undef KC
#undef VC
#undef LIST
#undef LISTW
#undef HID
#undef P2
#undef P1B
#undef USSM
#undef XL
}

extern "C" void kernel_launch(void* const* d_in, const int* in_sizes, int n_in, void* d_out, int out_size, void* d_ws, size_t ws_size, hipStream_t stream) {
    static int grid = 0;
    if (grid == 0) {
        if (n_in != 26 || out_size != T * DM || ws_size < WS_END) { fprintf(stderr, "kernel_launch: unexpected shapes (n_in %d out %d ws %zu)\n", n_in, out_size, ws_size); grid = -1; return; }
        int dev = 0, cus = 0, per_cu = 0;
        if (hipGetDevice(&dev) != hipSuccess || hipDeviceGetAttribute(&cus, hipDeviceAttributeMultiprocessorCount, dev) != hipSuccess) { grid = -1; return; }
        if (hipFuncSetAttribute((const void*)fwd, hipFuncAttributeMaxDynamicSharedMemorySize, LDS_BYTES) != hipSuccess) { fprintf(stderr, "kernel_launch: hipFuncSetAttribute failed\n"); grid = -1; return; }
        if (hipOccupancyMaxActiveBlocksPerMultiprocessor(&per_cu, (const void*)fwd, NTHR, LDS_BYTES) != hipSuccess || per_cu < 1) fprintf(stderr, "kernel_launch: occupancy query says %d\n", per_cu);
        (void)hipGetLastError();
        grid = cus;
    }
    if (grid < 0) return;
    (void)hipMemsetAsync((char*)d_ws + WS_CTL, 0, CTL_ZERO_BYTES, stream);
    Args a{};
    for (int i = 0; i < 26; ++i) a.in[i] = (const float*)d_in[i];
    a.out = (float*)d_out; a.ws = (unsigned char*)d_ws;
    if (N_LAUNCH_MODE == 1) {
        a.ph_lo = 0; a.ph_hi = N_PHASES;
        hipLaunchKernelGGL(fwd, dim3(grid), dim3(NTHR), LDS_BYTES, stream, a);
    } else {
        for (int p = 0; p < N_PHASES; ++p) { a.ph_lo = p; a.ph_hi = p + 1; hipLaunchKernelGGL(fwd, dim3(grid), dim3(NTHR), LDS_BYTES, stream, a); }
    }
}
```

```cpp
#include <hip/hip_runtime.h>
#include <cstdio>
#include <cstdint>

#ifndef N_LAUNCH_MODE
#define N_LAUNCH_MODE 1
#endif

#define GAS __attribute__((address_space(1)))
#define LAS __attribute__((address_space(3)))
typedef unsigned short bf16;
typedef float f32x4 __attribute__((ext_vector_type(4)));
typedef unsigned u32x4 __attribute__((ext_vector_type(4)));
typedef unsigned u32x2 __attribute__((ext_vector_type(2)));

constexpr int BATCH = 8, SEQ = 4096, DM = 1024, T = BATCH * SEQ, DEPTH = 2;
constexpr int D_SSM = 512, NGRP = 32, SGRP = 16, SST = 64;
constexpr int D_IN = 1816, ZP = 2048;
constexpr int ZC_U = 0, ZC_Q = 512, ZC_KV = 1024, ZC_G = 1792;
constexpr int NCMP = 255, NCMPP = 256;
constexpr float EPS = 1e-6f;
constexpr int NWAVES = 8, NTHR = 512;
constexpr float QSCALE = 0.125f * 1.4426950408889634f;

constexpr size_t MiB = 1u << 20;
constexpr size_t WS_CTL = 0, CTL_ZERO_BYTES = 1 * MiB;
constexpr size_t WS_KC = 1 * MiB, WS_VC = 2 * MiB, WS_ROUTE = 3 * MiB;
constexpr size_t WS_HN = 16 * MiB;
constexpr size_t WS_Z = 80 * MiB;
constexpr size_t WS_YC = 208 * MiB;
constexpr size_t WS_G1 = 272 * MiB;
constexpr size_t WS_WIN = 304 * MiB;
constexpr size_t WS_WGLU = 312 * MiB;
constexpr size_t WS_WOUT = 314 * MiB;
constexpr size_t WS_WGU = 318 * MiB;
constexpr size_t WS_WDN = 382 * MiB;
constexpr size_t WS_LIST = 414 * MiB;
constexpr size_t WS_LISTW = 418 * MiB;
constexpr size_t WS_HID = 422 * MiB;
constexpr size_t WS_P2 = WS_Z;
constexpr size_t WS_USSM = WS_YC;
constexpr size_t WS_XL = WS_HID;
constexpr size_t WS_BT1 = 458 * MiB;
constexpr size_t WS_BT2 = 466 * MiB;
constexpr size_t WS_W1T = 478 * MiB;
constexpr size_t WS_HIDC = 4 * MiB;
constexpr size_t WS_CBIAS = 5 * MiB;
constexpr size_t WS_W2T = 6 * MiB;
constexpr size_t WS_END = 482 * MiB;
constexpr int LCAP = 32768, CW_CNT = 8192;
constexpr int CW_BAR = 4096;

constexpr int LDS_BYTES = 163840;
constexpr int ETAB_OFF = LDS_BYTES - 1024, MISC_OFF = LDS_BYTES - 512;

__device__ __forceinline__ float bf2f(bf16 v) { return __uint_as_float(((unsigned)v) << 16); }
__device__ __forceinline__ unsigned f2bf(float f) { unsigned u = __float_as_uint(f); return (u + 0x7fffu + ((u >> 16) & 1u)) >> 16; }
__device__ __forceinline__ unsigned pk2(float lo, float hi) { return f2bf(lo) | (f2bf(hi) << 16); }
__device__ __forceinline__ float wave_sum(float v, int) {
    v += __builtin_bit_cast(float, __builtin_amdgcn_update_dpp(0, __builtin_bit_cast(int, v), 0xB1, 0xF, 0xF, true));
    v += __builtin_bit_cast(float, __builtin_amdgcn_update_dpp(0, __builtin_bit_cast(int, v), 0x4E, 0xF, 0xF, true));
    v += __builtin_bit_cast(float, __builtin_amdgcn_update_dpp(0, __builtin_bit_cast(int, v), 0x141, 0xF, 0xF, true));
    v += __builtin_bit_cast(float, __builtin_amdgcn_update_dpp(0, __builtin_bit_cast(int, v), 0x140, 0xF, 0xF, true));
    const int iv = __builtin_bit_cast(int, v);
    const float s0 = __builtin_bit_cast(float, __builtin_amdgcn_readlane(iv, 0)), s1 = __builtin_bit_cast(float, __builtin_amdgcn_readlane(iv, 16));
    const float s2 = __builtin_bit_cast(float, __builtin_amdgcn_readlane(iv, 32)), s3 = __builtin_bit_cast(float, __builtin_amdgcn_readlane(iv, 48));
    return (s0 + s1) + (s2 + s3);
}
__device__ __forceinline__ float wave_max(float v, int lane) {
#pragma unroll
    for (int o = 1; o < 64; o <<= 1) v = fmaxf(v, __int_as_float(__builtin_amdgcn_ds_bpermute((lane ^ o) << 2, __float_as_int(v))));
    return v;
}
__device__ __forceinline__ float lane_bcast(float v, int src) { return __int_as_float(__builtin_amdgcn_ds_bpermute(src << 2, __float_as_int(v))); }
__device__ __forceinline__ float gelu_tanh(float x) {
    const float u = 0.7978845608028654f * (x + 0.044715f * x * x * x);
    return 0.5f * x * (1.0f + tanhf(u));
}
__device__ __forceinline__ float sigmoidf_(float x) { return 1.0f / (1.0f + __expf(-x)); }
__device__ __forceinline__ int t5_bucket(int n) {
    if (n < 16) return n < 0 ? 0 : n;
    int b = 16;
    b += (n >= 19); b += (n >= 21); b += (n >= 24); b += (n >= 27); b += (n >= 31); b += (n >= 35); b += (n >= 40); b += (n >= 46);
    b += (n >= 52); b += (n >= 59); b += (n >= 67); b += (n >= 77); b += (n >= 87); b += (n >= 99); b += (n >= 113);
    return b;
}

#define XB_TMO      128
#define XB_XCNT(j)  (256  + 64 * (j))
#define XB_XSUB(j)  (1280 + 64 * (j))
#define XB_XGEN(j)  (2304 + 64 * (j))
#define XB_TOP      3328
#define XB_TOPGEN   3392
#define XCD_BAR_WORDS 3456
#define XB_SPIN_CAP (1u << 22)

__device__ __forceinline__ unsigned xb_ld(unsigned* p)              { return __hip_atomic_load(p, __ATOMIC_RELAXED, __HIP_MEMORY_SCOPE_AGENT); }
__device__ __forceinline__ unsigned xb_add(unsigned* p, unsigned v) { return __hip_atomic_fetch_add(p, v, __ATOMIC_RELAXED, __HIP_MEMORY_SCOPE_AGENT); }
__device__ __forceinline__ unsigned xb_xcc_id() { return (unsigned)__builtin_amdgcn_s_getreg((3 << 11) | 20) & 0xFu; }
#define XB_SPIN(cond, bar) do { unsigned _sp = 0; while (cond) { __builtin_amdgcn_s_sleep(1); \
    if ((++_sp & 255u) == 0u) { if (xb_ld(&(bar)[XB_TMO])) break; if (_sp > XB_SPIN_CAP) { atomicAdd(&(bar)[XB_TMO], 1u); break; } } } } while (0)

struct XcdBarrier { unsigned* bar; unsigned x; volatile LAS unsigned* st; };

__device__ __forceinline__ XcdBarrier xcd_barrier_post(unsigned* bar, volatile LAS unsigned* st) {
    XcdBarrier b; b.bar = bar; b.x = xb_xcc_id(); b.st = st;
    if (threadIdx.x == 0) (void)xb_add(&bar[XB_XCNT(b.x)], 1u);
    return b;
}
__device__ __forceinline__ void xcd_barrier_complete(unsigned* bar, unsigned x, unsigned& nloc, unsigned& nx) {
    const unsigned G = gridDim.x * gridDim.y * gridDim.z;
    unsigned sum, cnt, mine, sp = 0u;
    for (;;) {
        sum = 0u; cnt = 0u; mine = 0u;
#pragma unroll
        for (unsigned j = 0; j < 16; ++j) { const unsigned c = xb_ld(&bar[XB_XCNT(j)]); sum += c; cnt += (c > 0u) ? 1u : 0u; mine = (j == x) ? c : mine; }
        if (sum == G) break;
        __builtin_amdgcn_s_sleep(1);
        if ((++sp & 255u) == 0u) { if (xb_ld(&bar[XB_TMO])) break; if (sp > XB_SPIN_CAP) { atomicAdd(&bar[XB_TMO], 1u); break; } }
    }
    nloc = mine > 0u ? mine : 1u; nx = cnt > 0u ? cnt : 1u;
}
__device__ __forceinline__ void xcd_barrier(const XcdBarrier& b, const int tid) {
    asm volatile("s_waitcnt vmcnt(0)" ::: "memory");
    __syncthreads();
    if (tid == 0) {
        unsigned* bar = b.bar;
        __builtin_amdgcn_s_waitcnt(0);
        unsigned nloc = b.st[0], nx = b.st[1];
        if (nloc == 0u) { xcd_barrier_complete(bar, b.x, nloc, nx); b.st[0] = nloc; b.st[1] = nx; }
        const unsigned old = xb_add(&bar[XB_XSUB(b.x)], 1u);
        const unsigned gen = old / nloc;
        if (old + 1u == (gen + 1u) * nloc) {
            __builtin_amdgcn_fence(__ATOMIC_RELEASE, "agent");
            asm volatile("s_waitcnt vmcnt(0)" ::: "memory");
            const unsigned og = xb_add(&bar[XB_TOP], 1u);
            const unsigned tg = og / nx;
            if (og + 1u == (tg + 1u) * nx) xb_add(&bar[XB_TOPGEN], 1u);
            else XB_SPIN(xb_ld(&bar[XB_TOPGEN]) == tg, bar);
            __builtin_amdgcn_fence(__ATOMIC_ACQUIRE, "agent");
            xb_add(&bar[XB_XGEN(b.x)], 1u);
            asm volatile("s_waitcnt vmcnt(0)" ::: "memory");
        } else {
            XB_SPIN(xb_ld(&bar[XB_XGEN(b.x)]) == gen, bar);
            __builtin_amdgcn_fence(__ATOMIC_ACQUIRE, "agent");
            asm volatile("s_waitcnt vmcnt(0)" ::: "memory");
        }
    }
    __syncthreads();
}

namespace pg8 {
#define PG8_LAS __attribute__((address_space(3)))
typedef unsigned short bf16_t;
typedef short bf16x8 __attribute__((ext_vector_type(8)));
typedef float f32x4 __attribute__((ext_vector_type(4)));
typedef unsigned u32x4 __attribute__((ext_vector_type(4)));
constexpr int BM = 256, BK = 64, HALF = 128, HTB = HALF * BK * 2  , STAGE_BYTES = 8 * HTB, NXCD = 8, WGM = 8;

__host__ __device__ __forceinline__ int lds_byte(int r, int c) { const int st = (r >> 4) * 2 + (c >> 5), rr = r & 15, cc = c & 31, ob = rr * 64 + cc * 2; return st * 1024 + (ob ^ (((ob >> 9) & 1) << 5)); }
__host__ __device__ __forceinline__ void stage_rc(int b, int& R, int& C) { const int st = b / 1024, sb = b % 1024, swz = sb ^ (((sb >> 9) & 1) << 5); R = (st >> 1) * 16 + swz / 64; C = (st & 1) * 32 + (swz % 64) / 2; }
__host__ __device__ __forceinline__ int perm32(int rho) { const int n = rho >> 4, i = rho & 15; return 8 * (i >> 2) + 4 * n + (i & 3); }

struct Unit { int pm, pn, eb, p0, cnt; };
struct Gemm { const bf16_t* A; const bf16_t* Bt; int M, N, K; int lda; size_t bstride; const unsigned* list; int cap; size_t astride; int kstepA; };

struct StaticOrder {
    int nM, nN, nwg, G, c;
    __host__ __device__ void init(int M, int N, int G_, int c_) { nM = M / BM; nN = N / BM; nwg = nM * nN; G = G_; c = c_; }
    __host__ __device__ bool next(int i, Unit& u) const {
        const long L = (long)i * G + c; if (L >= nwg) return false;
        int wgid = (int)L; { const int q = nwg / NXCD, r = nwg % NXCD, xcd = wgid % NXCD, off = wgid / NXCD; wgid = (xcd < r ? xcd * (q + 1) : r * (q + 1) + (xcd - r) * q) + off; }
        const int nig = WGM * nN, gid = wgid / nig, fm = gid * WGM, gsz = (nM - fm) < WGM ? (nM - fm) : WGM;
        u.pm = fm + ((wgid % nig) % gsz); u.pn = (wgid % nig) / gsz; u.eb = 0; u.p0 = 0; u.cnt = 0; return true;
    }
    __device__ __forceinline__ void a_ready(const Unit&) const {}
    __device__ __forceinline__ void done(const Unit&) const {}
};

__device__ __forceinline__ unsigned cvt_pk_bf16(float lo, float hi) { unsigned r; asm volatile("v_cvt_pk_bf16_f32 %0, %1, %2" : "=v"(r) : "v"(lo), "v"(hi)); return r; }
typedef float f32x2 __attribute__((ext_vector_type(2)));
__device__ __forceinline__ f32x2 gelu_pk(f32x2 v) {
    const f32x2 av = __builtin_elementwise_abs(v), d = av * 0.2316418882f + 1.0f;
    f32x2 t; t.x = __builtin_amdgcn_rcpf(d.x); t.y = __builtin_amdgcn_rcpf(d.y);
    f32x2 q = t * 0.5307027145f + (-0.7265760135f); q = q * t + 0.7107068705f; q = q * t + (-0.142248368f); q = q * t + 0.127414796f; q = q * t;
    const f32x2 s = (v * v) * (-0.72134752044f);
    f32x2 e; e.x = __builtin_amdgcn_exp2f(s.x); e.y = __builtin_amdgcn_exp2f(s.y);
    const f32x2 m = v * (q * e), r = v - m;
    f32x2 o; o.x = v.x < 0.f ? m.x : r.x; o.y = v.y < 0.f ? m.y : r.y; return o;
}

template <int ACT  > struct EpiBf16 {
    static constexpr bool PERM = true, AFTER_DRAIN = false; static_assert(ACT == 0 || ACT == 1, "EpiBf16: ACT is 0 (none) or 1 (gelu_pk)");
    bf16_t* O; int ldc; const float* bias; int split_cols; size_t split_stride; float scale0;
    __device__ __forceinline__ void operator()(const f32x4 (&acc)[2][2][4][2], const Unit& u, int wr, int wc, int fr, int fq) const {
        const int row0 = u.pm * BM + wr * 64 + fr; int colt = u.pn * BM; bf16_t* base = O;
        float sc = 1.f; if (split_cols) { const int t = colt / split_cols; base += (size_t)t * split_stride; colt -= t * split_cols; if (t == 0) sc = scale0; }
        const int col0 = colt + wc * 32 + 8 * fq, bcol0 = u.pn * BM + wc * 32 + 8 * fq;
        f32x4 bv[2][2];
#pragma unroll
        for (int bj = 0; bj < 2; ++bj)
#pragma unroll
            for (int n = 0; n < 2; ++n) bv[bj][n] = bias ? *(const f32x4*)(bias + bcol0 + bj * HALF + 4 * n) : (f32x4){0.f, 0.f, 0.f, 0.f};
#pragma unroll
        for (int ai = 0; ai < 2; ++ai)
#pragma unroll
            for (int m = 0; m < 4; ++m) { bf16_t* rowp = base + (size_t)(row0 + ai * HALF + m * 16) * ldc + col0;
#pragma unroll
                for (int bj = 0; bj < 2; ++bj) { f32x4 v0 = acc[ai][bj][m][0] + bv[bj][0], v1 = acc[ai][bj][m][1] + bv[bj][1];
                    if (ACT == 1) { f32x2 a = gelu_pk((f32x2){v0[0], v0[1]}), b = gelu_pk((f32x2){v0[2], v0[3]}), c = gelu_pk((f32x2){v1[0], v1[1]}), d = gelu_pk((f32x2){v1[2], v1[3]});
                        v0 = (f32x4){a.x, a.y, b.x, b.y}; v1 = (f32x4){c.x, c.y, d.x, d.y}; }
                    v0 = v0 * sc; v1 = v1 * sc; u32x4 w; w.x = cvt_pk_bf16(v0[0], v0[1]); w.y = cvt_pk_bf16(v0[2], v0[3]); w.z = cvt_pk_bf16(v1[0], v1[1]); w.w = cvt_pk_bf16(v1[2], v1[3]);
                    *(u32x4*)(rowp + bj * HALF) = w; } }
    }
};
template <class Epi, class Sched, bool ALIGN_EPI = false, bool SP2 = false>
__device__ __forceinline__ void gemm_phase(PG8_LAS unsigned char* lds, const Gemm g, const Sched& S, const Epi& E) {
    int tid_ = threadIdx.x; asm volatile("" : "+v"(tid_));
    const int tid = tid_, wid = __builtin_amdgcn_readfirstlane(tid >> 6), lane = tid & 63, wr = wid >> 2, wc = wid & 3, fr = lane & 15, fq = lane >> 4;
    const int K = g.K, nt = K / BK;
    unsigned voffA[2], voffB[2];
#pragma unroll
    for (int i = 0; i < 2; ++i) { int R, C; stage_rc(tid * 16 + i * 8192, R, C); const int Rb = Epi::PERM ? ((R & ~31) + perm32(R & 31)) : R;
        voffA[i] = (unsigned)(R * K + C) * 2u; voffB[i] = (unsigned)(Rb * K + C) * 2u; }
    const size_t kstep = (size_t)(BK * 2);
    const size_t hstep = (size_t)HALF * K * 2;
    const size_t tstep = 2 * hstep;
    const unsigned ldsw = (unsigned)wid * 1024u;
    const int aoff = lds_byte(wr * 64 + fr, fq * 8), boff = lds_byte(wc * 32 + fr, fq * 8);
#define PG8_SA(b, h) (((b) * 2 + (h)) * HTB)
#define PG8_SB(b, h) ((4 + (b) * 2 + (h)) * HTB)
#define PG8_STAGE(bufoff, gbase, voff) do { _Pragma("unroll") for (int _i = 0; _i < 2; ++_i) \
        __builtin_amdgcn_global_load_lds((const unsigned*)((const char*)(gbase) + (voff)[_i]), (PG8_LAS unsigned*)(lds + (bufoff) + ldsw + _i * 8192), 16, 0, 0); } while (0)
#define PG8_LDA(dst, b, h) do { _Pragma("unroll") for (int m = 0; m < 4; ++m) _Pragma("unroll") for (int k = 0; k < 2; ++k) dst[m][k] = *(const PG8_LAS bf16x8*)(lds + PG8_SA(b, h) + aoff + m * 2048 + k * 1024); } while (0)
#define PG8_LDB(dst, b, h) do { _Pragma("unroll") for (int n = 0; n < 2; ++n) _Pragma("unroll") for (int k = 0; k < 2; ++k) dst[n][k] = *(const PG8_LAS bf16x8*)(lds + PG8_SB(b, h) + boff + n * 2048 + k * 1024); } while (0)
#define PG8_MMA(ai, bj, At, Bt) do { __builtin_amdgcn_s_setprio(1); _Pragma("unroll") for (int m = 0; m < 4; ++m) _Pragma("unroll") for (int n = 0; n < 2; ++n) _Pragma("unroll") for (int k = 0; k < 2; ++k) \
        acc[ai][bj][m][n] = __builtin_amdgcn_mfma_f32_16x16x32_bf16(Bt[n][k], At[m][k], acc[ai][bj][m][n], 0, 0, 0); __builtin_amdgcn_s_setprio(0); } while (0)
#define PG8_WAIT_V(n) asm volatile("s_waitcnt vmcnt(" #n ")" ::: "memory")
#define PG8_WAIT_L(n) asm volatile("s_waitcnt lgkmcnt(" #n ")" ::: "memory")
#define PG8_BAR __builtin_amdgcn_s_barrier()
#define PG8_SCHED __builtin_amdgcn_sched_barrier(0)
    Unit cur, nxt; int ui = 0;
    if (!S.next(0, cur)) return;
    f32x4 acc[2][2][4][2];
#pragma unroll
    for (int a = 0; a < 2; ++a)
#pragma unroll
        for (int b = 0; b < 2; ++b)
#pragma unroll
            for (int m = 0; m < 4; ++m)
#pragma unroll
                for (int n = 0; n < 2; ++n) acc[a][b][m][n] = (f32x4){0.f, 0.f, 0.f, 0.f};
    bf16x8 At[4][2], B0[2][2], B1[2][2];
    const char* cA = (const char*)g.A + (size_t)cur.pm * tstep; const char* cB = (const char*)g.Bt + (size_t)cur.pn * tstep;
    S.a_ready(cur);
    if constexpr (SP2) {
        PG8_STAGE(PG8_SB(0, 0), cB, voffB); PG8_STAGE(PG8_SB(0, 1), cB + hstep, voffB); PG8_STAGE(PG8_SA(0, 0), cA, voffA); PG8_STAGE(PG8_SA(0, 1), cA + hstep, voffA);
        if (wr == 1) PG8_BAR;
        PG8_WAIT_V(2); PG8_BAR;
        PG8_STAGE(PG8_SB(1, 0), cB + kstep, voffB); PG8_STAGE(PG8_SA(1, 0), cA + kstep, voffA); PG8_STAGE(PG8_SB(1, 1), cB + hstep + kstep, voffB);
        PG8_WAIT_V(6); PG8_BAR;
    } else {
        PG8_STAGE(PG8_SB(0, 0), cB, voffB); PG8_STAGE(PG8_SA(0, 0), cA, voffA); PG8_STAGE(PG8_SB(0, 1), cB + hstep, voffB); PG8_STAGE(PG8_SA(0, 1), cA + hstep, voffA);
        if (wr == 1) PG8_BAR;
        PG8_WAIT_V(4); PG8_BAR;
        PG8_STAGE(PG8_SB(1, 0), cB + kstep, voffB); PG8_STAGE(PG8_SA(1, 0), cA + kstep, voffA); PG8_STAGE(PG8_SB(1, 1), cB + hstep + kstep, voffB);
        PG8_WAIT_V(6); PG8_BAR;
    }
    for (;;) {
        const bool has_next = S.next(ui + 1, nxt);
        const char* nA = has_next ? (const char*)g.A + (size_t)nxt.pm * tstep : cA; const char* nB = has_next ? (const char*)g.Bt + (size_t)nxt.pn * tstep : cB;
        for (int t = 0; t < nt; t += 2) {
            const bool last = (t == nt - 2);
            const char* a1 = cA + (size_t)(t + 1) * kstep;
            const char* a2 = last ? nA : cA + (size_t)(t + 2) * kstep; const char* b2 = last ? nB : cB + (size_t)(t + 2) * kstep;
            const char* a3 = a2 + kstep; const char* b3 = b2 + kstep;
            if (last && has_next) S.a_ready(nxt);
            if constexpr (SP2) {
            PG8_LDB(B0, 0, 0); PG8_LDB(B1, 0, 1); PG8_SCHED; PG8_LDA(At, 0, 0); PG8_STAGE(PG8_SA(1, 1), a1 + hstep, voffA);
            PG8_WAIT_V(8); PG8_WAIT_L(0); PG8_BAR; PG8_MMA(0, 0, At, B0); PG8_MMA(0, 1, At, B1); PG8_BAR; PG8_SCHED;
            PG8_LDA(At, 0, 1); PG8_STAGE(PG8_SB(0, 0), b2, voffB); PG8_STAGE(PG8_SB(0, 1), b2 + hstep, voffB); PG8_STAGE(PG8_SA(0, 0), a2, voffA);
            PG8_WAIT_V(8); PG8_WAIT_L(0); PG8_BAR; PG8_MMA(1, 0, At, B0); PG8_MMA(1, 1, At, B1); PG8_BAR; PG8_SCHED;
            PG8_LDB(B0, 1, 0); PG8_LDB(B1, 1, 1); PG8_SCHED; PG8_LDA(At, 1, 0); PG8_STAGE(PG8_SA(0, 1), a2 + hstep, voffA);
            PG8_WAIT_V(8); PG8_WAIT_L(0); PG8_BAR; PG8_MMA(0, 0, At, B0); PG8_MMA(0, 1, At, B1); PG8_BAR; PG8_SCHED;
            PG8_LDA(At, 1, 1); PG8_STAGE(PG8_SB(1, 0), b3, voffB); PG8_STAGE(PG8_SB(1, 1), b3 + hstep, voffB); PG8_STAGE(PG8_SA(1, 0), a3, voffA);
            PG8_WAIT_V(8); PG8_WAIT_L(0); PG8_BAR; PG8_MMA(1, 0, At, B0); PG8_MMA(1, 1, At, B1); PG8_BAR; PG8_SCHED;
            } else {
            PG8_LDB(B0, 0, 0); PG8_SCHED; PG8_LDA(At, 0, 0); PG8_STAGE(PG8_SA(1, 1), a1 + hstep, voffA);
            PG8_WAIT_L(8); PG8_BAR; PG8_WAIT_L(0); PG8_MMA(0, 0, At, B0); PG8_BAR; PG8_SCHED;
            PG8_LDB(B1, 0, 1); PG8_STAGE(PG8_SB(0, 0), b2, voffB);
            PG8_BAR; PG8_WAIT_L(0); PG8_MMA(0, 1, At, B1); PG8_BAR;
            PG8_LDA(At, 0, 1); PG8_STAGE(PG8_SA(0, 0), a2, voffA);
            PG8_BAR; PG8_WAIT_L(0); PG8_MMA(1, 0, At, B0); PG8_BAR; PG8_SCHED;
            PG8_STAGE(PG8_SB(0, 1), b2 + hstep, voffB);
            PG8_WAIT_V(6); PG8_BAR; PG8_MMA(1, 1, At, B1); PG8_BAR;
            PG8_LDB(B0, 1, 0); PG8_SCHED; PG8_LDA(At, 1, 0); PG8_STAGE(PG8_SA(0, 1), a2 + hstep, voffA);
            PG8_WAIT_L(8); PG8_BAR; PG8_WAIT_L(0); PG8_MMA(0, 0, At, B0); PG8_BAR; PG8_SCHED;
            PG8_LDB(B1, 1, 1); PG8_STAGE(PG8_SB(1, 0), b3, voffB);
            PG8_BAR; PG8_WAIT_L(0); PG8_MMA(0, 1, At, B1); PG8_BAR;
            PG8_LDA(At, 1, 1); PG8_STAGE(PG8_SA(1, 0), a3, voffA);
            PG8_BAR; PG8_WAIT_L(0); PG8_MMA(1, 0, At, B0); PG8_BAR; PG8_SCHED;
            PG8_STAGE(PG8_SB(1, 1), b3 + hstep, voffB);
            PG8_WAIT_V(6); PG8_BAR; PG8_MMA(1, 1, At, B1); PG8_BAR;
            }
        }
        if constexpr (ALIGN_EPI) { if (wr == 0) PG8_BAR; }
        if constexpr (!Epi::AFTER_DRAIN) { E(acc, cur, wr, wc, fr, fq); S.done(cur); }
        if (!has_next) break;
#pragma unroll
        for (int a = 0; a < 2; ++a)
#pragma unroll
            for (int b = 0; b < 2; ++b)
#pragma unroll
                for (int m = 0; m < 4; ++m)
#pragma unroll
                    for (int n = 0; n < 2; ++n) acc[a][b][m][n] = (f32x4){0.f, 0.f, 0.f, 0.f};
        cur = nxt; cA = nA; cB = nB; ++ui;
        if constexpr (ALIGN_EPI) { if (wr == 1) PG8_BAR; }
    }
    PG8_WAIT_V(0);
    if constexpr (!ALIGN_EPI) { if (wr == 0) PG8_BAR; }
    PG8_BAR;
    if constexpr (Epi::AFTER_DRAIN) { E.fused(acc, cur, wr, wc, fr, fq, lds, wid, lane); S.done(cur); }
#undef PG8_SA
#undef PG8_SB
#undef PG8_STAGE
#undef PG8_LDA
#undef PG8_LDB
#undef PG8_MMA
#undef PG8_WAIT_V
#undef PG8_WAIT_L
#undef PG8_BAR
#undef PG8_SCHED
}

__device__ __forceinline__ float sigm(float x) { return 1.0f / (1.0f + __expf(-x)); }
struct EpiGlu {
    static constexpr bool PERM = true, AFTER_DRAIN = false;
    bf16_t* O; int ldc;
    __device__ __forceinline__ void operator()(const f32x4 (&acc)[2][2][4][2], const Unit& u, int wr, int wc, int fr, int fq) const {
        const int row0 = u.pm * BM + wr * 64 + fr, col0 = u.pn * HALF + wc * 32 + 8 * fq;
#pragma unroll
        for (int ai = 0; ai < 2; ++ai)
#pragma unroll
            for (int m = 0; m < 4; ++m) {
                bf16_t* rowp = O + (size_t)(row0 + ai * HALF + m * 16) * ldc + col0;
                const f32x4 a0 = acc[ai][0][m][0], a1 = acc[ai][0][m][1], b0 = acc[ai][1][m][0], b1 = acc[ai][1][m][1];
                u32x4 w;
                w.x = cvt_pk_bf16(a0[0] * sigm(b0[0]), a0[1] * sigm(b0[1])); w.y = cvt_pk_bf16(a0[2] * sigm(b0[2]), a0[3] * sigm(b0[3]));
                w.z = cvt_pk_bf16(a1[0] * sigm(b1[0]), a1[1] * sigm(b1[1])); w.w = cvt_pk_bf16(a1[2] * sigm(b1[2]), a1[3] * sigm(b1[3]));
                *(u32x4*)rowp = w;
            }
    }
};
struct EpiResid {
    static constexpr bool PERM = false, AFTER_DRAIN = false;
    const float* X; float* O; int ldc;
    __device__ __forceinline__ void operator()(const f32x4 (&acc)[2][2][4][2], const Unit& u, int wr, int wc, int fr, int fq) const {
        const int row0 = u.pm * BM + wr * 64 + fr, col0 = u.pn * BM + wc * 32 + 4 * fq;
#pragma unroll
        for (int ai = 0; ai < 2; ++ai)
#pragma unroll
            for (int m = 0; m < 4; ++m) {
                const size_t off = (size_t)(row0 + ai * HALF + m * 16) * ldc + col0;
#pragma unroll
                for (int bj = 0; bj < 2; ++bj)
#pragma unroll
                    for (int n = 0; n < 2; ++n) *(f32x4*)(O + off + bj * HALF + n * 16) = *(const f32x4*)(X + off + bj * HALF + n * 16) + acc[ai][bj][m][n];
            }
    }
};

struct ADense { static constexpr bool GATHER = false; __device__ __forceinline__ static unsigned rowoff(const Gemm&, const Unit&, int) { return 0u; } };
struct AList { static constexpr bool GATHER = true;
    __device__ __forceinline__ static unsigned rowoff(const Gemm& g, const Unit& u, int r) { const int pos = u.p0 + r; const unsigned tok = pos < u.cnt ? (g.list[(size_t)u.eb * g.cap + pos] >> 1) : 0u; return tok * (unsigned)g.lda * 2u; } };
struct ACompress { static constexpr bool GATHER = true;
    __device__ __forceinline__ static unsigned rowoff(const Gemm&, const Unit& u, int r) { const unsigned rg = (unsigned)(u.pm * BM + r), b = rg >> 9, n = (rg >> 1) & 255u, hkv = rg & 1u;
        return (((b * 4096u + 16u * n) * 2048u) + 1024u + (unsigned)u.eb * 128u + hkv * 64u) * 2u; } };
template <class Epi, class Sched, class AMap>
__device__ __forceinline__ void gemm2(PG8_LAS unsigned char* lds, const Gemm g, const Sched& S, const Epi& E, const int tid) {
    constexpr bool GATHER = AMap::GATHER;
    int K_ = g.K; asm volatile("" : "+s"(K_));
    const int wid = __builtin_amdgcn_readfirstlane(tid >> 6), lane = tid & 63, wr = wid >> 2, wc = wid & 3, fr = lane & 15, fq = lane >> 4;
    const int K = K_, nt = K / BK, lda = g.lda;
    unsigned voffA[2], voffB[2]; int Rst[2], Cst[2];
#pragma unroll
    for (int i = 0; i < 2; ++i) { int R, C; stage_rc(tid * 16 + i * 8192, R, C); const int Rb = Epi::PERM ? ((R & ~31) + perm32(R & 31)) : R;
        voffA[i] = (unsigned)(R * lda + C) * 2u; voffB[i] = (unsigned)(Rb * K + C) * 2u; Rst[i] = R; Cst[i] = C; }
    const size_t kstep = (size_t)(BK * 2), kstepA = (size_t)g.kstepA;
    const size_t hstepA = (size_t)HALF * lda * 2, tstepA = 2 * hstepA, hstepB = (size_t)HALF * K * 2, tstepB = 2 * hstepB;
    const unsigned ldsw = (unsigned)wid * 1024u;
    const int aoff = lds_byte(wr * 64 + fr, fq * 8), boff = lds_byte(wc * 32 + fr, fq * 8);
#define PG8_SA(b, h) (((b) * 2 + (h)) * HTB)
#define PG8_SB(b, h) ((4 + (b) * 2 + (h)) * HTB)
#define PG8_STAGE(bufoff, gbase, voff) do { _Pragma("unroll") for (int _i = 0; _i < 2; ++_i) \
        __builtin_amdgcn_global_load_lds((const unsigned*)((const char*)(gbase) + (voff)[_i]), (PG8_LAS unsigned*)(lds + (bufoff) + ldsw + _i * 8192), 16, 0, 0); } while (0)
#define PG8_STAGE_A(bufoff, gbase, h) do { if constexpr (GATHER) { PG8_STAGE(bufoff, gbase, vg[h]); } else { PG8_STAGE(bufoff, (gbase) + (h) * hstepA, voffA); } } while (0)
#define PG8_GOFFS(u, dst) do { _Pragma("unroll") for (int _h = 0; _h < 2; ++_h) _Pragma("unroll") for (int _i = 0; _i < 2; ++_i) dst[_h][_i] = AMap::rowoff(g, (u), _h * HALF + Rst[_i]) + (unsigned)Cst[_i] * 2u; } while (0)
#define PG8_LDA(dst, b, h) do { _Pragma("unroll") for (int m = 0; m < 4; ++m) _Pragma("unroll") for (int k = 0; k < 2; ++k) dst[m][k] = *(const PG8_LAS bf16x8*)(lds + PG8_SA(b, h) + aoff + m * 2048 + k * 1024); } while (0)
#define PG8_LDB(dst, b, h) do { _Pragma("unroll") for (int n = 0; n < 2; ++n) _Pragma("unroll") for (int k = 0; k < 2; ++k) dst[n][k] = *(const PG8_LAS bf16x8*)(lds + PG8_SB(b, h) + boff + n * 2048 + k * 1024); } while (0)
#define PG8_MMA(ai, bj, At, Bt) do { __builtin_amdgcn_s_setprio(1); _Pragma("unroll") for (int m = 0; m < 4; ++m) _Pragma("unroll") for (int n = 0; n < 2; ++n) _Pragma("unroll") for (int k = 0; k < 2; ++k) \
        acc[ai][bj][m][n] = __builtin_amdgcn_mfma_f32_16x16x32_bf16(Bt[n][k], At[m][k], acc[ai][bj][m][n], 0, 0, 0); __builtin_amdgcn_s_setprio(0); } while (0)
#define PG8_WAIT_V(n) asm volatile("s_waitcnt vmcnt(" #n ")" ::: "memory")
#define PG8_WAIT_L(n) asm volatile("s_waitcnt lgkmcnt(" #n ")" ::: "memory")
#define PG8_BAR __builtin_amdgcn_s_barrier()
#define PG8_SCHED __builtin_amdgcn_sched_barrier(0)
    Unit cur, nxt; int ui = 0;
    if (!S.next(0, cur)) return;
    f32x4 acc[2][2][4][2];
#pragma unroll
    for (int a = 0; a < 2; ++a)
#pragma unroll
        for (int b = 0; b < 2; ++b)
#pragma unroll
            for (int m = 0; m < 4; ++m)
#pragma unroll
                for (int n = 0; n < 2; ++n) acc[a][b][m][n] = (f32x4){0.f, 0.f, 0.f, 0.f};
    bf16x8 At[4][2], B0[2][2], B1[2][2];
    unsigned vg[2][2] = {{0u, 0u}, {0u, 0u}};
    if constexpr (GATHER) PG8_GOFFS(cur, vg);
    const char* cA = (const char*)g.A + (GATHER ? (size_t)0 : (size_t)cur.pm * tstepA + (size_t)cur.eb * g.astride * 2);
    const char* cB = (const char*)g.Bt + ((size_t)cur.eb * g.bstride) * 2 + (size_t)cur.pn * tstepB;
    S.a_ready(cur);
    PG8_STAGE(PG8_SB(0, 0), cB, voffB); PG8_STAGE(PG8_SB(0, 1), cB + hstepB, voffB); PG8_STAGE_A(PG8_SA(0, 0), cA, 0); PG8_STAGE_A(PG8_SA(0, 1), cA, 1);
    if (wr == 1) PG8_BAR;
    PG8_WAIT_V(2); PG8_BAR;
    PG8_STAGE(PG8_SB(1, 0), cB + kstep, voffB); PG8_STAGE_A(PG8_SA(1, 0), cA + kstepA, 0); PG8_STAGE(PG8_SB(1, 1), cB + hstepB + kstep, voffB);
    PG8_WAIT_V(6); PG8_BAR;
    for (;;) {
        const bool has_next = S.next(ui + 1, nxt);
        const char* nA = has_next ? (const char*)g.A + (GATHER ? (size_t)0 : (size_t)nxt.pm * tstepA + (size_t)nxt.eb * g.astride * 2) : cA;
        const char* nB = has_next ? (const char*)g.Bt + ((size_t)nxt.eb * g.bstride) * 2 + (size_t)nxt.pn * tstepB : cB;
        for (int t = 0; t < nt; t += 2) {
            const bool last = (t == nt - 2);
            const char* a1 = cA + (size_t)(t + 1) * kstepA;
            const char* a2 = last ? nA : cA + (size_t)(t + 2) * kstepA; const char* b2 = last ? nB : cB + (size_t)(t + 2) * kstep;
            const char* a3 = a2 + kstepA; const char* b3 = b2 + kstep;
            unsigned vn1[2] = {vg[1][0], vg[1][1]};
            if constexpr (GATHER) { if (last && has_next) { unsigned vn[2][2]; PG8_GOFFS(nxt, vn); vg[0][0] = vn[0][0]; vg[0][1] = vn[0][1]; vn1[0] = vn[1][0]; vn1[1] = vn[1][1]; } }
            if (last && has_next) S.a_ready(nxt);
            PG8_LDB(B0, 0, 0); PG8_LDB(B1, 0, 1); PG8_SCHED; PG8_LDA(At, 0, 0); PG8_STAGE_A(PG8_SA(1, 1), a1, 1);
            PG8_WAIT_V(8); PG8_WAIT_L(0); PG8_BAR; PG8_MMA(0, 0, At, B0); PG8_MMA(0, 1, At, B1); PG8_BAR; PG8_SCHED;
            if constexpr (GATHER) { vg[1][0] = vn1[0]; vg[1][1] = vn1[1]; }
            PG8_LDA(At, 0, 1); PG8_STAGE(PG8_SB(0, 0), b2, voffB); PG8_STAGE(PG8_SB(0, 1), b2 + hstepB, voffB); PG8_STAGE_A(PG8_SA(0, 0), a2, 0);
            PG8_WAIT_V(8); PG8_WAIT_L(0); PG8_BAR; PG8_MMA(1, 0, At, B0); PG8_MMA(1, 1, At, B1); PG8_BAR; PG8_SCHED;
            PG8_LDB(B0, 1, 0); PG8_LDB(B1, 1, 1); PG8_SCHED; PG8_LDA(At, 1, 0); PG8_STAGE_A(PG8_SA(0, 1), a2, 1);
            PG8_WAIT_V(8); PG8_WAIT_L(0); PG8_BAR; PG8_MMA(0, 0, At, B0); PG8_MMA(0, 1, At, B1); PG8_BAR; PG8_SCHED;
            PG8_LDA(At, 1, 1); PG8_STAGE(PG8_SB(1, 0), b3, voffB); PG8_STAGE(PG8_SB(1, 1), b3 + hstepB, voffB); PG8_STAGE_A(PG8_SA(1, 0), a3, 0);
            PG8_WAIT_V(8); PG8_WAIT_L(0); PG8_BAR; PG8_MMA(1, 0, At, B0); PG8_MMA(1, 1, At, B1); PG8_BAR; PG8_SCHED;
        }
        if (wr == 0) PG8_BAR;
        E(acc, cur, wr, wc, fr, fq); S.done(cur);
        if (!has_next) break;
#pragma unroll
        for (int a = 0; a < 2; ++a)
#pragma unroll
            for (int b = 0; b < 2; ++b)
#pragma unroll
                for (int m = 0; m < 4; ++m)
#pragma unroll
                    for (int n = 0; n < 2; ++n) acc[a][b][m][n] = (f32x4){0.f, 0.f, 0.f, 0.f};
        cur = nxt; cA = nA; cB = nB; ++ui;
        if (wr == 1) PG8_BAR;
    }
    PG8_WAIT_V(0);
    PG8_BAR;
#undef PG8_SA
#undef PG8_SB
#undef PG8_STAGE
#undef PG8_STAGE_A
#undef PG8_GOFFS
#undef PG8_LDA
#undef PG8_LDB
#undef PG8_MMA
#undef PG8_WAIT_V
#undef PG8_WAIT_L
#undef PG8_BAR
#undef PG8_SCHED
}

struct ExpertOrder {
    const PG8_LAS int* tab; int nN, G, c;
    __device__ __forceinline__ bool next(int i, Unit& u) const {
        int rt, pn, e;
        if ((G & 7) == 0) {
            const int x = c & 7, R = G >> 3, Lx = i * R + (c >> 3);
            const int n0 = (tab[x + 1] - tab[x]) * nN, n1 = (tab[x + 9] - tab[x + 8]) * nN, n2 = (tab[x + 17] - tab[x + 16]) * nN, n3 = (tab[x + 25] - tab[x + 24]) * nN;
            const int c1 = n0, c2 = n0 + n1, c3 = c2 + n2, c4 = c3 + n3;
            if (Lx >= c4) return false;
            const int k = (Lx >= c1 ? 1 : 0) + (Lx >= c2 ? 1 : 0) + (Lx >= c3 ? 1 : 0), ul = Lx - (k == 0 ? 0 : (k == 1 ? c1 : (k == 2 ? c2 : c3)));
            e = x + 8 * k; rt = tab[e] + ul / nN; pn = ul % nN;
        } else {
            const int total = tab[32] * nN; const long L = (long)i * G + c; if (L >= total) return false;
            rt = (int)L / nN; pn = (int)L % nN; e = 0;
#pragma unroll
            for (int k = 1; k < 32; ++k) e += (rt >= tab[k]) ? 1 : 0;
        }
        u.pm = __builtin_amdgcn_readfirstlane(rt); u.pn = __builtin_amdgcn_readfirstlane(pn); u.eb = __builtin_amdgcn_readfirstlane(e);
        u.p0 = __builtin_amdgcn_readfirstlane((rt - tab[e]) * BM); u.cnt = __builtin_amdgcn_readfirstlane(tab[33 + e]); return true;
    }
    __device__ __forceinline__ void a_ready(const Unit&) const {}
    __device__ __forceinline__ void done(const Unit&) const {}
};
struct EpiGateUp {
    static constexpr bool PERM = true, AFTER_DRAIN = false;
    bf16_t* H; const float* listw; int cap;
    __device__ __forceinline__ void operator()(const f32x4 (&acc)[2][2][4][2], const Unit& u, int wr, int wc, int fr, int fq) const {
        const int rl0 = wr * 64 + fr, col0 = u.pn * HALF + wc * 32 + 8 * fq;
#pragma unroll
        for (int ai = 0; ai < 2; ++ai)
#pragma unroll
            for (int m = 0; m < 4; ++m) {
                const int rl = rl0 + ai * HALF + m * 16, pos = u.p0 + rl;
                const float w = pos < u.cnt ? listw[(size_t)u.eb * cap + pos] : 0.f;
                bf16_t* rowp = H + (size_t)(u.pm * BM + rl) * 256 + col0;
                const f32x4 g0 = acc[ai][0][m][0], g1 = acc[ai][0][m][1], u0 = acc[ai][1][m][0], u1 = acc[ai][1][m][1];
                u32x4 o;
                o.x = cvt_pk_bf16(g0[0] * sigm(g0[0]) * u0[0] * w, g0[1] * sigm(g0[1]) * u0[1] * w); o.y = cvt_pk_bf16(g0[2] * sigm(g0[2]) * u0[2] * w, g0[3] * sigm(g0[3]) * u0[3] * w);
                o.z = cvt_pk_bf16(g1[0] * sigm(g1[0]) * u1[0] * w, g1[1] * sigm(g1[1]) * u1[1] * w); o.w = cvt_pk_bf16(g1[2] * sigm(g1[2]) * u1[2] * w, g1[3] * sigm(g1[3]) * u1[3] * w);
                *(u32x4*)rowp = o;
            }
    }
};
struct EpiDown {
    static constexpr bool PERM = true, AFTER_DRAIN = false;
    bf16_t* P1; long d12; const unsigned* list; int cap;
    __device__ __forceinline__ void operator()(const f32x4 (&acc)[2][2][4][2], const Unit& u, int wr, int wc, int fr, int fq) const {
        const int rl0 = wr * 64 + fr, col0 = u.pn * BM + wc * 32 + 8 * fq;
#pragma unroll
        for (int ai = 0; ai < 2; ++ai) {
            unsigned ent[4];
#pragma unroll
            for (int m = 0; m < 4; ++m) { const int pos = u.p0 + rl0 + ai * HALF + m * 16; ent[m] = pos < u.cnt ? list[(size_t)u.eb * cap + pos] : 0xffffffffu; }
#pragma unroll
            for (int m = 0; m < 4; ++m) {
                if (ent[m] != 0xffffffffu) {
                    bf16_t* dst = P1 + (long)(ent[m] & 1u) * d12 + (size_t)(ent[m] >> 1) * 1024 + col0;
#pragma unroll
                    for (int bj = 0; bj < 2; ++bj) { const f32x4 v0 = acc[ai][bj][m][0], v1 = acc[ai][bj][m][1];
                        u32x4 w; w.x = cvt_pk_bf16(v0[0], v0[1]); w.y = cvt_pk_bf16(v0[2], v0[3]); w.z = cvt_pk_bf16(v1[0], v1[1]); w.w = cvt_pk_bf16(v1[2], v1[3]);
                        *(u32x4*)(dst + bj * HALF) = w; }
                }
            }
            asm volatile("" ::: "memory");
        }
    }
};

struct BatchOrder {
    int nb, nM, nN, G, c;
    __device__ __forceinline__ bool next(int i, Unit& u) const {
        const long L = (long)i * G + c; if (L >= (long)nb * nM * nN) return false;
        const int per = nM * nN, e = (int)L / per, rem = (int)L % per;
        u.eb = e; u.pm = rem / nN; u.pn = rem % nN; u.p0 = 0; u.cnt = 0; return true;
    }
    __device__ __forceinline__ void a_ready(const Unit&) const {}
    __device__ __forceinline__ void done(const Unit&) const {}
};
struct EpiInProj {
    static constexpr bool PERM = true, AFTER_DRAIN = false;
    bf16_t* Zo; bf16_t* U;
    __device__ __forceinline__ void operator()(const f32x4 (&acc)[2][2][4][2], const Unit& u, int wr, int wc, int fr, int fq) const {
        const int row0 = u.pm * BM + wr * 64 + fr;
#pragma unroll
        for (int ai = 0; ai < 2; ++ai)
#pragma unroll
            for (int m = 0; m < 4; ++m) { const int row = row0 + ai * HALF + m * 16;
#pragma unroll
                for (int bj = 0; bj < 2; ++bj) { const int c0 = u.pn * BM + bj * HALF + wc * 32 + 8 * fq;
                    const f32x4 v0 = acc[ai][bj][m][0], v1 = acc[ai][bj][m][1];
                    u32x4 w; w.x = cvt_pk_bf16(v0[0], v0[1]); w.y = cvt_pk_bf16(v0[2], v0[3]); w.z = cvt_pk_bf16(v1[0], v1[1]); w.w = cvt_pk_bf16(v1[2], v1[3]);
                    bf16_t* dst = u.pn < 2 ? U + ((size_t)((c0 >> 4) * 2048 + (row >> 4)) * 512 + (row & 15) * 16 + (c0 & 15)) : Zo + (size_t)row * 2048 + c0;
                    *(u32x4*)dst = w; } }
    }
};
struct EpiXloc {
    static constexpr bool PERM = false, AFTER_DRAIN = false;
    float* XL;
    __device__ __forceinline__ void operator()(const f32x4 (&acc)[2][2][4][2], const Unit& u, int wr, int wc, int fr, int fq) const {
        const int row0 = u.pm * BM + wr * 64 + fr, col0 = wc * 32 + 4 * fq;
#pragma unroll
        for (int ai = 0; ai < 2; ++ai)
#pragma unroll
            for (int m = 0; m < 4; ++m) { float* rowp = XL + ((size_t)u.eb * 2048 + row0 + ai * HALF + m * 16) * 128 + col0;
#pragma unroll
                for (int n = 0; n < 2; ++n) *(f32x4*)(rowp + n * 16) = acc[ai][0][m][n]; }
    }
};
__device__ __forceinline__ float gelu_t(float x) { const float u2 = -2.302208198f * (x + 0.044715f * x * x * x); return x * __builtin_amdgcn_rcpf(1.0f + __builtin_amdgcn_exp2f(u2)); }
struct EpiSsmOut {
    static constexpr bool PERM = true, AFTER_DRAIN = false;
    bf16_t* G;
    __device__ __forceinline__ void operator()(const f32x4 (&acc)[2][2][4][2], const Unit& u, int wr, int wc, int fr, int fq) const {
        const int row0 = u.pm * BM + wr * 64 + fr;
#pragma unroll
        for (int ai = 0; ai < 2; ++ai)
#pragma unroll
            for (int m = 0; m < 4; ++m) { const int row = row0 + ai * HALF + m * 16;
#pragma unroll
                for (int bj = 0; bj < 2; ++bj) { const int n0 = bj * HALF + wc * 32 + 8 * fq;
                    const f32x4 v0 = acc[ai][bj][m][0], v1 = acc[ai][bj][m][1];
                    u32x4 w; w.x = cvt_pk_bf16(gelu_t(v0[0]), gelu_t(v0[1])); w.y = cvt_pk_bf16(gelu_t(v0[2]), gelu_t(v0[3])); w.z = cvt_pk_bf16(gelu_t(v1[0]), gelu_t(v1[1])); w.w = cvt_pk_bf16(gelu_t(v1[2]), gelu_t(v1[3]));
                    *(u32x4*)(G + ((size_t)row * 16 + (n0 >> 4)) * 512 + u.eb * 16 + (n0 & 15)) = w; } }
    }
};

struct CmpOrder {
    int G, c;
    __device__ __forceinline__ bool next(int i, Unit& u) const { const int L = i * G + c; if (L >= 32) return false; u.eb = L >> 4; u.pm = L & 15; u.pn = 0; u.p0 = 0; u.cnt = 0; return true; }
    __device__ __forceinline__ void a_ready(const Unit&) const {}
    __device__ __forceinline__ void done(const Unit&) const {}
};
struct EpiCmpHid {
    static constexpr bool PERM = false, AFTER_DRAIN = false;
    bf16_t* HC; const float* bias;
    __device__ __forceinline__ void operator()(const f32x4 (&acc)[2][2][4][2], const Unit& u, int wr, int wc, int fr, int fq) const {
        if (wc < 2) {
            const int row0 = u.pm * BM + wr * 64 + fr, col0 = wc * 32 + 4 * fq;
#pragma unroll
            for (int n = 0; n < 2; ++n) { const f32x4 bv = *(const f32x4*)(bias + u.eb * 64 + col0 + n * 16);
#pragma unroll
                for (int ai = 0; ai < 2; ++ai)
#pragma unroll
                    for (int m = 0; m < 4; ++m) { const f32x4 v = acc[ai][0][m][n] + bv;
                        typedef unsigned u32x2_ __attribute__((ext_vector_type(2)));
                        u32x2_ w; w.x = cvt_pk_bf16(gelu_t(v[0]), gelu_t(v[1])); w.y = cvt_pk_bf16(gelu_t(v[2]), gelu_t(v[3]));
                        *(u32x2_*)(HC + ((size_t)u.eb * 4096 + row0 + ai * HALF + m * 16) * 64 + col0 + n * 16) = w; } }
        }
    }
};

struct SingleUnit {
    int eb, pm;
    __device__ __forceinline__ bool next(int i, Unit& u) const { if (i > 0) return false; u.eb = eb; u.pm = pm; u.pn = 0; u.p0 = 0; u.cnt = 0; return true; }
    __device__ __forceinline__ void a_ready(const Unit&) const {}
    __device__ __forceinline__ void done(const Unit&) const {}
};
}

struct Args { const float* in[26]; float* out; unsigned char* ws; int ph_lo, ph_hi; };

struct Frame {
    LAS unsigned char* lds;
    int tid, lane, wave, blk, G;
};

__device__ __forceinline__ f32x4 bf4(u32x2 p) { f32x4 r; r.x = __uint_as_float(p.x << 16); r.y = __uint_as_float(p.x & 0xffff0000u); r.z = __uint_as_float(p.y << 16); r.w = __uint_as_float(p.y & 0xffff0000u); return r; }
__device__ __forceinline__ void ph_norm(const Frame& F, const float* xin, const bf16* add, const bf16* add2, float* xout, const float* g, bf16* hn) {
    const int gw = F.blk * NWAVES + F.wave, NGW = F.G * NWAVES;
    f32x4 gg[4];
#pragma unroll
    for (int j = 0; j < 4; ++j) gg[j] = ((const f32x4*)g)[F.lane + 64 * j];
    f32x4 nv[4]; u32x2 na[4], nb[4];
    if (gw < T) {
#pragma unroll
        for (int j = 0; j < 4; ++j) { nv[j] = ((const f32x4*)(xin + (size_t)gw * DM))[F.lane + 64 * j];
            if (add) { na[j] = ((const u32x2*)(add + (size_t)gw * DM))[F.lane + 64 * j]; nb[j] = ((const u32x2*)(add2 + (size_t)gw * DM))[F.lane + 64 * j]; } }
    }
    for (int row = gw; row < T; row += NGW) {
        f32x4 v[4]; float s = 0.f;
#pragma unroll
        for (int j = 0; j < 4; ++j) { v[j] = nv[j]; if (add) v[j] += bf4(na[j]) + bf4(nb[j]); }
        const int nrow = row + NGW;
        if (nrow < T) {
#pragma unroll
            for (int j = 0; j < 4; ++j) { nv[j] = ((const f32x4*)(xin + (size_t)nrow * DM))[F.lane + 64 * j];
                if (add) { na[j] = ((const u32x2*)(add + (size_t)nrow * DM))[F.lane + 64 * j]; nb[j] = ((const u32x2*)(add2 + (size_t)nrow * DM))[F.lane + 64 * j]; } }
        }
#pragma unroll
        for (int j = 0; j < 4; ++j) { if (add) ((f32x4*)(xout + (size_t)row * DM))[F.lane + 64 * j] = v[j];
            s += v[j].x * v[j].x + v[j].y * v[j].y + v[j].z * v[j].z + v[j].w * v[j].w; }
        s = wave_sum(s, F.lane);
        const float r = rsqrtf(s * (1.0f / DM) + EPS);
#pragma unroll
        for (int j = 0; j < 4; ++j) {
            u32x2 o; o.x = pk2(v[j].x * r * gg[j].x, v[j].y * r * gg[j].y); o.y = pk2(v[j].z * r * gg[j].z, v[j].w * r * gg[j].w);
            *(u32x2*)(hn + (size_t)row * DM + (F.lane + 64 * j) * 4) = o;
        }
    }
}
__device__ __forceinline__ void ph_final_norm(const Frame& F, float* x, const bf16* add, const bf16* add2, const float* g) {
    const int gw = F.blk * NWAVES + F.wave, NGW = F.G * NWAVES;
    f32x4 gg[4];
#pragma unroll
    for (int j = 0; j < 4; ++j) gg[j] = ((const f32x4*)g)[F.lane + 64 * j];
    f32x4 nv[4]; u32x2 na[4], nb[4];
    if (gw < T) {
#pragma unroll
        for (int j = 0; j < 4; ++j) { nv[j] = ((const f32x4*)(x + (size_t)gw * DM))[F.lane + 64 * j]; na[j] = ((const u32x2*)(add + (size_t)gw * DM))[F.lane + 64 * j]; nb[j] = ((const u32x2*)(add2 + (size_t)gw * DM))[F.lane + 64 * j]; }
    }
    for (int row = gw; row < T; row += NGW) {
        f32x4 v[4]; float s = 0.f;
#pragma unroll
        for (int j = 0; j < 4; ++j) { v[j] = nv[j] + bf4(na[j]) + bf4(nb[j]); s += v[j].x * v[j].x + v[j].y * v[j].y + v[j].z * v[j].z + v[j].w * v[j].w; }
        const int nrow = row + NGW;
        if (nrow < T) {
#pragma unroll
            for (int j = 0; j < 4; ++j) { nv[j] = ((const f32x4*)(x + (size_t)nrow * DM))[F.lane + 64 * j]; na[j] = ((const u32x2*)(add + (size_t)nrow * DM))[F.lane + 64 * j]; nb[j] = ((const u32x2*)(add2 + (size_t)nrow * DM))[F.lane + 64 * j]; }
        }
        s = wave_sum(s, F.lane);
        const float r = rsqrtf(s * (1.0f / DM) + EPS);
#pragma unroll
        for (int j = 0; j < 4; ++j) {
            f32x4 o; o.x = v[j].x * r * gg[j].x; o.y = v[j].y * r * gg[j].y; o.z = v[j].z * r * gg[j].z; o.w = v[j].w * r * gg[j].w;
            ((f32x4*)(x + (size_t)row * DM))[F.lane + 64 * j] = o;
        }
    }
}

template <bool DUAL, class Epi>
__device__ __forceinline__ void sgemm_naive(const Frame& F, const bf16* A, int lda, const float* B, int ldb, int M, int N, int K, int dualoff, const Epi& epi) {
    LAS float* As = (LAS float*)F.lds;
    LAS float* Bs = As + 16 * 132;
    LAS float* Bs2 = Bs + 16 * 128;
    const int tiles_n = (N + 127) / 128, tiles_m = M / 128;
    const int tx = F.tid & 31, ty = F.tid >> 5;
    for (int tile = F.blk; tile < tiles_m * tiles_n; tile += F.G) {
        const int tm = tile / tiles_n, tn = tile % tiles_n;
        float acc[8][4], acc2[8][4];
#pragma unroll
        for (int i = 0; i < 8; ++i)
#pragma unroll
            for (int j = 0; j < 4; ++j) { acc[i][j] = 0.f; acc2[i][j] = 0.f; }
        const int arow = F.tid >> 2, akq = (F.tid & 3) * 4;
        const int bk = F.tid >> 5, bn = (F.tid & 31) * 4;
        for (int k0 = 0; k0 < K; k0 += 16) {
            {
                const u32x2 av = *(const u32x2*)(A + (size_t)(tm * 128 + arow) * lda + k0 + akq);
                As[(akq + 0) * 132 + arow] = __uint_as_float(av.x << 16);
                As[(akq + 1) * 132 + arow] = __uint_as_float(av.x & 0xffff0000u);
                As[(akq + 2) * 132 + arow] = __uint_as_float(av.y << 16);
                As[(akq + 3) * 132 + arow] = __uint_as_float(av.y & 0xffff0000u);
                const int col = tn * 128 + bn;
                f32x4 bv = (f32x4){0.f, 0.f, 0.f, 0.f};
                const float* bp = B + (size_t)(k0 + bk) * ldb + col;
                if (col + 3 < N) { bv.x = bp[0]; bv.y = bp[1]; bv.z = bp[2]; bv.w = bp[3]; }
                else { if (col < N) bv.x = bp[0]; if (col + 1 < N) bv.y = bp[1]; if (col + 2 < N) bv.z = bp[2]; }
                *(LAS f32x4*)(Bs + bk * 128 + bn) = bv;
                if (DUAL) {
                    const float* bp2 = bp + dualoff;
                    f32x4 bw; bw.x = bp2[0]; bw.y = bp2[1]; bw.z = bp2[2]; bw.w = bp2[3];
                    *(LAS f32x4*)(Bs2 + bk * 128 + bn) = bw;
                }
            }
            __syncthreads();
#pragma unroll 4
            for (int k = 0; k < 16; ++k) {
                float a[8];
                const f32x4 a0 = *(const LAS f32x4*)(As + k * 132 + ty * 8), a1 = *(const LAS f32x4*)(As + k * 132 + ty * 8 + 4);
                a[0] = a0.x; a[1] = a0.y; a[2] = a0.z; a[3] = a0.w; a[4] = a1.x; a[5] = a1.y; a[6] = a1.z; a[7] = a1.w;
                const f32x4 b = *(const LAS f32x4*)(Bs + k * 128 + tx * 4);
#pragma unroll
                for (int i = 0; i < 8; ++i) { acc[i][0] += a[i] * b.x; acc[i][1] += a[i] * b.y; acc[i][2] += a[i] * b.z; acc[i][3] += a[i] * b.w; }
                if (DUAL) {
                    const f32x4 b2 = *(const LAS f32x4*)(Bs2 + k * 128 + tx * 4);
#pragma unroll
                    for (int i = 0; i < 8; ++i) { acc2[i][0] += a[i] * b2.x; acc2[i][1] += a[i] * b2.y; acc2[i][2] += a[i] * b2.z; acc2[i][3] += a[i] * b2.w; }
                }
            }
            __syncthreads();
        }
#pragma unroll
        for (int i = 0; i < 8; ++i)
#pragma unroll
            for (int j = 0; j < 4; ++j) {
                const int row = tm * 128 + ty * 8 + i, col = tn * 128 + tx * 4 + j;
                if (col < N) epi(row, col, acc[i][j], acc2[i][j]);
            }
    }
}
struct EpiStoreBf16 { bf16* O; int ldo; __device__ __forceinline__ void operator()(int r, int c, float a, float) const { O[(size_t)r * ldo + c] = (bf16)f2bf(a); } };
struct EpiGlu { bf16* O; int ldo; __device__ __forceinline__ void operator()(int r, int c, float a, float b) const { O[(size_t)r * ldo + c] = (bf16)f2bf(a * sigmoidf_(b)); } };
struct EpiResid { const float* X; float* O; __device__ __forceinline__ void operator()(int r, int c, float a, float) const { O[(size_t)r * DM + c] = X[(size_t)r * DM + c] + a; } };

__device__ __forceinline__ void ssm_naive_item(int b, int g, const float* a_re, const float* a_im, const float* b_re, const float* b_im, const float* c_re, const float* c_im,
                                               const float* dpar, const float* log_dt, const bf16* Z, bf16* G1, int lane) {
    const int p = lane;
    const float are = a_re[g * 64 + p], aim = a_im[g * 64 + p], dt = expf(log_dt[g]);
    const float er = expf(are * dt), lbr = er * cosf(aim * dt), lbi = er * sinf(aim * dt);
    const float xx = lbr - 1.0f, yy = lbi, den = are * are + aim * aim;
    const float fr = (xx * are + yy * aim) / den, fi = (yy * are - xx * aim) / den;
    float bbr[16], bbi[16], cr[16], ci[16];
#pragma unroll
    for (int h = 0; h < 16; ++h) {
        const float br = b_re[(g * 64 + p) * 16 + h], bi = b_im[(g * 64 + p) * 16 + h];
        bbr[h] = fr * br - fi * bi; bbi[h] = fr * bi + fi * br;
        cr[h] = c_re[(g * 16 + h) * 64 + p]; ci[h] = c_im[(g * 16 + h) * 64 + p];
    }
    const float dd = dpar[g * 16 + (lane & 15)];
    float xr = 0.f, xi = 0.f;
    for (int t = 0; t < SEQ; ++t) {
        const size_t row = (size_t)b * SEQ + t;
        const u32x4 u0 = *(const u32x4*)(Z + row * ZP + ZC_U + g * 16), u1 = *(const u32x4*)(Z + row * ZP + ZC_U + g * 16 + 8);
        float u[16];
        u[0] = __uint_as_float(u0.x << 16); u[1] = __uint_as_float(u0.x & 0xffff0000u); u[2] = __uint_as_float(u0.y << 16); u[3] = __uint_as_float(u0.y & 0xffff0000u);
        u[4] = __uint_as_float(u0.z << 16); u[5] = __uint_as_float(u0.z & 0xffff0000u); u[6] = __uint_as_float(u0.w << 16); u[7] = __uint_as_float(u0.w & 0xffff0000u);
        u[8] = __uint_as_float(u1.x << 16); u[9] = __uint_as_float(u1.x & 0xffff0000u); u[10] = __uint_as_float(u1.y << 16); u[11] = __uint_as_float(u1.y & 0xffff0000u);
        u[12] = __uint_as_float(u1.z << 16); u[13] = __uint_as_float(u1.z & 0xffff0000u); u[14] = __uint_as_float(u1.w << 16); u[15] = __uint_as_float(u1.w & 0xffff0000u);
        float bur = 0.f, bui = 0.f;
#pragma unroll
        for (int h = 0; h < 16; ++h) { bur += bbr[h] * u[h]; bui += bbi[h] * u[h]; }
        const float nxr = lbr * xr - lbi * xi + bur, nxi = lbr * xi + lbi * xr + bui;
        xr = nxr; xi = nxi;
        float y = 0.f;
#pragma unroll
        for (int h = 0; h < 16; ++h) { const float v = wave_sum(cr[h] * xr - ci[h] * xi, lane); if (lane == h) y = v; }
        if (lane < 16) {
            const float ul = bf2f(Z[row * ZP + ZC_U + g * 16 + lane]);
            G1[row * D_SSM + g * 16 + lane] = (bf16)f2bf(gelu_tanh(y + dd * ul));
        }
    }
}
__device__ __forceinline__ void compress_naive_item(int item, const bf16* Z, const float* pos, const float* w1, const float* w2, bf16* KC, bf16* VC, int lane) {
    const int i = item & 1, hkv = (item >> 1) & 1, n = (item >> 2) % NCMPP, b = (item >> 2) / NCMPP;
    bf16* dst = i ? VC : KC;
    if (n == NCMP) { dst[(((size_t)b * NCMPP + n) * 2 + hkv) * 64 + lane] = 0; return; }
    const float* posi = pos + i * 32 * 64; const float* w1i = w1 + (size_t)i * 32 * 64 * 64; const float* w2i = w2 + i * 64 * 64;
    float acc = 0.f;
    for (int l = 0; l < 32; ++l) {
        const bf16* zr = Z + ((size_t)b * SEQ + 16 * n + l) * ZP + ZC_KV + i * 128 + hkv * 64;
        for (int d = 0; d < 64; ++d) acc += (bf2f(zr[d]) + posi[l * 64 + d]) * w1i[(l * 64 + d) * 64 + lane];
    }
    const float hid = gelu_tanh(acc);
    float o = 0.f;
    for (int e = 0; e < 64; ++e) o += lane_bcast(hid, e) * w2i[e * 64 + lane];
    dst[(((size_t)b * NCMPP + n) * 2 + hkv) * 64 + lane] = (bf16)f2bf(o);
}

__device__ __forceinline__ void attn_chunk(LAS float* wl, const bf16* Z, const float* rel_bias, int b, int hkv, int t, int base, int kcol, int vcol, int lane,
                                           float (&m)[4], float (&l)[4], float (&o)[4]) {
    const int pos = base + lane; const bool valid = (pos >= 0) && (pos <= t);
    const int posc = pos < 0 ? 0 : (pos > SEQ - 1 ? SEQ - 1 : pos);
    const bf16* kr = Z + ((size_t)b * SEQ + posc) * ZP + kcol + hkv * 64;
    float s[4] = {0.f, 0.f, 0.f, 0.f};
#pragma unroll 2
    for (int c = 0; c < 8; ++c) {
        const u32x4 kv = *(const u32x4*)(kr + c * 8);
        float k[8];
        k[0] = __uint_as_float(kv.x << 16); k[1] = __uint_as_float(kv.x & 0xffff0000u); k[2] = __uint_as_float(kv.y << 16); k[3] = __uint_as_float(kv.y & 0xffff0000u);
        k[4] = __uint_as_float(kv.z << 16); k[5] = __uint_as_float(kv.z & 0xffff0000u); k[6] = __uint_as_float(kv.w << 16); k[7] = __uint_as_float(kv.w & 0xffff0000u);
#pragma unroll
        for (int g = 0; g < 4; ++g) {
            const f32x4 q0 = *(const LAS f32x4*)(wl + g * 64 + c * 8), q1 = *(const LAS f32x4*)(wl + g * 64 + c * 8 + 4);
            s[g] += q0.x * k[0] + q0.y * k[1] + q0.z * k[2] + q0.w * k[3] + q1.x * k[4] + q1.y * k[5] + q1.z * k[6] + q1.w * k[7];
        }
    }
    const int bk = t5_bucket(t - pos);
#pragma unroll
    for (int g = 0; g < 4; ++g) {
        const float sv = valid ? s[g] + rel_bias[bk * 8 + hkv * 4 + g] : -1e30f;
        const float mn = fmaxf(m[g], wave_max(sv, lane));
        const float alpha = __expf(m[g] - mn);
        const float p = valid ? __expf(sv - mn) : 0.f;
        l[g] = l[g] * alpha + wave_sum(p, lane);
        o[g] *= alpha; m[g] = mn;
        wl[256 + g * 64 + lane] = p;
    }
#pragma unroll 4
    for (int key = 0; key < 64; ++key) {
        int pk = base + key; pk = pk < 0 ? 0 : (pk > SEQ - 1 ? SEQ - 1 : pk);
        const float v = bf2f(Z[((size_t)b * SEQ + pk) * ZP + vcol + hkv * 64 + lane]);
#pragma unroll
        for (int g = 0; g < 4; ++g) o[g] += wl[256 + g * 64 + key] * v;
    }
}
__device__ __forceinline__ void attn_naive_item(LAS float* wl, int b, int hkv, int t, const bf16* Z, const float* KC, const float* VC, const float* rel_bias, bf16* YC, int lane) {
    const size_t row = (size_t)b * SEQ + t;
#pragma unroll
    for (int g = 0; g < 4; ++g) wl[g * 64 + lane] = bf2f(Z[row * ZP + ZC_Q + hkv * 256 + g * 64 + lane]) * 0.125f;
#pragma unroll 1
    for (int c = 0; c < 4; ++c) {
        const int n = c * 64 + lane; const bool valid = (n < NCMP) && (16 * n + 31 <= t);
        const float* kr = KC + (((size_t)b * NCMPP + (n < NCMP ? n : 0)) * 2 + hkv) * 64;
        float s[4] = {0.f, 0.f, 0.f, 0.f};
#pragma unroll 4
        for (int d4 = 0; d4 < 16; ++d4) {
            const f32x4 k = *(const f32x4*)(kr + d4 * 4);
#pragma unroll
            for (int g = 0; g < 4; ++g) { const f32x4 q = *(const LAS f32x4*)(wl + g * 64 + d4 * 4); s[g] += q.x * k.x + q.y * k.y + q.z * k.z + q.w * k.w; }
        }
        const int bk = t5_bucket(t - (16 * n + 31));
#pragma unroll
        for (int g = 0; g < 4; ++g) wl[256 + g * 256 + n] = valid ? s[g] + rel_bias[bk * 8 + hkv * 4 + g] : -1e30f;
    }
#pragma unroll
    for (int g = 0; g < 4; ++g) {
        float sc[4];
#pragma unroll
        for (int c = 0; c < 4; ++c) sc[c] = wl[256 + g * 256 + c * 64 + lane];
        const float mx = wave_max(fmaxf(fmaxf(sc[0], sc[1]), fmaxf(sc[2], sc[3])), lane);
        float e[4], ls = 0.f;
#pragma unroll
        for (int c = 0; c < 4; ++c) { e[c] = sc[c] > -1e29f ? __expf(sc[c] - mx) : 0.f; ls += e[c]; }
        ls = wave_sum(ls, lane);
        const float inv = ls > 0.f ? 1.0f / ls : 0.f;
#pragma unroll
        for (int c = 0; c < 4; ++c) wl[256 + g * 256 + c * 64 + lane] = e[c] * inv;
    }
    float oc[4] = {0.f, 0.f, 0.f, 0.f};
    const int nmax = t >= 31 ? ((t - 31) / 16 + 1 < NCMP ? (t - 31) / 16 + 1 : NCMP) : 0;
#pragma unroll 4
    for (int n = 0; n < nmax; ++n) {
        const float v = VC[(((size_t)b * NCMPP + n) * 2 + hkv) * 64 + lane];
#pragma unroll
        for (int g = 0; g < 4; ++g) oc[g] += wl[256 + g * 256 + n] * v;
    }
    float imp = 0.f;
#pragma unroll
    for (int g = 0; g < 4; ++g) {
        const LAS float* P = wl + 256 + g * 256;
        imp += P[4 * lane] + P[4 * lane + 1] + P[4 * lane + 2] + 0.5f * P[4 * lane + 3] + (lane > 0 ? 0.5f * P[4 * lane - 1] : 0.f);
    }
    const int blk = t >> 6;
    const bool forced = (lane == 0) || (lane <= blk && lane > blk - 2), future = lane > blk;
    const float v = forced ? 1e9f : (future ? -1e9f : imp);
    int rank = 0;
    for (int jj = 0; jj < 64; ++jj) { const float vj = lane_bcast(v, jj); rank += (vj > v) || (vj == v && jj < lane); }
    unsigned long long mask = __ballot(rank < 16 && !future);
    float m[4], l[4], o[4];
#pragma unroll
    for (int g = 0; g < 4; ++g) { m[g] = -1e30f; l[g] = 0.f; o[g] = 0.f; }
    while (mask) {
        const int j = __builtin_ctzll(mask); mask &= mask - 1;
        attn_chunk(wl, Z, rel_bias, b, hkv, t, 64 * j, ZC_KV + 256, ZC_KV + 384, lane, m, l, o);
    }
    float os[4];
#pragma unroll
    for (int g = 0; g < 4; ++g) { os[g] = l[g] > 0.f ? o[g] / l[g] : 0.f; m[g] = -1e30f; l[g] = 0.f; o[g] = 0.f; }
    for (int c = 0; c < 8; ++c) attn_chunk(wl, Z, rel_bias, b, hkv, t, t - 511 + 64 * c, ZC_KV + 512, ZC_KV + 640, lane, m, l, o);
#pragma unroll
    for (int g = 0; g < 4; ++g) {
        const float ow = l[g] > 0.f ? o[g] / l[g] : 0.f;
        const bf16* gp = Z + row * ZP + ZC_G + hkv * 12 + g * 3;
        const float r = sigmoidf_(bf2f(gp[0])) * oc[g] + sigmoidf_(bf2f(gp[1])) * os[g] + sigmoidf_(bf2f(gp[2])) * ow;
        YC[row * DM + D_SSM + hkv * 256 + g * 64 + lane] = (bf16)f2bf(r);
    }
}

__device__ __forceinline__ void ph_norm_route(const Frame& F, const float* x, const float* g, const float* rgw, const float* rgb, const float* rew, const float* reb, bf16* hn,
                                              unsigned* gcnt, unsigned* list, float* listw) {
    LAS f32x4* RG = (LAS f32x4*)F.lds; LAS f32x4* RE = RG + 1024;
    LAS unsigned* cnt_l = (LAS unsigned*)(F.lds + 147456); LAS unsigned* base_l = cnt_l + 32; LAS unsigned* ent = cnt_l + 64;
    for (int d = F.tid; d < 1024; d += NTHR) { const int ln = d & 63, jc = d >> 6, row = (ln + 64 * (jc >> 2)) * 4 + (jc & 3); RG[d] = ((const f32x4*)rgw)[row]; }
    { f32x4 t[16];
#pragma unroll
      for (int k = 0; k < 16; ++k) { const int d = F.tid + k * NTHR, ln = d & 63, q = d >> 6, half = q & 1, c = (q >> 1) & 3, j = (q >> 3) & 3, gi = q >> 5, row = (ln + 64 * j) * 4 + c;
          t[k] = ((const f32x4*)rew)[((size_t)gi * DM + row) * 2 + half]; }
#pragma unroll
      for (int k = 0; k < 16; ++k) RE[F.tid + k * NTHR] = t[k]; }
    __syncthreads();
    for (int row0 = F.blk * 128; row0 < T; row0 += F.G * 128) {
        if (F.tid < 32) cnt_l[F.tid] = 0u;
        __syncthreads();
        f32x4 nv[4];
#pragma unroll
        for (int j = 0; j < 4; ++j) nv[j] = ((const f32x4*)(x + (size_t)(row0 + F.wave * 16) * DM))[F.lane + 64 * j];
        for (int kk = 0; kk < 16; ++kk) {
            const int row = row0 + F.wave * 16 + kk;
            f32x4 v[4]; float s = 0.f;
#pragma unroll
            for (int j = 0; j < 4; ++j) { v[j] = nv[j]; s += v[j].x * v[j].x + v[j].y * v[j].y + v[j].z * v[j].z + v[j].w * v[j].w; }
            if (kk < 15) {
#pragma unroll
                for (int j = 0; j < 4; ++j) nv[j] = ((const f32x4*)(x + (size_t)(row + 1) * DM))[F.lane + 64 * j]; }
            s = wave_sum(s, F.lane);
            const float r = rsqrtf(s * (1.0f / DM) + EPS);
            float lg[4] = {0.f, 0.f, 0.f, 0.f};
#pragma unroll
            for (int j = 0; j < 4; ++j) {
                const f32x4 gg = ((const f32x4*)g)[F.lane + 64 * j];
                v[j].x = v[j].x * r * gg.x; v[j].y = v[j].y * r * gg.y; v[j].z = v[j].z * r * gg.z; v[j].w = v[j].w * r * gg.w;
                u32x2 o; o.x = pk2(v[j].x, v[j].y); o.y = pk2(v[j].z, v[j].w);
                *(u32x2*)(hn + (size_t)row * DM + (F.lane + 64 * j) * 4) = o;
                const f32x4 w0 = RG[(j * 4 + 0) * 64 + F.lane], w1 = RG[(j * 4 + 1) * 64 + F.lane], w2 = RG[(j * 4 + 2) * 64 + F.lane], w3 = RG[(j * 4 + 3) * 64 + F.lane];
                lg[0] += v[j].x * w0.x + v[j].y * w1.x + v[j].z * w2.x + v[j].w * w3.x;
                lg[1] += v[j].x * w0.y + v[j].y * w1.y + v[j].z * w2.y + v[j].w * w3.y;
                lg[2] += v[j].x * w0.z + v[j].y * w1.z + v[j].z * w2.z + v[j].w * w3.z;
                lg[3] += v[j].x * w0.w + v[j].y * w1.w + v[j].z * w2.w + v[j].w * w3.w;
            }
#pragma unroll
            for (int o = 0; o < 4; ++o) lg[o] = wave_sum(lg[o], F.lane) + rgb[o];
            int gi = 0; float gm = lg[0];
#pragma unroll
            for (int o = 1; o < 4; ++o) if (lg[o] > gm) { gm = lg[o]; gi = o; }
            float gs = 0.f;
#pragma unroll
            for (int o = 0; o < 4; ++o) gs += __expf(lg[o] - gm);
            const float gval = 1.0f / gs;
            const LAS f32x4* we = RE + gi * 2048;
            float le[8] = {0.f, 0.f, 0.f, 0.f, 0.f, 0.f, 0.f, 0.f};
#pragma unroll
            for (int j = 0; j < 4; ++j) {
                const float hv[4] = {v[j].x, v[j].y, v[j].z, v[j].w};
#pragma unroll
                for (int c = 0; c < 4; ++c) {
                    const f32x4 wa = we[((j * 4 + c) * 2 + 0) * 64 + F.lane], wb = we[((j * 4 + c) * 2 + 1) * 64 + F.lane];
                    le[0] += hv[c] * wa.x; le[1] += hv[c] * wa.y; le[2] += hv[c] * wa.z; le[3] += hv[c] * wa.w;
                    le[4] += hv[c] * wb.x; le[5] += hv[c] * wb.y; le[6] += hv[c] * wb.z; le[7] += hv[c] * wb.w;
                }
            }
#pragma unroll
            for (int e = 0; e < 8; ++e) le[e] = wave_sum(le[e], F.lane) + reb[gi * 8 + e];
            int e1 = 0; float m1 = le[0];
#pragma unroll
            for (int e = 1; e < 8; ++e) if (le[e] > m1) { m1 = le[e]; e1 = e; }
            int e2 = -1; float m2 = -3.0e38f;
#pragma unroll
            for (int e = 0; e < 8; ++e) if (e != e1 && le[e] > m2) { m2 = le[e]; e2 = e; }
            const float p2 = __expf(m2 - m1), inv = 1.0f / (1.0f + p2);
            if (F.lane == 0) {
                const unsigned ea = (unsigned)(gi * 8 + e1), eb = (unsigned)(gi * 8 + e2);
                const unsigned pa = __hip_atomic_fetch_add(cnt_l + ea, 1u, __ATOMIC_RELAXED, __HIP_MEMORY_SCOPE_WORKGROUP);
                const unsigned pb = __hip_atomic_fetch_add(cnt_l + eb, 1u, __ATOMIC_RELAXED, __HIP_MEMORY_SCOPE_WORKGROUP);
                LAS unsigned* en = ent + (F.wave * 16 + kk) * 6;
                en[0] = ea; en[1] = eb; en[2] = pa; en[3] = pb; en[4] = __float_as_uint(gval * inv); en[5] = __float_as_uint(gval * p2 * inv);
            }
        }
        __syncthreads();
        if (F.tid < 32) base_l[F.tid] = __hip_atomic_fetch_add(gcnt + F.tid * 64, cnt_l[F.tid], __ATOMIC_RELAXED, __HIP_MEMORY_SCOPE_AGENT);
        __syncthreads();
        if (F.tid < 128) {
            const LAS unsigned* en = ent + F.tid * 6; const unsigned tok = (unsigned)(row0 + F.tid);
            const unsigned ia = en[0] * LCAP + base_l[en[0]] + en[2], ib = en[1] * LCAP + base_l[en[1]] + en[3];
            list[ia] = tok * 2u; listw[ia] = __uint_as_float(en[4]);
            list[ib] = tok * 2u + 1u; listw[ib] = __uint_as_float(en[5]);
        }
        __syncthreads();
    }
}
__device__ __forceinline__ void build_expert_tab(const Frame& F, const unsigned* gcnt, LAS int* tab) {
    if (F.tid < 64) {
        const int c = F.lane < 32 ? (int)__hip_atomic_load(gcnt + F.lane * 64, __ATOMIC_RELAXED, __HIP_MEMORY_SCOPE_AGENT) : 0;
        int tiles = (c + 255) >> 8, incl = tiles;
#pragma unroll
        for (int o = 1; o < 32; o <<= 1) { const int t = __builtin_amdgcn_ds_bpermute((F.lane - o) << 2, incl); if (F.lane >= o) incl += t; }
        if (F.lane < 32) { tab[F.lane + 1] = incl; tab[33 + F.lane] = c; }
        if (F.lane == 0) tab[0] = 0;
    }
    __syncthreads();
}
__device__ __forceinline__ void ph_experts_naive(const Frame& F, const bf16* hn, const unsigned* route, const float* wg, const float* wu, const float* wd, float* x) {
    LAS float* hs = (LAS float*)F.lds;
    LAS float* hd = hs + 1024;
    for (int tok = F.blk; tok < T; tok += F.G) {
        { const unsigned pv = *(const unsigned*)(hn + (size_t)tok * DM + F.tid * 2); hs[F.tid * 2] = __uint_as_float(pv << 16); hs[F.tid * 2 + 1] = __uint_as_float(pv & 0xffff0000u); }
        const u32x4 rt = *(const u32x4*)(route + (size_t)tok * 4);
        __syncthreads();
        {
            const int s = F.tid >> 8, f = F.tid & 255;
            const unsigned e = s ? rt.y : rt.x; const float w = __uint_as_float(s ? rt.w : rt.z);
            const float* pg = wg + (size_t)e * DM * 256 + f; const float* pu = wu + (size_t)e * DM * 256 + f;
            float ga = 0.f, ua = 0.f;
            for (int d = 0; d < DM; ++d) { const float hv = hs[d]; ga += hv * pg[(size_t)d * 256]; ua += hv * pu[(size_t)d * 256]; }
            hd[s * 256 + f] = ga * sigmoidf_(ga) * ua * w;
        }
        __syncthreads();
        for (int dd = F.tid; dd < DM; dd += NTHR) {
            float acc = 0.f;
            const float* p0 = wd + (size_t)rt.x * 256 * DM + dd; const float* p1 = wd + (size_t)rt.y * 256 * DM + dd;
            for (int f = 0; f < 256; ++f) acc += hd[f] * p0[(size_t)f * DM];
            for (int f = 0; f < 256; ++f) acc += hd[256 + f] * p1[(size_t)f * DM];
            x[(size_t)tok * DM + dd] += acc;
        }
        __syncthreads();
    }
}


namespace nsa {
typedef short bf16x8 __attribute__((ext_vector_type(8)));
typedef short s16x4 __attribute__((ext_vector_type(4)));
typedef float f32x16 __attribute__((ext_vector_type(16)));
typedef float f32x2_t __attribute__((ext_vector_type(2)));
typedef __bf16 bf16x2_t __attribute__((ext_vector_type(2)));
constexpr int SLOTB = 8192;
constexpr int L_K = 0, L_V = 3 * SLOTB, L_IMP = 6 * SLOTB, L_BT = L_IMP + 65536, L_WS = L_BT + 4 * 132 * 4, L_RL = L_WS + 8 * 64 * 4, L_SM = L_RL + 4 * 64 * 4, L_RT = L_SM + 64 * 8, L_END = L_RT + 4 * 320 * 4;
static_assert(L_END <= 131072, "nsa LDS map");
constexpr float LOG2E = 1.4426950408889634f;
constexpr float NEG_INF = -__builtin_inff();
#define NSA_SBAR() __builtin_amdgcn_sched_barrier(0)
__device__ __forceinline__ int crow(int r, int hi) { return (r & 3) + 8 * (r >> 2) + 4 * hi; }
__device__ __forceinline__ void glds16(const void* gsrc, unsigned lds_dst) { unsigned keep;
    asm volatile("s_mov_b32 %0, m0\n\ts_mov_b32 m0, %2\n\ts_nop 0\n\tglobal_load_lds_dwordx4 %1, off\n\ts_mov_b32 m0, %0" : "=&s"(keep) : "v"(gsrc), "s"(lds_dst) : "memory"); }
__device__ __forceinline__ unsigned cvtpk(float lo, float hi) { f32x2_t v = {lo, hi}; bf16x2_t b = __builtin_convertvector(v, bf16x2_t); return __builtin_bit_cast(unsigned, b); }
#define NSA_WAIT_BAR(N) asm volatile("s_waitcnt vmcnt(" #N ") lgkmcnt(0)\n\ts_barrier" ::: "memory")
__device__ __forceinline__ void qkt(f32x16& p0, f32x16& p1, const LAS char* kb, const bf16x8 (&qr)[4], const f32x16& cinit) {
#pragma unroll
    for (int d0 = 0; d0 < 4; ++d0) {
        const bf16x8 b0 = *(const LAS bf16x8*)(kb + d0 * 2048);
        const bf16x8 b1 = *(const LAS bf16x8*)(kb + d0 * 2048 + 512);
        if (d0 == 0) { p0 = __builtin_amdgcn_mfma_f32_32x32x16_bf16(b0, qr[0], cinit, 0, 0, 0); p1 = __builtin_amdgcn_mfma_f32_32x32x16_bf16(b1, qr[0], cinit, 0, 0, 0); }
        else { p0 = __builtin_amdgcn_mfma_f32_32x32x16_bf16(b0, qr[d0], p0, 0, 0, 0); p1 = __builtin_amdgcn_mfma_f32_32x32x16_bf16(b1, qr[d0], p1, 0, 0, 0); }
    }
}
__device__ __forceinline__ void pv(f32x16 (&o)[2], int vb, bf16x8 pa0, bf16x8 pa1, bf16x8 pa2, bf16x8 pa3) {
#pragma unroll
    for (int d0 = 0; d0 < 2; ++d0) { s16x4 lo[4], hi[4];
#pragma unroll
        for (int ks = 0; ks < 4; ++ks) {
            asm volatile("ds_read_b64_tr_b16 %0,%1 offset:%c2" : "=&v"(lo[ks]) : "v"(vb), "i"(d0 * 4096 + ks * 1024) : "memory");
            asm volatile("ds_read_b64_tr_b16 %0,%1 offset:%c2" : "=&v"(hi[ks]) : "v"(vb), "i"(d0 * 4096 + ks * 1024 + 512) : "memory"); }
        asm volatile("s_waitcnt lgkmcnt(0)" ::: "memory"); NSA_SBAR();
#define NSA_PK(k) (bf16x8){lo[k][0], lo[k][1], lo[k][2], lo[k][3], hi[k][0], hi[k][1], hi[k][2], hi[k][3]}
        o[d0] = __builtin_amdgcn_mfma_f32_32x32x16_bf16(pa0, NSA_PK(0), o[d0], 0, 0, 0);
        o[d0] = __builtin_amdgcn_mfma_f32_32x32x16_bf16(pa1, NSA_PK(1), o[d0], 0, 0, 0);
        o[d0] = __builtin_amdgcn_mfma_f32_32x32x16_bf16(pa2, NSA_PK(2), o[d0], 0, 0, 0);
        o[d0] = __builtin_amdgcn_mfma_f32_32x32x16_bf16(pa3, NSA_PK(3), o[d0], 0, 0, 0);
#undef NSA_PK
    }
}
typedef short v4i16_t __attribute__((ext_vector_type(4)));
__device__ __forceinline__ s16x4 vtr(const LAS char* p) { return __builtin_bit_cast(s16x4, __builtin_amdgcn_ds_read_tr16_b64_v4i16((LAS v4i16_t*)p)); }
__device__ __forceinline__ void pv2(f32x16 (&o)[2], const LAS char* vp, bf16x8 pa0, bf16x8 pa1, bf16x8 pa2, bf16x8 pa3) {
#pragma unroll
    for (int d0 = 0; d0 < 2; ++d0) {
        s16x4 lo[4], hi[4];
#pragma unroll
        for (int ks = 0; ks < 4; ++ks) { lo[ks] = vtr(vp + d0 * 4096 + ks * 1024); hi[ks] = vtr(vp + d0 * 4096 + ks * 1024 + 512); }
#define NSA_PK(k) (bf16x8){lo[k][0], lo[k][1], lo[k][2], lo[k][3], hi[k][0], hi[k][1], hi[k][2], hi[k][3]}
        o[d0] = __builtin_amdgcn_mfma_f32_32x32x16_bf16(pa0, NSA_PK(0), o[d0], 0, 0, 0);
        o[d0] = __builtin_amdgcn_mfma_f32_32x32x16_bf16(pa1, NSA_PK(1), o[d0], 0, 0, 0);
        o[d0] = __builtin_amdgcn_mfma_f32_32x32x16_bf16(pa2, NSA_PK(2), o[d0], 0, 0, 0);
        o[d0] = __builtin_amdgcn_mfma_f32_32x32x16_bf16(pa3, NSA_PK(3), o[d0], 0, 0, 0);
#undef NSA_PK
    }
}
__device__ __forceinline__ float other_half(float v, int hi) { auto rr = __builtin_amdgcn_permlane32_swap(__float_as_uint(v), __float_as_uint(v), false, false); return __uint_as_float(hi ? rr[0] : rr[1]); }
__device__ __forceinline__ float rowmax(const f32x16& p0, const f32x16& p1, int hi) {
    float a = fmaxf(fmaxf(p0[0], p0[1]), p1[0]), b = fmaxf(fmaxf(p0[2], p0[3]), p1[1]); a = fmaxf(fmaxf(a, p1[2]), p1[3]);
#pragma unroll
    for (int r = 4; r < 16; r += 4) { a = fmaxf(fmaxf(a, p0[r]), p0[r + 1]); b = fmaxf(fmaxf(b, p0[r + 2]), p0[r + 3]); a = fmaxf(fmaxf(a, p1[r]), p1[r + 1]); b = fmaxf(fmaxf(b, p1[r + 2]), p1[r + 3]); }
    const float m = fmaxf(a, b);
    return fmaxf(m, other_half(m, hi));
}
__device__ __forceinline__ void pack_p(const f32x16& p0, const f32x16& p1, bf16x8& a0, bf16x8& a1, bf16x8& a2, bf16x8& a3) {
    u32x4 w0, w1, w2, w3;
    w0 = (u32x4){cvtpk(p0[0], p0[1]), cvtpk(p0[2], p0[3]), cvtpk(p0[4], p0[5]), cvtpk(p0[6], p0[7])};
    w1 = (u32x4){cvtpk(p0[8], p0[9]), cvtpk(p0[10], p0[11]), cvtpk(p0[12], p0[13]), cvtpk(p0[14], p0[15])};
    w2 = (u32x4){cvtpk(p1[0], p1[1]), cvtpk(p1[2], p1[3]), cvtpk(p1[4], p1[5]), cvtpk(p1[6], p1[7])};
    w3 = (u32x4){cvtpk(p1[8], p1[9]), cvtpk(p1[10], p1[11]), cvtpk(p1[12], p1[13]), cvtpk(p1[14], p1[15])};
    a0 = __builtin_bit_cast(bf16x8, w0); a1 = __builtin_bit_cast(bf16x8, w1); a2 = __builtin_bit_cast(bf16x8, w2); a3 = __builtin_bit_cast(bf16x8, w3);
}

struct Ctx {
    LAS char* lds; unsigned lds0; int wid, lane, r32, hi, g, th, qloc;
    const LAS float* bt;
    const LAS float* rt;
    LAS float* wsf;
    const LAS float* wrow;
    int vb0;
    const LAS char* vp0;
    const LAS char* kb0;
};
__device__ __forceinline__ void dma_k(const Ctx& c, const bf16* kbase, int pitch, int slot) { glds16(kbase + (size_t)c.lane * pitch + c.wid * 8, (unsigned)__builtin_amdgcn_readfirstlane(c.lds0 + L_K + slot * SLOTB + c.wid * 1024)); }
__device__ __forceinline__ void dma_v(const Ctx& c, const bf16* vbase, int pitch, int slot) { glds16(vbase + (size_t)(16 * (c.wid & 3) + (c.lane >> 2)) * pitch + (c.wid >> 2) * 32 + (c.lane & 3) * 8, (unsigned)__builtin_amdgcn_readfirstlane(c.lds0 + L_V + slot * SLOTB + c.wid * 1024)); }

__device__ __forceinline__ void cmp_scores(const Ctx& c, int slot, const bf16x8 (&qr)[4], int t0, int kt, f32x16& p0, f32x16& p1) {
    const int dmin = t0 + 32 * c.th - 16 * (64 * kt + 63) - 31;
    const bool special = dmin < 113;
    f32x16 ci; { const float v = special ? 0.f : c.bt[128];
#pragma unroll
        for (int r = 0; r < 16; ++r) ci[r] = v; }
    qkt(p0, p1, c.kb0 + slot * SLOTB, qr, ci);
    if (special) {
        int hi64 = 64 * c.hi; asm volatile("" : "+v"(hi64));
        const int dqh = t0 + c.qloc - 1024 * kt - 31 - hi64;
        float b0[16], b1[16];
#pragma unroll
        for (int r = 0; r < 16; ++r) { const int d0 = dqh - 16 * ((r & 3) + 8 * (r >> 2)), d1 = d0 - 512; b0[r] = c.bt[d0 < 0 ? 0 : (d0 > 128 ? 128 : d0)]; b1[r] = c.bt[d1 < 0 ? 0 : (d1 > 128 ? 128 : d1)]; }
#pragma unroll
        for (int r = 0; r < 16; ++r) {
            const int d0 = dqh - 16 * ((r & 3) + 8 * (r >> 2)), d1 = d0 - 512;
            p0[r] = d0 < 0 ? NEG_INF : p0[r] + b0[r]; p1[r] = d1 < 0 ? NEG_INF : p1[r] + b1[r];
        }
    }
}
template <int MODE>
__device__ __forceinline__ void online_tile(const Ctx& c, int slot, const bf16x8 (&qr)[4], int dq, bool near, bool masked_tile, bool lane_off, float& mhat, float& lsum, f32x16 (&o)[2]) {
    f32x16 ci; { const float v = (near ? 0.f : c.bt[128]) - mhat;
#pragma unroll
        for (int r = 0; r < 16; ++r) ci[r] = v; }
    f32x16 p0, p1;
    qkt(p0, p1, c.kb0 + slot * SLOTB, qr, ci);
    if (near || masked_tile) {
        int hi4 = 4 * c.hi; asm volatile("" : "+v"(hi4));
        const int dqh = dq - hi4;
#pragma unroll
        for (int r = 0; r < 16; ++r) {
            const int d0 = dqh - ((r & 3) + 8 * (r >> 2)), d1 = d0 - 32;
            if (near) { p0[r] += c.bt[d0 < 0 ? 0 : (d0 > 128 ? 128 : d0)]; p1[r] += c.bt[d1 < 0 ? 0 : (d1 > 128 ? 128 : d1)]; }
            if (d0 < 0 || (MODE == 1 && d0 >= 512)) p0[r] = NEG_INF;
            if (d1 < 0 || (MODE == 1 && d1 >= 512)) p1[r] = NEG_INF;
        }
    }
    if (MODE == 0) { if (lane_off) {
#pragma unroll
        for (int r = 0; r < 16; ++r) { p0[r] = NEG_INF; p1[r] = NEG_INF; } } }
    const float rm = rowmax(p0, p1, c.hi);
    if (__any(rm > 8.0f)) {
        const float dl = fmaxf(rm, 0.f); mhat += dl;
#pragma unroll
        for (int r = 0; r < 16; ++r) { p0[r] -= dl; p1[r] -= dl; }
        const float f = __builtin_amdgcn_exp2f(-dl); lsum *= f;
        if (c.hi == 0) c.wsf[c.r32] = f;
        asm volatile("s_waitcnt lgkmcnt(0)" ::: "memory");
#pragma unroll
        for (int r = 0; r < 16; ++r) { const float fr = c.wrow[(r & 3) + 8 * (r >> 2)]; o[0][r] *= fr; o[1][r] *= fr; }
    }
    float sacc = 0.f;
#pragma unroll
    for (int r = 0; r < 16; ++r) { p0[r] = __builtin_amdgcn_exp2f(p0[r]); p1[r] = __builtin_amdgcn_exp2f(p1[r]); sacc += p0[r] + p1[r]; }
    lsum += sacc;
    bf16x8 a0, a1, a2, a3; pack_p(p0, p1, a0, a1, a2, a3);
    pv(o, c.vb0 + slot * SLOTB, a0, a1, a2, a3);
}
struct Pipe { bf16x8 a0, a1, a2, a3; bool have, resc; };
template <int MODE, int SPECIAL  , bool HAVE>
__device__ __forceinline__ void online_step(const Ctx& c, int kslot, int vslot_prev, const bf16x8 (&qr)[4], int dq, bool near, bool lane_off, float& mhat, float& lsum, f32x16 (&o)[2], Pipe& pp) {
    if (pp.resc) {
#pragma unroll
        for (int r = 0; r < 16; ++r) { const float fr = c.wrow[(r & 3) + 8 * (r >> 2)]; o[0][r] *= fr; o[1][r] *= fr; }
    }
    f32x16 ci; { const float v = (MODE == 0 && lane_off) ? NEG_INF : ((SPECIAL == 1 ? 0.f : c.bt[128]) - mhat);
#pragma unroll
        for (int r = 0; r < 16; ++r) ci[r] = v; }
    f32x16 p0, p1;
    qkt(p0, p1, c.kb0 + kslot * SLOTB, qr, ci);
    if (HAVE) pv2(o, c.vp0 + vslot_prev * SLOTB, pp.a0, pp.a1, pp.a2, pp.a3);
    if (SPECIAL == 1) {
        const LAS float* rp = c.rt + (255 - dq + 4 * c.hi);
#pragma unroll
        for (int r = 0; r < 16; ++r) { p0[r] += rp[(r & 3) + 8 * (r >> 2)]; p1[r] += rp[32 + (r & 3) + 8 * (r >> 2)]; }
    }
    if (SPECIAL == 2) {
        int hi4 = 4 * c.hi; asm volatile("" : "+v"(hi4));
        const int dqh = dq - hi4;
#pragma unroll
        for (int r = 0; r < 16; ++r) {
            const int d0 = dqh - ((r & 3) + 8 * (r >> 2)), d1 = d0 - 32;
            if (d0 < 0 || (MODE == 1 && d0 >= 512)) p0[r] = NEG_INF;
            if (d1 < 0 || (MODE == 1 && d1 >= 512)) p1[r] = NEG_INF;
        }
    }
    const float rm = rowmax(p0, p1, c.hi);
    const bool mv = __any(rm > 8.0f);
    if (mv) {
        const float dl = fmaxf(rm, 0.f); mhat += dl;
#pragma unroll
        for (int r = 0; r < 16; ++r) { p0[r] -= dl; p1[r] -= dl; }
        const float f = __builtin_amdgcn_exp2f(-dl); lsum *= f;
        c.wsf[c.r32] = f;
    }
    pp.resc = mv;
    float sacc = 0.f;
#pragma unroll
    for (int r = 0; r < 16; ++r) { p0[r] = __builtin_amdgcn_exp2f(p0[r]); p1[r] = __builtin_amdgcn_exp2f(p1[r]); sacc += p0[r] + p1[r]; }
    lsum += sacc;
    pack_p(p0, p1, pp.a0, pp.a1, pp.a2, pp.a3); pp.have = true;
}
__device__ __forceinline__ void online_drain(const Ctx& c, int vslot_prev, f32x16 (&o)[2], Pipe& pp) {
    if (pp.resc) {
#pragma unroll
        for (int r = 0; r < 16; ++r) { const float fr = c.wrow[(r & 3) + 8 * (r >> 2)]; o[0][r] *= fr; o[1][r] *= fr; }
    }
    if (pp.have) pv2(o, c.vp0 + vslot_prev * SLOTB, pp.a0, pp.a1, pp.a2, pp.a3);
}
__device__ __forceinline__ void add_scaled(const Ctx& c, f32x16 (&oacc)[2], const f32x16 (&o)[2], float s) {
    if (c.hi == 0) c.wsf[32 + c.r32] = s;
    asm volatile("s_waitcnt lgkmcnt(0)" ::: "memory");
#pragma unroll
    for (int r = 0; r < 16; ++r) { const float f = c.wrow[32 + (r & 3) + 8 * (r >> 2)]; oacc[0][r] += o[0][r] * f; oacc[1][r] += o[1][r] * f; }
    asm volatile("s_waitcnt lgkmcnt(0)" ::: "memory");
}

__device__ __forceinline__ void add_scaled_park(const Ctx& c, LAS float* park, const f32x16 (&o)[2], float s) {
    if (c.hi == 0) c.wsf[32 + c.r32] = s;
    asm volatile("s_waitcnt lgkmcnt(0)" ::: "memory");
#pragma unroll
    for (int r = 0; r < 16; ++r) { const float f = c.wrow[32 + (r & 3) + 8 * (r >> 2)]; park[r * 64] += o[0][r] * f; park[(16 + r) * 64] += o[1][r] * f; }
    asm volatile("s_waitcnt lgkmcnt(0)" ::: "memory");
}
__device__ __forceinline__ void unit(LAS char* lds, int tid, int b, int hkv, int jt, const bf16* Z, const bf16* KCm, const bf16* VCm, const float* rel_bias, bf16* YC, bool fill_table) {
    Ctx c; c.lds = lds; c.lds0 = (unsigned)(uintptr_t)lds; c.wid = __builtin_amdgcn_readfirstlane(tid >> 6); c.lane = tid & 63; c.r32 = c.lane & 31; c.hi = c.lane >> 5;
    c.g = c.wid & 3; c.th = c.wid >> 2; c.qloc = 32 * c.th + c.r32;
    c.bt = (const LAS float*)(lds + L_BT) + c.g * 132; c.rt = (const LAS float*)(lds + L_RT) + c.g * 320; c.wsf = (LAS float*)(lds + L_WS) + c.wid * 64; c.wrow = c.wsf + 4 * c.hi;
    c.vb0 = (int)(c.lds0 + L_V) + ((c.lane >> 4) & 1) * 32 + (c.lane & 3) * 8 + (4 * c.hi + ((c.lane & 15) >> 2)) * 64;
    c.kb0 = (const LAS char*)(lds + L_K) + c.hi * 1024 + c.r32 * 16;
    c.vp0 = (const LAS char*)(lds + L_V) + ((c.lane >> 4) & 1) * 32 + (c.lane & 3) * 8 + (4 * c.hi + ((c.lane & 15) >> 2)) * 64;
    const int t0 = 64 * jt;
    const bf16* Zb = Z + (size_t)b * SEQ * ZP;
    const size_t qrow = (size_t)b * SEQ + t0 + c.qloc;
    if (fill_table) for (int i = tid; i < 4 * 129; i += NTHR) { const int gg = i / 129, d = i % 129; ((LAS float*)(lds + L_BT))[gg * 132 + d] = rel_bias[t5_bucket(d) * 8 + hkv * 4 + gg] * LOG2E; }
    if (fill_table) for (int i = tid; i < 4 * 320; i += NTHR) { const int gg = i / 320, d = 255 - (i % 320); ((LAS float*)(lds + L_RT))[i] = d < 0 ? NEG_INF : rel_bias[t5_bucket(d > 128 ? 128 : d) * 8 + hkv * 4 + gg] * LOG2E; }
    bf16x8 qr[4];
#pragma unroll
    for (int d0 = 0; d0 < 4; ++d0) qr[d0] = *(const bf16x8*)(Z + qrow * ZP + ZC_Q + hkv * 256 + c.g * 64 + d0 * 16 + c.hi * 8);
    const bf16* gp = Z + qrow * ZP + ZC_G + hkv * 12 + c.g * 3;
    const float gate0 = sigmoidf_(bf2f(gp[0])), gate1 = sigmoidf_(bf2f(gp[1])), gate2 = sigmoidf_(bf2f(gp[2]));
    f32x16 oacc[2];
#pragma unroll
    for (int r = 0; r < 16; ++r) { oacc[0][r] = 0.f; oacc[1][r] = 0.f; }

    const int nct = (4 * jt + 2) / 64 + 1;
    const bf16* kcb = KCm + (size_t)b * NCMPP * 128 + hkv * 64; const bf16* vcb = VCm + (size_t)b * NCMPP * 128 + hkv * 64;
    const bf16* skb = Zb + ZC_KV + 256 + hkv * 64; const bf16* svb = Zb + ZC_KV + 384 + hkv * 64;
    {
        float mhat = 0.f, lsum = 0.f, carry = 0.f; f32x16 o[2];
#pragma unroll
        for (int r = 0; r < 16; ++r) { o[0][r] = 0.f; o[1][r] = 0.f; }
        LAS float* impw = (LAS float*)(lds + L_IMP) + (c.g * 64 + c.qloc) * 64;
        dma_k(c, kcb, 128, 0); dma_v(c, vcb, 128, 0); if (nct > 1) { dma_k(c, kcb + 64 * 128, 128, 1); dma_v(c, vcb + 64 * 128, 128, 1); }
        for (int i = 0; i < nct; ++i) {
            if (i + 1 < nct) NSA_WAIT_BAR(2); else NSA_WAIT_BAR(0);
            if (i + 2 < nct) { dma_k(c, kcb + (size_t)(i + 2) * 64 * 128, 128, (i + 2) % 3); dma_v(c, vcb + (size_t)(i + 2) * 64 * 128, 128, (i + 2) % 3); }
            f32x16 p0, p1; cmp_scores(c, i % 3, qr, t0, i, p0, p1);
            const float rm = rowmax(p0, p1, c.hi) - mhat;
            if (__any(rm > 8.0f)) {
                const float dl = fmaxf(rm, 0.f); mhat += dl;
                const float f = __builtin_amdgcn_exp2f(-dl); lsum *= f; carry *= f;
                c.wsf[c.r32] = f;
                asm volatile("s_waitcnt lgkmcnt(0)" ::: "memory");
#pragma unroll
                for (int r = 0; r < 16; ++r) { const float fr = c.wrow[(r & 3) + 8 * (r >> 2)]; o[0][r] *= fr; o[1][r] *= fr; }
                for (int e = c.hi; e < 16 * i; e += 2) impw[e] *= f;
            }
            float sacc = 0.f;
#pragma unroll
            for (int r = 0; r < 16; ++r) { p0[r] = __builtin_amdgcn_exp2f(p0[r] - mhat); p1[r] = __builtin_amdgcn_exp2f(p1[r] - mhat); sacc += p0[r] + p1[r]; }
            lsum += sacc;
            float o3[8];
#pragma unroll
            for (int k = 0; k < 4; ++k) { o3[k] = other_half(p0[4 * k + 3], c.hi); o3[4 + k] = other_half(p1[4 * k + 3], c.hi); }
#pragma unroll
            for (int idx = 0; idx < 8; ++idx) {
                const int X = idx >> 2, k = idx & 3;
                const f32x16& p = X ? p1 : p0;
                const float cin = c.hi ? o3[idx] : (idx ? o3[idx - 1] : carry);
                impw[16 * i + 8 * X + 2 * k + c.hi] = p[4 * k] + p[4 * k + 1] + p[4 * k + 2] + 0.5f * p[4 * k + 3] + 0.5f * cin;
            }
            carry = o3[7];
            bf16x8 a0, a1, a2, a3; pack_p(p0, p1, a0, a1, a2, a3);
            pv(o, c.vb0 + (i % 3) * SLOTB, a0, a1, a2, a3);
        }
        const float lt = lsum + other_half(lsum, c.hi);
        const float rl = lt > 0.f ? 1.0f / lt : 0.f;
        if (c.hi == 0) ((LAS float*)(lds + L_RL))[c.g * 64 + c.qloc] = rl;
        add_scaled(c, oacc, o, rl * gate0);
        NSA_WAIT_BAR(0);
    }
    { const int nt = jt + 1; dma_k(c, skb, ZP, 0); if (nt > 1) dma_k(c, skb + (size_t)64 * ZP, ZP, 1); dma_v(c, svb, ZP, 0); }
    for (int k = 0; k < 8; ++k) {
        const int tok = c.wid * 8 + k;
        float v = 0.f;
#pragma unroll
        for (int gg = 0; gg < 4; ++gg) v += ((const LAS float*)(lds + L_IMP))[(gg * 64 + tok) * 64 + c.lane] * ((const LAS float*)(lds + L_RL))[gg * 64 + tok];
        const bool forced = (c.lane == 0) || (c.lane <= jt && c.lane > jt - 2), future = c.lane > jt;
        v = forced ? 1e9f : (future ? -1e9f : v);
        int rank = 0;
#pragma unroll
        for (int jj = 0; jj < 64; ++jj) { const float vj = __builtin_bit_cast(float, __builtin_amdgcn_readlane(__builtin_bit_cast(int, v), jj)); rank += ((vj > v) || (vj == v && jj < c.lane)) ? 1 : 0; }
        const unsigned long long msk = __ballot(rank < 16 && !future);
        if (c.lane == 0) ((LAS unsigned long long*)(lds + L_SM))[tok] = msk;
    }
    asm volatile("s_waitcnt lgkmcnt(0)\n\ts_barrier" ::: "memory");
    const unsigned long long mymask = ((const LAS unsigned long long*)(lds + L_SM))[c.qloc];
    LAS float* park = (LAS float*)(lds + L_IMP) + c.wid * 2048 + c.lane;
#pragma unroll
    for (int r = 0; r < 16; ++r) { park[r * 64] = oacc[0][r]; park[(16 + r) * 64] = oacc[1][r]; }
    {
        const bf16* kb = skb; const bf16* vb = svb;
        const int nt = jt + 1;
        float mhat = 0.f, lsum = 0.f; f32x16 o[2]; Pipe pp; pp.have = false; pp.resc = false;
#pragma unroll
        for (int r = 0; r < 16; ++r) { o[0][r] = 0.f; o[1][r] = 0.f; }
#define NSA_ITER_HEAD(i) do { if ((i) + 1 < nt) NSA_WAIT_BAR(2); else NSA_WAIT_BAR(1); \
            if ((i) + 2 < nt) dma_k(c, kb + (size_t)((i) + 2) * 64 * ZP, ZP, ((i) + 2) % 3); \
            if ((i) + 1 < nt) dma_v(c, vb + (size_t)((i) + 1) * 64 * ZP, ZP, ((i) + 1) % 3); } while (0)
        {
            NSA_ITER_HEAD(0);
            if (jt <= 2) online_step<0, 1, false>(c, 0, 2, qr, 64 * jt + c.qloc, true, !(mymask & 1ull), mhat, lsum, o, pp); else online_step<0, 0, false>(c, 0, 2, qr, 0, false, !(mymask & 1ull), mhat, lsum, o, pp); }
        const int nfar = jt - 2;
        int i = 1;
        for (; i < nfar; ++i) { NSA_ITER_HEAD(i);
            online_step<0, 0, true>(c, i % 3, (i + 2) % 3, qr, 0, false, !((mymask >> i) & 1ull), mhat, lsum, o, pp); }
        for (; i < nt; ++i) { NSA_ITER_HEAD(i);
            online_step<0, 1, true>(c, i % 3, (i + 2) % 3, qr, 64 * (jt - i) + c.qloc, true, !((mymask >> i) & 1ull), mhat, lsum, o, pp); }
        NSA_WAIT_BAR(0);
        online_drain(c, (nt - 1) % 3, o, pp);
        const float lt = lsum + other_half(lsum, c.hi);
        add_scaled_park(c, park, o, (lt > 0.f ? 1.0f / lt : 0.f) * gate1);
        NSA_WAIT_BAR(0);
    }
    {
        const int j0 = jt > 8 ? jt - 8 : 0, nt = jt - j0 + 1;
        const bf16* kb = Zb + (size_t)j0 * 64 * ZP + ZC_KV + 512 + hkv * 64; const bf16* vb = Zb + (size_t)j0 * 64 * ZP + ZC_KV + 640 + hkv * 64;
        float mhat = 0.f, lsum = 0.f; f32x16 o[2]; Pipe pp; pp.have = false; pp.resc = false;
#pragma unroll
        for (int r = 0; r < 16; ++r) { o[0][r] = 0.f; o[1][r] = 0.f; }
        dma_k(c, kb, ZP, 0); if (nt > 1) dma_k(c, kb + (size_t)64 * ZP, ZP, 1); dma_v(c, vb, ZP, 0);
        {
            NSA_ITER_HEAD(0);
            if (j0 >= jt - 2) online_step<1, 1, false>(c, 0, 2, qr, 64 * (jt - j0) + c.qloc, true, false, mhat, lsum, o, pp); else online_step<1, 2, false>(c, 0, 2, qr, 64 * (jt - j0) + c.qloc, false, false, mhat, lsum, o, pp); }
        int i = 1;
        for (; j0 + i < jt - 2; ++i) { NSA_ITER_HEAD(i);
            online_step<1, 0, true>(c, i % 3, (i + 2) % 3, qr, 0, false, false, mhat, lsum, o, pp); }
        for (; i < nt; ++i) { NSA_ITER_HEAD(i); const int j = j0 + i;
            online_step<1, 1, true>(c, i % 3, (i + 2) % 3, qr, 64 * (jt - j) + c.qloc, true, false, mhat, lsum, o, pp); }
#undef NSA_ITER_HEAD
        NSA_WAIT_BAR(0);
        online_drain(c, (nt - 1) % 3, o, pp);
        const float lt = lsum + other_half(lsum, c.hi);
        add_scaled_park(c, park, o, (lt > 0.f ? 1.0f / lt : 0.f) * gate2);
    }
    {
        bf16* yb = YC + ((size_t)b * SEQ + t0 + 32 * c.th + 4 * c.hi) * DM + D_SSM + hkv * 256 + c.g * 64 + c.r32;
#pragma unroll
        for (int r = 0; r < 16; ++r) { bf16* yr = yb + (size_t)((r & 3) + 8 * (r >> 2)) * DM; yr[0] = (bf16)f2bf(park[r * 64]); yr[32] = (bf16)f2bf(park[(16 + r) * 64]); }
    }
    asm volatile("s_waitcnt vmcnt(0)" ::: "memory");
    NSA_WAIT_BAR(0);
}
#undef NSA_SBAR
#undef NSA_WAIT_BAR
}


__device__ __forceinline__ void ssm_precompute(const Frame& F, const __attribute__((address_space(4))) Args* args, unsigned char* ws, int item) {
    const int layer = item >> 5, g = item & 31, lg = layer * 32 + g;
    LAS float* L = (LAS float*)F.lds;
    LAS float* lkr = L; LAS float* lki = L + 17 * 64; LAS float* bbr = L + 2 * 17 * 64; LAS float* bbi = bbr + 1024; LAS float* ccr = bbi + 1024; LAS float* cci = ccr + 1024;
    LAS float* wk = cci + 1024; LAS float* dd = wk + 4096;
    const float* a_re = args->in[6] + lg * 64; const float* a_im = args->in[7] + lg * 64;
    const float dt = expf(args->in[13][lg]);
    for (int i = F.tid; i < 17 * 64; i += NTHR) { const int k = i >> 6, p = i & 63; const float er = expf(a_re[p] * dt * (float)k), ang = a_im[p] * dt * (float)k; lkr[i] = er * cosf(ang); lki[i] = er * sinf(ang); }
    for (int i = F.tid; i < 1024; i += NTHR) {
        { const int p = i >> 4, h = i & 15; const float are = a_re[p], aim = a_im[p];
          const float er = expf(are * dt), lbr = er * cosf(aim * dt), lbi = er * sinf(aim * dt);
          const float xx = lbr - 1.0f, yy = lbi, den = are * are + aim * aim, fr = (xx * are + yy * aim) / den, fi = (yy * are - xx * aim) / den;
          const float br = args->in[8][((size_t)lg * 64 + p) * 16 + h], bi = args->in[9][((size_t)lg * 64 + p) * 16 + h];
          bbr[i] = fr * br - fi * bi; bbi[i] = fr * bi + fi * br; }
        ccr[i] = args->in[10][(size_t)lg * 1024 + i]; cci[i] = args->in[11][(size_t)lg * 1024 + i];
    }
    if (F.tid < 16) dd[F.tid] = args->in[12][lg * 16 + F.tid];
    __syncthreads();
    for (int i = F.tid; i < 4096; i += NTHR) { const int k = i >> 8, ho = (i >> 4) & 15, hi = i & 15; float acc = 0.f;
        for (int p = 0; p < 64; ++p) { const float cr = ccr[ho * 64 + p], ci = cci[ho * 64 + p], lr = lkr[k * 64 + p], li = lki[k * 64 + p];
            const float tr = cr * lr - ci * li, ti = cr * li + ci * lr; acc += tr * bbr[p * 16 + hi] - ti * bbi[p * 16 + hi]; }
        wk[i] = acc + ((k == 0 && ho == hi) ? dd[ho] : 0.f); }
    __syncthreads();
    bf16* B2 = (bf16*)(ws + WS_BT2) + (size_t)lg * 256 * 384;
    for (int i = F.tid; i < 256 * 384; i += NTHR) { const int n = i / 384, kk = i % 384, t = n >> 4, ho = n & 15; float v;
        if (kk < 256) { const int sidx = kk >> 4, hi = kk & 15; v = sidx <= t ? wk[((t - sidx) << 8) + ho * 16 + hi] : 0.f; }
        else { const int j = kk - 256, p = j & 63; const float cr = ccr[ho * 64 + p], ci = cci[ho * 64 + p], lr = lkr[(t + 1) * 64 + p], li = lki[(t + 1) * 64 + p];
            v = j < 64 ? (cr * lr - ci * li) : -(cr * li + ci * lr); }
        B2[i] = (bf16)f2bf(v); }
    bf16* B1 = (bf16*)(ws + WS_BT1) + (size_t)lg * 256 * 256;
    for (int i = F.tid; i < 65536; i += NTHR) { const int j = i >> 8, kk = i & 255, sidx = kk >> 4, hi = kk & 15; float v = 0.f;
        if (j < 128) { const int p = j & 63; const float lr = lkr[(15 - sidx) * 64 + p], li = lki[(15 - sidx) * 64 + p], br = bbr[p * 16 + hi], bi = bbi[p * 16 + hi];
            v = j < 64 ? (lr * br - li * bi) : (lr * bi + li * br); }
        B1[i] = (bf16)f2bf(v); }
    __syncthreads();
}
__device__ __forceinline__ void ssm_carry_item(int b, int g, const float* a_re, const float* a_im, const float* log_dt, const float* XL, bf16* U, int lane) {
    const float dt16 = 16.0f * expf(log_dt[g]);
    const float er = expf(a_re[g * 64 + lane] * dt16), ang = a_im[g * 64 + lane] * dt16, lr = er * cosf(ang), li = er * sinf(ang);
    float xr = 0.f, xi = 0.f;
    const float* __restrict__ xl = XL + ((size_t)g * 2048 + b * 256) * 128 + lane;
    bf16* __restrict__ up = U + ((size_t)g * 2048 + b * 256) * 512 + 256 + lane;
    float ar[16], ai[16], nr_[16], ni_[16];
#pragma unroll
    for (int k = 0; k < 16; ++k) { ar[k] = xl[(size_t)k * 128]; ai[k] = xl[(size_t)k * 128 + 64]; }
    for (int cb = 0; cb < 16; ++cb) {
        const int cn = cb < 15 ? (cb + 1) * 16 : cb * 16;
#pragma unroll
        for (int k = 0; k < 16; ++k) { nr_[k] = xl[(size_t)(cn + k) * 128]; ni_[k] = xl[(size_t)(cn + k) * 128 + 64]; }
#pragma unroll
        for (int k = 0; k < 16; ++k) {
            const int c = cb * 16 + k;
            up[(size_t)c * 512] = (bf16)f2bf(xr); up[(size_t)c * 512 + 64] = (bf16)f2bf(xi);
            const float nr = lr * xr - li * xi + ar[k], ni = lr * xi + li * xr + ai[k];
            xr = nr; xi = ni;
        }
#pragma unroll
        for (int k = 0; k < 16; ++k) { ar[k] = nr_[k]; ai[k] = ni_[k]; }
    }
}


__device__ __forceinline__ void compress_stage2(const Frame& F, int eb, int pm, const bf16* HC, const bf16* W2T, bf16* KCo, bf16* VCo) {
    typedef short bf16x8_ __attribute__((ext_vector_type(8))); typedef float f32x16_ __attribute__((ext_vector_type(16)));
    const int r32 = F.lane & 31, hi = F.lane >> 5, rg0 = pm * 256 + F.wave * 32;
    const bf16* ar = HC + ((size_t)eb * 4096 + rg0 + r32) * 64 + 8 * hi; const bf16* br = W2T + (size_t)eb * 4096 + (size_t)r32 * 64 + 8 * hi;
    bf16x8_ a[4], b0[4], b1[4];
#pragma unroll
    for (int ks = 0; ks < 4; ++ks) { a[ks] = *(const bf16x8_*)(ar + ks * 16); b0[ks] = *(const bf16x8_*)(br + ks * 16); b1[ks] = *(const bf16x8_*)(br + 32 * 64 + ks * 16); }
    f32x16_ d0, d1;
#pragma unroll
    for (int r = 0; r < 16; ++r) { d0[r] = 0.f; d1[r] = 0.f; }
#pragma unroll
    for (int ks = 0; ks < 4; ++ks) { d0 = __builtin_amdgcn_mfma_f32_32x32x16_bf16(a[ks], b0[ks], d0, 0, 0, 0); d1 = __builtin_amdgcn_mfma_f32_32x32x16_bf16(a[ks], b1[ks], d1, 0, 0, 0); }
    bf16* dstb = (eb ? VCo : KCo) + (size_t)(rg0 + 4 * hi) * 64 + r32;
#pragma unroll
    for (int r = 0; r < 16; ++r) { const int ro = (r & 3) + 8 * (r >> 2); const bool pad = (((rg0 + 4 * hi + ro) >> 1) & 255) == NCMP;
        dstb[(size_t)ro * 64] = pad ? (bf16)0 : (bf16)f2bf(d0[r]); dstb[(size_t)ro * 64 + 32] = pad ? (bf16)0 : (bf16)f2bf(d1[r]); }
}

__device__ __forceinline__ void titem_load(const float* W, int N, int k0, int n0, int lane, float (&t)[32]) {
#pragma unroll
    for (int i = 0; i < 32; ++i) t[i] = W[(size_t)(k0 + 2 * i + (lane >> 5)) * N + n0 + (lane & 31)];
}
__device__ __forceinline__ void titem_finish(const float (&t)[32], int K, bf16* WT, int k0, int drow0, LAS float* scr, int lane, float scale) {
#pragma unroll
    for (int i = 0; i < 32; ++i) scr[(2 * i + (lane >> 5)) * 33 + (lane & 31)] = t[i];
    asm volatile("s_waitcnt lgkmcnt(0)" ::: "memory");
    const int c = lane & 7;
#pragma unroll
    for (int j = 0; j < 4; ++j) { const int n = (lane >> 3) + 8 * j; const LAS float* sp = scr + (8 * c) * 33 + n;
        u32x4 o; o.x = pk2(sp[0 * 33] * scale, sp[1 * 33] * scale); o.y = pk2(sp[2 * 33] * scale, sp[3 * 33] * scale); o.z = pk2(sp[4 * 33] * scale, sp[5 * 33] * scale); o.w = pk2(sp[6 * 33] * scale, sp[7 * 33] * scale);
        *(u32x4*)(WT + (size_t)(drow0 + n) * K + k0 + 8 * c) = o; }
    asm volatile("s_waitcnt lgkmcnt(0)" ::: "memory");
}
__device__ __forceinline__ void transpose_item(const float* W, int K, int N, bf16* WT, int k0, int n0, int drow0, LAS float* scr, int lane, float scale = 1.0f) {
    float t[32]; titem_load(W, N, k0, n0, lane, t); titem_finish(t, K, WT, k0, drow0, scr, lane, scale);
}
struct XItem { const float* W; bf16* WT; int K, N, k0, n0, drow0; };
__device__ __forceinline__ XItem xitem(const __attribute__((address_space(4))) Args* args, unsigned char* ws, int it) {
    XItem x; const int le = it / 384, r = it % 384;
    if (r < 256) { const int isup = r >> 7, q = r & 127, nb = q & 7, kb = q >> 3, n0 = 32 * nb;
        x.W = args->in[isup ? 24 : 23] + (size_t)le * DM * 256; x.K = DM; x.N = 256; x.WT = (bf16*)(ws + WS_WGU) + (size_t)le * 512 * DM; x.k0 = 64 * kb; x.n0 = n0; x.drow0 = 256 * (n0 >> 7) + 128 * isup + (n0 & 127); }
    else { const int q = r - 256, nb = q & 31, kb = q >> 5;
        x.W = args->in[25] + (size_t)le * 256 * DM; x.K = 256; x.N = DM; x.WT = (bf16*)(ws + WS_WDN) + (size_t)le * DM * 256; x.k0 = 64 * kb; x.n0 = 32 * nb; x.drow0 = 32 * nb; }
    return x;
}
__device__ __forceinline__ void convert_experts(const Frame& F, const __attribute__((address_space(4))) Args* args, unsigned char* ws, int layer, int vw, int nvw) {
    LAS float* scr = (LAS float*)(F.lds + F.wave * 16384);
    const int lo_ = layer * 32 * 384, hi_ = (layer + 1) * 32 * 384;
    float ta[32], tb[32]; XItem xa, xb;
    int it = lo_ + vw;
    if (it < hi_) { xa = xitem(args, ws, it); titem_load(xa.W, xa.N, xa.k0, xa.n0, F.lane, ta); }
    for (; it < hi_; it += nvw) {
        const bool hn = it + nvw < hi_;
        if (hn) { xb = xitem(args, ws, it + nvw); titem_load(xb.W, xb.N, xb.k0, xb.n0, F.lane, tb); }
        titem_finish(ta, xa.K, xa.WT, xa.k0, xa.drow0, scr, F.lane, 1.0f);
        if (hn) { xa = xb;
#pragma unroll
            for (int i = 0; i < 32; ++i) ta[i] = tb[i]; }
    }
}
__device__ __forceinline__ void ph_convert(const Frame& F, const __attribute__((address_space(4))) Args* args, unsigned char* ws) {
    for (int it = F.blk; it < DEPTH * NGRP; it += F.G) ssm_precompute(F, args, ws, it);
    LAS float* scr = (LAS float*)(F.lds + F.wave * 16384);
    const int gw = F.blk * NWAVES + F.wave, NGW = F.G * NWAVES;
    constexpr int I_IN = (DM / 64) * (1792 / 32), I_GLU = (D_SSM / 64) * (2 * D_SSM / 32), I_OUT = (DM / 64) * (DM / 32);
    constexpr int PER_LAYER = I_IN + I_GLU + I_OUT;
    for (int it = gw; it < DEPTH * 2 * 64; it += NGW) { const int li = it >> 6, q = it & 63, nb = q & 1, kb = q >> 1;
        transpose_item(args->in[16] + (size_t)li * 2048 * 64, 2048, 64, (bf16*)(ws + WS_W1T) + (size_t)li * 256 * 2048, 64 * kb, 32 * nb, 32 * nb, scr, F.lane); }
    { const int gt = F.blk * NTHR + F.tid, NGT = F.G * NTHR;
      for (int idx = gt; idx < DEPTH * 2 * 192 * 2048 / 8; idx += NGT) { const int li = idx / (192 * 256), rem = idx % (192 * 256);
          *(u32x4*)((bf16*)(ws + WS_W1T) + (size_t)li * 256 * 2048 + (size_t)64 * 2048 + (size_t)rem * 8) = (u32x4){0u, 0u, 0u, 0u}; }
      for (int idx = gt; idx < DEPTH * 2 * 4096; idx += NGT) { const int li = idx >> 12, f = (idx >> 6) & 63, e = idx & 63; ((bf16*)(ws + WS_W2T))[idx] = (bf16)f2bf(args->in[17][(size_t)li * 4096 + e * 64 + f]); }
    }
    for (int idx = gw; idx < DEPTH * 2 * 64; idx += NGW) { const int li = idx >> 6, e = idx & 63; const float* pp = args->in[15] + (size_t)li * 2048; const float* ww = args->in[16] + (size_t)li * 2048 * 64 + e;
        float a = 0.f;
#pragma unroll 8
        for (int k = F.lane; k < 2048; k += 64) a += pp[k] * ww[(size_t)k * 64];
        a = wave_sum(a, F.lane);
        if (F.lane == 0) ((float*)(ws + WS_CBIAS))[idx] = a; }
    for (int it = gw; it < DEPTH * PER_LAYER; it += NGW) {
        const int layer = it / PER_LAYER; int r = it % PER_LAYER;
        if (r < I_IN) { const int nb = r % 56, kb = r / 56;
            transpose_item(args->in[4] + (size_t)layer * DM * D_IN, DM, D_IN, (bf16*)(ws + WS_WIN) + (size_t)layer * ZP * DM, 64 * kb, 32 * nb, 32 * nb, scr, F.lane, (nb >= 16 && nb < 32) ? QSCALE : 1.0f); continue; }
        r -= I_IN;
        if (r < I_GLU) { const int nb = r % 32, kb = r / 32, n0 = 32 * nb;
            const int half = n0 >> 9, c = n0 & 511, drow = 256 * (c >> 7) + 128 * half + (c & 127);
            transpose_item(args->in[14] + (size_t)layer * D_SSM * 2 * D_SSM, D_SSM, 2 * D_SSM, (bf16*)(ws + WS_WGLU) + (size_t)layer * 2 * D_SSM * D_SSM, 64 * kb, n0, drow, scr, F.lane); continue; }
        r -= I_GLU;
        { const int nb = r % 32, kb = r / 32;
            transpose_item(args->in[5] + (size_t)layer * DM * DM, DM, DM, (bf16*)(ws + WS_WOUT) + (size_t)layer * DM * DM, 64 * kb, 32 * nb, 32 * nb, scr, F.lane); }
    }
    const int gt = F.blk * NTHR + F.tid, NGT = F.G * NTHR;
    for (int idx = gt; idx < DEPTH * 256 * DM; idx += NGT) {
        const int layer = idx / (256 * DM), rem = idx % (256 * DM), n = 1792 + rem / DM, k = rem % DM;
        const float v = n < D_IN ? args->in[4][(size_t)layer * DM * D_IN + (size_t)k * D_IN + n] : 0.f;
        ((bf16*)(ws + WS_WIN))[(size_t)layer * ZP * DM + (size_t)n * DM + k] = (bf16)f2bf(v);
    }
}

constexpr int PH_PER_LAYER = 8, N_PHASES = 1 + DEPTH * PH_PER_LAYER + 1;
#ifndef FAST_GEMM
#define FAST_GEMM 1
#endif
#ifndef REP_ATTN
#define REP_ATTN 1
#endif
#ifndef REP_CMP
#define REP_CMP 1
#endif
#ifndef REP_CARRY
#define REP_CARRY 1
#endif
#ifndef REP_CONV
#define REP_CONV 1
#endif
#ifndef REP_INPROJ
#define REP_INPROJ 1
#endif
#ifndef REP_G1
#define REP_G1 1
#endif
#ifndef REP_G2
#define REP_G2 1
#endif
#ifndef REP_GLU
#define REP_GLU 1
#endif
#ifndef REP_OUT
#define REP_OUT 1
#endif
#ifndef REP_NORM
#define REP_NORM 1
#endif
#ifndef REP_ROUTE
#define REP_ROUTE 1
#endif
#ifndef REP_GU
#define REP_GU 1
#endif
#ifndef REP_DN
#define REP_DN 1
#endif

__global__ void __launch_bounds__(NTHR, 2) fwd(Args args) {
    extern __shared__ __attribute__((aligned(16))) unsigned char lds_raw[];
    Frame F;
    F.lds = (LAS unsigned char*)lds_raw;
    F.tid = threadIdx.x; F.lane = F.tid & 63; F.wave = __builtin_amdgcn_readfirstlane(F.tid >> 6);
    F.blk = blockIdx.x; F.G = gridDim.x;
    typedef const __attribute__((address_space(4))) Args* KArgs;
    KArgs kp = (KArgs)__builtin_amdgcn_kernarg_segment_ptr();
    asm volatile("" : "+s"(kp));
    unsigned char* ws = kp->ws;
    volatile LAS unsigned* MISC = (volatile LAS unsigned*)(F.lds + MISC_OFF);
    if (F.tid < 32) MISC[F.tid] = 0u;
    __syncthreads();
    XcdBarrier bar; bar.bar = (unsigned*)(ws + WS_CTL) + CW_BAR; bar.x = 0; bar.st = nullptr;
    if (N_LAUNCH_MODE == 1) bar = xcd_barrier_post((unsigned*)(ws + WS_CTL) + CW_BAR, MISC + 8);
#define IN(k) (kp->ph_lo <= (k) && (k) < kp->ph_hi)
#define FRESH_IDS() do { int l_; asm volatile("v_mbcnt_lo_u32_b32 %0, -1, 0\n\tv_mbcnt_hi_u32_b32 %0, -1, %0" : "=v"(l_)); asm volatile("" : "+s"(F.wave), "+s"(F.blk), "+s"(F.G)); F.lane = l_; F.tid = F.wave * 64 + l_; asm volatile("" : "+s"(kp)); ws = kp->ws; bar.bar = (unsigned*)(ws + WS_CTL) + CW_BAR; } while (0)
#define SEAM(k) do { FRESH_IDS(); if (IN(k) && IN((k) + 1)) xcd_barrier(bar, F.tid); FRESH_IDS(); } while (0)

    const float* x0 = kp->in[0];
    float* XR = kp->out;
#define HN ((bf16*)(ws + WS_HN))
#define Z ((bf16*)(ws + WS_Z))
#define YC ((bf16*)(ws + WS_YC))
#define G1 ((bf16*)(ws + WS_G1))
#define KC ((bf16*)(ws + WS_KC))
#define VC ((bf16*)(ws + WS_VC))
#define LIST ((unsigned*)(ws + WS_LIST))
#define LISTW ((float*)(ws + WS_LISTW))
#define HID ((bf16*)(ws + WS_HID))
#define P2 ((bf16*)(ws + WS_P2))
#define P1B ((bf16*)(ws + WS_YC))
#define USSM ((bf16*)(ws + WS_USSM))
#define XL ((float*)(ws + WS_XL))
    LAS int* etab = (LAS int*)(F.lds + ETAB_OFF);

    if (IN(0)) { for (int rep_ = 0; rep_ < REP_CONV; ++rep_) ph_convert(F, kp, ws);
                 ph_norm(F, kp->in[0], nullptr, nullptr, kp->out, kp->in[1], HN); }
    SEAM(0);
    for (int layer = 0; layer < DEPTH; ++layer) {
        const int pb = 1 + layer * PH_PER_LAYER;
        const float* xin = layer == 0 ? x0 : XR;
        unsigned* gcnt = (unsigned*)(ws + WS_CTL) + CW_CNT + layer * 32 * 64;
        if (IN(pb + 0) && layer > 0) { ph_norm(F, xin, P1B, P2, XR, kp->in[1] + layer * DM, HN); for (int rep_ = 1; rep_ < REP_NORM; ++rep_) ph_norm(F, xin, nullptr, nullptr, XR, kp->in[1] + layer * DM, HN); }
        if (layer > 0) SEAM(pb + 0);
        if (IN(pb + 1)) {
            pg8::Gemm g{HN, (const bf16*)(ws + WS_WIN) + (size_t)layer * ZP * DM, T, ZP, DM, DM, 0, nullptr, 0, 0, 128}; pg8::StaticOrder S; S.init(T, ZP, F.G, F.blk);
            pg8::EpiInProj E{Z, USSM};
            for (int rep_ = 0; rep_ < REP_INPROJ; ++rep_) pg8::gemm2<pg8::EpiInProj, pg8::StaticOrder, pg8::ADense>(F.lds, g, S, E, F.tid);
        }
        SEAM(pb + 1);
        if (IN(pb + 2)) {
            for (int rep_ = 0; rep_ < REP_CMP; ++rep_) {
                { pg8::Gemm g{Z, (const bf16*)(ws + WS_W1T) + (size_t)layer * 2 * 256 * 2048, 0, 256, 2048, ZP, (size_t)256 * 2048, nullptr, 0, 0, ZP * 2};
                  pg8::CmpOrder S{F.G, F.blk}; pg8::EpiCmpHid E{(bf16*)(ws + WS_HIDC), (const float*)(ws + WS_CBIAS) + layer * 128};
                  pg8::gemm2<pg8::EpiCmpHid, pg8::CmpOrder, pg8::ACompress>(F.lds, g, S, E, F.tid); }
                asm volatile("s_waitcnt vmcnt(0)" ::: "memory"); __syncthreads();
                for (int L = F.blk; L < 32; L += F.G) compress_stage2(F, L >> 4, L & 15, (const bf16*)(ws + WS_HIDC), (const bf16*)(ws + WS_W2T) + (size_t)layer * 2 * 4096, KC, VC);
            }
#pragma unroll 1
            for (int L = F.blk; L < NGRP * BATCH; L += F.G) {
                const int sg = L >> 3, sb = L & 7;
                FRESH_IDS();
                { pg8::Gemm g{USSM, (const bf16*)(ws + WS_BT1) + (size_t)layer * 32 * 256 * 256, 0, 256, 256, 512, (size_t)256 * 256, nullptr, 0, (size_t)2048 * 512, 128};
                  pg8::SingleUnit S{sg, sb}; pg8::EpiXloc E{XL};
                  pg8::gemm2<pg8::EpiXloc, pg8::SingleUnit, pg8::ADense>(F.lds, g, S, E, F.tid); }
                asm volatile("s_waitcnt vmcnt(0)" ::: "memory"); __syncthreads();
                for (int rep_ = 0; rep_ < REP_CARRY; ++rep_)
                if (F.wave == 0) ssm_carry_item(sb, sg, kp->in[6] + layer * NGRP * SST, kp->in[7] + layer * NGRP * SST, kp->in[13] + layer * NGRP, XL, USSM, F.lane);
                asm volatile("s_waitcnt vmcnt(0)" ::: "memory"); __syncthreads();
                FRESH_IDS();
                { pg8::Gemm g{USSM, (const bf16*)(ws + WS_BT2) + (size_t)layer * 32 * 256 * 384, 0, 256, 384, 512, (size_t)256 * 384, nullptr, 0, (size_t)2048 * 512, 128};
                  pg8::SingleUnit S{sg, sb}; pg8::EpiSsmOut E{G1};
                  pg8::gemm2<pg8::EpiSsmOut, pg8::SingleUnit, pg8::ADense>(F.lds, g, S, E, F.tid); }
            }
            if (F.G > 64) { if (F.blk >= 32) convert_experts(F, kp, ws, layer, (F.blk - 32) * NWAVES + F.wave, (F.G - 32) * NWAVES); }
            else convert_experts(F, kp, ws, layer, F.blk * NWAVES + F.wave, F.G * NWAVES);
        }
        SEAM(pb + 2);
        if (IN(pb + 3)) {
            { pg8::Gemm g{G1, (const bf16*)(ws + WS_WGLU) + (size_t)layer * 2 * D_SSM * D_SSM, T, 2 * D_SSM, D_SSM, D_SSM, 0, nullptr, 0, 0, 128}; pg8::StaticOrder S; S.init(T, 2 * D_SSM, F.G, F.blk);
              pg8::EpiGlu E{YC, DM};
              for (int rep_ = 0; rep_ < REP_GLU; ++rep_) pg8::gemm2<pg8::EpiGlu, pg8::StaticOrder, pg8::ADense>(F.lds, g, S, E, F.tid); }
            __syncthreads();
            int last_hkv = -1;
            for (int rep_ = 0; rep_ < REP_ATTN; ++rep_)
            for (int slot = F.blk; slot < 256; slot += F.G) {
                const int bh = slot >> 4, sq = slot & 15;
#pragma unroll 1
                for (int uq = 0; uq < 4; ++uq) { const int jt = uq == 0 ? 63 - sq : (uq == 1 ? 32 + sq : (uq == 2 ? 31 - sq : sq));
                    nsa::unit((LAS char*)F.lds, F.tid, bh >> 1, bh & 1, jt, Z, KC, VC, kp->in[18], YC, (bh & 1) != last_hkv); last_hkv = bh & 1; }
            }
        }
        SEAM(pb + 3);
        if (IN(pb + 4)) {
            pg8::Gemm g{YC, (const bf16*)(ws + WS_WOUT) + (size_t)layer * DM * DM, T, DM, DM, DM, 0, nullptr, 0, 0, 128}; pg8::StaticOrder S; S.init(T, DM, F.G, F.blk);
            for (int rep_ = 1; rep_ < REP_OUT; ++rep_) { pg8::EpiResid Ed{xin, (float*)(ws + WS_Z), DM}; pg8::gemm2<pg8::EpiResid, pg8::StaticOrder, pg8::ADense>(F.lds, g, S, Ed, F.tid); }
            pg8::EpiResid E{xin, XR, DM};
            pg8::gemm2<pg8::EpiResid, pg8::StaticOrder, pg8::ADense>(F.lds, g, S, E, F.tid);
        }
        SEAM(pb + 4);
        if (IN(pb + 5)) ph_norm_route(F, XR, kp->in[2] + layer * DM, kp->in[19] + (size_t)layer * DM * 4, kp->in[20] + layer * 4, kp->in[21] + (size_t)layer * 4 * DM * 8, kp->in[22] + layer * 32, HN, gcnt, LIST, LISTW);
        if (IN(pb + 5)) for (int rep_ = 1; rep_ < REP_ROUTE; ++rep_) ph_norm_route(F, XR, kp->in[2] + layer * DM, kp->in[19] + (size_t)layer * DM * 4, kp->in[20] + layer * 4, kp->in[21] + (size_t)layer * 4 * DM * 8, kp->in[22] + layer * 32, HN, gcnt + (2 + rep_) * 32 * 64, (unsigned*)(ws + 484 * MiB), (float*)(ws + 488 * MiB));
        SEAM(pb + 5);
        if (IN(pb + 6)) {
            build_expert_tab(F, gcnt, etab);
            pg8::Gemm g{HN, (const bf16*)(ws + WS_WGU) + (size_t)layer * 32 * 512 * DM, 0, 512, DM, DM, (size_t)512 * DM, LIST, LCAP, 0, 128};
            pg8::ExpertOrder S{etab, 2, F.G, F.blk};
            pg8::EpiGateUp E{HID, LISTW, LCAP};
            for (int rep_ = 0; rep_ < REP_GU; ++rep_) pg8::gemm2<pg8::EpiGateUp, pg8::ExpertOrder, pg8::AList>(F.lds, g, S, E, F.tid);
        }
        SEAM(pb + 6);
        if (IN(pb + 7)) {
            build_expert_tab(F, gcnt, etab);
            pg8::Gemm g{HID, (const bf16*)(ws + WS_WDN) + (size_t)layer * 32 * DM * 256, 0, DM, 256, 256, (size_t)DM * 256, nullptr, 0, 0, 128};
            pg8::ExpertOrder S{etab, 4, F.G, F.blk};
            for (int rep_ = 1; rep_ < REP_DN; ++rep_) { pg8::EpiDown Ed{P1B, (long)(P2 - P1B), LIST, LCAP}; pg8::gemm2<pg8::EpiDown, pg8::ExpertOrder, pg8::ADense>(F.lds, g, S, Ed, F.tid); }
            pg8::EpiDown E{P1B, (long)(P2 - P1B), LIST, LCAP};
            pg8::gemm2<pg8::EpiDown, pg8::ExpertOrder, pg8::ADense>(F.lds, g, S, E, F.tid);
        }
        SEAM(pb + 7);
    }
    if (IN(N_PHASES - 1)) ph_final_norm(F, XR, P1B, P2, kp->in[3]);
#undef IN
#undef SEAM
#undef HN
#undef Z
#undef YC
#undef G1
#undef KC
#undef VC
#undef LIST
#undef LISTW
#undef HID
#undef P2
#undef P1B
#undef USSM
#undef XL
}

extern "C" void kernel_launch(void* const* d_in, const int* in_sizes, int n_in, void* d_out, int out_size, void* d_ws, size_t ws_size, hipStream_t stream) {
    static int grid = 0;
    if (grid == 0) {
        if (n_in != 26 || out_size != T * DM || ws_size < WS_END) { fprintf(stderr, "kernel_launch: unexpected shapes (n_in %d out %d ws %zu)\n", n_in, out_size, ws_size); grid = -1; return; }
        int dev = 0, cus = 0, per_cu = 0;
        if (hipGetDevice(&dev) != hipSuccess || hipDeviceGetAttribute(&cus, hipDeviceAttributeMultiprocessorCount, dev) != hipSuccess) { grid = -1; return; }
        if (hipFuncSetAttribute((const void*)fwd, hipFuncAttributeMaxDynamicSharedMemorySize, LDS_BYTES) != hipSuccess) { fprintf(stderr, "kernel_launch: hipFuncSetAttribute failed\n"); grid = -1; return; }
        if (hipOccupancyMaxActiveBlocksPerMultiprocessor(&per_cu, (const void*)fwd, NTHR, LDS_BYTES) != hipSuccess || per_cu < 1) fprintf(stderr, "kernel_launch: occupancy query says %d\n", per_cu);
        (void)hipGetLastError();
        grid = cus;
    }
    if (grid < 0) return;
    (void)hipMemsetAsync((char*)d_ws + WS_CTL, 0, CTL_ZERO_BYTES, stream);
    Args a{};
    for (int i = 0; i < 26; ++i) a.in[i] = (const float*)d_in[i];
    a.out = (float*)d_out; a.ws = (unsigned char*)d_ws;
    if (N_LAUNCH_MODE == 1) {
        a.ph_lo = 0; a.ph_hi = N_PHASES;
        hipLaunchKernelGGL(fwd, dim3(grid), dim3(NTHR), LDS_BYTES, stream, a);
    } else {
        for (int p = 0; p < N_PHASES; ++p) { a.ph_lo = p; a.ph_hi = p + 1; hipLaunchKernelGGL(fwd, dim3(grid), dim3(NTHR), LDS_BYTES, stream, a); }
    }
}
```

```cpp
#include <hip/hip_runtime.h>
#include <cstdio>
#include <cstdint>

#ifndef N_LAUNCH_MODE
#define N_LAUNCH_MODE 1
#endif

#define GAS __attribute__((address_space(1)))
#define LAS __attribute__((address_space(3)))
typedef unsigned short bf16;
typedef float f32x4 __attribute__((ext_vector_type(4)));
typedef unsigned u32x4 __attribute__((ext_vector_type(4)));
typedef unsigned u32x2 __attribute__((ext_vector_type(2)));

constexpr int BATCH = 8, SEQ = 4096, DM = 1024, T = BATCH * SEQ, DEPTH = 2;
constexpr int D_SSM = 512, NGRP = 32, SGRP = 16, SST = 64;
constexpr int D_IN = 1816, NINP = 2048, ZP = 1536;
constexpr int ZC_U = 0, ZC_Q = 0, ZC_KV = 512, ZC_G = 1280;
constexpr int NCMP = 255, NCMPP = 256;
constexpr float EPS = 1e-6f;
constexpr int NWAVES = 8, NTHR = 512;
constexpr float QSCALE = 0.125f * 1.4426950408889634f;

constexpr size_t MiB = 1u << 20;
constexpr size_t WS_CTL = 0, CTL_ZERO_BYTES = 1 * MiB;
constexpr size_t WS_KC = 1 * MiB, WS_VC = 2 * MiB, WS_ROUTE = 3 * MiB;
constexpr size_t WS_HIDC = 4 * MiB;
constexpr size_t WS_CBIAS = 5 * MiB;
constexpr size_t WS_W2T = 6 * MiB;
constexpr size_t WS_W1T = 8 * MiB;
constexpr size_t WS_HN = 16 * MiB;
constexpr size_t WS_Z = 80 * MiB;
constexpr size_t WS_XB = 176 * MiB;
constexpr size_t WS_YC = 240 * MiB;
constexpr size_t WS_G1 = 304 * MiB;
constexpr size_t WS_WIN = 336 * MiB;
constexpr size_t WS_WGLU = 344 * MiB;
constexpr size_t WS_WOUT = 346 * MiB;
constexpr size_t WS_WGU = 350 * MiB;
constexpr size_t WS_WDN = 414 * MiB;
constexpr size_t WS_LIST = 446 * MiB;
constexpr size_t WS_LISTW = 450 * MiB;
constexpr size_t WS_HID = 454 * MiB;
constexpr size_t WS_P2 = WS_Z;
constexpr size_t WS_USSM = WS_YC;
constexpr size_t WS_XL = WS_HID;
constexpr size_t WS_BT1 = 490 * MiB;
constexpr size_t WS_BT2 = 498 * MiB;
constexpr size_t WS_END = 510 * MiB;
constexpr int LCAP = 32768, CW_CNT = 8192;
constexpr int CW_BAR = 4096;

constexpr int LDS_BYTES = 163840;
constexpr int ETAB_OFF = LDS_BYTES - 1024, MISC_OFF = LDS_BYTES - 512;

__device__ __forceinline__ float bf2f(bf16 v) { return __uint_as_float(((unsigned)v) << 16); }
__device__ __forceinline__ unsigned f2bf(float f) { unsigned u = __float_as_uint(f); return (u + 0x7fffu + ((u >> 16) & 1u)) >> 16; }
__device__ __forceinline__ unsigned pk2(float lo, float hi) { return f2bf(lo) | (f2bf(hi) << 16); }
__device__ __forceinline__ float wave_sum(float v, int) {
    v += __builtin_bit_cast(float, __builtin_amdgcn_update_dpp(0, __builtin_bit_cast(int, v), 0xB1, 0xF, 0xF, true));
    v += __builtin_bit_cast(float, __builtin_amdgcn_update_dpp(0, __builtin_bit_cast(int, v), 0x4E, 0xF, 0xF, true));
    v += __builtin_bit_cast(float, __builtin_amdgcn_update_dpp(0, __builtin_bit_cast(int, v), 0x141, 0xF, 0xF, true));
    v += __builtin_bit_cast(float, __builtin_amdgcn_update_dpp(0, __builtin_bit_cast(int, v), 0x140, 0xF, 0xF, true));
    const int iv = __builtin_bit_cast(int, v);
    const float s0 = __builtin_bit_cast(float, __builtin_amdgcn_readlane(iv, 0)), s1 = __builtin_bit_cast(float, __builtin_amdgcn_readlane(iv, 16));
    const float s2 = __builtin_bit_cast(float, __builtin_amdgcn_readlane(iv, 32)), s3 = __builtin_bit_cast(float, __builtin_amdgcn_readlane(iv, 48));
    return (s0 + s1) + (s2 + s3);
}
__device__ __forceinline__ float wave_max(float v, int lane) {
#pragma unroll
    for (int o = 1; o < 64; o <<= 1) v = fmaxf(v, __int_as_float(__builtin_amdgcn_ds_bpermute((lane ^ o) << 2, __float_as_int(v))));
    return v;
}
__device__ __forceinline__ float lane_bcast(float v, int src) { return __int_as_float(__builtin_amdgcn_ds_bpermute(src << 2, __float_as_int(v))); }
__device__ __forceinline__ float gelu_tanh(float x) {
    const float u = 0.7978845608028654f * (x + 0.044715f * x * x * x);
    return 0.5f * x * (1.0f + tanhf(u));
}
__device__ __forceinline__ float sigmoidf_(float x) { return 1.0f / (1.0f + __expf(-x)); }
__device__ __forceinline__ int t5_bucket(int n) {
    if (n < 16) return n < 0 ? 0 : n;
    int b = 16;
    b += (n >= 19); b += (n >= 21); b += (n >= 24); b += (n >= 27); b += (n >= 31); b += (n >= 35); b += (n >= 40); b += (n >= 46);
    b += (n >= 52); b += (n >= 59); b += (n >= 67); b += (n >= 77); b += (n >= 87); b += (n >= 99); b += (n >= 113);
    return b;
}

#define XB_TMO      128
#define XB_XCNT(j)  (256  + 64 * (j))
#define XB_XSUB(j)  (1280 + 64 * (j))
#define XB_XGEN(j)  (2304 + 64 * (j))
#define XB_TOP      3328
#define XB_TOPGEN   3392
#define XCD_BAR_WORDS 3456
#define XB_SPIN_CAP (1u << 22)

__device__ __forceinline__ unsigned xb_ld(unsigned* p)              { return __hip_atomic_load(p, __ATOMIC_RELAXED, __HIP_MEMORY_SCOPE_AGENT); }
__device__ __forceinline__ unsigned xb_add(unsigned* p, unsigned v) { return __hip_atomic_fetch_add(p, v, __ATOMIC_RELAXED, __HIP_MEMORY_SCOPE_AGENT); }
__device__ __forceinline__ unsigned xb_xcc_id() { return (unsigned)__builtin_amdgcn_s_getreg((3 << 11) | 20) & 0xFu; }
#define XB_SPIN(cond, bar) do { unsigned _sp = 0; while (cond) { __builtin_amdgcn_s_sleep(1); \
    if ((++_sp & 255u) == 0u) { if (xb_ld(&(bar)[XB_TMO])) break; if (_sp > XB_SPIN_CAP) { atomicAdd(&(bar)[XB_TMO], 1u); break; } } } } while (0)

struct XcdBarrier { unsigned* bar; unsigned x; volatile LAS unsigned* st; };

__device__ __forceinline__ XcdBarrier xcd_barrier_post(unsigned* bar, volatile LAS unsigned* st) {
    XcdBarrier b; b.bar = bar; b.x = xb_xcc_id(); b.st = st;
    if (threadIdx.x == 0) (void)xb_add(&bar[XB_XCNT(b.x)], 1u);
    return b;
}
__device__ __forceinline__ void xcd_barrier_complete(unsigned* bar, unsigned x, unsigned& nloc, unsigned& nx) {
    const unsigned G = gridDim.x * gridDim.y * gridDim.z;
    unsigned sum, cnt, mine, sp = 0u;
    for (;;) {
        sum = 0u; cnt = 0u; mine = 0u;
#pragma unroll
        for (unsigned j = 0; j < 16; ++j) { const unsigned c = xb_ld(&bar[XB_XCNT(j)]); sum += c; cnt += (c > 0u) ? 1u : 0u; mine = (j == x) ? c : mine; }
        if (sum == G) break;
        __builtin_amdgcn_s_sleep(1);
        if ((++sp & 255u) == 0u) { if (xb_ld(&bar[XB_TMO])) break; if (sp > XB_SPIN_CAP) { atomicAdd(&bar[XB_TMO], 1u); break; } }
    }
    nloc = mine > 0u ? mine : 1u; nx = cnt > 0u ? cnt : 1u;
}
__device__ __forceinline__ void xcd_barrier(const XcdBarrier& b, const int tid) {
    asm volatile("s_waitcnt vmcnt(0)" ::: "memory");
    __syncthreads();
    if (tid == 0) {
        unsigned* bar = b.bar;
        __builtin_amdgcn_s_waitcnt(0);
        unsigned nloc = b.st[0], nx = b.st[1];
        if (nloc == 0u) { xcd_barrier_complete(bar, b.x, nloc, nx); b.st[0] = nloc; b.st[1] = nx; }
        const unsigned old = xb_add(&bar[XB_XSUB(b.x)], 1u);
        const unsigned gen = old / nloc;
        if (old + 1u == (gen + 1u) * nloc) {
            __builtin_amdgcn_fence(__ATOMIC_RELEASE, "agent");
            asm volatile("s_waitcnt vmcnt(0)" ::: "memory");
            const unsigned og = xb_add(&bar[XB_TOP], 1u);
            const unsigned tg = og / nx;
            if (og + 1u == (tg + 1u) * nx) xb_add(&bar[XB_TOPGEN], 1u);
            else XB_SPIN(xb_ld(&bar[XB_TOPGEN]) == tg, bar);
            __builtin_amdgcn_fence(__ATOMIC_ACQUIRE, "agent");
            xb_add(&bar[XB_XGEN(b.x)], 1u);
            asm volatile("s_waitcnt vmcnt(0)" ::: "memory");
        } else {
            XB_SPIN(xb_ld(&bar[XB_XGEN(b.x)]) == gen, bar);
            __builtin_amdgcn_fence(__ATOMIC_ACQUIRE, "agent");
            asm volatile("s_waitcnt vmcnt(0)" ::: "memory");
        }
    }
    __syncthreads();
}

namespace pg8 {
#define PG8_LAS __attribute__((address_space(3)))
typedef unsigned short bf16_t;
typedef short bf16x8 __attribute__((ext_vector_type(8)));
typedef float f32x4 __attribute__((ext_vector_type(4)));
typedef unsigned u32x4 __attribute__((ext_vector_type(4)));
constexpr int BM = 256, BK = 64, HALF = 128, HTB = HALF * BK * 2  , STAGE_BYTES = 8 * HTB, NXCD = 8, WGM = 8;

__host__ __device__ __forceinline__ int lds_byte(int r, int c) { const int st = (r >> 4) * 2 + (c >> 5), rr = r & 15, cc = c & 31, ob = rr * 64 + cc * 2; return st * 1024 + (ob ^ (((ob >> 9) & 1) << 5)); }
__host__ __device__ __forceinline__ void stage_rc(int b, int& R, int& C) { const int st = b / 1024, sb = b % 1024, swz = sb ^ (((sb >> 9) & 1) << 5); R = (st >> 1) * 16 + swz / 64; C = (st & 1) * 32 + (swz % 64) / 2; }
__host__ __device__ __forceinline__ int perm32(int rho) { const int n = rho >> 4, i = rho & 15; return 8 * (i >> 2) + 4 * n + (i & 3); }

struct Unit { int pm, pn, eb, p0, cnt; };
struct Gemm { const bf16_t* A; const bf16_t* Bt; int M, N, K; int lda; size_t bstride; const unsigned* list; int cap; size_t astride; int kstepA; };

struct StaticOrder {
    int nM, nN, nwg, G, c;
    __host__ __device__ void init(int M, int N, int G_, int c_) { nM = M / BM; nN = N / BM; nwg = nM * nN; G = G_; c = c_; }
    __host__ __device__ bool next(int i, Unit& u) const {
        const long L = (long)i * G + c; if (L >= nwg) return false;
        int wgid = (int)L; { const int q = nwg / NXCD, r = nwg % NXCD, xcd = wgid % NXCD, off = wgid / NXCD; wgid = (xcd < r ? xcd * (q + 1) : r * (q + 1) + (xcd - r) * q) + off; }
        const int nig = WGM * nN, gid = wgid / nig, fm = gid * WGM, gsz = (nM - fm) < WGM ? (nM - fm) : WGM;
        u.pm = fm + ((wgid % nig) % gsz); u.pn = (wgid % nig) / gsz; u.eb = 0; u.p0 = 0; u.cnt = 0; return true;
    }
    __device__ __forceinline__ void a_ready(const Unit&) const {}
    __device__ __forceinline__ void done(const Unit&) const {}
};

__device__ __forceinline__ unsigned cvt_pk_bf16(float lo, float hi) { unsigned r; asm volatile("v_cvt_pk_bf16_f32 %0, %1, %2" : "=v"(r) : "v"(lo), "v"(hi)); return r; }
typedef float f32x2 __attribute__((ext_vector_type(2)));
__device__ __forceinline__ f32x2 gelu_pk(f32x2 v) {
    const f32x2 av = __builtin_elementwise_abs(v), d = av * 0.2316418882f + 1.0f;
    f32x2 t; t.x = __builtin_amdgcn_rcpf(d.x); t.y = __builtin_amdgcn_rcpf(d.y);
    f32x2 q = t * 0.5307027145f + (-0.7265760135f); q = q * t + 0.7107068705f; q = q * t + (-0.142248368f); q = q * t + 0.127414796f; q = q * t;
    const f32x2 s = (v * v) * (-0.72134752044f);
    f32x2 e; e.x = __builtin_amdgcn_exp2f(s.x); e.y = __builtin_amdgcn_exp2f(s.y);
    const f32x2 m = v * (q * e), r = v - m;
    f32x2 o; o.x = v.x < 0.f ? m.x : r.x; o.y = v.y < 0.f ? m.y : r.y; return o;
}

template <int ACT  > struct EpiBf16 {
    static constexpr bool PERM = true, AFTER_DRAIN = false; static_assert(ACT == 0 || ACT == 1, "EpiBf16: ACT is 0 (none) or 1 (gelu_pk)");
    bf16_t* O; int ldc; const float* bias; int split_cols; size_t split_stride; float scale0;
    __device__ __forceinline__ void operator()(const f32x4 (&acc)[2][2][4][2], const Unit& u, int wr, int wc, int fr, int fq) const {
        const int row0 = u.pm * BM + wr * 64 + fr; int colt = u.pn * BM; bf16_t* base = O;
        float sc = 1.f; if (split_cols) { const int t = colt / split_cols; base += (size_t)t * split_stride; colt -= t * split_cols; if (t == 0) sc = scale0; }
        const int col0 = colt + wc * 32 + 8 * fq, bcol0 = u.pn * BM + wc * 32 + 8 * fq;
        f32x4 bv[2][2];
#pragma unroll
        for (int bj = 0; bj < 2; ++bj)
#pragma unroll
            for (int n = 0; n < 2; ++n) bv[bj][n] = bias ? *(const f32x4*)(bias + bcol0 + bj * HALF + 4 * n) : (f32x4){0.f, 0.f, 0.f, 0.f};
#pragma unroll
        for (int ai = 0; ai < 2; ++ai)
#pragma unroll
            for (int m = 0; m < 4; ++m) { bf16_t* rowp = base + (size_t)(row0 + ai * HALF + m * 16) * ldc + col0;
#pragma unroll
                for (int bj = 0; bj < 2; ++bj) { f32x4 v0 = acc[ai][bj][m][0] + bv[bj][0], v1 = acc[ai][bj][m][1] + bv[bj][1];
                    if (ACT == 1) { f32x2 a = gelu_pk((f32x2){v0[0], v0[1]}), b = gelu_pk((f32x2){v0[2], v0[3]}), c = gelu_pk((f32x2){v1[0], v1[1]}), d = gelu_pk((f32x2){v1[2], v1[3]});
                        v0 = (f32x4){a.x, a.y, b.x, b.y}; v1 = (f32x4){c.x, c.y, d.x, d.y}; }
                    v0 = v0 * sc; v1 = v1 * sc; u32x4 w; w.x = cvt_pk_bf16(v0[0], v0[1]); w.y = cvt_pk_bf16(v0[2], v0[3]); w.z = cvt_pk_bf16(v1[0], v1[1]); w.w = cvt_pk_bf16(v1[2], v1[3]);
                    *(u32x4*)(rowp + bj * HALF) = w; } }
    }
};
template <class Epi, class Sched, bool ALIGN_EPI = false, bool SP2 = false>
__device__ __forceinline__ void gemm_phase(PG8_LAS unsigned char* lds, const Gemm g, const Sched& S, const Epi& E) {
    int tid_ = threadIdx.x; asm volatile("" : "+v"(tid_));
    const int tid = tid_, wid = __builtin_amdgcn_readfirstlane(tid >> 6), lane = tid & 63, wr = wid >> 2, wc = wid & 3, fr = lane & 15, fq = lane >> 4;
    const int K = g.K, nt = K / BK;
    unsigned voffA[2], voffB[2];
#pragma unroll
    for (int i = 0; i < 2; ++i) { int R, C; stage_rc(tid * 16 + i * 8192, R, C); const int Rb = Epi::PERM ? ((R & ~31) + perm32(R & 31)) : R;
        voffA[i] = (unsigned)(R * K + C) * 2u; voffB[i] = (unsigned)(Rb * K + C) * 2u; }
    const size_t kstep = (size_t)(BK * 2);
    const size_t hstep = (size_t)HALF * K * 2;
    const size_t tstep = 2 * hstep;
    const unsigned ldsw = (unsigned)wid * 1024u;
    const int aoff = lds_byte(wr * 64 + fr, fq * 8), boff = lds_byte(wc * 32 + fr, fq * 8);
#define PG8_SA(b, h) (((b) * 2 + (h)) * HTB)
#define PG8_SB(b, h) ((4 + (b) * 2 + (h)) * HTB)
#define PG8_STAGE(bufoff, gbase, voff) do { _Pragma("unroll") for (int _i = 0; _i < 2; ++_i) \
        __builtin_amdgcn_global_load_lds((const unsigned*)((const char*)(gbase) + (voff)[_i]), (PG8_LAS unsigned*)(lds + (bufoff) + ldsw + _i * 8192), 16, 0, 0); } while (0)
#define PG8_LDA(dst, b, h) do { _Pragma("unroll") for (int m = 0; m < 4; ++m) _Pragma("unroll") for (int k = 0; k < 2; ++k) dst[m][k] = *(const PG8_LAS bf16x8*)(lds + PG8_SA(b, h) + aoff + m * 2048 + k * 1024); } while (0)
#define PG8_LDB(dst, b, h) do { _Pragma("unroll") for (int n = 0; n < 2; ++n) _Pragma("unroll") for (int k = 0; k < 2; ++k) dst[n][k] = *(const PG8_LAS bf16x8*)(lds + PG8_SB(b, h) + boff + n * 2048 + k * 1024); } while (0)
#define PG8_MMA(ai, bj, At, Bt) do { __builtin_amdgcn_s_setprio(1); _Pragma("unroll") for (int m = 0; m < 4; ++m) _Pragma("unroll") for (int n = 0; n < 2; ++n) _Pragma("unroll") for (int k = 0; k < 2; ++k) \
        acc[ai][bj][m][n] = __builtin_amdgcn_mfma_f32_16x16x32_bf16(Bt[n][k], At[m][k], acc[ai][bj][m][n], 0, 0, 0); __builtin_amdgcn_s_setprio(0); } while (0)
#define PG8_WAIT_V(n) asm volatile("s_waitcnt vmcnt(" #n ")" ::: "memory")
#define PG8_WAIT_L(n) asm volatile("s_waitcnt lgkmcnt(" #n ")" ::: "memory")
#define PG8_BAR __builtin_amdgcn_s_barrier()
#define PG8_SCHED __builtin_amdgcn_sched_barrier(0)
    Unit cur, nxt; int ui = 0;
    if (!S.next(0, cur)) return;
    f32x4 acc[2][2][4][2];
#pragma unroll
    for (int a = 0; a < 2; ++a)
#pragma unroll
        for (int b = 0; b < 2; ++b)
#pragma unroll
            for (int m = 0; m < 4; ++m)
#pragma unroll
                for (int n = 0; n < 2; ++n) acc[a][b][m][n] = (f32x4){0.f, 0.f, 0.f, 0.f};
    bf16x8 At[4][2], B0[2][2], B1[2][2];
    const char* cA = (const char*)g.A + (size_t)cur.pm * tstep; const char* cB = (const char*)g.Bt + (size_t)cur.pn * tstep;
    S.a_ready(cur);
    if constexpr (SP2) {
        PG8_STAGE(PG8_SB(0, 0), cB, voffB); PG8_STAGE(PG8_SB(0, 1), cB + hstep, voffB); PG8_STAGE(PG8_SA(0, 0), cA, voffA); PG8_STAGE(PG8_SA(0, 1), cA + hstep, voffA);
        if (wr == 1) PG8_BAR;
        PG8_WAIT_V(2); PG8_BAR;
        PG8_STAGE(PG8_SB(1, 0), cB + kstep, voffB); PG8_STAGE(PG8_SA(1, 0), cA + kstep, voffA); PG8_STAGE(PG8_SB(1, 1), cB + hstep + kstep, voffB);
        PG8_WAIT_V(6); PG8_BAR;
    } else {
        PG8_STAGE(PG8_SB(0, 0), cB, voffB); PG8_STAGE(PG8_SA(0, 0), cA, voffA); PG8_STAGE(PG8_SB(0, 1), cB + hstep, voffB); PG8_STAGE(PG8_SA(0, 1), cA + hstep, voffA);
        if (wr == 1) PG8_BAR;
        PG8_WAIT_V(4); PG8_BAR;
        PG8_STAGE(PG8_SB(1, 0), cB + kstep, voffB); PG8_STAGE(PG8_SA(1, 0), cA + kstep, voffA); PG8_STAGE(PG8_SB(1, 1), cB + hstep + kstep, voffB);
        PG8_WAIT_V(6); PG8_BAR;
    }
    for (;;) {
        const bool has_next = S.next(ui + 1, nxt);
        const char* nA = has_next ? (const char*)g.A + (size_t)nxt.pm * tstep : cA; const char* nB = has_next ? (const char*)g.Bt + (size_t)nxt.pn * tstep : cB;
        for (int t = 0; t < nt; t += 2) {
            const bool last = (t == nt - 2);
            const char* a1 = cA + (size_t)(t + 1) * kstep;
            const char* a2 = last ? nA : cA + (size_t)(t + 2) * kstep; const char* b2 = last ? nB : cB + (size_t)(t + 2) * kstep;
            const char* a3 = a2 + kstep; const char* b3 = b2 + kstep;
            if (last && has_next) S.a_ready(nxt);
            if constexpr (SP2) {
            PG8_LDB(B0, 0, 0); PG8_LDB(B1, 0, 1); PG8_SCHED; PG8_LDA(At, 0, 0); PG8_STAGE(PG8_SA(1, 1), a1 + hstep, voffA);
            PG8_WAIT_V(8); PG8_WAIT_L(0); PG8_BAR; PG8_MMA(0, 0, At, B0); PG8_MMA(0, 1, At, B1); PG8_BAR; PG8_SCHED;
            PG8_LDA(At, 0, 1); PG8_STAGE(PG8_SB(0, 0), b2, voffB); PG8_STAGE(PG8_SB(0, 1), b2 + hstep, voffB); PG8_STAGE(PG8_SA(0, 0), a2, voffA);
            PG8_WAIT_V(8); PG8_WAIT_L(0); PG8_BAR; PG8_MMA(1, 0, At, B0); PG8_MMA(1, 1, At, B1); PG8_BAR; PG8_SCHED;
            PG8_LDB(B0, 1, 0); PG8_LDB(B1, 1, 1); PG8_SCHED; PG8_LDA(At, 1, 0); PG8_STAGE(PG8_SA(0, 1), a2 + hstep, voffA);
            PG8_WAIT_V(8); PG8_WAIT_L(0); PG8_BAR; PG8_MMA(0, 0, At, B0); PG8_MMA(0, 1, At, B1); PG8_BAR; PG8_SCHED;
            PG8_LDA(At, 1, 1); PG8_STAGE(PG8_SB(1, 0), b3, voffB); PG8_STAGE(PG8_SB(1, 1), b3 + hstep, voffB); PG8_STAGE(PG8_SA(1, 0), a3, voffA);
            PG8_WAIT_V(8); PG8_WAIT_L(0); PG8_BAR; PG8_MMA(1, 0, At, B0); PG8_MMA(1, 1, At, B1); PG8_BAR; PG8_SCHED;
            } else {
            PG8_LDB(B0, 0, 0); PG8_SCHED; PG8_LDA(At, 0, 0); PG8_STAGE(PG8_SA(1, 1), a1 + hstep, voffA);
            PG8_WAIT_L(8); PG8_BAR; PG8_WAIT_L(0); PG8_MMA(0, 0, At, B0); PG8_BAR; PG8_SCHED;
            PG8_LDB(B1, 0, 1); PG8_STAGE(PG8_SB(0, 0), b2, voffB);
            PG8_BAR; PG8_WAIT_L(0); PG8_MMA(0, 1, At, B1); PG8_BAR;
            PG8_LDA(At, 0, 1); PG8_STAGE(PG8_SA(0, 0), a2, voffA);
            PG8_BAR; PG8_WAIT_L(0); PG8_MMA(1, 0, At, B0); PG8_BAR; PG8_SCHED;
            PG8_STAGE(PG8_SB(0, 1), b2 + hstep, voffB);
            PG8_WAIT_V(6); PG8_BAR; PG8_MMA(1, 1, At, B1); PG8_BAR;
            PG8_LDB(B0, 1, 0); PG8_SCHED; PG8_LDA(At, 1, 0); PG8_STAGE(PG8_SA(0, 1), a2 + hstep, voffA);
            PG8_WAIT_L(8); PG8_BAR; PG8_WAIT_L(0); PG8_MMA(0, 0, At, B0); PG8_BAR; PG8_SCHED;
            PG8_LDB(B1, 1, 1); PG8_STAGE(PG8_SB(1, 0), b3, voffB);
            PG8_BAR; PG8_WAIT_L(0); PG8_MMA(0, 1, At, B1); PG8_BAR;
            PG8_LDA(At, 1, 1); PG8_STAGE(PG8_SA(1, 0), a3, voffA);
            PG8_BAR; PG8_WAIT_L(0); PG8_MMA(1, 0, At, B0); PG8_BAR; PG8_SCHED;
            PG8_STAGE(PG8_SB(1, 1), b3 + hstep, voffB);
            PG8_WAIT_V(6); PG8_BAR; PG8_MMA(1, 1, At, B1); PG8_BAR;
            }
        }
        if constexpr (ALIGN_EPI) { if (wr == 0) PG8_BAR; }
        if constexpr (!Epi::AFTER_DRAIN) { E(acc, cur, wr, wc, fr, fq); S.done(cur); }
        if (!has_next) break;
#pragma unroll
        for (int a = 0; a < 2; ++a)
#pragma unroll
            for (int b = 0; b < 2; ++b)
#pragma unroll
                for (int m = 0; m < 4; ++m)
#pragma unroll
                    for (int n = 0; n < 2; ++n) acc[a][b][m][n] = (f32x4){0.f, 0.f, 0.f, 0.f};
        cur = nxt; cA = nA; cB = nB; ++ui;
        if constexpr (ALIGN_EPI) { if (wr == 1) PG8_BAR; }
    }
    PG8_WAIT_V(0);
    if constexpr (!ALIGN_EPI) { if (wr == 0) PG8_BAR; }
    PG8_BAR;
    if constexpr (Epi::AFTER_DRAIN) { E.fused(acc, cur, wr, wc, fr, fq, lds, wid, lane); S.done(cur); }
#undef PG8_SA
#undef PG8_SB
#undef PG8_STAGE
#undef PG8_LDA
#undef PG8_LDB
#undef PG8_MMA
#undef PG8_WAIT_V
#undef PG8_WAIT_L
#undef PG8_BAR
#undef PG8_SCHED
}

__device__ __forceinline__ float sigm(float x) { return 1.0f / (1.0f + __expf(-x)); }
struct EpiGlu {
    static constexpr bool PERM = true, AFTER_DRAIN = false;
    bf16_t* O; int ldc;
    __device__ __forceinline__ void operator()(const f32x4 (&acc)[2][2][4][2], const Unit& u, int wr, int wc, int fr, int fq) const {
        const int row0 = u.pm * BM + wr * 64 + fr, col0 = u.pn * HALF + wc * 32 + 8 * fq;
#pragma unroll
        for (int ai = 0; ai < 2; ++ai)
#pragma unroll
            for (int m = 0; m < 4; ++m) {
                bf16_t* rowp = O + (size_t)(row0 + ai * HALF + m * 16) * ldc + col0;
                const f32x4 a0 = acc[ai][0][m][0], a1 = acc[ai][0][m][1], b0 = acc[ai][1][m][0], b1 = acc[ai][1][m][1];
                u32x4 w;
                w.x = cvt_pk_bf16(a0[0] * sigm(b0[0]), a0[1] * sigm(b0[1])); w.y = cvt_pk_bf16(a0[2] * sigm(b0[2]), a0[3] * sigm(b0[3]));
                w.z = cvt_pk_bf16(a1[0] * sigm(b1[0]), a1[1] * sigm(b1[1])); w.w = cvt_pk_bf16(a1[2] * sigm(b1[2]), a1[3] * sigm(b1[3]));
                *(u32x4*)rowp = w;
            }
    }
};
struct EpiResid {
    static constexpr bool PERM = false, AFTER_DRAIN = false;
    const float* X; float* O; int ldc;
    __device__ __forceinline__ void operator()(const f32x4 (&acc)[2][2][4][2], const Unit& u, int wr, int wc, int fr, int fq) const {
        const int row0 = u.pm * BM + wr * 64 + fr, col0 = u.pn * BM + wc * 32 + 4 * fq;
#pragma unroll
        for (int ai = 0; ai < 2; ++ai)
#pragma unroll
            for (int m = 0; m < 4; ++m) {
                const size_t off = (size_t)(row0 + ai * HALF + m * 16) * ldc + col0;
#pragma unroll
                for (int bj = 0; bj < 2; ++bj)
#pragma unroll
                    for (int n = 0; n < 2; ++n) *(f32x4*)(O + off + bj * HALF + n * 16) = *(const f32x4*)(X + off + bj * HALF + n * 16) + acc[ai][bj][m][n];
            }
    }
};
struct EpiResidB {
    static constexpr bool PERM = true, AFTER_DRAIN = false;
    const float* X32; const bf16_t* XBin; bf16_t* XBout;
    __device__ __forceinline__ void operator()(const f32x4 (&acc)[2][2][4][2], const Unit& u, int wr, int wc, int fr, int fq) const {
        const int row0 = u.pm * BM + wr * 64 + fr, col0 = u.pn * BM + wc * 32 + 8 * fq;
#pragma unroll
        for (int ai = 0; ai < 2; ++ai)
#pragma unroll
            for (int m = 0; m < 4; ++m) {
                const size_t off = (size_t)(row0 + ai * HALF + m * 16) * 1024 + col0;
#pragma unroll
                for (int bj = 0; bj < 2; ++bj) {
                    f32x4 r0, r1;
                    if (X32) { r0 = *(const f32x4*)(X32 + off + bj * HALF); r1 = *(const f32x4*)(X32 + off + bj * HALF + 4); }
                    else { const u32x4 q = *(const u32x4*)(XBin + off + bj * HALF);
                        r0 = (f32x4){__uint_as_float(q.x << 16), __uint_as_float(q.x & 0xffff0000u), __uint_as_float(q.y << 16), __uint_as_float(q.y & 0xffff0000u)};
                        r1 = (f32x4){__uint_as_float(q.z << 16), __uint_as_float(q.z & 0xffff0000u), __uint_as_float(q.w << 16), __uint_as_float(q.w & 0xffff0000u)}; }
                    const f32x4 v0 = acc[ai][bj][m][0] + r0, v1 = acc[ai][bj][m][1] + r1;
                    u32x4 w; w.x = cvt_pk_bf16(v0[0], v0[1]); w.y = cvt_pk_bf16(v0[2], v0[3]); w.z = cvt_pk_bf16(v1[0], v1[1]); w.w = cvt_pk_bf16(v1[2], v1[3]);
                    *(u32x4*)(XBout + off + bj * HALF) = w; }
                if (m & 1) asm volatile("" ::: "memory");
            }
    }
};

struct ADense { static constexpr bool GATHER = false; __device__ __forceinline__ static unsigned rowoff(const Gemm&, const Unit&, int) { return 0u; } };
struct AList { static constexpr bool GATHER = true;
    __device__ __forceinline__ static unsigned rowoff(const Gemm& g, const Unit& u, int r) { const int pos = u.p0 + r; const unsigned tok = pos < u.cnt ? (g.list[(size_t)u.eb * g.cap + pos] >> 1) : 0u; return tok * (unsigned)g.lda * 2u; } };
struct ACompress { static constexpr bool GATHER = true;
    __device__ __forceinline__ static unsigned rowoff(const Gemm&, const Unit& u, int r) { const unsigned rg = (unsigned)(u.pm * BM + r), b = rg >> 9, n = (rg >> 1) & 255u, hkv = rg & 1u;
        return (((b * 4096u + 16u * n) * 1536u) + 512u + (unsigned)u.eb * 128u + hkv * 64u) * 2u; } };
template <class Epi, class Sched, class AMap>
__device__ __forceinline__ void gemm2(PG8_LAS unsigned char* lds, const Gemm g, const Sched& S, const Epi& E, const int tid) {
    constexpr bool GATHER = AMap::GATHER;
    int K_ = g.K; asm volatile("" : "+s"(K_));
    const int wid = __builtin_amdgcn_readfirstlane(tid >> 6), lane = tid & 63, wr = wid >> 2, wc = wid & 3, fr = lane & 15, fq = lane >> 4;
    const int K = K_, nt = K / BK, lda = g.lda;
    unsigned voffA[2], voffB[2]; int Rst[2], Cst[2];
#pragma unroll
    for (int i = 0; i < 2; ++i) { int R, C; stage_rc(tid * 16 + i * 8192, R, C); const int Rb = Epi::PERM ? ((R & ~31) + perm32(R & 31)) : R;
        voffA[i] = (unsigned)(R * lda + C) * 2u; voffB[i] = (unsigned)(Rb * K + C) * 2u; Rst[i] = R; Cst[i] = C; }
    const size_t kstep = (size_t)(BK * 2), kstepA = (size_t)g.kstepA;
    const size_t hstepA = (size_t)HALF * lda * 2, tstepA = 2 * hstepA, hstepB = (size_t)HALF * K * 2, tstepB = 2 * hstepB;
    const unsigned ldsw = (unsigned)wid * 1024u;
    const int aoff = lds_byte(wr * 64 + fr, fq * 8), boff = lds_byte(wc * 32 + fr, fq * 8);
#define PG8_SA(b, h) (((b) * 2 + (h)) * HTB)
#define PG8_SB(b, h) ((4 + (b) * 2 + (h)) * HTB)
#define PG8_STAGE(bufoff, gbase, voff) do { _Pragma("unroll") for (int _i = 0; _i < 2; ++_i) \
        __builtin_amdgcn_global_load_lds((const unsigned*)((const char*)(gbase) + (voff)[_i]), (PG8_LAS unsigned*)(lds + (bufoff) + ldsw + _i * 8192), 16, 0, 0); } while (0)
#define PG8_STAGE_A(bufoff, gbase, h) do { if constexpr (GATHER) { PG8_STAGE(bufoff, gbase, vg[h]); } else { PG8_STAGE(bufoff, (gbase) + (h) * hstepA, voffA); } } while (0)
#define PG8_GOFFS(u, dst) do { _Pragma("unroll") for (int _h = 0; _h < 2; ++_h) _Pragma("unroll") for (int _i = 0; _i < 2; ++_i) dst[_h][_i] = AMap::rowoff(g, (u), _h * HALF + Rst[_i]) + (unsigned)Cst[_i] * 2u; } while (0)
#define PG8_LDA(dst, b, h) do { _Pragma("unroll") for (int m = 0; m < 4; ++m) _Pragma("unroll") for (int k = 0; k < 2; ++k) dst[m][k] = *(const PG8_LAS bf16x8*)(lds + PG8_SA(b, h) + aoff + m * 2048 + k * 1024); } while (0)
#define PG8_LDB(dst, b, h) do { _Pragma("unroll") for (int n = 0; n < 2; ++n) _Pragma("unroll") for (int k = 0; k < 2; ++k) dst[n][k] = *(const PG8_LAS bf16x8*)(lds + PG8_SB(b, h) + boff + n * 2048 + k * 1024); } while (0)
#define PG8_MMA(ai, bj, At, Bt) do { __builtin_amdgcn_s_setprio(1); _Pragma("unroll") for (int m = 0; m < 4; ++m) _Pragma("unroll") for (int n = 0; n < 2; ++n) _Pragma("unroll") for (int k = 0; k < 2; ++k) \
        acc[ai][bj][m][n] = __builtin_amdgcn_mfma_f32_16x16x32_bf16(Bt[n][k], At[m][k], acc[ai][bj][m][n], 0, 0, 0); __builtin_amdgcn_s_setprio(0); } while (0)
#define PG8_WAIT_V(n) asm volatile("s_waitcnt vmcnt(" #n ")" ::: "memory")
#define PG8_WAIT_L(n) asm volatile("s_waitcnt lgkmcnt(" #n ")" ::: "memory")
#define PG8_BAR __builtin_amdgcn_s_barrier()
#define PG8_SCHED __builtin_amdgcn_sched_barrier(0)
    Unit cur, nxt; int ui = 0;
    if (!S.next(0, cur)) return;
    f32x4 acc[2][2][4][2];
#pragma unroll
    for (int a = 0; a < 2; ++a)
#pragma unroll
        for (int b = 0; b < 2; ++b)
#pragma unroll
            for (int m = 0; m < 4; ++m)
#pragma unroll
                for (int n = 0; n < 2; ++n) acc[a][b][m][n] = (f32x4){0.f, 0.f, 0.f, 0.f};
    bf16x8 At[4][2], B0[2][2], B1[2][2];
    unsigned vg[2][2] = {{0u, 0u}, {0u, 0u}};
    if constexpr (GATHER) PG8_GOFFS(cur, vg);
    const char* cA = (const char*)g.A + (GATHER ? (size_t)0 : (size_t)cur.pm * tstepA + (size_t)cur.eb * g.astride * 2);
    const char* cB = (const char*)g.Bt + ((size_t)cur.eb * g.bstride) * 2 + (size_t)cur.pn * tstepB;
    S.a_ready(cur);
    PG8_STAGE(PG8_SB(0, 0), cB, voffB); PG8_STAGE(PG8_SB(0, 1), cB + hstepB, voffB); PG8_STAGE_A(PG8_SA(0, 0), cA, 0); PG8_STAGE_A(PG8_SA(0, 1), cA, 1);
    if (wr == 1) PG8_BAR;
    PG8_WAIT_V(2); PG8_BAR;
    PG8_STAGE(PG8_SB(1, 0), cB + kstep, voffB); PG8_STAGE_A(PG8_SA(1, 0), cA + kstepA, 0); PG8_STAGE(PG8_SB(1, 1), cB + hstepB + kstep, voffB);
    PG8_WAIT_V(6); PG8_BAR;
    for (;;) {
        const bool has_next = S.next(ui + 1, nxt);
        const char* nA = has_next ? (const char*)g.A + (GATHER ? (size_t)0 : (size_t)nxt.pm * tstepA + (size_t)nxt.eb * g.astride * 2) : cA;
        const char* nB = has_next ? (const char*)g.Bt + ((size_t)nxt.eb * g.bstride) * 2 + (size_t)nxt.pn * tstepB : cB;
        for (int t = 0; t < nt; t += 2) {
            const bool last = (t == nt - 2);
            const char* a1 = cA + (size_t)(t + 1) * kstepA;
            const char* a2 = last ? nA : cA + (size_t)(t + 2) * kstepA; const char* b2 = last ? nB : cB + (size_t)(t + 2) * kstep;
            const char* a3 = a2 + kstepA; const char* b3 = b2 + kstep;
            unsigned vn1[2] = {vg[1][0], vg[1][1]};
            if constexpr (GATHER) { if (last && has_next) { unsigned vn[2][2]; PG8_GOFFS(nxt, vn); vg[0][0] = vn[0][0]; vg[0][1] = vn[0][1]; vn1[0] = vn[1][0]; vn1[1] = vn[1][1]; } }
            if (last && has_next) S.a_ready(nxt);
            PG8_LDB(B0, 0, 0); PG8_LDB(B1, 0, 1); PG8_SCHED; PG8_LDA(At, 0, 0); PG8_STAGE_A(PG8_SA(1, 1), a1, 1);
            PG8_WAIT_V(8); PG8_WAIT_L(0); PG8_BAR; PG8_MMA(0, 0, At, B0); PG8_MMA(0, 1, At, B1); PG8_BAR; PG8_SCHED;
            if constexpr (GATHER) { vg[1][0] = vn1[0]; vg[1][1] = vn1[1]; }
            PG8_LDA(At, 0, 1); PG8_STAGE(PG8_SB(0, 0), b2, voffB); PG8_STAGE(PG8_SB(0, 1), b2 + hstepB, voffB); PG8_STAGE_A(PG8_SA(0, 0), a2, 0);
            PG8_WAIT_V(8); PG8_WAIT_L(0); PG8_BAR; PG8_MMA(1, 0, At, B0); PG8_MMA(1, 1, At, B1); PG8_BAR; PG8_SCHED;
            PG8_LDB(B0, 1, 0); PG8_LDB(B1, 1, 1); PG8_SCHED; PG8_LDA(At, 1, 0); PG8_STAGE_A(PG8_SA(0, 1), a2, 1);
            PG8_WAIT_V(8); PG8_WAIT_L(0); PG8_BAR; PG8_MMA(0, 0, At, B0); PG8_MMA(0, 1, At, B1); PG8_BAR; PG8_SCHED;
            PG8_LDA(At, 1, 1); PG8_STAGE(PG8_SB(1, 0), b3, voffB); PG8_STAGE(PG8_SB(1, 1), b3 + hstepB, voffB); PG8_STAGE_A(PG8_SA(1, 0), a3, 0);
            PG8_WAIT_V(8); PG8_WAIT_L(0); PG8_BAR; PG8_MMA(1, 0, At, B0); PG8_MMA(1, 1, At, B1); PG8_BAR; PG8_SCHED;
        }
        if (wr == 0) PG8_BAR;
        E(acc, cur, wr, wc, fr, fq); S.done(cur);
        if (!has_next) break;
#pragma unroll
        for (int a = 0; a < 2; ++a)
#pragma unroll
            for (int b = 0; b < 2; ++b)
#pragma unroll
                for (int m = 0; m < 4; ++m)
#pragma unroll
                    for (int n = 0; n < 2; ++n) acc[a][b][m][n] = (f32x4){0.f, 0.f, 0.f, 0.f};
        cur = nxt; cA = nA; cB = nB; ++ui;
        if (wr == 1) PG8_BAR;
    }
    PG8_WAIT_V(0);
    PG8_BAR;
#undef PG8_SA
#undef PG8_SB
#undef PG8_STAGE
#undef PG8_STAGE_A
#undef PG8_GOFFS
#undef PG8_LDA
#undef PG8_LDB
#undef PG8_MMA
#undef PG8_WAIT_V
#undef PG8_WAIT_L
#undef PG8_BAR
#undef PG8_SCHED
}

struct ExpertOrder {
    const PG8_LAS int* tab; int nN, G, c;
    __device__ __forceinline__ bool next(int i, Unit& u) const {
        int rt, pn, e;
        if ((G & 7) == 0) {
            const int x = c & 7, R = G >> 3, Lx = i * R + (c >> 3);
            const int n0 = (tab[x + 1] - tab[x]) * nN, n1 = (tab[x + 9] - tab[x + 8]) * nN, n2 = (tab[x + 17] - tab[x + 16]) * nN, n3 = (tab[x + 25] - tab[x + 24]) * nN;
            const int c1 = n0, c2 = n0 + n1, c3 = c2 + n2, c4 = c3 + n3;
            if (Lx >= c4) return false;
            const int k = (Lx >= c1 ? 1 : 0) + (Lx >= c2 ? 1 : 0) + (Lx >= c3 ? 1 : 0), ul = Lx - (k == 0 ? 0 : (k == 1 ? c1 : (k == 2 ? c2 : c3)));
            e = x + 8 * k; rt = tab[e] + ul / nN; pn = ul % nN;
        } else {
            const int total = tab[32] * nN; const long L = (long)i * G + c; if (L >= total) return false;
            rt = (int)L / nN; pn = (int)L % nN; e = 0;
#pragma unroll
            for (int k = 1; k < 32; ++k) e += (rt >= tab[k]) ? 1 : 0;
        }
        u.pm = __builtin_amdgcn_readfirstlane(rt); u.pn = __builtin_amdgcn_readfirstlane(pn); u.eb = __builtin_amdgcn_readfirstlane(e);
        u.p0 = __builtin_amdgcn_readfirstlane((rt - tab[e]) * BM); u.cnt = __builtin_amdgcn_readfirstlane(tab[33 + e]); return true;
    }
    __device__ __forceinline__ void a_ready(const Unit&) const {}
    __device__ __forceinline__ void done(const Unit&) const {}
};
struct EpiGateUp {
    static constexpr bool PERM = true, AFTER_DRAIN = false;
    bf16_t* H; const float* listw; int cap;
    __device__ __forceinline__ void operator()(const f32x4 (&acc)[2][2][4][2], const Unit& u, int wr, int wc, int fr, int fq) const {
        const int rl0 = wr * 64 + fr, col0 = u.pn * HALF + wc * 32 + 8 * fq;
#pragma unroll
        for (int ai = 0; ai < 2; ++ai)
#pragma unroll
            for (int m = 0; m < 4; ++m) {
                const int rl = rl0 + ai * HALF + m * 16, pos = u.p0 + rl;
                const float w = pos < u.cnt ? listw[(size_t)u.eb * cap + pos] : 0.f;
                bf16_t* rowp = H + (size_t)(u.pm * BM + rl) * 256 + col0;
                const f32x4 g0 = acc[ai][0][m][0], g1 = acc[ai][0][m][1], u0 = acc[ai][1][m][0], u1 = acc[ai][1][m][1];
                u32x4 o;
                o.x = cvt_pk_bf16(g0[0] * sigm(g0[0]) * u0[0] * w, g0[1] * sigm(g0[1]) * u0[1] * w); o.y = cvt_pk_bf16(g0[2] * sigm(g0[2]) * u0[2] * w, g0[3] * sigm(g0[3]) * u0[3] * w);
                o.z = cvt_pk_bf16(g1[0] * sigm(g1[0]) * u1[0] * w, g1[1] * sigm(g1[1]) * u1[1] * w); o.w = cvt_pk_bf16(g1[2] * sigm(g1[2]) * u1[2] * w, g1[3] * sigm(g1[3]) * u1[3] * w);
                *(u32x4*)rowp = o;
            }
    }
};
struct EpiDown {
    static constexpr bool PERM = true, AFTER_DRAIN = false;
    bf16_t* P1; long d12; const unsigned* list; int cap;
    __device__ __forceinline__ void operator()(const f32x4 (&acc)[2][2][4][2], const Unit& u, int wr, int wc, int fr, int fq) const {
        const int rl0 = wr * 64 + fr, col0 = u.pn * BM + wc * 32 + 8 * fq;
#pragma unroll
        for (int ai = 0; ai < 2; ++ai) {
            unsigned ent[4];
#pragma unroll
            for (int m = 0; m < 4; ++m) { const int pos = u.p0 + rl0 + ai * HALF + m * 16; ent[m] = pos < u.cnt ? list[(size_t)u.eb * cap + pos] : 0xffffffffu; }
#pragma unroll
            for (int m = 0; m < 4; ++m) {
                if (ent[m] != 0xffffffffu) {
                    bf16_t* dst = P1 + (long)(ent[m] & 1u) * d12 + (size_t)(ent[m] >> 1) * 1024 + col0;
#pragma unroll
                    for (int bj = 0; bj < 2; ++bj) { const f32x4 v0 = acc[ai][bj][m][0], v1 = acc[ai][bj][m][1];
                        u32x4 w; w.x = cvt_pk_bf16(v0[0], v0[1]); w.y = cvt_pk_bf16(v0[2], v0[3]); w.z = cvt_pk_bf16(v1[0], v1[1]); w.w = cvt_pk_bf16(v1[2], v1[3]);
                        *(u32x4*)(dst + bj * HALF) = w; }
                }
            }
            asm volatile("" ::: "memory");
        }
    }
};

struct BatchOrder {
    int nb, nM, nN, G, c;
    __device__ __forceinline__ bool next(int i, Unit& u) const {
        const long L = (long)i * G + c; if (L >= (long)nb * nM * nN) return false;
        const int per = nM * nN, e = (int)L / per, rem = (int)L % per;
        u.eb = e; u.pm = rem / nN; u.pn = rem % nN; u.p0 = 0; u.cnt = 0; return true;
    }
    __device__ __forceinline__ void a_ready(const Unit&) const {}
    __device__ __forceinline__ void done(const Unit&) const {}
};
struct EpiInProj {
    static constexpr bool PERM = true, AFTER_DRAIN = false;
    bf16_t* Zo; bf16_t* U;
    __device__ __forceinline__ void operator()(const f32x4 (&acc)[2][2][4][2], const Unit& u, int wr, int wc, int fr, int fq) const {
        const int row0 = u.pm * BM + wr * 64 + fr;
#pragma unroll
        for (int ai = 0; ai < 2; ++ai)
#pragma unroll
            for (int m = 0; m < 4; ++m) { const int row = row0 + ai * HALF + m * 16;
#pragma unroll
                for (int bj = 0; bj < 2; ++bj) { const int c0 = u.pn * BM + bj * HALF + wc * 32 + 8 * fq;
                    const f32x4 v0 = acc[ai][bj][m][0], v1 = acc[ai][bj][m][1];
                    u32x4 w; w.x = cvt_pk_bf16(v0[0], v0[1]); w.y = cvt_pk_bf16(v0[2], v0[3]); w.z = cvt_pk_bf16(v1[0], v1[1]); w.w = cvt_pk_bf16(v1[2], v1[3]);
                    bf16_t* dst = u.pn < 2 ? U + ((size_t)((c0 >> 4) * 2048 + (row >> 4)) * 512 + (row & 15) * 16 + (c0 & 15)) : Zo + (size_t)row * 1536 + (c0 - 512);
                    *(u32x4*)dst = w; } }
    }
};
struct EpiXloc {
    static constexpr bool PERM = false, AFTER_DRAIN = false;
    float* XL;
    __device__ __forceinline__ void operator()(const f32x4 (&acc)[2][2][4][2], const Unit& u, int wr, int wc, int fr, int fq) const {
        const int row0 = u.pm * BM + wr * 64 + fr, col0 = wc * 32 + 4 * fq;
#pragma unroll
        for (int ai = 0; ai < 2; ++ai)
#pragma unroll
            for (int m = 0; m < 4; ++m) { float* rowp = XL + ((size_t)u.eb * 2048 + row0 + ai * HALF + m * 16) * 128 + col0;
#pragma unroll
                for (int n = 0; n < 2; ++n) *(f32x4*)(rowp + n * 16) = acc[ai][0][m][n]; }
    }
};
__device__ __forceinline__ float gelu_t(float x) { const float u2 = -2.302208198f * (x + 0.044715f * x * x * x); return x * __builtin_amdgcn_rcpf(1.0f + __builtin_amdgcn_exp2f(u2)); }
struct EpiSsmOut {
    static constexpr bool PERM = true, AFTER_DRAIN = false;
    bf16_t* G;
    __device__ __forceinline__ void operator()(const f32x4 (&acc)[2][2][4][2], const Unit& u, int wr, int wc, int fr, int fq) const {
        const int row0 = u.pm * BM + wr * 64 + fr;
#pragma unroll
        for (int ai = 0; ai < 2; ++ai)
#pragma unroll
            for (int m = 0; m < 4; ++m) { const int row = row0 + ai * HALF + m * 16;
#pragma unroll
                for (int bj = 0; bj < 2; ++bj) { const int n0 = bj * HALF + wc * 32 + 8 * fq;
                    const f32x4 v0 = acc[ai][bj][m][0], v1 = acc[ai][bj][m][1];
                    u32x4 w; w.x = cvt_pk_bf16(gelu_t(v0[0]), gelu_t(v0[1])); w.y = cvt_pk_bf16(gelu_t(v0[2]), gelu_t(v0[3])); w.z = cvt_pk_bf16(gelu_t(v1[0]), gelu_t(v1[1])); w.w = cvt_pk_bf16(gelu_t(v1[2]), gelu_t(v1[3]));
                    *(u32x4*)(G + ((size_t)row * 16 + (n0 >> 4)) * 512 + u.eb * 16 + (n0 & 15)) = w; } }
    }
};

struct CmpOrder {
    int G, c;
    __device__ __forceinline__ bool next(int i, Unit& u) const { const int L = i * G + c; if (L >= 32) return false; u.eb = L >> 4; u.pm = L & 15; u.pn = 0; u.p0 = 0; u.cnt = 0; return true; }
    __device__ __forceinline__ void a_ready(const Unit&) const {}
    __device__ __forceinline__ void done(const Unit&) const {}
};
struct EpiCmpHid {
    static constexpr bool PERM = false, AFTER_DRAIN = false;
    bf16_t* HC; const float* bias;
    __device__ __forceinline__ void operator()(const f32x4 (&acc)[2][2][4][2], const Unit& u, int wr, int wc, int fr, int fq) const {
        if (wc < 2) {
            const int row0 = u.pm * BM + wr * 64 + fr, col0 = wc * 32 + 4 * fq;
#pragma unroll
            for (int n = 0; n < 2; ++n) { const f32x4 bv = *(const f32x4*)(bias + u.eb * 64 + col0 + n * 16);
#pragma unroll
                for (int ai = 0; ai < 2; ++ai)
#pragma unroll
                    for (int m = 0; m < 4; ++m) { const f32x4 v = acc[ai][0][m][n] + bv;
                        typedef unsigned u32x2_ __attribute__((ext_vector_type(2)));
                        u32x2_ w; w.x = cvt_pk_bf16(gelu_t(v[0]), gelu_t(v[1])); w.y = cvt_pk_bf16(gelu_t(v[2]), gelu_t(v[3]));
                        *(u32x2_*)(HC + ((size_t)u.eb * 4096 + row0 + ai * HALF + m * 16) * 64 + col0 + n * 16) = w; } }
        }
    }
};

struct SingleUnit {
    int eb, pm;
    __device__ __forceinline__ bool next(int i, Unit& u) const { if (i > 0) return false; u.eb = eb; u.pm = pm; u.pn = 0; u.p0 = 0; u.cnt = 0; return true; }
    __device__ __forceinline__ void a_ready(const Unit&) const {}
    __device__ __forceinline__ void done(const Unit&) const {}
};
}

struct Args { const float* in[26]; float* out; unsigned char* ws; int ph_lo, ph_hi; };

struct Frame {
    LAS unsigned char* lds;
    int tid, lane, wave, blk, G;
};

__device__ __forceinline__ f32x4 bf4(u32x2 p) { f32x4 r; r.x = __uint_as_float(p.x << 16); r.y = __uint_as_float(p.x & 0xffff0000u); r.z = __uint_as_float(p.y << 16); r.w = __uint_as_float(p.y & 0xffff0000u); return r; }
__device__ __forceinline__ void ph_norm(const Frame& F, const float* xin, const bf16* add, const bf16* add2, float* xout, const float* g, bf16* hn) {
    const int gw = F.blk * NWAVES + F.wave, NGW = F.G * NWAVES;
    f32x4 gg[4];
#pragma unroll
    for (int j = 0; j < 4; ++j) gg[j] = ((const f32x4*)g)[F.lane + 64 * j];
    f32x4 nv[4]; u32x2 na[4], nb[4];
    if (gw < T) {
#pragma unroll
        for (int j = 0; j < 4; ++j) { nv[j] = ((const f32x4*)(xin + (size_t)gw * DM))[F.lane + 64 * j];
            if (add) { na[j] = ((const u32x2*)(add + (size_t)gw * DM))[F.lane + 64 * j]; nb[j] = ((const u32x2*)(add2 + (size_t)gw * DM))[F.lane + 64 * j]; } }
    }
    for (int row = gw; row < T; row += NGW) {
        f32x4 v[4]; float s = 0.f;
#pragma unroll
        for (int j = 0; j < 4; ++j) { v[j] = nv[j]; if (add) v[j] += bf4(na[j]) + bf4(nb[j]); }
        const int nrow = row + NGW;
        if (nrow < T) {
#pragma unroll
            for (int j = 0; j < 4; ++j) { nv[j] = ((const f32x4*)(xin + (size_t)nrow * DM))[F.lane + 64 * j];
                if (add) { na[j] = ((const u32x2*)(add + (size_t)nrow * DM))[F.lane + 64 * j]; nb[j] = ((const u32x2*)(add2 + (size_t)nrow * DM))[F.lane + 64 * j]; } }
        }
#pragma unroll
        for (int j = 0; j < 4; ++j) { if (add) ((f32x4*)(xout + (size_t)row * DM))[F.lane + 64 * j] = v[j];
            s += v[j].x * v[j].x + v[j].y * v[j].y + v[j].z * v[j].z + v[j].w * v[j].w; }
        s = wave_sum(s, F.lane);
        const float r = rsqrtf(s * (1.0f / DM) + EPS);
#pragma unroll
        for (int j = 0; j < 4; ++j) {
            u32x2 o; o.x = pk2(v[j].x * r * gg[j].x, v[j].y * r * gg[j].y); o.y = pk2(v[j].z * r * gg[j].z, v[j].w * r * gg[j].w);
            *(u32x2*)(hn + (size_t)row * DM + (F.lane + 64 * j) * 4) = o;
        }
    }
}
__device__ __forceinline__ void ph_norm_b(const Frame& F, bf16* xb, const bf16* add, const bf16* add2, const float* g, bf16* hn) {
    const int gw = F.blk * NWAVES + F.wave, NGW = F.G * NWAVES;
    f32x4 gg[4];
#pragma unroll
    for (int j = 0; j < 4; ++j) gg[j] = ((const f32x4*)g)[F.lane + 64 * j];
    u32x2 nx[4], na[4], nb[4];
    if (gw < T) {
#pragma unroll
        for (int j = 0; j < 4; ++j) { nx[j] = ((const u32x2*)(xb + (size_t)gw * DM))[F.lane + 64 * j]; na[j] = ((const u32x2*)(add + (size_t)gw * DM))[F.lane + 64 * j]; nb[j] = ((const u32x2*)(add2 + (size_t)gw * DM))[F.lane + 64 * j]; }
    }
    for (int row = gw; row < T; row += NGW) {
        f32x4 v[4]; float s = 0.f;
#pragma unroll
        for (int j = 0; j < 4; ++j) v[j] = bf4(nx[j]) + bf4(na[j]) + bf4(nb[j]);
        const int nrow = row + NGW;
        if (nrow < T) {
#pragma unroll
            for (int j = 0; j < 4; ++j) { nx[j] = ((const u32x2*)(xb + (size_t)nrow * DM))[F.lane + 64 * j]; na[j] = ((const u32x2*)(add + (size_t)nrow * DM))[F.lane + 64 * j]; nb[j] = ((const u32x2*)(add2 + (size_t)nrow * DM))[F.lane + 64 * j]; }
        }
#pragma unroll
        for (int j = 0; j < 4; ++j) { u32x2 o; o.x = pk2(v[j].x, v[j].y); o.y = pk2(v[j].z, v[j].w); ((u32x2*)(xb + (size_t)row * DM))[F.lane + 64 * j] = o;
            s += v[j].x * v[j].x + v[j].y * v[j].y + v[j].z * v[j].z + v[j].w * v[j].w; }
        s = wave_sum(s, F.lane);
        const float r = rsqrtf(s * (1.0f / DM) + EPS);
#pragma unroll
        for (int j = 0; j < 4; ++j) {
            u32x2 o; o.x = pk2(v[j].x * r * gg[j].x, v[j].y * r * gg[j].y); o.y = pk2(v[j].z * r * gg[j].z, v[j].w * r * gg[j].w);
            *(u32x2*)(hn + (size_t)row * DM + (F.lane + 64 * j) * 4) = o;
        }
    }
}
__device__ __forceinline__ void ph_final_norm(const Frame& F, float* out, const bf16* xb, const bf16* add, const bf16* add2, const float* g) {
    const int gw = F.blk * NWAVES + F.wave, NGW = F.G * NWAVES;
    f32x4 gg[4];
#pragma unroll
    for (int j = 0; j < 4; ++j) gg[j] = ((const f32x4*)g)[F.lane + 64 * j];
    u32x2 nx[4], na[4], nb[4];
    if (gw < T) {
#pragma unroll
        for (int j = 0; j < 4; ++j) { nx[j] = ((const u32x2*)(xb + (size_t)gw * DM))[F.lane + 64 * j]; na[j] = ((const u32x2*)(add + (size_t)gw * DM))[F.lane + 64 * j]; nb[j] = ((const u32x2*)(add2 + (size_t)gw * DM))[F.lane + 64 * j]; }
    }
    for (int row = gw; row < T; row += NGW) {
        f32x4 v[4]; float s = 0.f;
#pragma unroll
        for (int j = 0; j < 4; ++j) { v[j] = bf4(nx[j]) + bf4(na[j]) + bf4(nb[j]); s += v[j].x * v[j].x + v[j].y * v[j].y + v[j].z * v[j].z + v[j].w * v[j].w; }
        const int nrow = row + NGW;
        if (nrow < T) {
#pragma unroll
            for (int j = 0; j < 4; ++j) { nx[j] = ((const u32x2*)(xb + (size_t)nrow * DM))[F.lane + 64 * j]; na[j] = ((const u32x2*)(add + (size_t)nrow * DM))[F.lane + 64 * j]; nb[j] = ((const u32x2*)(add2 + (size_t)nrow * DM))[F.lane + 64 * j]; }
        }
        s = wave_sum(s, F.lane);
        const float r = rsqrtf(s * (1.0f / DM) + EPS);
#pragma unroll
        for (int j = 0; j < 4; ++j) {
            f32x4 o; o.x = v[j].x * r * gg[j].x; o.y = v[j].y * r * gg[j].y; o.z = v[j].z * r * gg[j].z; o.w = v[j].w * r * gg[j].w;
            ((f32x4*)(out + (size_t)row * DM))[F.lane + 64 * j] = o;
        }
    }
}

template <bool DUAL, class Epi>
__device__ __forceinline__ void sgemm_naive(const Frame& F, const bf16* A, int lda, const float* B, int ldb, int M, int N, int K, int dualoff, const Epi& epi) {
    LAS float* As = (LAS float*)F.lds;
    LAS float* Bs = As + 16 * 132;
    LAS float* Bs2 = Bs + 16 * 128;
    const int tiles_n = (N + 127) / 128, tiles_m = M / 128;
    const int tx = F.tid & 31, ty = F.tid >> 5;
    for (int tile = F.blk; tile < tiles_m * tiles_n; tile += F.G) {
        const int tm = tile / tiles_n, tn = tile % tiles_n;
        float acc[8][4], acc2[8][4];
#pragma unroll
        for (int i = 0; i < 8; ++i)
#pragma unroll
            for (int j = 0; j < 4; ++j) { acc[i][j] = 0.f; acc2[i][j] = 0.f; }
        const int arow = F.tid >> 2, akq = (F.tid & 3) * 4;
        const int bk = F.tid >> 5, bn = (F.tid & 31) * 4;
        for (int k0 = 0; k0 < K; k0 += 16) {
            {
                const u32x2 av = *(const u32x2*)(A + (size_t)(tm * 128 + arow) * lda + k0 + akq);
                As[(akq + 0) * 132 + arow] = __uint_as_float(av.x << 16);
                As[(akq + 1) * 132 + arow] = __uint_as_float(av.x & 0xffff0000u);
                As[(akq + 2) * 132 + arow] = __uint_as_float(av.y << 16);
                As[(akq + 3) * 132 + arow] = __uint_as_float(av.y & 0xffff0000u);
                const int col = tn * 128 + bn;
                f32x4 bv = (f32x4){0.f, 0.f, 0.f, 0.f};
                const float* bp = B + (size_t)(k0 + bk) * ldb + col;
                if (col + 3 < N) { bv.x = bp[0]; bv.y = bp[1]; bv.z = bp[2]; bv.w = bp[3]; }
                else { if (col < N) bv.x = bp[0]; if (col + 1 < N) bv.y = bp[1]; if (col + 2 < N) bv.z = bp[2]; }
                *(LAS f32x4*)(Bs + bk * 128 + bn) = bv;
                if (DUAL) {
                    const float* bp2 = bp + dualoff;
                    f32x4 bw; bw.x = bp2[0]; bw.y = bp2[1]; bw.z = bp2[2]; bw.w = bp2[3];
                    *(LAS f32x4*)(Bs2 + bk * 128 + bn) = bw;
                }
            }
            __syncthreads();
#pragma unroll 4
            for (int k = 0; k < 16; ++k) {
                float a[8];
                const f32x4 a0 = *(const LAS f32x4*)(As + k * 132 + ty * 8), a1 = *(const LAS f32x4*)(As + k * 132 + ty * 8 + 4);
                a[0] = a0.x; a[1] = a0.y; a[2] = a0.z; a[3] = a0.w; a[4] = a1.x; a[5] = a1.y; a[6] = a1.z; a[7] = a1.w;
                const f32x4 b = *(const LAS f32x4*)(Bs + k * 128 + tx * 4);
#pragma unroll
                for (int i = 0; i < 8; ++i) { acc[i][0] += a[i] * b.x; acc[i][1] += a[i] * b.y; acc[i][2] += a[i] * b.z; acc[i][3] += a[i] * b.w; }
                if (DUAL) {
                    const f32x4 b2 = *(const LAS f32x4*)(Bs2 + k * 128 + tx * 4);
#pragma unroll
                    for (int i = 0; i < 8; ++i) { acc2[i][0] += a[i] * b2.x; acc2[i][1] += a[i] * b2.y; acc2[i][2] += a[i] * b2.z; acc2[i][3] += a[i] * b2.w; }
                }
            }
            __syncthreads();
        }
#pragma unroll
        for (int i = 0; i < 8; ++i)
#pragma unroll
            for (int j = 0; j < 4; ++j) {
                const int row = tm * 128 + ty * 8 + i, col = tn * 128 + tx * 4 + j;
                if (col < N) epi(row, col, acc[i][j], acc2[i][j]);
            }
    }
}
struct EpiStoreBf16 { bf16* O; int ldo; __device__ __forceinline__ void operator()(int r, int c, float a, float) const { O[(size_t)r * ldo + c] = (bf16)f2bf(a); } };
struct EpiGlu { bf16* O; int ldo; __device__ __forceinline__ void operator()(int r, int c, float a, float b) const { O[(size_t)r * ldo + c] = (bf16)f2bf(a * sigmoidf_(b)); } };
struct EpiResid { const float* X; float* O; __device__ __forceinline__ void operator()(int r, int c, float a, float) const { O[(size_t)r * DM + c] = X[(size_t)r * DM + c] + a; } };

__device__ __forceinline__ void ssm_naive_item(int b, int g, const float* a_re, const float* a_im, const float* b_re, const float* b_im, const float* c_re, const float* c_im,
                                               const float* dpar, const float* log_dt, const bf16* Z, bf16* G1, int lane) {
    const int p = lane;
    const float are = a_re[g * 64 + p], aim = a_im[g * 64 + p], dt = expf(log_dt[g]);
    const float er = expf(are * dt), lbr = er * cosf(aim * dt), lbi = er * sinf(aim * dt);
    const float xx = lbr - 1.0f, yy = lbi, den = are * are + aim * aim;
    const float fr = (xx * are + yy * aim) / den, fi = (yy * are - xx * aim) / den;
    float bbr[16], bbi[16], cr[16], ci[16];
#pragma unroll
    for (int h = 0; h < 16; ++h) {
        const float br = b_re[(g * 64 + p) * 16 + h], bi = b_im[(g * 64 + p) * 16 + h];
        bbr[h] = fr * br - fi * bi; bbi[h] = fr * bi + fi * br;
        cr[h] = c_re[(g * 16 + h) * 64 + p]; ci[h] = c_im[(g * 16 + h) * 64 + p];
    }
    const float dd = dpar[g * 16 + (lane & 15)];
    float xr = 0.f, xi = 0.f;
    for (int t = 0; t < SEQ; ++t) {
        const size_t row = (size_t)b * SEQ + t;
        const u32x4 u0 = *(const u32x4*)(Z + row * ZP + ZC_U + g * 16), u1 = *(const u32x4*)(Z + row * ZP + ZC_U + g * 16 + 8);
        float u[16];
        u[0] = __uint_as_float(u0.x << 16); u[1] = __uint_as_float(u0.x & 0xffff0000u); u[2] = __uint_as_float(u0.y << 16); u[3] = __uint_as_float(u0.y & 0xffff0000u);
        u[4] = __uint_as_float(u0.z << 16); u[5] = __uint_as_float(u0.z & 0xffff0000u); u[6] = __uint_as_float(u0.w << 16); u[7] = __uint_as_float(u0.w & 0xffff0000u);
        u[8] = __uint_as_float(u1.x << 16); u[9] = __uint_as_float(u1.x & 0xffff0000u); u[10] = __uint_as_float(u1.y << 16); u[11] = __uint_as_float(u1.y & 0xffff0000u);
        u[12] = __uint_as_float(u1.z << 16); u[13] = __uint_as_float(u1.z & 0xffff0000u); u[14] = __uint_as_float(u1.w << 16); u[15] = __uint_as_float(u1.w & 0xffff0000u);
        float bur = 0.f, bui = 0.f;
#pragma unroll
        for (int h = 0; h < 16; ++h) { bur += bbr[h] * u[h]; bui += bbi[h] * u[h]; }
        const float nxr = lbr * xr - lbi * xi + bur, nxi = lbr * xi + lbi * xr + bui;
        xr = nxr; xi = nxi;
        float y = 0.f;
#pragma unroll
        for (int h = 0; h < 16; ++h) { const float v = wave_sum(cr[h] * xr - ci[h] * xi, lane); if (lane == h) y = v; }
        if (lane < 16) {
            const float ul = bf2f(Z[row * ZP + ZC_U + g * 16 + lane]);
            G1[row * D_SSM + g * 16 + lane] = (bf16)f2bf(gelu_tanh(y + dd * ul));
        }
    }
}
__device__ __forceinline__ void compress_naive_item(int item, const bf16* Z, const float* pos, const float* w1, const float* w2, bf16* KC, bf16* VC, int lane) {
    const int i = item & 1, hkv = (item >> 1) & 1, n = (item >> 2) % NCMPP, b = (item >> 2) / NCMPP;
    bf16* dst = i ? VC : KC;
    if (n == NCMP) { dst[(((size_t)b * NCMPP + n) * 2 + hkv) * 64 + lane] = 0; return; }
    const float* posi = pos + i * 32 * 64; const float* w1i = w1 + (size_t)i * 32 * 64 * 64; const float* w2i = w2 + i * 64 * 64;
    float acc = 0.f;
    for (int l = 0; l < 32; ++l) {
        const bf16* zr = Z + ((size_t)b * SEQ + 16 * n + l) * ZP + ZC_KV + i * 128 + hkv * 64;
        for (int d = 0; d < 64; ++d) acc += (bf2f(zr[d]) + posi[l * 64 + d]) * w1i[(l * 64 + d) * 64 + lane];
    }
    const float hid = gelu_tanh(acc);
    float o = 0.f;
    for (int e = 0; e < 64; ++e) o += lane_bcast(hid, e) * w2i[e * 64 + lane];
    dst[(((size_t)b * NCMPP + n) * 2 + hkv) * 64 + lane] = (bf16)f2bf(o);
}

__device__ __forceinline__ void attn_chunk(LAS float* wl, const bf16* Z, const float* rel_bias, int b, int hkv, int t, int base, int kcol, int vcol, int lane,
                                           float (&m)[4], float (&l)[4], float (&o)[4]) {
    const int pos = base + lane; const bool valid = (pos >= 0) && (pos <= t);
    const int posc = pos < 0 ? 0 : (pos > SEQ - 1 ? SEQ - 1 : pos);
    const bf16* kr = Z + ((size_t)b * SEQ + posc) * ZP + kcol + hkv * 64;
    float s[4] = {0.f, 0.f, 0.f, 0.f};
#pragma unroll 2
    for (int c = 0; c < 8; ++c) {
        const u32x4 kv = *(const u32x4*)(kr + c * 8);
        float k[8];
        k[0] = __uint_as_float(kv.x << 16); k[1] = __uint_as_float(kv.x & 0xffff0000u); k[2] = __uint_as_float(kv.y << 16); k[3] = __uint_as_float(kv.y & 0xffff0000u);
        k[4] = __uint_as_float(kv.z << 16); k[5] = __uint_as_float(kv.z & 0xffff0000u); k[6] = __uint_as_float(kv.w << 16); k[7] = __uint_as_float(kv.w & 0xffff0000u);
#pragma unroll
        for (int g = 0; g < 4; ++g) {
            const f32x4 q0 = *(const LAS f32x4*)(wl + g * 64 + c * 8), q1 = *(const LAS f32x4*)(wl + g * 64 + c * 8 + 4);
            s[g] += q0.x * k[0] + q0.y * k[1] + q0.z * k[2] + q0.w * k[3] + q1.x * k[4] + q1.y * k[5] + q1.z * k[6] + q1.w * k[7];
        }
    }
    const int bk = t5_bucket(t - pos);
#pragma unroll
    for (int g = 0; g < 4; ++g) {
        const float sv = valid ? s[g] + rel_bias[bk * 8 + hkv * 4 + g] : -1e30f;
        const float mn = fmaxf(m[g], wave_max(sv, lane));
        const float alpha = __expf(m[g] - mn);
        const float p = valid ? __expf(sv - mn) : 0.f;
        l[g] = l[g] * alpha + wave_sum(p, lane);
        o[g] *= alpha; m[g] = mn;
        wl[256 + g * 64 + lane] = p;
    }
#pragma unroll 4
    for (int key = 0; key < 64; ++key) {
        int pk = base + key; pk = pk < 0 ? 0 : (pk > SEQ - 1 ? SEQ - 1 : pk);
        const float v = bf2f(Z[((size_t)b * SEQ + pk) * ZP + vcol + hkv * 64 + lane]);
#pragma unroll
        for (int g = 0; g < 4; ++g) o[g] += wl[256 + g * 64 + key] * v;
    }
}
__device__ __forceinline__ void attn_naive_item(LAS float* wl, int b, int hkv, int t, const bf16* Z, const float* KC, const float* VC, const float* rel_bias, bf16* YC, int lane) {
    const size_t row = (size_t)b * SEQ + t;
#pragma unroll
    for (int g = 0; g < 4; ++g) wl[g * 64 + lane] = bf2f(Z[row * ZP + ZC_Q + hkv * 256 + g * 64 + lane]) * 0.125f;
#pragma unroll 1
    for (int c = 0; c < 4; ++c) {
        const int n = c * 64 + lane; const bool valid = (n < NCMP) && (16 * n + 31 <= t);
        const float* kr = KC + (((size_t)b * NCMPP + (n < NCMP ? n : 0)) * 2 + hkv) * 64;
        float s[4] = {0.f, 0.f, 0.f, 0.f};
#pragma unroll 4
        for (int d4 = 0; d4 < 16; ++d4) {
            const f32x4 k = *(const f32x4*)(kr + d4 * 4);
#pragma unroll
            for (int g = 0; g < 4; ++g) { const f32x4 q = *(const LAS f32x4*)(wl + g * 64 + d4 * 4); s[g] += q.x * k.x + q.y * k.y + q.z * k.z + q.w * k.w; }
        }
        const int bk = t5_bucket(t - (16 * n + 31));
#pragma unroll
        for (int g = 0; g < 4; ++g) wl[256 + g * 256 + n] = valid ? s[g] + rel_bias[bk * 8 + hkv * 4 + g] : -1e30f;
    }
#pragma unroll
    for (int g = 0; g < 4; ++g) {
        float sc[4];
#pragma unroll
        for (int c = 0; c < 4; ++c) sc[c] = wl[256 + g * 256 + c * 64 + lane];
        const float mx = wave_max(fmaxf(fmaxf(sc[0], sc[1]), fmaxf(sc[2], sc[3])), lane);
        float e[4], ls = 0.f;
#pragma unroll
        for (int c = 0; c < 4; ++c) { e[c] = sc[c] > -1e29f ? __expf(sc[c] - mx) : 0.f; ls += e[c]; }
        ls = wave_sum(ls, lane);
        const float inv = ls > 0.f ? 1.0f / ls : 0.f;
#pragma unroll
        for (int c = 0; c < 4; ++c) wl[256 + g * 256 + c * 64 + lane] = e[c] * inv;
    }
    float oc[4] = {0.f, 0.f, 0.f, 0.f};
    const int nmax = t >= 31 ? ((t - 31) / 16 + 1 < NCMP ? (t - 31) / 16 + 1 : NCMP) : 0;
#pragma unroll 4
    for (int n = 0; n < nmax; ++n) {
        const float v = VC[(((size_t)b * NCMPP + n) * 2 + hkv) * 64 + lane];
#pragma unroll
        for (int g = 0; g < 4; ++g) oc[g] += wl[256 + g * 256 + n] * v;
    }
    float imp = 0.f;
#pragma unroll
    for (int g = 0; g < 4; ++g) {
        const LAS float* P = wl + 256 + g * 256;
        imp += P[4 * lane] + P[4 * lane + 1] + P[4 * lane + 2] + 0.5f * P[4 * lane + 3] + (lane > 0 ? 0.5f * P[4 * lane - 1] : 0.f);
    }
    const int blk = t >> 6;
    const bool forced = (lane == 0) || (lane <= blk && lane > blk - 2), future = lane > blk;
    const float v = forced ? 1e9f : (future ? -1e9f : imp);
    int rank = 0;
    for (int jj = 0; jj < 64; ++jj) { const float vj = lane_bcast(v, jj); rank += (vj > v) || (vj == v && jj < lane); }
    unsigned long long mask = __ballot(rank < 16 && !future);
    float m[4], l[4], o[4];
#pragma unroll
    for (int g = 0; g < 4; ++g) { m[g] = -1e30f; l[g] = 0.f; o[g] = 0.f; }
    while (mask) {
        const int j = __builtin_ctzll(mask); mask &= mask - 1;
        attn_chunk(wl, Z, rel_bias, b, hkv, t, 64 * j, ZC_KV + 256, ZC_KV + 384, lane, m, l, o);
    }
    float os[4];
#pragma unroll
    for (int g = 0; g < 4; ++g) { os[g] = l[g] > 0.f ? o[g] / l[g] : 0.f; m[g] = -1e30f; l[g] = 0.f; o[g] = 0.f; }
    for (int c = 0; c < 8; ++c) attn_chunk(wl, Z, rel_bias, b, hkv, t, t - 511 + 64 * c, ZC_KV + 512, ZC_KV + 640, lane, m, l, o);
#pragma unroll
    for (int g = 0; g < 4; ++g) {
        const float ow = l[g] > 0.f ? o[g] / l[g] : 0.f;
        const bf16* gp = Z + row * ZP + ZC_G + hkv * 12 + g * 3;
        const float r = sigmoidf_(bf2f(gp[0])) * oc[g] + sigmoidf_(bf2f(gp[1])) * os[g] + sigmoidf_(bf2f(gp[2])) * ow;
        YC[row * DM + D_SSM + hkv * 256 + g * 64 + lane] = (bf16)f2bf(r);
    }
}

__device__ __forceinline__ void ph_norm_route(const Frame& F, const bf16* x, const float* g, const float* rgw, const float* rgb, const float* rew, const float* reb, bf16* hn,
                                              unsigned* gcnt, unsigned* list, float* listw) {
    LAS f32x4* RG = (LAS f32x4*)F.lds; LAS f32x4* RE = RG + 1024;
    LAS unsigned* cnt_l = (LAS unsigned*)(F.lds + 147456); LAS unsigned* base_l = cnt_l + 32; LAS unsigned* ent = cnt_l + 64;
    for (int d = F.tid; d < 1024; d += NTHR) { const int ln = d & 63, jc = d >> 6, row = (ln + 64 * (jc >> 2)) * 4 + (jc & 3); RG[d] = ((const f32x4*)rgw)[row]; }
    { f32x4 t[16];
#pragma unroll
      for (int k = 0; k < 16; ++k) { const int d = F.tid + k * NTHR, ln = d & 63, q = d >> 6, half = q & 1, c = (q >> 1) & 3, j = (q >> 3) & 3, gi = q >> 5, row = (ln + 64 * j) * 4 + c;
          t[k] = ((const f32x4*)rew)[((size_t)gi * DM + row) * 2 + half]; }
#pragma unroll
      for (int k = 0; k < 16; ++k) RE[F.tid + k * NTHR] = t[k]; }
    __syncthreads();
    for (int row0 = F.blk * 128; row0 < T; row0 += F.G * 128) {
        if (F.tid < 32) cnt_l[F.tid] = 0u;
        __syncthreads();
        u32x2 nv[4];
#pragma unroll
        for (int j = 0; j < 4; ++j) nv[j] = ((const u32x2*)(x + (size_t)(row0 + F.wave * 16) * DM))[F.lane + 64 * j];
        for (int kk = 0; kk < 16; ++kk) {
            const int row = row0 + F.wave * 16 + kk;
            f32x4 v[4]; float s = 0.f;
#pragma unroll
            for (int j = 0; j < 4; ++j) { v[j] = bf4(nv[j]); s += v[j].x * v[j].x + v[j].y * v[j].y + v[j].z * v[j].z + v[j].w * v[j].w; }
            if (kk < 15) {
#pragma unroll
                for (int j = 0; j < 4; ++j) nv[j] = ((const u32x2*)(x + (size_t)(row + 1) * DM))[F.lane + 64 * j]; }
            s = wave_sum(s, F.lane);
            const float r = rsqrtf(s * (1.0f / DM) + EPS);
            float lg[4] = {0.f, 0.f, 0.f, 0.f};
#pragma unroll
            for (int j = 0; j < 4; ++j) {
                const f32x4 gg = ((const f32x4*)g)[F.lane + 64 * j];
                v[j].x = v[j].x * r * gg.x; v[j].y = v[j].y * r * gg.y; v[j].z = v[j].z * r * gg.z; v[j].w = v[j].w * r * gg.w;
                u32x2 o; o.x = pk2(v[j].x, v[j].y); o.y = pk2(v[j].z, v[j].w);
                *(u32x2*)(hn + (size_t)row * DM + (F.lane + 64 * j) * 4) = o;
                const f32x4 w0 = RG[(j * 4 + 0) * 64 + F.lane], w1 = RG[(j * 4 + 1) * 64 + F.lane], w2 = RG[(j * 4 + 2) * 64 + F.lane], w3 = RG[(j * 4 + 3) * 64 + F.lane];
                lg[0] += v[j].x * w0.x + v[j].y * w1.x + v[j].z * w2.x + v[j].w * w3.x;
                lg[1] += v[j].x * w0.y + v[j].y * w1.y + v[j].z * w2.y + v[j].w * w3.y;
                lg[2] += v[j].x * w0.z + v[j].y * w1.z + v[j].z * w2.z + v[j].w * w3.z;
                lg[3] += v[j].x * w0.w + v[j].y * w1.w + v[j].z * w2.w + v[j].w * w3.w;
            }
#pragma unroll
            for (int o = 0; o < 4; ++o) lg[o] = wave_sum(lg[o], F.lane) + rgb[o];
            int gi = 0; float gm = lg[0];
#pragma unroll
            for (int o = 1; o < 4; ++o) if (lg[o] > gm) { gm = lg[o]; gi = o; }
            float gs = 0.f;
#pragma unroll
            for (int o = 0; o < 4; ++o) gs += __expf(lg[o] - gm);
            const float gval = 1.0f / gs;
            const LAS f32x4* we = RE + gi * 2048;
            float le[8] = {0.f, 0.f, 0.f, 0.f, 0.f, 0.f, 0.f, 0.f};
#pragma unroll
            for (int j = 0; j < 4; ++j) {
                const float hv[4] = {v[j].x, v[j].y, v[j].z, v[j].w};
#pragma unroll
                for (int c = 0; c < 4; ++c) {
                    const f32x4 wa = we[((j * 4 + c) * 2 + 0) * 64 + F.lane], wb = we[((j * 4 + c) * 2 + 1) * 64 + F.lane];
                    le[0] += hv[c] * wa.x; le[1] += hv[c] * wa.y; le[2] += hv[c] * wa.z; le[3] += hv[c] * wa.w;
                    le[4] += hv[c] * wb.x; le[5] += hv[c] * wb.y; le[6] += hv[c] * wb.z; le[7] += hv[c] * wb.w;
                }
            }
#pragma unroll
            for (int e = 0; e < 8; ++e) le[e] = wave_sum(le[e], F.lane) + reb[gi * 8 + e];
            int e1 = 0; float m1 = le[0];
#pragma unroll
            for (int e = 1; e < 8; ++e) if (le[e] > m1) { m1 = le[e]; e1 = e; }
            int e2 = -1; float m2 = -3.0e38f;
#pragma unroll
            for (int e = 0; e < 8; ++e) if (e != e1 && le[e] > m2) { m2 = le[e]; e2 = e; }
            const float p2 = __expf(m2 - m1), inv = 1.0f / (1.0f + p2);
            if (F.lane == 0) {
                const unsigned ea = (unsigned)(gi * 8 + e1), eb = (unsigned)(gi * 8 + e2);
                const unsigned pa = __hip_atomic_fetch_add(cnt_l + ea, 1u, __ATOMIC_RELAXED, __HIP_MEMORY_SCOPE_WORKGROUP);
                const unsigned pb = __hip_atomic_fetch_add(cnt_l + eb, 1u, __ATOMIC_RELAXED, __HIP_MEMORY_SCOPE_WORKGROUP);
                LAS unsigned* en = ent + (F.wave * 16 + kk) * 6;
                en[0] = ea; en[1] = eb; en[2] = pa; en[3] = pb; en[4] = __float_as_uint(gval * inv); en[5] = __float_as_uint(gval * p2 * inv);
            }
        }
        __syncthreads();
        if (F.tid < 32) base_l[F.tid] = __hip_atomic_fetch_add(gcnt + F.tid * 64, cnt_l[F.tid], __ATOMIC_RELAXED, __HIP_MEMORY_SCOPE_AGENT);
        __syncthreads();
        if (F.tid < 128) {
            const LAS unsigned* en = ent + F.tid * 6; const unsigned tok = (unsigned)(row0 + F.tid);
            const unsigned ia = en[0] * LCAP + base_l[en[0]] + en[2], ib = en[1] * LCAP + base_l[en[1]] + en[3];
            list[ia] = tok * 2u; listw[ia] = __uint_as_float(en[4]);
            list[ib] = tok * 2u + 1u; listw[ib] = __uint_as_float(en[5]);
        }
        __syncthreads();
    }
}
__device__ __forceinline__ void build_expert_tab(const Frame& F, const unsigned* gcnt, LAS int* tab) {
    if (F.tid < 64) {
        const int c = F.lane < 32 ? (int)__hip_atomic_load(gcnt + F.lane * 64, __ATOMIC_RELAXED, __HIP_MEMORY_SCOPE_AGENT) : 0;
        int tiles = (c + 255) >> 8, incl = tiles;
#pragma unroll
        for (int o = 1; o < 32; o <<= 1) { const int t = __builtin_amdgcn_ds_bpermute((F.lane - o) << 2, incl); if (F.lane >= o) incl += t; }
        if (F.lane < 32) { tab[F.lane + 1] = incl; tab[33 + F.lane] = c; }
        if (F.lane == 0) tab[0] = 0;
    }
    __syncthreads();
}
__device__ __forceinline__ void ph_experts_naive(const Frame& F, const bf16* hn, const unsigned* route, const float* wg, const float* wu, const float* wd, float* x) {
    LAS float* hs = (LAS float*)F.lds;
    LAS float* hd = hs + 1024;
    for (int tok = F.blk; tok < T; tok += F.G) {
        { const unsigned pv = *(const unsigned*)(hn + (size_t)tok * DM + F.tid * 2); hs[F.tid * 2] = __uint_as_float(pv << 16); hs[F.tid * 2 + 1] = __uint_as_float(pv & 0xffff0000u); }
        const u32x4 rt = *(const u32x4*)(route + (size_t)tok * 4);
        __syncthreads();
        {
            const int s = F.tid >> 8, f = F.tid & 255;
            const unsigned e = s ? rt.y : rt.x; const float w = __uint_as_float(s ? rt.w : rt.z);
            const float* pg = wg + (size_t)e * DM * 256 + f; const float* pu = wu + (size_t)e * DM * 256 + f;
            float ga = 0.f, ua = 0.f;
            for (int d = 0; d < DM; ++d) { const float hv = hs[d]; ga += hv * pg[(size_t)d * 256]; ua += hv * pu[(size_t)d * 256]; }
            hd[s * 256 + f] = ga * sigmoidf_(ga) * ua * w;
        }
        __syncthreads();
        for (int dd = F.tid; dd < DM; dd += NTHR) {
            float acc = 0.f;
            const float* p0 = wd + (size_t)rt.x * 256 * DM + dd; const float* p1 = wd + (size_t)rt.y * 256 * DM + dd;
            for (int f = 0; f < 256; ++f) acc += hd[f] * p0[(size_t)f * DM];
            for (int f = 0; f < 256; ++f) acc += hd[256 + f] * p1[(size_t)f * DM];
            x[(size_t)tok * DM + dd] += acc;
        }
        __syncthreads();
    }
}


namespace nsa {
typedef short bf16x8 __attribute__((ext_vector_type(8)));
typedef short s16x4 __attribute__((ext_vector_type(4)));
typedef float f32x16 __attribute__((ext_vector_type(16)));
typedef float f32x2_t __attribute__((ext_vector_type(2)));
typedef __bf16 bf16x2_t __attribute__((ext_vector_type(2)));
constexpr int SLOTB = 8192;
constexpr int L_K = 0, L_V = 3 * SLOTB, L_IMP = 6 * SLOTB, L_BT = L_IMP + 65536, L_WS = L_BT + 4 * 132 * 4, L_RL = L_WS + 8 * 64 * 4, L_SM = L_RL + 4 * 64 * 4, L_RT = L_SM + 64 * 8, L_END = L_RT + 4 * 320 * 4;
static_assert(L_END <= 131072, "nsa LDS map");
constexpr float LOG2E = 1.4426950408889634f;
constexpr float NEG_INF = -__builtin_inff();
#define NSA_SBAR() __builtin_amdgcn_sched_barrier(0)
__device__ __forceinline__ int crow(int r, int hi) { return (r & 3) + 8 * (r >> 2) + 4 * hi; }
__device__ __forceinline__ void glds16(const void* gsrc, unsigned lds_dst) { unsigned keep;
    asm volatile("s_mov_b32 %0, m0\n\ts_mov_b32 m0, %2\n\ts_nop 0\n\tglobal_load_lds_dwordx4 %1, off\n\ts_mov_b32 m0, %0" : "=&s"(keep) : "v"(gsrc), "s"(lds_dst) : "memory"); }
__device__ __forceinline__ unsigned cvtpk(float lo, float hi) { f32x2_t v = {lo, hi}; bf16x2_t b = __builtin_convertvector(v, bf16x2_t); return __builtin_bit_cast(unsigned, b); }
#define NSA_WAIT_BAR(N) asm volatile("s_waitcnt vmcnt(" #N ") lgkmcnt(0)\n\ts_barrier" ::: "memory")
__device__ __forceinline__ void qkt(f32x16& p0, f32x16& p1, const LAS char* kb, const bf16x8 (&qr)[4], const f32x16& cinit) {
#pragma unroll
    for (int d0 = 0; d0 < 4; ++d0) {
        const bf16x8 b0 = *(const LAS bf16x8*)(kb + d0 * 2048);
        const bf16x8 b1 = *(const LAS bf16x8*)(kb + d0 * 2048 + 512);
        if (d0 == 0) { p0 = __builtin_amdgcn_mfma_f32_32x32x16_bf16(b0, qr[0], cinit, 0, 0, 0); p1 = __builtin_amdgcn_mfma_f32_32x32x16_bf16(b1, qr[0], cinit, 0, 0, 0); }
        else { p0 = __builtin_amdgcn_mfma_f32_32x32x16_bf16(b0, qr[d0], p0, 0, 0, 0); p1 = __builtin_amdgcn_mfma_f32_32x32x16_bf16(b1, qr[d0], p1, 0, 0, 0); }
    }
}
__device__ __forceinline__ void pv(f32x16 (&o)[2], int vb, bf16x8 pa0, bf16x8 pa1, bf16x8 pa2, bf16x8 pa3) {
#pragma unroll
    for (int d0 = 0; d0 < 2; ++d0) { s16x4 lo[4], hi[4];
#pragma unroll
        for (int ks = 0; ks < 4; ++ks) {
            asm volatile("ds_read_b64_tr_b16 %0,%1 offset:%c2" : "=&v"(lo[ks]) : "v"(vb), "i"(d0 * 4096 + ks * 1024) : "memory");
            asm volatile("ds_read_b64_tr_b16 %0,%1 offset:%c2" : "=&v"(hi[ks]) : "v"(vb), "i"(d0 * 4096 + ks * 1024 + 512) : "memory"); }
        asm volatile("s_waitcnt lgkmcnt(0)" ::: "memory"); NSA_SBAR();
#define NSA_PK(k) (bf16x8){lo[k][0], lo[k][1], lo[k][2], lo[k][3], hi[k][0], hi[k][1], hi[k][2], hi[k][3]}
        o[d0] = __builtin_amdgcn_mfma_f32_32x32x16_bf16(pa0, NSA_PK(0), o[d0], 0, 0, 0);
        o[d0] = __builtin_amdgcn_mfma_f32_32x32x16_bf16(pa1, NSA_PK(1), o[d0], 0, 0, 0);
        o[d0] = __builtin_amdgcn_mfma_f32_32x32x16_bf16(pa2, NSA_PK(2), o[d0], 0, 0, 0);
        o[d0] = __builtin_amdgcn_mfma_f32_32x32x16_bf16(pa3, NSA_PK(3), o[d0], 0, 0, 0);
#undef NSA_PK
    }
}
typedef short v4i16_t __attribute__((ext_vector_type(4)));
__device__ __forceinline__ s16x4 vtr(const LAS char* p) { return __builtin_bit_cast(s16x4, __builtin_amdgcn_ds_read_tr16_b64_v4i16((LAS v4i16_t*)p)); }
__device__ __forceinline__ void pv2(f32x16 (&o)[2], const LAS char* vp, bf16x8 pa0, bf16x8 pa1, bf16x8 pa2, bf16x8 pa3) {
#pragma unroll
    for (int d0 = 0; d0 < 2; ++d0) {
        s16x4 lo[4], hi[4];
#pragma unroll
        for (int ks = 0; ks < 4; ++ks) { lo[ks] = vtr(vp + d0 * 4096 + ks * 1024); hi[ks] = vtr(vp + d0 * 4096 + ks * 1024 + 512); }
#define NSA_PK(k) (bf16x8){lo[k][0], lo[k][1], lo[k][2], lo[k][3], hi[k][0], hi[k][1], hi[k][2], hi[k][3]}
        o[d0] = __builtin_amdgcn_mfma_f32_32x32x16_bf16(pa0, NSA_PK(0), o[d0], 0, 0, 0);
        o[d0] = __builtin_amdgcn_mfma_f32_32x32x16_bf16(pa1, NSA_PK(1), o[d0], 0, 0, 0);
        o[d0] = __builtin_amdgcn_mfma_f32_32x32x16_bf16(pa2, NSA_PK(2), o[d0], 0, 0, 0);
        o[d0] = __builtin_amdgcn_mfma_f32_32x32x16_bf16(pa3, NSA_PK(3), o[d0], 0, 0, 0);
#undef NSA_PK
    }
}
__device__ __forceinline__ float other_half(float v, int hi) { auto rr = __builtin_amdgcn_permlane32_swap(__float_as_uint(v), __float_as_uint(v), false, false); return __uint_as_float(hi ? rr[0] : rr[1]); }
__device__ __forceinline__ float rowmax(const f32x16& p0, const f32x16& p1, int hi) {
    float a = fmaxf(fmaxf(p0[0], p0[1]), p1[0]), b = fmaxf(fmaxf(p0[2], p0[3]), p1[1]); a = fmaxf(fmaxf(a, p1[2]), p1[3]);
#pragma unroll
    for (int r = 4; r < 16; r += 4) { a = fmaxf(fmaxf(a, p0[r]), p0[r + 1]); b = fmaxf(fmaxf(b, p0[r + 2]), p0[r + 3]); a = fmaxf(fmaxf(a, p1[r]), p1[r + 1]); b = fmaxf(fmaxf(b, p1[r + 2]), p1[r + 3]); }
    const float m = fmaxf(a, b);
    return fmaxf(m, other_half(m, hi));
}
__device__ __forceinline__ void pack_p(const f32x16& p0, const f32x16& p1, bf16x8& a0, bf16x8& a1, bf16x8& a2, bf16x8& a3) {
    u32x4 w0, w1, w2, w3;
    w0 = (u32x4){cvtpk(p0[0], p0[1]), cvtpk(p0[2], p0[3]), cvtpk(p0[4], p0[5]), cvtpk(p0[6], p0[7])};
    w1 = (u32x4){cvtpk(p0[8], p0[9]), cvtpk(p0[10], p0[11]), cvtpk(p0[12], p0[13]), cvtpk(p0[14], p0[15])};
    w2 = (u32x4){cvtpk(p1[0], p1[1]), cvtpk(p1[2], p1[3]), cvtpk(p1[4], p1[5]), cvtpk(p1[6], p1[7])};
    w3 = (u32x4){cvtpk(p1[8], p1[9]), cvtpk(p1[10], p1[11]), cvtpk(p1[12], p1[13]), cvtpk(p1[14], p1[15])};
    a0 = __builtin_bit_cast(bf16x8, w0); a1 = __builtin_bit_cast(bf16x8, w1); a2 = __builtin_bit_cast(bf16x8, w2); a3 = __builtin_bit_cast(bf16x8, w3);
}

struct Ctx {
    LAS char* lds; unsigned lds0; int wid, lane, r32, hi, g, th, qloc;
    const LAS float* bt;
    const LAS float* rt;
    LAS float* wsf;
    const LAS float* wrow;
    int vb0;
    const LAS char* vp0;
    const LAS char* kb0;
};
__device__ __forceinline__ void dma_k(const Ctx& c, const bf16* kbase, int pitch, int slot) { glds16(kbase + (size_t)c.lane * pitch + c.wid * 8, (unsigned)__builtin_amdgcn_readfirstlane(c.lds0 + L_K + slot * SLOTB + c.wid * 1024)); }
__device__ __forceinline__ void dma_v(const Ctx& c, const bf16* vbase, int pitch, int slot) { glds16(vbase + (size_t)(16 * (c.wid & 3) + (c.lane >> 2)) * pitch + (c.wid >> 2) * 32 + (c.lane & 3) * 8, (unsigned)__builtin_amdgcn_readfirstlane(c.lds0 + L_V + slot * SLOTB + c.wid * 1024)); }

__device__ __forceinline__ void cmp_scores(const Ctx& c, int slot, const bf16x8 (&qr)[4], int t0, int kt, f32x16& p0, f32x16& p1) {
    const int dmin = t0 + 32 * c.th - 16 * (64 * kt + 63) - 31;
    const bool special = dmin < 113;
    f32x16 ci; { const float v = special ? 0.f : c.bt[128];
#pragma unroll
        for (int r = 0; r < 16; ++r) ci[r] = v; }
    qkt(p0, p1, c.kb0 + slot * SLOTB, qr, ci);
    if (special) {
        int hi64 = 64 * c.hi; asm volatile("" : "+v"(hi64));
        const int dqh = t0 + c.qloc - 1024 * kt - 31 - hi64;
        float b0[16], b1[16];
#pragma unroll
        for (int r = 0; r < 16; ++r) { const int d0 = dqh - 16 * ((r & 3) + 8 * (r >> 2)), d1 = d0 - 512; b0[r] = c.bt[d0 < 0 ? 0 : (d0 > 128 ? 128 : d0)]; b1[r] = c.bt[d1 < 0 ? 0 : (d1 > 128 ? 128 : d1)]; }
#pragma unroll
        for (int r = 0; r < 16; ++r) {
            const int d0 = dqh - 16 * ((r & 3) + 8 * (r >> 2)), d1 = d0 - 512;
            p0[r] = d0 < 0 ? NEG_INF : p0[r] + b0[r]; p1[r] = d1 < 0 ? NEG_INF : p1[r] + b1[r];
        }
    }
}
template <int MODE>
__device__ __forceinline__ void online_tile(const Ctx& c, int slot, const bf16x8 (&qr)[4], int dq, bool near, bool masked_tile, bool lane_off, float& mhat, float& lsum, f32x16 (&o)[2]) {
    f32x16 ci; { const float v = (near ? 0.f : c.bt[128]) - mhat;
#pragma unroll
        for (int r = 0; r < 16; ++r) ci[r] = v; }
    f32x16 p0, p1;
    qkt(p0, p1, c.kb0 + slot * SLOTB, qr, ci);
    if (near || masked_tile) {
        int hi4 = 4 * c.hi; asm volatile("" : "+v"(hi4));
        const int dqh = dq - hi4;
#pragma unroll
        for (int r = 0; r < 16; ++r) {
            const int d0 = dqh - ((r & 3) + 8 * (r >> 2)), d1 = d0 - 32;
            if (near) { p0[r] += c.bt[d0 < 0 ? 0 : (d0 > 128 ? 128 : d0)]; p1[r] += c.bt[d1 < 0 ? 0 : (d1 > 128 ? 128 : d1)]; }
            if (d0 < 0 || (MODE == 1 && d0 >= 512)) p0[r] = NEG_INF;
            if (d1 < 0 || (MODE == 1 && d1 >= 512)) p1[r] = NEG_INF;
        }
    }
    if (MODE == 0) { if (lane_off) {
#pragma unroll
        for (int r = 0; r < 16; ++r) { p0[r] = NEG_INF; p1[r] = NEG_INF; } } }
    const float rm = rowmax(p0, p1, c.hi);
    if (__any(rm > 8.0f)) {
        const float dl = fmaxf(rm, 0.f); mhat += dl;
#pragma unroll
        for (int r = 0; r < 16; ++r) { p0[r] -= dl; p1[r] -= dl; }
        const float f = __builtin_amdgcn_exp2f(-dl); lsum *= f;
        if (c.hi == 0) c.wsf[c.r32] = f;
        asm volatile("s_waitcnt lgkmcnt(0)" ::: "memory");
#pragma unroll
        for (int r = 0; r < 16; ++r) { const float fr = c.wrow[(r & 3) + 8 * (r >> 2)]; o[0][r] *= fr; o[1][r] *= fr; }
    }
    float sacc = 0.f;
#pragma unroll
    for (int r = 0; r < 16; ++r) { p0[r] = __builtin_amdgcn_exp2f(p0[r]); p1[r] = __builtin_amdgcn_exp2f(p1[r]); sacc += p0[r] + p1[r]; }
    lsum += sacc;
    bf16x8 a0, a1, a2, a3; pack_p(p0, p1, a0, a1, a2, a3);
    pv(o, c.vb0 + slot * SLOTB, a0, a1, a2, a3);
}
struct Pipe { bf16x8 a0, a1, a2, a3; bool have, resc; };
template <int MODE, int SPECIAL  , bool HAVE>
__device__ __forceinline__ void online_step(const Ctx& c, int kslot, int vslot_prev, const bf16x8 (&qr)[4], int dq, bool near, bool lane_off, float& mhat, float& lsum, f32x16 (&o)[2], Pipe& pp) {
    if (pp.resc) {
#pragma unroll
        for (int r = 0; r < 16; ++r) { const float fr = c.wrow[(r & 3) + 8 * (r >> 2)]; o[0][r] *= fr; o[1][r] *= fr; }
    }
    f32x16 ci; { const float v = (MODE == 0 && lane_off) ? NEG_INF : ((SPECIAL == 1 ? 0.f : c.bt[128]) - mhat);
#pragma unroll
        for (int r = 0; r < 16; ++r) ci[r] = v; }
    f32x16 p0, p1;
    qkt(p0, p1, c.kb0 + kslot * SLOTB, qr, ci);
    if (HAVE) pv2(o, c.vp0 + vslot_prev * SLOTB, pp.a0, pp.a1, pp.a2, pp.a3);
    if (SPECIAL == 1) {
        const LAS float* rp = c.rt + (255 - dq + 4 * c.hi);
#pragma unroll
        for (int r = 0; r < 16; ++r) { p0[r] += rp[(r & 3) + 8 * (r >> 2)]; p1[r] += rp[32 + (r & 3) + 8 * (r >> 2)]; }
    }
    if (SPECIAL == 2) {
        int hi4 = 4 * c.hi; asm volatile("" : "+v"(hi4));
        const int dqh = dq - hi4;
#pragma unroll
        for (int r = 0; r < 16; ++r) {
            const int d0 = dqh - ((r & 3) + 8 * (r >> 2)), d1 = d0 - 32;
            if (d0 < 0 || (MODE == 1 && d0 >= 512)) p0[r] = NEG_INF;
            if (d1 < 0 || (MODE == 1 && d1 >= 512)) p1[r] = NEG_INF;
        }
    }
    const float rm = rowmax(p0, p1, c.hi);
    const bool mv = __any(rm > 8.0f);
    if (mv) {
        const float dl = fmaxf(rm, 0.f); mhat += dl;
#pragma unroll
        for (int r = 0; r < 16; ++r) { p0[r] -= dl; p1[r] -= dl; }
        const float f = __builtin_amdgcn_exp2f(-dl); lsum *= f;
        c.wsf[c.r32] = f;
    }
    pp.resc = mv;
    float sacc = 0.f;
#pragma unroll
    for (int r = 0; r < 16; ++r) { p0[r] = __builtin_amdgcn_exp2f(p0[r]); p1[r] = __builtin_amdgcn_exp2f(p1[r]); sacc += p0[r] + p1[r]; }
    lsum += sacc;
    pack_p(p0, p1, pp.a0, pp.a1, pp.a2, pp.a3); pp.have = true;
}
__device__ __forceinline__ void online_drain(const Ctx& c, int vslot_prev, f32x16 (&o)[2], Pipe& pp) {
    if (pp.resc) {
#pragma unroll
        for (int r = 0; r < 16; ++r) { const float fr = c.wrow[(r & 3) + 8 * (r >> 2)]; o[0][r] *= fr; o[1][r] *= fr; }
    }
    if (pp.have) pv2(o, c.vp0 + vslot_prev * SLOTB, pp.a0, pp.a1, pp.a2, pp.a3);
}
__device__ __forceinline__ void add_scaled(const Ctx& c, f32x16 (&oacc)[2], const f32x16 (&o)[2], float s) {
    if (c.hi == 0) c.wsf[32 + c.r32] = s;
    asm volatile("s_waitcnt lgkmcnt(0)" ::: "memory");
#pragma unroll
    for (int r = 0; r < 16; ++r) { const float f = c.wrow[32 + (r & 3) + 8 * (r >> 2)]; oacc[0][r] += o[0][r] * f; oacc[1][r] += o[1][r] * f; }
    asm volatile("s_waitcnt lgkmcnt(0)" ::: "memory");
}

__device__ __forceinline__ void add_scaled_park(const Ctx& c, LAS float* park, const f32x16 (&o)[2], float s) {
    if (c.hi == 0) c.wsf[32 + c.r32] = s;
    asm volatile("s_waitcnt lgkmcnt(0)" ::: "memory");
#pragma unroll
    for (int r = 0; r < 16; ++r) { const float f = c.wrow[32 + (r & 3) + 8 * (r >> 2)]; park[r * 64] += o[0][r] * f; park[(16 + r) * 64] += o[1][r] * f; }
    asm volatile("s_waitcnt lgkmcnt(0)" ::: "memory");
}
__device__ __forceinline__ void unit(LAS char* lds, int tid, int b, int hkv, int jt, const bf16* Z, const bf16* KCm, const bf16* VCm, const float* rel_bias, bf16* YC, bool fill_table) {
    Ctx c; c.lds = lds; c.lds0 = (unsigned)(uintptr_t)lds; c.wid = __builtin_amdgcn_readfirstlane(tid >> 6); c.lane = tid & 63; c.r32 = c.lane & 31; c.hi = c.lane >> 5;
    c.g = c.wid & 3; c.th = c.wid >> 2; c.qloc = 32 * c.th + c.r32;
    c.bt = (const LAS float*)(lds + L_BT) + c.g * 132; c.rt = (const LAS float*)(lds + L_RT) + c.g * 320; c.wsf = (LAS float*)(lds + L_WS) + c.wid * 64; c.wrow = c.wsf + 4 * c.hi;
    c.vb0 = (int)(c.lds0 + L_V) + ((c.lane >> 4) & 1) * 32 + (c.lane & 3) * 8 + (4 * c.hi + ((c.lane & 15) >> 2)) * 64;
    c.kb0 = (const LAS char*)(lds + L_K) + c.hi * 1024 + c.r32 * 16;
    c.vp0 = (const LAS char*)(lds + L_V) + ((c.lane >> 4) & 1) * 32 + (c.lane & 3) * 8 + (4 * c.hi + ((c.lane & 15) >> 2)) * 64;
    const int t0 = 64 * jt;
    const bf16* Zb = Z + (size_t)b * SEQ * ZP;
    const size_t qrow = (size_t)b * SEQ + t0 + c.qloc;
    if (fill_table) for (int i = tid; i < 4 * 129; i += NTHR) { const int gg = i / 129, d = i % 129; ((LAS float*)(lds + L_BT))[gg * 132 + d] = rel_bias[t5_bucket(d) * 8 + hkv * 4 + gg] * LOG2E; }
    if (fill_table) for (int i = tid; i < 4 * 320; i += NTHR) { const int gg = i / 320, d = 255 - (i % 320); ((LAS float*)(lds + L_RT))[i] = d < 0 ? NEG_INF : rel_bias[t5_bucket(d > 128 ? 128 : d) * 8 + hkv * 4 + gg] * LOG2E; }
    bf16x8 qr[4];
#pragma unroll
    for (int d0 = 0; d0 < 4; ++d0) qr[d0] = *(const bf16x8*)(Z + qrow * ZP + ZC_Q + hkv * 256 + c.g * 64 + d0 * 16 + c.hi * 8);
    const bf16* gp = Z + qrow * ZP + ZC_G + hkv * 12 + c.g * 3;
    const float gate0 = sigmoidf_(bf2f(gp[0])), gate1 = sigmoidf_(bf2f(gp[1])), gate2 = sigmoidf_(bf2f(gp[2]));
    f32x16 oacc[2];
#pragma unroll
    for (int r = 0; r < 16; ++r) { oacc[0][r] = 0.f; oacc[1][r] = 0.f; }

    const int nct = (4 * jt + 2) / 64 + 1;
    const bf16* kcb = KCm + (size_t)b * NCMPP * 128 + hkv * 64; const bf16* vcb = VCm + (size_t)b * NCMPP * 128 + hkv * 64;
    const bf16* skb = Zb + ZC_KV + 256 + hkv * 64; const bf16* svb = Zb + ZC_KV + 384 + hkv * 64;
    {
        float mhat = 0.f, lsum = 0.f, carry = 0.f; f32x16 o[2];
#pragma unroll
        for (int r = 0; r < 16; ++r) { o[0][r] = 0.f; o[1][r] = 0.f; }
        LAS float* impw = (LAS float*)(lds + L_IMP) + (c.g * 64 + c.qloc) * 64;
        dma_k(c, kcb, 128, 0); dma_v(c, vcb, 128, 0); if (nct > 1) { dma_k(c, kcb + 64 * 128, 128, 1); dma_v(c, vcb + 64 * 128, 128, 1); }
        for (int i = 0; i < nct; ++i) {
            if (i + 1 < nct) NSA_WAIT_BAR(2); else NSA_WAIT_BAR(0);
            if (i + 2 < nct) { dma_k(c, kcb + (size_t)(i + 2) * 64 * 128, 128, (i + 2) % 3); dma_v(c, vcb + (size_t)(i + 2) * 64 * 128, 128, (i + 2) % 3); }
            f32x16 p0, p1; cmp_scores(c, i % 3, qr, t0, i, p0, p1);
            const float rm = rowmax(p0, p1, c.hi) - mhat;
            if (__any(rm > 8.0f)) {
                const float dl = fmaxf(rm, 0.f); mhat += dl;
                const float f = __builtin_amdgcn_exp2f(-dl); lsum *= f; carry *= f;
                c.wsf[c.r32] = f;
                asm volatile("s_waitcnt lgkmcnt(0)" ::: "memory");
#pragma unroll
                for (int r = 0; r < 16; ++r) { const float fr = c.wrow[(r & 3) + 8 * (r >> 2)]; o[0][r] *= fr; o[1][r] *= fr; }
                for (int e = c.hi; e < 16 * i; e += 2) impw[e] *= f;
            }
            float sacc = 0.f;
#pragma unroll
            for (int r = 0; r < 16; ++r) { p0[r] = __builtin_amdgcn_exp2f(p0[r] - mhat); p1[r] = __builtin_amdgcn_exp2f(p1[r] - mhat); sacc += p0[r] + p1[r]; }
            lsum += sacc;
            float o3[8];
#pragma unroll
            for (int k = 0; k < 4; ++k) { o3[k] = other_half(p0[4 * k + 3], c.hi); o3[4 + k] = other_half(p1[4 * k + 3], c.hi); }
#pragma unroll
            for (int idx = 0; idx < 8; ++idx) {
                const int X = idx >> 2, k = idx & 3;
                const f32x16& p = X ? p1 : p0;
                const float cin = c.hi ? o3[idx] : (idx ? o3[idx - 1] : carry);
                impw[16 * i + 8 * X + 2 * k + c.hi] = p[4 * k] + p[4 * k + 1] + p[4 * k + 2] + 0.5f * p[4 * k + 3] + 0.5f * cin;
            }
            carry = o3[7];
            bf16x8 a0, a1, a2, a3; pack_p(p0, p1, a0, a1, a2, a3);
            pv(o, c.vb0 + (i % 3) * SLOTB, a0, a1, a2, a3);
        }
        const float lt = lsum + other_half(lsum, c.hi);
        const float rl = lt > 0.f ? 1.0f / lt : 0.f;
        if (c.hi == 0) ((LAS float*)(lds + L_RL))[c.g * 64 + c.qloc] = rl;
        add_scaled(c, oacc, o, rl * gate0);
        NSA_WAIT_BAR(0);
    }
    { const int nt = jt + 1; dma_k(c, skb, ZP, 0); if (nt > 1) dma_k(c, skb + (size_t)64 * ZP, ZP, 1); dma_v(c, svb, ZP, 0); }
    for (int k = 0; k < 8; ++k) {
        const int tok = c.wid * 8 + k;
        float v = 0.f;
#pragma unroll
        for (int gg = 0; gg < 4; ++gg) v += ((const LAS float*)(lds + L_IMP))[(gg * 64 + tok) * 64 + c.lane] * ((const LAS float*)(lds + L_RL))[gg * 64 + tok];
        const bool forced = (c.lane == 0) || (c.lane <= jt && c.lane > jt - 2), future = c.lane > jt;
        v = forced ? 1e9f : (future ? -1e9f : v);
        int rank = 0;
#pragma unroll
        for (int jj = 0; jj < 64; ++jj) { const float vj = __builtin_bit_cast(float, __builtin_amdgcn_readlane(__builtin_bit_cast(int, v), jj)); rank += ((vj > v) || (vj == v && jj < c.lane)) ? 1 : 0; }
        const unsigned long long msk = __ballot(rank < 16 && !future);
        if (c.lane == 0) ((LAS unsigned long long*)(lds + L_SM))[tok] = msk;
    }
    asm volatile("s_waitcnt lgkmcnt(0)\n\ts_barrier" ::: "memory");
    const unsigned long long mymask = ((const LAS unsigned long long*)(lds + L_SM))[c.qloc];
    LAS float* park = (LAS float*)(lds + L_IMP) + c.wid * 2048 + c.lane;
#pragma unroll
    for (int r = 0; r < 16; ++r) { park[r * 64] = oacc[0][r]; park[(16 + r) * 64] = oacc[1][r]; }
    {
        const bf16* kb = skb; const bf16* vb = svb;
        const int nt = jt + 1;
        float mhat = 0.f, lsum = 0.f; f32x16 o[2]; Pipe pp; pp.have = false; pp.resc = false;
#pragma unroll
        for (int r = 0; r < 16; ++r) { o[0][r] = 0.f; o[1][r] = 0.f; }
#define NSA_ITER_HEAD(i) do { if ((i) + 1 < nt) NSA_WAIT_BAR(2); else NSA_WAIT_BAR(1); \
            if ((i) + 2 < nt) dma_k(c, kb + (size_t)((i) + 2) * 64 * ZP, ZP, ((i) + 2) % 3); \
            if ((i) + 1 < nt) dma_v(c, vb + (size_t)((i) + 1) * 64 * ZP, ZP, ((i) + 1) % 3); } while (0)
        {
            NSA_ITER_HEAD(0);
            if (jt <= 2) online_step<0, 1, false>(c, 0, 2, qr, 64 * jt + c.qloc, true, !(mymask & 1ull), mhat, lsum, o, pp); else online_step<0, 0, false>(c, 0, 2, qr, 0, false, !(mymask & 1ull), mhat, lsum, o, pp); }
        const int nfar = jt - 2;
        int i = 1;
        for (; i < nfar; ++i) { NSA_ITER_HEAD(i);
            online_step<0, 0, true>(c, i % 3, (i + 2) % 3, qr, 0, false, !((mymask >> i) & 1ull), mhat, lsum, o, pp); }
        for (; i < nt; ++i) { NSA_ITER_HEAD(i);
            online_step<0, 1, true>(c, i % 3, (i + 2) % 3, qr, 64 * (jt - i) + c.qloc, true, !((mymask >> i) & 1ull), mhat, lsum, o, pp); }
        NSA_WAIT_BAR(0);
        online_drain(c, (nt - 1) % 3, o, pp);
        const float lt = lsum + other_half(lsum, c.hi);
        add_scaled_park(c, park, o, (lt > 0.f ? 1.0f / lt : 0.f) * gate1);
        NSA_WAIT_BAR(0);
    }
    {
        const int j0 = jt > 8 ? jt - 8 : 0, nt = jt - j0 + 1;
        const bf16* kb = Zb + (size_t)j0 * 64 * ZP + ZC_KV + 512 + hkv * 64; const bf16* vb = Zb + (size_t)j0 * 64 * ZP + ZC_KV + 640 + hkv * 64;
        float mhat = 0.f, lsum = 0.f; f32x16 o[2]; Pipe pp; pp.have = false; pp.resc = false;
#pragma unroll
        for (int r = 0; r < 16; ++r) { o[0][r] = 0.f; o[1][r] = 0.f; }
        dma_k(c, kb, ZP, 0); if (nt > 1) dma_k(c, kb + (size_t)64 * ZP, ZP, 1); dma_v(c, vb, ZP, 0);
        {
            NSA_ITER_HEAD(0);
            if (j0 >= jt - 2) online_step<1, 1, false>(c, 0, 2, qr, 64 * (jt - j0) + c.qloc, true, false, mhat, lsum, o, pp); else online_step<1, 2, false>(c, 0, 2, qr, 64 * (jt - j0) + c.qloc, false, false, mhat, lsum, o, pp); }
        int i = 1;
        for (; j0 + i < jt - 2; ++i) { NSA_ITER_HEAD(i);
            online_step<1, 0, true>(c, i % 3, (i + 2) % 3, qr, 0, false, false, mhat, lsum, o, pp); }
        for (; i < nt; ++i) { NSA_ITER_HEAD(i); const int j = j0 + i;
            online_step<1, 1, true>(c, i % 3, (i + 2) % 3, qr, 64 * (jt - j) + c.qloc, true, false, mhat, lsum, o, pp); }
#undef NSA_ITER_HEAD
        NSA_WAIT_BAR(0);
        online_drain(c, (nt - 1) % 3, o, pp);
        const float lt = lsum + other_half(lsum, c.hi);
        add_scaled_park(c, park, o, (lt > 0.f ? 1.0f / lt : 0.f) * gate2);
    }
    {
        bf16* yb = YC + ((size_t)b * SEQ + t0 + 32 * c.th + 4 * c.hi) * DM + D_SSM + hkv * 256 + c.g * 64 + c.r32;
#pragma unroll
        for (int r = 0; r < 16; ++r) { bf16* yr = yb + (size_t)((r & 3) + 8 * (r >> 2)) * DM; yr[0] = (bf16)f2bf(park[r * 64]); yr[32] = (bf16)f2bf(park[(16 + r) * 64]); }
    }
    asm volatile("s_waitcnt vmcnt(0)" ::: "memory");
    NSA_WAIT_BAR(0);
}
#undef NSA_SBAR
#undef NSA_WAIT_BAR
}


__device__ __forceinline__ void ssm_precompute(const Frame& F, const __attribute__((address_space(4))) Args* args, unsigned char* ws, int item) {
    const int layer = item >> 5, g = item & 31, lg = layer * 32 + g;
    LAS float* L = (LAS float*)F.lds;
    LAS float* lkr = L; LAS float* lki = L + 17 * 64; LAS float* bbr = L + 2 * 17 * 64; LAS float* bbi = bbr + 1024; LAS float* ccr = bbi + 1024; LAS float* cci = ccr + 1024;
    LAS float* wk = cci + 1024; LAS float* dd = wk + 4096;
    const float* a_re = args->in[6] + lg * 64; const float* a_im = args->in[7] + lg * 64;
    const float dt = expf(args->in[13][lg]);
    for (int i = F.tid; i < 17 * 64; i += NTHR) { const int k = i >> 6, p = i & 63; const float er = expf(a_re[p] * dt * (float)k), ang = a_im[p] * dt * (float)k; lkr[i] = er * cosf(ang); lki[i] = er * sinf(ang); }
    for (int i = F.tid; i < 1024; i += NTHR) {
        { const int p = i >> 4, h = i & 15; const float are = a_re[p], aim = a_im[p];
          const float er = expf(are * dt), lbr = er * cosf(aim * dt), lbi = er * sinf(aim * dt);
          const float xx = lbr - 1.0f, yy = lbi, den = are * are + aim * aim, fr = (xx * are + yy * aim) / den, fi = (yy * are - xx * aim) / den;
          const float br = args->in[8][((size_t)lg * 64 + p) * 16 + h], bi = args->in[9][((size_t)lg * 64 + p) * 16 + h];
          bbr[i] = fr * br - fi * bi; bbi[i] = fr * bi + fi * br; }
        ccr[i] = args->in[10][(size_t)lg * 1024 + i]; cci[i] = args->in[11][(size_t)lg * 1024 + i];
    }
    if (F.tid < 16) dd[F.tid] = args->in[12][lg * 16 + F.tid];
    __syncthreads();
    for (int i = F.tid; i < 4096; i += NTHR) { const int k = i >> 8, ho = (i >> 4) & 15, hi = i & 15; float acc = 0.f;
        for (int p = 0; p < 64; ++p) { const float cr = ccr[ho * 64 + p], ci = cci[ho * 64 + p], lr = lkr[k * 64 + p], li = lki[k * 64 + p];
            const float tr = cr * lr - ci * li, ti = cr * li + ci * lr; acc += tr * bbr[p * 16 + hi] - ti * bbi[p * 16 + hi]; }
        wk[i] = acc + ((k == 0 && ho == hi) ? dd[ho] : 0.f); }
    __syncthreads();
    bf16* B2 = (bf16*)(ws + WS_BT2) + (size_t)lg * 256 * 384;
    for (int i = F.tid; i < 256 * 384; i += NTHR) { const int n = i / 384, kk = i % 384, t = n >> 4, ho = n & 15; float v;
        if (kk < 256) { const int sidx = kk >> 4, hi = kk & 15; v = sidx <= t ? wk[((t - sidx) << 8) + ho * 16 + hi] : 0.f; }
        else { const int j = kk - 256, p = j & 63; const float cr = ccr[ho * 64 + p], ci = cci[ho * 64 + p], lr = lkr[(t + 1) * 64 + p], li = lki[(t + 1) * 64 + p];
            v = j < 64 ? (cr * lr - ci * li) : -(cr * li + ci * lr); }
        B2[i] = (bf16)f2bf(v); }
    bf16* B1 = (bf16*)(ws + WS_BT1) + (size_t)lg * 256 * 256;
    for (int i = F.tid; i < 65536; i += NTHR) { const int j = i >> 8, kk = i & 255, sidx = kk >> 4, hi = kk & 15; float v = 0.f;
        if (j < 128) { const int p = j & 63; const float lr = lkr[(15 - sidx) * 64 + p], li = lki[(15 - sidx) * 64 + p], br = bbr[p * 16 + hi], bi = bbi[p * 16 + hi];
            v = j < 64 ? (lr * br - li * bi) : (lr * bi + li * br); }
        B1[i] = (bf16)f2bf(v); }
    __syncthreads();
}
__device__ __forceinline__ void ssm_carry_item(int b, int g, const float* a_re, const float* a_im, const float* log_dt, const float* XL, bf16* U, int lane) {
    const float dt16 = 16.0f * expf(log_dt[g]);
    const float er = expf(a_re[g * 64 + lane] * dt16), ang = a_im[g * 64 + lane] * dt16, lr = er * cosf(ang), li = er * sinf(ang);
    float xr = 0.f, xi = 0.f;
    const float* __restrict__ xl = XL + ((size_t)g * 2048 + b * 256) * 128 + lane;
    bf16* __restrict__ up = U + ((size_t)g * 2048 + b * 256) * 512 + 256 + lane;
    float ar[16], ai[16], nr_[16], ni_[16];
#pragma unroll
    for (int k = 0; k < 16; ++k) { ar[k] = xl[(size_t)k * 128]; ai[k] = xl[(size_t)k * 128 + 64]; }
    for (int cb = 0; cb < 16; ++cb) {
        const int cn = cb < 15 ? (cb + 1) * 16 : cb * 16;
#pragma unroll
        for (int k = 0; k < 16; ++k) { nr_[k] = xl[(size_t)(cn + k) * 128]; ni_[k] = xl[(size_t)(cn + k) * 128 + 64]; }
#pragma unroll
        for (int k = 0; k < 16; ++k) {
            const int c = cb * 16 + k;
            up[(size_t)c * 512] = (bf16)f2bf(xr); up[(size_t)c * 512 + 64] = (bf16)f2bf(xi);
            const float nr = lr * xr - li * xi + ar[k], ni = lr * xi + li * xr + ai[k];
            xr = nr; xi = ni;
        }
#pragma unroll
        for (int k = 0; k < 16; ++k) { ar[k] = nr_[k]; ai[k] = ni_[k]; }
    }
}


__device__ __forceinline__ void compress_stage2(const Frame& F, int eb, int pm, const bf16* HC, const bf16* W2T, bf16* KCo, bf16* VCo) {
    typedef short bf16x8_ __attribute__((ext_vector_type(8))); typedef float f32x16_ __attribute__((ext_vector_type(16)));
    const int r32 = F.lane & 31, hi = F.lane >> 5, rg0 = pm * 256 + F.wave * 32;
    const bf16* ar = HC + ((size_t)eb * 4096 + rg0 + r32) * 64 + 8 * hi; const bf16* br = W2T + (size_t)eb * 4096 + (size_t)r32 * 64 + 8 * hi;
    bf16x8_ a[4], b0[4], b1[4];
#pragma unroll
    for (int ks = 0; ks < 4; ++ks) { a[ks] = *(const bf16x8_*)(ar + ks * 16); b0[ks] = *(const bf16x8_*)(br + ks * 16); b1[ks] = *(const bf16x8_*)(br + 32 * 64 + ks * 16); }
    f32x16_ d0, d1;
#pragma unroll
    for (int r = 0; r < 16; ++r) { d0[r] = 0.f; d1[r] = 0.f; }
#pragma unroll
    for (int ks = 0; ks < 4; ++ks) { d0 = __builtin_amdgcn_mfma_f32_32x32x16_bf16(a[ks], b0[ks], d0, 0, 0, 0); d1 = __builtin_amdgcn_mfma_f32_32x32x16_bf16(a[ks], b1[ks], d1, 0, 0, 0); }
    bf16* dstb = (eb ? VCo : KCo) + (size_t)(rg0 + 4 * hi) * 64 + r32;
#pragma unroll
    for (int r = 0; r < 16; ++r) { const int ro = (r & 3) + 8 * (r >> 2); const bool pad = (((rg0 + 4 * hi + ro) >> 1) & 255) == NCMP;
        dstb[(size_t)ro * 64] = pad ? (bf16)0 : (bf16)f2bf(d0[r]); dstb[(size_t)ro * 64 + 32] = pad ? (bf16)0 : (bf16)f2bf(d1[r]); }
}

__device__ __forceinline__ void titem_load(const float* W, int N, int k0, int n0, int lane, float (&t)[32]) {
#pragma unroll
    for (int i = 0; i < 32; ++i) t[i] = W[(size_t)(k0 + 2 * i + (lane >> 5)) * N + n0 + (lane & 31)];
}
__device__ __forceinline__ void titem_finish(const float (&t)[32], int K, bf16* WT, int k0, int drow0, LAS float* scr, int lane, float scale) {
#pragma unroll
    for (int i = 0; i < 32; ++i) scr[(2 * i + (lane >> 5)) * 33 + (lane & 31)] = t[i];
    asm volatile("s_waitcnt lgkmcnt(0)" ::: "memory");
    const int c = lane & 7;
#pragma unroll
    for (int j = 0; j < 4; ++j) { const int n = (lane >> 3) + 8 * j; const LAS float* sp = scr + (8 * c) * 33 + n;
        u32x4 o; o.x = pk2(sp[0 * 33] * scale, sp[1 * 33] * scale); o.y = pk2(sp[2 * 33] * scale, sp[3 * 33] * scale); o.z = pk2(sp[4 * 33] * scale, sp[5 * 33] * scale); o.w = pk2(sp[6 * 33] * scale, sp[7 * 33] * scale);
        *(u32x4*)(WT + (size_t)(drow0 + n) * K + k0 + 8 * c) = o; }
    asm volatile("s_waitcnt lgkmcnt(0)" ::: "memory");
}
__device__ __forceinline__ void transpose_item(const float* W, int K, int N, bf16* WT, int k0, int n0, int drow0, LAS float* scr, int lane, float scale = 1.0f) {
    float t[32]; titem_load(W, N, k0, n0, lane, t); titem_finish(t, K, WT, k0, drow0, scr, lane, scale);
}
struct XItem { const float* W; bf16* WT; int K, N, k0, n0, drow0; };
__device__ __forceinline__ XItem xitem(const __attribute__((address_space(4))) Args* args, unsigned char* ws, int it) {
    XItem x; const int le = it / 384, r = it % 384;
    if (r < 256) { const int isup = r >> 7, q = r & 127, nb = q & 7, kb = q >> 3, n0 = 32 * nb;
        x.W = args->in[isup ? 24 : 23] + (size_t)le * DM * 256; x.K = DM; x.N = 256; x.WT = (bf16*)(ws + WS_WGU) + (size_t)le * 512 * DM; x.k0 = 64 * kb; x.n0 = n0; x.drow0 = 256 * (n0 >> 7) + 128 * isup + (n0 & 127); }
    else { const int q = r - 256, nb = q & 31, kb = q >> 5;
        x.W = args->in[25] + (size_t)le * 256 * DM; x.K = 256; x.N = DM; x.WT = (bf16*)(ws + WS_WDN) + (size_t)le * DM * 256; x.k0 = 64 * kb; x.n0 = 32 * nb; x.drow0 = 32 * nb; }
    return x;
}
__device__ __forceinline__ void convert_experts(const Frame& F, const __attribute__((address_space(4))) Args* args, unsigned char* ws, int layer, int vw, int nvw) {
    LAS float* scr = (LAS float*)(F.lds + F.wave * 16384);
    const int lo_ = layer * 32 * 384, hi_ = (layer + 1) * 32 * 384;
    float ta[32], tb[32]; XItem xa, xb;
    int it = lo_ + vw;
    if (it < hi_) { xa = xitem(args, ws, it); titem_load(xa.W, xa.N, xa.k0, xa.n0, F.lane, ta); }
    for (; it < hi_; it += nvw) {
        const bool hn = it + nvw < hi_;
        if (hn) { xb = xitem(args, ws, it + nvw); titem_load(xb.W, xb.N, xb.k0, xb.n0, F.lane, tb); }
        titem_finish(ta, xa.K, xa.WT, xa.k0, xa.drow0, scr, F.lane, 1.0f);
        if (hn) { xa = xb;
#pragma unroll
            for (int i = 0; i < 32; ++i) ta[i] = tb[i]; }
    }
}
__device__ __forceinline__ void ph_convert(const Frame& F, const __attribute__((address_space(4))) Args* args, unsigned char* ws) {
    for (int it = F.blk; it < DEPTH * NGRP; it += F.G) ssm_precompute(F, args, ws, it);
    LAS float* scr = (LAS float*)(F.lds + F.wave * 16384);
    const int gw = F.blk * NWAVES + F.wave, NGW = F.G * NWAVES;
    constexpr int I_IN = (DM / 64) * (1792 / 32), I_GLU = (D_SSM / 64) * (2 * D_SSM / 32), I_OUT = (DM / 64) * (DM / 32);
    constexpr int PER_LAYER = I_IN + I_GLU + I_OUT;
    for (int it = gw; it < DEPTH * 2 * 64; it += NGW) { const int li = it >> 6, q = it & 63, nb = q & 1, kb = q >> 1;
        transpose_item(args->in[16] + (size_t)li * 2048 * 64, 2048, 64, (bf16*)(ws + WS_W1T) + (size_t)li * 256 * 2048, 64 * kb, 32 * nb, 32 * nb, scr, F.lane); }
    { const int gt = F.blk * NTHR + F.tid, NGT = F.G * NTHR;
      for (int idx = gt; idx < DEPTH * 2 * 192 * 2048 / 8; idx += NGT) { const int li = idx / (192 * 256), rem = idx % (192 * 256);
          *(u32x4*)((bf16*)(ws + WS_W1T) + (size_t)li * 256 * 2048 + (size_t)64 * 2048 + (size_t)rem * 8) = (u32x4){0u, 0u, 0u, 0u}; }
      for (int idx = gt; idx < DEPTH * 2 * 4096; idx += NGT) { const int li = idx >> 12, f = (idx >> 6) & 63, e = idx & 63; ((bf16*)(ws + WS_W2T))[idx] = (bf16)f2bf(args->in[17][(size_t)li * 4096 + e * 64 + f]); }
    }
    for (int idx = gw; idx < DEPTH * 2 * 64; idx += NGW) { const int li = idx >> 6, e = idx & 63; const float* pp = args->in[15] + (size_t)li * 2048; const float* ww = args->in[16] + (size_t)li * 2048 * 64 + e;
        float a = 0.f;
#pragma unroll 8
        for (int k = F.lane; k < 2048; k += 64) a += pp[k] * ww[(size_t)k * 64];
        a = wave_sum(a, F.lane);
        if (F.lane == 0) ((float*)(ws + WS_CBIAS))[idx] = a; }
    for (int it = gw; it < DEPTH * PER_LAYER; it += NGW) {
        const int layer = it / PER_LAYER; int r = it % PER_LAYER;
        if (r < I_IN) { const int nb = r % 56, kb = r / 56;
            transpose_item(args->in[4] + (size_t)layer * DM * D_IN, DM, D_IN, (bf16*)(ws + WS_WIN) + (size_t)layer * NINP * DM, 64 * kb, 32 * nb, 32 * nb, scr, F.lane, (nb >= 16 && nb < 32) ? QSCALE : 1.0f); continue; }
        r -= I_IN;
        if (r < I_GLU) { const int nb = r % 32, kb = r / 32, n0 = 32 * nb;
            const int half = n0 >> 9, c = n0 & 511, drow = 256 * (c >> 7) + 128 * half + (c & 127);
            transpose_item(args->in[14] + (size_t)layer * D_SSM * 2 * D_SSM, D_SSM, 2 * D_SSM, (bf16*)(ws + WS_WGLU) + (size_t)layer * 2 * D_SSM * D_SSM, 64 * kb, n0, drow, scr, F.lane); continue; }
        r -= I_GLU;
        { const int nb = r % 32, kb = r / 32;
            transpose_item(args->in[5] + (size_t)layer * DM * DM, DM, DM, (bf16*)(ws + WS_WOUT) + (size_t)layer * DM * DM, 64 * kb, 32 * nb, 32 * nb, scr, F.lane); }
    }
    const int gt = F.blk * NTHR + F.tid, NGT = F.G * NTHR;
    for (int idx = gt; idx < DEPTH * 256 * DM; idx += NGT) {
        const int layer = idx / (256 * DM), rem = idx % (256 * DM), n = 1792 + rem / DM, k = rem % DM;
        const float v = n < D_IN ? args->in[4][(size_t)layer * DM * D_IN + (size_t)k * D_IN + n] : 0.f;
        ((bf16*)(ws + WS_WIN))[(size_t)layer * NINP * DM + (size_t)n * DM + k] = (bf16)f2bf(v);
    }
}

constexpr int PH_PER_LAYER = 8, N_PHASES = 1 + DEPTH * PH_PER_LAYER + 1;
#ifndef FAST_GEMM
#define FAST_GEMM 1
#endif
#ifndef REP_ATTN
#define REP_ATTN 1
#endif
#ifndef REP_CMP
#define REP_CMP 1
#endif
#ifndef REP_CARRY
#define REP_CARRY 1
#endif
#ifndef REP_CONV
#define REP_CONV 1
#endif
#ifndef REP_INPROJ
#define REP_INPROJ 1
#endif
#ifndef REP_G1
#define REP_G1 1
#endif
#ifndef REP_G2
#define REP_G2 1
#endif
#ifndef REP_GLU
#define REP_GLU 1
#endif
#ifndef REP_OUT
#define REP_OUT 1
#endif
#ifndef REP_NORM
#define REP_NORM 1
#endif
#ifndef REP_ROUTE
#define REP_ROUTE 1
#endif
#ifndef REP_GU
#define REP_GU 1
#endif
#ifndef REP_DN
#define REP_DN 1
#endif

__global__ void __launch_bounds__(NTHR, 2) fwd(Args args) {
    extern __shared__ __attribute__((aligned(16))) unsigned char lds_raw[];
    Frame F;
    F.lds = (LAS unsigned char*)lds_raw;
    F.tid = threadIdx.x; F.lane = F.tid & 63; F.wave = __builtin_amdgcn_readfirstlane(F.tid >> 6);
    F.blk = blockIdx.x; F.G = gridDim.x;
    typedef const __attribute__((address_space(4))) Args* KArgs;
    KArgs kp = (KArgs)__builtin_amdgcn_kernarg_segment_ptr();
    asm volatile("" : "+s"(kp));
    unsigned char* ws = kp->ws;
    volatile LAS unsigned* MISC = (volatile LAS unsigned*)(F.lds + MISC_OFF);
    if (F.tid < 32) MISC[F.tid] = 0u;
    __syncthreads();
    XcdBarrier bar; bar.bar = (unsigned*)(ws + WS_CTL) + CW_BAR; bar.x = 0; bar.st = nullptr;
    if (N_LAUNCH_MODE == 1) bar = xcd_barrier_post((unsigned*)(ws + WS_CTL) + CW_BAR, MISC + 8);
#define IN(k) (kp->ph_lo <= (k) && (k) < kp->ph_hi)
#define FRESH_IDS() do { int l_; asm volatile("v_mbcnt_lo_u32_b32 %0, -1, 0\n\tv_mbcnt_hi_u32_b32 %0, -1, %0" : "=v"(l_)); asm volatile("" : "+s"(F.wave), "+s"(F.blk), "+s"(F.G)); F.lane = l_; F.tid = F.wave * 64 + l_; asm volatile("" : "+s"(kp)); ws = kp->ws; bar.bar = (unsigned*)(ws + WS_CTL) + CW_BAR; } while (0)
#define SEAM(k) do { FRESH_IDS(); if (IN(k) && IN((k) + 1)) xcd_barrier(bar, F.tid); FRESH_IDS(); } while (0)

    const float* x0 = kp->in[0];
    float* XR = kp->out;
#define HN ((bf16*)(ws + WS_HN))
#define Z ((bf16*)(ws + WS_Z))
#define YC ((bf16*)(ws + WS_YC))
#define G1 ((bf16*)(ws + WS_G1))
#define KC ((bf16*)(ws + WS_KC))
#define VC ((bf16*)(ws + WS_VC))
#define LIST ((unsigned*)(ws + WS_LIST))
#define LISTW ((float*)(ws + WS_LISTW))
#define HID ((bf16*)(ws + WS_HID))
#define P2 ((bf16*)(ws + WS_P2))
#define P1B ((bf16*)(ws + WS_YC))
#define XB ((bf16*)(ws + WS_XB))
#define USSM ((bf16*)(ws + WS_USSM))
#define XL ((float*)(ws + WS_XL))
    LAS int* etab = (LAS int*)(F.lds + ETAB_OFF);

    if (IN(0)) { for (int rep_ = 0; rep_ < REP_CONV; ++rep_) ph_convert(F, kp, ws);
                 ph_norm(F, kp->in[0], nullptr, nullptr, nullptr, kp->in[1], HN); }
    SEAM(0);
    for (int layer = 0; layer < DEPTH; ++layer) {
        const int pb = 1 + layer * PH_PER_LAYER;
        const float* xin = layer == 0 ? x0 : XR;
        unsigned* gcnt = (unsigned*)(ws + WS_CTL) + CW_CNT + layer * 32 * 64;
        if (IN(pb + 0) && layer > 0) { ph_norm_b(F, XB, P1B, P2, kp->in[1] + layer * DM, HN); for (int rep_ = 1; rep_ < REP_NORM; ++rep_) ph_norm_b(F, XB, P1B, P2, kp->in[1] + layer * DM, HN); }
        if (layer > 0) SEAM(pb + 0);
        if (IN(pb + 1)) {
            pg8::Gemm g{HN, (const bf16*)(ws + WS_WIN) + (size_t)layer * NINP * DM, T, NINP, DM, DM, 0, nullptr, 0, 0, 128}; pg8::StaticOrder S; S.init(T, NINP, F.G, F.blk);
            pg8::EpiInProj E{Z, USSM};
            for (int rep_ = 0; rep_ < REP_INPROJ; ++rep_) pg8::gemm2<pg8::EpiInProj, pg8::StaticOrder, pg8::ADense>(F.lds, g, S, E, F.tid);
        }
        SEAM(pb + 1);
        if (IN(pb + 2)) {
            for (int rep_ = 0; rep_ < REP_CMP; ++rep_) {
                { pg8::Gemm g{Z, (const bf16*)(ws + WS_W1T) + (size_t)layer * 2 * 256 * 2048, 0, 256, 2048, ZP, (size_t)256 * 2048, nullptr, 0, 0, ZP * 2};
                  pg8::CmpOrder S{F.G, F.blk}; pg8::EpiCmpHid E{(bf16*)(ws + WS_HIDC), (const float*)(ws + WS_CBIAS) + layer * 128};
                  pg8::gemm2<pg8::EpiCmpHid, pg8::CmpOrder, pg8::ACompress>(F.lds, g, S, E, F.tid); }
                asm volatile("s_waitcnt vmcnt(0)" ::: "memory"); __syncthreads();
                for (int L = F.blk; L < 32; L += F.G) compress_stage2(F, L >> 4, L & 15, (const bf16*)(ws + WS_HIDC), (const bf16*)(ws + WS_W2T) + (size_t)layer * 2 * 4096, KC, VC);
            }
#pragma unroll 1
            for (int L = F.blk; L < NGRP * BATCH; L += F.G) {
                const int sg = L >> 3, sb = L & 7;
                FRESH_IDS();
                { pg8::Gemm g{USSM, (const bf16*)(ws + WS_BT1) + (size_t)layer * 32 * 256 * 256, 0, 256, 256, 512, (size_t)256 * 256, nullptr, 0, (size_t)2048 * 512, 128};
                  pg8::SingleUnit S{sg, sb}; pg8::EpiXloc E{XL};
                  pg8::gemm2<pg8::EpiXloc, pg8::SingleUnit, pg8::ADense>(F.lds, g, S, E, F.tid); }
                asm volatile("s_waitcnt vmcnt(0)" ::: "memory"); __syncthreads();
                for (int rep_ = 0; rep_ < REP_CARRY; ++rep_)
                if (F.wave == 0) ssm_carry_item(sb, sg, kp->in[6] + layer * NGRP * SST, kp->in[7] + layer * NGRP * SST, kp->in[13] + layer * NGRP, XL, USSM, F.lane);
                asm volatile("s_waitcnt vmcnt(0)" ::: "memory"); __syncthreads();
                FRESH_IDS();
                { pg8::Gemm g{USSM, (const bf16*)(ws + WS_BT2) + (size_t)layer * 32 * 256 * 384, 0, 256, 384, 512, (size_t)256 * 384, nullptr, 0, (size_t)2048 * 512, 128};
                  pg8::SingleUnit S{sg, sb}; pg8::EpiSsmOut E{G1};
                  pg8::gemm2<pg8::EpiSsmOut, pg8::SingleUnit, pg8::ADense>(F.lds, g, S, E, F.tid); }
            }
            if (F.G > 64) { if (F.blk >= 32) convert_experts(F, kp, ws, layer, (F.blk - 32) * NWAVES + F.wave, (F.G - 32) * NWAVES); }
            else convert_experts(F, kp, ws, layer, F.blk * NWAVES + F.wave, F.G * NWAVES);
        }
        SEAM(pb + 2);
        if (IN(pb + 3)) {
            { pg8::Gemm g{G1, (const bf16*)(ws + WS_WGLU) + (size_t)layer * 2 * D_SSM * D_SSM, T, 2 * D_SSM, D_SSM, D_SSM, 0, nullptr, 0, 0, 128}; pg8::StaticOrder S; S.init(T, 2 * D_SSM, F.G, F.blk);
              pg8::EpiGlu E{YC, DM};
              for (int rep_ = 0; rep_ < REP_GLU; ++rep_) pg8::gemm2<pg8::EpiGlu, pg8::StaticOrder, pg8::ADense>(F.lds, g, S, E, F.tid); }
            __syncthreads();
            int last_hkv = -1;
            for (int rep_ = 0; rep_ < REP_ATTN; ++rep_)
            for (int slot = F.blk; slot < 256; slot += F.G) {
                const int bh = slot >> 4, sq = slot & 15;
#pragma unroll 1
                for (int uq = 0; uq < 4; ++uq) { const int jt = uq == 0 ? 63 - sq : (uq == 1 ? 32 + sq : (uq == 2 ? 31 - sq : sq));
                    nsa::unit((LAS char*)F.lds, F.tid, bh >> 1, bh & 1, jt, Z, KC, VC, kp->in[18], YC, (bh & 1) != last_hkv); last_hkv = bh & 1; }
            }
        }
        SEAM(pb + 3);
        if (IN(pb + 4)) {
            pg8::Gemm g{YC, (const bf16*)(ws + WS_WOUT) + (size_t)layer * DM * DM, T, DM, DM, DM, 0, nullptr, 0, 0, 128}; pg8::StaticOrder S; S.init(T, DM, F.G, F.blk);
            pg8::EpiResidB E{layer == 0 ? kp->in[0] : nullptr, XB, XB};
            pg8::gemm2<pg8::EpiResidB, pg8::StaticOrder, pg8::ADense>(F.lds, g, S, E, F.tid);
        }
        SEAM(pb + 4);
        if (IN(pb + 5)) ph_norm_route(F, XB, kp->in[2] + layer * DM, kp->in[19] + (size_t)layer * DM * 4, kp->in[20] + layer * 4, kp->in[21] + (size_t)layer * 4 * DM * 8, kp->in[22] + layer * 32, HN, gcnt, LIST, LISTW);
        if (IN(pb + 5)) for (int rep_ = 1; rep_ < REP_ROUTE; ++rep_) ph_norm_route(F, XB, kp->in[2] + layer * DM, kp->in[19] + (size_t)layer * DM * 4, kp->in[20] + layer * 4, kp->in[21] + (size_t)layer * 4 * DM * 8, kp->in[22] + layer * 32, HN, gcnt + (2 + rep_) * 32 * 64, (unsigned*)(ws + 484 * MiB), (float*)(ws + 488 * MiB));
        SEAM(pb + 5);
        if (IN(pb + 6)) {
            build_expert_tab(F, gcnt, etab);
            pg8::Gemm g{HN, (const bf16*)(ws + WS_WGU) + (size_t)layer * 32 * 512 * DM, 0, 512, DM, DM, (size_t)512 * DM, LIST, LCAP, 0, 128};
            pg8::ExpertOrder S{etab, 2, F.G, F.blk};
            pg8::EpiGateUp E{HID, LISTW, LCAP};
            for (int rep_ = 0; rep_ < REP_GU; ++rep_) pg8::gemm2<pg8::EpiGateUp, pg8::ExpertOrder, pg8::AList>(F.lds, g, S, E, F.tid);
        }
        SEAM(pb + 6);
        if (IN(pb + 7)) {
            build_expert_tab(F, gcnt, etab);
            pg8::Gemm g{HID, (const bf16*)(ws + WS_WDN) + (size_t)layer * 32 * DM * 256, 0, DM, 256, 256, (size_t)DM * 256, nullptr, 0, 0, 128};
            pg8::ExpertOrder S{etab, 4, F.G, F.blk};
            for (int rep_ = 1; rep_ < REP_DN; ++rep_) { pg8::EpiDown Ed{P1B, (long)(P2 - P1B), LIST, LCAP}; pg8::gemm2<pg8::EpiDown, pg8::ExpertOrder, pg8::ADense>(F.lds, g, S, Ed, F.tid); }
            pg8::EpiDown E{P1B, (long)(P2 - P1B), LIST, LCAP};
            pg8::gemm2<pg8::EpiDown, pg8::ExpertOrder, pg8::ADense>(F.lds, g, S, E, F.tid);
        }
        SEAM(pb + 7);
    }
    if (IN(N_PHASES - 1)) ph_final_norm(F, kp->out, XB, P1B, P2, kp->in[3]);
#undef IN
#undef SEAM
#undef HN
#undef Z
#undef YC
#undef G1
#undef KC
#undef VC
#undef LIST
#undef LISTW
#undef HID
#undef P2
#undef P1B
#undef XB
#undef USSM
#undef XL
}

extern "C" void kernel_launch(void* const* d_in, const int* in_sizes, int n_in, void* d_out, int out_size, void* d_ws, size_t ws_size, hipStream_t stream) {
    static int grid = 0;
    if (grid == 0) {
        if (n_in != 26 || out_size != T * DM || ws_size < WS_END) { fprintf(stderr, "kernel_launch: unexpected shapes (n_in %d out %d ws %zu)\n", n_in, out_size, ws_size); grid = -1; return; }
        int dev = 0, cus = 0, per_cu = 0;
        if (hipGetDevice(&dev) != hipSuccess || hipDeviceGetAttribute(&cus, hipDeviceAttributeMultiprocessorCount, dev) != hipSuccess) { grid = -1; return; }
        if (hipFuncSetAttribute((const void*)fwd, hipFuncAttributeMaxDynamicSharedMemorySize, LDS_BYTES) != hipSuccess) { fprintf(stderr, "kernel_launch: hipFuncSetAttribute failed\n"); grid = -1; return; }
        if (hipOccupancyMaxActiveBlocksPerMultiprocessor(&per_cu, (const void*)fwd, NTHR, LDS_BYTES) != hipSuccess || per_cu < 1) fprintf(stderr, "kernel_launch: occupancy query says %d\n", per_cu);
        (void)hipGetLastError();
        grid = cus;
    }
    if (grid < 0) return;
    (void)hipMemsetAsync((char*)d_ws + WS_CTL, 0, CTL_ZERO_BYTES, stream);
    Args a{};
    for (int i = 0; i < 26; ++i) a.in[i] = (const float*)d_in[i];
    a.out = (float*)d_out; a.ws = (unsigned char*)d_ws;
    if (N_LAUNCH_MODE == 1) {
        a.ph_lo = 0; a.ph_hi = N_PHASES;
        hipLaunchKernelGGL(fwd, dim3(grid), dim3(NTHR), LDS_BYTES, stream, a);
    } else {
        for (int p = 0; p < N_PHASES; ++p) { a.ph_lo = p; a.ph_hi = p + 1; hipLaunchKernelGGL(fwd, dim3(grid), dim3(NTHR), LDS_BYTES, stream, a); }
    }
}
```

```cpp
#include <hip/hip_runtime.h>
#include <cstdio>
#include <cstdint>

#ifndef N_LAUNCH_MODE
#define N_LAUNCH_MODE 1
#endif

#define GAS __attribute__((address_space(1)))
#define LAS __attribute__((address_space(3)))
typedef unsigned short bf16;
typedef float f32x4 __attribute__((ext_vector_type(4)));
typedef unsigned u32x4 __attribute__((ext_vector_type(4)));
typedef unsigned u32x2 __attribute__((ext_vector_type(2)));

constexpr int BATCH = 8, SEQ = 4096, DM = 1024, T = BATCH * SEQ, DEPTH = 2;
constexpr int D_SSM = 512, NGRP = 32, SGRP = 16, SST = 64;
constexpr int D_IN = 1816, NINP = 2048, ZP = 1536;
constexpr int ZC_U = 0, ZC_Q = 0, ZC_KV = 512, ZC_G = 1280;
constexpr int NCMP = 255, NCMPP = 256;
constexpr float EPS = 1e-6f;
constexpr int NWAVES = 8, NTHR = 512;
constexpr float QSCALE = 0.125f * 1.4426950408889634f;

constexpr size_t MiB = 1u << 20;
constexpr size_t WS_CTL = 0, CTL_ZERO_BYTES = 1 * MiB;
constexpr size_t WS_KC = 1 * MiB, WS_VC = 2 * MiB, WS_ROUTE = 3 * MiB;
constexpr size_t WS_HIDC = 4 * MiB;
constexpr size_t WS_CBIAS = 5 * MiB;
constexpr size_t WS_W2T = 6 * MiB;
constexpr size_t WS_W1T = 8 * MiB;
constexpr size_t WS_HN = 16 * MiB;
constexpr size_t WS_Z = 80 * MiB;
constexpr size_t WS_XB = 176 * MiB;
constexpr size_t WS_YC = 240 * MiB;
constexpr size_t WS_G1 = 304 * MiB;
constexpr size_t WS_WIN = 336 * MiB;
constexpr size_t WS_WGLU = 344 * MiB;
constexpr size_t WS_WOUT = 346 * MiB;
constexpr size_t WS_WGU = 350 * MiB;
constexpr size_t WS_WDN = 414 * MiB;
constexpr size_t WS_LIST = 446 * MiB;
constexpr size_t WS_LISTW = 450 * MiB;
constexpr size_t WS_HID = 454 * MiB;
constexpr size_t WS_P2 = WS_Z;
constexpr size_t WS_USSM = WS_YC;
constexpr size_t WS_XL = WS_HID;
constexpr size_t WS_BT1 = 490 * MiB;
constexpr size_t WS_BT2 = 498 * MiB;
constexpr size_t WS_END = 510 * MiB;
constexpr int LCAP = 32768, CW_CNT = 8192;
constexpr int CW_BAR = 4096;

constexpr int LDS_BYTES = 163840;
constexpr int ETAB_OFF = LDS_BYTES - 1024, MISC_OFF = LDS_BYTES - 512;

__device__ __forceinline__ float bf2f(bf16 v) { return __uint_as_float(((unsigned)v) << 16); }
__device__ __forceinline__ unsigned f2bf(float f) { unsigned u = __float_as_uint(f); return (u + 0x7fffu + ((u >> 16) & 1u)) >> 16; }
__device__ __forceinline__ unsigned pk2(float lo, float hi) { unsigned r; asm("v_cvt_pk_bf16_f32 %0, %1, %2" : "=v"(r) : "v"(lo), "v"(hi)); return r; }
__device__ __forceinline__ float wave_sum(float v, int) {
    v += __builtin_bit_cast(float, __builtin_amdgcn_update_dpp(0, __builtin_bit_cast(int, v), 0xB1, 0xF, 0xF, true));
    v += __builtin_bit_cast(float, __builtin_amdgcn_update_dpp(0, __builtin_bit_cast(int, v), 0x4E, 0xF, 0xF, true));
    v += __builtin_bit_cast(float, __builtin_amdgcn_update_dpp(0, __builtin_bit_cast(int, v), 0x141, 0xF, 0xF, true));
    v += __builtin_bit_cast(float, __builtin_amdgcn_update_dpp(0, __builtin_bit_cast(int, v), 0x140, 0xF, 0xF, true));
    const int iv = __builtin_bit_cast(int, v);
    const float s0 = __builtin_bit_cast(float, __builtin_amdgcn_readlane(iv, 0)), s1 = __builtin_bit_cast(float, __builtin_amdgcn_readlane(iv, 16));
    const float s2 = __builtin_bit_cast(float, __builtin_amdgcn_readlane(iv, 32)), s3 = __builtin_bit_cast(float, __builtin_amdgcn_readlane(iv, 48));
    return (s0 + s1) + (s2 + s3);
}
__device__ __forceinline__ float wave_max(float v, int lane) {
#pragma unroll
    for (int o = 1; o < 64; o <<= 1) v = fmaxf(v, __int_as_float(__builtin_amdgcn_ds_bpermute((lane ^ o) << 2, __float_as_int(v))));
    return v;
}
__device__ __forceinline__ float lane_bcast(float v, int src) { return __int_as_float(__builtin_amdgcn_ds_bpermute(src << 2, __float_as_int(v))); }
__device__ __forceinline__ float gelu_tanh(float x) {
    const float u = 0.7978845608028654f * (x + 0.044715f * x * x * x);
    return 0.5f * x * (1.0f + tanhf(u));
}
__device__ __forceinline__ float sigmoidf_(float x) { return 1.0f / (1.0f + __expf(-x)); }
__device__ __forceinline__ int t5_bucket(int n) {
    if (n < 16) return n < 0 ? 0 : n;
    int b = 16;
    b += (n >= 19); b += (n >= 21); b += (n >= 24); b += (n >= 27); b += (n >= 31); b += (n >= 35); b += (n >= 40); b += (n >= 46);
    b += (n >= 52); b += (n >= 59); b += (n >= 67); b += (n >= 77); b += (n >= 87); b += (n >= 99); b += (n >= 113);
    return b;
}

#define XB_TMO      128
#define XB_XCNT(j)  (256  + 64 * (j))
#define XB_XSUB(j)  (1280 + 64 * (j))
#define XB_XGEN(j)  (2304 + 64 * (j))
#define XB_TOP      3328
#define XB_TOPGEN   3392
#define XCD_BAR_WORDS 3456
#define XB_SPIN_CAP (1u << 22)

__device__ __forceinline__ unsigned xb_ld(unsigned* p)              { return __hip_atomic_load(p, __ATOMIC_RELAXED, __HIP_MEMORY_SCOPE_AGENT); }
__device__ __forceinline__ unsigned xb_add(unsigned* p, unsigned v) { return __hip_atomic_fetch_add(p, v, __ATOMIC_RELAXED, __HIP_MEMORY_SCOPE_AGENT); }
__device__ __forceinline__ unsigned xb_xcc_id() { return (unsigned)__builtin_amdgcn_s_getreg((3 << 11) | 20) & 0xFu; }
#define XB_SPIN(cond, bar) do { unsigned _sp = 0; while (cond) { __builtin_amdgcn_s_sleep(1); \
    if ((++_sp & 255u) == 0u) { if (xb_ld(&(bar)[XB_TMO])) break; if (_sp > XB_SPIN_CAP) { atomicAdd(&(bar)[XB_TMO], 1u); break; } } } } while (0)

struct XcdBarrier { unsigned* bar; unsigned x; volatile LAS unsigned* st; };

__device__ __forceinline__ XcdBarrier xcd_barrier_post(unsigned* bar, volatile LAS unsigned* st) {
    XcdBarrier b; b.bar = bar; b.x = xb_xcc_id(); b.st = st;
    if (threadIdx.x == 0) (void)xb_add(&bar[XB_XCNT(b.x)], 1u);
    return b;
}
__device__ __forceinline__ void xcd_barrier_complete(unsigned* bar, unsigned x, unsigned& nloc, unsigned& nx) {
    const unsigned G = gridDim.x * gridDim.y * gridDim.z;
    unsigned sum, cnt, mine, sp = 0u;
    for (;;) {
        sum = 0u; cnt = 0u; mine = 0u;
#pragma unroll
        for (unsigned j = 0; j < 16; ++j) { const unsigned c = xb_ld(&bar[XB_XCNT(j)]); sum += c; cnt += (c > 0u) ? 1u : 0u; mine = (j == x) ? c : mine; }
        if (sum == G) break;
        __builtin_amdgcn_s_sleep(1);
        if ((++sp & 255u) == 0u) { if (xb_ld(&bar[XB_TMO])) break; if (sp > XB_SPIN_CAP) { atomicAdd(&bar[XB_TMO], 1u); break; } }
    }
    nloc = mine > 0u ? mine : 1u; nx = cnt > 0u ? cnt : 1u;
}
__device__ __forceinline__ void xcd_barrier(const XcdBarrier& b, const int tid) {
    asm volatile("s_waitcnt vmcnt(0)" ::: "memory");
    __syncthreads();
    if (tid == 0) {
        unsigned* bar = b.bar;
        __builtin_amdgcn_s_waitcnt(0);
        unsigned nloc = b.st[0], nx = b.st[1];
        if (nloc == 0u) { xcd_barrier_complete(bar, b.x, nloc, nx); b.st[0] = nloc; b.st[1] = nx; }
        const unsigned old = xb_add(&bar[XB_XSUB(b.x)], 1u);
        const unsigned gen = old / nloc;
        if (old + 1u == (gen + 1u) * nloc) {
            __builtin_amdgcn_fence(__ATOMIC_RELEASE, "agent");
            asm volatile("s_waitcnt vmcnt(0)" ::: "memory");
            const unsigned og = xb_add(&bar[XB_TOP], 1u);
            const unsigned tg = og / nx;
            if (og + 1u == (tg + 1u) * nx) xb_add(&bar[XB_TOPGEN], 1u);
            else XB_SPIN(xb_ld(&bar[XB_TOPGEN]) == tg, bar);
            __builtin_amdgcn_fence(__ATOMIC_ACQUIRE, "agent");
            xb_add(&bar[XB_XGEN(b.x)], 1u);
            asm volatile("s_waitcnt vmcnt(0)" ::: "memory");
        } else {
            XB_SPIN(xb_ld(&bar[XB_XGEN(b.x)]) == gen, bar);
            __builtin_amdgcn_fence(__ATOMIC_ACQUIRE, "agent");
            asm volatile("s_waitcnt vmcnt(0)" ::: "memory");
        }
    }
    __syncthreads();
}

namespace pg8 {
#define PG8_LAS __attribute__((address_space(3)))
typedef unsigned short bf16_t;
typedef short bf16x8 __attribute__((ext_vector_type(8)));
typedef float f32x4 __attribute__((ext_vector_type(4)));
typedef unsigned u32x4 __attribute__((ext_vector_type(4)));
constexpr int BM = 256, BK = 64, HALF = 128, HTB = HALF * BK * 2  , STAGE_BYTES = 8 * HTB, NXCD = 8, WGM = 8;

__host__ __device__ __forceinline__ int lds_byte(int r, int c) { const int st = (r >> 4) * 2 + (c >> 5), rr = r & 15, cc = c & 31, ob = rr * 64 + cc * 2; return st * 1024 + (ob ^ (((ob >> 9) & 1) << 5)); }
__host__ __device__ __forceinline__ void stage_rc(int b, int& R, int& C) { const int st = b / 1024, sb = b % 1024, swz = sb ^ (((sb >> 9) & 1) << 5); R = (st >> 1) * 16 + swz / 64; C = (st & 1) * 32 + (swz % 64) / 2; }
__host__ __device__ __forceinline__ int perm32(int rho) { const int n = rho >> 4, i = rho & 15; return 8 * (i >> 2) + 4 * n + (i & 3); }

struct Unit { int pm, pn, eb, p0, cnt; };
struct Gemm { const bf16_t* A; const bf16_t* Bt; int M, N, K; int lda; size_t bstride; const unsigned* list; int cap; size_t astride; int kstepA; };

struct StaticOrder {
    int nM, nN, nwg, G, c;
    __host__ __device__ void init(int M, int N, int G_, int c_) { nM = M / BM; nN = N / BM; nwg = nM * nN; G = G_; c = c_; }
    __host__ __device__ bool next(int i, Unit& u) const {
        const long L = (long)i * G + c; if (L >= nwg) return false;
        int wgid = (int)L; { const int q = nwg / NXCD, r = nwg % NXCD, xcd = wgid % NXCD, off = wgid / NXCD; wgid = (xcd < r ? xcd * (q + 1) : r * (q + 1) + (xcd - r) * q) + off; }
        const int nig = WGM * nN, gid = wgid / nig, fm = gid * WGM, gsz = (nM - fm) < WGM ? (nM - fm) : WGM;
        u.pm = fm + ((wgid % nig) % gsz); u.pn = (wgid % nig) / gsz; u.eb = 0; u.p0 = 0; u.cnt = 0; return true;
    }
    __device__ __forceinline__ void a_ready(const Unit&) const {}
    __device__ __forceinline__ void done(const Unit&) const {}
};

__device__ __forceinline__ unsigned cvt_pk_bf16(float lo, float hi) { unsigned r; asm volatile("v_cvt_pk_bf16_f32 %0, %1, %2" : "=v"(r) : "v"(lo), "v"(hi)); return r; }
typedef float f32x2 __attribute__((ext_vector_type(2)));
__device__ __forceinline__ f32x2 gelu_pk(f32x2 v) {
    const f32x2 av = __builtin_elementwise_abs(v), d = av * 0.2316418882f + 1.0f;
    f32x2 t; t.x = __builtin_amdgcn_rcpf(d.x); t.y = __builtin_amdgcn_rcpf(d.y);
    f32x2 q = t * 0.5307027145f + (-0.7265760135f); q = q * t + 0.7107068705f; q = q * t + (-0.142248368f); q = q * t + 0.127414796f; q = q * t;
    const f32x2 s = (v * v) * (-0.72134752044f);
    f32x2 e; e.x = __builtin_amdgcn_exp2f(s.x); e.y = __builtin_amdgcn_exp2f(s.y);
    const f32x2 m = v * (q * e), r = v - m;
    f32x2 o; o.x = v.x < 0.f ? m.x : r.x; o.y = v.y < 0.f ? m.y : r.y; return o;
}

template <int ACT  > struct EpiBf16 {
    static constexpr bool PERM = true, AFTER_DRAIN = false; static_assert(ACT == 0 || ACT == 1, "EpiBf16: ACT is 0 (none) or 1 (gelu_pk)");
    bf16_t* O; int ldc; const float* bias; int split_cols; size_t split_stride; float scale0;
    __device__ __forceinline__ void operator()(const f32x4 (&acc)[2][2][4][2], const Unit& u, int wr, int wc, int fr, int fq) const {
        const int row0 = u.pm * BM + wr * 64 + fr; int colt = u.pn * BM; bf16_t* base = O;
        float sc = 1.f; if (split_cols) { const int t = colt / split_cols; base += (size_t)t * split_stride; colt -= t * split_cols; if (t == 0) sc = scale0; }
        const int col0 = colt + wc * 32 + 8 * fq, bcol0 = u.pn * BM + wc * 32 + 8 * fq;
        f32x4 bv[2][2];
#pragma unroll
        for (int bj = 0; bj < 2; ++bj)
#pragma unroll
            for (int n = 0; n < 2; ++n) bv[bj][n] = bias ? *(const f32x4*)(bias + bcol0 + bj * HALF + 4 * n) : (f32x4){0.f, 0.f, 0.f, 0.f};
#pragma unroll
        for (int ai = 0; ai < 2; ++ai)
#pragma unroll
            for (int m = 0; m < 4; ++m) { bf16_t* rowp = base + (size_t)(row0 + ai * HALF + m * 16) * ldc + col0;
#pragma unroll
                for (int bj = 0; bj < 2; ++bj) { f32x4 v0 = acc[ai][bj][m][0] + bv[bj][0], v1 = acc[ai][bj][m][1] + bv[bj][1];
                    if (ACT == 1) { f32x2 a = gelu_pk((f32x2){v0[0], v0[1]}), b = gelu_pk((f32x2){v0[2], v0[3]}), c = gelu_pk((f32x2){v1[0], v1[1]}), d = gelu_pk((f32x2){v1[2], v1[3]});
                        v0 = (f32x4){a.x, a.y, b.x, b.y}; v1 = (f32x4){c.x, c.y, d.x, d.y}; }
                    v0 = v0 * sc; v1 = v1 * sc; u32x4 w; w.x = cvt_pk_bf16(v0[0], v0[1]); w.y = cvt_pk_bf16(v0[2], v0[3]); w.z = cvt_pk_bf16(v1[0], v1[1]); w.w = cvt_pk_bf16(v1[2], v1[3]);
                    *(u32x4*)(rowp + bj * HALF) = w; } }
    }
};
template <class Epi, class Sched, bool ALIGN_EPI = false, bool SP2 = false>
__device__ __forceinline__ void gemm_phase(PG8_LAS unsigned char* lds, const Gemm g, const Sched& S, const Epi& E) {
    int tid_ = threadIdx.x; asm volatile("" : "+v"(tid_));
    const int tid = tid_, wid = __builtin_amdgcn_readfirstlane(tid >> 6), lane = tid & 63, wr = wid >> 2, wc = wid & 3, fr = lane & 15, fq = lane >> 4;
    const int K = g.K, nt = K / BK;
    unsigned voffA[2], voffB[2];
#pragma unroll
    for (int i = 0; i < 2; ++i) { int R, C; stage_rc(tid * 16 + i * 8192, R, C); const int Rb = Epi::PERM ? ((R & ~31) + perm32(R & 31)) : R;
        voffA[i] = (unsigned)(R * K + C) * 2u; voffB[i] = (unsigned)(Rb * K + C) * 2u; }
    const size_t kstep = (size_t)(BK * 2);
    const size_t hstep = (size_t)HALF * K * 2;
    const size_t tstep = 2 * hstep;
    const unsigned ldsw = (unsigned)wid * 1024u;
    const int aoff = lds_byte(wr * 64 + fr, fq * 8), boff = lds_byte(wc * 32 + fr, fq * 8);
#define PG8_SA(b, h) (((b) * 2 + (h)) * HTB)
#define PG8_SB(b, h) ((4 + (b) * 2 + (h)) * HTB)
#define PG8_STAGE(bufoff, gbase, voff) do { _Pragma("unroll") for (int _i = 0; _i < 2; ++_i) \
        __builtin_amdgcn_global_load_lds((const unsigned*)((const char*)(gbase) + (voff)[_i]), (PG8_LAS unsigned*)(lds + (bufoff) + ldsw + _i * 8192), 16, 0, 0); } while (0)
#define PG8_LDA(dst, b, h) do { _Pragma("unroll") for (int m = 0; m < 4; ++m) _Pragma("unroll") for (int k = 0; k < 2; ++k) dst[m][k] = *(const PG8_LAS bf16x8*)(lds + PG8_SA(b, h) + aoff + m * 2048 + k * 1024); } while (0)
#define PG8_LDB(dst, b, h) do { _Pragma("unroll") for (int n = 0; n < 2; ++n) _Pragma("unroll") for (int k = 0; k < 2; ++k) dst[n][k] = *(const PG8_LAS bf16x8*)(lds + PG8_SB(b, h) + boff + n * 2048 + k * 1024); } while (0)
#define PG8_MMA(ai, bj, At, Bt) do { __builtin_amdgcn_s_setprio(1); _Pragma("unroll") for (int m = 0; m < 4; ++m) _Pragma("unroll") for (int n = 0; n < 2; ++n) _Pragma("unroll") for (int k = 0; k < 2; ++k) \
        acc[ai][bj][m][n] = __builtin_amdgcn_mfma_f32_16x16x32_bf16(Bt[n][k], At[m][k], acc[ai][bj][m][n], 0, 0, 0); __builtin_amdgcn_s_setprio(0); } while (0)
#define PG8_WAIT_V(n) asm volatile("s_waitcnt vmcnt(" #n ")" ::: "memory")
#define PG8_WAIT_L(n) asm volatile("s_waitcnt lgkmcnt(" #n ")" ::: "memory")
#define PG8_BAR __builtin_amdgcn_s_barrier()
#define PG8_SCHED __builtin_amdgcn_sched_barrier(0)
    Unit cur, nxt; int ui = 0;
    if (!S.next(0, cur)) return;
    f32x4 acc[2][2][4][2];
#pragma unroll
    for (int a = 0; a < 2; ++a)
#pragma unroll
        for (int b = 0; b < 2; ++b)
#pragma unroll
            for (int m = 0; m < 4; ++m)
#pragma unroll
                for (int n = 0; n < 2; ++n) acc[a][b][m][n] = (f32x4){0.f, 0.f, 0.f, 0.f};
    bf16x8 At[4][2], B0[2][2], B1[2][2];
    const char* cA = (const char*)g.A + (size_t)cur.pm * tstep; const char* cB = (const char*)g.Bt + (size_t)cur.pn * tstep;
    S.a_ready(cur);
    if constexpr (SP2) {
        PG8_STAGE(PG8_SB(0, 0), cB, voffB); PG8_STAGE(PG8_SB(0, 1), cB + hstep, voffB); PG8_STAGE(PG8_SA(0, 0), cA, voffA); PG8_STAGE(PG8_SA(0, 1), cA + hstep, voffA);
        if (wr == 1) PG8_BAR;
        PG8_WAIT_V(2); PG8_BAR;
        PG8_STAGE(PG8_SB(1, 0), cB + kstep, voffB); PG8_STAGE(PG8_SA(1, 0), cA + kstep, voffA); PG8_STAGE(PG8_SB(1, 1), cB + hstep + kstep, voffB);
        PG8_WAIT_V(6); PG8_BAR;
    } else {
        PG8_STAGE(PG8_SB(0, 0), cB, voffB); PG8_STAGE(PG8_SA(0, 0), cA, voffA); PG8_STAGE(PG8_SB(0, 1), cB + hstep, voffB); PG8_STAGE(PG8_SA(0, 1), cA + hstep, voffA);
        if (wr == 1) PG8_BAR;
        PG8_WAIT_V(4); PG8_BAR;
        PG8_STAGE(PG8_SB(1, 0), cB + kstep, voffB); PG8_STAGE(PG8_SA(1, 0), cA + kstep, voffA); PG8_STAGE(PG8_SB(1, 1), cB + hstep + kstep, voffB);
        PG8_WAIT_V(6); PG8_BAR;
    }
    for (;;) {
        const bool has_next = S.next(ui + 1, nxt);
        const char* nA = has_next ? (const char*)g.A + (size_t)nxt.pm * tstep : cA; const char* nB = has_next ? (const char*)g.Bt + (size_t)nxt.pn * tstep : cB;
        for (int t = 0; t < nt; t += 2) {
            const bool last = (t == nt - 2);
            const char* a1 = cA + (size_t)(t + 1) * kstep;
            const char* a2 = last ? nA : cA + (size_t)(t + 2) * kstep; const char* b2 = last ? nB : cB + (size_t)(t + 2) * kstep;
            const char* a3 = a2 + kstep; const char* b3 = b2 + kstep;
            if (last && has_next) S.a_ready(nxt);
            if constexpr (SP2) {
            PG8_LDB(B0, 0, 0); PG8_LDB(B1, 0, 1); PG8_SCHED; PG8_LDA(At, 0, 0); PG8_STAGE(PG8_SA(1, 1), a1 + hstep, voffA);
            PG8_WAIT_V(8); PG8_WAIT_L(0); PG8_BAR; PG8_MMA(0, 0, At, B0); PG8_MMA(0, 1, At, B1); PG8_BAR; PG8_SCHED;
            PG8_LDA(At, 0, 1); PG8_STAGE(PG8_SB(0, 0), b2, voffB); PG8_STAGE(PG8_SB(0, 1), b2 + hstep, voffB); PG8_STAGE(PG8_SA(0, 0), a2, voffA);
            PG8_WAIT_V(8); PG8_WAIT_L(0); PG8_BAR; PG8_MMA(1, 0, At, B0); PG8_MMA(1, 1, At, B1); PG8_BAR; PG8_SCHED;
            PG8_LDB(B0, 1, 0); PG8_LDB(B1, 1, 1); PG8_SCHED; PG8_LDA(At, 1, 0); PG8_STAGE(PG8_SA(0, 1), a2 + hstep, voffA);
            PG8_WAIT_V(8); PG8_WAIT_L(0); PG8_BAR; PG8_MMA(0, 0, At, B0); PG8_MMA(0, 1, At, B1); PG8_BAR; PG8_SCHED;
            PG8_LDA(At, 1, 1); PG8_STAGE(PG8_SB(1, 0), b3, voffB); PG8_STAGE(PG8_SB(1, 1), b3 + hstep, voffB); PG8_STAGE(PG8_SA(1, 0), a3, voffA);
            PG8_WAIT_V(8); PG8_WAIT_L(0); PG8_BAR; PG8_MMA(1, 0, At, B0); PG8_MMA(1, 1, At, B1); PG8_BAR; PG8_SCHED;
            } else {
            PG8_LDB(B0, 0, 0); PG8_SCHED; PG8_LDA(At, 0, 0); PG8_STAGE(PG8_SA(1, 1), a1 + hstep, voffA);
            PG8_WAIT_L(8); PG8_BAR; PG8_WAIT_L(0); PG8_MMA(0, 0, At, B0); PG8_BAR; PG8_SCHED;
            PG8_LDB(B1, 0, 1); PG8_STAGE(PG8_SB(0, 0), b2, voffB);
            PG8_BAR; PG8_WAIT_L(0); PG8_MMA(0, 1, At, B1); PG8_BAR;
            PG8_LDA(At, 0, 1); PG8_STAGE(PG8_SA(0, 0), a2, voffA);
            PG8_BAR; PG8_WAIT_L(0); PG8_MMA(1, 0, At, B0); PG8_BAR; PG8_SCHED;
            PG8_STAGE(PG8_SB(0, 1), b2 + hstep, voffB);
            PG8_WAIT_V(6); PG8_BAR; PG8_MMA(1, 1, At, B1); PG8_BAR;
            PG8_LDB(B0, 1, 0); PG8_SCHED; PG8_LDA(At, 1, 0); PG8_STAGE(PG8_SA(0, 1), a2 + hstep, voffA);
            PG8_WAIT_L(8); PG8_BAR; PG8_WAIT_L(0); PG8_MMA(0, 0, At, B0); PG8_BAR; PG8_SCHED;
            PG8_LDB(B1, 1, 1); PG8_STAGE(PG8_SB(1, 0), b3, voffB);
            PG8_BAR; PG8_WAIT_L(0); PG8_MMA(0, 1, At, B1); PG8_BAR;
            PG8_LDA(At, 1, 1); PG8_STAGE(PG8_SA(1, 0), a3, voffA);
            PG8_BAR; PG8_WAIT_L(0); PG8_MMA(1, 0, At, B0); PG8_BAR; PG8_SCHED;
            PG8_STAGE(PG8_SB(1, 1), b3 + hstep, voffB);
            PG8_WAIT_V(6); PG8_BAR; PG8_MMA(1, 1, At, B1); PG8_BAR;
            }
        }
        if constexpr (ALIGN_EPI) { if (wr == 0) PG8_BAR; }
        if constexpr (!Epi::AFTER_DRAIN) { E(acc, cur, wr, wc, fr, fq); S.done(cur); }
        if (!has_next) break;
#pragma unroll
        for (int a = 0; a < 2; ++a)
#pragma unroll
            for (int b = 0; b < 2; ++b)
#pragma unroll
                for (int m = 0; m < 4; ++m)
#pragma unroll
                    for (int n = 0; n < 2; ++n) acc[a][b][m][n] = (f32x4){0.f, 0.f, 0.f, 0.f};
        cur = nxt; cA = nA; cB = nB; ++ui;
        if constexpr (ALIGN_EPI) { if (wr == 1) PG8_BAR; }
    }
    PG8_WAIT_V(0);
    if constexpr (!ALIGN_EPI) { if (wr == 0) PG8_BAR; }
    PG8_BAR;
    if constexpr (Epi::AFTER_DRAIN) { E.fused(acc, cur, wr, wc, fr, fq, lds, wid, lane); S.done(cur); }
#undef PG8_SA
#undef PG8_SB
#undef PG8_STAGE
#undef PG8_LDA
#undef PG8_LDB
#undef PG8_MMA
#undef PG8_WAIT_V
#undef PG8_WAIT_L
#undef PG8_BAR
#undef PG8_SCHED
}

__device__ __forceinline__ float sigm(float x) { return 1.0f / (1.0f + __expf(-x)); }
struct EpiGlu {
    static constexpr bool PERM = true, AFTER_DRAIN = false;
    bf16_t* O; int ldc;
    __device__ __forceinline__ void operator()(const f32x4 (&acc)[2][2][4][2], const Unit& u, int wr, int wc, int fr, int fq) const {
        const int row0 = u.pm * BM + wr * 64 + fr, col0 = u.pn * HALF + wc * 32 + 8 * fq;
#pragma unroll
        for (int ai = 0; ai < 2; ++ai)
#pragma unroll
            for (int m = 0; m < 4; ++m) {
                bf16_t* rowp = O + (size_t)(row0 + ai * HALF + m * 16) * ldc + col0;
                const f32x4 a0 = acc[ai][0][m][0], a1 = acc[ai][0][m][1], b0 = acc[ai][1][m][0], b1 = acc[ai][1][m][1];
                u32x4 w;
                w.x = cvt_pk_bf16(a0[0] * sigm(b0[0]), a0[1] * sigm(b0[1])); w.y = cvt_pk_bf16(a0[2] * sigm(b0[2]), a0[3] * sigm(b0[3]));
                w.z = cvt_pk_bf16(a1[0] * sigm(b1[0]), a1[1] * sigm(b1[1])); w.w = cvt_pk_bf16(a1[2] * sigm(b1[2]), a1[3] * sigm(b1[3]));
                *(u32x4*)rowp = w;
            }
    }
};
struct EpiResid {
    static constexpr bool PERM = false, AFTER_DRAIN = false;
    const float* X; float* O; int ldc;
    __device__ __forceinline__ void operator()(const f32x4 (&acc)[2][2][4][2], const Unit& u, int wr, int wc, int fr, int fq) const {
        const int row0 = u.pm * BM + wr * 64 + fr, col0 = u.pn * BM + wc * 32 + 4 * fq;
#pragma unroll
        for (int ai = 0; ai < 2; ++ai)
#pragma unroll
            for (int m = 0; m < 4; ++m) {
                const size_t off = (size_t)(row0 + ai * HALF + m * 16) * ldc + col0;
#pragma unroll
                for (int bj = 0; bj < 2; ++bj)
#pragma unroll
                    for (int n = 0; n < 2; ++n) *(f32x4*)(O + off + bj * HALF + n * 16) = *(const f32x4*)(X + off + bj * HALF + n * 16) + acc[ai][bj][m][n];
            }
    }
};
struct EpiResidB {
    static constexpr bool PERM = true, AFTER_DRAIN = false;
    const float* X32; const bf16_t* XBin; bf16_t* XBout;
    __device__ __forceinline__ void operator()(const f32x4 (&acc)[2][2][4][2], const Unit& u, int wr, int wc, int fr, int fq) const {
        const int row0 = u.pm * BM + wr * 64 + fr, col0 = u.pn * BM + wc * 32 + 8 * fq;
#pragma unroll
        for (int ai = 0; ai < 2; ++ai)
#pragma unroll
            for (int m = 0; m < 4; ++m) {
                const size_t off = (size_t)(row0 + ai * HALF + m * 16) * 1024 + col0;
#pragma unroll
                for (int bj = 0; bj < 2; ++bj) {
                    f32x4 r0, r1;
                    if (X32) { r0 = *(const f32x4*)(X32 + off + bj * HALF); r1 = *(const f32x4*)(X32 + off + bj * HALF + 4); }
                    else { const u32x4 q = *(const u32x4*)(XBin + off + bj * HALF);
                        r0 = (f32x4){__uint_as_float(q.x << 16), __uint_as_float(q.x & 0xffff0000u), __uint_as_float(q.y << 16), __uint_as_float(q.y & 0xffff0000u)};
                        r1 = (f32x4){__uint_as_float(q.z << 16), __uint_as_float(q.z & 0xffff0000u), __uint_as_float(q.w << 16), __uint_as_float(q.w & 0xffff0000u)}; }
                    const f32x4 v0 = acc[ai][bj][m][0] + r0, v1 = acc[ai][bj][m][1] + r1;
                    u32x4 w; w.x = cvt_pk_bf16(v0[0], v0[1]); w.y = cvt_pk_bf16(v0[2], v0[3]); w.z = cvt_pk_bf16(v1[0], v1[1]); w.w = cvt_pk_bf16(v1[2], v1[3]);
                    *(u32x4*)(XBout + off + bj * HALF) = w; }
                if (m & 1) asm volatile("" ::: "memory");
            }
    }
};

struct ADense { static constexpr bool GATHER = false; __device__ __forceinline__ static unsigned rowoff(const Gemm&, const Unit&, int) { return 0u; } };
struct AList { static constexpr bool GATHER = true;
    __device__ __forceinline__ static unsigned rowoff(const Gemm& g, const Unit& u, int r) { const int pos = u.p0 + r; const unsigned tok = pos < u.cnt ? (g.list[(size_t)u.eb * g.cap + pos] >> 1) : 0u; return tok * (unsigned)g.lda * 2u; } };
struct ACompress { static constexpr bool GATHER = true;
    __device__ __forceinline__ static unsigned rowoff(const Gemm&, const Unit& u, int r) { const unsigned rg = (unsigned)(u.pm * BM + r), b = rg >> 9, n = (rg >> 1) & 255u, hkv = rg & 1u;
        return (((b * 4096u + 16u * n) * 1536u) + 512u + (unsigned)u.eb * 128u + hkv * 64u) * 2u; } };
template <class Epi, class Sched, class AMap>
__device__ __forceinline__ void gemm2(PG8_LAS unsigned char* lds, const Gemm g, const Sched& S, const Epi& E, const int tid) {
    constexpr bool GATHER = AMap::GATHER;
    int K_ = g.K; asm volatile("" : "+s"(K_));
    const int wid = __builtin_amdgcn_readfirstlane(tid >> 6), lane = tid & 63, wr = wid >> 2, wc = wid & 3, fr = lane & 15, fq = lane >> 4;
    const int K = K_, nt = K / BK, lda = g.lda;
    unsigned voffA[2], voffB[2]; int Rst[2], Cst[2];
#pragma unroll
    for (int i = 0; i < 2; ++i) { int R, C; stage_rc(tid * 16 + i * 8192, R, C); const int Rb = Epi::PERM ? ((R & ~31) + perm32(R & 31)) : R;
        voffA[i] = (unsigned)(R * lda + C) * 2u; voffB[i] = (unsigned)(Rb * K + C) * 2u; Rst[i] = R; Cst[i] = C; }
    const size_t kstep = (size_t)(BK * 2), kstepA = (size_t)g.kstepA;
    const size_t hstepA = (size_t)HALF * lda * 2, tstepA = 2 * hstepA, hstepB = (size_t)HALF * K * 2, tstepB = 2 * hstepB;
    const unsigned ldsw = (unsigned)wid * 1024u;
    const int aoff = lds_byte(wr * 64 + fr, fq * 8), boff = lds_byte(wc * 32 + fr, fq * 8);
#define PG8_SA(b, h) (((b) * 2 + (h)) * HTB)
#define PG8_SB(b, h) ((4 + (b) * 2 + (h)) * HTB)
#define PG8_STAGE(bufoff, gbase, voff) do { _Pragma("unroll") for (int _i = 0; _i < 2; ++_i) \
        __builtin_amdgcn_global_load_lds((const unsigned*)((const char*)(gbase) + (voff)[_i]), (PG8_LAS unsigned*)(lds + (bufoff) + ldsw + _i * 8192), 16, 0, 0); } while (0)
#define PG8_STAGE_A(bufoff, gbase, h) do { if constexpr (GATHER) { PG8_STAGE(bufoff, gbase, vg[h]); } else { PG8_STAGE(bufoff, (gbase) + (h) * hstepA, voffA); } } while (0)
#define PG8_GOFFS(u, dst) do { _Pragma("unroll") for (int _h = 0; _h < 2; ++_h) _Pragma("unroll") for (int _i = 0; _i < 2; ++_i) dst[_h][_i] = AMap::rowoff(g, (u), _h * HALF + Rst[_i]) + (unsigned)Cst[_i] * 2u; } while (0)
#define PG8_LDA(dst, b, h) do { _Pragma("unroll") for (int m = 0; m < 4; ++m) _Pragma("unroll") for (int k = 0; k < 2; ++k) dst[m][k] = *(const PG8_LAS bf16x8*)(lds + PG8_SA(b, h) + aoff + m * 2048 + k * 1024); } while (0)
#define PG8_LDB(dst, b, h) do { _Pragma("unroll") for (int n = 0; n < 2; ++n) _Pragma("unroll") for (int k = 0; k < 2; ++k) dst[n][k] = *(const PG8_LAS bf16x8*)(lds + PG8_SB(b, h) + boff + n * 2048 + k * 1024); } while (0)
#define PG8_MMA(ai, bj, At, Bt) do { __builtin_amdgcn_s_setprio(1); _Pragma("unroll") for (int m = 0; m < 4; ++m) _Pragma("unroll") for (int n = 0; n < 2; ++n) _Pragma("unroll") for (int k = 0; k < 2; ++k) \
        acc[ai][bj][m][n] = __builtin_amdgcn_mfma_f32_16x16x32_bf16(Bt[n][k], At[m][k], acc[ai][bj][m][n], 0, 0, 0); __builtin_amdgcn_s_setprio(0); } while (0)
#define PG8_WAIT_V(n) asm volatile("s_waitcnt vmcnt(" #n ")" ::: "memory")
#define PG8_WAIT_L(n) asm volatile("s_waitcnt lgkmcnt(" #n ")" ::: "memory")
#define PG8_BAR __builtin_amdgcn_s_barrier()
#define PG8_SCHED __builtin_amdgcn_sched_barrier(0)
    Unit cur, nxt; int ui = 0;
    if (!S.next(0, cur)) return;
    f32x4 acc[2][2][4][2];
#pragma unroll
    for (int a = 0; a < 2; ++a)
#pragma unroll
        for (int b = 0; b < 2; ++b)
#pragma unroll
            for (int m = 0; m < 4; ++m)
#pragma unroll
                for (int n = 0; n < 2; ++n) acc[a][b][m][n] = (f32x4){0.f, 0.f, 0.f, 0.f};
    bf16x8 At[4][2], B0[2][2], B1[2][2];
    unsigned vg[2][2] = {{0u, 0u}, {0u, 0u}};
    if constexpr (GATHER) PG8_GOFFS(cur, vg);
    const char* cA = (const char*)g.A + (GATHER ? (size_t)0 : (size_t)cur.pm * tstepA + (size_t)cur.eb * g.astride * 2);
    const char* cB = (const char*)g.Bt + ((size_t)cur.eb * g.bstride) * 2 + (size_t)cur.pn * tstepB;
    S.a_ready(cur);
    PG8_STAGE(PG8_SB(0, 0), cB, voffB); PG8_STAGE(PG8_SB(0, 1), cB + hstepB, voffB); PG8_STAGE_A(PG8_SA(0, 0), cA, 0); PG8_STAGE_A(PG8_SA(0, 1), cA, 1);
    if (wr == 1) PG8_BAR;
    PG8_WAIT_V(2); PG8_BAR;
    PG8_STAGE(PG8_SB(1, 0), cB + kstep, voffB); PG8_STAGE_A(PG8_SA(1, 0), cA + kstepA, 0); PG8_STAGE(PG8_SB(1, 1), cB + hstepB + kstep, voffB);
    PG8_WAIT_V(6); PG8_BAR;
    for (;;) {
        const bool has_next = S.next(ui + 1, nxt);
        const char* nA = has_next ? (const char*)g.A + (GATHER ? (size_t)0 : (size_t)nxt.pm * tstepA + (size_t)nxt.eb * g.astride * 2) : cA;
        const char* nB = has_next ? (const char*)g.Bt + ((size_t)nxt.eb * g.bstride) * 2 + (size_t)nxt.pn * tstepB : cB;
        for (int t = 0; t < nt; t += 2) {
            const bool last = (t == nt - 2);
            const char* a1 = cA + (size_t)(t + 1) * kstepA;
            const char* a2 = last ? nA : cA + (size_t)(t + 2) * kstepA; const char* b2 = last ? nB : cB + (size_t)(t + 2) * kstep;
            const char* a3 = a2 + kstepA; const char* b3 = b2 + kstep;
            unsigned vn1[2] = {vg[1][0], vg[1][1]};
            if constexpr (GATHER) { if (last && has_next) { unsigned vn[2][2]; PG8_GOFFS(nxt, vn); vg[0][0] = vn[0][0]; vg[0][1] = vn[0][1]; vn1[0] = vn[1][0]; vn1[1] = vn[1][1]; } }
            if (last && has_next) S.a_ready(nxt);
            PG8_LDB(B0, 0, 0); PG8_LDB(B1, 0, 1); PG8_SCHED; PG8_LDA(At, 0, 0); PG8_STAGE_A(PG8_SA(1, 1), a1, 1);
            PG8_WAIT_V(8); PG8_WAIT_L(0); PG8_BAR; PG8_MMA(0, 0, At, B0); PG8_MMA(0, 1, At, B1); PG8_BAR; PG8_SCHED;
            if constexpr (GATHER) { vg[1][0] = vn1[0]; vg[1][1] = vn1[1]; }
            PG8_LDA(At, 0, 1); PG8_STAGE(PG8_SB(0, 0), b2, voffB); PG8_STAGE(PG8_SB(0, 1), b2 + hstepB, voffB); PG8_STAGE_A(PG8_SA(0, 0), a2, 0);
            PG8_WAIT_V(8); PG8_WAIT_L(0); PG8_BAR; PG8_MMA(1, 0, At, B0); PG8_MMA(1, 1, At, B1); PG8_BAR; PG8_SCHED;
            PG8_LDB(B0, 1, 0); PG8_LDB(B1, 1, 1); PG8_SCHED; PG8_LDA(At, 1, 0); PG8_STAGE_A(PG8_SA(0, 1), a2, 1);
            PG8_WAIT_V(8); PG8_WAIT_L(0); PG8_BAR; PG8_MMA(0, 0, At, B0); PG8_MMA(0, 1, At, B1); PG8_BAR; PG8_SCHED;
            PG8_LDA(At, 1, 1); PG8_STAGE(PG8_SB(1, 0), b3, voffB); PG8_STAGE(PG8_SB(1, 1), b3 + hstepB, voffB); PG8_STAGE_A(PG8_SA(1, 0), a3, 0);
            PG8_WAIT_V(8); PG8_WAIT_L(0); PG8_BAR; PG8_MMA(1, 0, At, B0); PG8_MMA(1, 1, At, B1); PG8_BAR; PG8_SCHED;
        }
        if (wr == 0) PG8_BAR;
        E(acc, cur, wr, wc, fr, fq); S.done(cur);
        if (!has_next) break;
#pragma unroll
        for (int a = 0; a < 2; ++a)
#pragma unroll
            for (int b = 0; b < 2; ++b)
#pragma unroll
                for (int m = 0; m < 4; ++m)
#pragma unroll
                    for (int n = 0; n < 2; ++n) acc[a][b][m][n] = (f32x4){0.f, 0.f, 0.f, 0.f};
        cur = nxt; cA = nA; cB = nB; ++ui;
        if (wr == 1) PG8_BAR;
    }
    PG8_WAIT_V(0);
    PG8_BAR;
#undef PG8_SA
#undef PG8_SB
#undef PG8_STAGE
#undef PG8_STAGE_A
#undef PG8_GOFFS
#undef PG8_LDA
#undef PG8_LDB
#undef PG8_MMA
#undef PG8_WAIT_V
#undef PG8_WAIT_L
#undef PG8_BAR
#undef PG8_SCHED
}

struct ExpertOrder {
    const PG8_LAS int* tab; int nN, G, c;
    __device__ __forceinline__ bool next(int i, Unit& u) const {
        int rt, pn, e;
        if ((G & 7) == 0) {
            const int x = c & 7, R = G >> 3, Lx = i * R + (c >> 3);
            const int n0 = (tab[x + 1] - tab[x]) * nN, n1 = (tab[x + 9] - tab[x + 8]) * nN, n2 = (tab[x + 17] - tab[x + 16]) * nN, n3 = (tab[x + 25] - tab[x + 24]) * nN;
            const int c1 = n0, c2 = n0 + n1, c3 = c2 + n2, c4 = c3 + n3;
            if (Lx >= c4) return false;
            const int k = (Lx >= c1 ? 1 : 0) + (Lx >= c2 ? 1 : 0) + (Lx >= c3 ? 1 : 0), ul = Lx - (k == 0 ? 0 : (k == 1 ? c1 : (k == 2 ? c2 : c3)));
            e = x + 8 * k; rt = tab[e] + ul / nN; pn = ul % nN;
        } else {
            const int total = tab[32] * nN; const long L = (long)i * G + c; if (L >= total) return false;
            rt = (int)L / nN; pn = (int)L % nN; e = 0;
#pragma unroll
            for (int k = 1; k < 32; ++k) e += (rt >= tab[k]) ? 1 : 0;
        }
        u.pm = __builtin_amdgcn_readfirstlane(rt); u.pn = __builtin_amdgcn_readfirstlane(pn); u.eb = __builtin_amdgcn_readfirstlane(e);
        u.p0 = __builtin_amdgcn_readfirstlane((rt - tab[e]) * BM); u.cnt = __builtin_amdgcn_readfirstlane(tab[33 + e]); return true;
    }
    __device__ __forceinline__ void a_ready(const Unit&) const {}
    __device__ __forceinline__ void done(const Unit&) const {}
};
struct EpiGateUp {
    static constexpr bool PERM = true, AFTER_DRAIN = false;
    bf16_t* H; const float* listw; int cap;
    __device__ __forceinline__ void operator()(const f32x4 (&acc)[2][2][4][2], const Unit& u, int wr, int wc, int fr, int fq) const {
        const int rl0 = wr * 64 + fr, col0 = u.pn * HALF + wc * 32 + 8 * fq;
#pragma unroll
        for (int ai = 0; ai < 2; ++ai)
#pragma unroll
            for (int m = 0; m < 4; ++m) {
                const int rl = rl0 + ai * HALF + m * 16, pos = u.p0 + rl;
                const float w = pos < u.cnt ? listw[(size_t)u.eb * cap + pos] : 0.f;
                bf16_t* rowp = H + (size_t)(u.pm * BM + rl) * 256 + col0;
                const f32x4 g0 = acc[ai][0][m][0], g1 = acc[ai][0][m][1], u0 = acc[ai][1][m][0], u1 = acc[ai][1][m][1];
                u32x4 o;
                o.x = cvt_pk_bf16(g0[0] * sigm(g0[0]) * u0[0] * w, g0[1] * sigm(g0[1]) * u0[1] * w); o.y = cvt_pk_bf16(g0[2] * sigm(g0[2]) * u0[2] * w, g0[3] * sigm(g0[3]) * u0[3] * w);
                o.z = cvt_pk_bf16(g1[0] * sigm(g1[0]) * u1[0] * w, g1[1] * sigm(g1[1]) * u1[1] * w); o.w = cvt_pk_bf16(g1[2] * sigm(g1[2]) * u1[2] * w, g1[3] * sigm(g1[3]) * u1[3] * w);
                *(u32x4*)rowp = o;
            }
    }
};
struct EpiDown {
    static constexpr bool PERM = true, AFTER_DRAIN = false;
    bf16_t* P1; long d12; const unsigned* list; int cap;
    __device__ __forceinline__ void operator()(const f32x4 (&acc)[2][2][4][2], const Unit& u, int wr, int wc, int fr, int fq) const {
        const int rl0 = wr * 64 + fr, col0 = u.pn * BM + wc * 32 + 8 * fq;
#pragma unroll
        for (int ai = 0; ai < 2; ++ai) {
            unsigned ent[4];
#pragma unroll
            for (int m = 0; m < 4; ++m) { const int pos = u.p0 + rl0 + ai * HALF + m * 16; ent[m] = pos < u.cnt ? list[(size_t)u.eb * cap + pos] : 0xffffffffu; }
#pragma unroll
            for (int m = 0; m < 4; ++m) {
                if (ent[m] != 0xffffffffu) {
                    bf16_t* dst = P1 + (long)(ent[m] & 1u) * d12 + (size_t)(ent[m] >> 1) * 1024 + col0;
#pragma unroll
                    for (int bj = 0; bj < 2; ++bj) { const f32x4 v0 = acc[ai][bj][m][0], v1 = acc[ai][bj][m][1];
                        u32x4 w; w.x = cvt_pk_bf16(v0[0], v0[1]); w.y = cvt_pk_bf16(v0[2], v0[3]); w.z = cvt_pk_bf16(v1[0], v1[1]); w.w = cvt_pk_bf16(v1[2], v1[3]);
                        *(u32x4*)(dst + bj * HALF) = w; }
                }
            }
            asm volatile("" ::: "memory");
        }
    }
};

struct BatchOrder {
    int nb, nM, nN, G, c;
    __device__ __forceinline__ bool next(int i, Unit& u) const {
        const long L = (long)i * G + c; if (L >= (long)nb * nM * nN) return false;
        const int per = nM * nN, e = (int)L / per, rem = (int)L % per;
        u.eb = e; u.pm = rem / nN; u.pn = rem % nN; u.p0 = 0; u.cnt = 0; return true;
    }
    __device__ __forceinline__ void a_ready(const Unit&) const {}
    __device__ __forceinline__ void done(const Unit&) const {}
};
struct EpiInProj {
    static constexpr bool PERM = true, AFTER_DRAIN = false;
    bf16_t* Zo; bf16_t* U;
    __device__ __forceinline__ void operator()(const f32x4 (&acc)[2][2][4][2], const Unit& u, int wr, int wc, int fr, int fq) const {
        const int row0 = u.pm * BM + wr * 64 + fr;
#pragma unroll
        for (int ai = 0; ai < 2; ++ai)
#pragma unroll
            for (int m = 0; m < 4; ++m) { const int row = row0 + ai * HALF + m * 16;
#pragma unroll
                for (int bj = 0; bj < 2; ++bj) { const int c0 = u.pn * BM + bj * HALF + wc * 32 + 8 * fq;
                    const f32x4 v0 = acc[ai][bj][m][0], v1 = acc[ai][bj][m][1];
                    u32x4 w; w.x = cvt_pk_bf16(v0[0], v0[1]); w.y = cvt_pk_bf16(v0[2], v0[3]); w.z = cvt_pk_bf16(v1[0], v1[1]); w.w = cvt_pk_bf16(v1[2], v1[3]);
                    bf16_t* dst = u.pn < 2 ? U + ((size_t)((c0 >> 4) * 2048 + (row >> 4)) * 512 + (row & 15) * 16 + (c0 & 15)) : Zo + (size_t)row * 1536 + (c0 - 512);
                    *(u32x4*)dst = w; } }
    }
};
struct EpiXloc {
    static constexpr bool PERM = false, AFTER_DRAIN = false;
    float* XL;
    __device__ __forceinline__ void operator()(const f32x4 (&acc)[2][2][4][2], const Unit& u, int wr, int wc, int fr, int fq) const {
        const int row0 = u.pm * BM + wr * 64 + fr, col0 = wc * 32 + 4 * fq;
#pragma unroll
        for (int ai = 0; ai < 2; ++ai)
#pragma unroll
            for (int m = 0; m < 4; ++m) { float* rowp = XL + ((size_t)u.eb * 2048 + row0 + ai * HALF + m * 16) * 128 + col0;
#pragma unroll
                for (int n = 0; n < 2; ++n) *(f32x4*)(rowp + n * 16) = acc[ai][0][m][n]; }
    }
};
__device__ __forceinline__ float gelu_t(float x) { const float u2 = -2.302208198f * (x + 0.044715f * x * x * x); return x * __builtin_amdgcn_rcpf(1.0f + __builtin_amdgcn_exp2f(u2)); }
struct EpiSsmOut {
    static constexpr bool PERM = true, AFTER_DRAIN = false;
    bf16_t* G;
    __device__ __forceinline__ void operator()(const f32x4 (&acc)[2][2][4][2], const Unit& u, int wr, int wc, int fr, int fq) const {
        const int row0 = u.pm * BM + wr * 64 + fr;
#pragma unroll
        for (int ai = 0; ai < 2; ++ai)
#pragma unroll
            for (int m = 0; m < 4; ++m) { const int row = row0 + ai * HALF + m * 16;
#pragma unroll
                for (int bj = 0; bj < 2; ++bj) { const int n0 = bj * HALF + wc * 32 + 8 * fq;
                    const f32x4 v0 = acc[ai][bj][m][0], v1 = acc[ai][bj][m][1];
                    u32x4 w; w.x = cvt_pk_bf16(gelu_t(v0[0]), gelu_t(v0[1])); w.y = cvt_pk_bf16(gelu_t(v0[2]), gelu_t(v0[3])); w.z = cvt_pk_bf16(gelu_t(v1[0]), gelu_t(v1[1])); w.w = cvt_pk_bf16(gelu_t(v1[2]), gelu_t(v1[3]));
                    *(u32x4*)(G + ((size_t)row * 16 + (n0 >> 4)) * 512 + u.eb * 16 + (n0 & 15)) = w; } }
    }
};

struct CmpOrder {
    int G, c;
    __device__ __forceinline__ bool next(int i, Unit& u) const { const int L = i * G + c; if (L >= 32) return false; u.eb = L >> 4; u.pm = L & 15; u.pn = 0; u.p0 = 0; u.cnt = 0; return true; }
    __device__ __forceinline__ void a_ready(const Unit&) const {}
    __device__ __forceinline__ void done(const Unit&) const {}
};
struct EpiCmpHid {
    static constexpr bool PERM = false, AFTER_DRAIN = false;
    bf16_t* HC; const float* bias;
    __device__ __forceinline__ void operator()(const f32x4 (&acc)[2][2][4][2], const Unit& u, int wr, int wc, int fr, int fq) const {
        if (wc < 2) {
            const int row0 = u.pm * BM + wr * 64 + fr, col0 = wc * 32 + 4 * fq;
#pragma unroll
            for (int n = 0; n < 2; ++n) { const f32x4 bv = *(const f32x4*)(bias + u.eb * 64 + col0 + n * 16);
#pragma unroll
                for (int ai = 0; ai < 2; ++ai)
#pragma unroll
                    for (int m = 0; m < 4; ++m) { const f32x4 v = acc[ai][0][m][n] + bv;
                        typedef unsigned u32x2_ __attribute__((ext_vector_type(2)));
                        u32x2_ w; w.x = cvt_pk_bf16(gelu_t(v[0]), gelu_t(v[1])); w.y = cvt_pk_bf16(gelu_t(v[2]), gelu_t(v[3]));
                        *(u32x2_*)(HC + ((size_t)u.eb * 4096 + row0 + ai * HALF + m * 16) * 64 + col0 + n * 16) = w; } }
        }
    }
};

struct SingleUnit {
    int eb, pm;
    __device__ __forceinline__ bool next(int i, Unit& u) const { if (i > 0) return false; u.eb = eb; u.pm = pm; u.pn = 0; u.p0 = 0; u.cnt = 0; return true; }
    __device__ __forceinline__ void a_ready(const Unit&) const {}
    __device__ __forceinline__ void done(const Unit&) const {}
};
}

struct Args { const float* in[26]; float* out; unsigned char* ws; int ph_lo, ph_hi; };

struct Frame {
    LAS unsigned char* lds;
    int tid, lane, wave, blk, G;
};

__device__ __forceinline__ f32x4 bf4(u32x2 p) { f32x4 r; r.x = __uint_as_float(p.x << 16); r.y = __uint_as_float(p.x & 0xffff0000u); r.z = __uint_as_float(p.y << 16); r.w = __uint_as_float(p.y & 0xffff0000u); return r; }
__device__ __forceinline__ void ph_norm(const Frame& F, const float* xin, const bf16* add, const bf16* add2, float* xout, const float* g, bf16* hn) {
    const int gw = F.blk * NWAVES + F.wave, NGW = F.G * NWAVES;
    f32x4 gg[4];
#pragma unroll
    for (int j = 0; j < 4; ++j) gg[j] = ((const f32x4*)g)[F.lane + 64 * j];
    f32x4 nv[4]; u32x2 na[4], nb[4];
    if (gw < T) {
#pragma unroll
        for (int j = 0; j < 4; ++j) { nv[j] = ((const f32x4*)(xin + (size_t)gw * DM))[F.lane + 64 * j];
            if (add) { na[j] = ((const u32x2*)(add + (size_t)gw * DM))[F.lane + 64 * j]; nb[j] = ((const u32x2*)(add2 + (size_t)gw * DM))[F.lane + 64 * j]; } }
    }
    for (int row = gw; row < T; row += NGW) {
        f32x4 v[4]; float s = 0.f;
#pragma unroll
        for (int j = 0; j < 4; ++j) { v[j] = nv[j]; if (add) v[j] += bf4(na[j]) + bf4(nb[j]); }
        const int nrow = row + NGW;
        if (nrow < T) {
#pragma unroll
            for (int j = 0; j < 4; ++j) { nv[j] = ((const f32x4*)(xin + (size_t)nrow * DM))[F.lane + 64 * j];
                if (add) { na[j] = ((const u32x2*)(add + (size_t)nrow * DM))[F.lane + 64 * j]; nb[j] = ((const u32x2*)(add2 + (size_t)nrow * DM))[F.lane + 64 * j]; } }
        }
#pragma unroll
        for (int j = 0; j < 4; ++j) { if (add) ((f32x4*)(xout + (size_t)row * DM))[F.lane + 64 * j] = v[j];
            s += v[j].x * v[j].x + v[j].y * v[j].y + v[j].z * v[j].z + v[j].w * v[j].w; }
        s = wave_sum(s, F.lane);
        const float r = rsqrtf(s * (1.0f / DM) + EPS);
#pragma unroll
        for (int j = 0; j < 4; ++j) {
            u32x2 o; o.x = pk2(v[j].x * r * gg[j].x, v[j].y * r * gg[j].y); o.y = pk2(v[j].z * r * gg[j].z, v[j].w * r * gg[j].w);
            *(u32x2*)(hn + (size_t)row * DM + (F.lane + 64 * j) * 4) = o;
        }
    }
}
__device__ __forceinline__ void ph_norm_b(const Frame& F, bf16* xb, const bf16* add, const bf16* add2, const float* g, bf16* hn) {
    const int gw = F.blk * NWAVES + F.wave, NGW = F.G * NWAVES;
    f32x4 gg[4];
#pragma unroll
    for (int j = 0; j < 4; ++j) gg[j] = ((const f32x4*)g)[F.lane + 64 * j];
    u32x2 nx[4], na[4], nb[4];
    if (gw < T) {
#pragma unroll
        for (int j = 0; j < 4; ++j) { nx[j] = ((const u32x2*)(xb + (size_t)gw * DM))[F.lane + 64 * j]; na[j] = ((const u32x2*)(add + (size_t)gw * DM))[F.lane + 64 * j]; nb[j] = ((const u32x2*)(add2 + (size_t)gw * DM))[F.lane + 64 * j]; }
    }
    for (int row = gw; row < T; row += NGW) {
        f32x4 v[4]; float s = 0.f;
#pragma unroll
        for (int j = 0; j < 4; ++j) v[j] = bf4(nx[j]) + bf4(na[j]) + bf4(nb[j]);
        const int nrow = row + NGW;
        if (nrow < T) {
#pragma unroll
            for (int j = 0; j < 4; ++j) { nx[j] = ((const u32x2*)(xb + (size_t)nrow * DM))[F.lane + 64 * j]; na[j] = ((const u32x2*)(add + (size_t)nrow * DM))[F.lane + 64 * j]; nb[j] = ((const u32x2*)(add2 + (size_t)nrow * DM))[F.lane + 64 * j]; }
        }
#pragma unroll
        for (int j = 0; j < 4; ++j) { u32x2 o; o.x = pk2(v[j].x, v[j].y); o.y = pk2(v[j].z, v[j].w); ((u32x2*)(xb + (size_t)row * DM))[F.lane + 64 * j] = o;
            s += v[j].x * v[j].x + v[j].y * v[j].y + v[j].z * v[j].z + v[j].w * v[j].w; }
        s = wave_sum(s, F.lane);
        const float r = rsqrtf(s * (1.0f / DM) + EPS);
#pragma unroll
        for (int j = 0; j < 4; ++j) {
            u32x2 o; o.x = pk2(v[j].x * r * gg[j].x, v[j].y * r * gg[j].y); o.y = pk2(v[j].z * r * gg[j].z, v[j].w * r * gg[j].w);
            *(u32x2*)(hn + (size_t)row * DM + (F.lane + 64 * j) * 4) = o;
        }
    }
}
__device__ __forceinline__ void ph_final_norm(const Frame& F, float* out, const bf16* xb, const bf16* add, const bf16* add2, const float* g) {
    const int gw = F.blk * NWAVES + F.wave, NGW = F.G * NWAVES;
    f32x4 gg[4];
#pragma unroll
    for (int j = 0; j < 4; ++j) gg[j] = ((const f32x4*)g)[F.lane + 64 * j];
    u32x2 nx[4], na[4], nb[4];
    if (gw < T) {
#pragma unroll
        for (int j = 0; j < 4; ++j) { nx[j] = ((const u32x2*)(xb + (size_t)gw * DM))[F.lane + 64 * j]; na[j] = ((const u32x2*)(add + (size_t)gw * DM))[F.lane + 64 * j]; nb[j] = ((const u32x2*)(add2 + (size_t)gw * DM))[F.lane + 64 * j]; }
    }
    for (int row = gw; row < T; row += NGW) {
        f32x4 v[4]; float s = 0.f;
#pragma unroll
        for (int j = 0; j < 4; ++j) { v[j] = bf4(nx[j]) + bf4(na[j]) + bf4(nb[j]); s += v[j].x * v[j].x + v[j].y * v[j].y + v[j].z * v[j].z + v[j].w * v[j].w; }
        const int nrow = row + NGW;
        if (nrow < T) {
#pragma unroll
            for (int j = 0; j < 4; ++j) { nx[j] = ((const u32x2*)(xb + (size_t)nrow * DM))[F.lane + 64 * j]; na[j] = ((const u32x2*)(add + (size_t)nrow * DM))[F.lane + 64 * j]; nb[j] = ((const u32x2*)(add2 + (size_t)nrow * DM))[F.lane + 64 * j]; }
        }
        s = wave_sum(s, F.lane);
        const float r = rsqrtf(s * (1.0f / DM) + EPS);
#pragma unroll
        for (int j = 0; j < 4; ++j) {
            f32x4 o; o.x = v[j].x * r * gg[j].x; o.y = v[j].y * r * gg[j].y; o.z = v[j].z * r * gg[j].z; o.w = v[j].w * r * gg[j].w;
            ((f32x4*)(out + (size_t)row * DM))[F.lane + 64 * j] = o;
        }
    }
}

template <bool DUAL, class Epi>
__device__ __forceinline__ void sgemm_naive(const Frame& F, const bf16* A, int lda, const float* B, int ldb, int M, int N, int K, int dualoff, const Epi& epi) {
    LAS float* As = (LAS float*)F.lds;
    LAS float* Bs = As + 16 * 132;
    LAS float* Bs2 = Bs + 16 * 128;
    const int tiles_n = (N + 127) / 128, tiles_m = M / 128;
    const int tx = F.tid & 31, ty = F.tid >> 5;
    for (int tile = F.blk; tile < tiles_m * tiles_n; tile += F.G) {
        const int tm = tile / tiles_n, tn = tile % tiles_n;
        float acc[8][4], acc2[8][4];
#pragma unroll
        for (int i = 0; i < 8; ++i)
#pragma unroll
            for (int j = 0; j < 4; ++j) { acc[i][j] = 0.f; acc2[i][j] = 0.f; }
        const int arow = F.tid >> 2, akq = (F.tid & 3) * 4;
        const int bk = F.tid >> 5, bn = (F.tid & 31) * 4;
        for (int k0 = 0; k0 < K; k0 += 16) {
            {
                const u32x2 av = *(const u32x2*)(A + (size_t)(tm * 128 + arow) * lda + k0 + akq);
                As[(akq + 0) * 132 + arow] = __uint_as_float(av.x << 16);
                As[(akq + 1) * 132 + arow] = __uint_as_float(av.x & 0xffff0000u);
                As[(akq + 2) * 132 + arow] = __uint_as_float(av.y << 16);
                As[(akq + 3) * 132 + arow] = __uint_as_float(av.y & 0xffff0000u);
                const int col = tn * 128 + bn;
                f32x4 bv = (f32x4){0.f, 0.f, 0.f, 0.f};
                const float* bp = B + (size_t)(k0 + bk) * ldb + col;
                if (col + 3 < N) { bv.x = bp[0]; bv.y = bp[1]; bv.z = bp[2]; bv.w = bp[3]; }
                else { if (col < N) bv.x = bp[0]; if (col + 1 < N) bv.y = bp[1]; if (col + 2 < N) bv.z = bp[2]; }
                *(LAS f32x4*)(Bs + bk * 128 + bn) = bv;
                if (DUAL) {
                    const float* bp2 = bp + dualoff;
                    f32x4 bw; bw.x = bp2[0]; bw.y = bp2[1]; bw.z = bp2[2]; bw.w = bp2[3];
                    *(LAS f32x4*)(Bs2 + bk * 128 + bn) = bw;
                }
            }
            __syncthreads();
#pragma unroll 4
            for (int k = 0; k < 16; ++k) {
                float a[8];
                const f32x4 a0 = *(const LAS f32x4*)(As + k * 132 + ty * 8), a1 = *(const LAS f32x4*)(As + k * 132 + ty * 8 + 4);
                a[0] = a0.x; a[1] = a0.y; a[2] = a0.z; a[3] = a0.w; a[4] = a1.x; a[5] = a1.y; a[6] = a1.z; a[7] = a1.w;
                const f32x4 b = *(const LAS f32x4*)(Bs + k * 128 + tx * 4);
#pragma unroll
                for (int i = 0; i < 8; ++i) { acc[i][0] += a[i] * b.x; acc[i][1] += a[i] * b.y; acc[i][2] += a[i] * b.z; acc[i][3] += a[i] * b.w; }
                if (DUAL) {
                    const f32x4 b2 = *(const LAS f32x4*)(Bs2 + k * 128 + tx * 4);
#pragma unroll
                    for (int i = 0; i < 8; ++i) { acc2[i][0] += a[i] * b2.x; acc2[i][1] += a[i] * b2.y; acc2[i][2] += a[i] * b2.z; acc2[i][3] += a[i] * b2.w; }
                }
            }
            __syncthreads();
        }
#pragma unroll
        for (int i = 0; i < 8; ++i)
#pragma unroll
            for (int j = 0; j < 4; ++j) {
                const int row = tm * 128 + ty * 8 + i, col = tn * 128 + tx * 4 + j;
                if (col < N) epi(row, col, acc[i][j], acc2[i][j]);
            }
    }
}
struct EpiStoreBf16 { bf16* O; int ldo; __device__ __forceinline__ void operator()(int r, int c, float a, float) const { O[(size_t)r * ldo + c] = (bf16)f2bf(a); } };
struct EpiGlu { bf16* O; int ldo; __device__ __forceinline__ void operator()(int r, int c, float a, float b) const { O[(size_t)r * ldo + c] = (bf16)f2bf(a * sigmoidf_(b)); } };
struct EpiResid { const float* X; float* O; __device__ __forceinline__ void operator()(int r, int c, float a, float) const { O[(size_t)r * DM + c] = X[(size_t)r * DM + c] + a; } };

__device__ __forceinline__ void ssm_naive_item(int b, int g, const float* a_re, const float* a_im, const float* b_re, const float* b_im, const float* c_re, const float* c_im,
                                               const float* dpar, const float* log_dt, const bf16* Z, bf16* G1, int lane) {
    const int p = lane;
    const float are = a_re[g * 64 + p], aim = a_im[g * 64 + p], dt = expf(log_dt[g]);
    const float er = expf(are * dt), lbr = er * cosf(aim * dt), lbi = er * sinf(aim * dt);
    const float xx = lbr - 1.0f, yy = lbi, den = are * are + aim * aim;
    const float fr = (xx * are + yy * aim) / den, fi = (yy * are - xx * aim) / den;
    float bbr[16], bbi[16], cr[16], ci[16];
#pragma unroll
    for (int h = 0; h < 16; ++h) {
        const float br = b_re[(g * 64 + p) * 16 + h], bi = b_im[(g * 64 + p) * 16 + h];
        bbr[h] = fr * br - fi * bi; bbi[h] = fr * bi + fi * br;
        cr[h] = c_re[(g * 16 + h) * 64 + p]; ci[h] = c_im[(g * 16 + h) * 64 + p];
    }
    const float dd = dpar[g * 16 + (lane & 15)];
    float xr = 0.f, xi = 0.f;
    for (int t = 0; t < SEQ; ++t) {
        const size_t row = (size_t)b * SEQ + t;
        const u32x4 u0 = *(const u32x4*)(Z + row * ZP + ZC_U + g * 16), u1 = *(const u32x4*)(Z + row * ZP + ZC_U + g * 16 + 8);
        float u[16];
        u[0] = __uint_as_float(u0.x << 16); u[1] = __uint_as_float(u0.x & 0xffff0000u); u[2] = __uint_as_float(u0.y << 16); u[3] = __uint_as_float(u0.y & 0xffff0000u);
        u[4] = __uint_as_float(u0.z << 16); u[5] = __uint_as_float(u0.z & 0xffff0000u); u[6] = __uint_as_float(u0.w << 16); u[7] = __uint_as_float(u0.w & 0xffff0000u);
        u[8] = __uint_as_float(u1.x << 16); u[9] = __uint_as_float(u1.x & 0xffff0000u); u[10] = __uint_as_float(u1.y << 16); u[11] = __uint_as_float(u1.y & 0xffff0000u);
        u[12] = __uint_as_float(u1.z << 16); u[13] = __uint_as_float(u1.z & 0xffff0000u); u[14] = __uint_as_float(u1.w << 16); u[15] = __uint_as_float(u1.w & 0xffff0000u);
        float bur = 0.f, bui = 0.f;
#pragma unroll
        for (int h = 0; h < 16; ++h) { bur += bbr[h] * u[h]; bui += bbi[h] * u[h]; }
        const float nxr = lbr * xr - lbi * xi + bur, nxi = lbr * xi + lbi * xr + bui;
        xr = nxr; xi = nxi;
        float y = 0.f;
#pragma unroll
        for (int h = 0; h < 16; ++h) { const float v = wave_sum(cr[h] * xr - ci[h] * xi, lane); if (lane == h) y = v; }
        if (lane < 16) {
            const float ul = bf2f(Z[row * ZP + ZC_U + g * 16 + lane]);
            G1[row * D_SSM + g * 16 + lane] = (bf16)f2bf(gelu_tanh(y + dd * ul));
        }
    }
}
__device__ __forceinline__ void compress_naive_item(int item, const bf16* Z, const float* pos, const float* w1, const float* w2, bf16* KC, bf16* VC, int lane) {
    const int i = item & 1, hkv = (item >> 1) & 1, n = (item >> 2) % NCMPP, b = (item >> 2) / NCMPP;
    bf16* dst = i ? VC : KC;
    if (n == NCMP) { dst[(((size_t)b * NCMPP + n) * 2 + hkv) * 64 + lane] = 0; return; }
    const float* posi = pos + i * 32 * 64; const float* w1i = w1 + (size_t)i * 32 * 64 * 64; const float* w2i = w2 + i * 64 * 64;
    float acc = 0.f;
    for (int l = 0; l < 32; ++l) {
        const bf16* zr = Z + ((size_t)b * SEQ + 16 * n + l) * ZP + ZC_KV + i * 128 + hkv * 64;
        for (int d = 0; d < 64; ++d) acc += (bf2f(zr[d]) + posi[l * 64 + d]) * w1i[(l * 64 + d) * 64 + lane];
    }
    const float hid = gelu_tanh(acc);
    float o = 0.f;
    for (int e = 0; e < 64; ++e) o += lane_bcast(hid, e) * w2i[e * 64 + lane];
    dst[(((size_t)b * NCMPP + n) * 2 + hkv) * 64 + lane] = (bf16)f2bf(o);
}

__device__ __forceinline__ void attn_chunk(LAS float* wl, const bf16* Z, const float* rel_bias, int b, int hkv, int t, int base, int kcol, int vcol, int lane,
                                           float (&m)[4], float (&l)[4], float (&o)[4]) {
    const int pos = base + lane; const bool valid = (pos >= 0) && (pos <= t);
    const int posc = pos < 0 ? 0 : (pos > SEQ - 1 ? SEQ - 1 : pos);
    const bf16* kr = Z + ((size_t)b * SEQ + posc) * ZP + kcol + hkv * 64;
    float s[4] = {0.f, 0.f, 0.f, 0.f};
#pragma unroll 2
    for (int c = 0; c < 8; ++c) {
        const u32x4 kv = *(const u32x4*)(kr + c * 8);
        float k[8];
        k[0] = __uint_as_float(kv.x << 16); k[1] = __uint_as_float(kv.x & 0xffff0000u); k[2] = __uint_as_float(kv.y << 16); k[3] = __uint_as_float(kv.y & 0xffff0000u);
        k[4] = __uint_as_float(kv.z << 16); k[5] = __uint_as_float(kv.z & 0xffff0000u); k[6] = __uint_as_float(kv.w << 16); k[7] = __uint_as_float(kv.w & 0xffff0000u);
#pragma unroll
        for (int g = 0; g < 4; ++g) {
            const f32x4 q0 = *(const LAS f32x4*)(wl + g * 64 + c * 8), q1 = *(const LAS f32x4*)(wl + g * 64 + c * 8 + 4);
            s[g] += q0.x * k[0] + q0.y * k[1] + q0.z * k[2] + q0.w * k[3] + q1.x * k[4] + q1.y * k[5] + q1.z * k[6] + q1.w * k[7];
        }
    }
    const int bk = t5_bucket(t - pos);
#pragma unroll
    for (int g = 0; g < 4; ++g) {
        const float sv = valid ? s[g] + rel_bias[bk * 8 + hkv * 4 + g] : -1e30f;
        const float mn = fmaxf(m[g], wave_max(sv, lane));
        const float alpha = __expf(m[g] - mn);
        const float p = valid ? __expf(sv - mn) : 0.f;
        l[g] = l[g] * alpha + wave_sum(p, lane);
        o[g] *= alpha; m[g] = mn;
        wl[256 + g * 64 + lane] = p;
    }
#pragma unroll 4
    for (int key = 0; key < 64; ++key) {
        int pk = base + key; pk = pk < 0 ? 0 : (pk > SEQ - 1 ? SEQ - 1 : pk);
        const float v = bf2f(Z[((size_t)b * SEQ + pk) * ZP + vcol + hkv * 64 + lane]);
#pragma unroll
        for (int g = 0; g < 4; ++g) o[g] += wl[256 + g * 64 + key] * v;
    }
}
__device__ __forceinline__ void attn_naive_item(LAS float* wl, int b, int hkv, int t, const bf16* Z, const float* KC, const float* VC, const float* rel_bias, bf16* YC, int lane) {
    const size_t row = (size_t)b * SEQ + t;
#pragma unroll
    for (int g = 0; g < 4; ++g) wl[g * 64 + lane] = bf2f(Z[row * ZP + ZC_Q + hkv * 256 + g * 64 + lane]) * 0.125f;
#pragma unroll 1
    for (int c = 0; c < 4; ++c) {
        const int n = c * 64 + lane; const bool valid = (n < NCMP) && (16 * n + 31 <= t);
        const float* kr = KC + (((size_t)b * NCMPP + (n < NCMP ? n : 0)) * 2 + hkv) * 64;
        float s[4] = {0.f, 0.f, 0.f, 0.f};
#pragma unroll 4
        for (int d4 = 0; d4 < 16; ++d4) {
            const f32x4 k = *(const f32x4*)(kr + d4 * 4);
#pragma unroll
            for (int g = 0; g < 4; ++g) { const f32x4 q = *(const LAS f32x4*)(wl + g * 64 + d4 * 4); s[g] += q.x * k.x + q.y * k.y + q.z * k.z + q.w * k.w; }
        }
        const int bk = t5_bucket(t - (16 * n + 31));
#pragma unroll
        for (int g = 0; g < 4; ++g) wl[256 + g * 256 + n] = valid ? s[g] + rel_bias[bk * 8 + hkv * 4 + g] : -1e30f;
    }
#pragma unroll
    for (int g = 0; g < 4; ++g) {
        float sc[4];
#pragma unroll
        for (int c = 0; c < 4; ++c) sc[c] = wl[256 + g * 256 + c * 64 + lane];
        const float mx = wave_max(fmaxf(fmaxf(sc[0], sc[1]), fmaxf(sc[2], sc[3])), lane);
        float e[4], ls = 0.f;
#pragma unroll
        for (int c = 0; c < 4; ++c) { e[c] = sc[c] > -1e29f ? __expf(sc[c] - mx) : 0.f; ls += e[c]; }
        ls = wave_sum(ls, lane);
        const float inv = ls > 0.f ? 1.0f / ls : 0.f;
#pragma unroll
        for (int c = 0; c < 4; ++c) wl[256 + g * 256 + c * 64 + lane] = e[c] * inv;
    }
    float oc[4] = {0.f, 0.f, 0.f, 0.f};
    const int nmax = t >= 31 ? ((t - 31) / 16 + 1 < NCMP ? (t - 31) / 16 + 1 : NCMP) : 0;
#pragma unroll 4
    for (int n = 0; n < nmax; ++n) {
        const float v = VC[(((size_t)b * NCMPP + n) * 2 + hkv) * 64 + lane];
#pragma unroll
        for (int g = 0; g < 4; ++g) oc[g] += wl[256 + g * 256 + n] * v;
    }
    float imp = 0.f;
#pragma unroll
    for (int g = 0; g < 4; ++g) {
        const LAS float* P = wl + 256 + g * 256;
        imp += P[4 * lane] + P[4 * lane + 1] + P[4 * lane + 2] + 0.5f * P[4 * lane + 3] + (lane > 0 ? 0.5f * P[4 * lane - 1] : 0.f);
    }
    const int blk = t >> 6;
    const bool forced = (lane == 0) || (lane <= blk && lane > blk - 2), future = lane > blk;
    const float v = forced ? 1e9f : (future ? -1e9f : imp);
    int rank = 0;
    for (int jj = 0; jj < 64; ++jj) { const float vj = lane_bcast(v, jj); rank += (vj > v) || (vj == v && jj < lane); }
    unsigned long long mask = __ballot(rank < 16 && !future);
    float m[4], l[4], o[4];
#pragma unroll
    for (int g = 0; g < 4; ++g) { m[g] = -1e30f; l[g] = 0.f; o[g] = 0.f; }
    while (mask) {
        const int j = __builtin_ctzll(mask); mask &= mask - 1;
        attn_chunk(wl, Z, rel_bias, b, hkv, t, 64 * j, ZC_KV + 256, ZC_KV + 384, lane, m, l, o);
    }
    float os[4];
#pragma unroll
    for (int g = 0; g < 4; ++g) { os[g] = l[g] > 0.f ? o[g] / l[g] : 0.f; m[g] = -1e30f; l[g] = 0.f; o[g] = 0.f; }
    for (int c = 0; c < 8; ++c) attn_chunk(wl, Z, rel_bias, b, hkv, t, t - 511 + 64 * c, ZC_KV + 512, ZC_KV + 640, lane, m, l, o);
#pragma unroll
    for (int g = 0; g < 4; ++g) {
        const float ow = l[g] > 0.f ? o[g] / l[g] : 0.f;
        const bf16* gp = Z + row * ZP + ZC_G + hkv * 12 + g * 3;
        const float r = sigmoidf_(bf2f(gp[0])) * oc[g] + sigmoidf_(bf2f(gp[1])) * os[g] + sigmoidf_(bf2f(gp[2])) * ow;
        YC[row * DM + D_SSM + hkv * 256 + g * 64 + lane] = (bf16)f2bf(r);
    }
}

struct RTok { f32x4 v[4]; int gi; float gval; };
__device__ __forceinline__ unsigned cvtpk_rne(float lo, float hi) { unsigned r; asm("v_cvt_pk_bf16_f32 %0, %1, %2" : "=v"(r) : "v"(lo), "v"(hi)); return r; }
__device__ __forceinline__ void route_a(const Frame& F, const u32x2 (&nv)[4], const f32x4 (&gg)[4], const LAS f32x4* RG, const f32x4 rgbv, bf16* hrow, RTok& t) {
    float s = 0.f;
#pragma unroll
    for (int j = 0; j < 4; ++j) { t.v[j] = bf4(nv[j]); s += t.v[j].x * t.v[j].x + t.v[j].y * t.v[j].y + t.v[j].z * t.v[j].z + t.v[j].w * t.v[j].w; }
    s = wave_sum(s, F.lane);
    const float r = rsqrtf(s * (1.0f / DM) + EPS);
    float lg[4] = {0.f, 0.f, 0.f, 0.f};
#pragma unroll
    for (int j = 0; j < 4; ++j) {
        t.v[j].x = t.v[j].x * r * gg[j].x; t.v[j].y = t.v[j].y * r * gg[j].y; t.v[j].z = t.v[j].z * r * gg[j].z; t.v[j].w = t.v[j].w * r * gg[j].w;
        u32x2 o; o.x = cvtpk_rne(t.v[j].x, t.v[j].y); o.y = cvtpk_rne(t.v[j].z, t.v[j].w);
        *(u32x2*)(hrow + (F.lane + 64 * j) * 4) = o;
        const f32x4 w0 = RG[(j * 4 + 0) * 64 + F.lane], w1 = RG[(j * 4 + 1) * 64 + F.lane], w2 = RG[(j * 4 + 2) * 64 + F.lane], w3 = RG[(j * 4 + 3) * 64 + F.lane];
        lg[0] += t.v[j].x * w0.x + t.v[j].y * w1.x + t.v[j].z * w2.x + t.v[j].w * w3.x;
        lg[1] += t.v[j].x * w0.y + t.v[j].y * w1.y + t.v[j].z * w2.y + t.v[j].w * w3.y;
        lg[2] += t.v[j].x * w0.z + t.v[j].y * w1.z + t.v[j].z * w2.z + t.v[j].w * w3.z;
        lg[3] += t.v[j].x * w0.w + t.v[j].y * w1.w + t.v[j].z * w2.w + t.v[j].w * w3.w;
    }
    lg[0] = wave_sum(lg[0], F.lane) + rgbv.x; lg[1] = wave_sum(lg[1], F.lane) + rgbv.y; lg[2] = wave_sum(lg[2], F.lane) + rgbv.z; lg[3] = wave_sum(lg[3], F.lane) + rgbv.w;
    int gi = 0; float gm = lg[0];
#pragma unroll
    for (int o = 1; o < 4; ++o) if (lg[o] > gm) { gm = lg[o]; gi = o; }
    float gs = 0.f;
#pragma unroll
    for (int o = 0; o < 4; ++o) gs += __expf(lg[o] - gm);
    t.gi = gi; t.gval = 1.0f / gs;
}
__device__ __forceinline__ void route_b(const Frame& F, const RTok& t, const LAS f32x4* RE, const float* reb, unsigned& ea, unsigned& eb, float& wa_, float& wb_) {
    const LAS f32x4* we = RE + t.gi * 2048;
    float le[8] = {0.f, 0.f, 0.f, 0.f, 0.f, 0.f, 0.f, 0.f};
#pragma unroll
    for (int j = 0; j < 4; ++j) {
#pragma unroll
        for (int c = 0; c < 4; ++c) {
            const float hv = t.v[j][c];
            const f32x4 wa = we[((j * 4 + c) * 2 + 0) * 64 + F.lane], wb = we[((j * 4 + c) * 2 + 1) * 64 + F.lane];
            le[0] += hv * wa.x; le[1] += hv * wa.y; le[2] += hv * wa.z; le[3] += hv * wa.w;
            le[4] += hv * wb.x; le[5] += hv * wb.y; le[6] += hv * wb.z; le[7] += hv * wb.w;
        }
    }
    const f32x4 b0 = *(const f32x4*)(reb + t.gi * 8), b1 = *(const f32x4*)(reb + t.gi * 8 + 4);
    le[0] = wave_sum(le[0], F.lane) + b0.x; le[1] = wave_sum(le[1], F.lane) + b0.y; le[2] = wave_sum(le[2], F.lane) + b0.z; le[3] = wave_sum(le[3], F.lane) + b0.w;
    le[4] = wave_sum(le[4], F.lane) + b1.x; le[5] = wave_sum(le[5], F.lane) + b1.y; le[6] = wave_sum(le[6], F.lane) + b1.z; le[7] = wave_sum(le[7], F.lane) + b1.w;
    int e1 = 0; float m1 = le[0];
#pragma unroll
    for (int e = 1; e < 8; ++e) if (le[e] > m1) { m1 = le[e]; e1 = e; }
    int e2 = -1; float m2 = -3.0e38f;
#pragma unroll
    for (int e = 0; e < 8; ++e) if (e != e1 && le[e] > m2) { m2 = le[e]; e2 = e; }
    const float p2 = __expf(m2 - m1), inv = 1.0f / (1.0f + p2);
    ea = (unsigned)(t.gi * 8 + e1); eb = (unsigned)(t.gi * 8 + e2); wa_ = t.gval * inv; wb_ = t.gval * p2 * inv;
}
__device__ __forceinline__ void ph_norm_route(const Frame& F, const bf16* x, const float* g, const float* rgw, const float* rgb, const float* rew, const float* reb, bf16* hn,
                                              unsigned* gcnt, unsigned* list, float* listw) {
    LAS f32x4* RG = (LAS f32x4*)F.lds; LAS f32x4* RE = RG + 1024;
    LAS unsigned* cnt_l = (LAS unsigned*)(F.lds + 147456); LAS unsigned* base_l = cnt_l + 32; LAS unsigned* ent = cnt_l + 64;
    for (int d = F.tid; d < 1024; d += NTHR) { const int ln = d & 63, jc = d >> 6, row = (ln + 64 * (jc >> 2)) * 4 + (jc & 3); RG[d] = ((const f32x4*)rgw)[row]; }
    { f32x4 t[16];
#pragma unroll
      for (int k = 0; k < 16; ++k) { const int d = F.tid + k * NTHR, ln = d & 63, q = d >> 6, half = q & 1, c = (q >> 1) & 3, j = (q >> 3) & 3, gi = q >> 5, row = (ln + 64 * j) * 4 + c;
          t[k] = ((const f32x4*)rew)[((size_t)gi * DM + row) * 2 + half]; }
#pragma unroll
      for (int k = 0; k < 16; ++k) RE[F.tid + k * NTHR] = t[k]; }
    f32x4 gg[4];
#pragma unroll
    for (int j = 0; j < 4; ++j) gg[j] = ((const f32x4*)g)[F.lane + 64 * j];
    const f32x4 rgbv = *(const f32x4*)rgb;
    __syncthreads();
    for (int row0 = F.blk * 128; row0 < T; row0 += F.G * 128) {
        if (F.tid < 32) cnt_l[F.tid] = 0u;
        __syncthreads();
        const int rbase = row0 + F.wave * 16;
        u32x2 na[4], nb[4];
#pragma unroll
        for (int j = 0; j < 4; ++j) { na[j] = ((const u32x2*)(x + (size_t)rbase * DM))[F.lane + 64 * j]; nb[j] = ((const u32x2*)(x + (size_t)(rbase + 1) * DM))[F.lane + 64 * j]; }
        for (int kk = 0; kk < 16; kk += 2) {
            const int row = rbase + kk;
            u32x2 ca[4], cb[4];
#pragma unroll
            for (int j = 0; j < 4; ++j) { ca[j] = na[j]; cb[j] = nb[j]; }
            if (kk < 14) {
#pragma unroll
                for (int j = 0; j < 4; ++j) { na[j] = ((const u32x2*)(x + (size_t)(row + 2) * DM))[F.lane + 64 * j]; nb[j] = ((const u32x2*)(x + (size_t)(row + 3) * DM))[F.lane + 64 * j]; } }
            RTok ta, tb;
            route_a(F, ca, gg, RG, rgbv, hn + (size_t)row * DM, ta);
            route_a(F, cb, gg, RG, rgbv, hn + (size_t)(row + 1) * DM, tb);
            unsigned ea0, eb0, ea1, eb1; float wa0, wb0, wa1, wb1;
            route_b(F, ta, RE, reb, ea0, eb0, wa0, wb0);
            route_b(F, tb, RE, reb, ea1, eb1, wa1, wb1);
            if (F.lane == 0) {
                const unsigned pa0 = __hip_atomic_fetch_add(cnt_l + ea0, 1u, __ATOMIC_RELAXED, __HIP_MEMORY_SCOPE_WORKGROUP);
                const unsigned pb0 = __hip_atomic_fetch_add(cnt_l + eb0, 1u, __ATOMIC_RELAXED, __HIP_MEMORY_SCOPE_WORKGROUP);
                const unsigned pa1 = __hip_atomic_fetch_add(cnt_l + ea1, 1u, __ATOMIC_RELAXED, __HIP_MEMORY_SCOPE_WORKGROUP);
                const unsigned pb1 = __hip_atomic_fetch_add(cnt_l + eb1, 1u, __ATOMIC_RELAXED, __HIP_MEMORY_SCOPE_WORKGROUP);
                LAS unsigned* en = ent + (F.wave * 16 + kk) * 6;
                en[0] = ea0; en[1] = eb0; en[2] = pa0; en[3] = pb0; en[4] = __float_as_uint(wa0); en[5] = __float_as_uint(wb0);
                en[6] = ea1; en[7] = eb1; en[8] = pa1; en[9] = pb1; en[10] = __float_as_uint(wa1); en[11] = __float_as_uint(wb1);
            }
        }
        __syncthreads();
        if (F.tid < 32) base_l[F.tid] = __hip_atomic_fetch_add(gcnt + F.tid * 64, cnt_l[F.tid], __ATOMIC_RELAXED, __HIP_MEMORY_SCOPE_AGENT);
        __syncthreads();
        if (F.tid < 128) {
            const LAS unsigned* en = ent + F.tid * 6; const unsigned tok = (unsigned)(row0 + F.tid);
            const unsigned ia = en[0] * LCAP + base_l[en[0]] + en[2], ib = en[1] * LCAP + base_l[en[1]] + en[3];
            list[ia] = tok * 2u; listw[ia] = __uint_as_float(en[4]);
            list[ib] = tok * 2u + 1u; listw[ib] = __uint_as_float(en[5]);
        }
        __syncthreads();
    }
}
__device__ __forceinline__ void build_expert_tab(const Frame& F, const unsigned* gcnt, LAS int* tab) {
    if (F.tid < 64) {
        const int c = F.lane < 32 ? (int)__hip_atomic_load(gcnt + F.lane * 64, __ATOMIC_RELAXED, __HIP_MEMORY_SCOPE_AGENT) : 0;
        int tiles = (c + 255) >> 8, incl = tiles;
#pragma unroll
        for (int o = 1; o < 32; o <<= 1) { const int t = __builtin_amdgcn_ds_bpermute((F.lane - o) << 2, incl); if (F.lane >= o) incl += t; }
        if (F.lane < 32) { tab[F.lane + 1] = incl; tab[33 + F.lane] = c; }
        if (F.lane == 0) tab[0] = 0;
    }
    __syncthreads();
}
__device__ __forceinline__ void ph_experts_naive(const Frame& F, const bf16* hn, const unsigned* route, const float* wg, const float* wu, const float* wd, float* x) {
    LAS float* hs = (LAS float*)F.lds;
    LAS float* hd = hs + 1024;
    for (int tok = F.blk; tok < T; tok += F.G) {
        { const unsigned pv = *(const unsigned*)(hn + (size_t)tok * DM + F.tid * 2); hs[F.tid * 2] = __uint_as_float(pv << 16); hs[F.tid * 2 + 1] = __uint_as_float(pv & 0xffff0000u); }
        const u32x4 rt = *(const u32x4*)(route + (size_t)tok * 4);
        __syncthreads();
        {
            const int s = F.tid >> 8, f = F.tid & 255;
            const unsigned e = s ? rt.y : rt.x; const float w = __uint_as_float(s ? rt.w : rt.z);
            const float* pg = wg + (size_t)e * DM * 256 + f; const float* pu = wu + (size_t)e * DM * 256 + f;
            float ga = 0.f, ua = 0.f;
            for (int d = 0; d < DM; ++d) { const float hv = hs[d]; ga += hv * pg[(size_t)d * 256]; ua += hv * pu[(size_t)d * 256]; }
            hd[s * 256 + f] = ga * sigmoidf_(ga) * ua * w;
        }
        __syncthreads();
        for (int dd = F.tid; dd < DM; dd += NTHR) {
            float acc = 0.f;
            const float* p0 = wd + (size_t)rt.x * 256 * DM + dd; const float* p1 = wd + (size_t)rt.y * 256 * DM + dd;
            for (int f = 0; f < 256; ++f) acc += hd[f] * p0[(size_t)f * DM];
            for (int f = 0; f < 256; ++f) acc += hd[256 + f] * p1[(size_t)f * DM];
            x[(size_t)tok * DM + dd] += acc;
        }
        __syncthreads();
    }
}


namespace nsa {
typedef short bf16x8 __attribute__((ext_vector_type(8)));
typedef short s16x4 __attribute__((ext_vector_type(4)));
typedef float f32x16 __attribute__((ext_vector_type(16)));
typedef float f32x2_t __attribute__((ext_vector_type(2)));
typedef __bf16 bf16x2_t __attribute__((ext_vector_type(2)));
constexpr int SLOTB = 8192;
constexpr int L_K = 0, L_V = 3 * SLOTB, L_IMP = 6 * SLOTB, L_BT = L_IMP + 65536, L_WS = L_BT + 4 * 132 * 4, L_RL = L_WS + 8 * 64 * 4, L_SM = L_RL + 4 * 64 * 4, L_RT = L_SM + 64 * 8, L_END = L_RT + 4 * 320 * 4;
static_assert(L_END <= 131072, "nsa LDS map");
constexpr float LOG2E = 1.4426950408889634f;
constexpr float NEG_INF = -__builtin_inff();
#define NSA_SBAR() __builtin_amdgcn_sched_barrier(0)
__device__ __forceinline__ int crow(int r, int hi) { return (r & 3) + 8 * (r >> 2) + 4 * hi; }
__device__ __forceinline__ void glds16(const void* gsrc, unsigned lds_dst) { unsigned keep;
    asm volatile("s_mov_b32 %0, m0\n\ts_mov_b32 m0, %2\n\ts_nop 0\n\tglobal_load_lds_dwordx4 %1, off\n\ts_mov_b32 m0, %0" : "=&s"(keep) : "v"(gsrc), "s"(lds_dst) : "memory"); }
__device__ __forceinline__ unsigned cvtpk(float lo, float hi) { f32x2_t v = {lo, hi}; bf16x2_t b = __builtin_convertvector(v, bf16x2_t); return __builtin_bit_cast(unsigned, b); }
#define NSA_WAIT_BAR(N) asm volatile("s_waitcnt vmcnt(" #N ") lgkmcnt(0)\n\ts_barrier" ::: "memory")
__device__ __forceinline__ void qkt(f32x16& p0, f32x16& p1, const LAS char* kb, const bf16x8 (&qr)[4], const f32x16& cinit) {
#pragma unroll
    for (int d0 = 0; d0 < 4; ++d0) {
        const bf16x8 b0 = *(const LAS bf16x8*)(kb + d0 * 2048);
        const bf16x8 b1 = *(const LAS bf16x8*)(kb + d0 * 2048 + 512);
        if (d0 == 0) { p0 = __builtin_amdgcn_mfma_f32_32x32x16_bf16(b0, qr[0], cinit, 0, 0, 0); p1 = __builtin_amdgcn_mfma_f32_32x32x16_bf16(b1, qr[0], cinit, 0, 0, 0); }
        else { p0 = __builtin_amdgcn_mfma_f32_32x32x16_bf16(b0, qr[d0], p0, 0, 0, 0); p1 = __builtin_amdgcn_mfma_f32_32x32x16_bf16(b1, qr[d0], p1, 0, 0, 0); }
    }
}
__device__ __forceinline__ void pv(f32x16 (&o)[2], int vb, bf16x8 pa0, bf16x8 pa1, bf16x8 pa2, bf16x8 pa3) {
#pragma unroll
    for (int d0 = 0; d0 < 2; ++d0) { s16x4 lo[4], hi[4];
#pragma unroll
        for (int ks = 0; ks < 4; ++ks) {
            asm volatile("ds_read_b64_tr_b16 %0,%1 offset:%c2" : "=&v"(lo[ks]) : "v"(vb), "i"(d0 * 4096 + ks * 1024) : "memory");
            asm volatile("ds_read_b64_tr_b16 %0,%1 offset:%c2" : "=&v"(hi[ks]) : "v"(vb), "i"(d0 * 4096 + ks * 1024 + 512) : "memory"); }
        asm volatile("s_waitcnt lgkmcnt(0)" ::: "memory"); NSA_SBAR();
#define NSA_PK(k) (bf16x8){lo[k][0], lo[k][1], lo[k][2], lo[k][3], hi[k][0], hi[k][1], hi[k][2], hi[k][3]}
        o[d0] = __builtin_amdgcn_mfma_f32_32x32x16_bf16(pa0, NSA_PK(0), o[d0], 0, 0, 0);
        o[d0] = __builtin_amdgcn_mfma_f32_32x32x16_bf16(pa1, NSA_PK(1), o[d0], 0, 0, 0);
        o[d0] = __builtin_amdgcn_mfma_f32_32x32x16_bf16(pa2, NSA_PK(2), o[d0], 0, 0, 0);
        o[d0] = __builtin_amdgcn_mfma_f32_32x32x16_bf16(pa3, NSA_PK(3), o[d0], 0, 0, 0);
#undef NSA_PK
    }
}
typedef short v4i16_t __attribute__((ext_vector_type(4)));
__device__ __forceinline__ s16x4 vtr(const LAS char* p) { return __builtin_bit_cast(s16x4, __builtin_amdgcn_ds_read_tr16_b64_v4i16((LAS v4i16_t*)p)); }
__device__ __forceinline__ void pv2(f32x16 (&o)[2], const LAS char* vp, bf16x8 pa0, bf16x8 pa1, bf16x8 pa2, bf16x8 pa3) {
#pragma unroll
    for (int d0 = 0; d0 < 2; ++d0) {
        s16x4 lo[4], hi[4];
#pragma unroll
        for (int ks = 0; ks < 4; ++ks) { lo[ks] = vtr(vp + d0 * 4096 + ks * 1024); hi[ks] = vtr(vp + d0 * 4096 + ks * 1024 + 512); }
#define NSA_PK(k) (bf16x8){lo[k][0], lo[k][1], lo[k][2], lo[k][3], hi[k][0], hi[k][1], hi[k][2], hi[k][3]}
        o[d0] = __builtin_amdgcn_mfma_f32_32x32x16_bf16(pa0, NSA_PK(0), o[d0], 0, 0, 0);
        o[d0] = __builtin_amdgcn_mfma_f32_32x32x16_bf16(pa1, NSA_PK(1), o[d0], 0, 0, 0);
        o[d0] = __builtin_amdgcn_mfma_f32_32x32x16_bf16(pa2, NSA_PK(2), o[d0], 0, 0, 0);
        o[d0] = __builtin_amdgcn_mfma_f32_32x32x16_bf16(pa3, NSA_PK(3), o[d0], 0, 0, 0);
#undef NSA_PK
    }
}
__device__ __forceinline__ float other_half(float v, int hi) { auto rr = __builtin_amdgcn_permlane32_swap(__float_as_uint(v), __float_as_uint(v), false, false); return __uint_as_float(hi ? rr[0] : rr[1]); }
__device__ __forceinline__ float rowmax(const f32x16& p0, const f32x16& p1, int hi) {
    float a = fmaxf(fmaxf(p0[0], p0[1]), p1[0]), b = fmaxf(fmaxf(p0[2], p0[3]), p1[1]); a = fmaxf(fmaxf(a, p1[2]), p1[3]);
#pragma unroll
    for (int r = 4; r < 16; r += 4) { a = fmaxf(fmaxf(a, p0[r]), p0[r + 1]); b = fmaxf(fmaxf(b, p0[r + 2]), p0[r + 3]); a = fmaxf(fmaxf(a, p1[r]), p1[r + 1]); b = fmaxf(fmaxf(b, p1[r + 2]), p1[r + 3]); }
    const float m = fmaxf(a, b);
    return fmaxf(m, other_half(m, hi));
}
__device__ __forceinline__ void pack_p(const f32x16& p0, const f32x16& p1, bf16x8& a0, bf16x8& a1, bf16x8& a2, bf16x8& a3) {
    u32x4 w0, w1, w2, w3;
    w0 = (u32x4){cvtpk(p0[0], p0[1]), cvtpk(p0[2], p0[3]), cvtpk(p0[4], p0[5]), cvtpk(p0[6], p0[7])};
    w1 = (u32x4){cvtpk(p0[8], p0[9]), cvtpk(p0[10], p0[11]), cvtpk(p0[12], p0[13]), cvtpk(p0[14], p0[15])};
    w2 = (u32x4){cvtpk(p1[0], p1[1]), cvtpk(p1[2], p1[3]), cvtpk(p1[4], p1[5]), cvtpk(p1[6], p1[7])};
    w3 = (u32x4){cvtpk(p1[8], p1[9]), cvtpk(p1[10], p1[11]), cvtpk(p1[12], p1[13]), cvtpk(p1[14], p1[15])};
    a0 = __builtin_bit_cast(bf16x8, w0); a1 = __builtin_bit_cast(bf16x8, w1); a2 = __builtin_bit_cast(bf16x8, w2); a3 = __builtin_bit_cast(bf16x8, w3);
}

struct Ctx {
    LAS char* lds; unsigned lds0; int wid, lane, r32, hi, g, th, qloc;
    const LAS float* bt;
    const LAS float* rt;
    LAS float* wsf;
    const LAS float* wrow;
    int vb0;
    const LAS char* vp0;
    const LAS char* kb0;
};
__device__ __forceinline__ void dma_k(const Ctx& c, const bf16* kbase, int pitch, int slot) { glds16(kbase + (size_t)c.lane * pitch + c.wid * 8, (unsigned)__builtin_amdgcn_readfirstlane(c.lds0 + L_K + slot * SLOTB + c.wid * 1024)); }
__device__ __forceinline__ void dma_v(const Ctx& c, const bf16* vbase, int pitch, int slot) { glds16(vbase + (size_t)(16 * (c.wid & 3) + (c.lane >> 2)) * pitch + (c.wid >> 2) * 32 + (c.lane & 3) * 8, (unsigned)__builtin_amdgcn_readfirstlane(c.lds0 + L_V + slot * SLOTB + c.wid * 1024)); }

__device__ __forceinline__ void cmp_scores(const Ctx& c, int slot, const bf16x8 (&qr)[4], int t0, int kt, f32x16& p0, f32x16& p1) {
    const int dmin = t0 + 32 * c.th - 16 * (64 * kt + 63) - 31;
    const bool special = dmin < 113;
    f32x16 ci; { const float v = special ? 0.f : c.bt[128];
#pragma unroll
        for (int r = 0; r < 16; ++r) ci[r] = v; }
    qkt(p0, p1, c.kb0 + slot * SLOTB, qr, ci);
    if (special) {
        int hi64 = 64 * c.hi; asm volatile("" : "+v"(hi64));
        const int dqh = t0 + c.qloc - 1024 * kt - 31 - hi64;
        float b0[16], b1[16];
#pragma unroll
        for (int r = 0; r < 16; ++r) { const int d0 = dqh - 16 * ((r & 3) + 8 * (r >> 2)), d1 = d0 - 512; b0[r] = c.bt[d0 < 0 ? 0 : (d0 > 128 ? 128 : d0)]; b1[r] = c.bt[d1 < 0 ? 0 : (d1 > 128 ? 128 : d1)]; }
#pragma unroll
        for (int r = 0; r < 16; ++r) {
            const int d0 = dqh - 16 * ((r & 3) + 8 * (r >> 2)), d1 = d0 - 512;
            p0[r] = d0 < 0 ? NEG_INF : p0[r] + b0[r]; p1[r] = d1 < 0 ? NEG_INF : p1[r] + b1[r];
        }
    }
}
template <int MODE>
__device__ __forceinline__ void online_tile(const Ctx& c, int slot, const bf16x8 (&qr)[4], int dq, bool near, bool masked_tile, bool lane_off, float& mhat, float& lsum, f32x16 (&o)[2]) {
    f32x16 ci; { const float v = (near ? 0.f : c.bt[128]) - mhat;
#pragma unroll
        for (int r = 0; r < 16; ++r) ci[r] = v; }
    f32x16 p0, p1;
    qkt(p0, p1, c.kb0 + slot * SLOTB, qr, ci);
    if (near || masked_tile) {
        int hi4 = 4 * c.hi; asm volatile("" : "+v"(hi4));
        const int dqh = dq - hi4;
#pragma unroll
        for (int r = 0; r < 16; ++r) {
            const int d0 = dqh - ((r & 3) + 8 * (r >> 2)), d1 = d0 - 32;
            if (near) { p0[r] += c.bt[d0 < 0 ? 0 : (d0 > 128 ? 128 : d0)]; p1[r] += c.bt[d1 < 0 ? 0 : (d1 > 128 ? 128 : d1)]; }
            if (d0 < 0 || (MODE == 1 && d0 >= 512)) p0[r] = NEG_INF;
            if (d1 < 0 || (MODE == 1 && d1 >= 512)) p1[r] = NEG_INF;
        }
    }
    if (MODE == 0) { if (lane_off) {
#pragma unroll
        for (int r = 0; r < 16; ++r) { p0[r] = NEG_INF; p1[r] = NEG_INF; } } }
    const float rm = rowmax(p0, p1, c.hi);
    if (__any(rm > 8.0f)) {
        const float dl = fmaxf(rm, 0.f); mhat += dl;
#pragma unroll
        for (int r = 0; r < 16; ++r) { p0[r] -= dl; p1[r] -= dl; }
        const float f = __builtin_amdgcn_exp2f(-dl); lsum *= f;
        if (c.hi == 0) c.wsf[c.r32] = f;
        asm volatile("s_waitcnt lgkmcnt(0)" ::: "memory");
#pragma unroll
        for (int r = 0; r < 16; ++r) { const float fr = c.wrow[(r & 3) + 8 * (r >> 2)]; o[0][r] *= fr; o[1][r] *= fr; }
    }
    float sacc = 0.f;
#pragma unroll
    for (int r = 0; r < 16; ++r) { p0[r] = __builtin_amdgcn_exp2f(p0[r]); p1[r] = __builtin_amdgcn_exp2f(p1[r]); sacc += p0[r] + p1[r]; }
    lsum += sacc;
    bf16x8 a0, a1, a2, a3; pack_p(p0, p1, a0, a1, a2, a3);
    pv(o, c.vb0 + slot * SLOTB, a0, a1, a2, a3);
}
struct Pipe { bf16x8 a0, a1, a2, a3; bool have, resc; };
template <int MODE, int SPECIAL  , bool HAVE>
__device__ __forceinline__ void online_step(const Ctx& c, int kslot, int vslot_prev, const bf16x8 (&qr)[4], int dq, bool near, bool lane_off, float& mhat, float& lsum, f32x16 (&o)[2], Pipe& pp) {
    if (pp.resc) {
#pragma unroll
        for (int r = 0; r < 16; ++r) { const float fr = c.wrow[(r & 3) + 8 * (r >> 2)]; o[0][r] *= fr; o[1][r] *= fr; }
    }
    f32x16 ci; { const float v = (MODE == 0 && lane_off) ? NEG_INF : ((SPECIAL == 1 ? 0.f : c.bt[128]) - mhat);
#pragma unroll
        for (int r = 0; r < 16; ++r) ci[r] = v; }
    f32x16 p0, p1;
    qkt(p0, p1, c.kb0 + kslot * SLOTB, qr, ci);
    if (HAVE) pv2(o, c.vp0 + vslot_prev * SLOTB, pp.a0, pp.a1, pp.a2, pp.a3);
    if (SPECIAL == 1) {
        const LAS float* rp = c.rt + (255 - dq + 4 * c.hi);
#pragma unroll
        for (int r = 0; r < 16; ++r) { p0[r] += rp[(r & 3) + 8 * (r >> 2)]; p1[r] += rp[32 + (r & 3) + 8 * (r >> 2)]; }
    }
    if (SPECIAL == 2) {
        int hi4 = 4 * c.hi; asm volatile("" : "+v"(hi4));
        const int dqh = dq - hi4;
#pragma unroll
        for (int r = 0; r < 16; ++r) {
            const int d0 = dqh - ((r & 3) + 8 * (r >> 2)), d1 = d0 - 32;
            if (d0 < 0 || (MODE == 1 && d0 >= 512)) p0[r] = NEG_INF;
            if (d1 < 0 || (MODE == 1 && d1 >= 512)) p1[r] = NEG_INF;
        }
    }
    const float rm = rowmax(p0, p1, c.hi);
    const bool mv = __any(rm > 8.0f);
    if (mv) {
        const float dl = fmaxf(rm, 0.f); mhat += dl;
#pragma unroll
        for (int r = 0; r < 16; ++r) { p0[r] -= dl; p1[r] -= dl; }
        const float f = __builtin_amdgcn_exp2f(-dl); lsum *= f;
        c.wsf[c.r32] = f;
    }
    pp.resc = mv;
    float sacc = 0.f;
#pragma unroll
    for (int r = 0; r < 16; ++r) { p0[r] = __builtin_amdgcn_exp2f(p0[r]); p1[r] = __builtin_amdgcn_exp2f(p1[r]); sacc += p0[r] + p1[r]; }
    lsum += sacc;
    pack_p(p0, p1, pp.a0, pp.a1, pp.a2, pp.a3); pp.have = true;
}
__device__ __forceinline__ void online_drain(const Ctx& c, int vslot_prev, f32x16 (&o)[2], Pipe& pp) {
    if (pp.resc) {
#pragma unroll
        for (int r = 0; r < 16; ++r) { const float fr = c.wrow[(r & 3) + 8 * (r >> 2)]; o[0][r] *= fr; o[1][r] *= fr; }
    }
    if (pp.have) pv2(o, c.vp0 + vslot_prev * SLOTB, pp.a0, pp.a1, pp.a2, pp.a3);
}
__device__ __forceinline__ void add_scaled(const Ctx& c, f32x16 (&oacc)[2], const f32x16 (&o)[2], float s) {
    if (c.hi == 0) c.wsf[32 + c.r32] = s;
    asm volatile("s_waitcnt lgkmcnt(0)" ::: "memory");
#pragma unroll
    for (int r = 0; r < 16; ++r) { const float f = c.wrow[32 + (r & 3) + 8 * (r >> 2)]; oacc[0][r] += o[0][r] * f; oacc[1][r] += o[1][r] * f; }
    asm volatile("s_waitcnt lgkmcnt(0)" ::: "memory");
}

__device__ __forceinline__ void add_scaled_park(const Ctx& c, LAS float* park, const f32x16 (&o)[2], float s) {
    if (c.hi == 0) c.wsf[32 + c.r32] = s;
    asm volatile("s_waitcnt lgkmcnt(0)" ::: "memory");
#pragma unroll
    for (int r = 0; r < 16; ++r) { const float f = c.wrow[32 + (r & 3) + 8 * (r >> 2)]; park[r * 64] += o[0][r] * f; park[(16 + r) * 64] += o[1][r] * f; }
    asm volatile("s_waitcnt lgkmcnt(0)" ::: "memory");
}
__device__ __forceinline__ void unit(LAS char* lds, int tid, int b, int hkv, int jt, const bf16* Z, const bf16* KCm, const bf16* VCm, const float* rel_bias, bf16* YC, bool fill_table) {
    Ctx c; c.lds = lds; c.lds0 = (unsigned)(uintptr_t)lds; c.wid = __builtin_amdgcn_readfirstlane(tid >> 6); c.lane = tid & 63; c.r32 = c.lane & 31; c.hi = c.lane >> 5;
    c.g = c.wid & 3; c.th = c.wid >> 2; c.qloc = 32 * c.th + c.r32;
    c.bt = (const LAS float*)(lds + L_BT) + c.g * 132; c.rt = (const LAS float*)(lds + L_RT) + c.g * 320; c.wsf = (LAS float*)(lds + L_WS) + c.wid * 64; c.wrow = c.wsf + 4 * c.hi;
    c.vb0 = (int)(c.lds0 + L_V) + ((c.lane >> 4) & 1) * 32 + (c.lane & 3) * 8 + (4 * c.hi + ((c.lane & 15) >> 2)) * 64;
    c.kb0 = (const LAS char*)(lds + L_K) + c.hi * 1024 + c.r32 * 16;
    c.vp0 = (const LAS char*)(lds + L_V) + ((c.lane >> 4) & 1) * 32 + (c.lane & 3) * 8 + (4 * c.hi + ((c.lane & 15) >> 2)) * 64;
    const int t0 = 64 * jt;
    const bf16* Zb = Z + (size_t)b * SEQ * ZP;
    const size_t qrow = (size_t)b * SEQ + t0 + c.qloc;
    if (fill_table) for (int i = tid; i < 4 * 129; i += NTHR) { const int gg = i / 129, d = i % 129; ((LAS float*)(lds + L_BT))[gg * 132 + d] = rel_bias[t5_bucket(d) * 8 + hkv * 4 + gg] * LOG2E; }
    if (fill_table) for (int i = tid; i < 4 * 320; i += NTHR) { const int gg = i / 320, d = 255 - (i % 320); ((LAS float*)(lds + L_RT))[i] = d < 0 ? NEG_INF : rel_bias[t5_bucket(d > 128 ? 128 : d) * 8 + hkv * 4 + gg] * LOG2E; }
    bf16x8 qr[4];
#pragma unroll
    for (int d0 = 0; d0 < 4; ++d0) qr[d0] = *(const bf16x8*)(Z + qrow * ZP + ZC_Q + hkv * 256 + c.g * 64 + d0 * 16 + c.hi * 8);
    const bf16* gp = Z + qrow * ZP + ZC_G + hkv * 12 + c.g * 3;
    const float gate0 = sigmoidf_(bf2f(gp[0])), gate1 = sigmoidf_(bf2f(gp[1])), gate2 = sigmoidf_(bf2f(gp[2]));
    f32x16 oacc[2];
#pragma unroll
    for (int r = 0; r < 16; ++r) { oacc[0][r] = 0.f; oacc[1][r] = 0.f; }

    const int nct = (4 * jt + 2) / 64 + 1;
    const bf16* kcb = KCm + (size_t)b * NCMPP * 128 + hkv * 64; const bf16* vcb = VCm + (size_t)b * NCMPP * 128 + hkv * 64;
    const bf16* skb = Zb + ZC_KV + 256 + hkv * 64; const bf16* svb = Zb + ZC_KV + 384 + hkv * 64;
    {
        float mhat = 0.f, lsum = 0.f, carry = 0.f; f32x16 o[2];
#pragma unroll
        for (int r = 0; r < 16; ++r) { o[0][r] = 0.f; o[1][r] = 0.f; }
        LAS float* impw = (LAS float*)(lds + L_IMP) + (c.g * 64 + c.qloc) * 64;
        dma_k(c, kcb, 128, 0); dma_v(c, vcb, 128, 0); if (nct > 1) { dma_k(c, kcb + 64 * 128, 128, 1); dma_v(c, vcb + 64 * 128, 128, 1); }
        for (int i = 0; i < nct; ++i) {
            if (i + 1 < nct) NSA_WAIT_BAR(2); else NSA_WAIT_BAR(0);
            if (i + 2 < nct) { dma_k(c, kcb + (size_t)(i + 2) * 64 * 128, 128, (i + 2) % 3); dma_v(c, vcb + (size_t)(i + 2) * 64 * 128, 128, (i + 2) % 3); }
            f32x16 p0, p1; cmp_scores(c, i % 3, qr, t0, i, p0, p1);
            const float rm = rowmax(p0, p1, c.hi) - mhat;
            if (__any(rm > 8.0f)) {
                const float dl = fmaxf(rm, 0.f); mhat += dl;
                const float f = __builtin_amdgcn_exp2f(-dl); lsum *= f; carry *= f;
                c.wsf[c.r32] = f;
                asm volatile("s_waitcnt lgkmcnt(0)" ::: "memory");
#pragma unroll
                for (int r = 0; r < 16; ++r) { const float fr = c.wrow[(r & 3) + 8 * (r >> 2)]; o[0][r] *= fr; o[1][r] *= fr; }
                for (int e = c.hi; e < 16 * i; e += 2) impw[e] *= f;
            }
            float sacc = 0.f;
#pragma unroll
            for (int r = 0; r < 16; ++r) { p0[r] = __builtin_amdgcn_exp2f(p0[r] - mhat); p1[r] = __builtin_amdgcn_exp2f(p1[r] - mhat); sacc += p0[r] + p1[r]; }
            lsum += sacc;
            float o3[8];
#pragma unroll
            for (int k = 0; k < 4; ++k) { o3[k] = other_half(p0[4 * k + 3], c.hi); o3[4 + k] = other_half(p1[4 * k + 3], c.hi); }
#pragma unroll
            for (int idx = 0; idx < 8; ++idx) {
                const int X = idx >> 2, k = idx & 3;
                const f32x16& p = X ? p1 : p0;
                const float cin = c.hi ? o3[idx] : (idx ? o3[idx - 1] : carry);
                impw[16 * i + 8 * X + 2 * k + c.hi] = p[4 * k] + p[4 * k + 1] + p[4 * k + 2] + 0.5f * p[4 * k + 3] + 0.5f * cin;
            }
            carry = o3[7];
            bf16x8 a0, a1, a2, a3; pack_p(p0, p1, a0, a1, a2, a3);
            pv(o, c.vb0 + (i % 3) * SLOTB, a0, a1, a2, a3);
        }
        const float lt = lsum + other_half(lsum, c.hi);
        const float rl = lt > 0.f ? 1.0f / lt : 0.f;
        if (c.hi == 0) ((LAS float*)(lds + L_RL))[c.g * 64 + c.qloc] = rl;
        add_scaled(c, oacc, o, rl * gate0);
        NSA_WAIT_BAR(0);
    }
    { const int nt = jt + 1; dma_k(c, skb, ZP, 0); if (nt > 1) dma_k(c, skb + (size_t)64 * ZP, ZP, 1); dma_v(c, svb, ZP, 0); }
    for (int k = 0; k < 8; ++k) {
        const int tok = c.wid * 8 + k;
        float v = 0.f;
#pragma unroll
        for (int gg = 0; gg < 4; ++gg) v += ((const LAS float*)(lds + L_IMP))[(gg * 64 + tok) * 64 + c.lane] * ((const LAS float*)(lds + L_RL))[gg * 64 + tok];
        const bool forced = (c.lane == 0) || (c.lane <= jt && c.lane > jt - 2), future = c.lane > jt;
        v = forced ? 1e9f : (future ? -1e9f : v);
        int rank = 0;
#pragma unroll
        for (int jj = 0; jj < 64; ++jj) { const float vj = __builtin_bit_cast(float, __builtin_amdgcn_readlane(__builtin_bit_cast(int, v), jj)); rank += ((vj > v) || (vj == v && jj < c.lane)) ? 1 : 0; }
        const unsigned long long msk = __ballot(rank < 16 && !future);
        if (c.lane == 0) ((LAS unsigned long long*)(lds + L_SM))[tok] = msk;
    }
    asm volatile("s_waitcnt lgkmcnt(0)\n\ts_barrier" ::: "memory");
    const unsigned long long mymask = ((const LAS unsigned long long*)(lds + L_SM))[c.qloc];
    LAS float* park = (LAS float*)(lds + L_IMP) + c.wid * 2048 + c.lane;
#pragma unroll
    for (int r = 0; r < 16; ++r) { park[r * 64] = oacc[0][r]; park[(16 + r) * 64] = oacc[1][r]; }
    {
        const bf16* kb = skb; const bf16* vb = svb;
        const int nt = jt + 1;
        float mhat = 0.f, lsum = 0.f; f32x16 o[2]; Pipe pp; pp.have = false; pp.resc = false;
#pragma unroll
        for (int r = 0; r < 16; ++r) { o[0][r] = 0.f; o[1][r] = 0.f; }
#define NSA_ITER_HEAD(i) do { if ((i) + 1 < nt) NSA_WAIT_BAR(2); else NSA_WAIT_BAR(1); \
            if ((i) + 2 < nt) dma_k(c, kb + (size_t)((i) + 2) * 64 * ZP, ZP, ((i) + 2) % 3); \
            if ((i) + 1 < nt) dma_v(c, vb + (size_t)((i) + 1) * 64 * ZP, ZP, ((i) + 1) % 3); } while (0)
        {
            NSA_ITER_HEAD(0);
            if (jt <= 2) online_step<0, 1, false>(c, 0, 2, qr, 64 * jt + c.qloc, true, !(mymask & 1ull), mhat, lsum, o, pp); else online_step<0, 0, false>(c, 0, 2, qr, 0, false, !(mymask & 1ull), mhat, lsum, o, pp); }
        const int nfar = jt - 2;
        int i = 1;
        for (; i < nfar; ++i) { NSA_ITER_HEAD(i);
            online_step<0, 0, true>(c, i % 3, (i + 2) % 3, qr, 0, false, !((mymask >> i) & 1ull), mhat, lsum, o, pp); }
        for (; i < nt; ++i) { NSA_ITER_HEAD(i);
            online_step<0, 1, true>(c, i % 3, (i + 2) % 3, qr, 64 * (jt - i) + c.qloc, true, !((mymask >> i) & 1ull), mhat, lsum, o, pp); }
        NSA_WAIT_BAR(0);
        online_drain(c, (nt - 1) % 3, o, pp);
        const float lt = lsum + other_half(lsum, c.hi);
        add_scaled_park(c, park, o, (lt > 0.f ? 1.0f / lt : 0.f) * gate1);
        NSA_WAIT_BAR(0);
    }
    {
        const int j0 = jt > 8 ? jt - 8 : 0, nt = jt - j0 + 1;
        const bf16* kb = Zb + (size_t)j0 * 64 * ZP + ZC_KV + 512 + hkv * 64; const bf16* vb = Zb + (size_t)j0 * 64 * ZP + ZC_KV + 640 + hkv * 64;
        float mhat = 0.f, lsum = 0.f; f32x16 o[2]; Pipe pp; pp.have = false; pp.resc = false;
#pragma unroll
        for (int r = 0; r < 16; ++r) { o[0][r] = 0.f; o[1][r] = 0.f; }
        dma_k(c, kb, ZP, 0); if (nt > 1) dma_k(c, kb + (size_t)64 * ZP, ZP, 1); dma_v(c, vb, ZP, 0);
        {
            NSA_ITER_HEAD(0);
            if (j0 >= jt - 2) online_step<1, 1, false>(c, 0, 2, qr, 64 * (jt - j0) + c.qloc, true, false, mhat, lsum, o, pp); else online_step<1, 2, false>(c, 0, 2, qr, 64 * (jt - j0) + c.qloc, false, false, mhat, lsum, o, pp); }
        int i = 1;
        for (; j0 + i < jt - 2; ++i) { NSA_ITER_HEAD(i);
            online_step<1, 0, true>(c, i % 3, (i + 2) % 3, qr, 0, false, false, mhat, lsum, o, pp); }
        for (; i < nt; ++i) { NSA_ITER_HEAD(i); const int j = j0 + i;
            online_step<1, 1, true>(c, i % 3, (i + 2) % 3, qr, 64 * (jt - j) + c.qloc, true, false, mhat, lsum, o, pp); }
#undef NSA_ITER_HEAD
        NSA_WAIT_BAR(0);
        online_drain(c, (nt - 1) % 3, o, pp);
        const float lt = lsum + other_half(lsum, c.hi);
        add_scaled_park(c, park, o, (lt > 0.f ? 1.0f / lt : 0.f) * gate2);
    }
    {
        bf16* yb = YC + ((size_t)b * SEQ + t0 + 32 * c.th + 4 * c.hi) * DM + D_SSM + hkv * 256 + c.g * 64 + c.r32;
#pragma unroll
        for (int r = 0; r < 16; ++r) { bf16* yr = yb + (size_t)((r & 3) + 8 * (r >> 2)) * DM; yr[0] = (bf16)f2bf(park[r * 64]); yr[32] = (bf16)f2bf(park[(16 + r) * 64]); }
    }
    asm volatile("s_waitcnt vmcnt(0)" ::: "memory");
    NSA_WAIT_BAR(0);
}
#undef NSA_SBAR
#undef NSA_WAIT_BAR
}


__device__ __forceinline__ void ssm_precompute(const Frame& F, const __attribute__((address_space(4))) Args* args, unsigned char* ws, int item) {
    const int layer = item >> 5, g = item & 31, lg = layer * 32 + g;
    LAS float* L = (LAS float*)F.lds;
    LAS float* lkr = L; LAS float* lki = L + 17 * 64; LAS float* bbr = L + 2 * 17 * 64; LAS float* bbi = bbr + 1024; LAS float* ccr = bbi + 1024; LAS float* cci = ccr + 1024;
    LAS float* wk = cci + 1024; LAS float* dd = wk + 4096;
    const float* a_re = args->in[6] + lg * 64; const float* a_im = args->in[7] + lg * 64;
    const float dt = expf(args->in[13][lg]);
    for (int i = F.tid; i < 17 * 64; i += NTHR) { const int k = i >> 6, p = i & 63; const float er = expf(a_re[p] * dt * (float)k), ang = a_im[p] * dt * (float)k; lkr[i] = er * cosf(ang); lki[i] = er * sinf(ang); }
    for (int i = F.tid; i < 1024; i += NTHR) {
        { const int p = i >> 4, h = i & 15; const float are = a_re[p], aim = a_im[p];
          const float er = expf(are * dt), lbr = er * cosf(aim * dt), lbi = er * sinf(aim * dt);
          const float xx = lbr - 1.0f, yy = lbi, den = are * are + aim * aim, fr = (xx * are + yy * aim) / den, fi = (yy * are - xx * aim) / den;
          const float br = args->in[8][((size_t)lg * 64 + p) * 16 + h], bi = args->in[9][((size_t)lg * 64 + p) * 16 + h];
          bbr[i] = fr * br - fi * bi; bbi[i] = fr * bi + fi * br; }
        ccr[i] = args->in[10][(size_t)lg * 1024 + i]; cci[i] = args->in[11][(size_t)lg * 1024 + i];
    }
    if (F.tid < 16) dd[F.tid] = args->in[12][lg * 16 + F.tid];
    __syncthreads();
    for (int i = F.tid; i < 4096; i += NTHR) { const int k = i >> 8, ho = (i >> 4) & 15, hi = i & 15; float acc = 0.f;
        for (int p = 0; p < 64; ++p) { const float cr = ccr[ho * 64 + p], ci = cci[ho * 64 + p], lr = lkr[k * 64 + p], li = lki[k * 64 + p];
            const float tr = cr * lr - ci * li, ti = cr * li + ci * lr; acc += tr * bbr[p * 16 + hi] - ti * bbi[p * 16 + hi]; }
        wk[i] = acc + ((k == 0 && ho == hi) ? dd[ho] : 0.f); }
    __syncthreads();
    bf16* B2 = (bf16*)(ws + WS_BT2) + (size_t)lg * 256 * 384;
    for (int i = F.tid; i < 256 * 384; i += NTHR) { const int n = i / 384, kk = i % 384, t = n >> 4, ho = n & 15; float v;
        if (kk < 256) { const int sidx = kk >> 4, hi = kk & 15; v = sidx <= t ? wk[((t - sidx) << 8) + ho * 16 + hi] : 0.f; }
        else { const int j = kk - 256, p = j & 63; const float cr = ccr[ho * 64 + p], ci = cci[ho * 64 + p], lr = lkr[(t + 1) * 64 + p], li = lki[(t + 1) * 64 + p];
            v = j < 64 ? (cr * lr - ci * li) : -(cr * li + ci * lr); }
        B2[i] = (bf16)f2bf(v); }
    bf16* B1 = (bf16*)(ws + WS_BT1) + (size_t)lg * 256 * 256;
    for (int i = F.tid; i < 65536; i += NTHR) { const int j = i >> 8, kk = i & 255, sidx = kk >> 4, hi = kk & 15; float v = 0.f;
        if (j < 128) { const int p = j & 63; const float lr = lkr[(15 - sidx) * 64 + p], li = lki[(15 - sidx) * 64 + p], br = bbr[p * 16 + hi], bi = bbi[p * 16 + hi];
            v = j < 64 ? (lr * br - li * bi) : (lr * bi + li * br); }
        B1[i] = (bf16)f2bf(v); }
    __syncthreads();
}
__device__ __forceinline__ void ssm_carry_item(int b, int g, const float* a_re, const float* a_im, const float* log_dt, const float* XL, bf16* U, int lane) {
    const float dt16 = 16.0f * expf(log_dt[g]);
    const float er = expf(a_re[g * 64 + lane] * dt16), ang = a_im[g * 64 + lane] * dt16, lr = er * cosf(ang), li = er * sinf(ang);
    float xr = 0.f, xi = 0.f;
    const float* __restrict__ xl = XL + ((size_t)g * 2048 + b * 256) * 128 + lane;
    bf16* __restrict__ up = U + ((size_t)g * 2048 + b * 256) * 512 + 256 + lane;
    float ar[16], ai[16], nr_[16], ni_[16];
#pragma unroll
    for (int k = 0; k < 16; ++k) { ar[k] = xl[(size_t)k * 128]; ai[k] = xl[(size_t)k * 128 + 64]; }
    for (int cb = 0; cb < 16; ++cb) {
        const int cn = cb < 15 ? (cb + 1) * 16 : cb * 16;
#pragma unroll
        for (int k = 0; k < 16; ++k) { nr_[k] = xl[(size_t)(cn + k) * 128]; ni_[k] = xl[(size_t)(cn + k) * 128 + 64]; }
#pragma unroll
        for (int k = 0; k < 16; ++k) {
            const int c = cb * 16 + k;
            up[(size_t)c * 512] = (bf16)f2bf(xr); up[(size_t)c * 512 + 64] = (bf16)f2bf(xi);
            const float nr = lr * xr - li * xi + ar[k], ni = lr * xi + li * xr + ai[k];
            xr = nr; xi = ni;
        }
#pragma unroll
        for (int k = 0; k < 16; ++k) { ar[k] = nr_[k]; ai[k] = ni_[k]; }
    }
}


__device__ __forceinline__ void compress_stage2(const Frame& F, int eb, int pm, const bf16* HC, const bf16* W2T, bf16* KCo, bf16* VCo) {
    typedef short bf16x8_ __attribute__((ext_vector_type(8))); typedef float f32x16_ __attribute__((ext_vector_type(16)));
    const int r32 = F.lane & 31, hi = F.lane >> 5, rg0 = pm * 256 + F.wave * 32;
    const bf16* ar = HC + ((size_t)eb * 4096 + rg0 + r32) * 64 + 8 * hi; const bf16* br = W2T + (size_t)eb * 4096 + (size_t)r32 * 64 + 8 * hi;
    bf16x8_ a[4], b0[4], b1[4];
#pragma unroll
    for (int ks = 0; ks < 4; ++ks) { a[ks] = *(const bf16x8_*)(ar + ks * 16); b0[ks] = *(const bf16x8_*)(br + ks * 16); b1[ks] = *(const bf16x8_*)(br + 32 * 64 + ks * 16); }
    f32x16_ d0, d1;
#pragma unroll
    for (int r = 0; r < 16; ++r) { d0[r] = 0.f; d1[r] = 0.f; }
#pragma unroll
    for (int ks = 0; ks < 4; ++ks) { d0 = __builtin_amdgcn_mfma_f32_32x32x16_bf16(a[ks], b0[ks], d0, 0, 0, 0); d1 = __builtin_amdgcn_mfma_f32_32x32x16_bf16(a[ks], b1[ks], d1, 0, 0, 0); }
    bf16* dstb = (eb ? VCo : KCo) + (size_t)(rg0 + 4 * hi) * 64 + r32;
#pragma unroll
    for (int r = 0; r < 16; ++r) { const int ro = (r & 3) + 8 * (r >> 2); const bool pad = (((rg0 + 4 * hi + ro) >> 1) & 255) == NCMP;
        dstb[(size_t)ro * 64] = pad ? (bf16)0 : (bf16)f2bf(d0[r]); dstb[(size_t)ro * 64 + 32] = pad ? (bf16)0 : (bf16)f2bf(d1[r]); }
}

__device__ __forceinline__ void titem_load(const float* W, int N, int k0, int n0, int lane, float (&t)[32]) {
#pragma unroll
    for (int i = 0; i < 32; ++i) t[i] = W[(size_t)(k0 + 2 * i + (lane >> 5)) * N + n0 + (lane & 31)];
}
__device__ __forceinline__ void titem_finish(const float (&t)[32], int K, bf16* WT, int k0, int drow0, LAS float* scr, int lane, float scale) {
#pragma unroll
    for (int i = 0; i < 32; ++i) scr[(2 * i + (lane >> 5)) * 33 + (lane & 31)] = t[i];
    asm volatile("s_waitcnt lgkmcnt(0)" ::: "memory");
    const int c = lane & 7;
#pragma unroll
    for (int j = 0; j < 4; ++j) { const int n = (lane >> 3) + 8 * j; const LAS float* sp = scr + (8 * c) * 33 + n;
        u32x4 o; o.x = pk2(sp[0 * 33] * scale, sp[1 * 33] * scale); o.y = pk2(sp[2 * 33] * scale, sp[3 * 33] * scale); o.z = pk2(sp[4 * 33] * scale, sp[5 * 33] * scale); o.w = pk2(sp[6 * 33] * scale, sp[7 * 33] * scale);
        *(u32x4*)(WT + (size_t)(drow0 + n) * K + k0 + 8 * c) = o; }
    asm volatile("s_waitcnt lgkmcnt(0)" ::: "memory");
}
__device__ __forceinline__ void transpose_item(const float* W, int K, int N, bf16* WT, int k0, int n0, int drow0, LAS float* scr, int lane, float scale = 1.0f) {
    float t[32]; titem_load(W, N, k0, n0, lane, t); titem_finish(t, K, WT, k0, drow0, scr, lane, scale);
}
struct XItem { const float* W; bf16* WT; int K, N, k0, n0, drow0; };
__device__ __forceinline__ XItem xitem(const __attribute__((address_space(4))) Args* args, unsigned char* ws, int it) {
    XItem x; const int le = it / 384, r = it % 384;
    if (r < 256) { const int isup = r >> 7, q = r & 127, nb = q & 7, kb = q >> 3, n0 = 32 * nb;
        x.W = args->in[isup ? 24 : 23] + (size_t)le * DM * 256; x.K = DM; x.N = 256; x.WT = (bf16*)(ws + WS_WGU) + (size_t)le * 512 * DM; x.k0 = 64 * kb; x.n0 = n0; x.drow0 = 256 * (n0 >> 7) + 128 * isup + (n0 & 127); }
    else { const int q = r - 256, nb = q & 31, kb = q >> 5;
        x.W = args->in[25] + (size_t)le * 256 * DM; x.K = 256; x.N = DM; x.WT = (bf16*)(ws + WS_WDN) + (size_t)le * DM * 256; x.k0 = 64 * kb; x.n0 = 32 * nb; x.drow0 = 32 * nb; }
    return x;
}
__device__ __forceinline__ void convert_experts(const Frame& F, const __attribute__((address_space(4))) Args* args, unsigned char* ws, int layer, int vw, int nvw) {
    LAS float* scr = (LAS float*)(F.lds + F.wave * 16384);
    const int lo_ = layer * 32 * 384, hi_ = (layer + 1) * 32 * 384;
    float ta[32], tb[32]; XItem xa, xb;
    int it = lo_ + vw;
    if (it < hi_) { xa = xitem(args, ws, it); titem_load(xa.W, xa.N, xa.k0, xa.n0, F.lane, ta); }
    for (; it < hi_; it += nvw) {
        const bool hn = it + nvw < hi_;
        if (hn) { xb = xitem(args, ws, it + nvw); titem_load(xb.W, xb.N, xb.k0, xb.n0, F.lane, tb); }
        titem_finish(ta, xa.K, xa.WT, xa.k0, xa.drow0, scr, F.lane, 1.0f);
        if (hn) { xa = xb;
#pragma unroll
            for (int i = 0; i < 32; ++i) ta[i] = tb[i]; }
    }
}
__device__ __forceinline__ void ph_convert(const Frame& F, const __attribute__((address_space(4))) Args* args, unsigned char* ws) {
    for (int it = F.blk; it < DEPTH * NGRP; it += F.G) ssm_precompute(F, args, ws, it);
    LAS float* scr = (LAS float*)(F.lds + F.wave * 16384);
    const int gw = F.blk * NWAVES + F.wave, NGW = F.G * NWAVES;
    constexpr int I_IN = (DM / 64) * (1792 / 32), I_GLU = (D_SSM / 64) * (2 * D_SSM / 32), I_OUT = (DM / 64) * (DM / 32);
    constexpr int PER_LAYER = I_IN + I_GLU + I_OUT;
    for (int it = gw; it < DEPTH * 2 * 64; it += NGW) { const int li = it >> 6, q = it & 63, nb = q & 1, kb = q >> 1;
        transpose_item(args->in[16] + (size_t)li * 2048 * 64, 2048, 64, (bf16*)(ws + WS_W1T) + (size_t)li * 256 * 2048, 64 * kb, 32 * nb, 32 * nb, scr, F.lane); }
    { const int gt = F.blk * NTHR + F.tid, NGT = F.G * NTHR;
      for (int idx = gt; idx < DEPTH * 2 * 192 * 2048 / 8; idx += NGT) { const int li = idx / (192 * 256), rem = idx % (192 * 256);
          *(u32x4*)((bf16*)(ws + WS_W1T) + (size_t)li * 256 * 2048 + (size_t)64 * 2048 + (size_t)rem * 8) = (u32x4){0u, 0u, 0u, 0u}; }
      for (int idx = gt; idx < DEPTH * 2 * 4096; idx += NGT) { const int li = idx >> 12, f = (idx >> 6) & 63, e = idx & 63; ((bf16*)(ws + WS_W2T))[idx] = (bf16)f2bf(args->in[17][(size_t)li * 4096 + e * 64 + f]); }
    }
    for (int idx = gw; idx < DEPTH * 2 * 64; idx += NGW) { const int li = idx >> 6, e = idx & 63; const float* pp = args->in[15] + (size_t)li * 2048; const float* ww = args->in[16] + (size_t)li * 2048 * 64 + e;
        float a = 0.f;
#pragma unroll 8
        for (int k = F.lane; k < 2048; k += 64) a += pp[k] * ww[(size_t)k * 64];
        a = wave_sum(a, F.lane);
        if (F.lane == 0) ((float*)(ws + WS_CBIAS))[idx] = a; }
    for (int it = gw; it < DEPTH * PER_LAYER; it += NGW) {
        const int layer = it / PER_LAYER; int r = it % PER_LAYER;
        if (r < I_IN) { const int nb = r % 56, kb = r / 56;
            transpose_item(args->in[4] + (size_t)layer * DM * D_IN, DM, D_IN, (bf16*)(ws + WS_WIN) + (size_t)layer * NINP * DM, 64 * kb, 32 * nb, 32 * nb, scr, F.lane, (nb >= 16 && nb < 32) ? QSCALE : 1.0f); continue; }
        r -= I_IN;
        if (r < I_GLU) { const int nb = r % 32, kb = r / 32, n0 = 32 * nb;
            const int half = n0 >> 9, c = n0 & 511, drow = 256 * (c >> 7) + 128 * half + (c & 127);
            transpose_item(args->in[14] + (size_t)layer * D_SSM * 2 * D_SSM, D_SSM, 2 * D_SSM, (bf16*)(ws + WS_WGLU) + (size_t)layer * 2 * D_SSM * D_SSM, 64 * kb, n0, drow, scr, F.lane); continue; }
        r -= I_GLU;
        { const int nb = r % 32, kb = r / 32;
            transpose_item(args->in[5] + (size_t)layer * DM * DM, DM, DM, (bf16*)(ws + WS_WOUT) + (size_t)layer * DM * DM, 64 * kb, 32 * nb, 32 * nb, scr, F.lane); }
    }
    const int gt = F.blk * NTHR + F.tid, NGT = F.G * NTHR;
    for (int idx = gt; idx < DEPTH * 256 * DM; idx += NGT) {
        const int layer = idx / (256 * DM), rem = idx % (256 * DM), n = 1792 + rem / DM, k = rem % DM;
        const float v = n < D_IN ? args->in[4][(size_t)layer * DM * D_IN + (size_t)k * D_IN + n] : 0.f;
        ((bf16*)(ws + WS_WIN))[(size_t)layer * NINP * DM + (size_t)n * DM + k] = (bf16)f2bf(v);
    }
}

constexpr int PH_PER_LAYER = 8, N_PHASES = 1 + DEPTH * PH_PER_LAYER + 1;
#ifndef FAST_GEMM
#define FAST_GEMM 1
#endif
#ifndef REP_ATTN
#define REP_ATTN 1
#endif
#ifndef REP_CMP
#define REP_CMP 1
#endif
#ifndef REP_CARRY
#define REP_CARRY 1
#endif
#ifndef REP_CONV
#define REP_CONV 1
#endif
#ifndef REP_INPROJ
#define REP_INPROJ 1
#endif
#ifndef REP_G1
#define REP_G1 1
#endif
#ifndef REP_G2
#define REP_G2 1
#endif
#ifndef REP_GLU
#define REP_GLU 1
#endif
#ifndef REP_OUT
#define REP_OUT 1
#endif
#ifndef REP_NORM
#define REP_NORM 1
#endif
#ifndef REP_ROUTE
#define REP_ROUTE 1
#endif
#ifndef REP_GU
#define REP_GU 1
#endif
#ifndef REP_DN
#define REP_DN 1
#endif

__global__ void __launch_bounds__(NTHR, 2) fwd(Args args) {
    extern __shared__ __attribute__((aligned(16))) unsigned char lds_raw[];
    Frame F;
    F.lds = (LAS unsigned char*)lds_raw;
    F.tid = threadIdx.x; F.lane = F.tid & 63; F.wave = __builtin_amdgcn_readfirstlane(F.tid >> 6);
    F.blk = blockIdx.x; F.G = gridDim.x;
    typedef const __attribute__((address_space(4))) Args* KArgs;
    KArgs kp = (KArgs)__builtin_amdgcn_kernarg_segment_ptr();
    asm volatile("" : "+s"(kp));
    unsigned char* ws = kp->ws;
    volatile LAS unsigned* MISC = (volatile LAS unsigned*)(F.lds + MISC_OFF);
    if (F.tid < 32) MISC[F.tid] = 0u;
    __syncthreads();
    XcdBarrier bar; bar.bar = (unsigned*)(ws + WS_CTL) + CW_BAR; bar.x = 0; bar.st = nullptr;
    if (N_LAUNCH_MODE == 1) bar = xcd_barrier_post((unsigned*)(ws + WS_CTL) + CW_BAR, MISC + 8);
#define IN(k) (kp->ph_lo <= (k) && (k) < kp->ph_hi)
#define FRESH_IDS() do { int l_; asm volatile("v_mbcnt_lo_u32_b32 %0, -1, 0\n\tv_mbcnt_hi_u32_b32 %0, -1, %0" : "=v"(l_)); asm volatile("" : "+s"(F.wave), "+s"(F.blk), "+s"(F.G)); F.lane = l_; F.tid = F.wave * 64 + l_; asm volatile("" : "+s"(kp)); ws = kp->ws; bar.bar = (unsigned*)(ws + WS_CTL) + CW_BAR; } while (0)
#define SEAM(k) do { FRESH_IDS(); if (IN(k) && IN((k) + 1)) xcd_barrier(bar, F.tid); FRESH_IDS(); } while (0)

    const float* x0 = kp->in[0];
    float* XR = kp->out;
#define HN ((bf16*)(ws + WS_HN))
#define Z ((bf16*)(ws + WS_Z))
#define YC ((bf16*)(ws + WS_YC))
#define G1 ((bf16*)(ws + WS_G1))
#define KC ((bf16*)(ws + WS_KC))
#define VC ((bf16*)(ws + WS_VC))
#define LIST ((unsigned*)(ws + WS_LIST))
#define LISTW ((float*)(ws + WS_LISTW))
#define HID ((bf16*)(ws + WS_HID))
#define P2 ((bf16*)(ws + WS_P2))
#define P1B ((bf16*)(ws + WS_YC))
#define XB ((bf16*)(ws + WS_XB))
#define USSM ((bf16*)(ws + WS_USSM))
#define XL ((float*)(ws + WS_XL))
    LAS int* etab = (LAS int*)(F.lds + ETAB_OFF);

    if (IN(0)) { for (int rep_ = 0; rep_ < REP_CONV; ++rep_) ph_convert(F, kp, ws);
                 ph_norm(F, kp->in[0], nullptr, nullptr, nullptr, kp->in[1], HN); }
    SEAM(0);
    for (int layer = 0; layer < DEPTH; ++layer) {
        const int pb = 1 + layer * PH_PER_LAYER;
        const float* xin = layer == 0 ? x0 : XR;
        unsigned* gcnt = (unsigned*)(ws + WS_CTL) + CW_CNT + layer * 32 * 64;
        if (IN(pb + 0) && layer > 0) { ph_norm_b(F, XB, P1B, P2, kp->in[1] + layer * DM, HN); for (int rep_ = 1; rep_ < REP_NORM; ++rep_) ph_norm_b(F, XB, P1B, P2, kp->in[1] + layer * DM, HN); }
        if (layer > 0) SEAM(pb + 0);
        if (IN(pb + 1)) {
            pg8::Gemm g{HN, (const bf16*)(ws + WS_WIN) + (size_t)layer * NINP * DM, T, NINP, DM, DM, 0, nullptr, 0, 0, 128}; pg8::StaticOrder S; S.init(T, NINP, F.G, F.blk);
            pg8::EpiInProj E{Z, USSM};
            for (int rep_ = 0; rep_ < REP_INPROJ; ++rep_) pg8::gemm2<pg8::EpiInProj, pg8::StaticOrder, pg8::ADense>(F.lds, g, S, E, F.tid);
        }
        SEAM(pb + 1);
        if (IN(pb + 2)) {
            for (int rep_ = 0; rep_ < REP_CMP; ++rep_) {
                { pg8::Gemm g{Z, (const bf16*)(ws + WS_W1T) + (size_t)layer * 2 * 256 * 2048, 0, 256, 2048, ZP, (size_t)256 * 2048, nullptr, 0, 0, ZP * 2};
                  pg8::CmpOrder S{F.G, F.blk}; pg8::EpiCmpHid E{(bf16*)(ws + WS_HIDC), (const float*)(ws + WS_CBIAS) + layer * 128};
                  pg8::gemm2<pg8::EpiCmpHid, pg8::CmpOrder, pg8::ACompress>(F.lds, g, S, E, F.tid); }
                asm volatile("s_waitcnt vmcnt(0)" ::: "memory"); __syncthreads();
                for (int L = F.blk; L < 32; L += F.G) compress_stage2(F, L >> 4, L & 15, (const bf16*)(ws + WS_HIDC), (const bf16*)(ws + WS_W2T) + (size_t)layer * 2 * 4096, KC, VC);
            }
#pragma unroll 1
            for (int L = F.blk; L < NGRP * BATCH; L += F.G) {
                const int sg = L >> 3, sb = L & 7;
                FRESH_IDS();
                { pg8::Gemm g{USSM, (const bf16*)(ws + WS_BT1) + (size_t)layer * 32 * 256 * 256, 0, 256, 256, 512, (size_t)256 * 256, nullptr, 0, (size_t)2048 * 512, 128};
                  pg8::SingleUnit S{sg, sb}; pg8::EpiXloc E{XL};
                  pg8::gemm2<pg8::EpiXloc, pg8::SingleUnit, pg8::ADense>(F.lds, g, S, E, F.tid); }
                asm volatile("s_waitcnt vmcnt(0)" ::: "memory"); __syncthreads();
                for (int rep_ = 0; rep_ < REP_CARRY; ++rep_)
                if (F.wave == 0) ssm_carry_item(sb, sg, kp->in[6] + layer * NGRP * SST, kp->in[7] + layer * NGRP * SST, kp->in[13] + layer * NGRP, XL, USSM, F.lane);
                asm volatile("s_waitcnt vmcnt(0)" ::: "memory"); __syncthreads();
                FRESH_IDS();
                { pg8::Gemm g{USSM, (const bf16*)(ws + WS_BT2) + (size_t)layer * 32 * 256 * 384, 0, 256, 384, 512, (size_t)256 * 384, nullptr, 0, (size_t)2048 * 512, 128};
                  pg8::SingleUnit S{sg, sb}; pg8::EpiSsmOut E{G1};
                  pg8::gemm2<pg8::EpiSsmOut, pg8::SingleUnit, pg8::ADense>(F.lds, g, S, E, F.tid); }
            }
            if (F.G > 64) { if (F.blk >= 32) convert_experts(F, kp, ws, layer, (F.blk - 32) * NWAVES + F.wave, (F.G - 32) * NWAVES); }
            else convert_experts(F, kp, ws, layer, F.blk * NWAVES + F.wave, F.G * NWAVES);
        }
        SEAM(pb + 2);
        if (IN(pb + 3)) {
            { pg8::Gemm g{G1, (const bf16*)(ws + WS_WGLU) + (size_t)layer * 2 * D_SSM * D_SSM, T, 2 * D_SSM, D_SSM, D_SSM, 0, nullptr, 0, 0, 128}; pg8::StaticOrder S; S.init(T, 2 * D_SSM, F.G, F.blk);
              pg8::EpiGlu E{YC, DM};
              for (int rep_ = 0; rep_ < REP_GLU; ++rep_) pg8::gemm2<pg8::EpiGlu, pg8::StaticOrder, pg8::ADense>(F.lds, g, S, E, F.tid); }
            __syncthreads();
            int last_hkv = -1;
            for (int rep_ = 0; rep_ < REP_ATTN; ++rep_)
            for (int slot = F.blk; slot < 256; slot += F.G) {
                const int bh = slot >> 4, sq = slot & 15;
#pragma unroll 1
                for (int uq = 0; uq < 4; ++uq) { const int jt = uq == 0 ? 63 - sq : (uq == 1 ? 32 + sq : (uq == 2 ? 31 - sq : sq));
                    nsa::unit((LAS char*)F.lds, F.tid, bh >> 1, bh & 1, jt, Z, KC, VC, kp->in[18], YC, (bh & 1) != last_hkv); last_hkv = bh & 1; }
            }
        }
        SEAM(pb + 3);
        if (IN(pb + 4)) {
            pg8::Gemm g{YC, (const bf16*)(ws + WS_WOUT) + (size_t)layer * DM * DM, T, DM, DM, DM, 0, nullptr, 0, 0, 128}; pg8::StaticOrder S; S.init(T, DM, F.G, F.blk);
            pg8::EpiResidB E{layer == 0 ? kp->in[0] : nullptr, XB, XB};
            pg8::gemm2<pg8::EpiResidB, pg8::StaticOrder, pg8::ADense>(F.lds, g, S, E, F.tid);
        }
        SEAM(pb + 4);
        if (IN(pb + 5)) ph_norm_route(F, XB, kp->in[2] + layer * DM, kp->in[19] + (size_t)layer * DM * 4, kp->in[20] + layer * 4, kp->in[21] + (size_t)layer * 4 * DM * 8, kp->in[22] + layer * 32, HN, gcnt, LIST, LISTW);
        if (IN(pb + 5)) for (int rep_ = 1; rep_ < REP_ROUTE; ++rep_) ph_norm_route(F, XB, kp->in[2] + layer * DM, kp->in[19] + (size_t)layer * DM * 4, kp->in[20] + layer * 4, kp->in[21] + (size_t)layer * 4 * DM * 8, kp->in[22] + layer * 32, HN, gcnt + (2 + rep_) * 32 * 64, (unsigned*)(ws + 484 * MiB), (float*)(ws + 488 * MiB));
        SEAM(pb + 5);
        if (IN(pb + 6)) {
            build_expert_tab(F, gcnt, etab);
            pg8::Gemm g{HN, (const bf16*)(ws + WS_WGU) + (size_t)layer * 32 * 512 * DM, 0, 512, DM, DM, (size_t)512 * DM, LIST, LCAP, 0, 128};
            pg8::ExpertOrder S{etab, 2, F.G, F.blk};
            pg8::EpiGateUp E{HID, LISTW, LCAP};
            for (int rep_ = 0; rep_ < REP_GU; ++rep_) pg8::gemm2<pg8::EpiGateUp, pg8::ExpertOrder, pg8::AList>(F.lds, g, S, E, F.tid);
        }
        SEAM(pb + 6);
        if (IN(pb + 7)) {
            build_expert_tab(F, gcnt, etab);
            pg8::Gemm g{HID, (const bf16*)(ws + WS_WDN) + (size_t)layer * 32 * DM * 256, 0, DM, 256, 256, (size_t)DM * 256, nullptr, 0, 0, 128};
            pg8::ExpertOrder S{etab, 4, F.G, F.blk};
            for (int rep_ = 1; rep_ < REP_DN; ++rep_) { pg8::EpiDown Ed{P1B, (long)(P2 - P1B), LIST, LCAP}; pg8::gemm2<pg8::EpiDown, pg8::ExpertOrder, pg8::ADense>(F.lds, g, S, Ed, F.tid); }
            pg8::EpiDown E{P1B, (long)(P2 - P1B), LIST, LCAP};
            pg8::gemm2<pg8::EpiDown, pg8::ExpertOrder, pg8::ADense>(F.lds, g, S, E, F.tid);
        }
        SEAM(pb + 7);
    }
    if (IN(N_PHASES - 1)) ph_final_norm(F, kp->out, XB, P1B, P2, kp->in[3]);
#undef IN
#undef SEAM
#undef HN
#undef Z
#undef YC
#undef G1
#undef KC
#undef VC
#undef LIST
#undef LISTW
#undef HID
#undef P2
#undef P1B
#undef XB
#undef USSM
#undef XL
}

extern "C" void kernel_launch(void* const* d_in, const int* in_sizes, int n_in, void* d_out, int out_size, void* d_ws, size_t ws_size, hipStream_t stream) {
    static int grid = 0;
    if (grid == 0) {
        if (n_in != 26 || out_size != T * DM || ws_size < WS_END) { fprintf(stderr, "kernel_launch: unexpected shapes (n_in %d out %d ws %zu)\n", n_in, out_size, ws_size); grid = -1; return; }
        int dev = 0, cus = 0, per_cu = 0;
        if (hipGetDevice(&dev) != hipSuccess || hipDeviceGetAttribute(&cus, hipDeviceAttributeMultiprocessorCount, dev) != hipSuccess) { grid = -1; return; }
        if (hipFuncSetAttribute((const void*)fwd, hipFuncAttributeMaxDynamicSharedMemorySize, LDS_BYTES) != hipSuccess) { fprintf(stderr, "kernel_launch: hipFuncSetAttribute failed\n"); grid = -1; return; }
        if (hipOccupancyMaxActiveBlocksPerMultiprocessor(&per_cu, (const void*)fwd, NTHR, LDS_BYTES) != hipSuccess || per_cu < 1) fprintf(stderr, "kernel_launch: occupancy query says %d\n", per_cu);
        (void)hipGetLastError();
        grid = cus;
    }
    if (grid < 0) return;
    (void)hipMemsetAsync((char*)d_ws + WS_CTL, 0, CTL_ZERO_BYTES, stream);
    Args a{};
    for (int i = 0; i < 26; ++i) a.in[i] = (const float*)d_in[i];
    a.out = (float*)d_out; a.ws = (unsigned char*)d_ws;
    if (N_LAUNCH_MODE == 1) {
        a.ph_lo = 0; a.ph_hi = N_PHASES;
        hipLaunchKernelGGL(fwd, dim3(grid), dim3(NTHR), LDS_BYTES, stream, a);
    } else {
        for (int p = 0; p < N_PHASES; ++p) { a.ph_lo = p; a.ph_hi = p + 1; hipLaunchKernelGGL(fwd, dim3(grid), dim3(NTHR), LDS_BYTES, stream, a); }
    }
}
```

```cpp
#include <hip/hip_runtime.h>
#include <cstdio>
#include <cstdint>

#ifndef N_LAUNCH_MODE
#define N_LAUNCH_MODE 1
#endif

#define GAS __attribute__((address_space(1)))
#define LAS __attribute__((address_space(3)))
typedef unsigned short bf16;
typedef float f32x4 __attribute__((ext_vector_type(4)));
typedef unsigned u32x4 __attribute__((ext_vector_type(4)));
typedef unsigned u32x2 __attribute__((ext_vector_type(2)));

constexpr int BATCH = 8, SEQ = 4096, DM = 1024, T = BATCH * SEQ, DEPTH = 2;
constexpr int D_SSM = 512, NGRP = 32, SGRP = 16, SST = 64;
constexpr int D_IN = 1816, NINP = 2048, ZP = 1536;
constexpr int ZC_U = 0, ZC_Q = 0, ZC_KV = 512, ZC_G = 1280;
constexpr int NCMP = 255, NCMPP = 256;
constexpr float EPS = 1e-6f;
constexpr int NWAVES = 8, NTHR = 512;
constexpr float QSCALE = 0.125f * 1.4426950408889634f;

constexpr size_t MiB = 1u << 20;
constexpr size_t WS_CTL = 0, CTL_ZERO_BYTES = 1 * MiB;
constexpr size_t WS_KC = 1 * MiB, WS_VC = 2 * MiB, WS_ROUTE = 3 * MiB;
constexpr size_t WS_HIDC = 4 * MiB;
constexpr size_t WS_CBIAS = 5 * MiB;
constexpr size_t WS_W2T = 6 * MiB;
constexpr size_t WS_W1T = 8 * MiB;
constexpr size_t WS_HN = 16 * MiB;
constexpr size_t WS_Z = 80 * MiB;
constexpr size_t WS_XB = 176 * MiB;
constexpr size_t WS_YC = 240 * MiB;
constexpr size_t WS_G1 = 304 * MiB;
constexpr size_t WS_WIN = 336 * MiB;
constexpr size_t WS_WGLU = 344 * MiB;
constexpr size_t WS_WOUT = 346 * MiB;
constexpr size_t WS_WGU = 350 * MiB;
constexpr size_t WS_WDN = 414 * MiB;
constexpr size_t WS_LIST = 446 * MiB;
constexpr size_t WS_LISTW = 450 * MiB;
constexpr size_t WS_HID = 454 * MiB;
constexpr size_t WS_P2 = WS_Z;
constexpr size_t WS_USSM = WS_YC;
constexpr size_t WS_XL = WS_HID;
constexpr size_t WS_BT1 = 490 * MiB;
constexpr size_t WS_BT2 = 498 * MiB;
constexpr size_t WS_END = 510 * MiB;
constexpr int LCAP = 32768, CW_CNT = 8192;
constexpr int CW_BAR = 4096;

constexpr int LDS_BYTES = 163840;
constexpr int ETAB_OFF = LDS_BYTES - 1024, MISC_OFF = LDS_BYTES - 512;

__device__ __forceinline__ float bf2f(bf16 v) { return __uint_as_float(((unsigned)v) << 16); }
__device__ __forceinline__ unsigned f2bf(float f) { unsigned u = __float_as_uint(f); return (u + 0x7fffu + ((u >> 16) & 1u)) >> 16; }
__device__ __forceinline__ unsigned pk2(float lo, float hi) { unsigned r; asm("v_cvt_pk_bf16_f32 %0, %1, %2" : "=v"(r) : "v"(lo), "v"(hi)); return r; }
__device__ __forceinline__ float wave_sum(float v, int) {
    v += __builtin_bit_cast(float, __builtin_amdgcn_update_dpp(0, __builtin_bit_cast(int, v), 0xB1, 0xF, 0xF, true));
    v += __builtin_bit_cast(float, __builtin_amdgcn_update_dpp(0, __builtin_bit_cast(int, v), 0x4E, 0xF, 0xF, true));
    v += __builtin_bit_cast(float, __builtin_amdgcn_update_dpp(0, __builtin_bit_cast(int, v), 0x141, 0xF, 0xF, true));
    v += __builtin_bit_cast(float, __builtin_amdgcn_update_dpp(0, __builtin_bit_cast(int, v), 0x140, 0xF, 0xF, true));
    const int iv = __builtin_bit_cast(int, v);
    const float s0 = __builtin_bit_cast(float, __builtin_amdgcn_readlane(iv, 0)), s1 = __builtin_bit_cast(float, __builtin_amdgcn_readlane(iv, 16));
    const float s2 = __builtin_bit_cast(float, __builtin_amdgcn_readlane(iv, 32)), s3 = __builtin_bit_cast(float, __builtin_amdgcn_readlane(iv, 48));
    return (s0 + s1) + (s2 + s3);
}
__device__ __forceinline__ float wave_max(float v, int lane) {
#pragma unroll
    for (int o = 1; o < 64; o <<= 1) v = fmaxf(v, __int_as_float(__builtin_amdgcn_ds_bpermute((lane ^ o) << 2, __float_as_int(v))));
    return v;
}
__device__ __forceinline__ float lane_bcast(float v, int src) { return __int_as_float(__builtin_amdgcn_ds_bpermute(src << 2, __float_as_int(v))); }
__device__ __forceinline__ float gelu_tanh(float x) {
    const float u = 0.7978845608028654f * (x + 0.044715f * x * x * x);
    return 0.5f * x * (1.0f + tanhf(u));
}
__device__ __forceinline__ float sigmoidf_(float x) { return 1.0f / (1.0f + __expf(-x)); }
__device__ __forceinline__ int t5_bucket(int n) {
    if (n < 16) return n < 0 ? 0 : n;
    int b = 16;
    b += (n >= 19); b += (n >= 21); b += (n >= 24); b += (n >= 27); b += (n >= 31); b += (n >= 35); b += (n >= 40); b += (n >= 46);
    b += (n >= 52); b += (n >= 59); b += (n >= 67); b += (n >= 77); b += (n >= 87); b += (n >= 99); b += (n >= 113);
    return b;
}

#define XB_TMO      128
#define XB_XCNT(j)  (256  + 64 * (j))
#define XB_XSUB(j)  (1280 + 64 * (j))
#define XB_XGEN(j)  (2304 + 64 * (j))
#define XB_TOP      3328
#define XB_TOPGEN   3392
#define XCD_BAR_WORDS 3456
#define XB_SPIN_CAP (1u << 22)

__device__ __forceinline__ unsigned xb_ld(unsigned* p)              { return __hip_atomic_load(p, __ATOMIC_RELAXED, __HIP_MEMORY_SCOPE_AGENT); }
__device__ __forceinline__ unsigned xb_add(unsigned* p, unsigned v) { return __hip_atomic_fetch_add(p, v, __ATOMIC_RELAXED, __HIP_MEMORY_SCOPE_AGENT); }
__device__ __forceinline__ unsigned xb_xcc_id() { return (unsigned)__builtin_amdgcn_s_getreg((3 << 11) | 20) & 0xFu; }
#define XB_SPIN(cond, bar) do { unsigned _sp = 0; while (cond) { __builtin_amdgcn_s_sleep(1); \
    if ((++_sp & 255u) == 0u) { if (xb_ld(&(bar)[XB_TMO])) break; if (_sp > XB_SPIN_CAP) { atomicAdd(&(bar)[XB_TMO], 1u); break; } } } } while (0)

struct XcdBarrier { unsigned* bar; unsigned x; volatile LAS unsigned* st; };

__device__ __forceinline__ XcdBarrier xcd_barrier_post(unsigned* bar, volatile LAS unsigned* st) {
    XcdBarrier b; b.bar = bar; b.x = xb_xcc_id(); b.st = st;
    if (threadIdx.x == 0) (void)xb_add(&bar[XB_XCNT(b.x)], 1u);
    return b;
}
__device__ __forceinline__ void xcd_barrier_complete(unsigned* bar, unsigned x, unsigned& nloc, unsigned& nx) {
    const unsigned G = gridDim.x * gridDim.y * gridDim.z;
    unsigned sum, cnt, mine, sp = 0u;
    for (;;) {
        sum = 0u; cnt = 0u; mine = 0u;
#pragma unroll
        for (unsigned j = 0; j < 16; ++j) { const unsigned c = xb_ld(&bar[XB_XCNT(j)]); sum += c; cnt += (c > 0u) ? 1u : 0u; mine = (j == x) ? c : mine; }
        if (sum == G) break;
        __builtin_amdgcn_s_sleep(1);
        if ((++sp & 255u) == 0u) { if (xb_ld(&bar[XB_TMO])) break; if (sp > XB_SPIN_CAP) { atomicAdd(&bar[XB_TMO], 1u); break; } }
    }
    nloc = mine > 0u ? mine : 1u; nx = cnt > 0u ? cnt : 1u;
}
__device__ __forceinline__ void xcd_barrier(const XcdBarrier& b, const int tid) {
    asm volatile("s_waitcnt vmcnt(0)" ::: "memory");
    __syncthreads();
    if (tid == 0) {
        unsigned* bar = b.bar;
        __builtin_amdgcn_s_waitcnt(0);
        unsigned nloc = b.st[0], nx = b.st[1];
        if (nloc == 0u) { xcd_barrier_complete(bar, b.x, nloc, nx); b.st[0] = nloc; b.st[1] = nx; }
        const unsigned old = xb_add(&bar[XB_XSUB(b.x)], 1u);
        const unsigned gen = old / nloc;
        if (old + 1u == (gen + 1u) * nloc) {
            __builtin_amdgcn_fence(__ATOMIC_RELEASE, "agent");
            asm volatile("s_waitcnt vmcnt(0)" ::: "memory");
            const unsigned og = xb_add(&bar[XB_TOP], 1u);
            const unsigned tg = og / nx;
            if (og + 1u == (tg + 1u) * nx) xb_add(&bar[XB_TOPGEN], 1u);
            else XB_SPIN(xb_ld(&bar[XB_TOPGEN]) == tg, bar);
            __builtin_amdgcn_fence(__ATOMIC_ACQUIRE, "agent");
            xb_add(&bar[XB_XGEN(b.x)], 1u);
            asm volatile("s_waitcnt vmcnt(0)" ::: "memory");
        } else {
            XB_SPIN(xb_ld(&bar[XB_XGEN(b.x)]) == gen, bar);
            __builtin_amdgcn_fence(__ATOMIC_ACQUIRE, "agent");
            asm volatile("s_waitcnt vmcnt(0)" ::: "memory");
        }
    }
    __syncthreads();
}

namespace pg8 {
#define PG8_LAS __attribute__((address_space(3)))
typedef unsigned short bf16_t;
typedef short bf16x8 __attribute__((ext_vector_type(8)));
typedef float f32x4 __attribute__((ext_vector_type(4)));
typedef unsigned u32x4 __attribute__((ext_vector_type(4)));
constexpr int BM = 256, BK = 64, HALF = 128, HTB = HALF * BK * 2  , STAGE_BYTES = 8 * HTB, NXCD = 8, WGM = 8;

__host__ __device__ __forceinline__ int lds_byte(int r, int c) { const int st = (r >> 4) * 2 + (c >> 5), rr = r & 15, cc = c & 31, ob = rr * 64 + cc * 2; return st * 1024 + (ob ^ (((ob >> 9) & 1) << 5)); }
__host__ __device__ __forceinline__ void stage_rc(int b, int& R, int& C) { const int st = b / 1024, sb = b % 1024, swz = sb ^ (((sb >> 9) & 1) << 5); R = (st >> 1) * 16 + swz / 64; C = (st & 1) * 32 + (swz % 64) / 2; }
__host__ __device__ __forceinline__ int perm32(int rho) { const int n = rho >> 4, i = rho & 15; return 8 * (i >> 2) + 4 * n + (i & 3); }

struct Unit { int pm, pn, eb, p0, cnt; };
struct Gemm { const bf16_t* A; const bf16_t* Bt; int M, N, K; int lda; size_t bstride; const unsigned* list; int cap; size_t astride; int kstepA; };

struct StaticOrder {
    int nM, nN, nwg, G, c;
    __host__ __device__ void init(int M, int N, int G_, int c_) { nM = M / BM; nN = N / BM; nwg = nM * nN; G = G_; c = c_; }
    __host__ __device__ bool next(int i, Unit& u) const {
        const long L = (long)i * G + c; if (L >= nwg) return false;
        int wgid = (int)L; { const int q = nwg / NXCD, r = nwg % NXCD, xcd = wgid % NXCD, off = wgid / NXCD; wgid = (xcd < r ? xcd * (q + 1) : r * (q + 1) + (xcd - r) * q) + off; }
        const int nig = WGM * nN, gid = wgid / nig, fm = gid * WGM, gsz = (nM - fm) < WGM ? (nM - fm) : WGM;
        u.pm = fm + ((wgid % nig) % gsz); u.pn = (wgid % nig) / gsz; u.eb = 0; u.p0 = 0; u.cnt = 0; return true;
    }
    __device__ __forceinline__ void a_ready(const Unit&) const {}
    __device__ __forceinline__ void done(const Unit&) const {}
};

__device__ __forceinline__ unsigned cvt_pk_bf16(float lo, float hi) { unsigned r; asm volatile("v_cvt_pk_bf16_f32 %0, %1, %2" : "=v"(r) : "v"(lo), "v"(hi)); return r; }
typedef float f32x2 __attribute__((ext_vector_type(2)));
__device__ __forceinline__ f32x2 gelu_pk(f32x2 v) {
    const f32x2 av = __builtin_elementwise_abs(v), d = av * 0.2316418882f + 1.0f;
    f32x2 t; t.x = __builtin_amdgcn_rcpf(d.x); t.y = __builtin_amdgcn_rcpf(d.y);
    f32x2 q = t * 0.5307027145f + (-0.7265760135f); q = q * t + 0.7107068705f; q = q * t + (-0.142248368f); q = q * t + 0.127414796f; q = q * t;
    const f32x2 s = (v * v) * (-0.72134752044f);
    f32x2 e; e.x = __builtin_amdgcn_exp2f(s.x); e.y = __builtin_amdgcn_exp2f(s.y);
    const f32x2 m = v * (q * e), r = v - m;
    f32x2 o; o.x = v.x < 0.f ? m.x : r.x; o.y = v.y < 0.f ? m.y : r.y; return o;
}

template <int ACT  > struct EpiBf16 {
    static constexpr bool PERM = true, AFTER_DRAIN = false; static_assert(ACT == 0 || ACT == 1, "EpiBf16: ACT is 0 (none) or 1 (gelu_pk)");
    bf16_t* O; int ldc; const float* bias; int split_cols; size_t split_stride; float scale0;
    __device__ __forceinline__ void operator()(const f32x4 (&acc)[2][2][4][2], const Unit& u, int wr, int wc, int fr, int fq) const {
        const int row0 = u.pm * BM + wr * 64 + fr; int colt = u.pn * BM; bf16_t* base = O;
        float sc = 1.f; if (split_cols) { const int t = colt / split_cols; base += (size_t)t * split_stride; colt -= t * split_cols; if (t == 0) sc = scale0; }
        const int col0 = colt + wc * 32 + 8 * fq, bcol0 = u.pn * BM + wc * 32 + 8 * fq;
        f32x4 bv[2][2];
#pragma unroll
        for (int bj = 0; bj < 2; ++bj)
#pragma unroll
            for (int n = 0; n < 2; ++n) bv[bj][n] = bias ? *(const f32x4*)(bias + bcol0 + bj * HALF + 4 * n) : (f32x4){0.f, 0.f, 0.f, 0.f};
#pragma unroll
        for (int ai = 0; ai < 2; ++ai)
#pragma unroll
            for (int m = 0; m < 4; ++m) { bf16_t* rowp = base + (size_t)(row0 + ai * HALF + m * 16) * ldc + col0;
#pragma unroll
                for (int bj = 0; bj < 2; ++bj) { f32x4 v0 = acc[ai][bj][m][0] + bv[bj][0], v1 = acc[ai][bj][m][1] + bv[bj][1];
                    if (ACT == 1) { f32x2 a = gelu_pk((f32x2){v0[0], v0[1]}), b = gelu_pk((f32x2){v0[2], v0[3]}), c = gelu_pk((f32x2){v1[0], v1[1]}), d = gelu_pk((f32x2){v1[2], v1[3]});
                        v0 = (f32x4){a.x, a.y, b.x, b.y}; v1 = (f32x4){c.x, c.y, d.x, d.y}; }
                    v0 = v0 * sc; v1 = v1 * sc; u32x4 w; w.x = cvt_pk_bf16(v0[0], v0[1]); w.y = cvt_pk_bf16(v0[2], v0[3]); w.z = cvt_pk_bf16(v1[0], v1[1]); w.w = cvt_pk_bf16(v1[2], v1[3]);
                    *(u32x4*)(rowp + bj * HALF) = w; } }
    }
};
template <class Epi, class Sched, bool ALIGN_EPI = false, bool SP2 = false>
__device__ __forceinline__ void gemm_phase(PG8_LAS unsigned char* lds, const Gemm g, const Sched& S, const Epi& E) {
    int tid_ = threadIdx.x; asm volatile("" : "+v"(tid_));
    const int tid = tid_, wid = __builtin_amdgcn_readfirstlane(tid >> 6), lane = tid & 63, wr = wid >> 2, wc = wid & 3, fr = lane & 15, fq = lane >> 4;
    const int K = g.K, nt = K / BK;
    unsigned voffA[2], voffB[2];
#pragma unroll
    for (int i = 0; i < 2; ++i) { int R, C; stage_rc(tid * 16 + i * 8192, R, C); const int Rb = Epi::PERM ? ((R & ~31) + perm32(R & 31)) : R;
        voffA[i] = (unsigned)(R * K + C) * 2u; voffB[i] = (unsigned)(Rb * K + C) * 2u; }
    const size_t kstep = (size_t)(BK * 2);
    const size_t hstep = (size_t)HALF * K * 2;
    const size_t tstep = 2 * hstep;
    const unsigned ldsw = (unsigned)wid * 1024u;
    const int aoff = lds_byte(wr * 64 + fr, fq * 8), boff = lds_byte(wc * 32 + fr, fq * 8);
#define PG8_SA(b, h) (((b) * 2 + (h)) * HTB)
#define PG8_SB(b, h) ((4 + (b) * 2 + (h)) * HTB)
#define PG8_STAGE(bufoff, gbase, voff) do { _Pragma("unroll") for (int _i = 0; _i < 2; ++_i) \
        __builtin_amdgcn_global_load_lds((const unsigned*)((const char*)(gbase) + (voff)[_i]), (PG8_LAS unsigned*)(lds + (bufoff) + ldsw + _i * 8192), 16, 0, 0); } while (0)
#define PG8_LDA(dst, b, h) do { _Pragma("unroll") for (int m = 0; m < 4; ++m) _Pragma("unroll") for (int k = 0; k < 2; ++k) dst[m][k] = *(const PG8_LAS bf16x8*)(lds + PG8_SA(b, h) + aoff + m * 2048 + k * 1024); } while (0)
#define PG8_LDB(dst, b, h) do { _Pragma("unroll") for (int n = 0; n < 2; ++n) _Pragma("unroll") for (int k = 0; k < 2; ++k) dst[n][k] = *(const PG8_LAS bf16x8*)(lds + PG8_SB(b, h) + boff + n * 2048 + k * 1024); } while (0)
#define PG8_MMA(ai, bj, At, Bt) do { __builtin_amdgcn_s_setprio(1); _Pragma("unroll") for (int m = 0; m < 4; ++m) _Pragma("unroll") for (int n = 0; n < 2; ++n) _Pragma("unroll") for (int k = 0; k < 2; ++k) \
        acc[ai][bj][m][n] = __builtin_amdgcn_mfma_f32_16x16x32_bf16(Bt[n][k], At[m][k], acc[ai][bj][m][n], 0, 0, 0); __builtin_amdgcn_s_setprio(0); } while (0)
#define PG8_WAIT_V(n) asm volatile("s_waitcnt vmcnt(" #n ")" ::: "memory")
#define PG8_WAIT_L(n) asm volatile("s_waitcnt lgkmcnt(" #n ")" ::: "memory")
#define PG8_BAR __builtin_amdgcn_s_barrier()
#define PG8_SCHED __builtin_amdgcn_sched_barrier(0)
    Unit cur, nxt; int ui = 0;
    if (!S.next(0, cur)) return;
    f32x4 acc[2][2][4][2];
#pragma unroll
    for (int a = 0; a < 2; ++a)
#pragma unroll
        for (int b = 0; b < 2; ++b)
#pragma unroll
            for (int m = 0; m < 4; ++m)
#pragma unroll
                for (int n = 0; n < 2; ++n) acc[a][b][m][n] = (f32x4){0.f, 0.f, 0.f, 0.f};
    bf16x8 At[4][2], B0[2][2], B1[2][2];
    const char* cA = (const char*)g.A + (size_t)cur.pm * tstep; const char* cB = (const char*)g.Bt + (size_t)cur.pn * tstep;
    S.a_ready(cur);
    if constexpr (SP2) {
        PG8_STAGE(PG8_SB(0, 0), cB, voffB); PG8_STAGE(PG8_SB(0, 1), cB + hstep, voffB); PG8_STAGE(PG8_SA(0, 0), cA, voffA); PG8_STAGE(PG8_SA(0, 1), cA + hstep, voffA);
        if (wr == 1) PG8_BAR;
        PG8_WAIT_V(2); PG8_BAR;
        PG8_STAGE(PG8_SB(1, 0), cB + kstep, voffB); PG8_STAGE(PG8_SA(1, 0), cA + kstep, voffA); PG8_STAGE(PG8_SB(1, 1), cB + hstep + kstep, voffB);
        PG8_WAIT_V(6); PG8_BAR;
    } else {
        PG8_STAGE(PG8_SB(0, 0), cB, voffB); PG8_STAGE(PG8_SA(0, 0), cA, voffA); PG8_STAGE(PG8_SB(0, 1), cB + hstep, voffB); PG8_STAGE(PG8_SA(0, 1), cA + hstep, voffA);
        if (wr == 1) PG8_BAR;
        PG8_WAIT_V(4); PG8_BAR;
        PG8_STAGE(PG8_SB(1, 0), cB + kstep, voffB); PG8_STAGE(PG8_SA(1, 0), cA + kstep, voffA); PG8_STAGE(PG8_SB(1, 1), cB + hstep + kstep, voffB);
        PG8_WAIT_V(6); PG8_BAR;
    }
    for (;;) {
        const bool has_next = S.next(ui + 1, nxt);
        const char* nA = has_next ? (const char*)g.A + (size_t)nxt.pm * tstep : cA; const char* nB = has_next ? (const char*)g.Bt + (size_t)nxt.pn * tstep : cB;
        for (int t = 0; t < nt; t += 2) {
            const bool last = (t == nt - 2);
            const char* a1 = cA + (size_t)(t + 1) * kstep;
            const char* a2 = last ? nA : cA + (size_t)(t + 2) * kstep; const char* b2 = last ? nB : cB + (size_t)(t + 2) * kstep;
            const char* a3 = a2 + kstep; const char* b3 = b2 + kstep;
            if (last && has_next) S.a_ready(nxt);
            if constexpr (SP2) {
            PG8_LDB(B0, 0, 0); PG8_LDB(B1, 0, 1); PG8_SCHED; PG8_LDA(At, 0, 0); PG8_STAGE(PG8_SA(1, 1), a1 + hstep, voffA);
            PG8_WAIT_V(8); PG8_WAIT_L(0); PG8_BAR; PG8_MMA(0, 0, At, B0); PG8_MMA(0, 1, At, B1); PG8_BAR; PG8_SCHED;
            PG8_LDA(At, 0, 1); PG8_STAGE(PG8_SB(0, 0), b2, voffB); PG8_STAGE(PG8_SB(0, 1), b2 + hstep, voffB); PG8_STAGE(PG8_SA(0, 0), a2, voffA);
            PG8_WAIT_V(8); PG8_WAIT_L(0); PG8_BAR; PG8_MMA(1, 0, At, B0); PG8_MMA(1, 1, At, B1); PG8_BAR; PG8_SCHED;
            PG8_LDB(B0, 1, 0); PG8_LDB(B1, 1, 1); PG8_SCHED; PG8_LDA(At, 1, 0); PG8_STAGE(PG8_SA(0, 1), a2 + hstep, voffA);
            PG8_WAIT_V(8); PG8_WAIT_L(0); PG8_BAR; PG8_MMA(0, 0, At, B0); PG8_MMA(0, 1, At, B1); PG8_BAR; PG8_SCHED;
            PG8_LDA(At, 1, 1); PG8_STAGE(PG8_SB(1, 0), b3, voffB); PG8_STAGE(PG8_SB(1, 1), b3 + hstep, voffB); PG8_STAGE(PG8_SA(1, 0), a3, voffA);
            PG8_WAIT_V(8); PG8_WAIT_L(0); PG8_BAR; PG8_MMA(1, 0, At, B0); PG8_MMA(1, 1, At, B1); PG8_BAR; PG8_SCHED;
            } else {
            PG8_LDB(B0, 0, 0); PG8_SCHED; PG8_LDA(At, 0, 0); PG8_STAGE(PG8_SA(1, 1), a1 + hstep, voffA);
            PG8_WAIT_L(8); PG8_BAR; PG8_WAIT_L(0); PG8_MMA(0, 0, At, B0); PG8_BAR; PG8_SCHED;
            PG8_LDB(B1, 0, 1); PG8_STAGE(PG8_SB(0, 0), b2, voffB);
            PG8_BAR; PG8_WAIT_L(0); PG8_MMA(0, 1, At, B1); PG8_BAR;
            PG8_LDA(At, 0, 1); PG8_STAGE(PG8_SA(0, 0), a2, voffA);
            PG8_BAR; PG8_WAIT_L(0); PG8_MMA(1, 0, At, B0); PG8_BAR; PG8_SCHED;
            PG8_STAGE(PG8_SB(0, 1), b2 + hstep, voffB);
            PG8_WAIT_V(6); PG8_BAR; PG8_MMA(1, 1, At, B1); PG8_BAR;
            PG8_LDB(B0, 1, 0); PG8_SCHED; PG8_LDA(At, 1, 0); PG8_STAGE(PG8_SA(0, 1), a2 + hstep, voffA);
            PG8_WAIT_L(8); PG8_BAR; PG8_WAIT_L(0); PG8_MMA(0, 0, At, B0); PG8_BAR; PG8_SCHED;
            PG8_LDB(B1, 1, 1); PG8_STAGE(PG8_SB(1, 0), b3, voffB);
            PG8_BAR; PG8_WAIT_L(0); PG8_MMA(0, 1, At, B1); PG8_BAR;
            PG8_LDA(At, 1, 1); PG8_STAGE(PG8_SA(1, 0), a3, voffA);
            PG8_BAR; PG8_WAIT_L(0); PG8_MMA(1, 0, At, B0); PG8_BAR; PG8_SCHED;
            PG8_STAGE(PG8_SB(1, 1), b3 + hstep, voffB);
            PG8_WAIT_V(6); PG8_BAR; PG8_MMA(1, 1, At, B1); PG8_BAR;
            }
        }
        if constexpr (ALIGN_EPI) { if (wr == 0) PG8_BAR; }
        if constexpr (!Epi::AFTER_DRAIN) { E(acc, cur, wr, wc, fr, fq); S.done(cur); }
        if (!has_next) break;
#pragma unroll
        for (int a = 0; a < 2; ++a)
#pragma unroll
            for (int b = 0; b < 2; ++b)
#pragma unroll
                for (int m = 0; m < 4; ++m)
#pragma unroll
                    for (int n = 0; n < 2; ++n) acc[a][b][m][n] = (f32x4){0.f, 0.f, 0.f, 0.f};
        cur = nxt; cA = nA; cB = nB; ++ui;
        if constexpr (ALIGN_EPI) { if (wr == 1) PG8_BAR; }
    }
    PG8_WAIT_V(0);
    if constexpr (!ALIGN_EPI) { if (wr == 0) PG8_BAR; }
    PG8_BAR;
    if constexpr (Epi::AFTER_DRAIN) { E.fused(acc, cur, wr, wc, fr, fq, lds, wid, lane); S.done(cur); }
#undef PG8_SA
#undef PG8_SB
#undef PG8_STAGE
#undef PG8_LDA
#undef PG8_LDB
#undef PG8_MMA
#undef PG8_WAIT_V
#undef PG8_WAIT_L
#undef PG8_BAR
#undef PG8_SCHED
}

__device__ __forceinline__ float sigm(float x) { return 1.0f / (1.0f + __expf(-x)); }
struct EpiGlu {
    static constexpr bool PERM = true, AFTER_DRAIN = false;
    bf16_t* O; int ldc;
    __device__ __forceinline__ void operator()(const f32x4 (&acc)[2][2][4][2], const Unit& u, int wr, int wc, int fr, int fq) const {
        const int row0 = u.pm * BM + wr * 64 + fr, col0 = u.pn * HALF + wc * 32 + 8 * fq;
#pragma unroll
        for (int ai = 0; ai < 2; ++ai)
#pragma unroll
            for (int m = 0; m < 4; ++m) {
                bf16_t* rowp = O + (size_t)(row0 + ai * HALF + m * 16) * ldc + col0;
                const f32x4 a0 = acc[ai][0][m][0], a1 = acc[ai][0][m][1], b0 = acc[ai][1][m][0], b1 = acc[ai][1][m][1];
                u32x4 w;
                w.x = cvt_pk_bf16(a0[0] * sigm(b0[0]), a0[1] * sigm(b0[1])); w.y = cvt_pk_bf16(a0[2] * sigm(b0[2]), a0[3] * sigm(b0[3]));
                w.z = cvt_pk_bf16(a1[0] * sigm(b1[0]), a1[1] * sigm(b1[1])); w.w = cvt_pk_bf16(a1[2] * sigm(b1[2]), a1[3] * sigm(b1[3]));
                *(u32x4*)rowp = w;
            }
    }
};
struct EpiResid {
    static constexpr bool PERM = false, AFTER_DRAIN = false;
    const float* X; float* O; int ldc;
    __device__ __forceinline__ void operator()(const f32x4 (&acc)[2][2][4][2], const Unit& u, int wr, int wc, int fr, int fq) const {
        const int row0 = u.pm * BM + wr * 64 + fr, col0 = u.pn * BM + wc * 32 + 4 * fq;
#pragma unroll
        for (int ai = 0; ai < 2; ++ai)
#pragma unroll
            for (int m = 0; m < 4; ++m) {
                const size_t off = (size_t)(row0 + ai * HALF + m * 16) * ldc + col0;
#pragma unroll
                for (int bj = 0; bj < 2; ++bj)
#pragma unroll
                    for (int n = 0; n < 2; ++n) *(f32x4*)(O + off + bj * HALF + n * 16) = *(const f32x4*)(X + off + bj * HALF + n * 16) + acc[ai][bj][m][n];
            }
    }
};
struct EpiResidB {
    static constexpr bool PERM = true, AFTER_DRAIN = false;
    const float* X32; const bf16_t* XBin; bf16_t* XBout;
    __device__ __forceinline__ void operator()(const f32x4 (&acc)[2][2][4][2], const Unit& u, int wr, int wc, int fr, int fq) const {
        const int row0 = u.pm * BM + wr * 64 + fr, col0 = u.pn * BM + wc * 32 + 8 * fq;
#pragma unroll
        for (int ai = 0; ai < 2; ++ai)
#pragma unroll
            for (int m = 0; m < 4; ++m) {
                const size_t off = (size_t)(row0 + ai * HALF + m * 16) * 1024 + col0;
#pragma unroll
                for (int bj = 0; bj < 2; ++bj) {
                    f32x4 r0, r1;
                    if (X32) { r0 = *(const f32x4*)(X32 + off + bj * HALF); r1 = *(const f32x4*)(X32 + off + bj * HALF + 4); }
                    else { const u32x4 q = *(const u32x4*)(XBin + off + bj * HALF);
                        r0 = (f32x4){__uint_as_float(q.x << 16), __uint_as_float(q.x & 0xffff0000u), __uint_as_float(q.y << 16), __uint_as_float(q.y & 0xffff0000u)};
                        r1 = (f32x4){__uint_as_float(q.z << 16), __uint_as_float(q.z & 0xffff0000u), __uint_as_float(q.w << 16), __uint_as_float(q.w & 0xffff0000u)}; }
                    const f32x4 v0 = acc[ai][bj][m][0] + r0, v1 = acc[ai][bj][m][1] + r1;
                    u32x4 w; w.x = cvt_pk_bf16(v0[0], v0[1]); w.y = cvt_pk_bf16(v0[2], v0[3]); w.z = cvt_pk_bf16(v1[0], v1[1]); w.w = cvt_pk_bf16(v1[2], v1[3]);
                    *(u32x4*)(XBout + off + bj * HALF) = w; }
                if (m & 1) asm volatile("" ::: "memory");
            }
    }
};

struct ADense { static constexpr bool GATHER = false; __device__ __forceinline__ static unsigned rowoff(const Gemm&, const Unit&, int) { return 0u; } };
struct AList { static constexpr bool GATHER = true;
    __device__ __forceinline__ static unsigned rowoff(const Gemm& g, const Unit& u, int r) { const int pos = u.p0 + r; const unsigned tok = pos < u.cnt ? (g.list[(size_t)u.eb * g.cap + pos] >> 1) : 0u; return tok * (unsigned)g.lda * 2u; } };
struct ACompress { static constexpr bool GATHER = true;
    __device__ __forceinline__ static unsigned rowoff(const Gemm&, const Unit& u, int r) { const unsigned rg = (unsigned)(u.pm * BM + r), b = rg >> 9, n = (rg >> 1) & 255u, hkv = rg & 1u;
        return (((b * 4096u + 16u * n) * 1536u) + 512u + (unsigned)u.eb * 128u + hkv * 64u) * 2u; } };
template <class Epi, class Sched, class AMap>
__device__ __forceinline__ void gemm2(PG8_LAS unsigned char* lds, const Gemm g, const Sched& S, const Epi& E, const int tid) {
    constexpr bool GATHER = AMap::GATHER;
    int K_ = g.K; asm volatile("" : "+s"(K_));
    const int wid = __builtin_amdgcn_readfirstlane(tid >> 6), lane = tid & 63, wr = wid >> 2, wc = wid & 3, fr = lane & 15, fq = lane >> 4;
    const int K = K_, nt = K / BK, lda = g.lda;
    unsigned voffA[2], voffB[2]; int Rst[2], Cst[2];
#pragma unroll
    for (int i = 0; i < 2; ++i) { int R, C; stage_rc(tid * 16 + i * 8192, R, C); const int Rb = Epi::PERM ? ((R & ~31) + perm32(R & 31)) : R;
        voffA[i] = (unsigned)(R * lda + C) * 2u; voffB[i] = (unsigned)(Rb * K + C) * 2u; Rst[i] = R; Cst[i] = C; }
    const size_t kstep = (size_t)(BK * 2), kstepA = (size_t)g.kstepA;
    const size_t hstepA = (size_t)HALF * lda * 2, tstepA = 2 * hstepA, hstepB = (size_t)HALF * K * 2, tstepB = 2 * hstepB;
    const unsigned ldsw = (unsigned)wid * 1024u;
    const int aoff = lds_byte(wr * 64 + fr, fq * 8), boff = lds_byte(wc * 32 + fr, fq * 8);
#define PG8_SA(b, h) (((b) * 2 + (h)) * HTB)
#define PG8_SB(b, h) ((4 + (b) * 2 + (h)) * HTB)
#define PG8_STAGE(bufoff, gbase, voff) do { _Pragma("unroll") for (int _i = 0; _i < 2; ++_i) \
        __builtin_amdgcn_global_load_lds((const unsigned*)((const char*)(gbase) + (voff)[_i]), (PG8_LAS unsigned*)(lds + (bufoff) + ldsw + _i * 8192), 16, 0, 0); } while (0)
#define PG8_STAGE_A(bufoff, gbase, h) do { if constexpr (GATHER) { PG8_STAGE(bufoff, gbase, vg[h]); } else { PG8_STAGE(bufoff, (gbase) + (h) * hstepA, voffA); } } while (0)
#define PG8_GOFFS(u, dst) do { _Pragma("unroll") for (int _h = 0; _h < 2; ++_h) _Pragma("unroll") for (int _i = 0; _i < 2; ++_i) dst[_h][_i] = AMap::rowoff(g, (u), _h * HALF + Rst[_i]) + (unsigned)Cst[_i] * 2u; } while (0)
#define PG8_LDA(dst, b, h) do { _Pragma("unroll") for (int m = 0; m < 4; ++m) _Pragma("unroll") for (int k = 0; k < 2; ++k) dst[m][k] = *(const PG8_LAS bf16x8*)(lds + PG8_SA(b, h) + aoff + m * 2048 + k * 1024); } while (0)
#define PG8_LDB(dst, b, h) do { _Pragma("unroll") for (int n = 0; n < 2; ++n) _Pragma("unroll") for (int k = 0; k < 2; ++k) dst[n][k] = *(const PG8_LAS bf16x8*)(lds + PG8_SB(b, h) + boff + n * 2048 + k * 1024); } while (0)
#define PG8_MMA(ai, bj, At, Bt) do { __builtin_amdgcn_s_setprio(1); _Pragma("unroll") for (int m = 0; m < 4; ++m) _Pragma("unroll") for (int n = 0; n < 2; ++n) _Pragma("unroll") for (int k = 0; k < 2; ++k) \
        acc[ai][bj][m][n] = __builtin_amdgcn_mfma_f32_16x16x32_bf16(Bt[n][k], At[m][k], acc[ai][bj][m][n], 0, 0, 0); __builtin_amdgcn_s_setprio(0); } while (0)
#define PG8_WAIT_V(n) asm volatile("s_waitcnt vmcnt(" #n ")" ::: "memory")
#define PG8_WAIT_L(n) asm volatile("s_waitcnt lgkmcnt(" #n ")" ::: "memory")
#define PG8_BAR __builtin_amdgcn_s_barrier()
#define PG8_SCHED __builtin_amdgcn_sched_barrier(0)
    Unit cur, nxt; int ui = 0;
    if (!S.next(0, cur)) return;
    f32x4 acc[2][2][4][2];
#pragma unroll
    for (int a = 0; a < 2; ++a)
#pragma unroll
        for (int b = 0; b < 2; ++b)
#pragma unroll
            for (int m = 0; m < 4; ++m)
#pragma unroll
                for (int n = 0; n < 2; ++n) acc[a][b][m][n] = (f32x4){0.f, 0.f, 0.f, 0.f};
    bf16x8 At[4][2], B0[2][2], B1[2][2];
    unsigned vg[2][2] = {{0u, 0u}, {0u, 0u}};
    if constexpr (GATHER) PG8_GOFFS(cur, vg);
    const char* cA = (const char*)g.A + (GATHER ? (size_t)0 : (size_t)cur.pm * tstepA + (size_t)cur.eb * g.astride * 2);
    const char* cB = (const char*)g.Bt + ((size_t)cur.eb * g.bstride) * 2 + (size_t)cur.pn * tstepB;
    S.a_ready(cur);
    PG8_STAGE(PG8_SB(0, 0), cB, voffB); PG8_STAGE(PG8_SB(0, 1), cB + hstepB, voffB); PG8_STAGE_A(PG8_SA(0, 0), cA, 0); PG8_STAGE_A(PG8_SA(0, 1), cA, 1);
    if (wr == 1) PG8_BAR;
    PG8_WAIT_V(2); PG8_BAR;
    PG8_STAGE(PG8_SB(1, 0), cB + kstep, voffB); PG8_STAGE_A(PG8_SA(1, 0), cA + kstepA, 0); PG8_STAGE(PG8_SB(1, 1), cB + hstepB + kstep, voffB);
    PG8_WAIT_V(6); PG8_BAR;
    for (;;) {
        const bool has_next = S.next(ui + 1, nxt);
        const char* nA = has_next ? (const char*)g.A + (GATHER ? (size_t)0 : (size_t)nxt.pm * tstepA + (size_t)nxt.eb * g.astride * 2) : cA;
        const char* nB = has_next ? (const char*)g.Bt + ((size_t)nxt.eb * g.bstride) * 2 + (size_t)nxt.pn * tstepB : cB;
        for (int t = 0; t < nt; t += 2) {
            const bool last = (t == nt - 2);
            const char* a1 = cA + (size_t)(t + 1) * kstepA;
            const char* a2 = last ? nA : cA + (size_t)(t + 2) * kstepA; const char* b2 = last ? nB : cB + (size_t)(t + 2) * kstep;
            const char* a3 = a2 + kstepA; const char* b3 = b2 + kstep;
            unsigned vn1[2] = {vg[1][0], vg[1][1]};
            if constexpr (GATHER) { if (last && has_next) { unsigned vn[2][2]; PG8_GOFFS(nxt, vn); vg[0][0] = vn[0][0]; vg[0][1] = vn[0][1]; vn1[0] = vn[1][0]; vn1[1] = vn[1][1]; } }
            if (last && has_next) S.a_ready(nxt);
            PG8_LDB(B0, 0, 0); PG8_LDB(B1, 0, 1); PG8_SCHED; PG8_LDA(At, 0, 0); PG8_STAGE_A(PG8_SA(1, 1), a1, 1);
            PG8_WAIT_V(8); PG8_WAIT_L(0); PG8_BAR; PG8_MMA(0, 0, At, B0); PG8_MMA(0, 1, At, B1); PG8_BAR; PG8_SCHED;
            if constexpr (GATHER) { vg[1][0] = vn1[0]; vg[1][1] = vn1[1]; }
            PG8_LDA(At, 0, 1); PG8_STAGE(PG8_SB(0, 0), b2, voffB); PG8_STAGE(PG8_SB(0, 1), b2 + hstepB, voffB); PG8_STAGE_A(PG8_SA(0, 0), a2, 0);
            PG8_WAIT_V(8); PG8_WAIT_L(0); PG8_BAR; PG8_MMA(1, 0, At, B0); PG8_MMA(1, 1, At, B1); PG8_BAR; PG8_SCHED;
            PG8_LDB(B0, 1, 0); PG8_LDB(B1, 1, 1); PG8_SCHED; PG8_LDA(At, 1, 0); PG8_STAGE_A(PG8_SA(0, 1), a2, 1);
            PG8_WAIT_V(8); PG8_WAIT_L(0); PG8_BAR; PG8_MMA(0, 0, At, B0); PG8_MMA(0, 1, At, B1); PG8_BAR; PG8_SCHED;
            PG8_LDA(At, 1, 1); PG8_STAGE(PG8_SB(1, 0), b3, voffB); PG8_STAGE(PG8_SB(1, 1), b3 + hstepB, voffB); PG8_STAGE_A(PG8_SA(1, 0), a3, 0);
            PG8_WAIT_V(8); PG8_WAIT_L(0); PG8_BAR; PG8_MMA(1, 0, At, B0); PG8_MMA(1, 1, At, B1); PG8_BAR; PG8_SCHED;
        }
        if (wr == 0) PG8_BAR;
        E(acc, cur, wr, wc, fr, fq); S.done(cur);
        if (!has_next) break;
#pragma unroll
        for (int a = 0; a < 2; ++a)
#pragma unroll
            for (int b = 0; b < 2; ++b)
#pragma unroll
                for (int m = 0; m < 4; ++m)
#pragma unroll
                    for (int n = 0; n < 2; ++n) acc[a][b][m][n] = (f32x4){0.f, 0.f, 0.f, 0.f};
        cur = nxt; cA = nA; cB = nB; ++ui;
        if (wr == 1) PG8_BAR;
    }
    PG8_WAIT_V(0);
    PG8_BAR;
#undef PG8_SA
#undef PG8_SB
#undef PG8_STAGE
#undef PG8_STAGE_A
#undef PG8_GOFFS
#undef PG8_LDA
#undef PG8_LDB
#undef PG8_MMA
#undef PG8_WAIT_V
#undef PG8_WAIT_L
#undef PG8_BAR
#undef PG8_SCHED
}

struct ExpertOrder {
    const PG8_LAS int* tab; int nN, G, c;
    __device__ __forceinline__ bool next(int i, Unit& u) const {
        int rt, pn, e;
        if ((G & 7) == 0) {
            const int x = c & 7, R = G >> 3, Lx = i * R + (c >> 3);
            const int n0 = (tab[x + 1] - tab[x]) * nN, n1 = (tab[x + 9] - tab[x + 8]) * nN, n2 = (tab[x + 17] - tab[x + 16]) * nN, n3 = (tab[x + 25] - tab[x + 24]) * nN;
            const int c1 = n0, c2 = n0 + n1, c3 = c2 + n2, c4 = c3 + n3;
            if (Lx >= c4) return false;
            const int k = (Lx >= c1 ? 1 : 0) + (Lx >= c2 ? 1 : 0) + (Lx >= c3 ? 1 : 0), ul = Lx - (k == 0 ? 0 : (k == 1 ? c1 : (k == 2 ? c2 : c3)));
            e = x + 8 * k; rt = tab[e] + ul / nN; pn = ul % nN;
        } else {
            const int total = tab[32] * nN; const long L = (long)i * G + c; if (L >= total) return false;
            rt = (int)L / nN; pn = (int)L % nN; e = 0;
#pragma unroll
            for (int k = 1; k < 32; ++k) e += (rt >= tab[k]) ? 1 : 0;
        }
        u.pm = __builtin_amdgcn_readfirstlane(rt); u.pn = __builtin_amdgcn_readfirstlane(pn); u.eb = __builtin_amdgcn_readfirstlane(e);
        u.p0 = __builtin_amdgcn_readfirstlane((rt - tab[e]) * BM); u.cnt = __builtin_amdgcn_readfirstlane(tab[33 + e]); return true;
    }
    __device__ __forceinline__ void a_ready(const Unit&) const {}
    __device__ __forceinline__ void done(const Unit&) const {}
};
struct EpiGateUp {
    static constexpr bool PERM = true, AFTER_DRAIN = false;
    bf16_t* H; const float* listw; int cap;
    __device__ __forceinline__ void operator()(const f32x4 (&acc)[2][2][4][2], const Unit& u, int wr, int wc, int fr, int fq) const {
        const int rl0 = wr * 64 + fr, col0 = u.pn * HALF + wc * 32 + 8 * fq;
#pragma unroll
        for (int ai = 0; ai < 2; ++ai)
#pragma unroll
            for (int m = 0; m < 4; ++m) {
                const int rl = rl0 + ai * HALF + m * 16, pos = u.p0 + rl;
                const float w = pos < u.cnt ? listw[(size_t)u.eb * cap + pos] : 0.f;
                bf16_t* rowp = H + (size_t)(u.pm * BM + rl) * 256 + col0;
                const f32x4 g0 = acc[ai][0][m][0], g1 = acc[ai][0][m][1], u0 = acc[ai][1][m][0], u1 = acc[ai][1][m][1];
                u32x4 o;
                o.x = cvt_pk_bf16(g0[0] * sigm(g0[0]) * u0[0] * w, g0[1] * sigm(g0[1]) * u0[1] * w); o.y = cvt_pk_bf16(g0[2] * sigm(g0[2]) * u0[2] * w, g0[3] * sigm(g0[3]) * u0[3] * w);
                o.z = cvt_pk_bf16(g1[0] * sigm(g1[0]) * u1[0] * w, g1[1] * sigm(g1[1]) * u1[1] * w); o.w = cvt_pk_bf16(g1[2] * sigm(g1[2]) * u1[2] * w, g1[3] * sigm(g1[3]) * u1[3] * w);
                *(u32x4*)rowp = o;
            }
    }
};
struct EpiDown {
    static constexpr bool PERM = true, AFTER_DRAIN = false;
    bf16_t* P1; long d12; const unsigned* list; int cap;
    __device__ __forceinline__ void operator()(const f32x4 (&acc)[2][2][4][2], const Unit& u, int wr, int wc, int fr, int fq) const {
        const int rl0 = wr * 64 + fr, col0 = u.pn * BM + wc * 32 + 8 * fq;
#pragma unroll
        for (int ai = 0; ai < 2; ++ai) {
            unsigned ent[4];
#pragma unroll
            for (int m = 0; m < 4; ++m) { const int pos = u.p0 + rl0 + ai * HALF + m * 16; ent[m] = pos < u.cnt ? list[(size_t)u.eb * cap + pos] : 0xffffffffu; }
#pragma unroll
            for (int m = 0; m < 4; ++m) {
                if (ent[m] != 0xffffffffu) {
                    bf16_t* dst = P1 + (long)(ent[m] & 1u) * d12 + (size_t)(ent[m] >> 1) * 1024 + col0;
#pragma unroll
                    for (int bj = 0; bj < 2; ++bj) { const f32x4 v0 = acc[ai][bj][m][0], v1 = acc[ai][bj][m][1];
                        u32x4 w; w.x = cvt_pk_bf16(v0[0], v0[1]); w.y = cvt_pk_bf16(v0[2], v0[3]); w.z = cvt_pk_bf16(v1[0], v1[1]); w.w = cvt_pk_bf16(v1[2], v1[3]);
                        *(u32x4*)(dst + bj * HALF) = w; }
                }
            }
            asm volatile("" ::: "memory");
        }
    }
};

struct BatchOrder {
    int nb, nM, nN, G, c;
    __device__ __forceinline__ bool next(int i, Unit& u) const {
        const long L = (long)i * G + c; if (L >= (long)nb * nM * nN) return false;
        const int per = nM * nN, e = (int)L / per, rem = (int)L % per;
        u.eb = e; u.pm = rem / nN; u.pn = rem % nN; u.p0 = 0; u.cnt = 0; return true;
    }
    __device__ __forceinline__ void a_ready(const Unit&) const {}
    __device__ __forceinline__ void done(const Unit&) const {}
};
struct EpiInProj {
    static constexpr bool PERM = true, AFTER_DRAIN = false;
    bf16_t* Zo; bf16_t* U;
    __device__ __forceinline__ void operator()(const f32x4 (&acc)[2][2][4][2], const Unit& u, int wr, int wc, int fr, int fq) const {
        const int row0 = u.pm * BM + wr * 64 + fr;
#pragma unroll
        for (int ai = 0; ai < 2; ++ai)
#pragma unroll
            for (int m = 0; m < 4; ++m) { const int row = row0 + ai * HALF + m * 16;
#pragma unroll
                for (int bj = 0; bj < 2; ++bj) { const int c0 = u.pn * BM + bj * HALF + wc * 32 + 8 * fq;
                    const f32x4 v0 = acc[ai][bj][m][0], v1 = acc[ai][bj][m][1];
                    u32x4 w; w.x = cvt_pk_bf16(v0[0], v0[1]); w.y = cvt_pk_bf16(v0[2], v0[3]); w.z = cvt_pk_bf16(v1[0], v1[1]); w.w = cvt_pk_bf16(v1[2], v1[3]);
                    bf16_t* dst = u.pn < 2 ? U + ((size_t)((c0 >> 4) * 2048 + (row >> 4)) * 512 + (row & 15) * 16 + (c0 & 15)) : Zo + (size_t)row * 1536 + (c0 - 512);
                    *(u32x4*)dst = w; } }
    }
};
struct EpiXloc {
    static constexpr bool PERM = false, AFTER_DRAIN = false;
    float* XL;
    __device__ __forceinline__ void operator()(const f32x4 (&acc)[2][2][4][2], const Unit& u, int wr, int wc, int fr, int fq) const {
        const int row0 = u.pm * BM + wr * 64 + fr, col0 = wc * 32 + 4 * fq;
#pragma unroll
        for (int ai = 0; ai < 2; ++ai)
#pragma unroll
            for (int m = 0; m < 4; ++m) { float* rowp = XL + ((size_t)u.eb * 2048 + row0 + ai * HALF + m * 16) * 128 + col0;
#pragma unroll
                for (int n = 0; n < 2; ++n) *(f32x4*)(rowp + n * 16) = acc[ai][0][m][n]; }
    }
};
__device__ __forceinline__ float gelu_t(float x) { const float u2 = -2.302208198f * (x + 0.044715f * x * x * x); return x * __builtin_amdgcn_rcpf(1.0f + __builtin_amdgcn_exp2f(u2)); }
struct EpiSsmOut {
    static constexpr bool PERM = true, AFTER_DRAIN = false;
    bf16_t* G;
    __device__ __forceinline__ void operator()(const f32x4 (&acc)[2][2][4][2], const Unit& u, int wr, int wc, int fr, int fq) const {
        const int row0 = u.pm * BM + wr * 64 + fr;
#pragma unroll
        for (int ai = 0; ai < 2; ++ai)
#pragma unroll
            for (int m = 0; m < 4; ++m) { const int row = row0 + ai * HALF + m * 16;
#pragma unroll
                for (int bj = 0; bj < 2; ++bj) { const int n0 = bj * HALF + wc * 32 + 8 * fq;
                    const f32x4 v0 = acc[ai][bj][m][0], v1 = acc[ai][bj][m][1];
                    u32x4 w; w.x = cvt_pk_bf16(gelu_t(v0[0]), gelu_t(v0[1])); w.y = cvt_pk_bf16(gelu_t(v0[2]), gelu_t(v0[3])); w.z = cvt_pk_bf16(gelu_t(v1[0]), gelu_t(v1[1])); w.w = cvt_pk_bf16(gelu_t(v1[2]), gelu_t(v1[3]));
                    *(u32x4*)(G + ((size_t)row * 16 + (n0 >> 4)) * 512 + u.eb * 16 + (n0 & 15)) = w; } }
    }
};

struct CmpOrder {
    int G, c;
    __device__ __forceinline__ bool next(int i, Unit& u) const { const int L = i * G + c; if (L >= 32) return false; u.eb = L >> 4; u.pm = L & 15; u.pn = 0; u.p0 = 0; u.cnt = 0; return true; }
    __device__ __forceinline__ void a_ready(const Unit&) const {}
    __device__ __forceinline__ void done(const Unit&) const {}
};
struct EpiCmpHid {
    static constexpr bool PERM = false, AFTER_DRAIN = false;
    bf16_t* HC; const float* bias;
    __device__ __forceinline__ void operator()(const f32x4 (&acc)[2][2][4][2], const Unit& u, int wr, int wc, int fr, int fq) const {
        if (wc < 2) {
            const int row0 = u.pm * BM + wr * 64 + fr, col0 = wc * 32 + 4 * fq;
#pragma unroll
            for (int n = 0; n < 2; ++n) { const f32x4 bv = *(const f32x4*)(bias + u.eb * 64 + col0 + n * 16);
#pragma unroll
                for (int ai = 0; ai < 2; ++ai)
#pragma unroll
                    for (int m = 0; m < 4; ++m) { const f32x4 v = acc[ai][0][m][n] + bv;
                        typedef unsigned u32x2_ __attribute__((ext_vector_type(2)));
                        u32x2_ w; w.x = cvt_pk_bf16(gelu_t(v[0]), gelu_t(v[1])); w.y = cvt_pk_bf16(gelu_t(v[2]), gelu_t(v[3]));
                        *(u32x2_*)(HC + ((size_t)u.eb * 4096 + row0 + ai * HALF + m * 16) * 64 + col0 + n * 16) = w; } }
        }
    }
};

struct SingleUnit {
    int eb, pm;
    __device__ __forceinline__ bool next(int i, Unit& u) const { if (i > 0) return false; u.eb = eb; u.pm = pm; u.pn = 0; u.p0 = 0; u.cnt = 0; return true; }
    __device__ __forceinline__ void a_ready(const Unit&) const {}
    __device__ __forceinline__ void done(const Unit&) const {}
};
}

struct Args { const float* in[26]; float* out; unsigned char* ws; int ph_lo, ph_hi; };

struct Frame {
    LAS unsigned char* lds;
    int tid, lane, wave, blk, G;
};

__device__ __forceinline__ f32x4 bf4(u32x2 p) { f32x4 r; r.x = __uint_as_float(p.x << 16); r.y = __uint_as_float(p.x & 0xffff0000u); r.z = __uint_as_float(p.y << 16); r.w = __uint_as_float(p.y & 0xffff0000u); return r; }
__device__ __forceinline__ void ph_norm(const Frame& F, const float* xin, const bf16* add, const bf16* add2, float* xout, const float* g, bf16* hn) {
    const int gw = F.blk * NWAVES + F.wave, NGW = F.G * NWAVES;
    f32x4 gg[4];
#pragma unroll
    for (int j = 0; j < 4; ++j) gg[j] = ((const f32x4*)g)[F.lane + 64 * j];
    f32x4 nv[4]; u32x2 na[4], nb[4];
    if (gw < T) {
#pragma unroll
        for (int j = 0; j < 4; ++j) { nv[j] = ((const f32x4*)(xin + (size_t)gw * DM))[F.lane + 64 * j];
            if (add) { na[j] = ((const u32x2*)(add + (size_t)gw * DM))[F.lane + 64 * j]; nb[j] = ((const u32x2*)(add2 + (size_t)gw * DM))[F.lane + 64 * j]; } }
    }
    for (int row = gw; row < T; row += NGW) {
        f32x4 v[4]; float s = 0.f;
#pragma unroll
        for (int j = 0; j < 4; ++j) { v[j] = nv[j]; if (add) v[j] += bf4(na[j]) + bf4(nb[j]); }
        const int nrow = row + NGW;
        if (nrow < T) {
#pragma unroll
            for (int j = 0; j < 4; ++j) { nv[j] = ((const f32x4*)(xin + (size_t)nrow * DM))[F.lane + 64 * j];
                if (add) { na[j] = ((const u32x2*)(add + (size_t)nrow * DM))[F.lane + 64 * j]; nb[j] = ((const u32x2*)(add2 + (size_t)nrow * DM))[F.lane + 64 * j]; } }
        }
#pragma unroll
        for (int j = 0; j < 4; ++j) { if (add) ((f32x4*)(xout + (size_t)row * DM))[F.lane + 64 * j] = v[j];
            s += v[j].x * v[j].x + v[j].y * v[j].y + v[j].z * v[j].z + v[j].w * v[j].w; }
        s = wave_sum(s, F.lane);
        const float r = rsqrtf(s * (1.0f / DM) + EPS);
#pragma unroll
        for (int j = 0; j < 4; ++j) {
            u32x2 o; o.x = pk2(v[j].x * r * gg[j].x, v[j].y * r * gg[j].y); o.y = pk2(v[j].z * r * gg[j].z, v[j].w * r * gg[j].w);
            *(u32x2*)(hn + (size_t)row * DM + (F.lane + 64 * j) * 4) = o;
        }
    }
}
__device__ __forceinline__ void ph_norm_b(const Frame& F, bf16* xb, const bf16* add, const bf16* add2, const float* g, bf16* hn) {
    const int gw = F.blk * NWAVES + F.wave, NGW = F.G * NWAVES;
    f32x4 gg[4];
#pragma unroll
    for (int j = 0; j < 4; ++j) gg[j] = ((const f32x4*)g)[F.lane + 64 * j];
    u32x2 nx[4], na[4], nb[4];
    if (gw < T) {
#pragma unroll
        for (int j = 0; j < 4; ++j) { nx[j] = ((const u32x2*)(xb + (size_t)gw * DM))[F.lane + 64 * j]; na[j] = ((const u32x2*)(add + (size_t)gw * DM))[F.lane + 64 * j]; nb[j] = ((const u32x2*)(add2 + (size_t)gw * DM))[F.lane + 64 * j]; }
    }
    for (int row = gw; row < T; row += NGW) {
        f32x4 v[4]; float s = 0.f;
#pragma unroll
        for (int j = 0; j < 4; ++j) v[j] = bf4(nx[j]) + bf4(na[j]) + bf4(nb[j]);
        const int nrow = row + NGW;
        if (nrow < T) {
#pragma unroll
            for (int j = 0; j < 4; ++j) { nx[j] = ((const u32x2*)(xb + (size_t)nrow * DM))[F.lane + 64 * j]; na[j] = ((const u32x2*)(add + (size_t)nrow * DM))[F.lane + 64 * j]; nb[j] = ((const u32x2*)(add2 + (size_t)nrow * DM))[F.lane + 64 * j]; }
        }
#pragma unroll
        for (int j = 0; j < 4; ++j) { u32x2 o; o.x = pk2(v[j].x, v[j].y); o.y = pk2(v[j].z, v[j].w); ((u32x2*)(xb + (size_t)row * DM))[F.lane + 64 * j] = o;
            s += v[j].x * v[j].x + v[j].y * v[j].y + v[j].z * v[j].z + v[j].w * v[j].w; }
        s = wave_sum(s, F.lane);
        const float r = rsqrtf(s * (1.0f / DM) + EPS);
#pragma unroll
        for (int j = 0; j < 4; ++j) {
            u32x2 o; o.x = pk2(v[j].x * r * gg[j].x, v[j].y * r * gg[j].y); o.y = pk2(v[j].z * r * gg[j].z, v[j].w * r * gg[j].w);
            *(u32x2*)(hn + (size_t)row * DM + (F.lane + 64 * j) * 4) = o;
        }
    }
}
__device__ __forceinline__ void ph_final_norm(const Frame& F, float* out, const bf16* xb, const bf16* add, const bf16* add2, const float* g) {
    const int gw = F.blk * NWAVES + F.wave, NGW = F.G * NWAVES;
    f32x4 gg[4];
#pragma unroll
    for (int j = 0; j < 4; ++j) gg[j] = ((const f32x4*)g)[F.lane + 64 * j];
    u32x2 nx[4], na[4], nb[4];
    if (gw < T) {
#pragma unroll
        for (int j = 0; j < 4; ++j) { nx[j] = ((const u32x2*)(xb + (size_t)gw * DM))[F.lane + 64 * j]; na[j] = ((const u32x2*)(add + (size_t)gw * DM))[F.lane + 64 * j]; nb[j] = ((const u32x2*)(add2 + (size_t)gw * DM))[F.lane + 64 * j]; }
    }
    for (int row = gw; row < T; row += NGW) {
        f32x4 v[4]; float s = 0.f;
#pragma unroll
        for (int j = 0; j < 4; ++j) { v[j] = bf4(nx[j]) + bf4(na[j]) + bf4(nb[j]); s += v[j].x * v[j].x + v[j].y * v[j].y + v[j].z * v[j].z + v[j].w * v[j].w; }
        const int nrow = row + NGW;
        if (nrow < T) {
#pragma unroll
            for (int j = 0; j < 4; ++j) { nx[j] = ((const u32x2*)(xb + (size_t)nrow * DM))[F.lane + 64 * j]; na[j] = ((const u32x2*)(add + (size_t)nrow * DM))[F.lane + 64 * j]; nb[j] = ((const u32x2*)(add2 + (size_t)nrow * DM))[F.lane + 64 * j]; }
        }
        s = wave_sum(s, F.lane);
        const float r = rsqrtf(s * (1.0f / DM) + EPS);
#pragma unroll
        for (int j = 0; j < 4; ++j) {
            f32x4 o; o.x = v[j].x * r * gg[j].x; o.y = v[j].y * r * gg[j].y; o.z = v[j].z * r * gg[j].z; o.w = v[j].w * r * gg[j].w;
            ((f32x4*)(out + (size_t)row * DM))[F.lane + 64 * j] = o;
        }
    }
}

template <bool DUAL, class Epi>
__device__ __forceinline__ void sgemm_naive(const Frame& F, const bf16* A, int lda, const float* B, int ldb, int M, int N, int K, int dualoff, const Epi& epi) {
    LAS float* As = (LAS float*)F.lds;
    LAS float* Bs = As + 16 * 132;
    LAS float* Bs2 = Bs + 16 * 128;
    const int tiles_n = (N + 127) / 128, tiles_m = M / 128;
    const int tx = F.tid & 31, ty = F.tid >> 5;
    for (int tile = F.blk; tile < tiles_m * tiles_n; tile += F.G) {
        const int tm = tile / tiles_n, tn = tile % tiles_n;
        float acc[8][4], acc2[8][4];
#pragma unroll
        for (int i = 0; i < 8; ++i)
#pragma unroll
            for (int j = 0; j < 4; ++j) { acc[i][j] = 0.f; acc2[i][j] = 0.f; }
        const int arow = F.tid >> 2, akq = (F.tid & 3) * 4;
        const int bk = F.tid >> 5, bn = (F.tid & 31) * 4;
        for (int k0 = 0; k0 < K; k0 += 16) {
            {
                const u32x2 av = *(const u32x2*)(A + (size_t)(tm * 128 + arow) * lda + k0 + akq);
                As[(akq + 0) * 132 + arow] = __uint_as_float(av.x << 16);
                As[(akq + 1) * 132 + arow] = __uint_as_float(av.x & 0xffff0000u);
                As[(akq + 2) * 132 + arow] = __uint_as_float(av.y << 16);
                As[(akq + 3) * 132 + arow] = __uint_as_float(av.y & 0xffff0000u);
                const int col = tn * 128 + bn;
                f32x4 bv = (f32x4){0.f, 0.f, 0.f, 0.f};
                const float* bp = B + (size_t)(k0 + bk) * ldb + col;
                if (col + 3 < N) { bv.x = bp[0]; bv.y = bp[1]; bv.z = bp[2]; bv.w = bp[3]; }
                else { if (col < N) bv.x = bp[0]; if (col + 1 < N) bv.y = bp[1]; if (col + 2 < N) bv.z = bp[2]; }
                *(LAS f32x4*)(Bs + bk * 128 + bn) = bv;
                if (DUAL) {
                    const float* bp2 = bp + dualoff;
                    f32x4 bw; bw.x = bp2[0]; bw.y = bp2[1]; bw.z = bp2[2]; bw.w = bp2[3];
                    *(LAS f32x4*)(Bs2 + bk * 128 + bn) = bw;
                }
            }
            __syncthreads();
#pragma unroll 4
            for (int k = 0; k < 16; ++k) {
                float a[8];
                const f32x4 a0 = *(const LAS f32x4*)(As + k * 132 + ty * 8), a1 = *(const LAS f32x4*)(As + k * 132 + ty * 8 + 4);
                a[0] = a0.x; a[1] = a0.y; a[2] = a0.z; a[3] = a0.w; a[4] = a1.x; a[5] = a1.y; a[6] = a1.z; a[7] = a1.w;
                const f32x4 b = *(const LAS f32x4*)(Bs + k * 128 + tx * 4);
#pragma unroll
                for (int i = 0; i < 8; ++i) { acc[i][0] += a[i] * b.x; acc[i][1] += a[i] * b.y; acc[i][2] += a[i] * b.z; acc[i][3] += a[i] * b.w; }
                if (DUAL) {
                    const f32x4 b2 = *(const LAS f32x4*)(Bs2 + k * 128 + tx * 4);
#pragma unroll
                    for (int i = 0; i < 8; ++i) { acc2[i][0] += a[i] * b2.x; acc2[i][1] += a[i] * b2.y; acc2[i][2] += a[i] * b2.z; acc2[i][3] += a[i] * b2.w; }
                }
            }
            __syncthreads();
        }
#pragma unroll
        for (int i = 0; i < 8; ++i)
#pragma unroll
            for (int j = 0; j < 4; ++j) {
                const int row = tm * 128 + ty * 8 + i, col = tn * 128 + tx * 4 + j;
                if (col < N) epi(row, col, acc[i][j], acc2[i][j]);
            }
    }
}
struct EpiStoreBf16 { bf16* O; int ldo; __device__ __forceinline__ void operator()(int r, int c, float a, float) const { O[(size_t)r * ldo + c] = (bf16)f2bf(a); } };
struct EpiGlu { bf16* O; int ldo; __device__ __forceinline__ void operator()(int r, int c, float a, float b) const { O[(size_t)r * ldo + c] = (bf16)f2bf(a * sigmoidf_(b)); } };
struct EpiResid { const float* X; float* O; __device__ __forceinline__ void operator()(int r, int c, float a, float) const { O[(size_t)r * DM + c] = X[(size_t)r * DM + c] + a; } };

__device__ __forceinline__ void ssm_naive_item(int b, int g, const float* a_re, const float* a_im, const float* b_re, const float* b_im, const float* c_re, const float* c_im,
                                               const float* dpar, const float* log_dt, const bf16* Z, bf16* G1, int lane) {
    const int p = lane;
    const float are = a_re[g * 64 + p], aim = a_im[g * 64 + p], dt = expf(log_dt[g]);
    const float er = expf(are * dt), lbr = er * cosf(aim * dt), lbi = er * sinf(aim * dt);
    const float xx = lbr - 1.0f, yy = lbi, den = are * are + aim * aim;
    const float fr = (xx * are + yy * aim) / den, fi = (yy * are - xx * aim) / den;
    float bbr[16], bbi[16], cr[16], ci[16];
#pragma unroll
    for (int h = 0; h < 16; ++h) {
        const float br = b_re[(g * 64 + p) * 16 + h], bi = b_im[(g * 64 + p) * 16 + h];
        bbr[h] = fr * br - fi * bi; bbi[h] = fr * bi + fi * br;
        cr[h] = c_re[(g * 16 + h) * 64 + p]; ci[h] = c_im[(g * 16 + h) * 64 + p];
    }
    const float dd = dpar[g * 16 + (lane & 15)];
    float xr = 0.f, xi = 0.f;
    for (int t = 0; t < SEQ; ++t) {
        const size_t row = (size_t)b * SEQ + t;
        const u32x4 u0 = *(const u32x4*)(Z + row * ZP + ZC_U + g * 16), u1 = *(const u32x4*)(Z + row * ZP + ZC_U + g * 16 + 8);
        float u[16];
        u[0] = __uint_as_float(u0.x << 16); u[1] = __uint_as_float(u0.x & 0xffff0000u); u[2] = __uint_as_float(u0.y << 16); u[3] = __uint_as_float(u0.y & 0xffff0000u);
        u[4] = __uint_as_float(u0.z << 16); u[5] = __uint_as_float(u0.z & 0xffff0000u); u[6] = __uint_as_float(u0.w << 16); u[7] = __uint_as_float(u0.w & 0xffff0000u);
        u[8] = __uint_as_float(u1.x << 16); u[9] = __uint_as_float(u1.x & 0xffff0000u); u[10] = __uint_as_float(u1.y << 16); u[11] = __uint_as_float(u1.y & 0xffff0000u);
        u[12] = __uint_as_float(u1.z << 16); u[13] = __uint_as_float(u1.z & 0xffff0000u); u[14] = __uint_as_float(u1.w << 16); u[15] = __uint_as_float(u1.w & 0xffff0000u);
        float bur = 0.f, bui = 0.f;
#pragma unroll
        for (int h = 0; h < 16; ++h) { bur += bbr[h] * u[h]; bui += bbi[h] * u[h]; }
        const float nxr = lbr * xr - lbi * xi + bur, nxi = lbr * xi + lbi * xr + bui;
        xr = nxr; xi = nxi;
        float y = 0.f;
#pragma unroll
        for (int h = 0; h < 16; ++h) { const float v = wave_sum(cr[h] * xr - ci[h] * xi, lane); if (lane == h) y = v; }
        if (lane < 16) {
            const float ul = bf2f(Z[row * ZP + ZC_U + g * 16 + lane]);
            G1[row * D_SSM + g * 16 + lane] = (bf16)f2bf(gelu_tanh(y + dd * ul));
        }
    }
}
__device__ __forceinline__ void compress_naive_item(int item, const bf16* Z, const float* pos, const float* w1, const float* w2, bf16* KC, bf16* VC, int lane) {
    const int i = item & 1, hkv = (item >> 1) & 1, n = (item >> 2) % NCMPP, b = (item >> 2) / NCMPP;
    bf16* dst = i ? VC : KC;
    if (n == NCMP) { dst[(((size_t)b * NCMPP + n) * 2 + hkv) * 64 + lane] = 0; return; }
    const float* posi = pos + i * 32 * 64; const float* w1i = w1 + (size_t)i * 32 * 64 * 64; const float* w2i = w2 + i * 64 * 64;
    float acc = 0.f;
    for (int l = 0; l < 32; ++l) {
        const bf16* zr = Z + ((size_t)b * SEQ + 16 * n + l) * ZP + ZC_KV + i * 128 + hkv * 64;
        for (int d = 0; d < 64; ++d) acc += (bf2f(zr[d]) + posi[l * 64 + d]) * w1i[(l * 64 + d) * 64 + lane];
    }
    const float hid = gelu_tanh(acc);
    float o = 0.f;
    for (int e = 0; e < 64; ++e) o += lane_bcast(hid, e) * w2i[e * 64 + lane];
    dst[(((size_t)b * NCMPP + n) * 2 + hkv) * 64 + lane] = (bf16)f2bf(o);
}

__device__ __forceinline__ void attn_chunk(LAS float* wl, const bf16* Z, const float* rel_bias, int b, int hkv, int t, int base, int kcol, int vcol, int lane,
                                           float (&m)[4], float (&l)[4], float (&o)[4]) {
    const int pos = base + lane; const bool valid = (pos >= 0) && (pos <= t);
    const int posc = pos < 0 ? 0 : (pos > SEQ - 1 ? SEQ - 1 : pos);
    const bf16* kr = Z + ((size_t)b * SEQ + posc) * ZP + kcol + hkv * 64;
    float s[4] = {0.f, 0.f, 0.f, 0.f};
#pragma unroll 2
    for (int c = 0; c < 8; ++c) {
        const u32x4 kv = *(const u32x4*)(kr + c * 8);
        float k[8];
        k[0] = __uint_as_float(kv.x << 16); k[1] = __uint_as_float(kv.x & 0xffff0000u); k[2] = __uint_as_float(kv.y << 16); k[3] = __uint_as_float(kv.y & 0xffff0000u);
        k[4] = __uint_as_float(kv.z << 16); k[5] = __uint_as_float(kv.z & 0xffff0000u); k[6] = __uint_as_float(kv.w << 16); k[7] = __uint_as_float(kv.w & 0xffff0000u);
#pragma unroll
        for (int g = 0; g < 4; ++g) {
            const f32x4 q0 = *(const LAS f32x4*)(wl + g * 64 + c * 8), q1 = *(const LAS f32x4*)(wl + g * 64 + c * 8 + 4);
            s[g] += q0.x * k[0] + q0.y * k[1] + q0.z * k[2] + q0.w * k[3] + q1.x * k[4] + q1.y * k[5] + q1.z * k[6] + q1.w * k[7];
        }
    }
    const int bk = t5_bucket(t - pos);
#pragma unroll
    for (int g = 0; g < 4; ++g) {
        const float sv = valid ? s[g] + rel_bias[bk * 8 + hkv * 4 + g] : -1e30f;
        const float mn = fmaxf(m[g], wave_max(sv, lane));
        const float alpha = __expf(m[g] - mn);
        const float p = valid ? __expf(sv - mn) : 0.f;
        l[g] = l[g] * alpha + wave_sum(p, lane);
        o[g] *= alpha; m[g] = mn;
        wl[256 + g * 64 + lane] = p;
    }
#pragma unroll 4
    for (int key = 0; key < 64; ++key) {
        int pk = base + key; pk = pk < 0 ? 0 : (pk > SEQ - 1 ? SEQ - 1 : pk);
        const float v = bf2f(Z[((size_t)b * SEQ + pk) * ZP + vcol + hkv * 64 + lane]);
#pragma unroll
        for (int g = 0; g < 4; ++g) o[g] += wl[256 + g * 64 + key] * v;
    }
}
__device__ __forceinline__ void attn_naive_item(LAS float* wl, int b, int hkv, int t, const bf16* Z, const float* KC, const float* VC, const float* rel_bias, bf16* YC, int lane) {
    const size_t row = (size_t)b * SEQ + t;
#pragma unroll
    for (int g = 0; g < 4; ++g) wl[g * 64 + lane] = bf2f(Z[row * ZP + ZC_Q + hkv * 256 + g * 64 + lane]) * 0.125f;
#pragma unroll 1
    for (int c = 0; c < 4; ++c) {
        const int n = c * 64 + lane; const bool valid = (n < NCMP) && (16 * n + 31 <= t);
        const float* kr = KC + (((size_t)b * NCMPP + (n < NCMP ? n : 0)) * 2 + hkv) * 64;
        float s[4] = {0.f, 0.f, 0.f, 0.f};
#pragma unroll 4
        for (int d4 = 0; d4 < 16; ++d4) {
            const f32x4 k = *(const f32x4*)(kr + d4 * 4);
#pragma unroll
            for (int g = 0; g < 4; ++g) { const f32x4 q = *(const LAS f32x4*)(wl + g * 64 + d4 * 4); s[g] += q.x * k.x + q.y * k.y + q.z * k.z + q.w * k.w; }
        }
        const int bk = t5_bucket(t - (16 * n + 31));
#pragma unroll
        for (int g = 0; g < 4; ++g) wl[256 + g * 256 + n] = valid ? s[g] + rel_bias[bk * 8 + hkv * 4 + g] : -1e30f;
    }
#pragma unroll
    for (int g = 0; g < 4; ++g) {
        float sc[4];
#pragma unroll
        for (int c = 0; c < 4; ++c) sc[c] = wl[256 + g * 256 + c * 64 + lane];
        const float mx = wave_max(fmaxf(fmaxf(sc[0], sc[1]), fmaxf(sc[2], sc[3])), lane);
        float e[4], ls = 0.f;
#pragma unroll
        for (int c = 0; c < 4; ++c) { e[c] = sc[c] > -1e29f ? __expf(sc[c] - mx) : 0.f; ls += e[c]; }
        ls = wave_sum(ls, lane);
        const float inv = ls > 0.f ? 1.0f / ls : 0.f;
#pragma unroll
        for (int c = 0; c < 4; ++c) wl[256 + g * 256 + c * 64 + lane] = e[c] * inv;
    }
    float oc[4] = {0.f, 0.f, 0.f, 0.f};
    const int nmax = t >= 31 ? ((t - 31) / 16 + 1 < NCMP ? (t - 31) / 16 + 1 : NCMP) : 0;
#pragma unroll 4
    for (int n = 0; n < nmax; ++n) {
        const float v = VC[(((size_t)b * NCMPP + n) * 2 + hkv) * 64 + lane];
#pragma unroll
        for (int g = 0; g < 4; ++g) oc[g] += wl[256 + g * 256 + n] * v;
    }
    float imp = 0.f;
#pragma unroll
    for (int g = 0; g < 4; ++g) {
        const LAS float* P = wl + 256 + g * 256;
        imp += P[4 * lane] + P[4 * lane + 1] + P[4 * lane + 2] + 0.5f * P[4 * lane + 3] + (lane > 0 ? 0.5f * P[4 * lane - 1] : 0.f);
    }
    const int blk = t >> 6;
    const bool forced = (lane == 0) || (lane <= blk && lane > blk - 2), future = lane > blk;
    const float v = forced ? 1e9f : (future ? -1e9f : imp);
    int rank = 0;
    for (int jj = 0; jj < 64; ++jj) { const float vj = lane_bcast(v, jj); rank += (vj > v) || (vj == v && jj < lane); }
    unsigned long long mask = __ballot(rank < 16 && !future);
    float m[4], l[4], o[4];
#pragma unroll
    for (int g = 0; g < 4; ++g) { m[g] = -1e30f; l[g] = 0.f; o[g] = 0.f; }
    while (mask) {
        const int j = __builtin_ctzll(mask); mask &= mask - 1;
        attn_chunk(wl, Z, rel_bias, b, hkv, t, 64 * j, ZC_KV + 256, ZC_KV + 384, lane, m, l, o);
    }
    float os[4];
#pragma unroll
    for (int g = 0; g < 4; ++g) { os[g] = l[g] > 0.f ? o[g] / l[g] : 0.f; m[g] = -1e30f; l[g] = 0.f; o[g] = 0.f; }
    for (int c = 0; c < 8; ++c) attn_chunk(wl, Z, rel_bias, b, hkv, t, t - 511 + 64 * c, ZC_KV + 512, ZC_KV + 640, lane, m, l, o);
#pragma unroll
    for (int g = 0; g < 4; ++g) {
        const float ow = l[g] > 0.f ? o[g] / l[g] : 0.f;
        const bf16* gp = Z + row * ZP + ZC_G + hkv * 12 + g * 3;
        const float r = sigmoidf_(bf2f(gp[0])) * oc[g] + sigmoidf_(bf2f(gp[1])) * os[g] + sigmoidf_(bf2f(gp[2])) * ow;
        YC[row * DM + D_SSM + hkv * 256 + g * 64 + lane] = (bf16)f2bf(r);
    }
}

struct RTok { f32x4 v[4]; int gi; float gval; };
__device__ __forceinline__ unsigned cvtpk_rne(float lo, float hi) { unsigned r; asm("v_cvt_pk_bf16_f32 %0, %1, %2" : "=v"(r) : "v"(lo), "v"(hi)); return r; }
__device__ __forceinline__ void route_a(const Frame& F, const u32x2 (&nv)[4], const f32x4 (&gg)[4], const LAS f32x4* RG, const f32x4 rgbv, bf16* hrow, RTok& t) {
    float s = 0.f;
#pragma unroll
    for (int j = 0; j < 4; ++j) { t.v[j] = bf4(nv[j]); s += t.v[j].x * t.v[j].x + t.v[j].y * t.v[j].y + t.v[j].z * t.v[j].z + t.v[j].w * t.v[j].w; }
    s = wave_sum(s, F.lane);
    const float r = rsqrtf(s * (1.0f / DM) + EPS);
    float lg[4] = {0.f, 0.f, 0.f, 0.f};
#pragma unroll
    for (int j = 0; j < 4; ++j) {
        t.v[j].x = t.v[j].x * r * gg[j].x; t.v[j].y = t.v[j].y * r * gg[j].y; t.v[j].z = t.v[j].z * r * gg[j].z; t.v[j].w = t.v[j].w * r * gg[j].w;
        u32x2 o; o.x = cvtpk_rne(t.v[j].x, t.v[j].y); o.y = cvtpk_rne(t.v[j].z, t.v[j].w);
        *(u32x2*)(hrow + (F.lane + 64 * j) * 4) = o;
        const f32x4 w0 = RG[(j * 4 + 0) * 64 + F.lane], w1 = RG[(j * 4 + 1) * 64 + F.lane], w2 = RG[(j * 4 + 2) * 64 + F.lane], w3 = RG[(j * 4 + 3) * 64 + F.lane];
        lg[0] += t.v[j].x * w0.x + t.v[j].y * w1.x + t.v[j].z * w2.x + t.v[j].w * w3.x;
        lg[1] += t.v[j].x * w0.y + t.v[j].y * w1.y + t.v[j].z * w2.y + t.v[j].w * w3.y;
        lg[2] += t.v[j].x * w0.z + t.v[j].y * w1.z + t.v[j].z * w2.z + t.v[j].w * w3.z;
        lg[3] += t.v[j].x * w0.w + t.v[j].y * w1.w + t.v[j].z * w2.w + t.v[j].w * w3.w;
    }
    lg[0] = wave_sum(lg[0], F.lane) + rgbv.x; lg[1] = wave_sum(lg[1], F.lane) + rgbv.y; lg[2] = wave_sum(lg[2], F.lane) + rgbv.z; lg[3] = wave_sum(lg[3], F.lane) + rgbv.w;
    int gi = 0; float gm = lg[0];
#pragma unroll
    for (int o = 1; o < 4; ++o) if (lg[o] > gm) { gm = lg[o]; gi = o; }
    float gs = 0.f;
#pragma unroll
    for (int o = 0; o < 4; ++o) gs += __expf(lg[o] - gm);
    t.gi = gi; t.gval = 1.0f / gs;
}
__device__ __forceinline__ void route_b(const Frame& F, const RTok& t, const LAS f32x4* RE, const float* reb, unsigned& ea, unsigned& eb, float& wa_, float& wb_) {
    const LAS f32x4* we = RE + t.gi * 2048;
    float le[8] = {0.f, 0.f, 0.f, 0.f, 0.f, 0.f, 0.f, 0.f};
#pragma unroll
    for (int j = 0; j < 4; ++j) {
#pragma unroll
        for (int c = 0; c < 4; ++c) {
            const float hv = t.v[j][c];
            const f32x4 wa = we[((j * 4 + c) * 2 + 0) * 64 + F.lane], wb = we[((j * 4 + c) * 2 + 1) * 64 + F.lane];
            le[0] += hv * wa.x; le[1] += hv * wa.y; le[2] += hv * wa.z; le[3] += hv * wa.w;
            le[4] += hv * wb.x; le[5] += hv * wb.y; le[6] += hv * wb.z; le[7] += hv * wb.w;
        }
    }
    const f32x4 b0 = *(const f32x4*)(reb + t.gi * 8), b1 = *(const f32x4*)(reb + t.gi * 8 + 4);
    le[0] = wave_sum(le[0], F.lane) + b0.x; le[1] = wave_sum(le[1], F.lane) + b0.y; le[2] = wave_sum(le[2], F.lane) + b0.z; le[3] = wave_sum(le[3], F.lane) + b0.w;
    le[4] = wave_sum(le[4], F.lane) + b1.x; le[5] = wave_sum(le[5], F.lane) + b1.y; le[6] = wave_sum(le[6], F.lane) + b1.z; le[7] = wave_sum(le[7], F.lane) + b1.w;
    int e1 = 0; float m1 = le[0];
#pragma unroll
    for (int e = 1; e < 8; ++e) if (le[e] > m1) { m1 = le[e]; e1 = e; }
    int e2 = -1; float m2 = -3.0e38f;
#pragma unroll
    for (int e = 0; e < 8; ++e) if (e != e1 && le[e] > m2) { m2 = le[e]; e2 = e; }
    const float p2 = __expf(m2 - m1), inv = 1.0f / (1.0f + p2);
    ea = (unsigned)(t.gi * 8 + e1); eb = (unsigned)(t.gi * 8 + e2); wa_ = t.gval * inv; wb_ = t.gval * p2 * inv;
}
__device__ __forceinline__ void ph_norm_route(const Frame& F, const bf16* x, const float* g, const float* rgw, const float* rgb, const float* rew, const float* reb, bf16* hn,
                                              unsigned* gcnt, unsigned* list, float* listw) {
    LAS f32x4* RG = (LAS f32x4*)F.lds; LAS f32x4* RE = RG + 1024;
    LAS unsigned* cnt_l = (LAS unsigned*)(F.lds + 147456); LAS unsigned* base_l = cnt_l + 32; LAS unsigned* ent = cnt_l + 64;
    for (int d = F.tid; d < 1024; d += NTHR) { const int ln = d & 63, jc = d >> 6, row = (ln + 64 * (jc >> 2)) * 4 + (jc & 3); RG[d] = ((const f32x4*)rgw)[row]; }
    { f32x4 t[16];
#pragma unroll
      for (int k = 0; k < 16; ++k) { const int d = F.tid + k * NTHR, ln = d & 63, q = d >> 6, half = q & 1, c = (q >> 1) & 3, j = (q >> 3) & 3, gi = q >> 5, row = (ln + 64 * j) * 4 + c;
          t[k] = ((const f32x4*)rew)[((size_t)gi * DM + row) * 2 + half]; }
#pragma unroll
      for (int k = 0; k < 16; ++k) RE[F.tid + k * NTHR] = t[k]; }
    f32x4 gg[4];
#pragma unroll
    for (int j = 0; j < 4; ++j) gg[j] = ((const f32x4*)g)[F.lane + 64 * j];
    const f32x4 rgbv = *(const f32x4*)rgb;
    __syncthreads();
    for (int row0 = F.blk * 128; row0 < T; row0 += F.G * 128) {
        if (F.tid < 32) cnt_l[F.tid] = 0u;
        __syncthreads();
        const int rbase = row0 + F.wave * 16;
        u32x2 na[4], nb[4];
#pragma unroll
        for (int j = 0; j < 4; ++j) { na[j] = ((const u32x2*)(x + (size_t)rbase * DM))[F.lane + 64 * j]; nb[j] = ((const u32x2*)(x + (size_t)(rbase + 1) * DM))[F.lane + 64 * j]; }
        for (int kk = 0; kk < 16; kk += 2) {
            const int row = rbase + kk;
            u32x2 ca[4], cb[4];
#pragma unroll
            for (int j = 0; j < 4; ++j) { ca[j] = na[j]; cb[j] = nb[j]; }
            if (kk < 14) {
#pragma unroll
                for (int j = 0; j < 4; ++j) { na[j] = ((const u32x2*)(x + (size_t)(row + 2) * DM))[F.lane + 64 * j]; nb[j] = ((const u32x2*)(x + (size_t)(row + 3) * DM))[F.lane + 64 * j]; } }
            RTok ta, tb;
            route_a(F, ca, gg, RG, rgbv, hn + (size_t)row * DM, ta);
            route_a(F, cb, gg, RG, rgbv, hn + (size_t)(row + 1) * DM, tb);
            unsigned ea0, eb0, ea1, eb1; float wa0, wb0, wa1, wb1;
            route_b(F, ta, RE, reb, ea0, eb0, wa0, wb0);
            route_b(F, tb, RE, reb, ea1, eb1, wa1, wb1);
            if (F.lane == 0) {
                const unsigned pa0 = __hip_atomic_fetch_add(cnt_l + ea0, 1u, __ATOMIC_RELAXED, __HIP_MEMORY_SCOPE_WORKGROUP);
                const unsigned pb0 = __hip_atomic_fetch_add(cnt_l + eb0, 1u, __ATOMIC_RELAXED, __HIP_MEMORY_SCOPE_WORKGROUP);
                const unsigned pa1 = __hip_atomic_fetch_add(cnt_l + ea1, 1u, __ATOMIC_RELAXED, __HIP_MEMORY_SCOPE_WORKGROUP);
                const unsigned pb1 = __hip_atomic_fetch_add(cnt_l + eb1, 1u, __ATOMIC_RELAXED, __HIP_MEMORY_SCOPE_WORKGROUP);
                LAS unsigned* en = ent + (F.wave * 16 + kk) * 6;
                en[0] = ea0; en[1] = eb0; en[2] = pa0; en[3] = pb0; en[4] = __float_as_uint(wa0); en[5] = __float_as_uint(wb0);
                en[6] = ea1; en[7] = eb1; en[8] = pa1; en[9] = pb1; en[10] = __float_as_uint(wa1); en[11] = __float_as_uint(wb1);
            }
        }
        __syncthreads();
        if (F.tid < 32) base_l[F.tid] = __hip_atomic_fetch_add(gcnt + F.tid * 64, cnt_l[F.tid], __ATOMIC_RELAXED, __HIP_MEMORY_SCOPE_AGENT);
        __syncthreads();
        if (F.tid < 128) {
            const LAS unsigned* en = ent + F.tid * 6; const unsigned tok = (unsigned)(row0 + F.tid);
            const unsigned ia = en[0] * LCAP + base_l[en[0]] + en[2], ib = en[1] * LCAP + base_l[en[1]] + en[3];
            list[ia] = tok * 2u; listw[ia] = __uint_as_float(en[4]);
            list[ib] = tok * 2u + 1u; listw[ib] = __uint_as_float(en[5]);
        }
        __syncthreads();
    }
}
__device__ __forceinline__ void build_expert_tab(const Frame& F, const unsigned* gcnt, LAS int* tab) {
    if (F.tid < 64) {
        const int c = F.lane < 32 ? (int)__hip_atomic_load(gcnt + F.lane * 64, __ATOMIC_RELAXED, __HIP_MEMORY_SCOPE_AGENT) : 0;
        int tiles = (c + 255) >> 8, incl = tiles;
#pragma unroll
        for (int o = 1; o < 32; o <<= 1) { const int t = __builtin_amdgcn_ds_bpermute((F.lane - o) << 2, incl); if (F.lane >= o) incl += t; }
        if (F.lane < 32) { tab[F.lane + 1] = incl; tab[33 + F.lane] = c; }
        if (F.lane == 0) tab[0] = 0;
    }
    __syncthreads();
}
__device__ __forceinline__ void ph_experts_naive(const Frame& F, const bf16* hn, const unsigned* route, const float* wg, const float* wu, const float* wd, float* x) {
    LAS float* hs = (LAS float*)F.lds;
    LAS float* hd = hs + 1024;
    for (int tok = F.blk; tok < T; tok += F.G) {
        { const unsigned pv = *(const unsigned*)(hn + (size_t)tok * DM + F.tid * 2); hs[F.tid * 2] = __uint_as_float(pv << 16); hs[F.tid * 2 + 1] = __uint_as_float(pv & 0xffff0000u); }
        const u32x4 rt = *(const u32x4*)(route + (size_t)tok * 4);
        __syncthreads();
        {
            const int s = F.tid >> 8, f = F.tid & 255;
            const unsigned e = s ? rt.y : rt.x; const float w = __uint_as_float(s ? rt.w : rt.z);
            const float* pg = wg + (size_t)e * DM * 256 + f; const float* pu = wu + (size_t)e * DM * 256 + f;
            float ga = 0.f, ua = 0.f;
            for (int d = 0; d < DM; ++d) { const float hv = hs[d]; ga += hv * pg[(size_t)d * 256]; ua += hv * pu[(size_t)d * 256]; }
            hd[s * 256 + f] = ga * sigmoidf_(ga) * ua * w;
        }
        __syncthreads();
        for (int dd = F.tid; dd < DM; dd += NTHR) {
            float acc = 0.f;
            const float* p0 = wd + (size_t)rt.x * 256 * DM + dd; const float* p1 = wd + (size_t)rt.y * 256 * DM + dd;
            for (int f = 0; f < 256; ++f) acc += hd[f] * p0[(size_t)f * DM];
            for (int f = 0; f < 256; ++f) acc += hd[256 + f] * p1[(size_t)f * DM];
            x[(size_t)tok * DM + dd] += acc;
        }
        __syncthreads();
    }
}


namespace nsa {
typedef short bf16x8 __attribute__((ext_vector_type(8)));
typedef short s16x4 __attribute__((ext_vector_type(4)));
typedef float f32x16 __attribute__((ext_vector_type(16)));
typedef float f32x2_t __attribute__((ext_vector_type(2)));
typedef __bf16 bf16x2_t __attribute__((ext_vector_type(2)));
constexpr int SLOTB = 8192;
constexpr int L_K = 0, L_V = 3 * SLOTB, L_IMP = 6 * SLOTB, L_BT = L_IMP + 65536, L_WS = L_BT + 4 * 132 * 4, L_RL = L_WS + 8 * 64 * 4, L_SM = L_RL + 4 * 64 * 4, L_RT = L_SM + 64 * 8, L_END = L_RT + 4 * 320 * 4;
static_assert(L_END <= 131072, "nsa LDS map");
constexpr float LOG2E = 1.4426950408889634f;
constexpr float NEG_INF = -__builtin_inff();
#define NSA_SBAR() __builtin_amdgcn_sched_barrier(0)
__device__ __forceinline__ int crow(int r, int hi) { return (r & 3) + 8 * (r >> 2) + 4 * hi; }
__device__ __forceinline__ void glds16(const void* gsrc, unsigned lds_dst) { unsigned keep;
    asm volatile("s_mov_b32 %0, m0\n\ts_mov_b32 m0, %2\n\ts_nop 0\n\tglobal_load_lds_dwordx4 %1, off\n\ts_mov_b32 m0, %0" : "=&s"(keep) : "v"(gsrc), "s"(lds_dst) : "memory"); }
__device__ __forceinline__ unsigned cvtpk(float lo, float hi) { f32x2_t v = {lo, hi}; bf16x2_t b = __builtin_convertvector(v, bf16x2_t); return __builtin_bit_cast(unsigned, b); }
#define NSA_WAIT_BAR(N) asm volatile("s_waitcnt vmcnt(" #N ") lgkmcnt(0)\n\ts_barrier" ::: "memory")
__device__ __forceinline__ void qkt(f32x16& p0, f32x16& p1, const LAS char* kb, const bf16x8 (&qr)[4], const f32x16& cinit) {
#pragma unroll
    for (int d0 = 0; d0 < 4; ++d0) {
        const bf16x8 b0 = *(const LAS bf16x8*)(kb + d0 * 2048);
        const bf16x8 b1 = *(const LAS bf16x8*)(kb + d0 * 2048 + 512);
        if (d0 == 0) { p0 = __builtin_amdgcn_mfma_f32_32x32x16_bf16(b0, qr[0], cinit, 0, 0, 0); p1 = __builtin_amdgcn_mfma_f32_32x32x16_bf16(b1, qr[0], cinit, 0, 0, 0); }
        else { p0 = __builtin_amdgcn_mfma_f32_32x32x16_bf16(b0, qr[d0], p0, 0, 0, 0); p1 = __builtin_amdgcn_mfma_f32_32x32x16_bf16(b1, qr[d0], p1, 0, 0, 0); }
    }
}
__device__ __forceinline__ void pv(f32x16 (&o)[2], int vb, bf16x8 pa0, bf16x8 pa1, bf16x8 pa2, bf16x8 pa3) {
#pragma unroll
    for (int d0 = 0; d0 < 2; ++d0) { s16x4 lo[4], hi[4];
#pragma unroll
        for (int ks = 0; ks < 4; ++ks) {
            asm volatile("ds_read_b64_tr_b16 %0,%1 offset:%c2" : "=&v"(lo[ks]) : "v"(vb), "i"(d0 * 4096 + ks * 1024) : "memory");
            asm volatile("ds_read_b64_tr_b16 %0,%1 offset:%c2" : "=&v"(hi[ks]) : "v"(vb), "i"(d0 * 4096 + ks * 1024 + 512) : "memory"); }
        asm volatile("s_waitcnt lgkmcnt(0)" ::: "memory"); NSA_SBAR();
#define NSA_PK(k) (bf16x8){lo[k][0], lo[k][1], lo[k][2], lo[k][3], hi[k][0], hi[k][1], hi[k][2], hi[k][3]}
        o[d0] = __builtin_amdgcn_mfma_f32_32x32x16_bf16(pa0, NSA_PK(0), o[d0], 0, 0, 0);
        o[d0] = __builtin_amdgcn_mfma_f32_32x32x16_bf16(pa1, NSA_PK(1), o[d0], 0, 0, 0);
        o[d0] = __builtin_amdgcn_mfma_f32_32x32x16_bf16(pa2, NSA_PK(2), o[d0], 0, 0, 0);
        o[d0] = __builtin_amdgcn_mfma_f32_32x32x16_bf16(pa3, NSA_PK(3), o[d0], 0, 0, 0);
#undef NSA_PK
    }
}
typedef short v4i16_t __attribute__((ext_vector_type(4)));
__device__ __forceinline__ s16x4 vtr(const LAS char* p) { return __builtin_bit_cast(s16x4, __builtin_amdgcn_ds_read_tr16_b64_v4i16((LAS v4i16_t*)p)); }
__device__ __forceinline__ void pv2(f32x16 (&o)[2], const LAS char* vp, bf16x8 pa0, bf16x8 pa1, bf16x8 pa2, bf16x8 pa3) {
#pragma unroll
    for (int d0 = 0; d0 < 2; ++d0) {
        s16x4 lo[4], hi[4];
#pragma unroll
        for (int ks = 0; ks < 4; ++ks) { lo[ks] = vtr(vp + d0 * 4096 + ks * 1024); hi[ks] = vtr(vp + d0 * 4096 + ks * 1024 + 512); }
#define NSA_PK(k) (bf16x8){lo[k][0], lo[k][1], lo[k][2], lo[k][3], hi[k][0], hi[k][1], hi[k][2], hi[k][3]}
        o[d0] = __builtin_amdgcn_mfma_f32_32x32x16_bf16(pa0, NSA_PK(0), o[d0], 0, 0, 0);
        o[d0] = __builtin_amdgcn_mfma_f32_32x32x16_bf16(pa1, NSA_PK(1), o[d0], 0, 0, 0);
        o[d0] = __builtin_amdgcn_mfma_f32_32x32x16_bf16(pa2, NSA_PK(2), o[d0], 0, 0, 0);
        o[d0] = __builtin_amdgcn_mfma_f32_32x32x16_bf16(pa3, NSA_PK(3), o[d0], 0, 0, 0);
#undef NSA_PK
    }
}
__device__ __forceinline__ float other_half(float v, int hi) { auto rr = __builtin_amdgcn_permlane32_swap(__float_as_uint(v), __float_as_uint(v), false, false); return __uint_as_float(hi ? rr[0] : rr[1]); }
__device__ __forceinline__ float rowmax(const f32x16& p0, const f32x16& p1, int hi) {
    float a = fmaxf(fmaxf(p0[0], p0[1]), p1[0]), b = fmaxf(fmaxf(p0[2], p0[3]), p1[1]); a = fmaxf(fmaxf(a, p1[2]), p1[3]);
#pragma unroll
    for (int r = 4; r < 16; r += 4) { a = fmaxf(fmaxf(a, p0[r]), p0[r + 1]); b = fmaxf(fmaxf(b, p0[r + 2]), p0[r + 3]); a = fmaxf(fmaxf(a, p1[r]), p1[r + 1]); b = fmaxf(fmaxf(b, p1[r + 2]), p1[r + 3]); }
    const float m = fmaxf(a, b);
    return fmaxf(m, other_half(m, hi));
}
__device__ __forceinline__ void pack_p(const f32x16& p0, const f32x16& p1, bf16x8& a0, bf16x8& a1, bf16x8& a2, bf16x8& a3) {
    u32x4 w0, w1, w2, w3;
    w0 = (u32x4){cvtpk(p0[0], p0[1]), cvtpk(p0[2], p0[3]), cvtpk(p0[4], p0[5]), cvtpk(p0[6], p0[7])};
    w1 = (u32x4){cvtpk(p0[8], p0[9]), cvtpk(p0[10], p0[11]), cvtpk(p0[12], p0[13]), cvtpk(p0[14], p0[15])};
    w2 = (u32x4){cvtpk(p1[0], p1[1]), cvtpk(p1[2], p1[3]), cvtpk(p1[4], p1[5]), cvtpk(p1[6], p1[7])};
    w3 = (u32x4){cvtpk(p1[8], p1[9]), cvtpk(p1[10], p1[11]), cvtpk(p1[12], p1[13]), cvtpk(p1[14], p1[15])};
    a0 = __builtin_bit_cast(bf16x8, w0); a1 = __builtin_bit_cast(bf16x8, w1); a2 = __builtin_bit_cast(bf16x8, w2); a3 = __builtin_bit_cast(bf16x8, w3);
}

struct Ctx {
    LAS char* lds; unsigned lds0; int wid, lane, r32, hi, g, th, qloc;
    const LAS float* bt;
    const LAS float* rt;
    LAS float* wsf;
    const LAS float* wrow;
    int vb0;
    const LAS char* vp0;
    const LAS char* kb0;
};
__device__ __forceinline__ void dma_k(const Ctx& c, const bf16* kbase, int pitch, int slot) { glds16(kbase + (size_t)c.lane * pitch + c.wid * 8, (unsigned)__builtin_amdgcn_readfirstlane(c.lds0 + L_K + slot * SLOTB + c.wid * 1024)); }
__device__ __forceinline__ void dma_v(const Ctx& c, const bf16* vbase, int pitch, int slot) { glds16(vbase + (size_t)(16 * (c.wid & 3) + (c.lane >> 2)) * pitch + (c.wid >> 2) * 32 + (c.lane & 3) * 8, (unsigned)__builtin_amdgcn_readfirstlane(c.lds0 + L_V + slot * SLOTB + c.wid * 1024)); }

__device__ __forceinline__ void cmp_scores(const Ctx& c, int slot, const bf16x8 (&qr)[4], int t0, int kt, f32x16& p0, f32x16& p1) {
    const int dmin = t0 + 32 * c.th - 16 * (64 * kt + 63) - 31;
    const bool special = dmin < 113;
    f32x16 ci; { const float v = special ? 0.f : c.bt[128];
#pragma unroll
        for (int r = 0; r < 16; ++r) ci[r] = v; }
    qkt(p0, p1, c.kb0 + slot * SLOTB, qr, ci);
    if (special) {
        int hi64 = 64 * c.hi; asm volatile("" : "+v"(hi64));
        const int dqh = t0 + c.qloc - 1024 * kt - 31 - hi64;
        float b0[16], b1[16];
#pragma unroll
        for (int r = 0; r < 16; ++r) { const int d0 = dqh - 16 * ((r & 3) + 8 * (r >> 2)), d1 = d0 - 512; b0[r] = c.bt[d0 < 0 ? 0 : (d0 > 128 ? 128 : d0)]; b1[r] = c.bt[d1 < 0 ? 0 : (d1 > 128 ? 128 : d1)]; }
#pragma unroll
        for (int r = 0; r < 16; ++r) {
            const int d0 = dqh - 16 * ((r & 3) + 8 * (r >> 2)), d1 = d0 - 512;
            p0[r] = d0 < 0 ? NEG_INF : p0[r] + b0[r]; p1[r] = d1 < 0 ? NEG_INF : p1[r] + b1[r];
        }
    }
}
template <int MODE>
__device__ __forceinline__ void online_tile(const Ctx& c, int slot, const bf16x8 (&qr)[4], int dq, bool near, bool masked_tile, bool lane_off, float& mhat, float& lsum, f32x16 (&o)[2]) {
    f32x16 ci; { const float v = (near ? 0.f : c.bt[128]) - mhat;
#pragma unroll
        for (int r = 0; r < 16; ++r) ci[r] = v; }
    f32x16 p0, p1;
    qkt(p0, p1, c.kb0 + slot * SLOTB, qr, ci);
    if (near || masked_tile) {
        int hi4 = 4 * c.hi; asm volatile("" : "+v"(hi4));
        const int dqh = dq - hi4;
#pragma unroll
        for (int r = 0; r < 16; ++r) {
            const int d0 = dqh - ((r & 3) + 8 * (r >> 2)), d1 = d0 - 32;
            if (near) { p0[r] += c.bt[d0 < 0 ? 0 : (d0 > 128 ? 128 : d0)]; p1[r] += c.bt[d1 < 0 ? 0 : (d1 > 128 ? 128 : d1)]; }
            if (d0 < 0 || (MODE == 1 && d0 >= 512)) p0[r] = NEG_INF;
            if (d1 < 0 || (MODE == 1 && d1 >= 512)) p1[r] = NEG_INF;
        }
    }
    if (MODE == 0) { if (lane_off) {
#pragma unroll
        for (int r = 0; r < 16; ++r) { p0[r] = NEG_INF; p1[r] = NEG_INF; } } }
    const float rm = rowmax(p0, p1, c.hi);
    if (__any(rm > 8.0f)) {
        const float dl = fmaxf(rm, 0.f); mhat += dl;
#pragma unroll
        for (int r = 0; r < 16; ++r) { p0[r] -= dl; p1[r] -= dl; }
        const float f = __builtin_amdgcn_exp2f(-dl); lsum *= f;
        if (c.hi == 0) c.wsf[c.r32] = f;
        asm volatile("s_waitcnt lgkmcnt(0)" ::: "memory");
#pragma unroll
        for (int r = 0; r < 16; ++r) { const float fr = c.wrow[(r & 3) + 8 * (r >> 2)]; o[0][r] *= fr; o[1][r] *= fr; }
    }
    float sacc = 0.f;
#pragma unroll
    for (int r = 0; r < 16; ++r) { p0[r] = __builtin_amdgcn_exp2f(p0[r]); p1[r] = __builtin_amdgcn_exp2f(p1[r]); sacc += p0[r] + p1[r]; }
    lsum += sacc;
    bf16x8 a0, a1, a2, a3; pack_p(p0, p1, a0, a1, a2, a3);
    pv(o, c.vb0 + slot * SLOTB, a0, a1, a2, a3);
}
struct Pipe { bf16x8 a0, a1, a2, a3; bool have, resc; };
template <int MODE, int SPECIAL  , bool HAVE>
__device__ __forceinline__ void online_step(const Ctx& c, int kslot, int vslot_prev, const bf16x8 (&qr)[4], int dq, bool near, bool lane_off, float& mhat, float& lsum, f32x16 (&o)[2], Pipe& pp) {
    if (pp.resc) {
#pragma unroll
        for (int r = 0; r < 16; ++r) { const float fr = c.wrow[(r & 3) + 8 * (r >> 2)]; o[0][r] *= fr; o[1][r] *= fr; }
    }
    f32x16 ci; { const float v = (MODE == 0 && lane_off) ? NEG_INF : ((SPECIAL == 1 ? 0.f : c.bt[128]) - mhat);
#pragma unroll
        for (int r = 0; r < 16; ++r) ci[r] = v; }
    f32x16 p0, p1;
    qkt(p0, p1, c.kb0 + kslot * SLOTB, qr, ci);
    if (HAVE) pv2(o, c.vp0 + vslot_prev * SLOTB, pp.a0, pp.a1, pp.a2, pp.a3);
    if (SPECIAL == 1) {
        const LAS float* rp = c.rt + (255 - dq + 4 * c.hi);
#pragma unroll
        for (int r = 0; r < 16; ++r) { p0[r] += rp[(r & 3) + 8 * (r >> 2)]; p1[r] += rp[32 + (r & 3) + 8 * (r >> 2)]; }
    }
    if (SPECIAL == 2) {
        int hi4 = 4 * c.hi; asm volatile("" : "+v"(hi4));
        const int dqh = dq - hi4;
#pragma unroll
        for (int r = 0; r < 16; ++r) {
            const int d0 = dqh - ((r & 3) + 8 * (r >> 2)), d1 = d0 - 32;
            if (d0 < 0 || (MODE == 1 && d0 >= 512)) p0[r] = NEG_INF;
            if (d1 < 0 || (MODE == 1 && d1 >= 512)) p1[r] = NEG_INF;
        }
    }
    const float rm = rowmax(p0, p1, c.hi);
    const bool mv = __any(rm > 8.0f);
    if (mv) {
        const float dl = fmaxf(rm, 0.f); mhat += dl;
#pragma unroll
        for (int r = 0; r < 16; ++r) { p0[r] -= dl; p1[r] -= dl; }
        const float f = __builtin_amdgcn_exp2f(-dl); lsum *= f;
        c.wsf[c.r32] = f;
    }
    pp.resc = mv;
    float sacc = 0.f;
#pragma unroll
    for (int r = 0; r < 16; ++r) { p0[r] = __builtin_amdgcn_exp2f(p0[r]); p1[r] = __builtin_amdgcn_exp2f(p1[r]); sacc += p0[r] + p1[r]; }
    lsum += sacc;
    pack_p(p0, p1, pp.a0, pp.a1, pp.a2, pp.a3); pp.have = true;
}
__device__ __forceinline__ void online_drain(const Ctx& c, int vslot_prev, f32x16 (&o)[2], Pipe& pp) {
    if (pp.resc) {
#pragma unroll
        for (int r = 0; r < 16; ++r) { const float fr = c.wrow[(r & 3) + 8 * (r >> 2)]; o[0][r] *= fr; o[1][r] *= fr; }
    }
    if (pp.have) pv2(o, c.vp0 + vslot_prev * SLOTB, pp.a0, pp.a1, pp.a2, pp.a3);
}
__device__ __forceinline__ void add_scaled(const Ctx& c, f32x16 (&oacc)[2], const f32x16 (&o)[2], float s) {
    if (c.hi == 0) c.wsf[32 + c.r32] = s;
    asm volatile("s_waitcnt lgkmcnt(0)" ::: "memory");
#pragma unroll
    for (int r = 0; r < 16; ++r) { const float f = c.wrow[32 + (r & 3) + 8 * (r >> 2)]; oacc[0][r] += o[0][r] * f; oacc[1][r] += o[1][r] * f; }
    asm volatile("s_waitcnt lgkmcnt(0)" ::: "memory");
}

__device__ __forceinline__ void add_scaled_park(const Ctx& c, LAS float* park, const f32x16 (&o)[2], float s) {
    if (c.hi == 0) c.wsf[32 + c.r32] = s;
    asm volatile("s_waitcnt lgkmcnt(0)" ::: "memory");
#pragma unroll
    for (int r = 0; r < 16; ++r) { const float f = c.wrow[32 + (r & 3) + 8 * (r >> 2)]; park[r * 64] += o[0][r] * f; park[(16 + r) * 64] += o[1][r] * f; }
    asm volatile("s_waitcnt lgkmcnt(0)" ::: "memory");
}
__device__ __forceinline__ void unit(LAS char* lds, int tid, int b, int hkv, int jt, const bf16* Z, const bf16* KCm, const bf16* VCm, const float* rel_bias, bf16* YC, bool fill_table) {
    Ctx c; c.lds = lds; c.lds0 = (unsigned)(uintptr_t)lds; c.wid = __builtin_amdgcn_readfirstlane(tid >> 6); c.lane = tid & 63; c.r32 = c.lane & 31; c.hi = c.lane >> 5;
    c.g = c.wid & 3; c.th = c.wid >> 2; c.qloc = 32 * c.th + c.r32;
    c.bt = (const LAS float*)(lds + L_BT) + c.g * 132; c.rt = (const LAS float*)(lds + L_RT) + c.g * 320; c.wsf = (LAS float*)(lds + L_WS) + c.wid * 64; c.wrow = c.wsf + 4 * c.hi;
    c.vb0 = (int)(c.lds0 + L_V) + ((c.lane >> 4) & 1) * 32 + (c.lane & 3) * 8 + (4 * c.hi + ((c.lane & 15) >> 2)) * 64;
    c.kb0 = (const LAS char*)(lds + L_K) + c.hi * 1024 + c.r32 * 16;
    c.vp0 = (const LAS char*)(lds + L_V) + ((c.lane >> 4) & 1) * 32 + (c.lane & 3) * 8 + (4 * c.hi + ((c.lane & 15) >> 2)) * 64;
    const int t0 = 64 * jt;
    const bf16* Zb = Z + (size_t)b * SEQ * ZP;
    const size_t qrow = (size_t)b * SEQ + t0 + c.qloc;
    if (fill_table) for (int i = tid; i < 4 * 129; i += NTHR) { const int gg = i / 129, d = i % 129; ((LAS float*)(lds + L_BT))[gg * 132 + d] = rel_bias[t5_bucket(d) * 8 + hkv * 4 + gg] * LOG2E; }
    if (fill_table) for (int i = tid; i < 4 * 320; i += NTHR) { const int gg = i / 320, d = 255 - (i % 320); ((LAS float*)(lds + L_RT))[i] = d < 0 ? NEG_INF : rel_bias[t5_bucket(d > 128 ? 128 : d) * 8 + hkv * 4 + gg] * LOG2E; }
    bf16x8 qr[4];
#pragma unroll
    for (int d0 = 0; d0 < 4; ++d0) qr[d0] = *(const bf16x8*)(Z + qrow * ZP + ZC_Q + hkv * 256 + c.g * 64 + d0 * 16 + c.hi * 8);
    const bf16* gp = Z + qrow * ZP + ZC_G + hkv * 12 + c.g * 3;
    const float gate0 = sigmoidf_(bf2f(gp[0])), gate1 = sigmoidf_(bf2f(gp[1])), gate2 = sigmoidf_(bf2f(gp[2]));
    f32x16 oacc[2];
#pragma unroll
    for (int r = 0; r < 16; ++r) { oacc[0][r] = 0.f; oacc[1][r] = 0.f; }

    const int nct = (4 * jt + 2) / 64 + 1;
    const bf16* kcb = KCm + (size_t)b * NCMPP * 128 + hkv * 64; const bf16* vcb = VCm + (size_t)b * NCMPP * 128 + hkv * 64;
    const bf16* skb = Zb + ZC_KV + 256 + hkv * 64; const bf16* svb = Zb + ZC_KV + 384 + hkv * 64;
    {
        float mhat = 0.f, lsum = 0.f, carry = 0.f; f32x16 o[2];
#pragma unroll
        for (int r = 0; r < 16; ++r) { o[0][r] = 0.f; o[1][r] = 0.f; }
        LAS float* impw = (LAS float*)(lds + L_IMP) + (c.g * 64 + c.qloc) * 64;
        dma_k(c, kcb, 128, 0); dma_v(c, vcb, 128, 0); if (nct > 1) { dma_k(c, kcb + 64 * 128, 128, 1); dma_v(c, vcb + 64 * 128, 128, 1); }
        for (int i = 0; i < nct; ++i) {
            if (i + 1 < nct) NSA_WAIT_BAR(2); else NSA_WAIT_BAR(0);
            if (i + 2 < nct) { dma_k(c, kcb + (size_t)(i + 2) * 64 * 128, 128, (i + 2) % 3); dma_v(c, vcb + (size_t)(i + 2) * 64 * 128, 128, (i + 2) % 3); }
            f32x16 p0, p1; cmp_scores(c, i % 3, qr, t0, i, p0, p1);
            const float rm = rowmax(p0, p1, c.hi) - mhat;
            if (__any(rm > 8.0f)) {
                const float dl = fmaxf(rm, 0.f); mhat += dl;
                const float f = __builtin_amdgcn_exp2f(-dl); lsum *= f; carry *= f;
                c.wsf[c.r32] = f;
                asm volatile("s_waitcnt lgkmcnt(0)" ::: "memory");
#pragma unroll
                for (int r = 0; r < 16; ++r) { const float fr = c.wrow[(r & 3) + 8 * (r >> 2)]; o[0][r] *= fr; o[1][r] *= fr; }
                for (int e = c.hi; e < 16 * i; e += 2) impw[e] *= f;
            }
            float sacc = 0.f;
#pragma unroll
            for (int r = 0; r < 16; ++r) { p0[r] = __builtin_amdgcn_exp2f(p0[r] - mhat); p1[r] = __builtin_amdgcn_exp2f(p1[r] - mhat); sacc += p0[r] + p1[r]; }
            lsum += sacc;
            float o3[8];
#pragma unroll
            for (int k = 0; k < 4; ++k) { o3[k] = other_half(p0[4 * k + 3], c.hi); o3[4 + k] = other_half(p1[4 * k + 3], c.hi); }
#pragma unroll
            for (int idx = 0; idx < 8; ++idx) {
                const int X = idx >> 2, k = idx & 3;
                const f32x16& p = X ? p1 : p0;
                const float cin = c.hi ? o3[idx] : (idx ? o3[idx - 1] : carry);
                impw[16 * i + 8 * X + 2 * k + c.hi] = p[4 * k] + p[4 * k + 1] + p[4 * k + 2] + 0.5f * p[4 * k + 3] + 0.5f * cin;
            }
            carry = o3[7];
            bf16x8 a0, a1, a2, a3; pack_p(p0, p1, a0, a1, a2, a3);
            pv(o, c.vb0 + (i % 3) * SLOTB, a0, a1, a2, a3);
        }
        const float lt = lsum + other_half(lsum, c.hi);
        const float rl = lt > 0.f ? 1.0f / lt : 0.f;
        if (c.hi == 0) ((LAS float*)(lds + L_RL))[c.g * 64 + c.qloc] = rl;
        add_scaled(c, oacc, o, rl * gate0);
        NSA_WAIT_BAR(0);
    }
    { const int nt = jt + 1; dma_k(c, skb, ZP, 0); if (nt > 1) dma_k(c, skb + (size_t)64 * ZP, ZP, 1); dma_v(c, svb, ZP, 0); }
    for (int k = 0; k < 8; ++k) {
        const int tok = c.wid * 8 + k;
        float v = 0.f;
#pragma unroll
        for (int gg = 0; gg < 4; ++gg) v += ((const LAS float*)(lds + L_IMP))[(gg * 64 + tok) * 64 + c.lane] * ((const LAS float*)(lds + L_RL))[gg * 64 + tok];
        const bool forced = (c.lane == 0) || (c.lane <= jt && c.lane > jt - 2), future = c.lane > jt;
        v = forced ? 1e9f : (future ? -1e9f : v);
        int rank = 0;
#pragma unroll
        for (int jj = 0; jj < 64; ++jj) { const float vj = __builtin_bit_cast(float, __builtin_amdgcn_readlane(__builtin_bit_cast(int, v), jj)); rank += ((vj > v) || (vj == v && jj < c.lane)) ? 1 : 0; }
        const unsigned long long msk = __ballot(rank < 16 && !future);
        if (c.lane == 0) ((LAS unsigned long long*)(lds + L_SM))[tok] = msk;
    }
    asm volatile("s_waitcnt lgkmcnt(0)\n\ts_barrier" ::: "memory");
    const unsigned long long mymask = ((const LAS unsigned long long*)(lds + L_SM))[c.qloc];
    LAS float* park = (LAS float*)(lds + L_IMP) + c.wid * 2048 + c.lane;
#pragma unroll
    for (int r = 0; r < 16; ++r) { park[r * 64] = oacc[0][r]; park[(16 + r) * 64] = oacc[1][r]; }
    {
        const bf16* kb = skb; const bf16* vb = svb;
        const int nt = jt + 1;
        float mhat = 0.f, lsum = 0.f; f32x16 o[2]; Pipe pp; pp.have = false; pp.resc = false;
#pragma unroll
        for (int r = 0; r < 16; ++r) { o[0][r] = 0.f; o[1][r] = 0.f; }
#define NSA_ITER_HEAD(i) do { if ((i) + 1 < nt) NSA_WAIT_BAR(2); else NSA_WAIT_BAR(1); \
            if ((i) + 2 < nt) dma_k(c, kb + (size_t)((i) + 2) * 64 * ZP, ZP, ((i) + 2) % 3); \
            if ((i) + 1 < nt) dma_v(c, vb + (size_t)((i) + 1) * 64 * ZP, ZP, ((i) + 1) % 3); } while (0)
        {
            NSA_ITER_HEAD(0);
            if (jt <= 2) online_step<0, 1, false>(c, 0, 2, qr, 64 * jt + c.qloc, true, !(mymask & 1ull), mhat, lsum, o, pp); else online_step<0, 0, false>(c, 0, 2, qr, 0, false, !(mymask & 1ull), mhat, lsum, o, pp); }
        const int nfar = jt - 2;
        int i = 1;
        for (; i < nfar; ++i) { NSA_ITER_HEAD(i);
            online_step<0, 0, true>(c, i % 3, (i + 2) % 3, qr, 0, false, !((mymask >> i) & 1ull), mhat, lsum, o, pp); }
        for (; i < nt; ++i) { NSA_ITER_HEAD(i);
            online_step<0, 1, true>(c, i % 3, (i + 2) % 3, qr, 64 * (jt - i) + c.qloc, true, !((mymask >> i) & 1ull), mhat, lsum, o, pp); }
        NSA_WAIT_BAR(0);
        online_drain(c, (nt - 1) % 3, o, pp);
        const float lt = lsum + other_half(lsum, c.hi);
        add_scaled_park(c, park, o, (lt > 0.f ? 1.0f / lt : 0.f) * gate1);
        NSA_WAIT_BAR(0);
    }
    {
        const int j0 = jt > 8 ? jt - 8 : 0, nt = jt - j0 + 1;
        const bf16* kb = Zb + (size_t)j0 * 64 * ZP + ZC_KV + 512 + hkv * 64; const bf16* vb = Zb + (size_t)j0 * 64 * ZP + ZC_KV + 640 + hkv * 64;
        float mhat = 0.f, lsum = 0.f; f32x16 o[2]; Pipe pp; pp.have = false; pp.resc = false;
#pragma unroll
        for (int r = 0; r < 16; ++r) { o[0][r] = 0.f; o[1][r] = 0.f; }
        dma_k(c, kb, ZP, 0); if (nt > 1) dma_k(c, kb + (size_t)64 * ZP, ZP, 1); dma_v(c, vb, ZP, 0);
        {
            NSA_ITER_HEAD(0);
            if (j0 >= jt - 2) online_step<1, 1, false>(c, 0, 2, qr, 64 * (jt - j0) + c.qloc, true, false, mhat, lsum, o, pp); else online_step<1, 2, false>(c, 0, 2, qr, 64 * (jt - j0) + c.qloc, false, false, mhat, lsum, o, pp); }
        int i = 1;
        for (; j0 + i < jt - 2; ++i) { NSA_ITER_HEAD(i);
            online_step<1, 0, true>(c, i % 3, (i + 2) % 3, qr, 0, false, false, mhat, lsum, o, pp); }
        for (; i < nt; ++i) { NSA_ITER_HEAD(i); const int j = j0 + i;
            online_step<1, 1, true>(c, i % 3, (i + 2) % 3, qr, 64 * (jt - j) + c.qloc, true, false, mhat, lsum, o, pp); }
#undef NSA_ITER_HEAD
        NSA_WAIT_BAR(0);
        online_drain(c, (nt - 1) % 3, o, pp);
        const float lt = lsum + other_half(lsum, c.hi);
        add_scaled_park(c, park, o, (lt > 0.f ? 1.0f / lt : 0.f) * gate2);
    }
    {
        bf16* yb = YC + ((size_t)b * SEQ + t0 + 32 * c.th + 4 * c.hi) * DM + D_SSM + hkv * 256 + c.g * 64 + c.r32;
#pragma unroll
        for (int r = 0; r < 16; ++r) { bf16* yr = yb + (size_t)((r & 3) + 8 * (r >> 2)) * DM; yr[0] = (bf16)f2bf(park[r * 64]); yr[32] = (bf16)f2bf(park[(16 + r) * 64]); }
    }
    asm volatile("s_waitcnt vmcnt(0)" ::: "memory");
    NSA_WAIT_BAR(0);
}
#undef NSA_SBAR
#undef NSA_WAIT_BAR
}


__device__ __forceinline__ void ssm_precompute(const Frame& F, const __attribute__((address_space(4))) Args* args, unsigned char* ws, int item) {
    const int layer = item >> 5, g = item & 31, lg = layer * 32 + g;
    LAS float* L = (LAS float*)F.lds;
    LAS float* lkr = L; LAS float* lki = L + 17 * 64; LAS float* bbr = L + 2 * 17 * 64; LAS float* bbi = bbr + 1024; LAS float* ccr = bbi + 1024; LAS float* cci = ccr + 1024;
    LAS float* wk = cci + 1024; LAS float* dd = wk + 4096;
    const float* a_re = args->in[6] + lg * 64; const float* a_im = args->in[7] + lg * 64;
    const float dt = expf(args->in[13][lg]);
    for (int i = F.tid; i < 17 * 64; i += NTHR) { const int k = i >> 6, p = i & 63; const float er = expf(a_re[p] * dt * (float)k), ang = a_im[p] * dt * (float)k; lkr[i] = er * cosf(ang); lki[i] = er * sinf(ang); }
    for (int i = F.tid; i < 1024; i += NTHR) {
        { const int p = i >> 4, h = i & 15; const float are = a_re[p], aim = a_im[p];
          const float er = expf(are * dt), lbr = er * cosf(aim * dt), lbi = er * sinf(aim * dt);
          const float xx = lbr - 1.0f, yy = lbi, den = are * are + aim * aim, fr = (xx * are + yy * aim) / den, fi = (yy * are - xx * aim) / den;
          const float br = args->in[8][((size_t)lg * 64 + p) * 16 + h], bi = args->in[9][((size_t)lg * 64 + p) * 16 + h];
          bbr[i] = fr * br - fi * bi; bbi[i] = fr * bi + fi * br; }
        ccr[i] = args->in[10][(size_t)lg * 1024 + i]; cci[i] = args->in[11][(size_t)lg * 1024 + i];
    }
    if (F.tid < 16) dd[F.tid] = args->in[12][lg * 16 + F.tid];
    __syncthreads();
    for (int i = F.tid; i < 4096; i += NTHR) { const int k = i >> 8, ho = (i >> 4) & 15, hi = i & 15; float acc = 0.f;
        for (int p = 0; p < 64; ++p) { const float cr = ccr[ho * 64 + p], ci = cci[ho * 64 + p], lr = lkr[k * 64 + p], li = lki[k * 64 + p];
            const float tr = cr * lr - ci * li, ti = cr * li + ci * lr; acc += tr * bbr[p * 16 + hi] - ti * bbi[p * 16 + hi]; }
        wk[i] = acc + ((k == 0 && ho == hi) ? dd[ho] : 0.f); }
    __syncthreads();
    bf16* B2 = (bf16*)(ws + WS_BT2) + (size_t)lg * 256 * 384;
    for (int i = F.tid; i < 256 * 384; i += NTHR) { const int n = i / 384, kk = i % 384, t = n >> 4, ho = n & 15; float v;
        if (kk < 256) { const int sidx = kk >> 4, hi = kk & 15; v = sidx <= t ? wk[((t - sidx) << 8) + ho * 16 + hi] : 0.f; }
        else { const int j = kk - 256, p = j & 63; const float cr = ccr[ho * 64 + p], ci = cci[ho * 64 + p], lr = lkr[(t + 1) * 64 + p], li = lki[(t + 1) * 64 + p];
            v = j < 64 ? (cr * lr - ci * li) : -(cr * li + ci * lr); }
        B2[i] = (bf16)f2bf(v); }
    bf16* B1 = (bf16*)(ws + WS_BT1) + (size_t)lg * 256 * 256;
    for (int i = F.tid; i < 65536; i += NTHR) { const int j = i >> 8, kk = i & 255, sidx = kk >> 4, hi = kk & 15; float v = 0.f;
        if (j < 128) { const int p = j & 63; const float lr = lkr[(15 - sidx) * 64 + p], li = lki[(15 - sidx) * 64 + p], br = bbr[p * 16 + hi], bi = bbi[p * 16 + hi];
            v = j < 64 ? (lr * br - li * bi) : (lr * bi + li * br); }
        B1[i] = (bf16)f2bf(v); }
    __syncthreads();
}
__device__ __forceinline__ void ssm_carry_item(int b, int g, const float* a_re, const float* a_im, const float* log_dt, const float* XL, bf16* U, int lane) {
    const float dt16 = 16.0f * expf(log_dt[g]);
    const float er = expf(a_re[g * 64 + lane] * dt16), ang = a_im[g * 64 + lane] * dt16, lr = er * cosf(ang), li = er * sinf(ang);
    float xr = 0.f, xi = 0.f;
    const float* __restrict__ xl = XL + ((size_t)g * 2048 + b * 256) * 128 + lane;
    bf16* __restrict__ up = U + ((size_t)g * 2048 + b * 256) * 512 + 256 + lane;
    float ar[16], ai[16], nr_[16], ni_[16];
#pragma unroll
    for (int k = 0; k < 16; ++k) { ar[k] = xl[(size_t)k * 128]; ai[k] = xl[(size_t)k * 128 + 64]; }
    for (int cb = 0; cb < 16; ++cb) {
        const int cn = cb < 15 ? (cb + 1) * 16 : cb * 16;
#pragma unroll
        for (int k = 0; k < 16; ++k) { nr_[k] = xl[(size_t)(cn + k) * 128]; ni_[k] = xl[(size_t)(cn + k) * 128 + 64]; }
#pragma unroll
        for (int k = 0; k < 16; ++k) {
            const int c = cb * 16 + k;
            up[(size_t)c * 512] = (bf16)f2bf(xr); up[(size_t)c * 512 + 64] = (bf16)f2bf(xi);
            const float nr = lr * xr - li * xi + ar[k], ni = lr * xi + li * xr + ai[k];
            xr = nr; xi = ni;
        }
#pragma unroll
        for (int k = 0; k < 16; ++k) { ar[k] = nr_[k]; ai[k] = ni_[k]; }
    }
}


__device__ __forceinline__ void compress_stage2(const Frame& F, int eb, int pm, const bf16* HC, const bf16* W2T, bf16* KCo, bf16* VCo) {
    typedef short bf16x8_ __attribute__((ext_vector_type(8))); typedef float f32x16_ __attribute__((ext_vector_type(16)));
    const int r32 = F.lane & 31, hi = F.lane >> 5, rg0 = pm * 256 + F.wave * 32;
    const bf16* ar = HC + ((size_t)eb * 4096 + rg0 + r32) * 64 + 8 * hi; const bf16* br = W2T + (size_t)eb * 4096 + (size_t)r32 * 64 + 8 * hi;
    bf16x8_ a[4], b0[4], b1[4];
#pragma unroll
    for (int ks = 0; ks < 4; ++ks) { a[ks] = *(const bf16x8_*)(ar + ks * 16); b0[ks] = *(const bf16x8_*)(br + ks * 16); b1[ks] = *(const bf16x8_*)(br + 32 * 64 + ks * 16); }
    f32x16_ d0, d1;
#pragma unroll
    for (int r = 0; r < 16; ++r) { d0[r] = 0.f; d1[r] = 0.f; }
#pragma unroll
    for (int ks = 0; ks < 4; ++ks) { d0 = __builtin_amdgcn_mfma_f32_32x32x16_bf16(a[ks], b0[ks], d0, 0, 0, 0); d1 = __builtin_amdgcn_mfma_f32_32x32x16_bf16(a[ks], b1[ks], d1, 0, 0, 0); }
    bf16* dstb = (eb ? VCo : KCo) + (size_t)(rg0 + 4 * hi) * 64 + r32;
#pragma unroll
    for (int r = 0; r < 16; ++r) { const int ro = (r & 3) + 8 * (r >> 2); const bool pad = (((rg0 + 4 * hi + ro) >> 1) & 255) == NCMP;
        dstb[(size_t)ro * 64] = pad ? (bf16)0 : (bf16)f2bf(d0[r]); dstb[(size_t)ro * 64 + 32] = pad ? (bf16)0 : (bf16)f2bf(d1[r]); }
}

__device__ __forceinline__ void titem_load(const float* W, int N, int k0, int n0, int lane, float (&t)[32]) {
#pragma unroll
    for (int i = 0; i < 32; ++i) t[i] = __builtin_nontemporal_load(W + (size_t)(k0 + 2 * i + (lane >> 5)) * N + n0 + (lane & 31));
}
__device__ __forceinline__ void titem_finish(const float (&t)[32], int K, bf16* WT, int k0, int drow0, LAS float* scr, int lane, float scale) {
#pragma unroll
    for (int i = 0; i < 32; ++i) scr[(2 * i + (lane >> 5)) * 33 + (lane & 31)] = t[i];
    asm volatile("s_waitcnt lgkmcnt(0)" ::: "memory");
    const int c = lane & 7;
#pragma unroll
    for (int j = 0; j < 4; ++j) { const int n = (lane >> 3) + 8 * j; const LAS float* sp = scr + (8 * c) * 33 + n;
        u32x4 o; o.x = pk2(sp[0 * 33] * scale, sp[1 * 33] * scale); o.y = pk2(sp[2 * 33] * scale, sp[3 * 33] * scale); o.z = pk2(sp[4 * 33] * scale, sp[5 * 33] * scale); o.w = pk2(sp[6 * 33] * scale, sp[7 * 33] * scale);
        *(u32x4*)(WT + (size_t)(drow0 + n) * K + k0 + 8 * c) = o; }
    asm volatile("s_waitcnt lgkmcnt(0)" ::: "memory");
}
__device__ __forceinline__ void transpose_item(const float* W, int K, int N, bf16* WT, int k0, int n0, int drow0, LAS float* scr, int lane, float scale = 1.0f) {
    float t[32]; titem_load(W, N, k0, n0, lane, t); titem_finish(t, K, WT, k0, drow0, scr, lane, scale);
}
struct XItem { const float* W; bf16* WT; int K, N, k0, n0, drow0; };
__device__ __forceinline__ XItem xitem(const __attribute__((address_space(4))) Args* args, unsigned char* ws, int it) {
    XItem x; const int le = it / 384, r = it % 384;
    if (r < 256) { const int isup = r >> 7, q = r & 127, nb = q & 7, kb = q >> 3, n0 = 32 * nb;
        x.W = args->in[isup ? 24 : 23] + (size_t)le * DM * 256; x.K = DM; x.N = 256; x.WT = (bf16*)(ws + WS_WGU) + (size_t)le * 512 * DM; x.k0 = 64 * kb; x.n0 = n0; x.drow0 = 256 * (n0 >> 7) + 128 * isup + (n0 & 127); }
    else { const int q = r - 256, nb = q & 31, kb = q >> 5;
        x.W = args->in[25] + (size_t)le * 256 * DM; x.K = 256; x.N = DM; x.WT = (bf16*)(ws + WS_WDN) + (size_t)le * DM * 256; x.k0 = 64 * kb; x.n0 = 32 * nb; x.drow0 = 32 * nb; }
    return x;
}
__device__ __forceinline__ void convert_experts(const Frame& F, const __attribute__((address_space(4))) Args* args, unsigned char* ws, int layer, int vw, int nvw) {
    LAS float* scr = (LAS float*)(F.lds + F.wave * 16384);
    const int lo_ = layer * 32 * 384, hi_ = (layer + 1) * 32 * 384;
    float ta[32], tb[32]; XItem xa, xb;
    int it = lo_ + vw;
    if (it < hi_) { xa = xitem(args, ws, it); titem_load(xa.W, xa.N, xa.k0, xa.n0, F.lane, ta); }
    for (; it < hi_; it += nvw) {
        const bool hn = it + nvw < hi_;
        if (hn) { xb = xitem(args, ws, it + nvw); titem_load(xb.W, xb.N, xb.k0, xb.n0, F.lane, tb); }
        titem_finish(ta, xa.K, xa.WT, xa.k0, xa.drow0, scr, F.lane, 1.0f);
        if (hn) { xa = xb;
#pragma unroll
            for (int i = 0; i < 32; ++i) ta[i] = tb[i]; }
    }
}
__device__ __forceinline__ void ph_convert(const Frame& F, const __attribute__((address_space(4))) Args* args, unsigned char* ws) {
    for (int it = F.blk; it < DEPTH * NGRP; it += F.G) ssm_precompute(F, args, ws, it);
    LAS float* scr = (LAS float*)(F.lds + F.wave * 16384);
    const int gw = F.blk * NWAVES + F.wave, NGW = F.G * NWAVES;
    constexpr int I_IN = (DM / 64) * (1792 / 32), I_GLU = (D_SSM / 64) * (2 * D_SSM / 32), I_OUT = (DM / 64) * (DM / 32);
    constexpr int PER_LAYER = I_IN + I_GLU + I_OUT;
    for (int it = gw; it < DEPTH * 2 * 64; it += NGW) { const int li = it >> 6, q = it & 63, nb = q & 1, kb = q >> 1;
        transpose_item(args->in[16] + (size_t)li * 2048 * 64, 2048, 64, (bf16*)(ws + WS_W1T) + (size_t)li * 256 * 2048, 64 * kb, 32 * nb, 32 * nb, scr, F.lane); }
    { const int gt = F.blk * NTHR + F.tid, NGT = F.G * NTHR;
      for (int idx = gt; idx < DEPTH * 2 * 192 * 2048 / 8; idx += NGT) { const int li = idx / (192 * 256), rem = idx % (192 * 256);
          *(u32x4*)((bf16*)(ws + WS_W1T) + (size_t)li * 256 * 2048 + (size_t)64 * 2048 + (size_t)rem * 8) = (u32x4){0u, 0u, 0u, 0u}; }
      for (int idx = gt; idx < DEPTH * 2 * 4096; idx += NGT) { const int li = idx >> 12, f = (idx >> 6) & 63, e = idx & 63; ((bf16*)(ws + WS_W2T))[idx] = (bf16)f2bf(args->in[17][(size_t)li * 4096 + e * 64 + f]); }
    }
    for (int idx = gw; idx < DEPTH * 2 * 64; idx += NGW) { const int li = idx >> 6, e = idx & 63; const float* pp = args->in[15] + (size_t)li * 2048; const float* ww = args->in[16] + (size_t)li * 2048 * 64 + e;
        float a = 0.f;
#pragma unroll 8
        for (int k = F.lane; k < 2048; k += 64) a += pp[k] * ww[(size_t)k * 64];
        a = wave_sum(a, F.lane);
        if (F.lane == 0) ((float*)(ws + WS_CBIAS))[idx] = a; }
    for (int it = gw; it < DEPTH * PER_LAYER; it += NGW) {
        const int layer = it / PER_LAYER; int r = it % PER_LAYER;
        if (r < I_IN) { const int nb = r % 56, kb = r / 56;
            transpose_item(args->in[4] + (size_t)layer * DM * D_IN, DM, D_IN, (bf16*)(ws + WS_WIN) + (size_t)layer * NINP * DM, 64 * kb, 32 * nb, 32 * nb, scr, F.lane, (nb >= 16 && nb < 32) ? QSCALE : 1.0f); continue; }
        r -= I_IN;
        if (r < I_GLU) { const int nb = r % 32, kb = r / 32, n0 = 32 * nb;
            const int half = n0 >> 9, c = n0 & 511, drow = 256 * (c >> 7) + 128 * half + (c & 127);
            transpose_item(args->in[14] + (size_t)layer * D_SSM * 2 * D_SSM, D_SSM, 2 * D_SSM, (bf16*)(ws + WS_WGLU) + (size_t)layer * 2 * D_SSM * D_SSM, 64 * kb, n0, drow, scr, F.lane); continue; }
        r -= I_GLU;
        { const int nb = r % 32, kb = r / 32;
            transpose_item(args->in[5] + (size_t)layer * DM * DM, DM, DM, (bf16*)(ws + WS_WOUT) + (size_t)layer * DM * DM, 64 * kb, 32 * nb, 32 * nb, scr, F.lane); }
    }
    const int gt = F.blk * NTHR + F.tid, NGT = F.G * NTHR;
    for (int idx = gt; idx < DEPTH * 256 * DM; idx += NGT) {
        const int layer = idx / (256 * DM), rem = idx % (256 * DM), n = 1792 + rem / DM, k = rem % DM;
        const float v = n < D_IN ? args->in[4][(size_t)layer * DM * D_IN + (size_t)k * D_IN + n] : 0.f;
        ((bf16*)(ws + WS_WIN))[(size_t)layer * NINP * DM + (size_t)n * DM + k] = (bf16)f2bf(v);
    }
}

constexpr int PH_PER_LAYER = 8, N_PHASES = 1 + DEPTH * PH_PER_LAYER + 1;
#ifndef FAST_GEMM
#define FAST_GEMM 1
#endif
#ifndef REP_ATTN
#define REP_ATTN 1
#endif
#ifndef REP_CMP
#define REP_CMP 1
#endif
#ifndef REP_CARRY
#define REP_CARRY 1
#endif
#ifndef REP_CONV
#define REP_CONV 1
#endif
#ifndef REP_INPROJ
#define REP_INPROJ 1
#endif
#ifndef REP_G1
#define REP_G1 1
#endif
#ifndef REP_G2
#define REP_G2 1
#endif
#ifndef REP_GLU
#define REP_GLU 1
#endif
#ifndef REP_OUT
#define REP_OUT 1
#endif
#ifndef REP_NORM
#define REP_NORM 1
#endif
#ifndef REP_ROUTE
#define REP_ROUTE 1
#endif
#ifndef REP_GU
#define REP_GU 1
#endif
#ifndef REP_DN
#define REP_DN 1
#endif

__global__ void __launch_bounds__(NTHR, 2) fwd(Args args) {
    extern __shared__ __attribute__((aligned(16))) unsigned char lds_raw[];
    Frame F;
    F.lds = (LAS unsigned char*)lds_raw;
    F.tid = threadIdx.x; F.lane = F.tid & 63; F.wave = __builtin_amdgcn_readfirstlane(F.tid >> 6);
    F.blk = blockIdx.x; F.G = gridDim.x;
    typedef const __attribute__((address_space(4))) Args* KArgs;
    KArgs kp = (KArgs)__builtin_amdgcn_kernarg_segment_ptr();
    asm volatile("" : "+s"(kp));
    unsigned char* ws = kp->ws;
    volatile LAS unsigned* MISC = (volatile LAS unsigned*)(F.lds + MISC_OFF);
    if (F.tid < 32) MISC[F.tid] = 0u;
    __syncthreads();
    XcdBarrier bar; bar.bar = (unsigned*)(ws + WS_CTL) + CW_BAR; bar.x = 0; bar.st = nullptr;
    if (N_LAUNCH_MODE == 1) bar = xcd_barrier_post((unsigned*)(ws + WS_CTL) + CW_BAR, MISC + 8);
#define IN(k) (kp->ph_lo <= (k) && (k) < kp->ph_hi)
#define FRESH_IDS() do { int l_; asm volatile("v_mbcnt_lo_u32_b32 %0, -1, 0\n\tv_mbcnt_hi_u32_b32 %0, -1, %0" : "=v"(l_)); asm volatile("" : "+s"(F.wave), "+s"(F.blk), "+s"(F.G)); F.lane = l_; F.tid = F.wave * 64 + l_; asm volatile("" : "+s"(kp)); ws = kp->ws; bar.bar = (unsigned*)(ws + WS_CTL) + CW_BAR; } while (0)
#define SEAM(k) do { FRESH_IDS(); if (IN(k) && IN((k) + 1)) xcd_barrier(bar, F.tid); FRESH_IDS(); } while (0)

    const float* x0 = kp->in[0];
    float* XR = kp->out;
#define HN ((bf16*)(ws + WS_HN))
#define Z ((bf16*)(ws + WS_Z))
#define YC ((bf16*)(ws + WS_YC))
#define G1 ((bf16*)(ws + WS_G1))
#define KC ((bf16*)(ws + WS_KC))
#define VC ((bf16*)(ws + WS_VC))
#define LIST ((unsigned*)(ws + WS_LIST))
#define LISTW ((float*)(ws + WS_LISTW))
#define HID ((bf16*)(ws + WS_HID))
#define P2 ((bf16*)(ws + WS_P2))
#define P1B ((bf16*)(ws + WS_YC))
#define XB ((bf16*)(ws + WS_XB))
#define USSM ((bf16*)(ws + WS_USSM))
#define XL ((float*)(ws + WS_XL))
    LAS int* etab = (LAS int*)(F.lds + ETAB_OFF);

    if (IN(0)) { for (int rep_ = 0; rep_ < REP_CONV; ++rep_) ph_convert(F, kp, ws);
                 ph_norm(F, kp->in[0], nullptr, nullptr, nullptr, kp->in[1], HN); }
    SEAM(0);
    for (int layer = 0; layer < DEPTH; ++layer) {
        const int pb = 1 + layer * PH_PER_LAYER;
        const float* xin = layer == 0 ? x0 : XR;
        unsigned* gcnt = (unsigned*)(ws + WS_CTL) + CW_CNT + layer * 32 * 64;
        if (IN(pb + 0) && layer > 0) { ph_norm_b(F, XB, P1B, P2, kp->in[1] + layer * DM, HN); for (int rep_ = 1; rep_ < REP_NORM; ++rep_) ph_norm_b(F, XB, P1B, P2, kp->in[1] + layer * DM, HN); }
        if (layer > 0) SEAM(pb + 0);
        if (IN(pb + 1)) {
            pg8::Gemm g{HN, (const bf16*)(ws + WS_WIN) + (size_t)layer * NINP * DM, T, NINP, DM, DM, 0, nullptr, 0, 0, 128}; pg8::StaticOrder S; S.init(T, NINP, F.G, F.blk);
            pg8::EpiInProj E{Z, USSM};
            for (int rep_ = 0; rep_ < REP_INPROJ; ++rep_) pg8::gemm2<pg8::EpiInProj, pg8::StaticOrder, pg8::ADense>(F.lds, g, S, E, F.tid);
        }
        SEAM(pb + 1);
        if (IN(pb + 2)) {
            for (int rep_ = 0; rep_ < REP_CMP; ++rep_) {
                { pg8::Gemm g{Z, (const bf16*)(ws + WS_W1T) + (size_t)layer * 2 * 256 * 2048, 0, 256, 2048, ZP, (size_t)256 * 2048, nullptr, 0, 0, ZP * 2};
                  pg8::CmpOrder S{F.G, F.blk}; pg8::EpiCmpHid E{(bf16*)(ws + WS_HIDC), (const float*)(ws + WS_CBIAS) + layer * 128};
                  pg8::gemm2<pg8::EpiCmpHid, pg8::CmpOrder, pg8::ACompress>(F.lds, g, S, E, F.tid); }
                asm volatile("s_waitcnt vmcnt(0)" ::: "memory"); __syncthreads();
                for (int L = F.blk; L < 32; L += F.G) compress_stage2(F, L >> 4, L & 15, (const bf16*)(ws + WS_HIDC), (const bf16*)(ws + WS_W2T) + (size_t)layer * 2 * 4096, KC, VC);
            }
#pragma unroll 1
            for (int L = F.blk; L < NGRP * BATCH; L += F.G) {
                const int sg = L >> 3, sb = L & 7;
                FRESH_IDS();
                { pg8::Gemm g{USSM, (const bf16*)(ws + WS_BT1) + (size_t)layer * 32 * 256 * 256, 0, 256, 256, 512, (size_t)256 * 256, nullptr, 0, (size_t)2048 * 512, 128};
                  pg8::SingleUnit S{sg, sb}; pg8::EpiXloc E{XL};
                  pg8::gemm2<pg8::EpiXloc, pg8::SingleUnit, pg8::ADense>(F.lds, g, S, E, F.tid); }
                asm volatile("s_waitcnt vmcnt(0)" ::: "memory"); __syncthreads();
                for (int rep_ = 0; rep_ < REP_CARRY; ++rep_)
                if (F.wave == 0) ssm_carry_item(sb, sg, kp->in[6] + layer * NGRP * SST, kp->in[7] + layer * NGRP * SST, kp->in[13] + layer * NGRP, XL, USSM, F.lane);
                asm volatile("s_waitcnt vmcnt(0)" ::: "memory"); __syncthreads();
                FRESH_IDS();
                { pg8::Gemm g{USSM, (const bf16*)(ws + WS_BT2) + (size_t)layer * 32 * 256 * 384, 0, 256, 384, 512, (size_t)256 * 384, nullptr, 0, (size_t)2048 * 512, 128};
                  pg8::SingleUnit S{sg, sb}; pg8::EpiSsmOut E{G1};
                  pg8::gemm2<pg8::EpiSsmOut, pg8::SingleUnit, pg8::ADense>(F.lds, g, S, E, F.tid); }
            }
            if (F.G > 64) { if (F.blk >= 32) convert_experts(F, kp, ws, layer, (F.blk - 32) * NWAVES + F.wave, (F.G - 32) * NWAVES); }
            else convert_experts(F, kp, ws, layer, F.blk * NWAVES + F.wave, F.G * NWAVES);
        }
        SEAM(pb + 2);
        if (IN(pb + 3)) {
            { pg8::Gemm g{G1, (const bf16*)(ws + WS_WGLU) + (size_t)layer * 2 * D_SSM * D_SSM, T, 2 * D_SSM, D_SSM, D_SSM, 0, nullptr, 0, 0, 128}; pg8::StaticOrder S; S.init(T, 2 * D_SSM, F.G, F.blk);
              pg8::EpiGlu E{YC, DM};
              for (int rep_ = 0; rep_ < REP_GLU; ++rep_) pg8::gemm2<pg8::EpiGlu, pg8::StaticOrder, pg8::ADense>(F.lds, g, S, E, F.tid); }
            __syncthreads();
            int last_hkv = -1;
            for (int rep_ = 0; rep_ < REP_ATTN; ++rep_)
            for (int slot = F.blk; slot < 256; slot += F.G) {
                const int bh = slot >> 4, sq = slot & 15;
#pragma unroll 1
                for (int uq = 0; uq < 4; ++uq) { const int jt = uq == 0 ? 63 - sq : (uq == 1 ? 32 + sq : (uq == 2 ? 31 - sq : sq));
                    nsa::unit((LAS char*)F.lds, F.tid, bh >> 1, bh & 1, jt, Z, KC, VC, kp->in[18], YC, (bh & 1) != last_hkv); last_hkv = bh & 1; }
            }
        }
        SEAM(pb + 3);
        if (IN(pb + 4)) {
            pg8::Gemm g{YC, (const bf16*)(ws + WS_WOUT) + (size_t)layer * DM * DM, T, DM, DM, DM, 0, nullptr, 0, 0, 128}; pg8::StaticOrder S; S.init(T, DM, F.G, F.blk);
            pg8::EpiResidB E{layer == 0 ? kp->in[0] : nullptr, XB, XB};
            pg8::gemm2<pg8::EpiResidB, pg8::StaticOrder, pg8::ADense>(F.lds, g, S, E, F.tid);
        }
        SEAM(pb + 4);
        if (IN(pb + 5)) ph_norm_route(F, XB, kp->in[2] + layer * DM, kp->in[19] + (size_t)layer * DM * 4, kp->in[20] + layer * 4, kp->in[21] + (size_t)layer * 4 * DM * 8, kp->in[22] + layer * 32, HN, gcnt, LIST, LISTW);
        if (IN(pb + 5)) for (int rep_ = 1; rep_ < REP_ROUTE; ++rep_) ph_norm_route(F, XB, kp->in[2] + layer * DM, kp->in[19] + (size_t)layer * DM * 4, kp->in[20] + layer * 4, kp->in[21] + (size_t)layer * 4 * DM * 8, kp->in[22] + layer * 32, HN, gcnt + (2 + rep_) * 32 * 64, (unsigned*)(ws + 484 * MiB), (float*)(ws + 488 * MiB));
        SEAM(pb + 5);
        if (IN(pb + 6)) {
            build_expert_tab(F, gcnt, etab);
            pg8::Gemm g{HN, (const bf16*)(ws + WS_WGU) + (size_t)layer * 32 * 512 * DM, 0, 512, DM, DM, (size_t)512 * DM, LIST, LCAP, 0, 128};
            pg8::ExpertOrder S{etab, 2, F.G, F.blk};
            pg8::EpiGateUp E{HID, LISTW, LCAP};
            for (int rep_ = 0; rep_ < REP_GU; ++rep_) pg8::gemm2<pg8::EpiGateUp, pg8::ExpertOrder, pg8::AList>(F.lds, g, S, E, F.tid);
        }
        SEAM(pb + 6);
        if (IN(pb + 7)) {
            build_expert_tab(F, gcnt, etab);
            pg8::Gemm g{HID, (const bf16*)(ws + WS_WDN) + (size_t)layer * 32 * DM * 256, 0, DM, 256, 256, (size_t)DM * 256, nullptr, 0, 0, 128};
            pg8::ExpertOrder S{etab, 4, F.G, F.blk};
            for (int rep_ = 1; rep_ < REP_DN; ++rep_) { pg8::EpiDown Ed{P1B, (long)(P2 - P1B), LIST, LCAP}; pg8::gemm2<pg8::EpiDown, pg8::ExpertOrder, pg8::ADense>(F.lds, g, S, Ed, F.tid); }
            pg8::EpiDown E{P1B, (long)(P2 - P1B), LIST, LCAP};
            pg8::gemm2<pg8::EpiDown, pg8::ExpertOrder, pg8::ADense>(F.lds, g, S, E, F.tid);
        }
        SEAM(pb + 7);
    }
    if (IN(N_PHASES - 1)) ph_final_norm(F, kp->out, XB, P1B, P2, kp->in[3]);
#undef IN
#undef SEAM
#undef HN
#undef Z
#undef YC
#undef G1
#undef KC
#undef VC
#undef LIST
#undef LISTW
#undef HID
#undef P2
#undef P1B
#undef XB
#undef USSM
#undef XL
}

extern "C" void kernel_launch(void* const* d_in, const int* in_sizes, int n_in, void* d_out, int out_size, void* d_ws, size_t ws_size, hipStream_t stream) {
    static int grid = 0;
    if (grid == 0) {
        if (n_in != 26 || out_size != T * DM || ws_size < WS_END) { fprintf(stderr, "kernel_launch: unexpected shapes (n_in %d out %d ws %zu)\n", n_in, out_size, ws_size); grid = -1; return; }
        int dev = 0, cus = 0, per_cu = 0;
        if (hipGetDevice(&dev) != hipSuccess || hipDeviceGetAttribute(&cus, hipDeviceAttributeMultiprocessorCount, dev) != hipSuccess) { grid = -1; return; }
        if (hipFuncSetAttribute((const void*)fwd, hipFuncAttributeMaxDynamicSharedMemorySize, LDS_BYTES) != hipSuccess) { fprintf(stderr, "kernel_launch: hipFuncSetAttribute failed\n"); grid = -1; return; }
        if (hipOccupancyMaxActiveBlocksPerMultiprocessor(&per_cu, (const void*)fwd, NTHR, LDS_BYTES) != hipSuccess || per_cu < 1) fprintf(stderr, "kernel_launch: occupancy query says %d\n", per_cu);
        (void)hipGetLastError();
        grid = cus;
    }
    if (grid < 0) return;
    (void)hipMemsetAsync((char*)d_ws + WS_CTL, 0, CTL_ZERO_BYTES, stream);
    Args a{};
    for (int i = 0; i < 26; ++i) a.in[i] = (const float*)d_in[i];
    a.out = (float*)d_out; a.ws = (unsigned char*)d_ws;
    if (N_LAUNCH_MODE == 1) {
        a.ph_lo = 0; a.ph_hi = N_PHASES;
        hipLaunchKernelGGL(fwd, dim3(grid), dim3(NTHR), LDS_BYTES, stream, a);
    } else {
        for (int p = 0; p < N_PHASES; ++p) { a.ph_lo = p; a.ph_hi = p + 1; hipLaunchKernelGGL(fwd, dim3(grid), dim3(NTHR), LDS_BYTES, stream, a); }
    }
}
```
